# Optimizing an MI355X kernel written in HIP

```python
import math
import jax
import jax.numpy as jnp
from jax import lax
import numpy as np


D_MODEL = 1024
BATCH = 2
SEQ = 8192
DEPTH = 2

MIX_WIDTH = 1024
MIX_A = MIX_WIDTH // 2
MIX_B = MIX_WIDTH - MIX_A
MIX_C = MIX_WIDTH // 2
MIX_D = MIX_WIDTH - MIX_C

MLSTM_HEADS = 4
MLSTM_DH = MIX_A // MLSTM_HEADS
MLSTM_CHUNK = 64

LRU_HEADS = 4
LRU_DH = MIX_B // LRU_HEADS
LRU_CONV = 4
LRU_C = 8.0

S5_GROUP = 16
S5_GROUPS = MIX_C // S5_GROUP
S5_STATE = 64

GLA_HEADS = 4
GLA_DK = 64
GLA_DV = MIX_D // GLA_HEADS
GLA_GATE_RANK = 16
GLA_GATE_TEMP = 16.0
GLA_CHUNK = 64

N_EXPERTS = 64
TOP_K = 8
N_GROUPS = 8
TOPK_GROUPS = 4
D_EXPERT = 256
D_SHARED = 256
ROUTED_SCALE = 2.5
MOE_BLOCK = 128

N_EVEN = (DEPTH + 1) // 2
N_ODD = DEPTH // 2
ALPHA = (2.0 * DEPTH) ** 0.25
BETA = (8.0 * DEPTH) ** -0.25
EPS = 1e-5
F32 = jnp.float32

EVEN_SPLITS = [MIX_A, 2 * MIX_A, 3 * MIX_A, 4 * MIX_A, 4 * MIX_A + 2 * MLSTM_HEADS, 4 * MIX_A + 2 * MLSTM_HEADS + MIX_B]
EVEN_IN = 4 * MIX_A + 2 * MLSTM_HEADS + 2 * MIX_B
ODD_SPLITS = [MIX_C, MIX_C + GLA_HEADS * GLA_DK, MIX_C + 2 * GLA_HEADS * GLA_DK, MIX_C + 2 * GLA_HEADS * GLA_DK + MIX_D, MIX_C + 2 * GLA_HEADS * GLA_DK + 2 * MIX_D]
ODD_IN = MIX_C + 2 * GLA_HEADS * GLA_DK + 2 * MIX_D + GLA_GATE_RANK

kernel_name = 'hybrid_mlstm_rglru_s5_gla_moe_deepnorm'


def layer_norm(x, w, b):
    xf = x.astype(F32)
    mu = jnp.mean(xf, axis=-1, keepdims=True)
    xc = xf - mu
    y = xc * lax.rsqrt(jnp.mean(xc * xc, axis=-1, keepdims=True) + EPS)
    return (y * w.astype(F32) + b.astype(F32)).astype(x.dtype)


def head_norm(h, w, center):
    if center:
        h = h - jnp.mean(h, axis=-1, keepdims=True)
    y = h * lax.rsqrt(jnp.mean(h * h, axis=-1, keepdims=True) + EPS)
    return y.reshape(h.shape[0], h.shape[1], -1) * w.astype(F32)


def to_chunks(t, L):
    b, s, h = t.shape[:3]
    t = t.reshape((b, s // L, L, h) + t.shape[3:])
    return jnp.moveaxis(t, 3, 1)


def from_chunks(t):
    t = jnp.moveaxis(t, 1, 3)
    b, n, l, h = t.shape[:4]
    return t.reshape((b, n * l, h) + t.shape[4:])


def linear_scan(a, u, axis):
    def combine(lhs, rhs):
        a1, u1 = lhs
        a2, u2 = rhs
        return a1 * a2, a2 * u1 + u2
    return lax.associative_scan(combine, (a, u), axis=axis)[1]


def mlstm(q, k, v, i_pre, f_pre):
    L = MLSTM_CHUNK
    bsz, _, nh, dh = q.shape
    qc = to_chunks(q, L)
    kc = to_chunks(k, L) * (dh ** -0.5)
    vc = to_chunks(v, L)
    ig = to_chunks(i_pre, L)
    b = jnp.cumsum(to_chunks(jax.nn.log_sigmoid(f_pre), L), axis=-1)
    b_last = b[..., -1]
    w_loc = b_last[..., None] - b + ig
    m_loc = jnp.max(w_loc, axis=-1)
    p_loc = jnp.exp(w_loc - m_loc[..., None])
    c_loc = jnp.einsum('bhnl,bhnld,bhnle->bhnde', p_loc, kc, vc)
    n_loc = jnp.einsum('bhnl,bhnld->bhnd', p_loc, kc)

    def step(carry, xs):
        c, n, m = carry
        bl, ml, cl, nl = xs
        m_new = jnp.maximum(bl + m, ml)
        keep = jnp.exp(bl + m - m_new)
        add = jnp.exp(ml - m_new)
        c_new = keep[..., None, None] * c + add[..., None, None] * cl
        n_new = keep[..., None] * n + add[..., None] * nl
        return (c_new, n_new, m_new), (c, n, m)

    init = (jnp.zeros((bsz, nh, dh, dh), F32), jnp.zeros((bsz, nh, dh), F32), jnp.zeros((bsz, nh), F32))
    xs = (jnp.moveaxis(b_last, 2, 0), jnp.moveaxis(m_loc, 2, 0), jnp.moveaxis(c_loc, 2, 0), jnp.moveaxis(n_loc, 2, 0))
    _, (c_prev, n_prev, m_prev) = lax.scan(step, init, xs)
    c_prev = jnp.moveaxis(c_prev, 0, 2)
    n_prev = jnp.moveaxis(n_prev, 0, 2)
    m_prev = jnp.moveaxis(m_prev, 0, 2)
    causal = jnp.tril(jnp.ones((L, L), dtype=bool))
    d_mat = jnp.where(causal, b[..., :, None] - b[..., None, :] + ig[..., None, :], -jnp.inf)
    m_inter = b + m_prev[..., None]
    m_i = jnp.maximum(m_inter, jnp.max(d_mat, axis=-1))
    s = jnp.einsum('bhnid,bhnjd->bhnij', qc, kc) * jnp.exp(d_mat - m_i[..., None])
    w_inter = jnp.exp(m_inter - m_i)
    num = jnp.einsum('bhnij,bhnje->bhnie', s, vc) + w_inter[..., None] * jnp.einsum('bhnid,bhnde->bhnie', qc, c_prev)
    den = jnp.sum(s, axis=-1) + w_inter * jnp.einsum('bhnid,bhnd->bhni', qc, n_prev)
    h = num / jnp.maximum(jnp.abs(den), jnp.exp(-m_i))[..., None]
    return from_chunks(h)


def rglru(xb, gb, conv_w, conv_b, wa, ba, wx, bx, lam):
    bsz, s, c = xb.shape
    xc = lax.conv_general_dilated(xb, conv_w[:, None, :], (1,), [(LRU_CONV - 1, 0)],
                                  dimension_numbers=('NWC', 'WIO', 'NWC'), feature_group_count=c) + conv_b
    xh = xc.reshape(bsz, s, LRU_HEADS, LRU_DH)
    r = jax.nn.sigmoid((jnp.einsum('bshi,hij->bshj', xh, wa).reshape(bsz, s, c) + ba).astype(F32))
    i = jax.nn.sigmoid((jnp.einsum('bshi,hij->bshj', xh, wx).reshape(bsz, s, c) + bx).astype(F32))
    log_a = -LRU_C * r * jax.nn.softplus(-lam.astype(F32))
    a = jnp.exp(log_a)
    u = jnp.sqrt(-jnp.expm1(2.0 * log_a)) * i * xc.astype(F32)
    h = linear_scan(a, u, axis=1)
    return h * jax.nn.gelu(gb.astype(F32))


def even_mixer(x, w_in, gate_b, norm_w, conv_w, conv_b, wa, ba, wx, bx, lam):
    bsz, s, _ = x.shape
    q, k, v, o, g, xb, gb = jnp.split(x @ w_in, EVEN_SPLITS, axis=-1)
    heads = lambda t: t.astype(F32).reshape(bsz, s, MLSTM_HEADS, MLSTM_DH)
    g = g.astype(F32) + gate_b.astype(F32)
    h = mlstm(heads(q), heads(k), heads(v), g[..., :MLSTM_HEADS], g[..., MLSTM_HEADS:])
    y_a = head_norm(h, norm_w, True) * jax.nn.sigmoid(o.astype(F32))
    y_b = rglru(xb, gb, conv_w, conv_b, wa, ba, wx, bx, lam)
    return jnp.concatenate([y_a.astype(x.dtype), y_b.astype(x.dtype)], axis=-1)


def s5(u, lam_re, lam_im, b_re, b_im, c_re, c_im, d_skip, log_dt, glu_w, glu_b):
    bsz, s, _ = u.shape
    uf = u.astype(F32).reshape(bsz, s, S5_GROUPS, S5_GROUP)
    lr = lam_re.astype(F32)
    li = lam_im.astype(F32)
    dt = jnp.exp(log_dt.astype(F32))[:, None]
    mag = jnp.exp(lr * dt)
    abar_re = mag * jnp.cos(li * dt)
    abar_im = mag * jnp.sin(li * dt)
    den = lr * lr + li * li
    nr = abar_re - 1.0
    coef_re = (nr * lr + abar_im * li) / den
    coef_im = (abar_im * lr - nr * li) / den
    br = b_re.astype(F32)
    bi = b_im.astype(F32)
    bbar_re = coef_re[..., None] * br - coef_im[..., None] * bi
    bbar_im = coef_re[..., None] * bi + coef_im[..., None] * br
    bu_re = jnp.einsum('bsgh,gph->bsgp', uf, bbar_re)
    bu_im = jnp.einsum('bsgh,gph->bsgp', uf, bbar_im)
    a_re = jnp.broadcast_to(abar_re, (1, s, S5_GROUPS, S5_STATE))
    a_im = jnp.broadcast_to(abar_im, (1, s, S5_GROUPS, S5_STATE))

    def combine(lhs, rhs):
        a1r, a1i, u1r, u1i = lhs
        a2r, a2i, u2r, u2i = rhs
        return (a1r * a2r - a1i * a2i, a1r * a2i + a1i * a2r,
                a2r * u1r - a2i * u1i + u2r, a2r * u1i + a2i * u1r + u2i)

    _, _, xr, xi = lax.associative_scan(combine, (a_re, a_im, bu_re, bu_im), axis=1)
    y = (jnp.einsum('bsgp,ghp->bsgh', xr, c_re.astype(F32)) - jnp.einsum('bsgp,ghp->bsgh', xi, c_im.astype(F32))
         + d_skip.astype(F32).reshape(S5_GROUPS, S5_GROUP) * uf)
    g = jax.nn.gelu(y.reshape(bsz, s, MIX_C)).astype(u.dtype)
    return g * jax.nn.sigmoid(g @ glu_w + glu_b)


def gla(q, k, v, log_alpha, r, norm_w):
    L = GLA_CHUNK
    bsz, _, nh, dk = q.shape
    dv = v.shape[-1]
    qc = to_chunks(q, L) * (dk ** -0.5)
    kc = to_chunks(k, L)
    vc = to_chunks(v, L)
    bcum = jnp.cumsum(to_chunks(log_alpha, L), axis=3)
    b_last = bcum[..., -1, :]
    q_dec = qc * jnp.exp(bcum)
    k_inv = kc * jnp.exp(-bcum)
    k_end = kc * jnp.exp(b_last[..., None, :] - bcum)
    u = jnp.einsum('bhnld,bhnle->bhnde', k_end, vc)

    def step(state, xs):
        g, uu = xs
        return jnp.exp(g)[..., None] * state + uu, state

    _, s_prev = lax.scan(step, jnp.zeros((bsz, nh, dk, dv), F32), (jnp.moveaxis(b_last, 2, 0), jnp.moveaxis(u, 2, 0)))
    s_prev = jnp.moveaxis(s_prev, 0, 2)
    causal = jnp.tril(jnp.ones((L, L), dtype=bool))
    att = jnp.where(causal, jnp.einsum('bhnid,bhnjd->bhnij', q_dec, k_inv), 0.0)
    o = jnp.einsum('bhnij,bhnje->bhnie', att, vc) + jnp.einsum('bhnid,bhnde->bhnie', q_dec, s_prev)
    o = head_norm(from_chunks(o), norm_w, False)
    return o * jax.nn.silu(r.astype(F32))


def odd_mixer(x, w_in, lam_re, lam_im, b_re, b_im, c_re, c_im, d_skip, log_dt, glu_w, glu_b, gate_w, gate_b, norm_w):
    bsz, s, _ = x.shape
    u, q, k, v, r, glow = jnp.split(x @ w_in, ODD_SPLITS, axis=-1)
    y_c = s5(u, lam_re, lam_im, b_re, b_im, c_re, c_im, d_skip, log_dt, glu_w, glu_b)
    log_alpha = jax.nn.log_sigmoid((glow @ gate_w + gate_b).astype(F32)) / GLA_GATE_TEMP
    hk = lambda t, d: t.astype(F32).reshape(bsz, s, GLA_HEADS, d)
    y_d = gla(hk(q, GLA_DK), hk(k, GLA_DK), hk(v, GLA_DV), hk(log_alpha, GLA_DK), r, norm_w)
    return jnp.concatenate([y_c.astype(x.dtype), y_d.astype(x.dtype)], axis=-1)


def moe(x, router_w, router_bias, w_gate, w_up, w_down, sw_gate, sw_up, sw_down):
    bsz, s, d = x.shape
    xt = x.reshape(-1, d)
    t = xt.shape[0]
    scores = jax.nn.sigmoid((xt @ router_w).astype(F32))
    biased = scores + router_bias.astype(F32)
    grp_score = jnp.sum(lax.top_k(biased.reshape(t, N_GROUPS, -1), 2)[0], axis=-1)
    _, grp_idx = lax.top_k(grp_score, TOPK_GROUPS)
    grp_mask = jnp.sum(jax.nn.one_hot(grp_idx, N_GROUPS, dtype=F32), axis=-2) > 0
    exp_mask = jnp.repeat(grp_mask, N_EXPERTS // N_GROUPS, axis=-1)
    _, idx = lax.top_k(jnp.where(exp_mask, biased, -jnp.inf), TOP_K)
    wts = jnp.take_along_axis(scores, idx, axis=-1)
    wts = wts / jnp.sum(wts, axis=-1, keepdims=True) * ROUTED_SCALE
    n_assign = t * TOP_K
    e_flat = idx.reshape(-1)
    tok = jnp.broadcast_to(jnp.arange(t, dtype=jnp.int32)[:, None], (t, TOP_K)).reshape(-1)
    order = jnp.argsort(e_flat)
    e_s = e_flat[order]
    tok_s = tok[order]
    w_s = wts.reshape(-1)[order]
    counts = jnp.bincount(e_flat, length=N_EXPERTS)
    start = jnp.cumsum(counts) - counts
    padded = (counts + MOE_BLOCK - 1) // MOE_BLOCK * MOE_BLOCK
    pend = jnp.cumsum(padded)
    pstart = pend - padded
    pos = pstart[e_s] + jnp.arange(n_assign) - start[e_s]
    n_blocks = n_assign // MOE_BLOCK + N_EXPERTS
    rows = n_blocks * MOE_BLOCK
    row_tok = jnp.zeros((rows,), jnp.int32).at[pos].set(tok_s)
    row_w = jnp.zeros((rows,), F32).at[pos].set(w_s)
    block_e = jnp.minimum(jnp.searchsorted(pend, jnp.arange(n_blocks) * MOE_BLOCK, side='right'), N_EXPERTS - 1)

    def expert_block(args):
        b_tok, b_w, e = args
        xb = xt[b_tok]
        h = jax.nn.silu(xb @ w_gate[e]) * (xb @ w_up[e])
        return (h @ w_down[e]) * b_w[:, None].astype(xt.dtype)

    y_rows = lax.map(expert_block, (row_tok.reshape(n_blocks, MOE_BLOCK), row_w.reshape(n_blocks, MOE_BLOCK), block_e))
    routed = jax.ops.segment_sum(y_rows.reshape(rows, d), row_tok, num_segments=t)
    shared = (jax.nn.silu(xt @ sw_gate) * (xt @ sw_up)) @ sw_down
    return (routed + shared).reshape(bsz, s, d)


def setup_inputs(seed: int = 0) -> dict:
    key = jax.random.key(seed)
    keys = iter(jax.random.split(key, 64))

    def nrm(shape, scale):
        return jax.random.normal(next(keys), shape, F32) * scale

    def gain(shape):
        return 1.0 + nrm(shape, 0.02)

    D = D_MODEL
    x = nrm((BATCH, SEQ, D), 1.0)
    ln1_w = gain((DEPTH, D))
    ln1_b = nrm((DEPTH, D), 0.02)
    ln2_w = gain((DEPTH, D))
    ln2_b = nrm((DEPTH, D), 0.02)
    w_out = nrm((DEPTH, MIX_WIDTH, D), MIX_WIDTH ** -0.5 * BETA)
    w_in_even = nrm((N_EVEN, D, EVEN_IN), D ** -0.5)
    mlstm_gate_b = jnp.concatenate([nrm((N_EVEN, MLSTM_HEADS), 0.1),
                                    jnp.linspace(3.0, 6.0, MLSTM_HEADS, dtype=F32) + nrm((N_EVEN, MLSTM_HEADS), 0.1)], axis=-1)
    mlstm_norm_w = gain((N_EVEN, MIX_A))
    lru_conv_w = nrm((N_EVEN, LRU_CONV, MIX_B), LRU_CONV ** -0.5)
    lru_conv_b = nrm((N_EVEN, MIX_B), 0.02)
    lru_wa = nrm((N_EVEN, LRU_HEADS, LRU_DH, LRU_DH), LRU_DH ** -0.5)
    lru_ba = nrm((N_EVEN, MIX_B), 0.02)
    lru_wx = nrm((N_EVEN, LRU_HEADS, LRU_DH, LRU_DH), LRU_DH ** -0.5)
    lru_bx = nrm((N_EVEN, MIX_B), 0.02)
    a0 = jax.random.uniform(next(keys), (N_EVEN, MIX_B), F32, minval=0.9, maxval=0.999)
    p0 = a0 ** (1.0 / LRU_C)
    lru_lambda = jnp.log(p0) - jnp.log1p(-p0)
    w_in_odd = nrm((N_ODD, D, ODD_IN), D ** -0.5)
    s5_lam_re = -0.5 + nrm((N_ODD, S5_GROUPS, S5_STATE), 0.01)
    s5_lam_im = jnp.pi * jnp.arange(S5_STATE, dtype=F32) + nrm((N_ODD, S5_GROUPS, S5_STATE), 0.01)
    s5_b_re = nrm((N_ODD, S5_GROUPS, S5_STATE, S5_GROUP), S5_GROUP ** -0.5)
    s5_b_im = nrm((N_ODD, S5_GROUPS, S5_STATE, S5_GROUP), S5_GROUP ** -0.5)
    s5_c_re = nrm((N_ODD, S5_GROUPS, S5_GROUP, S5_STATE), S5_STATE ** -0.5)
    s5_c_im = nrm((N_ODD, S5_GROUPS, S5_GROUP, S5_STATE), S5_STATE ** -0.5)
    s5_d = nrm((N_ODD, MIX_C), 1.0)
    s5_log_dt = jax.random.uniform(next(keys), (N_ODD, S5_GROUPS), F32, minval=math.log(1e-3), maxval=math.log(1e-1))
    s5_glu_w = nrm((N_ODD, MIX_C, MIX_C), MIX_C ** -0.5)
    s5_glu_b = nrm((N_ODD, MIX_C), 0.02)
    gla_gate_w = nrm((N_ODD, GLA_GATE_RANK, GLA_HEADS * GLA_DK), GLA_GATE_RANK ** -0.5)
    gla_gate_b = nrm((N_ODD, GLA_HEADS * GLA_DK), 0.02)
    gla_norm_w = gain((N_ODD, MIX_D))
    router_w = nrm((DEPTH, D, N_EXPERTS), D ** -0.5)
    router_bias = nrm((DEPTH, N_EXPERTS), 0.01)
    exp_w_gate = nrm((DEPTH, N_EXPERTS, D, D_EXPERT), D ** -0.5)
    exp_w_up = nrm((DEPTH, N_EXPERTS, D, D_EXPERT), D ** -0.5)
    exp_w_down = nrm((DEPTH, N_EXPERTS, D_EXPERT, D), D_EXPERT ** -0.5 * BETA)
    sh_w_gate = nrm((DEPTH, D, D_SHARED), D ** -0.5)
    sh_w_up = nrm((DEPTH, D, D_SHARED), D ** -0.5)
    sh_w_down = nrm((DEPTH, D_SHARED, D), D_SHARED ** -0.5 * BETA)
    return {'x': x, 'ln1_w': ln1_w, 'ln1_b': ln1_b, 'ln2_w': ln2_w, 'ln2_b': ln2_b, 'w_out': w_out,
            'w_in_even': w_in_even, 'mlstm_gate_b': mlstm_gate_b, 'mlstm_norm_w': mlstm_norm_w,
            'lru_conv_w': lru_conv_w, 'lru_conv_b': lru_conv_b, 'lru_wa': lru_wa, 'lru_ba': lru_ba,
            'lru_wx': lru_wx, 'lru_bx': lru_bx, 'lru_lambda': lru_lambda,
            'w_in_odd': w_in_odd, 's5_lam_re': s5_lam_re, 's5_lam_im': s5_lam_im, 's5_b_re': s5_b_re,
            's5_b_im': s5_b_im, 's5_c_re': s5_c_re, 's5_c_im': s5_c_im, 's5_d': s5_d, 's5_log_dt': s5_log_dt,
            's5_glu_w': s5_glu_w, 's5_glu_b': s5_glu_b, 'gla_gate_w': gla_gate_w, 'gla_gate_b': gla_gate_b,
            'gla_norm_w': gla_norm_w, 'router_w': router_w, 'router_bias': router_bias,
            'exp_w_gate': exp_w_gate, 'exp_w_up': exp_w_up, 'exp_w_down': exp_w_down,
            'sh_w_gate': sh_w_gate, 'sh_w_up': sh_w_up, 'sh_w_down': sh_w_down}


def reference(x, ln1_w, ln1_b, ln2_w, ln2_b, w_out,
              w_in_even, mlstm_gate_b, mlstm_norm_w,
              lru_conv_w, lru_conv_b, lru_wa, lru_ba, lru_wx, lru_bx, lru_lambda,
              w_in_odd, s5_lam_re, s5_lam_im, s5_b_re, s5_b_im, s5_c_re, s5_c_im, s5_d, s5_log_dt,
              s5_glu_w, s5_glu_b, gla_gate_w, gla_gate_b, gla_norm_w,
              router_w, router_bias, exp_w_gate, exp_w_up, exp_w_down,
              sh_w_gate, sh_w_up, sh_w_down):
    h = x
    for layer in range(DEPTH):
        j = layer // 2
        if layer % 2 == 0:
            mixed = even_mixer(h, w_in_even[j], mlstm_gate_b[j], mlstm_norm_w[j], lru_conv_w[j], lru_conv_b[j],
                               lru_wa[j], lru_ba[j], lru_wx[j], lru_bx[j], lru_lambda[j])
        else:
            mixed = odd_mixer(h, w_in_odd[j], s5_lam_re[j], s5_lam_im[j], s5_b_re[j], s5_b_im[j], s5_c_re[j],
                              s5_c_im[j], s5_d[j], s5_log_dt[j], s5_glu_w[j], s5_glu_b[j], gla_gate_w[j],
                              gla_gate_b[j], gla_norm_w[j])
        h = layer_norm(ALPHA * h + mixed @ w_out[layer], ln1_w[layer], ln1_b[layer])
        ffn = moe(h, router_w[layer], router_bias[layer], exp_w_gate[layer], exp_w_up[layer], exp_w_down[layer],
                  sh_w_gate[layer], sh_w_up[layer], sh_w_down[layer])
        h = layer_norm(ALPHA * h + ffn, ln2_w[layer], ln2_b[layer])
    return h
```

```cpp
#include <hip/hip_runtime.h>
#ifdef CPU_TEST
#include <cmath>
#include <cstddef>
#define HD inline
#else
#define HD __device__ __forceinline__
#endif

#ifndef SEQ_
#define SEQ_ 8192
#endif
namespace nv {
constexpr int B_ = 2, S_ = SEQ_, T_ = B_ * S_, D_ = 1024, NCH = S_ / 64;
constexpr int EIN = 3080, OIN = 2064;
constexpr int SLAB = (S_ < 1024 ? S_ : 1024);
constexpr float ALPHA = 1.41421356237309515f, EPS = 1e-5f;

enum Stage { ST_GEMM, ST_ML_GATES, ST_ML_CLOC, ST_ML_SCAN, ST_ML_MI, ST_ML_SMAT, ST_ML_DEN, ST_ML_H, ST_ML_NORM,
             ST_LRU_CONV, ST_LRU_GATE, ST_LRU_SCAN, ST_LN, ST_SCORES, ST_SELECT, ST_HID, ST_FFN,
             ST_S5_PAR, ST_S5_SCAN, ST_S5_OUT, ST_S5_GLU, ST_GLA_GATE, ST_GLA_CUM, ST_GLA_U, ST_GLA_SCAN, ST_GLA_ATT, ST_GLA_O, ST_GLA_NORM };

struct Ctx {
    const float* in[38];
    const float* gA; const float* gW; const float* gR; float* gC; const float* gBias;
    const float* hcur;
    float* hout;
    const float* lnw; const float* lnb;
    float* proj; float* mixed; float* z;
    float* mb; float* mig; float* mblast; float* mmloc; float* mmprev; float* cloc; float* nloc; float* smat; float* mmi; float* mwin; float* mden; float* htil;
    float* lxc; float* la; float* lu;
    float* scores; int* ridx; float* rwt; float* hid;
    float* s5ab; float* s5bbr; float* s5bbi; float* s5st; float* s5x; float* s5g;
    float* gla_la; float* gla_bc; float* gla_bl; float* gu; float* gatt; float* go;
    long gM, gN, gK, glda, gldw, gldc, gldr;
    float gralpha; int layer; int slab; int pad0;
};

HD float sigm(float x) { return 1.0f / (1.0f + expf(-x)); }
HD float logsig(float x) { return fminf(x, 0.f) - log1pf(expf(-fabsf(x))); }
HD float softplus(float x) { return fmaxf(x, 0.f) + log1pf(expf(-fabsf(x))); }
HD float silu(float x) { return x * sigm(x); }
HD float gelu_t(float x) { return 0.5f * x * (1.0f + tanhf(0.7978845608028654f * (x + 0.044715f * x * x * x))); }

template <int ST> HD void item(const Ctx& c, long idx);

template <> HD void item<ST_GEMM>(const Ctx& c, long idx) {
    const long m = idx / c.gN, n = idx % c.gN;
    float acc = 0.f;
    const float* a = c.gA + m * c.glda; const float* w = c.gW + n;
    for (long k = 0; k < c.gK; ++k) acc += a[k] * w[k * c.gldw];
    if (c.gBias) acc += c.gBias[n];
    if (c.gR) acc += c.gralpha * c.gR[m * c.gldr + n];
    c.gC[m * c.gldc + n] = acc;
}
template <> HD void item<ST_ML_GATES>(const Ctx& c, long idx) {
    const int bh = (int)(idx / NCH), n = (int)(idx % NCH), b = bh / 4, h = bh % 4;
    const float* gb = c.in[7];
    const long t0 = (long)b * S_ + n * 64; const long o0 = (long)bh * S_ + n * 64;
    float acc = 0.f;
    for (int l = 0; l < 64; ++l) {
        const float f = c.proj[(t0 + l) * EIN + 2052 + h] + gb[4 + h];
        acc += logsig(f);
        c.mb[o0 + l] = acc;
        c.mig[o0 + l] = c.proj[(t0 + l) * EIN + 2048 + h] + gb[h];
    }
    c.mblast[idx] = acc;
    float ml = -INFINITY;
    for (int l = 0; l < 64; ++l) ml = fmaxf(ml, acc - c.mb[o0 + l] + c.mig[o0 + l]);
    c.mmloc[idx] = ml;
}
template <> HD void item<ST_ML_CLOC>(const Ctx& c, long idx) {
    const int e = (int)(idx % 128), d = (int)((idx / 128) % 128); const long cn = idx / 16384;
    const int bh = (int)(cn / NCH), n = (int)(cn % NCH), b = bh / 4, h = bh % 4;
    const long t0 = (long)b * S_ + n * 64; const long o0 = (long)bh * S_ + n * 64;
    const float bl = c.mblast[cn], ml = c.mmloc[cn]; const float sc = 0.08838834764831845f;
    float acc = 0.f, accn = 0.f;
    for (int l = 0; l < 64; ++l) {
        const float p = expf(bl - c.mb[o0 + l] + c.mig[o0 + l] - ml);
        const float kk = c.proj[(t0 + l) * EIN + 512 + h * 128 + d] * sc;
        acc += p * kk * c.proj[(t0 + l) * EIN + 1024 + h * 128 + e];
        accn += p * kk;
    }
    c.cloc[idx] = acc;
    if (e == 0) c.nloc[cn * 128 + d] = accn;
}
template <> HD void item<ST_ML_SCAN>(const Ctx& c, long idx) {
    const bool isn = idx >= 8L * 16384;
    long bh, de; float* buf; long stride;
    if (!isn) { bh = idx / 16384; de = idx % 16384; buf = c.cloc; stride = 16384; }
    else { const long r = idx - 8L * 16384; bh = r / 128; de = r % 128; buf = c.nloc; stride = 128; }
    float st = 0.f, m = 0.f;
    for (int n = 0; n < NCH; ++n) {
        const long cn = bh * NCH + n;
        const float cl = buf[cn * stride + de]; buf[cn * stride + de] = st;
        const float bl = c.mblast[cn], ml = c.mmloc[cn];
        const float mn = fmaxf(bl + m, ml);
        st = expf(bl + m - mn) * st + expf(ml - mn) * cl;
        if (!isn && de == 0) c.mmprev[cn] = m;
        m = mn;
    }
}
template <> HD void item<ST_ML_MI>(const Ctx& c, long idx) {
    const long bh = idx / S_; const int s = (int)(idx % S_), n = s / 64, i = s % 64; const long cn = bh * NCH + n;
    const long o0 = bh * S_ + n * 64;
    const float bi = c.mb[idx]; const float minter = bi + c.mmprev[cn];
    float dmax = -INFINITY;
    for (int j = 0; j <= i; ++j) dmax = fmaxf(dmax, bi - c.mb[o0 + j] + c.mig[o0 + j]);
    const float mi = fmaxf(minter, dmax);
    c.mmi[idx] = mi; c.mwin[idx] = expf(minter - mi);
}
template <> HD void item<ST_ML_SMAT>(const Ctx& c, long idx) {
    const int j = (int)(idx % 64), i = (int)((idx / 64) % 64); const long cn = idx / 4096;
    const int bh = (int)(cn / NCH), n = (int)(cn % NCH), b = bh / 4, h = bh % 4;
    if (j > i) { c.smat[idx] = 0.f; return; }
    const long t0 = (long)b * S_ + n * 64; const long o0 = (long)bh * S_ + n * 64;
    const float* q = c.proj + (t0 + i) * EIN + h * 128; const float* k = c.proj + (t0 + j) * EIN + 512 + h * 128;
    float dot = 0.f;
    for (int d = 0; d < 128; ++d) dot += q[d] * k[d];
    dot *= 0.08838834764831845f;
    c.smat[idx] = dot * expf(c.mb[o0 + i] - c.mb[o0 + j] + c.mig[o0 + j] - c.mmi[o0 + i]);
}
template <> HD void item<ST_ML_DEN>(const Ctx& c, long idx) {
    const long bh = idx / S_; const int s = (int)(idx % S_), n = s / 64, i = s % 64; const long cn = bh * NCH + n;
    const int b = (int)(bh / 4), h = (int)(bh % 4);
    float den = 0.f;
    for (int j = 0; j <= i; ++j) den += c.smat[cn * 4096 + i * 64 + j];
    const float* q = c.proj + ((long)b * S_ + s) * EIN + h * 128;
    float qn = 0.f;
    for (int d = 0; d < 128; ++d) qn += q[d] * c.nloc[cn * 128 + d];
    den += c.mwin[idx] * qn;
    c.mden[idx] = fmaxf(fabsf(den), expf(-c.mmi[idx]));
}
template <> HD void item<ST_ML_H>(const Ctx& c, long idx) {
    const int e = (int)(idx % 128); const long bs = idx / 128; const long bh = bs / S_; const int s = (int)(bs % S_), n = s / 64, i = s % 64;
    const long cn = bh * NCH + n; const int b = (int)(bh / 4), h = (int)(bh % 4);
    const long t0 = (long)b * S_ + n * 64;
    float num = 0.f;
    for (int j = 0; j <= i; ++j) num += c.smat[cn * 4096 + i * 64 + j] * c.proj[(t0 + j) * EIN + 1024 + h * 128 + e];
    const float* q = c.proj + (t0 + i) * EIN + h * 128;
    float qc = 0.f;
    for (int d = 0; d < 128; ++d) qc += q[d] * c.cloc[cn * 16384 + d * 128 + e];
    num += c.mwin[bs] * qc;
    c.htil[(t0 + i) * 512 + h * 128 + e] = num / c.mden[bs];
}
template <> HD void item<ST_ML_NORM>(const Ctx& c, long idx) {
    const long bh = idx / S_; const int s = (int)(idx % S_); const int b = (int)(bh / 4), h = (int)(bh % 4);
    const long t = (long)b * S_ + s;
    const float* ht = c.htil + t * 512 + h * 128; const float* nw = c.in[8];
    float mean = 0.f;
    for (int e = 0; e < 128; ++e) mean += ht[e];
    mean *= (1.f / 128.f);
    float var = 0.f;
    for (int e = 0; e < 128; ++e) { const float d = ht[e] - mean; var += d * d; }
    const float rstd = 1.0f / sqrtf(var * (1.f / 128.f) + EPS);
    for (int e = 0; e < 128; ++e)
        c.mixed[t * 1024 + h * 128 + e] = (ht[e] - mean) * rstd * nw[h * 128 + e] * sigm(c.proj[t * EIN + 1536 + h * 128 + e]);
}
template <> HD void item<ST_LRU_CONV>(const Ctx& c, long idx) {
    const long t = idx / 512; const int ch = (int)(idx % 512); const int s = (int)(t % S_);
    const float* cw = c.in[9];
    float acc = c.in[10][ch];
    for (int j = 0; j < 4; ++j) { const int ss = s - 3 + j; if (ss >= 0) acc += cw[j * 512 + ch] * c.proj[(t - 3 + j) * EIN + 2056 + ch]; }
    c.lxc[idx] = acc;
}
template <> HD void item<ST_LRU_GATE>(const Ctx& c, long idx) {
    const long t = idx / 512; const int ch = (int)(idx % 512), hh = ch / 128, jj = ch % 128;
    const float* wa = c.in[11] + (long)hh * 16384; const float* wx = c.in[13] + (long)hh * 16384;
    const float* xr = c.lxc + t * 512 + hh * 128;
    float ra = c.in[12][ch], xa = c.in[14][ch];
    for (int i = 0; i < 128; ++i) { ra += xr[i] * wa[i * 128 + jj]; xa += xr[i] * wx[i * 128 + jj]; }
    const float r = sigm(ra), ii = sigm(xa);
    const float la = -8.0f * r * softplus(-c.in[15][ch]);
    c.la[idx] = expf(la);
    c.lu[idx] = sqrtf(-expm1f(2.0f * la)) * ii * c.lxc[idx];
}
template <> HD void item<ST_LRU_SCAN>(const Ctx& c, long idx) {
    const int b = (int)(idx / 512), ch = (int)(idx % 512);
    float h = 0.f;
    for (int s = 0; s < S_; ++s) {
        const long t = (long)b * S_ + s;
        h = c.la[t * 512 + ch] * h + c.lu[t * 512 + ch];
        c.mixed[t * 1024 + 512 + ch] = h * gelu_t(c.proj[t * EIN + 2568 + ch]);
    }
}
template <> HD void item<ST_LN>(const Ctx& c, long t) {
    const float* zr = c.z + t * 1024;
    float mean = 0.f;
    for (int i = 0; i < 1024; ++i) mean += zr[i];
    mean *= (1.f / 1024.f);
    float var = 0.f;
    for (int i = 0; i < 1024; ++i) { const float d = zr[i] - mean; var += d * d; }
    const float rstd = 1.0f / sqrtf(var * (1.f / 1024.f) + EPS);
    for (int i = 0; i < 1024; ++i) c.hout[t * 1024 + i] = (zr[i] - mean) * rstd * c.lnw[i] + c.lnb[i];
}
template <> HD void item<ST_SCORES>(const Ctx& c, long idx) {
    const long t = idx / 64; const int e = (int)(idx % 64);
    const float* rw = c.in[30] + (long)c.layer * 1024 * 64; const float* hr = c.hcur + t * 1024;
    float acc = 0.f;
    for (int k = 0; k < 1024; ++k) acc += hr[k] * rw[k * 64 + e];
    c.scores[idx] = sigm(acc);
}
template <> HD void item<ST_SELECT>(const Ctx& c, long t) {
    const float* sc = c.scores + t * 64; const float* bias = c.in[31] + c.layer * 64;
    float gs[8];
#pragma unroll
    for (int g = 0; g < 8; ++g) {
        float m1 = -INFINITY, m2 = -INFINITY;
        for (int j = 0; j < 8; ++j) { const float v = sc[g * 8 + j] + bias[g * 8 + j]; if (v > m1) { m2 = m1; m1 = v; } else if (v > m2) m2 = v; }
        gs[g] = m1 + m2;
    }
    unsigned gsel = 0;
    for (int it = 0; it < 4; ++it) {
        float best = -INFINITY; int bi = 0;
#pragma unroll
        for (int g = 0; g < 8; ++g) { const bool ok = !((gsel >> g) & 1u) && gs[g] > best; best = ok ? gs[g] : best; bi = ok ? g : bi; }
        gsel |= 1u << bi;
    }
    unsigned long long taken = 0ull; float wsum = 0.f;
    for (int it = 0; it < 8; ++it) {
        float best = -INFINITY; int bi = 0;
        for (int e = 0; e < 64; ++e) {
            if (!((gsel >> (e >> 3)) & 1u) || ((taken >> e) & 1ull)) continue;
            const float v = sc[e] + bias[e];
            if (v > best) { best = v; bi = e; }
        }
        taken |= 1ull << bi;
        c.ridx[t * 8 + it] = bi; const float w = sc[bi]; c.rwt[t * 8 + it] = w; wsum += w;
    }
    const float inv = 2.5f / wsum;
    for (int it = 0; it < 8; ++it) c.rwt[t * 8 + it] *= inv;
}
template <> HD void item<ST_HID>(const Ctx& c, long idx) {
    const int j = (int)(idx % 256), k = (int)((idx / 256) % 9); const long t = idx / 2304;
    const float *wg, *wu;
    if (k < 8) { const long e = (long)c.layer * 64 + c.ridx[t * 8 + k]; wg = c.in[32] + e * 262144; wu = c.in[33] + e * 262144; }
    else { wg = c.in[35] + (long)c.layer * 262144; wu = c.in[36] + (long)c.layer * 262144; }
    const float* hr = c.hcur + t * 1024;
    float g = 0.f, u = 0.f;
    for (int d = 0; d < 1024; ++d) { const float x = hr[d]; g += x * wg[d * 256 + j]; u += x * wu[d * 256 + j]; }
    c.hid[idx] = silu(g) * u;
}
template <> HD void item<ST_FFN>(const Ctx& c, long idx) {
    const long t = idx / 1024; const int n = (int)(idx % 1024);
    float tot = 0.f;
    for (int k = 0; k < 9; ++k) {
        const float* wd; float w;
        if (k < 8) { const long e = (long)c.layer * 64 + c.ridx[t * 8 + k]; wd = c.in[34] + e * 262144; w = c.rwt[t * 8 + k]; }
        else { wd = c.in[37] + (long)c.layer * 262144; w = 1.f; }
        const float* hr = c.hid + (t * 9 + k) * 256;
        float acc = 0.f;
        for (int j = 0; j < 256; ++j) acc += hr[j] * wd[j * 1024 + n];
        tot += w * acc;
    }
    c.z[idx] = ALPHA * c.hcur[idx] + tot;
}
template <> HD void item<ST_S5_PAR>(const Ctx& c, long idx) {
    const int g = (int)(idx / 64);
    const float lr = c.in[17][idx], li = c.in[18][idx]; const float dt = expf(c.in[24][g]);
    const float mag = expf(lr * dt); const float ar = mag * cosf(li * dt), ai = mag * sinf(li * dt);
    const float den = lr * lr + li * li, nr = ar - 1.0f;
    const float cr = (nr * lr + ai * li) / den, ci = (ai * lr - nr * li) / den;
    c.s5ab[idx * 2] = ar; c.s5ab[idx * 2 + 1] = ai;
    for (int h = 0; h < 16; ++h) {
        const float br = c.in[19][idx * 16 + h], bi = c.in[20][idx * 16 + h];
        c.s5bbr[idx * 16 + h] = cr * br - ci * bi; c.s5bbi[idx * 16 + h] = cr * bi + ci * br;
    }
}
template <> HD void item<ST_S5_SCAN>(const Ctx& c, long idx) {
    const int gp = (int)(idx % 2048), g = gp / 64, b = (int)(idx / 2048);
    const float ar = c.s5ab[gp * 2], ai = c.s5ab[gp * 2 + 1];
    float xr = 0.f, xi = 0.f;
    if (c.slab > 0) { xr = c.s5st[idx * 2]; xi = c.s5st[idx * 2 + 1]; }
    for (int sl = 0; sl < SLAB; ++sl) {
        const long t = (long)b * S_ + (long)c.slab * SLAB + sl;
        const float* u = c.proj + t * OIN + g * 16;
        float br = 0.f, bi = 0.f;
        for (int h = 0; h < 16; ++h) { br += u[h] * c.s5bbr[gp * 16 + h]; bi += u[h] * c.s5bbi[gp * 16 + h]; }
        const float nr = ar * xr - ai * xi + br, ni = ar * xi + ai * xr + bi;
        xr = nr; xi = ni;
        const long o = (((long)b * SLAB + sl) * 2048 + gp) * 2;
        c.s5x[o] = xr; c.s5x[o + 1] = xi;
    }
    c.s5st[idx * 2] = xr; c.s5st[idx * 2 + 1] = xi;
}
template <> HD void item<ST_S5_OUT>(const Ctx& c, long idx) {
    const int ch = (int)(idx % 512), g = ch / 16; const long bs = idx / 512; const int b = (int)(bs / SLAB), sl = (int)(bs % SLAB);
    const long t = (long)b * S_ + (long)c.slab * SLAB + sl;
    const float* x = c.s5x + (bs * 2048 + g * 64) * 2; const float* cre = c.in[21] + ch * 64; const float* cim = c.in[22] + ch * 64;
    float y = 0.f;
    for (int p = 0; p < 64; ++p) y += x[2 * p] * cre[p] - x[2 * p + 1] * cim[p];
    y += c.in[23][ch] * c.proj[t * OIN + ch];
    c.s5g[t * 512 + ch] = gelu_t(y);
}
template <> HD void item<ST_S5_GLU>(const Ctx& c, long idx) {
    const long t = idx / 512; const int n = (int)(idx % 512);
    const float* gr = c.s5g + t * 512; const float* w = c.in[25];
    float acc = c.in[26][n];
    for (int k = 0; k < 512; ++k) acc += gr[k] * w[k * 512 + n];
    c.mixed[t * 1024 + n] = gr[n] * sigm(acc);
}
template <> HD void item<ST_GLA_GATE>(const Ctx& c, long idx) {
    const long t = idx / 256; const int ch = (int)(idx % 256);
    float acc = c.in[28][ch];
    for (int r = 0; r < 16; ++r) acc += c.proj[t * OIN + 2048 + r] * c.in[27][r * 256 + ch];
    c.gla_la[idx] = logsig(acc) * (1.0f / 16.0f);
}
template <> HD void item<ST_GLA_CUM>(const Ctx& c, long idx) {
    const int ch = (int)(idx % 256); const long bn = idx / 256; const int b = (int)(bn / NCH), n = (int)(bn % NCH);
    const long t0 = (long)b * S_ + n * 64;
    float acc = 0.f;
    for (int l = 0; l < 64; ++l) { acc += c.gla_la[(t0 + l) * 256 + ch]; c.gla_bc[(t0 + l) * 256 + ch] = acc; }
    c.gla_bl[idx] = acc;
}
template <> HD void item<ST_GLA_U>(const Ctx& c, long idx) {
    const int e = (int)(idx % 128), d = (int)((idx / 128) % 64); const long cn = idx / 8192;
    const int bh = (int)(cn / NCH), n = (int)(cn % NCH), b = bh / 4, h = bh % 4;
    const long t0 = (long)b * S_ + n * 64;
    const float bl = c.gla_bl[((long)b * NCH + n) * 256 + h * 64 + d];
    float acc = 0.f;
    for (int l = 0; l < 64; ++l)
        acc += c.proj[(t0 + l) * OIN + 768 + h * 64 + d] * expf(bl - c.gla_bc[(t0 + l) * 256 + h * 64 + d]) * c.proj[(t0 + l) * OIN + 1024 + h * 128 + e];
    c.gu[idx] = acc;
}
template <> HD void item<ST_GLA_SCAN>(const Ctx& c, long idx) {
    const long bh = idx / 8192; const int de = (int)(idx % 8192), d = de / 128; const int b = (int)(bh / 4), h = (int)(bh % 4);
    float st = 0.f;
    for (int n = 0; n < NCH; ++n) {
        const long cn = bh * NCH + n;
        const float u = c.gu[cn * 8192 + de]; c.gu[cn * 8192 + de] = st;
        st = expf(c.gla_bl[((long)b * NCH + n) * 256 + h * 64 + d]) * st + u;
    }
}
template <> HD void item<ST_GLA_ATT>(const Ctx& c, long idx) {
    const int j = (int)(idx % 64), i = (int)((idx / 64) % 64); const long cn = idx / 4096;
    const int bh = (int)(cn / NCH), n = (int)(cn % NCH), b = bh / 4, h = bh % 4;
    if (j > i) { c.gatt[idx] = 0.f; return; }
    const long ti = (long)b * S_ + n * 64 + i, tj = (long)b * S_ + n * 64 + j;
    float acc = 0.f;
    for (int d = 0; d < 64; ++d)
        acc += c.proj[ti * OIN + 512 + h * 64 + d] * 0.125f * expf(c.gla_bc[ti * 256 + h * 64 + d] - c.gla_bc[tj * 256 + h * 64 + d]) * c.proj[tj * OIN + 768 + h * 64 + d];
    c.gatt[idx] = acc;
}
template <> HD void item<ST_GLA_O>(const Ctx& c, long idx) {
    const int e = (int)(idx % 128); const long bs = idx / 128; const long bh = bs / S_; const int s = (int)(bs % S_), n = s / 64, i = s % 64;
    const long cn = bh * NCH + n; const int b = (int)(bh / 4), h = (int)(bh % 4);
    const long t0 = (long)b * S_ + n * 64, t = t0 + i;
    float acc = 0.f;
    for (int j = 0; j <= i; ++j) acc += c.gatt[cn * 4096 + i * 64 + j] * c.proj[(t0 + j) * OIN + 1024 + h * 128 + e];
    for (int d = 0; d < 64; ++d)
        acc += c.proj[t * OIN + 512 + h * 64 + d] * 0.125f * expf(c.gla_bc[t * 256 + h * 64 + d]) * c.gu[cn * 8192 + d * 128 + e];
    c.go[t * 512 + h * 128 + e] = acc;
}
template <> HD void item<ST_GLA_NORM>(const Ctx& c, long idx) {
    const long bh = idx / S_; const int s = (int)(idx % S_); const int b = (int)(bh / 4), h = (int)(bh % 4);
    const long t = (long)b * S_ + s;
    const float* o = c.go + t * 512 + h * 128;
    float ms = 0.f;
    for (int e = 0; e < 128; ++e) ms += o[e] * o[e];
    const float rstd = 1.0f / sqrtf(ms * (1.f / 128.f) + EPS);
    for (int e = 0; e < 128; ++e)
        c.mixed[t * 1024 + 512 + h * 128 + e] = o[e] * rstd * c.in[29][h * 128 + e] * silu(c.proj[t * OIN + 1536 + h * 128 + e]);
}

struct Mem { float* base; size_t off; float* get(size_t n) { float* p = base + off; off += (n + 63) & ~(size_t)63; return p; } };

template <class Runner> void forward(Runner& R, void* const* d_in, float* d_out, float* ws) {
    Ctx c{};
    for (int i = 0; i < 38; ++i) c.in[i] = (const float*)d_in[i];
    Mem M{ws, 0};
    c.z = M.get((size_t)T_ * 1024); c.mixed = M.get((size_t)T_ * 1024); c.scores = M.get((size_t)T_ * 64);
    c.ridx = (int*)M.get((size_t)T_ * 8); c.rwt = M.get((size_t)T_ * 8);
    const size_t scratch0 = M.off;
    for (int layer = 0; layer < 2; ++layer) {
        c.layer = layer;
        c.hcur = layer == 0 ? c.in[0] : d_out;
        M.off = scratch0;
        if (layer == 0) {
            c.proj = M.get((size_t)T_ * EIN);
            c.mb = M.get(8 * S_); c.mig = M.get(8 * S_); c.mblast = M.get(8 * NCH); c.mmloc = M.get(8 * NCH); c.mmprev = M.get(8 * NCH);
            c.mmi = M.get(8 * S_); c.mwin = M.get(8 * S_); c.mden = M.get(8 * S_); c.nloc = M.get(8 * NCH * 128);
            const size_t ov = M.off;
            c.cloc = M.get((size_t)8 * NCH * 16384); c.smat = M.get((size_t)8 * NCH * 4096); c.htil = M.get((size_t)T_ * 512);
            M.off = ov; c.lxc = M.get((size_t)T_ * 512); c.la = M.get((size_t)T_ * 512); c.lu = M.get((size_t)T_ * 512);
            c.gA = c.hcur; c.glda = 1024; c.gW = c.in[6]; c.gldw = EIN; c.gC = c.proj; c.gldc = EIN; c.gR = nullptr; c.gBias = nullptr; c.gM = T_; c.gN = EIN; c.gK = 1024;
            R.template run<ST_GEMM>(c, (long)T_ * EIN);
            R.template run<ST_ML_GATES>(c, 8L * NCH);
            R.template run<ST_ML_CLOC>(c, 8L * NCH * 16384);
            R.template run<ST_ML_SCAN>(c, 8L * 16384 + 8 * 128);
            R.template run<ST_ML_MI>(c, 8L * S_);
            R.template run<ST_ML_SMAT>(c, 8L * NCH * 4096);
            R.template run<ST_ML_DEN>(c, 8L * S_);
            R.template run<ST_ML_H>(c, 8L * S_ * 128);
            R.template run<ST_ML_NORM>(c, 8L * S_);
            R.template run<ST_LRU_CONV>(c, (long)T_ * 512);
            R.template run<ST_LRU_GATE>(c, (long)T_ * 512);
            R.template run<ST_LRU_SCAN>(c, 2L * 512);
        } else {
            c.proj = M.get((size_t)T_ * OIN);
            c.s5ab = M.get(2048 * 2); c.s5bbr = M.get(2048 * 16); c.s5bbi = M.get(2048 * 16); c.s5st = M.get(2 * 2048 * 2);
            c.s5x = M.get((size_t)B_ * SLAB * 2048 * 2); c.s5g = M.get((size_t)T_ * 512);
            c.gla_la = M.get((size_t)T_ * 256); c.gla_bc = M.get((size_t)T_ * 256); c.gla_bl = M.get((size_t)B_ * NCH * 256);
            c.gu = M.get((size_t)8 * NCH * 8192); c.gatt = M.get((size_t)8 * NCH * 4096); c.go = M.get((size_t)T_ * 512);
            c.gA = c.hcur; c.glda = 1024; c.gW = c.in[16]; c.gldw = OIN; c.gC = c.proj; c.gldc = OIN; c.gR = nullptr; c.gBias = nullptr; c.gM = T_; c.gN = OIN; c.gK = 1024;
            R.template run<ST_GEMM>(c, (long)T_ * OIN);
            R.template run<ST_S5_PAR>(c, 2048);
            for (int sl = 0; sl < S_ / SLAB; ++sl) { c.slab = sl; R.template run<ST_S5_SCAN>(c, 2L * 2048); R.template run<ST_S5_OUT>(c, (long)B_ * SLAB * 512); }
            c.slab = 0;
            R.template run<ST_S5_GLU>(c, (long)T_ * 512);
            R.template run<ST_GLA_GATE>(c, (long)T_ * 256);
            R.template run<ST_GLA_CUM>(c, (long)B_ * NCH * 256);
            R.template run<ST_GLA_U>(c, 8L * NCH * 8192);
            R.template run<ST_GLA_SCAN>(c, 8L * 8192);
            R.template run<ST_GLA_ATT>(c, 8L * NCH * 4096);
            R.template run<ST_GLA_O>(c, 8L * S_ * 128);
            R.template run<ST_GLA_NORM>(c, 8L * S_);
        }
        c.gA = c.mixed; c.glda = 1024; c.gW = c.in[5] + (size_t)layer * 1024 * 1024; c.gldw = 1024; c.gC = c.z; c.gldc = 1024; c.gR = c.hcur; c.gldr = 1024; c.gralpha = ALPHA; c.gM = T_; c.gN = 1024; c.gK = 1024;
        R.template run<ST_GEMM>(c, (long)T_ * 1024);
        c.gR = nullptr;
        c.hout = d_out; c.lnw = c.in[1] + layer * 1024; c.lnb = c.in[2] + layer * 1024;
        R.template run<ST_LN>(c, T_);
        c.hcur = d_out;
        M.off = scratch0; c.hid = M.get((size_t)T_ * 9 * 256);
        R.template run<ST_SCORES>(c, (long)T_ * 64);
        R.template run<ST_SELECT>(c, T_);
        R.template run<ST_HID>(c, (long)T_ * 9 * 256);
        R.template run<ST_FFN>(c, (long)T_ * 1024);
        c.lnw = c.in[3] + layer * 1024; c.lnb = c.in[4] + layer * 1024;
        R.template run<ST_LN>(c, T_);
    }
}
}
template <int ST> __global__ void __launch_bounds__(256) k_items(nv::Ctx c, long n) {
    for (long i = (long)blockIdx.x * blockDim.x + threadIdx.x; i < n; i += (long)gridDim.x * blockDim.x) nv::item<ST>(c, i);
}
struct GpuRunner {
    hipStream_t s;
    template <int ST> void run(const nv::Ctx& c, long n) {
        const int bs = n < 65536 ? 64 : 256;
        long nb = (n + bs - 1) / bs; if (nb > (1 << 20)) nb = 1 << 20;
        hipLaunchKernelGGL(k_items<ST>, dim3((unsigned)nb), dim3(bs), 0, s, c, n);
    }
};
extern "C" void kernel_launch(void* const* d_in, const int* in_sizes, int n_in, void* d_out, int out_size, void* d_ws, size_t ws_size, hipStream_t stream) {
    GpuRunner R{stream};
    nv::forward(R, d_in, (float*)d_out, (float*)d_ws);
}
```

```cpp
#include <hip/hip_runtime.h>
#ifdef CPU_TEST
#include <cmath>
#include <cstddef>
#define HD inline
#define HDF inline
#else
#define HD __device__ __forceinline__
#define HDF __host__ __device__ __forceinline__
#endif

#ifndef SEQ_
#define SEQ_ 8192
#endif
namespace nv {
constexpr int B_ = 2, S_ = SEQ_, T_ = B_ * S_, D_ = 1024, NCH = S_ / 64;
constexpr int EIN = 3080, OIN = 2064;
constexpr int SLAB = (S_ < 1024 ? S_ : 1024);
constexpr float ALPHA = 1.41421356237309515f, EPS = 1e-5f;

enum Stage { ST_GEMM, ST_ML_GATES, ST_ML_CLOC, ST_ML_SCAN, ST_ML_MI, ST_ML_SMAT, ST_ML_DEN, ST_ML_H, ST_ML_NORM,
             ST_LRU_CONV, ST_LRU_GATE, ST_LRU_SCAN, ST_LN, ST_SCORES, ST_SELECT, ST_HID, ST_FFN,
             ST_S5_PAR, ST_S5_SCAN, ST_S5_OUT, ST_S5_GLU, ST_GLA_GATE, ST_GLA_CUM, ST_GLA_U, ST_GLA_SCAN, ST_GLA_ATT, ST_GLA_O, ST_GLA_NORM };

struct Ctx {
    const float* in[38];
    const float* gA; const float* gW; const float* gR; float* gC; const float* gBias;
    const float* hcur;
    float* hout;
    const float* lnw; const float* lnb;
    float* proj; float* mixed; float* z;
    float* mb; float* mig; float* mblast; float* mmloc; float* mmprev; float* cloc; float* nloc; float* smat; float* mmi; float* mwin; float* mden; float* htil;
    float* lxc; float* la; float* lu;
    float* scores; int* ridx; float* rwt; float* hid;
    float* s5ab; float* s5bbr; float* s5bbi; float* s5st; float* s5x; float* s5g;
    float* gla_la; float* gla_bc; float* gla_bl; float* gu; float* gatt; float* go;
    long gM, gN, gK, glda, gldw, gldc, gldr;
    float gralpha; int layer; int slab; int pad0;
};

HD float sigm(float x) { return 1.0f / (1.0f + expf(-x)); }
HD float logsig(float x) { return fminf(x, 0.f) - log1pf(expf(-fabsf(x))); }
HD float softplus(float x) { return fmaxf(x, 0.f) + log1pf(expf(-fabsf(x))); }
HD float silu(float x) { return x * sigm(x); }
HD float gelu_t(float x) { return 0.5f * x * (1.0f + tanhf(0.7978845608028654f * (x + 0.044715f * x * x * x))); }

template <int ST> HD void item(const Ctx& c, long idx);

template <> HD void item<ST_GEMM>(const Ctx& c, long idx) {
    const long m = idx / c.gN, n = idx % c.gN;
    float acc = 0.f;
    const float* a = c.gA + m * c.glda; const float* w = c.gW + n;
    for (long k = 0; k < c.gK; ++k) acc += a[k] * w[k * c.gldw];
    if (c.gBias) acc += c.gBias[n];
    if (c.gR) acc += c.gralpha * c.gR[m * c.gldr + n];
    c.gC[m * c.gldc + n] = acc;
}
template <> HD void item<ST_ML_GATES>(const Ctx& c, long idx) {
    const int bh = (int)(idx / NCH), n = (int)(idx % NCH), b = bh / 4, h = bh % 4;
    const float* gb = c.in[7];
    const long t0 = (long)b * S_ + n * 64; const long o0 = (long)bh * S_ + n * 64;
    float acc = 0.f;
    for (int l = 0; l < 64; ++l) {
        const float f = c.proj[(t0 + l) * EIN + 2052 + h] + gb[4 + h];
        acc += logsig(f);
        c.mb[o0 + l] = acc;
        c.mig[o0 + l] = c.proj[(t0 + l) * EIN + 2048 + h] + gb[h];
    }
    c.mblast[idx] = acc;
    float ml = -INFINITY;
    for (int l = 0; l < 64; ++l) ml = fmaxf(ml, acc - c.mb[o0 + l] + c.mig[o0 + l]);
    c.mmloc[idx] = ml;
}
template <> HD void item<ST_ML_CLOC>(const Ctx& c, long idx) {
    const int e = (int)(idx % 128), d = (int)((idx / 128) % 128); const long cn = idx / 16384;
    const int bh = (int)(cn / NCH), n = (int)(cn % NCH), b = bh / 4, h = bh % 4;
    const long t0 = (long)b * S_ + n * 64; const long o0 = (long)bh * S_ + n * 64;
    const float bl = c.mblast[cn], ml = c.mmloc[cn]; const float sc = 0.08838834764831845f;
    float acc = 0.f, accn = 0.f;
    for (int l = 0; l < 64; ++l) {
        const float p = expf(bl - c.mb[o0 + l] + c.mig[o0 + l] - ml);
        const float kk = c.proj[(t0 + l) * EIN + 512 + h * 128 + d] * sc;
        acc += p * kk * c.proj[(t0 + l) * EIN + 1024 + h * 128 + e];
        accn += p * kk;
    }
    c.cloc[idx] = acc;
    if (e == 0) c.nloc[cn * 128 + d] = accn;
}
template <> HD void item<ST_ML_SCAN>(const Ctx& c, long idx) {
    const bool isn = idx >= 8L * 16384;
    long bh, de; float* buf; long stride;
    if (!isn) { bh = idx / 16384; de = idx % 16384; buf = c.cloc; stride = 16384; }
    else { const long r = idx - 8L * 16384; bh = r / 128; de = r % 128; buf = c.nloc; stride = 128; }
    float st = 0.f, m = 0.f;
    for (int n = 0; n < NCH; ++n) {
        const long cn = bh * NCH + n;
        const float cl = buf[cn * stride + de]; buf[cn * stride + de] = st;
        const float bl = c.mblast[cn], ml = c.mmloc[cn];
        const float mn = fmaxf(bl + m, ml);
        st = expf(bl + m - mn) * st + expf(ml - mn) * cl;
        if (!isn && de == 0) c.mmprev[cn] = m;
        m = mn;
    }
}
template <> HD void item<ST_ML_MI>(const Ctx& c, long idx) {
    const long bh = idx / S_; const int s = (int)(idx % S_), n = s / 64, i = s % 64; const long cn = bh * NCH + n;
    const long o0 = bh * S_ + n * 64;
    const float bi = c.mb[idx]; const float minter = bi + c.mmprev[cn];
    float dmax = -INFINITY;
    for (int j = 0; j <= i; ++j) dmax = fmaxf(dmax, bi - c.mb[o0 + j] + c.mig[o0 + j]);
    const float mi = fmaxf(minter, dmax);
    c.mmi[idx] = mi; c.mwin[idx] = expf(minter - mi);
}
template <> HD void item<ST_ML_SMAT>(const Ctx& c, long idx) {
    const int j = (int)(idx % 64), i = (int)((idx / 64) % 64); const long cn = idx / 4096;
    const int bh = (int)(cn / NCH), n = (int)(cn % NCH), b = bh / 4, h = bh % 4;
    if (j > i) { c.smat[idx] = 0.f; return; }
    const long t0 = (long)b * S_ + n * 64; const long o0 = (long)bh * S_ + n * 64;
    const float* q = c.proj + (t0 + i) * EIN + h * 128; const float* k = c.proj + (t0 + j) * EIN + 512 + h * 128;
    float dot = 0.f;
    for (int d = 0; d < 128; ++d) dot += q[d] * k[d];
    dot *= 0.08838834764831845f;
    c.smat[idx] = dot * expf(c.mb[o0 + i] - c.mb[o0 + j] + c.mig[o0 + j] - c.mmi[o0 + i]);
}
template <> HD void item<ST_ML_DEN>(const Ctx& c, long idx) {
    const long bh = idx / S_; const int s = (int)(idx % S_), n = s / 64, i = s % 64; const long cn = bh * NCH + n;
    const int b = (int)(bh / 4), h = (int)(bh % 4);
    float den = 0.f;
    for (int j = 0; j <= i; ++j) den += c.smat[cn * 4096 + i * 64 + j];
    const float* q = c.proj + ((long)b * S_ + s) * EIN + h * 128;
    float qn = 0.f;
    for (int d = 0; d < 128; ++d) qn += q[d] * c.nloc[cn * 128 + d];
    den += c.mwin[idx] * qn;
    c.mden[idx] = fmaxf(fabsf(den), expf(-c.mmi[idx]));
}
template <> HD void item<ST_ML_H>(const Ctx& c, long idx) {
    const int e = (int)(idx % 128); const long bs = idx / 128; const long bh = bs / S_; const int s = (int)(bs % S_), n = s / 64, i = s % 64;
    const long cn = bh * NCH + n; const int b = (int)(bh / 4), h = (int)(bh % 4);
    const long t0 = (long)b * S_ + n * 64;
    float num = 0.f;
    for (int j = 0; j <= i; ++j) num += c.smat[cn * 4096 + i * 64 + j] * c.proj[(t0 + j) * EIN + 1024 + h * 128 + e];
    const float* q = c.proj + (t0 + i) * EIN + h * 128;
    float qc = 0.f;
    for (int d = 0; d < 128; ++d) qc += q[d] * c.cloc[cn * 16384 + d * 128 + e];
    num += c.mwin[bs] * qc;
    c.htil[(t0 + i) * 512 + h * 128 + e] = num / c.mden[bs];
}
template <> HD void item<ST_ML_NORM>(const Ctx& c, long idx) {
    const long bh = idx / S_; const int s = (int)(idx % S_); const int b = (int)(bh / 4), h = (int)(bh % 4);
    const long t = (long)b * S_ + s;
    const float* ht = c.htil + t * 512 + h * 128; const float* nw = c.in[8];
    float mean = 0.f;
    for (int e = 0; e < 128; ++e) mean += ht[e];
    mean *= (1.f / 128.f);
    float var = 0.f;
    for (int e = 0; e < 128; ++e) { const float d = ht[e] - mean; var += d * d; }
    const float rstd = 1.0f / sqrtf(var * (1.f / 128.f) + EPS);
    for (int e = 0; e < 128; ++e)
        c.mixed[t * 1024 + h * 128 + e] = (ht[e] - mean) * rstd * nw[h * 128 + e] * sigm(c.proj[t * EIN + 1536 + h * 128 + e]);
}
template <> HD void item<ST_LRU_CONV>(const Ctx& c, long idx) {
    const long t = idx / 512; const int ch = (int)(idx % 512); const int s = (int)(t % S_);
    const float* cw = c.in[9];
    float acc = c.in[10][ch];
    for (int j = 0; j < 4; ++j) { const int ss = s - 3 + j; if (ss >= 0) acc += cw[j * 512 + ch] * c.proj[(t - 3 + j) * EIN + 2056 + ch]; }
    c.lxc[idx] = acc;
}
template <> HD void item<ST_LRU_GATE>(const Ctx& c, long idx) {
    const long t = idx / 512; const int ch = (int)(idx % 512), hh = ch / 128, jj = ch % 128;
    const float* wa = c.in[11] + (long)hh * 16384; const float* wx = c.in[13] + (long)hh * 16384;
    const float* xr = c.lxc + t * 512 + hh * 128;
    float ra = c.in[12][ch], xa = c.in[14][ch];
    for (int i = 0; i < 128; ++i) { ra += xr[i] * wa[i * 128 + jj]; xa += xr[i] * wx[i * 128 + jj]; }
    const float r = sigm(ra), ii = sigm(xa);
    const float la = -8.0f * r * softplus(-c.in[15][ch]);
    c.la[idx] = expf(la);
    c.lu[idx] = sqrtf(-expm1f(2.0f * la)) * ii * c.lxc[idx];
}
template <> HD void item<ST_LRU_SCAN>(const Ctx& c, long idx) {
    const int b = (int)(idx / 512), ch = (int)(idx % 512);
    float h = 0.f;
    for (int s = 0; s < S_; ++s) {
        const long t = (long)b * S_ + s;
        h = c.la[t * 512 + ch] * h + c.lu[t * 512 + ch];
        c.mixed[t * 1024 + 512 + ch] = h * gelu_t(c.proj[t * EIN + 2568 + ch]);
    }
}
template <> HD void item<ST_LN>(const Ctx& c, long t) {
    const float* zr = c.z + t * 1024;
    float mean = 0.f;
    for (int i = 0; i < 1024; ++i) mean += zr[i];
    mean *= (1.f / 1024.f);
    float var = 0.f;
    for (int i = 0; i < 1024; ++i) { const float d = zr[i] - mean; var += d * d; }
    const float rstd = 1.0f / sqrtf(var * (1.f / 1024.f) + EPS);
    for (int i = 0; i < 1024; ++i) c.hout[t * 1024 + i] = (zr[i] - mean) * rstd * c.lnw[i] + c.lnb[i];
}
template <> HD void item<ST_SCORES>(const Ctx& c, long idx) {
    const long t = idx / 64; const int e = (int)(idx % 64);
    const float* rw = c.in[30] + (long)c.layer * 1024 * 64; const float* hr = c.hcur + t * 1024;
    float acc = 0.f;
    for (int k = 0; k < 1024; ++k) acc += hr[k] * rw[k * 64 + e];
    c.scores[idx] = sigm(acc);
}
template <> HD void item<ST_SELECT>(const Ctx& c, long t) {
    const float* sc = c.scores + t * 64; const float* bias = c.in[31] + c.layer * 64;
    float gs[8];
#pragma unroll
    for (int g = 0; g < 8; ++g) {
        float m1 = -INFINITY, m2 = -INFINITY;
        for (int j = 0; j < 8; ++j) { const float v = sc[g * 8 + j] + bias[g * 8 + j]; if (v > m1) { m2 = m1; m1 = v; } else if (v > m2) m2 = v; }
        gs[g] = m1 + m2;
    }
    unsigned gsel = 0;
    for (int it = 0; it < 4; ++it) {
        float best = -INFINITY; int bi = 0;
#pragma unroll
        for (int g = 0; g < 8; ++g) { const bool ok = !((gsel >> g) & 1u) && gs[g] > best; best = ok ? gs[g] : best; bi = ok ? g : bi; }
        gsel |= 1u << bi;
    }
    unsigned long long taken = 0ull; float wsum = 0.f;
    for (int it = 0; it < 8; ++it) {
        float best = -INFINITY; int bi = 0;
        for (int e = 0; e < 64; ++e) {
            if (!((gsel >> (e >> 3)) & 1u) || ((taken >> e) & 1ull)) continue;
            const float v = sc[e] + bias[e];
            if (v > best) { best = v; bi = e; }
        }
        taken |= 1ull << bi;
        c.ridx[t * 8 + it] = bi; const float w = sc[bi]; c.rwt[t * 8 + it] = w; wsum += w;
    }
    const float inv = 2.5f / wsum;
    for (int it = 0; it < 8; ++it) c.rwt[t * 8 + it] *= inv;
}
template <> HD void item<ST_HID>(const Ctx& c, long idx) {
    const int j = (int)(idx % 256), k = (int)((idx / 256) % 9); const long t = idx / 2304;
    const float *wg, *wu;
    if (k < 8) { const long e = (long)c.layer * 64 + c.ridx[t * 8 + k]; wg = c.in[32] + e * 262144; wu = c.in[33] + e * 262144; }
    else { wg = c.in[35] + (long)c.layer * 262144; wu = c.in[36] + (long)c.layer * 262144; }
    const float* hr = c.hcur + t * 1024;
    float g = 0.f, u = 0.f;
    for (int d = 0; d < 1024; ++d) { const float x = hr[d]; g += x * wg[d * 256 + j]; u += x * wu[d * 256 + j]; }
    c.hid[idx] = silu(g) * u;
}
template <> HD void item<ST_FFN>(const Ctx& c, long idx) {
    const long t = idx / 1024; const int n = (int)(idx % 1024);
    float tot = 0.f;
    for (int k = 0; k < 9; ++k) {
        const float* wd; float w;
        if (k < 8) { const long e = (long)c.layer * 64 + c.ridx[t * 8 + k]; wd = c.in[34] + e * 262144; w = c.rwt[t * 8 + k]; }
        else { wd = c.in[37] + (long)c.layer * 262144; w = 1.f; }
        const float* hr = c.hid + (t * 9 + k) * 256;
        float acc = 0.f;
        for (int j = 0; j < 256; ++j) acc += hr[j] * wd[j * 1024 + n];
        tot += w * acc;
    }
    c.z[idx] = ALPHA * c.hcur[idx] + tot;
}
template <> HD void item<ST_S5_PAR>(const Ctx& c, long idx) {
    const int g = (int)(idx / 64);
    const float lr = c.in[17][idx], li = c.in[18][idx]; const float dt = expf(c.in[24][g]);
    const float mag = expf(lr * dt); const float ar = mag * cosf(li * dt), ai = mag * sinf(li * dt);
    const float den = lr * lr + li * li, nr = ar - 1.0f;
    const float cr = (nr * lr + ai * li) / den, ci = (ai * lr - nr * li) / den;
    c.s5ab[idx * 2] = ar; c.s5ab[idx * 2 + 1] = ai;
    for (int h = 0; h < 16; ++h) {
        const float br = c.in[19][idx * 16 + h], bi = c.in[20][idx * 16 + h];
        c.s5bbr[idx * 16 + h] = cr * br - ci * bi; c.s5bbi[idx * 16 + h] = cr * bi + ci * br;
    }
}
template <> HD void item<ST_S5_SCAN>(const Ctx& c, long idx) {
    const int gp = (int)(idx % 2048), g = gp / 64, b = (int)(idx / 2048);
    const float ar = c.s5ab[gp * 2], ai = c.s5ab[gp * 2 + 1];
    float xr = 0.f, xi = 0.f;
    if (c.slab > 0) { xr = c.s5st[idx * 2]; xi = c.s5st[idx * 2 + 1]; }
    for (int sl = 0; sl < SLAB; ++sl) {
        const long t = (long)b * S_ + (long)c.slab * SLAB + sl;
        const float* u = c.proj + t * OIN + g * 16;
        float br = 0.f, bi = 0.f;
        for (int h = 0; h < 16; ++h) { br += u[h] * c.s5bbr[gp * 16 + h]; bi += u[h] * c.s5bbi[gp * 16 + h]; }
        const float nr = ar * xr - ai * xi + br, ni = ar * xi + ai * xr + bi;
        xr = nr; xi = ni;
        const long o = (((long)b * SLAB + sl) * 2048 + gp) * 2;
        c.s5x[o] = xr; c.s5x[o + 1] = xi;
    }
    c.s5st[idx * 2] = xr; c.s5st[idx * 2 + 1] = xi;
}
template <> HD void item<ST_S5_OUT>(const Ctx& c, long idx) {
    const int ch = (int)(idx % 512), g = ch / 16; const long bs = idx / 512; const int b = (int)(bs / SLAB), sl = (int)(bs % SLAB);
    const long t = (long)b * S_ + (long)c.slab * SLAB + sl;
    const float* x = c.s5x + (bs * 2048 + g * 64) * 2; const float* cre = c.in[21] + ch * 64; const float* cim = c.in[22] + ch * 64;
    float y = 0.f;
    for (int p = 0; p < 64; ++p) y += x[2 * p] * cre[p] - x[2 * p + 1] * cim[p];
    y += c.in[23][ch] * c.proj[t * OIN + ch];
    c.s5g[t * 512 + ch] = gelu_t(y);
}
template <> HD void item<ST_S5_GLU>(const Ctx& c, long idx) {
    const long t = idx / 512; const int n = (int)(idx % 512);
    const float* gr = c.s5g + t * 512; const float* w = c.in[25];
    float acc = c.in[26][n];
    for (int k = 0; k < 512; ++k) acc += gr[k] * w[k * 512 + n];
    c.mixed[t * 1024 + n] = gr[n] * sigm(acc);
}
template <> HD void item<ST_GLA_GATE>(const Ctx& c, long idx) {
    const long t = idx / 256; const int ch = (int)(idx % 256);
    float acc = c.in[28][ch];
    for (int r = 0; r < 16; ++r) acc += c.proj[t * OIN + 2048 + r] * c.in[27][r * 256 + ch];
    c.gla_la[idx] = logsig(acc) * (1.0f / 16.0f);
}
template <> HD void item<ST_GLA_CUM>(const Ctx& c, long idx) {
    const int ch = (int)(idx % 256); const long bn = idx / 256; const int b = (int)(bn / NCH), n = (int)(bn % NCH);
    const long t0 = (long)b * S_ + n * 64;
    float acc = 0.f;
    for (int l = 0; l < 64; ++l) { acc += c.gla_la[(t0 + l) * 256 + ch]; c.gla_bc[(t0 + l) * 256 + ch] = acc; }
    c.gla_bl[idx] = acc;
}
template <> HD void item<ST_GLA_U>(const Ctx& c, long idx) {
    const int e = (int)(idx % 128), d = (int)((idx / 128) % 64); const long cn = idx / 8192;
    const int bh = (int)(cn / NCH), n = (int)(cn % NCH), b = bh / 4, h = bh % 4;
    const long t0 = (long)b * S_ + n * 64;
    const float bl = c.gla_bl[((long)b * NCH + n) * 256 + h * 64 + d];
    float acc = 0.f;
    for (int l = 0; l < 64; ++l)
        acc += c.proj[(t0 + l) * OIN + 768 + h * 64 + d] * expf(bl - c.gla_bc[(t0 + l) * 256 + h * 64 + d]) * c.proj[(t0 + l) * OIN + 1024 + h * 128 + e];
    c.gu[idx] = acc;
}
template <> HD void item<ST_GLA_SCAN>(const Ctx& c, long idx) {
    const long bh = idx / 8192; const int de = (int)(idx % 8192), d = de / 128; const int b = (int)(bh / 4), h = (int)(bh % 4);
    float st = 0.f;
    for (int n = 0; n < NCH; ++n) {
        const long cn = bh * NCH + n;
        const float u = c.gu[cn * 8192 + de]; c.gu[cn * 8192 + de] = st;
        st = expf(c.gla_bl[((long)b * NCH + n) * 256 + h * 64 + d]) * st + u;
    }
}
template <> HD void item<ST_GLA_ATT>(const Ctx& c, long idx) {
    const int j = (int)(idx % 64), i = (int)((idx / 64) % 64); const long cn = idx / 4096;
    const int bh = (int)(cn / NCH), n = (int)(cn % NCH), b = bh / 4, h = bh % 4;
    if (j > i) { c.gatt[idx] = 0.f; return; }
    const long ti = (long)b * S_ + n * 64 + i, tj = (long)b * S_ + n * 64 + j;
    float acc = 0.f;
    for (int d = 0; d < 64; ++d)
        acc += c.proj[ti * OIN + 512 + h * 64 + d] * 0.125f * expf(c.gla_bc[ti * 256 + h * 64 + d] - c.gla_bc[tj * 256 + h * 64 + d]) * c.proj[tj * OIN + 768 + h * 64 + d];
    c.gatt[idx] = acc;
}
template <> HD void item<ST_GLA_O>(const Ctx& c, long idx) {
    const int e = (int)(idx % 128); const long bs = idx / 128; const long bh = bs / S_; const int s = (int)(bs % S_), n = s / 64, i = s % 64;
    const long cn = bh * NCH + n; const int b = (int)(bh / 4), h = (int)(bh % 4);
    const long t0 = (long)b * S_ + n * 64, t = t0 + i;
    float acc = 0.f;
    for (int j = 0; j <= i; ++j) acc += c.gatt[cn * 4096 + i * 64 + j] * c.proj[(t0 + j) * OIN + 1024 + h * 128 + e];
    for (int d = 0; d < 64; ++d)
        acc += c.proj[t * OIN + 512 + h * 64 + d] * 0.125f * expf(c.gla_bc[t * 256 + h * 64 + d]) * c.gu[cn * 8192 + d * 128 + e];
    c.go[t * 512 + h * 128 + e] = acc;
}
template <> HD void item<ST_GLA_NORM>(const Ctx& c, long idx) {
    const long bh = idx / S_; const int s = (int)(idx % S_); const int b = (int)(bh / 4), h = (int)(bh % 4);
    const long t = (long)b * S_ + s;
    const float* o = c.go + t * 512 + h * 128;
    float ms = 0.f;
    for (int e = 0; e < 128; ++e) ms += o[e] * o[e];
    const float rstd = 1.0f / sqrtf(ms * (1.f / 128.f) + EPS);
    for (int e = 0; e < 128; ++e)
        c.mixed[t * 1024 + 512 + h * 128 + e] = o[e] * rstd * c.in[29][h * 128 + e] * silu(c.proj[t * OIN + 1536 + h * 128 + e]);
}

struct Mem { float* base; size_t off; HDF float* get(size_t n) { float* p = base + off; off += (n + 63) & ~(size_t)63; return p; } };

template <class Runner> HDF void forward(Runner& R, void* const* d_in, float* d_out, float* ws) {
    Ctx c{};
    for (int i = 0; i < 38; ++i) c.in[i] = (const float*)d_in[i];
    Mem M{ws, 0};
    c.z = M.get((size_t)T_ * 1024); c.mixed = M.get((size_t)T_ * 1024); c.scores = M.get((size_t)T_ * 64);
    c.ridx = (int*)M.get((size_t)T_ * 8); c.rwt = M.get((size_t)T_ * 8);
    const size_t scratch0 = M.off;
    for (int layer = 0; layer < 2; ++layer) {
        c.layer = layer;
        c.hcur = layer == 0 ? c.in[0] : d_out;
        M.off = scratch0;
        if (layer == 0) {
            c.proj = M.get((size_t)T_ * EIN);
            c.mb = M.get(8 * S_); c.mig = M.get(8 * S_); c.mblast = M.get(8 * NCH); c.mmloc = M.get(8 * NCH); c.mmprev = M.get(8 * NCH);
            c.mmi = M.get(8 * S_); c.mwin = M.get(8 * S_); c.mden = M.get(8 * S_); c.nloc = M.get(8 * NCH * 128);
            const size_t ov = M.off;
            c.cloc = M.get((size_t)8 * NCH * 16384); c.smat = M.get((size_t)8 * NCH * 4096); c.htil = M.get((size_t)T_ * 512);
            M.off = ov; c.lxc = M.get((size_t)T_ * 512); c.la = M.get((size_t)T_ * 512); c.lu = M.get((size_t)T_ * 512);
            c.gA = c.hcur; c.glda = 1024; c.gW = c.in[6]; c.gldw = EIN; c.gC = c.proj; c.gldc = EIN; c.gR = nullptr; c.gBias = nullptr; c.gM = T_; c.gN = EIN; c.gK = 1024;
            R.template run<ST_GEMM>(c, (long)T_ * EIN);
            R.template run<ST_ML_GATES>(c, 8L * NCH);
            R.template run<ST_ML_CLOC>(c, 8L * NCH * 16384);
            R.template run<ST_ML_SCAN>(c, 8L * 16384 + 8 * 128);
            R.template run<ST_ML_MI>(c, 8L * S_);
            R.template run<ST_ML_SMAT>(c, 8L * NCH * 4096);
            R.template run<ST_ML_DEN>(c, 8L * S_);
            R.template run<ST_ML_H>(c, 8L * S_ * 128);
            R.template run<ST_ML_NORM>(c, 8L * S_);
            R.template run<ST_LRU_CONV>(c, (long)T_ * 512);
            R.template run<ST_LRU_GATE>(c, (long)T_ * 512);
            R.template run<ST_LRU_SCAN>(c, 2L * 512);
        } else {
            c.proj = M.get((size_t)T_ * OIN);
            c.s5ab = M.get(2048 * 2); c.s5bbr = M.get(2048 * 16); c.s5bbi = M.get(2048 * 16); c.s5st = M.get(2 * 2048 * 2);
            c.s5x = M.get((size_t)B_ * SLAB * 2048 * 2); c.s5g = M.get((size_t)T_ * 512);
            c.gla_la = M.get((size_t)T_ * 256); c.gla_bc = M.get((size_t)T_ * 256); c.gla_bl = M.get((size_t)B_ * NCH * 256);
            c.gu = M.get((size_t)8 * NCH * 8192); c.gatt = M.get((size_t)8 * NCH * 4096); c.go = M.get((size_t)T_ * 512);
            c.gA = c.hcur; c.glda = 1024; c.gW = c.in[16]; c.gldw = OIN; c.gC = c.proj; c.gldc = OIN; c.gR = nullptr; c.gBias = nullptr; c.gM = T_; c.gN = OIN; c.gK = 1024;
            R.template run<ST_GEMM>(c, (long)T_ * OIN);
            R.template run<ST_S5_PAR>(c, 2048);
            for (int sl = 0; sl < S_ / SLAB; ++sl) { c.slab = sl; R.template run<ST_S5_SCAN>(c, 2L * 2048); R.template run<ST_S5_OUT>(c, (long)B_ * SLAB * 512); }
            c.slab = 0;
            R.template run<ST_S5_GLU>(c, (long)T_ * 512);
            R.template run<ST_GLA_GATE>(c, (long)T_ * 256);
            R.template run<ST_GLA_CUM>(c, (long)B_ * NCH * 256);
            R.template run<ST_GLA_U>(c, 8L * NCH * 8192);
            R.template run<ST_GLA_SCAN>(c, 8L * 8192);
            R.template run<ST_GLA_ATT>(c, 8L * NCH * 4096);
            R.template run<ST_GLA_O>(c, 8L * S_ * 128);
            R.template run<ST_GLA_NORM>(c, 8L * S_);
        }
        c.gA = c.mixed; c.glda = 1024; c.gW = c.in[5] + (size_t)layer * 1024 * 1024; c.gldw = 1024; c.gC = c.z; c.gldc = 1024; c.gR = c.hcur; c.gldr = 1024; c.gralpha = ALPHA; c.gM = T_; c.gN = 1024; c.gK = 1024;
        R.template run<ST_GEMM>(c, (long)T_ * 1024);
        c.gR = nullptr;
        c.hout = d_out; c.lnw = c.in[1] + layer * 1024; c.lnb = c.in[2] + layer * 1024;
        R.template run<ST_LN>(c, T_);
        c.hcur = d_out;
        M.off = scratch0; c.hid = M.get((size_t)T_ * 9 * 256);
        R.template run<ST_SCORES>(c, (long)T_ * 64);
        R.template run<ST_SELECT>(c, T_);
        R.template run<ST_HID>(c, (long)T_ * 9 * 256);
        R.template run<ST_FFN>(c, (long)T_ * 1024);
        c.lnw = c.in[3] + layer * 1024; c.lnb = c.in[4] + layer * 1024;
        R.template run<ST_LN>(c, T_);
    }
}
}
#define GAS __attribute__((address_space(1)))
#define LAS __attribute__((address_space(3)))
#define XB_TMO      128
#define XB_XCNT(j)  (256  + 64 * (j))
#define XB_XSUB(j)  (1280 + 64 * (j))
#define XB_XGEN(j)  (2304 + 64 * (j))
#define XB_TOP      3328
#define XB_TOPGEN   3392
#define XCD_BAR_WORDS 3456
#define XB_SPIN_CAP (1u << 22)
__device__ __forceinline__ unsigned xb_ld(unsigned* p)              { return __hip_atomic_load(p, __ATOMIC_RELAXED, __HIP_MEMORY_SCOPE_AGENT); }
__device__ __forceinline__ unsigned xb_add(unsigned* p, unsigned v) { return __hip_atomic_fetch_add(p, v, __ATOMIC_RELAXED, __HIP_MEMORY_SCOPE_AGENT); }
__device__ __forceinline__ unsigned xb_xcc_id() { return (unsigned)__builtin_amdgcn_s_getreg((3 << 11) | 20) & 0xFu; }
#define XB_SPIN(cond, bar) do { unsigned _sp = 0; while (cond) { __builtin_amdgcn_s_sleep(1); \
    if ((++_sp & 255u) == 0u) { if (xb_ld(&(bar)[XB_TMO])) break; if (_sp > XB_SPIN_CAP) { atomicAdd(&(bar)[XB_TMO], 1u); break; } } } } while (0)
struct XcdBarrier { unsigned* bar; unsigned x; volatile LAS unsigned* st; };
__device__ __forceinline__ XcdBarrier xcd_barrier_post(unsigned* bar, volatile LAS unsigned* st) {
    XcdBarrier b; b.bar = bar; b.x = xb_xcc_id(); b.st = st;
    if (threadIdx.x == 0) (void)xb_add(&bar[XB_XCNT(b.x)], 1u);
    return b;
}
__device__ __forceinline__ void xcd_barrier_complete(unsigned* bar, unsigned x, unsigned& nloc, unsigned& nx) {
    const unsigned G = gridDim.x * gridDim.y * gridDim.z;
    unsigned sum, cnt, mine, sp = 0u;
    for (;;) {
        sum = 0u; cnt = 0u; mine = 0u;
#pragma unroll
        for (unsigned j = 0; j < 16; ++j) { const unsigned c = xb_ld(&bar[XB_XCNT(j)]); sum += c; cnt += (c > 0u) ? 1u : 0u; mine = (j == x) ? c : mine; }
        if (sum == G) break;
        __builtin_amdgcn_s_sleep(1);
        if ((++sp & 255u) == 0u) { if (xb_ld(&bar[XB_TMO])) break; if (sp > XB_SPIN_CAP) { atomicAdd(&bar[XB_TMO], 1u); break; } }
    }
    nloc = mine > 0u ? mine : 1u; nx = cnt > 0u ? cnt : 1u;
}
__device__ __forceinline__ void xcd_barrier(const XcdBarrier& b) {
    asm volatile("s_waitcnt vmcnt(0)" ::: "memory");
    __syncthreads();
    if (threadIdx.x == 0) {
        unsigned* bar = b.bar;
        __builtin_amdgcn_s_waitcnt(0);
        unsigned nloc = b.st[0], nx = b.st[1];
        if (nloc == 0u) { xcd_barrier_complete(bar, b.x, nloc, nx); b.st[0] = nloc; b.st[1] = nx; }
        const unsigned old = xb_add(&bar[XB_XSUB(b.x)], 1u);
        const unsigned gen = old / nloc;
        if (old + 1u == (gen + 1u) * nloc) {
            __builtin_amdgcn_fence(__ATOMIC_RELEASE, "agent");
            asm volatile("s_waitcnt vmcnt(0)" ::: "memory");
            const unsigned og = xb_add(&bar[XB_TOP], 1u);
            const unsigned tg = og / nx;
            if (og + 1u == (tg + 1u) * nx) xb_add(&bar[XB_TOPGEN], 1u);
            else XB_SPIN(xb_ld(&bar[XB_TOPGEN]) == tg, bar);
            __builtin_amdgcn_fence(__ATOMIC_ACQUIRE, "agent");
            xb_add(&bar[XB_XGEN(b.x)], 1u);
            asm volatile("s_waitcnt vmcnt(0)" ::: "memory");
        } else {
            XB_SPIN(xb_ld(&bar[XB_XGEN(b.x)]) == gen, bar);
            __builtin_amdgcn_fence(__ATOMIC_ACQUIRE, "agent");
            asm volatile("s_waitcnt vmcnt(0)" ::: "memory");
        }
    }
    __syncthreads();
}
constexpr int NTHREADS = 512;
constexpr int LDS_BYTES = 147456;
constexpr int MISC_OFF = 131072 + 320;
constexpr size_t CTL_BYTES = 1u << 20;
struct DevRunner {
    XcdBarrier bar;
    template <int ST> __device__ __forceinline__ void run(const nv::Ctx& c, long n) {
        for (long i = (long)blockIdx.x * NTHREADS + threadIdx.x; i < n; i += (long)gridDim.x * NTHREADS) nv::item<ST>(c, i);
        xcd_barrier(bar);
    }
};
struct Args { const float* in[38]; float* out; unsigned char* ws; };
__global__ void __launch_bounds__(NTHREADS, 2) mega_fwd(Args a) {
    extern __shared__ __attribute__((aligned(16))) unsigned char lds[];
    LAS unsigned char* l = (LAS unsigned char*)lds;
    for (int u = threadIdx.x; u < (LDS_BYTES - 131072) / 4; u += NTHREADS) ((LAS unsigned*)(l + 131072))[u] = 0u;
    __syncthreads();
    DevRunner R;
    R.bar = xcd_barrier_post((unsigned*)a.ws + 4096, (volatile LAS unsigned*)(l + MISC_OFF) + 8);
    nv::forward(R, (void* const*)a.in, a.out, (float*)(a.ws + CTL_BYTES));
}
extern "C" void kernel_launch(void* const* d_in, const int* in_sizes, int n_in, void* d_out, int out_size, void* d_ws, size_t ws_size, hipStream_t stream) {
    static int grid = 0;
    if (grid == 0) {
        int dev = 0, cus = 0, per_cu = 0;
        hipGetDevice(&dev); hipDeviceGetAttribute(&cus, hipDeviceAttributeMultiprocessorCount, dev);
        hipFuncSetAttribute((const void*)mega_fwd, hipFuncAttributeMaxDynamicSharedMemorySize, LDS_BYTES);
        hipOccupancyMaxActiveBlocksPerMultiprocessor(&per_cu, (const void*)mega_fwd, NTHREADS, LDS_BYTES);
        (void)hipGetLastError();
        grid = (per_cu >= 1) ? cus : -1;
    }
    if (grid < 0) return;
    hipMemsetAsync(d_ws, 0, CTL_BYTES, stream);
    Args a{};
    for (int i = 0; i < 38; ++i) a.in[i] = (const float*)d_in[i];
    a.out = (float*)d_out; a.ws = (unsigned char*)d_ws;
    hipLaunchKernelGGL(mega_fwd, dim3(grid), dim3(NTHREADS), LDS_BYTES, stream, a);
}
```

```cpp
#include <hip/hip_runtime.h>
#ifdef CPU_TEST
#include <cmath>
#include <cstddef>
#define HD inline
#define HDF inline
#else
#define HD __device__ __forceinline__
#define HDF __host__ __device__ __forceinline__
#endif

#ifndef SEQ_
#define SEQ_ 8192
#endif
namespace nv {
constexpr int B_ = 2, S_ = SEQ_, T_ = B_ * S_, D_ = 1024, NCH = S_ / 64;
constexpr int EIN = 3080, OIN = 2064;
constexpr int SLAB = (S_ < 1024 ? S_ : 1024);
constexpr float ALPHA = 1.41421356237309515f, EPS = 1e-5f;

enum Stage { ST_GEMM, ST_ML_GATES, ST_ML_CLOC, ST_ML_SCAN, ST_ML_MI, ST_ML_SMAT, ST_ML_DEN, ST_ML_H, ST_ML_NORM,
             ST_LRU_CONV, ST_LRU_GATE, ST_LRU_SCAN, ST_LN, ST_SCORES, ST_SELECT, ST_HID, ST_FFN,
             ST_S5_PAR, ST_S5_SCAN, ST_S5_OUT, ST_S5_GLU, ST_GLA_GATE, ST_GLA_CUM, ST_GLA_U, ST_GLA_SCAN, ST_GLA_ATT, ST_GLA_O, ST_GLA_NORM };

struct Ctx {
    const float* in[38];
    const float* gA; const float* gW; const float* gR; float* gC; const float* gBias;
    const float* hcur;
    float* hout;
    const float* lnw; const float* lnb;
    float* proj; float* mixed; float* z;
    float* mb; float* mig; float* mblast; float* mmloc; float* mmprev; float* cloc; float* nloc; float* smat; float* mmi; float* mwin; float* mden; float* htil;
    float* lxc; float* la; float* lu;
    float* scores; int* ridx; float* rwt; float* hid;
    float* s5ab; float* s5bbr; float* s5bbi; float* s5st; float* s5x; float* s5g;
    float* gla_la; float* gla_bc; float* gla_bl; float* gu; float* gatt; float* go;
    long gM, gN, gK, glda, gldw, gldc, gldr;
    long ldp;
    float gralpha; int layer; int slab; int pad0;
};

HD float sigm(float x) { return 1.0f / (1.0f + expf(-x)); }
HD float logsig(float x) { return fminf(x, 0.f) - log1pf(expf(-fabsf(x))); }
HD float softplus(float x) { return fmaxf(x, 0.f) + log1pf(expf(-fabsf(x))); }
HD float silu(float x) { return x * sigm(x); }
HD float gelu_t(float x) { return 0.5f * x * (1.0f + tanhf(0.7978845608028654f * (x + 0.044715f * x * x * x))); }

template <int ST> HD void item(const Ctx& c, long idx);

template <> HD void item<ST_GEMM>(const Ctx& c, long idx) {
    const long m = idx / c.gN, n = idx % c.gN;
    float acc = 0.f;
    const float* a = c.gA + m * c.glda; const float* w = c.gW + n;
    for (long k = 0; k < c.gK; ++k) acc += a[k] * w[k * c.gldw];
    if (c.gBias) acc += c.gBias[n];
    if (c.gR) acc += c.gralpha * c.gR[m * c.gldr + n];
    c.gC[m * c.gldc + n] = acc;
}
template <> HD void item<ST_ML_GATES>(const Ctx& c, long idx) {
    const int bh = (int)(idx / NCH), n = (int)(idx % NCH), b = bh / 4, h = bh % 4;
    const float* gb = c.in[7];
    const long t0 = (long)b * S_ + n * 64; const long o0 = (long)bh * S_ + n * 64;
    float acc = 0.f;
    for (int l = 0; l < 64; ++l) {
        const float f = c.proj[(t0 + l) * c.ldp + 2052 + h] + gb[4 + h];
        acc += logsig(f);
        c.mb[o0 + l] = acc;
        c.mig[o0 + l] = c.proj[(t0 + l) * c.ldp + 2048 + h] + gb[h];
    }
    c.mblast[idx] = acc;
    float ml = -INFINITY;
    for (int l = 0; l < 64; ++l) ml = fmaxf(ml, acc - c.mb[o0 + l] + c.mig[o0 + l]);
    c.mmloc[idx] = ml;
}
template <> HD void item<ST_ML_CLOC>(const Ctx& c, long idx) {
    const int e = (int)(idx % 128), d = (int)((idx / 128) % 128); const long cn = idx / 16384;
    const int bh = (int)(cn / NCH), n = (int)(cn % NCH), b = bh / 4, h = bh % 4;
    const long t0 = (long)b * S_ + n * 64; const long o0 = (long)bh * S_ + n * 64;
    const float bl = c.mblast[cn], ml = c.mmloc[cn]; const float sc = 0.08838834764831845f;
    float acc = 0.f, accn = 0.f;
    for (int l = 0; l < 64; ++l) {
        const float p = expf(bl - c.mb[o0 + l] + c.mig[o0 + l] - ml);
        const float kk = c.proj[(t0 + l) * c.ldp + 512 + h * 128 + d] * sc;
        acc += p * kk * c.proj[(t0 + l) * c.ldp + 1024 + h * 128 + e];
        accn += p * kk;
    }
    c.cloc[idx] = acc;
    if (e == 0) c.nloc[cn * 128 + d] = accn;
}
template <> HD void item<ST_ML_SCAN>(const Ctx& c, long idx) {
    const bool isn = idx >= 8L * 16384;
    long bh, de; float* buf; long stride;
    if (!isn) { bh = idx / 16384; de = idx % 16384; buf = c.cloc; stride = 16384; }
    else { const long r = idx - 8L * 16384; bh = r / 128; de = r % 128; buf = c.nloc; stride = 128; }
    float st = 0.f, m = 0.f;
    for (int n = 0; n < NCH; ++n) {
        const long cn = bh * NCH + n;
        const float cl = buf[cn * stride + de]; buf[cn * stride + de] = st;
        const float bl = c.mblast[cn], ml = c.mmloc[cn];
        const float mn = fmaxf(bl + m, ml);
        st = expf(bl + m - mn) * st + expf(ml - mn) * cl;
        if (!isn && de == 0) c.mmprev[cn] = m;
        m = mn;
    }
}
template <> HD void item<ST_ML_MI>(const Ctx& c, long idx) {
    const long bh = idx / S_; const int s = (int)(idx % S_), n = s / 64, i = s % 64; const long cn = bh * NCH + n;
    const long o0 = bh * S_ + n * 64;
    const float bi = c.mb[idx]; const float minter = bi + c.mmprev[cn];
    float dmax = -INFINITY;
    for (int j = 0; j <= i; ++j) dmax = fmaxf(dmax, bi - c.mb[o0 + j] + c.mig[o0 + j]);
    const float mi = fmaxf(minter, dmax);
    c.mmi[idx] = mi; c.mwin[idx] = expf(minter - mi);
}
template <> HD void item<ST_ML_SMAT>(const Ctx& c, long idx) {
    const int j = (int)(idx % 64), i = (int)((idx / 64) % 64); const long cn = idx / 4096;
    const int bh = (int)(cn / NCH), n = (int)(cn % NCH), b = bh / 4, h = bh % 4;
    if (j > i) { c.smat[idx] = 0.f; return; }
    const long t0 = (long)b * S_ + n * 64; const long o0 = (long)bh * S_ + n * 64;
    const float* q = c.proj + (t0 + i) * c.ldp + h * 128; const float* k = c.proj + (t0 + j) * c.ldp + 512 + h * 128;
    float dot = 0.f;
    for (int d = 0; d < 128; ++d) dot += q[d] * k[d];
    dot *= 0.08838834764831845f;
    c.smat[idx] = dot * expf(c.mb[o0 + i] - c.mb[o0 + j] + c.mig[o0 + j] - c.mmi[o0 + i]);
}
template <> HD void item<ST_ML_DEN>(const Ctx& c, long idx) {
    const long bh = idx / S_; const int s = (int)(idx % S_), n = s / 64, i = s % 64; const long cn = bh * NCH + n;
    const int b = (int)(bh / 4), h = (int)(bh % 4);
    float den = 0.f;
    for (int j = 0; j <= i; ++j) den += c.smat[cn * 4096 + i * 64 + j];
    const float* q = c.proj + ((long)b * S_ + s) * c.ldp + h * 128;
    float qn = 0.f;
    for (int d = 0; d < 128; ++d) qn += q[d] * c.nloc[cn * 128 + d];
    den += c.mwin[idx] * qn;
    c.mden[idx] = fmaxf(fabsf(den), expf(-c.mmi[idx]));
}
template <> HD void item<ST_ML_H>(const Ctx& c, long idx) {
    const int e = (int)(idx % 128); const long bs = idx / 128; const long bh = bs / S_; const int s = (int)(bs % S_), n = s / 64, i = s % 64;
    const long cn = bh * NCH + n; const int b = (int)(bh / 4), h = (int)(bh % 4);
    const long t0 = (long)b * S_ + n * 64;
    float num = 0.f;
    for (int j = 0; j <= i; ++j) num += c.smat[cn * 4096 + i * 64 + j] * c.proj[(t0 + j) * c.ldp + 1024 + h * 128 + e];
    const float* q = c.proj + (t0 + i) * c.ldp + h * 128;
    float qc = 0.f;
    for (int d = 0; d < 128; ++d) qc += q[d] * c.cloc[cn * 16384 + d * 128 + e];
    num += c.mwin[bs] * qc;
    c.htil[(t0 + i) * 512 + h * 128 + e] = num / c.mden[bs];
}
template <> HD void item<ST_ML_NORM>(const Ctx& c, long idx) {
    const long bh = idx / S_; const int s = (int)(idx % S_); const int b = (int)(bh / 4), h = (int)(bh % 4);
    const long t = (long)b * S_ + s;
    const float* ht = c.htil + t * 512 + h * 128; const float* nw = c.in[8];
    float mean = 0.f;
    for (int e = 0; e < 128; ++e) mean += ht[e];
    mean *= (1.f / 128.f);
    float var = 0.f;
    for (int e = 0; e < 128; ++e) { const float d = ht[e] - mean; var += d * d; }
    const float rstd = 1.0f / sqrtf(var * (1.f / 128.f) + EPS);
    for (int e = 0; e < 128; ++e)
        c.mixed[t * 1024 + h * 128 + e] = (ht[e] - mean) * rstd * nw[h * 128 + e] * sigm(c.proj[t * c.ldp + 1536 + h * 128 + e]);
}
template <> HD void item<ST_LRU_CONV>(const Ctx& c, long idx) {
    const long t = idx / 512; const int ch = (int)(idx % 512); const int s = (int)(t % S_);
    const float* cw = c.in[9];
    float acc = c.in[10][ch];
    for (int j = 0; j < 4; ++j) { const int ss = s - 3 + j; if (ss >= 0) acc += cw[j * 512 + ch] * c.proj[(t - 3 + j) * c.ldp + 2056 + ch]; }
    c.lxc[idx] = acc;
}
template <> HD void item<ST_LRU_GATE>(const Ctx& c, long idx) {
    const long t = idx / 512; const int ch = (int)(idx % 512), hh = ch / 128, jj = ch % 128;
    const float* wa = c.in[11] + (long)hh * 16384; const float* wx = c.in[13] + (long)hh * 16384;
    const float* xr = c.lxc + t * 512 + hh * 128;
    float ra = c.in[12][ch], xa = c.in[14][ch];
    for (int i = 0; i < 128; ++i) { ra += xr[i] * wa[i * 128 + jj]; xa += xr[i] * wx[i * 128 + jj]; }
    const float r = sigm(ra), ii = sigm(xa);
    const float la = -8.0f * r * softplus(-c.in[15][ch]);
    c.la[idx] = expf(la);
    c.lu[idx] = sqrtf(-expm1f(2.0f * la)) * ii * c.lxc[idx];
}
template <> HD void item<ST_LRU_SCAN>(const Ctx& c, long idx) {
    const int b = (int)(idx / 512), ch = (int)(idx % 512);
    float h = 0.f;
    for (int s = 0; s < S_; ++s) {
        const long t = (long)b * S_ + s;
        h = c.la[t * 512 + ch] * h + c.lu[t * 512 + ch];
        c.mixed[t * 1024 + 512 + ch] = h * gelu_t(c.proj[t * c.ldp + 2568 + ch]);
    }
}
template <> HD void item<ST_LN>(const Ctx& c, long t) {
    const float* zr = c.z + t * 1024;
    float mean = 0.f;
    for (int i = 0; i < 1024; ++i) mean += zr[i];
    mean *= (1.f / 1024.f);
    float var = 0.f;
    for (int i = 0; i < 1024; ++i) { const float d = zr[i] - mean; var += d * d; }
    const float rstd = 1.0f / sqrtf(var * (1.f / 1024.f) + EPS);
    for (int i = 0; i < 1024; ++i) c.hout[t * 1024 + i] = (zr[i] - mean) * rstd * c.lnw[i] + c.lnb[i];
}
template <> HD void item<ST_SCORES>(const Ctx& c, long idx) {
    const long t = idx / 64; const int e = (int)(idx % 64);
    const float* rw = c.in[30] + (long)c.layer * 1024 * 64; const float* hr = c.hcur + t * 1024;
    float acc = 0.f;
    for (int k = 0; k < 1024; ++k) acc += hr[k] * rw[k * 64 + e];
    c.scores[idx] = sigm(acc);
}
template <> HD void item<ST_SELECT>(const Ctx& c, long t) {
    const float* sc = c.scores + t * 64; const float* bias = c.in[31] + c.layer * 64;
    float gs[8];
#pragma unroll
    for (int g = 0; g < 8; ++g) {
        float m1 = -INFINITY, m2 = -INFINITY;
        for (int j = 0; j < 8; ++j) { const float v = sc[g * 8 + j] + bias[g * 8 + j]; if (v > m1) { m2 = m1; m1 = v; } else if (v > m2) m2 = v; }
        gs[g] = m1 + m2;
    }
    unsigned gsel = 0;
    for (int it = 0; it < 4; ++it) {
        float best = -INFINITY; int bi = 0;
#pragma unroll
        for (int g = 0; g < 8; ++g) { const bool ok = !((gsel >> g) & 1u) && gs[g] > best; best = ok ? gs[g] : best; bi = ok ? g : bi; }
        gsel |= 1u << bi;
    }
    unsigned long long taken = 0ull; float wsum = 0.f;
    for (int it = 0; it < 8; ++it) {
        float best = -INFINITY; int bi = 0;
        for (int e = 0; e < 64; ++e) {
            if (!((gsel >> (e >> 3)) & 1u) || ((taken >> e) & 1ull)) continue;
            const float v = sc[e] + bias[e];
            if (v > best) { best = v; bi = e; }
        }
        taken |= 1ull << bi;
        c.ridx[t * 8 + it] = bi; const float w = sc[bi]; c.rwt[t * 8 + it] = w; wsum += w;
    }
    const float inv = 2.5f / wsum;
    for (int it = 0; it < 8; ++it) c.rwt[t * 8 + it] *= inv;
}
template <> HD void item<ST_HID>(const Ctx& c, long idx) {
    const int j = (int)(idx % 256), k = (int)((idx / 256) % 9); const long t = idx / 2304;
    const float *wg, *wu;
    if (k < 8) { const long e = (long)c.layer * 64 + c.ridx[t * 8 + k]; wg = c.in[32] + e * 262144; wu = c.in[33] + e * 262144; }
    else { wg = c.in[35] + (long)c.layer * 262144; wu = c.in[36] + (long)c.layer * 262144; }
    const float* hr = c.hcur + t * 1024;
    float g = 0.f, u = 0.f;
    for (int d = 0; d < 1024; ++d) { const float x = hr[d]; g += x * wg[d * 256 + j]; u += x * wu[d * 256 + j]; }
    c.hid[idx] = silu(g) * u;
}
template <> HD void item<ST_FFN>(const Ctx& c, long idx) {
    const long t = idx / 1024; const int n = (int)(idx % 1024);
    float tot = 0.f;
    for (int k = 0; k < 9; ++k) {
        const float* wd; float w;
        if (k < 8) { const long e = (long)c.layer * 64 + c.ridx[t * 8 + k]; wd = c.in[34] + e * 262144; w = c.rwt[t * 8 + k]; }
        else { wd = c.in[37] + (long)c.layer * 262144; w = 1.f; }
        const float* hr = c.hid + (t * 9 + k) * 256;
        float acc = 0.f;
        for (int j = 0; j < 256; ++j) acc += hr[j] * wd[j * 1024 + n];
        tot += w * acc;
    }
    c.z[idx] = ALPHA * c.hcur[idx] + tot;
}
template <> HD void item<ST_S5_PAR>(const Ctx& c, long idx) {
    const int g = (int)(idx / 64);
    const float lr = c.in[17][idx], li = c.in[18][idx]; const float dt = expf(c.in[24][g]);
    const float mag = expf(lr * dt); const float ar = mag * cosf(li * dt), ai = mag * sinf(li * dt);
    const float den = lr * lr + li * li, nr = ar - 1.0f;
    const float cr = (nr * lr + ai * li) / den, ci = (ai * lr - nr * li) / den;
    c.s5ab[idx * 2] = ar; c.s5ab[idx * 2 + 1] = ai;
    for (int h = 0; h < 16; ++h) {
        const float br = c.in[19][idx * 16 + h], bi = c.in[20][idx * 16 + h];
        c.s5bbr[idx * 16 + h] = cr * br - ci * bi; c.s5bbi[idx * 16 + h] = cr * bi + ci * br;
    }
}
template <> HD void item<ST_S5_SCAN>(const Ctx& c, long idx) {
    const int gp = (int)(idx % 2048), g = gp / 64, b = (int)(idx / 2048);
    const float ar = c.s5ab[gp * 2], ai = c.s5ab[gp * 2 + 1];
    float xr = 0.f, xi = 0.f;
    if (c.slab > 0) { xr = c.s5st[idx * 2]; xi = c.s5st[idx * 2 + 1]; }
    for (int sl = 0; sl < SLAB; ++sl) {
        const long t = (long)b * S_ + (long)c.slab * SLAB + sl;
        const float* u = c.proj + t * c.ldp + g * 16;
        float br = 0.f, bi = 0.f;
        for (int h = 0; h < 16; ++h) { br += u[h] * c.s5bbr[gp * 16 + h]; bi += u[h] * c.s5bbi[gp * 16 + h]; }
        const float nr = ar * xr - ai * xi + br, ni = ar * xi + ai * xr + bi;
        xr = nr; xi = ni;
        const long o = (((long)b * SLAB + sl) * 2048 + gp) * 2;
        c.s5x[o] = xr; c.s5x[o + 1] = xi;
    }
    c.s5st[idx * 2] = xr; c.s5st[idx * 2 + 1] = xi;
}
template <> HD void item<ST_S5_OUT>(const Ctx& c, long idx) {
    const int ch = (int)(idx % 512), g = ch / 16; const long bs = idx / 512; const int b = (int)(bs / SLAB), sl = (int)(bs % SLAB);
    const long t = (long)b * S_ + (long)c.slab * SLAB + sl;
    const float* x = c.s5x + (bs * 2048 + g * 64) * 2; const float* cre = c.in[21] + ch * 64; const float* cim = c.in[22] + ch * 64;
    float y = 0.f;
    for (int p = 0; p < 64; ++p) y += x[2 * p] * cre[p] - x[2 * p + 1] * cim[p];
    y += c.in[23][ch] * c.proj[t * c.ldp + ch];
    c.s5g[t * 512 + ch] = gelu_t(y);
}
template <> HD void item<ST_S5_GLU>(const Ctx& c, long idx) {
    const long t = idx / 512; const int n = (int)(idx % 512);
    const float* gr = c.s5g + t * 512; const float* w = c.in[25];
    float acc = c.in[26][n];
    for (int k = 0; k < 512; ++k) acc += gr[k] * w[k * 512 + n];
    c.mixed[t * 1024 + n] = gr[n] * sigm(acc);
}
template <> HD void item<ST_GLA_GATE>(const Ctx& c, long idx) {
    const long t = idx / 256; const int ch = (int)(idx % 256);
    float acc = c.in[28][ch];
    for (int r = 0; r < 16; ++r) acc += c.proj[t * c.ldp + 2048 + r] * c.in[27][r * 256 + ch];
    c.gla_la[idx] = logsig(acc) * (1.0f / 16.0f);
}
template <> HD void item<ST_GLA_CUM>(const Ctx& c, long idx) {
    const int ch = (int)(idx % 256); const long bn = idx / 256; const int b = (int)(bn / NCH), n = (int)(bn % NCH);
    const long t0 = (long)b * S_ + n * 64;
    float acc = 0.f;
    for (int l = 0; l < 64; ++l) { acc += c.gla_la[(t0 + l) * 256 + ch]; c.gla_bc[(t0 + l) * 256 + ch] = acc; }
    c.gla_bl[idx] = acc;
}
template <> HD void item<ST_GLA_U>(const Ctx& c, long idx) {
    const int e = (int)(idx % 128), d = (int)((idx / 128) % 64); const long cn = idx / 8192;
    const int bh = (int)(cn / NCH), n = (int)(cn % NCH), b = bh / 4, h = bh % 4;
    const long t0 = (long)b * S_ + n * 64;
    const float bl = c.gla_bl[((long)b * NCH + n) * 256 + h * 64 + d];
    float acc = 0.f;
    for (int l = 0; l < 64; ++l)
        acc += c.proj[(t0 + l) * c.ldp + 768 + h * 64 + d] * expf(bl - c.gla_bc[(t0 + l) * 256 + h * 64 + d]) * c.proj[(t0 + l) * c.ldp + 1024 + h * 128 + e];
    c.gu[idx] = acc;
}
template <> HD void item<ST_GLA_SCAN>(const Ctx& c, long idx) {
    const long bh = idx / 8192; const int de = (int)(idx % 8192), d = de / 128; const int b = (int)(bh / 4), h = (int)(bh % 4);
    float st = 0.f;
    for (int n = 0; n < NCH; ++n) {
        const long cn = bh * NCH + n;
        const float u = c.gu[cn * 8192 + de]; c.gu[cn * 8192 + de] = st;
        st = expf(c.gla_bl[((long)b * NCH + n) * 256 + h * 64 + d]) * st + u;
    }
}
template <> HD void item<ST_GLA_ATT>(const Ctx& c, long idx) {
    const int j = (int)(idx % 64), i = (int)((idx / 64) % 64); const long cn = idx / 4096;
    const int bh = (int)(cn / NCH), n = (int)(cn % NCH), b = bh / 4, h = bh % 4;
    if (j > i) { c.gatt[idx] = 0.f; return; }
    const long ti = (long)b * S_ + n * 64 + i, tj = (long)b * S_ + n * 64 + j;
    float acc = 0.f;
    for (int d = 0; d < 64; ++d)
        acc += c.proj[ti * c.ldp + 512 + h * 64 + d] * 0.125f * expf(c.gla_bc[ti * 256 + h * 64 + d] - c.gla_bc[tj * 256 + h * 64 + d]) * c.proj[tj * c.ldp + 768 + h * 64 + d];
    c.gatt[idx] = acc;
}
template <> HD void item<ST_GLA_O>(const Ctx& c, long idx) {
    const int e = (int)(idx % 128); const long bs = idx / 128; const long bh = bs / S_; const int s = (int)(bs % S_), n = s / 64, i = s % 64;
    const long cn = bh * NCH + n; const int b = (int)(bh / 4), h = (int)(bh % 4);
    const long t0 = (long)b * S_ + n * 64, t = t0 + i;
    float acc = 0.f;
    for (int j = 0; j <= i; ++j) acc += c.gatt[cn * 4096 + i * 64 + j] * c.proj[(t0 + j) * c.ldp + 1024 + h * 128 + e];
    for (int d = 0; d < 64; ++d)
        acc += c.proj[t * c.ldp + 512 + h * 64 + d] * 0.125f * expf(c.gla_bc[t * 256 + h * 64 + d]) * c.gu[cn * 8192 + d * 128 + e];
    c.go[t * 512 + h * 128 + e] = acc;
}
template <> HD void item<ST_GLA_NORM>(const Ctx& c, long idx) {
    const long bh = idx / S_; const int s = (int)(idx % S_); const int b = (int)(bh / 4), h = (int)(bh % 4);
    const long t = (long)b * S_ + s;
    const float* o = c.go + t * 512 + h * 128;
    float ms = 0.f;
    for (int e = 0; e < 128; ++e) ms += o[e] * o[e];
    const float rstd = 1.0f / sqrtf(ms * (1.f / 128.f) + EPS);
    for (int e = 0; e < 128; ++e)
        c.mixed[t * 1024 + 512 + h * 128 + e] = o[e] * rstd * c.in[29][h * 128 + e] * silu(c.proj[t * c.ldp + 1536 + h * 128 + e]);
}

struct Mem { float* base; size_t off; HDF float* get(size_t n) { float* p = base + off; off += (n + 63) & ~(size_t)63; return p; } };

template <class Runner> HDF void forward(Runner& R, void* const* d_in, float* d_out, float* ws) {
    Ctx c{};
    for (int i = 0; i < 38; ++i) c.in[i] = (const float*)d_in[i];
    Mem M{ws, 0};
    c.z = M.get((size_t)T_ * 1024); c.mixed = M.get((size_t)T_ * 1024); c.scores = M.get((size_t)T_ * 64);
    c.ridx = (int*)M.get((size_t)T_ * 8); c.rwt = M.get((size_t)T_ * 8);
    const size_t scratch0 = M.off;
    for (int layer = 0; layer < 2; ++layer) {
        c.layer = layer;
        c.hcur = layer == 0 ? c.in[0] : d_out;
        M.off = scratch0;
        if (layer == 0) {
            c.ldp = EIN; c.proj = M.get((size_t)T_ * c.ldp);
            c.mb = M.get(8 * S_); c.mig = M.get(8 * S_); c.mblast = M.get(8 * NCH); c.mmloc = M.get(8 * NCH); c.mmprev = M.get(8 * NCH);
            c.mmi = M.get(8 * S_); c.mwin = M.get(8 * S_); c.mden = M.get(8 * S_); c.nloc = M.get(8 * NCH * 128);
            const size_t ov = M.off;
            c.cloc = M.get((size_t)8 * NCH * 16384); c.smat = M.get((size_t)8 * NCH * 4096); c.htil = M.get((size_t)T_ * 512);
            M.off = ov; c.lxc = M.get((size_t)T_ * 512); c.la = M.get((size_t)T_ * 512); c.lu = M.get((size_t)T_ * 512);
            c.gA = c.hcur; c.glda = 1024; c.gW = c.in[6]; c.gldw = EIN; c.gC = c.proj; c.gldc = EIN; c.gR = nullptr; c.gBias = nullptr; c.gM = T_; c.gN = EIN; c.gK = 1024;
            R.template run<ST_GEMM>(c, (long)T_ * c.ldp);
            R.template run<ST_ML_GATES>(c, 8L * NCH);
            R.template run<ST_ML_CLOC>(c, 8L * NCH * 16384);
            R.template run<ST_ML_SCAN>(c, 8L * 16384 + 8 * 128);
            R.template run<ST_ML_MI>(c, 8L * S_);
            R.template run<ST_ML_SMAT>(c, 8L * NCH * 4096);
            R.template run<ST_ML_DEN>(c, 8L * S_);
            R.template run<ST_ML_H>(c, 8L * S_ * 128);
            R.template run<ST_ML_NORM>(c, 8L * S_);
            R.template run<ST_LRU_CONV>(c, (long)T_ * 512);
            R.template run<ST_LRU_GATE>(c, (long)T_ * 512);
            R.template run<ST_LRU_SCAN>(c, 2L * 512);
        } else {
            c.ldp = OIN; c.proj = M.get((size_t)T_ * c.ldp);
            c.s5ab = M.get(2048 * 2); c.s5bbr = M.get(2048 * 16); c.s5bbi = M.get(2048 * 16); c.s5st = M.get(2 * 2048 * 2);
            c.s5x = M.get((size_t)B_ * SLAB * 2048 * 2); c.s5g = M.get((size_t)T_ * 512);
            c.gla_la = M.get((size_t)T_ * 256); c.gla_bc = M.get((size_t)T_ * 256); c.gla_bl = M.get((size_t)B_ * NCH * 256);
            c.gu = M.get((size_t)8 * NCH * 8192); c.gatt = M.get((size_t)8 * NCH * 4096); c.go = M.get((size_t)T_ * 512);
            c.gA = c.hcur; c.glda = 1024; c.gW = c.in[16]; c.gldw = OIN; c.gC = c.proj; c.gldc = OIN; c.gR = nullptr; c.gBias = nullptr; c.gM = T_; c.gN = OIN; c.gK = 1024;
            R.template run<ST_GEMM>(c, (long)T_ * c.ldp);
            R.template run<ST_S5_PAR>(c, 2048);
            for (int sl = 0; sl < S_ / SLAB; ++sl) { c.slab = sl; R.template run<ST_S5_SCAN>(c, 2L * 2048); R.template run<ST_S5_OUT>(c, (long)B_ * SLAB * 512); }
            c.slab = 0;
            R.template run<ST_S5_GLU>(c, (long)T_ * 512);
            R.template run<ST_GLA_GATE>(c, (long)T_ * 256);
            R.template run<ST_GLA_CUM>(c, (long)B_ * NCH * 256);
            R.template run<ST_GLA_U>(c, 8L * NCH * 8192);
            R.template run<ST_GLA_SCAN>(c, 8L * 8192);
            R.template run<ST_GLA_ATT>(c, 8L * NCH * 4096);
            R.template run<ST_GLA_O>(c, 8L * S_ * 128);
            R.template run<ST_GLA_NORM>(c, 8L * S_);
        }
        c.gA = c.mixed; c.glda = 1024; c.gW = c.in[5] + (size_t)layer * 1024 * 1024; c.gldw = 1024; c.gC = c.z; c.gldc = 1024; c.gR = c.hcur; c.gldr = 1024; c.gralpha = ALPHA; c.gM = T_; c.gN = 1024; c.gK = 1024;
        R.template run<ST_GEMM>(c, (long)T_ * 1024);
        c.gR = nullptr;
        c.hout = d_out; c.lnw = c.in[1] + layer * 1024; c.lnb = c.in[2] + layer * 1024;
        R.template run<ST_LN>(c, T_);
        c.hcur = d_out;
        M.off = scratch0; c.hid = M.get((size_t)T_ * 9 * 256);
        R.template run<ST_SCORES>(c, (long)T_ * 64);
        R.template run<ST_SELECT>(c, T_);
        R.template run<ST_HID>(c, (long)T_ * 9 * 256);
        R.template run<ST_FFN>(c, (long)T_ * 1024);
        c.lnw = c.in[3] + layer * 1024; c.lnb = c.in[4] + layer * 1024;
        R.template run<ST_LN>(c, T_);
    }
}
}
#define GAS __attribute__((address_space(1)))
#define LAS __attribute__((address_space(3)))
#define XB_TMO      128
#define XB_XCNT(j)  (256  + 64 * (j))
#define XB_XSUB(j)  (1280 + 64 * (j))
#define XB_XGEN(j)  (2304 + 64 * (j))
#define XB_TOP      3328
#define XB_TOPGEN   3392
#define XCD_BAR_WORDS 3456
#define XB_SPIN_CAP (1u << 22)
__device__ __forceinline__ unsigned xb_ld(unsigned* p)              { return __hip_atomic_load(p, __ATOMIC_RELAXED, __HIP_MEMORY_SCOPE_AGENT); }
__device__ __forceinline__ unsigned xb_add(unsigned* p, unsigned v) { return __hip_atomic_fetch_add(p, v, __ATOMIC_RELAXED, __HIP_MEMORY_SCOPE_AGENT); }
__device__ __forceinline__ unsigned xb_xcc_id() { return (unsigned)__builtin_amdgcn_s_getreg((3 << 11) | 20) & 0xFu; }
#define XB_SPIN(cond, bar) do { unsigned _sp = 0; while (cond) { __builtin_amdgcn_s_sleep(1); \
    if ((++_sp & 255u) == 0u) { if (xb_ld(&(bar)[XB_TMO])) break; if (_sp > XB_SPIN_CAP) { atomicAdd(&(bar)[XB_TMO], 1u); break; } } } } while (0)
struct XcdBarrier { unsigned* bar; unsigned x; volatile LAS unsigned* st; };
__device__ __forceinline__ XcdBarrier xcd_barrier_post(unsigned* bar, volatile LAS unsigned* st) {
    XcdBarrier b; b.bar = bar; b.x = xb_xcc_id(); b.st = st;
    if (threadIdx.x == 0) (void)xb_add(&bar[XB_XCNT(b.x)], 1u);
    return b;
}
__device__ __forceinline__ void xcd_barrier_complete(unsigned* bar, unsigned x, unsigned& nloc, unsigned& nx) {
    const unsigned G = gridDim.x * gridDim.y * gridDim.z;
    unsigned sum, cnt, mine, sp = 0u;
    for (;;) {
        sum = 0u; cnt = 0u; mine = 0u;
#pragma unroll
        for (unsigned j = 0; j < 16; ++j) { const unsigned c = xb_ld(&bar[XB_XCNT(j)]); sum += c; cnt += (c > 0u) ? 1u : 0u; mine = (j == x) ? c : mine; }
        if (sum == G) break;
        __builtin_amdgcn_s_sleep(1);
        if ((++sp & 255u) == 0u) { if (xb_ld(&bar[XB_TMO])) break; if (sp > XB_SPIN_CAP) { atomicAdd(&bar[XB_TMO], 1u); break; } }
    }
    nloc = mine > 0u ? mine : 1u; nx = cnt > 0u ? cnt : 1u;
}
__device__ __forceinline__ void xcd_barrier(const XcdBarrier& b) {
    asm volatile("s_waitcnt vmcnt(0)" ::: "memory");
    __syncthreads();
    if (threadIdx.x == 0) {
        unsigned* bar = b.bar;
        __builtin_amdgcn_s_waitcnt(0);
        unsigned nloc = b.st[0], nx = b.st[1];
        if (nloc == 0u) { xcd_barrier_complete(bar, b.x, nloc, nx); b.st[0] = nloc; b.st[1] = nx; }
        const unsigned old = xb_add(&bar[XB_XSUB(b.x)], 1u);
        const unsigned gen = old / nloc;
        if (old + 1u == (gen + 1u) * nloc) {
            __builtin_amdgcn_fence(__ATOMIC_RELEASE, "agent");
            asm volatile("s_waitcnt vmcnt(0)" ::: "memory");
            const unsigned og = xb_add(&bar[XB_TOP], 1u);
            const unsigned tg = og / nx;
            if (og + 1u == (tg + 1u) * nx) xb_add(&bar[XB_TOPGEN], 1u);
            else XB_SPIN(xb_ld(&bar[XB_TOPGEN]) == tg, bar);
            __builtin_amdgcn_fence(__ATOMIC_ACQUIRE, "agent");
            xb_add(&bar[XB_XGEN(b.x)], 1u);
            asm volatile("s_waitcnt vmcnt(0)" ::: "memory");
        } else {
            XB_SPIN(xb_ld(&bar[XB_XGEN(b.x)]) == gen, bar);
            __builtin_amdgcn_fence(__ATOMIC_ACQUIRE, "agent");
            asm volatile("s_waitcnt vmcnt(0)" ::: "memory");
        }
    }
    __syncthreads();
}
namespace pg8 {
#define PG8_LAS __attribute__((address_space(3)))
typedef unsigned short bf16_t;
typedef short bf16x8 __attribute__((ext_vector_type(8)));
typedef float f32x4 __attribute__((ext_vector_type(4)));
typedef unsigned u32x4 __attribute__((ext_vector_type(4)));
constexpr int BM = 256, BK = 64, HALF = 128, HTB = HALF * BK * 2, STAGE_BYTES = 8 * HTB, NXCD = 8, WGM = 8;
__host__ __device__ __forceinline__ int lds_byte(int r, int c) { const int st = (r >> 4) * 2 + (c >> 5), rr = r & 15, cc = c & 31, ob = rr * 64 + cc * 2; return st * 1024 + (ob ^ (((ob >> 9) & 1) << 5)); }
__host__ __device__ __forceinline__ void stage_rc(int b, int& R, int& C) { const int st = b / 1024, sb = b % 1024, swz = sb ^ (((sb >> 9) & 1) << 5); R = (st >> 1) * 16 + swz / 64; C = (st & 1) * 32 + (swz % 64) / 2; }
__host__ __device__ __forceinline__ int perm32(int rho) { const int n = rho >> 4, i = rho & 15; return 8 * (i >> 2) + 4 * n + (i & 3); }
struct Unit { int pm, pn, e, aux; };
struct Gemm { const bf16_t* A; const bf16_t* Bt; int K; int pad; size_t bstride; const int* rows; };
struct StaticOrder {
    int nM, nN, nwg, G, c;
    __host__ __device__ void init(int M, int N, int G_, int c_) { nM = M / BM; nN = N / BM; nwg = nM * nN; G = G_; c = c_; }
    __host__ __device__ bool next(int i, Unit& u) const {
        const long L = (long)i * G + c; if (L >= nwg) return false;
        int wgid = (int)L; { const int q = nwg / NXCD, r = nwg % NXCD, xcd = wgid % NXCD, off = wgid / NXCD; wgid = (xcd < r ? xcd * (q + 1) : r * (q + 1) + (xcd - r) * q) + off; }
        const int nig = WGM * nN, gid = wgid / nig, fm = gid * WGM, gsz = (nM - fm) < WGM ? (nM - fm) : WGM;
        u.pm = fm + ((wgid % nig) % gsz); u.pn = (wgid % nig) / gsz; u.e = 0; u.aux = 0; return true;
    }
};
__device__ __forceinline__ unsigned cvt_pk_bf16(float lo, float hi) { unsigned r; asm volatile("v_cvt_pk_bf16_f32 %0, %1, %2" : "=v"(r) : "v"(lo), "v"(hi)); return r; }
struct EpiF32R {
    static constexpr bool PERM = false;
    float* C; int ldc; const float* R; float ralpha;
    __device__ __forceinline__ void operator()(const f32x4 (&acc)[2][2][4][2], const Unit& u, int wr, int wc, int fr, int fq) const {
        const int row0 = u.pm * BM + wr * 64 + fr, col0 = u.pn * BM + wc * 32 + 4 * fq;
#pragma unroll
        for (int ai = 0; ai < 2; ++ai)
#pragma unroll
            for (int m = 0; m < 4; ++m) { const size_t off = (size_t)(row0 + ai * HALF + m * 16) * ldc + col0;
#pragma unroll
                for (int bj = 0; bj < 2; ++bj)
#pragma unroll
                    for (int n = 0; n < 2; ++n) { f32x4 v = acc[ai][bj][m][n]; if (R) v = v + ralpha * *(const f32x4*)(R + off + bj * HALF + n * 16); *(f32x4*)(C + off + bj * HALF + n * 16) = v; } }
    }
};
template <class Epi, class Sched, bool ALIGN_EPI, bool GATHER>
__device__ __forceinline__ void gemm_phase(PG8_LAS unsigned char* lds, const Gemm g, const Sched& S, const Epi& E) {
    int tid_ = threadIdx.x; asm volatile("" : "+v"(tid_));
    const int tid = tid_, wid = __builtin_amdgcn_readfirstlane(tid >> 6), lane = tid & 63, wr = wid >> 2, wc = wid & 3, fr = lane & 15, fq = lane >> 4;
    const int K = g.K, nt = K / BK;
    unsigned voffA[2], voffB[2]; int RA[2], CA2[2];
#pragma unroll
    for (int i = 0; i < 2; ++i) { int R, C; stage_rc(tid * 16 + i * 8192, R, C); const int Rb = Epi::PERM ? ((R & ~31) + perm32(R & 31)) : R;
        voffA[i] = (unsigned)(R * K + C) * 2u; voffB[i] = (unsigned)(Rb * K + C) * 2u; RA[i] = R; CA2[i] = C * 2; }
    const size_t kstep = (size_t)(BK * 2);
    const size_t hstep = (size_t)HALF * K * 2;
    const size_t tstep = 2 * hstep;
    const unsigned ldsw = (unsigned)wid * 1024u;
    const int aoff = lds_byte(wr * 64 + fr, fq * 8), boff = lds_byte(wc * 32 + fr, fq * 8);
#define PG8_SA(b, h) (((b) * 2 + (h)) * HTB)
#define PG8_SB(b, h) ((4 + (b) * 2 + (h)) * HTB)
#define PG8_STAGE(bufoff, gbase, voff) do { _Pragma("unroll") for (int _i = 0; _i < 2; ++_i) \
        __builtin_amdgcn_global_load_lds((const unsigned*)((const char*)(gbase) + (voff)[_i]), (PG8_LAS unsigned*)(lds + (bufoff) + ldsw + _i * 8192), 16, 0, 0); } while (0)
#define PG8_STAGE_A(bufoff, gbase, h, GV) do { if constexpr (GATHER) { PG8_STAGE(bufoff, gbase, GV[h]); } else { PG8_STAGE(bufoff, (gbase) + (h) * hstep, voffA); } } while (0)
#define PG8_LDA(dst, b, h) do { _Pragma("unroll") for (int m = 0; m < 4; ++m) _Pragma("unroll") for (int k = 0; k < 2; ++k) dst[m][k] = *(const PG8_LAS bf16x8*)(lds + PG8_SA(b, h) + aoff + m * 2048 + k * 1024); } while (0)
#define PG8_LDB(dst, b, h) do { _Pragma("unroll") for (int n = 0; n < 2; ++n) _Pragma("unroll") for (int k = 0; k < 2; ++k) dst[n][k] = *(const PG8_LAS bf16x8*)(lds + PG8_SB(b, h) + boff + n * 2048 + k * 1024); } while (0)
#define PG8_MMA(ai, bj, At, Bt) do { __builtin_amdgcn_s_setprio(1); _Pragma("unroll") for (int m = 0; m < 4; ++m) _Pragma("unroll") for (int n = 0; n < 2; ++n) _Pragma("unroll") for (int k = 0; k < 2; ++k) \
        acc[ai][bj][m][n] = __builtin_amdgcn_mfma_f32_16x16x32_bf16(Bt[n][k], At[m][k], acc[ai][bj][m][n], 0, 0, 0); __builtin_amdgcn_s_setprio(0); } while (0)
#define PG8_WAIT_V(n) asm volatile("s_waitcnt vmcnt(" #n ")" ::: "memory")
#define PG8_WAIT_L(n) asm volatile("s_waitcnt lgkmcnt(" #n ")" ::: "memory")
#define PG8_BAR __builtin_amdgcn_s_barrier()
#define PG8_SCHED __builtin_amdgcn_sched_barrier(0)
#define PG8_GLOAD(GV, u) do { _Pragma("unroll") for (int _h = 0; _h < 2; ++_h) _Pragma("unroll") for (int _i = 0; _i < 2; ++_i) \
        GV[_h][_i] = (unsigned)g.rows[(u).pm * BM + _h * HALF + RA[_i]] * (unsigned)(K * 2) + (unsigned)CA2[_i]; } while (0)
    Unit cur, nxt; int ui = 0;
    if (!S.next(0, cur)) return;
    f32x4 acc[2][2][4][2];
#pragma unroll
    for (int a = 0; a < 2; ++a)
#pragma unroll
        for (int b = 0; b < 2; ++b)
#pragma unroll
            for (int m = 0; m < 4; ++m)
#pragma unroll
                for (int n = 0; n < 2; ++n) acc[a][b][m][n] = (f32x4){0.f, 0.f, 0.f, 0.f};
    bf16x8 At[4][2], B0[2][2], B1[2][2];
    unsigned gcur[2][2] = {{0u, 0u}, {0u, 0u}}, gnxt[2][2] = {{0u, 0u}, {0u, 0u}}, g2[2][2] = {{0u, 0u}, {0u, 0u}};
    if constexpr (GATHER) { PG8_GLOAD(gcur, cur); }
    const char* cA = GATHER ? (const char*)g.A : (const char*)g.A + (size_t)cur.pm * tstep;
    const char* cB = (const char*)g.Bt + ((size_t)cur.e * g.bstride) * 2 + (size_t)cur.pn * tstep;
    PG8_STAGE(PG8_SB(0, 0), cB, voffB); PG8_STAGE(PG8_SB(0, 1), cB + hstep, voffB); PG8_STAGE_A(PG8_SA(0, 0), cA, 0, gcur); PG8_STAGE_A(PG8_SA(0, 1), cA, 1, gcur);
    if (wr == 1) PG8_BAR;
    PG8_WAIT_V(2); PG8_BAR;
    PG8_STAGE(PG8_SB(1, 0), cB + kstep, voffB); PG8_STAGE_A(PG8_SA(1, 0), cA + kstep, 0, gcur); PG8_STAGE(PG8_SB(1, 1), cB + hstep + kstep, voffB);
    PG8_WAIT_V(6); PG8_BAR;
    for (;;) {
        const bool has_next = S.next(ui + 1, nxt);
        if constexpr (GATHER) { if (has_next) { PG8_GLOAD(gnxt, nxt); } else {
#pragma unroll
            for (int _h = 0; _h < 2; ++_h)
#pragma unroll
                for (int _i = 0; _i < 2; ++_i) gnxt[_h][_i] = gcur[_h][_i]; } }
        const char* nA = GATHER ? cA : (has_next ? (const char*)g.A + (size_t)nxt.pm * tstep : cA);
        const char* nB = has_next ? (const char*)g.Bt + ((size_t)nxt.e * g.bstride) * 2 + (size_t)nxt.pn * tstep : cB;
        for (int t = 0; t < nt; t += 2) {
            const bool last = (t == nt - 2);
            const char* a1 = cA + (size_t)(t + 1) * kstep;
            const char* a2 = last ? nA : cA + (size_t)(t + 2) * kstep; const char* b2 = last ? nB : cB + (size_t)(t + 2) * kstep;
            const char* a3 = a2 + kstep; const char* b3 = b2 + kstep;
            if constexpr (GATHER) {
#pragma unroll
                for (int _h = 0; _h < 2; ++_h)
#pragma unroll
                    for (int _i = 0; _i < 2; ++_i) g2[_h][_i] = last ? gnxt[_h][_i] : gcur[_h][_i]; }
            PG8_LDB(B0, 0, 0); PG8_LDB(B1, 0, 1); PG8_SCHED; PG8_LDA(At, 0, 0); PG8_STAGE_A(PG8_SA(1, 1), a1, 1, gcur);
            PG8_WAIT_V(8); PG8_WAIT_L(0); PG8_BAR; PG8_MMA(0, 0, At, B0); PG8_MMA(0, 1, At, B1); PG8_BAR; PG8_SCHED;
            PG8_LDA(At, 0, 1); PG8_STAGE(PG8_SB(0, 0), b2, voffB); PG8_STAGE(PG8_SB(0, 1), b2 + hstep, voffB); PG8_STAGE_A(PG8_SA(0, 0), a2, 0, g2);
            PG8_WAIT_V(8); PG8_WAIT_L(0); PG8_BAR; PG8_MMA(1, 0, At, B0); PG8_MMA(1, 1, At, B1); PG8_BAR; PG8_SCHED;
            PG8_LDB(B0, 1, 0); PG8_LDB(B1, 1, 1); PG8_SCHED; PG8_LDA(At, 1, 0); PG8_STAGE_A(PG8_SA(0, 1), a2, 1, g2);
            PG8_WAIT_V(8); PG8_WAIT_L(0); PG8_BAR; PG8_MMA(0, 0, At, B0); PG8_MMA(0, 1, At, B1); PG8_BAR; PG8_SCHED;
            PG8_LDA(At, 1, 1); PG8_STAGE(PG8_SB(1, 0), b3, voffB); PG8_STAGE(PG8_SB(1, 1), b3 + hstep, voffB); PG8_STAGE_A(PG8_SA(1, 0), a3, 0, g2);
            PG8_WAIT_V(8); PG8_WAIT_L(0); PG8_BAR; PG8_MMA(1, 0, At, B0); PG8_MMA(1, 1, At, B1); PG8_BAR; PG8_SCHED;
        }
        if constexpr (ALIGN_EPI) { if (wr == 0) PG8_BAR; }
        E(acc, cur, wr, wc, fr, fq);
        if (!has_next) break;
#pragma unroll
        for (int a = 0; a < 2; ++a)
#pragma unroll
            for (int b = 0; b < 2; ++b)
#pragma unroll
                for (int m = 0; m < 4; ++m)
#pragma unroll
                    for (int n = 0; n < 2; ++n) acc[a][b][m][n] = (f32x4){0.f, 0.f, 0.f, 0.f};
        cur = nxt; cA = nA; cB = nB; ++ui;
        if constexpr (GATHER) {
#pragma unroll
            for (int _h = 0; _h < 2; ++_h)
#pragma unroll
                for (int _i = 0; _i < 2; ++_i) gcur[_h][_i] = gnxt[_h][_i]; }
        if constexpr (ALIGN_EPI) { if (wr == 1) PG8_BAR; }
    }
    PG8_WAIT_V(0);
    if constexpr (!ALIGN_EPI) { if (wr == 0) PG8_BAR; }
    PG8_BAR;
#undef PG8_SA
#undef PG8_SB
#undef PG8_STAGE
#undef PG8_STAGE_A
#undef PG8_LDA
#undef PG8_LDB
#undef PG8_MMA
#undef PG8_WAIT_V
#undef PG8_WAIT_L
#undef PG8_BAR
#undef PG8_SCHED
#undef PG8_GLOAD
}
}
typedef unsigned short bf16;
typedef unsigned v4u __attribute__((ext_vector_type(4)));
typedef unsigned v2u __attribute__((ext_vector_type(2)));
typedef float f32x4 __attribute__((ext_vector_type(4)));
constexpr int NTHREADS = 512, NWAVES = 8;
constexpr int LDS_BYTES = 147456;
constexpr int MISC_OFF = 131072 + 320;
constexpr size_t MiB = 1u << 20;
constexpr size_t CTL_BYTES = 1 * MiB;
constexpr int T_ = nv::T_, S_ = nv::S_, NCH = nv::NCH;
constexpr int EINP = 3328, OINP = 2304;
#define LDS_WAIT() asm volatile("s_waitcnt lgkmcnt(0)" ::: "memory")
__device__ __forceinline__ unsigned f2bf(float f) { unsigned u = __builtin_bit_cast(unsigned, f); return (u + 0x7fffu + ((u >> 16) & 1u)) >> 16; }
__device__ __forceinline__ unsigned pk2(float lo, float hi) { return f2bf(lo) | (f2bf(hi) << 16); }
__device__ __forceinline__ float bf2f(unsigned short b) { return __builtin_bit_cast(float, (unsigned)b << 16); }
__device__ __forceinline__ void tr_item(const float* W, long ldw, int nvalid, bf16* dst, long ldd, LAS float* scr, int lane) {
#pragma unroll 8
    for (int i = 0; i < 32; ++i) { const int kk = 2 * i + (lane >> 5), nn = lane & 31; scr[kk * 33 + nn] = nn < nvalid ? W[(long)kk * ldw + nn] : 0.f; }
    LDS_WAIT(); asm volatile("" ::: "memory");
    const int c = lane & 7;
#pragma unroll
    for (int j = 0; j < 4; ++j) { const int n = (lane >> 3) + 8 * j; const LAS float* s = scr + (8 * c) * 33 + n;
        v4u o; o.x = pk2(s[0 * 33], s[1 * 33]); o.y = pk2(s[2 * 33], s[3 * 33]); o.z = pk2(s[4 * 33], s[5 * 33]); o.w = pk2(s[6 * 33], s[7 * 33]);
        *(v4u*)(dst + (long)n * ldd + 8 * c) = o; }
    LDS_WAIT(); asm volatile("" ::: "memory");
}
__device__ __forceinline__ void tr_matrix(const float* W, int K, int N, int NP, bf16* WT, LAS float* scr, int gw, int NGW, int lane) {
    const int nblk = NP / 32, nitems = (K / 64) * nblk;
    for (int it = gw; it < nitems; it += NGW) { const int kb = it / nblk, nb = it % nblk, k0 = 64 * kb, n0 = 32 * nb; int nvalid = N - n0; nvalid = nvalid < 0 ? 0 : (nvalid > 32 ? 32 : nvalid);
        tr_item(W + (long)k0 * N + n0, N, nvalid, WT + (long)n0 * K + k0, K, scr, lane); }
}
__device__ __forceinline__ void cvt_rows(const float* src, bf16* dst, long n, long gtid, long gsz) {
    for (long i = gtid * 8; i < n; i += gsz * 8) { const f32x4 a = *(const f32x4*)(src + i), b = *(const f32x4*)(src + i + 4);
        v4u o; o.x = pk2(a.x, a.y); o.y = pk2(a.z, a.w); o.z = pk2(b.x, b.y); o.w = pk2(b.z, b.w); *(v4u*)(dst + i) = o; }
}
__device__ __forceinline__ int sopaque(int v) { asm volatile("" : "+s"(v)); return v; }
constexpr int CTX_OFF = 131072 + 1024;
constexpr size_t WS_WINE = 1 * MiB, WS_WINO = WS_WINE + (size_t)EINP * 1024 * 2, WS_WOUT = WS_WINO + (size_t)OINP * 1024 * 2, WS_XBF = 16 * MiB, WS_MIXBF = 48 * MiB, WS_NAIVE = 80 * MiB;
static_assert(WS_WOUT + 2 * 1024 * 1024 * 2 <= WS_XBF, "ws map");
struct DevRunner {
    XcdBarrier bar;
    template <int ST> __device__ __forceinline__ void run(const nv::Ctx& c, long n) {
        int i0 = blockIdx.x * NTHREADS + threadIdx.x; asm volatile("" : "+v"(i0));
        for (long i = i0; i < n; i += (long)gridDim.x * NTHREADS) nv::item<ST>(c, i);
        xcd_barrier(bar);
    }
};
struct Args { const float* in[38]; float* out; unsigned char* ws; };
__global__ void __launch_bounds__(NTHREADS, 2) mega_fwd(Args a) {
    extern __shared__ __attribute__((aligned(16))) unsigned char lds_raw[];
    LAS unsigned char* lds = (LAS unsigned char*)lds_raw;
    for (int u = threadIdx.x; u < (LDS_BYTES - 131072) / 4; u += NTHREADS) ((LAS unsigned*)(lds + 131072))[u] = 0u;
    __syncthreads();
    DevRunner R;
    R.bar = xcd_barrier_post((unsigned*)a.ws + 4096, (volatile LAS unsigned*)(lds + MISC_OFF) + 8);
    const int tid = threadIdx.x, lane = tid & 63, wave = __builtin_amdgcn_readfirstlane(tid >> 6);
    const int G = gridDim.x, gw = blockIdx.x * NWAVES + wave, NGW = G * NWAVES;
    const long gtid = (long)blockIdx.x * NTHREADS + tid, gsz = (long)G * NTHREADS;
    unsigned char* ws = a.ws;
    bf16* WinE = (bf16*)(ws + WS_WINE); bf16* WinO = (bf16*)(ws + WS_WINO); bf16* Wout = (bf16*)(ws + WS_WOUT);
    bf16* XBF = (bf16*)(ws + WS_XBF); bf16* MIXBF = (bf16*)(ws + WS_MIXBF);
    float* d_out = a.out;
    {
        LAS float* scr = (LAS float*)(lds + wave * 16384);
        tr_matrix(a.in[6], 1024, nv::EIN, EINP, WinE, scr, gw, NGW, lane);
        tr_matrix(a.in[16], 1024, nv::OIN, OINP, WinO, scr, gw, NGW, lane);
        tr_matrix(a.in[5], 1024, 1024, 1024, Wout, scr, gw, NGW, lane);
        tr_matrix(a.in[5] + 1024 * 1024, 1024, 1024, 1024, Wout + 1024 * 1024, scr, gw, NGW, lane);
        cvt_rows(a.in[0], XBF, (long)T_ * 1024, gtid, gsz);
        xcd_barrier(R.bar);
    }
    nv::Ctx* const ctab = (nv::Ctx*)(lds_raw + CTX_OFF);
    const size_t scratch0 = (size_t)T_ * 1024 + (size_t)T_ * 64 + (size_t)T_ * 8 * 2;
    if (tid == 0) {
        for (int layer = 0; layer < 2; ++layer) {
            nv::Ctx& c = ctab[layer * 2];
            nv::Mem M{(float*)(ws + WS_NAIVE), 0};
            for (int i = 0; i < 38; ++i) c.in[i] = a.in[i];
            c.mixed = M.get((size_t)T_ * 1024); c.scores = M.get((size_t)T_ * 64);
            c.ridx = (int*)M.get((size_t)T_ * 8); c.rwt = M.get((size_t)T_ * 8);
            c.gR = nullptr; c.gBias = nullptr; c.slab = 0;
            c.layer = layer;
            c.hcur = layer == 0 ? a.in[0] : d_out;
            if (layer == 0) {
                c.ldp = EINP; c.proj = M.get((size_t)T_ * c.ldp);
                c.mb = M.get(8 * S_); c.mig = M.get(8 * S_); c.mblast = M.get(8 * NCH); c.mmloc = M.get(8 * NCH); c.mmprev = M.get(8 * NCH);
                c.mmi = M.get(8 * S_); c.mwin = M.get(8 * S_); c.mden = M.get(8 * S_); c.nloc = M.get(8 * NCH * 128);
                const size_t ov = M.off;
                c.cloc = M.get((size_t)8 * NCH * 16384); c.smat = M.get((size_t)8 * NCH * 4096); c.htil = M.get((size_t)T_ * 512);
                M.off = ov; c.lxc = M.get((size_t)T_ * 512); c.la = M.get((size_t)T_ * 512); c.lu = M.get((size_t)T_ * 512);
            } else {
                c.ldp = OINP; c.proj = M.get((size_t)T_ * c.ldp);
                c.s5ab = M.get(2048 * 2); c.s5bbr = M.get(2048 * 16); c.s5bbi = M.get(2048 * 16); c.s5st = M.get(2 * 2048 * 2);
                c.s5x = M.get((size_t)nv::B_ * nv::SLAB * 2048 * 2); c.s5g = M.get((size_t)T_ * 512);
                c.gla_la = M.get((size_t)T_ * 256); c.gla_bc = M.get((size_t)T_ * 256); c.gla_bl = M.get((size_t)nv::B_ * NCH * 256);
                c.gu = M.get((size_t)8 * NCH * 8192); c.gatt = M.get((size_t)8 * NCH * 4096); c.go = M.get((size_t)T_ * 512);
            }
            c.z = c.proj; c.hout = d_out; c.lnw = a.in[1] + layer * 1024; c.lnb = a.in[2] + layer * 1024;
            M.off = scratch0; c.hid = M.get((size_t)T_ * 9 * 256);
            nv::Ctx& cm = ctab[layer * 2 + 1];
            cm = c; cm.hcur = d_out; cm.z = c.mixed; cm.lnw = a.in[3] + layer * 1024; cm.lnb = a.in[4] + layer * 1024;
        }
    }
    __syncthreads();
#pragma unroll 1
    for (int layer = 0; layer < 2; ++layer) {
        nv::Ctx& c = ctab[layer * 2];
        float* const proj = (float*)(ws + WS_NAIVE) + scratch0;
        const float* const hcur = layer == 0 ? a.in[0] : d_out;
        if (layer == 0) {
            { pg8::Gemm g{XBF, WinE, 1024, 0, 0, nullptr}; pg8::StaticOrder S; S.init(T_, EINP, sopaque(G), sopaque((int)blockIdx.x));
              pg8::EpiF32R E{proj, EINP, nullptr, 0.f};
              pg8::gemm_phase<pg8::EpiF32R, pg8::StaticOrder, true, false>(lds, g, S, E); xcd_barrier(R.bar); }
            R.run<nv::ST_ML_GATES>(c, 8L * NCH);
            R.run<nv::ST_ML_CLOC>(c, 8L * NCH * 16384);
            R.run<nv::ST_ML_SCAN>(c, 8L * 16384 + 8 * 128);
            R.run<nv::ST_ML_MI>(c, 8L * S_);
            R.run<nv::ST_ML_SMAT>(c, 8L * NCH * 4096);
            R.run<nv::ST_ML_DEN>(c, 8L * S_);
            R.run<nv::ST_ML_H>(c, 8L * S_ * 128);
            R.run<nv::ST_ML_NORM>(c, 8L * S_);
            R.run<nv::ST_LRU_CONV>(c, (long)T_ * 512);
            R.run<nv::ST_LRU_GATE>(c, (long)T_ * 512);
            R.run<nv::ST_LRU_SCAN>(c, 2L * 512);
        } else {
            { pg8::Gemm g{XBF, WinO, 1024, 0, 0, nullptr}; pg8::StaticOrder S; S.init(T_, OINP, sopaque(G), sopaque((int)blockIdx.x));
              pg8::EpiF32R E{proj, OINP, nullptr, 0.f};
              pg8::gemm_phase<pg8::EpiF32R, pg8::StaticOrder, true, false>(lds, g, S, E); xcd_barrier(R.bar); }
            R.run<nv::ST_S5_PAR>(c, 2048);
            for (int sl = 0; sl < S_ / nv::SLAB; ++sl) { if (tid == 0) c.slab = sl; __syncthreads(); R.run<nv::ST_S5_SCAN>(c, 2L * 2048); R.run<nv::ST_S5_OUT>(c, (long)nv::B_ * nv::SLAB * 512); }
            R.run<nv::ST_S5_GLU>(c, (long)T_ * 512);
            R.run<nv::ST_GLA_GATE>(c, (long)T_ * 256);
            R.run<nv::ST_GLA_CUM>(c, (long)nv::B_ * NCH * 256);
            R.run<nv::ST_GLA_U>(c, 8L * NCH * 8192);
            R.run<nv::ST_GLA_SCAN>(c, 8L * 8192);
            R.run<nv::ST_GLA_ATT>(c, 8L * NCH * 4096);
            R.run<nv::ST_GLA_O>(c, 8L * S_ * 128);
            R.run<nv::ST_GLA_NORM>(c, 8L * S_);
        }
        { int g0 = (int)gtid; asm volatile("" : "+v"(g0)); cvt_rows((const float*)(ws + WS_NAIVE), MIXBF, (long)T_ * 1024, g0, gsz); } xcd_barrier(R.bar);
        { pg8::Gemm g{MIXBF, Wout + (size_t)layer * 1024 * 1024, 1024, 0, 0, nullptr}; pg8::StaticOrder S; S.init(T_, 1024, sopaque(G), sopaque((int)blockIdx.x));
          pg8::EpiF32R E{proj, 1024, hcur, nv::ALPHA};
          pg8::gemm_phase<pg8::EpiF32R, pg8::StaticOrder, true, false>(lds, g, S, E); xcd_barrier(R.bar); }
        R.run<nv::ST_LN>(c, T_);
        { nv::Ctx& cm = ctab[layer * 2 + 1];
        R.run<nv::ST_SCORES>(cm, (long)T_ * 64);
        R.run<nv::ST_SELECT>(cm, T_);
        R.run<nv::ST_HID>(cm, (long)T_ * 9 * 256);
        R.run<nv::ST_FFN>(cm, (long)T_ * 1024);
        R.run<nv::ST_LN>(cm, T_); }
        if (layer == 0) { int g0 = (int)gtid; asm volatile("" : "+v"(g0)); cvt_rows(d_out, XBF, (long)T_ * 1024, g0, gsz); xcd_barrier(R.bar); }
    }
}
extern "C" void kernel_launch(void* const* d_in, const int* in_sizes, int n_in, void* d_out, int out_size, void* d_ws, size_t ws_size, hipStream_t stream) {
    static int grid = 0;
    if (grid == 0) {
        int dev = 0, cus = 0, per_cu = 0;
        hipGetDevice(&dev); hipDeviceGetAttribute(&cus, hipDeviceAttributeMultiprocessorCount, dev);
        hipFuncSetAttribute((const void*)mega_fwd, hipFuncAttributeMaxDynamicSharedMemorySize, LDS_BYTES);
        hipOccupancyMaxActiveBlocksPerMultiprocessor(&per_cu, (const void*)mega_fwd, NTHREADS, LDS_BYTES);
        (void)hipGetLastError();
        grid = (per_cu >= 1) ? cus : -1;
    }
    if (grid < 0) return;
    hipMemsetAsync(d_ws, 0, CTL_BYTES, stream);
    Args a{};
    for (int i = 0; i < 38; ++i) a.in[i] = (const float*)d_in[i];
    a.out = (float*)d_out; a.ws = (unsigned char*)d_ws;
    hipLaunchKernelGGL(mega_fwd, dim3(grid), dim3(NTHREADS), LDS_BYTES, stream, a);
}
```

```cpp
#include <hip/hip_runtime.h>
#ifdef CPU_TEST
#include <cmath>
#include <cstddef>
#define HD inline
#define HDF inline
#else
#define HD __device__ __forceinline__
#define HDF __host__ __device__ __forceinline__
#endif

#ifndef SEQ_
#define SEQ_ 8192
#endif
namespace nv {
constexpr int B_ = 2, S_ = SEQ_, T_ = B_ * S_, D_ = 1024, NCH = S_ / 64;
constexpr int EIN = 3080, OIN = 2064;
constexpr int SLAB = (S_ < 1024 ? S_ : 1024);
constexpr float ALPHA = 1.41421356237309515f, EPS = 1e-5f;

enum Stage { ST_GEMM, ST_ML_GATES, ST_ML_CLOC, ST_ML_SCAN, ST_ML_MI, ST_ML_SMAT, ST_ML_DEN, ST_ML_H, ST_ML_NORM,
             ST_LRU_CONV, ST_LRU_GATE, ST_LRU_SCAN, ST_LN, ST_SCORES, ST_SELECT, ST_HID, ST_FFN,
             ST_S5_PAR, ST_S5_SCAN, ST_S5_OUT, ST_S5_GLU, ST_GLA_GATE, ST_GLA_CUM, ST_GLA_U, ST_GLA_SCAN, ST_GLA_ATT, ST_GLA_O, ST_GLA_NORM };

struct Ctx {
    const float* in[38];
    const float* gA; const float* gW; const float* gR; float* gC; const float* gBias;
    const float* hcur;
    float* hout;
    const float* lnw; const float* lnb;
    float* proj; float* mixed; float* z;
    float* mb; float* mig; float* mblast; float* mmloc; float* mmprev; float* cloc; float* nloc; float* smat; float* mmi; float* mwin; float* mden; float* htil;
    float* lxc; float* la; float* lu;
    float* scores; int* ridx; float* rwt; float* hid;
    float* s5ab; float* s5bbr; float* s5bbi; float* s5st; float* s5x; float* s5g;
    float* gla_la; float* gla_bc; float* gla_bl; float* gu; float* gatt; float* go;
    long gM, gN, gK, glda, gldw, gldc, gldr;
    long ldp;
    float gralpha; int layer; int slab; int pad0;
};

HD float sigm(float x) { return 1.0f / (1.0f + expf(-x)); }
HD float logsig(float x) { return fminf(x, 0.f) - log1pf(expf(-fabsf(x))); }
HD float softplus(float x) { return fmaxf(x, 0.f) + log1pf(expf(-fabsf(x))); }
HD float silu(float x) { return x * sigm(x); }
HD float gelu_t(float x) { return 0.5f * x * (1.0f + tanhf(0.7978845608028654f * (x + 0.044715f * x * x * x))); }

template <int ST> HD void item(const Ctx& c, long idx);

template <> HD void item<ST_GEMM>(const Ctx& c, long idx) {
    const long m = idx / c.gN, n = idx % c.gN;
    float acc = 0.f;
    const float* a = c.gA + m * c.glda; const float* w = c.gW + n;
    for (long k = 0; k < c.gK; ++k) acc += a[k] * w[k * c.gldw];
    if (c.gBias) acc += c.gBias[n];
    if (c.gR) acc += c.gralpha * c.gR[m * c.gldr + n];
    c.gC[m * c.gldc + n] = acc;
}
template <> HD void item<ST_ML_GATES>(const Ctx& c, long idx) {
    const int bh = (int)(idx / NCH), n = (int)(idx % NCH), b = bh / 4, h = bh % 4;
    const float* gb = c.in[7];
    const long t0 = (long)b * S_ + n * 64; const long o0 = (long)bh * S_ + n * 64;
    float acc = 0.f;
    for (int l = 0; l < 64; ++l) {
        const float f = c.proj[(t0 + l) * c.ldp + 2052 + h] + gb[4 + h];
        acc += logsig(f);
        c.mb[o0 + l] = acc;
        c.mig[o0 + l] = c.proj[(t0 + l) * c.ldp + 2048 + h] + gb[h];
    }
    c.mblast[idx] = acc;
    float ml = -INFINITY;
    for (int l = 0; l < 64; ++l) ml = fmaxf(ml, acc - c.mb[o0 + l] + c.mig[o0 + l]);
    c.mmloc[idx] = ml;
}
template <> HD void item<ST_ML_CLOC>(const Ctx& c, long idx) {
    const int e = (int)(idx % 128), d = (int)((idx / 128) % 128); const long cn = idx / 16384;
    const int bh = (int)(cn / NCH), n = (int)(cn % NCH), b = bh / 4, h = bh % 4;
    const long t0 = (long)b * S_ + n * 64; const long o0 = (long)bh * S_ + n * 64;
    const float bl = c.mblast[cn], ml = c.mmloc[cn]; const float sc = 0.08838834764831845f;
    float acc = 0.f, accn = 0.f;
    for (int l = 0; l < 64; ++l) {
        const float p = expf(bl - c.mb[o0 + l] + c.mig[o0 + l] - ml);
        const float kk = c.proj[(t0 + l) * c.ldp + 512 + h * 128 + d] * sc;
        acc += p * kk * c.proj[(t0 + l) * c.ldp + 1024 + h * 128 + e];
        accn += p * kk;
    }
    c.cloc[idx] = acc;
    if (e == 0) c.nloc[cn * 128 + d] = accn;
}
template <> HD void item<ST_ML_SCAN>(const Ctx& c, long idx) {
    const bool isn = idx >= 8L * 16384;
    long bh, de; float* buf; long stride;
    if (!isn) { bh = idx / 16384; de = idx % 16384; buf = c.cloc; stride = 16384; }
    else { const long r = idx - 8L * 16384; bh = r / 128; de = r % 128; buf = c.nloc; stride = 128; }
    float st = 0.f, m = 0.f;
    for (int n = 0; n < NCH; ++n) {
        const long cn = bh * NCH + n;
        const float cl = buf[cn * stride + de]; buf[cn * stride + de] = st;
        const float bl = c.mblast[cn], ml = c.mmloc[cn];
        const float mn = fmaxf(bl + m, ml);
        st = expf(bl + m - mn) * st + expf(ml - mn) * cl;
        if (!isn && de == 0) c.mmprev[cn] = m;
        m = mn;
    }
}
template <> HD void item<ST_ML_MI>(const Ctx& c, long idx) {
    const long bh = idx / S_; const int s = (int)(idx % S_), n = s / 64, i = s % 64; const long cn = bh * NCH + n;
    const long o0 = bh * S_ + n * 64;
    const float bi = c.mb[idx]; const float minter = bi + c.mmprev[cn];
    float dmax = -INFINITY;
    for (int j = 0; j <= i; ++j) dmax = fmaxf(dmax, bi - c.mb[o0 + j] + c.mig[o0 + j]);
    const float mi = fmaxf(minter, dmax);
    c.mmi[idx] = mi; c.mwin[idx] = expf(minter - mi);
}
template <> HD void item<ST_ML_SMAT>(const Ctx& c, long idx) {
    const int j = (int)(idx % 64), i = (int)((idx / 64) % 64); const long cn = idx / 4096;
    const int bh = (int)(cn / NCH), n = (int)(cn % NCH), b = bh / 4, h = bh % 4;
    if (j > i) { c.smat[idx] = 0.f; return; }
    const long t0 = (long)b * S_ + n * 64; const long o0 = (long)bh * S_ + n * 64;
    const float* q = c.proj + (t0 + i) * c.ldp + h * 128; const float* k = c.proj + (t0 + j) * c.ldp + 512 + h * 128;
    float dot = 0.f;
    for (int d = 0; d < 128; ++d) dot += q[d] * k[d];
    dot *= 0.08838834764831845f;
    c.smat[idx] = dot * expf(c.mb[o0 + i] - c.mb[o0 + j] + c.mig[o0 + j] - c.mmi[o0 + i]);
}
template <> HD void item<ST_ML_DEN>(const Ctx& c, long idx) {
    const long bh = idx / S_; const int s = (int)(idx % S_), n = s / 64, i = s % 64; const long cn = bh * NCH + n;
    const int b = (int)(bh / 4), h = (int)(bh % 4);
    float den = 0.f;
    for (int j = 0; j <= i; ++j) den += c.smat[cn * 4096 + i * 64 + j];
    const float* q = c.proj + ((long)b * S_ + s) * c.ldp + h * 128;
    float qn = 0.f;
    for (int d = 0; d < 128; ++d) qn += q[d] * c.nloc[cn * 128 + d];
    den += c.mwin[idx] * qn;
    c.mden[idx] = fmaxf(fabsf(den), expf(-c.mmi[idx]));
}
template <> HD void item<ST_ML_H>(const Ctx& c, long idx) {
    const int e = (int)(idx % 128); const long bs = idx / 128; const long bh = bs / S_; const int s = (int)(bs % S_), n = s / 64, i = s % 64;
    const long cn = bh * NCH + n; const int b = (int)(bh / 4), h = (int)(bh % 4);
    const long t0 = (long)b * S_ + n * 64;
    float num = 0.f;
    for (int j = 0; j <= i; ++j) num += c.smat[cn * 4096 + i * 64 + j] * c.proj[(t0 + j) * c.ldp + 1024 + h * 128 + e];
    const float* q = c.proj + (t0 + i) * c.ldp + h * 128;
    float qc = 0.f;
    for (int d = 0; d < 128; ++d) qc += q[d] * c.cloc[cn * 16384 + d * 128 + e];
    num += c.mwin[bs] * qc;
    c.htil[(t0 + i) * 512 + h * 128 + e] = num / c.mden[bs];
}
template <> HD void item<ST_ML_NORM>(const Ctx& c, long idx) {
    const long bh = idx / S_; const int s = (int)(idx % S_); const int b = (int)(bh / 4), h = (int)(bh % 4);
    const long t = (long)b * S_ + s;
    const float* ht = c.htil + t * 512 + h * 128; const float* nw = c.in[8];
    float mean = 0.f;
    for (int e = 0; e < 128; ++e) mean += ht[e];
    mean *= (1.f / 128.f);
    float var = 0.f;
    for (int e = 0; e < 128; ++e) { const float d = ht[e] - mean; var += d * d; }
    const float rstd = 1.0f / sqrtf(var * (1.f / 128.f) + EPS);
    for (int e = 0; e < 128; ++e)
        c.mixed[t * 1024 + h * 128 + e] = (ht[e] - mean) * rstd * nw[h * 128 + e] * sigm(c.proj[t * c.ldp + 1536 + h * 128 + e]);
}
template <> HD void item<ST_LRU_CONV>(const Ctx& c, long idx) {
    const long t = idx / 512; const int ch = (int)(idx % 512); const int s = (int)(t % S_);
    const float* cw = c.in[9];
    float acc = c.in[10][ch];
    for (int j = 0; j < 4; ++j) { const int ss = s - 3 + j; if (ss >= 0) acc += cw[j * 512 + ch] * c.proj[(t - 3 + j) * c.ldp + 2056 + ch]; }
    c.lxc[idx] = acc;
}
template <> HD void item<ST_LRU_GATE>(const Ctx& c, long idx) {
    const long t = idx / 512; const int ch = (int)(idx % 512), hh = ch / 128, jj = ch % 128;
    const float* wa = c.in[11] + (long)hh * 16384; const float* wx = c.in[13] + (long)hh * 16384;
    const float* xr = c.lxc + t * 512 + hh * 128;
    float ra = c.in[12][ch], xa = c.in[14][ch];
    for (int i = 0; i < 128; ++i) { ra += xr[i] * wa[i * 128 + jj]; xa += xr[i] * wx[i * 128 + jj]; }
    const float r = sigm(ra), ii = sigm(xa);
    const float la = -8.0f * r * softplus(-c.in[15][ch]);
    c.la[idx] = expf(la);
    c.lu[idx] = sqrtf(-expm1f(2.0f * la)) * ii * c.lxc[idx];
}
template <> HD void item<ST_LRU_SCAN>(const Ctx& c, long idx) {
    const int b = (int)(idx / 512), ch = (int)(idx % 512);
    float h = 0.f;
    for (int s = 0; s < S_; ++s) {
        const long t = (long)b * S_ + s;
        h = c.la[t * 512 + ch] * h + c.lu[t * 512 + ch];
        c.mixed[t * 1024 + 512 + ch] = h * gelu_t(c.proj[t * c.ldp + 2568 + ch]);
    }
}
template <> HD void item<ST_LN>(const Ctx& c, long t) {
    const float* zr = c.z + t * 1024;
    float mean = 0.f;
    for (int i = 0; i < 1024; ++i) mean += zr[i];
    mean *= (1.f / 1024.f);
    float var = 0.f;
    for (int i = 0; i < 1024; ++i) { const float d = zr[i] - mean; var += d * d; }
    const float rstd = 1.0f / sqrtf(var * (1.f / 1024.f) + EPS);
    for (int i = 0; i < 1024; ++i) c.hout[t * 1024 + i] = (zr[i] - mean) * rstd * c.lnw[i] + c.lnb[i];
}
template <> HD void item<ST_SCORES>(const Ctx& c, long idx) {
    const long t = idx / 64; const int e = (int)(idx % 64);
    const float* rw = c.in[30] + (long)c.layer * 1024 * 64; const float* hr = c.hcur + t * 1024;
    float acc = 0.f;
    for (int k = 0; k < 1024; ++k) acc += hr[k] * rw[k * 64 + e];
    c.scores[idx] = sigm(acc);
}
template <> HD void item<ST_SELECT>(const Ctx& c, long t) {
    const float* sc = c.scores + t * 64; const float* bias = c.in[31] + c.layer * 64;
    float gs[8];
#pragma unroll
    for (int g = 0; g < 8; ++g) {
        float m1 = -INFINITY, m2 = -INFINITY;
        for (int j = 0; j < 8; ++j) { const float v = sc[g * 8 + j] + bias[g * 8 + j]; if (v > m1) { m2 = m1; m1 = v; } else if (v > m2) m2 = v; }
        gs[g] = m1 + m2;
    }
    unsigned gsel = 0;
    for (int it = 0; it < 4; ++it) {
        float best = -INFINITY; int bi = 0;
#pragma unroll
        for (int g = 0; g < 8; ++g) { const bool ok = !((gsel >> g) & 1u) && gs[g] > best; best = ok ? gs[g] : best; bi = ok ? g : bi; }
        gsel |= 1u << bi;
    }
    unsigned long long taken = 0ull; float wsum = 0.f;
    for (int it = 0; it < 8; ++it) {
        float best = -INFINITY; int bi = 0;
        for (int e = 0; e < 64; ++e) {
            if (!((gsel >> (e >> 3)) & 1u) || ((taken >> e) & 1ull)) continue;
            const float v = sc[e] + bias[e];
            if (v > best) { best = v; bi = e; }
        }
        taken |= 1ull << bi;
        c.ridx[t * 8 + it] = bi; const float w = sc[bi]; c.rwt[t * 8 + it] = w; wsum += w;
    }
    const float inv = 2.5f / wsum;
    for (int it = 0; it < 8; ++it) c.rwt[t * 8 + it] *= inv;
}
template <> HD void item<ST_HID>(const Ctx& c, long idx) {
    const int j = (int)(idx % 256), k = (int)((idx / 256) % 9); const long t = idx / 2304;
    const float *wg, *wu;
    if (k < 8) { const long e = (long)c.layer * 64 + c.ridx[t * 8 + k]; wg = c.in[32] + e * 262144; wu = c.in[33] + e * 262144; }
    else { wg = c.in[35] + (long)c.layer * 262144; wu = c.in[36] + (long)c.layer * 262144; }
    const float* hr = c.hcur + t * 1024;
    float g = 0.f, u = 0.f;
    for (int d = 0; d < 1024; ++d) { const float x = hr[d]; g += x * wg[d * 256 + j]; u += x * wu[d * 256 + j]; }
    c.hid[idx] = silu(g) * u;
}
template <> HD void item<ST_FFN>(const Ctx& c, long idx) {
    const long t = idx / 1024; const int n = (int)(idx % 1024);
    float tot = 0.f;
    for (int k = 0; k < 9; ++k) {
        const float* wd; float w;
        if (k < 8) { const long e = (long)c.layer * 64 + c.ridx[t * 8 + k]; wd = c.in[34] + e * 262144; w = c.rwt[t * 8 + k]; }
        else { wd = c.in[37] + (long)c.layer * 262144; w = 1.f; }
        const float* hr = c.hid + (t * 9 + k) * 256;
        float acc = 0.f;
        for (int j = 0; j < 256; ++j) acc += hr[j] * wd[j * 1024 + n];
        tot += w * acc;
    }
    c.z[idx] = ALPHA * c.hcur[idx] + tot;
}
template <> HD void item<ST_S5_PAR>(const Ctx& c, long idx) {
    const int g = (int)(idx / 64);
    const float lr = c.in[17][idx], li = c.in[18][idx]; const float dt = expf(c.in[24][g]);
    const float mag = expf(lr * dt); const float ar = mag * cosf(li * dt), ai = mag * sinf(li * dt);
    const float den = lr * lr + li * li, nr = ar - 1.0f;
    const float cr = (nr * lr + ai * li) / den, ci = (ai * lr - nr * li) / den;
    c.s5ab[idx * 2] = ar; c.s5ab[idx * 2 + 1] = ai;
    for (int h = 0; h < 16; ++h) {
        const float br = c.in[19][idx * 16 + h], bi = c.in[20][idx * 16 + h];
        c.s5bbr[idx * 16 + h] = cr * br - ci * bi; c.s5bbi[idx * 16 + h] = cr * bi + ci * br;
    }
}
template <> HD void item<ST_S5_SCAN>(const Ctx& c, long idx) {
    const int gp = (int)(idx % 2048), g = gp / 64, b = (int)(idx / 2048);
    const float ar = c.s5ab[gp * 2], ai = c.s5ab[gp * 2 + 1];
    float xr = 0.f, xi = 0.f;
    if (c.slab > 0) { xr = c.s5st[idx * 2]; xi = c.s5st[idx * 2 + 1]; }
    for (int sl = 0; sl < SLAB; ++sl) {
        const long t = (long)b * S_ + (long)c.slab * SLAB + sl;
        const float* u = c.proj + t * c.ldp + g * 16;
        float br = 0.f, bi = 0.f;
        for (int h = 0; h < 16; ++h) { br += u[h] * c.s5bbr[gp * 16 + h]; bi += u[h] * c.s5bbi[gp * 16 + h]; }
        const float nr = ar * xr - ai * xi + br, ni = ar * xi + ai * xr + bi;
        xr = nr; xi = ni;
        const long o = (((long)b * SLAB + sl) * 2048 + gp) * 2;
        c.s5x[o] = xr; c.s5x[o + 1] = xi;
    }
    c.s5st[idx * 2] = xr; c.s5st[idx * 2 + 1] = xi;
}
template <> HD void item<ST_S5_OUT>(const Ctx& c, long idx) {
    const int ch = (int)(idx % 512), g = ch / 16; const long bs = idx / 512; const int b = (int)(bs / SLAB), sl = (int)(bs % SLAB);
    const long t = (long)b * S_ + (long)c.slab * SLAB + sl;
    const float* x = c.s5x + (bs * 2048 + g * 64) * 2; const float* cre = c.in[21] + ch * 64; const float* cim = c.in[22] + ch * 64;
    float y = 0.f;
    for (int p = 0; p < 64; ++p) y += x[2 * p] * cre[p] - x[2 * p + 1] * cim[p];
    y += c.in[23][ch] * c.proj[t * c.ldp + ch];
    c.s5g[t * 512 + ch] = gelu_t(y);
}
template <> HD void item<ST_S5_GLU>(const Ctx& c, long idx) {
    const long t = idx / 512; const int n = (int)(idx % 512);
    const float* gr = c.s5g + t * 512; const float* w = c.in[25];
    float acc = c.in[26][n];
    for (int k = 0; k < 512; ++k) acc += gr[k] * w[k * 512 + n];
    c.mixed[t * 1024 + n] = gr[n] * sigm(acc);
}
template <> HD void item<ST_GLA_GATE>(const Ctx& c, long idx) {
    const long t = idx / 256; const int ch = (int)(idx % 256);
    float acc = c.in[28][ch];
    for (int r = 0; r < 16; ++r) acc += c.proj[t * c.ldp + 2048 + r] * c.in[27][r * 256 + ch];
    c.gla_la[idx] = logsig(acc) * (1.0f / 16.0f);
}
template <> HD void item<ST_GLA_CUM>(const Ctx& c, long idx) {
    const int ch = (int)(idx % 256); const long bn = idx / 256; const int b = (int)(bn / NCH), n = (int)(bn % NCH);
    const long t0 = (long)b * S_ + n * 64;
    float acc = 0.f;
    for (int l = 0; l < 64; ++l) { acc += c.gla_la[(t0 + l) * 256 + ch]; c.gla_bc[(t0 + l) * 256 + ch] = acc; }
    c.gla_bl[idx] = acc;
}
template <> HD void item<ST_GLA_U>(const Ctx& c, long idx) {
    const int e = (int)(idx % 128), d = (int)((idx / 128) % 64); const long cn = idx / 8192;
    const int bh = (int)(cn / NCH), n = (int)(cn % NCH), b = bh / 4, h = bh % 4;
    const long t0 = (long)b * S_ + n * 64;
    const float bl = c.gla_bl[((long)b * NCH + n) * 256 + h * 64 + d];
    float acc = 0.f;
    for (int l = 0; l < 64; ++l)
        acc += c.proj[(t0 + l) * c.ldp + 768 + h * 64 + d] * expf(bl - c.gla_bc[(t0 + l) * 256 + h * 64 + d]) * c.proj[(t0 + l) * c.ldp + 1024 + h * 128 + e];
    c.gu[idx] = acc;
}
template <> HD void item<ST_GLA_SCAN>(const Ctx& c, long idx) {
    const long bh = idx / 8192; const int de = (int)(idx % 8192), d = de / 128; const int b = (int)(bh / 4), h = (int)(bh % 4);
    float st = 0.f;
    for (int n = 0; n < NCH; ++n) {
        const long cn = bh * NCH + n;
        const float u = c.gu[cn * 8192 + de]; c.gu[cn * 8192 + de] = st;
        st = expf(c.gla_bl[((long)b * NCH + n) * 256 + h * 64 + d]) * st + u;
    }
}
template <> HD void item<ST_GLA_ATT>(const Ctx& c, long idx) {
    const int j = (int)(idx % 64), i = (int)((idx / 64) % 64); const long cn = idx / 4096;
    const int bh = (int)(cn / NCH), n = (int)(cn % NCH), b = bh / 4, h = bh % 4;
    if (j > i) { c.gatt[idx] = 0.f; return; }
    const long ti = (long)b * S_ + n * 64 + i, tj = (long)b * S_ + n * 64 + j;
    float acc = 0.f;
    for (int d = 0; d < 64; ++d)
        acc += c.proj[ti * c.ldp + 512 + h * 64 + d] * 0.125f * expf(c.gla_bc[ti * 256 + h * 64 + d] - c.gla_bc[tj * 256 + h * 64 + d]) * c.proj[tj * c.ldp + 768 + h * 64 + d];
    c.gatt[idx] = acc;
}
template <> HD void item<ST_GLA_O>(const Ctx& c, long idx) {
    const int e = (int)(idx % 128); const long bs = idx / 128; const long bh = bs / S_; const int s = (int)(bs % S_), n = s / 64, i = s % 64;
    const long cn = bh * NCH + n; const int b = (int)(bh / 4), h = (int)(bh % 4);
    const long t0 = (long)b * S_ + n * 64, t = t0 + i;
    float acc = 0.f;
    for (int j = 0; j <= i; ++j) acc += c.gatt[cn * 4096 + i * 64 + j] * c.proj[(t0 + j) * c.ldp + 1024 + h * 128 + e];
    for (int d = 0; d < 64; ++d)
        acc += c.proj[t * c.ldp + 512 + h * 64 + d] * 0.125f * expf(c.gla_bc[t * 256 + h * 64 + d]) * c.gu[cn * 8192 + d * 128 + e];
    c.go[t * 512 + h * 128 + e] = acc;
}
template <> HD void item<ST_GLA_NORM>(const Ctx& c, long idx) {
    const long bh = idx / S_; const int s = (int)(idx % S_); const int b = (int)(bh / 4), h = (int)(bh % 4);
    const long t = (long)b * S_ + s;
    const float* o = c.go + t * 512 + h * 128;
    float ms = 0.f;
    for (int e = 0; e < 128; ++e) ms += o[e] * o[e];
    const float rstd = 1.0f / sqrtf(ms * (1.f / 128.f) + EPS);
    for (int e = 0; e < 128; ++e)
        c.mixed[t * 1024 + 512 + h * 128 + e] = o[e] * rstd * c.in[29][h * 128 + e] * silu(c.proj[t * c.ldp + 1536 + h * 128 + e]);
}

struct Mem { float* base; size_t off; HDF float* get(size_t n) { float* p = base + off; off += (n + 63) & ~(size_t)63; return p; } };

template <class Runner> HDF void forward(Runner& R, void* const* d_in, float* d_out, float* ws) {
    Ctx c{};
    for (int i = 0; i < 38; ++i) c.in[i] = (const float*)d_in[i];
    Mem M{ws, 0};
    c.z = M.get((size_t)T_ * 1024); c.mixed = M.get((size_t)T_ * 1024); c.scores = M.get((size_t)T_ * 64);
    c.ridx = (int*)M.get((size_t)T_ * 8); c.rwt = M.get((size_t)T_ * 8);
    const size_t scratch0 = M.off;
    for (int layer = 0; layer < 2; ++layer) {
        c.layer = layer;
        c.hcur = layer == 0 ? c.in[0] : d_out;
        M.off = scratch0;
        if (layer == 0) {
            c.ldp = EIN; c.proj = M.get((size_t)T_ * c.ldp);
            c.mb = M.get(8 * S_); c.mig = M.get(8 * S_); c.mblast = M.get(8 * NCH); c.mmloc = M.get(8 * NCH); c.mmprev = M.get(8 * NCH);
            c.mmi = M.get(8 * S_); c.mwin = M.get(8 * S_); c.mden = M.get(8 * S_); c.nloc = M.get(8 * NCH * 128);
            const size_t ov = M.off;
            c.cloc = M.get((size_t)8 * NCH * 16384); c.smat = M.get((size_t)8 * NCH * 4096); c.htil = M.get((size_t)T_ * 512);
            M.off = ov; c.lxc = M.get((size_t)T_ * 512); c.la = M.get((size_t)T_ * 512); c.lu = M.get((size_t)T_ * 512);
            c.gA = c.hcur; c.glda = 1024; c.gW = c.in[6]; c.gldw = EIN; c.gC = c.proj; c.gldc = EIN; c.gR = nullptr; c.gBias = nullptr; c.gM = T_; c.gN = EIN; c.gK = 1024;
            R.template run<ST_GEMM>(c, (long)T_ * c.ldp);
            R.template run<ST_ML_GATES>(c, 8L * NCH);
            R.template run<ST_ML_CLOC>(c, 8L * NCH * 16384);
            R.template run<ST_ML_SCAN>(c, 8L * 16384 + 8 * 128);
            R.template run<ST_ML_MI>(c, 8L * S_);
            R.template run<ST_ML_SMAT>(c, 8L * NCH * 4096);
            R.template run<ST_ML_DEN>(c, 8L * S_);
            R.template run<ST_ML_H>(c, 8L * S_ * 128);
            R.template run<ST_ML_NORM>(c, 8L * S_);
            R.template run<ST_LRU_CONV>(c, (long)T_ * 512);
            R.template run<ST_LRU_GATE>(c, (long)T_ * 512);
            R.template run<ST_LRU_SCAN>(c, 2L * 512);
        } else {
            c.ldp = OIN; c.proj = M.get((size_t)T_ * c.ldp);
            c.s5ab = M.get(2048 * 2); c.s5bbr = M.get(2048 * 16); c.s5bbi = M.get(2048 * 16); c.s5st = M.get(2 * 2048 * 2);
            c.s5x = M.get((size_t)B_ * SLAB * 2048 * 2); c.s5g = M.get((size_t)T_ * 512);
            c.gla_la = M.get((size_t)T_ * 256); c.gla_bc = M.get((size_t)T_ * 256); c.gla_bl = M.get((size_t)B_ * NCH * 256);
            c.gu = M.get((size_t)8 * NCH * 8192); c.gatt = M.get((size_t)8 * NCH * 4096); c.go = M.get((size_t)T_ * 512);
            c.gA = c.hcur; c.glda = 1024; c.gW = c.in[16]; c.gldw = OIN; c.gC = c.proj; c.gldc = OIN; c.gR = nullptr; c.gBias = nullptr; c.gM = T_; c.gN = OIN; c.gK = 1024;
            R.template run<ST_GEMM>(c, (long)T_ * c.ldp);
            R.template run<ST_S5_PAR>(c, 2048);
            for (int sl = 0; sl < S_ / SLAB; ++sl) { c.slab = sl; R.template run<ST_S5_SCAN>(c, 2L * 2048); R.template run<ST_S5_OUT>(c, (long)B_ * SLAB * 512); }
            c.slab = 0;
            R.template run<ST_S5_GLU>(c, (long)T_ * 512);
            R.template run<ST_GLA_GATE>(c, (long)T_ * 256);
            R.template run<ST_GLA_CUM>(c, (long)B_ * NCH * 256);
            R.template run<ST_GLA_U>(c, 8L * NCH * 8192);
            R.template run<ST_GLA_SCAN>(c, 8L * 8192);
            R.template run<ST_GLA_ATT>(c, 8L * NCH * 4096);
            R.template run<ST_GLA_O>(c, 8L * S_ * 128);
            R.template run<ST_GLA_NORM>(c, 8L * S_);
        }
        c.gA = c.mixed; c.glda = 1024; c.gW = c.in[5] + (size_t)layer * 1024 * 1024; c.gldw = 1024; c.gC = c.z; c.gldc = 1024; c.gR = c.hcur; c.gldr = 1024; c.gralpha = ALPHA; c.gM = T_; c.gN = 1024; c.gK = 1024;
        R.template run<ST_GEMM>(c, (long)T_ * 1024);
        c.gR = nullptr;
        c.hout = d_out; c.lnw = c.in[1] + layer * 1024; c.lnb = c.in[2] + layer * 1024;
        R.template run<ST_LN>(c, T_);
        c.hcur = d_out;
        M.off = scratch0; c.hid = M.get((size_t)T_ * 9 * 256);
        R.template run<ST_SCORES>(c, (long)T_ * 64);
        R.template run<ST_SELECT>(c, T_);
        R.template run<ST_HID>(c, (long)T_ * 9 * 256);
        R.template run<ST_FFN>(c, (long)T_ * 1024);
        c.lnw = c.in[3] + layer * 1024; c.lnb = c.in[4] + layer * 1024;
        R.template run<ST_LN>(c, T_);
    }
}
}
#define GAS __attribute__((address_space(1)))
#define LAS __attribute__((address_space(3)))
#define XB_TMO      128
#define XB_XCNT(j)  (256  + 64 * (j))
#define XB_XSUB(j)  (1280 + 64 * (j))
#define XB_XGEN(j)  (2304 + 64 * (j))
#define XB_TOP      3328
#define XB_TOPGEN   3392
#define XCD_BAR_WORDS 3456
#define XB_SPIN_CAP (1u << 22)
__device__ __forceinline__ unsigned xb_ld(unsigned* p)              { return __hip_atomic_load(p, __ATOMIC_RELAXED, __HIP_MEMORY_SCOPE_AGENT); }
__device__ __forceinline__ unsigned xb_add(unsigned* p, unsigned v) { return __hip_atomic_fetch_add(p, v, __ATOMIC_RELAXED, __HIP_MEMORY_SCOPE_AGENT); }
__device__ __forceinline__ unsigned xb_xcc_id() { return (unsigned)__builtin_amdgcn_s_getreg((3 << 11) | 20) & 0xFu; }
#define XB_SPIN(cond, bar) do { unsigned _sp = 0; while (cond) { __builtin_amdgcn_s_sleep(1); \
    if ((++_sp & 255u) == 0u) { if (xb_ld(&(bar)[XB_TMO])) break; if (_sp > XB_SPIN_CAP) { atomicAdd(&(bar)[XB_TMO], 1u); break; } } } } while (0)
struct XcdBarrier { unsigned* bar; unsigned x; volatile LAS unsigned* st; };
__device__ __forceinline__ XcdBarrier xcd_barrier_post(unsigned* bar, volatile LAS unsigned* st) {
    XcdBarrier b; b.bar = bar; b.x = xb_xcc_id(); b.st = st;
    if (threadIdx.x == 0) (void)xb_add(&bar[XB_XCNT(b.x)], 1u);
    return b;
}
__device__ __forceinline__ void xcd_barrier_complete(unsigned* bar, unsigned x, unsigned& nloc, unsigned& nx) {
    const unsigned G = gridDim.x * gridDim.y * gridDim.z;
    unsigned sum, cnt, mine, sp = 0u;
    for (;;) {
        sum = 0u; cnt = 0u; mine = 0u;
#pragma unroll
        for (unsigned j = 0; j < 16; ++j) { const unsigned c = xb_ld(&bar[XB_XCNT(j)]); sum += c; cnt += (c > 0u) ? 1u : 0u; mine = (j == x) ? c : mine; }
        if (sum == G) break;
        __builtin_amdgcn_s_sleep(1);
        if ((++sp & 255u) == 0u) { if (xb_ld(&bar[XB_TMO])) break; if (sp > XB_SPIN_CAP) { atomicAdd(&bar[XB_TMO], 1u); break; } }
    }
    nloc = mine > 0u ? mine : 1u; nx = cnt > 0u ? cnt : 1u;
}
__device__ __forceinline__ void xcd_barrier(const XcdBarrier& b) {
    asm volatile("s_waitcnt vmcnt(0)" ::: "memory");
    __syncthreads();
    if (threadIdx.x == 0) {
        unsigned* bar = b.bar;
        __builtin_amdgcn_s_waitcnt(0);
        unsigned nloc = b.st[0], nx = b.st[1];
        if (nloc == 0u) { xcd_barrier_complete(bar, b.x, nloc, nx); b.st[0] = nloc; b.st[1] = nx; }
        const unsigned old = xb_add(&bar[XB_XSUB(b.x)], 1u);
        const unsigned gen = old / nloc;
        if (old + 1u == (gen + 1u) * nloc) {
            __builtin_amdgcn_fence(__ATOMIC_RELEASE, "agent");
            asm volatile("s_waitcnt vmcnt(0)" ::: "memory");
            const unsigned og = xb_add(&bar[XB_TOP], 1u);
            const unsigned tg = og / nx;
            if (og + 1u == (tg + 1u) * nx) xb_add(&bar[XB_TOPGEN], 1u);
            else XB_SPIN(xb_ld(&bar[XB_TOPGEN]) == tg, bar);
            __builtin_amdgcn_fence(__ATOMIC_ACQUIRE, "agent");
            xb_add(&bar[XB_XGEN(b.x)], 1u);
            asm volatile("s_waitcnt vmcnt(0)" ::: "memory");
        } else {
            XB_SPIN(xb_ld(&bar[XB_XGEN(b.x)]) == gen, bar);
            __builtin_amdgcn_fence(__ATOMIC_ACQUIRE, "agent");
            asm volatile("s_waitcnt vmcnt(0)" ::: "memory");
        }
    }
    __syncthreads();
}
namespace pg8 {
#define PG8_LAS __attribute__((address_space(3)))
typedef unsigned short bf16_t;
typedef short bf16x8 __attribute__((ext_vector_type(8)));
typedef float f32x4 __attribute__((ext_vector_type(4)));
typedef unsigned u32x4 __attribute__((ext_vector_type(4)));
constexpr int BM = 256, BK = 64, HALF = 128, HTB = HALF * BK * 2, STAGE_BYTES = 8 * HTB, NXCD = 8, WGM = 8;
__host__ __device__ __forceinline__ int lds_byte(int r, int c) { const int st = (r >> 4) * 2 + (c >> 5), rr = r & 15, cc = c & 31, ob = rr * 64 + cc * 2; return st * 1024 + (ob ^ (((ob >> 9) & 1) << 5)); }
__host__ __device__ __forceinline__ void stage_rc(int b, int& R, int& C) { const int st = b / 1024, sb = b % 1024, swz = sb ^ (((sb >> 9) & 1) << 5); R = (st >> 1) * 16 + swz / 64; C = (st & 1) * 32 + (swz % 64) / 2; }
__host__ __device__ __forceinline__ int perm32(int rho) { const int n = rho >> 4, i = rho & 15; return 8 * (i >> 2) + 4 * n + (i & 3); }
struct Unit { int pm, pn, e, aux; };
struct Gemm { const bf16_t* A; const bf16_t* Bt; int K; int pad; size_t bstride; const int* rows; };
struct StaticOrder {
    int nM, nN, nwg, G, c;
    __host__ __device__ void init(int M, int N, int G_, int c_) { nM = M / BM; nN = N / BM; nwg = nM * nN; G = G_; c = c_; }
    __host__ __device__ bool next(int i, Unit& u) const {
        const long L = (long)i * G + c; if (L >= nwg) return false;
        int wgid = (int)L; { const int q = nwg / NXCD, r = nwg % NXCD, xcd = wgid % NXCD, off = wgid / NXCD; wgid = (xcd < r ? xcd * (q + 1) : r * (q + 1) + (xcd - r) * q) + off; }
        const int nig = WGM * nN, gid = wgid / nig, fm = gid * WGM, gsz = (nM - fm) < WGM ? (nM - fm) : WGM;
        u.pm = fm + ((wgid % nig) % gsz); u.pn = (wgid % nig) / gsz; u.e = 0; u.aux = 0; return true;
    }
};
__device__ __forceinline__ unsigned cvt_pk_bf16(float lo, float hi) { unsigned r; asm volatile("v_cvt_pk_bf16_f32 %0, %1, %2" : "=v"(r) : "v"(lo), "v"(hi)); return r; }
struct EpiF32R {
    static constexpr bool PERM = false;
    float* C; int ldc; const float* R; float ralpha;
    __device__ __forceinline__ void operator()(const f32x4 (&acc)[2][2][4][2], const Unit& u, int wr, int wc, int fr, int fq) const {
        const int row0 = u.pm * BM + wr * 64 + fr, col0 = u.pn * BM + wc * 32 + 4 * fq;
#pragma unroll
        for (int ai = 0; ai < 2; ++ai)
#pragma unroll
            for (int m = 0; m < 4; ++m) { const size_t off = (size_t)(row0 + ai * HALF + m * 16) * ldc + col0;
#pragma unroll
                for (int bj = 0; bj < 2; ++bj)
#pragma unroll
                    for (int n = 0; n < 2; ++n) { f32x4 v = acc[ai][bj][m][n]; if (R) v = v + ralpha * *(const f32x4*)(R + off + bj * HALF + n * 16); *(f32x4*)(C + off + bj * HALF + n * 16) = v; } }
    }
};
template <class Epi, class Sched, bool ALIGN_EPI, bool GATHER>
__device__ __forceinline__ void gemm_phase(PG8_LAS unsigned char* lds, const Gemm g, const Sched& S, const Epi& E) {
    int tid_ = threadIdx.x; asm volatile("" : "+v"(tid_));
    const int tid = tid_, wid = __builtin_amdgcn_readfirstlane(tid >> 6), lane = tid & 63, wr = wid >> 2, wc = wid & 3, fr = lane & 15, fq = lane >> 4;
    const int K = g.K, nt = K / BK;
    unsigned voffA[2], voffB[2];
#pragma unroll
    for (int i = 0; i < 2; ++i) { int R, C; stage_rc(tid * 16 + i * 8192, R, C); const int Rb = Epi::PERM ? ((R & ~31) + perm32(R & 31)) : R;
        voffA[i] = (unsigned)(R * K + C) * 2u; voffB[i] = (unsigned)(Rb * K + C) * 2u; }
    const size_t kstep = (size_t)(BK * 2);
    const size_t hstep = (size_t)HALF * K * 2;
    const size_t tstep = 2 * hstep;
    const unsigned ldsw = (unsigned)wid * 1024u;
    const int aoff = lds_byte(wr * 64 + fr, fq * 8), boff = lds_byte(wc * 32 + fr, fq * 8);
#define PG8_SA(b, h) (((b) * 2 + (h)) * HTB)
#define PG8_SB(b, h) ((4 + (b) * 2 + (h)) * HTB)
#define PG8_STAGE(bufoff, gbase, voff) do { _Pragma("unroll") for (int _i = 0; _i < 2; ++_i) { unsigned _vo = (voff)[_i]; asm volatile("" : "+v"(_vo));   \
        __builtin_amdgcn_global_load_lds((const unsigned*)((const char*)(gbase) + _vo), (PG8_LAS unsigned*)(lds + (bufoff) + ldsw + _i * 8192), 16, 0, 0); } } while (0)
#define PG8_STAGE_A(bufoff, gbase, h, GV) do { if constexpr (GATHER) { PG8_STAGE(bufoff, gbase, GV[h]); } else { PG8_STAGE(bufoff, (gbase) + (h) * hstep, voffA); } } while (0)
#define PG8_STAGE_A2(bufoff, gbase, h) do { if constexpr (GATHER) { unsigned _gv[2] = {last ? gnxt[h][0] : gcur[h][0], last ? gnxt[h][1] : gcur[h][1]}; PG8_STAGE(bufoff, gbase, _gv); } else { PG8_STAGE(bufoff, (gbase) + (h) * hstep, voffA); } } while (0)
#define PG8_LDA(dst, b, h) do { _Pragma("unroll") for (int m = 0; m < 4; ++m) _Pragma("unroll") for (int k = 0; k < 2; ++k) dst[m][k] = *(const PG8_LAS bf16x8*)(lds + PG8_SA(b, h) + aoff + m * 2048 + k * 1024); } while (0)
#define PG8_LDB(dst, b, h) do { _Pragma("unroll") for (int n = 0; n < 2; ++n) _Pragma("unroll") for (int k = 0; k < 2; ++k) dst[n][k] = *(const PG8_LAS bf16x8*)(lds + PG8_SB(b, h) + boff + n * 2048 + k * 1024); } while (0)
#define PG8_MMA(ai, bj, At, Bt) do { __builtin_amdgcn_s_setprio(1); _Pragma("unroll") for (int m = 0; m < 4; ++m) _Pragma("unroll") for (int n = 0; n < 2; ++n) _Pragma("unroll") for (int k = 0; k < 2; ++k) \
        acc[ai][bj][m][n] = __builtin_amdgcn_mfma_f32_16x16x32_bf16(Bt[n][k], At[m][k], acc[ai][bj][m][n], 0, 0, 0); __builtin_amdgcn_s_setprio(0); } while (0)
#define PG8_WAIT_V(n) asm volatile("s_waitcnt vmcnt(" #n ")" ::: "memory")
#define PG8_WAIT_L(n) asm volatile("s_waitcnt lgkmcnt(" #n ")" ::: "memory")
#define PG8_BAR __builtin_amdgcn_s_barrier()
#define PG8_SCHED __builtin_amdgcn_sched_barrier(0)
#define PG8_GLOAD(GV, u) do { _Pragma("unroll") for (int _i = 0; _i < 2; ++_i) { int _R, _C; stage_rc(tid * 16 + _i * 8192, _R, _C); _Pragma("unroll") for (int _h = 0; _h < 2; ++_h) \
        GV[_h][_i] = (unsigned)g.rows[(u).pm * BM + _h * HALF + _R] * (unsigned)(K * 2) + (unsigned)(_C * 2); } } while (0)
    Unit cur, nxt; int ui = 0;
    if (!S.next(0, cur)) return;
    f32x4 acc[2][2][4][2];
#pragma unroll
    for (int a = 0; a < 2; ++a)
#pragma unroll
        for (int b = 0; b < 2; ++b)
#pragma unroll
            for (int m = 0; m < 4; ++m)
#pragma unroll
                for (int n = 0; n < 2; ++n) acc[a][b][m][n] = (f32x4){0.f, 0.f, 0.f, 0.f};
    bf16x8 At[4][2], B0[2][2], B1[2][2];
    unsigned gcur[2][2] = {{0u, 0u}, {0u, 0u}}, gnxt[2][2] = {{0u, 0u}, {0u, 0u}};
    if constexpr (GATHER) { PG8_GLOAD(gcur, cur); }
    const char* cA = GATHER ? (const char*)g.A : (const char*)g.A + (size_t)cur.pm * tstep;
    const char* cB = (const char*)g.Bt + ((size_t)cur.e * g.bstride) * 2 + (size_t)cur.pn * tstep;
    PG8_STAGE(PG8_SB(0, 0), cB, voffB); PG8_STAGE(PG8_SB(0, 1), cB + hstep, voffB); PG8_STAGE_A(PG8_SA(0, 0), cA, 0, gcur); PG8_STAGE_A(PG8_SA(0, 1), cA, 1, gcur);
    if (wr == 1) PG8_BAR;
    PG8_WAIT_V(2); PG8_BAR;
    PG8_STAGE(PG8_SB(1, 0), cB + kstep, voffB); PG8_STAGE_A(PG8_SA(1, 0), cA + kstep, 0, gcur); PG8_STAGE(PG8_SB(1, 1), cB + hstep + kstep, voffB);
    PG8_WAIT_V(6); PG8_BAR;
    for (;;) {
        const bool has_next = S.next(ui + 1, nxt);
        if constexpr (GATHER) { if (has_next) { PG8_GLOAD(gnxt, nxt); } else {
#pragma unroll
            for (int _h = 0; _h < 2; ++_h)
#pragma unroll
                for (int _i = 0; _i < 2; ++_i) gnxt[_h][_i] = gcur[_h][_i]; } }
        const char* nA = GATHER ? cA : (has_next ? (const char*)g.A + (size_t)nxt.pm * tstep : cA);
        const char* nB = has_next ? (const char*)g.Bt + ((size_t)nxt.e * g.bstride) * 2 + (size_t)nxt.pn * tstep : cB;
#pragma unroll 1
        for (int t = 0; t < nt; t += 2) {
            const bool last = (t == nt - 2);
            const char* a1 = cA + (size_t)(t + 1) * kstep;
            const char* a2 = last ? nA : cA + (size_t)(t + 2) * kstep; const char* b2 = last ? nB : cB + (size_t)(t + 2) * kstep;
            const char* a3 = a2 + kstep; const char* b3 = b2 + kstep;
            PG8_LDB(B0, 0, 0); PG8_LDB(B1, 0, 1); PG8_SCHED; PG8_LDA(At, 0, 0); PG8_STAGE_A(PG8_SA(1, 1), a1, 1, gcur);
            PG8_WAIT_V(8); PG8_WAIT_L(0); PG8_BAR; PG8_MMA(0, 0, At, B0); PG8_MMA(0, 1, At, B1); PG8_BAR; PG8_SCHED;
            PG8_LDA(At, 0, 1); PG8_STAGE(PG8_SB(0, 0), b2, voffB); PG8_STAGE(PG8_SB(0, 1), b2 + hstep, voffB); PG8_STAGE_A2(PG8_SA(0, 0), a2, 0);
            PG8_WAIT_V(8); PG8_WAIT_L(0); PG8_BAR; PG8_MMA(1, 0, At, B0); PG8_MMA(1, 1, At, B1); PG8_BAR; PG8_SCHED;
            PG8_LDB(B0, 1, 0); PG8_LDB(B1, 1, 1); PG8_SCHED; PG8_LDA(At, 1, 0); PG8_STAGE_A2(PG8_SA(0, 1), a2, 1);
            PG8_WAIT_V(8); PG8_WAIT_L(0); PG8_BAR; PG8_MMA(0, 0, At, B0); PG8_MMA(0, 1, At, B1); PG8_BAR; PG8_SCHED;
            PG8_LDA(At, 1, 1); PG8_STAGE(PG8_SB(1, 0), b3, voffB); PG8_STAGE(PG8_SB(1, 1), b3 + hstep, voffB); PG8_STAGE_A2(PG8_SA(1, 0), a3, 0);
            PG8_WAIT_V(8); PG8_WAIT_L(0); PG8_BAR; PG8_MMA(1, 0, At, B0); PG8_MMA(1, 1, At, B1); PG8_BAR; PG8_SCHED;
        }
        if constexpr (ALIGN_EPI) { if (wr == 0) PG8_BAR; }
        E(acc, cur, wr, wc, fr, fq);
        if (!has_next) break;
#pragma unroll
        for (int a = 0; a < 2; ++a)
#pragma unroll
            for (int b = 0; b < 2; ++b)
#pragma unroll
                for (int m = 0; m < 4; ++m)
#pragma unroll
                    for (int n = 0; n < 2; ++n) acc[a][b][m][n] = (f32x4){0.f, 0.f, 0.f, 0.f};
        cur = nxt; cA = nA; cB = nB; ++ui;
        if constexpr (GATHER) {
#pragma unroll
            for (int _h = 0; _h < 2; ++_h)
#pragma unroll
                for (int _i = 0; _i < 2; ++_i) gcur[_h][_i] = gnxt[_h][_i]; }
        if constexpr (ALIGN_EPI) { if (wr == 1) PG8_BAR; }
    }
    PG8_WAIT_V(0);
    if constexpr (!ALIGN_EPI) { if (wr == 0) PG8_BAR; }
    PG8_BAR;
#undef PG8_SA
#undef PG8_SB
#undef PG8_STAGE
#undef PG8_STAGE_A
#undef PG8_STAGE_A2
#undef PG8_LDA
#undef PG8_LDB
#undef PG8_MMA
#undef PG8_WAIT_V
#undef PG8_WAIT_L
#undef PG8_BAR
#undef PG8_SCHED
#undef PG8_GLOAD
}
}
typedef unsigned short bf16;
typedef unsigned v4u __attribute__((ext_vector_type(4)));
typedef unsigned v2u __attribute__((ext_vector_type(2)));
typedef float f32x4 __attribute__((ext_vector_type(4)));
constexpr int NTHREADS = 512, NWAVES = 8;
constexpr int LDS_BYTES = 147456;
constexpr int MISC_OFF = 131072 + 320;
constexpr size_t MiB = 1u << 20;
constexpr size_t CTL_BYTES = 1 * MiB;
constexpr int T_ = nv::T_, S_ = nv::S_, NCH = nv::NCH;
constexpr int EINP = 3328, OINP = 2304;
#define LDS_WAIT() asm volatile("s_waitcnt lgkmcnt(0)" ::: "memory")
__device__ __forceinline__ unsigned f2bf(float f) { unsigned u = __builtin_bit_cast(unsigned, f); return (u + 0x7fffu + ((u >> 16) & 1u)) >> 16; }
__device__ __forceinline__ unsigned pk2(float lo, float hi) { return f2bf(lo) | (f2bf(hi) << 16); }
__device__ __forceinline__ float bf2f(unsigned short b) { return __builtin_bit_cast(float, (unsigned)b << 16); }
__device__ __forceinline__ void tr_item(const float* W, long ldw, int nvalid, bf16* dst, long ldd, LAS float* scr, int lane) {
#pragma unroll 8
    for (int i = 0; i < 32; ++i) { const int kk = 2 * i + (lane >> 5), nn = lane & 31; scr[kk * 33 + nn] = nn < nvalid ? W[(long)kk * ldw + nn] : 0.f; }
    LDS_WAIT(); asm volatile("" ::: "memory");
    const int c = lane & 7;
#pragma unroll
    for (int j = 0; j < 4; ++j) { const int n = (lane >> 3) + 8 * j; const LAS float* s = scr + (8 * c) * 33 + n;
        v4u o; o.x = pk2(s[0 * 33], s[1 * 33]); o.y = pk2(s[2 * 33], s[3 * 33]); o.z = pk2(s[4 * 33], s[5 * 33]); o.w = pk2(s[6 * 33], s[7 * 33]);
        *(v4u*)(dst + (long)n * ldd + 8 * c) = o; }
    LDS_WAIT(); asm volatile("" ::: "memory");
}
__device__ __forceinline__ void tr_matrix(const float* W, int K, int N, int NP, bf16* WT, LAS float* scr, int gw, int NGW, int lane) {
    const int nblk = NP / 32, nitems = (K / 64) * nblk;
    for (int it = gw; it < nitems; it += NGW) { const int kb = it / nblk, nb = it % nblk, k0 = 64 * kb, n0 = 32 * nb; int nvalid = N - n0; nvalid = nvalid < 0 ? 0 : (nvalid > 32 ? 32 : nvalid);
        tr_item(W + (long)k0 * N + n0, N, nvalid, WT + (long)n0 * K + k0, K, scr, lane); }
}
__device__ __forceinline__ void cvt_rows(const float* src, bf16* dst, long n, long gtid, long gsz) {
    for (long i = gtid * 8; i < n; i += gsz * 8) { const f32x4 a = *(const f32x4*)(src + i), b = *(const f32x4*)(src + i + 4);
        v4u o; o.x = pk2(a.x, a.y); o.y = pk2(a.z, a.w); o.z = pk2(b.x, b.y); o.w = pk2(b.z, b.w); *(v4u*)(dst + i) = o; }
}
__device__ __forceinline__ int sopaque(int v) { asm volatile("" : "+s"(v)); return v; }
__device__ __forceinline__ float wave_sum(float v) {
#define WS_STEP(o) v += __builtin_bit_cast(float, __builtin_amdgcn_ds_swizzle(__builtin_bit_cast(int, v), 0x1f | ((o) << 10)))
    WS_STEP(1); WS_STEP(2); WS_STEP(4); WS_STEP(8); WS_STEP(16);
#undef WS_STEP
    return __builtin_bit_cast(float, __builtin_amdgcn_readlane(__builtin_bit_cast(int, v), 0)) + __builtin_bit_cast(float, __builtin_amdgcn_readlane(__builtin_bit_cast(int, v), 32));
}
#ifndef DBG_SCALE
#define DBG_SCALE 20.0f
#endif
constexpr int MOE_MAXBLK = 640;
constexpr int CW_CNT = 8192, CW_CUR = 8192 + 128;
namespace pg8 {
struct MoeOrder {
    const int* blk_e; int nblk, npn, G, c;
    __device__ __forceinline__ bool next(int i, Unit& u) const {
        const long L = (long)i * G + c; if (L >= (long)nblk * npn) return false;
        const int blk = (int)(L / npn); u.pm = blk; u.pn = (int)(L % npn); u.e = __builtin_amdgcn_readfirstlane(blk_e[blk]); u.aux = 0; return true;
    }
};
__device__ __forceinline__ float silu_f(float x) { return x / (1.0f + __expf(-x)); }
struct EpiSwiGLU {
    static constexpr bool PERM = true;
    bf16_t* H;
    __device__ __forceinline__ void operator()(const f32x4 (&acc)[2][2][4][2], const Unit& u, int wr, int wc, int fr, int fq) const {
        const int row0 = u.pm * BM + wr * 64 + fr, col0 = u.pn * 128 + wc * 32 + 8 * fq;
#pragma unroll
        for (int ai = 0; ai < 2; ++ai)
#pragma unroll
            for (int m = 0; m < 4; ++m) { bf16_t* rowp = H + (size_t)(row0 + ai * HALF + m * 16) * 256 + col0;
                const f32x4 g0 = acc[ai][0][m][0], g1 = acc[ai][0][m][1], u0 = acc[ai][1][m][0], u1 = acc[ai][1][m][1];
                u32x4 w; w.x = cvt_pk_bf16(silu_f(g0[0]) * u0[0], silu_f(g0[1]) * u0[1]); w.y = cvt_pk_bf16(silu_f(g0[2]) * u0[2], silu_f(g0[3]) * u0[3]);
                w.z = cvt_pk_bf16(silu_f(g1[0]) * u1[0], silu_f(g1[1]) * u1[1]); w.w = cvt_pk_bf16(silu_f(g1[2]) * u1[2], silu_f(g1[3]) * u1[3]);
                *(u32x4*)rowp = w; }
    }
};
struct EpiDown {
    static constexpr bool PERM = true;
    bf16_t* rows8; bf16_t* rows_sh; const int* dest; const float* w; int nslot8;
    __device__ __forceinline__ void operator()(const f32x4 (&acc)[2][2][4][2], const Unit& u, int wr, int wc, int fr, int fq) const {
        const int row0 = u.pm * BM + wr * 64 + fr, col0 = u.pn * BM + wc * 32 + 8 * fq;
#pragma unroll
        for (int ai = 0; ai < 2; ++ai)
#pragma unroll
            for (int m = 0; m < 4; ++m) { const int r = row0 + ai * HALF + m * 16; const int d = dest[r]; const float ww = w[r];
                if (d >= 0) { bf16_t* rowp = (d < nslot8 ? rows8 + (size_t)d * 1024 : rows_sh + (size_t)(d - nslot8) * 1024) + col0;
#pragma unroll
                    for (int bj = 0; bj < 2; ++bj) { const f32x4 v0 = acc[ai][bj][m][0] * ww, v1 = acc[ai][bj][m][1] * ww;
                        u32x4 o; o.x = cvt_pk_bf16(v0[0], v0[1]); o.y = cvt_pk_bf16(v0[2], v0[3]); o.z = cvt_pk_bf16(v1[0], v1[1]); o.w = cvt_pk_bf16(v1[2], v1[3]);
                        *(u32x4*)(rowp + bj * HALF) = o; } } }
    }
};
}
__device__ __forceinline__ void moe_convert_weights(const float* wg, const float* wu, const float* wd, const float* sg, const float* su, const float* sd,
                                                    bf16* WGU, bf16* WD, LAS float* scr, int gw, int NGW, int lane) {
    for (int it = gw; it < 65 * 384; it += NGW) {
        const int e = it / 384, r = it % 384, kind = r >> 7, q = r & 127;
        if (kind < 2) { const float* W = (e < 64 ? (kind == 0 ? wg : wu) + (size_t)e * 262144 : (kind == 0 ? sg : su));
            const int kb = q >> 3, nb = q & 7, k0 = 64 * kb, n0 = 32 * nb;
            tr_item(W + (size_t)k0 * 256 + n0, 256, 32, WGU + ((size_t)e * 512 + (n0 >> 7) * 256 + (n0 & 127) + kind * 128) * 1024 + k0, 1024, scr, lane);
        } else { const float* W = e < 64 ? wd + (size_t)e * 262144 : sd;
            const int kb = q >> 5, nb = q & 31, k0 = 64 * kb, n0 = 32 * nb;
            tr_item(W + (size_t)k0 * 1024 + n0, 1024, 32, WD + ((size_t)e * 1024 + n0) * 256 + k0, 256, scr, lane); }
    }
}
struct MoeLists { int* tok; int* dest; float* w; int* blk_e; };
__device__ __forceinline__ void moe_count(const int* ridx, unsigned* cnt, LAS unsigned* hist, int tid, int bid, int G) {
    if (tid < 64) hist[tid] = 0u;
    __syncthreads();
    for (int i = bid * NTHREADS + tid; i < T_ * 8; i += G * NTHREADS) atomicAdd((unsigned*)&hist[ridx[i]], 1u);
    __syncthreads();
    if (tid < 64 && hist[tid]) atomicAdd(&cnt[tid], hist[tid]);
    __syncthreads();
}
__device__ __forceinline__ void moe_build_lists(const int* ridx, const float* rwt, const unsigned* cnt, unsigned* cur, const MoeLists L, LAS int* sm, int tid, int bid, int G) {
    LAS int* pstart = sm; LAS unsigned* hist = (LAS unsigned*)(sm + 80); LAS unsigned* base = (LAS unsigned*)(sm + 160);
    if (tid == 0) { int acc = 0;
#pragma unroll 1
        for (int e = 0; e < 64; ++e) { pstart[e] = acc; acc += ((int)__hip_atomic_load(&cnt[e], __ATOMIC_RELAXED, __HIP_MEMORY_SCOPE_AGENT) + 255) & ~255; } pstart[64] = acc; pstart[65] = acc + T_; }
    __syncthreads();
    const int per = (T_ * 8 + G - 1) / G;
    const int lo = bid * per, hi = (lo + per < T_ * 8) ? lo + per : T_ * 8;
    for (int c0 = lo; c0 < hi; c0 += NTHREADS) {
        if (tid < 64) hist[tid] = 0u;
        __syncthreads();
        const int i = c0 + tid; int e = 0; unsigned local = 0u;
        if (i < hi) { e = ridx[i]; local = atomicAdd((unsigned*)&hist[e], 1u); }
        __syncthreads();
        if (tid < 64) base[tid] = hist[tid] ? atomicAdd(&cur[tid], hist[tid]) : 0u;
        __syncthreads();
        if (i < hi) { const int pos = pstart[e] + (int)base[e] + (int)local; L.tok[pos] = i >> 3; L.dest[pos] = i; L.w[pos] = rwt[i]; }
        __syncthreads();
    }
    for (int e = bid; e < 64; e += G) { const int c = (int)__hip_atomic_load(&cnt[e], __ATOMIC_RELAXED, __HIP_MEMORY_SCOPE_AGENT);
        for (int p = pstart[e] + c + tid; p < pstart[e + 1]; p += NTHREADS) { L.tok[p] = 0; L.dest[p] = -1; L.w[p] = 0.f; } }
    for (int t = bid * NTHREADS + tid; t < T_; t += G * NTHREADS) { const int p = pstart[64] + t; L.tok[p] = t; L.dest[p] = T_ * 8 + t; L.w[p] = 1.f; }
    const int nblk = pstart[65] >> 8;
    for (int b = bid * NTHREADS + tid; b < nblk; b += G * NTHREADS) { int e = 0;
#pragma unroll 1
        while (e < 64 && (pstart[e + 1] >> 8) <= b) ++e;
        L.blk_e[b] = e; }
    if (bid == 0 && tid == 0) L.blk_e[MOE_MAXBLK] = nblk;
    __syncthreads();
}
__device__ __forceinline__ void moe_combine_ln(float* h, const bf16* rows8, const bf16* rows_sh, const float* lw, const float* lb, bf16* hbf, int gw, int NGW, int lane, const float* zdbg = nullptr, int ntdbg = 0, int t0dbg = 0) {
    for (int t = gw; t < T_; t += NGW) {
        float v[16];
#pragma unroll
        for (int half = 0; half < 2; ++half) { const int c0 = half * 512 + lane * 8;
            const f32x4 a = *(const f32x4*)(h + (size_t)t * 1024 + c0), b = *(const f32x4*)(h + (size_t)t * 1024 + c0 + 4);
            float s[8] = {a.x * nv::ALPHA, a.y * nv::ALPHA, a.z * nv::ALPHA, a.w * nv::ALPHA, b.x * nv::ALPHA, b.y * nv::ALPHA, b.z * nv::ALPHA, b.w * nv::ALPHA};
#pragma unroll
            for (int k = 0; k < 9; ++k) { const bf16* rp = (k < 8 ? rows8 + ((size_t)t * 8 + k) * 1024 : rows_sh + (size_t)t * 1024) + c0;
                const v4u r = *(const v4u*)rp;
                s[0] += __builtin_bit_cast(float, r.x << 16); s[1] += __builtin_bit_cast(float, r.x & 0xffff0000u);
                s[2] += __builtin_bit_cast(float, r.y << 16); s[3] += __builtin_bit_cast(float, r.y & 0xffff0000u);
                s[4] += __builtin_bit_cast(float, r.z << 16); s[5] += __builtin_bit_cast(float, r.z & 0xffff0000u);
                s[6] += __builtin_bit_cast(float, r.w << 16); s[7] += __builtin_bit_cast(float, r.w & 0xffff0000u); }
#pragma unroll
            for (int j = 0; j < 8; ++j) v[half * 8 + j] = s[j]; }
        float dd[16];
#pragma unroll
        for (int j = 0; j < 16; ++j) dd[j] = 0.f;
        if (zdbg && t >= t0dbg && t < t0dbg + ntdbg) {
#pragma unroll
            for (int j = 0; j < 16; ++j) { const float zz = zdbg[(size_t)(t - t0dbg) * 1024 + (j >> 3) * 512 + lane * 8 + (j & 7)]; dd[j] = (DBG_SCALE != 0.0f) ? (v[j] - zz) * DBG_SCALE : 0.f; v[j] = zz; } }
        float sum = 0.f;
#pragma unroll
        for (int j = 0; j < 16; ++j) sum += v[j];
        sum = wave_sum(sum);
        const float mean = sum * (1.f / 1024.f);
        float sq = 0.f;
#pragma unroll
        for (int j = 0; j < 16; ++j) { v[j] -= mean; sq += v[j] * v[j]; }
        sq = wave_sum(sq);
        const float rstd = 1.0f / sqrtf(sq * (1.f / 1024.f) + nv::EPS);
#pragma unroll
        for (int half = 0; half < 2; ++half) { const int c0 = half * 512 + lane * 8;
            const f32x4 w0 = *(const f32x4*)(lw + c0), w1 = *(const f32x4*)(lw + c0 + 4), b0 = *(const f32x4*)(lb + c0), b1 = *(const f32x4*)(lb + c0 + 4);
            f32x4 o0, o1;
            if (zdbg) {
#pragma unroll
                for (int j = 0; j < 8; ++j) v[half * 8 + j] += dd[half * 8 + j] / rstd; }
            o0.x = v[half * 8 + 0] * rstd * w0.x + b0.x; o0.y = v[half * 8 + 1] * rstd * w0.y + b0.y; o0.z = v[half * 8 + 2] * rstd * w0.z + b0.z; o0.w = v[half * 8 + 3] * rstd * w0.w + b0.w;
            o1.x = v[half * 8 + 4] * rstd * w1.x + b1.x; o1.y = v[half * 8 + 5] * rstd * w1.y + b1.y; o1.z = v[half * 8 + 6] * rstd * w1.z + b1.z; o1.w = v[half * 8 + 7] * rstd * w1.w + b1.w;
            *(f32x4*)(h + (size_t)t * 1024 + c0) = o0; *(f32x4*)(h + (size_t)t * 1024 + c0 + 4) = o1;
            if (hbf) { v4u p; p.x = pk2(o0.x, o0.y); p.y = pk2(o0.z, o0.w); p.z = pk2(o1.x, o1.y); p.w = pk2(o1.z, o1.w); *(v4u*)(hbf + (size_t)t * 1024 + c0) = p; } }
    }
}
constexpr int CTX_OFF = 131072 + 1024, TAB_OFF = 131072 + 8192;
constexpr size_t WS_WINE = 1 * MiB, WS_WINO = WS_WINE + (size_t)EINP * 1024 * 2, WS_WOUT = WS_WINO + (size_t)OINP * 1024 * 2, WS_XBF = 16 * MiB, WS_MIXBF = 48 * MiB, WS_NAIVE = 80 * MiB;
static_assert(WS_WOUT + 2 * 1024 * 1024 * 2 <= WS_XBF, "ws map");
constexpr size_t WS_WD = 48 * MiB, WS_WGU = WS_WD + 65 * 512 * 1024, WS_LISTS = 146 * MiB, WS_RIDX = 148 * MiB, WS_H = 149 * MiB, WS_ROWS8 = 229 * MiB;
static_assert(WS_WGU + (size_t)65 * 1024 * 1024 <= WS_LISTS && WS_H + (size_t)MOE_MAXBLK * 256 * 512 <= WS_ROWS8 && WS_ROWS8 + (size_t)nv::T_ * 8 * 2048 <= 512 * MiB, "moe ws map");
struct Tab { const float* in[38]; float* out; unsigned char* ws; };
struct Env { const Tab* tab; unsigned char* ws; float* out; LAS unsigned char* lds; int tid, lane, wave, bid, G, gw, NGW, gtid, gsz; };
__device__ __forceinline__ Env penv(unsigned char* lds_raw) {
    Env e; e.tab = (const Tab*)(lds_raw + TAB_OFF); e.ws = e.tab->ws; e.out = e.tab->out; e.lds = (LAS unsigned char*)lds_raw;
    int t = threadIdx.x; asm volatile("" : "+v"(t)); e.tid = t; e.lane = t & 63; e.wave = __builtin_amdgcn_readfirstlane(t >> 6);
    int b = blockIdx.x; asm volatile("" : "+s"(b)); e.bid = b; int g = gridDim.x; asm volatile("" : "+s"(g)); e.G = g;
    e.gw = b * NWAVES + e.wave; e.NGW = g * NWAVES; e.gtid = b * NTHREADS + t; e.gsz = g * NTHREADS;
    return e;
}
__device__ __forceinline__ void grid_bar(const Env& e) {
    XcdBarrier b; b.bar = (unsigned*)e.ws + 4096; b.x = xb_xcc_id(); b.st = (volatile LAS unsigned*)(e.lds + MISC_OFF) + 8;
    xcd_barrier(b);
}
template <int ST> __device__ __forceinline__ void run_naive(unsigned char* lds_raw, int ci, long n) {
    const Env e = penv(lds_raw);
    const nv::Ctx& c = ((const nv::Ctx*)(lds_raw + CTX_OFF))[ci];
    for (long i = e.gtid; i < n; i += e.gsz) nv::item<ST>(c, i);
    grid_bar(e);
}
__device__ __forceinline__ void phase_p0(unsigned char* lds_raw) {
    const Env e = penv(lds_raw);
    LAS float* scr = (LAS float*)(e.lds + e.wave * 16384);
    tr_matrix(e.tab->in[6], 1024, nv::EIN, EINP, (bf16*)(e.ws + WS_WINE), scr, e.gw, e.NGW, e.lane);
    tr_matrix(e.tab->in[16], 1024, nv::OIN, OINP, (bf16*)(e.ws + WS_WINO), scr, e.gw, e.NGW, e.lane);
    tr_matrix(e.tab->in[5], 1024, 1024, 1024, (bf16*)(e.ws + WS_WOUT), scr, e.gw, e.NGW, e.lane);
    tr_matrix(e.tab->in[5] + 1024 * 1024, 1024, 1024, 1024, (bf16*)(e.ws + WS_WOUT) + 1024 * 1024, scr, e.gw, e.NGW, e.lane);
    cvt_rows(e.tab->in[0], (bf16*)(e.ws + WS_XBF), (long)T_ * 1024, e.gtid, e.gsz);
    grid_bar(e);
}
__device__ __forceinline__ void phase_inproj(unsigned char* lds_raw, int layer) {
    const Env e = penv(lds_raw);
    float* proj = (float*)(e.ws + WS_NAIVE) + ((size_t)T_ * 1024 + (size_t)T_ * 64 + (size_t)T_ * 8 * 2);
    const int NP = layer == 0 ? EINP : OINP;
    pg8::Gemm g{(const bf16*)(e.ws + WS_XBF), (const bf16*)(e.ws + (layer == 0 ? WS_WINE : WS_WINO)), 1024, 0, 0, nullptr};
    pg8::StaticOrder S; S.init(T_, NP, e.G, e.bid);
    pg8::EpiF32R E{proj, NP, nullptr, 0.f};
    pg8::gemm_phase<pg8::EpiF32R, pg8::StaticOrder, true, false>(e.lds, g, S, E);
    grid_bar(e);
}
__device__ __forceinline__ void phase_cvt_mixed(unsigned char* lds_raw) {
    const Env e = penv(lds_raw);
    cvt_rows((const float*)(e.ws + WS_NAIVE), (bf16*)(e.ws + WS_MIXBF), (long)T_ * 1024, e.gtid, e.gsz);
    grid_bar(e);
}
__device__ __forceinline__ void phase_outproj(unsigned char* lds_raw, int layer) {
    const Env e = penv(lds_raw);
    float* z = (float*)(e.ws + WS_NAIVE) + ((size_t)T_ * 1024 + (size_t)T_ * 64 + (size_t)T_ * 8 * 2);
    const float* hcur = layer == 0 ? e.tab->in[0] : e.out;
    pg8::Gemm g{(const bf16*)(e.ws + WS_MIXBF), (const bf16*)(e.ws + WS_WOUT) + (size_t)layer * 1024 * 1024, 1024, 0, 0, nullptr};
    pg8::StaticOrder S; S.init(T_, 1024, e.G, e.bid);
    pg8::EpiF32R E{z, 1024, hcur, nv::ALPHA};
    pg8::gemm_phase<pg8::EpiF32R, pg8::StaticOrder, true, false>(e.lds, g, S, E);
    grid_bar(e);
}
__device__ __forceinline__ MoeLists moe_lists(unsigned char* ws) {
    MoeLists L; L.tok = (int*)(ws + WS_LISTS); L.dest = L.tok + MOE_MAXBLK * 256; L.w = (float*)(L.dest + MOE_MAXBLK * 256); L.blk_e = (int*)(L.w + MOE_MAXBLK * 256); return L;
}
__device__ __forceinline__ void phase_moe_x1(unsigned char* lds_raw, int layer) {
    const Env e = penv(lds_raw);
    LAS float* scr = (LAS float*)(e.lds + e.wave * 16384);
    moe_convert_weights(e.tab->in[32] + (size_t)layer * 64 * 262144, e.tab->in[33] + (size_t)layer * 64 * 262144, e.tab->in[34] + (size_t)layer * 64 * 262144,
                        e.tab->in[35] + (size_t)layer * 262144, e.tab->in[36] + (size_t)layer * 262144, e.tab->in[37] + (size_t)layer * 262144,
                        (bf16*)(e.ws + WS_WGU), (bf16*)(e.ws + WS_WD), scr, e.gw, e.NGW, e.lane);
    cvt_rows(e.out, (bf16*)(e.ws + WS_XBF), (long)T_ * 1024, e.gtid, e.gsz);
    __syncthreads();
    moe_count((const int*)(e.ws + WS_RIDX), (unsigned*)e.ws + CW_CNT + layer * 256, (LAS unsigned*)e.lds, e.tid, e.bid, e.G);
    grid_bar(e);
}
__device__ __forceinline__ void phase_moe_x2(unsigned char* lds_raw, int layer) {
    const Env e = penv(lds_raw);
    moe_build_lists((const int*)(e.ws + WS_RIDX), (const float*)(e.ws + WS_RIDX) + (size_t)T_ * 8, (unsigned*)e.ws + CW_CNT + layer * 256, (unsigned*)e.ws + CW_CUR + layer * 256,
                    moe_lists(e.ws), (LAS int*)e.lds, e.tid, e.bid, e.G);
    grid_bar(e);
}
__device__ __forceinline__ void phase_moe_g1(unsigned char* lds_raw) {
    const Env e = penv(lds_raw);
    const MoeLists L = moe_lists(e.ws);
    const int nblk = __builtin_amdgcn_readfirstlane(L.blk_e[MOE_MAXBLK]);
    pg8::Gemm g{(const bf16*)(e.ws + WS_XBF), (const bf16*)(e.ws + WS_WGU), 1024, 0, (size_t)512 * 1024, L.tok};
    pg8::MoeOrder S{L.blk_e, nblk, 2, e.G, e.bid};
    pg8::EpiSwiGLU E{(bf16*)(e.ws + WS_H)};
    pg8::gemm_phase<pg8::EpiSwiGLU, pg8::MoeOrder, true, true>(e.lds, g, S, E);
    grid_bar(e);
}
__device__ __forceinline__ void phase_moe_g2(unsigned char* lds_raw) {
    const Env e = penv(lds_raw);
    const MoeLists L = moe_lists(e.ws);
    const int nblk = __builtin_amdgcn_readfirstlane(L.blk_e[MOE_MAXBLK]);
    pg8::Gemm g{(const bf16*)(e.ws + WS_H), (const bf16*)(e.ws + WS_WD), 256, 0, (size_t)1024 * 256, nullptr};
    pg8::MoeOrder S{L.blk_e, nblk, 4, e.G, e.bid};
    pg8::EpiDown E{(bf16*)(e.ws + WS_ROWS8), (bf16*)(e.ws + WS_XBF), L.dest, L.w, T_ * 8};
    pg8::gemm_phase<pg8::EpiDown, pg8::MoeOrder, true, false>(e.lds, g, S, E);
    grid_bar(e);
}
__device__ __forceinline__ void phase_moe_combine(unsigned char* lds_raw, int layer) {
    const Env e = penv(lds_raw);
    moe_combine_ln(e.out, (const bf16*)(e.ws + WS_ROWS8), (const bf16*)(e.ws + WS_XBF), e.tab->in[3] + layer * 1024, e.tab->in[4] + layer * 1024,
                   layer == 0 ? (bf16*)(e.ws + WS_XBF) : nullptr, e.gw, e.NGW, e.lane
#ifdef DBG_LAYER
                   , layer == DBG_LAYER ? (const float*)(e.ws + 486 * MiB) : nullptr, DBG_NT, DBG_T0
#endif
                   );
    grid_bar(e);
}
template <int layer> __device__ __forceinline__ void layer_body(unsigned char* lds_raw) {
        phase_inproj(lds_raw, layer);
        const int ci = layer * 2;
        if (layer == 0) {
            run_naive<nv::ST_ML_GATES>(lds_raw, ci, 8L * NCH);
            run_naive<nv::ST_ML_CLOC>(lds_raw, ci, 8L * NCH * 16384);
            run_naive<nv::ST_ML_SCAN>(lds_raw, ci, 8L * 16384 + 8 * 128);
            run_naive<nv::ST_ML_MI>(lds_raw, ci, 8L * S_);
            run_naive<nv::ST_ML_SMAT>(lds_raw, ci, 8L * NCH * 4096);
            run_naive<nv::ST_ML_DEN>(lds_raw, ci, 8L * S_);
            run_naive<nv::ST_ML_H>(lds_raw, ci, 8L * S_ * 128);
            run_naive<nv::ST_ML_NORM>(lds_raw, ci, 8L * S_);
            run_naive<nv::ST_LRU_CONV>(lds_raw, ci, (long)T_ * 512);
            run_naive<nv::ST_LRU_GATE>(lds_raw, ci, (long)T_ * 512);
            run_naive<nv::ST_LRU_SCAN>(lds_raw, ci, 2L * 512);
        } else {
            run_naive<nv::ST_S5_PAR>(lds_raw, ci, 2048);
            for (int sl = 0; sl < S_ / nv::SLAB; ++sl) {
                if (threadIdx.x == 0) ((nv::Ctx*)(lds_raw + CTX_OFF))[ci].slab = sl;
                __syncthreads();
                run_naive<nv::ST_S5_SCAN>(lds_raw, ci, 2L * 2048); run_naive<nv::ST_S5_OUT>(lds_raw, ci, (long)nv::B_ * nv::SLAB * 512); }
            run_naive<nv::ST_S5_GLU>(lds_raw, ci, (long)T_ * 512);
            run_naive<nv::ST_GLA_GATE>(lds_raw, ci, (long)T_ * 256);
            run_naive<nv::ST_GLA_CUM>(lds_raw, ci, (long)nv::B_ * NCH * 256);
            run_naive<nv::ST_GLA_U>(lds_raw, ci, 8L * NCH * 8192);
            run_naive<nv::ST_GLA_SCAN>(lds_raw, ci, 8L * 8192);
            run_naive<nv::ST_GLA_ATT>(lds_raw, ci, 8L * NCH * 4096);
            run_naive<nv::ST_GLA_O>(lds_raw, ci, 8L * S_ * 128);
            run_naive<nv::ST_GLA_NORM>(lds_raw, ci, 8L * S_);
        }
        phase_cvt_mixed(lds_raw);
        phase_outproj(lds_raw, layer);
        run_naive<nv::ST_LN>(lds_raw, ci, T_);
        run_naive<nv::ST_SCORES>(lds_raw, ci + 1, (long)T_ * 64);
        run_naive<nv::ST_SELECT>(lds_raw, ci + 1, T_);
#ifdef NAIVE_MOE_LAYER
        if (layer == NAIVE_MOE_LAYER) {
            if (threadIdx.x == 0) { nv::Ctx& cm = ((nv::Ctx*)(lds_raw + CTX_OFF))[ci + 1]; cm.z = cm.mixed; cm.lnw = cm.in[3] + layer * 1024; cm.lnb = cm.in[4] + layer * 1024; }
            __syncthreads();
            run_naive<nv::ST_HID>(lds_raw, ci + 1, (long)T_ * 9 * 256);
            run_naive<nv::ST_FFN>(lds_raw, ci + 1, (long)T_ * 1024);
#ifdef E5
            { const Env e = penv(lds_raw);
              moe_combine_ln(e.out, (const bf16*)(e.ws + WS_ROWS8), (const bf16*)(e.ws + WS_XBF), e.tab->in[3] + layer * 1024, e.tab->in[4] + layer * 1024, nullptr, e.gw, e.NGW, e.lane,
                             (const float*)(e.ws + WS_NAIVE), T_, 0);
              grid_bar(e); }
#else
            run_naive<nv::ST_LN>(lds_raw, ci + 1, T_);
#endif
            if (layer == 0) { const Env e = penv(lds_raw); cvt_rows(e.out, (bf16*)(e.ws + WS_XBF), (long)T_ * 1024, e.gtid, e.gsz); grid_bar(e); }
            return;
        }
#endif
        phase_moe_x1(lds_raw, layer);
        phase_moe_x2(lds_raw, layer);
        phase_moe_g1(lds_raw);
        phase_moe_g2(lds_raw);
#ifdef DBG_LAYER
        if (layer == DBG_LAYER) { run_naive<nv::ST_HID>(lds_raw, 4, (long)DBG_NT * 9 * 256); run_naive<nv::ST_FFN>(lds_raw, 4, (long)DBG_NT * 1024); }
#endif
        phase_moe_combine(lds_raw, layer);
    }
struct Args { const float* in[38]; float* out; unsigned char* ws; };
__global__ void __launch_bounds__(NTHREADS, 2) mega_fwd(Args a) {
    extern __shared__ __attribute__((aligned(16))) unsigned char lds_raw[];
    {
        LAS unsigned char* lds = (LAS unsigned char*)lds_raw;
        for (int u = threadIdx.x; u < (LDS_BYTES - 131072) / 4; u += NTHREADS) ((LAS unsigned*)(lds + 131072))[u] = 0u;
        __syncthreads();
        if (threadIdx.x == 0) {
            (void)xb_add((unsigned*)a.ws + 4096 + XB_XCNT(xb_xcc_id()), 1u);
            Tab* tab = (Tab*)(lds_raw + TAB_OFF);
#pragma unroll
            for (int i = 0; i < 38; ++i) { tab->in[i] = a.in[i]; if ((i & 7) == 7) asm volatile("" ::: "memory"); }
            tab->out = a.out; tab->ws = a.ws;
            asm volatile("" ::: "memory");
            nv::Ctx* const ctab = (nv::Ctx*)(lds_raw + CTX_OFF);
            const size_t scratch0 = (size_t)T_ * 1024 + (size_t)T_ * 64 + (size_t)T_ * 8 * 2;
#pragma unroll 1
            for (int layer = 0; layer < 2; ++layer) {
                nv::Ctx& c = ctab[layer * 2];
                nv::Mem M{(float*)(a.ws + WS_NAIVE), 0};
#pragma unroll 1
                for (int i = 0; i < 38; ++i) c.in[i] = tab->in[i];
                c.mixed = M.get((size_t)T_ * 1024); c.scores = M.get((size_t)T_ * 64);
                c.ridx = (int*)M.get((size_t)T_ * 8); c.rwt = M.get((size_t)T_ * 8);
                c.gR = nullptr; c.gBias = nullptr; c.slab = 0;
                c.layer = layer;
                c.hcur = layer == 0 ? a.in[0] : a.out;
                if (layer == 0) {
                    c.ldp = EINP; c.proj = M.get((size_t)T_ * c.ldp);
                    c.mb = M.get(8 * S_); c.mig = M.get(8 * S_); c.mblast = M.get(8 * NCH); c.mmloc = M.get(8 * NCH); c.mmprev = M.get(8 * NCH);
                    c.mmi = M.get(8 * S_); c.mwin = M.get(8 * S_); c.mden = M.get(8 * S_); c.nloc = M.get(8 * NCH * 128);
                    const size_t ov = M.off;
                    c.cloc = M.get((size_t)8 * NCH * 16384); c.smat = M.get((size_t)8 * NCH * 4096); c.htil = M.get((size_t)T_ * 512);
                    M.off = ov; c.lxc = M.get((size_t)T_ * 512); c.la = M.get((size_t)T_ * 512); c.lu = M.get((size_t)T_ * 512);
                } else {
                    c.ldp = OINP; c.proj = M.get((size_t)T_ * c.ldp);
                    c.s5ab = M.get(2048 * 2); c.s5bbr = M.get(2048 * 16); c.s5bbi = M.get(2048 * 16); c.s5st = M.get(2 * 2048 * 2);
                    c.s5x = M.get((size_t)nv::B_ * nv::SLAB * 2048 * 2); c.s5g = M.get((size_t)T_ * 512);
                    c.gla_la = M.get((size_t)T_ * 256); c.gla_bc = M.get((size_t)T_ * 256); c.gla_bl = M.get((size_t)nv::B_ * NCH * 256);
                    c.gu = M.get((size_t)8 * NCH * 8192); c.gatt = M.get((size_t)8 * NCH * 4096); c.go = M.get((size_t)T_ * 512);
                }
                c.z = c.proj; c.hout = a.out; c.lnw = a.in[1] + layer * 1024; c.lnb = a.in[2] + layer * 1024;
                M.off = scratch0; c.hid = M.get((size_t)T_ * 9 * 256);
                nv::Ctx& cm = ctab[layer * 2 + 1];
                cm = c; cm.hcur = a.out;
#ifdef DBG_LAYER
                if (layer == DBG_LAYER) { nv::Ctx& cd = ctab[4]; cd = cm;
                cd.hid = (float*)(a.ws + 48 * MiB); cd.z = (float*)(a.ws + 486 * MiB); cd.hcur = a.out + (size_t)DBG_T0 * 1024; cd.ridx = c.ridx + (size_t)DBG_T0 * 8; cd.rwt = c.rwt + (size_t)DBG_T0 * 8; }
#endif
            }
        }
        __syncthreads();
    }
    phase_p0(lds_raw);
    layer_body<0>(lds_raw);
    layer_body<1>(lds_raw);
}
extern "C" void kernel_launch(void* const* d_in, const int* in_sizes, int n_in, void* d_out, int out_size, void* d_ws, size_t ws_size, hipStream_t stream) {
    static int grid = 0;
    if (grid == 0) {
        int dev = 0, cus = 0, per_cu = 0;
        hipGetDevice(&dev); hipDeviceGetAttribute(&cus, hipDeviceAttributeMultiprocessorCount, dev);
        hipFuncSetAttribute((const void*)mega_fwd, hipFuncAttributeMaxDynamicSharedMemorySize, LDS_BYTES);
        hipOccupancyMaxActiveBlocksPerMultiprocessor(&per_cu, (const void*)mega_fwd, NTHREADS, LDS_BYTES);
        (void)hipGetLastError();
        grid = (per_cu >= 1) ? cus : -1;
    }
    if (grid < 0) return;
    hipMemsetAsync(d_ws, 0, CTL_BYTES, stream);
    Args a{};
    for (int i = 0; i < 38; ++i) a.in[i] = (const float*)d_in[i];
    a.out = (float*)d_out; a.ws = (unsigned char*)d_ws;
    hipLaunchKernelGGL(mega_fwd, dim3(grid), dim3(NTHREADS), LDS_BYTES, stream, a);
}
```

```cpp
#define OPT_MIX0 1
#include <hip/hip_runtime.h>
#ifdef CPU_TEST
#include <cmath>
#include <cstddef>
#define HD inline
#define HDF inline
#else
#define HD __device__ __forceinline__
#define HDF __host__ __device__ __forceinline__
#endif

#ifndef SEQ_
#define SEQ_ 8192
#endif
namespace nv {
constexpr int B_ = 2, S_ = SEQ_, T_ = B_ * S_, D_ = 1024, NCH = S_ / 64;
constexpr int EIN = 3080, OIN = 2064;
constexpr int SLAB = (S_ < 1024 ? S_ : 1024);
constexpr float ALPHA = 1.41421356237309515f, EPS = 1e-5f;

enum Stage { ST_GEMM, ST_ML_GATES, ST_ML_CLOC, ST_ML_SCAN, ST_ML_MI, ST_ML_SMAT, ST_ML_DEN, ST_ML_H, ST_ML_NORM,
             ST_LRU_CONV, ST_LRU_GATE, ST_LRU_SCAN, ST_LN, ST_SCORES, ST_SELECT, ST_HID, ST_FFN,
             ST_S5_PAR, ST_S5_SCAN, ST_S5_OUT, ST_S5_GLU, ST_GLA_GATE, ST_GLA_CUM, ST_GLA_U, ST_GLA_SCAN, ST_GLA_ATT, ST_GLA_O, ST_GLA_NORM };

struct Ctx {
    const float* in[38];
    const float* gA; const float* gW; const float* gR; float* gC; const float* gBias;
    const float* hcur;
    float* hout;
    const float* lnw; const float* lnb;
    float* proj; float* mixed; float* z;
    float* mb; float* mig; float* mblast; float* mmloc; float* mmprev; float* cloc; float* nloc; float* smat; float* mmi; float* mwin; float* mden; float* htil;
    float* lxc; float* la; float* lu;
    float* scores; int* ridx; float* rwt; float* hid;
    float* s5ab; float* s5bbr; float* s5bbi; float* s5st; float* s5x; float* s5g;
    float* gla_la; float* gla_bc; float* gla_bl; float* gu; float* gatt; float* go;
    long gM, gN, gK, glda, gldw, gldc, gldr;
    long ldp;
    float gralpha; int layer; int slab; int pad0;
};

HD float sigm(float x) { return 1.0f / (1.0f + expf(-x)); }
HD float logsig(float x) { return fminf(x, 0.f) - log1pf(expf(-fabsf(x))); }
HD float softplus(float x) { return fmaxf(x, 0.f) + log1pf(expf(-fabsf(x))); }
HD float silu(float x) { return x * sigm(x); }
HD float gelu_t(float x) { return 0.5f * x * (1.0f + tanhf(0.7978845608028654f * (x + 0.044715f * x * x * x))); }

template <int ST> HD void item(const Ctx& c, long idx);

template <> HD void item<ST_GEMM>(const Ctx& c, long idx) {
    const long m = idx / c.gN, n = idx % c.gN;
    float acc = 0.f;
    const float* a = c.gA + m * c.glda; const float* w = c.gW + n;
    for (long k = 0; k < c.gK; ++k) acc += a[k] * w[k * c.gldw];
    if (c.gBias) acc += c.gBias[n];
    if (c.gR) acc += c.gralpha * c.gR[m * c.gldr + n];
    c.gC[m * c.gldc + n] = acc;
}
template <> HD void item<ST_ML_GATES>(const Ctx& c, long idx) {
    const int bh = (int)(idx / NCH), n = (int)(idx % NCH), b = bh / 4, h = bh % 4;
    const float* gb = c.in[7];
    const long t0 = (long)b * S_ + n * 64; const long o0 = (long)bh * S_ + n * 64;
    float acc = 0.f;
    for (int l = 0; l < 64; ++l) {
        const float f = c.proj[(t0 + l) * c.ldp + 2052 + h] + gb[4 + h];
        acc += logsig(f);
        c.mb[o0 + l] = acc;
        c.mig[o0 + l] = c.proj[(t0 + l) * c.ldp + 2048 + h] + gb[h];
    }
    c.mblast[idx] = acc;
    float ml = -INFINITY;
    for (int l = 0; l < 64; ++l) ml = fmaxf(ml, acc - c.mb[o0 + l] + c.mig[o0 + l]);
    c.mmloc[idx] = ml;
}
template <> HD void item<ST_ML_CLOC>(const Ctx& c, long idx) {
    const int e = (int)(idx % 128), d = (int)((idx / 128) % 128); const long cn = idx / 16384;
    const int bh = (int)(cn / NCH), n = (int)(cn % NCH), b = bh / 4, h = bh % 4;
    const long t0 = (long)b * S_ + n * 64; const long o0 = (long)bh * S_ + n * 64;
    const float bl = c.mblast[cn], ml = c.mmloc[cn]; const float sc = 0.08838834764831845f;
    float acc = 0.f, accn = 0.f;
    for (int l = 0; l < 64; ++l) {
        const float p = expf(bl - c.mb[o0 + l] + c.mig[o0 + l] - ml);
        const float kk = c.proj[(t0 + l) * c.ldp + 512 + h * 128 + d] * sc;
        acc += p * kk * c.proj[(t0 + l) * c.ldp + 1024 + h * 128 + e];
        accn += p * kk;
    }
    c.cloc[idx] = acc;
    if (e == 0) c.nloc[cn * 128 + d] = accn;
}
template <> HD void item<ST_ML_SCAN>(const Ctx& c, long idx) {
    const bool isn = idx >= 8L * 16384;
    long bh, de; float* buf; long stride;
    if (!isn) { bh = idx / 16384; de = idx % 16384; buf = c.cloc; stride = 16384; }
    else { const long r = idx - 8L * 16384; bh = r / 128; de = r % 128; buf = c.nloc; stride = 128; }
    float st = 0.f, m = 0.f;
    for (int n = 0; n < NCH; ++n) {
        const long cn = bh * NCH + n;
        const float cl = buf[cn * stride + de]; buf[cn * stride + de] = st;
        const float bl = c.mblast[cn], ml = c.mmloc[cn];
        const float mn = fmaxf(bl + m, ml);
        st = expf(bl + m - mn) * st + expf(ml - mn) * cl;
        if (!isn && de == 0) c.mmprev[cn] = m;
        m = mn;
    }
}
template <> HD void item<ST_ML_MI>(const Ctx& c, long idx) {
    const long bh = idx / S_; const int s = (int)(idx % S_), n = s / 64, i = s % 64; const long cn = bh * NCH + n;
    const long o0 = bh * S_ + n * 64;
    const float bi = c.mb[idx]; const float minter = bi + c.mmprev[cn];
    float dmax = -INFINITY;
    for (int j = 0; j <= i; ++j) dmax = fmaxf(dmax, bi - c.mb[o0 + j] + c.mig[o0 + j]);
    const float mi = fmaxf(minter, dmax);
    c.mmi[idx] = mi; c.mwin[idx] = expf(minter - mi);
}
template <> HD void item<ST_ML_SMAT>(const Ctx& c, long idx) {
    const int j = (int)(idx % 64), i = (int)((idx / 64) % 64); const long cn = idx / 4096;
    const int bh = (int)(cn / NCH), n = (int)(cn % NCH), b = bh / 4, h = bh % 4;
    if (j > i) { c.smat[idx] = 0.f; return; }
    const long t0 = (long)b * S_ + n * 64; const long o0 = (long)bh * S_ + n * 64;
    const float* q = c.proj + (t0 + i) * c.ldp + h * 128; const float* k = c.proj + (t0 + j) * c.ldp + 512 + h * 128;
    float dot = 0.f;
    for (int d = 0; d < 128; ++d) dot += q[d] * k[d];
    dot *= 0.08838834764831845f;
    c.smat[idx] = dot * expf(c.mb[o0 + i] - c.mb[o0 + j] + c.mig[o0 + j] - c.mmi[o0 + i]);
}
template <> HD void item<ST_ML_DEN>(const Ctx& c, long idx) {
    const long bh = idx / S_; const int s = (int)(idx % S_), n = s / 64, i = s % 64; const long cn = bh * NCH + n;
    const int b = (int)(bh / 4), h = (int)(bh % 4);
    float den = 0.f;
    for (int j = 0; j <= i; ++j) den += c.smat[cn * 4096 + i * 64 + j];
    const float* q = c.proj + ((long)b * S_ + s) * c.ldp + h * 128;
    float qn = 0.f;
    for (int d = 0; d < 128; ++d) qn += q[d] * c.nloc[cn * 128 + d];
    den += c.mwin[idx] * qn;
    c.mden[idx] = fmaxf(fabsf(den), expf(-c.mmi[idx]));
}
template <> HD void item<ST_ML_H>(const Ctx& c, long idx) {
    const int e = (int)(idx % 128); const long bs = idx / 128; const long bh = bs / S_; const int s = (int)(bs % S_), n = s / 64, i = s % 64;
    const long cn = bh * NCH + n; const int b = (int)(bh / 4), h = (int)(bh % 4);
    const long t0 = (long)b * S_ + n * 64;
    float num = 0.f;
    for (int j = 0; j <= i; ++j) num += c.smat[cn * 4096 + i * 64 + j] * c.proj[(t0 + j) * c.ldp + 1024 + h * 128 + e];
    const float* q = c.proj + (t0 + i) * c.ldp + h * 128;
    float qc = 0.f;
    for (int d = 0; d < 128; ++d) qc += q[d] * c.cloc[cn * 16384 + d * 128 + e];
    num += c.mwin[bs] * qc;
    c.htil[(t0 + i) * 512 + h * 128 + e] = num / c.mden[bs];
}
template <> HD void item<ST_ML_NORM>(const Ctx& c, long idx) {
    const long bh = idx / S_; const int s = (int)(idx % S_); const int b = (int)(bh / 4), h = (int)(bh % 4);
    const long t = (long)b * S_ + s;
    const float* ht = c.htil + t * 512 + h * 128; const float* nw = c.in[8];
    float mean = 0.f;
    for (int e = 0; e < 128; ++e) mean += ht[e];
    mean *= (1.f / 128.f);
    float var = 0.f;
    for (int e = 0; e < 128; ++e) { const float d = ht[e] - mean; var += d * d; }
    const float rstd = 1.0f / sqrtf(var * (1.f / 128.f) + EPS);
    for (int e = 0; e < 128; ++e)
        c.mixed[t * 1024 + h * 128 + e] = (ht[e] - mean) * rstd * nw[h * 128 + e] * sigm(c.proj[t * c.ldp + 1536 + h * 128 + e]);
}
template <> HD void item<ST_LRU_CONV>(const Ctx& c, long idx) {
    const long t = idx / 512; const int ch = (int)(idx % 512); const int s = (int)(t % S_);
    const float* cw = c.in[9];
    float acc = c.in[10][ch];
    for (int j = 0; j < 4; ++j) { const int ss = s - 3 + j; if (ss >= 0) acc += cw[j * 512 + ch] * c.proj[(t - 3 + j) * c.ldp + 2056 + ch]; }
    c.lxc[idx] = acc;
}
template <> HD void item<ST_LRU_GATE>(const Ctx& c, long idx) {
    const long t = idx / 512; const int ch = (int)(idx % 512), hh = ch / 128, jj = ch % 128;
    const float* wa = c.in[11] + (long)hh * 16384; const float* wx = c.in[13] + (long)hh * 16384;
    const float* xr = c.lxc + t * 512 + hh * 128;
    float ra = c.in[12][ch], xa = c.in[14][ch];
    for (int i = 0; i < 128; ++i) { ra += xr[i] * wa[i * 128 + jj]; xa += xr[i] * wx[i * 128 + jj]; }
    const float r = sigm(ra), ii = sigm(xa);
    const float la = -8.0f * r * softplus(-c.in[15][ch]);
    c.la[idx] = expf(la);
    c.lu[idx] = sqrtf(-expm1f(2.0f * la)) * ii * c.lxc[idx];
}
template <> HD void item<ST_LRU_SCAN>(const Ctx& c, long idx) {
    const int b = (int)(idx / 512), ch = (int)(idx % 512);
    float h = 0.f;
    for (int s = 0; s < S_; ++s) {
        const long t = (long)b * S_ + s;
        h = c.la[t * 512 + ch] * h + c.lu[t * 512 + ch];
        c.mixed[t * 1024 + 512 + ch] = h * gelu_t(c.proj[t * c.ldp + 2568 + ch]);
    }
}
template <> HD void item<ST_LN>(const Ctx& c, long t) {
    const float* zr = c.z + t * 1024;
    float mean = 0.f;
    for (int i = 0; i < 1024; ++i) mean += zr[i];
    mean *= (1.f / 1024.f);
    float var = 0.f;
    for (int i = 0; i < 1024; ++i) { const float d = zr[i] - mean; var += d * d; }
    const float rstd = 1.0f / sqrtf(var * (1.f / 1024.f) + EPS);
    for (int i = 0; i < 1024; ++i) c.hout[t * 1024 + i] = (zr[i] - mean) * rstd * c.lnw[i] + c.lnb[i];
}
template <> HD void item<ST_SCORES>(const Ctx& c, long idx) {
    const long t = idx / 64; const int e = (int)(idx % 64);
    const float* rw = c.in[30] + (long)c.layer * 1024 * 64; const float* hr = c.hcur + t * 1024;
    float acc = 0.f;
    for (int k = 0; k < 1024; ++k) acc += hr[k] * rw[k * 64 + e];
    c.scores[idx] = sigm(acc);
}
template <> HD void item<ST_SELECT>(const Ctx& c, long t) {
    const float* sc = c.scores + t * 64; const float* bias = c.in[31] + c.layer * 64;
    float gs[8];
#pragma unroll
    for (int g = 0; g < 8; ++g) {
        float m1 = -INFINITY, m2 = -INFINITY;
        for (int j = 0; j < 8; ++j) { const float v = sc[g * 8 + j] + bias[g * 8 + j]; if (v > m1) { m2 = m1; m1 = v; } else if (v > m2) m2 = v; }
        gs[g] = m1 + m2;
    }
    unsigned gsel = 0;
    for (int it = 0; it < 4; ++it) {
        float best = -INFINITY; int bi = 0;
#pragma unroll
        for (int g = 0; g < 8; ++g) { const bool ok = !((gsel >> g) & 1u) && gs[g] > best; best = ok ? gs[g] : best; bi = ok ? g : bi; }
        gsel |= 1u << bi;
    }
    unsigned long long taken = 0ull; float wsum = 0.f;
    for (int it = 0; it < 8; ++it) {
        float best = -INFINITY; int bi = 0;
        for (int e = 0; e < 64; ++e) {
            if (!((gsel >> (e >> 3)) & 1u) || ((taken >> e) & 1ull)) continue;
            const float v = sc[e] + bias[e];
            if (v > best) { best = v; bi = e; }
        }
        taken |= 1ull << bi;
        c.ridx[t * 8 + it] = bi; const float w = sc[bi]; c.rwt[t * 8 + it] = w; wsum += w;
    }
    const float inv = 2.5f / wsum;
    for (int it = 0; it < 8; ++it) c.rwt[t * 8 + it] *= inv;
}
template <> HD void item<ST_HID>(const Ctx& c, long idx) {
    const int j = (int)(idx % 256), k = (int)((idx / 256) % 9); const long t = idx / 2304;
    const float *wg, *wu;
    if (k < 8) { const long e = (long)c.layer * 64 + c.ridx[t * 8 + k]; wg = c.in[32] + e * 262144; wu = c.in[33] + e * 262144; }
    else { wg = c.in[35] + (long)c.layer * 262144; wu = c.in[36] + (long)c.layer * 262144; }
    const float* hr = c.hcur + t * 1024;
    float g = 0.f, u = 0.f;
    for (int d = 0; d < 1024; ++d) { const float x = hr[d]; g += x * wg[d * 256 + j]; u += x * wu[d * 256 + j]; }
    c.hid[idx] = silu(g) * u;
}
template <> HD void item<ST_FFN>(const Ctx& c, long idx) {
    const long t = idx / 1024; const int n = (int)(idx % 1024);
    float tot = 0.f;
    for (int k = 0; k < 9; ++k) {
        const float* wd; float w;
        if (k < 8) { const long e = (long)c.layer * 64 + c.ridx[t * 8 + k]; wd = c.in[34] + e * 262144; w = c.rwt[t * 8 + k]; }
        else { wd = c.in[37] + (long)c.layer * 262144; w = 1.f; }
        const float* hr = c.hid + (t * 9 + k) * 256;
        float acc = 0.f;
        for (int j = 0; j < 256; ++j) acc += hr[j] * wd[j * 1024 + n];
        tot += w * acc;
    }
    c.z[idx] = ALPHA * c.hcur[idx] + tot;
}
template <> HD void item<ST_S5_PAR>(const Ctx& c, long idx) {
    const int g = (int)(idx / 64);
    const float lr = c.in[17][idx], li = c.in[18][idx]; const float dt = expf(c.in[24][g]);
    const float mag = expf(lr * dt); const float ar = mag * cosf(li * dt), ai = mag * sinf(li * dt);
    const float den = lr * lr + li * li, nr = ar - 1.0f;
    const float cr = (nr * lr + ai * li) / den, ci = (ai * lr - nr * li) / den;
    c.s5ab[idx * 2] = ar; c.s5ab[idx * 2 + 1] = ai;
    for (int h = 0; h < 16; ++h) {
        const float br = c.in[19][idx * 16 + h], bi = c.in[20][idx * 16 + h];
        c.s5bbr[idx * 16 + h] = cr * br - ci * bi; c.s5bbi[idx * 16 + h] = cr * bi + ci * br;
    }
}
template <> HD void item<ST_S5_SCAN>(const Ctx& c, long idx) {
    const int gp = (int)(idx % 2048), g = gp / 64, b = (int)(idx / 2048);
    const float ar = c.s5ab[gp * 2], ai = c.s5ab[gp * 2 + 1];
    float xr = 0.f, xi = 0.f;
    if (c.slab > 0) { xr = c.s5st[idx * 2]; xi = c.s5st[idx * 2 + 1]; }
    for (int sl = 0; sl < SLAB; ++sl) {
        const long t = (long)b * S_ + (long)c.slab * SLAB + sl;
        const float* u = c.proj + t * c.ldp + g * 16;
        float br = 0.f, bi = 0.f;
        for (int h = 0; h < 16; ++h) { br += u[h] * c.s5bbr[gp * 16 + h]; bi += u[h] * c.s5bbi[gp * 16 + h]; }
        const float nr = ar * xr - ai * xi + br, ni = ar * xi + ai * xr + bi;
        xr = nr; xi = ni;
        const long o = (((long)b * SLAB + sl) * 2048 + gp) * 2;
        c.s5x[o] = xr; c.s5x[o + 1] = xi;
    }
    c.s5st[idx * 2] = xr; c.s5st[idx * 2 + 1] = xi;
}
template <> HD void item<ST_S5_OUT>(const Ctx& c, long idx) {
    const int ch = (int)(idx % 512), g = ch / 16; const long bs = idx / 512; const int b = (int)(bs / SLAB), sl = (int)(bs % SLAB);
    const long t = (long)b * S_ + (long)c.slab * SLAB + sl;
    const float* x = c.s5x + (bs * 2048 + g * 64) * 2; const float* cre = c.in[21] + ch * 64; const float* cim = c.in[22] + ch * 64;
    float y = 0.f;
    for (int p = 0; p < 64; ++p) y += x[2 * p] * cre[p] - x[2 * p + 1] * cim[p];
    y += c.in[23][ch] * c.proj[t * c.ldp + ch];
    c.s5g[t * 512 + ch] = gelu_t(y);
}
template <> HD void item<ST_S5_GLU>(const Ctx& c, long idx) {
    const long t = idx / 512; const int n = (int)(idx % 512);
    const float* gr = c.s5g + t * 512; const float* w = c.in[25];
    float acc = c.in[26][n];
    for (int k = 0; k < 512; ++k) acc += gr[k] * w[k * 512 + n];
    c.mixed[t * 1024 + n] = gr[n] * sigm(acc);
}
template <> HD void item<ST_GLA_GATE>(const Ctx& c, long idx) {
    const long t = idx / 256; const int ch = (int)(idx % 256);
    float acc = c.in[28][ch];
    for (int r = 0; r < 16; ++r) acc += c.proj[t * c.ldp + 2048 + r] * c.in[27][r * 256 + ch];
    c.gla_la[idx] = logsig(acc) * (1.0f / 16.0f);
}
template <> HD void item<ST_GLA_CUM>(const Ctx& c, long idx) {
    const int ch = (int)(idx % 256); const long bn = idx / 256; const int b = (int)(bn / NCH), n = (int)(bn % NCH);
    const long t0 = (long)b * S_ + n * 64;
    float acc = 0.f;
    for (int l = 0; l < 64; ++l) { acc += c.gla_la[(t0 + l) * 256 + ch]; c.gla_bc[(t0 + l) * 256 + ch] = acc; }
    c.gla_bl[idx] = acc;
}
template <> HD void item<ST_GLA_U>(const Ctx& c, long idx) {
    const int e = (int)(idx % 128), d = (int)((idx / 128) % 64); const long cn = idx / 8192;
    const int bh = (int)(cn / NCH), n = (int)(cn % NCH), b = bh / 4, h = bh % 4;
    const long t0 = (long)b * S_ + n * 64;
    const float bl = c.gla_bl[((long)b * NCH + n) * 256 + h * 64 + d];
    float acc = 0.f;
    for (int l = 0; l < 64; ++l)
        acc += c.proj[(t0 + l) * c.ldp + 768 + h * 64 + d] * expf(bl - c.gla_bc[(t0 + l) * 256 + h * 64 + d]) * c.proj[(t0 + l) * c.ldp + 1024 + h * 128 + e];
    c.gu[idx] = acc;
}
template <> HD void item<ST_GLA_SCAN>(const Ctx& c, long idx) {
    const long bh = idx / 8192; const int de = (int)(idx % 8192), d = de / 128; const int b = (int)(bh / 4), h = (int)(bh % 4);
    float st = 0.f;
    for (int n = 0; n < NCH; ++n) {
        const long cn = bh * NCH + n;
        const float u = c.gu[cn * 8192 + de]; c.gu[cn * 8192 + de] = st;
        st = expf(c.gla_bl[((long)b * NCH + n) * 256 + h * 64 + d]) * st + u;
    }
}
template <> HD void item<ST_GLA_ATT>(const Ctx& c, long idx) {
    const int j = (int)(idx % 64), i = (int)((idx / 64) % 64); const long cn = idx / 4096;
    const int bh = (int)(cn / NCH), n = (int)(cn % NCH), b = bh / 4, h = bh % 4;
    if (j > i) { c.gatt[idx] = 0.f; return; }
    const long ti = (long)b * S_ + n * 64 + i, tj = (long)b * S_ + n * 64 + j;
    float acc = 0.f;
    for (int d = 0; d < 64; ++d)
        acc += c.proj[ti * c.ldp + 512 + h * 64 + d] * 0.125f * expf(c.gla_bc[ti * 256 + h * 64 + d] - c.gla_bc[tj * 256 + h * 64 + d]) * c.proj[tj * c.ldp + 768 + h * 64 + d];
    c.gatt[idx] = acc;
}
template <> HD void item<ST_GLA_O>(const Ctx& c, long idx) {
    const int e = (int)(idx % 128); const long bs = idx / 128; const long bh = bs / S_; const int s = (int)(bs % S_), n = s / 64, i = s % 64;
    const long cn = bh * NCH + n; const int b = (int)(bh / 4), h = (int)(bh % 4);
    const long t0 = (long)b * S_ + n * 64, t = t0 + i;
    float acc = 0.f;
    for (int j = 0; j <= i; ++j) acc += c.gatt[cn * 4096 + i * 64 + j] * c.proj[(t0 + j) * c.ldp + 1024 + h * 128 + e];
    for (int d = 0; d < 64; ++d)
        acc += c.proj[t * c.ldp + 512 + h * 64 + d] * 0.125f * expf(c.gla_bc[t * 256 + h * 64 + d]) * c.gu[cn * 8192 + d * 128 + e];
    c.go[t * 512 + h * 128 + e] = acc;
}
template <> HD void item<ST_GLA_NORM>(const Ctx& c, long idx) {
    const long bh = idx / S_; const int s = (int)(idx % S_); const int b = (int)(bh / 4), h = (int)(bh % 4);
    const long t = (long)b * S_ + s;
    const float* o = c.go + t * 512 + h * 128;
    float ms = 0.f;
    for (int e = 0; e < 128; ++e) ms += o[e] * o[e];
    const float rstd = 1.0f / sqrtf(ms * (1.f / 128.f) + EPS);
    for (int e = 0; e < 128; ++e)
        c.mixed[t * 1024 + 512 + h * 128 + e] = o[e] * rstd * c.in[29][h * 128 + e] * silu(c.proj[t * c.ldp + 1536 + h * 128 + e]);
}

struct Mem { float* base; size_t off; HDF float* get(size_t n) { float* p = base + off; off += (n + 63) & ~(size_t)63; return p; } };

template <class Runner> HDF void forward(Runner& R, void* const* d_in, float* d_out, float* ws) {
    Ctx c{};
    for (int i = 0; i < 38; ++i) c.in[i] = (const float*)d_in[i];
    Mem M{ws, 0};
    c.z = M.get((size_t)T_ * 1024); c.mixed = M.get((size_t)T_ * 1024); c.scores = M.get((size_t)T_ * 64);
    c.ridx = (int*)M.get((size_t)T_ * 8); c.rwt = M.get((size_t)T_ * 8);
    const size_t scratch0 = M.off;
    for (int layer = 0; layer < 2; ++layer) {
        c.layer = layer;
        c.hcur = layer == 0 ? c.in[0] : d_out;
        M.off = scratch0;
        if (layer == 0) {
            c.ldp = EIN; c.proj = M.get((size_t)T_ * c.ldp);
            c.mb = M.get(8 * S_); c.mig = M.get(8 * S_); c.mblast = M.get(8 * NCH); c.mmloc = M.get(8 * NCH); c.mmprev = M.get(8 * NCH);
            c.mmi = M.get(8 * S_); c.mwin = M.get(8 * S_); c.mden = M.get(8 * S_); c.nloc = M.get(8 * NCH * 128);
            const size_t ov = M.off;
            c.cloc = M.get((size_t)8 * NCH * 16384); c.smat = M.get((size_t)8 * NCH * 4096); c.htil = M.get((size_t)T_ * 512);
            M.off = ov; c.lxc = M.get((size_t)T_ * 512); c.la = M.get((size_t)T_ * 512); c.lu = M.get((size_t)T_ * 512);
            c.gA = c.hcur; c.glda = 1024; c.gW = c.in[6]; c.gldw = EIN; c.gC = c.proj; c.gldc = EIN; c.gR = nullptr; c.gBias = nullptr; c.gM = T_; c.gN = EIN; c.gK = 1024;
            R.template run<ST_GEMM>(c, (long)T_ * c.ldp);
            R.template run<ST_ML_GATES>(c, 8L * NCH);
            R.template run<ST_ML_CLOC>(c, 8L * NCH * 16384);
            R.template run<ST_ML_SCAN>(c, 8L * 16384 + 8 * 128);
            R.template run<ST_ML_MI>(c, 8L * S_);
            R.template run<ST_ML_SMAT>(c, 8L * NCH * 4096);
            R.template run<ST_ML_DEN>(c, 8L * S_);
            R.template run<ST_ML_H>(c, 8L * S_ * 128);
            R.template run<ST_ML_NORM>(c, 8L * S_);
            R.template run<ST_LRU_CONV>(c, (long)T_ * 512);
            R.template run<ST_LRU_GATE>(c, (long)T_ * 512);
            R.template run<ST_LRU_SCAN>(c, 2L * 512);
        } else {
            c.ldp = OIN; c.proj = M.get((size_t)T_ * c.ldp);
            c.s5ab = M.get(2048 * 2); c.s5bbr = M.get(2048 * 16); c.s5bbi = M.get(2048 * 16); c.s5st = M.get(2 * 2048 * 2);
            c.s5x = M.get((size_t)B_ * SLAB * 2048 * 2); c.s5g = M.get((size_t)T_ * 512);
            c.gla_la = M.get((size_t)T_ * 256); c.gla_bc = M.get((size_t)T_ * 256); c.gla_bl = M.get((size_t)B_ * NCH * 256);
            c.gu = M.get((size_t)8 * NCH * 8192); c.gatt = M.get((size_t)8 * NCH * 4096); c.go = M.get((size_t)T_ * 512);
            c.gA = c.hcur; c.glda = 1024; c.gW = c.in[16]; c.gldw = OIN; c.gC = c.proj; c.gldc = OIN; c.gR = nullptr; c.gBias = nullptr; c.gM = T_; c.gN = OIN; c.gK = 1024;
            R.template run<ST_GEMM>(c, (long)T_ * c.ldp);
            R.template run<ST_S5_PAR>(c, 2048);
            for (int sl = 0; sl < S_ / SLAB; ++sl) { c.slab = sl; R.template run<ST_S5_SCAN>(c, 2L * 2048); R.template run<ST_S5_OUT>(c, (long)B_ * SLAB * 512); }
            c.slab = 0;
            R.template run<ST_S5_GLU>(c, (long)T_ * 512);
            R.template run<ST_GLA_GATE>(c, (long)T_ * 256);
            R.template run<ST_GLA_CUM>(c, (long)B_ * NCH * 256);
            R.template run<ST_GLA_U>(c, 8L * NCH * 8192);
            R.template run<ST_GLA_SCAN>(c, 8L * 8192);
            R.template run<ST_GLA_ATT>(c, 8L * NCH * 4096);
            R.template run<ST_GLA_O>(c, 8L * S_ * 128);
            R.template run<ST_GLA_NORM>(c, 8L * S_);
        }
        c.gA = c.mixed; c.glda = 1024; c.gW = c.in[5] + (size_t)layer * 1024 * 1024; c.gldw = 1024; c.gC = c.z; c.gldc = 1024; c.gR = c.hcur; c.gldr = 1024; c.gralpha = ALPHA; c.gM = T_; c.gN = 1024; c.gK = 1024;
        R.template run<ST_GEMM>(c, (long)T_ * 1024);
        c.gR = nullptr;
        c.hout = d_out; c.lnw = c.in[1] + layer * 1024; c.lnb = c.in[2] + layer * 1024;
        R.template run<ST_LN>(c, T_);
        c.hcur = d_out;
        M.off = scratch0; c.hid = M.get((size_t)T_ * 9 * 256);
        R.template run<ST_SCORES>(c, (long)T_ * 64);
        R.template run<ST_SELECT>(c, T_);
        R.template run<ST_HID>(c, (long)T_ * 9 * 256);
        R.template run<ST_FFN>(c, (long)T_ * 1024);
        c.lnw = c.in[3] + layer * 1024; c.lnb = c.in[4] + layer * 1024;
        R.template run<ST_LN>(c, T_);
    }
}
}
#define GAS __attribute__((address_space(1)))
#define LAS __attribute__((address_space(3)))
#define XB_TMO      128
#define XB_XCNT(j)  (256  + 64 * (j))
#define XB_XSUB(j)  (1280 + 64 * (j))
#define XB_XGEN(j)  (2304 + 64 * (j))
#define XB_TOP      3328
#define XB_TOPGEN   3392
#define XCD_BAR_WORDS 3456
#define XB_SPIN_CAP (1u << 22)
__device__ __forceinline__ unsigned xb_ld(unsigned* p)              { return __hip_atomic_load(p, __ATOMIC_RELAXED, __HIP_MEMORY_SCOPE_AGENT); }
__device__ __forceinline__ unsigned xb_add(unsigned* p, unsigned v) { return __hip_atomic_fetch_add(p, v, __ATOMIC_RELAXED, __HIP_MEMORY_SCOPE_AGENT); }
__device__ __forceinline__ unsigned xb_xcc_id() { return (unsigned)__builtin_amdgcn_s_getreg((3 << 11) | 20) & 0xFu; }
#define XB_SPIN(cond, bar) do { unsigned _sp = 0; while (cond) { __builtin_amdgcn_s_sleep(1); \
    if ((++_sp & 255u) == 0u) { if (xb_ld(&(bar)[XB_TMO])) break; if (_sp > XB_SPIN_CAP) { atomicAdd(&(bar)[XB_TMO], 1u); break; } } } } while (0)
struct XcdBarrier { unsigned* bar; unsigned x; volatile LAS unsigned* st; };
__device__ __forceinline__ XcdBarrier xcd_barrier_post(unsigned* bar, volatile LAS unsigned* st) {
    XcdBarrier b; b.bar = bar; b.x = xb_xcc_id(); b.st = st;
    if (threadIdx.x == 0) (void)xb_add(&bar[XB_XCNT(b.x)], 1u);
    return b;
}
__device__ __forceinline__ void xcd_barrier_complete(unsigned* bar, unsigned x, unsigned& nloc, unsigned& nx) {
    const unsigned G = gridDim.x * gridDim.y * gridDim.z;
    unsigned sum, cnt, mine, sp = 0u;
    for (;;) {
        sum = 0u; cnt = 0u; mine = 0u;
#pragma unroll
        for (unsigned j = 0; j < 16; ++j) { const unsigned c = xb_ld(&bar[XB_XCNT(j)]); sum += c; cnt += (c > 0u) ? 1u : 0u; mine = (j == x) ? c : mine; }
        if (sum == G) break;
        __builtin_amdgcn_s_sleep(1);
        if ((++sp & 255u) == 0u) { if (xb_ld(&bar[XB_TMO])) break; if (sp > XB_SPIN_CAP) { atomicAdd(&bar[XB_TMO], 1u); break; } }
    }
    nloc = mine > 0u ? mine : 1u; nx = cnt > 0u ? cnt : 1u;
}
__device__ __forceinline__ void xcd_barrier(const XcdBarrier& b) {
    asm volatile("s_waitcnt vmcnt(0)" ::: "memory");
    __syncthreads();
    if (threadIdx.x == 0) {
        unsigned* bar = b.bar;
        __builtin_amdgcn_s_waitcnt(0);
        unsigned nloc = b.st[0], nx = b.st[1];
        if (nloc == 0u) { xcd_barrier_complete(bar, b.x, nloc, nx); b.st[0] = nloc; b.st[1] = nx; }
        const unsigned old = xb_add(&bar[XB_XSUB(b.x)], 1u);
        const unsigned gen = old / nloc;
        if (old + 1u == (gen + 1u) * nloc) {
            __builtin_amdgcn_fence(__ATOMIC_RELEASE, "agent");
            asm volatile("s_waitcnt vmcnt(0)" ::: "memory");
            const unsigned og = xb_add(&bar[XB_TOP], 1u);
            const unsigned tg = og / nx;
            if (og + 1u == (tg + 1u) * nx) xb_add(&bar[XB_TOPGEN], 1u);
            else XB_SPIN(xb_ld(&bar[XB_TOPGEN]) == tg, bar);
            __builtin_amdgcn_fence(__ATOMIC_ACQUIRE, "agent");
            xb_add(&bar[XB_XGEN(b.x)], 1u);
            asm volatile("s_waitcnt vmcnt(0)" ::: "memory");
        } else {
            XB_SPIN(xb_ld(&bar[XB_XGEN(b.x)]) == gen, bar);
            __builtin_amdgcn_fence(__ATOMIC_ACQUIRE, "agent");
            asm volatile("s_waitcnt vmcnt(0)" ::: "memory");
        }
    }
    __syncthreads();
}
namespace pg8 {
#define PG8_LAS __attribute__((address_space(3)))
typedef unsigned short bf16_t;
typedef short bf16x8 __attribute__((ext_vector_type(8)));
typedef float f32x4 __attribute__((ext_vector_type(4)));
typedef unsigned u32x4 __attribute__((ext_vector_type(4)));
constexpr int BM = 256, BK = 64, HALF = 128, HTB = HALF * BK * 2, STAGE_BYTES = 8 * HTB, NXCD = 8, WGM = 8;
__host__ __device__ __forceinline__ int lds_byte(int r, int c) { const int st = (r >> 4) * 2 + (c >> 5), rr = r & 15, cc = c & 31, ob = rr * 64 + cc * 2; return st * 1024 + (ob ^ (((ob >> 9) & 1) << 5)); }
__host__ __device__ __forceinline__ void stage_rc(int b, int& R, int& C) { const int st = b / 1024, sb = b % 1024, swz = sb ^ (((sb >> 9) & 1) << 5); R = (st >> 1) * 16 + swz / 64; C = (st & 1) * 32 + (swz % 64) / 2; }
__host__ __device__ __forceinline__ int perm32(int rho) { const int n = rho >> 4, i = rho & 15; return 8 * (i >> 2) + 4 * n + (i & 3); }
struct Unit { int pm, pn, e, aux; };
struct Gemm { const bf16_t* A; const bf16_t* Bt; int K; int pad; size_t bstride; const int* rows; };
struct StaticOrder {
    int nM, nN, nwg, G, c;
    __host__ __device__ void init(int M, int N, int G_, int c_) { nM = M / BM; nN = N / BM; nwg = nM * nN; G = G_; c = c_; }
    __host__ __device__ bool next(int i, Unit& u) const {
        const long L = (long)i * G + c; if (L >= nwg) return false;
        int wgid = (int)L; { const int q = nwg / NXCD, r = nwg % NXCD, xcd = wgid % NXCD, off = wgid / NXCD; wgid = (xcd < r ? xcd * (q + 1) : r * (q + 1) + (xcd - r) * q) + off; }
        const int nig = WGM * nN, gid = wgid / nig, fm = gid * WGM, gsz = (nM - fm) < WGM ? (nM - fm) : WGM;
        u.pm = fm + ((wgid % nig) % gsz); u.pn = (wgid % nig) / gsz; u.e = 0; u.aux = 0; return true;
    }
};
__device__ __forceinline__ unsigned cvt_pk_bf16(float lo, float hi) { unsigned r; asm volatile("v_cvt_pk_bf16_f32 %0, %1, %2" : "=v"(r) : "v"(lo), "v"(hi)); return r; }
struct EpiF32R {
    static constexpr bool PERM = false;
    float* C; int ldc; const float* R; float ralpha;
    __device__ __forceinline__ void operator()(const f32x4 (&acc)[2][2][4][2], const Unit& u, int wr, int wc, int fr, int fq) const {
        const int row0 = u.pm * BM + wr * 64 + fr, col0 = u.pn * BM + wc * 32 + 4 * fq;
#pragma unroll
        for (int ai = 0; ai < 2; ++ai)
#pragma unroll
            for (int m = 0; m < 4; ++m) { const size_t off = (size_t)(row0 + ai * HALF + m * 16) * ldc + col0;
#pragma unroll
                for (int bj = 0; bj < 2; ++bj)
#pragma unroll
                    for (int n = 0; n < 2; ++n) { f32x4 v = acc[ai][bj][m][n]; if (R) v = v + ralpha * *(const f32x4*)(R + off + bj * HALF + n * 16); *(f32x4*)(C + off + bj * HALF + n * 16) = v; } }
    }
};
struct EpiBf16P {
    static constexpr bool PERM = true;
    bf16_t* O; int ldc;
    __device__ __forceinline__ void operator()(const f32x4 (&acc)[2][2][4][2], const Unit& u, int wr, int wc, int fr, int fq) const {
        const int row0 = u.pm * BM + wr * 64 + fr, col0 = u.pn * BM + wc * 32 + 8 * fq;
#pragma unroll
        for (int ai = 0; ai < 2; ++ai)
#pragma unroll
            for (int m = 0; m < 4; ++m) { bf16_t* rowp = O + (size_t)(row0 + ai * HALF + m * 16) * ldc + col0;
#pragma unroll
                for (int bj = 0; bj < 2; ++bj) { const f32x4 v0 = acc[ai][bj][m][0], v1 = acc[ai][bj][m][1];
                    u32x4 w; w.x = cvt_pk_bf16(v0[0], v0[1]); w.y = cvt_pk_bf16(v0[2], v0[3]); w.z = cvt_pk_bf16(v1[0], v1[1]); w.w = cvt_pk_bf16(v1[2], v1[3]);
                    *(u32x4*)(rowp + bj * HALF) = w; } }
    }
};
template <class Epi, class Sched, bool ALIGN_EPI, bool GATHER>
__device__ __forceinline__ void gemm_phase(PG8_LAS unsigned char* lds, const Gemm g, const Sched& S, const Epi& E) {
    int tid_ = threadIdx.x; asm volatile("" : "+v"(tid_));
    const int tid = tid_, wid = __builtin_amdgcn_readfirstlane(tid >> 6), lane = tid & 63, wr = wid >> 2, wc = wid & 3, fr = lane & 15, fq = lane >> 4;
    const int K = g.K, nt = K / BK;
    unsigned voffA[2], voffB[2];
#pragma unroll
    for (int i = 0; i < 2; ++i) { int R, C; stage_rc(tid * 16 + i * 8192, R, C); const int Rb = Epi::PERM ? ((R & ~31) + perm32(R & 31)) : R;
        voffA[i] = (unsigned)(R * K + C) * 2u; voffB[i] = (unsigned)(Rb * K + C) * 2u; }
    const size_t kstep = (size_t)(BK * 2);
    const size_t hstep = (size_t)HALF * K * 2;
    const size_t tstep = 2 * hstep;
    const unsigned ldsw = (unsigned)wid * 1024u;
    const int aoff = lds_byte(wr * 64 + fr, fq * 8), boff = lds_byte(wc * 32 + fr, fq * 8);
#define PG8_SA(b, h) (((b) * 2 + (h)) * HTB)
#define PG8_SB(b, h) ((4 + (b) * 2 + (h)) * HTB)
#define PG8_STAGE(bufoff, gbase, voff) do { _Pragma("unroll") for (int _i = 0; _i < 2; ++_i) { unsigned _vo = (voff)[_i]; asm volatile("" : "+v"(_vo));   \
        __builtin_amdgcn_global_load_lds((const unsigned*)((const char*)(gbase) + _vo), (PG8_LAS unsigned*)(lds + (bufoff) + ldsw + _i * 8192), 16, 0, 0); } } while (0)
#define PG8_STAGE_A(bufoff, gbase, h, GV) do { if constexpr (GATHER) { PG8_STAGE(bufoff, gbase, GV[h]); } else { PG8_STAGE(bufoff, (gbase) + (h) * hstep, voffA); } } while (0)
#define PG8_STAGE_A2(bufoff, gbase, h) do { if constexpr (GATHER) { unsigned _gv[2] = {last ? gnxt[h][0] : gcur[h][0], last ? gnxt[h][1] : gcur[h][1]}; PG8_STAGE(bufoff, gbase, _gv); } else { PG8_STAGE(bufoff, (gbase) + (h) * hstep, voffA); } } while (0)
#define PG8_LDA(dst, b, h) do { _Pragma("unroll") for (int m = 0; m < 4; ++m) _Pragma("unroll") for (int k = 0; k < 2; ++k) dst[m][k] = *(const PG8_LAS bf16x8*)(lds + PG8_SA(b, h) + aoff + m * 2048 + k * 1024); } while (0)
#define PG8_LDB(dst, b, h) do { _Pragma("unroll") for (int n = 0; n < 2; ++n) _Pragma("unroll") for (int k = 0; k < 2; ++k) dst[n][k] = *(const PG8_LAS bf16x8*)(lds + PG8_SB(b, h) + boff + n * 2048 + k * 1024); } while (0)
#define PG8_MMA(ai, bj, At, Bt) do { __builtin_amdgcn_s_setprio(1); _Pragma("unroll") for (int m = 0; m < 4; ++m) _Pragma("unroll") for (int n = 0; n < 2; ++n) _Pragma("unroll") for (int k = 0; k < 2; ++k) \
        acc[ai][bj][m][n] = __builtin_amdgcn_mfma_f32_16x16x32_bf16(Bt[n][k], At[m][k], acc[ai][bj][m][n], 0, 0, 0); __builtin_amdgcn_s_setprio(0); } while (0)
#define PG8_WAIT_V(n) asm volatile("s_waitcnt vmcnt(" #n ")" ::: "memory")
#define PG8_WAIT_L(n) asm volatile("s_waitcnt lgkmcnt(" #n ")" ::: "memory")
#define PG8_BAR __builtin_amdgcn_s_barrier()
#define PG8_SCHED __builtin_amdgcn_sched_barrier(0)
#define PG8_GLOAD(GV, u) do { _Pragma("unroll") for (int _i = 0; _i < 2; ++_i) { int _R, _C; stage_rc(tid * 16 + _i * 8192, _R, _C); _Pragma("unroll") for (int _h = 0; _h < 2; ++_h) \
        GV[_h][_i] = (unsigned)g.rows[(u).pm * BM + _h * HALF + _R] * (unsigned)(K * 2) + (unsigned)(_C * 2); } } while (0)
    Unit cur, nxt; int ui = 0;
    if (!S.next(0, cur)) return;
    f32x4 acc[2][2][4][2];
#pragma unroll
    for (int a = 0; a < 2; ++a)
#pragma unroll
        for (int b = 0; b < 2; ++b)
#pragma unroll
            for (int m = 0; m < 4; ++m)
#pragma unroll
                for (int n = 0; n < 2; ++n) acc[a][b][m][n] = (f32x4){0.f, 0.f, 0.f, 0.f};
    bf16x8 At[4][2], B0[2][2], B1[2][2];
    unsigned gcur[2][2] = {{0u, 0u}, {0u, 0u}}, gnxt[2][2] = {{0u, 0u}, {0u, 0u}};
    if constexpr (GATHER) { PG8_GLOAD(gcur, cur); }
    const char* cA = GATHER ? (const char*)g.A : (const char*)g.A + (size_t)cur.pm * tstep;
    const char* cB = (const char*)g.Bt + ((size_t)cur.e * g.bstride) * 2 + (size_t)cur.pn * tstep;
    PG8_STAGE(PG8_SB(0, 0), cB, voffB); PG8_STAGE(PG8_SB(0, 1), cB + hstep, voffB); PG8_STAGE_A(PG8_SA(0, 0), cA, 0, gcur); PG8_STAGE_A(PG8_SA(0, 1), cA, 1, gcur);
    if (wr == 1) PG8_BAR;
    PG8_WAIT_V(2); PG8_BAR;
    PG8_STAGE(PG8_SB(1, 0), cB + kstep, voffB); PG8_STAGE_A(PG8_SA(1, 0), cA + kstep, 0, gcur); PG8_STAGE(PG8_SB(1, 1), cB + hstep + kstep, voffB);
    PG8_WAIT_V(6); PG8_BAR;
    for (;;) {
        const bool has_next = S.next(ui + 1, nxt);
        if constexpr (GATHER) { if (has_next) { PG8_GLOAD(gnxt, nxt); } else {
#pragma unroll
            for (int _h = 0; _h < 2; ++_h)
#pragma unroll
                for (int _i = 0; _i < 2; ++_i) gnxt[_h][_i] = gcur[_h][_i]; } }
        const char* nA = GATHER ? cA : (has_next ? (const char*)g.A + (size_t)nxt.pm * tstep : cA);
        const char* nB = has_next ? (const char*)g.Bt + ((size_t)nxt.e * g.bstride) * 2 + (size_t)nxt.pn * tstep : cB;
#pragma unroll 1
        for (int t = 0; t < nt; t += 2) {
            const bool last = (t == nt - 2);
            const char* a1 = cA + (size_t)(t + 1) * kstep;
            const char* a2 = last ? nA : cA + (size_t)(t + 2) * kstep; const char* b2 = last ? nB : cB + (size_t)(t + 2) * kstep;
            const char* a3 = a2 + kstep; const char* b3 = b2 + kstep;
            PG8_LDB(B0, 0, 0); PG8_LDB(B1, 0, 1); PG8_SCHED; PG8_LDA(At, 0, 0); PG8_STAGE_A(PG8_SA(1, 1), a1, 1, gcur);
            PG8_WAIT_V(8); PG8_WAIT_L(0); PG8_BAR; PG8_MMA(0, 0, At, B0); PG8_MMA(0, 1, At, B1); PG8_BAR; PG8_SCHED;
            PG8_LDA(At, 0, 1); PG8_STAGE(PG8_SB(0, 0), b2, voffB); PG8_STAGE(PG8_SB(0, 1), b2 + hstep, voffB); PG8_STAGE_A2(PG8_SA(0, 0), a2, 0);
            PG8_WAIT_V(8); PG8_WAIT_L(0); PG8_BAR; PG8_MMA(1, 0, At, B0); PG8_MMA(1, 1, At, B1); PG8_BAR; PG8_SCHED;
            PG8_LDB(B0, 1, 0); PG8_LDB(B1, 1, 1); PG8_SCHED; PG8_LDA(At, 1, 0); PG8_STAGE_A2(PG8_SA(0, 1), a2, 1);
            PG8_WAIT_V(8); PG8_WAIT_L(0); PG8_BAR; PG8_MMA(0, 0, At, B0); PG8_MMA(0, 1, At, B1); PG8_BAR; PG8_SCHED;
            PG8_LDA(At, 1, 1); PG8_STAGE(PG8_SB(1, 0), b3, voffB); PG8_STAGE(PG8_SB(1, 1), b3 + hstep, voffB); PG8_STAGE_A2(PG8_SA(1, 0), a3, 0);
            PG8_WAIT_V(8); PG8_WAIT_L(0); PG8_BAR; PG8_MMA(1, 0, At, B0); PG8_MMA(1, 1, At, B1); PG8_BAR; PG8_SCHED;
        }
        if constexpr (ALIGN_EPI) { if (wr == 0) PG8_BAR; }
        E(acc, cur, wr, wc, fr, fq);
        if (!has_next) break;
#pragma unroll
        for (int a = 0; a < 2; ++a)
#pragma unroll
            for (int b = 0; b < 2; ++b)
#pragma unroll
                for (int m = 0; m < 4; ++m)
#pragma unroll
                    for (int n = 0; n < 2; ++n) acc[a][b][m][n] = (f32x4){0.f, 0.f, 0.f, 0.f};
        cur = nxt; cA = nA; cB = nB; ++ui;
        if constexpr (GATHER) {
#pragma unroll
            for (int _h = 0; _h < 2; ++_h)
#pragma unroll
                for (int _i = 0; _i < 2; ++_i) gcur[_h][_i] = gnxt[_h][_i]; }
        if constexpr (ALIGN_EPI) { if (wr == 1) PG8_BAR; }
    }
    PG8_WAIT_V(0);
    if constexpr (!ALIGN_EPI) { if (wr == 0) PG8_BAR; }
    PG8_BAR;
#undef PG8_SA
#undef PG8_SB
#undef PG8_STAGE
#undef PG8_STAGE_A
#undef PG8_STAGE_A2
#undef PG8_LDA
#undef PG8_LDB
#undef PG8_MMA
#undef PG8_WAIT_V
#undef PG8_WAIT_L
#undef PG8_BAR
#undef PG8_SCHED
#undef PG8_GLOAD
}
}
typedef unsigned short bf16;
typedef unsigned v4u __attribute__((ext_vector_type(4)));
typedef unsigned v2u __attribute__((ext_vector_type(2)));
typedef float f32x4 __attribute__((ext_vector_type(4)));
constexpr int NTHREADS = 512, NWAVES = 8;
constexpr int LDS_BYTES = 147456;
constexpr int MISC_OFF = 131072 + 320;
constexpr size_t MiB = 1u << 20;
constexpr size_t CTL_BYTES = 1 * MiB;
constexpr int T_ = nv::T_, S_ = nv::S_, NCH = nv::NCH;
constexpr int EINP = 3328, OINP = 2304;
#define LDS_WAIT() asm volatile("s_waitcnt lgkmcnt(0)" ::: "memory")
__device__ __forceinline__ unsigned f2bf(float f) { unsigned u = __builtin_bit_cast(unsigned, f); return (u + 0x7fffu + ((u >> 16) & 1u)) >> 16; }
__device__ __forceinline__ unsigned pk2(float lo, float hi) { return f2bf(lo) | (f2bf(hi) << 16); }
__device__ __forceinline__ float bf2f(unsigned short b) { return __builtin_bit_cast(float, (unsigned)b << 16); }
__device__ __forceinline__ void tr_item(const float* W, long ldw, int nvalid, bf16* dst, long ldd, LAS float* scr, int lane) {
#pragma unroll 8
    for (int i = 0; i < 32; ++i) { const int kk = 2 * i + (lane >> 5), nn = lane & 31; scr[kk * 33 + nn] = nn < nvalid ? W[(long)kk * ldw + nn] : 0.f; }
    LDS_WAIT(); asm volatile("" ::: "memory");
    const int c = lane & 7;
#pragma unroll
    for (int j = 0; j < 4; ++j) { const int n = (lane >> 3) + 8 * j; const LAS float* s = scr + (8 * c) * 33 + n;
        v4u o; o.x = pk2(s[0 * 33], s[1 * 33]); o.y = pk2(s[2 * 33], s[3 * 33]); o.z = pk2(s[4 * 33], s[5 * 33]); o.w = pk2(s[6 * 33], s[7 * 33]);
        *(v4u*)(dst + (long)n * ldd + 8 * c) = o; }
    LDS_WAIT(); asm volatile("" ::: "memory");
}
__device__ __forceinline__ void tr_matrix(const float* W, int K, int N, int NP, bf16* WT, LAS float* scr, int gw, int NGW, int lane) {
    const int nblk = NP / 32, nitems = (K / 64) * nblk;
    for (int it = gw; it < nitems; it += NGW) { const int kb = it / nblk, nb = it % nblk, k0 = 64 * kb, n0 = 32 * nb; int nvalid = N - n0; nvalid = nvalid < 0 ? 0 : (nvalid > 32 ? 32 : nvalid);
        tr_item(W + (long)k0 * N + n0, N, nvalid, WT + (long)n0 * K + k0, K, scr, lane); }
}
__device__ __forceinline__ void cvt_rows(const float* src, bf16* dst, long n, long gtid, long gsz) {
    for (long i = gtid * 8; i < n; i += gsz * 8) { const f32x4 a = *(const f32x4*)(src + i), b = *(const f32x4*)(src + i + 4);
        v4u o; o.x = pk2(a.x, a.y); o.y = pk2(a.z, a.w); o.z = pk2(b.x, b.y); o.w = pk2(b.z, b.w); *(v4u*)(dst + i) = o; }
}
__device__ __forceinline__ int sopaque(int v) { asm volatile("" : "+s"(v)); return v; }
__device__ __forceinline__ float wave_sum(float v) {
#define WS_STEP(o) v += __builtin_bit_cast(float, __builtin_amdgcn_ds_swizzle(__builtin_bit_cast(int, v), 0x1f | ((o) << 10)))
    WS_STEP(1); WS_STEP(2); WS_STEP(4); WS_STEP(8); WS_STEP(16);
#undef WS_STEP
    return __builtin_bit_cast(float, __builtin_amdgcn_readlane(__builtin_bit_cast(int, v), 0)) + __builtin_bit_cast(float, __builtin_amdgcn_readlane(__builtin_bit_cast(int, v), 32));
}
#ifndef DBG_SCALE
#define DBG_SCALE 20.0f
#endif
constexpr int MOE_MAXBLK = 640;
constexpr int CW_CNT = 8192, CW_CUR = 8192 + 128;
namespace pg8 {
struct MoeOrder {
    const int* blk_e; int nblk, npn, G, c;
    __device__ __forceinline__ bool next(int i, Unit& u) const {
        const long L = (long)i * G + c; if (L >= (long)nblk * npn) return false;
        const int blk = (int)(L / npn); u.pm = blk; u.pn = (int)(L % npn); u.e = __builtin_amdgcn_readfirstlane(blk_e[blk]); u.aux = 0; return true;
    }
};
__device__ __forceinline__ float silu_f(float x) { return x / (1.0f + __expf(-x)); }
struct EpiSwiGLU {
    static constexpr bool PERM = true;
    bf16_t* H;
    __device__ __forceinline__ void operator()(const f32x4 (&acc)[2][2][4][2], const Unit& u, int wr, int wc, int fr, int fq) const {
        const int row0 = u.pm * BM + wr * 64 + fr, col0 = u.pn * 128 + wc * 32 + 8 * fq;
#pragma unroll
        for (int ai = 0; ai < 2; ++ai)
#pragma unroll
            for (int m = 0; m < 4; ++m) { bf16_t* rowp = H + (size_t)(row0 + ai * HALF + m * 16) * 256 + col0;
                const f32x4 g0 = acc[ai][0][m][0], g1 = acc[ai][0][m][1], u0 = acc[ai][1][m][0], u1 = acc[ai][1][m][1];
                u32x4 w; w.x = cvt_pk_bf16(silu_f(g0[0]) * u0[0], silu_f(g0[1]) * u0[1]); w.y = cvt_pk_bf16(silu_f(g0[2]) * u0[2], silu_f(g0[3]) * u0[3]);
                w.z = cvt_pk_bf16(silu_f(g1[0]) * u1[0], silu_f(g1[1]) * u1[1]); w.w = cvt_pk_bf16(silu_f(g1[2]) * u1[2], silu_f(g1[3]) * u1[3]);
                *(u32x4*)rowp = w; }
    }
};
struct EpiDown {
    static constexpr bool PERM = true;
    bf16_t* rows8; bf16_t* rows_sh; const int* dest; const float* w; int nslot8;
    __device__ __forceinline__ void operator()(const f32x4 (&acc)[2][2][4][2], const Unit& u, int wr, int wc, int fr, int fq) const {
        const int row0 = u.pm * BM + wr * 64 + fr, col0 = u.pn * BM + wc * 32 + 8 * fq;
#pragma unroll
        for (int ai = 0; ai < 2; ++ai)
#pragma unroll
            for (int m = 0; m < 4; ++m) { const int r = row0 + ai * HALF + m * 16; const int d = dest[r]; const float ww = w[r];
                if (d >= 0) { bf16_t* rowp = (d < nslot8 ? rows8 + (size_t)d * 1024 : rows_sh + (size_t)(d - nslot8) * 1024) + col0;
#pragma unroll
                    for (int bj = 0; bj < 2; ++bj) { const f32x4 v0 = acc[ai][bj][m][0] * ww, v1 = acc[ai][bj][m][1] * ww;
                        u32x4 o; o.x = cvt_pk_bf16(v0[0], v0[1]); o.y = cvt_pk_bf16(v0[2], v0[3]); o.z = cvt_pk_bf16(v1[0], v1[1]); o.w = cvt_pk_bf16(v1[2], v1[3]);
                        *(u32x4*)(rowp + bj * HALF) = o; } } }
    }
};
}
__device__ __forceinline__ void moe_convert_weights(const float* wg, const float* wu, const float* wd, const float* sg, const float* su, const float* sd,
                                                    bf16* WGU, bf16* WD, LAS float* scr, int gw, int NGW, int lane) {
    for (int it = gw; it < 65 * 384; it += NGW) {
        const int e = it / 384, r = it % 384, kind = r >> 7, q = r & 127;
        if (kind < 2) { const float* W = (e < 64 ? (kind == 0 ? wg : wu) + (size_t)e * 262144 : (kind == 0 ? sg : su));
            const int kb = q >> 3, nb = q & 7, k0 = 64 * kb, n0 = 32 * nb;
            tr_item(W + (size_t)k0 * 256 + n0, 256, 32, WGU + ((size_t)e * 512 + (n0 >> 7) * 256 + (n0 & 127) + kind * 128) * 1024 + k0, 1024, scr, lane);
        } else { const float* W = e < 64 ? wd + (size_t)e * 262144 : sd;
            const int kb = q >> 5, nb = q & 31, k0 = 64 * kb, n0 = 32 * nb;
            tr_item(W + (size_t)k0 * 1024 + n0, 1024, 32, WD + ((size_t)e * 1024 + n0) * 256 + k0, 256, scr, lane); }
    }
}
struct MoeLists { int* tok; int* dest; float* w; int* blk_e; };
__device__ __forceinline__ void moe_count(const int* ridx, unsigned* cnt, LAS unsigned* hist, int tid, int bid, int G) {
    if (tid < 64) hist[tid] = 0u;
    __syncthreads();
    for (int i = bid * NTHREADS + tid; i < T_ * 8; i += G * NTHREADS) atomicAdd((unsigned*)&hist[ridx[i]], 1u);
    __syncthreads();
    if (tid < 64 && hist[tid]) atomicAdd(&cnt[tid], hist[tid]);
    __syncthreads();
}
__device__ __forceinline__ void moe_build_lists(const int* ridx, const float* rwt, const unsigned* cnt, unsigned* cur, const MoeLists L, LAS int* sm, int tid, int bid, int G) {
    LAS int* pstart = sm; LAS unsigned* hist = (LAS unsigned*)(sm + 80); LAS unsigned* base = (LAS unsigned*)(sm + 160);
    if (tid == 0) { int acc = 0;
#pragma unroll 1
        for (int e = 0; e < 64; ++e) { pstart[e] = acc; acc += ((int)__hip_atomic_load(&cnt[e], __ATOMIC_RELAXED, __HIP_MEMORY_SCOPE_AGENT) + 255) & ~255; } pstart[64] = acc; pstart[65] = acc + T_; }
    __syncthreads();
    const int per = (T_ * 8 + G - 1) / G;
    const int lo = bid * per, hi = (lo + per < T_ * 8) ? lo + per : T_ * 8;
    for (int c0 = lo; c0 < hi; c0 += NTHREADS) {
        if (tid < 64) hist[tid] = 0u;
        __syncthreads();
        const int i = c0 + tid; int e = 0; unsigned local = 0u;
        if (i < hi) { e = ridx[i]; local = atomicAdd((unsigned*)&hist[e], 1u); }
        __syncthreads();
        if (tid < 64) base[tid] = hist[tid] ? atomicAdd(&cur[tid], hist[tid]) : 0u;
        __syncthreads();
        if (i < hi) { const int pos = pstart[e] + (int)base[e] + (int)local; L.tok[pos] = i >> 3; L.dest[pos] = i; L.w[pos] = rwt[i]; }
        __syncthreads();
    }
    for (int e = bid; e < 64; e += G) { const int c = (int)__hip_atomic_load(&cnt[e], __ATOMIC_RELAXED, __HIP_MEMORY_SCOPE_AGENT);
        for (int p = pstart[e] + c + tid; p < pstart[e + 1]; p += NTHREADS) { L.tok[p] = 0; L.dest[p] = -1; L.w[p] = 0.f; } }
    for (int t = bid * NTHREADS + tid; t < T_; t += G * NTHREADS) { const int p = pstart[64] + t; L.tok[p] = t; L.dest[p] = T_ * 8 + t; L.w[p] = 1.f; }
    const int nblk = pstart[65] >> 8;
    for (int b = bid * NTHREADS + tid; b < nblk; b += G * NTHREADS) { int e = 0;
#pragma unroll 1
        while (e < 64 && (pstart[e + 1] >> 8) <= b) ++e;
        L.blk_e[b] = e; }
    if (bid == 0 && tid == 0) L.blk_e[MOE_MAXBLK] = nblk;
    __syncthreads();
}
__device__ __forceinline__ void moe_combine_ln(float* h, const bf16* rows8, const bf16* rows_sh, const float* lw, const float* lb, bf16* hbf, int gw, int NGW, int lane, const float* zdbg = nullptr, int ntdbg = 0, int t0dbg = 0) {
    for (int t = gw; t < T_; t += NGW) {
        float v[16];
#pragma unroll
        for (int half = 0; half < 2; ++half) { const int c0 = half * 512 + lane * 8;
            const f32x4 a = *(const f32x4*)(h + (size_t)t * 1024 + c0), b = *(const f32x4*)(h + (size_t)t * 1024 + c0 + 4);
            float s[8] = {a.x * nv::ALPHA, a.y * nv::ALPHA, a.z * nv::ALPHA, a.w * nv::ALPHA, b.x * nv::ALPHA, b.y * nv::ALPHA, b.z * nv::ALPHA, b.w * nv::ALPHA};
#pragma unroll
            for (int k = 0; k < 9; ++k) { const bf16* rp = (k < 8 ? rows8 + ((size_t)t * 8 + k) * 1024 : rows_sh + (size_t)t * 1024) + c0;
                const v4u r = *(const v4u*)rp;
                s[0] += __builtin_bit_cast(float, r.x << 16); s[1] += __builtin_bit_cast(float, r.x & 0xffff0000u);
                s[2] += __builtin_bit_cast(float, r.y << 16); s[3] += __builtin_bit_cast(float, r.y & 0xffff0000u);
                s[4] += __builtin_bit_cast(float, r.z << 16); s[5] += __builtin_bit_cast(float, r.z & 0xffff0000u);
                s[6] += __builtin_bit_cast(float, r.w << 16); s[7] += __builtin_bit_cast(float, r.w & 0xffff0000u); }
#pragma unroll
            for (int j = 0; j < 8; ++j) v[half * 8 + j] = s[j]; }
        float dd[16];
#pragma unroll
        for (int j = 0; j < 16; ++j) dd[j] = 0.f;
        if (zdbg && t >= t0dbg && t < t0dbg + ntdbg) {
#pragma unroll
            for (int j = 0; j < 16; ++j) { const float zz = zdbg[(size_t)(t - t0dbg) * 1024 + (j >> 3) * 512 + lane * 8 + (j & 7)]; dd[j] = (DBG_SCALE != 0.0f) ? (v[j] - zz) * DBG_SCALE : 0.f; v[j] = zz; } }
        float sum = 0.f;
#pragma unroll
        for (int j = 0; j < 16; ++j) sum += v[j];
        sum = wave_sum(sum);
        const float mean = sum * (1.f / 1024.f);
        float sq = 0.f;
#pragma unroll
        for (int j = 0; j < 16; ++j) { v[j] -= mean; sq += v[j] * v[j]; }
        sq = wave_sum(sq);
        const float rstd = 1.0f / sqrtf(sq * (1.f / 1024.f) + nv::EPS);
#pragma unroll
        for (int half = 0; half < 2; ++half) { const int c0 = half * 512 + lane * 8;
            const f32x4 w0 = *(const f32x4*)(lw + c0), w1 = *(const f32x4*)(lw + c0 + 4), b0 = *(const f32x4*)(lb + c0), b1 = *(const f32x4*)(lb + c0 + 4);
            f32x4 o0, o1;
            if (zdbg) {
#pragma unroll
                for (int j = 0; j < 8; ++j) v[half * 8 + j] += dd[half * 8 + j] / rstd; }
            o0.x = v[half * 8 + 0] * rstd * w0.x + b0.x; o0.y = v[half * 8 + 1] * rstd * w0.y + b0.y; o0.z = v[half * 8 + 2] * rstd * w0.z + b0.z; o0.w = v[half * 8 + 3] * rstd * w0.w + b0.w;
            o1.x = v[half * 8 + 4] * rstd * w1.x + b1.x; o1.y = v[half * 8 + 5] * rstd * w1.y + b1.y; o1.z = v[half * 8 + 6] * rstd * w1.z + b1.z; o1.w = v[half * 8 + 7] * rstd * w1.w + b1.w;
            *(f32x4*)(h + (size_t)t * 1024 + c0) = o0; *(f32x4*)(h + (size_t)t * 1024 + c0 + 4) = o1;
            if (hbf) { v4u p; p.x = pk2(o0.x, o0.y); p.y = pk2(o0.z, o0.w); p.z = pk2(o1.x, o1.y); p.w = pk2(o1.z, o1.w); *(v4u*)(hbf + (size_t)t * 1024 + c0) = p; } }
    }
}
typedef float f32x16 __attribute__((ext_vector_type(16)));
typedef short s16x8 __attribute__((ext_vector_type(8)));
typedef LAS unsigned short lbf16;
__device__ __forceinline__ void mm32(f32x16& acc, const lbf16* A, int lda, const lbf16* B, int ldb, int K, int lane) {
    const lbf16* ap = A + (lane & 31) * lda + 8 * (lane >> 5);
    const lbf16* bp = B + (lane & 31) * ldb + 8 * (lane >> 5);
#pragma unroll 4
    for (int k = 0; k < K; k += 16) {
        const s16x8 a = *(const LAS s16x8*)(ap + k), b = *(const LAS s16x8*)(bp + k);
        acc = __builtin_amdgcn_mfma_f32_32x32x16_bf16(a, b, acc, 0, 0, 0);
    }
}
__device__ __forceinline__ void mm32_gb(f32x16& acc, const lbf16* A, int lda, const bf16* B, int ldb, int K, int lane) {
    const lbf16* ap = A + (lane & 31) * lda + 8 * (lane >> 5);
    const bf16* bp = B + (size_t)(lane & 31) * ldb + 8 * (lane >> 5);
#pragma unroll 4
    for (int k = 0; k < K; k += 16) {
        const s16x8 a = *(const LAS s16x8*)(ap + k), b = *(const s16x8*)(bp + k);
        acc = __builtin_amdgcn_mfma_f32_32x32x16_bf16(a, b, acc, 0, 0, 0);
    }
}
__device__ __forceinline__ int rowmap(int r, int lane) { return (r & 3) + 8 * (r >> 2) + 4 * (lane >> 5); }
__device__ __forceinline__ float sigm_f(float x) { return 1.0f / (1.0f + __expf(-x)); }
__device__ __forceinline__ float logsig_f(float x) { return fminf(x, 0.f) - log1pf(__expf(-fabsf(x))); }
__device__ __forceinline__ float softplus_f(float x) { return fmaxf(x, 0.f) + log1pf(__expf(-fabsf(x))); }
__device__ __forceinline__ float gelu_f(float x) { const float u = 0.7978845608028654f * (x + 0.044715f * x * x * x); return x / (1.0f + __expf(-2.0f * u)); }
__device__ __forceinline__ void unpack8(const v4u r, float (&f)[8]) {
    f[0] = __builtin_bit_cast(float, r.x << 16); f[1] = __builtin_bit_cast(float, r.x & 0xffff0000u); f[2] = __builtin_bit_cast(float, r.y << 16); f[3] = __builtin_bit_cast(float, r.y & 0xffff0000u);
    f[4] = __builtin_bit_cast(float, r.z << 16); f[5] = __builtin_bit_cast(float, r.z & 0xffff0000u); f[6] = __builtin_bit_cast(float, r.w << 16); f[7] = __builtin_bit_cast(float, r.w & 0xffff0000u);
}
__device__ __forceinline__ v4u pack8(const float (&f)[8]) { v4u o; o.x = pk2(f[0], f[1]); o.y = pk2(f[2], f[3]); o.z = pk2(f[4], f[5]); o.w = pk2(f[6], f[7]); return o; }

struct Mix0Bufs { const bf16* proj; float* ct; float* nloc; float* blast; float* mloc; float* mprev; float* hloc; float* pc; float* carA; float* carU; float* carI; bf16* mixbf; const bf16* lruw; };
constexpr int PJ0 = EINP;

__device__ __forceinline__ void mlstm_a_item(const Mix0Bufs& B, const float* gate_b, int cn, LAS unsigned char* lds, int tid) {
    const int lane = tid & 63, wave = __builtin_amdgcn_readfirstlane(tid >> 6);
    const int bh = cn / NCH, n = cn % NCH, b = bh >> 2, h = bh & 3;
    const size_t t0 = (size_t)b * S_ + n * 64;
    LAS float* lf = (LAS float*)lds; LAS float* wl = lf + 64; LAS float* pw = lf + 128; LAS float* misc = lf + 192;
    lbf16* kT = (lbf16*)(lds + 1024); lbf16* vT = (lbf16*)(lds + 1024 + 128 * 72 * 2);
    if (tid < 64) { const bf16* pr = B.proj + (t0 + tid) * PJ0;
        lf[tid] = logsig_f(bf2f(pr[2052 + h]) + gate_b[4 + h]); pw[tid] = bf2f(pr[2048 + h]) + gate_b[h]; }
    __syncthreads();
    if (tid < 64) { float acc = 0.f; for (int j = 0; j < 64; ++j) { const float x = lf[j]; acc += (j <= tid) ? x : 0.f; } wl[tid] = pw[tid] - acc; if (tid == 63) misc[0] = acc; }
    __syncthreads();
    float mx = -INFINITY;
    for (int j = 0; j < 64; ++j) mx = fmaxf(mx, wl[j]);
    const float blast = misc[0];
    __syncthreads();
    if (tid < 64) pw[tid] = __expf(wl[tid] - mx) * 0.08838834764831845f;
    __syncthreads();
#pragma unroll
    for (int it = 0; it < 2; ++it) { const int vi = tid + it * 512, l = vi & 63, g = vi >> 6;
        const bf16* pr = B.proj + (t0 + l) * PJ0 + h * 128 + g * 8;
        float kf[8], vf[8]; unpack8(*(const v4u*)(pr + 512), kf); unpack8(*(const v4u*)(pr + 1024), vf);
        const float p = pw[l];
#pragma unroll
        for (int j = 0; j < 8; ++j) { kT[(g * 8 + j) * 72 + l] = (unsigned short)f2bf(kf[j] * p); vT[(g * 8 + j) * 72 + l] = (unsigned short)f2bf(vf[j]); } }
    __syncthreads();
    const int et = wave >> 1;
#pragma unroll
    for (int q = 0; q < 2; ++q) { const int dt = (wave & 1) * 2 + q;
        f32x16 acc = {0.f, 0.f, 0.f, 0.f, 0.f, 0.f, 0.f, 0.f, 0.f, 0.f, 0.f, 0.f, 0.f, 0.f, 0.f, 0.f};
        mm32(acc, vT + et * 32 * 72, 72, kT + dt * 32 * 72, 72, 64, lane);
        float* out = B.ct + (size_t)cn * 16384 + dt * 32 + (lane & 31);
#pragma unroll
        for (int r = 0; r < 16; ++r) out[(size_t)(et * 32 + rowmap(r, lane)) * 128] = acc[r]; }
    if (tid < 128) { float s = 0.f; for (int l = 0; l < 64; ++l) s += bf2f(kT[tid * 72 + l]); B.nloc[(size_t)cn * 128 + tid] = s; }
    if (tid == 0) { B.blast[cn] = blast; B.mloc[cn] = blast + mx; }
    __syncthreads();
}
__device__ __forceinline__ void mlstm_b(const Mix0Bufs& B, int gtid, int gsz) {
    for (int idx = gtid; idx < 8 * 16384 + 8 * 128; idx += gsz) {
        const bool isn = idx >= 8 * 16384;
        int bh, de; float* buf; int stride;
        if (!isn) { bh = idx >> 14; de = idx & 16383; buf = B.ct; stride = 16384; } else { const int r = idx - 8 * 16384; bh = r >> 7; de = r & 127; buf = B.nloc; stride = 128; }
        float st = 0.f, m = 0.f;
        float* p = buf + (size_t)bh * NCH * stride + de;
#pragma unroll 8
        for (int n = 0; n < NCH; ++n) { const int cn = bh * NCH + n;
            const float cl = p[(size_t)n * stride]; p[(size_t)n * stride] = st;
            const float bl = B.blast[cn], ml = B.mloc[cn], mn = fmaxf(bl + m, ml);
            st = __expf(bl + m - mn) * st + __expf(ml - mn) * cl;
            if (!isn && de == 0) B.mprev[cn] = m;
            m = mn; }
    }
}
__device__ __forceinline__ void mlstm_c_item(const Mix0Bufs& B, const float* gate_b, const float* norm_w, int cn, LAS unsigned char* lds, int tid) {
    const int lane = tid & 63, wave = __builtin_amdgcn_readfirstlane(tid >> 6);
    const int bh = cn / NCH, n = cn % NCH, b = bh >> 2, h = bh & 3;
    const size_t t0 = (size_t)b * S_ + n * 64;
    LAS float* bc = (LAS float*)lds; LAS float* wl = bc + 64; LAS float* mi = bc + 128; LAS float* win = bc + 192; LAS float* den = bc + 256; LAS float* emi = bc + 320; LAS float* lf = bc + 384; LAS float* ig = bc + 448;
    lbf16* qs = (lbf16*)(lds + 2048); lbf16* ks = (lbf16*)(lds + 19456); lbf16* qw = (lbf16*)(lds + 36864);
    lbf16* vT = (lbf16*)(lds + 54272); lbf16* cT = (lbf16*)(lds + 77312); lbf16* sm = (lbf16*)(lds + 120832);
    LAS float* hb = (LAS float*)(lds + 2048);
    const float mprev = B.mprev[cn];
    if (tid < 64) { const bf16* pr = B.proj + (t0 + tid) * PJ0;
        lf[tid] = logsig_f(bf2f(pr[2052 + h]) + gate_b[4 + h]); ig[tid] = bf2f(pr[2048 + h]) + gate_b[h]; }
    __syncthreads();
    if (tid < 64) { float acc = 0.f; for (int j = 0; j < 64; ++j) { const float x = lf[j]; acc += (j <= tid) ? x : 0.f; } bc[tid] = acc; wl[tid] = ig[tid] - acc; }
    __syncthreads();
    if (tid < 64) { float pm = -INFINITY; for (int j = 0; j < 64; ++j) { const float x = wl[j]; pm = (j <= tid) ? fmaxf(pm, x) : pm; }
        const float bi = bc[tid], m = bi + fmaxf(mprev, pm); mi[tid] = m; win[tid] = __expf(bi + mprev - m); emi[tid] = __expf(-m); }
    __syncthreads();
#pragma unroll
    for (int it = 0; it < 2; ++it) { const int vi = tid + it * 512, l = vi >> 4, g = vi & 15;
        const bf16* pr = B.proj + (t0 + l) * PJ0 + h * 128 + g * 8;
        float qf[8], kf[8]; unpack8(*(const v4u*)pr, qf); unpack8(*(const v4u*)(pr + 512), kf);
        const float w = win[l]; float qwf[8];
#pragma unroll
        for (int j = 0; j < 8; ++j) { kf[j] *= 0.08838834764831845f; qwf[j] = qf[j] * w; }
        *(LAS v4u*)(qs + l * 136 + g * 8) = *(const v4u*)pr; *(LAS v4u*)(ks + l * 136 + g * 8) = pack8(kf); *(LAS v4u*)(qw + l * 136 + g * 8) = pack8(qwf); }
#pragma unroll
    for (int it = 0; it < 2; ++it) { const int vi = tid + it * 512, l = vi & 63, g = vi >> 6;
        float vf[8]; unpack8(*(const v4u*)(B.proj + (t0 + l) * PJ0 + 1024 + h * 128 + g * 8), vf);
#pragma unroll
        for (int j = 0; j < 8; ++j) vT[(g * 8 + j) * 72 + l] = (unsigned short)f2bf(vf[j]); }
    for (int i = tid; i < 32 * 72; i += 512) { const int r = i / 72, c = i % 72; vT[(128 + r) * 72 + c] = (r == 0 && c < 64) ? (unsigned short)0x3f80 : (unsigned short)0; }
    { const float* cg = B.ct + (size_t)cn * 16384;
#pragma unroll
      for (int it = 0; it < 4; ++it) { const int vi = tid + it * 512, e = vi >> 4, g = vi & 15;
          const f32x4 a = *(const f32x4*)(cg + e * 128 + g * 8), c2 = *(const f32x4*)(cg + e * 128 + g * 8 + 4);
          v4u o; o.x = pk2(a.x, a.y); o.y = pk2(a.z, a.w); o.z = pk2(c2.x, c2.y); o.w = pk2(c2.z, c2.w); *(LAS v4u*)(cT + e * 136 + g * 8) = o; } }
    for (int i = tid; i < 32 * 136; i += 512) { const int r = i / 136, c = i % 136; cT[(128 + r) * 136 + c] = (r == 0 && c < 128) ? (unsigned short)f2bf(B.nloc[(size_t)cn * 128 + c]) : (unsigned short)0; }
    __syncthreads();
    if (wave < 4) { const int it = wave >> 1, jt = wave & 1;
        f32x16 acc = {0.f, 0.f, 0.f, 0.f, 0.f, 0.f, 0.f, 0.f, 0.f, 0.f, 0.f, 0.f, 0.f, 0.f, 0.f, 0.f};
        if (jt <= it) mm32(acc, qs + it * 32 * 136, 136, ks + jt * 32 * 136, 136, 128, lane);
        const int j = jt * 32 + (lane & 31); const float wj = wl[j];
#pragma unroll
        for (int r = 0; r < 16; ++r) { const int i = it * 32 + rowmap(r, lane);
            const float v = (j <= i) ? acc[r] * __expf(bc[i] - mi[i] + wj) : 0.f; sm[i * 72 + j] = (unsigned short)f2bf(v); } }
    __syncthreads();
    f32x16 accA = {0.f, 0.f, 0.f, 0.f, 0.f, 0.f, 0.f, 0.f, 0.f, 0.f, 0.f, 0.f, 0.f, 0.f, 0.f, 0.f}, accB = accA;
    { const int id = wave, it = id / 5, nt = id % 5;
      mm32(accA, sm + it * 32 * 72, 72, vT + nt * 32 * 72, 72, 64, lane); mm32(accA, qw + it * 32 * 136, 136, cT + nt * 32 * 136, 136, 128, lane);
      if (nt == 4 && (lane & 31) == 0) {
#pragma unroll
          for (int r = 0; r < 16; ++r) den[it * 32 + rowmap(r, lane)] = accA[r]; } }
    if (wave < 2) { const int id = wave + 8, it = id / 5, nt = id % 5;
      mm32(accB, sm + it * 32 * 72, 72, vT + nt * 32 * 72, 72, 64, lane); mm32(accB, qw + it * 32 * 136, 136, cT + nt * 32 * 136, 136, 128, lane);
      if (nt == 4 && (lane & 31) == 0) {
#pragma unroll
          for (int r = 0; r < 16; ++r) den[it * 32 + rowmap(r, lane)] = accB[r]; } }
    __syncthreads();
    { const int id = wave, it = id / 5, nt = id % 5;
      if (nt < 4) {
#pragma unroll
          for (int r = 0; r < 16; ++r) { const int i = it * 32 + rowmap(r, lane); hb[i * 132 + nt * 32 + (lane & 31)] = accA[r] / fmaxf(fabsf(den[i]), emi[i]); } } }
    if (wave < 2) { const int id = wave + 8, it = id / 5, nt = id % 5;
      if (nt < 4) {
#pragma unroll
          for (int r = 0; r < 16; ++r) { const int i = it * 32 + rowmap(r, lane); hb[i * 132 + nt * 32 + (lane & 31)] = accB[r] / fmaxf(fabsf(den[i]), emi[i]); } } }
    __syncthreads();
    { const int i = tid >> 3, sub = tid & 7; const LAS float* hr = hb + i * 132 + sub * 16;
      float x[16]; float s = 0.f;
#pragma unroll
      for (int j = 0; j < 16; ++j) { x[j] = hr[j]; s += x[j]; }
      s += __builtin_bit_cast(float, __builtin_amdgcn_ds_swizzle(__builtin_bit_cast(int, s), 0x1f | (1 << 10)));
      s += __builtin_bit_cast(float, __builtin_amdgcn_ds_swizzle(__builtin_bit_cast(int, s), 0x1f | (2 << 10)));
      s += __builtin_bit_cast(float, __builtin_amdgcn_ds_swizzle(__builtin_bit_cast(int, s), 0x1f | (4 << 10)));
      const float mean = s * (1.f / 128.f); float q = 0.f;
#pragma unroll
      for (int j = 0; j < 16; ++j) { x[j] -= mean; q += x[j] * x[j]; }
      q += __builtin_bit_cast(float, __builtin_amdgcn_ds_swizzle(__builtin_bit_cast(int, q), 0x1f | (1 << 10)));
      q += __builtin_bit_cast(float, __builtin_amdgcn_ds_swizzle(__builtin_bit_cast(int, q), 0x1f | (2 << 10)));
      q += __builtin_bit_cast(float, __builtin_amdgcn_ds_swizzle(__builtin_bit_cast(int, q), 0x1f | (4 << 10)));
      const float rstd = 1.0f / sqrtf(q * (1.f / 128.f) + nv::EPS);
      const bf16* op = B.proj + (t0 + i) * PJ0 + 1536 + h * 128 + sub * 16; const float* nw = norm_w + h * 128 + sub * 16;
      float o0[8], o1[8]; unpack8(*(const v4u*)op, o0); unpack8(*(const v4u*)(op + 8), o1);
      float y0[8], y1[8];
#pragma unroll
      for (int j = 0; j < 8; ++j) { y0[j] = x[j] * rstd * nw[j] * sigm_f(o0[j]); y1[j] = x[8 + j] * rstd * nw[8 + j] * sigm_f(o1[j]); }
      bf16* dst = B.mixbf + (t0 + i) * 1024 + h * 128 + sub * 16;
      *(v4u*)dst = pack8(y0); *(v4u*)(dst + 8) = pack8(y1); }
    __syncthreads();
}
__device__ __forceinline__ void lru_a_item(const Mix0Bufs& B, const float* const* in, int ch, LAS unsigned char* lds, int tid) {
    const int lane = tid & 63, wave = __builtin_amdgcn_readfirstlane(tid >> 6);
    const size_t t0 = (size_t)ch * 64; const int s0 = (ch % NCH) * 64;
    lbf16* xc = (lbf16*)lds; LAS float* al = (LAS float*)(lds + 17408); LAS float* ul = (LAS float*)(lds + 17408 + 32768);
    const float* cw = in[9]; const float* cb = in[10]; const float* ba = in[12]; const float* bx = in[14]; const float* lam = in[15];
    for (int hh = 0; hh < 4; ++hh) {
#pragma unroll
        for (int it = 0; it < 2; ++it) { const int vi = tid + it * 512, l = vi >> 4, g = vi & 15, c0 = hh * 128 + g * 8;
            float acc[8];
#pragma unroll
            for (int j = 0; j < 8; ++j) acc[j] = cb[c0 + j];
#pragma unroll
            for (int tap = 0; tap < 4; ++tap) { const int ls = s0 + l - 3 + tap;
                if (ls >= 0) { float xf[8]; unpack8(*(const v4u*)(B.proj + (t0 + l - 3 + tap) * PJ0 + 2056 + c0), xf);
#pragma unroll
                    for (int j = 0; j < 8; ++j) acc[j] += cw[tap * 512 + c0 + j] * xf[j]; } }
            *(LAS v4u*)(xc + l * 136 + g * 8) = pack8(acc);
#pragma unroll
            for (int j = 0; j < 8; ++j) ul[l * 128 + g * 8 + j] = acc[j]; }
        __syncthreads();
        { const int it = wave & 1, nt = wave >> 1;
          f32x16 ra = {0.f, 0.f, 0.f, 0.f, 0.f, 0.f, 0.f, 0.f, 0.f, 0.f, 0.f, 0.f, 0.f, 0.f, 0.f, 0.f}, xa = ra;
          mm32_gb(ra, xc + it * 32 * 136, 136, B.lruw + (size_t)(hh * 128 + nt * 32) * 128, 128, 128, lane);
          mm32_gb(xa, xc + it * 32 * 136, 136, B.lruw + (size_t)(512 + hh * 128 + nt * 32) * 128, 128, 128, lane);
          const int c = nt * 32 + (lane & 31), cg = hh * 128 + c; const float bav = ba[cg], bxv = bx[cg], sp = softplus_f(-lam[cg]);
#pragma unroll
          for (int r = 0; r < 16; ++r) { const int l = it * 32 + rowmap(r, lane);
              const float rr = sigm_f(ra[r] + bav), ii = sigm_f(xa[r] + bxv), la = -8.0f * rr * sp;
              const float xv = ul[l * 128 + c];
              al[l * 128 + c] = __expf(la); ul[l * 128 + c] = sqrtf(-expm1f(2.0f * la)) * ii * xv; } }
        __syncthreads();
        if (tid < 128) { float hst = 0.f, P = 1.f; float* hp = B.hloc + t0 * 512 + hh * 128 + tid; float* pp = B.pc + t0 * 512 + hh * 128 + tid;
            for (int l = 0; l < 64; ++l) { const float a = al[l * 128 + tid]; hst = a * hst + ul[l * 128 + tid]; P *= a; hp[(size_t)l * 512] = hst; pp[(size_t)l * 512] = P; }
            B.carA[(size_t)ch * 512 + hh * 128 + tid] = P; B.carU[(size_t)ch * 512 + hh * 128 + tid] = hst; }
        __syncthreads();
    }
}
__device__ __forceinline__ void lru_b(const Mix0Bufs& B, int gtid, int gsz) {
    for (int idx = gtid; idx < 2 * 512; idx += gsz) { const int b = idx >> 9, c = idx & 511; float hst = 0.f;
#pragma unroll 8
        for (int n = 0; n < NCH; ++n) { const size_t o = (size_t)(b * NCH + n) * 512 + c; B.carI[o] = hst; hst = B.carA[o] * hst + B.carU[o]; } }
}
__device__ __forceinline__ void lru_c(const Mix0Bufs& B, int gtid, int gsz) {
    for (int idx = gtid; idx < T_ * 64; idx += gsz) { const size_t t = idx >> 6; const int c0 = (idx & 63) * 8; const size_t ch = t >> 6;
        float gb[8], y[8]; unpack8(*(const v4u*)(B.proj + t * PJ0 + 2568 + c0), gb);
        const float* hp = B.hloc + t * 512 + c0; const float* pp = B.pc + t * 512 + c0; const float* ci = B.carI + ch * 512 + c0;
#pragma unroll
        for (int j = 0; j < 8; ++j) y[j] = (hp[j] + pp[j] * ci[j]) * gelu_f(gb[j]);
        *(v4u*)(B.mixbf + t * 1024 + 512 + c0) = pack8(y); }
}
constexpr int CTX_OFF = 131072 + 1024, TAB_OFF = 131072 + 8192;
constexpr size_t WS_WINE = 1 * MiB, WS_WINO = WS_WINE + (size_t)EINP * 1024 * 2, WS_WOUT = WS_WINO + (size_t)OINP * 1024 * 2, WS_XBF = 16 * MiB, WS_MIXBF = 48 * MiB, WS_NAIVE = 80 * MiB;
static_assert(WS_WOUT + 2 * 1024 * 1024 * 2 <= WS_XBF, "ws map");
constexpr size_t WS_WD = 48 * MiB, WS_WGU = WS_WD + 65 * 512 * 1024, WS_LISTS = 146 * MiB, WS_RIDX = 148 * MiB, WS_H = 149 * MiB, WS_ROWS8 = 229 * MiB;
static_assert(WS_WGU + (size_t)65 * 1024 * 1024 <= WS_LISTS && WS_H + (size_t)MOE_MAXBLK * 256 * 512 <= WS_ROWS8 && WS_ROWS8 + (size_t)nv::T_ * 8 * 2048 <= 512 * MiB, "moe ws map");
constexpr size_t WS_PROJB = 149 * MiB, WS_CT = 253 * MiB, WS_HLOC = 317 * MiB, WS_PC = 349 * MiB, WS_M0SMALL = 381 * MiB, WS_LRUW = 384 * MiB;
constexpr int CW_PROBE = 9000;
struct Tab { const float* in[38]; float* out; unsigned char* ws; };
struct Env { const Tab* tab; unsigned char* ws; float* out; LAS unsigned char* lds; int tid, lane, wave, bid, G, gw, NGW, gtid, gsz; };
__device__ __forceinline__ Env penv(unsigned char* lds_raw) {
    Env e; e.tab = (const Tab*)(lds_raw + TAB_OFF); e.ws = e.tab->ws; e.out = e.tab->out; e.lds = (LAS unsigned char*)lds_raw;
    int t = threadIdx.x; asm volatile("" : "+v"(t)); e.tid = t; e.lane = t & 63; e.wave = __builtin_amdgcn_readfirstlane(t >> 6);
    int b = blockIdx.x; asm volatile("" : "+s"(b)); e.bid = b; int g = gridDim.x; asm volatile("" : "+s"(g)); e.G = g;
    e.gw = b * NWAVES + e.wave; e.NGW = g * NWAVES; e.gtid = b * NTHREADS + t; e.gsz = g * NTHREADS;
    return e;
}
__device__ __forceinline__ void grid_bar(const Env& e) {
    XcdBarrier b; b.bar = (unsigned*)e.ws + 4096; b.x = xb_xcc_id(); b.st = (volatile LAS unsigned*)(e.lds + MISC_OFF) + 8;
    xcd_barrier(b);
}
template <int ST> __device__ __forceinline__ void run_naive(unsigned char* lds_raw, int ci, long n) {
    const Env e = penv(lds_raw);
    const nv::Ctx& c = ((const nv::Ctx*)(lds_raw + CTX_OFF))[ci];
    for (long i = e.gtid; i < n; i += e.gsz) nv::item<ST>(c, i);
    grid_bar(e);
}
__device__ __forceinline__ void phase_p0(unsigned char* lds_raw) {
    const Env e = penv(lds_raw);
    LAS float* scr = (LAS float*)(e.lds + e.wave * 16384);
    tr_matrix(e.tab->in[6], 1024, nv::EIN, EINP, (bf16*)(e.ws + WS_WINE), scr, e.gw, e.NGW, e.lane);
    tr_matrix(e.tab->in[16], 1024, nv::OIN, OINP, (bf16*)(e.ws + WS_WINO), scr, e.gw, e.NGW, e.lane);
    tr_matrix(e.tab->in[5], 1024, 1024, 1024, (bf16*)(e.ws + WS_WOUT), scr, e.gw, e.NGW, e.lane);
    tr_matrix(e.tab->in[5] + 1024 * 1024, 1024, 1024, 1024, (bf16*)(e.ws + WS_WOUT) + 1024 * 1024, scr, e.gw, e.NGW, e.lane);
    for (int h = 0; h < 4; ++h) { tr_matrix(e.tab->in[11] + h * 16384, 128, 128, 128, (bf16*)(e.ws + WS_LRUW) + h * 16384, scr, e.gw, e.NGW, e.lane);
                                  tr_matrix(e.tab->in[13] + h * 16384, 128, 128, 128, (bf16*)(e.ws + WS_LRUW) + 65536 + h * 16384, scr, e.gw, e.NGW, e.lane); }
    cvt_rows(e.tab->in[0], (bf16*)(e.ws + WS_XBF), (long)T_ * 1024, e.gtid, e.gsz);
    grid_bar(e);
}
__device__ __forceinline__ void phase_inproj(unsigned char* lds_raw, int layer) {
    const Env e = penv(lds_raw);
    float* proj = (float*)(e.ws + WS_NAIVE) + ((size_t)T_ * 1024 + (size_t)T_ * 64 + (size_t)T_ * 8 * 2);
    const int NP = layer == 0 ? EINP : OINP;
    pg8::Gemm g{(const bf16*)(e.ws + WS_XBF), (const bf16*)(e.ws + (layer == 0 ? WS_WINE : WS_WINO)), 1024, 0, 0, nullptr};
    pg8::StaticOrder S; S.init(T_, NP, e.G, e.bid);
    pg8::EpiF32R E{proj, NP, nullptr, 0.f};
    pg8::gemm_phase<pg8::EpiF32R, pg8::StaticOrder, true, false>(e.lds, g, S, E);
    grid_bar(e);
}
__device__ __forceinline__ void phase_cvt_mixed(unsigned char* lds_raw) {
    const Env e = penv(lds_raw);
    cvt_rows((const float*)(e.ws + WS_NAIVE), (bf16*)(e.ws + WS_MIXBF), (long)T_ * 1024, e.gtid, e.gsz);
    grid_bar(e);
}
__device__ __forceinline__ void phase_outproj(unsigned char* lds_raw, int layer) {
    const Env e = penv(lds_raw);
    float* z = (float*)(e.ws + WS_NAIVE) + ((size_t)T_ * 1024 + (size_t)T_ * 64 + (size_t)T_ * 8 * 2);
    const float* hcur = layer == 0 ? e.tab->in[0] : e.out;
    pg8::Gemm g{(const bf16*)(e.ws + WS_MIXBF), (const bf16*)(e.ws + WS_WOUT) + (size_t)layer * 1024 * 1024, 1024, 0, 0, nullptr};
    pg8::StaticOrder S; S.init(T_, 1024, e.G, e.bid);
    pg8::EpiF32R E{z, 1024, hcur, nv::ALPHA};
    pg8::gemm_phase<pg8::EpiF32R, pg8::StaticOrder, true, false>(e.lds, g, S, E);
    grid_bar(e);
}
__device__ __forceinline__ Mix0Bufs mix0_bufs(unsigned char* ws) {
    Mix0Bufs B; B.proj = (const bf16*)(ws + WS_PROJB); B.ct = (float*)(ws + WS_CT); B.hloc = (float*)(ws + WS_HLOC); B.pc = (float*)(ws + WS_PC);
    float* sm = (float*)(ws + WS_M0SMALL); B.nloc = sm; sm += 8 * NCH * 128; B.blast = sm; sm += 8 * NCH; B.mloc = sm; sm += 8 * NCH; B.mprev = sm; sm += 8 * NCH;
    B.carA = sm; sm += 2 * NCH * 512; B.carU = sm; sm += 2 * NCH * 512; B.carI = sm;
    B.mixbf = (bf16*)(ws + WS_MIXBF); B.lruw = (const bf16*)(ws + WS_LRUW); return B;
}
__device__ __forceinline__ void phase_inproj_bf16(unsigned char* lds_raw, int layer) {
    const Env e = penv(lds_raw);
    const int NP = layer == 0 ? EINP : OINP;
    pg8::Gemm g{(const bf16*)(e.ws + WS_XBF), (const bf16*)(e.ws + (layer == 0 ? WS_WINE : WS_WINO)), 1024, 0, 0, nullptr};
    pg8::StaticOrder S; S.init(T_, NP, e.G, e.bid);
    pg8::EpiBf16P E{(bf16*)(e.ws + WS_PROJB), NP};
    pg8::gemm_phase<pg8::EpiBf16P, pg8::StaticOrder, true, false>(e.lds, g, S, E);
    grid_bar(e);
}
__device__ __forceinline__ void phase_mix0_a(unsigned char* lds_raw) {
    const Env e = penv(lds_raw); const Mix0Bufs B = mix0_bufs(e.ws);
    for (int it = e.bid; it < 256 + 8 * NCH; it += e.G) {
        if (it < 256) lru_a_item(B, e.tab->in, it, e.lds, e.tid); else mlstm_a_item(B, e.tab->in[7], it - 256, e.lds, e.tid); }
    grid_bar(e);
}
__device__ __forceinline__ void phase_mix0_b(unsigned char* lds_raw) {
    const Env e = penv(lds_raw); const Mix0Bufs B = mix0_bufs(e.ws);
    lru_b(B, e.gtid, e.gsz); mlstm_b(B, e.gtid, e.gsz);
    grid_bar(e);
}
__device__ __forceinline__ void phase_mix0_c(unsigned char* lds_raw) {
    const Env e = penv(lds_raw); const Mix0Bufs B = mix0_bufs(e.ws);
    for (int it = e.bid; it < 8 * NCH; it += e.G) mlstm_c_item(B, e.tab->in[7], e.tab->in[8], it, e.lds, e.tid);
    lru_c(B, e.gtid, e.gsz);
    grid_bar(e);
}
__device__ __forceinline__ void phase_probe(unsigned char* lds_raw, int c0, int c1) {
    const Env e = penv(lds_raw);
    const bf16* a = (const bf16*)(e.ws + WS_MIXBF); const float* b = (const float*)(e.ws + WS_NAIVE);
    float sd = 0.f, sr = 0.f; const int w = c1 - c0;
    for (long i = e.gtid; i < (long)T_ * w; i += e.gsz) { const long t = i / w; const int c = c0 + (int)(i % w); const float x = bf2f(a[t * 1024 + c]), y = b[t * 1024 + c]; sd += (x - y) * (x - y); sr += y * y; }
    sd = wave_sum(sd); sr = wave_sum(sr);
    if (e.lane == 0) { atomicAdd((float*)e.ws + CW_PROBE, sd); atomicAdd((float*)e.ws + CW_PROBE + 1, sr); }
    grid_bar(e);
}
__device__ __forceinline__ void phase_probe_apply(unsigned char* lds_raw) {
    const Env e = penv(lds_raw);
    const float sd = __hip_atomic_load((float*)e.ws + CW_PROBE, __ATOMIC_RELAXED, __HIP_MEMORY_SCOPE_AGENT), sr = __hip_atomic_load((float*)e.ws + CW_PROBE + 1, __ATOMIC_RELAXED, __HIP_MEMORY_SCOPE_AGENT);
    const float f = 1.0f + 10.0f * sqrtf(sd / fmaxf(sr, 1e-30f));
    for (long i = e.gtid; i < (long)T_ * 1024; i += e.gsz) e.out[i] *= f;
}
__device__ __forceinline__ MoeLists moe_lists(unsigned char* ws) {
    MoeLists L; L.tok = (int*)(ws + WS_LISTS); L.dest = L.tok + MOE_MAXBLK * 256; L.w = (float*)(L.dest + MOE_MAXBLK * 256); L.blk_e = (int*)(L.w + MOE_MAXBLK * 256); return L;
}
__device__ __forceinline__ void phase_moe_x1(unsigned char* lds_raw, int layer) {
    const Env e = penv(lds_raw);
    LAS float* scr = (LAS float*)(e.lds + e.wave * 16384);
    moe_convert_weights(e.tab->in[32] + (size_t)layer * 64 * 262144, e.tab->in[33] + (size_t)layer * 64 * 262144, e.tab->in[34] + (size_t)layer * 64 * 262144,
                        e.tab->in[35] + (size_t)layer * 262144, e.tab->in[36] + (size_t)layer * 262144, e.tab->in[37] + (size_t)layer * 262144,
                        (bf16*)(e.ws + WS_WGU), (bf16*)(e.ws + WS_WD), scr, e.gw, e.NGW, e.lane);
    cvt_rows(e.out, (bf16*)(e.ws + WS_XBF), (long)T_ * 1024, e.gtid, e.gsz);
    __syncthreads();
    moe_count((const int*)(e.ws + WS_RIDX), (unsigned*)e.ws + CW_CNT + layer * 256, (LAS unsigned*)e.lds, e.tid, e.bid, e.G);
    grid_bar(e);
}
__device__ __forceinline__ void phase_moe_x2(unsigned char* lds_raw, int layer) {
    const Env e = penv(lds_raw);
    moe_build_lists((const int*)(e.ws + WS_RIDX), (const float*)(e.ws + WS_RIDX) + (size_t)T_ * 8, (unsigned*)e.ws + CW_CNT + layer * 256, (unsigned*)e.ws + CW_CUR + layer * 256,
                    moe_lists(e.ws), (LAS int*)e.lds, e.tid, e.bid, e.G);
    grid_bar(e);
}
__device__ __forceinline__ void phase_moe_g1(unsigned char* lds_raw) {
    const Env e = penv(lds_raw);
    const MoeLists L = moe_lists(e.ws);
    const int nblk = __builtin_amdgcn_readfirstlane(L.blk_e[MOE_MAXBLK]);
    pg8::Gemm g{(const bf16*)(e.ws + WS_XBF), (const bf16*)(e.ws + WS_WGU), 1024, 0, (size_t)512 * 1024, L.tok};
    pg8::MoeOrder S{L.blk_e, nblk, 2, e.G, e.bid};
    pg8::EpiSwiGLU E{(bf16*)(e.ws + WS_H)};
    pg8::gemm_phase<pg8::EpiSwiGLU, pg8::MoeOrder, true, true>(e.lds, g, S, E);
    grid_bar(e);
}
__device__ __forceinline__ void phase_moe_g2(unsigned char* lds_raw) {
    const Env e = penv(lds_raw);
    const MoeLists L = moe_lists(e.ws);
    const int nblk = __builtin_amdgcn_readfirstlane(L.blk_e[MOE_MAXBLK]);
    pg8::Gemm g{(const bf16*)(e.ws + WS_H), (const bf16*)(e.ws + WS_WD), 256, 0, (size_t)1024 * 256, nullptr};
    pg8::MoeOrder S{L.blk_e, nblk, 4, e.G, e.bid};
    pg8::EpiDown E{(bf16*)(e.ws + WS_ROWS8), (bf16*)(e.ws + WS_XBF), L.dest, L.w, T_ * 8};
    pg8::gemm_phase<pg8::EpiDown, pg8::MoeOrder, true, false>(e.lds, g, S, E);
    grid_bar(e);
}
__device__ __forceinline__ void phase_moe_combine(unsigned char* lds_raw, int layer) {
    const Env e = penv(lds_raw);
    moe_combine_ln(e.out, (const bf16*)(e.ws + WS_ROWS8), (const bf16*)(e.ws + WS_XBF), e.tab->in[3] + layer * 1024, e.tab->in[4] + layer * 1024,
                   layer == 0 ? (bf16*)(e.ws + WS_XBF) : nullptr, e.gw, e.NGW, e.lane
#ifdef DBG_LAYER
                   , layer == DBG_LAYER ? (const float*)(e.ws + 486 * MiB) : nullptr, DBG_NT, DBG_T0
#endif
                   );
    grid_bar(e);
}
template <int layer> __device__ __forceinline__ void layer_body(unsigned char* lds_raw) {
    constexpr int ci = layer * 2;
#if defined(OPT_MIX0)
    constexpr bool opt = (layer == 0);
#else
    constexpr bool opt = false;
#endif
#if defined(DBG_MIX0)
    constexpr bool naive_too = true;
#else
    constexpr bool naive_too = false;
#endif
    if (opt) { phase_inproj_bf16(lds_raw, layer); phase_mix0_a(lds_raw); phase_mix0_b(lds_raw); phase_mix0_c(lds_raw); }
    if (!opt || naive_too) {
        phase_inproj(lds_raw, layer);
        if (layer == 0) {
            run_naive<nv::ST_ML_GATES>(lds_raw, ci, 8L * NCH);
            run_naive<nv::ST_ML_CLOC>(lds_raw, ci, 8L * NCH * 16384);
            run_naive<nv::ST_ML_SCAN>(lds_raw, ci, 8L * 16384 + 8 * 128);
            run_naive<nv::ST_ML_MI>(lds_raw, ci, 8L * S_);
            run_naive<nv::ST_ML_SMAT>(lds_raw, ci, 8L * NCH * 4096);
            run_naive<nv::ST_ML_DEN>(lds_raw, ci, 8L * S_);
            run_naive<nv::ST_ML_H>(lds_raw, ci, 8L * S_ * 128);
            run_naive<nv::ST_ML_NORM>(lds_raw, ci, 8L * S_);
            run_naive<nv::ST_LRU_CONV>(lds_raw, ci, (long)T_ * 512);
            run_naive<nv::ST_LRU_GATE>(lds_raw, ci, (long)T_ * 512);
            run_naive<nv::ST_LRU_SCAN>(lds_raw, ci, 2L * 512);
        } else {
            run_naive<nv::ST_S5_PAR>(lds_raw, ci, 2048);
            for (int sl = 0; sl < S_ / nv::SLAB; ++sl) {
                if (threadIdx.x == 0) ((nv::Ctx*)(lds_raw + CTX_OFF))[ci].slab = sl;
                __syncthreads();
                run_naive<nv::ST_S5_SCAN>(lds_raw, ci, 2L * 2048); run_naive<nv::ST_S5_OUT>(lds_raw, ci, (long)nv::B_ * nv::SLAB * 512); }
            run_naive<nv::ST_S5_GLU>(lds_raw, ci, (long)T_ * 512);
            run_naive<nv::ST_GLA_GATE>(lds_raw, ci, (long)T_ * 256);
            run_naive<nv::ST_GLA_CUM>(lds_raw, ci, (long)nv::B_ * NCH * 256);
            run_naive<nv::ST_GLA_U>(lds_raw, ci, 8L * NCH * 8192);
            run_naive<nv::ST_GLA_SCAN>(lds_raw, ci, 8L * 8192);
            run_naive<nv::ST_GLA_ATT>(lds_raw, ci, 8L * NCH * 4096);
            run_naive<nv::ST_GLA_O>(lds_raw, ci, 8L * S_ * 128);
            run_naive<nv::ST_GLA_NORM>(lds_raw, ci, 8L * S_);
        }
#if defined(DBG_MIX0)
        if (opt) phase_probe(lds_raw, DBG_C0, DBG_C1);
#endif
        phase_cvt_mixed(lds_raw);
    }
    phase_outproj(lds_raw, layer);
    run_naive<nv::ST_LN>(lds_raw, ci, T_);
    run_naive<nv::ST_SCORES>(lds_raw, ci + 1, (long)T_ * 64);
    run_naive<nv::ST_SELECT>(lds_raw, ci + 1, T_);
    phase_moe_x1(lds_raw, layer);
    phase_moe_x2(lds_raw, layer);
    phase_moe_g1(lds_raw);
    phase_moe_g2(lds_raw);
    phase_moe_combine(lds_raw, layer);
}
struct Args { const float* in[38]; float* out; unsigned char* ws; };
__global__ void __launch_bounds__(NTHREADS, 2) mega_fwd(Args a) {
    extern __shared__ __attribute__((aligned(16))) unsigned char lds_raw[];
    {
        LAS unsigned char* lds = (LAS unsigned char*)lds_raw;
        for (int u = threadIdx.x; u < (LDS_BYTES - 131072) / 4; u += NTHREADS) ((LAS unsigned*)(lds + 131072))[u] = 0u;
        __syncthreads();
        if (threadIdx.x == 0) {
            (void)xb_add((unsigned*)a.ws + 4096 + XB_XCNT(xb_xcc_id()), 1u);
            Tab* tab = (Tab*)(lds_raw + TAB_OFF);
#pragma unroll
            for (int i = 0; i < 38; ++i) { tab->in[i] = a.in[i]; if ((i & 7) == 7) asm volatile("" ::: "memory"); }
            tab->out = a.out; tab->ws = a.ws;
            asm volatile("" ::: "memory");
            nv::Ctx* const ctab = (nv::Ctx*)(lds_raw + CTX_OFF);
            const size_t scratch0 = (size_t)T_ * 1024 + (size_t)T_ * 64 + (size_t)T_ * 8 * 2;
#pragma unroll 1
            for (int layer = 0; layer < 2; ++layer) {
                nv::Ctx& c = ctab[layer * 2];
                nv::Mem M{(float*)(a.ws + WS_NAIVE), 0};
#pragma unroll 1
                for (int i = 0; i < 38; ++i) c.in[i] = tab->in[i];
                c.mixed = M.get((size_t)T_ * 1024); c.scores = M.get((size_t)T_ * 64);
                c.ridx = (int*)M.get((size_t)T_ * 8); c.rwt = M.get((size_t)T_ * 8);
                c.gR = nullptr; c.gBias = nullptr; c.slab = 0;
                c.layer = layer;
                c.hcur = layer == 0 ? a.in[0] : a.out;
                if (layer == 0) {
                    c.ldp = EINP; c.proj = M.get((size_t)T_ * c.ldp);
                    c.mb = M.get(8 * S_); c.mig = M.get(8 * S_); c.mblast = M.get(8 * NCH); c.mmloc = M.get(8 * NCH); c.mmprev = M.get(8 * NCH);
                    c.mmi = M.get(8 * S_); c.mwin = M.get(8 * S_); c.mden = M.get(8 * S_); c.nloc = M.get(8 * NCH * 128);
                    const size_t ov = M.off;
                    c.cloc = M.get((size_t)8 * NCH * 16384); c.smat = M.get((size_t)8 * NCH * 4096); c.htil = M.get((size_t)T_ * 512);
                    M.off = ov; c.lxc = M.get((size_t)T_ * 512); c.la = M.get((size_t)T_ * 512); c.lu = M.get((size_t)T_ * 512);
                } else {
                    c.ldp = OINP; c.proj = M.get((size_t)T_ * c.ldp);
                    c.s5ab = M.get(2048 * 2); c.s5bbr = M.get(2048 * 16); c.s5bbi = M.get(2048 * 16); c.s5st = M.get(2 * 2048 * 2);
                    c.s5x = M.get((size_t)nv::B_ * nv::SLAB * 2048 * 2); c.s5g = M.get((size_t)T_ * 512);
                    c.gla_la = M.get((size_t)T_ * 256); c.gla_bc = M.get((size_t)T_ * 256); c.gla_bl = M.get((size_t)nv::B_ * NCH * 256);
                    c.gu = M.get((size_t)8 * NCH * 8192); c.gatt = M.get((size_t)8 * NCH * 4096); c.go = M.get((size_t)T_ * 512);
                }
                c.z = c.proj; c.hout = a.out; c.lnw = a.in[1] + layer * 1024; c.lnb = a.in[2] + layer * 1024;
                M.off = scratch0; c.hid = M.get((size_t)T_ * 9 * 256);
                nv::Ctx& cm = ctab[layer * 2 + 1];
                cm = c; cm.hcur = a.out;
#ifdef DBG_LAYER
                if (layer == DBG_LAYER) { nv::Ctx& cd = ctab[4]; cd = cm;
                cd.hid = (float*)(a.ws + 48 * MiB); cd.z = (float*)(a.ws + 486 * MiB); cd.hcur = a.out + (size_t)DBG_T0 * 1024; cd.ridx = c.ridx + (size_t)DBG_T0 * 8; cd.rwt = c.rwt + (size_t)DBG_T0 * 8; }
#endif
            }
        }
        __syncthreads();
    }
    phase_p0(lds_raw);
    layer_body<0>(lds_raw);
    layer_body<1>(lds_raw);
#if defined(DBG_MIX0)
    phase_probe_apply(lds_raw);
#endif
}
extern "C" void kernel_launch(void* const* d_in, const int* in_sizes, int n_in, void* d_out, int out_size, void* d_ws, size_t ws_size, hipStream_t stream) {
    static int grid = 0;
    if (grid == 0) {
        int dev = 0, cus = 0, per_cu = 0;
        hipGetDevice(&dev); hipDeviceGetAttribute(&cus, hipDeviceAttributeMultiprocessorCount, dev);
        hipFuncSetAttribute((const void*)mega_fwd, hipFuncAttributeMaxDynamicSharedMemorySize, LDS_BYTES);
        hipOccupancyMaxActiveBlocksPerMultiprocessor(&per_cu, (const void*)mega_fwd, NTHREADS, LDS_BYTES);
        (void)hipGetLastError();
        grid = (per_cu >= 1) ? cus : -1;
    }
    if (grid < 0) return;
    hipMemsetAsync(d_ws, 0, CTL_BYTES, stream);
    Args a{};
    for (int i = 0; i < 38; ++i) a.in[i] = (const float*)d_in[i];
    a.out = (float*)d_out; a.ws = (unsigned char*)d_ws;
    hipLaunchKernelGGL(mega_fwd, dim3(grid), dim3(NTHREADS), LDS_BYTES, stream, a);
}
```

```cpp
#define OPT_MIX0 1
#define OPT_MIX1 1
#include <hip/hip_runtime.h>
#ifdef CPU_TEST
#include <cmath>
#include <cstddef>
#define HD inline
#define HDF inline
#else
#define HD __device__ __forceinline__
#define HDF __host__ __device__ __forceinline__
#endif

#ifndef SEQ_
#define SEQ_ 8192
#endif
namespace nv {
constexpr int B_ = 2, S_ = SEQ_, T_ = B_ * S_, D_ = 1024, NCH = S_ / 64;
constexpr int EIN = 3080, OIN = 2064;
constexpr int SLAB = (S_ < 1024 ? S_ : 1024);
constexpr float ALPHA = 1.41421356237309515f, EPS = 1e-5f;

enum Stage { ST_GEMM, ST_ML_GATES, ST_ML_CLOC, ST_ML_SCAN, ST_ML_MI, ST_ML_SMAT, ST_ML_DEN, ST_ML_H, ST_ML_NORM,
             ST_LRU_CONV, ST_LRU_GATE, ST_LRU_SCAN, ST_LN, ST_SCORES, ST_SELECT, ST_HID, ST_FFN,
             ST_S5_PAR, ST_S5_SCAN, ST_S5_OUT, ST_S5_GLU, ST_GLA_GATE, ST_GLA_CUM, ST_GLA_U, ST_GLA_SCAN, ST_GLA_ATT, ST_GLA_O, ST_GLA_NORM };

struct Ctx {
    const float* in[38];
    const float* gA; const float* gW; const float* gR; float* gC; const float* gBias;
    const float* hcur;
    float* hout;
    const float* lnw; const float* lnb;
    float* proj; float* mixed; float* z;
    float* mb; float* mig; float* mblast; float* mmloc; float* mmprev; float* cloc; float* nloc; float* smat; float* mmi; float* mwin; float* mden; float* htil;
    float* lxc; float* la; float* lu;
    float* scores; int* ridx; float* rwt; float* hid;
    float* s5ab; float* s5bbr; float* s5bbi; float* s5st; float* s5x; float* s5g;
    float* gla_la; float* gla_bc; float* gla_bl; float* gu; float* gatt; float* go;
    long gM, gN, gK, glda, gldw, gldc, gldr;
    long ldp;
    float gralpha; int layer; int slab; int pad0;
};

HD float sigm(float x) { return 1.0f / (1.0f + expf(-x)); }
HD float logsig(float x) { return fminf(x, 0.f) - log1pf(expf(-fabsf(x))); }
HD float softplus(float x) { return fmaxf(x, 0.f) + log1pf(expf(-fabsf(x))); }
HD float silu(float x) { return x * sigm(x); }
HD float gelu_t(float x) { return 0.5f * x * (1.0f + tanhf(0.7978845608028654f * (x + 0.044715f * x * x * x))); }

template <int ST> HD void item(const Ctx& c, long idx);

template <> HD void item<ST_GEMM>(const Ctx& c, long idx) {
    const long m = idx / c.gN, n = idx % c.gN;
    float acc = 0.f;
    const float* a = c.gA + m * c.glda; const float* w = c.gW + n;
    for (long k = 0; k < c.gK; ++k) acc += a[k] * w[k * c.gldw];
    if (c.gBias) acc += c.gBias[n];
    if (c.gR) acc += c.gralpha * c.gR[m * c.gldr + n];
    c.gC[m * c.gldc + n] = acc;
}
template <> HD void item<ST_ML_GATES>(const Ctx& c, long idx) {
    const int bh = (int)(idx / NCH), n = (int)(idx % NCH), b = bh / 4, h = bh % 4;
    const float* gb = c.in[7];
    const long t0 = (long)b * S_ + n * 64; const long o0 = (long)bh * S_ + n * 64;
    float acc = 0.f;
    for (int l = 0; l < 64; ++l) {
        const float f = c.proj[(t0 + l) * c.ldp + 2052 + h] + gb[4 + h];
        acc += logsig(f);
        c.mb[o0 + l] = acc;
        c.mig[o0 + l] = c.proj[(t0 + l) * c.ldp + 2048 + h] + gb[h];
    }
    c.mblast[idx] = acc;
    float ml = -INFINITY;
    for (int l = 0; l < 64; ++l) ml = fmaxf(ml, acc - c.mb[o0 + l] + c.mig[o0 + l]);
    c.mmloc[idx] = ml;
}
template <> HD void item<ST_ML_CLOC>(const Ctx& c, long idx) {
    const int e = (int)(idx % 128), d = (int)((idx / 128) % 128); const long cn = idx / 16384;
    const int bh = (int)(cn / NCH), n = (int)(cn % NCH), b = bh / 4, h = bh % 4;
    const long t0 = (long)b * S_ + n * 64; const long o0 = (long)bh * S_ + n * 64;
    const float bl = c.mblast[cn], ml = c.mmloc[cn]; const float sc = 0.08838834764831845f;
    float acc = 0.f, accn = 0.f;
    for (int l = 0; l < 64; ++l) {
        const float p = expf(bl - c.mb[o0 + l] + c.mig[o0 + l] - ml);
        const float kk = c.proj[(t0 + l) * c.ldp + 512 + h * 128 + d] * sc;
        acc += p * kk * c.proj[(t0 + l) * c.ldp + 1024 + h * 128 + e];
        accn += p * kk;
    }
    c.cloc[idx] = acc;
    if (e == 0) c.nloc[cn * 128 + d] = accn;
}
template <> HD void item<ST_ML_SCAN>(const Ctx& c, long idx) {
    const bool isn = idx >= 8L * 16384;
    long bh, de; float* buf; long stride;
    if (!isn) { bh = idx / 16384; de = idx % 16384; buf = c.cloc; stride = 16384; }
    else { const long r = idx - 8L * 16384; bh = r / 128; de = r % 128; buf = c.nloc; stride = 128; }
    float st = 0.f, m = 0.f;
    for (int n = 0; n < NCH; ++n) {
        const long cn = bh * NCH + n;
        const float cl = buf[cn * stride + de]; buf[cn * stride + de] = st;
        const float bl = c.mblast[cn], ml = c.mmloc[cn];
        const float mn = fmaxf(bl + m, ml);
        st = expf(bl + m - mn) * st + expf(ml - mn) * cl;
        if (!isn && de == 0) c.mmprev[cn] = m;
        m = mn;
    }
}
template <> HD void item<ST_ML_MI>(const Ctx& c, long idx) {
    const long bh = idx / S_; const int s = (int)(idx % S_), n = s / 64, i = s % 64; const long cn = bh * NCH + n;
    const long o0 = bh * S_ + n * 64;
    const float bi = c.mb[idx]; const float minter = bi + c.mmprev[cn];
    float dmax = -INFINITY;
    for (int j = 0; j <= i; ++j) dmax = fmaxf(dmax, bi - c.mb[o0 + j] + c.mig[o0 + j]);
    const float mi = fmaxf(minter, dmax);
    c.mmi[idx] = mi; c.mwin[idx] = expf(minter - mi);
}
template <> HD void item<ST_ML_SMAT>(const Ctx& c, long idx) {
    const int j = (int)(idx % 64), i = (int)((idx / 64) % 64); const long cn = idx / 4096;
    const int bh = (int)(cn / NCH), n = (int)(cn % NCH), b = bh / 4, h = bh % 4;
    if (j > i) { c.smat[idx] = 0.f; return; }
    const long t0 = (long)b * S_ + n * 64; const long o0 = (long)bh * S_ + n * 64;
    const float* q = c.proj + (t0 + i) * c.ldp + h * 128; const float* k = c.proj + (t0 + j) * c.ldp + 512 + h * 128;
    float dot = 0.f;
    for (int d = 0; d < 128; ++d) dot += q[d] * k[d];
    dot *= 0.08838834764831845f;
    c.smat[idx] = dot * expf(c.mb[o0 + i] - c.mb[o0 + j] + c.mig[o0 + j] - c.mmi[o0 + i]);
}
template <> HD void item<ST_ML_DEN>(const Ctx& c, long idx) {
    const long bh = idx / S_; const int s = (int)(idx % S_), n = s / 64, i = s % 64; const long cn = bh * NCH + n;
    const int b = (int)(bh / 4), h = (int)(bh % 4);
    float den = 0.f;
    for (int j = 0; j <= i; ++j) den += c.smat[cn * 4096 + i * 64 + j];
    const float* q = c.proj + ((long)b * S_ + s) * c.ldp + h * 128;
    float qn = 0.f;
    for (int d = 0; d < 128; ++d) qn += q[d] * c.nloc[cn * 128 + d];
    den += c.mwin[idx] * qn;
    c.mden[idx] = fmaxf(fabsf(den), expf(-c.mmi[idx]));
}
template <> HD void item<ST_ML_H>(const Ctx& c, long idx) {
    const int e = (int)(idx % 128); const long bs = idx / 128; const long bh = bs / S_; const int s = (int)(bs % S_), n = s / 64, i = s % 64;
    const long cn = bh * NCH + n; const int b = (int)(bh / 4), h = (int)(bh % 4);
    const long t0 = (long)b * S_ + n * 64;
    float num = 0.f;
    for (int j = 0; j <= i; ++j) num += c.smat[cn * 4096 + i * 64 + j] * c.proj[(t0 + j) * c.ldp + 1024 + h * 128 + e];
    const float* q = c.proj + (t0 + i) * c.ldp + h * 128;
    float qc = 0.f;
    for (int d = 0; d < 128; ++d) qc += q[d] * c.cloc[cn * 16384 + d * 128 + e];
    num += c.mwin[bs] * qc;
    c.htil[(t0 + i) * 512 + h * 128 + e] = num / c.mden[bs];
}
template <> HD void item<ST_ML_NORM>(const Ctx& c, long idx) {
    const long bh = idx / S_; const int s = (int)(idx % S_); const int b = (int)(bh / 4), h = (int)(bh % 4);
    const long t = (long)b * S_ + s;
    const float* ht = c.htil + t * 512 + h * 128; const float* nw = c.in[8];
    float mean = 0.f;
    for (int e = 0; e < 128; ++e) mean += ht[e];
    mean *= (1.f / 128.f);
    float var = 0.f;
    for (int e = 0; e < 128; ++e) { const float d = ht[e] - mean; var += d * d; }
    const float rstd = 1.0f / sqrtf(var * (1.f / 128.f) + EPS);
    for (int e = 0; e < 128; ++e)
        c.mixed[t * 1024 + h * 128 + e] = (ht[e] - mean) * rstd * nw[h * 128 + e] * sigm(c.proj[t * c.ldp + 1536 + h * 128 + e]);
}
template <> HD void item<ST_LRU_CONV>(const Ctx& c, long idx) {
    const long t = idx / 512; const int ch = (int)(idx % 512); const int s = (int)(t % S_);
    const float* cw = c.in[9];
    float acc = c.in[10][ch];
    for (int j = 0; j < 4; ++j) { const int ss = s - 3 + j; if (ss >= 0) acc += cw[j * 512 + ch] * c.proj[(t - 3 + j) * c.ldp + 2056 + ch]; }
    c.lxc[idx] = acc;
}
template <> HD void item<ST_LRU_GATE>(const Ctx& c, long idx) {
    const long t = idx / 512; const int ch = (int)(idx % 512), hh = ch / 128, jj = ch % 128;
    const float* wa = c.in[11] + (long)hh * 16384; const float* wx = c.in[13] + (long)hh * 16384;
    const float* xr = c.lxc + t * 512 + hh * 128;
    float ra = c.in[12][ch], xa = c.in[14][ch];
    for (int i = 0; i < 128; ++i) { ra += xr[i] * wa[i * 128 + jj]; xa += xr[i] * wx[i * 128 + jj]; }
    const float r = sigm(ra), ii = sigm(xa);
    const float la = -8.0f * r * softplus(-c.in[15][ch]);
    c.la[idx] = expf(la);
    c.lu[idx] = sqrtf(-expm1f(2.0f * la)) * ii * c.lxc[idx];
}
template <> HD void item<ST_LRU_SCAN>(const Ctx& c, long idx) {
    const int b = (int)(idx / 512), ch = (int)(idx % 512);
    float h = 0.f;
    for (int s = 0; s < S_; ++s) {
        const long t = (long)b * S_ + s;
        h = c.la[t * 512 + ch] * h + c.lu[t * 512 + ch];
        c.mixed[t * 1024 + 512 + ch] = h * gelu_t(c.proj[t * c.ldp + 2568 + ch]);
    }
}
template <> HD void item<ST_LN>(const Ctx& c, long t) {
    const float* zr = c.z + t * 1024;
    float mean = 0.f;
    for (int i = 0; i < 1024; ++i) mean += zr[i];
    mean *= (1.f / 1024.f);
    float var = 0.f;
    for (int i = 0; i < 1024; ++i) { const float d = zr[i] - mean; var += d * d; }
    const float rstd = 1.0f / sqrtf(var * (1.f / 1024.f) + EPS);
    for (int i = 0; i < 1024; ++i) c.hout[t * 1024 + i] = (zr[i] - mean) * rstd * c.lnw[i] + c.lnb[i];
}
template <> HD void item<ST_SCORES>(const Ctx& c, long idx) {
    const long t = idx / 64; const int e = (int)(idx % 64);
    const float* rw = c.in[30] + (long)c.layer * 1024 * 64; const float* hr = c.hcur + t * 1024;
    float acc = 0.f;
    for (int k = 0; k < 1024; ++k) acc += hr[k] * rw[k * 64 + e];
    c.scores[idx] = sigm(acc);
}
template <> HD void item<ST_SELECT>(const Ctx& c, long t) {
    const float* sc = c.scores + t * 64; const float* bias = c.in[31] + c.layer * 64;
    float gs[8];
#pragma unroll
    for (int g = 0; g < 8; ++g) {
        float m1 = -INFINITY, m2 = -INFINITY;
        for (int j = 0; j < 8; ++j) { const float v = sc[g * 8 + j] + bias[g * 8 + j]; if (v > m1) { m2 = m1; m1 = v; } else if (v > m2) m2 = v; }
        gs[g] = m1 + m2;
    }
    unsigned gsel = 0;
    for (int it = 0; it < 4; ++it) {
        float best = -INFINITY; int bi = 0;
#pragma unroll
        for (int g = 0; g < 8; ++g) { const bool ok = !((gsel >> g) & 1u) && gs[g] > best; best = ok ? gs[g] : best; bi = ok ? g : bi; }
        gsel |= 1u << bi;
    }
    unsigned long long taken = 0ull; float wsum = 0.f;
    for (int it = 0; it < 8; ++it) {
        float best = -INFINITY; int bi = 0;
        for (int e = 0; e < 64; ++e) {
            if (!((gsel >> (e >> 3)) & 1u) || ((taken >> e) & 1ull)) continue;
            const float v = sc[e] + bias[e];
            if (v > best) { best = v; bi = e; }
        }
        taken |= 1ull << bi;
        c.ridx[t * 8 + it] = bi; const float w = sc[bi]; c.rwt[t * 8 + it] = w; wsum += w;
    }
    const float inv = 2.5f / wsum;
    for (int it = 0; it < 8; ++it) c.rwt[t * 8 + it] *= inv;
}
template <> HD void item<ST_HID>(const Ctx& c, long idx) {
    const int j = (int)(idx % 256), k = (int)((idx / 256) % 9); const long t = idx / 2304;
    const float *wg, *wu;
    if (k < 8) { const long e = (long)c.layer * 64 + c.ridx[t * 8 + k]; wg = c.in[32] + e * 262144; wu = c.in[33] + e * 262144; }
    else { wg = c.in[35] + (long)c.layer * 262144; wu = c.in[36] + (long)c.layer * 262144; }
    const float* hr = c.hcur + t * 1024;
    float g = 0.f, u = 0.f;
    for (int d = 0; d < 1024; ++d) { const float x = hr[d]; g += x * wg[d * 256 + j]; u += x * wu[d * 256 + j]; }
    c.hid[idx] = silu(g) * u;
}
template <> HD void item<ST_FFN>(const Ctx& c, long idx) {
    const long t = idx / 1024; const int n = (int)(idx % 1024);
    float tot = 0.f;
    for (int k = 0; k < 9; ++k) {
        const float* wd; float w;
        if (k < 8) { const long e = (long)c.layer * 64 + c.ridx[t * 8 + k]; wd = c.in[34] + e * 262144; w = c.rwt[t * 8 + k]; }
        else { wd = c.in[37] + (long)c.layer * 262144; w = 1.f; }
        const float* hr = c.hid + (t * 9 + k) * 256;
        float acc = 0.f;
        for (int j = 0; j < 256; ++j) acc += hr[j] * wd[j * 1024 + n];
        tot += w * acc;
    }
    c.z[idx] = ALPHA * c.hcur[idx] + tot;
}
template <> HD void item<ST_S5_PAR>(const Ctx& c, long idx) {
    const int g = (int)(idx / 64);
    const float lr = c.in[17][idx], li = c.in[18][idx]; const float dt = expf(c.in[24][g]);
    const float mag = expf(lr * dt); const float ar = mag * cosf(li * dt), ai = mag * sinf(li * dt);
    const float den = lr * lr + li * li, nr = ar - 1.0f;
    const float cr = (nr * lr + ai * li) / den, ci = (ai * lr - nr * li) / den;
    c.s5ab[idx * 2] = ar; c.s5ab[idx * 2 + 1] = ai;
    for (int h = 0; h < 16; ++h) {
        const float br = c.in[19][idx * 16 + h], bi = c.in[20][idx * 16 + h];
        c.s5bbr[idx * 16 + h] = cr * br - ci * bi; c.s5bbi[idx * 16 + h] = cr * bi + ci * br;
    }
}
template <> HD void item<ST_S5_SCAN>(const Ctx& c, long idx) {
    const int gp = (int)(idx % 2048), g = gp / 64, b = (int)(idx / 2048);
    const float ar = c.s5ab[gp * 2], ai = c.s5ab[gp * 2 + 1];
    float xr = 0.f, xi = 0.f;
    if (c.slab > 0) { xr = c.s5st[idx * 2]; xi = c.s5st[idx * 2 + 1]; }
    for (int sl = 0; sl < SLAB; ++sl) {
        const long t = (long)b * S_ + (long)c.slab * SLAB + sl;
        const float* u = c.proj + t * c.ldp + g * 16;
        float br = 0.f, bi = 0.f;
        for (int h = 0; h < 16; ++h) { br += u[h] * c.s5bbr[gp * 16 + h]; bi += u[h] * c.s5bbi[gp * 16 + h]; }
        const float nr = ar * xr - ai * xi + br, ni = ar * xi + ai * xr + bi;
        xr = nr; xi = ni;
        const long o = (((long)b * SLAB + sl) * 2048 + gp) * 2;
        c.s5x[o] = xr; c.s5x[o + 1] = xi;
    }
    c.s5st[idx * 2] = xr; c.s5st[idx * 2 + 1] = xi;
}
template <> HD void item<ST_S5_OUT>(const Ctx& c, long idx) {
    const int ch = (int)(idx % 512), g = ch / 16; const long bs = idx / 512; const int b = (int)(bs / SLAB), sl = (int)(bs % SLAB);
    const long t = (long)b * S_ + (long)c.slab * SLAB + sl;
    const float* x = c.s5x + (bs * 2048 + g * 64) * 2; const float* cre = c.in[21] + ch * 64; const float* cim = c.in[22] + ch * 64;
    float y = 0.f;
    for (int p = 0; p < 64; ++p) y += x[2 * p] * cre[p] - x[2 * p + 1] * cim[p];
    y += c.in[23][ch] * c.proj[t * c.ldp + ch];
    c.s5g[t * 512 + ch] = gelu_t(y);
}
template <> HD void item<ST_S5_GLU>(const Ctx& c, long idx) {
    const long t = idx / 512; const int n = (int)(idx % 512);
    const float* gr = c.s5g + t * 512; const float* w = c.in[25];
    float acc = c.in[26][n];
    for (int k = 0; k < 512; ++k) acc += gr[k] * w[k * 512 + n];
    c.mixed[t * 1024 + n] = gr[n] * sigm(acc);
}
template <> HD void item<ST_GLA_GATE>(const Ctx& c, long idx) {
    const long t = idx / 256; const int ch = (int)(idx % 256);
    float acc = c.in[28][ch];
    for (int r = 0; r < 16; ++r) acc += c.proj[t * c.ldp + 2048 + r] * c.in[27][r * 256 + ch];
    c.gla_la[idx] = logsig(acc) * (1.0f / 16.0f);
}
template <> HD void item<ST_GLA_CUM>(const Ctx& c, long idx) {
    const int ch = (int)(idx % 256); const long bn = idx / 256; const int b = (int)(bn / NCH), n = (int)(bn % NCH);
    const long t0 = (long)b * S_ + n * 64;
    float acc = 0.f;
    for (int l = 0; l < 64; ++l) { acc += c.gla_la[(t0 + l) * 256 + ch]; c.gla_bc[(t0 + l) * 256 + ch] = acc; }
    c.gla_bl[idx] = acc;
}
template <> HD void item<ST_GLA_U>(const Ctx& c, long idx) {
    const int e = (int)(idx % 128), d = (int)((idx / 128) % 64); const long cn = idx / 8192;
    const int bh = (int)(cn / NCH), n = (int)(cn % NCH), b = bh / 4, h = bh % 4;
    const long t0 = (long)b * S_ + n * 64;
    const float bl = c.gla_bl[((long)b * NCH + n) * 256 + h * 64 + d];
    float acc = 0.f;
    for (int l = 0; l < 64; ++l)
        acc += c.proj[(t0 + l) * c.ldp + 768 + h * 64 + d] * expf(bl - c.gla_bc[(t0 + l) * 256 + h * 64 + d]) * c.proj[(t0 + l) * c.ldp + 1024 + h * 128 + e];
    c.gu[idx] = acc;
}
template <> HD void item<ST_GLA_SCAN>(const Ctx& c, long idx) {
    const long bh = idx / 8192; const int de = (int)(idx % 8192), d = de / 128; const int b = (int)(bh / 4), h = (int)(bh % 4);
    float st = 0.f;
    for (int n = 0; n < NCH; ++n) {
        const long cn = bh * NCH + n;
        const float u = c.gu[cn * 8192 + de]; c.gu[cn * 8192 + de] = st;
        st = expf(c.gla_bl[((long)b * NCH + n) * 256 + h * 64 + d]) * st + u;
    }
}
template <> HD void item<ST_GLA_ATT>(const Ctx& c, long idx) {
    const int j = (int)(idx % 64), i = (int)((idx / 64) % 64); const long cn = idx / 4096;
    const int bh = (int)(cn / NCH), n = (int)(cn % NCH), b = bh / 4, h = bh % 4;
    if (j > i) { c.gatt[idx] = 0.f; return; }
    const long ti = (long)b * S_ + n * 64 + i, tj = (long)b * S_ + n * 64 + j;
    float acc = 0.f;
    for (int d = 0; d < 64; ++d)
        acc += c.proj[ti * c.ldp + 512 + h * 64 + d] * 0.125f * expf(c.gla_bc[ti * 256 + h * 64 + d] - c.gla_bc[tj * 256 + h * 64 + d]) * c.proj[tj * c.ldp + 768 + h * 64 + d];
    c.gatt[idx] = acc;
}
template <> HD void item<ST_GLA_O>(const Ctx& c, long idx) {
    const int e = (int)(idx % 128); const long bs = idx / 128; const long bh = bs / S_; const int s = (int)(bs % S_), n = s / 64, i = s % 64;
    const long cn = bh * NCH + n; const int b = (int)(bh / 4), h = (int)(bh % 4);
    const long t0 = (long)b * S_ + n * 64, t = t0 + i;
    float acc = 0.f;
    for (int j = 0; j <= i; ++j) acc += c.gatt[cn * 4096 + i * 64 + j] * c.proj[(t0 + j) * c.ldp + 1024 + h * 128 + e];
    for (int d = 0; d < 64; ++d)
        acc += c.proj[t * c.ldp + 512 + h * 64 + d] * 0.125f * expf(c.gla_bc[t * 256 + h * 64 + d]) * c.gu[cn * 8192 + d * 128 + e];
    c.go[t * 512 + h * 128 + e] = acc;
}
template <> HD void item<ST_GLA_NORM>(const Ctx& c, long idx) {
    const long bh = idx / S_; const int s = (int)(idx % S_); const int b = (int)(bh / 4), h = (int)(bh % 4);
    const long t = (long)b * S_ + s;
    const float* o = c.go + t * 512 + h * 128;
    float ms = 0.f;
    for (int e = 0; e < 128; ++e) ms += o[e] * o[e];
    const float rstd = 1.0f / sqrtf(ms * (1.f / 128.f) + EPS);
    for (int e = 0; e < 128; ++e)
        c.mixed[t * 1024 + 512 + h * 128 + e] = o[e] * rstd * c.in[29][h * 128 + e] * silu(c.proj[t * c.ldp + 1536 + h * 128 + e]);
}

struct Mem { float* base; size_t off; HDF float* get(size_t n) { float* p = base + off; off += (n + 63) & ~(size_t)63; return p; } };

template <class Runner> HDF void forward(Runner& R, void* const* d_in, float* d_out, float* ws) {
    Ctx c{};
    for (int i = 0; i < 38; ++i) c.in[i] = (const float*)d_in[i];
    Mem M{ws, 0};
    c.z = M.get((size_t)T_ * 1024); c.mixed = M.get((size_t)T_ * 1024); c.scores = M.get((size_t)T_ * 64);
    c.ridx = (int*)M.get((size_t)T_ * 8); c.rwt = M.get((size_t)T_ * 8);
    const size_t scratch0 = M.off;
    for (int layer = 0; layer < 2; ++layer) {
        c.layer = layer;
        c.hcur = layer == 0 ? c.in[0] : d_out;
        M.off = scratch0;
        if (layer == 0) {
            c.ldp = EIN; c.proj = M.get((size_t)T_ * c.ldp);
            c.mb = M.get(8 * S_); c.mig = M.get(8 * S_); c.mblast = M.get(8 * NCH); c.mmloc = M.get(8 * NCH); c.mmprev = M.get(8 * NCH);
            c.mmi = M.get(8 * S_); c.mwin = M.get(8 * S_); c.mden = M.get(8 * S_); c.nloc = M.get(8 * NCH * 128);
            const size_t ov = M.off;
            c.cloc = M.get((size_t)8 * NCH * 16384); c.smat = M.get((size_t)8 * NCH * 4096); c.htil = M.get((size_t)T_ * 512);
            M.off = ov; c.lxc = M.get((size_t)T_ * 512); c.la = M.get((size_t)T_ * 512); c.lu = M.get((size_t)T_ * 512);
            c.gA = c.hcur; c.glda = 1024; c.gW = c.in[6]; c.gldw = EIN; c.gC = c.proj; c.gldc = EIN; c.gR = nullptr; c.gBias = nullptr; c.gM = T_; c.gN = EIN; c.gK = 1024;
            R.template run<ST_GEMM>(c, (long)T_ * c.ldp);
            R.template run<ST_ML_GATES>(c, 8L * NCH);
            R.template run<ST_ML_CLOC>(c, 8L * NCH * 16384);
            R.template run<ST_ML_SCAN>(c, 8L * 16384 + 8 * 128);
            R.template run<ST_ML_MI>(c, 8L * S_);
            R.template run<ST_ML_SMAT>(c, 8L * NCH * 4096);
            R.template run<ST_ML_DEN>(c, 8L * S_);
            R.template run<ST_ML_H>(c, 8L * S_ * 128);
            R.template run<ST_ML_NORM>(c, 8L * S_);
            R.template run<ST_LRU_CONV>(c, (long)T_ * 512);
            R.template run<ST_LRU_GATE>(c, (long)T_ * 512);
            R.template run<ST_LRU_SCAN>(c, 2L * 512);
        } else {
            c.ldp = OIN; c.proj = M.get((size_t)T_ * c.ldp);
            c.s5ab = M.get(2048 * 2); c.s5bbr = M.get(2048 * 16); c.s5bbi = M.get(2048 * 16); c.s5st = M.get(2 * 2048 * 2);
            c.s5x = M.get((size_t)B_ * SLAB * 2048 * 2); c.s5g = M.get((size_t)T_ * 512);
            c.gla_la = M.get((size_t)T_ * 256); c.gla_bc = M.get((size_t)T_ * 256); c.gla_bl = M.get((size_t)B_ * NCH * 256);
            c.gu = M.get((size_t)8 * NCH * 8192); c.gatt = M.get((size_t)8 * NCH * 4096); c.go = M.get((size_t)T_ * 512);
            c.gA = c.hcur; c.glda = 1024; c.gW = c.in[16]; c.gldw = OIN; c.gC = c.proj; c.gldc = OIN; c.gR = nullptr; c.gBias = nullptr; c.gM = T_; c.gN = OIN; c.gK = 1024;
            R.template run<ST_GEMM>(c, (long)T_ * c.ldp);
            R.template run<ST_S5_PAR>(c, 2048);
            for (int sl = 0; sl < S_ / SLAB; ++sl) { c.slab = sl; R.template run<ST_S5_SCAN>(c, 2L * 2048); R.template run<ST_S5_OUT>(c, (long)B_ * SLAB * 512); }
            c.slab = 0;
            R.template run<ST_S5_GLU>(c, (long)T_ * 512);
            R.template run<ST_GLA_GATE>(c, (long)T_ * 256);
            R.template run<ST_GLA_CUM>(c, (long)B_ * NCH * 256);
            R.template run<ST_GLA_U>(c, 8L * NCH * 8192);
            R.template run<ST_GLA_SCAN>(c, 8L * 8192);
            R.template run<ST_GLA_ATT>(c, 8L * NCH * 4096);
            R.template run<ST_GLA_O>(c, 8L * S_ * 128);
            R.template run<ST_GLA_NORM>(c, 8L * S_);
        }
        c.gA = c.mixed; c.glda = 1024; c.gW = c.in[5] + (size_t)layer * 1024 * 1024; c.gldw = 1024; c.gC = c.z; c.gldc = 1024; c.gR = c.hcur; c.gldr = 1024; c.gralpha = ALPHA; c.gM = T_; c.gN = 1024; c.gK = 1024;
        R.template run<ST_GEMM>(c, (long)T_ * 1024);
        c.gR = nullptr;
        c.hout = d_out; c.lnw = c.in[1] + layer * 1024; c.lnb = c.in[2] + layer * 1024;
        R.template run<ST_LN>(c, T_);
        c.hcur = d_out;
        M.off = scratch0; c.hid = M.get((size_t)T_ * 9 * 256);
        R.template run<ST_SCORES>(c, (long)T_ * 64);
        R.template run<ST_SELECT>(c, T_);
        R.template run<ST_HID>(c, (long)T_ * 9 * 256);
        R.template run<ST_FFN>(c, (long)T_ * 1024);
        c.lnw = c.in[3] + layer * 1024; c.lnb = c.in[4] + layer * 1024;
        R.template run<ST_LN>(c, T_);
    }
}
}
#define GAS __attribute__((address_space(1)))
#define LAS __attribute__((address_space(3)))
#define XB_TMO      128
#define XB_XCNT(j)  (256  + 64 * (j))
#define XB_XSUB(j)  (1280 + 64 * (j))
#define XB_XGEN(j)  (2304 + 64 * (j))
#define XB_TOP      3328
#define XB_TOPGEN   3392
#define XCD_BAR_WORDS 3456
#define XB_SPIN_CAP (1u << 22)
__device__ __forceinline__ unsigned xb_ld(unsigned* p)              { return __hip_atomic_load(p, __ATOMIC_RELAXED, __HIP_MEMORY_SCOPE_AGENT); }
__device__ __forceinline__ unsigned xb_add(unsigned* p, unsigned v) { return __hip_atomic_fetch_add(p, v, __ATOMIC_RELAXED, __HIP_MEMORY_SCOPE_AGENT); }
__device__ __forceinline__ unsigned xb_xcc_id() { return (unsigned)__builtin_amdgcn_s_getreg((3 << 11) | 20) & 0xFu; }
#define XB_SPIN(cond, bar) do { unsigned _sp = 0; while (cond) { __builtin_amdgcn_s_sleep(1); \
    if ((++_sp & 255u) == 0u) { if (xb_ld(&(bar)[XB_TMO])) break; if (_sp > XB_SPIN_CAP) { atomicAdd(&(bar)[XB_TMO], 1u); break; } } } } while (0)
struct XcdBarrier { unsigned* bar; unsigned x; volatile LAS unsigned* st; };
__device__ __forceinline__ XcdBarrier xcd_barrier_post(unsigned* bar, volatile LAS unsigned* st) {
    XcdBarrier b; b.bar = bar; b.x = xb_xcc_id(); b.st = st;
    if (threadIdx.x == 0) (void)xb_add(&bar[XB_XCNT(b.x)], 1u);
    return b;
}
__device__ __forceinline__ void xcd_barrier_complete(unsigned* bar, unsigned x, unsigned& nloc, unsigned& nx) {
    const unsigned G = gridDim.x * gridDim.y * gridDim.z;
    unsigned sum, cnt, mine, sp = 0u;
    for (;;) {
        sum = 0u; cnt = 0u; mine = 0u;
#pragma unroll
        for (unsigned j = 0; j < 16; ++j) { const unsigned c = xb_ld(&bar[XB_XCNT(j)]); sum += c; cnt += (c > 0u) ? 1u : 0u; mine = (j == x) ? c : mine; }
        if (sum == G) break;
        __builtin_amdgcn_s_sleep(1);
        if ((++sp & 255u) == 0u) { if (xb_ld(&bar[XB_TMO])) break; if (sp > XB_SPIN_CAP) { atomicAdd(&bar[XB_TMO], 1u); break; } }
    }
    nloc = mine > 0u ? mine : 1u; nx = cnt > 0u ? cnt : 1u;
}
__device__ __forceinline__ void xcd_barrier(const XcdBarrier& b) {
    asm volatile("s_waitcnt vmcnt(0)" ::: "memory");
    __syncthreads();
    if (threadIdx.x == 0) {
        unsigned* bar = b.bar;
        __builtin_amdgcn_s_waitcnt(0);
        unsigned nloc = b.st[0], nx = b.st[1];
        if (nloc == 0u) { xcd_barrier_complete(bar, b.x, nloc, nx); b.st[0] = nloc; b.st[1] = nx; }
        const unsigned old = xb_add(&bar[XB_XSUB(b.x)], 1u);
        const unsigned gen = old / nloc;
        if (old + 1u == (gen + 1u) * nloc) {
            __builtin_amdgcn_fence(__ATOMIC_RELEASE, "agent");
            asm volatile("s_waitcnt vmcnt(0)" ::: "memory");
            const unsigned og = xb_add(&bar[XB_TOP], 1u);
            const unsigned tg = og / nx;
            if (og + 1u == (tg + 1u) * nx) xb_add(&bar[XB_TOPGEN], 1u);
            else XB_SPIN(xb_ld(&bar[XB_TOPGEN]) == tg, bar);
            __builtin_amdgcn_fence(__ATOMIC_ACQUIRE, "agent");
            xb_add(&bar[XB_XGEN(b.x)], 1u);
            asm volatile("s_waitcnt vmcnt(0)" ::: "memory");
        } else {
            XB_SPIN(xb_ld(&bar[XB_XGEN(b.x)]) == gen, bar);
            __builtin_amdgcn_fence(__ATOMIC_ACQUIRE, "agent");
            asm volatile("s_waitcnt vmcnt(0)" ::: "memory");
        }
    }
    __syncthreads();
}
namespace pg8 {
#define PG8_LAS __attribute__((address_space(3)))
typedef unsigned short bf16_t;
typedef short bf16x8 __attribute__((ext_vector_type(8)));
typedef float f32x4 __attribute__((ext_vector_type(4)));
typedef unsigned u32x4 __attribute__((ext_vector_type(4)));
constexpr int BM = 256, BK = 64, HALF = 128, HTB = HALF * BK * 2, STAGE_BYTES = 8 * HTB, NXCD = 8, WGM = 8;
__host__ __device__ __forceinline__ int lds_byte(int r, int c) { const int st = (r >> 4) * 2 + (c >> 5), rr = r & 15, cc = c & 31, ob = rr * 64 + cc * 2; return st * 1024 + (ob ^ (((ob >> 9) & 1) << 5)); }
__host__ __device__ __forceinline__ void stage_rc(int b, int& R, int& C) { const int st = b / 1024, sb = b % 1024, swz = sb ^ (((sb >> 9) & 1) << 5); R = (st >> 1) * 16 + swz / 64; C = (st & 1) * 32 + (swz % 64) / 2; }
__host__ __device__ __forceinline__ int perm32(int rho) { const int n = rho >> 4, i = rho & 15; return 8 * (i >> 2) + 4 * n + (i & 3); }
struct Unit { int pm, pn, e, aux; };
struct Gemm { const bf16_t* A; const bf16_t* Bt; int K; int pad; size_t bstride; const int* rows; };
struct StaticOrder {
    int nM, nN, nwg, G, c;
    __host__ __device__ void init(int M, int N, int G_, int c_) { nM = M / BM; nN = N / BM; nwg = nM * nN; G = G_; c = c_; }
    __host__ __device__ bool next(int i, Unit& u) const {
        const long L = (long)i * G + c; if (L >= nwg) return false;
        int wgid = (int)L; { const int q = nwg / NXCD, r = nwg % NXCD, xcd = wgid % NXCD, off = wgid / NXCD; wgid = (xcd < r ? xcd * (q + 1) : r * (q + 1) + (xcd - r) * q) + off; }
        const int nig = WGM * nN, gid = wgid / nig, fm = gid * WGM, gsz = (nM - fm) < WGM ? (nM - fm) : WGM;
        u.pm = fm + ((wgid % nig) % gsz); u.pn = (wgid % nig) / gsz; u.e = 0; u.aux = 0; return true;
    }
};
__device__ __forceinline__ unsigned cvt_pk_bf16(float lo, float hi) { unsigned r; asm volatile("v_cvt_pk_bf16_f32 %0, %1, %2" : "=v"(r) : "v"(lo), "v"(hi)); return r; }
struct EpiF32R {
    static constexpr bool PERM = false;
    float* C; int ldc; const float* R; float ralpha;
    __device__ __forceinline__ void operator()(const f32x4 (&acc)[2][2][4][2], const Unit& u, int wr, int wc, int fr, int fq) const {
        const int row0 = u.pm * BM + wr * 64 + fr, col0 = u.pn * BM + wc * 32 + 4 * fq;
#pragma unroll
        for (int ai = 0; ai < 2; ++ai)
#pragma unroll
            for (int m = 0; m < 4; ++m) { const size_t off = (size_t)(row0 + ai * HALF + m * 16) * ldc + col0;
#pragma unroll
                for (int bj = 0; bj < 2; ++bj)
#pragma unroll
                    for (int n = 0; n < 2; ++n) { f32x4 v = acc[ai][bj][m][n]; if (R) v = v + ralpha * *(const f32x4*)(R + off + bj * HALF + n * 16); *(f32x4*)(C + off + bj * HALF + n * 16) = v; } }
    }
};
struct EpiBf16P {
    static constexpr bool PERM = true;
    bf16_t* O; int ldc;
    __device__ __forceinline__ void operator()(const f32x4 (&acc)[2][2][4][2], const Unit& u, int wr, int wc, int fr, int fq) const {
        const int row0 = u.pm * BM + wr * 64 + fr, col0 = u.pn * BM + wc * 32 + 8 * fq;
#pragma unroll
        for (int ai = 0; ai < 2; ++ai)
#pragma unroll
            for (int m = 0; m < 4; ++m) { bf16_t* rowp = O + (size_t)(row0 + ai * HALF + m * 16) * ldc + col0;
#pragma unroll
                for (int bj = 0; bj < 2; ++bj) { const f32x4 v0 = acc[ai][bj][m][0], v1 = acc[ai][bj][m][1];
                    u32x4 w; w.x = cvt_pk_bf16(v0[0], v0[1]); w.y = cvt_pk_bf16(v0[2], v0[3]); w.z = cvt_pk_bf16(v1[0], v1[1]); w.w = cvt_pk_bf16(v1[2], v1[3]);
                    *(u32x4*)(rowp + bj * HALF) = w; } }
    }
};
struct EpiGlu {
    static constexpr bool PERM = true;
    bf16_t* O; int ldo; const bf16_t* Gm; int ldg; const float* bias;
    __device__ __forceinline__ void operator()(const f32x4 (&acc)[2][2][4][2], const Unit& u, int wr, int wc, int fr, int fq) const {
        const int row0 = u.pm * BM + wr * 64 + fr, col0 = u.pn * BM + wc * 32 + 8 * fq;
#pragma unroll
        for (int ai = 0; ai < 2; ++ai)
#pragma unroll
            for (int m = 0; m < 4; ++m) { const size_t r = (size_t)(row0 + ai * HALF + m * 16);
#pragma unroll
                for (int bj = 0; bj < 2; ++bj) { const int c = col0 + bj * HALF;
                    const f32x4 b0 = *(const f32x4*)(bias + c), b1 = *(const f32x4*)(bias + c + 4); const u32x4 gv = *(const u32x4*)(Gm + r * ldg + c);
                    const f32x4 v0 = acc[ai][bj][m][0] + b0, v1 = acc[ai][bj][m][1] + b1;
                    float g[8] = {__builtin_bit_cast(float, gv.x << 16), __builtin_bit_cast(float, gv.x & 0xffff0000u), __builtin_bit_cast(float, gv.y << 16), __builtin_bit_cast(float, gv.y & 0xffff0000u),
                                  __builtin_bit_cast(float, gv.z << 16), __builtin_bit_cast(float, gv.z & 0xffff0000u), __builtin_bit_cast(float, gv.w << 16), __builtin_bit_cast(float, gv.w & 0xffff0000u)};
                    u32x4 w; w.x = cvt_pk_bf16(g[0] / (1.f + __expf(-v0[0])), g[1] / (1.f + __expf(-v0[1]))); w.y = cvt_pk_bf16(g[2] / (1.f + __expf(-v0[2])), g[3] / (1.f + __expf(-v0[3])));
                    w.z = cvt_pk_bf16(g[4] / (1.f + __expf(-v1[0])), g[5] / (1.f + __expf(-v1[1]))); w.w = cvt_pk_bf16(g[6] / (1.f + __expf(-v1[2])), g[7] / (1.f + __expf(-v1[3])));
                    *(u32x4*)(O + r * ldo + c) = w; } }
    }
};
template <class Epi, class Sched, bool ALIGN_EPI, bool GATHER>
__device__ __forceinline__ void gemm_phase(PG8_LAS unsigned char* lds, const Gemm g, const Sched& S, const Epi& E) {
    int tid_ = threadIdx.x; asm volatile("" : "+v"(tid_));
    const int tid = tid_, wid = __builtin_amdgcn_readfirstlane(tid >> 6), lane = tid & 63, wr = wid >> 2, wc = wid & 3, fr = lane & 15, fq = lane >> 4;
    const int K = g.K, nt = K / BK;
    unsigned voffA[2], voffB[2];
#pragma unroll
    for (int i = 0; i < 2; ++i) { int R, C; stage_rc(tid * 16 + i * 8192, R, C); const int Rb = Epi::PERM ? ((R & ~31) + perm32(R & 31)) : R;
        voffA[i] = (unsigned)(R * K + C) * 2u; voffB[i] = (unsigned)(Rb * K + C) * 2u; }
    const size_t kstep = (size_t)(BK * 2);
    const size_t hstep = (size_t)HALF * K * 2;
    const size_t tstep = 2 * hstep;
    const unsigned ldsw = (unsigned)wid * 1024u;
    const int aoff = lds_byte(wr * 64 + fr, fq * 8), boff = lds_byte(wc * 32 + fr, fq * 8);
#define PG8_SA(b, h) (((b) * 2 + (h)) * HTB)
#define PG8_SB(b, h) ((4 + (b) * 2 + (h)) * HTB)
#define PG8_STAGE(bufoff, gbase, voff) do { _Pragma("unroll") for (int _i = 0; _i < 2; ++_i) { unsigned _vo = (voff)[_i]; asm volatile("" : "+v"(_vo));   \
        __builtin_amdgcn_global_load_lds((const unsigned*)((const char*)(gbase) + _vo), (PG8_LAS unsigned*)(lds + (bufoff) + ldsw + _i * 8192), 16, 0, 0); } } while (0)
#define PG8_STAGE_A(bufoff, gbase, h, GV) do { if constexpr (GATHER) { PG8_STAGE(bufoff, gbase, GV[h]); } else { PG8_STAGE(bufoff, (gbase) + (h) * hstep, voffA); } } while (0)
#define PG8_STAGE_A2(bufoff, gbase, h) do { if constexpr (GATHER) { unsigned _gv[2] = {last ? gnxt[h][0] : gcur[h][0], last ? gnxt[h][1] : gcur[h][1]}; PG8_STAGE(bufoff, gbase, _gv); } else { PG8_STAGE(bufoff, (gbase) + (h) * hstep, voffA); } } while (0)
#define PG8_LDA(dst, b, h) do { _Pragma("unroll") for (int m = 0; m < 4; ++m) _Pragma("unroll") for (int k = 0; k < 2; ++k) dst[m][k] = *(const PG8_LAS bf16x8*)(lds + PG8_SA(b, h) + aoff + m * 2048 + k * 1024); } while (0)
#define PG8_LDB(dst, b, h) do { _Pragma("unroll") for (int n = 0; n < 2; ++n) _Pragma("unroll") for (int k = 0; k < 2; ++k) dst[n][k] = *(const PG8_LAS bf16x8*)(lds + PG8_SB(b, h) + boff + n * 2048 + k * 1024); } while (0)
#define PG8_MMA(ai, bj, At, Bt) do { __builtin_amdgcn_s_setprio(1); _Pragma("unroll") for (int m = 0; m < 4; ++m) _Pragma("unroll") for (int n = 0; n < 2; ++n) _Pragma("unroll") for (int k = 0; k < 2; ++k) \
        acc[ai][bj][m][n] = __builtin_amdgcn_mfma_f32_16x16x32_bf16(Bt[n][k], At[m][k], acc[ai][bj][m][n], 0, 0, 0); __builtin_amdgcn_s_setprio(0); } while (0)
#define PG8_WAIT_V(n) asm volatile("s_waitcnt vmcnt(" #n ")" ::: "memory")
#define PG8_WAIT_L(n) asm volatile("s_waitcnt lgkmcnt(" #n ")" ::: "memory")
#define PG8_BAR __builtin_amdgcn_s_barrier()
#define PG8_SCHED __builtin_amdgcn_sched_barrier(0)
#define PG8_GLOAD(GV, u) do { _Pragma("unroll") for (int _i = 0; _i < 2; ++_i) { int _R, _C; stage_rc(tid * 16 + _i * 8192, _R, _C); _Pragma("unroll") for (int _h = 0; _h < 2; ++_h) \
        GV[_h][_i] = (unsigned)g.rows[(u).pm * BM + _h * HALF + _R] * (unsigned)(K * 2) + (unsigned)(_C * 2); } } while (0)
    Unit cur, nxt; int ui = 0;
    if (!S.next(0, cur)) return;
    f32x4 acc[2][2][4][2];
#pragma unroll
    for (int a = 0; a < 2; ++a)
#pragma unroll
        for (int b = 0; b < 2; ++b)
#pragma unroll
            for (int m = 0; m < 4; ++m)
#pragma unroll
                for (int n = 0; n < 2; ++n) acc[a][b][m][n] = (f32x4){0.f, 0.f, 0.f, 0.f};
    bf16x8 At[4][2], B0[2][2], B1[2][2];
    unsigned gcur[2][2] = {{0u, 0u}, {0u, 0u}}, gnxt[2][2] = {{0u, 0u}, {0u, 0u}};
    if constexpr (GATHER) { PG8_GLOAD(gcur, cur); }
    const char* cA = GATHER ? (const char*)g.A : (const char*)g.A + (size_t)cur.pm * tstep;
    const char* cB = (const char*)g.Bt + ((size_t)cur.e * g.bstride) * 2 + (size_t)cur.pn * tstep;
    PG8_STAGE(PG8_SB(0, 0), cB, voffB); PG8_STAGE(PG8_SB(0, 1), cB + hstep, voffB); PG8_STAGE_A(PG8_SA(0, 0), cA, 0, gcur); PG8_STAGE_A(PG8_SA(0, 1), cA, 1, gcur);
    if (wr == 1) PG8_BAR;
    PG8_WAIT_V(2); PG8_BAR;
    PG8_STAGE(PG8_SB(1, 0), cB + kstep, voffB); PG8_STAGE_A(PG8_SA(1, 0), cA + kstep, 0, gcur); PG8_STAGE(PG8_SB(1, 1), cB + hstep + kstep, voffB);
    PG8_WAIT_V(6); PG8_BAR;
    for (;;) {
        const bool has_next = S.next(ui + 1, nxt);
        if constexpr (GATHER) { if (has_next) { PG8_GLOAD(gnxt, nxt); } else {
#pragma unroll
            for (int _h = 0; _h < 2; ++_h)
#pragma unroll
                for (int _i = 0; _i < 2; ++_i) gnxt[_h][_i] = gcur[_h][_i]; } }
        const char* nA = GATHER ? cA : (has_next ? (const char*)g.A + (size_t)nxt.pm * tstep : cA);
        const char* nB = has_next ? (const char*)g.Bt + ((size_t)nxt.e * g.bstride) * 2 + (size_t)nxt.pn * tstep : cB;
#pragma unroll 1
        for (int t = 0; t < nt; t += 2) {
            const bool last = (t == nt - 2);
            const char* a1 = cA + (size_t)(t + 1) * kstep;
            const char* a2 = last ? nA : cA + (size_t)(t + 2) * kstep; const char* b2 = last ? nB : cB + (size_t)(t + 2) * kstep;
            const char* a3 = a2 + kstep; const char* b3 = b2 + kstep;
            PG8_LDB(B0, 0, 0); PG8_LDB(B1, 0, 1); PG8_SCHED; PG8_LDA(At, 0, 0); PG8_STAGE_A(PG8_SA(1, 1), a1, 1, gcur);
            PG8_WAIT_V(8); PG8_WAIT_L(0); PG8_BAR; PG8_MMA(0, 0, At, B0); PG8_MMA(0, 1, At, B1); PG8_BAR; PG8_SCHED;
            PG8_LDA(At, 0, 1); PG8_STAGE(PG8_SB(0, 0), b2, voffB); PG8_STAGE(PG8_SB(0, 1), b2 + hstep, voffB); PG8_STAGE_A2(PG8_SA(0, 0), a2, 0);
            PG8_WAIT_V(8); PG8_WAIT_L(0); PG8_BAR; PG8_MMA(1, 0, At, B0); PG8_MMA(1, 1, At, B1); PG8_BAR; PG8_SCHED;
            PG8_LDB(B0, 1, 0); PG8_LDB(B1, 1, 1); PG8_SCHED; PG8_LDA(At, 1, 0); PG8_STAGE_A2(PG8_SA(0, 1), a2, 1);
            PG8_WAIT_V(8); PG8_WAIT_L(0); PG8_BAR; PG8_MMA(0, 0, At, B0); PG8_MMA(0, 1, At, B1); PG8_BAR; PG8_SCHED;
            PG8_LDA(At, 1, 1); PG8_STAGE(PG8_SB(1, 0), b3, voffB); PG8_STAGE(PG8_SB(1, 1), b3 + hstep, voffB); PG8_STAGE_A2(PG8_SA(1, 0), a3, 0);
            PG8_WAIT_V(8); PG8_WAIT_L(0); PG8_BAR; PG8_MMA(1, 0, At, B0); PG8_MMA(1, 1, At, B1); PG8_BAR; PG8_SCHED;
        }
        if constexpr (ALIGN_EPI) { if (wr == 0) PG8_BAR; }
        E(acc, cur, wr, wc, fr, fq);
        if (!has_next) break;
#pragma unroll
        for (int a = 0; a < 2; ++a)
#pragma unroll
            for (int b = 0; b < 2; ++b)
#pragma unroll
                for (int m = 0; m < 4; ++m)
#pragma unroll
                    for (int n = 0; n < 2; ++n) acc[a][b][m][n] = (f32x4){0.f, 0.f, 0.f, 0.f};
        cur = nxt; cA = nA; cB = nB; ++ui;
        if constexpr (GATHER) {
#pragma unroll
            for (int _h = 0; _h < 2; ++_h)
#pragma unroll
                for (int _i = 0; _i < 2; ++_i) gcur[_h][_i] = gnxt[_h][_i]; }
        if constexpr (ALIGN_EPI) { if (wr == 1) PG8_BAR; }
    }
    PG8_WAIT_V(0);
    if constexpr (!ALIGN_EPI) { if (wr == 0) PG8_BAR; }
    PG8_BAR;
#undef PG8_SA
#undef PG8_SB
#undef PG8_STAGE
#undef PG8_STAGE_A
#undef PG8_STAGE_A2
#undef PG8_LDA
#undef PG8_LDB
#undef PG8_MMA
#undef PG8_WAIT_V
#undef PG8_WAIT_L
#undef PG8_BAR
#undef PG8_SCHED
#undef PG8_GLOAD
}
}
typedef unsigned short bf16;
typedef unsigned v4u __attribute__((ext_vector_type(4)));
typedef unsigned v2u __attribute__((ext_vector_type(2)));
typedef float f32x4 __attribute__((ext_vector_type(4)));
constexpr int NTHREADS = 512, NWAVES = 8;
constexpr int LDS_BYTES = 147456;
constexpr int MISC_OFF = 131072 + 320;
constexpr size_t MiB = 1u << 20;
constexpr size_t CTL_BYTES = 1 * MiB;
constexpr int T_ = nv::T_, S_ = nv::S_, NCH = nv::NCH;
constexpr int EINP = 3328, OINP = 2304;
#define LDS_WAIT() asm volatile("s_waitcnt lgkmcnt(0)" ::: "memory")
__device__ __forceinline__ unsigned f2bf(float f) { unsigned u = __builtin_bit_cast(unsigned, f); return (u + 0x7fffu + ((u >> 16) & 1u)) >> 16; }
__device__ __forceinline__ unsigned pk2(float lo, float hi) { return f2bf(lo) | (f2bf(hi) << 16); }
__device__ __forceinline__ float bf2f(unsigned short b) { return __builtin_bit_cast(float, (unsigned)b << 16); }
__device__ __forceinline__ void tr_item(const float* W, long ldw, int nvalid, bf16* dst, long ldd, LAS float* scr, int lane) {
#pragma unroll 8
    for (int i = 0; i < 32; ++i) { const int kk = 2 * i + (lane >> 5), nn = lane & 31; scr[kk * 33 + nn] = nn < nvalid ? W[(long)kk * ldw + nn] : 0.f; }
    LDS_WAIT(); asm volatile("" ::: "memory");
    const int c = lane & 7;
#pragma unroll
    for (int j = 0; j < 4; ++j) { const int n = (lane >> 3) + 8 * j; const LAS float* s = scr + (8 * c) * 33 + n;
        v4u o; o.x = pk2(s[0 * 33], s[1 * 33]); o.y = pk2(s[2 * 33], s[3 * 33]); o.z = pk2(s[4 * 33], s[5 * 33]); o.w = pk2(s[6 * 33], s[7 * 33]);
        *(v4u*)(dst + (long)n * ldd + 8 * c) = o; }
    LDS_WAIT(); asm volatile("" ::: "memory");
}
__device__ __forceinline__ void tr_matrix(const float* W, int K, int N, int NP, bf16* WT, LAS float* scr, int gw, int NGW, int lane) {
    const int nblk = NP / 32, nitems = (K / 64) * nblk;
    for (int it = gw; it < nitems; it += NGW) { const int kb = it / nblk, nb = it % nblk, k0 = 64 * kb, n0 = 32 * nb; int nvalid = N - n0; nvalid = nvalid < 0 ? 0 : (nvalid > 32 ? 32 : nvalid);
        tr_item(W + (long)k0 * N + n0, N, nvalid, WT + (long)n0 * K + k0, K, scr, lane); }
}
__device__ __forceinline__ void cvt_rows(const float* src, bf16* dst, long n, long gtid, long gsz) {
    for (long i = gtid * 8; i < n; i += gsz * 8) { const f32x4 a = *(const f32x4*)(src + i), b = *(const f32x4*)(src + i + 4);
        v4u o; o.x = pk2(a.x, a.y); o.y = pk2(a.z, a.w); o.z = pk2(b.x, b.y); o.w = pk2(b.z, b.w); *(v4u*)(dst + i) = o; }
}
__device__ __forceinline__ int sopaque(int v) { asm volatile("" : "+s"(v)); return v; }
__device__ __forceinline__ float wave_sum(float v) {
#define WS_STEP(o) v += __builtin_bit_cast(float, __builtin_amdgcn_ds_swizzle(__builtin_bit_cast(int, v), 0x1f | ((o) << 10)))
    WS_STEP(1); WS_STEP(2); WS_STEP(4); WS_STEP(8); WS_STEP(16);
#undef WS_STEP
    return __builtin_bit_cast(float, __builtin_amdgcn_readlane(__builtin_bit_cast(int, v), 0)) + __builtin_bit_cast(float, __builtin_amdgcn_readlane(__builtin_bit_cast(int, v), 32));
}
#ifndef DBG_SCALE
#define DBG_SCALE 20.0f
#endif
constexpr int MOE_MAXBLK = 640;
constexpr int CW_CNT = 8192, CW_CUR = 8192 + 128;
namespace pg8 {
struct MoeOrder {
    const int* blk_e; int nblk, npn, G, c;
    __device__ __forceinline__ bool next(int i, Unit& u) const {
        const long L = (long)i * G + c; if (L >= (long)nblk * npn) return false;
        const int blk = (int)(L / npn); u.pm = blk; u.pn = (int)(L % npn); u.e = __builtin_amdgcn_readfirstlane(blk_e[blk]); u.aux = 0; return true;
    }
};
__device__ __forceinline__ float silu_f(float x) { return x / (1.0f + __expf(-x)); }
struct EpiSwiGLU {
    static constexpr bool PERM = true;
    bf16_t* H;
    __device__ __forceinline__ void operator()(const f32x4 (&acc)[2][2][4][2], const Unit& u, int wr, int wc, int fr, int fq) const {
        const int row0 = u.pm * BM + wr * 64 + fr, col0 = u.pn * 128 + wc * 32 + 8 * fq;
#pragma unroll
        for (int ai = 0; ai < 2; ++ai)
#pragma unroll
            for (int m = 0; m < 4; ++m) { bf16_t* rowp = H + (size_t)(row0 + ai * HALF + m * 16) * 256 + col0;
                const f32x4 g0 = acc[ai][0][m][0], g1 = acc[ai][0][m][1], u0 = acc[ai][1][m][0], u1 = acc[ai][1][m][1];
                u32x4 w; w.x = cvt_pk_bf16(silu_f(g0[0]) * u0[0], silu_f(g0[1]) * u0[1]); w.y = cvt_pk_bf16(silu_f(g0[2]) * u0[2], silu_f(g0[3]) * u0[3]);
                w.z = cvt_pk_bf16(silu_f(g1[0]) * u1[0], silu_f(g1[1]) * u1[1]); w.w = cvt_pk_bf16(silu_f(g1[2]) * u1[2], silu_f(g1[3]) * u1[3]);
                *(u32x4*)rowp = w; }
    }
};
struct EpiDown {
    static constexpr bool PERM = true;
    bf16_t* rows8; bf16_t* rows_sh; const int* dest; const float* w; int nslot8;
    __device__ __forceinline__ void operator()(const f32x4 (&acc)[2][2][4][2], const Unit& u, int wr, int wc, int fr, int fq) const {
        const int row0 = u.pm * BM + wr * 64 + fr, col0 = u.pn * BM + wc * 32 + 8 * fq;
#pragma unroll
        for (int ai = 0; ai < 2; ++ai)
#pragma unroll
            for (int m = 0; m < 4; ++m) { const int r = row0 + ai * HALF + m * 16; const int d = dest[r]; const float ww = w[r];
                if (d >= 0) { bf16_t* rowp = (d < nslot8 ? rows8 + (size_t)d * 1024 : rows_sh + (size_t)(d - nslot8) * 1024) + col0;
#pragma unroll
                    for (int bj = 0; bj < 2; ++bj) { const f32x4 v0 = acc[ai][bj][m][0] * ww, v1 = acc[ai][bj][m][1] * ww;
                        u32x4 o; o.x = cvt_pk_bf16(v0[0], v0[1]); o.y = cvt_pk_bf16(v0[2], v0[3]); o.z = cvt_pk_bf16(v1[0], v1[1]); o.w = cvt_pk_bf16(v1[2], v1[3]);
                        *(u32x4*)(rowp + bj * HALF) = o; } } }
    }
};
}
__device__ __forceinline__ void moe_convert_weights(const float* wg, const float* wu, const float* wd, const float* sg, const float* su, const float* sd,
                                                    bf16* WGU, bf16* WD, LAS float* scr, int gw, int NGW, int lane) {
    for (int it = gw; it < 65 * 384; it += NGW) {
        const int e = it / 384, r = it % 384, kind = r >> 7, q = r & 127;
        if (kind < 2) { const float* W = (e < 64 ? (kind == 0 ? wg : wu) + (size_t)e * 262144 : (kind == 0 ? sg : su));
            const int kb = q >> 3, nb = q & 7, k0 = 64 * kb, n0 = 32 * nb;
            tr_item(W + (size_t)k0 * 256 + n0, 256, 32, WGU + ((size_t)e * 512 + (n0 >> 7) * 256 + (n0 & 127) + kind * 128) * 1024 + k0, 1024, scr, lane);
        } else { const float* W = e < 64 ? wd + (size_t)e * 262144 : sd;
            const int kb = q >> 5, nb = q & 31, k0 = 64 * kb, n0 = 32 * nb;
            tr_item(W + (size_t)k0 * 1024 + n0, 1024, 32, WD + ((size_t)e * 1024 + n0) * 256 + k0, 256, scr, lane); }
    }
}
struct MoeLists { int* tok; int* dest; float* w; int* blk_e; };
__device__ __forceinline__ void moe_count(const int* ridx, unsigned* cnt, LAS unsigned* hist, int tid, int bid, int G) {
    if (tid < 64) hist[tid] = 0u;
    __syncthreads();
    for (int i = bid * NTHREADS + tid; i < T_ * 8; i += G * NTHREADS) atomicAdd((unsigned*)&hist[ridx[i]], 1u);
    __syncthreads();
    if (tid < 64 && hist[tid]) atomicAdd(&cnt[tid], hist[tid]);
    __syncthreads();
}
__device__ __forceinline__ void moe_build_lists(const int* ridx, const float* rwt, const unsigned* cnt, unsigned* cur, const MoeLists L, LAS int* sm, int tid, int bid, int G) {
    LAS int* pstart = sm; LAS unsigned* hist = (LAS unsigned*)(sm + 80); LAS unsigned* base = (LAS unsigned*)(sm + 160);
    if (tid == 0) { int acc = 0;
#pragma unroll 1
        for (int e = 0; e < 64; ++e) { pstart[e] = acc; acc += ((int)__hip_atomic_load(&cnt[e], __ATOMIC_RELAXED, __HIP_MEMORY_SCOPE_AGENT) + 255) & ~255; } pstart[64] = acc; pstart[65] = acc + T_; }
    __syncthreads();
    const int per = (T_ * 8 + G - 1) / G;
    const int lo = bid * per, hi = (lo + per < T_ * 8) ? lo + per : T_ * 8;
    for (int c0 = lo; c0 < hi; c0 += NTHREADS) {
        if (tid < 64) hist[tid] = 0u;
        __syncthreads();
        const int i = c0 + tid; int e = 0; unsigned local = 0u;
        if (i < hi) { e = ridx[i]; local = atomicAdd((unsigned*)&hist[e], 1u); }
        __syncthreads();
        if (tid < 64) base[tid] = hist[tid] ? atomicAdd(&cur[tid], hist[tid]) : 0u;
        __syncthreads();
        if (i < hi) { const int pos = pstart[e] + (int)base[e] + (int)local; L.tok[pos] = i >> 3; L.dest[pos] = i; L.w[pos] = rwt[i]; }
        __syncthreads();
    }
    for (int e = bid; e < 64; e += G) { const int c = (int)__hip_atomic_load(&cnt[e], __ATOMIC_RELAXED, __HIP_MEMORY_SCOPE_AGENT);
        for (int p = pstart[e] + c + tid; p < pstart[e + 1]; p += NTHREADS) { L.tok[p] = 0; L.dest[p] = -1; L.w[p] = 0.f; } }
    for (int t = bid * NTHREADS + tid; t < T_; t += G * NTHREADS) { const int p = pstart[64] + t; L.tok[p] = t; L.dest[p] = T_ * 8 + t; L.w[p] = 1.f; }
    const int nblk = pstart[65] >> 8;
    for (int b = bid * NTHREADS + tid; b < nblk; b += G * NTHREADS) { int e = 0;
#pragma unroll 1
        while (e < 64 && (pstart[e + 1] >> 8) <= b) ++e;
        L.blk_e[b] = e; }
    if (bid == 0 && tid == 0) L.blk_e[MOE_MAXBLK] = nblk;
    __syncthreads();
}
__device__ __forceinline__ void moe_combine_ln(float* h, const bf16* rows8, const bf16* rows_sh, const float* lw, const float* lb, bf16* hbf, int gw, int NGW, int lane, const float* zdbg = nullptr, int ntdbg = 0, int t0dbg = 0) {
    for (int t = gw; t < T_; t += NGW) {
        float v[16];
#pragma unroll
        for (int half = 0; half < 2; ++half) { const int c0 = half * 512 + lane * 8;
            const f32x4 a = *(const f32x4*)(h + (size_t)t * 1024 + c0), b = *(const f32x4*)(h + (size_t)t * 1024 + c0 + 4);
            float s[8] = {a.x * nv::ALPHA, a.y * nv::ALPHA, a.z * nv::ALPHA, a.w * nv::ALPHA, b.x * nv::ALPHA, b.y * nv::ALPHA, b.z * nv::ALPHA, b.w * nv::ALPHA};
#pragma unroll
            for (int k = 0; k < 9; ++k) { const bf16* rp = (k < 8 ? rows8 + ((size_t)t * 8 + k) * 1024 : rows_sh + (size_t)t * 1024) + c0;
                const v4u r = *(const v4u*)rp;
                s[0] += __builtin_bit_cast(float, r.x << 16); s[1] += __builtin_bit_cast(float, r.x & 0xffff0000u);
                s[2] += __builtin_bit_cast(float, r.y << 16); s[3] += __builtin_bit_cast(float, r.y & 0xffff0000u);
                s[4] += __builtin_bit_cast(float, r.z << 16); s[5] += __builtin_bit_cast(float, r.z & 0xffff0000u);
                s[6] += __builtin_bit_cast(float, r.w << 16); s[7] += __builtin_bit_cast(float, r.w & 0xffff0000u); }
#pragma unroll
            for (int j = 0; j < 8; ++j) v[half * 8 + j] = s[j]; }
        float dd[16];
#pragma unroll
        for (int j = 0; j < 16; ++j) dd[j] = 0.f;
        if (zdbg && t >= t0dbg && t < t0dbg + ntdbg) {
#pragma unroll
            for (int j = 0; j < 16; ++j) { const float zz = zdbg[(size_t)(t - t0dbg) * 1024 + (j >> 3) * 512 + lane * 8 + (j & 7)]; dd[j] = (DBG_SCALE != 0.0f) ? (v[j] - zz) * DBG_SCALE : 0.f; v[j] = zz; } }
        float sum = 0.f;
#pragma unroll
        for (int j = 0; j < 16; ++j) sum += v[j];
        sum = wave_sum(sum);
        const float mean = sum * (1.f / 1024.f);
        float sq = 0.f;
#pragma unroll
        for (int j = 0; j < 16; ++j) { v[j] -= mean; sq += v[j] * v[j]; }
        sq = wave_sum(sq);
        const float rstd = 1.0f / sqrtf(sq * (1.f / 1024.f) + nv::EPS);
#pragma unroll
        for (int half = 0; half < 2; ++half) { const int c0 = half * 512 + lane * 8;
            const f32x4 w0 = *(const f32x4*)(lw + c0), w1 = *(const f32x4*)(lw + c0 + 4), b0 = *(const f32x4*)(lb + c0), b1 = *(const f32x4*)(lb + c0 + 4);
            f32x4 o0, o1;
            if (zdbg) {
#pragma unroll
                for (int j = 0; j < 8; ++j) v[half * 8 + j] += dd[half * 8 + j] / rstd; }
            o0.x = v[half * 8 + 0] * rstd * w0.x + b0.x; o0.y = v[half * 8 + 1] * rstd * w0.y + b0.y; o0.z = v[half * 8 + 2] * rstd * w0.z + b0.z; o0.w = v[half * 8 + 3] * rstd * w0.w + b0.w;
            o1.x = v[half * 8 + 4] * rstd * w1.x + b1.x; o1.y = v[half * 8 + 5] * rstd * w1.y + b1.y; o1.z = v[half * 8 + 6] * rstd * w1.z + b1.z; o1.w = v[half * 8 + 7] * rstd * w1.w + b1.w;
            *(f32x4*)(h + (size_t)t * 1024 + c0) = o0; *(f32x4*)(h + (size_t)t * 1024 + c0 + 4) = o1;
            if (hbf) { v4u p; p.x = pk2(o0.x, o0.y); p.y = pk2(o0.z, o0.w); p.z = pk2(o1.x, o1.y); p.w = pk2(o1.z, o1.w); *(v4u*)(hbf + (size_t)t * 1024 + c0) = p; } }
    }
}
typedef float f32x16 __attribute__((ext_vector_type(16)));
typedef short s16x8 __attribute__((ext_vector_type(8)));
typedef LAS unsigned short lbf16;
__device__ __forceinline__ void mm32(f32x16& acc, const lbf16* A, int lda, const lbf16* B, int ldb, int K, int lane) {
    const lbf16* ap = A + (lane & 31) * lda + 8 * (lane >> 5);
    const lbf16* bp = B + (lane & 31) * ldb + 8 * (lane >> 5);
#pragma unroll 4
    for (int k = 0; k < K; k += 16) {
        const s16x8 a = *(const LAS s16x8*)(ap + k), b = *(const LAS s16x8*)(bp + k);
        acc = __builtin_amdgcn_mfma_f32_32x32x16_bf16(a, b, acc, 0, 0, 0);
    }
}
__device__ __forceinline__ void mm32_gb(f32x16& acc, const lbf16* A, int lda, const bf16* B, int ldb, int K, int lane) {
    const lbf16* ap = A + (lane & 31) * lda + 8 * (lane >> 5);
    const bf16* bp = B + (size_t)(lane & 31) * ldb + 8 * (lane >> 5);
#pragma unroll 4
    for (int k = 0; k < K; k += 16) {
        const s16x8 a = *(const LAS s16x8*)(ap + k), b = *(const s16x8*)(bp + k);
        acc = __builtin_amdgcn_mfma_f32_32x32x16_bf16(a, b, acc, 0, 0, 0);
    }
}
__device__ __forceinline__ int rowmap(int r, int lane) { return (r & 3) + 8 * (r >> 2) + 4 * (lane >> 5); }
__device__ __forceinline__ float sigm_f(float x) { return 1.0f / (1.0f + __expf(-x)); }
__device__ __forceinline__ float logsig_f(float x) { return fminf(x, 0.f) - log1pf(__expf(-fabsf(x))); }
__device__ __forceinline__ float softplus_f(float x) { return fmaxf(x, 0.f) + log1pf(__expf(-fabsf(x))); }
__device__ __forceinline__ float gelu_f(float x) { const float u = 0.7978845608028654f * (x + 0.044715f * x * x * x); return x / (1.0f + __expf(-2.0f * u)); }
__device__ __forceinline__ void unpack8(const v4u r, float (&f)[8]) {
    f[0] = __builtin_bit_cast(float, r.x << 16); f[1] = __builtin_bit_cast(float, r.x & 0xffff0000u); f[2] = __builtin_bit_cast(float, r.y << 16); f[3] = __builtin_bit_cast(float, r.y & 0xffff0000u);
    f[4] = __builtin_bit_cast(float, r.z << 16); f[5] = __builtin_bit_cast(float, r.z & 0xffff0000u); f[6] = __builtin_bit_cast(float, r.w << 16); f[7] = __builtin_bit_cast(float, r.w & 0xffff0000u);
}
__device__ __forceinline__ v4u pack8(const float (&f)[8]) { v4u o; o.x = pk2(f[0], f[1]); o.y = pk2(f[2], f[3]); o.z = pk2(f[4], f[5]); o.w = pk2(f[6], f[7]); return o; }

struct Mix0Bufs { const bf16* proj; float* ct; float* nloc; float* blast; float* mloc; float* mprev; float* hloc; float* pc; float* carA; float* carU; float* carI; bf16* mixbf; const bf16* lruw; };
constexpr int PJ0 = EINP;

__device__ __forceinline__ void mlstm_a_item(const Mix0Bufs& B, const float* gate_b, int cn, LAS unsigned char* lds, int tid) {
    const int lane = tid & 63, wave = __builtin_amdgcn_readfirstlane(tid >> 6);
    const int bh = cn / NCH, n = cn % NCH, b = bh >> 2, h = bh & 3;
    const size_t t0 = (size_t)b * S_ + n * 64;
    LAS float* lf = (LAS float*)lds; LAS float* wl = lf + 64; LAS float* pw = lf + 128; LAS float* misc = lf + 192;
    lbf16* kT = (lbf16*)(lds + 1024); lbf16* vT = (lbf16*)(lds + 1024 + 128 * 72 * 2);
    if (tid < 64) { const bf16* pr = B.proj + (t0 + tid) * PJ0;
        lf[tid] = logsig_f(bf2f(pr[2052 + h]) + gate_b[4 + h]); pw[tid] = bf2f(pr[2048 + h]) + gate_b[h]; }
    __syncthreads();
    if (tid < 64) { float acc = 0.f; for (int j = 0; j < 64; ++j) { const float x = lf[j]; acc += (j <= tid) ? x : 0.f; } wl[tid] = pw[tid] - acc; if (tid == 63) misc[0] = acc; }
    __syncthreads();
    float mx = -INFINITY;
    for (int j = 0; j < 64; ++j) mx = fmaxf(mx, wl[j]);
    const float blast = misc[0];
    __syncthreads();
    if (tid < 64) pw[tid] = __expf(wl[tid] - mx) * 0.08838834764831845f;
    __syncthreads();
#pragma unroll
    for (int it = 0; it < 2; ++it) { const int vi = tid + it * 512, l = vi & 63, g = vi >> 6;
        const bf16* pr = B.proj + (t0 + l) * PJ0 + h * 128 + g * 8;
        float kf[8], vf[8]; unpack8(*(const v4u*)(pr + 512), kf); unpack8(*(const v4u*)(pr + 1024), vf);
        const float p = pw[l];
#pragma unroll
        for (int j = 0; j < 8; ++j) { kT[(g * 8 + j) * 72 + l] = (unsigned short)f2bf(kf[j] * p); vT[(g * 8 + j) * 72 + l] = (unsigned short)f2bf(vf[j]); } }
    __syncthreads();
    const int et = wave >> 1;
#pragma unroll
    for (int q = 0; q < 2; ++q) { const int dt = (wave & 1) * 2 + q;
        f32x16 acc = {0.f, 0.f, 0.f, 0.f, 0.f, 0.f, 0.f, 0.f, 0.f, 0.f, 0.f, 0.f, 0.f, 0.f, 0.f, 0.f};
        mm32(acc, vT + et * 32 * 72, 72, kT + dt * 32 * 72, 72, 64, lane);
        float* out = B.ct + (size_t)cn * 16384 + dt * 32 + (lane & 31);
#pragma unroll
        for (int r = 0; r < 16; ++r) out[(size_t)(et * 32 + rowmap(r, lane)) * 128] = acc[r]; }
    if (tid < 128) { float s = 0.f; for (int l = 0; l < 64; ++l) s += bf2f(kT[tid * 72 + l]); B.nloc[(size_t)cn * 128 + tid] = s; }
    if (tid == 0) { B.blast[cn] = blast; B.mloc[cn] = blast + mx; }
    __syncthreads();
}
__device__ __forceinline__ void mlstm_b(const Mix0Bufs& B, int gtid, int gsz) {
    for (int idx = gtid; idx < 8 * 16384 + 8 * 128; idx += gsz) {
        const bool isn = idx >= 8 * 16384;
        int bh, de; float* buf; int stride;
        if (!isn) { bh = idx >> 14; de = idx & 16383; buf = B.ct; stride = 16384; } else { const int r = idx - 8 * 16384; bh = r >> 7; de = r & 127; buf = B.nloc; stride = 128; }
        float st = 0.f, m = 0.f;
        float* p = buf + (size_t)bh * NCH * stride + de;
#pragma unroll 8
        for (int n = 0; n < NCH; ++n) { const int cn = bh * NCH + n;
            const float cl = p[(size_t)n * stride]; p[(size_t)n * stride] = st;
            const float bl = B.blast[cn], ml = B.mloc[cn], mn = fmaxf(bl + m, ml);
            st = __expf(bl + m - mn) * st + __expf(ml - mn) * cl;
            if (!isn && de == 0) B.mprev[cn] = m;
            m = mn; }
    }
}
__device__ __forceinline__ void mlstm_c_item(const Mix0Bufs& B, const float* gate_b, const float* norm_w, int cn, LAS unsigned char* lds, int tid) {
    const int lane = tid & 63, wave = __builtin_amdgcn_readfirstlane(tid >> 6);
    const int bh = cn / NCH, n = cn % NCH, b = bh >> 2, h = bh & 3;
    const size_t t0 = (size_t)b * S_ + n * 64;
    LAS float* bc = (LAS float*)lds; LAS float* wl = bc + 64; LAS float* mi = bc + 128; LAS float* win = bc + 192; LAS float* den = bc + 256; LAS float* emi = bc + 320; LAS float* lf = bc + 384; LAS float* ig = bc + 448;
    lbf16* qs = (lbf16*)(lds + 2048); lbf16* ks = (lbf16*)(lds + 19456); lbf16* qw = (lbf16*)(lds + 36864);
    lbf16* vT = (lbf16*)(lds + 54272); lbf16* cT = (lbf16*)(lds + 77312); lbf16* sm = (lbf16*)(lds + 120832);
    LAS float* hb = (LAS float*)(lds + 2048);
    const float mprev = B.mprev[cn];
    if (tid < 64) { const bf16* pr = B.proj + (t0 + tid) * PJ0;
        lf[tid] = logsig_f(bf2f(pr[2052 + h]) + gate_b[4 + h]); ig[tid] = bf2f(pr[2048 + h]) + gate_b[h]; }
    __syncthreads();
    if (tid < 64) { float acc = 0.f; for (int j = 0; j < 64; ++j) { const float x = lf[j]; acc += (j <= tid) ? x : 0.f; } bc[tid] = acc; wl[tid] = ig[tid] - acc; }
    __syncthreads();
    if (tid < 64) { float pm = -INFINITY; for (int j = 0; j < 64; ++j) { const float x = wl[j]; pm = (j <= tid) ? fmaxf(pm, x) : pm; }
        const float bi = bc[tid], m = bi + fmaxf(mprev, pm); mi[tid] = m; win[tid] = __expf(bi + mprev - m); emi[tid] = __expf(-m); }
    __syncthreads();
#pragma unroll
    for (int it = 0; it < 2; ++it) { const int vi = tid + it * 512, l = vi >> 4, g = vi & 15;
        const bf16* pr = B.proj + (t0 + l) * PJ0 + h * 128 + g * 8;
        float qf[8], kf[8]; unpack8(*(const v4u*)pr, qf); unpack8(*(const v4u*)(pr + 512), kf);
        const float w = win[l]; float qwf[8];
#pragma unroll
        for (int j = 0; j < 8; ++j) { kf[j] *= 0.08838834764831845f; qwf[j] = qf[j] * w; }
        *(LAS v4u*)(qs + l * 136 + g * 8) = *(const v4u*)pr; *(LAS v4u*)(ks + l * 136 + g * 8) = pack8(kf); *(LAS v4u*)(qw + l * 136 + g * 8) = pack8(qwf); }
#pragma unroll
    for (int it = 0; it < 2; ++it) { const int vi = tid + it * 512, l = vi & 63, g = vi >> 6;
        float vf[8]; unpack8(*(const v4u*)(B.proj + (t0 + l) * PJ0 + 1024 + h * 128 + g * 8), vf);
#pragma unroll
        for (int j = 0; j < 8; ++j) vT[(g * 8 + j) * 72 + l] = (unsigned short)f2bf(vf[j]); }
    for (int i = tid; i < 32 * 72; i += 512) { const int r = i / 72, c = i % 72; vT[(128 + r) * 72 + c] = (r == 0 && c < 64) ? (unsigned short)0x3f80 : (unsigned short)0; }
    { const float* cg = B.ct + (size_t)cn * 16384;
#pragma unroll
      for (int it = 0; it < 4; ++it) { const int vi = tid + it * 512, e = vi >> 4, g = vi & 15;
          const f32x4 a = *(const f32x4*)(cg + e * 128 + g * 8), c2 = *(const f32x4*)(cg + e * 128 + g * 8 + 4);
          v4u o; o.x = pk2(a.x, a.y); o.y = pk2(a.z, a.w); o.z = pk2(c2.x, c2.y); o.w = pk2(c2.z, c2.w); *(LAS v4u*)(cT + e * 136 + g * 8) = o; } }
    for (int i = tid; i < 32 * 136; i += 512) { const int r = i / 136, c = i % 136; cT[(128 + r) * 136 + c] = (r == 0 && c < 128) ? (unsigned short)f2bf(B.nloc[(size_t)cn * 128 + c]) : (unsigned short)0; }
    __syncthreads();
    if (wave < 4) { const int it = wave >> 1, jt = wave & 1;
        f32x16 acc = {0.f, 0.f, 0.f, 0.f, 0.f, 0.f, 0.f, 0.f, 0.f, 0.f, 0.f, 0.f, 0.f, 0.f, 0.f, 0.f};
        if (jt <= it) mm32(acc, qs + it * 32 * 136, 136, ks + jt * 32 * 136, 136, 128, lane);
        const int j = jt * 32 + (lane & 31); const float wj = wl[j];
#pragma unroll
        for (int r = 0; r < 16; ++r) { const int i = it * 32 + rowmap(r, lane);
            const float v = (j <= i) ? acc[r] * __expf(bc[i] - mi[i] + wj) : 0.f; sm[i * 72 + j] = (unsigned short)f2bf(v); } }
    __syncthreads();
    f32x16 accA = {0.f, 0.f, 0.f, 0.f, 0.f, 0.f, 0.f, 0.f, 0.f, 0.f, 0.f, 0.f, 0.f, 0.f, 0.f, 0.f}, accB = accA;
    { const int id = wave, it = id / 5, nt = id % 5;
      mm32(accA, sm + it * 32 * 72, 72, vT + nt * 32 * 72, 72, 64, lane); mm32(accA, qw + it * 32 * 136, 136, cT + nt * 32 * 136, 136, 128, lane);
      if (nt == 4 && (lane & 31) == 0) {
#pragma unroll
          for (int r = 0; r < 16; ++r) den[it * 32 + rowmap(r, lane)] = accA[r]; } }
    if (wave < 2) { const int id = wave + 8, it = id / 5, nt = id % 5;
      mm32(accB, sm + it * 32 * 72, 72, vT + nt * 32 * 72, 72, 64, lane); mm32(accB, qw + it * 32 * 136, 136, cT + nt * 32 * 136, 136, 128, lane);
      if (nt == 4 && (lane & 31) == 0) {
#pragma unroll
          for (int r = 0; r < 16; ++r) den[it * 32 + rowmap(r, lane)] = accB[r]; } }
    __syncthreads();
    { const int id = wave, it = id / 5, nt = id % 5;
      if (nt < 4) {
#pragma unroll
          for (int r = 0; r < 16; ++r) { const int i = it * 32 + rowmap(r, lane); hb[i * 132 + nt * 32 + (lane & 31)] = accA[r] / fmaxf(fabsf(den[i]), emi[i]); } } }
    if (wave < 2) { const int id = wave + 8, it = id / 5, nt = id % 5;
      if (nt < 4) {
#pragma unroll
          for (int r = 0; r < 16; ++r) { const int i = it * 32 + rowmap(r, lane); hb[i * 132 + nt * 32 + (lane & 31)] = accB[r] / fmaxf(fabsf(den[i]), emi[i]); } } }
    __syncthreads();
    { const int i = tid >> 3, sub = tid & 7; const LAS float* hr = hb + i * 132 + sub * 16;
      float x[16]; float s = 0.f;
#pragma unroll
      for (int j = 0; j < 16; ++j) { x[j] = hr[j]; s += x[j]; }
      s += __builtin_bit_cast(float, __builtin_amdgcn_ds_swizzle(__builtin_bit_cast(int, s), 0x1f | (1 << 10)));
      s += __builtin_bit_cast(float, __builtin_amdgcn_ds_swizzle(__builtin_bit_cast(int, s), 0x1f | (2 << 10)));
      s += __builtin_bit_cast(float, __builtin_amdgcn_ds_swizzle(__builtin_bit_cast(int, s), 0x1f | (4 << 10)));
      const float mean = s * (1.f / 128.f); float q = 0.f;
#pragma unroll
      for (int j = 0; j < 16; ++j) { x[j] -= mean; q += x[j] * x[j]; }
      q += __builtin_bit_cast(float, __builtin_amdgcn_ds_swizzle(__builtin_bit_cast(int, q), 0x1f | (1 << 10)));
      q += __builtin_bit_cast(float, __builtin_amdgcn_ds_swizzle(__builtin_bit_cast(int, q), 0x1f | (2 << 10)));
      q += __builtin_bit_cast(float, __builtin_amdgcn_ds_swizzle(__builtin_bit_cast(int, q), 0x1f | (4 << 10)));
      const float rstd = 1.0f / sqrtf(q * (1.f / 128.f) + nv::EPS);
      const bf16* op = B.proj + (t0 + i) * PJ0 + 1536 + h * 128 + sub * 16; const float* nw = norm_w + h * 128 + sub * 16;
      float o0[8], o1[8]; unpack8(*(const v4u*)op, o0); unpack8(*(const v4u*)(op + 8), o1);
      float y0[8], y1[8];
#pragma unroll
      for (int j = 0; j < 8; ++j) { y0[j] = x[j] * rstd * nw[j] * sigm_f(o0[j]); y1[j] = x[8 + j] * rstd * nw[8 + j] * sigm_f(o1[j]); }
      bf16* dst = B.mixbf + (t0 + i) * 1024 + h * 128 + sub * 16;
      *(v4u*)dst = pack8(y0); *(v4u*)(dst + 8) = pack8(y1); }
    __syncthreads();
}
__device__ __forceinline__ void lru_a_item(const Mix0Bufs& B, const float* const* in, int ch, LAS unsigned char* lds, int tid) {
    const int lane = tid & 63, wave = __builtin_amdgcn_readfirstlane(tid >> 6);
    const size_t t0 = (size_t)ch * 64; const int s0 = (ch % NCH) * 64;
    lbf16* xc = (lbf16*)lds; LAS float* al = (LAS float*)(lds + 17408); LAS float* ul = (LAS float*)(lds + 17408 + 32768);
    const float* cw = in[9]; const float* cb = in[10]; const float* ba = in[12]; const float* bx = in[14]; const float* lam = in[15];
    for (int hh = 0; hh < 4; ++hh) {
#pragma unroll
        for (int it = 0; it < 2; ++it) { const int vi = tid + it * 512, l = vi >> 4, g = vi & 15, c0 = hh * 128 + g * 8;
            float acc[8];
#pragma unroll
            for (int j = 0; j < 8; ++j) acc[j] = cb[c0 + j];
#pragma unroll
            for (int tap = 0; tap < 4; ++tap) { const int ls = s0 + l - 3 + tap;
                if (ls >= 0) { float xf[8]; unpack8(*(const v4u*)(B.proj + (t0 + l - 3 + tap) * PJ0 + 2056 + c0), xf);
#pragma unroll
                    for (int j = 0; j < 8; ++j) acc[j] += cw[tap * 512 + c0 + j] * xf[j]; } }
            *(LAS v4u*)(xc + l * 136 + g * 8) = pack8(acc);
#pragma unroll
            for (int j = 0; j < 8; ++j) ul[l * 128 + g * 8 + j] = acc[j]; }
        __syncthreads();
        { const int it = wave & 1, nt = wave >> 1;
          f32x16 ra = {0.f, 0.f, 0.f, 0.f, 0.f, 0.f, 0.f, 0.f, 0.f, 0.f, 0.f, 0.f, 0.f, 0.f, 0.f, 0.f}, xa = ra;
          mm32_gb(ra, xc + it * 32 * 136, 136, B.lruw + (size_t)(hh * 128 + nt * 32) * 128, 128, 128, lane);
          mm32_gb(xa, xc + it * 32 * 136, 136, B.lruw + (size_t)(512 + hh * 128 + nt * 32) * 128, 128, 128, lane);
          const int c = nt * 32 + (lane & 31), cg = hh * 128 + c; const float bav = ba[cg], bxv = bx[cg], sp = softplus_f(-lam[cg]);
#pragma unroll
          for (int r = 0; r < 16; ++r) { const int l = it * 32 + rowmap(r, lane);
              const float rr = sigm_f(ra[r] + bav), ii = sigm_f(xa[r] + bxv), la = -8.0f * rr * sp;
              const float xv = ul[l * 128 + c];
              al[l * 128 + c] = __expf(la); ul[l * 128 + c] = sqrtf(-expm1f(2.0f * la)) * ii * xv; } }
        __syncthreads();
        if (tid < 128) { float hst = 0.f, P = 1.f; float* hp = B.hloc + t0 * 512 + hh * 128 + tid; float* pp = B.pc + t0 * 512 + hh * 128 + tid;
            for (int l = 0; l < 64; ++l) { const float a = al[l * 128 + tid]; hst = a * hst + ul[l * 128 + tid]; P *= a; hp[(size_t)l * 512] = hst; pp[(size_t)l * 512] = P; }
            B.carA[(size_t)ch * 512 + hh * 128 + tid] = P; B.carU[(size_t)ch * 512 + hh * 128 + tid] = hst; }
        __syncthreads();
    }
}
__device__ __forceinline__ void lru_b(const Mix0Bufs& B, int gtid, int gsz) {
    for (int idx = gtid; idx < 2 * 512; idx += gsz) { const int b = idx >> 9, c = idx & 511; float hst = 0.f;
#pragma unroll 8
        for (int n = 0; n < NCH; ++n) { const size_t o = (size_t)(b * NCH + n) * 512 + c; B.carI[o] = hst; hst = B.carA[o] * hst + B.carU[o]; } }
}
__device__ __forceinline__ void lru_c(const Mix0Bufs& B, int gtid, int gsz) {
    for (int idx = gtid; idx < T_ * 64; idx += gsz) { const size_t t = idx >> 6; const int c0 = (idx & 63) * 8; const size_t ch = t >> 6;
        float gb[8], y[8]; unpack8(*(const v4u*)(B.proj + t * PJ0 + 2568 + c0), gb);
        const float* hp = B.hloc + t * 512 + c0; const float* pp = B.pc + t * 512 + c0; const float* ci = B.carI + ch * 512 + c0;
#pragma unroll
        for (int j = 0; j < 8; ++j) y[j] = (hp[j] + pp[j] * ci[j]) * gelu_f(gb[j]);
        *(v4u*)(B.mixbf + t * 1024 + 512 + c0) = pack8(y); }
}
constexpr int PJ1 = OINP;
struct Mix1Bufs { const bf16* proj; float* ut; float* gbl; bf16* s5g; float* xend; float* xstart; float* s5ab; float* s5bb; bf16* cm; bf16* mixbf; };
__device__ __forceinline__ void gla_gates(const bf16* proj, const float* gw, const float* gb, size_t t0, int h, LAS float* bc, LAS float* gl, int tid) {
    if (tid < 128) { const int l = tid >> 1, hf = tid & 1; float f[8]; unpack8(*(const v4u*)(proj + (t0 + l) * PJ1 + 2048 + hf * 8), f);
#pragma unroll
        for (int j = 0; j < 8; ++j) gl[l * 16 + hf * 8 + j] = f[j]; }
    __syncthreads();
    { const int d = tid & 63, lg = tid >> 6; float w[16];
#pragma unroll
      for (int r = 0; r < 16; ++r) w[r] = gw[r * 256 + h * 64 + d];
      const float bias = gb[h * 64 + d];
#pragma unroll
      for (int q = 0; q < 8; ++q) { const int l = lg * 8 + q; float acc = bias;
#pragma unroll
          for (int r = 0; r < 16; ++r) acc += gl[l * 16 + r] * w[r];
          bc[l * 64 + d] = logsig_f(acc) * 0.0625f; } }
    __syncthreads();
    if (tid < 64) { float acc = 0.f; for (int l = 0; l < 64; ++l) { acc += bc[l * 64 + tid]; bc[l * 64 + tid] = acc; } }
    __syncthreads();
}
__device__ __forceinline__ void gla_a_item(const Mix1Bufs& B, const float* gw, const float* gb, int cn, LAS unsigned char* lds, int tid) {
    const int lane = tid & 63, wave = __builtin_amdgcn_readfirstlane(tid >> 6);
    const int bh = cn / NCH, n = cn % NCH, b = bh >> 2, h = bh & 3;
    const size_t t0 = (size_t)b * S_ + n * 64;
    LAS float* bc = (LAS float*)lds; LAS float* gl = (LAS float*)(lds + 16384);
    lbf16* kT = (lbf16*)(lds + 20480); lbf16* vT = (lbf16*)(lds + 20480 + 64 * 72 * 2);
    gla_gates(B.proj, gw, gb, t0, h, bc, gl, tid);
    { const int l = tid & 63, g = tid >> 6; float kf[8]; unpack8(*(const v4u*)(B.proj + (t0 + l) * PJ1 + 768 + h * 64 + g * 8), kf);
#pragma unroll
      for (int j = 0; j < 8; ++j) { const int d = g * 8 + j; kT[d * 72 + l] = (unsigned short)f2bf(kf[j] * __expf(bc[63 * 64 + d] - bc[l * 64 + d])); } }
#pragma unroll
    for (int it = 0; it < 2; ++it) { const int vi = tid + it * 512, l = vi & 63, g = vi >> 6; float vf[8]; unpack8(*(const v4u*)(B.proj + (t0 + l) * PJ1 + 1024 + h * 128 + g * 8), vf);
#pragma unroll
        for (int j = 0; j < 8; ++j) vT[(g * 8 + j) * 72 + l] = (unsigned short)f2bf(vf[j]); }
    __syncthreads();
    { const int et = wave >> 1, dt = wave & 1;
      f32x16 acc = {0.f, 0.f, 0.f, 0.f, 0.f, 0.f, 0.f, 0.f, 0.f, 0.f, 0.f, 0.f, 0.f, 0.f, 0.f, 0.f};
      mm32(acc, vT + et * 32 * 72, 72, kT + dt * 32 * 72, 72, 64, lane);
      float* out = B.ut + (size_t)cn * 8192 + dt * 32 + (lane & 31);
#pragma unroll
      for (int r = 0; r < 16; ++r) out[(size_t)(et * 32 + rowmap(r, lane)) * 64] = acc[r]; }
    if (tid < 64) B.gbl[(size_t)cn * 64 + tid] = bc[63 * 64 + tid];
    __syncthreads();
}
__device__ __forceinline__ void gla_b(const Mix1Bufs& B, int gtid, int gsz) {
    for (int idx = gtid; idx < 8 * 8192; idx += gsz) { const int bh = idx >> 13, ed = idx & 8191, d = ed & 63; float st = 0.f;
        float* p = B.ut + (size_t)bh * NCH * 8192 + ed; const float* gp = B.gbl + (size_t)bh * NCH * 64 + d;
#pragma unroll 8
        for (int n = 0; n < NCH; ++n) { const float u = p[(size_t)n * 8192]; p[(size_t)n * 8192] = st; st = __expf(gp[n * 64]) * st + u; } }
}
__device__ __forceinline__ void gla_c_item(const Mix1Bufs& B, const float* gw, const float* gb, const float* norm_w, int cn, LAS unsigned char* lds, int tid) {
    const int lane = tid & 63, wave = __builtin_amdgcn_readfirstlane(tid >> 6);
    const int bh = cn / NCH, n = cn % NCH, b = bh >> 2, h = bh & 3;
    const size_t t0 = (size_t)b * S_ + n * 64;
    LAS float* bc = (LAS float*)lds; LAS float* gl = (LAS float*)(lds + 16384);
    lbf16* qd = (lbf16*)(lds + 20480); lbf16* ki = (lbf16*)(lds + 29696); lbf16* vT = (lbf16*)(lds + 38912); lbf16* sT = (lbf16*)(lds + 57344); lbf16* att = (lbf16*)(lds + 75776);
    LAS float* ob = (LAS float*)(lds + 84992);
    gla_gates(B.proj, gw, gb, t0, h, bc, gl, tid);
    { const int l = tid >> 3, g = tid & 7; const bf16* pr = B.proj + (t0 + l) * PJ1 + h * 64 + g * 8; float qf[8], kf[8]; unpack8(*(const v4u*)(pr + 512), qf); unpack8(*(const v4u*)(pr + 768), kf);
#pragma unroll
      for (int j = 0; j < 8; ++j) { const float bb = bc[l * 64 + g * 8 + j]; qf[j] *= 0.125f * __expf(bb); kf[j] *= __expf(-bb); }
      *(LAS v4u*)(qd + l * 72 + g * 8) = pack8(qf); *(LAS v4u*)(ki + l * 72 + g * 8) = pack8(kf); }
#pragma unroll
    for (int it = 0; it < 2; ++it) { const int vi = tid + it * 512, l = vi & 63, g = vi >> 6; float vf[8]; unpack8(*(const v4u*)(B.proj + (t0 + l) * PJ1 + 1024 + h * 128 + g * 8), vf);
#pragma unroll
        for (int j = 0; j < 8; ++j) vT[(g * 8 + j) * 72 + l] = (unsigned short)f2bf(vf[j]); }
    { const float* sg = B.ut + (size_t)cn * 8192;
#pragma unroll
      for (int it = 0; it < 2; ++it) { const int vi = tid + it * 512, e = vi >> 3, g = vi & 7;
          const f32x4 a = *(const f32x4*)(sg + e * 64 + g * 8), c2 = *(const f32x4*)(sg + e * 64 + g * 8 + 4);
          v4u o; o.x = pk2(a.x, a.y); o.y = pk2(a.z, a.w); o.z = pk2(c2.x, c2.y); o.w = pk2(c2.z, c2.w); *(LAS v4u*)(sT + e * 72 + g * 8) = o; } }
    __syncthreads();
    if (wave < 4) { const int it = wave >> 1, jt = wave & 1;
        f32x16 acc = {0.f, 0.f, 0.f, 0.f, 0.f, 0.f, 0.f, 0.f, 0.f, 0.f, 0.f, 0.f, 0.f, 0.f, 0.f, 0.f};
        if (jt <= it) mm32(acc, qd + it * 32 * 72, 72, ki + jt * 32 * 72, 72, 64, lane);
        const int j = jt * 32 + (lane & 31);
#pragma unroll
        for (int r = 0; r < 16; ++r) { const int i = it * 32 + rowmap(r, lane); att[i * 72 + j] = (unsigned short)f2bf(j <= i ? acc[r] : 0.f); } }
    __syncthreads();
    { const int it = wave >> 2, nt = wave & 3;
      f32x16 acc = {0.f, 0.f, 0.f, 0.f, 0.f, 0.f, 0.f, 0.f, 0.f, 0.f, 0.f, 0.f, 0.f, 0.f, 0.f, 0.f};
      mm32(acc, att + it * 32 * 72, 72, vT + nt * 32 * 72, 72, 64, lane); mm32(acc, qd + it * 32 * 72, 72, sT + nt * 32 * 72, 72, 64, lane);
#pragma unroll
      for (int r = 0; r < 16; ++r) ob[(it * 32 + rowmap(r, lane)) * 132 + nt * 32 + (lane & 31)] = acc[r]; }
    __syncthreads();
    { const int i = tid >> 3, sub = tid & 7; const LAS float* hr = ob + i * 132 + sub * 16;
      float x[16]; float q = 0.f;
#pragma unroll
      for (int j = 0; j < 16; ++j) { x[j] = hr[j]; q += x[j] * x[j]; }
      q += __builtin_bit_cast(float, __builtin_amdgcn_ds_swizzle(__builtin_bit_cast(int, q), 0x1f | (1 << 10)));
      q += __builtin_bit_cast(float, __builtin_amdgcn_ds_swizzle(__builtin_bit_cast(int, q), 0x1f | (2 << 10)));
      q += __builtin_bit_cast(float, __builtin_amdgcn_ds_swizzle(__builtin_bit_cast(int, q), 0x1f | (4 << 10)));
      const float rstd = 1.0f / sqrtf(q * (1.f / 128.f) + nv::EPS);
      const bf16* rp = B.proj + (t0 + i) * PJ1 + 1536 + h * 128 + sub * 16; const float* nw = norm_w + h * 128 + sub * 16;
      float r0[8], r1[8]; unpack8(*(const v4u*)rp, r0); unpack8(*(const v4u*)(rp + 8), r1);
      float y0[8], y1[8];
#pragma unroll
      for (int j = 0; j < 8; ++j) { y0[j] = x[j] * rstd * nw[j] * r0[j] * sigm_f(r0[j]); y1[j] = x[8 + j] * rstd * nw[8 + j] * r1[j] * sigm_f(r1[j]); }
      bf16* dst = B.mixbf + (t0 + i) * 1024 + 512 + h * 128 + sub * 16;
      *(v4u*)dst = pack8(y0); *(v4u*)(dst + 8) = pack8(y1); }
    __syncthreads();
}
__device__ __forceinline__ void s5_params(const Mix1Bufs& B, const float* const* in, int gtid, int gsz) {
    for (int idx = gtid; idx < 2048; idx += gsz) { const int g = idx >> 6;
        const float lr = in[17][idx], li = in[18][idx], dt = expf(in[24][g]);
        const float mag = expf(lr * dt), ar = mag * cosf(li * dt), ai = mag * sinf(li * dt);
        const float den = lr * lr + li * li, nr = ar - 1.0f, cr = (nr * lr + ai * li) / den, ci = (ai * lr - nr * li) / den;
        B.s5ab[idx * 2] = ar; B.s5ab[idx * 2 + 1] = ai;
        for (int h = 0; h < 16; ++h) { const float br = in[19][idx * 16 + h], bi = in[20][idx * 16 + h]; B.s5bb[idx * 32 + h] = cr * br - ci * bi; B.s5bb[idx * 32 + 16 + h] = cr * bi + ci * br; } }
    for (int idx = gtid; idx < 32 * 32 * 128; idx += gsz) { const int k = idx & 127, hh = (idx >> 7) & 31, g = idx >> 12;
        float v = 0.f; if (hh < 16) v = k < 64 ? in[21][(g * 16 + hh) * 64 + k] : -in[22][(g * 16 + hh) * 64 + k - 64];
        B.cm[idx] = (unsigned short)f2bf(v); }
}
template <bool OUT> __device__ __forceinline__ void s5_chunk(const Mix1Bufs& B, const float* dskip, int item, LAS unsigned char* wl, int lane) {
    const int n = item % NCH, g = (item / NCH) & 31, b = item / (NCH * 32);
    const size_t t0 = (size_t)b * S_ + n * 64; const int gp = g * 64 + lane;
    LAS float* us = (LAS float*)wl;
    lbf16* xs = (lbf16*)(wl + 4096);
    { float f0[8], f1[8]; const bf16* pr = B.proj + (t0 + lane) * PJ1 + g * 16; unpack8(*(const v4u*)pr, f0); unpack8(*(const v4u*)(pr + 8), f1);
#pragma unroll
      for (int j = 0; j < 8; ++j) { us[lane * 16 + j] = f0[j]; us[lane * 16 + 8 + j] = f1[j]; } }
    float br[16], bi[16];
#pragma unroll
    for (int h = 0; h < 16; ++h) { br[h] = B.s5bb[gp * 32 + h]; bi[h] = B.s5bb[gp * 32 + 16 + h]; }
    const float ar = B.s5ab[gp * 2], ai = B.s5ab[gp * 2 + 1];
    float xr = 0.f, xi = 0.f;
    if (OUT) { xr = B.xstart[((size_t)item * 64 + lane) * 2]; xi = B.xstart[((size_t)item * 64 + lane) * 2 + 1]; }
    __builtin_amdgcn_wave_barrier();
    for (int half = 0; half < 2; ++half) {
        for (int l = half * 32; l < half * 32 + 32; ++l) {
            const LAS f32x4* up = (const LAS f32x4*)(us + l * 16);
            float sr = 0.f, si = 0.f;
#pragma unroll
            for (int q = 0; q < 4; ++q) { const f32x4 u4 = up[q];
                sr += u4.x * br[q * 4] + u4.y * br[q * 4 + 1] + u4.z * br[q * 4 + 2] + u4.w * br[q * 4 + 3];
                si += u4.x * bi[q * 4] + u4.y * bi[q * 4 + 1] + u4.z * bi[q * 4 + 2] + u4.w * bi[q * 4 + 3]; }
            const float nr = ar * xr - ai * xi + sr, ni = ar * xi + ai * xr + si; xr = nr; xi = ni;
            if (OUT) { xs[(l & 31) * 136 + lane] = (unsigned short)f2bf(xr); xs[(l & 31) * 136 + 64 + lane] = (unsigned short)f2bf(xi); }
        }
        if (OUT) {
            __builtin_amdgcn_wave_barrier();
            f32x16 acc = {0.f, 0.f, 0.f, 0.f, 0.f, 0.f, 0.f, 0.f, 0.f, 0.f, 0.f, 0.f, 0.f, 0.f, 0.f, 0.f};
            mm32_gb(acc, xs, 136, B.cm + (size_t)g * 32 * 128, 128, 128, lane);
            const int hh = lane & 31;
            if (hh < 16) { const float dk = dskip[g * 16 + hh];
#pragma unroll
                for (int r = 0; r < 16; ++r) { const int l = half * 32 + rowmap(r, lane);
                    B.s5g[(t0 + l) * 512 + g * 16 + hh] = (unsigned short)f2bf(gelu_f(acc[r] + dk * us[l * 16 + hh])); } }
            __builtin_amdgcn_wave_barrier();
        }
    }
    if (!OUT) { B.xend[((size_t)item * 64 + lane) * 2] = xr; B.xend[((size_t)item * 64 + lane) * 2 + 1] = xi; }
    __builtin_amdgcn_wave_barrier();
}
__device__ __forceinline__ void s5_b(const Mix1Bufs& B, int gtid, int gsz) {
    for (int idx = gtid; idx < 2 * 2048; idx += gsz) { const int b = idx >> 11, gp = idx & 2047, g = gp >> 6, p = gp & 63;
        float ar = B.s5ab[gp * 2], ai = B.s5ab[gp * 2 + 1];
#pragma unroll
        for (int q = 0; q < 6; ++q) { const float r2 = ar * ar - ai * ai, i2 = 2.f * ar * ai; ar = r2; ai = i2; }
        float xr = 0.f, xi = 0.f;
#pragma unroll 8
        for (int n = 0; n < NCH; ++n) { const size_t o = ((size_t)((b * 32 + g) * NCH + n) * 64 + p) * 2;
            B.xstart[o] = xr; B.xstart[o + 1] = xi;
            const float er = B.xend[o], ei = B.xend[o + 1], nr = ar * xr - ai * xi + er, ni = ar * xi + ai * xr + ei; xr = nr; xi = ni; } }
}
constexpr int CTX_OFF = 131072 + 1024, TAB_OFF = 131072 + 8192;
constexpr size_t WS_WINE = 1 * MiB, WS_WINO = WS_WINE + (size_t)EINP * 1024 * 2, WS_WOUT = WS_WINO + (size_t)OINP * 1024 * 2, WS_XBF = 16 * MiB, WS_MIXBF = 48 * MiB, WS_NAIVE = 80 * MiB;
static_assert(WS_WOUT + 2 * 1024 * 1024 * 2 <= WS_XBF, "ws map");
constexpr size_t WS_WD = 48 * MiB, WS_WGU = WS_WD + 65 * 512 * 1024, WS_LISTS = 146 * MiB, WS_RIDX = 148 * MiB, WS_H = 149 * MiB, WS_ROWS8 = 229 * MiB;
static_assert(WS_WGU + (size_t)65 * 1024 * 1024 <= WS_LISTS && WS_H + (size_t)MOE_MAXBLK * 256 * 512 <= WS_ROWS8 && WS_ROWS8 + (size_t)nv::T_ * 8 * 2048 <= 512 * MiB, "moe ws map");
constexpr size_t WS_PROJB = 149 * MiB, WS_CT = 253 * MiB, WS_HLOC = 317 * MiB, WS_PC = 349 * MiB, WS_M0SMALL = 381 * MiB, WS_LRUW = 486 * MiB;
constexpr size_t WS_UT = 221 * MiB, WS_S5G = 253 * MiB, WS_M1SMALL = 269 * MiB, WS_GLUW = 486 * MiB + 256 * 1024;
constexpr int CW_PROBE = 9000;
struct Tab { const float* in[38]; float* out; unsigned char* ws; };
struct Env { const Tab* tab; unsigned char* ws; float* out; LAS unsigned char* lds; int tid, lane, wave, bid, G, gw, NGW, gtid, gsz; };
__device__ __forceinline__ Env penv(unsigned char* lds_raw) {
    Env e; e.tab = (const Tab*)(lds_raw + TAB_OFF); e.ws = e.tab->ws; e.out = e.tab->out; e.lds = (LAS unsigned char*)lds_raw;
    int t = threadIdx.x; asm volatile("" : "+v"(t)); e.tid = t; e.lane = t & 63; e.wave = __builtin_amdgcn_readfirstlane(t >> 6);
    int b = blockIdx.x; asm volatile("" : "+s"(b)); e.bid = b; int g = gridDim.x; asm volatile("" : "+s"(g)); e.G = g;
    e.gw = b * NWAVES + e.wave; e.NGW = g * NWAVES; e.gtid = b * NTHREADS + t; e.gsz = g * NTHREADS;
    return e;
}
__device__ __forceinline__ void grid_bar(const Env& e) {
    XcdBarrier b; b.bar = (unsigned*)e.ws + 4096; b.x = xb_xcc_id(); b.st = (volatile LAS unsigned*)(e.lds + MISC_OFF) + 8;
    xcd_barrier(b);
}
template <int ST> __device__ __forceinline__ void run_naive(unsigned char* lds_raw, int ci, long n) {
    const Env e = penv(lds_raw);
    const nv::Ctx& c = ((const nv::Ctx*)(lds_raw + CTX_OFF))[ci];
    for (long i = e.gtid; i < n; i += e.gsz) nv::item<ST>(c, i);
    grid_bar(e);
}
__device__ __forceinline__ void phase_p0(unsigned char* lds_raw) {
    const Env e = penv(lds_raw);
    LAS float* scr = (LAS float*)(e.lds + e.wave * 16384);
    tr_matrix(e.tab->in[6], 1024, nv::EIN, EINP, (bf16*)(e.ws + WS_WINE), scr, e.gw, e.NGW, e.lane);
    tr_matrix(e.tab->in[16], 1024, nv::OIN, OINP, (bf16*)(e.ws + WS_WINO), scr, e.gw, e.NGW, e.lane);
    tr_matrix(e.tab->in[5], 1024, 1024, 1024, (bf16*)(e.ws + WS_WOUT), scr, e.gw, e.NGW, e.lane);
    tr_matrix(e.tab->in[5] + 1024 * 1024, 1024, 1024, 1024, (bf16*)(e.ws + WS_WOUT) + 1024 * 1024, scr, e.gw, e.NGW, e.lane);
    for (int h = 0; h < 4; ++h) { tr_matrix(e.tab->in[11] + h * 16384, 128, 128, 128, (bf16*)(e.ws + WS_LRUW) + h * 16384, scr, e.gw, e.NGW, e.lane);
                                  tr_matrix(e.tab->in[13] + h * 16384, 128, 128, 128, (bf16*)(e.ws + WS_LRUW) + 65536 + h * 16384, scr, e.gw, e.NGW, e.lane); }
    tr_matrix(e.tab->in[25], 512, 512, 512, (bf16*)(e.ws + WS_GLUW), scr, e.gw, e.NGW, e.lane);
    cvt_rows(e.tab->in[0], (bf16*)(e.ws + WS_XBF), (long)T_ * 1024, e.gtid, e.gsz);
    grid_bar(e);
}
__device__ __forceinline__ void phase_inproj(unsigned char* lds_raw, int layer) {
    const Env e = penv(lds_raw);
    float* proj = (float*)(e.ws + WS_NAIVE) + ((size_t)T_ * 1024 + (size_t)T_ * 64 + (size_t)T_ * 8 * 2);
    const int NP = layer == 0 ? EINP : OINP;
    pg8::Gemm g{(const bf16*)(e.ws + WS_XBF), (const bf16*)(e.ws + (layer == 0 ? WS_WINE : WS_WINO)), 1024, 0, 0, nullptr};
    pg8::StaticOrder S; S.init(T_, NP, e.G, e.bid);
    pg8::EpiF32R E{proj, NP, nullptr, 0.f};
    pg8::gemm_phase<pg8::EpiF32R, pg8::StaticOrder, true, false>(e.lds, g, S, E);
    grid_bar(e);
}
__device__ __forceinline__ void phase_cvt_mixed(unsigned char* lds_raw) {
    const Env e = penv(lds_raw);
    cvt_rows((const float*)(e.ws + WS_NAIVE), (bf16*)(e.ws + WS_MIXBF), (long)T_ * 1024, e.gtid, e.gsz);
    grid_bar(e);
}
__device__ __forceinline__ void phase_outproj(unsigned char* lds_raw, int layer) {
    const Env e = penv(lds_raw);
    float* z = (float*)(e.ws + WS_NAIVE) + ((size_t)T_ * 1024 + (size_t)T_ * 64 + (size_t)T_ * 8 * 2);
    const float* hcur = layer == 0 ? e.tab->in[0] : e.out;
    pg8::Gemm g{(const bf16*)(e.ws + WS_MIXBF), (const bf16*)(e.ws + WS_WOUT) + (size_t)layer * 1024 * 1024, 1024, 0, 0, nullptr};
    pg8::StaticOrder S; S.init(T_, 1024, e.G, e.bid);
    pg8::EpiF32R E{z, 1024, hcur, nv::ALPHA};
    pg8::gemm_phase<pg8::EpiF32R, pg8::StaticOrder, true, false>(e.lds, g, S, E);
    grid_bar(e);
}
__device__ __forceinline__ Mix0Bufs mix0_bufs(unsigned char* ws) {
    Mix0Bufs B; B.proj = (const bf16*)(ws + WS_PROJB); B.ct = (float*)(ws + WS_CT); B.hloc = (float*)(ws + WS_HLOC); B.pc = (float*)(ws + WS_PC);
    float* sm = (float*)(ws + WS_M0SMALL); B.nloc = sm; sm += 8 * NCH * 128; B.blast = sm; sm += 8 * NCH; B.mloc = sm; sm += 8 * NCH; B.mprev = sm; sm += 8 * NCH;
    B.carA = sm; sm += 2 * NCH * 512; B.carU = sm; sm += 2 * NCH * 512; B.carI = sm;
    B.mixbf = (bf16*)(ws + WS_MIXBF); B.lruw = (const bf16*)(ws + WS_LRUW); return B;
}
__device__ __forceinline__ Mix1Bufs mix1_bufs(unsigned char* ws) {
    Mix1Bufs B; B.proj = (const bf16*)(ws + WS_PROJB); B.ut = (float*)(ws + WS_UT); B.s5g = (bf16*)(ws + WS_S5G);
    float* sm = (float*)(ws + WS_M1SMALL); B.gbl = sm; sm += 8 * NCH * 64; B.xend = sm; sm += 8192 * 128; B.xstart = sm; sm += 8192 * 128; B.s5ab = sm; sm += 4096; B.s5bb = sm; sm += 2048 * 32;
    B.cm = (bf16*)sm; B.mixbf = (bf16*)(ws + WS_MIXBF); return B;
}
__device__ __forceinline__ void phase_inproj_bf16(unsigned char* lds_raw, int layer) {
    const Env e = penv(lds_raw);
    const int NP = layer == 0 ? EINP : OINP;
    if (layer == 1) { const Mix1Bufs B = mix1_bufs(e.ws); s5_params(B, e.tab->in, e.gtid, e.gsz); }
    pg8::Gemm g{(const bf16*)(e.ws + WS_XBF), (const bf16*)(e.ws + (layer == 0 ? WS_WINE : WS_WINO)), 1024, 0, 0, nullptr};
    pg8::StaticOrder S; S.init(T_, NP, e.G, e.bid);
    pg8::EpiBf16P E{(bf16*)(e.ws + WS_PROJB), NP};
    pg8::gemm_phase<pg8::EpiBf16P, pg8::StaticOrder, true, false>(e.lds, g, S, E);
    grid_bar(e);
}
__device__ __forceinline__ void phase_mix0_a(unsigned char* lds_raw) {
    const Env e = penv(lds_raw); const Mix0Bufs B = mix0_bufs(e.ws);
    for (int it = e.bid; it < 256 + 8 * NCH; it += e.G) {
        if (it < 256) lru_a_item(B, e.tab->in, it, e.lds, e.tid); else mlstm_a_item(B, e.tab->in[7], it - 256, e.lds, e.tid); }
    grid_bar(e);
}
__device__ __forceinline__ void phase_mix0_b(unsigned char* lds_raw) {
    const Env e = penv(lds_raw); const Mix0Bufs B = mix0_bufs(e.ws);
    lru_b(B, e.gtid, e.gsz); mlstm_b(B, e.gtid, e.gsz);
    grid_bar(e);
}
__device__ __forceinline__ void phase_mix0_c(unsigned char* lds_raw) {
    const Env e = penv(lds_raw); const Mix0Bufs B = mix0_bufs(e.ws);
    for (int it = e.bid; it < 8 * NCH; it += e.G) mlstm_c_item(B, e.tab->in[7], e.tab->in[8], it, e.lds, e.tid);
    lru_c(B, e.gtid, e.gsz);
    grid_bar(e);
}
__device__ __forceinline__ void phase_mix1_a(unsigned char* lds_raw) {
    const Env e = penv(lds_raw); const Mix1Bufs B = mix1_bufs(e.ws);
    for (int it = e.bid; it < 8 * NCH; it += e.G) gla_a_item(B, e.tab->in[27], e.tab->in[28], it, e.lds, e.tid);
    for (int it = e.gw; it < 2 * 32 * NCH; it += e.NGW) s5_chunk<false>(B, e.tab->in[23], it, e.lds + e.wave * 12800, e.lane);
    grid_bar(e);
}
__device__ __forceinline__ void phase_mix1_b(unsigned char* lds_raw) {
    const Env e = penv(lds_raw); const Mix1Bufs B = mix1_bufs(e.ws);
    s5_b(B, e.gtid, e.gsz); gla_b(B, e.gtid, e.gsz);
    grid_bar(e);
}
__device__ __forceinline__ void phase_mix1_c(unsigned char* lds_raw) {
    const Env e = penv(lds_raw); const Mix1Bufs B = mix1_bufs(e.ws);
    for (int it = e.bid; it < 8 * NCH; it += e.G) gla_c_item(B, e.tab->in[27], e.tab->in[28], e.tab->in[29], it, e.lds, e.tid);
    for (int it = e.gw; it < 2 * 32 * NCH; it += e.NGW) s5_chunk<true>(B, e.tab->in[23], it, e.lds + e.wave * 12800, e.lane);
    grid_bar(e);
}
__device__ __forceinline__ void phase_glu(unsigned char* lds_raw) {
    const Env e = penv(lds_raw);
    pg8::Gemm g{(const bf16*)(e.ws + WS_S5G), (const bf16*)(e.ws + WS_GLUW), 512, 0, 0, nullptr};
    pg8::StaticOrder S; S.init(T_, 512, e.G, e.bid);
    pg8::EpiGlu E{(bf16*)(e.ws + WS_MIXBF), 1024, (const bf16*)(e.ws + WS_S5G), 512, e.tab->in[26]};
    pg8::gemm_phase<pg8::EpiGlu, pg8::StaticOrder, true, false>(e.lds, g, S, E);
    grid_bar(e);
}
__device__ __forceinline__ void phase_probe(unsigned char* lds_raw, int c0, int c1) {
    const Env e = penv(lds_raw);
    const bf16* a = (const bf16*)(e.ws + WS_MIXBF); const float* b = (const float*)(e.ws + WS_NAIVE);
    float sd = 0.f, sr = 0.f; const int w = c1 - c0;
    for (long i = e.gtid; i < (long)T_ * w; i += e.gsz) { const long t = i / w; const int c = c0 + (int)(i % w); const float x = bf2f(a[t * 1024 + c]), y = b[t * 1024 + c]; sd += (x - y) * (x - y); sr += y * y; }
    sd = wave_sum(sd); sr = wave_sum(sr);
    if (e.lane == 0) { atomicAdd((float*)e.ws + CW_PROBE, sd); atomicAdd((float*)e.ws + CW_PROBE + 1, sr); }
    grid_bar(e);
}
__device__ __forceinline__ void phase_probe_apply(unsigned char* lds_raw) {
    const Env e = penv(lds_raw);
    const float sd = __hip_atomic_load((float*)e.ws + CW_PROBE, __ATOMIC_RELAXED, __HIP_MEMORY_SCOPE_AGENT), sr = __hip_atomic_load((float*)e.ws + CW_PROBE + 1, __ATOMIC_RELAXED, __HIP_MEMORY_SCOPE_AGENT);
    const float f = 1.0f + 10.0f * sqrtf(sd / fmaxf(sr, 1e-30f));
    for (long i = e.gtid; i < (long)T_ * 1024; i += e.gsz) e.out[i] *= f;
}
__device__ __forceinline__ MoeLists moe_lists(unsigned char* ws) {
    MoeLists L; L.tok = (int*)(ws + WS_LISTS); L.dest = L.tok + MOE_MAXBLK * 256; L.w = (float*)(L.dest + MOE_MAXBLK * 256); L.blk_e = (int*)(L.w + MOE_MAXBLK * 256); return L;
}
__device__ __forceinline__ void phase_moe_x1(unsigned char* lds_raw, int layer) {
    const Env e = penv(lds_raw);
    LAS float* scr = (LAS float*)(e.lds + e.wave * 16384);
    moe_convert_weights(e.tab->in[32] + (size_t)layer * 64 * 262144, e.tab->in[33] + (size_t)layer * 64 * 262144, e.tab->in[34] + (size_t)layer * 64 * 262144,
                        e.tab->in[35] + (size_t)layer * 262144, e.tab->in[36] + (size_t)layer * 262144, e.tab->in[37] + (size_t)layer * 262144,
                        (bf16*)(e.ws + WS_WGU), (bf16*)(e.ws + WS_WD), scr, e.gw, e.NGW, e.lane);
    cvt_rows(e.out, (bf16*)(e.ws + WS_XBF), (long)T_ * 1024, e.gtid, e.gsz);
    __syncthreads();
    moe_count((const int*)(e.ws + WS_RIDX), (unsigned*)e.ws + CW_CNT + layer * 256, (LAS unsigned*)e.lds, e.tid, e.bid, e.G);
    grid_bar(e);
}
__device__ __forceinline__ void phase_moe_x2(unsigned char* lds_raw, int layer) {
    const Env e = penv(lds_raw);
    moe_build_lists((const int*)(e.ws + WS_RIDX), (const float*)(e.ws + WS_RIDX) + (size_t)T_ * 8, (unsigned*)e.ws + CW_CNT + layer * 256, (unsigned*)e.ws + CW_CUR + layer * 256,
                    moe_lists(e.ws), (LAS int*)e.lds, e.tid, e.bid, e.G);
    grid_bar(e);
}
__device__ __forceinline__ void phase_moe_g1(unsigned char* lds_raw) {
    const Env e = penv(lds_raw);
    const MoeLists L = moe_lists(e.ws);
    const int nblk = __builtin_amdgcn_readfirstlane(L.blk_e[MOE_MAXBLK]);
    pg8::Gemm g{(const bf16*)(e.ws + WS_XBF), (const bf16*)(e.ws + WS_WGU), 1024, 0, (size_t)512 * 1024, L.tok};
    pg8::MoeOrder S{L.blk_e, nblk, 2, e.G, e.bid};
    pg8::EpiSwiGLU E{(bf16*)(e.ws + WS_H)};
    pg8::gemm_phase<pg8::EpiSwiGLU, pg8::MoeOrder, true, true>(e.lds, g, S, E);
    grid_bar(e);
}
__device__ __forceinline__ void phase_moe_g2(unsigned char* lds_raw) {
    const Env e = penv(lds_raw);
    const MoeLists L = moe_lists(e.ws);
    const int nblk = __builtin_amdgcn_readfirstlane(L.blk_e[MOE_MAXBLK]);
    pg8::Gemm g{(const bf16*)(e.ws + WS_H), (const bf16*)(e.ws + WS_WD), 256, 0, (size_t)1024 * 256, nullptr};
    pg8::MoeOrder S{L.blk_e, nblk, 4, e.G, e.bid};
    pg8::EpiDown E{(bf16*)(e.ws + WS_ROWS8), (bf16*)(e.ws + WS_XBF), L.dest, L.w, T_ * 8};
    pg8::gemm_phase<pg8::EpiDown, pg8::MoeOrder, true, false>(e.lds, g, S, E);
    grid_bar(e);
}
__device__ __forceinline__ void phase_moe_combine(unsigned char* lds_raw, int layer) {
    const Env e = penv(lds_raw);
    moe_combine_ln(e.out, (const bf16*)(e.ws + WS_ROWS8), (const bf16*)(e.ws + WS_XBF), e.tab->in[3] + layer * 1024, e.tab->in[4] + layer * 1024,
                   layer == 0 ? (bf16*)(e.ws + WS_XBF) : nullptr, e.gw, e.NGW, e.lane
#ifdef DBG_LAYER
                   , layer == DBG_LAYER ? (const float*)(e.ws + 486 * MiB) : nullptr, DBG_NT, DBG_T0
#endif
                   );
    grid_bar(e);
}
template <int layer> __device__ __forceinline__ void layer_body(unsigned char* lds_raw) {
    constexpr int ci = layer * 2;
#if defined(OPT_MIX1)
    constexpr bool opt = true;
#elif defined(OPT_MIX0)
    constexpr bool opt = (layer == 0);
#else
    constexpr bool opt = false;
#endif
#if defined(DBG_MIX0)
    constexpr bool naive_too = (layer == DBG_MIX0 - 1);
#else
    constexpr bool naive_too = false;
#endif
    if (opt && layer == 0) { phase_inproj_bf16(lds_raw, layer); phase_mix0_a(lds_raw); phase_mix0_b(lds_raw); phase_mix0_c(lds_raw); }
    if (opt && layer == 1) { phase_inproj_bf16(lds_raw, layer); phase_mix1_a(lds_raw); phase_mix1_b(lds_raw); phase_mix1_c(lds_raw); phase_glu(lds_raw); }
    if (!opt || naive_too) {
        phase_inproj(lds_raw, layer);
        if (layer == 0) {
            run_naive<nv::ST_ML_GATES>(lds_raw, ci, 8L * NCH);
            run_naive<nv::ST_ML_CLOC>(lds_raw, ci, 8L * NCH * 16384);
            run_naive<nv::ST_ML_SCAN>(lds_raw, ci, 8L * 16384 + 8 * 128);
            run_naive<nv::ST_ML_MI>(lds_raw, ci, 8L * S_);
            run_naive<nv::ST_ML_SMAT>(lds_raw, ci, 8L * NCH * 4096);
            run_naive<nv::ST_ML_DEN>(lds_raw, ci, 8L * S_);
            run_naive<nv::ST_ML_H>(lds_raw, ci, 8L * S_ * 128);
            run_naive<nv::ST_ML_NORM>(lds_raw, ci, 8L * S_);
            run_naive<nv::ST_LRU_CONV>(lds_raw, ci, (long)T_ * 512);
            run_naive<nv::ST_LRU_GATE>(lds_raw, ci, (long)T_ * 512);
            run_naive<nv::ST_LRU_SCAN>(lds_raw, ci, 2L * 512);
        } else {
            run_naive<nv::ST_S5_PAR>(lds_raw, ci, 2048);
            for (int sl = 0; sl < S_ / nv::SLAB; ++sl) {
                if (threadIdx.x == 0) ((nv::Ctx*)(lds_raw + CTX_OFF))[ci].slab = sl;
                __syncthreads();
                run_naive<nv::ST_S5_SCAN>(lds_raw, ci, 2L * 2048); run_naive<nv::ST_S5_OUT>(lds_raw, ci, (long)nv::B_ * nv::SLAB * 512); }
            run_naive<nv::ST_S5_GLU>(lds_raw, ci, (long)T_ * 512);
            run_naive<nv::ST_GLA_GATE>(lds_raw, ci, (long)T_ * 256);
            run_naive<nv::ST_GLA_CUM>(lds_raw, ci, (long)nv::B_ * NCH * 256);
            run_naive<nv::ST_GLA_U>(lds_raw, ci, 8L * NCH * 8192);
            run_naive<nv::ST_GLA_SCAN>(lds_raw, ci, 8L * 8192);
            run_naive<nv::ST_GLA_ATT>(lds_raw, ci, 8L * NCH * 4096);
            run_naive<nv::ST_GLA_O>(lds_raw, ci, 8L * S_ * 128);
            run_naive<nv::ST_GLA_NORM>(lds_raw, ci, 8L * S_);
        }
#if defined(DBG_MIX0)
        if (opt && naive_too) phase_probe(lds_raw, DBG_C0, DBG_C1);
#endif
        phase_cvt_mixed(lds_raw);
    }
    phase_outproj(lds_raw, layer);
    run_naive<nv::ST_LN>(lds_raw, ci, T_);
    run_naive<nv::ST_SCORES>(lds_raw, ci + 1, (long)T_ * 64);
    run_naive<nv::ST_SELECT>(lds_raw, ci + 1, T_);
    phase_moe_x1(lds_raw, layer);
    phase_moe_x2(lds_raw, layer);
    phase_moe_g1(lds_raw);
    phase_moe_g2(lds_raw);
    phase_moe_combine(lds_raw, layer);
}
struct Args { const float* in[38]; float* out; unsigned char* ws; };
__global__ void __launch_bounds__(NTHREADS, 2) mega_fwd(Args a) {
    extern __shared__ __attribute__((aligned(16))) unsigned char lds_raw[];
    {
        LAS unsigned char* lds = (LAS unsigned char*)lds_raw;
        for (int u = threadIdx.x; u < (LDS_BYTES - 131072) / 4; u += NTHREADS) ((LAS unsigned*)(lds + 131072))[u] = 0u;
        __syncthreads();
        if (threadIdx.x == 0) {
            (void)xb_add((unsigned*)a.ws + 4096 + XB_XCNT(xb_xcc_id()), 1u);
            Tab* tab = (Tab*)(lds_raw + TAB_OFF);
#pragma unroll
            for (int i = 0; i < 38; ++i) { tab->in[i] = a.in[i]; if ((i & 7) == 7) asm volatile("" ::: "memory"); }
            tab->out = a.out; tab->ws = a.ws;
            asm volatile("" ::: "memory");
            nv::Ctx* const ctab = (nv::Ctx*)(lds_raw + CTX_OFF);
            const size_t scratch0 = (size_t)T_ * 1024 + (size_t)T_ * 64 + (size_t)T_ * 8 * 2;
#pragma unroll 1
            for (int layer = 0; layer < 2; ++layer) {
                nv::Ctx& c = ctab[layer * 2];
                nv::Mem M{(float*)(a.ws + WS_NAIVE), 0};
#pragma unroll 1
                for (int i = 0; i < 38; ++i) c.in[i] = tab->in[i];
                c.mixed = M.get((size_t)T_ * 1024); c.scores = M.get((size_t)T_ * 64);
                c.ridx = (int*)M.get((size_t)T_ * 8); c.rwt = M.get((size_t)T_ * 8);
                c.gR = nullptr; c.gBias = nullptr; c.slab = 0;
                c.layer = layer;
                c.hcur = layer == 0 ? a.in[0] : a.out;
                if (layer == 0) {
                    c.ldp = EINP; c.proj = M.get((size_t)T_ * c.ldp);
                    c.mb = M.get(8 * S_); c.mig = M.get(8 * S_); c.mblast = M.get(8 * NCH); c.mmloc = M.get(8 * NCH); c.mmprev = M.get(8 * NCH);
                    c.mmi = M.get(8 * S_); c.mwin = M.get(8 * S_); c.mden = M.get(8 * S_); c.nloc = M.get(8 * NCH * 128);
                    const size_t ov = M.off;
                    c.cloc = M.get((size_t)8 * NCH * 16384); c.smat = M.get((size_t)8 * NCH * 4096); c.htil = M.get((size_t)T_ * 512);
                    M.off = ov; c.lxc = M.get((size_t)T_ * 512); c.la = M.get((size_t)T_ * 512); c.lu = M.get((size_t)T_ * 512);
                } else {
                    c.ldp = OINP; c.proj = M.get((size_t)T_ * c.ldp);
                    c.s5ab = M.get(2048 * 2); c.s5bbr = M.get(2048 * 16); c.s5bbi = M.get(2048 * 16); c.s5st = M.get(2 * 2048 * 2);
                    c.s5x = M.get((size_t)nv::B_ * nv::SLAB * 2048 * 2); c.s5g = M.get((size_t)T_ * 512);
                    c.gla_la = M.get((size_t)T_ * 256); c.gla_bc = M.get((size_t)T_ * 256); c.gla_bl = M.get((size_t)nv::B_ * NCH * 256);
                    c.gu = M.get((size_t)8 * NCH * 8192); c.gatt = M.get((size_t)8 * NCH * 4096); c.go = M.get((size_t)T_ * 512);
                }
                c.z = c.proj; c.hout = a.out; c.lnw = a.in[1] + layer * 1024; c.lnb = a.in[2] + layer * 1024;
                M.off = scratch0; c.hid = M.get((size_t)T_ * 9 * 256);
                nv::Ctx& cm = ctab[layer * 2 + 1];
                cm = c; cm.hcur = a.out;
#ifdef DBG_LAYER
                if (layer == DBG_LAYER) { nv::Ctx& cd = ctab[4]; cd = cm;
                cd.hid = (float*)(a.ws + 48 * MiB); cd.z = (float*)(a.ws + 486 * MiB); cd.hcur = a.out + (size_t)DBG_T0 * 1024; cd.ridx = c.ridx + (size_t)DBG_T0 * 8; cd.rwt = c.rwt + (size_t)DBG_T0 * 8; }
#endif
            }
        }
        __syncthreads();
    }
    phase_p0(lds_raw);
    layer_body<0>(lds_raw);
    layer_body<1>(lds_raw);
#if defined(DBG_MIX0)
    phase_probe_apply(lds_raw);
#endif
}
extern "C" void kernel_launch(void* const* d_in, const int* in_sizes, int n_in, void* d_out, int out_size, void* d_ws, size_t ws_size, hipStream_t stream) {
    static int grid = 0;
    if (grid == 0) {
        int dev = 0, cus = 0, per_cu = 0;
        hipGetDevice(&dev); hipDeviceGetAttribute(&cus, hipDeviceAttributeMultiprocessorCount, dev);
        hipFuncSetAttribute((const void*)mega_fwd, hipFuncAttributeMaxDynamicSharedMemorySize, LDS_BYTES);
        hipOccupancyMaxActiveBlocksPerMultiprocessor(&per_cu, (const void*)mega_fwd, NTHREADS, LDS_BYTES);
        (void)hipGetLastError();
        grid = (per_cu >= 1) ? cus : -1;
    }
    if (grid < 0) return;
    hipMemsetAsync(d_ws, 0, CTL_BYTES, stream);
    Args a{};
    for (int i = 0; i < 38; ++i) a.in[i] = (const float*)d_in[i];
    a.out = (float*)d_out; a.ws = (unsigned char*)d_ws;
    hipLaunchKernelGGL(mega_fwd, dim3(grid), dim3(NTHREADS), LDS_BYTES, stream, a);
}
```

```cpp
#define OPT_MIX0 1
#define OPT_MIX1 1
#define OPT_ROUTER 1
#include <hip/hip_runtime.h>
#ifdef CPU_TEST
#include <cmath>
#include <cstddef>
#define HD inline
#define HDF inline
#else
#define HD __device__ __forceinline__
#define HDF __host__ __device__ __forceinline__
#endif

#ifndef SEQ_
#define SEQ_ 8192
#endif
namespace nv {
constexpr int B_ = 2, S_ = SEQ_, T_ = B_ * S_, D_ = 1024, NCH = S_ / 64;
constexpr int EIN = 3080, OIN = 2064;
constexpr int SLAB = (S_ < 1024 ? S_ : 1024);
constexpr float ALPHA = 1.41421356237309515f, EPS = 1e-5f;

enum Stage { ST_GEMM, ST_ML_GATES, ST_ML_CLOC, ST_ML_SCAN, ST_ML_MI, ST_ML_SMAT, ST_ML_DEN, ST_ML_H, ST_ML_NORM,
             ST_LRU_CONV, ST_LRU_GATE, ST_LRU_SCAN, ST_LN, ST_SCORES, ST_SELECT, ST_HID, ST_FFN,
             ST_S5_PAR, ST_S5_SCAN, ST_S5_OUT, ST_S5_GLU, ST_GLA_GATE, ST_GLA_CUM, ST_GLA_U, ST_GLA_SCAN, ST_GLA_ATT, ST_GLA_O, ST_GLA_NORM };

struct Ctx {
    const float* in[38];
    const float* gA; const float* gW; const float* gR; float* gC; const float* gBias;
    const float* hcur;
    float* hout;
    const float* lnw; const float* lnb;
    float* proj; float* mixed; float* z;
    float* mb; float* mig; float* mblast; float* mmloc; float* mmprev; float* cloc; float* nloc; float* smat; float* mmi; float* mwin; float* mden; float* htil;
    float* lxc; float* la; float* lu;
    float* scores; int* ridx; float* rwt; float* hid;
    float* s5ab; float* s5bbr; float* s5bbi; float* s5st; float* s5x; float* s5g;
    float* gla_la; float* gla_bc; float* gla_bl; float* gu; float* gatt; float* go;
    long gM, gN, gK, glda, gldw, gldc, gldr;
    long ldp;
    float gralpha; int layer; int slab; int pad0;
};

HD float sigm(float x) { return 1.0f / (1.0f + expf(-x)); }
HD float logsig(float x) { return fminf(x, 0.f) - log1pf(expf(-fabsf(x))); }
HD float softplus(float x) { return fmaxf(x, 0.f) + log1pf(expf(-fabsf(x))); }
HD float silu(float x) { return x * sigm(x); }
HD float gelu_t(float x) { return 0.5f * x * (1.0f + tanhf(0.7978845608028654f * (x + 0.044715f * x * x * x))); }

template <int ST> HD void item(const Ctx& c, long idx);

template <> HD void item<ST_GEMM>(const Ctx& c, long idx) {
    const long m = idx / c.gN, n = idx % c.gN;
    float acc = 0.f;
    const float* a = c.gA + m * c.glda; const float* w = c.gW + n;
    for (long k = 0; k < c.gK; ++k) acc += a[k] * w[k * c.gldw];
    if (c.gBias) acc += c.gBias[n];
    if (c.gR) acc += c.gralpha * c.gR[m * c.gldr + n];
    c.gC[m * c.gldc + n] = acc;
}
template <> HD void item<ST_ML_GATES>(const Ctx& c, long idx) {
    const int bh = (int)(idx / NCH), n = (int)(idx % NCH), b = bh / 4, h = bh % 4;
    const float* gb = c.in[7];
    const long t0 = (long)b * S_ + n * 64; const long o0 = (long)bh * S_ + n * 64;
    float acc = 0.f;
    for (int l = 0; l < 64; ++l) {
        const float f = c.proj[(t0 + l) * c.ldp + 2052 + h] + gb[4 + h];
        acc += logsig(f);
        c.mb[o0 + l] = acc;
        c.mig[o0 + l] = c.proj[(t0 + l) * c.ldp + 2048 + h] + gb[h];
    }
    c.mblast[idx] = acc;
    float ml = -INFINITY;
    for (int l = 0; l < 64; ++l) ml = fmaxf(ml, acc - c.mb[o0 + l] + c.mig[o0 + l]);
    c.mmloc[idx] = ml;
}
template <> HD void item<ST_ML_CLOC>(const Ctx& c, long idx) {
    const int e = (int)(idx % 128), d = (int)((idx / 128) % 128); const long cn = idx / 16384;
    const int bh = (int)(cn / NCH), n = (int)(cn % NCH), b = bh / 4, h = bh % 4;
    const long t0 = (long)b * S_ + n * 64; const long o0 = (long)bh * S_ + n * 64;
    const float bl = c.mblast[cn], ml = c.mmloc[cn]; const float sc = 0.08838834764831845f;
    float acc = 0.f, accn = 0.f;
    for (int l = 0; l < 64; ++l) {
        const float p = expf(bl - c.mb[o0 + l] + c.mig[o0 + l] - ml);
        const float kk = c.proj[(t0 + l) * c.ldp + 512 + h * 128 + d] * sc;
        acc += p * kk * c.proj[(t0 + l) * c.ldp + 1024 + h * 128 + e];
        accn += p * kk;
    }
    c.cloc[idx] = acc;
    if (e == 0) c.nloc[cn * 128 + d] = accn;
}
template <> HD void item<ST_ML_SCAN>(const Ctx& c, long idx) {
    const bool isn = idx >= 8L * 16384;
    long bh, de; float* buf; long stride;
    if (!isn) { bh = idx / 16384; de = idx % 16384; buf = c.cloc; stride = 16384; }
    else { const long r = idx - 8L * 16384; bh = r / 128; de = r % 128; buf = c.nloc; stride = 128; }
    float st = 0.f, m = 0.f;
    for (int n = 0; n < NCH; ++n) {
        const long cn = bh * NCH + n;
        const float cl = buf[cn * stride + de]; buf[cn * stride + de] = st;
        const float bl = c.mblast[cn], ml = c.mmloc[cn];
        const float mn = fmaxf(bl + m, ml);
        st = expf(bl + m - mn) * st + expf(ml - mn) * cl;
        if (!isn && de == 0) c.mmprev[cn] = m;
        m = mn;
    }
}
template <> HD void item<ST_ML_MI>(const Ctx& c, long idx) {
    const long bh = idx / S_; const int s = (int)(idx % S_), n = s / 64, i = s % 64; const long cn = bh * NCH + n;
    const long o0 = bh * S_ + n * 64;
    const float bi = c.mb[idx]; const float minter = bi + c.mmprev[cn];
    float dmax = -INFINITY;
    for (int j = 0; j <= i; ++j) dmax = fmaxf(dmax, bi - c.mb[o0 + j] + c.mig[o0 + j]);
    const float mi = fmaxf(minter, dmax);
    c.mmi[idx] = mi; c.mwin[idx] = expf(minter - mi);
}
template <> HD void item<ST_ML_SMAT>(const Ctx& c, long idx) {
    const int j = (int)(idx % 64), i = (int)((idx / 64) % 64); const long cn = idx / 4096;
    const int bh = (int)(cn / NCH), n = (int)(cn % NCH), b = bh / 4, h = bh % 4;
    if (j > i) { c.smat[idx] = 0.f; return; }
    const long t0 = (long)b * S_ + n * 64; const long o0 = (long)bh * S_ + n * 64;
    const float* q = c.proj + (t0 + i) * c.ldp + h * 128; const float* k = c.proj + (t0 + j) * c.ldp + 512 + h * 128;
    float dot = 0.f;
    for (int d = 0; d < 128; ++d) dot += q[d] * k[d];
    dot *= 0.08838834764831845f;
    c.smat[idx] = dot * expf(c.mb[o0 + i] - c.mb[o0 + j] + c.mig[o0 + j] - c.mmi[o0 + i]);
}
template <> HD void item<ST_ML_DEN>(const Ctx& c, long idx) {
    const long bh = idx / S_; const int s = (int)(idx % S_), n = s / 64, i = s % 64; const long cn = bh * NCH + n;
    const int b = (int)(bh / 4), h = (int)(bh % 4);
    float den = 0.f;
    for (int j = 0; j <= i; ++j) den += c.smat[cn * 4096 + i * 64 + j];
    const float* q = c.proj + ((long)b * S_ + s) * c.ldp + h * 128;
    float qn = 0.f;
    for (int d = 0; d < 128; ++d) qn += q[d] * c.nloc[cn * 128 + d];
    den += c.mwin[idx] * qn;
    c.mden[idx] = fmaxf(fabsf(den), expf(-c.mmi[idx]));
}
template <> HD void item<ST_ML_H>(const Ctx& c, long idx) {
    const int e = (int)(idx % 128); const long bs = idx / 128; const long bh = bs / S_; const int s = (int)(bs % S_), n = s / 64, i = s % 64;
    const long cn = bh * NCH + n; const int b = (int)(bh / 4), h = (int)(bh % 4);
    const long t0 = (long)b * S_ + n * 64;
    float num = 0.f;
    for (int j = 0; j <= i; ++j) num += c.smat[cn * 4096 + i * 64 + j] * c.proj[(t0 + j) * c.ldp + 1024 + h * 128 + e];
    const float* q = c.proj + (t0 + i) * c.ldp + h * 128;
    float qc = 0.f;
    for (int d = 0; d < 128; ++d) qc += q[d] * c.cloc[cn * 16384 + d * 128 + e];
    num += c.mwin[bs] * qc;
    c.htil[(t0 + i) * 512 + h * 128 + e] = num / c.mden[bs];
}
template <> HD void item<ST_ML_NORM>(const Ctx& c, long idx) {
    const long bh = idx / S_; const int s = (int)(idx % S_); const int b = (int)(bh / 4), h = (int)(bh % 4);
    const long t = (long)b * S_ + s;
    const float* ht = c.htil + t * 512 + h * 128; const float* nw = c.in[8];
    float mean = 0.f;
    for (int e = 0; e < 128; ++e) mean += ht[e];
    mean *= (1.f / 128.f);
    float var = 0.f;
    for (int e = 0; e < 128; ++e) { const float d = ht[e] - mean; var += d * d; }
    const float rstd = 1.0f / sqrtf(var * (1.f / 128.f) + EPS);
    for (int e = 0; e < 128; ++e)
        c.mixed[t * 1024 + h * 128 + e] = (ht[e] - mean) * rstd * nw[h * 128 + e] * sigm(c.proj[t * c.ldp + 1536 + h * 128 + e]);
}
template <> HD void item<ST_LRU_CONV>(const Ctx& c, long idx) {
    const long t = idx / 512; const int ch = (int)(idx % 512); const int s = (int)(t % S_);
    const float* cw = c.in[9];
    float acc = c.in[10][ch];
    for (int j = 0; j < 4; ++j) { const int ss = s - 3 + j; if (ss >= 0) acc += cw[j * 512 + ch] * c.proj[(t - 3 + j) * c.ldp + 2056 + ch]; }
    c.lxc[idx] = acc;
}
template <> HD void item<ST_LRU_GATE>(const Ctx& c, long idx) {
    const long t = idx / 512; const int ch = (int)(idx % 512), hh = ch / 128, jj = ch % 128;
    const float* wa = c.in[11] + (long)hh * 16384; const float* wx = c.in[13] + (long)hh * 16384;
    const float* xr = c.lxc + t * 512 + hh * 128;
    float ra = c.in[12][ch], xa = c.in[14][ch];
    for (int i = 0; i < 128; ++i) { ra += xr[i] * wa[i * 128 + jj]; xa += xr[i] * wx[i * 128 + jj]; }
    const float r = sigm(ra), ii = sigm(xa);
    const float la = -8.0f * r * softplus(-c.in[15][ch]);
    c.la[idx] = expf(la);
    c.lu[idx] = sqrtf(-expm1f(2.0f * la)) * ii * c.lxc[idx];
}
template <> HD void item<ST_LRU_SCAN>(const Ctx& c, long idx) {
    const int b = (int)(idx / 512), ch = (int)(idx % 512);
    float h = 0.f;
    for (int s = 0; s < S_; ++s) {
        const long t = (long)b * S_ + s;
        h = c.la[t * 512 + ch] * h + c.lu[t * 512 + ch];
        c.mixed[t * 1024 + 512 + ch] = h * gelu_t(c.proj[t * c.ldp + 2568 + ch]);
    }
}
template <> HD void item<ST_LN>(const Ctx& c, long t) {
    const float* zr = c.z + t * 1024;
    float mean = 0.f;
    for (int i = 0; i < 1024; ++i) mean += zr[i];
    mean *= (1.f / 1024.f);
    float var = 0.f;
    for (int i = 0; i < 1024; ++i) { const float d = zr[i] - mean; var += d * d; }
    const float rstd = 1.0f / sqrtf(var * (1.f / 1024.f) + EPS);
    for (int i = 0; i < 1024; ++i) c.hout[t * 1024 + i] = (zr[i] - mean) * rstd * c.lnw[i] + c.lnb[i];
}
template <> HD void item<ST_SCORES>(const Ctx& c, long idx) {
    const long t = idx / 64; const int e = (int)(idx % 64);
    const float* rw = c.in[30] + (long)c.layer * 1024 * 64; const float* hr = c.hcur + t * 1024;
    float acc = 0.f;
    for (int k = 0; k < 1024; ++k) acc += hr[k] * rw[k * 64 + e];
    c.scores[idx] = sigm(acc);
}
template <> HD void item<ST_SELECT>(const Ctx& c, long t) {
    const float* sc = c.scores + t * 64; const float* bias = c.in[31] + c.layer * 64;
    float gs[8];
#pragma unroll
    for (int g = 0; g < 8; ++g) {
        float m1 = -INFINITY, m2 = -INFINITY;
        for (int j = 0; j < 8; ++j) { const float v = sc[g * 8 + j] + bias[g * 8 + j]; if (v > m1) { m2 = m1; m1 = v; } else if (v > m2) m2 = v; }
        gs[g] = m1 + m2;
    }
    unsigned gsel = 0;
    for (int it = 0; it < 4; ++it) {
        float best = -INFINITY; int bi = 0;
#pragma unroll
        for (int g = 0; g < 8; ++g) { const bool ok = !((gsel >> g) & 1u) && gs[g] > best; best = ok ? gs[g] : best; bi = ok ? g : bi; }
        gsel |= 1u << bi;
    }
    unsigned long long taken = 0ull; float wsum = 0.f;
    for (int it = 0; it < 8; ++it) {
        float best = -INFINITY; int bi = 0;
        for (int e = 0; e < 64; ++e) {
            if (!((gsel >> (e >> 3)) & 1u) || ((taken >> e) & 1ull)) continue;
            const float v = sc[e] + bias[e];
            if (v > best) { best = v; bi = e; }
        }
        taken |= 1ull << bi;
        c.ridx[t * 8 + it] = bi; const float w = sc[bi]; c.rwt[t * 8 + it] = w; wsum += w;
    }
    const float inv = 2.5f / wsum;
    for (int it = 0; it < 8; ++it) c.rwt[t * 8 + it] *= inv;
}
template <> HD void item<ST_HID>(const Ctx& c, long idx) {
    const int j = (int)(idx % 256), k = (int)((idx / 256) % 9); const long t = idx / 2304;
    const float *wg, *wu;
    if (k < 8) { const long e = (long)c.layer * 64 + c.ridx[t * 8 + k]; wg = c.in[32] + e * 262144; wu = c.in[33] + e * 262144; }
    else { wg = c.in[35] + (long)c.layer * 262144; wu = c.in[36] + (long)c.layer * 262144; }
    const float* hr = c.hcur + t * 1024;
    float g = 0.f, u = 0.f;
    for (int d = 0; d < 1024; ++d) { const float x = hr[d]; g += x * wg[d * 256 + j]; u += x * wu[d * 256 + j]; }
    c.hid[idx] = silu(g) * u;
}
template <> HD void item<ST_FFN>(const Ctx& c, long idx) {
    const long t = idx / 1024; const int n = (int)(idx % 1024);
    float tot = 0.f;
    for (int k = 0; k < 9; ++k) {
        const float* wd; float w;
        if (k < 8) { const long e = (long)c.layer * 64 + c.ridx[t * 8 + k]; wd = c.in[34] + e * 262144; w = c.rwt[t * 8 + k]; }
        else { wd = c.in[37] + (long)c.layer * 262144; w = 1.f; }
        const float* hr = c.hid + (t * 9 + k) * 256;
        float acc = 0.f;
        for (int j = 0; j < 256; ++j) acc += hr[j] * wd[j * 1024 + n];
        tot += w * acc;
    }
    c.z[idx] = ALPHA * c.hcur[idx] + tot;
}
template <> HD void item<ST_S5_PAR>(const Ctx& c, long idx) {
    const int g = (int)(idx / 64);
    const float lr = c.in[17][idx], li = c.in[18][idx]; const float dt = expf(c.in[24][g]);
    const float mag = expf(lr * dt); const float ar = mag * cosf(li * dt), ai = mag * sinf(li * dt);
    const float den = lr * lr + li * li, nr = ar - 1.0f;
    const float cr = (nr * lr + ai * li) / den, ci = (ai * lr - nr * li) / den;
    c.s5ab[idx * 2] = ar; c.s5ab[idx * 2 + 1] = ai;
    for (int h = 0; h < 16; ++h) {
        const float br = c.in[19][idx * 16 + h], bi = c.in[20][idx * 16 + h];
        c.s5bbr[idx * 16 + h] = cr * br - ci * bi; c.s5bbi[idx * 16 + h] = cr * bi + ci * br;
    }
}
template <> HD void item<ST_S5_SCAN>(const Ctx& c, long idx) {
    const int gp = (int)(idx % 2048), g = gp / 64, b = (int)(idx / 2048);
    const float ar = c.s5ab[gp * 2], ai = c.s5ab[gp * 2 + 1];
    float xr = 0.f, xi = 0.f;
    if (c.slab > 0) { xr = c.s5st[idx * 2]; xi = c.s5st[idx * 2 + 1]; }
    for (int sl = 0; sl < SLAB; ++sl) {
        const long t = (long)b * S_ + (long)c.slab * SLAB + sl;
        const float* u = c.proj + t * c.ldp + g * 16;
        float br = 0.f, bi = 0.f;
        for (int h = 0; h < 16; ++h) { br += u[h] * c.s5bbr[gp * 16 + h]; bi += u[h] * c.s5bbi[gp * 16 + h]; }
        const float nr = ar * xr - ai * xi + br, ni = ar * xi + ai * xr + bi;
        xr = nr; xi = ni;
        const long o = (((long)b * SLAB + sl) * 2048 + gp) * 2;
        c.s5x[o] = xr; c.s5x[o + 1] = xi;
    }
    c.s5st[idx * 2] = xr; c.s5st[idx * 2 + 1] = xi;
}
template <> HD void item<ST_S5_OUT>(const Ctx& c, long idx) {
    const int ch = (int)(idx % 512), g = ch / 16; const long bs = idx / 512; const int b = (int)(bs / SLAB), sl = (int)(bs % SLAB);
    const long t = (long)b * S_ + (long)c.slab * SLAB + sl;
    const float* x = c.s5x + (bs * 2048 + g * 64) * 2; const float* cre = c.in[21] + ch * 64; const float* cim = c.in[22] + ch * 64;
    float y = 0.f;
    for (int p = 0; p < 64; ++p) y += x[2 * p] * cre[p] - x[2 * p + 1] * cim[p];
    y += c.in[23][ch] * c.proj[t * c.ldp + ch];
    c.s5g[t * 512 + ch] = gelu_t(y);
}
template <> HD void item<ST_S5_GLU>(const Ctx& c, long idx) {
    const long t = idx / 512; const int n = (int)(idx % 512);
    const float* gr = c.s5g + t * 512; const float* w = c.in[25];
    float acc = c.in[26][n];
    for (int k = 0; k < 512; ++k) acc += gr[k] * w[k * 512 + n];
    c.mixed[t * 1024 + n] = gr[n] * sigm(acc);
}
template <> HD void item<ST_GLA_GATE>(const Ctx& c, long idx) {
    const long t = idx / 256; const int ch = (int)(idx % 256);
    float acc = c.in[28][ch];
    for (int r = 0; r < 16; ++r) acc += c.proj[t * c.ldp + 2048 + r] * c.in[27][r * 256 + ch];
    c.gla_la[idx] = logsig(acc) * (1.0f / 16.0f);
}
template <> HD void item<ST_GLA_CUM>(const Ctx& c, long idx) {
    const int ch = (int)(idx % 256); const long bn = idx / 256; const int b = (int)(bn / NCH), n = (int)(bn % NCH);
    const long t0 = (long)b * S_ + n * 64;
    float acc = 0.f;
    for (int l = 0; l < 64; ++l) { acc += c.gla_la[(t0 + l) * 256 + ch]; c.gla_bc[(t0 + l) * 256 + ch] = acc; }
    c.gla_bl[idx] = acc;
}
template <> HD void item<ST_GLA_U>(const Ctx& c, long idx) {
    const int e = (int)(idx % 128), d = (int)((idx / 128) % 64); const long cn = idx / 8192;
    const int bh = (int)(cn / NCH), n = (int)(cn % NCH), b = bh / 4, h = bh % 4;
    const long t0 = (long)b * S_ + n * 64;
    const float bl = c.gla_bl[((long)b * NCH + n) * 256 + h * 64 + d];
    float acc = 0.f;
    for (int l = 0; l < 64; ++l)
        acc += c.proj[(t0 + l) * c.ldp + 768 + h * 64 + d] * expf(bl - c.gla_bc[(t0 + l) * 256 + h * 64 + d]) * c.proj[(t0 + l) * c.ldp + 1024 + h * 128 + e];
    c.gu[idx] = acc;
}
template <> HD void item<ST_GLA_SCAN>(const Ctx& c, long idx) {
    const long bh = idx / 8192; const int de = (int)(idx % 8192), d = de / 128; const int b = (int)(bh / 4), h = (int)(bh % 4);
    float st = 0.f;
    for (int n = 0; n < NCH; ++n) {
        const long cn = bh * NCH + n;
        const float u = c.gu[cn * 8192 + de]; c.gu[cn * 8192 + de] = st;
        st = expf(c.gla_bl[((long)b * NCH + n) * 256 + h * 64 + d]) * st + u;
    }
}
template <> HD void item<ST_GLA_ATT>(const Ctx& c, long idx) {
    const int j = (int)(idx % 64), i = (int)((idx / 64) % 64); const long cn = idx / 4096;
    const int bh = (int)(cn / NCH), n = (int)(cn % NCH), b = bh / 4, h = bh % 4;
    if (j > i) { c.gatt[idx] = 0.f; return; }
    const long ti = (long)b * S_ + n * 64 + i, tj = (long)b * S_ + n * 64 + j;
    float acc = 0.f;
    for (int d = 0; d < 64; ++d)
        acc += c.proj[ti * c.ldp + 512 + h * 64 + d] * 0.125f * expf(c.gla_bc[ti * 256 + h * 64 + d] - c.gla_bc[tj * 256 + h * 64 + d]) * c.proj[tj * c.ldp + 768 + h * 64 + d];
    c.gatt[idx] = acc;
}
template <> HD void item<ST_GLA_O>(const Ctx& c, long idx) {
    const int e = (int)(idx % 128); const long bs = idx / 128; const long bh = bs / S_; const int s = (int)(bs % S_), n = s / 64, i = s % 64;
    const long cn = bh * NCH + n; const int b = (int)(bh / 4), h = (int)(bh % 4);
    const long t0 = (long)b * S_ + n * 64, t = t0 + i;
    float acc = 0.f;
    for (int j = 0; j <= i; ++j) acc += c.gatt[cn * 4096 + i * 64 + j] * c.proj[(t0 + j) * c.ldp + 1024 + h * 128 + e];
    for (int d = 0; d < 64; ++d)
        acc += c.proj[t * c.ldp + 512 + h * 64 + d] * 0.125f * expf(c.gla_bc[t * 256 + h * 64 + d]) * c.gu[cn * 8192 + d * 128 + e];
    c.go[t * 512 + h * 128 + e] = acc;
}
template <> HD void item<ST_GLA_NORM>(const Ctx& c, long idx) {
    const long bh = idx / S_; const int s = (int)(idx % S_); const int b = (int)(bh / 4), h = (int)(bh % 4);
    const long t = (long)b * S_ + s;
    const float* o = c.go + t * 512 + h * 128;
    float ms = 0.f;
    for (int e = 0; e < 128; ++e) ms += o[e] * o[e];
    const float rstd = 1.0f / sqrtf(ms * (1.f / 128.f) + EPS);
    for (int e = 0; e < 128; ++e)
        c.mixed[t * 1024 + 512 + h * 128 + e] = o[e] * rstd * c.in[29][h * 128 + e] * silu(c.proj[t * c.ldp + 1536 + h * 128 + e]);
}

struct Mem { float* base; size_t off; HDF float* get(size_t n) { float* p = base + off; off += (n + 63) & ~(size_t)63; return p; } };

template <class Runner> HDF void forward(Runner& R, void* const* d_in, float* d_out, float* ws) {
    Ctx c{};
    for (int i = 0; i < 38; ++i) c.in[i] = (const float*)d_in[i];
    Mem M{ws, 0};
    c.z = M.get((size_t)T_ * 1024); c.mixed = M.get((size_t)T_ * 1024); c.scores = M.get((size_t)T_ * 64);
    c.ridx = (int*)M.get((size_t)T_ * 8); c.rwt = M.get((size_t)T_ * 8);
    const size_t scratch0 = M.off;
    for (int layer = 0; layer < 2; ++layer) {
        c.layer = layer;
        c.hcur = layer == 0 ? c.in[0] : d_out;
        M.off = scratch0;
        if (layer == 0) {
            c.ldp = EIN; c.proj = M.get((size_t)T_ * c.ldp);
            c.mb = M.get(8 * S_); c.mig = M.get(8 * S_); c.mblast = M.get(8 * NCH); c.mmloc = M.get(8 * NCH); c.mmprev = M.get(8 * NCH);
            c.mmi = M.get(8 * S_); c.mwin = M.get(8 * S_); c.mden = M.get(8 * S_); c.nloc = M.get(8 * NCH * 128);
            const size_t ov = M.off;
            c.cloc = M.get((size_t)8 * NCH * 16384); c.smat = M.get((size_t)8 * NCH * 4096); c.htil = M.get((size_t)T_ * 512);
            M.off = ov; c.lxc = M.get((size_t)T_ * 512); c.la = M.get((size_t)T_ * 512); c.lu = M.get((size_t)T_ * 512);
            c.gA = c.hcur; c.glda = 1024; c.gW = c.in[6]; c.gldw = EIN; c.gC = c.proj; c.gldc = EIN; c.gR = nullptr; c.gBias = nullptr; c.gM = T_; c.gN = EIN; c.gK = 1024;
            R.template run<ST_GEMM>(c, (long)T_ * c.ldp);
            R.template run<ST_ML_GATES>(c, 8L * NCH);
            R.template run<ST_ML_CLOC>(c, 8L * NCH * 16384);
            R.template run<ST_ML_SCAN>(c, 8L * 16384 + 8 * 128);
            R.template run<ST_ML_MI>(c, 8L * S_);
            R.template run<ST_ML_SMAT>(c, 8L * NCH * 4096);
            R.template run<ST_ML_DEN>(c, 8L * S_);
            R.template run<ST_ML_H>(c, 8L * S_ * 128);
            R.template run<ST_ML_NORM>(c, 8L * S_);
            R.template run<ST_LRU_CONV>(c, (long)T_ * 512);
            R.template run<ST_LRU_GATE>(c, (long)T_ * 512);
            R.template run<ST_LRU_SCAN>(c, 2L * 512);
        } else {
            c.ldp = OIN; c.proj = M.get((size_t)T_ * c.ldp);
            c.s5ab = M.get(2048 * 2); c.s5bbr = M.get(2048 * 16); c.s5bbi = M.get(2048 * 16); c.s5st = M.get(2 * 2048 * 2);
            c.s5x = M.get((size_t)B_ * SLAB * 2048 * 2); c.s5g = M.get((size_t)T_ * 512);
            c.gla_la = M.get((size_t)T_ * 256); c.gla_bc = M.get((size_t)T_ * 256); c.gla_bl = M.get((size_t)B_ * NCH * 256);
            c.gu = M.get((size_t)8 * NCH * 8192); c.gatt = M.get((size_t)8 * NCH * 4096); c.go = M.get((size_t)T_ * 512);
            c.gA = c.hcur; c.glda = 1024; c.gW = c.in[16]; c.gldw = OIN; c.gC = c.proj; c.gldc = OIN; c.gR = nullptr; c.gBias = nullptr; c.gM = T_; c.gN = OIN; c.gK = 1024;
            R.template run<ST_GEMM>(c, (long)T_ * c.ldp);
            R.template run<ST_S5_PAR>(c, 2048);
            for (int sl = 0; sl < S_ / SLAB; ++sl) { c.slab = sl; R.template run<ST_S5_SCAN>(c, 2L * 2048); R.template run<ST_S5_OUT>(c, (long)B_ * SLAB * 512); }
            c.slab = 0;
            R.template run<ST_S5_GLU>(c, (long)T_ * 512);
            R.template run<ST_GLA_GATE>(c, (long)T_ * 256);
            R.template run<ST_GLA_CUM>(c, (long)B_ * NCH * 256);
            R.template run<ST_GLA_U>(c, 8L * NCH * 8192);
            R.template run<ST_GLA_SCAN>(c, 8L * 8192);
            R.template run<ST_GLA_ATT>(c, 8L * NCH * 4096);
            R.template run<ST_GLA_O>(c, 8L * S_ * 128);
            R.template run<ST_GLA_NORM>(c, 8L * S_);
        }
        c.gA = c.mixed; c.glda = 1024; c.gW = c.in[5] + (size_t)layer * 1024 * 1024; c.gldw = 1024; c.gC = c.z; c.gldc = 1024; c.gR = c.hcur; c.gldr = 1024; c.gralpha = ALPHA; c.gM = T_; c.gN = 1024; c.gK = 1024;
        R.template run<ST_GEMM>(c, (long)T_ * 1024);
        c.gR = nullptr;
        c.hout = d_out; c.lnw = c.in[1] + layer * 1024; c.lnb = c.in[2] + layer * 1024;
        R.template run<ST_LN>(c, T_);
        c.hcur = d_out;
        M.off = scratch0; c.hid = M.get((size_t)T_ * 9 * 256);
        R.template run<ST_SCORES>(c, (long)T_ * 64);
        R.template run<ST_SELECT>(c, T_);
        R.template run<ST_HID>(c, (long)T_ * 9 * 256);
        R.template run<ST_FFN>(c, (long)T_ * 1024);
        c.lnw = c.in[3] + layer * 1024; c.lnb = c.in[4] + layer * 1024;
        R.template run<ST_LN>(c, T_);
    }
}
}
#define GAS __attribute__((address_space(1)))
#define LAS __attribute__((address_space(3)))
#define XB_TMO      128
#define XB_XCNT(j)  (256  + 64 * (j))
#define XB_XSUB(j)  (1280 + 64 * (j))
#define XB_XGEN(j)  (2304 + 64 * (j))
#define XB_TOP      3328
#define XB_TOPGEN   3392
#define XCD_BAR_WORDS 3456
#define XB_SPIN_CAP (1u << 22)
__device__ __forceinline__ unsigned xb_ld(unsigned* p)              { return __hip_atomic_load(p, __ATOMIC_RELAXED, __HIP_MEMORY_SCOPE_AGENT); }
__device__ __forceinline__ unsigned xb_add(unsigned* p, unsigned v) { return __hip_atomic_fetch_add(p, v, __ATOMIC_RELAXED, __HIP_MEMORY_SCOPE_AGENT); }
__device__ __forceinline__ unsigned xb_xcc_id() { return (unsigned)__builtin_amdgcn_s_getreg((3 << 11) | 20) & 0xFu; }
#define XB_SPIN(cond, bar) do { unsigned _sp = 0; while (cond) { __builtin_amdgcn_s_sleep(1); \
    if ((++_sp & 255u) == 0u) { if (xb_ld(&(bar)[XB_TMO])) break; if (_sp > XB_SPIN_CAP) { atomicAdd(&(bar)[XB_TMO], 1u); break; } } } } while (0)
struct XcdBarrier { unsigned* bar; unsigned x; volatile LAS unsigned* st; };
__device__ __forceinline__ XcdBarrier xcd_barrier_post(unsigned* bar, volatile LAS unsigned* st) {
    XcdBarrier b; b.bar = bar; b.x = xb_xcc_id(); b.st = st;
    if (threadIdx.x == 0) (void)xb_add(&bar[XB_XCNT(b.x)], 1u);
    return b;
}
__device__ __forceinline__ void xcd_barrier_complete(unsigned* bar, unsigned x, unsigned& nloc, unsigned& nx) {
    const unsigned G = gridDim.x * gridDim.y * gridDim.z;
    unsigned sum, cnt, mine, sp = 0u;
    for (;;) {
        sum = 0u; cnt = 0u; mine = 0u;
#pragma unroll
        for (unsigned j = 0; j < 16; ++j) { const unsigned c = xb_ld(&bar[XB_XCNT(j)]); sum += c; cnt += (c > 0u) ? 1u : 0u; mine = (j == x) ? c : mine; }
        if (sum == G) break;
        __builtin_amdgcn_s_sleep(1);
        if ((++sp & 255u) == 0u) { if (xb_ld(&bar[XB_TMO])) break; if (sp > XB_SPIN_CAP) { atomicAdd(&bar[XB_TMO], 1u); break; } }
    }
    nloc = mine > 0u ? mine : 1u; nx = cnt > 0u ? cnt : 1u;
}
__device__ __forceinline__ void xcd_barrier(const XcdBarrier& b) {
    asm volatile("s_waitcnt vmcnt(0)" ::: "memory");
    __syncthreads();
    if (threadIdx.x == 0) {
        unsigned* bar = b.bar;
        __builtin_amdgcn_s_waitcnt(0);
        unsigned nloc = b.st[0], nx = b.st[1];
        if (nloc == 0u) { xcd_barrier_complete(bar, b.x, nloc, nx); b.st[0] = nloc; b.st[1] = nx; }
        const unsigned old = xb_add(&bar[XB_XSUB(b.x)], 1u);
        const unsigned gen = old / nloc;
        if (old + 1u == (gen + 1u) * nloc) {
            __builtin_amdgcn_fence(__ATOMIC_RELEASE, "agent");
            asm volatile("s_waitcnt vmcnt(0)" ::: "memory");
            const unsigned og = xb_add(&bar[XB_TOP], 1u);
            const unsigned tg = og / nx;
            if (og + 1u == (tg + 1u) * nx) xb_add(&bar[XB_TOPGEN], 1u);
            else XB_SPIN(xb_ld(&bar[XB_TOPGEN]) == tg, bar);
            __builtin_amdgcn_fence(__ATOMIC_ACQUIRE, "agent");
            xb_add(&bar[XB_XGEN(b.x)], 1u);
            asm volatile("s_waitcnt vmcnt(0)" ::: "memory");
        } else {
            XB_SPIN(xb_ld(&bar[XB_XGEN(b.x)]) == gen, bar);
            __builtin_amdgcn_fence(__ATOMIC_ACQUIRE, "agent");
            asm volatile("s_waitcnt vmcnt(0)" ::: "memory");
        }
    }
    __syncthreads();
}
namespace pg8 {
#define PG8_LAS __attribute__((address_space(3)))
typedef unsigned short bf16_t;
typedef short bf16x8 __attribute__((ext_vector_type(8)));
typedef float f32x4 __attribute__((ext_vector_type(4)));
typedef unsigned u32x4 __attribute__((ext_vector_type(4)));
constexpr int BM = 256, BK = 64, HALF = 128, HTB = HALF * BK * 2, STAGE_BYTES = 8 * HTB, NXCD = 8, WGM = 8;
__host__ __device__ __forceinline__ int lds_byte(int r, int c) { const int st = (r >> 4) * 2 + (c >> 5), rr = r & 15, cc = c & 31, ob = rr * 64 + cc * 2; return st * 1024 + (ob ^ (((ob >> 9) & 1) << 5)); }
__host__ __device__ __forceinline__ void stage_rc(int b, int& R, int& C) { const int st = b / 1024, sb = b % 1024, swz = sb ^ (((sb >> 9) & 1) << 5); R = (st >> 1) * 16 + swz / 64; C = (st & 1) * 32 + (swz % 64) / 2; }
__host__ __device__ __forceinline__ int perm32(int rho) { const int n = rho >> 4, i = rho & 15; return 8 * (i >> 2) + 4 * n + (i & 3); }
struct Unit { int pm, pn, e, aux; };
struct Gemm { const bf16_t* A; const bf16_t* Bt; int K; int pad; size_t bstride; const int* rows; };
struct StaticOrder {
    int nM, nN, nwg, G, c;
    __host__ __device__ void init(int M, int N, int G_, int c_) { nM = M / BM; nN = N / BM; nwg = nM * nN; G = G_; c = c_; }
    __host__ __device__ bool next(int i, Unit& u) const {
        const long L = (long)i * G + c; if (L >= nwg) return false;
        int wgid = (int)L; { const int q = nwg / NXCD, r = nwg % NXCD, xcd = wgid % NXCD, off = wgid / NXCD; wgid = (xcd < r ? xcd * (q + 1) : r * (q + 1) + (xcd - r) * q) + off; }
        const int nig = WGM * nN, gid = wgid / nig, fm = gid * WGM, gsz = (nM - fm) < WGM ? (nM - fm) : WGM;
        u.pm = fm + ((wgid % nig) % gsz); u.pn = (wgid % nig) / gsz; u.e = 0; u.aux = 0; return true;
    }
};
__device__ __forceinline__ unsigned cvt_pk_bf16(float lo, float hi) { unsigned r; asm volatile("v_cvt_pk_bf16_f32 %0, %1, %2" : "=v"(r) : "v"(lo), "v"(hi)); return r; }
struct EpiF32R {
    static constexpr bool PERM = false;
    float* C; int ldc; const float* R; float ralpha;
    __device__ __forceinline__ void operator()(const f32x4 (&acc)[2][2][4][2], const Unit& u, int wr, int wc, int fr, int fq) const {
        const int row0 = u.pm * BM + wr * 64 + fr, col0 = u.pn * BM + wc * 32 + 4 * fq;
#pragma unroll
        for (int ai = 0; ai < 2; ++ai)
#pragma unroll
            for (int m = 0; m < 4; ++m) { const size_t off = (size_t)(row0 + ai * HALF + m * 16) * ldc + col0;
#pragma unroll
                for (int bj = 0; bj < 2; ++bj)
#pragma unroll
                    for (int n = 0; n < 2; ++n) { f32x4 v = acc[ai][bj][m][n]; if (R) v = v + ralpha * *(const f32x4*)(R + off + bj * HALF + n * 16); *(f32x4*)(C + off + bj * HALF + n * 16) = v; } }
    }
};
struct EpiBf16P {
    static constexpr bool PERM = true;
    bf16_t* O; int ldc;
    __device__ __forceinline__ void operator()(const f32x4 (&acc)[2][2][4][2], const Unit& u, int wr, int wc, int fr, int fq) const {
        const int row0 = u.pm * BM + wr * 64 + fr, col0 = u.pn * BM + wc * 32 + 8 * fq;
#pragma unroll
        for (int ai = 0; ai < 2; ++ai)
#pragma unroll
            for (int m = 0; m < 4; ++m) { bf16_t* rowp = O + (size_t)(row0 + ai * HALF + m * 16) * ldc + col0;
#pragma unroll
                for (int bj = 0; bj < 2; ++bj) { const f32x4 v0 = acc[ai][bj][m][0], v1 = acc[ai][bj][m][1];
                    u32x4 w; w.x = cvt_pk_bf16(v0[0], v0[1]); w.y = cvt_pk_bf16(v0[2], v0[3]); w.z = cvt_pk_bf16(v1[0], v1[1]); w.w = cvt_pk_bf16(v1[2], v1[3]);
                    *(u32x4*)(rowp + bj * HALF) = w; } }
    }
};
struct EpiGlu {
    static constexpr bool PERM = true;
    bf16_t* O; int ldo; const bf16_t* Gm; int ldg; const float* bias;
    __device__ __forceinline__ void operator()(const f32x4 (&acc)[2][2][4][2], const Unit& u, int wr, int wc, int fr, int fq) const {
        const int row0 = u.pm * BM + wr * 64 + fr, col0 = u.pn * BM + wc * 32 + 8 * fq;
#pragma unroll
        for (int ai = 0; ai < 2; ++ai)
#pragma unroll
            for (int m = 0; m < 4; ++m) { const size_t r = (size_t)(row0 + ai * HALF + m * 16);
#pragma unroll
                for (int bj = 0; bj < 2; ++bj) { const int c = col0 + bj * HALF;
                    const f32x4 b0 = *(const f32x4*)(bias + c), b1 = *(const f32x4*)(bias + c + 4); const u32x4 gv = *(const u32x4*)(Gm + r * ldg + c);
                    const f32x4 v0 = acc[ai][bj][m][0] + b0, v1 = acc[ai][bj][m][1] + b1;
                    float g[8] = {__builtin_bit_cast(float, gv.x << 16), __builtin_bit_cast(float, gv.x & 0xffff0000u), __builtin_bit_cast(float, gv.y << 16), __builtin_bit_cast(float, gv.y & 0xffff0000u),
                                  __builtin_bit_cast(float, gv.z << 16), __builtin_bit_cast(float, gv.z & 0xffff0000u), __builtin_bit_cast(float, gv.w << 16), __builtin_bit_cast(float, gv.w & 0xffff0000u)};
                    u32x4 w; w.x = cvt_pk_bf16(g[0] / (1.f + __expf(-v0[0])), g[1] / (1.f + __expf(-v0[1]))); w.y = cvt_pk_bf16(g[2] / (1.f + __expf(-v0[2])), g[3] / (1.f + __expf(-v0[3])));
                    w.z = cvt_pk_bf16(g[4] / (1.f + __expf(-v1[0])), g[5] / (1.f + __expf(-v1[1]))); w.w = cvt_pk_bf16(g[6] / (1.f + __expf(-v1[2])), g[7] / (1.f + __expf(-v1[3])));
                    *(u32x4*)(O + r * ldo + c) = w; } }
    }
};
template <class Epi, class Sched, bool ALIGN_EPI, bool GATHER>
__device__ __forceinline__ void gemm_phase(PG8_LAS unsigned char* lds, const Gemm g, const Sched& S, const Epi& E) {
    int tid_ = threadIdx.x; asm volatile("" : "+v"(tid_));
    const int tid = tid_, wid = __builtin_amdgcn_readfirstlane(tid >> 6), lane = tid & 63, wr = wid >> 2, wc = wid & 3, fr = lane & 15, fq = lane >> 4;
    const int K = g.K, nt = K / BK;
    unsigned voffA[2], voffB[2];
#pragma unroll
    for (int i = 0; i < 2; ++i) { int R, C; stage_rc(tid * 16 + i * 8192, R, C); const int Rb = Epi::PERM ? ((R & ~31) + perm32(R & 31)) : R;
        voffA[i] = (unsigned)(R * K + C) * 2u; voffB[i] = (unsigned)(Rb * K + C) * 2u; }
    const size_t kstep = (size_t)(BK * 2);
    const size_t hstep = (size_t)HALF * K * 2;
    const size_t tstep = 2 * hstep;
    const unsigned ldsw = (unsigned)wid * 1024u;
    const int aoff = lds_byte(wr * 64 + fr, fq * 8), boff = lds_byte(wc * 32 + fr, fq * 8);
#define PG8_SA(b, h) (((b) * 2 + (h)) * HTB)
#define PG8_SB(b, h) ((4 + (b) * 2 + (h)) * HTB)
#define PG8_STAGE(bufoff, gbase, voff) do { _Pragma("unroll") for (int _i = 0; _i < 2; ++_i) { unsigned _vo = (voff)[_i]; asm volatile("" : "+v"(_vo));   \
        __builtin_amdgcn_global_load_lds((const unsigned*)((const char*)(gbase) + _vo), (PG8_LAS unsigned*)(lds + (bufoff) + ldsw + _i * 8192), 16, 0, 0); } } while (0)
#define PG8_STAGE_A(bufoff, gbase, h, GV) do { if constexpr (GATHER) { PG8_STAGE(bufoff, gbase, GV[h]); } else { PG8_STAGE(bufoff, (gbase) + (h) * hstep, voffA); } } while (0)
#define PG8_STAGE_A2(bufoff, gbase, h) do { if constexpr (GATHER) { unsigned _gv[2] = {last ? gnxt[h][0] : gcur[h][0], last ? gnxt[h][1] : gcur[h][1]}; PG8_STAGE(bufoff, gbase, _gv); } else { PG8_STAGE(bufoff, (gbase) + (h) * hstep, voffA); } } while (0)
#define PG8_LDA(dst, b, h) do { _Pragma("unroll") for (int m = 0; m < 4; ++m) _Pragma("unroll") for (int k = 0; k < 2; ++k) dst[m][k] = *(const PG8_LAS bf16x8*)(lds + PG8_SA(b, h) + aoff + m * 2048 + k * 1024); } while (0)
#define PG8_LDB(dst, b, h) do { _Pragma("unroll") for (int n = 0; n < 2; ++n) _Pragma("unroll") for (int k = 0; k < 2; ++k) dst[n][k] = *(const PG8_LAS bf16x8*)(lds + PG8_SB(b, h) + boff + n * 2048 + k * 1024); } while (0)
#define PG8_MMA(ai, bj, At, Bt) do { __builtin_amdgcn_s_setprio(1); _Pragma("unroll") for (int m = 0; m < 4; ++m) _Pragma("unroll") for (int n = 0; n < 2; ++n) _Pragma("unroll") for (int k = 0; k < 2; ++k) \
        acc[ai][bj][m][n] = __builtin_amdgcn_mfma_f32_16x16x32_bf16(Bt[n][k], At[m][k], acc[ai][bj][m][n], 0, 0, 0); __builtin_amdgcn_s_setprio(0); } while (0)
#define PG8_WAIT_V(n) asm volatile("s_waitcnt vmcnt(" #n ")" ::: "memory")
#define PG8_WAIT_L(n) asm volatile("s_waitcnt lgkmcnt(" #n ")" ::: "memory")
#define PG8_BAR __builtin_amdgcn_s_barrier()
#define PG8_SCHED __builtin_amdgcn_sched_barrier(0)
#define PG8_GLOAD(GV, u) do { _Pragma("unroll") for (int _i = 0; _i < 2; ++_i) { int _R, _C; stage_rc(tid * 16 + _i * 8192, _R, _C); _Pragma("unroll") for (int _h = 0; _h < 2; ++_h) \
        GV[_h][_i] = (unsigned)g.rows[(u).pm * BM + _h * HALF + _R] * (unsigned)(K * 2) + (unsigned)(_C * 2); } } while (0)
    Unit cur, nxt; int ui = 0;
    if (!S.next(0, cur)) return;
    f32x4 acc[2][2][4][2];
#pragma unroll
    for (int a = 0; a < 2; ++a)
#pragma unroll
        for (int b = 0; b < 2; ++b)
#pragma unroll
            for (int m = 0; m < 4; ++m)
#pragma unroll
                for (int n = 0; n < 2; ++n) acc[a][b][m][n] = (f32x4){0.f, 0.f, 0.f, 0.f};
    bf16x8 At[4][2], B0[2][2], B1[2][2];
    unsigned gcur[2][2] = {{0u, 0u}, {0u, 0u}}, gnxt[2][2] = {{0u, 0u}, {0u, 0u}};
    if constexpr (GATHER) { PG8_GLOAD(gcur, cur); }
    const char* cA = GATHER ? (const char*)g.A : (const char*)g.A + (size_t)cur.pm * tstep;
    const char* cB = (const char*)g.Bt + ((size_t)cur.e * g.bstride) * 2 + (size_t)cur.pn * tstep;
    PG8_STAGE(PG8_SB(0, 0), cB, voffB); PG8_STAGE(PG8_SB(0, 1), cB + hstep, voffB); PG8_STAGE_A(PG8_SA(0, 0), cA, 0, gcur); PG8_STAGE_A(PG8_SA(0, 1), cA, 1, gcur);
    if (wr == 1) PG8_BAR;
    PG8_WAIT_V(2); PG8_BAR;
    PG8_STAGE(PG8_SB(1, 0), cB + kstep, voffB); PG8_STAGE_A(PG8_SA(1, 0), cA + kstep, 0, gcur); PG8_STAGE(PG8_SB(1, 1), cB + hstep + kstep, voffB);
    PG8_WAIT_V(6); PG8_BAR;
    for (;;) {
        const bool has_next = S.next(ui + 1, nxt);
        if constexpr (GATHER) { if (has_next) { PG8_GLOAD(gnxt, nxt); } else {
#pragma unroll
            for (int _h = 0; _h < 2; ++_h)
#pragma unroll
                for (int _i = 0; _i < 2; ++_i) gnxt[_h][_i] = gcur[_h][_i]; } }
        const char* nA = GATHER ? cA : (has_next ? (const char*)g.A + (size_t)nxt.pm * tstep : cA);
        const char* nB = has_next ? (const char*)g.Bt + ((size_t)nxt.e * g.bstride) * 2 + (size_t)nxt.pn * tstep : cB;
#pragma unroll 1
        for (int t = 0; t < nt; t += 2) {
            const bool last = (t == nt - 2);
            const char* a1 = cA + (size_t)(t + 1) * kstep;
            const char* a2 = last ? nA : cA + (size_t)(t + 2) * kstep; const char* b2 = last ? nB : cB + (size_t)(t + 2) * kstep;
            const char* a3 = a2 + kstep; const char* b3 = b2 + kstep;
            PG8_LDB(B0, 0, 0); PG8_LDB(B1, 0, 1); PG8_SCHED; PG8_LDA(At, 0, 0); PG8_STAGE_A(PG8_SA(1, 1), a1, 1, gcur);
            PG8_WAIT_V(8); PG8_WAIT_L(0); PG8_BAR; PG8_MMA(0, 0, At, B0); PG8_MMA(0, 1, At, B1); PG8_BAR; PG8_SCHED;
            PG8_LDA(At, 0, 1); PG8_STAGE(PG8_SB(0, 0), b2, voffB); PG8_STAGE(PG8_SB(0, 1), b2 + hstep, voffB); PG8_STAGE_A2(PG8_SA(0, 0), a2, 0);
            PG8_WAIT_V(8); PG8_WAIT_L(0); PG8_BAR; PG8_MMA(1, 0, At, B0); PG8_MMA(1, 1, At, B1); PG8_BAR; PG8_SCHED;
            PG8_LDB(B0, 1, 0); PG8_LDB(B1, 1, 1); PG8_SCHED; PG8_LDA(At, 1, 0); PG8_STAGE_A2(PG8_SA(0, 1), a2, 1);
            PG8_WAIT_V(8); PG8_WAIT_L(0); PG8_BAR; PG8_MMA(0, 0, At, B0); PG8_MMA(0, 1, At, B1); PG8_BAR; PG8_SCHED;
            PG8_LDA(At, 1, 1); PG8_STAGE(PG8_SB(1, 0), b3, voffB); PG8_STAGE(PG8_SB(1, 1), b3 + hstep, voffB); PG8_STAGE_A2(PG8_SA(1, 0), a3, 0);
            PG8_WAIT_V(8); PG8_WAIT_L(0); PG8_BAR; PG8_MMA(1, 0, At, B0); PG8_MMA(1, 1, At, B1); PG8_BAR; PG8_SCHED;
        }
        if constexpr (ALIGN_EPI) { if (wr == 0) PG8_BAR; }
        E(acc, cur, wr, wc, fr, fq);
        if (!has_next) break;
#pragma unroll
        for (int a = 0; a < 2; ++a)
#pragma unroll
            for (int b = 0; b < 2; ++b)
#pragma unroll
                for (int m = 0; m < 4; ++m)
#pragma unroll
                    for (int n = 0; n < 2; ++n) acc[a][b][m][n] = (f32x4){0.f, 0.f, 0.f, 0.f};
        cur = nxt; cA = nA; cB = nB; ++ui;
        if constexpr (GATHER) {
#pragma unroll
            for (int _h = 0; _h < 2; ++_h)
#pragma unroll
                for (int _i = 0; _i < 2; ++_i) gcur[_h][_i] = gnxt[_h][_i]; }
        if constexpr (ALIGN_EPI) { if (wr == 1) PG8_BAR; }
    }
    PG8_WAIT_V(0);
    if constexpr (!ALIGN_EPI) { if (wr == 0) PG8_BAR; }
    PG8_BAR;
#undef PG8_SA
#undef PG8_SB
#undef PG8_STAGE
#undef PG8_STAGE_A
#undef PG8_STAGE_A2
#undef PG8_LDA
#undef PG8_LDB
#undef PG8_MMA
#undef PG8_WAIT_V
#undef PG8_WAIT_L
#undef PG8_BAR
#undef PG8_SCHED
#undef PG8_GLOAD
}
}
typedef unsigned short bf16;
typedef unsigned v4u __attribute__((ext_vector_type(4)));
typedef unsigned v2u __attribute__((ext_vector_type(2)));
typedef float f32x4 __attribute__((ext_vector_type(4)));
constexpr int NTHREADS = 512, NWAVES = 8;
constexpr int LDS_BYTES = 147456;
constexpr int MISC_OFF = 131072 + 320;
constexpr size_t MiB = 1u << 20;
constexpr size_t CTL_BYTES = 1 * MiB;
constexpr int T_ = nv::T_, S_ = nv::S_, NCH = nv::NCH;
constexpr int EINP = 3328, OINP = 2304;
#define LDS_WAIT() asm volatile("s_waitcnt lgkmcnt(0)" ::: "memory")
__device__ __forceinline__ unsigned f2bf(float f) { unsigned u = __builtin_bit_cast(unsigned, f); return (u + 0x7fffu + ((u >> 16) & 1u)) >> 16; }
__device__ __forceinline__ unsigned pk2(float lo, float hi) { return f2bf(lo) | (f2bf(hi) << 16); }
__device__ __forceinline__ float bf2f(unsigned short b) { return __builtin_bit_cast(float, (unsigned)b << 16); }
__device__ __forceinline__ void tr_item(const float* W, long ldw, int nvalid, bf16* dst, long ldd, LAS float* scr, int lane) {
#pragma unroll 8
    for (int i = 0; i < 32; ++i) { const int kk = 2 * i + (lane >> 5), nn = lane & 31; scr[kk * 33 + nn] = nn < nvalid ? W[(long)kk * ldw + nn] : 0.f; }
    LDS_WAIT(); asm volatile("" ::: "memory");
    const int c = lane & 7;
#pragma unroll
    for (int j = 0; j < 4; ++j) { const int n = (lane >> 3) + 8 * j; const LAS float* s = scr + (8 * c) * 33 + n;
        v4u o; o.x = pk2(s[0 * 33], s[1 * 33]); o.y = pk2(s[2 * 33], s[3 * 33]); o.z = pk2(s[4 * 33], s[5 * 33]); o.w = pk2(s[6 * 33], s[7 * 33]);
        *(v4u*)(dst + (long)n * ldd + 8 * c) = o; }
    LDS_WAIT(); asm volatile("" ::: "memory");
}
__device__ __forceinline__ void tr_matrix(const float* W, int K, int N, int NP, bf16* WT, LAS float* scr, int gw, int NGW, int lane) {
    const int nblk = NP / 32, nitems = (K / 64) * nblk;
    for (int it = gw; it < nitems; it += NGW) { const int kb = it / nblk, nb = it % nblk, k0 = 64 * kb, n0 = 32 * nb; int nvalid = N - n0; nvalid = nvalid < 0 ? 0 : (nvalid > 32 ? 32 : nvalid);
        tr_item(W + (long)k0 * N + n0, N, nvalid, WT + (long)n0 * K + k0, K, scr, lane); }
}
__device__ __forceinline__ void cvt_rows(const float* src, bf16* dst, long n, long gtid, long gsz) {
    for (long i = gtid * 8; i < n; i += gsz * 8) { const f32x4 a = *(const f32x4*)(src + i), b = *(const f32x4*)(src + i + 4);
        v4u o; o.x = pk2(a.x, a.y); o.y = pk2(a.z, a.w); o.z = pk2(b.x, b.y); o.w = pk2(b.z, b.w); *(v4u*)(dst + i) = o; }
}
__device__ __forceinline__ int sopaque(int v) { asm volatile("" : "+s"(v)); return v; }
__device__ __forceinline__ float wave_sum(float v) {
#define WS_STEP(o) v += __builtin_bit_cast(float, __builtin_amdgcn_ds_swizzle(__builtin_bit_cast(int, v), 0x1f | ((o) << 10)))
    WS_STEP(1); WS_STEP(2); WS_STEP(4); WS_STEP(8); WS_STEP(16);
#undef WS_STEP
    return __builtin_bit_cast(float, __builtin_amdgcn_readlane(__builtin_bit_cast(int, v), 0)) + __builtin_bit_cast(float, __builtin_amdgcn_readlane(__builtin_bit_cast(int, v), 32));
}
#ifndef DBG_SCALE
#define DBG_SCALE 20.0f
#endif
constexpr int MOE_MAXBLK = 640;
constexpr int CW_CNT = 8192, CW_CUR = 8192 + 128;
namespace pg8 {
struct MoeOrder {
    const int* blk_e; int nblk, npn, G, c;
    __device__ __forceinline__ bool next(int i, Unit& u) const {
        const long L = (long)i * G + c; if (L >= (long)nblk * npn) return false;
        const int blk = (int)(L / npn); u.pm = blk; u.pn = (int)(L % npn); u.e = __builtin_amdgcn_readfirstlane(blk_e[blk]); u.aux = 0; return true;
    }
};
__device__ __forceinline__ float silu_f(float x) { return x / (1.0f + __expf(-x)); }
struct EpiSwiGLU {
    static constexpr bool PERM = true;
    bf16_t* H;
    __device__ __forceinline__ void operator()(const f32x4 (&acc)[2][2][4][2], const Unit& u, int wr, int wc, int fr, int fq) const {
        const int row0 = u.pm * BM + wr * 64 + fr, col0 = u.pn * 128 + wc * 32 + 8 * fq;
#pragma unroll
        for (int ai = 0; ai < 2; ++ai)
#pragma unroll
            for (int m = 0; m < 4; ++m) { bf16_t* rowp = H + (size_t)(row0 + ai * HALF + m * 16) * 256 + col0;
                const f32x4 g0 = acc[ai][0][m][0], g1 = acc[ai][0][m][1], u0 = acc[ai][1][m][0], u1 = acc[ai][1][m][1];
                u32x4 w; w.x = cvt_pk_bf16(silu_f(g0[0]) * u0[0], silu_f(g0[1]) * u0[1]); w.y = cvt_pk_bf16(silu_f(g0[2]) * u0[2], silu_f(g0[3]) * u0[3]);
                w.z = cvt_pk_bf16(silu_f(g1[0]) * u1[0], silu_f(g1[1]) * u1[1]); w.w = cvt_pk_bf16(silu_f(g1[2]) * u1[2], silu_f(g1[3]) * u1[3]);
                *(u32x4*)rowp = w; }
    }
};
struct EpiDown {
    static constexpr bool PERM = true;
    bf16_t* rows8; bf16_t* rows_sh; const int* dest; const float* w; int nslot8;
    __device__ __forceinline__ void operator()(const f32x4 (&acc)[2][2][4][2], const Unit& u, int wr, int wc, int fr, int fq) const {
        const int row0 = u.pm * BM + wr * 64 + fr, col0 = u.pn * BM + wc * 32 + 8 * fq;
#pragma unroll
        for (int ai = 0; ai < 2; ++ai)
#pragma unroll
            for (int m = 0; m < 4; ++m) { const int r = row0 + ai * HALF + m * 16; const int d = dest[r]; const float ww = w[r];
                if (d >= 0) { bf16_t* rowp = (d < nslot8 ? rows8 + (size_t)d * 1024 : rows_sh + (size_t)(d - nslot8) * 1024) + col0;
#pragma unroll
                    for (int bj = 0; bj < 2; ++bj) { const f32x4 v0 = acc[ai][bj][m][0] * ww, v1 = acc[ai][bj][m][1] * ww;
                        u32x4 o; o.x = cvt_pk_bf16(v0[0], v0[1]); o.y = cvt_pk_bf16(v0[2], v0[3]); o.z = cvt_pk_bf16(v1[0], v1[1]); o.w = cvt_pk_bf16(v1[2], v1[3]);
                        *(u32x4*)(rowp + bj * HALF) = o; } } }
    }
};
}
__device__ __forceinline__ void moe_convert_weights(const float* wg, const float* wu, const float* wd, const float* sg, const float* su, const float* sd,
                                                    bf16* WGU, bf16* WD, LAS float* scr, int gw, int NGW, int lane) {
    for (int it = gw; it < 65 * 384; it += NGW) {
        const int e = it / 384, r = it % 384, kind = r >> 7, q = r & 127;
        if (kind < 2) { const float* W = (e < 64 ? (kind == 0 ? wg : wu) + (size_t)e * 262144 : (kind == 0 ? sg : su));
            const int kb = q >> 3, nb = q & 7, k0 = 64 * kb, n0 = 32 * nb;
            tr_item(W + (size_t)k0 * 256 + n0, 256, 32, WGU + ((size_t)e * 512 + (n0 >> 7) * 256 + (n0 & 127) + kind * 128) * 1024 + k0, 1024, scr, lane);
        } else { const float* W = e < 64 ? wd + (size_t)e * 262144 : sd;
            const int kb = q >> 5, nb = q & 31, k0 = 64 * kb, n0 = 32 * nb;
            tr_item(W + (size_t)k0 * 1024 + n0, 1024, 32, WD + ((size_t)e * 1024 + n0) * 256 + k0, 256, scr, lane); }
    }
}
struct MoeLists { int* tok; int* dest; float* w; int* blk_e; };
__device__ __forceinline__ void moe_count(const int* ridx, unsigned* cnt, LAS unsigned* hist, int tid, int bid, int G) {
    if (tid < 64) hist[tid] = 0u;
    __syncthreads();
    for (int i = bid * NTHREADS + tid; i < T_ * 8; i += G * NTHREADS) atomicAdd((unsigned*)&hist[ridx[i]], 1u);
    __syncthreads();
    if (tid < 64 && hist[tid]) atomicAdd(&cnt[tid], hist[tid]);
    __syncthreads();
}
__device__ __forceinline__ void moe_build_lists(const int* ridx, const float* rwt, const unsigned* cnt, unsigned* cur, const MoeLists L, LAS int* sm, int tid, int bid, int G) {
    LAS int* pstart = sm; LAS unsigned* hist = (LAS unsigned*)(sm + 80); LAS unsigned* base = (LAS unsigned*)(sm + 160);
    if (tid == 0) { int acc = 0;
#pragma unroll 1
        for (int e = 0; e < 64; ++e) { pstart[e] = acc; acc += ((int)__hip_atomic_load(&cnt[e], __ATOMIC_RELAXED, __HIP_MEMORY_SCOPE_AGENT) + 255) & ~255; } pstart[64] = acc; pstart[65] = acc + T_; }
    __syncthreads();
    const int per = (T_ * 8 + G - 1) / G;
    const int lo = bid * per, hi = (lo + per < T_ * 8) ? lo + per : T_ * 8;
    for (int c0 = lo; c0 < hi; c0 += NTHREADS) {
        if (tid < 64) hist[tid] = 0u;
        __syncthreads();
        const int i = c0 + tid; int e = 0; unsigned local = 0u;
        if (i < hi) { e = ridx[i]; local = atomicAdd((unsigned*)&hist[e], 1u); }
        __syncthreads();
        if (tid < 64) base[tid] = hist[tid] ? atomicAdd(&cur[tid], hist[tid]) : 0u;
        __syncthreads();
        if (i < hi) { const int pos = pstart[e] + (int)base[e] + (int)local; L.tok[pos] = i >> 3; L.dest[pos] = i; L.w[pos] = rwt[i]; }
        __syncthreads();
    }
    for (int e = bid; e < 64; e += G) { const int c = (int)__hip_atomic_load(&cnt[e], __ATOMIC_RELAXED, __HIP_MEMORY_SCOPE_AGENT);
        for (int p = pstart[e] + c + tid; p < pstart[e + 1]; p += NTHREADS) { L.tok[p] = 0; L.dest[p] = -1; L.w[p] = 0.f; } }
    for (int t = bid * NTHREADS + tid; t < T_; t += G * NTHREADS) { const int p = pstart[64] + t; L.tok[p] = t; L.dest[p] = T_ * 8 + t; L.w[p] = 1.f; }
    const int nblk = pstart[65] >> 8;
    for (int b = bid * NTHREADS + tid; b < nblk; b += G * NTHREADS) { int e = 0;
#pragma unroll 1
        while (e < 64 && (pstart[e + 1] >> 8) <= b) ++e;
        L.blk_e[b] = e; }
    if (bid == 0 && tid == 0) L.blk_e[MOE_MAXBLK] = nblk;
    __syncthreads();
}
__device__ __forceinline__ void moe_combine_ln(float* h, const bf16* rows8, const bf16* rows_sh, const float* lw, const float* lb, bf16* hbf, int gw, int NGW, int lane, const float* zdbg = nullptr, int ntdbg = 0, int t0dbg = 0) {
    for (int t = gw; t < T_; t += NGW) {
        float v[16];
#pragma unroll
        for (int half = 0; half < 2; ++half) { const int c0 = half * 512 + lane * 8;
            const f32x4 a = *(const f32x4*)(h + (size_t)t * 1024 + c0), b = *(const f32x4*)(h + (size_t)t * 1024 + c0 + 4);
            float s[8] = {a.x * nv::ALPHA, a.y * nv::ALPHA, a.z * nv::ALPHA, a.w * nv::ALPHA, b.x * nv::ALPHA, b.y * nv::ALPHA, b.z * nv::ALPHA, b.w * nv::ALPHA};
#pragma unroll
            for (int k = 0; k < 9; ++k) { const bf16* rp = (k < 8 ? rows8 + ((size_t)t * 8 + k) * 1024 : rows_sh + (size_t)t * 1024) + c0;
                const v4u r = *(const v4u*)rp;
                s[0] += __builtin_bit_cast(float, r.x << 16); s[1] += __builtin_bit_cast(float, r.x & 0xffff0000u);
                s[2] += __builtin_bit_cast(float, r.y << 16); s[3] += __builtin_bit_cast(float, r.y & 0xffff0000u);
                s[4] += __builtin_bit_cast(float, r.z << 16); s[5] += __builtin_bit_cast(float, r.z & 0xffff0000u);
                s[6] += __builtin_bit_cast(float, r.w << 16); s[7] += __builtin_bit_cast(float, r.w & 0xffff0000u); }
#pragma unroll
            for (int j = 0; j < 8; ++j) v[half * 8 + j] = s[j]; }
        float dd[16];
#pragma unroll
        for (int j = 0; j < 16; ++j) dd[j] = 0.f;
        if (zdbg && t >= t0dbg && t < t0dbg + ntdbg) {
#pragma unroll
            for (int j = 0; j < 16; ++j) { const float zz = zdbg[(size_t)(t - t0dbg) * 1024 + (j >> 3) * 512 + lane * 8 + (j & 7)]; dd[j] = (DBG_SCALE != 0.0f) ? (v[j] - zz) * DBG_SCALE : 0.f; v[j] = zz; } }
        float sum = 0.f;
#pragma unroll
        for (int j = 0; j < 16; ++j) sum += v[j];
        sum = wave_sum(sum);
        const float mean = sum * (1.f / 1024.f);
        float sq = 0.f;
#pragma unroll
        for (int j = 0; j < 16; ++j) { v[j] -= mean; sq += v[j] * v[j]; }
        sq = wave_sum(sq);
        const float rstd = 1.0f / sqrtf(sq * (1.f / 1024.f) + nv::EPS);
#pragma unroll
        for (int half = 0; half < 2; ++half) { const int c0 = half * 512 + lane * 8;
            const f32x4 w0 = *(const f32x4*)(lw + c0), w1 = *(const f32x4*)(lw + c0 + 4), b0 = *(const f32x4*)(lb + c0), b1 = *(const f32x4*)(lb + c0 + 4);
            f32x4 o0, o1;
            if (zdbg) {
#pragma unroll
                for (int j = 0; j < 8; ++j) v[half * 8 + j] += dd[half * 8 + j] / rstd; }
            o0.x = v[half * 8 + 0] * rstd * w0.x + b0.x; o0.y = v[half * 8 + 1] * rstd * w0.y + b0.y; o0.z = v[half * 8 + 2] * rstd * w0.z + b0.z; o0.w = v[half * 8 + 3] * rstd * w0.w + b0.w;
            o1.x = v[half * 8 + 4] * rstd * w1.x + b1.x; o1.y = v[half * 8 + 5] * rstd * w1.y + b1.y; o1.z = v[half * 8 + 6] * rstd * w1.z + b1.z; o1.w = v[half * 8 + 7] * rstd * w1.w + b1.w;
            *(f32x4*)(h + (size_t)t * 1024 + c0) = o0; *(f32x4*)(h + (size_t)t * 1024 + c0 + 4) = o1;
            if (hbf) { v4u p; p.x = pk2(o0.x, o0.y); p.y = pk2(o0.z, o0.w); p.z = pk2(o1.x, o1.y); p.w = pk2(o1.z, o1.w); *(v4u*)(hbf + (size_t)t * 1024 + c0) = p; } }
    }
}
typedef float f32x16 __attribute__((ext_vector_type(16)));
typedef short s16x8 __attribute__((ext_vector_type(8)));
typedef LAS unsigned short lbf16;
__device__ __forceinline__ void mm32(f32x16& acc, const lbf16* A, int lda, const lbf16* B, int ldb, int K, int lane) {
    const lbf16* ap = A + (lane & 31) * lda + 8 * (lane >> 5);
    const lbf16* bp = B + (lane & 31) * ldb + 8 * (lane >> 5);
#pragma unroll 4
    for (int k = 0; k < K; k += 16) {
        const s16x8 a = *(const LAS s16x8*)(ap + k), b = *(const LAS s16x8*)(bp + k);
        acc = __builtin_amdgcn_mfma_f32_32x32x16_bf16(a, b, acc, 0, 0, 0);
    }
}
__device__ __forceinline__ void mm32_gb(f32x16& acc, const lbf16* A, int lda, const bf16* B, int ldb, int K, int lane) {
    const lbf16* ap = A + (lane & 31) * lda + 8 * (lane >> 5);
    const bf16* bp = B + (size_t)(lane & 31) * ldb + 8 * (lane >> 5);
#pragma unroll 4
    for (int k = 0; k < K; k += 16) {
        const s16x8 a = *(const LAS s16x8*)(ap + k), b = *(const s16x8*)(bp + k);
        acc = __builtin_amdgcn_mfma_f32_32x32x16_bf16(a, b, acc, 0, 0, 0);
    }
}
__device__ __forceinline__ int rowmap(int r, int lane) { return (r & 3) + 8 * (r >> 2) + 4 * (lane >> 5); }
__device__ __forceinline__ float sigm_f(float x) { return 1.0f / (1.0f + __expf(-x)); }
__device__ __forceinline__ float logsig_f(float x) { return fminf(x, 0.f) - log1pf(__expf(-fabsf(x))); }
__device__ __forceinline__ float softplus_f(float x) { return fmaxf(x, 0.f) + log1pf(__expf(-fabsf(x))); }
__device__ __forceinline__ float gelu_f(float x) { const float u = 0.7978845608028654f * (x + 0.044715f * x * x * x); return x / (1.0f + __expf(-2.0f * u)); }
__device__ __forceinline__ void unpack8(const v4u r, float (&f)[8]) {
    f[0] = __builtin_bit_cast(float, r.x << 16); f[1] = __builtin_bit_cast(float, r.x & 0xffff0000u); f[2] = __builtin_bit_cast(float, r.y << 16); f[3] = __builtin_bit_cast(float, r.y & 0xffff0000u);
    f[4] = __builtin_bit_cast(float, r.z << 16); f[5] = __builtin_bit_cast(float, r.z & 0xffff0000u); f[6] = __builtin_bit_cast(float, r.w << 16); f[7] = __builtin_bit_cast(float, r.w & 0xffff0000u);
}
__device__ __forceinline__ v4u pack8(const float (&f)[8]) { v4u o; o.x = pk2(f[0], f[1]); o.y = pk2(f[2], f[3]); o.z = pk2(f[4], f[5]); o.w = pk2(f[6], f[7]); return o; }

struct Mix0Bufs { const bf16* proj; float* ct; float* nloc; float* blast; float* mloc; float* mprev; float* hloc; float* pc; float* carA; float* carU; float* carI; bf16* mixbf; const bf16* lruw; };
constexpr int PJ0 = EINP;

__device__ __forceinline__ void mlstm_a_item(const Mix0Bufs& B, const float* gate_b, int cn, LAS unsigned char* lds, int tid) {
    const int lane = tid & 63, wave = __builtin_amdgcn_readfirstlane(tid >> 6);
    const int bh = cn / NCH, n = cn % NCH, b = bh >> 2, h = bh & 3;
    const size_t t0 = (size_t)b * S_ + n * 64;
    LAS float* lf = (LAS float*)lds; LAS float* wl = lf + 64; LAS float* pw = lf + 128; LAS float* misc = lf + 192;
    lbf16* kT = (lbf16*)(lds + 1024); lbf16* vT = (lbf16*)(lds + 1024 + 128 * 72 * 2);
    if (tid < 64) { const bf16* pr = B.proj + (t0 + tid) * PJ0;
        lf[tid] = logsig_f(bf2f(pr[2052 + h]) + gate_b[4 + h]); pw[tid] = bf2f(pr[2048 + h]) + gate_b[h]; }
    __syncthreads();
    if (tid < 64) { float acc = 0.f; for (int j = 0; j < 64; ++j) { const float x = lf[j]; acc += (j <= tid) ? x : 0.f; } wl[tid] = pw[tid] - acc; if (tid == 63) misc[0] = acc; }
    __syncthreads();
    float mx = -INFINITY;
    for (int j = 0; j < 64; ++j) mx = fmaxf(mx, wl[j]);
    const float blast = misc[0];
    __syncthreads();
    if (tid < 64) pw[tid] = __expf(wl[tid] - mx) * 0.08838834764831845f;
    __syncthreads();
#pragma unroll
    for (int it = 0; it < 2; ++it) { const int vi = tid + it * 512, l = vi & 63, g = vi >> 6;
        const bf16* pr = B.proj + (t0 + l) * PJ0 + h * 128 + g * 8;
        float kf[8], vf[8]; unpack8(*(const v4u*)(pr + 512), kf); unpack8(*(const v4u*)(pr + 1024), vf);
        const float p = pw[l];
#pragma unroll
        for (int j = 0; j < 8; ++j) { kT[(g * 8 + j) * 72 + l] = (unsigned short)f2bf(kf[j] * p); vT[(g * 8 + j) * 72 + l] = (unsigned short)f2bf(vf[j]); } }
    __syncthreads();
    const int et = wave >> 1;
#pragma unroll
    for (int q = 0; q < 2; ++q) { const int dt = (wave & 1) * 2 + q;
        f32x16 acc = {0.f, 0.f, 0.f, 0.f, 0.f, 0.f, 0.f, 0.f, 0.f, 0.f, 0.f, 0.f, 0.f, 0.f, 0.f, 0.f};
        mm32(acc, vT + et * 32 * 72, 72, kT + dt * 32 * 72, 72, 64, lane);
        float* out = B.ct + (size_t)cn * 16384 + dt * 32 + (lane & 31);
#pragma unroll
        for (int r = 0; r < 16; ++r) out[(size_t)(et * 32 + rowmap(r, lane)) * 128] = acc[r]; }
    if (tid < 128) { float s = 0.f; for (int l = 0; l < 64; ++l) s += bf2f(kT[tid * 72 + l]); B.nloc[(size_t)cn * 128 + tid] = s; }
    if (tid == 0) { B.blast[cn] = blast; B.mloc[cn] = blast + mx; }
    __syncthreads();
}
__device__ __forceinline__ void mlstm_b(const Mix0Bufs& B, int gtid, int gsz) {
    for (int idx = gtid; idx < 8 * 16384 + 8 * 128; idx += gsz) {
        const bool isn = idx >= 8 * 16384;
        int bh, de; float* buf; int stride;
        if (!isn) { bh = idx >> 14; de = idx & 16383; buf = B.ct; stride = 16384; } else { const int r = idx - 8 * 16384; bh = r >> 7; de = r & 127; buf = B.nloc; stride = 128; }
        float st = 0.f, m = 0.f;
        float* p = buf + (size_t)bh * NCH * stride + de;
#pragma unroll 8
        for (int n = 0; n < NCH; ++n) { const int cn = bh * NCH + n;
            const float cl = p[(size_t)n * stride]; p[(size_t)n * stride] = st;
            const float bl = B.blast[cn], ml = B.mloc[cn], mn = fmaxf(bl + m, ml);
            st = __expf(bl + m - mn) * st + __expf(ml - mn) * cl;
            if (!isn && de == 0) B.mprev[cn] = m;
            m = mn; }
    }
}
__device__ __forceinline__ void mlstm_c_item(const Mix0Bufs& B, const float* gate_b, const float* norm_w, int cn, LAS unsigned char* lds, int tid) {
    const int lane = tid & 63, wave = __builtin_amdgcn_readfirstlane(tid >> 6);
    const int bh = cn / NCH, n = cn % NCH, b = bh >> 2, h = bh & 3;
    const size_t t0 = (size_t)b * S_ + n * 64;
    LAS float* bc = (LAS float*)lds; LAS float* wl = bc + 64; LAS float* mi = bc + 128; LAS float* win = bc + 192; LAS float* den = bc + 256; LAS float* emi = bc + 320; LAS float* lf = bc + 384; LAS float* ig = bc + 448;
    lbf16* qs = (lbf16*)(lds + 2048); lbf16* ks = (lbf16*)(lds + 19456); lbf16* qw = (lbf16*)(lds + 36864);
    lbf16* vT = (lbf16*)(lds + 54272); lbf16* cT = (lbf16*)(lds + 77312); lbf16* sm = (lbf16*)(lds + 120832);
    LAS float* hb = (LAS float*)(lds + 2048);
    const float mprev = B.mprev[cn];
    if (tid < 64) { const bf16* pr = B.proj + (t0 + tid) * PJ0;
        lf[tid] = logsig_f(bf2f(pr[2052 + h]) + gate_b[4 + h]); ig[tid] = bf2f(pr[2048 + h]) + gate_b[h]; }
    __syncthreads();
    if (tid < 64) { float acc = 0.f; for (int j = 0; j < 64; ++j) { const float x = lf[j]; acc += (j <= tid) ? x : 0.f; } bc[tid] = acc; wl[tid] = ig[tid] - acc; }
    __syncthreads();
    if (tid < 64) { float pm = -INFINITY; for (int j = 0; j < 64; ++j) { const float x = wl[j]; pm = (j <= tid) ? fmaxf(pm, x) : pm; }
        const float bi = bc[tid], m = bi + fmaxf(mprev, pm); mi[tid] = m; win[tid] = __expf(bi + mprev - m); emi[tid] = __expf(-m); }
    __syncthreads();
#pragma unroll
    for (int it = 0; it < 2; ++it) { const int vi = tid + it * 512, l = vi >> 4, g = vi & 15;
        const bf16* pr = B.proj + (t0 + l) * PJ0 + h * 128 + g * 8;
        float qf[8], kf[8]; unpack8(*(const v4u*)pr, qf); unpack8(*(const v4u*)(pr + 512), kf);
        const float w = win[l]; float qwf[8];
#pragma unroll
        for (int j = 0; j < 8; ++j) { kf[j] *= 0.08838834764831845f; qwf[j] = qf[j] * w; }
        *(LAS v4u*)(qs + l * 136 + g * 8) = *(const v4u*)pr; *(LAS v4u*)(ks + l * 136 + g * 8) = pack8(kf); *(LAS v4u*)(qw + l * 136 + g * 8) = pack8(qwf); }
#pragma unroll
    for (int it = 0; it < 2; ++it) { const int vi = tid + it * 512, l = vi & 63, g = vi >> 6;
        float vf[8]; unpack8(*(const v4u*)(B.proj + (t0 + l) * PJ0 + 1024 + h * 128 + g * 8), vf);
#pragma unroll
        for (int j = 0; j < 8; ++j) vT[(g * 8 + j) * 72 + l] = (unsigned short)f2bf(vf[j]); }
    for (int i = tid; i < 32 * 72; i += 512) { const int r = i / 72, c = i % 72; vT[(128 + r) * 72 + c] = (r == 0 && c < 64) ? (unsigned short)0x3f80 : (unsigned short)0; }
    { const float* cg = B.ct + (size_t)cn * 16384;
#pragma unroll
      for (int it = 0; it < 4; ++it) { const int vi = tid + it * 512, e = vi >> 4, g = vi & 15;
          const f32x4 a = *(const f32x4*)(cg + e * 128 + g * 8), c2 = *(const f32x4*)(cg + e * 128 + g * 8 + 4);
          v4u o; o.x = pk2(a.x, a.y); o.y = pk2(a.z, a.w); o.z = pk2(c2.x, c2.y); o.w = pk2(c2.z, c2.w); *(LAS v4u*)(cT + e * 136 + g * 8) = o; } }
    for (int i = tid; i < 32 * 136; i += 512) { const int r = i / 136, c = i % 136; cT[(128 + r) * 136 + c] = (r == 0 && c < 128) ? (unsigned short)f2bf(B.nloc[(size_t)cn * 128 + c]) : (unsigned short)0; }
    __syncthreads();
    if (wave < 4) { const int it = wave >> 1, jt = wave & 1;
        f32x16 acc = {0.f, 0.f, 0.f, 0.f, 0.f, 0.f, 0.f, 0.f, 0.f, 0.f, 0.f, 0.f, 0.f, 0.f, 0.f, 0.f};
        if (jt <= it) mm32(acc, qs + it * 32 * 136, 136, ks + jt * 32 * 136, 136, 128, lane);
        const int j = jt * 32 + (lane & 31); const float wj = wl[j];
#pragma unroll
        for (int r = 0; r < 16; ++r) { const int i = it * 32 + rowmap(r, lane);
            const float v = (j <= i) ? acc[r] * __expf(bc[i] - mi[i] + wj) : 0.f; sm[i * 72 + j] = (unsigned short)f2bf(v); } }
    __syncthreads();
    f32x16 accA = {0.f, 0.f, 0.f, 0.f, 0.f, 0.f, 0.f, 0.f, 0.f, 0.f, 0.f, 0.f, 0.f, 0.f, 0.f, 0.f}, accB = accA;
    { const int id = wave, it = id / 5, nt = id % 5;
      mm32(accA, sm + it * 32 * 72, 72, vT + nt * 32 * 72, 72, 64, lane); mm32(accA, qw + it * 32 * 136, 136, cT + nt * 32 * 136, 136, 128, lane);
      if (nt == 4 && (lane & 31) == 0) {
#pragma unroll
          for (int r = 0; r < 16; ++r) den[it * 32 + rowmap(r, lane)] = accA[r]; } }
    if (wave < 2) { const int id = wave + 8, it = id / 5, nt = id % 5;
      mm32(accB, sm + it * 32 * 72, 72, vT + nt * 32 * 72, 72, 64, lane); mm32(accB, qw + it * 32 * 136, 136, cT + nt * 32 * 136, 136, 128, lane);
      if (nt == 4 && (lane & 31) == 0) {
#pragma unroll
          for (int r = 0; r < 16; ++r) den[it * 32 + rowmap(r, lane)] = accB[r]; } }
    __syncthreads();
    { const int id = wave, it = id / 5, nt = id % 5;
      if (nt < 4) {
#pragma unroll
          for (int r = 0; r < 16; ++r) { const int i = it * 32 + rowmap(r, lane); hb[i * 132 + nt * 32 + (lane & 31)] = accA[r] / fmaxf(fabsf(den[i]), emi[i]); } } }
    if (wave < 2) { const int id = wave + 8, it = id / 5, nt = id % 5;
      if (nt < 4) {
#pragma unroll
          for (int r = 0; r < 16; ++r) { const int i = it * 32 + rowmap(r, lane); hb[i * 132 + nt * 32 + (lane & 31)] = accB[r] / fmaxf(fabsf(den[i]), emi[i]); } } }
    __syncthreads();
    { const int i = tid >> 3, sub = tid & 7; const LAS float* hr = hb + i * 132 + sub * 16;
      float x[16]; float s = 0.f;
#pragma unroll
      for (int j = 0; j < 16; ++j) { x[j] = hr[j]; s += x[j]; }
      s += __builtin_bit_cast(float, __builtin_amdgcn_ds_swizzle(__builtin_bit_cast(int, s), 0x1f | (1 << 10)));
      s += __builtin_bit_cast(float, __builtin_amdgcn_ds_swizzle(__builtin_bit_cast(int, s), 0x1f | (2 << 10)));
      s += __builtin_bit_cast(float, __builtin_amdgcn_ds_swizzle(__builtin_bit_cast(int, s), 0x1f | (4 << 10)));
      const float mean = s * (1.f / 128.f); float q = 0.f;
#pragma unroll
      for (int j = 0; j < 16; ++j) { x[j] -= mean; q += x[j] * x[j]; }
      q += __builtin_bit_cast(float, __builtin_amdgcn_ds_swizzle(__builtin_bit_cast(int, q), 0x1f | (1 << 10)));
      q += __builtin_bit_cast(float, __builtin_amdgcn_ds_swizzle(__builtin_bit_cast(int, q), 0x1f | (2 << 10)));
      q += __builtin_bit_cast(float, __builtin_amdgcn_ds_swizzle(__builtin_bit_cast(int, q), 0x1f | (4 << 10)));
      const float rstd = 1.0f / sqrtf(q * (1.f / 128.f) + nv::EPS);
      const bf16* op = B.proj + (t0 + i) * PJ0 + 1536 + h * 128 + sub * 16; const float* nw = norm_w + h * 128 + sub * 16;
      float o0[8], o1[8]; unpack8(*(const v4u*)op, o0); unpack8(*(const v4u*)(op + 8), o1);
      float y0[8], y1[8];
#pragma unroll
      for (int j = 0; j < 8; ++j) { y0[j] = x[j] * rstd * nw[j] * sigm_f(o0[j]); y1[j] = x[8 + j] * rstd * nw[8 + j] * sigm_f(o1[j]); }
      bf16* dst = B.mixbf + (t0 + i) * 1024 + h * 128 + sub * 16;
      *(v4u*)dst = pack8(y0); *(v4u*)(dst + 8) = pack8(y1); }
    __syncthreads();
}
__device__ __forceinline__ void lru_a_item(const Mix0Bufs& B, const float* const* in, int ch, LAS unsigned char* lds, int tid) {
    const int lane = tid & 63, wave = __builtin_amdgcn_readfirstlane(tid >> 6);
    const size_t t0 = (size_t)ch * 64; const int s0 = (ch % NCH) * 64;
    lbf16* xc = (lbf16*)lds; LAS float* al = (LAS float*)(lds + 17408); LAS float* ul = (LAS float*)(lds + 17408 + 32768);
    const float* cw = in[9]; const float* cb = in[10]; const float* ba = in[12]; const float* bx = in[14]; const float* lam = in[15];
    for (int hh = 0; hh < 4; ++hh) {
#pragma unroll
        for (int it = 0; it < 2; ++it) { const int vi = tid + it * 512, l = vi >> 4, g = vi & 15, c0 = hh * 128 + g * 8;
            float acc[8];
#pragma unroll
            for (int j = 0; j < 8; ++j) acc[j] = cb[c0 + j];
#pragma unroll
            for (int tap = 0; tap < 4; ++tap) { const int ls = s0 + l - 3 + tap;
                if (ls >= 0) { float xf[8]; unpack8(*(const v4u*)(B.proj + (t0 + l - 3 + tap) * PJ0 + 2056 + c0), xf);
#pragma unroll
                    for (int j = 0; j < 8; ++j) acc[j] += cw[tap * 512 + c0 + j] * xf[j]; } }
            *(LAS v4u*)(xc + l * 136 + g * 8) = pack8(acc);
#pragma unroll
            for (int j = 0; j < 8; ++j) ul[l * 128 + g * 8 + j] = acc[j]; }
        __syncthreads();
        { const int it = wave & 1, nt = wave >> 1;
          f32x16 ra = {0.f, 0.f, 0.f, 0.f, 0.f, 0.f, 0.f, 0.f, 0.f, 0.f, 0.f, 0.f, 0.f, 0.f, 0.f, 0.f}, xa = ra;
          mm32_gb(ra, xc + it * 32 * 136, 136, B.lruw + (size_t)(hh * 128 + nt * 32) * 128, 128, 128, lane);
          mm32_gb(xa, xc + it * 32 * 136, 136, B.lruw + (size_t)(512 + hh * 128 + nt * 32) * 128, 128, 128, lane);
          const int c = nt * 32 + (lane & 31), cg = hh * 128 + c; const float bav = ba[cg], bxv = bx[cg], sp = softplus_f(-lam[cg]);
#pragma unroll
          for (int r = 0; r < 16; ++r) { const int l = it * 32 + rowmap(r, lane);
              const float rr = sigm_f(ra[r] + bav), ii = sigm_f(xa[r] + bxv), la = -8.0f * rr * sp;
              const float xv = ul[l * 128 + c];
              al[l * 128 + c] = __expf(la); ul[l * 128 + c] = sqrtf(-expm1f(2.0f * la)) * ii * xv; } }
        __syncthreads();
        if (tid < 128) { float hst = 0.f, P = 1.f; float* hp = B.hloc + t0 * 512 + hh * 128 + tid; float* pp = B.pc + t0 * 512 + hh * 128 + tid;
            for (int l = 0; l < 64; ++l) { const float a = al[l * 128 + tid]; hst = a * hst + ul[l * 128 + tid]; P *= a; hp[(size_t)l * 512] = hst; pp[(size_t)l * 512] = P; }
            B.carA[(size_t)ch * 512 + hh * 128 + tid] = P; B.carU[(size_t)ch * 512 + hh * 128 + tid] = hst; }
        __syncthreads();
    }
}
__device__ __forceinline__ void lru_b(const Mix0Bufs& B, int gtid, int gsz) {
    for (int idx = gtid; idx < 2 * 512; idx += gsz) { const int b = idx >> 9, c = idx & 511; float hst = 0.f;
#pragma unroll 8
        for (int n = 0; n < NCH; ++n) { const size_t o = (size_t)(b * NCH + n) * 512 + c; B.carI[o] = hst; hst = B.carA[o] * hst + B.carU[o]; } }
}
__device__ __forceinline__ void lru_c(const Mix0Bufs& B, int gtid, int gsz) {
    for (int idx = gtid; idx < T_ * 64; idx += gsz) { const size_t t = idx >> 6; const int c0 = (idx & 63) * 8; const size_t ch = t >> 6;
        float gb[8], y[8]; unpack8(*(const v4u*)(B.proj + t * PJ0 + 2568 + c0), gb);
        const float* hp = B.hloc + t * 512 + c0; const float* pp = B.pc + t * 512 + c0; const float* ci = B.carI + ch * 512 + c0;
#pragma unroll
        for (int j = 0; j < 8; ++j) y[j] = (hp[j] + pp[j] * ci[j]) * gelu_f(gb[j]);
        *(v4u*)(B.mixbf + t * 1024 + 512 + c0) = pack8(y); }
}
constexpr int PJ1 = OINP;
struct Mix1Bufs { const bf16* proj; float* ut; float* gbl; bf16* s5g; float* xend; float* xstart; float* s5ab; float* s5bb; bf16* cm; bf16* mixbf; };
__device__ __forceinline__ void gla_gates(const bf16* proj, const float* gw, const float* gb, size_t t0, int h, LAS float* bc, LAS float* gl, int tid) {
    if (tid < 128) { const int l = tid >> 1, hf = tid & 1; float f[8]; unpack8(*(const v4u*)(proj + (t0 + l) * PJ1 + 2048 + hf * 8), f);
#pragma unroll
        for (int j = 0; j < 8; ++j) gl[l * 16 + hf * 8 + j] = f[j]; }
    __syncthreads();
    { const int d = tid & 63, lg = tid >> 6; float w[16];
#pragma unroll
      for (int r = 0; r < 16; ++r) w[r] = gw[r * 256 + h * 64 + d];
      const float bias = gb[h * 64 + d];
#pragma unroll
      for (int q = 0; q < 8; ++q) { const int l = lg * 8 + q; float acc = bias;
#pragma unroll
          for (int r = 0; r < 16; ++r) acc += gl[l * 16 + r] * w[r];
          bc[l * 64 + d] = logsig_f(acc) * 0.0625f; } }
    __syncthreads();
    if (tid < 64) { float acc = 0.f; for (int l = 0; l < 64; ++l) { acc += bc[l * 64 + tid]; bc[l * 64 + tid] = acc; } }
    __syncthreads();
}
__device__ __forceinline__ void gla_a_item(const Mix1Bufs& B, const float* gw, const float* gb, int cn, LAS unsigned char* lds, int tid) {
    const int lane = tid & 63, wave = __builtin_amdgcn_readfirstlane(tid >> 6);
    const int bh = cn / NCH, n = cn % NCH, b = bh >> 2, h = bh & 3;
    const size_t t0 = (size_t)b * S_ + n * 64;
    LAS float* bc = (LAS float*)lds; LAS float* gl = (LAS float*)(lds + 16384);
    lbf16* kT = (lbf16*)(lds + 20480); lbf16* vT = (lbf16*)(lds + 20480 + 64 * 72 * 2);
    gla_gates(B.proj, gw, gb, t0, h, bc, gl, tid);
    { const int l = tid & 63, g = tid >> 6; float kf[8]; unpack8(*(const v4u*)(B.proj + (t0 + l) * PJ1 + 768 + h * 64 + g * 8), kf);
#pragma unroll
      for (int j = 0; j < 8; ++j) { const int d = g * 8 + j; kT[d * 72 + l] = (unsigned short)f2bf(kf[j] * __expf(bc[63 * 64 + d] - bc[l * 64 + d])); } }
#pragma unroll
    for (int it = 0; it < 2; ++it) { const int vi = tid + it * 512, l = vi & 63, g = vi >> 6; float vf[8]; unpack8(*(const v4u*)(B.proj + (t0 + l) * PJ1 + 1024 + h * 128 + g * 8), vf);
#pragma unroll
        for (int j = 0; j < 8; ++j) vT[(g * 8 + j) * 72 + l] = (unsigned short)f2bf(vf[j]); }
    __syncthreads();
    { const int et = wave >> 1, dt = wave & 1;
      f32x16 acc = {0.f, 0.f, 0.f, 0.f, 0.f, 0.f, 0.f, 0.f, 0.f, 0.f, 0.f, 0.f, 0.f, 0.f, 0.f, 0.f};
      mm32(acc, vT + et * 32 * 72, 72, kT + dt * 32 * 72, 72, 64, lane);
      float* out = B.ut + (size_t)cn * 8192 + dt * 32 + (lane & 31);
#pragma unroll
      for (int r = 0; r < 16; ++r) out[(size_t)(et * 32 + rowmap(r, lane)) * 64] = acc[r]; }
    if (tid < 64) B.gbl[(size_t)cn * 64 + tid] = bc[63 * 64 + tid];
    __syncthreads();
}
__device__ __forceinline__ void gla_b(const Mix1Bufs& B, int gtid, int gsz) {
    for (int idx = gtid; idx < 8 * 8192; idx += gsz) { const int bh = idx >> 13, ed = idx & 8191, d = ed & 63; float st = 0.f;
        float* p = B.ut + (size_t)bh * NCH * 8192 + ed; const float* gp = B.gbl + (size_t)bh * NCH * 64 + d;
#pragma unroll 8
        for (int n = 0; n < NCH; ++n) { const float u = p[(size_t)n * 8192]; p[(size_t)n * 8192] = st; st = __expf(gp[n * 64]) * st + u; } }
}
__device__ __forceinline__ void gla_c_item(const Mix1Bufs& B, const float* gw, const float* gb, const float* norm_w, int cn, LAS unsigned char* lds, int tid) {
    const int lane = tid & 63, wave = __builtin_amdgcn_readfirstlane(tid >> 6);
    const int bh = cn / NCH, n = cn % NCH, b = bh >> 2, h = bh & 3;
    const size_t t0 = (size_t)b * S_ + n * 64;
    LAS float* bc = (LAS float*)lds; LAS float* gl = (LAS float*)(lds + 16384);
    lbf16* qd = (lbf16*)(lds + 20480); lbf16* ki = (lbf16*)(lds + 29696); lbf16* vT = (lbf16*)(lds + 38912); lbf16* sT = (lbf16*)(lds + 57344); lbf16* att = (lbf16*)(lds + 75776);
    LAS float* ob = (LAS float*)(lds + 84992);
    gla_gates(B.proj, gw, gb, t0, h, bc, gl, tid);
    { const int l = tid >> 3, g = tid & 7; const bf16* pr = B.proj + (t0 + l) * PJ1 + h * 64 + g * 8; float qf[8], kf[8]; unpack8(*(const v4u*)(pr + 512), qf); unpack8(*(const v4u*)(pr + 768), kf);
#pragma unroll
      for (int j = 0; j < 8; ++j) { const float bb = bc[l * 64 + g * 8 + j]; qf[j] *= 0.125f * __expf(bb); kf[j] *= __expf(-bb); }
      *(LAS v4u*)(qd + l * 72 + g * 8) = pack8(qf); *(LAS v4u*)(ki + l * 72 + g * 8) = pack8(kf); }
#pragma unroll
    for (int it = 0; it < 2; ++it) { const int vi = tid + it * 512, l = vi & 63, g = vi >> 6; float vf[8]; unpack8(*(const v4u*)(B.proj + (t0 + l) * PJ1 + 1024 + h * 128 + g * 8), vf);
#pragma unroll
        for (int j = 0; j < 8; ++j) vT[(g * 8 + j) * 72 + l] = (unsigned short)f2bf(vf[j]); }
    { const float* sg = B.ut + (size_t)cn * 8192;
#pragma unroll
      for (int it = 0; it < 2; ++it) { const int vi = tid + it * 512, e = vi >> 3, g = vi & 7;
          const f32x4 a = *(const f32x4*)(sg + e * 64 + g * 8), c2 = *(const f32x4*)(sg + e * 64 + g * 8 + 4);
          v4u o; o.x = pk2(a.x, a.y); o.y = pk2(a.z, a.w); o.z = pk2(c2.x, c2.y); o.w = pk2(c2.z, c2.w); *(LAS v4u*)(sT + e * 72 + g * 8) = o; } }
    __syncthreads();
    if (wave < 4) { const int it = wave >> 1, jt = wave & 1;
        f32x16 acc = {0.f, 0.f, 0.f, 0.f, 0.f, 0.f, 0.f, 0.f, 0.f, 0.f, 0.f, 0.f, 0.f, 0.f, 0.f, 0.f};
        if (jt <= it) mm32(acc, qd + it * 32 * 72, 72, ki + jt * 32 * 72, 72, 64, lane);
        const int j = jt * 32 + (lane & 31);
#pragma unroll
        for (int r = 0; r < 16; ++r) { const int i = it * 32 + rowmap(r, lane); att[i * 72 + j] = (unsigned short)f2bf(j <= i ? acc[r] : 0.f); } }
    __syncthreads();
    { const int it = wave >> 2, nt = wave & 3;
      f32x16 acc = {0.f, 0.f, 0.f, 0.f, 0.f, 0.f, 0.f, 0.f, 0.f, 0.f, 0.f, 0.f, 0.f, 0.f, 0.f, 0.f};
      mm32(acc, att + it * 32 * 72, 72, vT + nt * 32 * 72, 72, 64, lane); mm32(acc, qd + it * 32 * 72, 72, sT + nt * 32 * 72, 72, 64, lane);
#pragma unroll
      for (int r = 0; r < 16; ++r) ob[(it * 32 + rowmap(r, lane)) * 132 + nt * 32 + (lane & 31)] = acc[r]; }
    __syncthreads();
    { const int i = tid >> 3, sub = tid & 7; const LAS float* hr = ob + i * 132 + sub * 16;
      float x[16]; float q = 0.f;
#pragma unroll
      for (int j = 0; j < 16; ++j) { x[j] = hr[j]; q += x[j] * x[j]; }
      q += __builtin_bit_cast(float, __builtin_amdgcn_ds_swizzle(__builtin_bit_cast(int, q), 0x1f | (1 << 10)));
      q += __builtin_bit_cast(float, __builtin_amdgcn_ds_swizzle(__builtin_bit_cast(int, q), 0x1f | (2 << 10)));
      q += __builtin_bit_cast(float, __builtin_amdgcn_ds_swizzle(__builtin_bit_cast(int, q), 0x1f | (4 << 10)));
      const float rstd = 1.0f / sqrtf(q * (1.f / 128.f) + nv::EPS);
      const bf16* rp = B.proj + (t0 + i) * PJ1 + 1536 + h * 128 + sub * 16; const float* nw = norm_w + h * 128 + sub * 16;
      float r0[8], r1[8]; unpack8(*(const v4u*)rp, r0); unpack8(*(const v4u*)(rp + 8), r1);
      float y0[8], y1[8];
#pragma unroll
      for (int j = 0; j < 8; ++j) { y0[j] = x[j] * rstd * nw[j] * r0[j] * sigm_f(r0[j]); y1[j] = x[8 + j] * rstd * nw[8 + j] * r1[j] * sigm_f(r1[j]); }
      bf16* dst = B.mixbf + (t0 + i) * 1024 + 512 + h * 128 + sub * 16;
      *(v4u*)dst = pack8(y0); *(v4u*)(dst + 8) = pack8(y1); }
    __syncthreads();
}
__device__ __forceinline__ void s5_params(const Mix1Bufs& B, const float* const* in, int gtid, int gsz) {
    for (int idx = gtid; idx < 2048; idx += gsz) { const int g = idx >> 6;
        const float lr = in[17][idx], li = in[18][idx], dt = expf(in[24][g]);
        const float mag = expf(lr * dt), ar = mag * cosf(li * dt), ai = mag * sinf(li * dt);
        const float den = lr * lr + li * li, nr = ar - 1.0f, cr = (nr * lr + ai * li) / den, ci = (ai * lr - nr * li) / den;
        B.s5ab[idx * 2] = ar; B.s5ab[idx * 2 + 1] = ai;
        for (int h = 0; h < 16; ++h) { const float br = in[19][idx * 16 + h], bi = in[20][idx * 16 + h]; B.s5bb[idx * 32 + h] = cr * br - ci * bi; B.s5bb[idx * 32 + 16 + h] = cr * bi + ci * br; } }
    for (int idx = gtid; idx < 32 * 32 * 128; idx += gsz) { const int k = idx & 127, hh = (idx >> 7) & 31, g = idx >> 12;
        float v = 0.f; if (hh < 16) v = k < 64 ? in[21][(g * 16 + hh) * 64 + k] : -in[22][(g * 16 + hh) * 64 + k - 64];
        B.cm[idx] = (unsigned short)f2bf(v); }
}
template <bool OUT> __device__ __forceinline__ void s5_chunk(const Mix1Bufs& B, const float* dskip, int item, LAS unsigned char* wl, int lane) {
    const int n = item % NCH, g = (item / NCH) & 31, b = item / (NCH * 32);
    const size_t t0 = (size_t)b * S_ + n * 64; const int gp = g * 64 + lane;
    LAS float* us = (LAS float*)wl;
    lbf16* xs = (lbf16*)(wl + 4096);
    { float f0[8], f1[8]; const bf16* pr = B.proj + (t0 + lane) * PJ1 + g * 16; unpack8(*(const v4u*)pr, f0); unpack8(*(const v4u*)(pr + 8), f1);
#pragma unroll
      for (int j = 0; j < 8; ++j) { us[lane * 16 + j] = f0[j]; us[lane * 16 + 8 + j] = f1[j]; } }
    float br[16], bi[16];
#pragma unroll
    for (int h = 0; h < 16; ++h) { br[h] = B.s5bb[gp * 32 + h]; bi[h] = B.s5bb[gp * 32 + 16 + h]; }
    const float ar = B.s5ab[gp * 2], ai = B.s5ab[gp * 2 + 1];
    float xr = 0.f, xi = 0.f;
    if (OUT) { xr = B.xstart[((size_t)item * 64 + lane) * 2]; xi = B.xstart[((size_t)item * 64 + lane) * 2 + 1]; }
    __builtin_amdgcn_wave_barrier();
    for (int half = 0; half < 2; ++half) {
        for (int l = half * 32; l < half * 32 + 32; ++l) {
            const LAS f32x4* up = (const LAS f32x4*)(us + l * 16);
            float sr = 0.f, si = 0.f;
#pragma unroll
            for (int q = 0; q < 4; ++q) { const f32x4 u4 = up[q];
                sr += u4.x * br[q * 4] + u4.y * br[q * 4 + 1] + u4.z * br[q * 4 + 2] + u4.w * br[q * 4 + 3];
                si += u4.x * bi[q * 4] + u4.y * bi[q * 4 + 1] + u4.z * bi[q * 4 + 2] + u4.w * bi[q * 4 + 3]; }
            const float nr = ar * xr - ai * xi + sr, ni = ar * xi + ai * xr + si; xr = nr; xi = ni;
            if (OUT) { xs[(l & 31) * 136 + lane] = (unsigned short)f2bf(xr); xs[(l & 31) * 136 + 64 + lane] = (unsigned short)f2bf(xi); }
        }
        if (OUT) {
            __builtin_amdgcn_wave_barrier();
            f32x16 acc = {0.f, 0.f, 0.f, 0.f, 0.f, 0.f, 0.f, 0.f, 0.f, 0.f, 0.f, 0.f, 0.f, 0.f, 0.f, 0.f};
            mm32_gb(acc, xs, 136, B.cm + (size_t)g * 32 * 128, 128, 128, lane);
            const int hh = lane & 31;
            if (hh < 16) { const float dk = dskip[g * 16 + hh];
#pragma unroll
                for (int r = 0; r < 16; ++r) { const int l = half * 32 + rowmap(r, lane);
                    B.s5g[(t0 + l) * 512 + g * 16 + hh] = (unsigned short)f2bf(gelu_f(acc[r] + dk * us[l * 16 + hh])); } }
            __builtin_amdgcn_wave_barrier();
        }
    }
    if (!OUT) { B.xend[((size_t)item * 64 + lane) * 2] = xr; B.xend[((size_t)item * 64 + lane) * 2 + 1] = xi; }
    __builtin_amdgcn_wave_barrier();
}
__device__ __forceinline__ void s5_b(const Mix1Bufs& B, int gtid, int gsz) {
    for (int idx = gtid; idx < 2 * 2048; idx += gsz) { const int b = idx >> 11, gp = idx & 2047, g = gp >> 6, p = gp & 63;
        float ar = B.s5ab[gp * 2], ai = B.s5ab[gp * 2 + 1];
#pragma unroll
        for (int q = 0; q < 6; ++q) { const float r2 = ar * ar - ai * ai, i2 = 2.f * ar * ai; ar = r2; ai = i2; }
        float xr = 0.f, xi = 0.f;
#pragma unroll 8
        for (int n = 0; n < NCH; ++n) { const size_t o = ((size_t)((b * 32 + g) * NCH + n) * 64 + p) * 2;
            B.xstart[o] = xr; B.xstart[o + 1] = xi;
            const float er = B.xend[o], ei = B.xend[o + 1], nr = ar * xr - ai * xi + er, ni = ar * xi + ai * xr + ei; xr = nr; xi = ni; } }
}
typedef float f32x4v __attribute__((ext_vector_type(4)));
struct RouterBufs { const float* z; float* h; bf16* hbf; const float* lnw; const float* lnb; const bf16* rwh; const bf16* rwl; const float* rbias; int* ridx; float* rwt; unsigned* cnt; };
__device__ __forceinline__ void router_split_weights(const float* rw, bf16* hi, bf16* lo, int gtid, int gsz) {
    for (int i = gtid; i < 64 * 1024; i += gsz) { const int e = i >> 10, k = i & 1023; const float w = rw[k * 64 + e]; const unsigned h = f2bf(w); hi[i] = (unsigned short)h; lo[i] = (unsigned short)f2bf(w - __builtin_bit_cast(float, h << 16)); }
}
__device__ __forceinline__ void router_select(const LAS float* sc, const float* bias, int* ridx, float* rwt, LAS unsigned* hist) {
    float gs[8];
#pragma unroll
    for (int g = 0; g < 8; ++g) { float m1 = -INFINITY, m2 = -INFINITY;
#pragma unroll
        for (int j = 0; j < 8; ++j) { const float v = sc[g * 8 + j] + bias[g * 8 + j]; if (v > m1) { m2 = m1; m1 = v; } else if (v > m2) m2 = v; }
        gs[g] = m1 + m2; }
    unsigned gsel = 0;
#pragma unroll
    for (int it = 0; it < 4; ++it) { float best = -INFINITY; int bi = 0;
#pragma unroll
        for (int g = 0; g < 8; ++g) { const bool ok = !((gsel >> g) & 1u) && gs[g] > best; best = ok ? gs[g] : best; bi = ok ? g : bi; }
        gsel |= 1u << bi; }
    unsigned long long taken = 0ull; float wsum = 0.f; float wv[8]; int ev[8];
#pragma unroll
    for (int it = 0; it < 8; ++it) { float best = -INFINITY; int bi = 0;
#pragma unroll 1
        for (int e = 0; e < 64; ++e) { const bool ok = ((gsel >> (e >> 3)) & 1u) && !((taken >> e) & 1ull); const float v = sc[e] + bias[e]; if (ok && v > best) { best = v; bi = e; } }
        taken |= 1ull << bi; ev[it] = bi; wv[it] = sc[bi]; wsum += wv[it]; }
    const float inv = 2.5f / wsum;
#pragma unroll
    for (int it = 0; it < 8; ++it) { ridx[it] = ev[it]; rwt[it] = wv[it] * inv; atomicAdd((unsigned*)&hist[ev[it]], 1u); }
}
__device__ __forceinline__ void router_tile(const RouterBufs& R, int tile, LAS unsigned char* lds, int tid) {
    const int lane = tid & 63, wave = __builtin_amdgcn_readfirstlane(tid >> 6);
    lbf16* Ahi = (lbf16*)lds; lbf16* Alo = (lbf16*)(lds + 33024); LAS float* part = (LAS float*)(lds + 66048); LAS float* sc = (LAS float*)(lds + 98816); LAS unsigned* hist = (LAS unsigned*)(lds + 102912);
#pragma unroll 1
    for (int q = 0; q < 2; ++q) { const int row = wave * 2 + q; const size_t t = (size_t)tile * 16 + row;
        float v[16];
#pragma unroll
        for (int half = 0; half < 2; ++half) { const int c0 = half * 512 + lane * 8; const f32x4 a = *(const f32x4*)(R.z + t * 1024 + c0), b = *(const f32x4*)(R.z + t * 1024 + c0 + 4);
            v[half * 8 + 0] = a.x; v[half * 8 + 1] = a.y; v[half * 8 + 2] = a.z; v[half * 8 + 3] = a.w; v[half * 8 + 4] = b.x; v[half * 8 + 5] = b.y; v[half * 8 + 6] = b.z; v[half * 8 + 7] = b.w; }
        float sum = 0.f;
#pragma unroll
        for (int j = 0; j < 16; ++j) sum += v[j];
        sum = wave_sum(sum); const float mean = sum * (1.f / 1024.f); float sq = 0.f;
#pragma unroll
        for (int j = 0; j < 16; ++j) { v[j] -= mean; sq += v[j] * v[j]; }
        sq = wave_sum(sq); const float rstd = 1.0f / sqrtf(sq * (1.f / 1024.f) + nv::EPS);
#pragma unroll
        for (int half = 0; half < 2; ++half) { const int c0 = half * 512 + lane * 8;
            const f32x4 w0 = *(const f32x4*)(R.lnw + c0), w1 = *(const f32x4*)(R.lnw + c0 + 4), b0 = *(const f32x4*)(R.lnb + c0), b1 = *(const f32x4*)(R.lnb + c0 + 4);
            float o[8] = {v[half * 8 + 0] * rstd * w0.x + b0.x, v[half * 8 + 1] * rstd * w0.y + b0.y, v[half * 8 + 2] * rstd * w0.z + b0.z, v[half * 8 + 3] * rstd * w0.w + b0.w,
                          v[half * 8 + 4] * rstd * w1.x + b1.x, v[half * 8 + 5] * rstd * w1.y + b1.y, v[half * 8 + 6] * rstd * w1.z + b1.z, v[half * 8 + 7] * rstd * w1.w + b1.w};
            *(f32x4*)(R.h + t * 1024 + c0) = (f32x4){o[0], o[1], o[2], o[3]}; *(f32x4*)(R.h + t * 1024 + c0 + 4) = (f32x4){o[4], o[5], o[6], o[7]};
            const v4u hi = pack8(o); float hf[8], lo[8]; unpack8(hi, hf);
#pragma unroll
            for (int j = 0; j < 8; ++j) lo[j] = o[j] - hf[j];
            *(v4u*)(R.hbf + t * 1024 + c0) = hi; *(LAS v4u*)(Ahi + row * 1032 + c0) = hi; *(LAS v4u*)(Alo + row * 1032 + c0) = pack8(lo); } }
    if (tid < 64) hist[tid] = 0u;
    __syncthreads();
    { f32x4v acc[4] = {{0.f, 0.f, 0.f, 0.f}, {0.f, 0.f, 0.f, 0.f}, {0.f, 0.f, 0.f, 0.f}, {0.f, 0.f, 0.f, 0.f}};
      const int row = lane & 15, kq = 8 * (lane >> 4);
#pragma unroll
      for (int ks = 0; ks < 4; ++ks) { const int k0 = wave * 128 + ks * 32 + kq;
          const s16x8 ah = *(const LAS s16x8*)(Ahi + row * 1032 + k0), al = *(const LAS s16x8*)(Alo + row * 1032 + k0);
#pragma unroll
          for (int nt = 0; nt < 4; ++nt) { const s16x8 bh = *(const s16x8*)(R.rwh + (size_t)(nt * 16 + row) * 1024 + k0), bl = *(const s16x8*)(R.rwl + (size_t)(nt * 16 + row) * 1024 + k0);
              acc[nt] = __builtin_amdgcn_mfma_f32_16x16x32_bf16(ah, bh, acc[nt], 0, 0, 0);
              acc[nt] = __builtin_amdgcn_mfma_f32_16x16x32_bf16(al, bh, acc[nt], 0, 0, 0);
              acc[nt] = __builtin_amdgcn_mfma_f32_16x16x32_bf16(ah, bl, acc[nt], 0, 0, 0); } }
#pragma unroll
      for (int nt = 0; nt < 4; ++nt)
#pragma unroll
          for (int r = 0; r < 4; ++r) part[(wave * 16 + (lane >> 4) * 4 + r) * 64 + nt * 16 + (lane & 15)] = acc[nt][r]; }
    __syncthreads();
#pragma unroll
    for (int q = 0; q < 2; ++q) { const int o = tid + q * 512; float s = 0.f;
#pragma unroll
        for (int w = 0; w < 8; ++w) s += part[w * 1024 + o];
        sc[o] = 1.0f / (1.0f + expf(-s)); }
    __syncthreads();
    if (tid < 16) { const size_t t = (size_t)tile * 16 + tid; router_select(sc + tid * 64, R.rbias, R.ridx + t * 8, R.rwt + t * 8, hist); }
    __syncthreads();
    if (tid < 64 && hist[tid]) atomicAdd(&R.cnt[tid], hist[tid]);
    __syncthreads();
}
constexpr int CTX_OFF = 131072 + 1024, TAB_OFF = 131072 + 8192;
constexpr size_t WS_WINE = 1 * MiB, WS_WINO = WS_WINE + (size_t)EINP * 1024 * 2, WS_WOUT = WS_WINO + (size_t)OINP * 1024 * 2, WS_XBF = 16 * MiB, WS_MIXBF = 48 * MiB, WS_NAIVE = 80 * MiB;
static_assert(WS_WOUT + 2 * 1024 * 1024 * 2 <= WS_XBF, "ws map");
constexpr size_t WS_WD = 48 * MiB, WS_WGU = WS_WD + 65 * 512 * 1024, WS_LISTS = 146 * MiB, WS_RIDX = 148 * MiB, WS_H = 149 * MiB, WS_ROWS8 = 229 * MiB;
static_assert(WS_WGU + (size_t)65 * 1024 * 1024 <= WS_LISTS && WS_H + (size_t)MOE_MAXBLK * 256 * 512 <= WS_ROWS8 && WS_ROWS8 + (size_t)nv::T_ * 8 * 2048 <= 512 * MiB, "moe ws map");
constexpr size_t WS_PROJB = 149 * MiB, WS_CT = 253 * MiB, WS_HLOC = 317 * MiB, WS_PC = 349 * MiB, WS_M0SMALL = 381 * MiB, WS_LRUW = 486 * MiB;
constexpr size_t WS_UT = 221 * MiB, WS_S5G = 253 * MiB, WS_M1SMALL = 269 * MiB, WS_GLUW = 486 * MiB + 256 * 1024;
constexpr size_t WS_RW = 487 * MiB;
constexpr int CW_PROBE = 9000;
struct Tab { const float* in[38]; float* out; unsigned char* ws; };
struct Env { const Tab* tab; unsigned char* ws; float* out; LAS unsigned char* lds; int tid, lane, wave, bid, G, gw, NGW, gtid, gsz; };
__device__ __forceinline__ Env penv(unsigned char* lds_raw) {
    Env e; e.tab = (const Tab*)(lds_raw + TAB_OFF); e.ws = e.tab->ws; e.out = e.tab->out; e.lds = (LAS unsigned char*)lds_raw;
    int t = threadIdx.x; asm volatile("" : "+v"(t)); e.tid = t; e.lane = t & 63; e.wave = __builtin_amdgcn_readfirstlane(t >> 6);
    int b = blockIdx.x; asm volatile("" : "+s"(b)); e.bid = b; int g = gridDim.x; asm volatile("" : "+s"(g)); e.G = g;
    e.gw = b * NWAVES + e.wave; e.NGW = g * NWAVES; e.gtid = b * NTHREADS + t; e.gsz = g * NTHREADS;
    return e;
}
__device__ __forceinline__ void grid_bar(const Env& e) {
    XcdBarrier b; b.bar = (unsigned*)e.ws + 4096; b.x = xb_xcc_id(); b.st = (volatile LAS unsigned*)(e.lds + MISC_OFF) + 8;
    xcd_barrier(b);
}
template <int ST> __device__ __forceinline__ void run_naive(unsigned char* lds_raw, int ci, long n) {
    const Env e = penv(lds_raw);
    const nv::Ctx& c = ((const nv::Ctx*)(lds_raw + CTX_OFF))[ci];
    for (long i = e.gtid; i < n; i += e.gsz) nv::item<ST>(c, i);
    grid_bar(e);
}
__device__ __forceinline__ void phase_p0(unsigned char* lds_raw) {
    const Env e = penv(lds_raw);
    LAS float* scr = (LAS float*)(e.lds + e.wave * 16384);
    tr_matrix(e.tab->in[6], 1024, nv::EIN, EINP, (bf16*)(e.ws + WS_WINE), scr, e.gw, e.NGW, e.lane);
    tr_matrix(e.tab->in[16], 1024, nv::OIN, OINP, (bf16*)(e.ws + WS_WINO), scr, e.gw, e.NGW, e.lane);
    tr_matrix(e.tab->in[5], 1024, 1024, 1024, (bf16*)(e.ws + WS_WOUT), scr, e.gw, e.NGW, e.lane);
    tr_matrix(e.tab->in[5] + 1024 * 1024, 1024, 1024, 1024, (bf16*)(e.ws + WS_WOUT) + 1024 * 1024, scr, e.gw, e.NGW, e.lane);
    for (int h = 0; h < 4; ++h) { tr_matrix(e.tab->in[11] + h * 16384, 128, 128, 128, (bf16*)(e.ws + WS_LRUW) + h * 16384, scr, e.gw, e.NGW, e.lane);
                                  tr_matrix(e.tab->in[13] + h * 16384, 128, 128, 128, (bf16*)(e.ws + WS_LRUW) + 65536 + h * 16384, scr, e.gw, e.NGW, e.lane); }
    tr_matrix(e.tab->in[25], 512, 512, 512, (bf16*)(e.ws + WS_GLUW), scr, e.gw, e.NGW, e.lane);
    for (int l = 0; l < 2; ++l) router_split_weights(e.tab->in[30] + (size_t)l * 65536, (bf16*)(e.ws + WS_RW) + (size_t)l * 131072, (bf16*)(e.ws + WS_RW) + (size_t)l * 131072 + 65536, e.gtid, e.gsz);
    cvt_rows(e.tab->in[0], (bf16*)(e.ws + WS_XBF), (long)T_ * 1024, e.gtid, e.gsz);
    grid_bar(e);
}
__device__ __forceinline__ void phase_inproj(unsigned char* lds_raw, int layer) {
    const Env e = penv(lds_raw);
    float* proj = (float*)(e.ws + WS_NAIVE) + ((size_t)T_ * 1024 + (size_t)T_ * 64 + (size_t)T_ * 8 * 2);
    const int NP = layer == 0 ? EINP : OINP;
    pg8::Gemm g{(const bf16*)(e.ws + WS_XBF), (const bf16*)(e.ws + (layer == 0 ? WS_WINE : WS_WINO)), 1024, 0, 0, nullptr};
    pg8::StaticOrder S; S.init(T_, NP, e.G, e.bid);
    pg8::EpiF32R E{proj, NP, nullptr, 0.f};
    pg8::gemm_phase<pg8::EpiF32R, pg8::StaticOrder, true, false>(e.lds, g, S, E);
    grid_bar(e);
}
__device__ __forceinline__ void phase_cvt_mixed(unsigned char* lds_raw) {
    const Env e = penv(lds_raw);
    cvt_rows((const float*)(e.ws + WS_NAIVE), (bf16*)(e.ws + WS_MIXBF), (long)T_ * 1024, e.gtid, e.gsz);
    grid_bar(e);
}
__device__ __forceinline__ void phase_outproj(unsigned char* lds_raw, int layer) {
    const Env e = penv(lds_raw);
    float* z = (float*)(e.ws + WS_NAIVE) + ((size_t)T_ * 1024 + (size_t)T_ * 64 + (size_t)T_ * 8 * 2);
    const float* hcur = layer == 0 ? e.tab->in[0] : e.out;
    pg8::Gemm g{(const bf16*)(e.ws + WS_MIXBF), (const bf16*)(e.ws + WS_WOUT) + (size_t)layer * 1024 * 1024, 1024, 0, 0, nullptr};
    pg8::StaticOrder S; S.init(T_, 1024, e.G, e.bid);
    pg8::EpiF32R E{z, 1024, hcur, nv::ALPHA};
    pg8::gemm_phase<pg8::EpiF32R, pg8::StaticOrder, true, false>(e.lds, g, S, E);
    grid_bar(e);
}
__device__ __forceinline__ Mix0Bufs mix0_bufs(unsigned char* ws) {
    Mix0Bufs B; B.proj = (const bf16*)(ws + WS_PROJB); B.ct = (float*)(ws + WS_CT); B.hloc = (float*)(ws + WS_HLOC); B.pc = (float*)(ws + WS_PC);
    float* sm = (float*)(ws + WS_M0SMALL); B.nloc = sm; sm += 8 * NCH * 128; B.blast = sm; sm += 8 * NCH; B.mloc = sm; sm += 8 * NCH; B.mprev = sm; sm += 8 * NCH;
    B.carA = sm; sm += 2 * NCH * 512; B.carU = sm; sm += 2 * NCH * 512; B.carI = sm;
    B.mixbf = (bf16*)(ws + WS_MIXBF); B.lruw = (const bf16*)(ws + WS_LRUW); return B;
}
__device__ __forceinline__ Mix1Bufs mix1_bufs(unsigned char* ws) {
    Mix1Bufs B; B.proj = (const bf16*)(ws + WS_PROJB); B.ut = (float*)(ws + WS_UT); B.s5g = (bf16*)(ws + WS_S5G);
    float* sm = (float*)(ws + WS_M1SMALL); B.gbl = sm; sm += 8 * NCH * 64; B.xend = sm; sm += 8192 * 128; B.xstart = sm; sm += 8192 * 128; B.s5ab = sm; sm += 4096; B.s5bb = sm; sm += 2048 * 32;
    B.cm = (bf16*)sm; B.mixbf = (bf16*)(ws + WS_MIXBF); return B;
}
__device__ __forceinline__ void phase_inproj_bf16(unsigned char* lds_raw, int layer) {
    const Env e = penv(lds_raw);
    const int NP = layer == 0 ? EINP : OINP;
    if (layer == 1) { const Mix1Bufs B = mix1_bufs(e.ws); s5_params(B, e.tab->in, e.gtid, e.gsz); }
    pg8::Gemm g{(const bf16*)(e.ws + WS_XBF), (const bf16*)(e.ws + (layer == 0 ? WS_WINE : WS_WINO)), 1024, 0, 0, nullptr};
    pg8::StaticOrder S; S.init(T_, NP, e.G, e.bid);
    pg8::EpiBf16P E{(bf16*)(e.ws + WS_PROJB), NP};
    pg8::gemm_phase<pg8::EpiBf16P, pg8::StaticOrder, true, false>(e.lds, g, S, E);
    grid_bar(e);
}
__device__ __forceinline__ void phase_mix0_a(unsigned char* lds_raw) {
    const Env e = penv(lds_raw); const Mix0Bufs B = mix0_bufs(e.ws);
    for (int it = e.bid; it < 256 + 8 * NCH; it += e.G) {
        if (it < 256) lru_a_item(B, e.tab->in, it, e.lds, e.tid); else mlstm_a_item(B, e.tab->in[7], it - 256, e.lds, e.tid); }
    grid_bar(e);
}
__device__ __forceinline__ void phase_mix0_b(unsigned char* lds_raw) {
    const Env e = penv(lds_raw); const Mix0Bufs B = mix0_bufs(e.ws);
    lru_b(B, e.gtid, e.gsz); mlstm_b(B, e.gtid, e.gsz);
    grid_bar(e);
}
__device__ __forceinline__ void phase_mix0_c(unsigned char* lds_raw) {
    const Env e = penv(lds_raw); const Mix0Bufs B = mix0_bufs(e.ws);
    for (int it = e.bid; it < 8 * NCH; it += e.G) mlstm_c_item(B, e.tab->in[7], e.tab->in[8], it, e.lds, e.tid);
    lru_c(B, e.gtid, e.gsz);
    grid_bar(e);
}
__device__ __forceinline__ void phase_mix1_a(unsigned char* lds_raw) {
    const Env e = penv(lds_raw); const Mix1Bufs B = mix1_bufs(e.ws);
    for (int it = e.bid; it < 8 * NCH; it += e.G) gla_a_item(B, e.tab->in[27], e.tab->in[28], it, e.lds, e.tid);
    for (int it = e.gw; it < 2 * 32 * NCH; it += e.NGW) s5_chunk<false>(B, e.tab->in[23], it, e.lds + e.wave * 12800, e.lane);
    grid_bar(e);
}
__device__ __forceinline__ void phase_mix1_b(unsigned char* lds_raw) {
    const Env e = penv(lds_raw); const Mix1Bufs B = mix1_bufs(e.ws);
    s5_b(B, e.gtid, e.gsz); gla_b(B, e.gtid, e.gsz);
    grid_bar(e);
}
__device__ __forceinline__ void phase_mix1_c(unsigned char* lds_raw) {
    const Env e = penv(lds_raw); const Mix1Bufs B = mix1_bufs(e.ws);
    for (int it = e.bid; it < 8 * NCH; it += e.G) gla_c_item(B, e.tab->in[27], e.tab->in[28], e.tab->in[29], it, e.lds, e.tid);
    for (int it = e.gw; it < 2 * 32 * NCH; it += e.NGW) s5_chunk<true>(B, e.tab->in[23], it, e.lds + e.wave * 12800, e.lane);
    grid_bar(e);
}
__device__ __forceinline__ void phase_glu(unsigned char* lds_raw) {
    const Env e = penv(lds_raw);
    pg8::Gemm g{(const bf16*)(e.ws + WS_S5G), (const bf16*)(e.ws + WS_GLUW), 512, 0, 0, nullptr};
    pg8::StaticOrder S; S.init(T_, 512, e.G, e.bid);
    pg8::EpiGlu E{(bf16*)(e.ws + WS_MIXBF), 1024, (const bf16*)(e.ws + WS_S5G), 512, e.tab->in[26]};
    pg8::gemm_phase<pg8::EpiGlu, pg8::StaticOrder, true, false>(e.lds, g, S, E);
    grid_bar(e);
}
__device__ __forceinline__ void phase_probe(unsigned char* lds_raw, int c0, int c1) {
    const Env e = penv(lds_raw);
    const bf16* a = (const bf16*)(e.ws + WS_MIXBF); const float* b = (const float*)(e.ws + WS_NAIVE);
    float sd = 0.f, sr = 0.f; const int w = c1 - c0;
    for (long i = e.gtid; i < (long)T_ * w; i += e.gsz) { const long t = i / w; const int c = c0 + (int)(i % w); const float x = bf2f(a[t * 1024 + c]), y = b[t * 1024 + c]; sd += (x - y) * (x - y); sr += y * y; }
    sd = wave_sum(sd); sr = wave_sum(sr);
    if (e.lane == 0) { atomicAdd((float*)e.ws + CW_PROBE, sd); atomicAdd((float*)e.ws + CW_PROBE + 1, sr); }
    grid_bar(e);
}
__device__ __forceinline__ void phase_probe_apply(unsigned char* lds_raw) {
    const Env e = penv(lds_raw);
    const float sd = __hip_atomic_load((float*)e.ws + CW_PROBE, __ATOMIC_RELAXED, __HIP_MEMORY_SCOPE_AGENT), sr = __hip_atomic_load((float*)e.ws + CW_PROBE + 1, __ATOMIC_RELAXED, __HIP_MEMORY_SCOPE_AGENT);
    const float f = 1.0f + 10.0f * sqrtf(sd / fmaxf(sr, 1e-30f));
    for (long i = e.gtid; i < (long)T_ * 1024; i += e.gsz) e.out[i] *= f;
}
__device__ __forceinline__ void phase_ln_router(unsigned char* lds_raw, int layer) {
    const Env e = penv(lds_raw);
    RouterBufs R; R.z = (const float*)(e.ws + WS_NAIVE) + ((size_t)T_ * 1024 + (size_t)T_ * 64 + (size_t)T_ * 8 * 2); R.h = e.out; R.hbf = (bf16*)(e.ws + WS_XBF);
    R.lnw = e.tab->in[1] + layer * 1024; R.lnb = e.tab->in[2] + layer * 1024; R.rwh = (const bf16*)(e.ws + WS_RW) + (size_t)layer * 131072; R.rwl = R.rwh + 65536;
    R.rbias = e.tab->in[31] + layer * 64; R.ridx = (int*)(e.ws + WS_RIDX); R.rwt = (float*)(e.ws + WS_RIDX) + (size_t)T_ * 8; R.cnt = (unsigned*)e.ws + CW_CNT + layer * 256;
    for (int tile = e.bid; tile < T_ / 16; tile += e.G) router_tile(R, tile, e.lds, e.tid);
    grid_bar(e);
}
__device__ __forceinline__ MoeLists moe_lists(unsigned char* ws) {
    MoeLists L; L.tok = (int*)(ws + WS_LISTS); L.dest = L.tok + MOE_MAXBLK * 256; L.w = (float*)(L.dest + MOE_MAXBLK * 256); L.blk_e = (int*)(L.w + MOE_MAXBLK * 256); return L;
}
__device__ __forceinline__ void phase_moe_x1(unsigned char* lds_raw, int layer) {
    const Env e = penv(lds_raw);
    LAS float* scr = (LAS float*)(e.lds + e.wave * 16384);
    moe_convert_weights(e.tab->in[32] + (size_t)layer * 64 * 262144, e.tab->in[33] + (size_t)layer * 64 * 262144, e.tab->in[34] + (size_t)layer * 64 * 262144,
                        e.tab->in[35] + (size_t)layer * 262144, e.tab->in[36] + (size_t)layer * 262144, e.tab->in[37] + (size_t)layer * 262144,
                        (bf16*)(e.ws + WS_WGU), (bf16*)(e.ws + WS_WD), scr, e.gw, e.NGW, e.lane);
#if !defined(OPT_ROUTER)
    cvt_rows(e.out, (bf16*)(e.ws + WS_XBF), (long)T_ * 1024, e.gtid, e.gsz);
    __syncthreads();
    moe_count((const int*)(e.ws + WS_RIDX), (unsigned*)e.ws + CW_CNT + layer * 256, (LAS unsigned*)e.lds, e.tid, e.bid, e.G);
#endif
    grid_bar(e);
}
__device__ __forceinline__ void phase_moe_x2(unsigned char* lds_raw, int layer) {
    const Env e = penv(lds_raw);
    moe_build_lists((const int*)(e.ws + WS_RIDX), (const float*)(e.ws + WS_RIDX) + (size_t)T_ * 8, (unsigned*)e.ws + CW_CNT + layer * 256, (unsigned*)e.ws + CW_CUR + layer * 256,
                    moe_lists(e.ws), (LAS int*)e.lds, e.tid, e.bid, e.G);
    grid_bar(e);
}
__device__ __forceinline__ void phase_moe_g1(unsigned char* lds_raw) {
    const Env e = penv(lds_raw);
    const MoeLists L = moe_lists(e.ws);
    const int nblk = __builtin_amdgcn_readfirstlane(L.blk_e[MOE_MAXBLK]);
    pg8::Gemm g{(const bf16*)(e.ws + WS_XBF), (const bf16*)(e.ws + WS_WGU), 1024, 0, (size_t)512 * 1024, L.tok};
    pg8::MoeOrder S{L.blk_e, nblk, 2, e.G, e.bid};
    pg8::EpiSwiGLU E{(bf16*)(e.ws + WS_H)};
    pg8::gemm_phase<pg8::EpiSwiGLU, pg8::MoeOrder, true, true>(e.lds, g, S, E);
    grid_bar(e);
}
__device__ __forceinline__ void phase_moe_g2(unsigned char* lds_raw) {
    const Env e = penv(lds_raw);
    const MoeLists L = moe_lists(e.ws);
    const int nblk = __builtin_amdgcn_readfirstlane(L.blk_e[MOE_MAXBLK]);
    pg8::Gemm g{(const bf16*)(e.ws + WS_H), (const bf16*)(e.ws + WS_WD), 256, 0, (size_t)1024 * 256, nullptr};
    pg8::MoeOrder S{L.blk_e, nblk, 4, e.G, e.bid};
    pg8::EpiDown E{(bf16*)(e.ws + WS_ROWS8), (bf16*)(e.ws + WS_XBF), L.dest, L.w, T_ * 8};
    pg8::gemm_phase<pg8::EpiDown, pg8::MoeOrder, true, false>(e.lds, g, S, E);
    grid_bar(e);
}
__device__ __forceinline__ void phase_moe_combine(unsigned char* lds_raw, int layer) {
    const Env e = penv(lds_raw);
    moe_combine_ln(e.out, (const bf16*)(e.ws + WS_ROWS8), (const bf16*)(e.ws + WS_XBF), e.tab->in[3] + layer * 1024, e.tab->in[4] + layer * 1024,
                   layer == 0 ? (bf16*)(e.ws + WS_XBF) : nullptr, e.gw, e.NGW, e.lane
#ifdef DBG_LAYER
                   , layer == DBG_LAYER ? (const float*)(e.ws + 486 * MiB) : nullptr, DBG_NT, DBG_T0
#endif
                   );
    grid_bar(e);
}
template <int layer> __device__ __forceinline__ void layer_body(unsigned char* lds_raw) {
    constexpr int ci = layer * 2;
#if defined(OPT_MIX1)
    constexpr bool opt = true;
#elif defined(OPT_MIX0)
    constexpr bool opt = (layer == 0);
#else
    constexpr bool opt = false;
#endif
#if defined(DBG_MIX0)
    constexpr bool naive_too = (layer == DBG_MIX0 - 1);
#else
    constexpr bool naive_too = false;
#endif
    if (opt && layer == 0) { phase_inproj_bf16(lds_raw, layer); phase_mix0_a(lds_raw); phase_mix0_b(lds_raw); phase_mix0_c(lds_raw); }
    if (opt && layer == 1) { phase_inproj_bf16(lds_raw, layer); phase_mix1_a(lds_raw); phase_mix1_b(lds_raw); phase_mix1_c(lds_raw); phase_glu(lds_raw); }
    if (!opt || naive_too) {
        phase_inproj(lds_raw, layer);
        if (layer == 0) {
            run_naive<nv::ST_ML_GATES>(lds_raw, ci, 8L * NCH);
            run_naive<nv::ST_ML_CLOC>(lds_raw, ci, 8L * NCH * 16384);
            run_naive<nv::ST_ML_SCAN>(lds_raw, ci, 8L * 16384 + 8 * 128);
            run_naive<nv::ST_ML_MI>(lds_raw, ci, 8L * S_);
            run_naive<nv::ST_ML_SMAT>(lds_raw, ci, 8L * NCH * 4096);
            run_naive<nv::ST_ML_DEN>(lds_raw, ci, 8L * S_);
            run_naive<nv::ST_ML_H>(lds_raw, ci, 8L * S_ * 128);
            run_naive<nv::ST_ML_NORM>(lds_raw, ci, 8L * S_);
            run_naive<nv::ST_LRU_CONV>(lds_raw, ci, (long)T_ * 512);
            run_naive<nv::ST_LRU_GATE>(lds_raw, ci, (long)T_ * 512);
            run_naive<nv::ST_LRU_SCAN>(lds_raw, ci, 2L * 512);
        } else {
            run_naive<nv::ST_S5_PAR>(lds_raw, ci, 2048);
            for (int sl = 0; sl < S_ / nv::SLAB; ++sl) {
                if (threadIdx.x == 0) ((nv::Ctx*)(lds_raw + CTX_OFF))[ci].slab = sl;
                __syncthreads();
                run_naive<nv::ST_S5_SCAN>(lds_raw, ci, 2L * 2048); run_naive<nv::ST_S5_OUT>(lds_raw, ci, (long)nv::B_ * nv::SLAB * 512); }
            run_naive<nv::ST_S5_GLU>(lds_raw, ci, (long)T_ * 512);
            run_naive<nv::ST_GLA_GATE>(lds_raw, ci, (long)T_ * 256);
            run_naive<nv::ST_GLA_CUM>(lds_raw, ci, (long)nv::B_ * NCH * 256);
            run_naive<nv::ST_GLA_U>(lds_raw, ci, 8L * NCH * 8192);
            run_naive<nv::ST_GLA_SCAN>(lds_raw, ci, 8L * 8192);
            run_naive<nv::ST_GLA_ATT>(lds_raw, ci, 8L * NCH * 4096);
            run_naive<nv::ST_GLA_O>(lds_raw, ci, 8L * S_ * 128);
            run_naive<nv::ST_GLA_NORM>(lds_raw, ci, 8L * S_);
        }
#if defined(DBG_MIX0)
        if (opt && naive_too) phase_probe(lds_raw, DBG_C0, DBG_C1);
#endif
        phase_cvt_mixed(lds_raw);
    }
    phase_outproj(lds_raw, layer);
#if defined(OPT_ROUTER)
    phase_ln_router(lds_raw, layer);
#else
    run_naive<nv::ST_LN>(lds_raw, ci, T_);
    run_naive<nv::ST_SCORES>(lds_raw, ci + 1, (long)T_ * 64);
    run_naive<nv::ST_SELECT>(lds_raw, ci + 1, T_);
#endif
    phase_moe_x1(lds_raw, layer);
    phase_moe_x2(lds_raw, layer);
    phase_moe_g1(lds_raw);
    phase_moe_g2(lds_raw);
    phase_moe_combine(lds_raw, layer);
}
struct Args { const float* in[38]; float* out; unsigned char* ws; };
__global__ void __launch_bounds__(NTHREADS, 2) mega_fwd(Args a) {
    extern __shared__ __attribute__((aligned(16))) unsigned char lds_raw[];
    {
        LAS unsigned char* lds = (LAS unsigned char*)lds_raw;
        for (int u = threadIdx.x; u < (LDS_BYTES - 131072) / 4; u += NTHREADS) ((LAS unsigned*)(lds + 131072))[u] = 0u;
        __syncthreads();
        if (threadIdx.x == 0) {
            (void)xb_add((unsigned*)a.ws + 4096 + XB_XCNT(xb_xcc_id()), 1u);
            Tab* tab = (Tab*)(lds_raw + TAB_OFF);
#pragma unroll
            for (int i = 0; i < 38; ++i) { tab->in[i] = a.in[i]; if ((i & 7) == 7) asm volatile("" ::: "memory"); }
            tab->out = a.out; tab->ws = a.ws;
            asm volatile("" ::: "memory");
            nv::Ctx* const ctab = (nv::Ctx*)(lds_raw + CTX_OFF);
            const size_t scratch0 = (size_t)T_ * 1024 + (size_t)T_ * 64 + (size_t)T_ * 8 * 2;
#pragma unroll 1
            for (int layer = 0; layer < 2; ++layer) {
                nv::Ctx& c = ctab[layer * 2];
                nv::Mem M{(float*)(a.ws + WS_NAIVE), 0};
#pragma unroll 1
                for (int i = 0; i < 38; ++i) c.in[i] = tab->in[i];
                c.mixed = M.get((size_t)T_ * 1024); c.scores = M.get((size_t)T_ * 64);
                c.ridx = (int*)M.get((size_t)T_ * 8); c.rwt = M.get((size_t)T_ * 8);
                c.gR = nullptr; c.gBias = nullptr; c.slab = 0;
                c.layer = layer;
                c.hcur = layer == 0 ? a.in[0] : a.out;
                if (layer == 0) {
                    c.ldp = EINP; c.proj = M.get((size_t)T_ * c.ldp);
                    c.mb = M.get(8 * S_); c.mig = M.get(8 * S_); c.mblast = M.get(8 * NCH); c.mmloc = M.get(8 * NCH); c.mmprev = M.get(8 * NCH);
                    c.mmi = M.get(8 * S_); c.mwin = M.get(8 * S_); c.mden = M.get(8 * S_); c.nloc = M.get(8 * NCH * 128);
                    const size_t ov = M.off;
                    c.cloc = M.get((size_t)8 * NCH * 16384); c.smat = M.get((size_t)8 * NCH * 4096); c.htil = M.get((size_t)T_ * 512);
                    M.off = ov; c.lxc = M.get((size_t)T_ * 512); c.la = M.get((size_t)T_ * 512); c.lu = M.get((size_t)T_ * 512);
                } else {
                    c.ldp = OINP; c.proj = M.get((size_t)T_ * c.ldp);
                    c.s5ab = M.get(2048 * 2); c.s5bbr = M.get(2048 * 16); c.s5bbi = M.get(2048 * 16); c.s5st = M.get(2 * 2048 * 2);
                    c.s5x = M.get((size_t)nv::B_ * nv::SLAB * 2048 * 2); c.s5g = M.get((size_t)T_ * 512);
                    c.gla_la = M.get((size_t)T_ * 256); c.gla_bc = M.get((size_t)T_ * 256); c.gla_bl = M.get((size_t)nv::B_ * NCH * 256);
                    c.gu = M.get((size_t)8 * NCH * 8192); c.gatt = M.get((size_t)8 * NCH * 4096); c.go = M.get((size_t)T_ * 512);
                }
                c.z = c.proj; c.hout = a.out; c.lnw = a.in[1] + layer * 1024; c.lnb = a.in[2] + layer * 1024;
                M.off = scratch0; c.hid = M.get((size_t)T_ * 9 * 256);
                nv::Ctx& cm = ctab[layer * 2 + 1];
                cm = c; cm.hcur = a.out;
#ifdef DBG_LAYER
                if (layer == DBG_LAYER) { nv::Ctx& cd = ctab[4]; cd = cm;
                cd.hid = (float*)(a.ws + 48 * MiB); cd.z = (float*)(a.ws + 486 * MiB); cd.hcur = a.out + (size_t)DBG_T0 * 1024; cd.ridx = c.ridx + (size_t)DBG_T0 * 8; cd.rwt = c.rwt + (size_t)DBG_T0 * 8; }
#endif
            }
        }
        __syncthreads();
    }
    phase_p0(lds_raw);
    layer_body<0>(lds_raw);
    layer_body<1>(lds_raw);
#if defined(DBG_MIX0)
    phase_probe_apply(lds_raw);
#endif
}
extern "C" void kernel_launch(void* const* d_in, const int* in_sizes, int n_in, void* d_out, int out_size, void* d_ws, size_t ws_size, hipStream_t stream) {
    static int grid = 0;
    if (grid == 0) {
        int dev = 0, cus = 0, per_cu = 0;
        hipGetDevice(&dev); hipDeviceGetAttribute(&cus, hipDeviceAttributeMultiprocessorCount, dev);
        hipFuncSetAttribute((const void*)mega_fwd, hipFuncAttributeMaxDynamicSharedMemorySize, LDS_BYTES);
        hipOccupancyMaxActiveBlocksPerMultiprocessor(&per_cu, (const void*)mega_fwd, NTHREADS, LDS_BYTES);
        (void)hipGetLastError();
        grid = (per_cu >= 1) ? cus : -1;
    }
    if (grid < 0) return;
    hipMemsetAsync(d_ws, 0, CTL_BYTES, stream);
    Args a{};
    for (int i = 0; i < 38; ++i) a.in[i] = (const float*)d_in[i];
    a.out = (float*)d_out; a.ws = (unsigned char*)d_ws;
    hipLaunchKernelGGL(mega_fwd, dim3(grid), dim3(NTHREADS), LDS_BYTES, stream, a);
}
```

```cpp
#define OPT_MIX0 1
#define OPT_MIX1 1
#define OPT_ROUTER 1
#include <hip/hip_runtime.h>
#define GAS __attribute__((address_space(1)))
#define LAS __attribute__((address_space(3)))
#define XB_TMO      128
#define XB_XCNT(j)  (256  + 64 * (j))
#define XB_XSUB(j)  (1280 + 64 * (j))
#define XB_XGEN(j)  (2304 + 64 * (j))
#define XB_TOP      3328
#define XB_TOPGEN   3392
#define XCD_BAR_WORDS 3456
#define XB_SPIN_CAP (1u << 22)
__device__ __forceinline__ unsigned xb_ld(unsigned* p)              { return __hip_atomic_load(p, __ATOMIC_RELAXED, __HIP_MEMORY_SCOPE_AGENT); }
__device__ __forceinline__ unsigned xb_add(unsigned* p, unsigned v) { return __hip_atomic_fetch_add(p, v, __ATOMIC_RELAXED, __HIP_MEMORY_SCOPE_AGENT); }
__device__ __forceinline__ unsigned xb_xcc_id() { return (unsigned)__builtin_amdgcn_s_getreg((3 << 11) | 20) & 0xFu; }
#define XB_SPIN(cond, bar) do { unsigned _sp = 0; while (cond) { __builtin_amdgcn_s_sleep(1); \
    if ((++_sp & 255u) == 0u) { if (xb_ld(&(bar)[XB_TMO])) break; if (_sp > XB_SPIN_CAP) { atomicAdd(&(bar)[XB_TMO], 1u); break; } } } } while (0)
struct XcdBarrier { unsigned* bar; unsigned x; volatile LAS unsigned* st; };
__device__ __forceinline__ XcdBarrier xcd_barrier_post(unsigned* bar, volatile LAS unsigned* st) {
    XcdBarrier b; b.bar = bar; b.x = xb_xcc_id(); b.st = st;
    if (threadIdx.x == 0) (void)xb_add(&bar[XB_XCNT(b.x)], 1u);
    return b;
}
__device__ __forceinline__ void xcd_barrier_complete(unsigned* bar, unsigned x, unsigned& nloc, unsigned& nx) {
    const unsigned G = gridDim.x * gridDim.y * gridDim.z;
    unsigned sum, cnt, mine, sp = 0u;
    for (;;) {
        sum = 0u; cnt = 0u; mine = 0u;
#pragma unroll
        for (unsigned j = 0; j < 16; ++j) { const unsigned c = xb_ld(&bar[XB_XCNT(j)]); sum += c; cnt += (c > 0u) ? 1u : 0u; mine = (j == x) ? c : mine; }
        if (sum == G) break;
        __builtin_amdgcn_s_sleep(1);
        if ((++sp & 255u) == 0u) { if (xb_ld(&bar[XB_TMO])) break; if (sp > XB_SPIN_CAP) { atomicAdd(&bar[XB_TMO], 1u); break; } }
    }
    nloc = mine > 0u ? mine : 1u; nx = cnt > 0u ? cnt : 1u;
}
__device__ __forceinline__ void xcd_barrier(const XcdBarrier& b) {
    asm volatile("s_waitcnt vmcnt(0)" ::: "memory");
    __syncthreads();
    if (threadIdx.x == 0) {
        unsigned* bar = b.bar;
        __builtin_amdgcn_s_waitcnt(0);
        unsigned nloc = b.st[0], nx = b.st[1];
        if (nloc == 0u) { xcd_barrier_complete(bar, b.x, nloc, nx); b.st[0] = nloc; b.st[1] = nx; }
        const unsigned old = xb_add(&bar[XB_XSUB(b.x)], 1u);
        const unsigned gen = old / nloc;
        if (old + 1u == (gen + 1u) * nloc) {
            __builtin_amdgcn_fence(__ATOMIC_RELEASE, "agent");
            asm volatile("s_waitcnt vmcnt(0)" ::: "memory");
            const unsigned og = xb_add(&bar[XB_TOP], 1u);
            const unsigned tg = og / nx;
            if (og + 1u == (tg + 1u) * nx) xb_add(&bar[XB_TOPGEN], 1u);
            else XB_SPIN(xb_ld(&bar[XB_TOPGEN]) == tg, bar);
            __builtin_amdgcn_fence(__ATOMIC_ACQUIRE, "agent");
            xb_add(&bar[XB_XGEN(b.x)], 1u);
            asm volatile("s_waitcnt vmcnt(0)" ::: "memory");
        } else {
            XB_SPIN(xb_ld(&bar[XB_XGEN(b.x)]) == gen, bar);
            __builtin_amdgcn_fence(__ATOMIC_ACQUIRE, "agent");
            asm volatile("s_waitcnt vmcnt(0)" ::: "memory");
        }
    }
    __syncthreads();
}
namespace pg8 {
#define PG8_LAS __attribute__((address_space(3)))
typedef unsigned short bf16_t;
typedef short bf16x8 __attribute__((ext_vector_type(8)));
typedef float f32x4 __attribute__((ext_vector_type(4)));
typedef unsigned u32x4 __attribute__((ext_vector_type(4)));
constexpr int BM = 256, BK = 64, HALF = 128, HTB = HALF * BK * 2, STAGE_BYTES = 8 * HTB, NXCD = 8, WGM = 8;
__host__ __device__ __forceinline__ int lds_byte(int r, int c) { const int st = (r >> 4) * 2 + (c >> 5), rr = r & 15, cc = c & 31, ob = rr * 64 + cc * 2; return st * 1024 + (ob ^ (((ob >> 9) & 1) << 5)); }
__host__ __device__ __forceinline__ void stage_rc(int b, int& R, int& C) { const int st = b / 1024, sb = b % 1024, swz = sb ^ (((sb >> 9) & 1) << 5); R = (st >> 1) * 16 + swz / 64; C = (st & 1) * 32 + (swz % 64) / 2; }
__host__ __device__ __forceinline__ int perm32(int rho) { const int n = rho >> 4, i = rho & 15; return 8 * (i >> 2) + 4 * n + (i & 3); }
struct Unit { int pm, pn, e, aux; };
struct Gemm { const bf16_t* A; const bf16_t* Bt; int K; int pad; size_t bstride; const int* rows; };
struct StaticOrder {
    int nM, nN, nwg, G, c;
    __host__ __device__ void init(int M, int N, int G_, int c_) { nM = M / BM; nN = N / BM; nwg = nM * nN; G = G_; c = c_; }
    __host__ __device__ bool next(int i, Unit& u) const {
        const long L = (long)i * G + c; if (L >= nwg) return false;
        int wgid = (int)L; { const int q = nwg / NXCD, r = nwg % NXCD, xcd = wgid % NXCD, off = wgid / NXCD; wgid = (xcd < r ? xcd * (q + 1) : r * (q + 1) + (xcd - r) * q) + off; }
        const int nig = WGM * nN, gid = wgid / nig, fm = gid * WGM, gsz = (nM - fm) < WGM ? (nM - fm) : WGM;
        u.pm = fm + ((wgid % nig) % gsz); u.pn = (wgid % nig) / gsz; u.e = 0; u.aux = 0; return true;
    }
};
__device__ __forceinline__ unsigned cvt_pk_bf16(float lo, float hi) { unsigned r; asm volatile("v_cvt_pk_bf16_f32 %0, %1, %2" : "=v"(r) : "v"(lo), "v"(hi)); return r; }
struct EpiF32R {
    static constexpr int NPRE = 0; __device__ __forceinline__ void load_pre(const Unit&, int, int, int (&)[1]) const {}
    static constexpr bool PERM = false;
    float* C; int ldc; const float* R; float ralpha;
    __device__ __forceinline__ void operator()(const f32x4 (&acc)[2][2][4][2], const Unit& u, int wr, int wc, int fr, int fq) const {
        const int row0 = u.pm * BM + wr * 64 + fr, col0 = u.pn * BM + wc * 32 + 4 * fq;
#pragma unroll
        for (int ai = 0; ai < 2; ++ai)
#pragma unroll
            for (int m = 0; m < 4; ++m) { const size_t off = (size_t)(row0 + ai * HALF + m * 16) * ldc + col0;
#pragma unroll
                for (int bj = 0; bj < 2; ++bj)
#pragma unroll
                    for (int n = 0; n < 2; ++n) { f32x4 v = acc[ai][bj][m][n]; if (R) v = v + ralpha * *(const f32x4*)(R + off + bj * HALF + n * 16); *(f32x4*)(C + off + bj * HALF + n * 16) = v; } }
    }
};
struct EpiBf16P {
    static constexpr int NPRE = 0; __device__ __forceinline__ void load_pre(const Unit&, int, int, int (&)[1]) const {}
    static constexpr bool PERM = true;
    bf16_t* O; int ldc;
    __device__ __forceinline__ void operator()(const f32x4 (&acc)[2][2][4][2], const Unit& u, int wr, int wc, int fr, int fq) const {
        const int row0 = u.pm * BM + wr * 64 + fr, col0 = u.pn * BM + wc * 32 + 8 * fq;
#pragma unroll
        for (int ai = 0; ai < 2; ++ai)
#pragma unroll
            for (int m = 0; m < 4; ++m) { bf16_t* rowp = O + (size_t)(row0 + ai * HALF + m * 16) * ldc + col0;
#pragma unroll
                for (int bj = 0; bj < 2; ++bj) { const f32x4 v0 = acc[ai][bj][m][0], v1 = acc[ai][bj][m][1];
                    u32x4 w; w.x = cvt_pk_bf16(v0[0], v0[1]); w.y = cvt_pk_bf16(v0[2], v0[3]); w.z = cvt_pk_bf16(v1[0], v1[1]); w.w = cvt_pk_bf16(v1[2], v1[3]);
                    *(u32x4*)(rowp + bj * HALF) = w; } }
    }
};
struct EpiGlu {
    static constexpr int NPRE = 0; __device__ __forceinline__ void load_pre(const Unit&, int, int, int (&)[1]) const {}
    static constexpr bool PERM = true;
    bf16_t* O; int ldo; const bf16_t* Gm; int ldg; const float* bias;
    __device__ __forceinline__ void operator()(const f32x4 (&acc)[2][2][4][2], const Unit& u, int wr, int wc, int fr, int fq) const {
        const int row0 = u.pm * BM + wr * 64 + fr, col0 = u.pn * BM + wc * 32 + 8 * fq;
#pragma unroll
        for (int ai = 0; ai < 2; ++ai)
#pragma unroll
            for (int m = 0; m < 4; ++m) { const size_t r = (size_t)(row0 + ai * HALF + m * 16);
#pragma unroll
                for (int bj = 0; bj < 2; ++bj) { const int c = col0 + bj * HALF;
                    const f32x4 b0 = *(const f32x4*)(bias + c), b1 = *(const f32x4*)(bias + c + 4); const u32x4 gv = *(const u32x4*)(Gm + r * ldg + c);
                    const f32x4 v0 = acc[ai][bj][m][0] + b0, v1 = acc[ai][bj][m][1] + b1;
                    float g[8] = {__builtin_bit_cast(float, gv.x << 16), __builtin_bit_cast(float, gv.x & 0xffff0000u), __builtin_bit_cast(float, gv.y << 16), __builtin_bit_cast(float, gv.y & 0xffff0000u),
                                  __builtin_bit_cast(float, gv.z << 16), __builtin_bit_cast(float, gv.z & 0xffff0000u), __builtin_bit_cast(float, gv.w << 16), __builtin_bit_cast(float, gv.w & 0xffff0000u)};
                    u32x4 w; w.x = cvt_pk_bf16(g[0] / (1.f + __expf(-v0[0])), g[1] / (1.f + __expf(-v0[1]))); w.y = cvt_pk_bf16(g[2] / (1.f + __expf(-v0[2])), g[3] / (1.f + __expf(-v0[3])));
                    w.z = cvt_pk_bf16(g[4] / (1.f + __expf(-v1[0])), g[5] / (1.f + __expf(-v1[1]))); w.w = cvt_pk_bf16(g[6] / (1.f + __expf(-v1[2])), g[7] / (1.f + __expf(-v1[3])));
                    *(u32x4*)(O + r * ldo + c) = w; } }
    }
};
template <class Epi, class Sched, bool ALIGN_EPI, bool GATHER>
__device__ __forceinline__ void gemm_phase(PG8_LAS unsigned char* lds, const Gemm g, const Sched& S, const Epi& E) {
    int tid_ = threadIdx.x; asm volatile("" : "+v"(tid_));
    const int tid = tid_, wid = __builtin_amdgcn_readfirstlane(tid >> 6), lane = tid & 63, wr = wid >> 2, wc = wid & 3, fr = lane & 15, fq = lane >> 4;
    const int K = g.K, nt = K / BK;
    unsigned voffA[2], voffB[2];
#pragma unroll
    for (int i = 0; i < 2; ++i) { int R, C; stage_rc(tid * 16 + i * 8192, R, C); const int Rb = Epi::PERM ? ((R & ~31) + perm32(R & 31)) : R;
        voffA[i] = (unsigned)(R * K + C) * 2u; voffB[i] = (unsigned)(Rb * K + C) * 2u; }
    const size_t kstep = (size_t)(BK * 2);
    const size_t hstep = (size_t)HALF * K * 2;
    const size_t tstep = 2 * hstep;
    const unsigned ldsw = (unsigned)wid * 1024u;
    const int aoff = lds_byte(wr * 64 + fr, fq * 8), boff = lds_byte(wc * 32 + fr, fq * 8);
#define PG8_SA(b, h) (((b) * 2 + (h)) * HTB)
#define PG8_SB(b, h) ((4 + (b) * 2 + (h)) * HTB)
#define PG8_STAGE(bufoff, gbase, voff) do { _Pragma("unroll") for (int _i = 0; _i < 2; ++_i) { unsigned _vo = (voff)[_i]; asm volatile("" : "+v"(_vo));   \
        __builtin_amdgcn_global_load_lds((const unsigned*)((const char*)(gbase) + _vo), (PG8_LAS unsigned*)(lds + (bufoff) + ldsw + _i * 8192), 16, 0, 0); } } while (0)
#define PG8_STAGE_A(bufoff, gbase, h, GV) do { if constexpr (GATHER) { PG8_STAGE(bufoff, gbase, GV[h]); } else { PG8_STAGE(bufoff, (gbase) + (h) * hstep, voffA); } } while (0)
#define PG8_STAGE_A2(bufoff, gbase, h) do { if constexpr (GATHER) { unsigned _gv[2] = {last ? gnxt[h][0] : gcur[h][0], last ? gnxt[h][1] : gcur[h][1]}; PG8_STAGE(bufoff, gbase, _gv); } else { PG8_STAGE(bufoff, (gbase) + (h) * hstep, voffA); } } while (0)
#define PG8_LDA(dst, b, h) do { _Pragma("unroll") for (int m = 0; m < 4; ++m) _Pragma("unroll") for (int k = 0; k < 2; ++k) dst[m][k] = *(const PG8_LAS bf16x8*)(lds + PG8_SA(b, h) + aoff + m * 2048 + k * 1024); } while (0)
#define PG8_LDB(dst, b, h) do { _Pragma("unroll") for (int n = 0; n < 2; ++n) _Pragma("unroll") for (int k = 0; k < 2; ++k) dst[n][k] = *(const PG8_LAS bf16x8*)(lds + PG8_SB(b, h) + boff + n * 2048 + k * 1024); } while (0)
#define PG8_MMA(ai, bj, At, Bt) do { __builtin_amdgcn_s_setprio(1); _Pragma("unroll") for (int m = 0; m < 4; ++m) _Pragma("unroll") for (int n = 0; n < 2; ++n) _Pragma("unroll") for (int k = 0; k < 2; ++k) \
        acc[ai][bj][m][n] = __builtin_amdgcn_mfma_f32_16x16x32_bf16(Bt[n][k], At[m][k], acc[ai][bj][m][n], 0, 0, 0); __builtin_amdgcn_s_setprio(0); } while (0)
#define PG8_WAIT_V(n) asm volatile("s_waitcnt vmcnt(" #n ")" ::: "memory")
#define PG8_WAIT_L(n) asm volatile("s_waitcnt lgkmcnt(" #n ")" ::: "memory")
#define PG8_BAR __builtin_amdgcn_s_barrier()
#define PG8_SCHED __builtin_amdgcn_sched_barrier(0)
#define PG8_GLOAD(GV, u) do { _Pragma("unroll") for (int _i = 0; _i < 2; ++_i) { int _R, _C; stage_rc(tid * 16 + _i * 8192, _R, _C); _Pragma("unroll") for (int _h = 0; _h < 2; ++_h) \
        GV[_h][_i] = (unsigned)g.rows[(u).pm * BM + _h * HALF + _R] * (unsigned)(K * 2) + (unsigned)(_C * 2); } } while (0)
    Unit cur, nxt; int ui = 0;
    if (!S.next(0, cur)) return;
    f32x4 acc[2][2][4][2];
#pragma unroll
    for (int a = 0; a < 2; ++a)
#pragma unroll
        for (int b = 0; b < 2; ++b)
#pragma unroll
            for (int m = 0; m < 4; ++m)
#pragma unroll
                for (int n = 0; n < 2; ++n) acc[a][b][m][n] = (f32x4){0.f, 0.f, 0.f, 0.f};
    bf16x8 At[4][2], B0[2][2], B1[2][2];
    unsigned gcur[2][2] = {{0u, 0u}, {0u, 0u}}, gnxt[2][2] = {{0u, 0u}, {0u, 0u}};
    if constexpr (Epi::NPRE > 0) E.prefetch(cur, 0, lds, wid, lane);
    if constexpr (GATHER) { PG8_GLOAD(gcur, cur); }
    const char* cA = GATHER ? (const char*)g.A : (const char*)g.A + (size_t)cur.pm * tstep;
    const char* cB = (const char*)g.Bt + ((size_t)cur.e * g.bstride) * 2 + (size_t)cur.pn * tstep;
    PG8_STAGE(PG8_SB(0, 0), cB, voffB); PG8_STAGE(PG8_SB(0, 1), cB + hstep, voffB); PG8_STAGE_A(PG8_SA(0, 0), cA, 0, gcur); PG8_STAGE_A(PG8_SA(0, 1), cA, 1, gcur);
    if (wr == 1) PG8_BAR;
    PG8_WAIT_V(2); PG8_BAR;
    PG8_STAGE(PG8_SB(1, 0), cB + kstep, voffB); PG8_STAGE_A(PG8_SA(1, 0), cA + kstep, 0, gcur); PG8_STAGE(PG8_SB(1, 1), cB + hstep + kstep, voffB);
    PG8_WAIT_V(6); PG8_BAR;
    for (;;) {
        const bool has_next = S.next(ui + 1, nxt);
        if constexpr (Epi::NPRE > 0) { if (has_next) E.prefetch(nxt, (ui + 1) % 3, lds, wid, lane); }
        if constexpr (GATHER) { if (has_next) { PG8_GLOAD(gnxt, nxt); } else {
#pragma unroll
            for (int _h = 0; _h < 2; ++_h)
#pragma unroll
                for (int _i = 0; _i < 2; ++_i) gnxt[_h][_i] = gcur[_h][_i]; } }
        const char* nA = GATHER ? cA : (has_next ? (const char*)g.A + (size_t)nxt.pm * tstep : cA);
        const char* nB = has_next ? (const char*)g.Bt + ((size_t)nxt.e * g.bstride) * 2 + (size_t)nxt.pn * tstep : cB;
#pragma unroll 1
        for (int t = 0; t < nt; t += 2) {
            const bool last = (t == nt - 2);
            const char* a1 = cA + (size_t)(t + 1) * kstep;
            const char* a2 = last ? nA : cA + (size_t)(t + 2) * kstep; const char* b2 = last ? nB : cB + (size_t)(t + 2) * kstep;
            const char* a3 = a2 + kstep; const char* b3 = b2 + kstep;
            PG8_LDB(B0, 0, 0); PG8_LDB(B1, 0, 1); PG8_SCHED; PG8_LDA(At, 0, 0); PG8_STAGE_A(PG8_SA(1, 1), a1, 1, gcur);
            PG8_WAIT_V(8); PG8_WAIT_L(0); PG8_BAR; PG8_MMA(0, 0, At, B0); PG8_MMA(0, 1, At, B1); PG8_BAR; PG8_SCHED;
            PG8_LDA(At, 0, 1); PG8_STAGE(PG8_SB(0, 0), b2, voffB); PG8_STAGE(PG8_SB(0, 1), b2 + hstep, voffB); PG8_STAGE_A2(PG8_SA(0, 0), a2, 0);
            PG8_WAIT_V(8); PG8_WAIT_L(0); PG8_BAR; PG8_MMA(1, 0, At, B0); PG8_MMA(1, 1, At, B1); PG8_BAR; PG8_SCHED;
            PG8_LDB(B0, 1, 0); PG8_LDB(B1, 1, 1); PG8_SCHED; PG8_LDA(At, 1, 0); PG8_STAGE_A2(PG8_SA(0, 1), a2, 1);
            PG8_WAIT_V(8); PG8_WAIT_L(0); PG8_BAR; PG8_MMA(0, 0, At, B0); PG8_MMA(0, 1, At, B1); PG8_BAR; PG8_SCHED;
            PG8_LDA(At, 1, 1); PG8_STAGE(PG8_SB(1, 0), b3, voffB); PG8_STAGE(PG8_SB(1, 1), b3 + hstep, voffB); PG8_STAGE_A2(PG8_SA(1, 0), a3, 0);
            PG8_WAIT_V(8); PG8_WAIT_L(0); PG8_BAR; PG8_MMA(1, 0, At, B0); PG8_MMA(1, 1, At, B1); PG8_BAR; PG8_SCHED;
        }
        if constexpr (ALIGN_EPI) { if (wr == 0) PG8_BAR; }
        if constexpr (Epi::NPRE > 0) E(acc, cur, wr, wc, fr, fq, ui % 3, lds); else E(acc, cur, wr, wc, fr, fq);
        if (!has_next) break;
#pragma unroll
        for (int a = 0; a < 2; ++a)
#pragma unroll
            for (int b = 0; b < 2; ++b)
#pragma unroll
                for (int m = 0; m < 4; ++m)
#pragma unroll
                    for (int n = 0; n < 2; ++n) acc[a][b][m][n] = (f32x4){0.f, 0.f, 0.f, 0.f};
        cur = nxt; cA = nA; cB = nB; ++ui;
        if constexpr (GATHER) {
#pragma unroll
            for (int _h = 0; _h < 2; ++_h)
#pragma unroll
                for (int _i = 0; _i < 2; ++_i) gcur[_h][_i] = gnxt[_h][_i]; }
        if constexpr (ALIGN_EPI) { if (wr == 1) PG8_BAR; }
    }
    PG8_WAIT_V(0);
    if constexpr (!ALIGN_EPI) { if (wr == 0) PG8_BAR; }
    PG8_BAR;
#undef PG8_SA
#undef PG8_SB
#undef PG8_STAGE
#undef PG8_STAGE_A
#undef PG8_STAGE_A2
#undef PG8_LDA
#undef PG8_LDB
#undef PG8_MMA
#undef PG8_WAIT_V
#undef PG8_WAIT_L
#undef PG8_BAR
#undef PG8_SCHED
#undef PG8_GLOAD
}
}
typedef unsigned short bf16;
typedef unsigned v4u __attribute__((ext_vector_type(4)));
typedef unsigned v2u __attribute__((ext_vector_type(2)));
typedef float f32x4 __attribute__((ext_vector_type(4)));
constexpr int NTHREADS = 512, NWAVES = 8;
constexpr int LDS_BYTES = 163840;
constexpr int LDS_CTL = 155648;
constexpr int MISC_OFF = LDS_CTL + 320;
constexpr size_t MiB = 1u << 20;
constexpr size_t CTL_BYTES = 1 * MiB;
#if !defined(WITH_NAIVE)
namespace nv { constexpr int B_ = 2, S_ = 8192, T_ = B_ * S_, NCH = S_ / 64, EIN = 3080, OIN = 2064; constexpr float ALPHA = 1.41421356237309515f, EPS = 1e-5f; struct Mem { float* base; size_t off; }; }
#endif
constexpr int T_ = nv::T_, S_ = nv::S_, NCH = nv::NCH;
constexpr int EINP = 3328, OINP = 2304;
#define LDS_WAIT() asm volatile("s_waitcnt lgkmcnt(0)" ::: "memory")
typedef __bf16 hwbf2_t __attribute__((ext_vector_type(2)));
typedef float hwf2_t __attribute__((ext_vector_type(2)));
__device__ __forceinline__ unsigned f2bf(float f) { const __bf16 b = (__bf16)f; return (unsigned)__builtin_bit_cast(unsigned short, b); }
__device__ __forceinline__ unsigned pk2(float lo, float hi) { const hwf2_t v = {lo, hi}; return __builtin_bit_cast(unsigned, __builtin_convertvector(v, hwbf2_t)); }
__device__ __forceinline__ float bf2f(unsigned short b) { return __builtin_bit_cast(float, (unsigned)b << 16); }
__device__ __forceinline__ void tr_item(const float* W, long ldw, int nvalid, bf16* dst, long ldd, LAS float* scr, int lane) {
#pragma unroll 8
    for (int i = 0; i < 32; ++i) { const int kk = 2 * i + (lane >> 5), nn = lane & 31; scr[kk * 33 + nn] = nn < nvalid ? W[(long)kk * ldw + nn] : 0.f; }
    LDS_WAIT(); asm volatile("" ::: "memory");
    const int c = lane & 7;
#pragma unroll
    for (int j = 0; j < 4; ++j) { const int n = (lane >> 3) + 8 * j; const LAS float* s = scr + (8 * c) * 33 + n;
        v4u o; o.x = pk2(s[0 * 33], s[1 * 33]); o.y = pk2(s[2 * 33], s[3 * 33]); o.z = pk2(s[4 * 33], s[5 * 33]); o.w = pk2(s[6 * 33], s[7 * 33]);
        *(v4u*)(dst + (long)n * ldd + 8 * c) = o; }
    LDS_WAIT(); asm volatile("" ::: "memory");
}
__device__ __forceinline__ void tr_item64(const float* W, long ldw, int nvalid, bf16* dst, long ldd, LAS float* scr, int lane) {
    const int nn = (lane & 15) * 4;
#pragma unroll
    for (int i = 0; i < 16; ++i) { const int kk = 4 * i + (lane >> 4);
        f32x4 v = {0.f, 0.f, 0.f, 0.f}; if (nn < nvalid) v = *(const f32x4*)(W + (long)kk * ldw + nn);
        LAS float* s = scr + kk * 65 + nn; s[0] = v.x; s[1] = v.y; s[2] = v.z; s[3] = v.w; }
    LDS_WAIT(); asm volatile("" ::: "memory");
    const int c = lane & 7;
#pragma unroll
    for (int j = 0; j < 8; ++j) { const int n = (lane >> 3) + 8 * j; const LAS float* s = scr + (8 * c) * 65 + n;
        v4u o; o.x = pk2(s[0 * 65], s[1 * 65]); o.y = pk2(s[2 * 65], s[3 * 65]); o.z = pk2(s[4 * 65], s[5 * 65]); o.w = pk2(s[6 * 65], s[7 * 65]);
        *(v4u*)(dst + (long)n * ldd + 8 * c) = o; }
    LDS_WAIT(); asm volatile("" ::: "memory");
}
__device__ __forceinline__ void tr_matrix(const float* W, int K, int N, int NP, bf16* WT, LAS float* scr, int gw, int NGW, int lane) {
    const int nblk = NP / 64, nitems = (K / 64) * nblk;
    for (int it = gw; it < nitems; it += NGW) { const int kb = it / nblk, nb = it % nblk, k0 = 64 * kb, n0 = 64 * nb; int nvalid = N - n0; nvalid = nvalid < 0 ? 0 : (nvalid > 64 ? 64 : nvalid);
        tr_item64(W + (long)k0 * N + n0, N, nvalid, WT + (long)n0 * K + k0, K, scr, lane); }
}
__device__ __forceinline__ void tr_matrix_item(const float* W, int K, int N, int NP, bf16* WT, LAS float* scr, int it, int lane) {
    const int nblk = NP / 64, kb = it / nblk, nb = it % nblk, k0 = 64 * kb, n0 = 64 * nb; int nvalid = N - n0; nvalid = nvalid < 0 ? 0 : (nvalid > 64 ? 64 : nvalid);
    tr_item64(W + (long)k0 * N + n0, N, nvalid, WT + (long)n0 * K + k0, K, scr, lane);
}
__device__ __forceinline__ void cvt_rows(const float* src, bf16* dst, long n, long gtid, long gsz) {
    long i = gtid * 8;
    for (; i + 3 * gsz * 8 < n; i += 4 * gsz * 8) {
        f32x4 a[4], b[4];
#pragma unroll
        for (int u = 0; u < 4; ++u) { a[u] = *(const f32x4*)(src + i + u * gsz * 8); b[u] = *(const f32x4*)(src + i + u * gsz * 8 + 4); }
#pragma unroll
        for (int u = 0; u < 4; ++u) { v4u o; o.x = pk2(a[u].x, a[u].y); o.y = pk2(a[u].z, a[u].w); o.z = pk2(b[u].x, b[u].y); o.w = pk2(b[u].z, b[u].w); *(v4u*)(dst + i + u * gsz * 8) = o; } }
    for (; i < n; i += gsz * 8) { const f32x4 a = *(const f32x4*)(src + i), b = *(const f32x4*)(src + i + 4);
        v4u o; o.x = pk2(a.x, a.y); o.y = pk2(a.z, a.w); o.z = pk2(b.x, b.y); o.w = pk2(b.z, b.w); *(v4u*)(dst + i) = o; }
}
__device__ __forceinline__ int sopaque(int v) { asm volatile("" : "+s"(v)); return v; }
__device__ __forceinline__ float wave_sum(float v) {
#define WS_STEP(o) v += __builtin_bit_cast(float, __builtin_amdgcn_ds_swizzle(__builtin_bit_cast(int, v), 0x1f | ((o) << 10)))
    WS_STEP(1); WS_STEP(2); WS_STEP(4); WS_STEP(8); WS_STEP(16);
#undef WS_STEP
    return __builtin_bit_cast(float, __builtin_amdgcn_readlane(__builtin_bit_cast(int, v), 0)) + __builtin_bit_cast(float, __builtin_amdgcn_readlane(__builtin_bit_cast(int, v), 32));
}
#ifndef DBG_SCALE
#define DBG_SCALE 20.0f
#endif
constexpr int MOE_MAXBLK = 640;
constexpr int CW_CNT = 8192, CW_CUR = 8192 + 128;
namespace pg8 {
struct MoeOrder {
    const int* blk_e; int nblk, npn, G, c;
    __device__ __forceinline__ bool next(int i, Unit& u) const {
        const long L = (long)i * G + c; if (L >= (long)nblk * npn) return false;
        const int blk = (int)(L / npn); u.pm = blk; u.pn = (int)(L % npn); u.e = __builtin_amdgcn_readfirstlane(blk_e[blk]); u.aux = 0; return true;
    }
};
__device__ __forceinline__ float silu_f(float x) { return x / (1.0f + __expf(-x)); }
struct EpiSwiGLU {
    static constexpr int NPRE = 0; __device__ __forceinline__ void load_pre(const Unit&, int, int, int (&)[1]) const {}
    static constexpr bool PERM = true;
    bf16_t* H;
    __device__ __forceinline__ void operator()(const f32x4 (&acc)[2][2][4][2], const Unit& u, int wr, int wc, int fr, int fq) const {
        const int row0 = u.pm * BM + wr * 64 + fr, col0 = u.pn * 128 + wc * 32 + 8 * fq;
#pragma unroll
        for (int ai = 0; ai < 2; ++ai)
#pragma unroll
            for (int m = 0; m < 4; ++m) { bf16_t* rowp = H + (size_t)(row0 + ai * HALF + m * 16) * 256 + col0;
                const f32x4 g0 = acc[ai][0][m][0], g1 = acc[ai][0][m][1], u0 = acc[ai][1][m][0], u1 = acc[ai][1][m][1];
                u32x4 w; w.x = cvt_pk_bf16(silu_f(g0[0]) * u0[0], silu_f(g0[1]) * u0[1]); w.y = cvt_pk_bf16(silu_f(g0[2]) * u0[2], silu_f(g0[3]) * u0[3]);
                w.z = cvt_pk_bf16(silu_f(g1[0]) * u1[0], silu_f(g1[1]) * u1[1]); w.w = cvt_pk_bf16(silu_f(g1[2]) * u1[2], silu_f(g1[3]) * u1[3]);
                *(u32x4*)rowp = w; }
    }
};
struct EpiDown {
    static constexpr bool PERM = true; static constexpr int NPRE = 1;
    bf16_t* rows8; bf16_t* rows_sh; const int* dest; int nslot8;
    __device__ __forceinline__ void prefetch(const Unit& u, int slot, PG8_LAS unsigned char* lds, int wid, int lane) const {
        if (wid < 4) __builtin_amdgcn_global_load_lds((const unsigned*)(dest + u.pm * BM + wid * 64 + lane), (PG8_LAS unsigned*)(lds + STAGE_BYTES + slot * 1024 + wid * 256), 4, 0, 0);
    }
    __device__ __forceinline__ void operator()(const f32x4 (&acc)[2][2][4][2], const Unit& u, int wr, int wc, int fr, int fq, int slot, PG8_LAS unsigned char* lds) const {
        const int col0 = u.pn * BM + wc * 32 + 8 * fq; const PG8_LAS int* dl = (const PG8_LAS int*)(lds + STAGE_BYTES + slot * 1024) + wr * 64 + fr;
#pragma unroll
        for (int ai = 0; ai < 2; ++ai)
#pragma unroll
            for (int m = 0; m < 4; ++m) { const int d = dl[ai * HALF + m * 16];
                if (d >= 0) { bf16_t* rowp = (d < nslot8 ? rows8 + (size_t)d * 1024 : rows_sh + (size_t)(d - nslot8) * 1024) + col0;
#pragma unroll
                    for (int bj = 0; bj < 2; ++bj) { const f32x4 v0 = acc[ai][bj][m][0], v1 = acc[ai][bj][m][1];
                        u32x4 o; o.x = cvt_pk_bf16(v0[0], v0[1]); o.y = cvt_pk_bf16(v0[2], v0[3]); o.z = cvt_pk_bf16(v1[0], v1[1]); o.w = cvt_pk_bf16(v1[2], v1[3]);
#if defined(NT_STORES)
                        __builtin_nontemporal_store(o, (u32x4*)(rowp + bj * HALF));
#else
                        *(u32x4*)(rowp + bj * HALF) = o;
#endif
                        } } }
    }
};
}
__device__ __forceinline__ void moe_convert_weights(const float* wg, const float* wu, const float* wd, const float* sg, const float* su, const float* sd,
                                                    bf16* WGU, bf16* WD, LAS float* scr, int first, int last, int stride, int lane) {
    for (int it = first; it < last; it += stride) {
        const int e = it / 192, r = it % 192, kind = r >> 6, q = r & 63;
        if (kind < 2) { const float* W = (e < 64 ? (kind == 0 ? wg : wu) + (size_t)e * 262144 : (kind == 0 ? sg : su));
            const int kb = q >> 2, nb = q & 3, k0 = 64 * kb, n0 = 64 * nb;
            tr_item64(W + (size_t)k0 * 256 + n0, 256, 64, WGU + ((size_t)e * 512 + (n0 >> 7) * 256 + (n0 & 127) + kind * 128) * 1024 + k0, 1024, scr, lane);
        } else { const float* W = e < 64 ? wd + (size_t)e * 262144 : sd;
            const int kb = q >> 4, nb = q & 15, k0 = 64 * kb, n0 = 64 * nb;
            tr_item64(W + (size_t)k0 * 1024 + n0, 1024, 64, WD + ((size_t)e * 1024 + n0) * 256 + k0, 256, scr, lane); }
    }
}
struct MoeLists { int* tok; int* dest; float* w; int* blk_e; };
__device__ __forceinline__ void moe_count(const int* ridx, unsigned* cnt, LAS unsigned* hist, int tid, int bid, int G) {
    if (tid < 64) hist[tid] = 0u;
    __syncthreads();
    for (int i = bid * NTHREADS + tid; i < T_ * 8; i += G * NTHREADS) atomicAdd((unsigned*)&hist[ridx[i]], 1u);
    __syncthreads();
    if (tid < 64 && hist[tid]) atomicAdd(&cnt[tid], hist[tid]);
    __syncthreads();
}
__device__ __forceinline__ void moe_build_lists(const int* ridx, const float* rwt, const unsigned* cnt, unsigned* cur, const MoeLists L, LAS int* sm, int tid, int bid, int G) {
    LAS int* pstart = sm; LAS unsigned* hist = (LAS unsigned*)(sm + 80); LAS unsigned* base = (LAS unsigned*)(sm + 160);
    if (tid == 0) { int acc = 0;
#pragma unroll 1
        for (int e = 0; e < 64; ++e) { pstart[e] = acc; acc += ((int)__hip_atomic_load(&cnt[e], __ATOMIC_RELAXED, __HIP_MEMORY_SCOPE_AGENT) + 255) & ~255; } pstart[64] = acc; pstart[65] = acc + T_; }
    __syncthreads();
    const int per = (T_ * 8 + G - 1) / G;
    const int lo = bid * per, hi = (lo + per < T_ * 8) ? lo + per : T_ * 8;
    for (int c0 = lo; c0 < hi; c0 += NTHREADS) {
        if (tid < 64) hist[tid] = 0u;
        __syncthreads();
        const int i = c0 + tid; int e = 0; unsigned local = 0u;
        if (i < hi) { e = ridx[i]; local = atomicAdd((unsigned*)&hist[e], 1u); }
        __syncthreads();
        if (tid < 64) base[tid] = hist[tid] ? atomicAdd(&cur[tid], hist[tid]) : 0u;
        __syncthreads();
        if (i < hi) { const int pos = pstart[e] + (int)base[e] + (int)local; L.tok[pos] = i >> 3; L.dest[pos] = i; L.w[pos] = rwt[i]; }
        __syncthreads();
    }
    for (int e = bid; e < 64; e += G) { const int c = (int)__hip_atomic_load(&cnt[e], __ATOMIC_RELAXED, __HIP_MEMORY_SCOPE_AGENT);
        for (int p = pstart[e] + c + tid; p < pstart[e + 1]; p += NTHREADS) { L.tok[p] = 0; L.dest[p] = -1; L.w[p] = 0.f; } }
    for (int t = bid * NTHREADS + tid; t < T_; t += G * NTHREADS) { const int p = pstart[64] + t; L.tok[p] = t; L.dest[p] = T_ * 8 + t; L.w[p] = 1.f; }
    const int nblk = pstart[65] >> 8;
    for (int b = bid * NTHREADS + tid; b < nblk; b += G * NTHREADS) { int e = 0;
#pragma unroll 1
        while (e < 64 && (pstart[e + 1] >> 8) <= b) ++e;
        L.blk_e[b] = e; }
    if (bid == 0 && tid == 0) L.blk_e[MOE_MAXBLK] = nblk;
    __syncthreads();
}
__device__ __forceinline__ void moe_combine_ln(float* h, const bf16* rows8, const bf16* rows_sh, const float* rwt, const float* lw, const float* lb, bf16* hbf, int gw, int NGW, int lane) {
    int t = gw; if (t >= T_) return;
    v4u rr[2][9]; f32x4 hh[4]; float wk[8];
#define CB_LOAD(tt) do { const size_t _t = (size_t)(tt); \
        _Pragma("unroll") for (int half = 0; half < 2; ++half) { const int c0 = half * 512 + lane * 8; \
            hh[half * 2] = *(const f32x4*)(h + _t * 1024 + c0); hh[half * 2 + 1] = *(const f32x4*)(h + _t * 1024 + c0 + 4); \
            _Pragma("unroll") for (int k = 0; k < 9; ++k) rr[half][k] = *(const v4u*)((k < 8 ? rows8 + (_t * 8 + k) * 1024 : rows_sh + _t * 1024) + c0); } \
        _Pragma("unroll") for (int k = 0; k < 8; ++k) wk[k] = rwt[_t * 8 + k]; } while (0)
    CB_LOAD(t);
    for (; t < T_; t += NGW) {
        float v[16];
#pragma unroll
        for (int half = 0; half < 2; ++half) { const f32x4 a = hh[half * 2], b = hh[half * 2 + 1];
            float s[8] = {a.x * nv::ALPHA, a.y * nv::ALPHA, a.z * nv::ALPHA, a.w * nv::ALPHA, b.x * nv::ALPHA, b.y * nv::ALPHA, b.z * nv::ALPHA, b.w * nv::ALPHA};
#pragma unroll
            for (int k = 0; k < 9; ++k) { const v4u r = rr[half][k]; const float w = k < 8 ? wk[k] : 1.0f;
                s[0] += w * __builtin_bit_cast(float, r.x << 16); s[1] += w * __builtin_bit_cast(float, r.x & 0xffff0000u);
                s[2] += w * __builtin_bit_cast(float, r.y << 16); s[3] += w * __builtin_bit_cast(float, r.y & 0xffff0000u);
                s[4] += w * __builtin_bit_cast(float, r.z << 16); s[5] += w * __builtin_bit_cast(float, r.z & 0xffff0000u);
                s[6] += w * __builtin_bit_cast(float, r.w << 16); s[7] += w * __builtin_bit_cast(float, r.w & 0xffff0000u); }
#pragma unroll
            for (int j = 0; j < 8; ++j) v[half * 8 + j] = s[j]; }
        if (t + NGW < T_) CB_LOAD(t + NGW);
        float sum = 0.f;
#pragma unroll
        for (int j = 0; j < 16; ++j) sum += v[j];
        sum = wave_sum(sum);
        const float mean = sum * (1.f / 1024.f);
        float sq = 0.f;
#pragma unroll
        for (int j = 0; j < 16; ++j) { v[j] -= mean; sq += v[j] * v[j]; }
        sq = wave_sum(sq);
        const float rstd = 1.0f / sqrtf(sq * (1.f / 1024.f) + nv::EPS);
#pragma unroll
        for (int half = 0; half < 2; ++half) { const int c0 = half * 512 + lane * 8;
            const f32x4 w0 = *(const f32x4*)(lw + c0), w1 = *(const f32x4*)(lw + c0 + 4), b0 = *(const f32x4*)(lb + c0), b1 = *(const f32x4*)(lb + c0 + 4);
            f32x4 o0, o1;
            o0.x = v[half * 8 + 0] * rstd * w0.x + b0.x; o0.y = v[half * 8 + 1] * rstd * w0.y + b0.y; o0.z = v[half * 8 + 2] * rstd * w0.z + b0.z; o0.w = v[half * 8 + 3] * rstd * w0.w + b0.w;
            o1.x = v[half * 8 + 4] * rstd * w1.x + b1.x; o1.y = v[half * 8 + 5] * rstd * w1.y + b1.y; o1.z = v[half * 8 + 6] * rstd * w1.z + b1.z; o1.w = v[half * 8 + 7] * rstd * w1.w + b1.w;
            *(f32x4*)(h + (size_t)t * 1024 + c0) = o0; *(f32x4*)(h + (size_t)t * 1024 + c0 + 4) = o1;
            if (hbf) { v4u p; p.x = pk2(o0.x, o0.y); p.y = pk2(o0.z, o0.w); p.z = pk2(o1.x, o1.y); p.w = pk2(o1.z, o1.w); *(v4u*)(hbf + (size_t)t * 1024 + c0) = p; } }
    }
#undef CB_LOAD
}
typedef float f32x16 __attribute__((ext_vector_type(16)));
typedef short s16x8 __attribute__((ext_vector_type(8)));
typedef LAS unsigned short lbf16;
__device__ __forceinline__ void mm32(f32x16& acc, const lbf16* A, int lda, const lbf16* B, int ldb, int K, int lane) {
    const lbf16* ap = A + (lane & 31) * lda + 8 * (lane >> 5);
    const lbf16* bp = B + (lane & 31) * ldb + 8 * (lane >> 5);
#pragma unroll 4
    for (int k = 0; k < K; k += 16) {
        const s16x8 a = *(const LAS s16x8*)(ap + k), b = *(const LAS s16x8*)(bp + k);
        acc = __builtin_amdgcn_mfma_f32_32x32x16_bf16(a, b, acc, 0, 0, 0);
    }
}
__device__ __forceinline__ void mm32_gb(f32x16& acc, const lbf16* A, int lda, const bf16* B, int ldb, int K, int lane) {
    const lbf16* ap = A + (lane & 31) * lda + 8 * (lane >> 5);
    const bf16* bp = B + (size_t)(lane & 31) * ldb + 8 * (lane >> 5);
#pragma unroll 4
    for (int k = 0; k < K; k += 16) {
        const s16x8 a = *(const LAS s16x8*)(ap + k), b = *(const s16x8*)(bp + k);
        acc = __builtin_amdgcn_mfma_f32_32x32x16_bf16(a, b, acc, 0, 0, 0);
    }
}
__device__ __forceinline__ int rowmap(int r, int lane) { return (r & 3) + 8 * (r >> 2) + 4 * (lane >> 5); }
__device__ __forceinline__ float sigm_f(float x) { return 1.0f / (1.0f + __expf(-x)); }
__device__ __forceinline__ float logsig_f(float x) { return fminf(x, 0.f) - log1pf(__expf(-fabsf(x))); }
__device__ __forceinline__ float softplus_f(float x) { return fmaxf(x, 0.f) + log1pf(__expf(-fabsf(x))); }
__device__ __forceinline__ float gelu_f(float x) { const float u = 0.7978845608028654f * (x + 0.044715f * x * x * x); return x / (1.0f + __expf(-2.0f * u)); }
__device__ __forceinline__ void unpack8(const v4u r, float (&f)[8]) {
    f[0] = __builtin_bit_cast(float, r.x << 16); f[1] = __builtin_bit_cast(float, r.x & 0xffff0000u); f[2] = __builtin_bit_cast(float, r.y << 16); f[3] = __builtin_bit_cast(float, r.y & 0xffff0000u);
    f[4] = __builtin_bit_cast(float, r.z << 16); f[5] = __builtin_bit_cast(float, r.z & 0xffff0000u); f[6] = __builtin_bit_cast(float, r.w << 16); f[7] = __builtin_bit_cast(float, r.w & 0xffff0000u);
}
__device__ __forceinline__ v4u pack8(const float (&f)[8]) { v4u o; o.x = pk2(f[0], f[1]); o.y = pk2(f[2], f[3]); o.z = pk2(f[4], f[5]); o.w = pk2(f[6], f[7]); return o; }

struct Mix0Bufs { const bf16* proj; bf16* ct; float* nloc; float* blast; float* mloc; float* mprev; float* hloc; float* pc; float* carA; float* carU; float* carI; bf16* mixbf; const bf16* lruw; };
constexpr int PJ0 = EINP;

__device__ __forceinline__ void mlstm_a_item(const Mix0Bufs& B, const float* gate_b, int cn, LAS unsigned char* lds, int tid) {
    const int lane = tid & 63, wave = __builtin_amdgcn_readfirstlane(tid >> 6);
    const int bh = cn / NCH, n = cn % NCH, b = bh >> 2, h = bh & 3;
    const size_t t0 = (size_t)b * S_ + n * 64;
    LAS float* lf = (LAS float*)lds; LAS float* wl = lf + 64; LAS float* pw = lf + 128; LAS float* misc = lf + 192;
    lbf16* kT = (lbf16*)(lds + 1024); lbf16* vT = (lbf16*)(lds + 1024 + 128 * 72 * 2);
    if (tid < 64) { const bf16* pr = B.proj + (t0 + tid) * PJ0;
        lf[tid] = logsig_f(bf2f(pr[2052 + h]) + gate_b[4 + h]); pw[tid] = bf2f(pr[2048 + h]) + gate_b[h]; }
    __syncthreads();
    if (tid < 64) { float acc = 0.f; for (int j = 0; j < 64; ++j) { const float x = lf[j]; acc += (j <= tid) ? x : 0.f; } wl[tid] = pw[tid] - acc; if (tid == 63) misc[0] = acc; }
    __syncthreads();
    float mx = -INFINITY;
    for (int j = 0; j < 64; ++j) mx = fmaxf(mx, wl[j]);
    const float blast = misc[0];
    __syncthreads();
    if (tid < 64) pw[tid] = __expf(wl[tid] - mx) * 0.08838834764831845f;
    __syncthreads();
#pragma unroll
    for (int it = 0; it < 2; ++it) { const int vi = tid + it * 512, l = vi & 63, g = vi >> 6;
        const bf16* pr = B.proj + (t0 + l) * PJ0 + h * 128 + g * 8;
        float kf[8], vf[8]; unpack8(*(const v4u*)(pr + 512), kf); unpack8(*(const v4u*)(pr + 1024), vf);
        const float p = pw[l];
#pragma unroll
        for (int j = 0; j < 8; ++j) { kT[(g * 8 + j) * 72 + l] = (unsigned short)f2bf(kf[j] * p); vT[(g * 8 + j) * 72 + l] = (unsigned short)f2bf(vf[j]); } }
    __syncthreads();
    const int et = wave >> 1;
#pragma unroll
    for (int q = 0; q < 2; ++q) { const int dt = (wave & 1) * 2 + q;
        f32x16 acc = {0.f, 0.f, 0.f, 0.f, 0.f, 0.f, 0.f, 0.f, 0.f, 0.f, 0.f, 0.f, 0.f, 0.f, 0.f, 0.f};
        mm32(acc, vT + et * 32 * 72, 72, kT + dt * 32 * 72, 72, 64, lane);
        bf16* out = B.ct + (size_t)cn * 16384 + dt * 32 + (lane & 31);
#pragma unroll
        for (int r = 0; r < 16; ++r) out[(size_t)(et * 32 + rowmap(r, lane)) * 128] = (unsigned short)f2bf(acc[r]); }
    if (tid < 128) { float s = 0.f; for (int l = 0; l < 64; ++l) s += bf2f(kT[tid * 72 + l]); B.nloc[(size_t)cn * 128 + tid] = s; }
    if (tid == 0) { B.blast[cn] = blast; B.mloc[cn] = blast + mx; }
    __syncthreads();
}
__device__ __forceinline__ void mlstm_b(const Mix0Bufs& B, int gtid, int gsz) {
    for (int idx = gtid; idx < 8 * 8192 + 8 * 128; idx += gsz) {
        const bool isn = idx >= 8 * 8192;
        if (!isn) { const int bh = idx >> 13, pe = idx & 8191;
            float s0 = 0.f, s1 = 0.f, m = 0.f; unsigned* p = (unsigned*)B.ct + (size_t)bh * NCH * 8192 + pe;
            for (int n0 = 0; n0 < NCH; n0 += 16) { unsigned cl[16]; float bl[16], ml[16];
#pragma unroll
                for (int j = 0; j < 16; ++j) { cl[j] = p[(size_t)(n0 + j) * 8192]; bl[j] = B.blast[bh * NCH + n0 + j]; ml[j] = B.mloc[bh * NCH + n0 + j]; }
#pragma unroll
                for (int j = 0; j < 16; ++j) { const unsigned out = pk2(s0, s1); const float mn = fmaxf(bl[j] + m, ml[j]), kf = __expf(bl[j] + m - mn), af = __expf(ml[j] - mn);
                    s0 = kf * s0 + af * __builtin_bit_cast(float, cl[j] << 16); s1 = kf * s1 + af * __builtin_bit_cast(float, cl[j] & 0xffff0000u);
                    if (pe == 0) B.mprev[bh * NCH + n0 + j] = m;
                    m = mn; cl[j] = out; }
#pragma unroll
                for (int j = 0; j < 16; ++j) p[(size_t)(n0 + j) * 8192] = cl[j]; }
        } else { const int r = idx - 8 * 8192, bh = r >> 7, de = r & 127;
            float st = 0.f, m = 0.f; float* p = B.nloc + (size_t)bh * NCH * 128 + de;
            for (int n0 = 0; n0 < NCH; n0 += 16) { float cl[16], bl[16], ml[16];
#pragma unroll
                for (int j = 0; j < 16; ++j) { cl[j] = p[(size_t)(n0 + j) * 128]; bl[j] = B.blast[bh * NCH + n0 + j]; ml[j] = B.mloc[bh * NCH + n0 + j]; }
#pragma unroll
                for (int j = 0; j < 16; ++j) { const float out = st; const float mn = fmaxf(bl[j] + m, ml[j]);
                    st = __expf(bl[j] + m - mn) * st + __expf(ml[j] - mn) * cl[j]; m = mn; cl[j] = out; }
#pragma unroll
                for (int j = 0; j < 16; ++j) p[(size_t)(n0 + j) * 128] = cl[j]; } }
    }
}
__device__ __forceinline__ void mlstm_c_item(const Mix0Bufs& B, const float* gate_b, const float* norm_w, int cn, LAS unsigned char* lds, int tid) {
    const int lane = tid & 63, wave = __builtin_amdgcn_readfirstlane(tid >> 6);
    const int bh = cn / NCH, n = cn % NCH, b = bh >> 2, h = bh & 3;
    const size_t t0 = (size_t)b * S_ + n * 64;
    LAS float* bc = (LAS float*)lds; LAS float* wl = bc + 64; LAS float* mi = bc + 128; LAS float* win = bc + 192; LAS float* den = bc + 256; LAS float* emi = bc + 320; LAS float* lf = bc + 384; LAS float* ig = bc + 448;
    lbf16* qs = (lbf16*)(lds + 2048); lbf16* ks = (lbf16*)(lds + 19456); lbf16* qw = (lbf16*)(lds + 36864);
    lbf16* vT = (lbf16*)(lds + 54272); lbf16* cT = (lbf16*)(lds + 77312); lbf16* sm = (lbf16*)(lds + 120832);
    LAS float* hb = (LAS float*)(lds + 2048);
    const float mprev = B.mprev[cn];
    v4u gq[2], gk[2], gv[2], go[2], gc[4];
#pragma unroll
    for (int it = 0; it < 2; ++it) { const int vi = tid + it * 512; { const int l = vi >> 4, g = vi & 15; const bf16* pr = B.proj + (t0 + l) * PJ0 + h * 128 + g * 8; gq[it] = *(const v4u*)pr; gk[it] = *(const v4u*)(pr + 512); }
        { const int l = vi & 63, g = vi >> 6; gv[it] = *(const v4u*)(B.proj + (t0 + l) * PJ0 + 1024 + h * 128 + g * 8); } }
    { const bf16* cg = B.ct + (size_t)cn * 16384;
#pragma unroll
      for (int it = 0; it < 4; ++it) { const int vi = tid + it * 512, e = vi >> 4, g = vi & 15; gc[it] = *(const v4u*)(cg + e * 128 + g * 8); } }
    { const int i = tid >> 3, sub = tid & 7; const bf16* op = B.proj + (t0 + i) * PJ0 + 1536 + h * 128 + sub * 16; go[0] = *(const v4u*)op; go[1] = *(const v4u*)(op + 8); }
    const float gnl = tid < 128 ? B.nloc[(size_t)cn * 128 + tid] : 0.f;
    if (tid < 64) { const bf16* pr = B.proj + (t0 + tid) * PJ0;
        lf[tid] = logsig_f(bf2f(pr[2052 + h]) + gate_b[4 + h]); ig[tid] = bf2f(pr[2048 + h]) + gate_b[h]; }
    __syncthreads();
    if (tid < 64) { float acc = 0.f; for (int j = 0; j < 64; ++j) { const float x = lf[j]; acc += (j <= tid) ? x : 0.f; } bc[tid] = acc; wl[tid] = ig[tid] - acc; }
    __syncthreads();
    if (tid < 64) { float pm = -INFINITY; for (int j = 0; j < 64; ++j) { const float x = wl[j]; pm = (j <= tid) ? fmaxf(pm, x) : pm; }
        const float bi = bc[tid], m = bi + fmaxf(mprev, pm); mi[tid] = m; win[tid] = __expf(bi + mprev - m); emi[tid] = __expf(-m); }
    __syncthreads();
#pragma unroll
    for (int it = 0; it < 2; ++it) { const int vi = tid + it * 512, l = vi >> 4, g = vi & 15;
        float qf[8], kf[8]; unpack8(gq[it], qf); unpack8(gk[it], kf);
        const float w = win[l]; float qwf[8];
#pragma unroll
        for (int j = 0; j < 8; ++j) { kf[j] *= 0.08838834764831845f; qwf[j] = qf[j] * w; }
        *(LAS v4u*)(qs + l * 136 + g * 8) = gq[it]; *(LAS v4u*)(ks + l * 136 + g * 8) = pack8(kf); *(LAS v4u*)(qw + l * 136 + g * 8) = pack8(qwf); }
#pragma unroll
    for (int it = 0; it < 2; ++it) { const int vi = tid + it * 512, l = vi & 63, g = vi >> 6;
        float vf[8]; unpack8(gv[it], vf);
#pragma unroll
        for (int j = 0; j < 8; ++j) vT[(g * 8 + j) * 72 + l] = (unsigned short)f2bf(vf[j]); }
    for (int i = tid; i < 32 * 72; i += 512) { const int r = i / 72, c = i % 72; vT[(128 + r) * 72 + c] = (r == 0 && c < 64) ? (unsigned short)0x3f80 : (unsigned short)0; }
#pragma unroll
    for (int it = 0; it < 4; ++it) { const int vi = tid + it * 512, e = vi >> 4, g = vi & 15; *(LAS v4u*)(cT + e * 136 + g * 8) = gc[it]; }
    for (int i = tid; i < 32 * 136; i += 512) { const int r = i / 136, c = i % 136; if (r > 0 || c >= 128) cT[(128 + r) * 136 + c] = (unsigned short)0; }
    if (tid < 128) cT[128 * 136 + tid] = (unsigned short)f2bf(gnl);
    __syncthreads();
    if (wave < 4) { const int it = wave >> 1, jt = wave & 1;
        f32x16 acc = {0.f, 0.f, 0.f, 0.f, 0.f, 0.f, 0.f, 0.f, 0.f, 0.f, 0.f, 0.f, 0.f, 0.f, 0.f, 0.f};
        if (jt <= it) mm32(acc, qs + it * 32 * 136, 136, ks + jt * 32 * 136, 136, 128, lane);
        const int j = jt * 32 + (lane & 31); const float wj = wl[j];
#pragma unroll
        for (int r = 0; r < 16; ++r) { const int i = it * 32 + rowmap(r, lane);
            const float v = (j <= i) ? acc[r] * __expf(bc[i] - mi[i] + wj) : 0.f; sm[i * 72 + j] = (unsigned short)f2bf(v); } }
    __syncthreads();
    f32x16 accA = {0.f, 0.f, 0.f, 0.f, 0.f, 0.f, 0.f, 0.f, 0.f, 0.f, 0.f, 0.f, 0.f, 0.f, 0.f, 0.f}, accB = accA;
    { const int id = wave, it = id / 5, nt = id % 5;
      mm32(accA, sm + it * 32 * 72, 72, vT + nt * 32 * 72, 72, 64, lane); mm32(accA, qw + it * 32 * 136, 136, cT + nt * 32 * 136, 136, 128, lane);
      if (nt == 4 && (lane & 31) == 0) {
#pragma unroll
          for (int r = 0; r < 16; ++r) den[it * 32 + rowmap(r, lane)] = accA[r]; } }
    if (wave < 2) { const int id = wave + 8, it = id / 5, nt = id % 5;
      mm32(accB, sm + it * 32 * 72, 72, vT + nt * 32 * 72, 72, 64, lane); mm32(accB, qw + it * 32 * 136, 136, cT + nt * 32 * 136, 136, 128, lane);
      if (nt == 4 && (lane & 31) == 0) {
#pragma unroll
          for (int r = 0; r < 16; ++r) den[it * 32 + rowmap(r, lane)] = accB[r]; } }
    __syncthreads();
    { const int id = wave, it = id / 5, nt = id % 5;
      if (nt < 4) {
#pragma unroll
          for (int r = 0; r < 16; ++r) { const int i = it * 32 + rowmap(r, lane); hb[i * 132 + nt * 32 + (lane & 31)] = accA[r] / fmaxf(fabsf(den[i]), emi[i]); } } }
    if (wave < 2) { const int id = wave + 8, it = id / 5, nt = id % 5;
      if (nt < 4) {
#pragma unroll
          for (int r = 0; r < 16; ++r) { const int i = it * 32 + rowmap(r, lane); hb[i * 132 + nt * 32 + (lane & 31)] = accB[r] / fmaxf(fabsf(den[i]), emi[i]); } } }
    __syncthreads();
    { const int i = tid >> 3, sub = tid & 7; const LAS float* hr = hb + i * 132 + sub * 16;
      float x[16]; float s = 0.f;
#pragma unroll
      for (int j = 0; j < 16; ++j) { x[j] = hr[j]; s += x[j]; }
      s += __builtin_bit_cast(float, __builtin_amdgcn_ds_swizzle(__builtin_bit_cast(int, s), 0x1f | (1 << 10)));
      s += __builtin_bit_cast(float, __builtin_amdgcn_ds_swizzle(__builtin_bit_cast(int, s), 0x1f | (2 << 10)));
      s += __builtin_bit_cast(float, __builtin_amdgcn_ds_swizzle(__builtin_bit_cast(int, s), 0x1f | (4 << 10)));
      const float mean = s * (1.f / 128.f); float q = 0.f;
#pragma unroll
      for (int j = 0; j < 16; ++j) { x[j] -= mean; q += x[j] * x[j]; }
      q += __builtin_bit_cast(float, __builtin_amdgcn_ds_swizzle(__builtin_bit_cast(int, q), 0x1f | (1 << 10)));
      q += __builtin_bit_cast(float, __builtin_amdgcn_ds_swizzle(__builtin_bit_cast(int, q), 0x1f | (2 << 10)));
      q += __builtin_bit_cast(float, __builtin_amdgcn_ds_swizzle(__builtin_bit_cast(int, q), 0x1f | (4 << 10)));
      const float rstd = 1.0f / sqrtf(q * (1.f / 128.f) + nv::EPS);
      const float* nw = norm_w + h * 128 + sub * 16;
      float o0[8], o1[8]; unpack8(go[0], o0); unpack8(go[1], o1);
      float y0[8], y1[8];
#pragma unroll
      for (int j = 0; j < 8; ++j) { y0[j] = x[j] * rstd * nw[j] * sigm_f(o0[j]); y1[j] = x[8 + j] * rstd * nw[8 + j] * sigm_f(o1[j]); }
      bf16* dst = B.mixbf + (t0 + i) * 1024 + h * 128 + sub * 16;
      *(v4u*)dst = pack8(y0); *(v4u*)(dst + 8) = pack8(y1); }
    __syncthreads();
}
__device__ __forceinline__ void lru_a_item(const Mix0Bufs& B, const float* const* in, int ch, LAS unsigned char* lds, int tid) {
    const int lane = tid & 63, wave = __builtin_amdgcn_readfirstlane(tid >> 6);
    const size_t t0 = (size_t)ch * 64; const int s0 = (ch % NCH) * 64;
    lbf16* xc = (lbf16*)lds; LAS float* al = (LAS float*)(lds + 17408); LAS float* ul = (LAS float*)(lds + 17408 + 32768);
    const float* cw = in[9]; const float* cb = in[10]; const float* ba = in[12]; const float* bx = in[14]; const float* lam = in[15];
    for (int hh = 0; hh < 4; ++hh) {
#pragma unroll
        for (int it = 0; it < 2; ++it) { const int vi = tid + it * 512, l = vi >> 4, g = vi & 15, c0 = hh * 128 + g * 8;
            float acc[8];
#pragma unroll
            for (int j = 0; j < 8; ++j) acc[j] = cb[c0 + j];
#pragma unroll
            for (int tap = 0; tap < 4; ++tap) { const int ls = s0 + l - 3 + tap;
                if (ls >= 0) { float xf[8]; unpack8(*(const v4u*)(B.proj + (t0 + l - 3 + tap) * PJ0 + 2056 + c0), xf);
#pragma unroll
                    for (int j = 0; j < 8; ++j) acc[j] += cw[tap * 512 + c0 + j] * xf[j]; } }
            *(LAS v4u*)(xc + l * 136 + g * 8) = pack8(acc);
#pragma unroll
            for (int j = 0; j < 8; ++j) ul[l * 128 + g * 8 + j] = acc[j]; }
        __syncthreads();
        { const int it = wave & 1, nt = wave >> 1;
          f32x16 ra = {0.f, 0.f, 0.f, 0.f, 0.f, 0.f, 0.f, 0.f, 0.f, 0.f, 0.f, 0.f, 0.f, 0.f, 0.f, 0.f}, xa = ra;
          mm32_gb(ra, xc + it * 32 * 136, 136, B.lruw + (size_t)(hh * 128 + nt * 32) * 128, 128, 128, lane);
          mm32_gb(xa, xc + it * 32 * 136, 136, B.lruw + (size_t)(512 + hh * 128 + nt * 32) * 128, 128, 128, lane);
          const int c = nt * 32 + (lane & 31), cg = hh * 128 + c; const float bav = ba[cg], bxv = bx[cg], sp = softplus_f(-lam[cg]);
#pragma unroll
          for (int r = 0; r < 16; ++r) { const int l = it * 32 + rowmap(r, lane);
              const float rr = sigm_f(ra[r] + bav), ii = sigm_f(xa[r] + bxv), la = -8.0f * rr * sp;
              const float xv = ul[l * 128 + c];
              al[l * 128 + c] = __expf(la); ul[l * 128 + c] = sqrtf(-expm1f(2.0f * la)) * ii * xv; } }
        __syncthreads();
        if (tid < 128) { float hst = 0.f, P = 1.f; float* hp = B.hloc + t0 * 512 + hh * 128 + tid; float* pp = B.pc + t0 * 512 + hh * 128 + tid;
            for (int l = 0; l < 64; ++l) { const float a = al[l * 128 + tid]; hst = a * hst + ul[l * 128 + tid]; P *= a; hp[(size_t)l * 512] = hst; pp[(size_t)l * 512] = P; }
            B.carA[(size_t)ch * 512 + hh * 128 + tid] = P; B.carU[(size_t)ch * 512 + hh * 128 + tid] = hst; }
        __syncthreads();
    }
}
__device__ __forceinline__ void lru_b(const Mix0Bufs& B, int gtid, int gsz) {
    for (int idx = gtid; idx < 2 * 512; idx += gsz) { const int b = idx >> 9, c = idx & 511; float hst = 0.f;
        for (int n0 = 0; n0 < NCH; n0 += 16) { float a[16], u[16];
#pragma unroll
            for (int j = 0; j < 16; ++j) { const size_t o = (size_t)(b * NCH + n0 + j) * 512 + c; a[j] = B.carA[o]; u[j] = B.carU[o]; }
#pragma unroll
            for (int j = 0; j < 16; ++j) { const float in = hst; hst = a[j] * hst + u[j]; a[j] = in; }
#pragma unroll
            for (int j = 0; j < 16; ++j) B.carI[(size_t)(b * NCH + n0 + j) * 512 + c] = a[j]; } }
}
__device__ __forceinline__ void lru_c(const Mix0Bufs& B, int gtid, int gsz) {
    for (int idx = gtid; idx < T_ * 64; idx += gsz) { const size_t t = idx >> 6; const int c0 = (idx & 63) * 8; const size_t ch = t >> 6;
        float gb[8], y[8]; unpack8(*(const v4u*)(B.proj + t * PJ0 + 2568 + c0), gb);
        const float* hp = B.hloc + t * 512 + c0; const float* pp = B.pc + t * 512 + c0; const float* ci = B.carI + ch * 512 + c0;
#pragma unroll
        for (int j = 0; j < 8; ++j) y[j] = (hp[j] + pp[j] * ci[j]) * gelu_f(gb[j]);
        *(v4u*)(B.mixbf + t * 1024 + 512 + c0) = pack8(y); }
}
constexpr int PJ1 = OINP;
struct Mix1Bufs { const bf16* proj; bf16* ut; float* gbl; bf16* s5g; float* xend; float* xstart; float* s5ab; float* s5bb; bf16* cm; bf16* bbt; bf16* mixbf; };
__device__ __forceinline__ void gla_gates(const bf16* proj, const float* gw, const float* gb, size_t t0, int h, LAS float* bc, LAS float* gl, int tid) {
    if (tid < 128) { const int l = tid >> 1, hf = tid & 1; float f[8]; unpack8(*(const v4u*)(proj + (t0 + l) * PJ1 + 2048 + hf * 8), f);
#pragma unroll
        for (int j = 0; j < 8; ++j) gl[l * 16 + hf * 8 + j] = f[j]; }
    __syncthreads();
    { const int d = tid & 63, lg = tid >> 6; float w[16];
#pragma unroll
      for (int r = 0; r < 16; ++r) w[r] = gw[r * 256 + h * 64 + d];
      const float bias = gb[h * 64 + d];
#pragma unroll
      for (int q = 0; q < 8; ++q) { const int l = lg * 8 + q; float acc = bias;
#pragma unroll
          for (int r = 0; r < 16; ++r) acc += gl[l * 16 + r] * w[r];
          bc[l * 64 + d] = logsig_f(acc) * 0.0625f; } }
    __syncthreads();
    if (tid < 64) { float acc = 0.f; for (int l = 0; l < 64; ++l) { acc += bc[l * 64 + tid]; bc[l * 64 + tid] = acc; } }
    __syncthreads();
}
__device__ __forceinline__ void gla_a_item(const Mix1Bufs& B, const float* gw, const float* gb, int cn, LAS unsigned char* lds, int tid) {
    const int lane = tid & 63, wave = __builtin_amdgcn_readfirstlane(tid >> 6);
    const int bh = cn / NCH, n = cn % NCH, b = bh >> 2, h = bh & 3;
    const size_t t0 = (size_t)b * S_ + n * 64;
    LAS float* bc = (LAS float*)lds; LAS float* gl = (LAS float*)(lds + 16384);
    lbf16* kT = (lbf16*)(lds + 20480); lbf16* vT = (lbf16*)(lds + 20480 + 64 * 72 * 2);
    gla_gates(B.proj, gw, gb, t0, h, bc, gl, tid);
    { const int l = tid & 63, g = tid >> 6; float kf[8]; unpack8(*(const v4u*)(B.proj + (t0 + l) * PJ1 + 768 + h * 64 + g * 8), kf);
#pragma unroll
      for (int j = 0; j < 8; ++j) { const int d = g * 8 + j; kT[d * 72 + l] = (unsigned short)f2bf(kf[j] * __expf(bc[63 * 64 + d] - bc[l * 64 + d])); } }
#pragma unroll
    for (int it = 0; it < 2; ++it) { const int vi = tid + it * 512, l = vi & 63, g = vi >> 6; float vf[8]; unpack8(*(const v4u*)(B.proj + (t0 + l) * PJ1 + 1024 + h * 128 + g * 8), vf);
#pragma unroll
        for (int j = 0; j < 8; ++j) vT[(g * 8 + j) * 72 + l] = (unsigned short)f2bf(vf[j]); }
    __syncthreads();
    { const int et = wave >> 1, dt = wave & 1;
      f32x16 acc = {0.f, 0.f, 0.f, 0.f, 0.f, 0.f, 0.f, 0.f, 0.f, 0.f, 0.f, 0.f, 0.f, 0.f, 0.f, 0.f};
      mm32(acc, vT + et * 32 * 72, 72, kT + dt * 32 * 72, 72, 64, lane);
      bf16* out = B.ut + (size_t)cn * 8192 + dt * 32 + (lane & 31);
#pragma unroll
      for (int r = 0; r < 16; ++r) out[(size_t)(et * 32 + rowmap(r, lane)) * 64] = (unsigned short)f2bf(acc[r]); }
    if (tid < 64) B.gbl[(size_t)cn * 64 + tid] = bc[63 * 64 + tid];
    __syncthreads();
}
__device__ __forceinline__ void gla_b(const Mix1Bufs& B, int gtid, int gsz) {
    for (int idx = gtid; idx < 8 * 4096; idx += gsz) { const int bh = idx >> 12, pe = idx & 4095, d = (pe * 2) & 63; float s0 = 0.f, s1 = 0.f;
        unsigned* p = (unsigned*)B.ut + (size_t)bh * NCH * 4096 + pe; const float* gp = B.gbl + (size_t)bh * NCH * 64 + d;
        for (int n0 = 0; n0 < NCH; n0 += 16) { unsigned u[16]; float g0[16], g1[16];
#pragma unroll
            for (int j = 0; j < 16; ++j) { u[j] = p[(size_t)(n0 + j) * 4096]; g0[j] = gp[(n0 + j) * 64]; g1[j] = gp[(n0 + j) * 64 + 1]; }
#pragma unroll
            for (int j = 0; j < 16; ++j) { const unsigned out = pk2(s0, s1);
                s0 = __expf(g0[j]) * s0 + __builtin_bit_cast(float, u[j] << 16); s1 = __expf(g1[j]) * s1 + __builtin_bit_cast(float, u[j] & 0xffff0000u); u[j] = out; }
#pragma unroll
            for (int j = 0; j < 16; ++j) p[(size_t)(n0 + j) * 4096] = u[j]; } }
}
__device__ __forceinline__ void gla_c_item(const Mix1Bufs& B, const float* gw, const float* gb, const float* norm_w, int cn, LAS unsigned char* lds, int tid) {
    const int lane = tid & 63, wave = __builtin_amdgcn_readfirstlane(tid >> 6);
    const int bh = cn / NCH, n = cn % NCH, b = bh >> 2, h = bh & 3;
    const size_t t0 = (size_t)b * S_ + n * 64;
    LAS float* bc = (LAS float*)lds; LAS float* gl = (LAS float*)(lds + 16384);
    lbf16* qd = (lbf16*)(lds + 20480); lbf16* ki = (lbf16*)(lds + 29696); lbf16* vT = (lbf16*)(lds + 38912); lbf16* sT = (lbf16*)(lds + 57344); lbf16* att = (lbf16*)(lds + 75776);
    LAS float* ob = (LAS float*)(lds + 84992);
    gla_gates(B.proj, gw, gb, t0, h, bc, gl, tid);
    { const int l = tid >> 3, g = tid & 7; const bf16* pr = B.proj + (t0 + l) * PJ1 + h * 64 + g * 8; float qf[8], kf[8]; unpack8(*(const v4u*)(pr + 512), qf); unpack8(*(const v4u*)(pr + 768), kf);
#pragma unroll
      for (int j = 0; j < 8; ++j) { const float bb = bc[l * 64 + g * 8 + j]; qf[j] *= 0.125f * __expf(bb); kf[j] *= __expf(-bb); }
      *(LAS v4u*)(qd + l * 72 + g * 8) = pack8(qf); *(LAS v4u*)(ki + l * 72 + g * 8) = pack8(kf); }
#pragma unroll
    for (int it = 0; it < 2; ++it) { const int vi = tid + it * 512, l = vi & 63, g = vi >> 6; float vf[8]; unpack8(*(const v4u*)(B.proj + (t0 + l) * PJ1 + 1024 + h * 128 + g * 8), vf);
#pragma unroll
        for (int j = 0; j < 8; ++j) vT[(g * 8 + j) * 72 + l] = (unsigned short)f2bf(vf[j]); }
    { const bf16* sg = B.ut + (size_t)cn * 8192;
#pragma unroll
      for (int it = 0; it < 2; ++it) { const int vi = tid + it * 512, e = vi >> 3, g = vi & 7; *(LAS v4u*)(sT + e * 72 + g * 8) = *(const v4u*)(sg + e * 64 + g * 8); } }
    __syncthreads();
    if (wave < 4) { const int it = wave >> 1, jt = wave & 1;
        f32x16 acc = {0.f, 0.f, 0.f, 0.f, 0.f, 0.f, 0.f, 0.f, 0.f, 0.f, 0.f, 0.f, 0.f, 0.f, 0.f, 0.f};
        if (jt <= it) mm32(acc, qd + it * 32 * 72, 72, ki + jt * 32 * 72, 72, 64, lane);
        const int j = jt * 32 + (lane & 31);
#pragma unroll
        for (int r = 0; r < 16; ++r) { const int i = it * 32 + rowmap(r, lane); att[i * 72 + j] = (unsigned short)f2bf(j <= i ? acc[r] : 0.f); } }
    __syncthreads();
    { const int it = wave >> 2, nt = wave & 3;
      f32x16 acc = {0.f, 0.f, 0.f, 0.f, 0.f, 0.f, 0.f, 0.f, 0.f, 0.f, 0.f, 0.f, 0.f, 0.f, 0.f, 0.f};
      mm32(acc, att + it * 32 * 72, 72, vT + nt * 32 * 72, 72, 64, lane); mm32(acc, qd + it * 32 * 72, 72, sT + nt * 32 * 72, 72, 64, lane);
#pragma unroll
      for (int r = 0; r < 16; ++r) ob[(it * 32 + rowmap(r, lane)) * 132 + nt * 32 + (lane & 31)] = acc[r]; }
    __syncthreads();
    { const int i = tid >> 3, sub = tid & 7; const LAS float* hr = ob + i * 132 + sub * 16;
      float x[16]; float q = 0.f;
#pragma unroll
      for (int j = 0; j < 16; ++j) { x[j] = hr[j]; q += x[j] * x[j]; }
      q += __builtin_bit_cast(float, __builtin_amdgcn_ds_swizzle(__builtin_bit_cast(int, q), 0x1f | (1 << 10)));
      q += __builtin_bit_cast(float, __builtin_amdgcn_ds_swizzle(__builtin_bit_cast(int, q), 0x1f | (2 << 10)));
      q += __builtin_bit_cast(float, __builtin_amdgcn_ds_swizzle(__builtin_bit_cast(int, q), 0x1f | (4 << 10)));
      const float rstd = 1.0f / sqrtf(q * (1.f / 128.f) + nv::EPS);
      const bf16* rp = B.proj + (t0 + i) * PJ1 + 1536 + h * 128 + sub * 16; const float* nw = norm_w + h * 128 + sub * 16;
      float r0[8], r1[8]; unpack8(*(const v4u*)rp, r0); unpack8(*(const v4u*)(rp + 8), r1);
      float y0[8], y1[8];
#pragma unroll
      for (int j = 0; j < 8; ++j) { y0[j] = x[j] * rstd * nw[j] * r0[j] * sigm_f(r0[j]); y1[j] = x[8 + j] * rstd * nw[8 + j] * r1[j] * sigm_f(r1[j]); }
      bf16* dst = B.mixbf + (t0 + i) * 1024 + 512 + h * 128 + sub * 16;
      *(v4u*)dst = pack8(y0); *(v4u*)(dst + 8) = pack8(y1); }
    __syncthreads();
}
__device__ __forceinline__ void s5_params(const Mix1Bufs& B, const float* const* in, int gtid, int gsz) {

    for (int idx = gtid; idx < 2048; idx += gsz) { const int g = idx >> 6;
        const float lr = in[17][idx], li = in[18][idx], dt = expf(in[24][g]);
        const float mag = expf(lr * dt), ar = mag * cosf(li * dt), ai = mag * sinf(li * dt);
        const float den = lr * lr + li * li, nr = ar - 1.0f, cr = (nr * lr + ai * li) / den, ci = (ai * lr - nr * li) / den;
        B.s5ab[idx * 2] = ar; B.s5ab[idx * 2 + 1] = ai;
        for (int h = 0; h < 16; ++h) { const float br = in[19][idx * 16 + h], bi = in[20][idx * 16 + h]; B.s5bb[idx * 32 + h] = cr * br - ci * bi; B.s5bb[idx * 32 + 16 + h] = cr * bi + ci * br; } }
    for (int idx = gtid; idx < 32 * 128 * 16; idx += gsz) { const int h = idx & 15, j = (idx >> 4) & 127, g = idx >> 11; const int gp = g * 64 + (j & 63);
        const float lr = in[17][gp], li = in[18][gp], dt = expf(in[24][g]);
        const float mag = expf(lr * dt), ar = mag * cosf(li * dt), ai = mag * sinf(li * dt);
        const float den = lr * lr + li * li, nr = ar - 1.0f, cr = (nr * lr + ai * li) / den, ci = (ai * lr - nr * li) / den;
        const float br = in[19][gp * 16 + h], bi = in[20][gp * 16 + h];
        B.bbt[idx] = (unsigned short)f2bf(j < 64 ? cr * br - ci * bi : cr * bi + ci * br); }
    for (int idx = gtid; idx < 32 * 32 * 128; idx += gsz) { const int k = idx & 127, hh = (idx >> 7) & 31, g = idx >> 12;
        float v = 0.f; if (hh < 16) v = k < 64 ? in[21][(g * 16 + hh) * 64 + k] : -in[22][(g * 16 + hh) * 64 + k - 64];
        B.cm[idx] = (unsigned short)f2bf(v); }
}
template <bool OUT> __device__ __forceinline__ void s5_chunk_v2(const Mix1Bufs& B, const float* dskip, int item, bool valid, LAS unsigned char* wl, int lane) {
    if (!valid) item = 0;
    const int n = item % NCH, g = (item / NCH) & 31, b = item / (NCH * 32);
    const size_t t0 = (size_t)b * S_ + n * 64; const int gp = g * 64 + lane;
    LAS float* bu = (LAS float*)wl;
    lbf16* xs = (lbf16*)(wl + 8192);
    const float ar = B.s5ab[gp * 2], ai = B.s5ab[gp * 2 + 1];
    float xr = 0.f, xi = 0.f;
    if (OUT) { xr = B.xstart[((size_t)item * 64 + lane) * 2]; xi = B.xstart[((size_t)item * 64 + lane) * 2 + 1]; }
    const bf16* bbt = B.bbt + (size_t)g * 2048 + (lane & 31) * 16 + 8 * (lane >> 5);
    for (int half = 0; half < 2; ++half) {
        const s16x8 a = *(const s16x8*)(B.proj + (t0 + half * 32 + (lane & 31)) * PJ1 + g * 16 + 8 * (lane >> 5));
        f32x16 acc[4];
#pragma unroll
        for (int nt = 0; nt < 4; ++nt) { const s16x8 bf = *(const s16x8*)(bbt + nt * 512);
            const f32x16 z = {0.f, 0.f, 0.f, 0.f, 0.f, 0.f, 0.f, 0.f, 0.f, 0.f, 0.f, 0.f, 0.f, 0.f, 0.f, 0.f};
            acc[nt] = __builtin_amdgcn_mfma_f32_32x32x16_bf16(a, bf, z, 0, 0, 0); }
#pragma unroll
        for (int q = 0; q < 2; ++q) {
#pragma unroll
            for (int nt = 0; nt < 4; ++nt)
#pragma unroll
                for (int rr = 0; rr < 8; ++rr) bu[((rr & 3) + 8 * (rr >> 2) + 4 * (lane >> 5)) * 128 + nt * 32 + (lane & 31)] = acc[nt][q * 8 + rr];
            __syncthreads();
#pragma unroll 4
            for (int l = 0; l < 16; ++l) { const float sr = bu[l * 128 + lane], si = bu[l * 128 + 64 + lane];
                const float nr = ar * xr - ai * xi + sr, ni = ar * xi + ai * xr + si; xr = nr; xi = ni;
                if (OUT) { xs[(q * 16 + l) * 136 + lane] = (unsigned short)f2bf(xr); xs[(q * 16 + l) * 136 + 64 + lane] = (unsigned short)f2bf(xi); } }
            __syncthreads();
        }
        if (OUT) {
            f32x16 acc2 = {0.f, 0.f, 0.f, 0.f, 0.f, 0.f, 0.f, 0.f, 0.f, 0.f, 0.f, 0.f, 0.f, 0.f, 0.f, 0.f};
            mm32_gb(acc2, xs, 136, B.cm + (size_t)g * 32 * 128, 128, 128, lane);
            const int hh = lane & 31;
            if (hh < 16 && valid) { const float dk = dskip[g * 16 + hh];
#pragma unroll
                for (int r = 0; r < 16; ++r) { const size_t t = t0 + half * 32 + rowmap(r, lane);
                    B.s5g[t * 512 + g * 16 + hh] = (unsigned short)f2bf(gelu_f(acc2[r] + dk * bf2f(B.proj[t * PJ1 + g * 16 + hh]))); } }
            __syncthreads();
        }
    }
    if (!OUT && valid) { B.xend[((size_t)item * 64 + lane) * 2] = xr; B.xend[((size_t)item * 64 + lane) * 2 + 1] = xi; }
}
__device__ __forceinline__ void s5_b(const Mix1Bufs& B, int gtid, int gsz) {
    for (int idx = gtid; idx < 2 * 2048; idx += gsz) { const int b = idx >> 11, gp = idx & 2047, g = gp >> 6, p = gp & 63;
        float ar = B.s5ab[gp * 2], ai = B.s5ab[gp * 2 + 1];
#pragma unroll
        for (int q = 0; q < 6; ++q) { const float r2 = ar * ar - ai * ai, i2 = 2.f * ar * ai; ar = r2; ai = i2; }
        float xr = 0.f, xi = 0.f;
        const size_t o0 = ((size_t)((b * 32 + g) * NCH) * 64 + p) * 2;
        for (int n0 = 0; n0 < NCH; n0 += 16) { float er[16], ei[16];
#pragma unroll
            for (int j = 0; j < 16; ++j) { const size_t o = o0 + (size_t)(n0 + j) * 128; er[j] = B.xend[o]; ei[j] = B.xend[o + 1]; }
#pragma unroll
            for (int j = 0; j < 16; ++j) { const float sr = xr, si = xi; const float nr = ar * xr - ai * xi + er[j], ni = ar * xi + ai * xr + ei[j]; xr = nr; xi = ni; er[j] = sr; ei[j] = si; }
#pragma unroll
            for (int j = 0; j < 16; ++j) { const size_t o = o0 + (size_t)(n0 + j) * 128; B.xstart[o] = er[j]; B.xstart[o + 1] = ei[j]; } } }
}
typedef float f32x4v __attribute__((ext_vector_type(4)));
struct RouterBufs { const float* z; float* h; bf16* hbf; const float* lnw; const float* lnb; const bf16* rwh; const bf16* rwl; const float* rbias; int* ridx; float* rwt; unsigned* cnt; };
__device__ __forceinline__ void router_split_weights(const float* rw, bf16* hi, bf16* lo, int gtid, int gsz) {
    for (int i = gtid; i < 64 * 1024; i += gsz) { const int e = i >> 10, k = i & 1023; const float w = rw[k * 64 + e]; const unsigned h = f2bf(w); hi[i] = (unsigned short)h; lo[i] = (unsigned short)f2bf(w - __builtin_bit_cast(float, h << 16)); }
}
__device__ __forceinline__ void router_select(const LAS float* sc, const float* bias, int* ridx, float* rwt, LAS unsigned* hist) {
    float gs[8];
#pragma unroll
    for (int g = 0; g < 8; ++g) { float m1 = -INFINITY, m2 = -INFINITY;
#pragma unroll
        for (int j = 0; j < 8; ++j) { const float v = sc[g * 8 + j] + bias[g * 8 + j]; if (v > m1) { m2 = m1; m1 = v; } else if (v > m2) m2 = v; }
        gs[g] = m1 + m2; }
    unsigned gsel = 0;
#pragma unroll
    for (int it = 0; it < 4; ++it) { float best = -INFINITY; int bi = 0;
#pragma unroll
        for (int g = 0; g < 8; ++g) { const bool ok = !((gsel >> g) & 1u) && gs[g] > best; best = ok ? gs[g] : best; bi = ok ? g : bi; }
        gsel |= 1u << bi; }
    unsigned long long taken = 0ull; float wsum = 0.f; float wv[8]; int ev[8];
#pragma unroll
    for (int it = 0; it < 8; ++it) { float best = -INFINITY; int bi = 0;
#pragma unroll 1
        for (int e = 0; e < 64; ++e) { const bool ok = ((gsel >> (e >> 3)) & 1u) && !((taken >> e) & 1ull); const float v = sc[e] + bias[e]; if (ok && v > best) { best = v; bi = e; } }
        taken |= 1ull << bi; ev[it] = bi; wv[it] = sc[bi]; wsum += wv[it]; }
    const float inv = 2.5f / wsum;
#pragma unroll
    for (int it = 0; it < 8; ++it) { ridx[it] = ev[it]; rwt[it] = wv[it] * inv; atomicAdd((unsigned*)&hist[ev[it]], 1u); }
}
__device__ __forceinline__ void router_tiles(const RouterBufs& R, int tile0, int tstride, int ntiles, LAS unsigned char* lds, int tid, bool count = true) {
    const int lane = tid & 63, wave = __builtin_amdgcn_readfirstlane(tid >> 6);
    lbf16* Ahi = (lbf16*)lds; lbf16* Alo = (lbf16*)(lds + 33024); LAS float* part = (LAS float*)(lds + 66048); LAS float* sc = (LAS float*)(lds + 98816); LAS unsigned* hist = (LAS unsigned*)(lds + 102912);
    if (tile0 >= ntiles) return;
    const int row16 = lane & 15, kq = 8 * (lane >> 4);
    s16x8 bh[4][4], bl[4][4];
#pragma unroll
    for (int ks = 0; ks < 4; ++ks)
#pragma unroll
        for (int nt = 0; nt < 4; ++nt) { const size_t o = (size_t)(nt * 16 + row16) * 1024 + wave * 128 + ks * 32 + kq; bh[ks][nt] = *(const s16x8*)(R.rwh + o); bl[ks][nt] = *(const s16x8*)(R.rwl + o); }
    const float bias = R.rbias[lane];
    f32x4 zr[2][4];
#define RT_LOAD(tile) do { _Pragma("unroll") for (int q = 0; q < 2; ++q) { const float* zp = R.z + ((size_t)(tile) * 16 + wave * 2 + q) * 1024 + lane * 8; \
        zr[q][0] = *(const f32x4*)zp; zr[q][1] = *(const f32x4*)(zp + 4); zr[q][2] = *(const f32x4*)(zp + 512); zr[q][3] = *(const f32x4*)(zp + 516); } } while (0)
    RT_LOAD(tile0);
    if (tid < 64) hist[tid] = 0u;
    for (int tile = tile0; tile < ntiles; tile += tstride) {
#pragma unroll
        for (int q = 0; q < 2; ++q) { const int row = wave * 2 + q; const size_t t = (size_t)tile * 16 + row;
            float v[16] = {zr[q][0].x, zr[q][0].y, zr[q][0].z, zr[q][0].w, zr[q][1].x, zr[q][1].y, zr[q][1].z, zr[q][1].w, zr[q][2].x, zr[q][2].y, zr[q][2].z, zr[q][2].w, zr[q][3].x, zr[q][3].y, zr[q][3].z, zr[q][3].w};
            float sum = 0.f;
#pragma unroll
            for (int j = 0; j < 16; ++j) sum += v[j];
            sum = wave_sum(sum); const float mean = sum * (1.f / 1024.f); float sq = 0.f;
#pragma unroll
            for (int j = 0; j < 16; ++j) { v[j] -= mean; sq += v[j] * v[j]; }
            sq = wave_sum(sq); const float rstd = 1.0f / sqrtf(sq * (1.f / 1024.f) + nv::EPS);
#pragma unroll
            for (int half = 0; half < 2; ++half) { const int c0 = half * 512 + lane * 8;
                const f32x4 w0 = *(const f32x4*)(R.lnw + c0), w1 = *(const f32x4*)(R.lnw + c0 + 4), b0 = *(const f32x4*)(R.lnb + c0), b1 = *(const f32x4*)(R.lnb + c0 + 4);
                float o[8] = {v[half * 8 + 0] * rstd * w0.x + b0.x, v[half * 8 + 1] * rstd * w0.y + b0.y, v[half * 8 + 2] * rstd * w0.z + b0.z, v[half * 8 + 3] * rstd * w0.w + b0.w,
                              v[half * 8 + 4] * rstd * w1.x + b1.x, v[half * 8 + 5] * rstd * w1.y + b1.y, v[half * 8 + 6] * rstd * w1.z + b1.z, v[half * 8 + 7] * rstd * w1.w + b1.w};
                *(f32x4*)(R.h + t * 1024 + c0) = (f32x4){o[0], o[1], o[2], o[3]}; *(f32x4*)(R.h + t * 1024 + c0 + 4) = (f32x4){o[4], o[5], o[6], o[7]};
                const v4u hi = pack8(o); float hf[8], lo[8]; unpack8(hi, hf);
#pragma unroll
                for (int j = 0; j < 8; ++j) lo[j] = o[j] - hf[j];
                *(v4u*)(R.hbf + t * 1024 + c0) = hi; *(LAS v4u*)(Ahi + row * 1032 + c0) = hi; *(LAS v4u*)(Alo + row * 1032 + c0) = pack8(lo); } }
        if (tile + tstride < ntiles) RT_LOAD(tile + tstride);
        __syncthreads();
        { f32x4v acc[4] = {{0.f, 0.f, 0.f, 0.f}, {0.f, 0.f, 0.f, 0.f}, {0.f, 0.f, 0.f, 0.f}, {0.f, 0.f, 0.f, 0.f}};
#pragma unroll
          for (int ks = 0; ks < 4; ++ks) { const int k0 = wave * 128 + ks * 32 + kq;
              const s16x8 ah = *(const LAS s16x8*)(Ahi + row16 * 1032 + k0), al = *(const LAS s16x8*)(Alo + row16 * 1032 + k0);
#pragma unroll
              for (int nt = 0; nt < 4; ++nt) {
                  acc[nt] = __builtin_amdgcn_mfma_f32_16x16x32_bf16(ah, bh[ks][nt], acc[nt], 0, 0, 0);
                  acc[nt] = __builtin_amdgcn_mfma_f32_16x16x32_bf16(al, bh[ks][nt], acc[nt], 0, 0, 0);
                  acc[nt] = __builtin_amdgcn_mfma_f32_16x16x32_bf16(ah, bl[ks][nt], acc[nt], 0, 0, 0); } }
#pragma unroll
          for (int nt = 0; nt < 4; ++nt)
#pragma unroll
              for (int r = 0; r < 4; ++r) part[(wave * 16 + (lane >> 4) * 4 + r) * 64 + nt * 16 + (lane & 15)] = acc[nt][r]; }
        __syncthreads();
#pragma unroll
        for (int q = 0; q < 2; ++q) { const int o = tid + q * 512; float s = 0.f;
#pragma unroll
            for (int w = 0; w < 8; ++w) s += part[w * 1024 + o];
            sc[o] = 1.0f / (1.0f + expf(-s)); }
        __syncthreads();
        { LAS float* gsl = part; LAS float* cvl = part + 128;
#pragma unroll 1
          for (int q = 0; q < 2; ++q) { const int tk = wave * 2 + q; const size_t t = (size_t)tile * 16 + tk;
              const float s = sc[tk * 64 + lane], v = s + bias;
#define SWZ_MAX(x, o) fmaxf(x, __builtin_bit_cast(float, __builtin_amdgcn_ds_swizzle(__builtin_bit_cast(int, x), 0x1f | ((o) << 10))))
#define SWZ_ADD(x, o) ((x) + __builtin_bit_cast(float, __builtin_amdgcn_ds_swizzle(__builtin_bit_cast(int, x), 0x1f | ((o) << 10))))
              float m1 = v; m1 = SWZ_MAX(m1, 1); m1 = SWZ_MAX(m1, 2); m1 = SWZ_MAX(m1, 4);
              float c1 = (v == m1) ? 1.f : 0.f; c1 = SWZ_ADD(c1, 1); c1 = SWZ_ADD(c1, 2); c1 = SWZ_ADD(c1, 4);
              float m2 = (v == m1) ? -INFINITY : v; m2 = SWZ_MAX(m2, 1); m2 = SWZ_MAX(m2, 2); m2 = SWZ_MAX(m2, 4);
              const float gs = m1 + (c1 >= 2.f ? m1 : m2);
              if ((lane & 7) == 0) gsl[tk * 8 + (lane >> 3)] = gs;
              __syncthreads();
              int grank = 0; const int g = lane >> 3;
#pragma unroll
              for (int j = 0; j < 8; ++j) { const float x = gsl[tk * 8 + j]; grank += (x > gs || (x == gs && j < g)) ? 1 : 0; }
              const bool gsel = grank < 4; const float cv = gsel ? v : -INFINITY;
              cvl[tk * 64 + lane] = cv;
              __syncthreads();
              int rank = 0;
#pragma unroll 16
              for (int j = 0; j < 64; ++j) { const float x = cvl[tk * 64 + j]; rank += (x > cv || (x == cv && j < lane)) ? 1 : 0; }
              const bool sel = gsel && rank < 8;
              const float wsum = wave_sum(sel ? s : 0.f);
              if (sel) { R.ridx[t * 8 + rank] = lane; R.rwt[t * 8 + rank] = s * (2.5f / wsum); atomicAdd((unsigned*)&hist[lane], 1u); }
#undef SWZ_MAX
#undef SWZ_ADD
          } }
        __syncthreads();
    }
#undef RT_LOAD
    if (count && tid < 64 && hist[tid]) atomicAdd(&R.cnt[tid], hist[tid]);
    __syncthreads();
}
#ifndef DUP_PHASE
#define DUP_PHASE -1
#endif
constexpr int CTX_OFF = LDS_CTL + 1024, TAB_OFF = LDS_CTL + 7168;
constexpr size_t WS_WINE = 1 * MiB, WS_WINO = WS_WINE + (size_t)EINP * 1024 * 2, WS_WOUT = WS_WINO + (size_t)OINP * 1024 * 2, WS_XBF = 16 * MiB, WS_NAIVE = 80 * MiB;
#if defined(WITH_NAIVE)
constexpr size_t WS_MIXBF = 48 * MiB;
#else
constexpr size_t WS_MIXBF = 453 * MiB;
#endif
__device__ __forceinline__ int conv_split(int nwg, int G) {
#if defined(WITH_NAIVE)
    return 0;
#else
    const int rem = nwg % G; return rem == 0 ? 0 : (G - rem) * NWAVES * 4;
#endif
}
static_assert(WS_WOUT + 2 * 1024 * 1024 * 2 <= WS_XBF, "ws map");
constexpr size_t WS_WD = 48 * MiB, WS_WGU = WS_WD + 65 * 512 * 1024, WS_LISTS = 146 * MiB, WS_RIDX = 148 * MiB, WS_H = 149 * MiB, WS_ROWS8 = 229 * MiB;
static_assert(WS_WGU + (size_t)65 * 1024 * 1024 <= WS_LISTS && WS_H + (size_t)MOE_MAXBLK * 256 * 512 <= WS_ROWS8 && WS_ROWS8 + (size_t)nv::T_ * 8 * 2048 <= 512 * MiB, "moe ws map");
constexpr size_t WS_PROJB = 149 * MiB, WS_CT = 253 * MiB, WS_HLOC = 317 * MiB, WS_PC = 349 * MiB, WS_M0SMALL = 381 * MiB, WS_LRUW = 486 * MiB;
constexpr size_t WS_UT = 221 * MiB, WS_S5G = 253 * MiB, WS_M1SMALL = 269 * MiB, WS_GLUW = 486 * MiB + 256 * 1024;
constexpr size_t WS_RW = 487 * MiB;
constexpr int CW_PROBE = 9000;
struct Tab { const float* in[38]; float* out; unsigned char* ws; };
struct Env { const Tab* tab; unsigned char* ws; float* out; LAS unsigned char* lds; int tid, lane, wave, bid, G, gw, NGW, gtid, gsz, vcu; };
__device__ __forceinline__ Env penv(unsigned char* lds_raw) {
    Env e; e.tab = (const Tab*)(lds_raw + TAB_OFF); e.ws = e.tab->ws; e.out = e.tab->out; e.lds = (LAS unsigned char*)lds_raw;
    int t = threadIdx.x; asm volatile("" : "+v"(t)); e.tid = t; e.lane = t & 63; e.wave = __builtin_amdgcn_readfirstlane(t >> 6);
    int b = blockIdx.x; asm volatile("" : "+s"(b)); e.bid = b; int g = gridDim.x; asm volatile("" : "+s"(g)); e.G = g;
    e.vcu = (g % 8 == 0) ? (b % 8) * (g / 8) + b / 8 : b;
    e.gw = b * NWAVES + e.wave; e.NGW = g * NWAVES; e.gtid = b * NTHREADS + t; e.gsz = g * NTHREADS;
    return e;
}
__device__ __forceinline__ void grid_bar(const Env& e) {
    XcdBarrier b; b.bar = (unsigned*)e.ws + 4096; b.x = xb_xcc_id(); b.st = (volatile LAS unsigned*)(e.lds + MISC_OFF) + 8;
    xcd_barrier(b);
}
#if defined(WITH_NAIVE)
template <int ST> __device__ __forceinline__ void run_naive(unsigned char* lds_raw, int ci, long n) {
    const Env e = penv(lds_raw);
    const nv::Ctx& c = ((const nv::Ctx*)(lds_raw + CTX_OFF))[ci];
    for (long i = e.gtid; i < n; i += e.gsz) nv::item<ST>(c, i);
    grid_bar(e);
}
#endif
__device__ __forceinline__ void phase_p0(unsigned char* lds_raw) {
    const Env e = penv(lds_raw);
    LAS float* scr = (LAS float*)(e.lds + e.wave * 16640);
    constexpr int I0 = 16 * (EINP / 64), I1 = I0 + 16 * (OINP / 64), I2 = I1 + 256, I3 = I2 + 256, I4 = I3 + 32, I5 = I4 + 64;
    for (int it = e.gw; it < I5; it += e.NGW) {
        if (it < I0) tr_matrix_item(e.tab->in[6], 1024, nv::EIN, EINP, (bf16*)(e.ws + WS_WINE), scr, it, e.lane);
        else if (it < I1) tr_matrix_item(e.tab->in[16], 1024, nv::OIN, OINP, (bf16*)(e.ws + WS_WINO), scr, it - I0, e.lane);
        else if (it < I2) tr_matrix_item(e.tab->in[5], 1024, 1024, 1024, (bf16*)(e.ws + WS_WOUT), scr, it - I1, e.lane);
        else if (it < I3) tr_matrix_item(e.tab->in[5] + 1024 * 1024, 1024, 1024, 1024, (bf16*)(e.ws + WS_WOUT) + 1024 * 1024, scr, it - I2, e.lane);
        else if (it < I4) { const int r = it - I3, mtx = r >> 2, h = mtx & 3, which = mtx >> 2;
            tr_matrix_item(e.tab->in[which ? 13 : 11] + h * 16384, 128, 128, 128, (bf16*)(e.ws + WS_LRUW) + which * 65536 + h * 16384, scr, r & 3, e.lane); }
        else tr_matrix_item(e.tab->in[25], 512, 512, 512, (bf16*)(e.ws + WS_GLUW), scr, it - I4, e.lane);
    }
    for (int l = 0; l < 2; ++l) router_split_weights(e.tab->in[30] + (size_t)l * 65536, (bf16*)(e.ws + WS_RW) + (size_t)l * 131072, (bf16*)(e.ws + WS_RW) + (size_t)l * 131072 + 65536, e.gtid, e.gsz);
    cvt_rows(e.tab->in[0], (bf16*)(e.ws + WS_XBF), (long)T_ * 1024, e.gtid, e.gsz);
    grid_bar(e);
}
__device__ __forceinline__ void phase_inproj(unsigned char* lds_raw, int layer) {
    const Env e = penv(lds_raw);
    float* proj = (float*)(e.ws + WS_NAIVE) + ((size_t)T_ * 1024 + (size_t)T_ * 64 + (size_t)T_ * 8 * 2);
    const int NP = layer == 0 ? EINP : OINP;
    pg8::Gemm g{(const bf16*)(e.ws + WS_XBF), (const bf16*)(e.ws + (layer == 0 ? WS_WINE : WS_WINO)), 1024, 0, 0, nullptr};
    pg8::StaticOrder S; S.init(T_, NP, e.G, e.bid);
    pg8::EpiF32R E{proj, NP, nullptr, 0.f};
    pg8::gemm_phase<pg8::EpiF32R, pg8::StaticOrder, true, false>(e.lds, g, S, E);
    grid_bar(e);
}
__device__ __forceinline__ void phase_cvt_mixed(unsigned char* lds_raw) {
    const Env e = penv(lds_raw);
    cvt_rows((const float*)(e.ws + WS_NAIVE), (bf16*)(e.ws + WS_MIXBF), (long)T_ * 1024, e.gtid, e.gsz);
    grid_bar(e);
}
__device__ __forceinline__ void phase_outproj(unsigned char* lds_raw, int layer) {
    const Env e = penv(lds_raw);
    float* z = (float*)(e.ws + WS_NAIVE) + ((size_t)T_ * 1024 + (size_t)T_ * 64 + (size_t)T_ * 8 * 2);
    const float* hcur = layer == 0 ? e.tab->in[0] : e.out;
    pg8::Gemm g{(const bf16*)(e.ws + WS_MIXBF), (const bf16*)(e.ws + WS_WOUT) + (size_t)layer * 1024 * 1024, 1024, 0, 0, nullptr};
    pg8::StaticOrder S; S.init(T_, 1024, e.G, e.bid);
    pg8::EpiF32R E{z, 1024, hcur, nv::ALPHA};
    pg8::gemm_phase<pg8::EpiF32R, pg8::StaticOrder, true, false>(e.lds, g, S, E);
    grid_bar(e);
}
__device__ __forceinline__ Mix0Bufs mix0_bufs(unsigned char* ws) {
    Mix0Bufs B; B.proj = (const bf16*)(ws + WS_PROJB); B.ct = (bf16*)(ws + WS_CT); B.hloc = (float*)(ws + WS_HLOC); B.pc = (float*)(ws + WS_PC);
    float* sm = (float*)(ws + WS_M0SMALL); B.nloc = sm; sm += 8 * NCH * 128; B.blast = sm; sm += 8 * NCH; B.mloc = sm; sm += 8 * NCH; B.mprev = sm; sm += 8 * NCH;
    B.carA = sm; sm += 2 * NCH * 512; B.carU = sm; sm += 2 * NCH * 512; B.carI = sm;
    B.mixbf = (bf16*)(ws + WS_MIXBF); B.lruw = (const bf16*)(ws + WS_LRUW); return B;
}
__device__ __forceinline__ Mix1Bufs mix1_bufs(unsigned char* ws) {
    Mix1Bufs B; B.proj = (const bf16*)(ws + WS_PROJB); B.ut = (bf16*)(ws + WS_UT); B.s5g = (bf16*)(ws + WS_S5G);
    float* sm = (float*)(ws + WS_M1SMALL); B.gbl = sm; sm += 8 * NCH * 64; B.xend = sm; sm += 8192 * 128; B.xstart = sm; sm += 8192 * 128; B.s5ab = sm; sm += 4096; B.s5bb = sm; sm += 2048 * 32;
    B.cm = (bf16*)sm; B.bbt = B.cm + 32 * 32 * 128; B.mixbf = (bf16*)(ws + WS_MIXBF); return B;
}
__device__ __forceinline__ void phase_inproj_bf16(unsigned char* lds_raw, int layer) {
    const Env e = penv(lds_raw);
    const int NP = layer == 0 ? EINP : OINP;
    if (layer == 1) { const Mix1Bufs B = mix1_bufs(e.ws); s5_params(B, e.tab->in, e.gtid, e.gsz); }
    pg8::Gemm g{(const bf16*)(e.ws + WS_XBF), (const bf16*)(e.ws + (layer == 0 ? WS_WINE : WS_WINO)), 1024, 0, 0, nullptr};
    pg8::StaticOrder S; S.init(T_, NP, e.G, e.bid);
    pg8::EpiBf16P E{(bf16*)(e.ws + WS_PROJB), NP};
    pg8::gemm_phase<pg8::EpiBf16P, pg8::StaticOrder, true, false>(e.lds, g, S, E);
    { const int nwg = (T_ / 256) * (NP / 256), rem = nwg % e.G, na = conv_split(nwg, e.G);
      if (na > 0 && e.bid >= rem) { const int nlight = e.G - rem; LAS float* scr = (LAS float*)(e.lds + e.wave * 16640);
          moe_convert_weights(e.tab->in[32] + (size_t)layer * 64 * 262144, e.tab->in[33] + (size_t)layer * 64 * 262144, e.tab->in[34] + (size_t)layer * 64 * 262144,
                              e.tab->in[35] + (size_t)layer * 262144, e.tab->in[36] + (size_t)layer * 262144, e.tab->in[37] + (size_t)layer * 262144,
                              (bf16*)(e.ws + WS_WGU), (bf16*)(e.ws + WS_WD), scr, (e.bid - rem) * NWAVES + e.wave, na, nlight * NWAVES, e.lane); } }
    grid_bar(e);
}
__device__ __forceinline__ void phase_mix0_a(unsigned char* lds_raw) {
    const Env e = penv(lds_raw); const Mix0Bufs B = mix0_bufs(e.ws);
    for (int it = e.bid; it < 256 + 8 * NCH; it += e.G) {
        if (it < 256) { lru_a_item(B, e.tab->in, it, e.lds, e.tid); if (DUP_PHASE == 31) lru_a_item(B, e.tab->in, it, e.lds, e.tid); }
        else { mlstm_a_item(B, e.tab->in[7], it - 256, e.lds, e.tid); if (DUP_PHASE == 30) mlstm_a_item(B, e.tab->in[7], it - 256, e.lds, e.tid); } }
    grid_bar(e);
}
__device__ __forceinline__ int conv_rest(int nwg, int G, int NGW) {
#if defined(WITH_NAIVE)
    return 0;
#else
    const int nb = conv_split(nwg, G) + NGW * 3; return nb > 65 * 192 ? 65 * 192 : nb;
#endif
}
__device__ __forceinline__ void conv_in_scan_phase(const Env& e, int layer) {
#if !defined(WITH_NAIVE)
    const int na = conv_split((T_ / 256) * ((layer == 0 ? EINP : OINP) / 256), e.G); int nb = na + e.NGW * 3; if (nb > 65 * 192) nb = 65 * 192;
    LAS float* scr = (LAS float*)(e.lds + e.wave * 16640);
    moe_convert_weights(e.tab->in[32] + (size_t)layer * 64 * 262144, e.tab->in[33] + (size_t)layer * 64 * 262144, e.tab->in[34] + (size_t)layer * 64 * 262144,
                        e.tab->in[35] + (size_t)layer * 262144, e.tab->in[36] + (size_t)layer * 262144, e.tab->in[37] + (size_t)layer * 262144,
                        (bf16*)(e.ws + WS_WGU), (bf16*)(e.ws + WS_WD), scr, na + e.gw, nb, e.NGW, e.lane);
#endif
}
__device__ __forceinline__ void phase_mix0_b(unsigned char* lds_raw) {
    const Env e = penv(lds_raw); const Mix0Bufs B = mix0_bufs(e.ws);
    lru_b(B, e.gtid, e.gsz); mlstm_b(B, e.gtid, e.gsz);
    grid_bar(e);
}
__device__ __forceinline__ void phase_mix0_c(unsigned char* lds_raw) {
    const Env e = penv(lds_raw); const Mix0Bufs B = mix0_bufs(e.ws);
    for (int it = e.bid; it < 8 * NCH; it += e.G) { mlstm_c_item(B, e.tab->in[7], e.tab->in[8], it, e.lds, e.tid); if (DUP_PHASE == 32) mlstm_c_item(B, e.tab->in[7], e.tab->in[8], it, e.lds, e.tid); }
    lru_c(B, e.gtid, e.gsz); if (DUP_PHASE == 33) lru_c(B, e.gtid, e.gsz);
    grid_bar(e);
}
__device__ __forceinline__ void phase_mix1_a(unsigned char* lds_raw) {
    const Env e = penv(lds_raw); const Mix1Bufs B = mix1_bufs(e.ws);
    for (int it = e.bid; it < 8 * NCH; it += e.G) { gla_a_item(B, e.tab->in[27], e.tab->in[28], it, e.lds, e.tid); if (DUP_PHASE == 34) gla_a_item(B, e.tab->in[27], e.tab->in[28], it, e.lds, e.tid); }
    for (int it = e.gw, k = 0; k < (2 * 32 * NCH + e.NGW - 1) / e.NGW; ++k, it += e.NGW) { s5_chunk_v2<false>(B, e.tab->in[23], it, it < 2 * 32 * NCH, e.lds + e.wave * 16896, e.lane);
        if (DUP_PHASE == 35) s5_chunk_v2<false>(B, e.tab->in[23], it, it < 2 * 32 * NCH, e.lds + e.wave * 16896, e.lane); }
    grid_bar(e);
}
__device__ __forceinline__ void phase_mix1_b(unsigned char* lds_raw) {
    const Env e = penv(lds_raw); const Mix1Bufs B = mix1_bufs(e.ws);
    s5_b(B, e.gtid, e.gsz); gla_b(B, e.gtid, e.gsz);
    grid_bar(e);
}
__device__ __forceinline__ void phase_mix1_c(unsigned char* lds_raw) {
    const Env e = penv(lds_raw); const Mix1Bufs B = mix1_bufs(e.ws);
    for (int it = e.bid; it < 8 * NCH; it += e.G) { gla_c_item(B, e.tab->in[27], e.tab->in[28], e.tab->in[29], it, e.lds, e.tid); if (DUP_PHASE == 36) gla_c_item(B, e.tab->in[27], e.tab->in[28], e.tab->in[29], it, e.lds, e.tid); }
    for (int it = e.gw, k = 0; k < (2 * 32 * NCH + e.NGW - 1) / e.NGW; ++k, it += e.NGW) { s5_chunk_v2<true>(B, e.tab->in[23], it, it < 2 * 32 * NCH, e.lds + e.wave * 16896, e.lane);
        if (DUP_PHASE == 37) s5_chunk_v2<true>(B, e.tab->in[23], it, it < 2 * 32 * NCH, e.lds + e.wave * 16896, e.lane); }
    grid_bar(e);
}
__device__ __forceinline__ void phase_glu(unsigned char* lds_raw) {
    const Env e = penv(lds_raw);
    pg8::Gemm g{(const bf16*)(e.ws + WS_S5G), (const bf16*)(e.ws + WS_GLUW), 512, 0, 0, nullptr};
    pg8::StaticOrder S; S.init(T_, 512, e.G, e.bid);
    pg8::EpiGlu E{(bf16*)(e.ws + WS_MIXBF), 1024, (const bf16*)(e.ws + WS_S5G), 512, e.tab->in[26]};
    pg8::gemm_phase<pg8::EpiGlu, pg8::StaticOrder, true, false>(e.lds, g, S, E);
    grid_bar(e);
}
__device__ __forceinline__ void phase_probe(unsigned char* lds_raw, int c0, int c1) {
    const Env e = penv(lds_raw);
    const bf16* a = (const bf16*)(e.ws + WS_MIXBF); const float* b = (const float*)(e.ws + WS_NAIVE);
    float sd = 0.f, sr = 0.f; const int w = c1 - c0;
    for (long i = e.gtid; i < (long)T_ * w; i += e.gsz) { const long t = i / w; const int c = c0 + (int)(i % w); const float x = bf2f(a[t * 1024 + c]), y = b[t * 1024 + c]; sd += (x - y) * (x - y); sr += y * y; }
    sd = wave_sum(sd); sr = wave_sum(sr);
    if (e.lane == 0) { atomicAdd((float*)e.ws + CW_PROBE, sd); atomicAdd((float*)e.ws + CW_PROBE + 1, sr); }
    grid_bar(e);
}
__device__ __forceinline__ void phase_probe_apply(unsigned char* lds_raw) {
    const Env e = penv(lds_raw);
    const float sd = __hip_atomic_load((float*)e.ws + CW_PROBE, __ATOMIC_RELAXED, __HIP_MEMORY_SCOPE_AGENT), sr = __hip_atomic_load((float*)e.ws + CW_PROBE + 1, __ATOMIC_RELAXED, __HIP_MEMORY_SCOPE_AGENT);
    const float f = 1.0f + 10.0f * sqrtf(sd / fmaxf(sr, 1e-30f));
    for (long i = e.gtid; i < (long)T_ * 1024; i += e.gsz) e.out[i] *= f;
}
__device__ __forceinline__ void phase_ln_router(unsigned char* lds_raw, int layer, bool count = true) {
    const Env e = penv(lds_raw);
    RouterBufs R; R.z = (const float*)(e.ws + WS_NAIVE) + ((size_t)T_ * 1024 + (size_t)T_ * 64 + (size_t)T_ * 8 * 2); R.h = e.out; R.hbf = (bf16*)(e.ws + WS_XBF);
    R.lnw = e.tab->in[1] + layer * 1024; R.lnb = e.tab->in[2] + layer * 1024; R.rwh = (const bf16*)(e.ws + WS_RW) + (size_t)layer * 131072; R.rwl = R.rwh + 65536;
    R.rbias = e.tab->in[31] + layer * 64; R.ridx = (int*)(e.ws + WS_RIDX); R.rwt = (float*)(e.ws + WS_RIDX) + (size_t)T_ * 8; R.cnt = (unsigned*)e.ws + CW_CNT + layer * 256;
    router_tiles(R, e.bid, e.G, T_ / 16, e.lds, e.tid, count);
    grid_bar(e);
}
__device__ __forceinline__ MoeLists moe_lists(unsigned char* ws) {
    MoeLists L; L.tok = (int*)(ws + WS_LISTS); L.dest = L.tok + MOE_MAXBLK * 256; L.w = (float*)(L.dest + MOE_MAXBLK * 256); L.blk_e = (int*)(L.w + MOE_MAXBLK * 256); return L;
}
__device__ __forceinline__ void phase_moe_x1(unsigned char* lds_raw, int layer, int curoff = 0) {
    const Env e = penv(lds_raw);
    moe_build_lists((const int*)(e.ws + WS_RIDX), (const float*)(e.ws + WS_RIDX) + (size_t)T_ * 8, (unsigned*)e.ws + CW_CNT + layer * 256, (unsigned*)e.ws + CW_CUR + layer * 256 + curoff,
                    moe_lists(e.ws), (LAS int*)e.lds, e.tid, e.bid, e.G);
    LAS float* scr = (LAS float*)(e.lds + e.wave * 16640);
    moe_convert_weights(e.tab->in[32] + (size_t)layer * 64 * 262144, e.tab->in[33] + (size_t)layer * 64 * 262144, e.tab->in[34] + (size_t)layer * 64 * 262144,
                        e.tab->in[35] + (size_t)layer * 262144, e.tab->in[36] + (size_t)layer * 262144, e.tab->in[37] + (size_t)layer * 262144,
                        (bf16*)(e.ws + WS_WGU), (bf16*)(e.ws + WS_WD), scr, conv_split((T_ / 256) * ((layer == 0 ? EINP : OINP) / 256), e.G) + e.gw, 65 * 192, e.NGW, e.lane);
    grid_bar(e);
}
__device__ __forceinline__ void phase_moe_g1(unsigned char* lds_raw) {
    const Env e = penv(lds_raw);
    const MoeLists L = moe_lists(e.ws);
    const int nblk = __builtin_amdgcn_readfirstlane(L.blk_e[MOE_MAXBLK]);
    pg8::Gemm g{(const bf16*)(e.ws + WS_XBF), (const bf16*)(e.ws + WS_WGU), 1024, 0, (size_t)512 * 1024, L.tok};
    pg8::MoeOrder S{L.blk_e, nblk, 2, e.G, e.vcu};
    pg8::EpiSwiGLU E{(bf16*)(e.ws + WS_H)};
    pg8::gemm_phase<pg8::EpiSwiGLU, pg8::MoeOrder, true, true>(e.lds, g, S, E);
    grid_bar(e);
}
__device__ __forceinline__ void phase_moe_g2(unsigned char* lds_raw) {
    const Env e = penv(lds_raw);
    const MoeLists L = moe_lists(e.ws);
    const int nblk = __builtin_amdgcn_readfirstlane(L.blk_e[MOE_MAXBLK]);
    pg8::Gemm g{(const bf16*)(e.ws + WS_H), (const bf16*)(e.ws + WS_WD), 256, 0, (size_t)1024 * 256, nullptr};
    pg8::MoeOrder S{L.blk_e, nblk, 4, e.G, e.vcu};
    pg8::EpiDown E{(bf16*)(e.ws + WS_ROWS8), (bf16*)(e.ws + WS_XBF), L.dest, T_ * 8};
    pg8::gemm_phase<pg8::EpiDown, pg8::MoeOrder, true, false>(e.lds, g, S, E);
    grid_bar(e);
}
__device__ __forceinline__ void phase_moe_combine(unsigned char* lds_raw, int layer) {
    const Env e = penv(lds_raw);
    moe_combine_ln(e.out, (const bf16*)(e.ws + WS_ROWS8), (const bf16*)(e.ws + WS_XBF), (const float*)(e.ws + WS_RIDX) + (size_t)T_ * 8, e.tab->in[3] + layer * 1024, e.tab->in[4] + layer * 1024,
                   layer == 0 ? (bf16*)(e.ws + WS_XBF) : nullptr, e.gw, e.NGW, e.lane);
    grid_bar(e);
}

#define RUN(k, call) do { call; if (DUP_PHASE == (k)) { call; } } while (0)
#ifndef TIME_PHASE
#define TIME_PHASE -1
#endif
#define TIMED(k, call) do { unsigned long long _t0 = 0; if (TIME_PHASE == (k)) _t0 = __builtin_amdgcn_s_memrealtime(); call; \
    if (TIME_PHASE == (k) && blockIdx.x == 0 && threadIdx.x == 0) { const unsigned long long _t1 = __builtin_amdgcn_s_memrealtime(); unsigned* w_ = (unsigned*)((Tab*)(lds_raw + TAB_OFF))->ws + CW_PROBE + 8; *w_ = *w_ + (unsigned)(_t1 - _t0); } } while (0)
template <int layer> __device__ __forceinline__ void layer_body(unsigned char* lds_raw) {
#if defined(WITH_NAIVE)
    constexpr int ci = layer * 2;
#if defined(DBG_MIX0)
    constexpr bool naive_too = (layer == DBG_MIX0 - 1);
#else
    constexpr bool naive_too = false;
#endif
#endif
    RUN(1, phase_inproj_bf16(lds_raw, layer));
    if (layer == 0) { RUN(2, phase_mix0_a(lds_raw)); TIMED(20, phase_mix0_b(lds_raw)); RUN(3, phase_mix0_c(lds_raw)); }
    if (layer == 1) { RUN(4, phase_mix1_a(lds_raw)); TIMED(21, phase_mix1_b(lds_raw)); RUN(5, phase_mix1_c(lds_raw)); RUN(6, phase_glu(lds_raw)); }
#if defined(WITH_NAIVE)
    if (naive_too) {
        phase_inproj(lds_raw, layer);
        if (layer == 0) {
            run_naive<nv::ST_ML_GATES>(lds_raw, ci, 8L * NCH);
            run_naive<nv::ST_ML_CLOC>(lds_raw, ci, 8L * NCH * 16384);
            run_naive<nv::ST_ML_SCAN>(lds_raw, ci, 8L * 16384 + 8 * 128);
            run_naive<nv::ST_ML_MI>(lds_raw, ci, 8L * S_);
            run_naive<nv::ST_ML_SMAT>(lds_raw, ci, 8L * NCH * 4096);
            run_naive<nv::ST_ML_DEN>(lds_raw, ci, 8L * S_);
            run_naive<nv::ST_ML_H>(lds_raw, ci, 8L * S_ * 128);
            run_naive<nv::ST_ML_NORM>(lds_raw, ci, 8L * S_);
            run_naive<nv::ST_LRU_CONV>(lds_raw, ci, (long)T_ * 512);
            run_naive<nv::ST_LRU_GATE>(lds_raw, ci, (long)T_ * 512);
            run_naive<nv::ST_LRU_SCAN>(lds_raw, ci, 2L * 512);
        } else {
            run_naive<nv::ST_S5_PAR>(lds_raw, ci, 2048);
            for (int sl = 0; sl < S_ / nv::SLAB; ++sl) {
                if (threadIdx.x == 0) ((nv::Ctx*)(lds_raw + CTX_OFF))[ci].slab = sl;
                __syncthreads();
                run_naive<nv::ST_S5_SCAN>(lds_raw, ci, 2L * 2048); run_naive<nv::ST_S5_OUT>(lds_raw, ci, (long)nv::B_ * nv::SLAB * 512); }
            run_naive<nv::ST_S5_GLU>(lds_raw, ci, (long)T_ * 512);
            run_naive<nv::ST_GLA_GATE>(lds_raw, ci, (long)T_ * 256);
            run_naive<nv::ST_GLA_CUM>(lds_raw, ci, (long)nv::B_ * NCH * 256);
            run_naive<nv::ST_GLA_U>(lds_raw, ci, 8L * NCH * 8192);
            run_naive<nv::ST_GLA_SCAN>(lds_raw, ci, 8L * 8192);
            run_naive<nv::ST_GLA_ATT>(lds_raw, ci, 8L * NCH * 4096);
            run_naive<nv::ST_GLA_O>(lds_raw, ci, 8L * S_ * 128);
            run_naive<nv::ST_GLA_NORM>(lds_raw, ci, 8L * S_);
        }
        phase_probe(lds_raw, DBG_C0, DBG_C1);
        phase_cvt_mixed(lds_raw);
    }
#endif
    RUN(7, phase_outproj(lds_raw, layer));
    TIMED(22, phase_ln_router(lds_raw, layer)); if (DUP_PHASE == 22) phase_ln_router(lds_raw, layer, false);
    phase_moe_x1(lds_raw, layer); if (DUP_PHASE == 8) phase_moe_x1(lds_raw, layer, 1024);
    RUN(9, phase_moe_g1(lds_raw));
    RUN(10, phase_moe_g2(lds_raw));
    TIMED(24, phase_moe_combine(lds_raw, layer));
}
#if defined(STORE_TEST)
__device__ __forceinline__ void phase_store_test(unsigned char* lds_raw) {
    const Env e = penv(lds_raw);
    unsigned char* base = e.ws + WS_ROWS8 + (size_t)e.bid * (1u << 20);
    const int wr = e.wave >> 2, wc = e.wave & 3, fr = e.lane & 15, fq = e.lane >> 4;
    const v4u val = {(unsigned)e.tid, 1u, 2u, 3u};
    for (int u = 0; u < 40; ++u) {
#pragma unroll
        for (int s = 0; s < 8; ++s)
#pragma unroll
            for (int bj = 0; bj < 2; ++bj) {
#if STORE_TEST == 1
                const int r = (s >> 2) * 128 + wr * 64 + (s & 3) * 16 + fr; const int cb = wc * 64 + fq * 16 + bj * 256;
#elif STORE_TEST == 2
                const int r = (s >> 2) * 128 + wr * 64 + (s & 3) * 16 + bj * 8 + (e.lane >> 3); const int cb = wc * 128 + (e.lane & 7) * 16;
#else
                const int r = (s >> 2) * 128 + wr * 64 + (s & 3) * 16 + bj * 8 + (e.lane >> 4) * 2 + (wc & 1); const int cb = (wc >> 1) * 256 + (e.lane & 15) * 16;
#endif
                *(v4u*)(base + (size_t)((u & 1) * 256 + r) * 2048 + cb) = val; }
        asm volatile("" ::: "memory"); }
    grid_bar(e);
}
#endif
struct Args { const float* in[38]; float* out; unsigned char* ws; };
__global__ void __launch_bounds__(NTHREADS, 2) mega_fwd(Args a) {
    extern __shared__ __attribute__((aligned(16))) unsigned char lds_raw[];
    {
        LAS unsigned char* lds = (LAS unsigned char*)lds_raw;
        for (int u = threadIdx.x; u < (LDS_BYTES - LDS_CTL) / 4; u += NTHREADS) ((LAS unsigned*)(lds + LDS_CTL))[u] = 0u;
        __syncthreads();
        if (threadIdx.x == 0) {
            (void)xb_add((unsigned*)a.ws + 4096 + XB_XCNT(xb_xcc_id()), 1u);
            Tab* tab = (Tab*)(lds_raw + TAB_OFF);
#pragma unroll
            for (int i = 0; i < 38; ++i) { tab->in[i] = a.in[i]; if ((i & 7) == 7) asm volatile("" ::: "memory"); }
            tab->out = a.out; tab->ws = a.ws;
            asm volatile("" ::: "memory");
#if defined(WITH_NAIVE)
            nv::Ctx* const ctab = (nv::Ctx*)(lds_raw + CTX_OFF);
            const size_t scratch0 = (size_t)T_ * 1024 + (size_t)T_ * 64 + (size_t)T_ * 8 * 2;
#pragma unroll 1
            for (int layer = 0; layer < 2; ++layer) {
                nv::Ctx& c = ctab[layer * 2];
                nv::Mem M{(float*)(a.ws + WS_NAIVE), 0};
#pragma unroll 1
                for (int i = 0; i < 38; ++i) c.in[i] = tab->in[i];
                c.mixed = M.get((size_t)T_ * 1024); c.scores = M.get((size_t)T_ * 64);
                c.ridx = (int*)M.get((size_t)T_ * 8); c.rwt = M.get((size_t)T_ * 8);
                c.gR = nullptr; c.gBias = nullptr; c.slab = 0;
                c.layer = layer;
                c.hcur = layer == 0 ? a.in[0] : a.out;
                if (layer == 0) {
                    c.ldp = EINP; c.proj = M.get((size_t)T_ * c.ldp);
                    c.mb = M.get(8 * S_); c.mig = M.get(8 * S_); c.mblast = M.get(8 * NCH); c.mmloc = M.get(8 * NCH); c.mmprev = M.get(8 * NCH);
                    c.mmi = M.get(8 * S_); c.mwin = M.get(8 * S_); c.mden = M.get(8 * S_); c.nloc = M.get(8 * NCH * 128);
                    const size_t ov = M.off;
                    c.cloc = M.get((size_t)8 * NCH * 16384); c.smat = M.get((size_t)8 * NCH * 4096); c.htil = M.get((size_t)T_ * 512);
                    M.off = ov; c.lxc = M.get((size_t)T_ * 512); c.la = M.get((size_t)T_ * 512); c.lu = M.get((size_t)T_ * 512);
                } else {
                    c.ldp = OINP; c.proj = M.get((size_t)T_ * c.ldp);
                    c.s5ab = M.get(2048 * 2); c.s5bbr = M.get(2048 * 16); c.s5bbi = M.get(2048 * 16); c.s5st = M.get(2 * 2048 * 2);
                    c.s5x = M.get((size_t)nv::B_ * nv::SLAB * 2048 * 2); c.s5g = M.get((size_t)T_ * 512);
                    c.gla_la = M.get((size_t)T_ * 256); c.gla_bc = M.get((size_t)T_ * 256); c.gla_bl = M.get((size_t)nv::B_ * NCH * 256);
                    c.gu = M.get((size_t)8 * NCH * 8192); c.gatt = M.get((size_t)8 * NCH * 4096); c.go = M.get((size_t)T_ * 512);
                }
                c.z = c.proj; c.hout = a.out; c.lnw = a.in[1] + layer * 1024; c.lnb = a.in[2] + layer * 1024;
                M.off = scratch0; c.hid = M.get((size_t)T_ * 9 * 256);
                nv::Ctx& cm = ctab[layer * 2 + 1];
                cm = c; cm.hcur = a.out;
#ifdef DBG_LAYER
                if (layer == DBG_LAYER) { nv::Ctx& cd = ctab[4]; cd = cm;
                cd.hid = (float*)(a.ws + 48 * MiB); cd.z = (float*)(a.ws + 486 * MiB); cd.hcur = a.out + (size_t)DBG_T0 * 1024; cd.ridx = c.ridx + (size_t)DBG_T0 * 8; cd.rwt = c.rwt + (size_t)DBG_T0 * 8; }
#endif
            }
#endif
        }
        __syncthreads();
    }
    RUN(0, phase_p0(lds_raw));
    layer_body<0>(lds_raw);
    layer_body<1>(lds_raw);
#if defined(STORE_TEST)
    phase_store_test(lds_raw);
#endif
#if defined(DBG_MIX0)
    phase_probe_apply(lds_raw);
#endif
    if (TIME_PHASE >= 0) { const Env e = penv(lds_raw); const unsigned ticks = __hip_atomic_load((unsigned*)e.ws + CW_PROBE + 8, __ATOMIC_RELAXED, __HIP_MEMORY_SCOPE_AGENT);
        const float f = 1.0f + 0.0005f * (float)ticks * 0.01f;
        for (long i = e.gtid; i < (long)T_ * 1024; i += e.gsz) e.out[i] *= f; }
}
extern "C" void kernel_launch(void* const* d_in, const int* in_sizes, int n_in, void* d_out, int out_size, void* d_ws, size_t ws_size, hipStream_t stream) {
    static int grid = 0;
    if (grid == 0) {
        int dev = 0, cus = 0, per_cu = 0;
        hipGetDevice(&dev); hipDeviceGetAttribute(&cus, hipDeviceAttributeMultiprocessorCount, dev);
        hipFuncSetAttribute((const void*)mega_fwd, hipFuncAttributeMaxDynamicSharedMemorySize, LDS_BYTES);
        hipOccupancyMaxActiveBlocksPerMultiprocessor(&per_cu, (const void*)mega_fwd, NTHREADS, LDS_BYTES);
        (void)hipGetLastError();
        grid = (per_cu >= 1) ? cus : -1;
    }
    if (grid < 0) return;
    hipMemsetAsync(d_ws, 0, CTL_BYTES, stream);
    Args a{};
    for (int i = 0; i < 38; ++i) a.in[i] = (const float*)d_in[i];
    a.out = (float*)d_out; a.ws = (unsigned char*)d_ws;
    hipLaunchKernelGGL(mega_fwd, dim3(grid), dim3(NTHREADS), LDS_BYTES, stream, a);
}
```

```cpp
#define OPT_MIX0 1
#define OPT_MIX1 1
#define OPT_ROUTER 1
#include <hip/hip_runtime.h>
#define GAS __attribute__((address_space(1)))
#define LAS __attribute__((address_space(3)))
#define XB_TMO      128
#define XB_XCNT(j)  (256  + 64 * (j))
#define XB_XSUB(j)  (1280 + 64 * (j))
#define XB_XGEN(j)  (2304 + 64 * (j))
#define XB_TOP      3328
#define XB_TOPGEN   3392
#define XCD_BAR_WORDS 3456
#define XB_SPIN_CAP (1u << 22)
__device__ __forceinline__ unsigned xb_ld(unsigned* p)              { return __hip_atomic_load(p, __ATOMIC_RELAXED, __HIP_MEMORY_SCOPE_AGENT); }
__device__ __forceinline__ unsigned xb_add(unsigned* p, unsigned v) { return __hip_atomic_fetch_add(p, v, __ATOMIC_RELAXED, __HIP_MEMORY_SCOPE_AGENT); }
__device__ __forceinline__ unsigned xb_xcc_id() { return (unsigned)__builtin_amdgcn_s_getreg((3 << 11) | 20) & 0xFu; }
#define XB_SPIN(cond, bar) do { unsigned _sp = 0; while (cond) { __builtin_amdgcn_s_sleep(1); \
    if ((++_sp & 255u) == 0u) { if (xb_ld(&(bar)[XB_TMO])) break; if (_sp > XB_SPIN_CAP) { atomicAdd(&(bar)[XB_TMO], 1u); break; } } } } while (0)
struct XcdBarrier { unsigned* bar; unsigned x; volatile LAS unsigned* st; };
__device__ __forceinline__ XcdBarrier xcd_barrier_post(unsigned* bar, volatile LAS unsigned* st) {
    XcdBarrier b; b.bar = bar; b.x = xb_xcc_id(); b.st = st;
    if (threadIdx.x == 0) (void)xb_add(&bar[XB_XCNT(b.x)], 1u);
    return b;
}
__device__ __forceinline__ void xcd_barrier_complete(unsigned* bar, unsigned x, unsigned& nloc, unsigned& nx) {
    const unsigned G = gridDim.x * gridDim.y * gridDim.z;
    unsigned sum, cnt, mine, sp = 0u;
    for (;;) {
        sum = 0u; cnt = 0u; mine = 0u;
#pragma unroll
        for (unsigned j = 0; j < 16; ++j) { const unsigned c = xb_ld(&bar[XB_XCNT(j)]); sum += c; cnt += (c > 0u) ? 1u : 0u; mine = (j == x) ? c : mine; }
        if (sum == G) break;
        __builtin_amdgcn_s_sleep(1);
        if ((++sp & 255u) == 0u) { if (xb_ld(&bar[XB_TMO])) break; if (sp > XB_SPIN_CAP) { atomicAdd(&bar[XB_TMO], 1u); break; } }
    }
    nloc = mine > 0u ? mine : 1u; nx = cnt > 0u ? cnt : 1u;
}
__device__ __forceinline__ void xcd_barrier(const XcdBarrier& b) {
    asm volatile("s_waitcnt vmcnt(0)" ::: "memory");
    __syncthreads();
    if (threadIdx.x == 0) {
        unsigned* bar = b.bar;
        __builtin_amdgcn_s_waitcnt(0);
        unsigned nloc = b.st[0], nx = b.st[1];
        if (nloc == 0u) { xcd_barrier_complete(bar, b.x, nloc, nx); b.st[0] = nloc; b.st[1] = nx; }
        const unsigned old = xb_add(&bar[XB_XSUB(b.x)], 1u);
        const unsigned gen = old / nloc;
        if (old + 1u == (gen + 1u) * nloc) {
            __builtin_amdgcn_fence(__ATOMIC_RELEASE, "agent");
            asm volatile("s_waitcnt vmcnt(0)" ::: "memory");
            const unsigned og = xb_add(&bar[XB_TOP], 1u);
            const unsigned tg = og / nx;
            if (og + 1u == (tg + 1u) * nx) xb_add(&bar[XB_TOPGEN], 1u);
            else XB_SPIN(xb_ld(&bar[XB_TOPGEN]) == tg, bar);
            __builtin_amdgcn_fence(__ATOMIC_ACQUIRE, "agent");
            xb_add(&bar[XB_XGEN(b.x)], 1u);
            asm volatile("s_waitcnt vmcnt(0)" ::: "memory");
        } else {
            XB_SPIN(xb_ld(&bar[XB_XGEN(b.x)]) == gen, bar);
            __builtin_amdgcn_fence(__ATOMIC_ACQUIRE, "agent");
            asm volatile("s_waitcnt vmcnt(0)" ::: "memory");
        }
    }
    __syncthreads();
}
namespace pg8 {
#define PG8_LAS __attribute__((address_space(3)))
typedef unsigned short bf16_t;
typedef short bf16x8 __attribute__((ext_vector_type(8)));
typedef float f32x4 __attribute__((ext_vector_type(4)));
typedef unsigned u32x4 __attribute__((ext_vector_type(4)));
constexpr int BM = 256, BK = 64, HALF = 128, HTB = HALF * BK * 2, STAGE_BYTES = 8 * HTB, NXCD = 8, WGM = 8;
__host__ __device__ __forceinline__ int lds_byte(int r, int c) { const int st = (r >> 4) * 2 + (c >> 5), rr = r & 15, cc = c & 31, ob = rr * 64 + cc * 2; return st * 1024 + (ob ^ (((ob >> 9) & 1) << 5)); }
__host__ __device__ __forceinline__ void stage_rc(int b, int& R, int& C) { const int st = b / 1024, sb = b % 1024, swz = sb ^ (((sb >> 9) & 1) << 5); R = (st >> 1) * 16 + swz / 64; C = (st & 1) * 32 + (swz % 64) / 2; }
__host__ __device__ __forceinline__ int perm32(int rho) { const int n = rho >> 4, i = rho & 15; return 8 * (i >> 2) + 4 * n + (i & 3); }
struct Unit { int pm, pn, e, aux; };
struct Gemm { const bf16_t* A; const bf16_t* Bt; int K; int pad; size_t bstride; const int* rows; };
struct StaticOrder {
    int nM, nN, nwg, G, c;
    __host__ __device__ void init(int M, int N, int G_, int c_) { nM = M / BM; nN = N / BM; nwg = nM * nN; G = G_; c = c_; }
    __host__ __device__ bool next(int i, Unit& u) const {
        const long L = (long)i * G + c; if (L >= nwg) return false;
        int wgid = (int)L; { const int q = nwg / NXCD, r = nwg % NXCD, xcd = wgid % NXCD, off = wgid / NXCD; wgid = (xcd < r ? xcd * (q + 1) : r * (q + 1) + (xcd - r) * q) + off; }
        const int nig = WGM * nN, gid = wgid / nig, fm = gid * WGM, gsz = (nM - fm) < WGM ? (nM - fm) : WGM;
        u.pm = fm + ((wgid % nig) % gsz); u.pn = (wgid % nig) / gsz; u.e = 0; u.aux = 0; return true;
    }
};
__device__ __forceinline__ unsigned cvt_pk_bf16(float lo, float hi) { unsigned r; asm volatile("v_cvt_pk_bf16_f32 %0, %1, %2" : "=v"(r) : "v"(lo), "v"(hi)); return r; }
struct EpiF32R {
    static constexpr int NPRE = 0; __device__ __forceinline__ void load_pre(const Unit&, int, int, int (&)[1]) const {}
    static constexpr bool PERM = false;
    float* C; int ldc; const float* R; float ralpha;
    __device__ __forceinline__ void operator()(const f32x4 (&acc)[2][2][4][2], const Unit& u, int wr, int wc, int fr, int fq) const {
        const int row0 = u.pm * BM + wr * 64 + fr, col0 = u.pn * BM + wc * 32 + 4 * fq;
#pragma unroll
        for (int ai = 0; ai < 2; ++ai)
#pragma unroll
            for (int m = 0; m < 4; ++m) { const size_t off = (size_t)(row0 + ai * HALF + m * 16) * ldc + col0;
#pragma unroll
                for (int bj = 0; bj < 2; ++bj)
#pragma unroll
                    for (int n = 0; n < 2; ++n) { f32x4 v = acc[ai][bj][m][n]; if (R) v = v + ralpha * *(const f32x4*)(R + off + bj * HALF + n * 16); *(f32x4*)(C + off + bj * HALF + n * 16) = v; } }
    }
};
struct EpiBf16P {
    static constexpr int NPRE = 0; __device__ __forceinline__ void load_pre(const Unit&, int, int, int (&)[1]) const {}
    static constexpr bool PERM = true;
    bf16_t* O; int ldc;
    __device__ __forceinline__ void operator()(const f32x4 (&acc)[2][2][4][2], const Unit& u, int wr, int wc, int fr, int fq) const {
        const int row0 = u.pm * BM + wr * 64 + fr, col0 = u.pn * BM + wc * 32 + 8 * fq;
#pragma unroll
        for (int ai = 0; ai < 2; ++ai)
#pragma unroll
            for (int m = 0; m < 4; ++m) { bf16_t* rowp = O + (size_t)(row0 + ai * HALF + m * 16) * ldc + col0;
#pragma unroll
                for (int bj = 0; bj < 2; ++bj) { const f32x4 v0 = acc[ai][bj][m][0], v1 = acc[ai][bj][m][1];
                    u32x4 w; w.x = cvt_pk_bf16(v0[0], v0[1]); w.y = cvt_pk_bf16(v0[2], v0[3]); w.z = cvt_pk_bf16(v1[0], v1[1]); w.w = cvt_pk_bf16(v1[2], v1[3]);
                    *(u32x4*)(rowp + bj * HALF) = w; } }
    }
};
struct EpiGlu {
    static constexpr int NPRE = 0; __device__ __forceinline__ void load_pre(const Unit&, int, int, int (&)[1]) const {}
    static constexpr bool PERM = true;
    bf16_t* O; int ldo; const bf16_t* Gm; int ldg; const float* bias;
    __device__ __forceinline__ void operator()(const f32x4 (&acc)[2][2][4][2], const Unit& u, int wr, int wc, int fr, int fq) const {
        const int row0 = u.pm * BM + wr * 64 + fr, col0 = u.pn * BM + wc * 32 + 8 * fq;
#pragma unroll
        for (int ai = 0; ai < 2; ++ai)
#pragma unroll
            for (int m = 0; m < 4; ++m) { const size_t r = (size_t)(row0 + ai * HALF + m * 16);
#pragma unroll
                for (int bj = 0; bj < 2; ++bj) { const int c = col0 + bj * HALF;
                    const f32x4 b0 = *(const f32x4*)(bias + c), b1 = *(const f32x4*)(bias + c + 4); const u32x4 gv = *(const u32x4*)(Gm + r * ldg + c);
                    const f32x4 v0 = acc[ai][bj][m][0] + b0, v1 = acc[ai][bj][m][1] + b1;
                    float g[8] = {__builtin_bit_cast(float, gv.x << 16), __builtin_bit_cast(float, gv.x & 0xffff0000u), __builtin_bit_cast(float, gv.y << 16), __builtin_bit_cast(float, gv.y & 0xffff0000u),
                                  __builtin_bit_cast(float, gv.z << 16), __builtin_bit_cast(float, gv.z & 0xffff0000u), __builtin_bit_cast(float, gv.w << 16), __builtin_bit_cast(float, gv.w & 0xffff0000u)};
                    u32x4 w; w.x = cvt_pk_bf16(g[0] / (1.f + __expf(-v0[0])), g[1] / (1.f + __expf(-v0[1]))); w.y = cvt_pk_bf16(g[2] / (1.f + __expf(-v0[2])), g[3] / (1.f + __expf(-v0[3])));
                    w.z = cvt_pk_bf16(g[4] / (1.f + __expf(-v1[0])), g[5] / (1.f + __expf(-v1[1]))); w.w = cvt_pk_bf16(g[6] / (1.f + __expf(-v1[2])), g[7] / (1.f + __expf(-v1[3])));
                    *(u32x4*)(O + r * ldo + c) = w; } }
    }
};
template <class Epi, class Sched, bool ALIGN_EPI, bool GATHER>
__device__ __forceinline__ void gemm_phase(PG8_LAS unsigned char* lds, const Gemm g, const Sched& S, const Epi& E) {
    int tid_ = threadIdx.x; asm volatile("" : "+v"(tid_));
    const int tid = tid_, wid = __builtin_amdgcn_readfirstlane(tid >> 6), lane = tid & 63, wr = wid >> 2, wc = wid & 3, fr = lane & 15, fq = lane >> 4;
    const int K = g.K, nt = K / BK;
    unsigned voffA[2], voffB[2];
#pragma unroll
    for (int i = 0; i < 2; ++i) { int R, C; stage_rc(tid * 16 + i * 8192, R, C); const int Rb = Epi::PERM ? ((R & ~31) + perm32(R & 31)) : R;
        voffA[i] = (unsigned)(R * K + C) * 2u; voffB[i] = (unsigned)(Rb * K + C) * 2u; }
    const size_t kstep = (size_t)(BK * 2);
    const size_t hstep = (size_t)HALF * K * 2;
    const size_t tstep = 2 * hstep;
    const unsigned ldsw = (unsigned)wid * 1024u;
    const int aoff = lds_byte(wr * 64 + fr, fq * 8), boff = lds_byte(wc * 32 + fr, fq * 8);
#define PG8_SA(b, h) (((b) * 2 + (h)) * HTB)
#define PG8_SB(b, h) ((4 + (b) * 2 + (h)) * HTB)
#define PG8_STAGE(bufoff, gbase, voff) do { _Pragma("unroll") for (int _i = 0; _i < 2; ++_i) { unsigned _vo = (voff)[_i]; asm volatile("" : "+v"(_vo));   \
        __builtin_amdgcn_global_load_lds((const unsigned*)((const char*)(gbase) + _vo), (PG8_LAS unsigned*)(lds + (bufoff) + ldsw + _i * 8192), 16, 0, 0); } } while (0)
#define PG8_STAGE_A(bufoff, gbase, h, GV) do { if constexpr (GATHER) { PG8_STAGE(bufoff, gbase, GV[h]); } else { PG8_STAGE(bufoff, (gbase) + (h) * hstep, voffA); } } while (0)
#define PG8_STAGE_A2(bufoff, gbase, h) do { if constexpr (GATHER) { unsigned _gv[2] = {last ? gnxt[h][0] : gcur[h][0], last ? gnxt[h][1] : gcur[h][1]}; PG8_STAGE(bufoff, gbase, _gv); } else { PG8_STAGE(bufoff, (gbase) + (h) * hstep, voffA); } } while (0)
#define PG8_LDA(dst, b, h) do { _Pragma("unroll") for (int m = 0; m < 4; ++m) _Pragma("unroll") for (int k = 0; k < 2; ++k) dst[m][k] = *(const PG8_LAS bf16x8*)(lds + PG8_SA(b, h) + aoff + m * 2048 + k * 1024); } while (0)
#define PG8_LDB(dst, b, h) do { _Pragma("unroll") for (int n = 0; n < 2; ++n) _Pragma("unroll") for (int k = 0; k < 2; ++k) dst[n][k] = *(const PG8_LAS bf16x8*)(lds + PG8_SB(b, h) + boff + n * 2048 + k * 1024); } while (0)
#define PG8_MMA(ai, bj, At, Bt) do { __builtin_amdgcn_s_setprio(1); _Pragma("unroll") for (int m = 0; m < 4; ++m) _Pragma("unroll") for (int n = 0; n < 2; ++n) _Pragma("unroll") for (int k = 0; k < 2; ++k) \
        acc[ai][bj][m][n] = __builtin_amdgcn_mfma_f32_16x16x32_bf16(Bt[n][k], At[m][k], acc[ai][bj][m][n], 0, 0, 0); __builtin_amdgcn_s_setprio(0); } while (0)
#define PG8_WAIT_V(n) asm volatile("s_waitcnt vmcnt(" #n ")" ::: "memory")
#define PG8_WAIT_L(n) asm volatile("s_waitcnt lgkmcnt(" #n ")" ::: "memory")
#define PG8_BAR __builtin_amdgcn_s_barrier()
#define PG8_SCHED __builtin_amdgcn_sched_barrier(0)
#define PG8_GLOAD(GV, u) do { _Pragma("unroll") for (int _i = 0; _i < 2; ++_i) { int _R, _C; stage_rc(tid * 16 + _i * 8192, _R, _C); _Pragma("unroll") for (int _h = 0; _h < 2; ++_h) \
        GV[_h][_i] = (unsigned)g.rows[(u).pm * BM + _h * HALF + _R] * (unsigned)(K * 2) + (unsigned)(_C * 2); } } while (0)
    Unit cur, nxt; int ui = 0;
    if (!S.next(0, cur)) return;
    f32x4 acc[2][2][4][2];
#pragma unroll
    for (int a = 0; a < 2; ++a)
#pragma unroll
        for (int b = 0; b < 2; ++b)
#pragma unroll
            for (int m = 0; m < 4; ++m)
#pragma unroll
                for (int n = 0; n < 2; ++n) acc[a][b][m][n] = (f32x4){0.f, 0.f, 0.f, 0.f};
    bf16x8 At[4][2], B0[2][2], B1[2][2];
    unsigned gcur[2][2] = {{0u, 0u}, {0u, 0u}}, gnxt[2][2] = {{0u, 0u}, {0u, 0u}};
    if constexpr (Epi::NPRE > 0) E.prefetch(cur, 0, lds, wid, lane);
    if constexpr (GATHER) { PG8_GLOAD(gcur, cur); }
    const char* cA = GATHER ? (const char*)g.A : (const char*)g.A + (size_t)cur.pm * tstep;
    const char* cB = (const char*)g.Bt + ((size_t)cur.e * g.bstride) * 2 + (size_t)cur.pn * tstep;
    PG8_STAGE(PG8_SB(0, 0), cB, voffB); PG8_STAGE(PG8_SB(0, 1), cB + hstep, voffB); PG8_STAGE_A(PG8_SA(0, 0), cA, 0, gcur); PG8_STAGE_A(PG8_SA(0, 1), cA, 1, gcur);
    if (wr == 1) PG8_BAR;
    PG8_WAIT_V(2); PG8_BAR;
    PG8_STAGE(PG8_SB(1, 0), cB + kstep, voffB); PG8_STAGE_A(PG8_SA(1, 0), cA + kstep, 0, gcur); PG8_STAGE(PG8_SB(1, 1), cB + hstep + kstep, voffB);
    PG8_WAIT_V(6); PG8_BAR;
    for (;;) {
        const bool has_next = S.next(ui + 1, nxt);
        if constexpr (Epi::NPRE > 0) { if (has_next) E.prefetch(nxt, (ui + 1) % 3, lds, wid, lane); }
        if constexpr (GATHER) { if (has_next) { PG8_GLOAD(gnxt, nxt); } else {
#pragma unroll
            for (int _h = 0; _h < 2; ++_h)
#pragma unroll
                for (int _i = 0; _i < 2; ++_i) gnxt[_h][_i] = gcur[_h][_i]; } }
        const char* nA = GATHER ? cA : (has_next ? (const char*)g.A + (size_t)nxt.pm * tstep : cA);
        const char* nB = has_next ? (const char*)g.Bt + ((size_t)nxt.e * g.bstride) * 2 + (size_t)nxt.pn * tstep : cB;
#pragma unroll 1
        for (int t = 0; t < nt; t += 2) {
            const bool last = (t == nt - 2);
            const char* a1 = cA + (size_t)(t + 1) * kstep;
            const char* a2 = last ? nA : cA + (size_t)(t + 2) * kstep; const char* b2 = last ? nB : cB + (size_t)(t + 2) * kstep;
            const char* a3 = a2 + kstep; const char* b3 = b2 + kstep;
            PG8_LDB(B0, 0, 0); PG8_LDB(B1, 0, 1); PG8_SCHED; PG8_LDA(At, 0, 0); PG8_STAGE_A(PG8_SA(1, 1), a1, 1, gcur);
            PG8_WAIT_V(8); PG8_WAIT_L(0); PG8_BAR; PG8_MMA(0, 0, At, B0); PG8_MMA(0, 1, At, B1); PG8_BAR; PG8_SCHED;
            PG8_LDA(At, 0, 1); PG8_STAGE(PG8_SB(0, 0), b2, voffB); PG8_STAGE(PG8_SB(0, 1), b2 + hstep, voffB); PG8_STAGE_A2(PG8_SA(0, 0), a2, 0);
            PG8_WAIT_V(8); PG8_WAIT_L(0); PG8_BAR; PG8_MMA(1, 0, At, B0); PG8_MMA(1, 1, At, B1); PG8_BAR; PG8_SCHED;
            PG8_LDB(B0, 1, 0); PG8_LDB(B1, 1, 1); PG8_SCHED; PG8_LDA(At, 1, 0); PG8_STAGE_A2(PG8_SA(0, 1), a2, 1);
            PG8_WAIT_V(8); PG8_WAIT_L(0); PG8_BAR; PG8_MMA(0, 0, At, B0); PG8_MMA(0, 1, At, B1); PG8_BAR; PG8_SCHED;
            PG8_LDA(At, 1, 1); PG8_STAGE(PG8_SB(1, 0), b3, voffB); PG8_STAGE(PG8_SB(1, 1), b3 + hstep, voffB); PG8_STAGE_A2(PG8_SA(1, 0), a3, 0);
            PG8_WAIT_V(8); PG8_WAIT_L(0); PG8_BAR; PG8_MMA(1, 0, At, B0); PG8_MMA(1, 1, At, B1); PG8_BAR; PG8_SCHED;
        }
        if constexpr (ALIGN_EPI) { if (wr == 0) PG8_BAR; }
        if constexpr (Epi::NPRE > 0) E(acc, cur, wr, wc, fr, fq, ui % 3, lds); else E(acc, cur, wr, wc, fr, fq);
        if (!has_next) break;
#pragma unroll
        for (int a = 0; a < 2; ++a)
#pragma unroll
            for (int b = 0; b < 2; ++b)
#pragma unroll
                for (int m = 0; m < 4; ++m)
#pragma unroll
                    for (int n = 0; n < 2; ++n) acc[a][b][m][n] = (f32x4){0.f, 0.f, 0.f, 0.f};
        cur = nxt; cA = nA; cB = nB; ++ui;
        if constexpr (GATHER) {
#pragma unroll
            for (int _h = 0; _h < 2; ++_h)
#pragma unroll
                for (int _i = 0; _i < 2; ++_i) gcur[_h][_i] = gnxt[_h][_i]; }
        if constexpr (ALIGN_EPI) { if (wr == 1) PG8_BAR; }
    }
    PG8_WAIT_V(0);
    if constexpr (!ALIGN_EPI) { if (wr == 0) PG8_BAR; }
    PG8_BAR;
#undef PG8_SA
#undef PG8_SB
#undef PG8_STAGE
#undef PG8_STAGE_A
#undef PG8_STAGE_A2
#undef PG8_LDA
#undef PG8_LDB
#undef PG8_MMA
#undef PG8_WAIT_V
#undef PG8_WAIT_L
#undef PG8_BAR
#undef PG8_SCHED
#undef PG8_GLOAD
}
}
typedef unsigned short bf16;
typedef unsigned v4u __attribute__((ext_vector_type(4)));
typedef unsigned v2u __attribute__((ext_vector_type(2)));
typedef float f32x4 __attribute__((ext_vector_type(4)));
constexpr int NTHREADS = 512, NWAVES = 8;
constexpr int LDS_BYTES = 163840;
constexpr int LDS_CTL = 155648;
constexpr int MISC_OFF = LDS_CTL + 320;
constexpr size_t MiB = 1u << 20;
constexpr size_t CTL_BYTES = 1 * MiB;
#if !defined(WITH_NAIVE)
namespace nv { constexpr int B_ = 2, S_ = 8192, T_ = B_ * S_, NCH = S_ / 64, EIN = 3080, OIN = 2064; constexpr float ALPHA = 1.41421356237309515f, EPS = 1e-5f; struct Mem { float* base; size_t off; }; }
#endif
constexpr int T_ = nv::T_, S_ = nv::S_, NCH = nv::NCH;
constexpr int EINP = 3328, OINP = 2304;
#define LDS_WAIT() asm volatile("s_waitcnt lgkmcnt(0)" ::: "memory")
typedef __bf16 hwbf2_t __attribute__((ext_vector_type(2)));
typedef float hwf2_t __attribute__((ext_vector_type(2)));
__device__ __forceinline__ unsigned f2bf(float f) { const __bf16 b = (__bf16)f; return (unsigned)__builtin_bit_cast(unsigned short, b); }
__device__ __forceinline__ unsigned pk2(float lo, float hi) { const hwf2_t v = {lo, hi}; return __builtin_bit_cast(unsigned, __builtin_convertvector(v, hwbf2_t)); }
__device__ __forceinline__ float bf2f(unsigned short b) { return __builtin_bit_cast(float, (unsigned)b << 16); }
__device__ __forceinline__ void tr_item(const float* W, long ldw, int nvalid, bf16* dst, long ldd, LAS float* scr, int lane) {
#pragma unroll 8
    for (int i = 0; i < 32; ++i) { const int kk = 2 * i + (lane >> 5), nn = lane & 31; scr[kk * 33 + nn] = nn < nvalid ? W[(long)kk * ldw + nn] : 0.f; }
    LDS_WAIT(); asm volatile("" ::: "memory");
    const int c = lane & 7;
#pragma unroll
    for (int j = 0; j < 4; ++j) { const int n = (lane >> 3) + 8 * j; const LAS float* s = scr + (8 * c) * 33 + n;
        v4u o; o.x = pk2(s[0 * 33], s[1 * 33]); o.y = pk2(s[2 * 33], s[3 * 33]); o.z = pk2(s[4 * 33], s[5 * 33]); o.w = pk2(s[6 * 33], s[7 * 33]);
        *(v4u*)(dst + (long)n * ldd + 8 * c) = o; }
    LDS_WAIT(); asm volatile("" ::: "memory");
}
__device__ __forceinline__ void tr_item64(const float* W, long ldw, int nvalid, bf16* dst, long ldd, LAS float* scr, int lane) {
    const int nn = (lane & 15) * 4;
#pragma unroll
    for (int i = 0; i < 16; ++i) { const int kk = 4 * i + (lane >> 4);
        f32x4 v = {0.f, 0.f, 0.f, 0.f}; if (nn < nvalid) v = *(const f32x4*)(W + (long)kk * ldw + nn);
        LAS float* s = scr + kk * 65 + nn; s[0] = v.x; s[1] = v.y; s[2] = v.z; s[3] = v.w; }
    LDS_WAIT(); asm volatile("" ::: "memory");
    const int c = lane & 7;
#pragma unroll
    for (int j = 0; j < 8; ++j) { const int n = (lane >> 3) + 8 * j; const LAS float* s = scr + (8 * c) * 65 + n;
        v4u o; o.x = pk2(s[0 * 65], s[1 * 65]); o.y = pk2(s[2 * 65], s[3 * 65]); o.z = pk2(s[4 * 65], s[5 * 65]); o.w = pk2(s[6 * 65], s[7 * 65]);
        *(v4u*)(dst + (long)n * ldd + 8 * c) = o; }
    LDS_WAIT(); asm volatile("" ::: "memory");
}
__device__ __forceinline__ void tr_matrix(const float* W, int K, int N, int NP, bf16* WT, LAS float* scr, int gw, int NGW, int lane) {
    const int nblk = NP / 64, nitems = (K / 64) * nblk;
    for (int it = gw; it < nitems; it += NGW) { const int kb = it / nblk, nb = it % nblk, k0 = 64 * kb, n0 = 64 * nb; int nvalid = N - n0; nvalid = nvalid < 0 ? 0 : (nvalid > 64 ? 64 : nvalid);
        tr_item64(W + (long)k0 * N + n0, N, nvalid, WT + (long)n0 * K + k0, K, scr, lane); }
}
__device__ __forceinline__ void tr_matrix_item(const float* W, int K, int N, int NP, bf16* WT, LAS float* scr, int it, int lane) {
    const int nblk = NP / 64, kb = it / nblk, nb = it % nblk, k0 = 64 * kb, n0 = 64 * nb; int nvalid = N - n0; nvalid = nvalid < 0 ? 0 : (nvalid > 64 ? 64 : nvalid);
    tr_item64(W + (long)k0 * N + n0, N, nvalid, WT + (long)n0 * K + k0, K, scr, lane);
}
__device__ __forceinline__ void cvt_rows(const float* src, bf16* dst, long n, long gtid, long gsz) {
    long i = gtid * 8;
    for (; i + 3 * gsz * 8 < n; i += 4 * gsz * 8) {
        f32x4 a[4], b[4];
#pragma unroll
        for (int u = 0; u < 4; ++u) { a[u] = *(const f32x4*)(src + i + u * gsz * 8); b[u] = *(const f32x4*)(src + i + u * gsz * 8 + 4); }
#pragma unroll
        for (int u = 0; u < 4; ++u) { v4u o; o.x = pk2(a[u].x, a[u].y); o.y = pk2(a[u].z, a[u].w); o.z = pk2(b[u].x, b[u].y); o.w = pk2(b[u].z, b[u].w); *(v4u*)(dst + i + u * gsz * 8) = o; } }
    for (; i < n; i += gsz * 8) { const f32x4 a = *(const f32x4*)(src + i), b = *(const f32x4*)(src + i + 4);
        v4u o; o.x = pk2(a.x, a.y); o.y = pk2(a.z, a.w); o.z = pk2(b.x, b.y); o.w = pk2(b.z, b.w); *(v4u*)(dst + i) = o; }
}
__device__ __forceinline__ int sopaque(int v) { asm volatile("" : "+s"(v)); return v; }
__device__ __forceinline__ float wave_sum(float v) {
#define WS_STEP(o) v += __builtin_bit_cast(float, __builtin_amdgcn_ds_swizzle(__builtin_bit_cast(int, v), 0x1f | ((o) << 10)))
    WS_STEP(1); WS_STEP(2); WS_STEP(4); WS_STEP(8); WS_STEP(16);
#undef WS_STEP
    return __builtin_bit_cast(float, __builtin_amdgcn_readlane(__builtin_bit_cast(int, v), 0)) + __builtin_bit_cast(float, __builtin_amdgcn_readlane(__builtin_bit_cast(int, v), 32));
}
#ifndef DBG_SCALE
#define DBG_SCALE 20.0f
#endif
constexpr int MOE_MAXBLK = 640;
constexpr int CW_CNT = 8192, CW_CUR = 8192 + 128;
namespace pg8 {
struct MoeOrder {
    const int* blk_e; int nblk, npn, G, c;
    __device__ __forceinline__ bool next(int i, Unit& u) const {
        const long L = (long)i * G + c; if (L >= (long)nblk * npn) return false;
        const int blk = (int)(L / npn); u.pm = blk; u.pn = (int)(L % npn); u.e = __builtin_amdgcn_readfirstlane(blk_e[blk]); u.aux = 0; return true;
    }
};
__device__ __forceinline__ float silu_f(float x) { return x / (1.0f + __expf(-x)); }
struct EpiSwiGLU {
    static constexpr int NPRE = 0; __device__ __forceinline__ void load_pre(const Unit&, int, int, int (&)[1]) const {}
    static constexpr bool PERM = true;
    bf16_t* H;
    __device__ __forceinline__ void operator()(const f32x4 (&acc)[2][2][4][2], const Unit& u, int wr, int wc, int fr, int fq) const {
        const int row0 = u.pm * BM + wr * 64 + fr, col0 = u.pn * 128 + wc * 32 + 8 * fq;
#pragma unroll
        for (int ai = 0; ai < 2; ++ai)
#pragma unroll
            for (int m = 0; m < 4; ++m) { bf16_t* rowp = H + (size_t)(row0 + ai * HALF + m * 16) * 256 + col0;
                const f32x4 g0 = acc[ai][0][m][0], g1 = acc[ai][0][m][1], u0 = acc[ai][1][m][0], u1 = acc[ai][1][m][1];
                u32x4 w; w.x = cvt_pk_bf16(silu_f(g0[0]) * u0[0], silu_f(g0[1]) * u0[1]); w.y = cvt_pk_bf16(silu_f(g0[2]) * u0[2], silu_f(g0[3]) * u0[3]);
                w.z = cvt_pk_bf16(silu_f(g1[0]) * u1[0], silu_f(g1[1]) * u1[1]); w.w = cvt_pk_bf16(silu_f(g1[2]) * u1[2], silu_f(g1[3]) * u1[3]);
                *(u32x4*)rowp = w; }
    }
};
struct EpiDown {
    static constexpr bool PERM = true; static constexpr int NPRE = 1;
    bf16_t* rows8; bf16_t* rows_sh; const int* dest; int nslot8;
    __device__ __forceinline__ void prefetch(const Unit& u, int slot, PG8_LAS unsigned char* lds, int wid, int lane) const {
        if (wid < 4) __builtin_amdgcn_global_load_lds((const unsigned*)(dest + u.pm * BM + wid * 64 + lane), (PG8_LAS unsigned*)(lds + STAGE_BYTES + slot * 1024 + wid * 256), 4, 0, 0);
    }
    __device__ __forceinline__ void operator()(const f32x4 (&acc)[2][2][4][2], const Unit& u, int wr, int wc, int fr, int fq, int slot, PG8_LAS unsigned char* lds) const {
        const int col0 = u.pn * BM + wc * 32 + 8 * fq; const PG8_LAS int* dl = (const PG8_LAS int*)(lds + STAGE_BYTES + slot * 1024) + wr * 64 + fr;
#pragma unroll
        for (int ai = 0; ai < 2; ++ai)
#pragma unroll
            for (int m = 0; m < 4; ++m) { const int d = dl[ai * HALF + m * 16];
                if (d >= 0) { bf16_t* rowp = (d < nslot8 ? rows8 + (size_t)d * 1024 : rows_sh + (size_t)(d - nslot8) * 1024) + col0;
#pragma unroll
                    for (int bj = 0; bj < 2; ++bj) { const f32x4 v0 = acc[ai][bj][m][0], v1 = acc[ai][bj][m][1];
                        u32x4 o; o.x = cvt_pk_bf16(v0[0], v0[1]); o.y = cvt_pk_bf16(v0[2], v0[3]); o.z = cvt_pk_bf16(v1[0], v1[1]); o.w = cvt_pk_bf16(v1[2], v1[3]);
#if defined(NT_STORES)
                        __builtin_nontemporal_store(o, (u32x4*)(rowp + bj * HALF));
#else
                        *(u32x4*)(rowp + bj * HALF) = o;
#endif
                        } } }
    }
};
}
__device__ __forceinline__ void moe_convert_weights(const float* wg, const float* wu, const float* wd, const float* sg, const float* su, const float* sd,
                                                    bf16* WGU, bf16* WD, LAS float* scr, int first, int last, int stride, int lane) {
    for (int it = first; it < last; it += stride) {
        const int e = it / 192, r = it % 192, kind = r >> 6, q = r & 63;
        if (kind < 2) { const float* W = (e < 64 ? (kind == 0 ? wg : wu) + (size_t)e * 262144 : (kind == 0 ? sg : su));
            const int kb = q >> 2, nb = q & 3, k0 = 64 * kb, n0 = 64 * nb;
            tr_item64(W + (size_t)k0 * 256 + n0, 256, 64, WGU + ((size_t)e * 512 + (n0 >> 7) * 256 + (n0 & 127) + kind * 128) * 1024 + k0, 1024, scr, lane);
        } else { const float* W = e < 64 ? wd + (size_t)e * 262144 : sd;
            const int kb = q >> 4, nb = q & 15, k0 = 64 * kb, n0 = 64 * nb;
            tr_item64(W + (size_t)k0 * 1024 + n0, 1024, 64, WD + ((size_t)e * 1024 + n0) * 256 + k0, 256, scr, lane); }
    }
}
struct MoeLists { int* tok; int* dest; float* w; int* blk_e; };
__device__ __forceinline__ void moe_count(const int* ridx, unsigned* cnt, LAS unsigned* hist, int tid, int bid, int G) {
    if (tid < 64) hist[tid] = 0u;
    __syncthreads();
    for (int i = bid * NTHREADS + tid; i < T_ * 8; i += G * NTHREADS) atomicAdd((unsigned*)&hist[ridx[i]], 1u);
    __syncthreads();
    if (tid < 64 && hist[tid]) atomicAdd(&cnt[tid], hist[tid]);
    __syncthreads();
}
__device__ __forceinline__ void moe_build_lists(const int* ridx, const float* rwt, const unsigned* cnt, unsigned* cur, const MoeLists L, LAS int* sm, int tid, int bid, int G) {
    LAS int* pstart = sm; LAS unsigned* hist = (LAS unsigned*)(sm + 80); LAS unsigned* base = (LAS unsigned*)(sm + 160);
    if (tid == 0) { int acc = 0;
#pragma unroll 1
        for (int e = 0; e < 64; ++e) { pstart[e] = acc; acc += ((int)__hip_atomic_load(&cnt[e], __ATOMIC_RELAXED, __HIP_MEMORY_SCOPE_AGENT) + 255) & ~255; } pstart[64] = acc; pstart[65] = acc + T_; }
    __syncthreads();
    const int per = (T_ * 8 + G - 1) / G;
    const int lo = bid * per, hi = (lo + per < T_ * 8) ? lo + per : T_ * 8;
    for (int c0 = lo; c0 < hi; c0 += NTHREADS) {
        if (tid < 64) hist[tid] = 0u;
        __syncthreads();
        const int i = c0 + tid; int e = 0; unsigned local = 0u;
        if (i < hi) { e = ridx[i]; local = atomicAdd((unsigned*)&hist[e], 1u); }
        __syncthreads();
        if (tid < 64) base[tid] = hist[tid] ? atomicAdd(&cur[tid], hist[tid]) : 0u;
        __syncthreads();
        if (i < hi) { const int pos = pstart[e] + (int)base[e] + (int)local; L.tok[pos] = i >> 3; L.dest[pos] = i; L.w[pos] = rwt[i]; }
        __syncthreads();
    }
    for (int e = bid; e < 64; e += G) { const int c = (int)__hip_atomic_load(&cnt[e], __ATOMIC_RELAXED, __HIP_MEMORY_SCOPE_AGENT);
        for (int p = pstart[e] + c + tid; p < pstart[e + 1]; p += NTHREADS) { L.tok[p] = 0; L.dest[p] = -1; L.w[p] = 0.f; } }
    for (int t = bid * NTHREADS + tid; t < T_; t += G * NTHREADS) { const int p = pstart[64] + t; L.tok[p] = t; L.dest[p] = T_ * 8 + t; L.w[p] = 1.f; }
    const int nblk = pstart[65] >> 8;
    for (int b = bid * NTHREADS + tid; b < nblk; b += G * NTHREADS) { int e = 0;
#pragma unroll 1
        while (e < 64 && (pstart[e + 1] >> 8) <= b) ++e;
        L.blk_e[b] = e; }
    if (bid == 0 && tid == 0) L.blk_e[MOE_MAXBLK] = nblk;
    __syncthreads();
}
__device__ __forceinline__ void moe_combine_ln(float* h, const bf16* rows8, const bf16* rows_sh, const float* rwt, const float* lw, const float* lb, bf16* hbf, int gw, int NGW, int lane) {
    int t = gw; if (t >= T_) return;
    v4u rr[2][9]; f32x4 hh[4]; float wk[8];
#define CB_LOAD(tt) do { const size_t _t = (size_t)(tt); \
        _Pragma("unroll") for (int half = 0; half < 2; ++half) { const int c0 = half * 512 + lane * 8; \
            hh[half * 2] = *(const f32x4*)(h + _t * 1024 + c0); hh[half * 2 + 1] = *(const f32x4*)(h + _t * 1024 + c0 + 4); \
            _Pragma("unroll") for (int k = 0; k < 9; ++k) rr[half][k] = *(const v4u*)((k < 8 ? rows8 + (_t * 8 + k) * 1024 : rows_sh + _t * 1024) + c0); } \
        _Pragma("unroll") for (int k = 0; k < 8; ++k) wk[k] = rwt[_t * 8 + k]; } while (0)
    CB_LOAD(t);
    for (; t < T_; t += NGW) {
        float v[16];
#pragma unroll
        for (int half = 0; half < 2; ++half) { const f32x4 a = hh[half * 2], b = hh[half * 2 + 1];
            float s[8] = {a.x * nv::ALPHA, a.y * nv::ALPHA, a.z * nv::ALPHA, a.w * nv::ALPHA, b.x * nv::ALPHA, b.y * nv::ALPHA, b.z * nv::ALPHA, b.w * nv::ALPHA};
#pragma unroll
            for (int k = 0; k < 9; ++k) { const v4u r = rr[half][k]; const float w = k < 8 ? wk[k] : 1.0f;
                s[0] += w * __builtin_bit_cast(float, r.x << 16); s[1] += w * __builtin_bit_cast(float, r.x & 0xffff0000u);
                s[2] += w * __builtin_bit_cast(float, r.y << 16); s[3] += w * __builtin_bit_cast(float, r.y & 0xffff0000u);
                s[4] += w * __builtin_bit_cast(float, r.z << 16); s[5] += w * __builtin_bit_cast(float, r.z & 0xffff0000u);
                s[6] += w * __builtin_bit_cast(float, r.w << 16); s[7] += w * __builtin_bit_cast(float, r.w & 0xffff0000u); }
#pragma unroll
            for (int j = 0; j < 8; ++j) v[half * 8 + j] = s[j]; }
        if (t + NGW < T_) CB_LOAD(t + NGW);
        float sum = 0.f;
#pragma unroll
        for (int j = 0; j < 16; ++j) sum += v[j];
        sum = wave_sum(sum);
        const float mean = sum * (1.f / 1024.f);
        float sq = 0.f;
#pragma unroll
        for (int j = 0; j < 16; ++j) { v[j] -= mean; sq += v[j] * v[j]; }
        sq = wave_sum(sq);
        const float rstd = 1.0f / sqrtf(sq * (1.f / 1024.f) + nv::EPS);
#pragma unroll
        for (int half = 0; half < 2; ++half) { const int c0 = half * 512 + lane * 8;
            const f32x4 w0 = *(const f32x4*)(lw + c0), w1 = *(const f32x4*)(lw + c0 + 4), b0 = *(const f32x4*)(lb + c0), b1 = *(const f32x4*)(lb + c0 + 4);
            f32x4 o0, o1;
            o0.x = v[half * 8 + 0] * rstd * w0.x + b0.x; o0.y = v[half * 8 + 1] * rstd * w0.y + b0.y; o0.z = v[half * 8 + 2] * rstd * w0.z + b0.z; o0.w = v[half * 8 + 3] * rstd * w0.w + b0.w;
            o1.x = v[half * 8 + 4] * rstd * w1.x + b1.x; o1.y = v[half * 8 + 5] * rstd * w1.y + b1.y; o1.z = v[half * 8 + 6] * rstd * w1.z + b1.z; o1.w = v[half * 8 + 7] * rstd * w1.w + b1.w;
            *(f32x4*)(h + (size_t)t * 1024 + c0) = o0; *(f32x4*)(h + (size_t)t * 1024 + c0 + 4) = o1;
            if (hbf) { v4u p; p.x = pk2(o0.x, o0.y); p.y = pk2(o0.z, o0.w); p.z = pk2(o1.x, o1.y); p.w = pk2(o1.z, o1.w); *(v4u*)(hbf + (size_t)t * 1024 + c0) = p; } }
    }
#undef CB_LOAD
}
typedef float f32x16 __attribute__((ext_vector_type(16)));
typedef short s16x8 __attribute__((ext_vector_type(8)));
typedef LAS unsigned short lbf16;
__device__ __forceinline__ void mm32(f32x16& acc, const lbf16* A, int lda, const lbf16* B, int ldb, int K, int lane) {
    const lbf16* ap = A + (lane & 31) * lda + 8 * (lane >> 5);
    const lbf16* bp = B + (lane & 31) * ldb + 8 * (lane >> 5);
#pragma unroll 4
    for (int k = 0; k < K; k += 16) {
        const s16x8 a = *(const LAS s16x8*)(ap + k), b = *(const LAS s16x8*)(bp + k);
        acc = __builtin_amdgcn_mfma_f32_32x32x16_bf16(a, b, acc, 0, 0, 0);
    }
}
__device__ __forceinline__ void mm32_gb(f32x16& acc, const lbf16* A, int lda, const bf16* B, int ldb, int K, int lane) {
    const lbf16* ap = A + (lane & 31) * lda + 8 * (lane >> 5);
    const bf16* bp = B + (size_t)(lane & 31) * ldb + 8 * (lane >> 5);
#pragma unroll 4
    for (int k = 0; k < K; k += 16) {
        const s16x8 a = *(const LAS s16x8*)(ap + k), b = *(const s16x8*)(bp + k);
        acc = __builtin_amdgcn_mfma_f32_32x32x16_bf16(a, b, acc, 0, 0, 0);
    }
}
__device__ __forceinline__ int rowmap(int r, int lane) { return (r & 3) + 8 * (r >> 2) + 4 * (lane >> 5); }
__device__ __forceinline__ float sigm_f(float x) { return 1.0f / (1.0f + __expf(-x)); }
__device__ __forceinline__ float logsig_f(float x) { return fminf(x, 0.f) - log1pf(__expf(-fabsf(x))); }
__device__ __forceinline__ float softplus_f(float x) { return fmaxf(x, 0.f) + log1pf(__expf(-fabsf(x))); }
__device__ __forceinline__ float gelu_f(float x) { const float u = 0.7978845608028654f * (x + 0.044715f * x * x * x); return x / (1.0f + __expf(-2.0f * u)); }
__device__ __forceinline__ void unpack8(const v4u r, float (&f)[8]) {
    f[0] = __builtin_bit_cast(float, r.x << 16); f[1] = __builtin_bit_cast(float, r.x & 0xffff0000u); f[2] = __builtin_bit_cast(float, r.y << 16); f[3] = __builtin_bit_cast(float, r.y & 0xffff0000u);
    f[4] = __builtin_bit_cast(float, r.z << 16); f[5] = __builtin_bit_cast(float, r.z & 0xffff0000u); f[6] = __builtin_bit_cast(float, r.w << 16); f[7] = __builtin_bit_cast(float, r.w & 0xffff0000u);
}
__device__ __forceinline__ v4u pack8(const float (&f)[8]) { v4u o; o.x = pk2(f[0], f[1]); o.y = pk2(f[2], f[3]); o.z = pk2(f[4], f[5]); o.w = pk2(f[6], f[7]); return o; }

struct Mix0Bufs { const bf16* proj; bf16* ct; float* nloc; float* blast; float* mloc; float* mprev; float* hloc; float* pc; float* carA; float* carU; float* carI; bf16* mixbf; const bf16* lruw; };
constexpr int PJ0 = EINP;

__device__ __forceinline__ void mlstm_a_item(const Mix0Bufs& B, const float* gate_b, int cn, LAS unsigned char* lds, int tid) {
    const int lane = tid & 63, wave = __builtin_amdgcn_readfirstlane(tid >> 6);
    const int bh = cn / NCH, n = cn % NCH, b = bh >> 2, h = bh & 3;
    const size_t t0 = (size_t)b * S_ + n * 64;
    LAS float* lf = (LAS float*)lds; LAS float* wl = lf + 64; LAS float* pw = lf + 128; LAS float* misc = lf + 192;
    lbf16* kT = (lbf16*)(lds + 1024); lbf16* vT = (lbf16*)(lds + 1024 + 128 * 72 * 2);
    if (tid < 64) { const bf16* pr = B.proj + (t0 + tid) * PJ0;
        lf[tid] = logsig_f(bf2f(pr[2052 + h]) + gate_b[4 + h]); pw[tid] = bf2f(pr[2048 + h]) + gate_b[h]; }
    __syncthreads();
    if (tid < 64) { float acc = 0.f; for (int j = 0; j < 64; ++j) { const float x = lf[j]; acc += (j <= tid) ? x : 0.f; } wl[tid] = pw[tid] - acc; if (tid == 63) misc[0] = acc; }
    __syncthreads();
    float mx = -INFINITY;
    for (int j = 0; j < 64; ++j) mx = fmaxf(mx, wl[j]);
    const float blast = misc[0];
    __syncthreads();
    if (tid < 64) pw[tid] = __expf(wl[tid] - mx) * 0.08838834764831845f;
    __syncthreads();
#pragma unroll
    for (int it = 0; it < 2; ++it) { const int vi = tid + it * 512, l = vi & 63, g = vi >> 6;
        const bf16* pr = B.proj + (t0 + l) * PJ0 + h * 128 + g * 8;
        float kf[8], vf[8]; unpack8(*(const v4u*)(pr + 512), kf); unpack8(*(const v4u*)(pr + 1024), vf);
        const float p = pw[l];
#pragma unroll
        for (int j = 0; j < 8; ++j) { kT[(g * 8 + j) * 72 + l] = (unsigned short)f2bf(kf[j] * p); vT[(g * 8 + j) * 72 + l] = (unsigned short)f2bf(vf[j]); } }
    __syncthreads();
    const int et = wave >> 1;
#pragma unroll
    for (int q = 0; q < 2; ++q) { const int dt = (wave & 1) * 2 + q;
        f32x16 acc = {0.f, 0.f, 0.f, 0.f, 0.f, 0.f, 0.f, 0.f, 0.f, 0.f, 0.f, 0.f, 0.f, 0.f, 0.f, 0.f};
        mm32(acc, vT + et * 32 * 72, 72, kT + dt * 32 * 72, 72, 64, lane);
        bf16* out = B.ct + (size_t)cn * 16384 + dt * 32 + (lane & 31);
#pragma unroll
        for (int r = 0; r < 16; ++r) out[(size_t)(et * 32 + rowmap(r, lane)) * 128] = (unsigned short)f2bf(acc[r]); }
    if (tid < 128) { float s = 0.f; for (int l = 0; l < 64; ++l) s += bf2f(kT[tid * 72 + l]); B.nloc[(size_t)cn * 128 + tid] = s; }
    if (tid == 0) { B.blast[cn] = blast; B.mloc[cn] = blast + mx; }
    __syncthreads();
}
__device__ __forceinline__ void mlstm_b(const Mix0Bufs& B, int gtid, int gsz) {
    for (int idx = gtid; idx < 8 * 8192 + 8 * 128; idx += gsz) {
        const bool isn = idx >= 8 * 8192;
        if (!isn) { const int bh = idx >> 13, pe = idx & 8191;
            float s0 = 0.f, s1 = 0.f, m = 0.f; unsigned* p = (unsigned*)B.ct + (size_t)bh * NCH * 8192 + pe;
            for (int n0 = 0; n0 < NCH; n0 += 16) { unsigned cl[16]; float bl[16], ml[16];
#pragma unroll
                for (int j = 0; j < 16; ++j) { cl[j] = p[(size_t)(n0 + j) * 8192]; bl[j] = B.blast[bh * NCH + n0 + j]; ml[j] = B.mloc[bh * NCH + n0 + j]; }
#pragma unroll
                for (int j = 0; j < 16; ++j) { const unsigned out = pk2(s0, s1); const float mn = fmaxf(bl[j] + m, ml[j]), kf = __expf(bl[j] + m - mn), af = __expf(ml[j] - mn);
                    s0 = kf * s0 + af * __builtin_bit_cast(float, cl[j] << 16); s1 = kf * s1 + af * __builtin_bit_cast(float, cl[j] & 0xffff0000u);
                    if (pe == 0) B.mprev[bh * NCH + n0 + j] = m;
                    m = mn; cl[j] = out; }
#pragma unroll
                for (int j = 0; j < 16; ++j) p[(size_t)(n0 + j) * 8192] = cl[j]; }
        } else { const int r = idx - 8 * 8192, bh = r >> 7, de = r & 127;
            float st = 0.f, m = 0.f; float* p = B.nloc + (size_t)bh * NCH * 128 + de;
            for (int n0 = 0; n0 < NCH; n0 += 16) { float cl[16], bl[16], ml[16];
#pragma unroll
                for (int j = 0; j < 16; ++j) { cl[j] = p[(size_t)(n0 + j) * 128]; bl[j] = B.blast[bh * NCH + n0 + j]; ml[j] = B.mloc[bh * NCH + n0 + j]; }
#pragma unroll
                for (int j = 0; j < 16; ++j) { const float out = st; const float mn = fmaxf(bl[j] + m, ml[j]);
                    st = __expf(bl[j] + m - mn) * st + __expf(ml[j] - mn) * cl[j]; m = mn; cl[j] = out; }
#pragma unroll
                for (int j = 0; j < 16; ++j) p[(size_t)(n0 + j) * 128] = cl[j]; } }
    }
}
__device__ __forceinline__ void mlstm_c_item(const Mix0Bufs& B, const float* gate_b, const float* norm_w, int cn, LAS unsigned char* lds, int tid) {
    const int lane = tid & 63, wave = __builtin_amdgcn_readfirstlane(tid >> 6);
    const int bh = cn / NCH, n = cn % NCH, b = bh >> 2, h = bh & 3;
    const size_t t0 = (size_t)b * S_ + n * 64;
    LAS float* bc = (LAS float*)lds; LAS float* wl = bc + 64; LAS float* mi = bc + 128; LAS float* win = bc + 192; LAS float* den = bc + 256; LAS float* emi = bc + 320; LAS float* lf = bc + 384; LAS float* ig = bc + 448;
    lbf16* qs = (lbf16*)(lds + 2048); lbf16* ks = (lbf16*)(lds + 19456); lbf16* qw = (lbf16*)(lds + 36864);
    lbf16* vT = (lbf16*)(lds + 54272); lbf16* cT = (lbf16*)(lds + 77312); lbf16* sm = (lbf16*)(lds + 120832);
    LAS float* hb = (LAS float*)(lds + 2048);
    const float mprev = B.mprev[cn];
    v4u gq[2], gk[2], gv[2], go[2], gc[4];
#pragma unroll
    for (int it = 0; it < 2; ++it) { const int vi = tid + it * 512; { const int l = vi >> 4, g = vi & 15; const bf16* pr = B.proj + (t0 + l) * PJ0 + h * 128 + g * 8; gq[it] = *(const v4u*)pr; gk[it] = *(const v4u*)(pr + 512); }
        { const int l = vi & 63, g = vi >> 6; gv[it] = *(const v4u*)(B.proj + (t0 + l) * PJ0 + 1024 + h * 128 + g * 8); } }
    { const bf16* cg = B.ct + (size_t)cn * 16384;
#pragma unroll
      for (int it = 0; it < 4; ++it) { const int vi = tid + it * 512, e = vi >> 4, g = vi & 15; gc[it] = *(const v4u*)(cg + e * 128 + g * 8); } }
    { const int i = tid >> 3, sub = tid & 7; const bf16* op = B.proj + (t0 + i) * PJ0 + 1536 + h * 128 + sub * 16; go[0] = *(const v4u*)op; go[1] = *(const v4u*)(op + 8); }
    const float gnl = tid < 128 ? B.nloc[(size_t)cn * 128 + tid] : 0.f;
    if (tid < 64) { const bf16* pr = B.proj + (t0 + tid) * PJ0;
        lf[tid] = logsig_f(bf2f(pr[2052 + h]) + gate_b[4 + h]); ig[tid] = bf2f(pr[2048 + h]) + gate_b[h]; }
    __syncthreads();
    if (tid < 64) { float acc = 0.f; for (int j = 0; j < 64; ++j) { const float x = lf[j]; acc += (j <= tid) ? x : 0.f; } bc[tid] = acc; wl[tid] = ig[tid] - acc; }
    __syncthreads();
    if (tid < 64) { float pm = -INFINITY; for (int j = 0; j < 64; ++j) { const float x = wl[j]; pm = (j <= tid) ? fmaxf(pm, x) : pm; }
        const float bi = bc[tid], m = bi + fmaxf(mprev, pm); mi[tid] = m; win[tid] = __expf(bi + mprev - m); emi[tid] = __expf(-m); }
    __syncthreads();
#pragma unroll
    for (int it = 0; it < 2; ++it) { const int vi = tid + it * 512, l = vi >> 4, g = vi & 15;
        float qf[8], kf[8]; unpack8(gq[it], qf); unpack8(gk[it], kf);
        const float w = win[l]; float qwf[8];
#pragma unroll
        for (int j = 0; j < 8; ++j) { kf[j] *= 0.08838834764831845f; qwf[j] = qf[j] * w; }
        *(LAS v4u*)(qs + l * 136 + g * 8) = gq[it]; *(LAS v4u*)(ks + l * 136 + g * 8) = pack8(kf); *(LAS v4u*)(qw + l * 136 + g * 8) = pack8(qwf); }
#pragma unroll
    for (int it = 0; it < 2; ++it) { const int vi = tid + it * 512, l = vi & 63, g = vi >> 6;
        float vf[8]; unpack8(gv[it], vf);
#pragma unroll
        for (int j = 0; j < 8; ++j) vT[(g * 8 + j) * 72 + l] = (unsigned short)f2bf(vf[j]); }
    for (int i = tid; i < 32 * 72; i += 512) { const int r = i / 72, c = i % 72; vT[(128 + r) * 72 + c] = (r == 0 && c < 64) ? (unsigned short)0x3f80 : (unsigned short)0; }
#pragma unroll
    for (int it = 0; it < 4; ++it) { const int vi = tid + it * 512, e = vi >> 4, g = vi & 15; *(LAS v4u*)(cT + e * 136 + g * 8) = gc[it]; }
    for (int i = tid; i < 32 * 136; i += 512) { const int r = i / 136, c = i % 136; if (r > 0 || c >= 128) cT[(128 + r) * 136 + c] = (unsigned short)0; }
    if (tid < 128) cT[128 * 136 + tid] = (unsigned short)f2bf(gnl);
    __syncthreads();
    if (wave < 4) { const int it = wave >> 1, jt = wave & 1;
        f32x16 acc = {0.f, 0.f, 0.f, 0.f, 0.f, 0.f, 0.f, 0.f, 0.f, 0.f, 0.f, 0.f, 0.f, 0.f, 0.f, 0.f};
        if (jt <= it) mm32(acc, qs + it * 32 * 136, 136, ks + jt * 32 * 136, 136, 128, lane);
        const int j = jt * 32 + (lane & 31); const float wj = wl[j];
#pragma unroll
        for (int r = 0; r < 16; ++r) { const int i = it * 32 + rowmap(r, lane);
            const float v = (j <= i) ? acc[r] * __expf(bc[i] - mi[i] + wj) : 0.f; sm[i * 72 + j] = (unsigned short)f2bf(v); } }
    __syncthreads();
    f32x16 accA = {0.f, 0.f, 0.f, 0.f, 0.f, 0.f, 0.f, 0.f, 0.f, 0.f, 0.f, 0.f, 0.f, 0.f, 0.f, 0.f}, accB = accA;
    { const int id = wave, it = id / 5, nt = id % 5;
      mm32(accA, sm + it * 32 * 72, 72, vT + nt * 32 * 72, 72, 64, lane); mm32(accA, qw + it * 32 * 136, 136, cT + nt * 32 * 136, 136, 128, lane);
      if (nt == 4 && (lane & 31) == 0) {
#pragma unroll
          for (int r = 0; r < 16; ++r) den[it * 32 + rowmap(r, lane)] = accA[r]; } }
    if (wave < 2) { const int id = wave + 8, it = id / 5, nt = id % 5;
      mm32(accB, sm + it * 32 * 72, 72, vT + nt * 32 * 72, 72, 64, lane); mm32(accB, qw + it * 32 * 136, 136, cT + nt * 32 * 136, 136, 128, lane);
      if (nt == 4 && (lane & 31) == 0) {
#pragma unroll
          for (int r = 0; r < 16; ++r) den[it * 32 + rowmap(r, lane)] = accB[r]; } }
    __syncthreads();
    { const int id = wave, it = id / 5, nt = id % 5;
      if (nt < 4) {
#pragma unroll
          for (int r = 0; r < 16; ++r) { const int i = it * 32 + rowmap(r, lane); hb[i * 132 + nt * 32 + (lane & 31)] = accA[r] / fmaxf(fabsf(den[i]), emi[i]); } } }
    if (wave < 2) { const int id = wave + 8, it = id / 5, nt = id % 5;
      if (nt < 4) {
#pragma unroll
          for (int r = 0; r < 16; ++r) { const int i = it * 32 + rowmap(r, lane); hb[i * 132 + nt * 32 + (lane & 31)] = accB[r] / fmaxf(fabsf(den[i]), emi[i]); } } }
    __syncthreads();
    { const int i = tid >> 3, sub = tid & 7; const LAS float* hr = hb + i * 132 + sub * 16;
      float x[16]; float s = 0.f;
#pragma unroll
      for (int j = 0; j < 16; ++j) { x[j] = hr[j]; s += x[j]; }
      s += __builtin_bit_cast(float, __builtin_amdgcn_ds_swizzle(__builtin_bit_cast(int, s), 0x1f | (1 << 10)));
      s += __builtin_bit_cast(float, __builtin_amdgcn_ds_swizzle(__builtin_bit_cast(int, s), 0x1f | (2 << 10)));
      s += __builtin_bit_cast(float, __builtin_amdgcn_ds_swizzle(__builtin_bit_cast(int, s), 0x1f | (4 << 10)));
      const float mean = s * (1.f / 128.f); float q = 0.f;
#pragma unroll
      for (int j = 0; j < 16; ++j) { x[j] -= mean; q += x[j] * x[j]; }
      q += __builtin_bit_cast(float, __builtin_amdgcn_ds_swizzle(__builtin_bit_cast(int, q), 0x1f | (1 << 10)));
      q += __builtin_bit_cast(float, __builtin_amdgcn_ds_swizzle(__builtin_bit_cast(int, q), 0x1f | (2 << 10)));
      q += __builtin_bit_cast(float, __builtin_amdgcn_ds_swizzle(__builtin_bit_cast(int, q), 0x1f | (4 << 10)));
      const float rstd = 1.0f / sqrtf(q * (1.f / 128.f) + nv::EPS);
      const float* nw = norm_w + h * 128 + sub * 16;
      float o0[8], o1[8]; unpack8(go[0], o0); unpack8(go[1], o1);
      float y0[8], y1[8];
#pragma unroll
      for (int j = 0; j < 8; ++j) { y0[j] = x[j] * rstd * nw[j] * sigm_f(o0[j]); y1[j] = x[8 + j] * rstd * nw[8 + j] * sigm_f(o1[j]); }
      bf16* dst = B.mixbf + (t0 + i) * 1024 + h * 128 + sub * 16;
      *(v4u*)dst = pack8(y0); *(v4u*)(dst + 8) = pack8(y1); }
    __syncthreads();
}
__device__ __forceinline__ void lru_a_item(const Mix0Bufs& B, const float* const* in, int ch, LAS unsigned char* lds, int tid) {
    const int lane = tid & 63, wave = __builtin_amdgcn_readfirstlane(tid >> 6);
    const size_t t0 = (size_t)ch * 64; const int s0 = (ch % NCH) * 64;
    lbf16* xc = (lbf16*)lds; LAS float* al = (LAS float*)(lds + 17408); LAS float* ul = (LAS float*)(lds + 17408 + 32768);
    const float* cw = in[9]; const float* cb = in[10]; const float* ba = in[12]; const float* bx = in[14]; const float* lam = in[15];
    for (int hh = 0; hh < 4; ++hh) {
#pragma unroll
        for (int it = 0; it < 2; ++it) { const int vi = tid + it * 512, l = vi >> 4, g = vi & 15, c0 = hh * 128 + g * 8;
            float acc[8];
#pragma unroll
            for (int j = 0; j < 8; ++j) acc[j] = cb[c0 + j];
#pragma unroll
            for (int tap = 0; tap < 4; ++tap) { const int ls = s0 + l - 3 + tap;
                if (ls >= 0) { float xf[8]; unpack8(*(const v4u*)(B.proj + (t0 + l - 3 + tap) * PJ0 + 2056 + c0), xf);
#pragma unroll
                    for (int j = 0; j < 8; ++j) acc[j] += cw[tap * 512 + c0 + j] * xf[j]; } }
            *(LAS v4u*)(xc + l * 136 + g * 8) = pack8(acc);
#pragma unroll
            for (int j = 0; j < 8; ++j) ul[l * 128 + g * 8 + j] = acc[j]; }
        __syncthreads();
        { const int it = wave & 1, nt = wave >> 1;
          f32x16 ra = {0.f, 0.f, 0.f, 0.f, 0.f, 0.f, 0.f, 0.f, 0.f, 0.f, 0.f, 0.f, 0.f, 0.f, 0.f, 0.f}, xa = ra;
          mm32_gb(ra, xc + it * 32 * 136, 136, B.lruw + (size_t)(hh * 128 + nt * 32) * 128, 128, 128, lane);
          mm32_gb(xa, xc + it * 32 * 136, 136, B.lruw + (size_t)(512 + hh * 128 + nt * 32) * 128, 128, 128, lane);
          const int c = nt * 32 + (lane & 31), cg = hh * 128 + c; const float bav = ba[cg], bxv = bx[cg], sp = softplus_f(-lam[cg]);
#pragma unroll
          for (int r = 0; r < 16; ++r) { const int l = it * 32 + rowmap(r, lane);
              const float rr = sigm_f(ra[r] + bav), ii = sigm_f(xa[r] + bxv), la = -8.0f * rr * sp;
              const float xv = ul[l * 128 + c];
              al[l * 128 + c] = __expf(la); ul[l * 128 + c] = sqrtf(-expm1f(2.0f * la)) * ii * xv; } }
        __syncthreads();
        if (tid < 128) { float hst = 0.f, P = 1.f; float* hp = B.hloc + t0 * 512 + hh * 128 + tid; float* pp = B.pc + t0 * 512 + hh * 128 + tid;
            for (int l = 0; l < 64; ++l) { const float a = al[l * 128 + tid]; hst = a * hst + ul[l * 128 + tid]; P *= a; hp[(size_t)l * 512] = hst; pp[(size_t)l * 512] = P; }
            B.carA[(size_t)ch * 512 + hh * 128 + tid] = P; B.carU[(size_t)ch * 512 + hh * 128 + tid] = hst; }
        __syncthreads();
    }
}
__device__ __forceinline__ void lru_b(const Mix0Bufs& B, int gtid, int gsz) {
    for (int idx = gtid; idx < 2 * 512; idx += gsz) { const int b = idx >> 9, c = idx & 511; float hst = 0.f;
        for (int n0 = 0; n0 < NCH; n0 += 16) { float a[16], u[16];
#pragma unroll
            for (int j = 0; j < 16; ++j) { const size_t o = (size_t)(b * NCH + n0 + j) * 512 + c; a[j] = B.carA[o]; u[j] = B.carU[o]; }
#pragma unroll
            for (int j = 0; j < 16; ++j) { const float in = hst; hst = a[j] * hst + u[j]; a[j] = in; }
#pragma unroll
            for (int j = 0; j < 16; ++j) B.carI[(size_t)(b * NCH + n0 + j) * 512 + c] = a[j]; } }
}
__device__ __forceinline__ void lru_c(const Mix0Bufs& B, int gtid, int gsz) {
    for (int idx = gtid; idx < T_ * 64; idx += gsz) { const size_t t = idx >> 6; const int c0 = (idx & 63) * 8; const size_t ch = t >> 6;
        float gb[8], y[8]; unpack8(*(const v4u*)(B.proj + t * PJ0 + 2568 + c0), gb);
        const float* hp = B.hloc + t * 512 + c0; const float* pp = B.pc + t * 512 + c0; const float* ci = B.carI + ch * 512 + c0;
#pragma unroll
        for (int j = 0; j < 8; ++j) y[j] = (hp[j] + pp[j] * ci[j]) * gelu_f(gb[j]);
        *(v4u*)(B.mixbf + t * 1024 + 512 + c0) = pack8(y); }
}
constexpr int PJ1 = OINP;
struct Mix1Bufs { const bf16* proj; bf16* ut; float* gbl; bf16* s5g; float* xend; float* xstart; float* s5ab; float* s5bb; bf16* cm; bf16* bbt; bf16* mixbf; };
__device__ __forceinline__ void gla_gates(const bf16* proj, const float* gw, const float* gb, size_t t0, int h, LAS float* bc, LAS float* gl, int tid) {
    if (tid < 128) { const int l = tid >> 1, hf = tid & 1; float f[8]; unpack8(*(const v4u*)(proj + (t0 + l) * PJ1 + 2048 + hf * 8), f);
#pragma unroll
        for (int j = 0; j < 8; ++j) gl[l * 16 + hf * 8 + j] = f[j]; }
    __syncthreads();
    { const int d = tid & 63, lg = tid >> 6; float w[16];
#pragma unroll
      for (int r = 0; r < 16; ++r) w[r] = gw[r * 256 + h * 64 + d];
      const float bias = gb[h * 64 + d];
#pragma unroll
      for (int q = 0; q < 8; ++q) { const int l = lg * 8 + q; float acc = bias;
#pragma unroll
          for (int r = 0; r < 16; ++r) acc += gl[l * 16 + r] * w[r];
          bc[l * 64 + d] = logsig_f(acc) * 0.0625f; } }
    __syncthreads();
    if (tid < 64) { float acc = 0.f; for (int l = 0; l < 64; ++l) { acc += bc[l * 64 + tid]; bc[l * 64 + tid] = acc; } }
    __syncthreads();
}
__device__ __forceinline__ void gla_a_item(const Mix1Bufs& B, const float* gw, const float* gb, int cn, LAS unsigned char* lds, int tid) {
    const int lane = tid & 63, wave = __builtin_amdgcn_readfirstlane(tid >> 6);
    const int bh = cn / NCH, n = cn % NCH, b = bh >> 2, h = bh & 3;
    const size_t t0 = (size_t)b * S_ + n * 64;
    LAS float* bc = (LAS float*)lds; LAS float* gl = (LAS float*)(lds + 16384);
    lbf16* kT = (lbf16*)(lds + 20480); lbf16* vT = (lbf16*)(lds + 20480 + 64 * 72 * 2);
    gla_gates(B.proj, gw, gb, t0, h, bc, gl, tid);
    { const int l = tid & 63, g = tid >> 6; float kf[8]; unpack8(*(const v4u*)(B.proj + (t0 + l) * PJ1 + 768 + h * 64 + g * 8), kf);
#pragma unroll
      for (int j = 0; j < 8; ++j) { const int d = g * 8 + j; kT[d * 72 + l] = (unsigned short)f2bf(kf[j] * __expf(bc[63 * 64 + d] - bc[l * 64 + d])); } }
#pragma unroll
    for (int it = 0; it < 2; ++it) { const int vi = tid + it * 512, l = vi & 63, g = vi >> 6; float vf[8]; unpack8(*(const v4u*)(B.proj + (t0 + l) * PJ1 + 1024 + h * 128 + g * 8), vf);
#pragma unroll
        for (int j = 0; j < 8; ++j) vT[(g * 8 + j) * 72 + l] = (unsigned short)f2bf(vf[j]); }
    __syncthreads();
    { const int et = wave >> 1, dt = wave & 1;
      f32x16 acc = {0.f, 0.f, 0.f, 0.f, 0.f, 0.f, 0.f, 0.f, 0.f, 0.f, 0.f, 0.f, 0.f, 0.f, 0.f, 0.f};
      mm32(acc, vT + et * 32 * 72, 72, kT + dt * 32 * 72, 72, 64, lane);
      bf16* out = B.ut + (size_t)cn * 8192 + dt * 32 + (lane & 31);
#pragma unroll
      for (int r = 0; r < 16; ++r) out[(size_t)(et * 32 + rowmap(r, lane)) * 64] = (unsigned short)f2bf(acc[r]); }
    if (tid < 64) B.gbl[(size_t)cn * 64 + tid] = bc[63 * 64 + tid];
    __syncthreads();
}
__device__ __forceinline__ void gla_b(const Mix1Bufs& B, int gtid, int gsz) {
    for (int idx = gtid; idx < 8 * 4096; idx += gsz) { const int bh = idx >> 12, pe = idx & 4095, d = (pe * 2) & 63; float s0 = 0.f, s1 = 0.f;
        unsigned* p = (unsigned*)B.ut + (size_t)bh * NCH * 4096 + pe; const float* gp = B.gbl + (size_t)bh * NCH * 64 + d;
        for (int n0 = 0; n0 < NCH; n0 += 16) { unsigned u[16]; float g0[16], g1[16];
#pragma unroll
            for (int j = 0; j < 16; ++j) { u[j] = p[(size_t)(n0 + j) * 4096]; g0[j] = gp[(n0 + j) * 64]; g1[j] = gp[(n0 + j) * 64 + 1]; }
#pragma unroll
            for (int j = 0; j < 16; ++j) { const unsigned out = pk2(s0, s1);
                s0 = __expf(g0[j]) * s0 + __builtin_bit_cast(float, u[j] << 16); s1 = __expf(g1[j]) * s1 + __builtin_bit_cast(float, u[j] & 0xffff0000u); u[j] = out; }
#pragma unroll
            for (int j = 0; j < 16; ++j) p[(size_t)(n0 + j) * 4096] = u[j]; } }
}
__device__ __forceinline__ void gla_c_item(const Mix1Bufs& B, const float* gw, const float* gb, const float* norm_w, int cn, LAS unsigned char* lds, int tid) {
    const int lane = tid & 63, wave = __builtin_amdgcn_readfirstlane(tid >> 6);
    const int bh = cn / NCH, n = cn % NCH, b = bh >> 2, h = bh & 3;
    const size_t t0 = (size_t)b * S_ + n * 64;
    LAS float* bc = (LAS float*)lds; LAS float* gl = (LAS float*)(lds + 16384);
    lbf16* qd = (lbf16*)(lds + 20480); lbf16* ki = (lbf16*)(lds + 29696); lbf16* vT = (lbf16*)(lds + 38912); lbf16* sT = (lbf16*)(lds + 57344); lbf16* att = (lbf16*)(lds + 75776);
    LAS float* ob = (LAS float*)(lds + 84992);
    gla_gates(B.proj, gw, gb, t0, h, bc, gl, tid);
    { const int l = tid >> 3, g = tid & 7; const bf16* pr = B.proj + (t0 + l) * PJ1 + h * 64 + g * 8; float qf[8], kf[8]; unpack8(*(const v4u*)(pr + 512), qf); unpack8(*(const v4u*)(pr + 768), kf);
#pragma unroll
      for (int j = 0; j < 8; ++j) { const float bb = bc[l * 64 + g * 8 + j]; qf[j] *= 0.125f * __expf(bb); kf[j] *= __expf(-bb); }
      *(LAS v4u*)(qd + l * 72 + g * 8) = pack8(qf); *(LAS v4u*)(ki + l * 72 + g * 8) = pack8(kf); }
#pragma unroll
    for (int it = 0; it < 2; ++it) { const int vi = tid + it * 512, l = vi & 63, g = vi >> 6; float vf[8]; unpack8(*(const v4u*)(B.proj + (t0 + l) * PJ1 + 1024 + h * 128 + g * 8), vf);
#pragma unroll
        for (int j = 0; j < 8; ++j) vT[(g * 8 + j) * 72 + l] = (unsigned short)f2bf(vf[j]); }
    { const bf16* sg = B.ut + (size_t)cn * 8192;
#pragma unroll
      for (int it = 0; it < 2; ++it) { const int vi = tid + it * 512, e = vi >> 3, g = vi & 7; *(LAS v4u*)(sT + e * 72 + g * 8) = *(const v4u*)(sg + e * 64 + g * 8); } }
    __syncthreads();
    if (wave < 4) { const int it = wave >> 1, jt = wave & 1;
        f32x16 acc = {0.f, 0.f, 0.f, 0.f, 0.f, 0.f, 0.f, 0.f, 0.f, 0.f, 0.f, 0.f, 0.f, 0.f, 0.f, 0.f};
        if (jt <= it) mm32(acc, qd + it * 32 * 72, 72, ki + jt * 32 * 72, 72, 64, lane);
        const int j = jt * 32 + (lane & 31);
#pragma unroll
        for (int r = 0; r < 16; ++r) { const int i = it * 32 + rowmap(r, lane); att[i * 72 + j] = (unsigned short)f2bf(j <= i ? acc[r] : 0.f); } }
    __syncthreads();
    { const int it = wave >> 2, nt = wave & 3;
      f32x16 acc = {0.f, 0.f, 0.f, 0.f, 0.f, 0.f, 0.f, 0.f, 0.f, 0.f, 0.f, 0.f, 0.f, 0.f, 0.f, 0.f};
      mm32(acc, att + it * 32 * 72, 72, vT + nt * 32 * 72, 72, 64, lane); mm32(acc, qd + it * 32 * 72, 72, sT + nt * 32 * 72, 72, 64, lane);
#pragma unroll
      for (int r = 0; r < 16; ++r) ob[(it * 32 + rowmap(r, lane)) * 132 + nt * 32 + (lane & 31)] = acc[r]; }
    __syncthreads();
    { const int i = tid >> 3, sub = tid & 7; const LAS float* hr = ob + i * 132 + sub * 16;
      float x[16]; float q = 0.f;
#pragma unroll
      for (int j = 0; j < 16; ++j) { x[j] = hr[j]; q += x[j] * x[j]; }
      q += __builtin_bit_cast(float, __builtin_amdgcn_ds_swizzle(__builtin_bit_cast(int, q), 0x1f | (1 << 10)));
      q += __builtin_bit_cast(float, __builtin_amdgcn_ds_swizzle(__builtin_bit_cast(int, q), 0x1f | (2 << 10)));
      q += __builtin_bit_cast(float, __builtin_amdgcn_ds_swizzle(__builtin_bit_cast(int, q), 0x1f | (4 << 10)));
      const float rstd = 1.0f / sqrtf(q * (1.f / 128.f) + nv::EPS);
      const bf16* rp = B.proj + (t0 + i) * PJ1 + 1536 + h * 128 + sub * 16; const float* nw = norm_w + h * 128 + sub * 16;
      float r0[8], r1[8]; unpack8(*(const v4u*)rp, r0); unpack8(*(const v4u*)(rp + 8), r1);
      float y0[8], y1[8];
#pragma unroll
      for (int j = 0; j < 8; ++j) { y0[j] = x[j] * rstd * nw[j] * r0[j] * sigm_f(r0[j]); y1[j] = x[8 + j] * rstd * nw[8 + j] * r1[j] * sigm_f(r1[j]); }
      bf16* dst = B.mixbf + (t0 + i) * 1024 + 512 + h * 128 + sub * 16;
      *(v4u*)dst = pack8(y0); *(v4u*)(dst + 8) = pack8(y1); }
    __syncthreads();
}
__device__ __forceinline__ void s5_params(const Mix1Bufs& B, const float* const* in, int gtid, int gsz) {

    for (int idx = gtid; idx < 2048; idx += gsz) { const int g = idx >> 6;
        const float lr = in[17][idx], li = in[18][idx], dt = expf(in[24][g]);
        const float mag = expf(lr * dt), ar = mag * cosf(li * dt), ai = mag * sinf(li * dt);
        const float den = lr * lr + li * li, nr = ar - 1.0f, cr = (nr * lr + ai * li) / den, ci = (ai * lr - nr * li) / den;
        B.s5ab[idx * 2] = ar; B.s5ab[idx * 2 + 1] = ai;
        for (int h = 0; h < 16; ++h) { const float br = in[19][idx * 16 + h], bi = in[20][idx * 16 + h]; B.s5bb[idx * 32 + h] = cr * br - ci * bi; B.s5bb[idx * 32 + 16 + h] = cr * bi + ci * br; } }
    for (int idx = gtid; idx < 32 * 128 * 16; idx += gsz) { const int h = idx & 15, j = (idx >> 4) & 127, g = idx >> 11; const int gp = g * 64 + (j & 63);
        const float lr = in[17][gp], li = in[18][gp], dt = expf(in[24][g]);
        const float mag = expf(lr * dt), ar = mag * cosf(li * dt), ai = mag * sinf(li * dt);
        const float den = lr * lr + li * li, nr = ar - 1.0f, cr = (nr * lr + ai * li) / den, ci = (ai * lr - nr * li) / den;
        const float br = in[19][gp * 16 + h], bi = in[20][gp * 16 + h];
        B.bbt[idx] = (unsigned short)f2bf(j < 64 ? cr * br - ci * bi : cr * bi + ci * br); }
    for (int idx = gtid; idx < 32 * 32 * 128; idx += gsz) { const int k = idx & 127, hh = (idx >> 7) & 31, g = idx >> 12;
        float v = 0.f; if (hh < 16) v = k < 64 ? in[21][(g * 16 + hh) * 64 + k] : -in[22][(g * 16 + hh) * 64 + k - 64];
        B.cm[idx] = (unsigned short)f2bf(v); }
}
template <bool OUT> __device__ __forceinline__ void s5_chunk_v2(const Mix1Bufs& B, const float* dskip, int item, bool valid, LAS unsigned char* wl, int lane) {
    if (!valid) item = 0;
    const int n = item % NCH, g = (item / NCH) & 31, b = item / (NCH * 32);
    const size_t t0 = (size_t)b * S_ + n * 64; const int gp = g * 64 + lane;
    LAS float* bu = (LAS float*)wl;
    lbf16* xs = (lbf16*)(wl + 8192);
    const float ar = B.s5ab[gp * 2], ai = B.s5ab[gp * 2 + 1];
    float xr = 0.f, xi = 0.f;
    if (OUT) { xr = B.xstart[((size_t)item * 64 + lane) * 2]; xi = B.xstart[((size_t)item * 64 + lane) * 2 + 1]; }
    const bf16* bbt = B.bbt + (size_t)g * 2048 + (lane & 31) * 16 + 8 * (lane >> 5);
    for (int half = 0; half < 2; ++half) {
        const s16x8 a = *(const s16x8*)(B.proj + (t0 + half * 32 + (lane & 31)) * PJ1 + g * 16 + 8 * (lane >> 5));
        f32x16 acc[4];
#pragma unroll
        for (int nt = 0; nt < 4; ++nt) { const s16x8 bf = *(const s16x8*)(bbt + nt * 512);
            const f32x16 z = {0.f, 0.f, 0.f, 0.f, 0.f, 0.f, 0.f, 0.f, 0.f, 0.f, 0.f, 0.f, 0.f, 0.f, 0.f, 0.f};
            acc[nt] = __builtin_amdgcn_mfma_f32_32x32x16_bf16(a, bf, z, 0, 0, 0); }
#pragma unroll
        for (int q = 0; q < 2; ++q) {
#pragma unroll
            for (int nt = 0; nt < 4; ++nt)
#pragma unroll
                for (int rr = 0; rr < 8; ++rr) bu[((rr & 3) + 8 * (rr >> 2) + 4 * (lane >> 5)) * 128 + nt * 32 + (lane & 31)] = acc[nt][q * 8 + rr];
            __syncthreads();
#pragma unroll 4
            for (int l = 0; l < 16; ++l) { const float sr = bu[l * 128 + lane], si = bu[l * 128 + 64 + lane];
                const float nr = ar * xr - ai * xi + sr, ni = ar * xi + ai * xr + si; xr = nr; xi = ni;
                if (OUT) { xs[(q * 16 + l) * 136 + lane] = (unsigned short)f2bf(xr); xs[(q * 16 + l) * 136 + 64 + lane] = (unsigned short)f2bf(xi); } }
            __syncthreads();
        }
        if (OUT) {
            f32x16 acc2 = {0.f, 0.f, 0.f, 0.f, 0.f, 0.f, 0.f, 0.f, 0.f, 0.f, 0.f, 0.f, 0.f, 0.f, 0.f, 0.f};
            mm32_gb(acc2, xs, 136, B.cm + (size_t)g * 32 * 128, 128, 128, lane);
            const int hh = lane & 31;
            if (hh < 16 && valid) { const float dk = dskip[g * 16 + hh];
#pragma unroll
                for (int r = 0; r < 16; ++r) { const size_t t = t0 + half * 32 + rowmap(r, lane);
                    B.s5g[t * 512 + g * 16 + hh] = (unsigned short)f2bf(gelu_f(acc2[r] + dk * bf2f(B.proj[t * PJ1 + g * 16 + hh]))); } }
            __syncthreads();
        }
    }
    if (!OUT && valid) { B.xend[((size_t)item * 64 + lane) * 2] = xr; B.xend[((size_t)item * 64 + lane) * 2 + 1] = xi; }
}
template <bool OUT> __device__ __forceinline__ void s5_phase(const Mix1Bufs& B, const float* dskip, int gw, int NGW, LAS unsigned char* wl, int lane) {
    const int wpg = NGW >> 5, g_ = gw / wpg, j0 = gw - g_ * wpg; const bool gvalid = g_ < 32; const int g = gvalid ? g_ : 0;
    const int nit = (2 * NCH + wpg - 1) / wpg;
    const float ar = B.s5ab[(g * 64 + lane) * 2], ai = B.s5ab[(g * 64 + lane) * 2 + 1];
    s16x8 bf[4]; { const bf16* bbt = B.bbt + (size_t)g * 2048 + (lane & 31) * 16 + 8 * (lane >> 5);
#pragma unroll
        for (int nt = 0; nt < 4; ++nt) bf[nt] = *(const s16x8*)(bbt + nt * 512); }
    s16x8 cf[4]; float dk[4];
    if (OUT) { const bf16* cm = B.cm + (size_t)g * 32 * 128 + (lane & 15) * 128 + 8 * (lane >> 4);
#pragma unroll
        for (int ks = 0; ks < 4; ++ks) cf[ks] = *(const s16x8*)(cm + ks * 32);
#pragma unroll
        for (int r = 0; r < 4; ++r) dk[r] = dskip[g * 16 + 4 * (lane >> 4) + r]; }
    s16x8 na[2]; v2u nu[2][2]; float nxr = 0.f, nxi = 0.f;
#define S5_LOAD(kk) do { const int _i = j0 + (kk) * wpg; const int _idx = (gvalid && _i < 2 * NCH) ? _i : 0; const int _b = _idx / NCH, _n = _idx % NCH; const size_t _t0 = (size_t)_b * S_ + _n * 64; \
        const bf16* _p = B.proj + (_t0 + (lane & 31)) * PJ1 + g * 16 + 8 * (lane >> 5); na[0] = *(const s16x8*)_p; na[1] = *(const s16x8*)(_p + (size_t)32 * PJ1); \
        if (OUT) { const size_t _it = (size_t)(_b * 32 + g) * NCH + _n; const float2 _x = *(const float2*)(B.xstart + (_it * 64 + lane) * 2); nxr = _x.x; nxi = _x.y; \
            const bf16* _q = B.proj + (_t0 + (lane & 15)) * PJ1 + g * 16 + 4 * (lane >> 4); _Pragma("unroll") for (int _h = 0; _h < 2; ++_h) _Pragma("unroll") for (int _t = 0; _t < 2; ++_t) nu[_h][_t] = *(const v2u*)(_q + (size_t)(_h * 32 + _t * 16) * PJ1); } } while (0)
    S5_LOAD(0);
    for (int k = 0; k < nit; ++k) {
        const int i_ = j0 + k * wpg; const bool valid = gvalid && i_ < 2 * NCH; const int idx = valid ? i_ : 0; const int b = idx / NCH, n = idx % NCH;
        const size_t t0 = (size_t)b * S_ + n * 64; const size_t item = (size_t)(b * 32 + g) * NCH + n;
        s16x8 a[2] = {na[0], na[1]}; v2u uu[2][2] = {{nu[0][0], nu[0][1]}, {nu[1][0], nu[1][1]}}; float xr = OUT ? nxr : 0.f, xi = OUT ? nxi : 0.f;
        if (k + 1 < nit) S5_LOAD(k + 1);
#pragma unroll
        for (int half = 0; half < 2; ++half) {
            f32x16 acc[4];
#pragma unroll
            for (int nt = 0; nt < 4; ++nt) { const f32x16 z = {0.f, 0.f, 0.f, 0.f, 0.f, 0.f, 0.f, 0.f, 0.f, 0.f, 0.f, 0.f, 0.f, 0.f, 0.f, 0.f};
                acc[nt] = __builtin_amdgcn_mfma_f32_32x32x16_bf16(a[half], bf[nt], z, 0, 0, 0); }
            float sre[2][16], sim[2][16];
#pragma unroll
            for (int r = 0; r < 16; ++r) {
                { auto w = __builtin_amdgcn_permlane32_swap(__float_as_uint(acc[0][r]), __float_as_uint(acc[1][r]), false, false); sre[0][r] = __uint_as_float(w[0]); sre[1][r] = __uint_as_float(w[1]); }
                { auto w = __builtin_amdgcn_permlane32_swap(__float_as_uint(acc[2][r]), __float_as_uint(acc[3][r]), false, false); sim[0][r] = __uint_as_float(w[0]); sim[1][r] = __uint_as_float(w[1]); } }
            lbf16* xs = (lbf16*)(wl + half * 8704);
#pragma unroll
            for (int q = 0; q < 4; ++q)
#pragma unroll
                for (int wch = 0; wch < 2; ++wch)
#pragma unroll
                    for (int i = 0; i < 4; ++i) { const int r = q * 4 + i, tok = q * 8 + wch * 4 + i;
                        const float sr = sre[wch][r], si = sim[wch][r];
                        const float nr = ar * xr - ai * xi + sr, ni = ar * xi + ai * xr + si; xr = nr; xi = ni;
                        if (OUT) { xs[tok * 136 + lane] = (unsigned short)f2bf(xr); xs[tok * 136 + 64 + lane] = (unsigned short)f2bf(xi); } }
            if (OUT) {
                __syncthreads();
#pragma unroll
                for (int tt = 0; tt < 2; ++tt) { f32x4 y = {0.f, 0.f, 0.f, 0.f};
                    const lbf16* xp = xs + (tt * 16 + (lane & 15)) * 136 + 8 * (lane >> 4);
#pragma unroll
                    for (int ks = 0; ks < 4; ++ks) y = __builtin_amdgcn_mfma_f32_16x16x32_bf16(cf[ks], *(const LAS s16x8*)(xp + ks * 32), y, 0, 0, 0);
                    const v2u u = uu[half][tt];
                    const float u0 = __builtin_bit_cast(float, u.x << 16), u1 = __builtin_bit_cast(float, u.x & 0xffff0000u), u2 = __builtin_bit_cast(float, u.y << 16), u3 = __builtin_bit_cast(float, u.y & 0xffff0000u);
                    v2u o; o.x = pk2(gelu_f(y[0] + dk[0] * u0), gelu_f(y[1] + dk[1] * u1)); o.y = pk2(gelu_f(y[2] + dk[2] * u2), gelu_f(y[3] + dk[3] * u3));
                    if (valid) *(v2u*)(B.s5g + (t0 + half * 32 + tt * 16 + (lane & 15)) * 512 + g * 16 + 4 * (lane >> 4)) = o; }
            }
        }
        if (!OUT && valid) { float2 o; o.x = xr; o.y = xi; *(float2*)(B.xend + (item * 64 + lane) * 2) = o; }
    }
#undef S5_LOAD
}
__device__ __forceinline__ void s5_b(const Mix1Bufs& B, int gtid, int gsz) {
    for (int idx = gtid; idx < 2 * 2048; idx += gsz) { const int b = idx >> 11, gp = idx & 2047, g = gp >> 6, p = gp & 63;
        float ar = B.s5ab[gp * 2], ai = B.s5ab[gp * 2 + 1];
#pragma unroll
        for (int q = 0; q < 6; ++q) { const float r2 = ar * ar - ai * ai, i2 = 2.f * ar * ai; ar = r2; ai = i2; }
        float xr = 0.f, xi = 0.f;
        const size_t o0 = ((size_t)((b * 32 + g) * NCH) * 64 + p) * 2;
        for (int n0 = 0; n0 < NCH; n0 += 16) { float er[16], ei[16];
#pragma unroll
            for (int j = 0; j < 16; ++j) { const size_t o = o0 + (size_t)(n0 + j) * 128; er[j] = B.xend[o]; ei[j] = B.xend[o + 1]; }
#pragma unroll
            for (int j = 0; j < 16; ++j) { const float sr = xr, si = xi; const float nr = ar * xr - ai * xi + er[j], ni = ar * xi + ai * xr + ei[j]; xr = nr; xi = ni; er[j] = sr; ei[j] = si; }
#pragma unroll
            for (int j = 0; j < 16; ++j) { const size_t o = o0 + (size_t)(n0 + j) * 128; B.xstart[o] = er[j]; B.xstart[o + 1] = ei[j]; } } }
}
typedef float f32x4v __attribute__((ext_vector_type(4)));
struct RouterBufs { const float* z; float* h; bf16* hbf; const float* lnw; const float* lnb; const bf16* rwh; const bf16* rwl; const float* rbias; int* ridx; float* rwt; unsigned* cnt; };
__device__ __forceinline__ void router_split_weights(const float* rw, bf16* hi, bf16* lo, int gtid, int gsz) {
    for (int i = gtid; i < 64 * 1024; i += gsz) { const int e = i >> 10, k = i & 1023; const float w = rw[k * 64 + e]; const unsigned h = f2bf(w); hi[i] = (unsigned short)h; lo[i] = (unsigned short)f2bf(w - __builtin_bit_cast(float, h << 16)); }
}
__device__ __forceinline__ void router_select(const LAS float* sc, const float* bias, int* ridx, float* rwt, LAS unsigned* hist) {
    float gs[8];
#pragma unroll
    for (int g = 0; g < 8; ++g) { float m1 = -INFINITY, m2 = -INFINITY;
#pragma unroll
        for (int j = 0; j < 8; ++j) { const float v = sc[g * 8 + j] + bias[g * 8 + j]; if (v > m1) { m2 = m1; m1 = v; } else if (v > m2) m2 = v; }
        gs[g] = m1 + m2; }
    unsigned gsel = 0;
#pragma unroll
    for (int it = 0; it < 4; ++it) { float best = -INFINITY; int bi = 0;
#pragma unroll
        for (int g = 0; g < 8; ++g) { const bool ok = !((gsel >> g) & 1u) && gs[g] > best; best = ok ? gs[g] : best; bi = ok ? g : bi; }
        gsel |= 1u << bi; }
    unsigned long long taken = 0ull; float wsum = 0.f; float wv[8]; int ev[8];
#pragma unroll
    for (int it = 0; it < 8; ++it) { float best = -INFINITY; int bi = 0;
#pragma unroll 1
        for (int e = 0; e < 64; ++e) { const bool ok = ((gsel >> (e >> 3)) & 1u) && !((taken >> e) & 1ull); const float v = sc[e] + bias[e]; if (ok && v > best) { best = v; bi = e; } }
        taken |= 1ull << bi; ev[it] = bi; wv[it] = sc[bi]; wsum += wv[it]; }
    const float inv = 2.5f / wsum;
#pragma unroll
    for (int it = 0; it < 8; ++it) { ridx[it] = ev[it]; rwt[it] = wv[it] * inv; atomicAdd((unsigned*)&hist[ev[it]], 1u); }
}
__device__ __forceinline__ void router_tiles(const RouterBufs& R, int tile0, int tstride, int ntiles, LAS unsigned char* lds, int tid, bool count = true) {
    const int lane = tid & 63, wave = __builtin_amdgcn_readfirstlane(tid >> 6);
    lbf16* Ahi = (lbf16*)lds; lbf16* Alo = (lbf16*)(lds + 33024); LAS float* part = (LAS float*)(lds + 66048); LAS float* sc = (LAS float*)(lds + 98816); LAS unsigned* hist = (LAS unsigned*)(lds + 102912);
    if (tile0 >= ntiles) return;
    const int row16 = lane & 15, kq = 8 * (lane >> 4);
    s16x8 bh[4][4], bl[4][4];
#pragma unroll
    for (int ks = 0; ks < 4; ++ks)
#pragma unroll
        for (int nt = 0; nt < 4; ++nt) { const size_t o = (size_t)(nt * 16 + row16) * 1024 + wave * 128 + ks * 32 + kq; bh[ks][nt] = *(const s16x8*)(R.rwh + o); bl[ks][nt] = *(const s16x8*)(R.rwl + o); }
    const float bias = R.rbias[lane];
    f32x4 zr[2][4];
#define RT_LOAD(tile) do { _Pragma("unroll") for (int q = 0; q < 2; ++q) { const float* zp = R.z + ((size_t)(tile) * 16 + wave * 2 + q) * 1024 + lane * 8; \
        zr[q][0] = *(const f32x4*)zp; zr[q][1] = *(const f32x4*)(zp + 4); zr[q][2] = *(const f32x4*)(zp + 512); zr[q][3] = *(const f32x4*)(zp + 516); } } while (0)
    RT_LOAD(tile0);
    if (tid < 64) hist[tid] = 0u;
    for (int tile = tile0; tile < ntiles; tile += tstride) {
#pragma unroll
        for (int q = 0; q < 2; ++q) { const int row = wave * 2 + q; const size_t t = (size_t)tile * 16 + row;
            float v[16] = {zr[q][0].x, zr[q][0].y, zr[q][0].z, zr[q][0].w, zr[q][1].x, zr[q][1].y, zr[q][1].z, zr[q][1].w, zr[q][2].x, zr[q][2].y, zr[q][2].z, zr[q][2].w, zr[q][3].x, zr[q][3].y, zr[q][3].z, zr[q][3].w};
            float sum = 0.f;
#pragma unroll
            for (int j = 0; j < 16; ++j) sum += v[j];
            sum = wave_sum(sum); const float mean = sum * (1.f / 1024.f); float sq = 0.f;
#pragma unroll
            for (int j = 0; j < 16; ++j) { v[j] -= mean; sq += v[j] * v[j]; }
            sq = wave_sum(sq); const float rstd = 1.0f / sqrtf(sq * (1.f / 1024.f) + nv::EPS);
#pragma unroll
            for (int half = 0; half < 2; ++half) { const int c0 = half * 512 + lane * 8;
                const f32x4 w0 = *(const f32x4*)(R.lnw + c0), w1 = *(const f32x4*)(R.lnw + c0 + 4), b0 = *(const f32x4*)(R.lnb + c0), b1 = *(const f32x4*)(R.lnb + c0 + 4);
                float o[8] = {v[half * 8 + 0] * rstd * w0.x + b0.x, v[half * 8 + 1] * rstd * w0.y + b0.y, v[half * 8 + 2] * rstd * w0.z + b0.z, v[half * 8 + 3] * rstd * w0.w + b0.w,
                              v[half * 8 + 4] * rstd * w1.x + b1.x, v[half * 8 + 5] * rstd * w1.y + b1.y, v[half * 8 + 6] * rstd * w1.z + b1.z, v[half * 8 + 7] * rstd * w1.w + b1.w};
                *(f32x4*)(R.h + t * 1024 + c0) = (f32x4){o[0], o[1], o[2], o[3]}; *(f32x4*)(R.h + t * 1024 + c0 + 4) = (f32x4){o[4], o[5], o[6], o[7]};
                const v4u hi = pack8(o); float hf[8], lo[8]; unpack8(hi, hf);
#pragma unroll
                for (int j = 0; j < 8; ++j) lo[j] = o[j] - hf[j];
                *(v4u*)(R.hbf + t * 1024 + c0) = hi; *(LAS v4u*)(Ahi + row * 1032 + c0) = hi; *(LAS v4u*)(Alo + row * 1032 + c0) = pack8(lo); } }
        if (tile + tstride < ntiles) RT_LOAD(tile + tstride);
        __syncthreads();
        { f32x4v acc[4] = {{0.f, 0.f, 0.f, 0.f}, {0.f, 0.f, 0.f, 0.f}, {0.f, 0.f, 0.f, 0.f}, {0.f, 0.f, 0.f, 0.f}};
#pragma unroll
          for (int ks = 0; ks < 4; ++ks) { const int k0 = wave * 128 + ks * 32 + kq;
              const s16x8 ah = *(const LAS s16x8*)(Ahi + row16 * 1032 + k0), al = *(const LAS s16x8*)(Alo + row16 * 1032 + k0);
#pragma unroll
              for (int nt = 0; nt < 4; ++nt) {
                  acc[nt] = __builtin_amdgcn_mfma_f32_16x16x32_bf16(ah, bh[ks][nt], acc[nt], 0, 0, 0);
                  acc[nt] = __builtin_amdgcn_mfma_f32_16x16x32_bf16(al, bh[ks][nt], acc[nt], 0, 0, 0);
                  acc[nt] = __builtin_amdgcn_mfma_f32_16x16x32_bf16(ah, bl[ks][nt], acc[nt], 0, 0, 0); } }
#pragma unroll
          for (int nt = 0; nt < 4; ++nt)
#pragma unroll
              for (int r = 0; r < 4; ++r) part[(wave * 16 + (lane >> 4) * 4 + r) * 64 + nt * 16 + (lane & 15)] = acc[nt][r]; }
        __syncthreads();
#pragma unroll
        for (int q = 0; q < 2; ++q) { const int o = tid + q * 512; float s = 0.f;
#pragma unroll
            for (int w = 0; w < 8; ++w) s += part[w * 1024 + o];
            sc[o] = 1.0f / (1.0f + expf(-s)); }
        __syncthreads();
        { LAS float* gsl = part; LAS float* cvl = part + 128;
#pragma unroll 1
          for (int q = 0; q < 2; ++q) { const int tk = wave * 2 + q; const size_t t = (size_t)tile * 16 + tk;
              const float s = sc[tk * 64 + lane], v = s + bias;
#define SWZ_MAX(x, o) fmaxf(x, __builtin_bit_cast(float, __builtin_amdgcn_ds_swizzle(__builtin_bit_cast(int, x), 0x1f | ((o) << 10))))
#define SWZ_ADD(x, o) ((x) + __builtin_bit_cast(float, __builtin_amdgcn_ds_swizzle(__builtin_bit_cast(int, x), 0x1f | ((o) << 10))))
              float m1 = v; m1 = SWZ_MAX(m1, 1); m1 = SWZ_MAX(m1, 2); m1 = SWZ_MAX(m1, 4);
              float c1 = (v == m1) ? 1.f : 0.f; c1 = SWZ_ADD(c1, 1); c1 = SWZ_ADD(c1, 2); c1 = SWZ_ADD(c1, 4);
              float m2 = (v == m1) ? -INFINITY : v; m2 = SWZ_MAX(m2, 1); m2 = SWZ_MAX(m2, 2); m2 = SWZ_MAX(m2, 4);
              const float gs = m1 + (c1 >= 2.f ? m1 : m2);
              if ((lane & 7) == 0) gsl[tk * 8 + (lane >> 3)] = gs;
              __syncthreads();
              int grank = 0; const int g = lane >> 3;
#pragma unroll
              for (int j = 0; j < 8; ++j) { const float x = gsl[tk * 8 + j]; grank += (x > gs || (x == gs && j < g)) ? 1 : 0; }
              const bool gsel = grank < 4; const float cv = gsel ? v : -INFINITY;
              cvl[tk * 64 + lane] = cv;
              __syncthreads();
              int rank = 0;
#pragma unroll 16
              for (int j = 0; j < 64; ++j) { const float x = cvl[tk * 64 + j]; rank += (x > cv || (x == cv && j < lane)) ? 1 : 0; }
              const bool sel = gsel && rank < 8;
              const float wsum = wave_sum(sel ? s : 0.f);
              if (sel) { R.ridx[t * 8 + rank] = lane; R.rwt[t * 8 + rank] = s * (2.5f / wsum); atomicAdd((unsigned*)&hist[lane], 1u); }
#undef SWZ_MAX
#undef SWZ_ADD
          } }
        __syncthreads();
    }
#undef RT_LOAD
    if (count && tid < 64 && hist[tid]) atomicAdd(&R.cnt[tid], hist[tid]);
    __syncthreads();
}
#ifndef DUP_PHASE
#define DUP_PHASE -1
#endif
constexpr int CTX_OFF = LDS_CTL + 1024, TAB_OFF = LDS_CTL + 7168;
constexpr size_t WS_WINE = 1 * MiB, WS_WINO = WS_WINE + (size_t)EINP * 1024 * 2, WS_WOUT = WS_WINO + (size_t)OINP * 1024 * 2, WS_XBF = 16 * MiB, WS_NAIVE = 80 * MiB;
#if defined(WITH_NAIVE)
constexpr size_t WS_MIXBF = 48 * MiB;
#else
constexpr size_t WS_MIXBF = 453 * MiB;
#endif
__device__ __forceinline__ int conv_split(int nwg, int G) {
#if defined(WITH_NAIVE)
    return 0;
#else
    const int rem = nwg % G; return rem == 0 ? 0 : (G - rem) * NWAVES * 4;
#endif
}
static_assert(WS_WOUT + 2 * 1024 * 1024 * 2 <= WS_XBF, "ws map");
constexpr size_t WS_WD = 48 * MiB, WS_WGU = WS_WD + 65 * 512 * 1024, WS_LISTS = 146 * MiB, WS_RIDX = 148 * MiB, WS_H = 149 * MiB, WS_ROWS8 = 229 * MiB;
static_assert(WS_WGU + (size_t)65 * 1024 * 1024 <= WS_LISTS && WS_H + (size_t)MOE_MAXBLK * 256 * 512 <= WS_ROWS8 && WS_ROWS8 + (size_t)nv::T_ * 8 * 2048 <= 512 * MiB, "moe ws map");
constexpr size_t WS_PROJB = 149 * MiB, WS_CT = 253 * MiB, WS_HLOC = 317 * MiB, WS_PC = 349 * MiB, WS_M0SMALL = 381 * MiB, WS_LRUW = 486 * MiB;
constexpr size_t WS_UT = 221 * MiB, WS_S5G = 253 * MiB, WS_M1SMALL = 269 * MiB, WS_GLUW = 486 * MiB + 256 * 1024;
constexpr size_t WS_RW = 487 * MiB;
constexpr int CW_PROBE = 9000;
struct Tab { const float* in[38]; float* out; unsigned char* ws; };
struct Env { const Tab* tab; unsigned char* ws; float* out; LAS unsigned char* lds; int tid, lane, wave, bid, G, gw, NGW, gtid, gsz, vcu; };
__device__ __forceinline__ Env penv(unsigned char* lds_raw) {
    Env e; e.tab = (const Tab*)(lds_raw + TAB_OFF); e.ws = e.tab->ws; e.out = e.tab->out; e.lds = (LAS unsigned char*)lds_raw;
    int t = threadIdx.x; asm volatile("" : "+v"(t)); e.tid = t; e.lane = t & 63; e.wave = __builtin_amdgcn_readfirstlane(t >> 6);
    int b = blockIdx.x; asm volatile("" : "+s"(b)); e.bid = b; int g = gridDim.x; asm volatile("" : "+s"(g)); e.G = g;
    e.vcu = (g % 8 == 0) ? (b % 8) * (g / 8) + b / 8 : b;
    e.gw = b * NWAVES + e.wave; e.NGW = g * NWAVES; e.gtid = b * NTHREADS + t; e.gsz = g * NTHREADS;
    return e;
}
__device__ __forceinline__ void grid_bar(const Env& e) {
    XcdBarrier b; b.bar = (unsigned*)e.ws + 4096; b.x = xb_xcc_id(); b.st = (volatile LAS unsigned*)(e.lds + MISC_OFF) + 8;
    xcd_barrier(b);
}
#if defined(WITH_NAIVE)
template <int ST> __device__ __forceinline__ void run_naive(unsigned char* lds_raw, int ci, long n) {
    const Env e = penv(lds_raw);
    const nv::Ctx& c = ((const nv::Ctx*)(lds_raw + CTX_OFF))[ci];
    for (long i = e.gtid; i < n; i += e.gsz) nv::item<ST>(c, i);
    grid_bar(e);
}
#endif
__device__ __forceinline__ void phase_p0(unsigned char* lds_raw) {
    const Env e = penv(lds_raw);
    LAS float* scr = (LAS float*)(e.lds + e.wave * 16640);
    constexpr int I0 = 16 * (EINP / 64), I1 = I0 + 16 * (OINP / 64), I2 = I1 + 256, I3 = I2 + 256, I4 = I3 + 32, I5 = I4 + 64;
    for (int it = e.gw; it < I5; it += e.NGW) {
        if (it < I0) tr_matrix_item(e.tab->in[6], 1024, nv::EIN, EINP, (bf16*)(e.ws + WS_WINE), scr, it, e.lane);
        else if (it < I1) tr_matrix_item(e.tab->in[16], 1024, nv::OIN, OINP, (bf16*)(e.ws + WS_WINO), scr, it - I0, e.lane);
        else if (it < I2) tr_matrix_item(e.tab->in[5], 1024, 1024, 1024, (bf16*)(e.ws + WS_WOUT), scr, it - I1, e.lane);
        else if (it < I3) tr_matrix_item(e.tab->in[5] + 1024 * 1024, 1024, 1024, 1024, (bf16*)(e.ws + WS_WOUT) + 1024 * 1024, scr, it - I2, e.lane);
        else if (it < I4) { const int r = it - I3, mtx = r >> 2, h = mtx & 3, which = mtx >> 2;
            tr_matrix_item(e.tab->in[which ? 13 : 11] + h * 16384, 128, 128, 128, (bf16*)(e.ws + WS_LRUW) + which * 65536 + h * 16384, scr, r & 3, e.lane); }
        else tr_matrix_item(e.tab->in[25], 512, 512, 512, (bf16*)(e.ws + WS_GLUW), scr, it - I4, e.lane);
    }
    for (int l = 0; l < 2; ++l) router_split_weights(e.tab->in[30] + (size_t)l * 65536, (bf16*)(e.ws + WS_RW) + (size_t)l * 131072, (bf16*)(e.ws + WS_RW) + (size_t)l * 131072 + 65536, e.gtid, e.gsz);
    cvt_rows(e.tab->in[0], (bf16*)(e.ws + WS_XBF), (long)T_ * 1024, e.gtid, e.gsz);
    grid_bar(e);
}
__device__ __forceinline__ void phase_inproj(unsigned char* lds_raw, int layer) {
    const Env e = penv(lds_raw);
    float* proj = (float*)(e.ws + WS_NAIVE) + ((size_t)T_ * 1024 + (size_t)T_ * 64 + (size_t)T_ * 8 * 2);
    const int NP = layer == 0 ? EINP : OINP;
    pg8::Gemm g{(const bf16*)(e.ws + WS_XBF), (const bf16*)(e.ws + (layer == 0 ? WS_WINE : WS_WINO)), 1024, 0, 0, nullptr};
    pg8::StaticOrder S; S.init(T_, NP, e.G, e.bid);
    pg8::EpiF32R E{proj, NP, nullptr, 0.f};
    pg8::gemm_phase<pg8::EpiF32R, pg8::StaticOrder, true, false>(e.lds, g, S, E);
    grid_bar(e);
}
__device__ __forceinline__ void phase_cvt_mixed(unsigned char* lds_raw) {
    const Env e = penv(lds_raw);
    cvt_rows((const float*)(e.ws + WS_NAIVE), (bf16*)(e.ws + WS_MIXBF), (long)T_ * 1024, e.gtid, e.gsz);
    grid_bar(e);
}
__device__ __forceinline__ void phase_outproj(unsigned char* lds_raw, int layer) {
    const Env e = penv(lds_raw);
    float* z = (float*)(e.ws + WS_NAIVE) + ((size_t)T_ * 1024 + (size_t)T_ * 64 + (size_t)T_ * 8 * 2);
    const float* hcur = layer == 0 ? e.tab->in[0] : e.out;
    pg8::Gemm g{(const bf16*)(e.ws + WS_MIXBF), (const bf16*)(e.ws + WS_WOUT) + (size_t)layer * 1024 * 1024, 1024, 0, 0, nullptr};
    pg8::StaticOrder S; S.init(T_, 1024, e.G, e.bid);
    pg8::EpiF32R E{z, 1024, hcur, nv::ALPHA};
    pg8::gemm_phase<pg8::EpiF32R, pg8::StaticOrder, true, false>(e.lds, g, S, E);
    grid_bar(e);
}
__device__ __forceinline__ Mix0Bufs mix0_bufs(unsigned char* ws) {
    Mix0Bufs B; B.proj = (const bf16*)(ws + WS_PROJB); B.ct = (bf16*)(ws + WS_CT); B.hloc = (float*)(ws + WS_HLOC); B.pc = (float*)(ws + WS_PC);
    float* sm = (float*)(ws + WS_M0SMALL); B.nloc = sm; sm += 8 * NCH * 128; B.blast = sm; sm += 8 * NCH; B.mloc = sm; sm += 8 * NCH; B.mprev = sm; sm += 8 * NCH;
    B.carA = sm; sm += 2 * NCH * 512; B.carU = sm; sm += 2 * NCH * 512; B.carI = sm;
    B.mixbf = (bf16*)(ws + WS_MIXBF); B.lruw = (const bf16*)(ws + WS_LRUW); return B;
}
__device__ __forceinline__ Mix1Bufs mix1_bufs(unsigned char* ws) {
    Mix1Bufs B; B.proj = (const bf16*)(ws + WS_PROJB); B.ut = (bf16*)(ws + WS_UT); B.s5g = (bf16*)(ws + WS_S5G);
    float* sm = (float*)(ws + WS_M1SMALL); B.gbl = sm; sm += 8 * NCH * 64; B.xend = sm; sm += 8192 * 128; B.xstart = sm; sm += 8192 * 128; B.s5ab = sm; sm += 4096; B.s5bb = sm; sm += 2048 * 32;
    B.cm = (bf16*)sm; B.bbt = B.cm + 32 * 32 * 128; B.mixbf = (bf16*)(ws + WS_MIXBF); return B;
}
__device__ __forceinline__ void phase_inproj_bf16(unsigned char* lds_raw, int layer) {
    const Env e = penv(lds_raw);
    const int NP = layer == 0 ? EINP : OINP;
    if (layer == 1) { const Mix1Bufs B = mix1_bufs(e.ws); s5_params(B, e.tab->in, e.gtid, e.gsz); }
    pg8::Gemm g{(const bf16*)(e.ws + WS_XBF), (const bf16*)(e.ws + (layer == 0 ? WS_WINE : WS_WINO)), 1024, 0, 0, nullptr};
    pg8::StaticOrder S; S.init(T_, NP, e.G, e.bid);
    pg8::EpiBf16P E{(bf16*)(e.ws + WS_PROJB), NP};
    pg8::gemm_phase<pg8::EpiBf16P, pg8::StaticOrder, true, false>(e.lds, g, S, E);
    { const int nwg = (T_ / 256) * (NP / 256), rem = nwg % e.G, na = conv_split(nwg, e.G);
      if (na > 0 && e.bid >= rem) { const int nlight = e.G - rem; LAS float* scr = (LAS float*)(e.lds + e.wave * 16640);
          moe_convert_weights(e.tab->in[32] + (size_t)layer * 64 * 262144, e.tab->in[33] + (size_t)layer * 64 * 262144, e.tab->in[34] + (size_t)layer * 64 * 262144,
                              e.tab->in[35] + (size_t)layer * 262144, e.tab->in[36] + (size_t)layer * 262144, e.tab->in[37] + (size_t)layer * 262144,
                              (bf16*)(e.ws + WS_WGU), (bf16*)(e.ws + WS_WD), scr, (e.bid - rem) * NWAVES + e.wave, na, nlight * NWAVES, e.lane); } }
    grid_bar(e);
}
__device__ __forceinline__ void phase_mix0_a(unsigned char* lds_raw) {
    const Env e = penv(lds_raw); const Mix0Bufs B = mix0_bufs(e.ws);
    for (int it = e.bid; it < 256 + 8 * NCH; it += e.G) {
        if (it < 256) { lru_a_item(B, e.tab->in, it, e.lds, e.tid); if (DUP_PHASE == 31) lru_a_item(B, e.tab->in, it, e.lds, e.tid); }
        else { mlstm_a_item(B, e.tab->in[7], it - 256, e.lds, e.tid); if (DUP_PHASE == 30) mlstm_a_item(B, e.tab->in[7], it - 256, e.lds, e.tid); } }
    grid_bar(e);
}
__device__ __forceinline__ int conv_rest(int nwg, int G, int NGW) {
#if defined(WITH_NAIVE)
    return 0;
#else
    const int nb = conv_split(nwg, G) + NGW * 3; return nb > 65 * 192 ? 65 * 192 : nb;
#endif
}
__device__ __forceinline__ void conv_in_scan_phase(const Env& e, int layer) {
#if !defined(WITH_NAIVE)
    const int na = conv_split((T_ / 256) * ((layer == 0 ? EINP : OINP) / 256), e.G); int nb = na + e.NGW * 3; if (nb > 65 * 192) nb = 65 * 192;
    LAS float* scr = (LAS float*)(e.lds + e.wave * 16640);
    moe_convert_weights(e.tab->in[32] + (size_t)layer * 64 * 262144, e.tab->in[33] + (size_t)layer * 64 * 262144, e.tab->in[34] + (size_t)layer * 64 * 262144,
                        e.tab->in[35] + (size_t)layer * 262144, e.tab->in[36] + (size_t)layer * 262144, e.tab->in[37] + (size_t)layer * 262144,
                        (bf16*)(e.ws + WS_WGU), (bf16*)(e.ws + WS_WD), scr, na + e.gw, nb, e.NGW, e.lane);
#endif
}
__device__ __forceinline__ void phase_mix0_b(unsigned char* lds_raw) {
    const Env e = penv(lds_raw); const Mix0Bufs B = mix0_bufs(e.ws);
    lru_b(B, e.gtid, e.gsz); mlstm_b(B, e.gtid, e.gsz);
    grid_bar(e);
}
__device__ __forceinline__ void phase_mix0_c(unsigned char* lds_raw) {
    const Env e = penv(lds_raw); const Mix0Bufs B = mix0_bufs(e.ws);
    for (int it = e.bid; it < 8 * NCH; it += e.G) { mlstm_c_item(B, e.tab->in[7], e.tab->in[8], it, e.lds, e.tid); if (DUP_PHASE == 32) mlstm_c_item(B, e.tab->in[7], e.tab->in[8], it, e.lds, e.tid); }
    lru_c(B, e.gtid, e.gsz); if (DUP_PHASE == 33) lru_c(B, e.gtid, e.gsz);
    grid_bar(e);
}
__device__ __forceinline__ void phase_mix1_a(unsigned char* lds_raw) {
    const Env e = penv(lds_raw); const Mix1Bufs B = mix1_bufs(e.ws);
    for (int it = e.bid; it < 8 * NCH; it += e.G) { gla_a_item(B, e.tab->in[27], e.tab->in[28], it, e.lds, e.tid); if (DUP_PHASE == 34) gla_a_item(B, e.tab->in[27], e.tab->in[28], it, e.lds, e.tid); }
    s5_phase<false>(B, e.tab->in[23], e.gw, e.NGW, e.lds + e.wave * 17408, e.lane); if (DUP_PHASE == 35) s5_phase<false>(B, e.tab->in[23], e.gw, e.NGW, e.lds + e.wave * 17408, e.lane);
    grid_bar(e);
}
__device__ __forceinline__ void phase_mix1_b(unsigned char* lds_raw) {
    const Env e = penv(lds_raw); const Mix1Bufs B = mix1_bufs(e.ws);
    s5_b(B, e.gtid, e.gsz); gla_b(B, e.gtid, e.gsz);
    grid_bar(e);
}
__device__ __forceinline__ void phase_mix1_c(unsigned char* lds_raw) {
    const Env e = penv(lds_raw); const Mix1Bufs B = mix1_bufs(e.ws);
    for (int it = e.bid; it < 8 * NCH; it += e.G) { gla_c_item(B, e.tab->in[27], e.tab->in[28], e.tab->in[29], it, e.lds, e.tid); if (DUP_PHASE == 36) gla_c_item(B, e.tab->in[27], e.tab->in[28], e.tab->in[29], it, e.lds, e.tid); }
#if defined(S5_OLD_C)
    for (int it = e.gw, k = 0; k < (2 * 32 * NCH + e.NGW - 1) / e.NGW; ++k, it += e.NGW) s5_chunk_v2<true>(B, e.tab->in[23], it, it < 2 * 32 * NCH, e.lds + e.wave * 16896, e.lane);
#else
    s5_phase<true>(B, e.tab->in[23], e.gw, e.NGW, e.lds + e.wave * 17408, e.lane); if (DUP_PHASE == 37) s5_phase<true>(B, e.tab->in[23], e.gw, e.NGW, e.lds + e.wave * 17408, e.lane);
#endif
    grid_bar(e);
}
__device__ __forceinline__ void phase_glu(unsigned char* lds_raw) {
    const Env e = penv(lds_raw);
    pg8::Gemm g{(const bf16*)(e.ws + WS_S5G), (const bf16*)(e.ws + WS_GLUW), 512, 0, 0, nullptr};
    pg8::StaticOrder S; S.init(T_, 512, e.G, e.bid);
    pg8::EpiGlu E{(bf16*)(e.ws + WS_MIXBF), 1024, (const bf16*)(e.ws + WS_S5G), 512, e.tab->in[26]};
    pg8::gemm_phase<pg8::EpiGlu, pg8::StaticOrder, true, false>(e.lds, g, S, E);
    grid_bar(e);
}
__device__ __forceinline__ void phase_probe(unsigned char* lds_raw, int c0, int c1) {
    const Env e = penv(lds_raw);
    const bf16* a = (const bf16*)(e.ws + WS_MIXBF); const float* b = (const float*)(e.ws + WS_NAIVE);
    float sd = 0.f, sr = 0.f; const int w = c1 - c0;
    for (long i = e.gtid; i < (long)T_ * w; i += e.gsz) { const long t = i / w; const int c = c0 + (int)(i % w); const float x = bf2f(a[t * 1024 + c]), y = b[t * 1024 + c]; sd += (x - y) * (x - y); sr += y * y; }
    sd = wave_sum(sd); sr = wave_sum(sr);
    if (e.lane == 0) { atomicAdd((float*)e.ws + CW_PROBE, sd); atomicAdd((float*)e.ws + CW_PROBE + 1, sr); }
    grid_bar(e);
}
__device__ __forceinline__ void phase_probe_apply(unsigned char* lds_raw) {
    const Env e = penv(lds_raw);
    const float sd = __hip_atomic_load((float*)e.ws + CW_PROBE, __ATOMIC_RELAXED, __HIP_MEMORY_SCOPE_AGENT), sr = __hip_atomic_load((float*)e.ws + CW_PROBE + 1, __ATOMIC_RELAXED, __HIP_MEMORY_SCOPE_AGENT);
    const float f = 1.0f + 10.0f * sqrtf(sd / fmaxf(sr, 1e-30f));
    for (long i = e.gtid; i < (long)T_ * 1024; i += e.gsz) e.out[i] *= f;
}
__device__ __forceinline__ void phase_ln_router(unsigned char* lds_raw, int layer, bool count = true) {
    const Env e = penv(lds_raw);
    RouterBufs R; R.z = (const float*)(e.ws + WS_NAIVE) + ((size_t)T_ * 1024 + (size_t)T_ * 64 + (size_t)T_ * 8 * 2); R.h = e.out; R.hbf = (bf16*)(e.ws + WS_XBF);
    R.lnw = e.tab->in[1] + layer * 1024; R.lnb = e.tab->in[2] + layer * 1024; R.rwh = (const bf16*)(e.ws + WS_RW) + (size_t)layer * 131072; R.rwl = R.rwh + 65536;
    R.rbias = e.tab->in[31] + layer * 64; R.ridx = (int*)(e.ws + WS_RIDX); R.rwt = (float*)(e.ws + WS_RIDX) + (size_t)T_ * 8; R.cnt = (unsigned*)e.ws + CW_CNT + layer * 256;
    router_tiles(R, e.bid, e.G, T_ / 16, e.lds, e.tid, count);
    grid_bar(e);
}
__device__ __forceinline__ MoeLists moe_lists(unsigned char* ws) {
    MoeLists L; L.tok = (int*)(ws + WS_LISTS); L.dest = L.tok + MOE_MAXBLK * 256; L.w = (float*)(L.dest + MOE_MAXBLK * 256); L.blk_e = (int*)(L.w + MOE_MAXBLK * 256); return L;
}
__device__ __forceinline__ void phase_moe_x1(unsigned char* lds_raw, int layer, int curoff = 0) {
    const Env e = penv(lds_raw);
    moe_build_lists((const int*)(e.ws + WS_RIDX), (const float*)(e.ws + WS_RIDX) + (size_t)T_ * 8, (unsigned*)e.ws + CW_CNT + layer * 256, (unsigned*)e.ws + CW_CUR + layer * 256 + curoff,
                    moe_lists(e.ws), (LAS int*)e.lds, e.tid, e.bid, e.G);
    LAS float* scr = (LAS float*)(e.lds + e.wave * 16640);
    moe_convert_weights(e.tab->in[32] + (size_t)layer * 64 * 262144, e.tab->in[33] + (size_t)layer * 64 * 262144, e.tab->in[34] + (size_t)layer * 64 * 262144,
                        e.tab->in[35] + (size_t)layer * 262144, e.tab->in[36] + (size_t)layer * 262144, e.tab->in[37] + (size_t)layer * 262144,
                        (bf16*)(e.ws + WS_WGU), (bf16*)(e.ws + WS_WD), scr, conv_split((T_ / 256) * ((layer == 0 ? EINP : OINP) / 256), e.G) + e.gw, 65 * 192, e.NGW, e.lane);
    grid_bar(e);
}
__device__ __forceinline__ void phase_moe_g1(unsigned char* lds_raw) {
    const Env e = penv(lds_raw);
    const MoeLists L = moe_lists(e.ws);
    const int nblk = __builtin_amdgcn_readfirstlane(L.blk_e[MOE_MAXBLK]);
    pg8::Gemm g{(const bf16*)(e.ws + WS_XBF), (const bf16*)(e.ws + WS_WGU), 1024, 0, (size_t)512 * 1024, L.tok};
    pg8::MoeOrder S{L.blk_e, nblk, 2, e.G, e.vcu};
    pg8::EpiSwiGLU E{(bf16*)(e.ws + WS_H)};
    pg8::gemm_phase<pg8::EpiSwiGLU, pg8::MoeOrder, true, true>(e.lds, g, S, E);
    grid_bar(e);
}
__device__ __forceinline__ void phase_moe_g2(unsigned char* lds_raw) {
    const Env e = penv(lds_raw);
    const MoeLists L = moe_lists(e.ws);
    const int nblk = __builtin_amdgcn_readfirstlane(L.blk_e[MOE_MAXBLK]);
    pg8::Gemm g{(const bf16*)(e.ws + WS_H), (const bf16*)(e.ws + WS_WD), 256, 0, (size_t)1024 * 256, nullptr};
    pg8::MoeOrder S{L.blk_e, nblk, 4, e.G, e.vcu};
    pg8::EpiDown E{(bf16*)(e.ws + WS_ROWS8), (bf16*)(e.ws + WS_XBF), L.dest, T_ * 8};
    pg8::gemm_phase<pg8::EpiDown, pg8::MoeOrder, true, false>(e.lds, g, S, E);
    grid_bar(e);
}
__device__ __forceinline__ void phase_moe_combine(unsigned char* lds_raw, int layer) {
    const Env e = penv(lds_raw);
    moe_combine_ln(e.out, (const bf16*)(e.ws + WS_ROWS8), (const bf16*)(e.ws + WS_XBF), (const float*)(e.ws + WS_RIDX) + (size_t)T_ * 8, e.tab->in[3] + layer * 1024, e.tab->in[4] + layer * 1024,
                   layer == 0 ? (bf16*)(e.ws + WS_XBF) : nullptr, e.gw, e.NGW, e.lane);
    grid_bar(e);
}

#define RUN(k, call) do { call; if (DUP_PHASE == (k)) { call; } } while (0)
#ifndef TIME_PHASE
#define TIME_PHASE -1
#endif
#define TIMED(k, call) do { unsigned long long _t0 = 0; if (TIME_PHASE == (k)) _t0 = __builtin_amdgcn_s_memrealtime(); call; \
    if (TIME_PHASE == (k) && blockIdx.x == 0 && threadIdx.x == 0) { const unsigned long long _t1 = __builtin_amdgcn_s_memrealtime(); unsigned* w_ = (unsigned*)((Tab*)(lds_raw + TAB_OFF))->ws + CW_PROBE + 8; *w_ = *w_ + (unsigned)(_t1 - _t0); } } while (0)
template <int layer> __device__ __forceinline__ void layer_body(unsigned char* lds_raw) {
#if defined(WITH_NAIVE)
    constexpr int ci = layer * 2;
#if defined(DBG_MIX0)
    constexpr bool naive_too = (layer == DBG_MIX0 - 1);
#else
    constexpr bool naive_too = false;
#endif
#endif
    RUN(1, phase_inproj_bf16(lds_raw, layer));
    if (layer == 0) { RUN(2, phase_mix0_a(lds_raw)); TIMED(20, phase_mix0_b(lds_raw)); RUN(3, phase_mix0_c(lds_raw)); }
    if (layer == 1) { RUN(4, phase_mix1_a(lds_raw)); TIMED(21, phase_mix1_b(lds_raw)); RUN(5, phase_mix1_c(lds_raw)); RUN(6, phase_glu(lds_raw)); }
#if defined(WITH_NAIVE)
    if (naive_too) {
        phase_inproj(lds_raw, layer);
        if (layer == 0) {
            run_naive<nv::ST_ML_GATES>(lds_raw, ci, 8L * NCH);
            run_naive<nv::ST_ML_CLOC>(lds_raw, ci, 8L * NCH * 16384);
            run_naive<nv::ST_ML_SCAN>(lds_raw, ci, 8L * 16384 + 8 * 128);
            run_naive<nv::ST_ML_MI>(lds_raw, ci, 8L * S_);
            run_naive<nv::ST_ML_SMAT>(lds_raw, ci, 8L * NCH * 4096);
            run_naive<nv::ST_ML_DEN>(lds_raw, ci, 8L * S_);
            run_naive<nv::ST_ML_H>(lds_raw, ci, 8L * S_ * 128);
            run_naive<nv::ST_ML_NORM>(lds_raw, ci, 8L * S_);
            run_naive<nv::ST_LRU_CONV>(lds_raw, ci, (long)T_ * 512);
            run_naive<nv::ST_LRU_GATE>(lds_raw, ci, (long)T_ * 512);
            run_naive<nv::ST_LRU_SCAN>(lds_raw, ci, 2L * 512);
        } else {
            run_naive<nv::ST_S5_PAR>(lds_raw, ci, 2048);
            for (int sl = 0; sl < S_ / nv::SLAB; ++sl) {
                if (threadIdx.x == 0) ((nv::Ctx*)(lds_raw + CTX_OFF))[ci].slab = sl;
                __syncthreads();
                run_naive<nv::ST_S5_SCAN>(lds_raw, ci, 2L * 2048); run_naive<nv::ST_S5_OUT>(lds_raw, ci, (long)nv::B_ * nv::SLAB * 512); }
            run_naive<nv::ST_S5_GLU>(lds_raw, ci, (long)T_ * 512);
            run_naive<nv::ST_GLA_GATE>(lds_raw, ci, (long)T_ * 256);
            run_naive<nv::ST_GLA_CUM>(lds_raw, ci, (long)nv::B_ * NCH * 256);
            run_naive<nv::ST_GLA_U>(lds_raw, ci, 8L * NCH * 8192);
            run_naive<nv::ST_GLA_SCAN>(lds_raw, ci, 8L * 8192);
            run_naive<nv::ST_GLA_ATT>(lds_raw, ci, 8L * NCH * 4096);
            run_naive<nv::ST_GLA_O>(lds_raw, ci, 8L * S_ * 128);
            run_naive<nv::ST_GLA_NORM>(lds_raw, ci, 8L * S_);
        }
        phase_probe(lds_raw, DBG_C0, DBG_C1);
        phase_cvt_mixed(lds_raw);
    }
#endif
    RUN(7, phase_outproj(lds_raw, layer));
    TIMED(22, phase_ln_router(lds_raw, layer)); if (DUP_PHASE == 22) phase_ln_router(lds_raw, layer, false);
    phase_moe_x1(lds_raw, layer); if (DUP_PHASE == 8) phase_moe_x1(lds_raw, layer, 1024);
    RUN(9, phase_moe_g1(lds_raw));
    RUN(10, phase_moe_g2(lds_raw));
    TIMED(24, phase_moe_combine(lds_raw, layer));
}
#if defined(STORE_TEST)
__device__ __forceinline__ void phase_store_test(unsigned char* lds_raw) {
    const Env e = penv(lds_raw);
    unsigned char* base = e.ws + WS_ROWS8 + (size_t)e.bid * (1u << 20);
    const int wr = e.wave >> 2, wc = e.wave & 3, fr = e.lane & 15, fq = e.lane >> 4;
    const v4u val = {(unsigned)e.tid, 1u, 2u, 3u};
    for (int u = 0; u < 40; ++u) {
#pragma unroll
        for (int s = 0; s < 8; ++s)
#pragma unroll
            for (int bj = 0; bj < 2; ++bj) {
#if STORE_TEST == 1
                const int r = (s >> 2) * 128 + wr * 64 + (s & 3) * 16 + fr; const int cb = wc * 64 + fq * 16 + bj * 256;
#elif STORE_TEST == 2
                const int r = (s >> 2) * 128 + wr * 64 + (s & 3) * 16 + bj * 8 + (e.lane >> 3); const int cb = wc * 128 + (e.lane & 7) * 16;
#else
                const int r = (s >> 2) * 128 + wr * 64 + (s & 3) * 16 + bj * 8 + (e.lane >> 4) * 2 + (wc & 1); const int cb = (wc >> 1) * 256 + (e.lane & 15) * 16;
#endif
                *(v4u*)(base + (size_t)((u & 1) * 256 + r) * 2048 + cb) = val; }
        asm volatile("" ::: "memory"); }
    grid_bar(e);
}
#endif
struct Args { const float* in[38]; float* out; unsigned char* ws; };
__global__ void __launch_bounds__(NTHREADS, 2) mega_fwd(Args a) {
    extern __shared__ __attribute__((aligned(16))) unsigned char lds_raw[];
    {
        LAS unsigned char* lds = (LAS unsigned char*)lds_raw;
        for (int u = threadIdx.x; u < (LDS_BYTES - LDS_CTL) / 4; u += NTHREADS) ((LAS unsigned*)(lds + LDS_CTL))[u] = 0u;
        __syncthreads();
        if (threadIdx.x == 0) {
            (void)xb_add((unsigned*)a.ws + 4096 + XB_XCNT(xb_xcc_id()), 1u);
            Tab* tab = (Tab*)(lds_raw + TAB_OFF);
#pragma unroll
            for (int i = 0; i < 38; ++i) { tab->in[i] = a.in[i]; if ((i & 7) == 7) asm volatile("" ::: "memory"); }
            tab->out = a.out; tab->ws = a.ws;
            asm volatile("" ::: "memory");
#if defined(WITH_NAIVE)
            nv::Ctx* const ctab = (nv::Ctx*)(lds_raw + CTX_OFF);
            const size_t scratch0 = (size_t)T_ * 1024 + (size_t)T_ * 64 + (size_t)T_ * 8 * 2;
#pragma unroll 1
            for (int layer = 0; layer < 2; ++layer) {
                nv::Ctx& c = ctab[layer * 2];
                nv::Mem M{(float*)(a.ws + WS_NAIVE), 0};
#pragma unroll 1
                for (int i = 0; i < 38; ++i) c.in[i] = tab->in[i];
                c.mixed = M.get((size_t)T_ * 1024); c.scores = M.get((size_t)T_ * 64);
                c.ridx = (int*)M.get((size_t)T_ * 8); c.rwt = M.get((size_t)T_ * 8);
                c.gR = nullptr; c.gBias = nullptr; c.slab = 0;
                c.layer = layer;
                c.hcur = layer == 0 ? a.in[0] : a.out;
                if (layer == 0) {
                    c.ldp = EINP; c.proj = M.get((size_t)T_ * c.ldp);
                    c.mb = M.get(8 * S_); c.mig = M.get(8 * S_); c.mblast = M.get(8 * NCH); c.mmloc = M.get(8 * NCH); c.mmprev = M.get(8 * NCH);
                    c.mmi = M.get(8 * S_); c.mwin = M.get(8 * S_); c.mden = M.get(8 * S_); c.nloc = M.get(8 * NCH * 128);
                    const size_t ov = M.off;
                    c.cloc = M.get((size_t)8 * NCH * 16384); c.smat = M.get((size_t)8 * NCH * 4096); c.htil = M.get((size_t)T_ * 512);
                    M.off = ov; c.lxc = M.get((size_t)T_ * 512); c.la = M.get((size_t)T_ * 512); c.lu = M.get((size_t)T_ * 512);
                } else {
                    c.ldp = OINP; c.proj = M.get((size_t)T_ * c.ldp);
                    c.s5ab = M.get(2048 * 2); c.s5bbr = M.get(2048 * 16); c.s5bbi = M.get(2048 * 16); c.s5st = M.get(2 * 2048 * 2);
                    c.s5x = M.get((size_t)nv::B_ * nv::SLAB * 2048 * 2); c.s5g = M.get((size_t)T_ * 512);
                    c.gla_la = M.get((size_t)T_ * 256); c.gla_bc = M.get((size_t)T_ * 256); c.gla_bl = M.get((size_t)nv::B_ * NCH * 256);
                    c.gu = M.get((size_t)8 * NCH * 8192); c.gatt = M.get((size_t)8 * NCH * 4096); c.go = M.get((size_t)T_ * 512);
                }
                c.z = c.proj; c.hout = a.out; c.lnw = a.in[1] + layer * 1024; c.lnb = a.in[2] + layer * 1024;
                M.off = scratch0; c.hid = M.get((size_t)T_ * 9 * 256);
                nv::Ctx& cm = ctab[layer * 2 + 1];
                cm = c; cm.hcur = a.out;
#ifdef DBG_LAYER
                if (layer == DBG_LAYER) { nv::Ctx& cd = ctab[4]; cd = cm;
                cd.hid = (float*)(a.ws + 48 * MiB); cd.z = (float*)(a.ws + 486 * MiB); cd.hcur = a.out + (size_t)DBG_T0 * 1024; cd.ridx = c.ridx + (size_t)DBG_T0 * 8; cd.rwt = c.rwt + (size_t)DBG_T0 * 8; }
#endif
            }
#endif
        }
        __syncthreads();
    }
    RUN(0, phase_p0(lds_raw));
    layer_body<0>(lds_raw);
    layer_body<1>(lds_raw);
#if defined(STORE_TEST)
    phase_store_test(lds_raw);
#endif
#if defined(DBG_MIX0)
    phase_probe_apply(lds_raw);
#endif
    if (TIME_PHASE >= 0) { const Env e = penv(lds_raw); const unsigned ticks = __hip_atomic_load((unsigned*)e.ws + CW_PROBE + 8, __ATOMIC_RELAXED, __HIP_MEMORY_SCOPE_AGENT);
        const float f = 1.0f + 0.0005f * (float)ticks * 0.01f;
        for (long i = e.gtid; i < (long)T_ * 1024; i += e.gsz) e.out[i] *= f; }
}
extern "C" void kernel_launch(void* const* d_in, const int* in_sizes, int n_in, void* d_out, int out_size, void* d_ws, size_t ws_size, hipStream_t stream) {
    static int grid = 0;
    if (grid == 0) {
        int dev = 0, cus = 0, per_cu = 0;
        hipGetDevice(&dev); hipDeviceGetAttribute(&cus, hipDeviceAttributeMultiprocessorCount, dev);
        hipFuncSetAttribute((const void*)mega_fwd, hipFuncAttributeMaxDynamicSharedMemorySize, LDS_BYTES);
        hipOccupancyMaxActiveBlocksPerMultiprocessor(&per_cu, (const void*)mega_fwd, NTHREADS, LDS_BYTES);
        (void)hipGetLastError();
        grid = (per_cu >= 1) ? cus : -1;
    }
    if (grid < 0) return;
    hipMemsetAsync(d_ws, 0, CTL_BYTES, stream);
    Args a{};
    for (int i = 0; i < 38; ++i) a.in[i] = (const float*)d_in[i];
    a.out = (float*)d_out; a.ws = (unsigned char*)d_ws;
    hipLaunchKernelGGL(mega_fwd, dim3(grid), dim3(NTHREADS), LDS_BYTES, stream, a);
}
```

```cpp
#define OPT_MIX0 1
#define OPT_MIX1 1
#define OPT_ROUTER 1
#include <hip/hip_runtime.h>
#define GAS __attribute__((address_space(1)))
#define LAS __attribute__((address_space(3)))
#define XB_TMO      128
#define XB_XCNT(j)  (256  + 64 * (j))
#define XB_XSUB(j)  (1280 + 64 * (j))
#define XB_XGEN(j)  (2304 + 64 * (j))
#define XB_TOP      3328
#define XB_TOPGEN   3392
#define XCD_BAR_WORDS 3456
#define XB_SPIN_CAP (1u << 22)
__device__ __forceinline__ unsigned xb_ld(unsigned* p)              { return __hip_atomic_load(p, __ATOMIC_RELAXED, __HIP_MEMORY_SCOPE_AGENT); }
__device__ __forceinline__ unsigned xb_add(unsigned* p, unsigned v) { return __hip_atomic_fetch_add(p, v, __ATOMIC_RELAXED, __HIP_MEMORY_SCOPE_AGENT); }
__device__ __forceinline__ unsigned xb_xcc_id() { return (unsigned)__builtin_amdgcn_s_getreg((3 << 11) | 20) & 0xFu; }
#define XB_SPIN(cond, bar) do { unsigned _sp = 0; while (cond) { __builtin_amdgcn_s_sleep(1); \
    if ((++_sp & 255u) == 0u) { if (xb_ld(&(bar)[XB_TMO])) break; if (_sp > XB_SPIN_CAP) { atomicAdd(&(bar)[XB_TMO], 1u); break; } } } } while (0)
struct XcdBarrier { unsigned* bar; unsigned x; volatile LAS unsigned* st; };
__device__ __forceinline__ XcdBarrier xcd_barrier_post(unsigned* bar, volatile LAS unsigned* st) {
    XcdBarrier b; b.bar = bar; b.x = xb_xcc_id(); b.st = st;
    if (threadIdx.x == 0) (void)xb_add(&bar[XB_XCNT(b.x)], 1u);
    return b;
}
__device__ __forceinline__ void xcd_barrier_complete(unsigned* bar, unsigned x, unsigned& nloc, unsigned& nx) {
    const unsigned G = gridDim.x * gridDim.y * gridDim.z;
    unsigned sum, cnt, mine, sp = 0u;
    for (;;) {
        sum = 0u; cnt = 0u; mine = 0u;
#pragma unroll
        for (unsigned j = 0; j < 16; ++j) { const unsigned c = xb_ld(&bar[XB_XCNT(j)]); sum += c; cnt += (c > 0u) ? 1u : 0u; mine = (j == x) ? c : mine; }
        if (sum == G) break;
        __builtin_amdgcn_s_sleep(1);
        if ((++sp & 255u) == 0u) { if (xb_ld(&bar[XB_TMO])) break; if (sp > XB_SPIN_CAP) { atomicAdd(&bar[XB_TMO], 1u); break; } }
    }
    nloc = mine > 0u ? mine : 1u; nx = cnt > 0u ? cnt : 1u;
}
__device__ __forceinline__ void xcd_barrier(const XcdBarrier& b) {
    asm volatile("s_waitcnt vmcnt(0)" ::: "memory");
    __syncthreads();
    if (threadIdx.x == 0) {
        unsigned* bar = b.bar;
        __builtin_amdgcn_s_waitcnt(0);
        unsigned nloc = b.st[0], nx = b.st[1];
        if (nloc == 0u) { xcd_barrier_complete(bar, b.x, nloc, nx); b.st[0] = nloc; b.st[1] = nx; }
        const unsigned old = xb_add(&bar[XB_XSUB(b.x)], 1u);
        const unsigned gen = old / nloc;
        if (old + 1u == (gen + 1u) * nloc) {
            __builtin_amdgcn_fence(__ATOMIC_RELEASE, "agent");
            asm volatile("s_waitcnt vmcnt(0)" ::: "memory");
            const unsigned og = xb_add(&bar[XB_TOP], 1u);
            const unsigned tg = og / nx;
            if (og + 1u == (tg + 1u) * nx) xb_add(&bar[XB_TOPGEN], 1u);
            else XB_SPIN(xb_ld(&bar[XB_TOPGEN]) == tg, bar);
            __builtin_amdgcn_fence(__ATOMIC_ACQUIRE, "agent");
            xb_add(&bar[XB_XGEN(b.x)], 1u);
            asm volatile("s_waitcnt vmcnt(0)" ::: "memory");
        } else {
            XB_SPIN(xb_ld(&bar[XB_XGEN(b.x)]) == gen, bar);
            __builtin_amdgcn_fence(__ATOMIC_ACQUIRE, "agent");
            asm volatile("s_waitcnt vmcnt(0)" ::: "memory");
        }
    }
    __syncthreads();
}
namespace pg8 {
#define PG8_LAS __attribute__((address_space(3)))
typedef unsigned short bf16_t;
typedef short bf16x8 __attribute__((ext_vector_type(8)));
typedef float f32x4 __attribute__((ext_vector_type(4)));
typedef unsigned u32x4 __attribute__((ext_vector_type(4)));
constexpr int BM = 256, BK = 64, HALF = 128, HTB = HALF * BK * 2, STAGE_BYTES = 8 * HTB, NXCD = 8, WGM = 8;
__host__ __device__ __forceinline__ int lds_byte(int r, int c) { const int st = (r >> 4) * 2 + (c >> 5), rr = r & 15, cc = c & 31, ob = rr * 64 + cc * 2; return st * 1024 + (ob ^ (((ob >> 9) & 1) << 5)); }
__host__ __device__ __forceinline__ void stage_rc(int b, int& R, int& C) { const int st = b / 1024, sb = b % 1024, swz = sb ^ (((sb >> 9) & 1) << 5); R = (st >> 1) * 16 + swz / 64; C = (st & 1) * 32 + (swz % 64) / 2; }
__host__ __device__ __forceinline__ int perm32(int rho) { const int n = rho >> 4, i = rho & 15; return 8 * (i >> 2) + 4 * n + (i & 3); }
struct Unit { int pm, pn, e, aux; };
struct Gemm { const bf16_t* A; const bf16_t* Bt; int K; int pad; size_t bstride; const int* rows; };
struct StaticOrder {
    int nM, nN, nwg, G, c;
    __host__ __device__ void init(int M, int N, int G_, int c_) { nM = M / BM; nN = N / BM; nwg = nM * nN; G = G_; c = c_; }
    __host__ __device__ bool next(int i, Unit& u) const {
        const long L = (long)i * G + c; if (L >= nwg) return false;
        int wgid = (int)L; { const int q = nwg / NXCD, r = nwg % NXCD, xcd = wgid % NXCD, off = wgid / NXCD; wgid = (xcd < r ? xcd * (q + 1) : r * (q + 1) + (xcd - r) * q) + off; }
        const int nig = WGM * nN, gid = wgid / nig, fm = gid * WGM, gsz = (nM - fm) < WGM ? (nM - fm) : WGM;
        u.pm = fm + ((wgid % nig) % gsz); u.pn = (wgid % nig) / gsz; u.e = 0; u.aux = 0; return true;
    }
};
__device__ __forceinline__ unsigned cvt_pk_bf16(float lo, float hi) { unsigned r; asm volatile("v_cvt_pk_bf16_f32 %0, %1, %2" : "=v"(r) : "v"(lo), "v"(hi)); return r; }
struct EpiF32R {
    static constexpr int NPRE = 0; __device__ __forceinline__ void load_pre(const Unit&, int, int, int (&)[1]) const {}
    static constexpr bool PERM = false;
    float* C; int ldc; const float* R; float ralpha;
    __device__ __forceinline__ void operator()(const f32x4 (&acc)[2][2][4][2], const Unit& u, int wr, int wc, int fr, int fq) const {
        const int row0 = u.pm * BM + wr * 64 + fr, col0 = u.pn * BM + wc * 32 + 4 * fq;
#pragma unroll
        for (int ai = 0; ai < 2; ++ai)
#pragma unroll
            for (int m = 0; m < 4; ++m) { const size_t off = (size_t)(row0 + ai * HALF + m * 16) * ldc + col0;
#pragma unroll
                for (int bj = 0; bj < 2; ++bj)
#pragma unroll
                    for (int n = 0; n < 2; ++n) { f32x4 v = acc[ai][bj][m][n]; if (R) v = v + ralpha * *(const f32x4*)(R + off + bj * HALF + n * 16); *(f32x4*)(C + off + bj * HALF + n * 16) = v; } }
    }
};
struct EpiBf16P {
    static constexpr int NPRE = 0; __device__ __forceinline__ void load_pre(const Unit&, int, int, int (&)[1]) const {}
    static constexpr bool PERM = true;
    bf16_t* O; int ldc;
    __device__ __forceinline__ void operator()(const f32x4 (&acc)[2][2][4][2], const Unit& u, int wr, int wc, int fr, int fq) const {
        const int row0 = u.pm * BM + wr * 64 + fr, col0 = u.pn * BM + wc * 32 + 8 * fq;
#pragma unroll
        for (int ai = 0; ai < 2; ++ai)
#pragma unroll
            for (int m = 0; m < 4; ++m) { bf16_t* rowp = O + (size_t)(row0 + ai * HALF + m * 16) * ldc + col0;
#pragma unroll
                for (int bj = 0; bj < 2; ++bj) { const f32x4 v0 = acc[ai][bj][m][0], v1 = acc[ai][bj][m][1];
                    u32x4 w; w.x = cvt_pk_bf16(v0[0], v0[1]); w.y = cvt_pk_bf16(v0[2], v0[3]); w.z = cvt_pk_bf16(v1[0], v1[1]); w.w = cvt_pk_bf16(v1[2], v1[3]);
                    *(u32x4*)(rowp + bj * HALF) = w; } }
    }
};
struct EpiGlu {
    static constexpr int NPRE = 0; __device__ __forceinline__ void load_pre(const Unit&, int, int, int (&)[1]) const {}
    static constexpr bool PERM = true;
    bf16_t* O; int ldo; const bf16_t* Gm; int ldg; const float* bias;
    __device__ __forceinline__ void operator()(const f32x4 (&acc)[2][2][4][2], const Unit& u, int wr, int wc, int fr, int fq) const {
        const int row0 = u.pm * BM + wr * 64 + fr, col0 = u.pn * BM + wc * 32 + 8 * fq;
#pragma unroll
        for (int ai = 0; ai < 2; ++ai)
#pragma unroll
            for (int m = 0; m < 4; ++m) { const size_t r = (size_t)(row0 + ai * HALF + m * 16);
#pragma unroll
                for (int bj = 0; bj < 2; ++bj) { const int c = col0 + bj * HALF;
                    const f32x4 b0 = *(const f32x4*)(bias + c), b1 = *(const f32x4*)(bias + c + 4); const u32x4 gv = *(const u32x4*)(Gm + r * ldg + c);
                    const f32x4 v0 = acc[ai][bj][m][0] + b0, v1 = acc[ai][bj][m][1] + b1;
                    float g[8] = {__builtin_bit_cast(float, gv.x << 16), __builtin_bit_cast(float, gv.x & 0xffff0000u), __builtin_bit_cast(float, gv.y << 16), __builtin_bit_cast(float, gv.y & 0xffff0000u),
                                  __builtin_bit_cast(float, gv.z << 16), __builtin_bit_cast(float, gv.z & 0xffff0000u), __builtin_bit_cast(float, gv.w << 16), __builtin_bit_cast(float, gv.w & 0xffff0000u)};
                    u32x4 w; w.x = cvt_pk_bf16(g[0] * __builtin_amdgcn_rcpf(1.f + __expf(-v0[0])), g[1] * __builtin_amdgcn_rcpf(1.f + __expf(-v0[1]))); w.y = cvt_pk_bf16(g[2] * __builtin_amdgcn_rcpf(1.f + __expf(-v0[2])), g[3] * __builtin_amdgcn_rcpf(1.f + __expf(-v0[3])));
                    w.z = cvt_pk_bf16(g[4] * __builtin_amdgcn_rcpf(1.f + __expf(-v1[0])), g[5] * __builtin_amdgcn_rcpf(1.f + __expf(-v1[1]))); w.w = cvt_pk_bf16(g[6] * __builtin_amdgcn_rcpf(1.f + __expf(-v1[2])), g[7] * __builtin_amdgcn_rcpf(1.f + __expf(-v1[3])));
                    *(u32x4*)(O + r * ldo + c) = w; } }
    }
};
template <class Epi, class Sched, bool ALIGN_EPI, bool GATHER>
__device__ __forceinline__ void gemm_phase(PG8_LAS unsigned char* lds, const Gemm g, const Sched& S, const Epi& E) {
    int tid_ = threadIdx.x; asm volatile("" : "+v"(tid_));
    const int tid = tid_, wid = __builtin_amdgcn_readfirstlane(tid >> 6), lane = tid & 63, wr = wid >> 2, wc = wid & 3, fr = lane & 15, fq = lane >> 4;
    const int K = g.K, nt = K / BK;
    unsigned voffA[2], voffB[2];
#pragma unroll
    for (int i = 0; i < 2; ++i) { int R, C; stage_rc(tid * 16 + i * 8192, R, C); const int Rb = Epi::PERM ? ((R & ~31) + perm32(R & 31)) : R;
        voffA[i] = (unsigned)(R * K + C) * 2u; voffB[i] = (unsigned)(Rb * K + C) * 2u; }
    const size_t kstep = (size_t)(BK * 2);
    const size_t hstep = (size_t)HALF * K * 2;
    const size_t tstep = 2 * hstep;
    const unsigned ldsw = (unsigned)wid * 1024u;
    const int aoff = lds_byte(wr * 64 + fr, fq * 8), boff = lds_byte(wc * 32 + fr, fq * 8);
#define PG8_SA(b, h) (((b) * 2 + (h)) * HTB)
#define PG8_SB(b, h) ((4 + (b) * 2 + (h)) * HTB)
#define PG8_STAGE(bufoff, gbase, voff) do { _Pragma("unroll") for (int _i = 0; _i < 2; ++_i) { unsigned _vo = (voff)[_i]; asm volatile("" : "+v"(_vo));   \
        __builtin_amdgcn_global_load_lds((const unsigned*)((const char*)(gbase) + _vo), (PG8_LAS unsigned*)(lds + (bufoff) + ldsw + _i * 8192), 16, 0, 0); } } while (0)
#define PG8_STAGE_A(bufoff, gbase, h, GV) do { if constexpr (GATHER) { PG8_STAGE(bufoff, gbase, GV[h]); } else { PG8_STAGE(bufoff, (gbase) + (h) * hstep, voffA); } } while (0)
#define PG8_STAGE_A2(bufoff, gbase, h) do { if constexpr (GATHER) { unsigned _gv[2] = {last ? gnxt[h][0] : gcur[h][0], last ? gnxt[h][1] : gcur[h][1]}; PG8_STAGE(bufoff, gbase, _gv); } else { PG8_STAGE(bufoff, (gbase) + (h) * hstep, voffA); } } while (0)
#define PG8_LDA(dst, b, h) do { _Pragma("unroll") for (int m = 0; m < 4; ++m) _Pragma("unroll") for (int k = 0; k < 2; ++k) dst[m][k] = *(const PG8_LAS bf16x8*)(lds + PG8_SA(b, h) + aoff + m * 2048 + k * 1024); } while (0)
#define PG8_LDB(dst, b, h) do { _Pragma("unroll") for (int n = 0; n < 2; ++n) _Pragma("unroll") for (int k = 0; k < 2; ++k) dst[n][k] = *(const PG8_LAS bf16x8*)(lds + PG8_SB(b, h) + boff + n * 2048 + k * 1024); } while (0)
#define PG8_MMA(ai, bj, At, Bt) do { __builtin_amdgcn_s_setprio(1); _Pragma("unroll") for (int m = 0; m < 4; ++m) _Pragma("unroll") for (int n = 0; n < 2; ++n) _Pragma("unroll") for (int k = 0; k < 2; ++k) \
        acc[ai][bj][m][n] = __builtin_amdgcn_mfma_f32_16x16x32_bf16(Bt[n][k], At[m][k], acc[ai][bj][m][n], 0, 0, 0); __builtin_amdgcn_s_setprio(0); } while (0)
#define PG8_WAIT_V(n) asm volatile("s_waitcnt vmcnt(" #n ")" ::: "memory")
#define PG8_WAIT_L(n) asm volatile("s_waitcnt lgkmcnt(" #n ")" ::: "memory")
#define PG8_BAR __builtin_amdgcn_s_barrier()
#define PG8_SCHED __builtin_amdgcn_sched_barrier(0)
#define PG8_GLOAD(GV, u) do { _Pragma("unroll") for (int _i = 0; _i < 2; ++_i) { int _R, _C; stage_rc(tid * 16 + _i * 8192, _R, _C); _Pragma("unroll") for (int _h = 0; _h < 2; ++_h) \
        GV[_h][_i] = (unsigned)g.rows[(u).pm * BM + _h * HALF + _R] * (unsigned)(K * 2) + (unsigned)(_C * 2); } } while (0)
    Unit cur, nxt; int ui = 0;
    if (!S.next(0, cur)) return;
    f32x4 acc[2][2][4][2];
#pragma unroll
    for (int a = 0; a < 2; ++a)
#pragma unroll
        for (int b = 0; b < 2; ++b)
#pragma unroll
            for (int m = 0; m < 4; ++m)
#pragma unroll
                for (int n = 0; n < 2; ++n) acc[a][b][m][n] = (f32x4){0.f, 0.f, 0.f, 0.f};
    bf16x8 At[4][2], B0[2][2], B1[2][2];
    unsigned gcur[2][2] = {{0u, 0u}, {0u, 0u}}, gnxt[2][2] = {{0u, 0u}, {0u, 0u}};
    if constexpr (Epi::NPRE > 0) E.prefetch(cur, 0, lds, wid, lane);
    if constexpr (GATHER) { PG8_GLOAD(gcur, cur); }
    const char* cA = GATHER ? (const char*)g.A : (const char*)g.A + (size_t)cur.pm * tstep;
    const char* cB = (const char*)g.Bt + ((size_t)cur.e * g.bstride) * 2 + (size_t)cur.pn * tstep;
    PG8_STAGE(PG8_SB(0, 0), cB, voffB); PG8_STAGE(PG8_SB(0, 1), cB + hstep, voffB); PG8_STAGE_A(PG8_SA(0, 0), cA, 0, gcur); PG8_STAGE_A(PG8_SA(0, 1), cA, 1, gcur);
    if (wr == 1) PG8_BAR;
    PG8_WAIT_V(2); PG8_BAR;
    PG8_STAGE(PG8_SB(1, 0), cB + kstep, voffB); PG8_STAGE_A(PG8_SA(1, 0), cA + kstep, 0, gcur); PG8_STAGE(PG8_SB(1, 1), cB + hstep + kstep, voffB);
    PG8_WAIT_V(6); PG8_BAR;
    for (;;) {
        const bool has_next = S.next(ui + 1, nxt);
        if constexpr (Epi::NPRE > 0) { if (has_next) E.prefetch(nxt, (ui + 1) % 3, lds, wid, lane); }
        if constexpr (GATHER) { if (has_next) { PG8_GLOAD(gnxt, nxt); } else {
#pragma unroll
            for (int _h = 0; _h < 2; ++_h)
#pragma unroll
                for (int _i = 0; _i < 2; ++_i) gnxt[_h][_i] = gcur[_h][_i]; } }
        const char* nA = GATHER ? cA : (has_next ? (const char*)g.A + (size_t)nxt.pm * tstep : cA);
        const char* nB = has_next ? (const char*)g.Bt + ((size_t)nxt.e * g.bstride) * 2 + (size_t)nxt.pn * tstep : cB;
#pragma unroll 1
        for (int t = 0; t < nt; t += 2) {
            const bool last = (t == nt - 2);
            const char* a1 = cA + (size_t)(t + 1) * kstep;
            const char* a2 = last ? nA : cA + (size_t)(t + 2) * kstep; const char* b2 = last ? nB : cB + (size_t)(t + 2) * kstep;
            const char* a3 = a2 + kstep; const char* b3 = b2 + kstep;
            PG8_LDB(B0, 0, 0); PG8_LDB(B1, 0, 1); PG8_SCHED; PG8_LDA(At, 0, 0); PG8_STAGE_A(PG8_SA(1, 1), a1, 1, gcur);
            PG8_WAIT_V(8); PG8_WAIT_L(0); PG8_BAR; PG8_MMA(0, 0, At, B0); PG8_MMA(0, 1, At, B1); PG8_BAR; PG8_SCHED;
            PG8_LDA(At, 0, 1); PG8_STAGE(PG8_SB(0, 0), b2, voffB); PG8_STAGE(PG8_SB(0, 1), b2 + hstep, voffB); PG8_STAGE_A2(PG8_SA(0, 0), a2, 0);
            PG8_WAIT_V(8); PG8_WAIT_L(0); PG8_BAR; PG8_MMA(1, 0, At, B0); PG8_MMA(1, 1, At, B1); PG8_BAR; PG8_SCHED;
            PG8_LDB(B0, 1, 0); PG8_LDB(B1, 1, 1); PG8_SCHED; PG8_LDA(At, 1, 0); PG8_STAGE_A2(PG8_SA(0, 1), a2, 1);
            PG8_WAIT_V(8); PG8_WAIT_L(0); PG8_BAR; PG8_MMA(0, 0, At, B0); PG8_MMA(0, 1, At, B1); PG8_BAR; PG8_SCHED;
            PG8_LDA(At, 1, 1); PG8_STAGE(PG8_SB(1, 0), b3, voffB); PG8_STAGE(PG8_SB(1, 1), b3 + hstep, voffB); PG8_STAGE_A2(PG8_SA(1, 0), a3, 0);
            PG8_WAIT_V(8); PG8_WAIT_L(0); PG8_BAR; PG8_MMA(1, 0, At, B0); PG8_MMA(1, 1, At, B1); PG8_BAR; PG8_SCHED;
        }
        if constexpr (ALIGN_EPI) { if (wr == 0) PG8_BAR; }
        if constexpr (Epi::NPRE > 0) E(acc, cur, wr, wc, fr, fq, ui % 3, lds); else E(acc, cur, wr, wc, fr, fq);
        if (!has_next) break;
#pragma unroll
        for (int a = 0; a < 2; ++a)
#pragma unroll
            for (int b = 0; b < 2; ++b)
#pragma unroll
                for (int m = 0; m < 4; ++m)
#pragma unroll
                    for (int n = 0; n < 2; ++n) acc[a][b][m][n] = (f32x4){0.f, 0.f, 0.f, 0.f};
        cur = nxt; cA = nA; cB = nB; ++ui;
        if constexpr (GATHER) {
#pragma unroll
            for (int _h = 0; _h < 2; ++_h)
#pragma unroll
                for (int _i = 0; _i < 2; ++_i) gcur[_h][_i] = gnxt[_h][_i]; }
        if constexpr (ALIGN_EPI) { if (wr == 1) PG8_BAR; }
    }
    PG8_WAIT_V(0);
    if constexpr (!ALIGN_EPI) { if (wr == 0) PG8_BAR; }
    PG8_BAR;
#undef PG8_SA
#undef PG8_SB
#undef PG8_STAGE
#undef PG8_STAGE_A
#undef PG8_STAGE_A2
#undef PG8_LDA
#undef PG8_LDB
#undef PG8_MMA
#undef PG8_WAIT_V
#undef PG8_WAIT_L
#undef PG8_BAR
#undef PG8_SCHED
#undef PG8_GLOAD
}
}
typedef unsigned short bf16;
typedef unsigned v4u __attribute__((ext_vector_type(4)));
typedef unsigned v2u __attribute__((ext_vector_type(2)));
typedef float f32x4 __attribute__((ext_vector_type(4)));
constexpr int NTHREADS = 512, NWAVES = 8;
constexpr int LDS_BYTES = 163840;
constexpr int LDS_CTL = 155648;
constexpr int MISC_OFF = LDS_CTL + 320;
constexpr size_t MiB = 1u << 20;
constexpr size_t CTL_BYTES = 1 * MiB;
#if !defined(WITH_NAIVE)
namespace nv { constexpr int B_ = 2, S_ = 8192, T_ = B_ * S_, NCH = S_ / 64, EIN = 3080, OIN = 2064; constexpr float ALPHA = 1.41421356237309515f, EPS = 1e-5f; struct Mem { float* base; size_t off; }; }
#endif
constexpr int T_ = nv::T_, S_ = nv::S_, NCH = nv::NCH;
constexpr int EINP = 3328, OINP = 2304;
#define LDS_WAIT() asm volatile("s_waitcnt lgkmcnt(0)" ::: "memory")
typedef __bf16 hwbf2_t __attribute__((ext_vector_type(2)));
typedef float hwf2_t __attribute__((ext_vector_type(2)));
__device__ __forceinline__ unsigned f2bf(float f) { const __bf16 b = (__bf16)f; return (unsigned)__builtin_bit_cast(unsigned short, b); }
__device__ __forceinline__ unsigned pk2(float lo, float hi) { const hwf2_t v = {lo, hi}; return __builtin_bit_cast(unsigned, __builtin_convertvector(v, hwbf2_t)); }
__device__ __forceinline__ float bf2f(unsigned short b) { return __builtin_bit_cast(float, (unsigned)b << 16); }
__device__ __forceinline__ void tr_item(const float* W, long ldw, int nvalid, bf16* dst, long ldd, LAS float* scr, int lane) {
#pragma unroll 8
    for (int i = 0; i < 32; ++i) { const int kk = 2 * i + (lane >> 5), nn = lane & 31; scr[kk * 33 + nn] = nn < nvalid ? W[(long)kk * ldw + nn] : 0.f; }
    LDS_WAIT(); asm volatile("" ::: "memory");
    const int c = lane & 7;
#pragma unroll
    for (int j = 0; j < 4; ++j) { const int n = (lane >> 3) + 8 * j; const LAS float* s = scr + (8 * c) * 33 + n;
        v4u o; o.x = pk2(s[0 * 33], s[1 * 33]); o.y = pk2(s[2 * 33], s[3 * 33]); o.z = pk2(s[4 * 33], s[5 * 33]); o.w = pk2(s[6 * 33], s[7 * 33]);
        *(v4u*)(dst + (long)n * ldd + 8 * c) = o; }
    LDS_WAIT(); asm volatile("" ::: "memory");
}
__device__ __forceinline__ void tr_item64(const float* W, long ldw, int nvalid, bf16* dst, long ldd, LAS float* scr, int lane) {
    const int nn = (lane & 15) * 4;
#pragma unroll
    for (int i = 0; i < 16; ++i) { const int kk = 4 * i + (lane >> 4);
        f32x4 v = {0.f, 0.f, 0.f, 0.f}; if (nn < nvalid) v = *(const f32x4*)(W + (long)kk * ldw + nn);
        LAS float* s = scr + kk * 65 + nn; s[0] = v.x; s[1] = v.y; s[2] = v.z; s[3] = v.w; }
    LDS_WAIT(); asm volatile("" ::: "memory");
    const int c = lane & 7;
#pragma unroll
    for (int j = 0; j < 8; ++j) { const int n = (lane >> 3) + 8 * j; const LAS float* s = scr + (8 * c) * 65 + n;
        v4u o; o.x = pk2(s[0 * 65], s[1 * 65]); o.y = pk2(s[2 * 65], s[3 * 65]); o.z = pk2(s[4 * 65], s[5 * 65]); o.w = pk2(s[6 * 65], s[7 * 65]);
        *(v4u*)(dst + (long)n * ldd + 8 * c) = o; }
    LDS_WAIT(); asm volatile("" ::: "memory");
}
__device__ __forceinline__ void tr_matrix(const float* W, int K, int N, int NP, bf16* WT, LAS float* scr, int gw, int NGW, int lane) {
    const int nblk = NP / 64, nitems = (K / 64) * nblk;
    for (int it = gw; it < nitems; it += NGW) { const int kb = it / nblk, nb = it % nblk, k0 = 64 * kb, n0 = 64 * nb; int nvalid = N - n0; nvalid = nvalid < 0 ? 0 : (nvalid > 64 ? 64 : nvalid);
        tr_item64(W + (long)k0 * N + n0, N, nvalid, WT + (long)n0 * K + k0, K, scr, lane); }
}
__device__ __forceinline__ void tr_matrix_item(const float* W, int K, int N, int NP, bf16* WT, LAS float* scr, int it, int lane) {
    const int nblk = NP / 64, kb = it / nblk, nb = it % nblk, k0 = 64 * kb, n0 = 64 * nb; int nvalid = N - n0; nvalid = nvalid < 0 ? 0 : (nvalid > 64 ? 64 : nvalid);
    tr_item64(W + (long)k0 * N + n0, N, nvalid, WT + (long)n0 * K + k0, K, scr, lane);
}
__device__ __forceinline__ void cvt_rows(const float* src, bf16* dst, long n, long gtid, long gsz) {
    long i = gtid * 8;
    for (; i + 3 * gsz * 8 < n; i += 4 * gsz * 8) {
        f32x4 a[4], b[4];
#pragma unroll
        for (int u = 0; u < 4; ++u) { a[u] = *(const f32x4*)(src + i + u * gsz * 8); b[u] = *(const f32x4*)(src + i + u * gsz * 8 + 4); }
#pragma unroll
        for (int u = 0; u < 4; ++u) { v4u o; o.x = pk2(a[u].x, a[u].y); o.y = pk2(a[u].z, a[u].w); o.z = pk2(b[u].x, b[u].y); o.w = pk2(b[u].z, b[u].w); *(v4u*)(dst + i + u * gsz * 8) = o; } }
    for (; i < n; i += gsz * 8) { const f32x4 a = *(const f32x4*)(src + i), b = *(const f32x4*)(src + i + 4);
        v4u o; o.x = pk2(a.x, a.y); o.y = pk2(a.z, a.w); o.z = pk2(b.x, b.y); o.w = pk2(b.z, b.w); *(v4u*)(dst + i) = o; }
}
__device__ __forceinline__ int sopaque(int v) { asm volatile("" : "+s"(v)); return v; }
__device__ __forceinline__ float wave_sum(float v) {
#define WS_STEP(o) v += __builtin_bit_cast(float, __builtin_amdgcn_ds_swizzle(__builtin_bit_cast(int, v), 0x1f | ((o) << 10)))
    WS_STEP(1); WS_STEP(2); WS_STEP(4); WS_STEP(8); WS_STEP(16);
#undef WS_STEP
    return __builtin_bit_cast(float, __builtin_amdgcn_readlane(__builtin_bit_cast(int, v), 0)) + __builtin_bit_cast(float, __builtin_amdgcn_readlane(__builtin_bit_cast(int, v), 32));
}
#ifndef DBG_SCALE
#define DBG_SCALE 20.0f
#endif
constexpr int MOE_MAXBLK = 640;
constexpr int CW_CNT = 8192, CW_CUR = 8192 + 128;
namespace pg8 {
struct MoeOrder {
    const int* blk_e; int nblk, npn, G, c;
    __device__ __forceinline__ bool next(int i, Unit& u) const {
        const long L = (long)i * G + c; if (L >= (long)nblk * npn) return false;
        const int blk = (int)(L / npn); u.pm = blk; u.pn = (int)(L % npn); u.e = __builtin_amdgcn_readfirstlane(blk_e[blk]); u.aux = 0; return true;
    }
};
__device__ __forceinline__ float silu_f(float x) { return x * __builtin_amdgcn_rcpf(1.0f + __expf(-x)); }
struct EpiSwiGLU {
    static constexpr int NPRE = 0; __device__ __forceinline__ void load_pre(const Unit&, int, int, int (&)[1]) const {}
    static constexpr bool PERM = true;
    bf16_t* H;
    __device__ __forceinline__ void operator()(const f32x4 (&acc)[2][2][4][2], const Unit& u, int wr, int wc, int fr, int fq) const {
        const int row0 = u.pm * BM + wr * 64 + fr, col0 = u.pn * 128 + wc * 32 + 8 * fq;
#pragma unroll
        for (int ai = 0; ai < 2; ++ai)
#pragma unroll
            for (int m = 0; m < 4; ++m) { bf16_t* rowp = H + (size_t)(row0 + ai * HALF + m * 16) * 256 + col0;
                const f32x4 g0 = acc[ai][0][m][0], g1 = acc[ai][0][m][1], u0 = acc[ai][1][m][0], u1 = acc[ai][1][m][1];
                u32x4 w; w.x = cvt_pk_bf16(silu_f(g0[0]) * u0[0], silu_f(g0[1]) * u0[1]); w.y = cvt_pk_bf16(silu_f(g0[2]) * u0[2], silu_f(g0[3]) * u0[3]);
                w.z = cvt_pk_bf16(silu_f(g1[0]) * u1[0], silu_f(g1[1]) * u1[1]); w.w = cvt_pk_bf16(silu_f(g1[2]) * u1[2], silu_f(g1[3]) * u1[3]);
                *(u32x4*)rowp = w; }
    }
};
struct EpiDown {
    static constexpr bool PERM = true; static constexpr int NPRE = 1;
    bf16_t* rows8; bf16_t* rows_sh; const int* dest; int nslot8;
    __device__ __forceinline__ void prefetch(const Unit& u, int slot, PG8_LAS unsigned char* lds, int wid, int lane) const {
        if (wid < 4) __builtin_amdgcn_global_load_lds((const unsigned*)(dest + u.pm * BM + wid * 64 + lane), (PG8_LAS unsigned*)(lds + STAGE_BYTES + slot * 1024 + wid * 256), 4, 0, 0);
    }
    __device__ __forceinline__ void operator()(const f32x4 (&acc)[2][2][4][2], const Unit& u, int wr, int wc, int fr, int fq, int slot, PG8_LAS unsigned char* lds) const {
        const int col0 = u.pn * BM + wc * 32 + 8 * fq; const PG8_LAS int* dl = (const PG8_LAS int*)(lds + STAGE_BYTES + slot * 1024) + wr * 64 + fr;
#pragma unroll
        for (int ai = 0; ai < 2; ++ai)
#pragma unroll
            for (int m = 0; m < 4; ++m) { const int d = dl[ai * HALF + m * 16];
                if (d >= 0) { bf16_t* rowp = (d < nslot8 ? rows8 + (size_t)d * 1024 : rows_sh + (size_t)(d - nslot8) * 1024) + col0;
#pragma unroll
                    for (int bj = 0; bj < 2; ++bj) { const f32x4 v0 = acc[ai][bj][m][0], v1 = acc[ai][bj][m][1];
                        u32x4 o; o.x = cvt_pk_bf16(v0[0], v0[1]); o.y = cvt_pk_bf16(v0[2], v0[3]); o.z = cvt_pk_bf16(v1[0], v1[1]); o.w = cvt_pk_bf16(v1[2], v1[3]);
#if defined(NT_STORES)
                        __builtin_nontemporal_store(o, (u32x4*)(rowp + bj * HALF));
#else
                        *(u32x4*)(rowp + bj * HALF) = o;
#endif
                        } } }
    }
};
}
__device__ __forceinline__ void moe_convert_weights(const float* wg, const float* wu, const float* wd, const float* sg, const float* su, const float* sd,
                                                    bf16* WGU, bf16* WD, LAS float* scr, int first, int last, int stride, int lane) {
    for (int it = first; it < last; it += stride) {
        const int e = it / 192, r = it % 192, kind = r >> 6, q = r & 63;
        if (kind < 2) { const float* W = (e < 64 ? (kind == 0 ? wg : wu) + (size_t)e * 262144 : (kind == 0 ? sg : su));
            const int kb = q >> 2, nb = q & 3, k0 = 64 * kb, n0 = 64 * nb;
            tr_item64(W + (size_t)k0 * 256 + n0, 256, 64, WGU + ((size_t)e * 512 + (n0 >> 7) * 256 + (n0 & 127) + kind * 128) * 1024 + k0, 1024, scr, lane);
        } else { const float* W = e < 64 ? wd + (size_t)e * 262144 : sd;
            const int kb = q >> 4, nb = q & 15, k0 = 64 * kb, n0 = 64 * nb;
            tr_item64(W + (size_t)k0 * 1024 + n0, 1024, 64, WD + ((size_t)e * 1024 + n0) * 256 + k0, 256, scr, lane); }
    }
}
struct MoeLists { int* tok; int* dest; float* w; int* blk_e; };
__device__ __forceinline__ void moe_count(const int* ridx, unsigned* cnt, LAS unsigned* hist, int tid, int bid, int G) {
    if (tid < 64) hist[tid] = 0u;
    __syncthreads();
    for (int i = bid * NTHREADS + tid; i < T_ * 8; i += G * NTHREADS) atomicAdd((unsigned*)&hist[ridx[i]], 1u);
    __syncthreads();
    if (tid < 64 && hist[tid]) atomicAdd(&cnt[tid], hist[tid]);
    __syncthreads();
}
__device__ __forceinline__ void moe_build_lists(const int* ridx, const float* rwt, const unsigned* cnt, unsigned* cur, const MoeLists L, LAS int* sm, int tid, int bid, int G) {
    LAS int* pstart = sm; LAS unsigned* hist = (LAS unsigned*)(sm + 80); LAS unsigned* base = (LAS unsigned*)(sm + 160);
    if (tid == 0) { int acc = 0;
#pragma unroll 1
        for (int e = 0; e < 64; ++e) { pstart[e] = acc; acc += ((int)__hip_atomic_load(&cnt[e], __ATOMIC_RELAXED, __HIP_MEMORY_SCOPE_AGENT) + 255) & ~255; } pstart[64] = acc; pstart[65] = acc + T_; }
    __syncthreads();
    const int per = (T_ * 8 + G - 1) / G;
    const int lo = bid * per, hi = (lo + per < T_ * 8) ? lo + per : T_ * 8;
    for (int c0 = lo; c0 < hi; c0 += NTHREADS) {
        if (tid < 64) hist[tid] = 0u;
        __syncthreads();
        const int i = c0 + tid; int e = 0; unsigned local = 0u;
        if (i < hi) { e = ridx[i]; local = atomicAdd((unsigned*)&hist[e], 1u); }
        __syncthreads();
        if (tid < 64) base[tid] = hist[tid] ? atomicAdd(&cur[tid], hist[tid]) : 0u;
        __syncthreads();
        if (i < hi) { const int pos = pstart[e] + (int)base[e] + (int)local; L.tok[pos] = i >> 3; L.dest[pos] = i; L.w[pos] = rwt[i]; }
        __syncthreads();
    }
    for (int e = bid; e < 64; e += G) { const int c = (int)__hip_atomic_load(&cnt[e], __ATOMIC_RELAXED, __HIP_MEMORY_SCOPE_AGENT);
        for (int p = pstart[e] + c + tid; p < pstart[e + 1]; p += NTHREADS) { L.tok[p] = 0; L.dest[p] = -1; L.w[p] = 0.f; } }
    for (int t = bid * NTHREADS + tid; t < T_; t += G * NTHREADS) { const int p = pstart[64] + t; L.tok[p] = t; L.dest[p] = T_ * 8 + t; L.w[p] = 1.f; }
    const int nblk = pstart[65] >> 8;
    for (int b = bid * NTHREADS + tid; b < nblk; b += G * NTHREADS) { int e = 0;
#pragma unroll 1
        while (e < 64 && (pstart[e + 1] >> 8) <= b) ++e;
        L.blk_e[b] = e; }
    if (bid == 0 && tid == 0) L.blk_e[MOE_MAXBLK] = nblk;
    __syncthreads();
}
__device__ __forceinline__ void moe_combine_ln(float* h, const bf16* rows8, const bf16* rows_sh, const float* rwt, const float* lw, const float* lb, bf16* hbf, int gw, int NGW, int lane) {
    int t = gw; if (t >= T_) return;
    v4u rr[2][9]; f32x4 hh[4]; float wk[8];
#define CB_LOAD(tt) do { const size_t _t = (size_t)(tt); \
        _Pragma("unroll") for (int half = 0; half < 2; ++half) { const int c0 = half * 512 + lane * 8; \
            hh[half * 2] = *(const f32x4*)(h + _t * 1024 + c0); hh[half * 2 + 1] = *(const f32x4*)(h + _t * 1024 + c0 + 4); \
            _Pragma("unroll") for (int k = 0; k < 9; ++k) rr[half][k] = *(const v4u*)((k < 8 ? rows8 + (_t * 8 + k) * 1024 : rows_sh + _t * 1024) + c0); } \
        _Pragma("unroll") for (int k = 0; k < 8; ++k) wk[k] = rwt[_t * 8 + k]; } while (0)
    CB_LOAD(t);
    for (; t < T_; t += NGW) {
        float v[16];
#pragma unroll
        for (int half = 0; half < 2; ++half) { const f32x4 a = hh[half * 2], b = hh[half * 2 + 1];
            float s[8] = {a.x * nv::ALPHA, a.y * nv::ALPHA, a.z * nv::ALPHA, a.w * nv::ALPHA, b.x * nv::ALPHA, b.y * nv::ALPHA, b.z * nv::ALPHA, b.w * nv::ALPHA};
#pragma unroll
            for (int k = 0; k < 9; ++k) { const v4u r = rr[half][k]; const float w = k < 8 ? wk[k] : 1.0f;
                s[0] += w * __builtin_bit_cast(float, r.x << 16); s[1] += w * __builtin_bit_cast(float, r.x & 0xffff0000u);
                s[2] += w * __builtin_bit_cast(float, r.y << 16); s[3] += w * __builtin_bit_cast(float, r.y & 0xffff0000u);
                s[4] += w * __builtin_bit_cast(float, r.z << 16); s[5] += w * __builtin_bit_cast(float, r.z & 0xffff0000u);
                s[6] += w * __builtin_bit_cast(float, r.w << 16); s[7] += w * __builtin_bit_cast(float, r.w & 0xffff0000u); }
#pragma unroll
            for (int j = 0; j < 8; ++j) v[half * 8 + j] = s[j]; }
        if (t + NGW < T_) CB_LOAD(t + NGW);
        float sum = 0.f;
#pragma unroll
        for (int j = 0; j < 16; ++j) sum += v[j];
        sum = wave_sum(sum);
        const float mean = sum * (1.f / 1024.f);
        float sq = 0.f;
#pragma unroll
        for (int j = 0; j < 16; ++j) { v[j] -= mean; sq += v[j] * v[j]; }
        sq = wave_sum(sq);
        const float rstd = 1.0f / sqrtf(sq * (1.f / 1024.f) + nv::EPS);
#pragma unroll
        for (int half = 0; half < 2; ++half) { const int c0 = half * 512 + lane * 8;
            const f32x4 w0 = *(const f32x4*)(lw + c0), w1 = *(const f32x4*)(lw + c0 + 4), b0 = *(const f32x4*)(lb + c0), b1 = *(const f32x4*)(lb + c0 + 4);
            f32x4 o0, o1;
            o0.x = v[half * 8 + 0] * rstd * w0.x + b0.x; o0.y = v[half * 8 + 1] * rstd * w0.y + b0.y; o0.z = v[half * 8 + 2] * rstd * w0.z + b0.z; o0.w = v[half * 8 + 3] * rstd * w0.w + b0.w;
            o1.x = v[half * 8 + 4] * rstd * w1.x + b1.x; o1.y = v[half * 8 + 5] * rstd * w1.y + b1.y; o1.z = v[half * 8 + 6] * rstd * w1.z + b1.z; o1.w = v[half * 8 + 7] * rstd * w1.w + b1.w;
            *(f32x4*)(h + (size_t)t * 1024 + c0) = o0; *(f32x4*)(h + (size_t)t * 1024 + c0 + 4) = o1;
            if (hbf) { v4u p; p.x = pk2(o0.x, o0.y); p.y = pk2(o0.z, o0.w); p.z = pk2(o1.x, o1.y); p.w = pk2(o1.z, o1.w); *(v4u*)(hbf + (size_t)t * 1024 + c0) = p; } }
    }
#undef CB_LOAD
}
typedef float f32x16 __attribute__((ext_vector_type(16)));
typedef short s16x8 __attribute__((ext_vector_type(8)));
typedef LAS unsigned short lbf16;
__device__ __forceinline__ void mm32(f32x16& acc, const lbf16* A, int lda, const lbf16* B, int ldb, int K, int lane) {
    const lbf16* ap = A + (lane & 31) * lda + 8 * (lane >> 5);
    const lbf16* bp = B + (lane & 31) * ldb + 8 * (lane >> 5);
#pragma unroll 4
    for (int k = 0; k < K; k += 16) {
        const s16x8 a = *(const LAS s16x8*)(ap + k), b = *(const LAS s16x8*)(bp + k);
        acc = __builtin_amdgcn_mfma_f32_32x32x16_bf16(a, b, acc, 0, 0, 0);
    }
}
__device__ __forceinline__ void mm32_gb(f32x16& acc, const lbf16* A, int lda, const bf16* B, int ldb, int K, int lane) {
    const lbf16* ap = A + (lane & 31) * lda + 8 * (lane >> 5);
    const bf16* bp = B + (size_t)(lane & 31) * ldb + 8 * (lane >> 5);
#pragma unroll 4
    for (int k = 0; k < K; k += 16) {
        const s16x8 a = *(const LAS s16x8*)(ap + k), b = *(const s16x8*)(bp + k);
        acc = __builtin_amdgcn_mfma_f32_32x32x16_bf16(a, b, acc, 0, 0, 0);
    }
}
__device__ __forceinline__ int rowmap(int r, int lane) { return (r & 3) + 8 * (r >> 2) + 4 * (lane >> 5); }
__device__ __forceinline__ float rcp_f(float x) { return __builtin_amdgcn_rcpf(x); }
__device__ __forceinline__ float sigm_f(float x) { return rcp_f(1.0f + __expf(-x)); }
__device__ __forceinline__ float logsig_f(float x) { return fminf(x, 0.f) - __logf(1.0f + __expf(-fabsf(x))); }
__device__ __forceinline__ float softplus_f(float x) { return fmaxf(x, 0.f) + __logf(1.0f + __expf(-fabsf(x))); }
__device__ __forceinline__ float gelu_f(float x) { const float u = 0.7978845608028654f * (x + 0.044715f * x * x * x); return x * rcp_f(1.0f + __expf(-2.0f * u)); }
__device__ __forceinline__ void unpack8(const v4u r, float (&f)[8]) {
    f[0] = __builtin_bit_cast(float, r.x << 16); f[1] = __builtin_bit_cast(float, r.x & 0xffff0000u); f[2] = __builtin_bit_cast(float, r.y << 16); f[3] = __builtin_bit_cast(float, r.y & 0xffff0000u);
    f[4] = __builtin_bit_cast(float, r.z << 16); f[5] = __builtin_bit_cast(float, r.z & 0xffff0000u); f[6] = __builtin_bit_cast(float, r.w << 16); f[7] = __builtin_bit_cast(float, r.w & 0xffff0000u);
}
__device__ __forceinline__ v4u pack8(const float (&f)[8]) { v4u o; o.x = pk2(f[0], f[1]); o.y = pk2(f[2], f[3]); o.z = pk2(f[4], f[5]); o.w = pk2(f[6], f[7]); return o; }

struct Mix0Bufs { const bf16* proj; bf16* ct; float* nloc; float* blast; float* mloc; float* mprev; float* hloc; float* pc; float* carA; float* carU; float* carI; bf16* mixbf; const bf16* lruw; };
constexpr int PJ0 = EINP;

__device__ __forceinline__ void mlstm_a_item(const Mix0Bufs& B, const float* gate_b, int cn, LAS unsigned char* lds, int tid) {
    const int lane = tid & 63, wave = __builtin_amdgcn_readfirstlane(tid >> 6);
    const int bh = cn / NCH, n = cn % NCH, b = bh >> 2, h = bh & 3;
    const size_t t0 = (size_t)b * S_ + n * 64;
    LAS float* lf = (LAS float*)lds; LAS float* wl = lf + 64; LAS float* pw = lf + 128; LAS float* misc = lf + 192;
    lbf16* kT = (lbf16*)(lds + 1024); lbf16* vT = (lbf16*)(lds + 1024 + 128 * 72 * 2);
    if (tid < 64) { const bf16* pr = B.proj + (t0 + tid) * PJ0;
        lf[tid] = logsig_f(bf2f(pr[2052 + h]) + gate_b[4 + h]); pw[tid] = bf2f(pr[2048 + h]) + gate_b[h]; }
    __syncthreads();
    if (tid < 64) { float acc = 0.f; for (int j = 0; j < 64; ++j) { const float x = lf[j]; acc += (j <= tid) ? x : 0.f; } wl[tid] = pw[tid] - acc; if (tid == 63) misc[0] = acc; }
    __syncthreads();
    float mx = -INFINITY;
    for (int j = 0; j < 64; ++j) mx = fmaxf(mx, wl[j]);
    const float blast = misc[0];
    __syncthreads();
    if (tid < 64) pw[tid] = __expf(wl[tid] - mx) * 0.08838834764831845f;
    __syncthreads();
#pragma unroll
    for (int it = 0; it < 2; ++it) { const int vi = tid + it * 512, l = vi & 63, g = vi >> 6;
        const bf16* pr = B.proj + (t0 + l) * PJ0 + h * 128 + g * 8;
        float kf[8], vf[8]; unpack8(*(const v4u*)(pr + 512), kf); unpack8(*(const v4u*)(pr + 1024), vf);
        const float p = pw[l];
#pragma unroll
        for (int j = 0; j < 8; ++j) { kT[(g * 8 + j) * 72 + l] = (unsigned short)f2bf(kf[j] * p); vT[(g * 8 + j) * 72 + l] = (unsigned short)f2bf(vf[j]); } }
    __syncthreads();
    const int et = wave >> 1;
#pragma unroll
    for (int q = 0; q < 2; ++q) { const int dt = (wave & 1) * 2 + q;
        f32x16 acc = {0.f, 0.f, 0.f, 0.f, 0.f, 0.f, 0.f, 0.f, 0.f, 0.f, 0.f, 0.f, 0.f, 0.f, 0.f, 0.f};
        mm32(acc, vT + et * 32 * 72, 72, kT + dt * 32 * 72, 72, 64, lane);
        bf16* out = B.ct + (size_t)cn * 16384 + dt * 32 + (lane & 31);
#pragma unroll
        for (int r = 0; r < 16; ++r) out[(size_t)(et * 32 + rowmap(r, lane)) * 128] = (unsigned short)f2bf(acc[r]); }
    if (tid < 128) { float s = 0.f; for (int l = 0; l < 64; ++l) s += bf2f(kT[tid * 72 + l]); B.nloc[(size_t)cn * 128 + tid] = s; }
    if (tid == 0) { B.blast[cn] = blast; B.mloc[cn] = blast + mx; }
    __syncthreads();
}
__device__ __forceinline__ void mlstm_b(const Mix0Bufs& B, int gtid, int gsz) {
    for (int idx = gtid; idx < 8 * 8192 + 8 * 128; idx += gsz) {
        const bool isn = idx >= 8 * 8192;
        if (!isn) { const int bh = idx >> 13, pe = idx & 8191;
            float s0 = 0.f, s1 = 0.f, m = 0.f; unsigned* p = (unsigned*)B.ct + (size_t)bh * NCH * 8192 + pe;
            for (int n0 = 0; n0 < NCH; n0 += 16) { unsigned cl[16]; float bl[16], ml[16];
#pragma unroll
                for (int j = 0; j < 16; ++j) { cl[j] = p[(size_t)(n0 + j) * 8192]; bl[j] = B.blast[bh * NCH + n0 + j]; ml[j] = B.mloc[bh * NCH + n0 + j]; }
#pragma unroll
                for (int j = 0; j < 16; ++j) { const unsigned out = pk2(s0, s1); const float mn = fmaxf(bl[j] + m, ml[j]), kf = __expf(bl[j] + m - mn), af = __expf(ml[j] - mn);
                    s0 = kf * s0 + af * __builtin_bit_cast(float, cl[j] << 16); s1 = kf * s1 + af * __builtin_bit_cast(float, cl[j] & 0xffff0000u);
                    if (pe == 0) B.mprev[bh * NCH + n0 + j] = m;
                    m = mn; cl[j] = out; }
#pragma unroll
                for (int j = 0; j < 16; ++j) p[(size_t)(n0 + j) * 8192] = cl[j]; }
        } else { const int r = idx - 8 * 8192, bh = r >> 7, de = r & 127;
            float st = 0.f, m = 0.f; float* p = B.nloc + (size_t)bh * NCH * 128 + de;
            for (int n0 = 0; n0 < NCH; n0 += 16) { float cl[16], bl[16], ml[16];
#pragma unroll
                for (int j = 0; j < 16; ++j) { cl[j] = p[(size_t)(n0 + j) * 128]; bl[j] = B.blast[bh * NCH + n0 + j]; ml[j] = B.mloc[bh * NCH + n0 + j]; }
#pragma unroll
                for (int j = 0; j < 16; ++j) { const float out = st; const float mn = fmaxf(bl[j] + m, ml[j]);
                    st = __expf(bl[j] + m - mn) * st + __expf(ml[j] - mn) * cl[j]; m = mn; cl[j] = out; }
#pragma unroll
                for (int j = 0; j < 16; ++j) p[(size_t)(n0 + j) * 128] = cl[j]; } }
    }
}
__device__ __forceinline__ void mlstm_c_item(const Mix0Bufs& B, const float* gate_b, const float* norm_w, int cn, LAS unsigned char* lds, int tid) {
    const int lane = tid & 63, wave = __builtin_amdgcn_readfirstlane(tid >> 6);
    const int bh = cn / NCH, n = cn % NCH, b = bh >> 2, h = bh & 3;
    const size_t t0 = (size_t)b * S_ + n * 64;
    LAS float* bc = (LAS float*)lds; LAS float* wl = bc + 64; LAS float* mi = bc + 128; LAS float* win = bc + 192; LAS float* den = bc + 256; LAS float* emi = bc + 320; LAS float* lf = bc + 384; LAS float* ig = bc + 448;
    lbf16* qs = (lbf16*)(lds + 2048); lbf16* ks = (lbf16*)(lds + 19456); lbf16* qw = (lbf16*)(lds + 36864);
    lbf16* vT = (lbf16*)(lds + 54272); lbf16* cT = (lbf16*)(lds + 77312); lbf16* sm = (lbf16*)(lds + 120832);
    LAS float* hb = (LAS float*)(lds + 2048);
    const float mprev = B.mprev[cn];
    v4u gq[2], gk[2], gv[2], go[2], gc[4];
#pragma unroll
    for (int it = 0; it < 2; ++it) { const int vi = tid + it * 512; { const int l = vi >> 4, g = vi & 15; const bf16* pr = B.proj + (t0 + l) * PJ0 + h * 128 + g * 8; gq[it] = *(const v4u*)pr; gk[it] = *(const v4u*)(pr + 512); }
        { const int l = vi & 63, g = vi >> 6; gv[it] = *(const v4u*)(B.proj + (t0 + l) * PJ0 + 1024 + h * 128 + g * 8); } }
    { const bf16* cg = B.ct + (size_t)cn * 16384;
#pragma unroll
      for (int it = 0; it < 4; ++it) { const int vi = tid + it * 512, e = vi >> 4, g = vi & 15; gc[it] = *(const v4u*)(cg + e * 128 + g * 8); } }
    { const int i = tid >> 3, sub = tid & 7; const bf16* op = B.proj + (t0 + i) * PJ0 + 1536 + h * 128 + sub * 16; go[0] = *(const v4u*)op; go[1] = *(const v4u*)(op + 8); }
    const float gnl = tid < 128 ? B.nloc[(size_t)cn * 128 + tid] : 0.f;
    if (tid < 64) { const bf16* pr = B.proj + (t0 + tid) * PJ0;
        lf[tid] = logsig_f(bf2f(pr[2052 + h]) + gate_b[4 + h]); ig[tid] = bf2f(pr[2048 + h]) + gate_b[h]; }
    __syncthreads();
    if (tid < 64) { float acc = 0.f; for (int j = 0; j < 64; ++j) { const float x = lf[j]; acc += (j <= tid) ? x : 0.f; } bc[tid] = acc; wl[tid] = ig[tid] - acc; }
    __syncthreads();
    if (tid < 64) { float pm = -INFINITY; for (int j = 0; j < 64; ++j) { const float x = wl[j]; pm = (j <= tid) ? fmaxf(pm, x) : pm; }
        const float bi = bc[tid], m = bi + fmaxf(mprev, pm); mi[tid] = m; win[tid] = __expf(bi + mprev - m); emi[tid] = __expf(-m); }
    __syncthreads();
#pragma unroll
    for (int it = 0; it < 2; ++it) { const int vi = tid + it * 512, l = vi >> 4, g = vi & 15;
        float qf[8], kf[8]; unpack8(gq[it], qf); unpack8(gk[it], kf);
        const float w = win[l]; float qwf[8];
#pragma unroll
        for (int j = 0; j < 8; ++j) { kf[j] *= 0.08838834764831845f; qwf[j] = qf[j] * w; }
        *(LAS v4u*)(qs + l * 136 + g * 8) = gq[it]; *(LAS v4u*)(ks + l * 136 + g * 8) = pack8(kf); *(LAS v4u*)(qw + l * 136 + g * 8) = pack8(qwf); }
#pragma unroll
    for (int it = 0; it < 2; ++it) { const int vi = tid + it * 512, l = vi & 63, g = vi >> 6;
        float vf[8]; unpack8(gv[it], vf);
#pragma unroll
        for (int j = 0; j < 8; ++j) vT[(g * 8 + j) * 72 + l] = (unsigned short)f2bf(vf[j]); }
    for (int i = tid; i < 32 * 72; i += 512) { const int r = i / 72, c = i % 72; vT[(128 + r) * 72 + c] = (r == 0 && c < 64) ? (unsigned short)0x3f80 : (unsigned short)0; }
#pragma unroll
    for (int it = 0; it < 4; ++it) { const int vi = tid + it * 512, e = vi >> 4, g = vi & 15; *(LAS v4u*)(cT + e * 136 + g * 8) = gc[it]; }
    for (int i = tid; i < 32 * 136; i += 512) { const int r = i / 136, c = i % 136; if (r > 0 || c >= 128) cT[(128 + r) * 136 + c] = (unsigned short)0; }
    if (tid < 128) cT[128 * 136 + tid] = (unsigned short)f2bf(gnl);
    __syncthreads();
    if (wave < 4) { const int it = wave >> 1, jt = wave & 1;
        f32x16 acc = {0.f, 0.f, 0.f, 0.f, 0.f, 0.f, 0.f, 0.f, 0.f, 0.f, 0.f, 0.f, 0.f, 0.f, 0.f, 0.f};
        if (jt <= it) mm32(acc, qs + it * 32 * 136, 136, ks + jt * 32 * 136, 136, 128, lane);
        const int j = jt * 32 + (lane & 31); const float wj = wl[j];
#pragma unroll
        for (int r = 0; r < 16; ++r) { const int i = it * 32 + rowmap(r, lane);
            const float v = (j <= i) ? acc[r] * __expf(bc[i] - mi[i] + wj) : 0.f; sm[i * 72 + j] = (unsigned short)f2bf(v); } }
    __syncthreads();
    f32x16 accA = {0.f, 0.f, 0.f, 0.f, 0.f, 0.f, 0.f, 0.f, 0.f, 0.f, 0.f, 0.f, 0.f, 0.f, 0.f, 0.f}, accB = accA;
    { const int id = wave, it = id / 5, nt = id % 5;
      mm32(accA, sm + it * 32 * 72, 72, vT + nt * 32 * 72, 72, 64, lane); mm32(accA, qw + it * 32 * 136, 136, cT + nt * 32 * 136, 136, 128, lane);
      if (nt == 4 && (lane & 31) == 0) {
#pragma unroll
          for (int r = 0; r < 16; ++r) den[it * 32 + rowmap(r, lane)] = accA[r]; } }
    if (wave < 2) { const int id = wave + 8, it = id / 5, nt = id % 5;
      mm32(accB, sm + it * 32 * 72, 72, vT + nt * 32 * 72, 72, 64, lane); mm32(accB, qw + it * 32 * 136, 136, cT + nt * 32 * 136, 136, 128, lane);
      if (nt == 4 && (lane & 31) == 0) {
#pragma unroll
          for (int r = 0; r < 16; ++r) den[it * 32 + rowmap(r, lane)] = accB[r]; } }
    __syncthreads();
    { const int id = wave, it = id / 5, nt = id % 5;
      if (nt < 4) {
#pragma unroll
          for (int r = 0; r < 16; ++r) { const int i = it * 32 + rowmap(r, lane); hb[i * 132 + nt * 32 + (lane & 31)] = accA[r] * rcp_f(fmaxf(fabsf(den[i]), emi[i])); } } }
    if (wave < 2) { const int id = wave + 8, it = id / 5, nt = id % 5;
      if (nt < 4) {
#pragma unroll
          for (int r = 0; r < 16; ++r) { const int i = it * 32 + rowmap(r, lane); hb[i * 132 + nt * 32 + (lane & 31)] = accB[r] * rcp_f(fmaxf(fabsf(den[i]), emi[i])); } } }
    __syncthreads();
    { const int i = tid >> 3, sub = tid & 7; const LAS float* hr = hb + i * 132 + sub * 16;
      float x[16]; float s = 0.f;
#pragma unroll
      for (int j = 0; j < 16; ++j) { x[j] = hr[j]; s += x[j]; }
      s += __builtin_bit_cast(float, __builtin_amdgcn_ds_swizzle(__builtin_bit_cast(int, s), 0x1f | (1 << 10)));
      s += __builtin_bit_cast(float, __builtin_amdgcn_ds_swizzle(__builtin_bit_cast(int, s), 0x1f | (2 << 10)));
      s += __builtin_bit_cast(float, __builtin_amdgcn_ds_swizzle(__builtin_bit_cast(int, s), 0x1f | (4 << 10)));
      const float mean = s * (1.f / 128.f); float q = 0.f;
#pragma unroll
      for (int j = 0; j < 16; ++j) { x[j] -= mean; q += x[j] * x[j]; }
      q += __builtin_bit_cast(float, __builtin_amdgcn_ds_swizzle(__builtin_bit_cast(int, q), 0x1f | (1 << 10)));
      q += __builtin_bit_cast(float, __builtin_amdgcn_ds_swizzle(__builtin_bit_cast(int, q), 0x1f | (2 << 10)));
      q += __builtin_bit_cast(float, __builtin_amdgcn_ds_swizzle(__builtin_bit_cast(int, q), 0x1f | (4 << 10)));
      const float rstd = __builtin_amdgcn_rsqf(q * (1.f / 128.f) + nv::EPS);
      const float* nw = norm_w + h * 128 + sub * 16;
      float o0[8], o1[8]; unpack8(go[0], o0); unpack8(go[1], o1);
      float y0[8], y1[8];
#pragma unroll
      for (int j = 0; j < 8; ++j) { y0[j] = x[j] * rstd * nw[j] * sigm_f(o0[j]); y1[j] = x[8 + j] * rstd * nw[8 + j] * sigm_f(o1[j]); }
      bf16* dst = B.mixbf + (t0 + i) * 1024 + h * 128 + sub * 16;
      *(v4u*)dst = pack8(y0); *(v4u*)(dst + 8) = pack8(y1); }
    __syncthreads();
}
__device__ __forceinline__ void lru_a_item(const Mix0Bufs& B, const float* const* in, int ch, LAS unsigned char* lds, int tid) {
    const int lane = tid & 63, wave = __builtin_amdgcn_readfirstlane(tid >> 6);
    const size_t t0 = (size_t)ch * 64; const int s0 = (ch % NCH) * 64;
    lbf16* xc = (lbf16*)lds; LAS float* al = (LAS float*)(lds + 17408); LAS float* ul = (LAS float*)(lds + 17408 + 32768);
    const float* cw = in[9]; const float* cb = in[10]; const float* ba = in[12]; const float* bx = in[14]; const float* lam = in[15];
    for (int hh = 0; hh < 4; ++hh) {
#pragma unroll
        for (int it = 0; it < 2; ++it) { const int vi = tid + it * 512, l = vi >> 4, g = vi & 15, c0 = hh * 128 + g * 8;
            float acc[8];
#pragma unroll
            for (int j = 0; j < 8; ++j) acc[j] = cb[c0 + j];
#pragma unroll
            for (int tap = 0; tap < 4; ++tap) { const int ls = s0 + l - 3 + tap;
                if (ls >= 0) { float xf[8]; unpack8(*(const v4u*)(B.proj + (t0 + l - 3 + tap) * PJ0 + 2056 + c0), xf);
#pragma unroll
                    for (int j = 0; j < 8; ++j) acc[j] += cw[tap * 512 + c0 + j] * xf[j]; } }
            *(LAS v4u*)(xc + l * 136 + g * 8) = pack8(acc);
#pragma unroll
            for (int j = 0; j < 8; ++j) ul[l * 128 + g * 8 + j] = acc[j]; }
        __syncthreads();
        { const int it = wave & 1, nt = wave >> 1;
          f32x16 ra = {0.f, 0.f, 0.f, 0.f, 0.f, 0.f, 0.f, 0.f, 0.f, 0.f, 0.f, 0.f, 0.f, 0.f, 0.f, 0.f}, xa = ra;
          mm32_gb(ra, xc + it * 32 * 136, 136, B.lruw + (size_t)(hh * 128 + nt * 32) * 128, 128, 128, lane);
          mm32_gb(xa, xc + it * 32 * 136, 136, B.lruw + (size_t)(512 + hh * 128 + nt * 32) * 128, 128, 128, lane);
          const int c = nt * 32 + (lane & 31), cg = hh * 128 + c; const float bav = ba[cg], bxv = bx[cg], sp = softplus_f(-lam[cg]);
#pragma unroll
          for (int r = 0; r < 16; ++r) { const int l = it * 32 + rowmap(r, lane);
              const float rr = sigm_f(ra[r] + bav), ii = sigm_f(xa[r] + bxv), la = -8.0f * rr * sp;
              const float xv = ul[l * 128 + c];
              al[l * 128 + c] = __expf(la); ul[l * 128 + c] = __builtin_amdgcn_sqrtf(1.0f - __expf(2.0f * la)) * ii * xv; } }
        __syncthreads();
        if (tid < 128) { float hst = 0.f, P = 1.f; float* hp = B.hloc + t0 * 512 + hh * 128 + tid; float* pp = B.pc + t0 * 512 + hh * 128 + tid;
            for (int l = 0; l < 64; ++l) { const float a = al[l * 128 + tid]; hst = a * hst + ul[l * 128 + tid]; P *= a; hp[(size_t)l * 512] = hst; pp[(size_t)l * 512] = P; }
            B.carA[(size_t)ch * 512 + hh * 128 + tid] = P; B.carU[(size_t)ch * 512 + hh * 128 + tid] = hst; }
        __syncthreads();
    }
}
__device__ __forceinline__ void lru_b(const Mix0Bufs& B, int gtid, int gsz) {
    for (int idx = gtid; idx < 2 * 512; idx += gsz) { const int b = idx >> 9, c = idx & 511; float hst = 0.f;
        for (int n0 = 0; n0 < NCH; n0 += 16) { float a[16], u[16];
#pragma unroll
            for (int j = 0; j < 16; ++j) { const size_t o = (size_t)(b * NCH + n0 + j) * 512 + c; a[j] = B.carA[o]; u[j] = B.carU[o]; }
#pragma unroll
            for (int j = 0; j < 16; ++j) { const float in = hst; hst = a[j] * hst + u[j]; a[j] = in; }
#pragma unroll
            for (int j = 0; j < 16; ++j) B.carI[(size_t)(b * NCH + n0 + j) * 512 + c] = a[j]; } }
}
__device__ __forceinline__ void lru_c(const Mix0Bufs& B, int gtid, int gsz) {
    for (int idx = gtid; idx < T_ * 64; idx += gsz) { const size_t t = idx >> 6; const int c0 = (idx & 63) * 8; const size_t ch = t >> 6;
        float gb[8], y[8]; unpack8(*(const v4u*)(B.proj + t * PJ0 + 2568 + c0), gb);
        const float* hp = B.hloc + t * 512 + c0; const float* pp = B.pc + t * 512 + c0; const float* ci = B.carI + ch * 512 + c0;
#pragma unroll
        for (int j = 0; j < 8; ++j) y[j] = (hp[j] + pp[j] * ci[j]) * gelu_f(gb[j]);
        *(v4u*)(B.mixbf + t * 1024 + 512 + c0) = pack8(y); }
}
constexpr int PJ1 = OINP;
struct Mix1Bufs { const bf16* proj; bf16* ut; float* gbl; bf16* s5g; float* xend; float* xstart; float* s5ab; float* s5bb; bf16* cm; bf16* bbt; bf16* mixbf; };
__device__ __forceinline__ void gla_gates(const bf16* proj, const float* gw, const float* gb, size_t t0, int h, LAS float* bc, LAS float* gl, int tid) {
    if (tid < 128) { const int l = tid >> 1, hf = tid & 1; float f[8]; unpack8(*(const v4u*)(proj + (t0 + l) * PJ1 + 2048 + hf * 8), f);
#pragma unroll
        for (int j = 0; j < 8; ++j) gl[l * 16 + hf * 8 + j] = f[j]; }
    __syncthreads();
    { const int d = tid & 63, lg = tid >> 6; float w[16];
#pragma unroll
      for (int r = 0; r < 16; ++r) w[r] = gw[r * 256 + h * 64 + d];
      const float bias = gb[h * 64 + d];
#pragma unroll
      for (int q = 0; q < 8; ++q) { const int l = lg * 8 + q; float acc = bias;
#pragma unroll
          for (int r = 0; r < 16; ++r) acc += gl[l * 16 + r] * w[r];
          bc[l * 64 + d] = logsig_f(acc) * 0.0625f; } }
    __syncthreads();
    if (tid < 64) { float acc = 0.f; for (int l = 0; l < 64; ++l) { acc += bc[l * 64 + tid]; bc[l * 64 + tid] = acc; } }
    __syncthreads();
}
__device__ __forceinline__ void gla_a_item(const Mix1Bufs& B, const float* gw, const float* gb, int cn, LAS unsigned char* lds, int tid) {
    const int lane = tid & 63, wave = __builtin_amdgcn_readfirstlane(tid >> 6);
    const int bh = cn / NCH, n = cn % NCH, b = bh >> 2, h = bh & 3;
    const size_t t0 = (size_t)b * S_ + n * 64;
    LAS float* bc = (LAS float*)lds; LAS float* gl = (LAS float*)(lds + 16384);
    lbf16* kT = (lbf16*)(lds + 20480); lbf16* vT = (lbf16*)(lds + 20480 + 64 * 72 * 2);
    gla_gates(B.proj, gw, gb, t0, h, bc, gl, tid);
    { const int l = tid & 63, g = tid >> 6; float kf[8]; unpack8(*(const v4u*)(B.proj + (t0 + l) * PJ1 + 768 + h * 64 + g * 8), kf);
#pragma unroll
      for (int j = 0; j < 8; ++j) { const int d = g * 8 + j; kT[d * 72 + l] = (unsigned short)f2bf(kf[j] * __expf(bc[63 * 64 + d] - bc[l * 64 + d])); } }
#pragma unroll
    for (int it = 0; it < 2; ++it) { const int vi = tid + it * 512, l = vi & 63, g = vi >> 6; float vf[8]; unpack8(*(const v4u*)(B.proj + (t0 + l) * PJ1 + 1024 + h * 128 + g * 8), vf);
#pragma unroll
        for (int j = 0; j < 8; ++j) vT[(g * 8 + j) * 72 + l] = (unsigned short)f2bf(vf[j]); }
    __syncthreads();
    { const int et = wave >> 1, dt = wave & 1;
      f32x16 acc = {0.f, 0.f, 0.f, 0.f, 0.f, 0.f, 0.f, 0.f, 0.f, 0.f, 0.f, 0.f, 0.f, 0.f, 0.f, 0.f};
      mm32(acc, vT + et * 32 * 72, 72, kT + dt * 32 * 72, 72, 64, lane);
      bf16* out = B.ut + (size_t)cn * 8192 + dt * 32 + (lane & 31);
#pragma unroll
      for (int r = 0; r < 16; ++r) out[(size_t)(et * 32 + rowmap(r, lane)) * 64] = (unsigned short)f2bf(acc[r]); }
    if (tid < 64) B.gbl[(size_t)cn * 64 + tid] = bc[63 * 64 + tid];
    __syncthreads();
}
__device__ __forceinline__ void gla_b(const Mix1Bufs& B, int gtid, int gsz) {
    for (int idx = gtid; idx < 8 * 4096; idx += gsz) { const int bh = idx >> 12, pe = idx & 4095, d = (pe * 2) & 63; float s0 = 0.f, s1 = 0.f;
        unsigned* p = (unsigned*)B.ut + (size_t)bh * NCH * 4096 + pe; const float* gp = B.gbl + (size_t)bh * NCH * 64 + d;
        for (int n0 = 0; n0 < NCH; n0 += 16) { unsigned u[16]; float g0[16], g1[16];
#pragma unroll
            for (int j = 0; j < 16; ++j) { u[j] = p[(size_t)(n0 + j) * 4096]; g0[j] = gp[(n0 + j) * 64]; g1[j] = gp[(n0 + j) * 64 + 1]; }
#pragma unroll
            for (int j = 0; j < 16; ++j) { const unsigned out = pk2(s0, s1);
                s0 = __expf(g0[j]) * s0 + __builtin_bit_cast(float, u[j] << 16); s1 = __expf(g1[j]) * s1 + __builtin_bit_cast(float, u[j] & 0xffff0000u); u[j] = out; }
#pragma unroll
            for (int j = 0; j < 16; ++j) p[(size_t)(n0 + j) * 4096] = u[j]; } }
}
__device__ __forceinline__ void gla_c_item(const Mix1Bufs& B, const float* gw, const float* gb, const float* norm_w, int cn, LAS unsigned char* lds, int tid) {
    const int lane = tid & 63, wave = __builtin_amdgcn_readfirstlane(tid >> 6);
    const int bh = cn / NCH, n = cn % NCH, b = bh >> 2, h = bh & 3;
    const size_t t0 = (size_t)b * S_ + n * 64;
    LAS float* bc = (LAS float*)lds; LAS float* gl = (LAS float*)(lds + 16384);
    lbf16* qd = (lbf16*)(lds + 20480); lbf16* ki = (lbf16*)(lds + 29696); lbf16* vT = (lbf16*)(lds + 38912); lbf16* sT = (lbf16*)(lds + 57344); lbf16* att = (lbf16*)(lds + 75776);
    LAS float* ob = (LAS float*)(lds + 84992);
    gla_gates(B.proj, gw, gb, t0, h, bc, gl, tid);
    { const int l = tid >> 3, g = tid & 7; const bf16* pr = B.proj + (t0 + l) * PJ1 + h * 64 + g * 8; float qf[8], kf[8]; unpack8(*(const v4u*)(pr + 512), qf); unpack8(*(const v4u*)(pr + 768), kf);
#pragma unroll
      for (int j = 0; j < 8; ++j) { const float bb = bc[l * 64 + g * 8 + j]; qf[j] *= 0.125f * __expf(bb); kf[j] *= __expf(-bb); }
      *(LAS v4u*)(qd + l * 72 + g * 8) = pack8(qf); *(LAS v4u*)(ki + l * 72 + g * 8) = pack8(kf); }
#pragma unroll
    for (int it = 0; it < 2; ++it) { const int vi = tid + it * 512, l = vi & 63, g = vi >> 6; float vf[8]; unpack8(*(const v4u*)(B.proj + (t0 + l) * PJ1 + 1024 + h * 128 + g * 8), vf);
#pragma unroll
        for (int j = 0; j < 8; ++j) vT[(g * 8 + j) * 72 + l] = (unsigned short)f2bf(vf[j]); }
    { const bf16* sg = B.ut + (size_t)cn * 8192;
#pragma unroll
      for (int it = 0; it < 2; ++it) { const int vi = tid + it * 512, e = vi >> 3, g = vi & 7; *(LAS v4u*)(sT + e * 72 + g * 8) = *(const v4u*)(sg + e * 64 + g * 8); } }
    __syncthreads();
    if (wave < 4) { const int it = wave >> 1, jt = wave & 1;
        f32x16 acc = {0.f, 0.f, 0.f, 0.f, 0.f, 0.f, 0.f, 0.f, 0.f, 0.f, 0.f, 0.f, 0.f, 0.f, 0.f, 0.f};
        if (jt <= it) mm32(acc, qd + it * 32 * 72, 72, ki + jt * 32 * 72, 72, 64, lane);
        const int j = jt * 32 + (lane & 31);
#pragma unroll
        for (int r = 0; r < 16; ++r) { const int i = it * 32 + rowmap(r, lane); att[i * 72 + j] = (unsigned short)f2bf(j <= i ? acc[r] : 0.f); } }
    __syncthreads();
    { const int it = wave >> 2, nt = wave & 3;
      f32x16 acc = {0.f, 0.f, 0.f, 0.f, 0.f, 0.f, 0.f, 0.f, 0.f, 0.f, 0.f, 0.f, 0.f, 0.f, 0.f, 0.f};
      mm32(acc, att + it * 32 * 72, 72, vT + nt * 32 * 72, 72, 64, lane); mm32(acc, qd + it * 32 * 72, 72, sT + nt * 32 * 72, 72, 64, lane);
#pragma unroll
      for (int r = 0; r < 16; ++r) ob[(it * 32 + rowmap(r, lane)) * 132 + nt * 32 + (lane & 31)] = acc[r]; }
    __syncthreads();
    { const int i = tid >> 3, sub = tid & 7; const LAS float* hr = ob + i * 132 + sub * 16;
      float x[16]; float q = 0.f;
#pragma unroll
      for (int j = 0; j < 16; ++j) { x[j] = hr[j]; q += x[j] * x[j]; }
      q += __builtin_bit_cast(float, __builtin_amdgcn_ds_swizzle(__builtin_bit_cast(int, q), 0x1f | (1 << 10)));
      q += __builtin_bit_cast(float, __builtin_amdgcn_ds_swizzle(__builtin_bit_cast(int, q), 0x1f | (2 << 10)));
      q += __builtin_bit_cast(float, __builtin_amdgcn_ds_swizzle(__builtin_bit_cast(int, q), 0x1f | (4 << 10)));
      const float rstd = __builtin_amdgcn_rsqf(q * (1.f / 128.f) + nv::EPS);
      const bf16* rp = B.proj + (t0 + i) * PJ1 + 1536 + h * 128 + sub * 16; const float* nw = norm_w + h * 128 + sub * 16;
      float r0[8], r1[8]; unpack8(*(const v4u*)rp, r0); unpack8(*(const v4u*)(rp + 8), r1);
      float y0[8], y1[8];
#pragma unroll
      for (int j = 0; j < 8; ++j) { y0[j] = x[j] * rstd * nw[j] * r0[j] * sigm_f(r0[j]); y1[j] = x[8 + j] * rstd * nw[8 + j] * r1[j] * sigm_f(r1[j]); }
      bf16* dst = B.mixbf + (t0 + i) * 1024 + 512 + h * 128 + sub * 16;
      *(v4u*)dst = pack8(y0); *(v4u*)(dst + 8) = pack8(y1); }
    __syncthreads();
}
__device__ __forceinline__ void s5_params(const Mix1Bufs& B, const float* const* in, int gtid, int gsz) {

    for (int idx = gtid; idx < 2048; idx += gsz) { const int g = idx >> 6;
        const float lr = in[17][idx], li = in[18][idx], dt = expf(in[24][g]);
        const float mag = expf(lr * dt), ar = mag * cosf(li * dt), ai = mag * sinf(li * dt);
        const float den = lr * lr + li * li, nr = ar - 1.0f, cr = (nr * lr + ai * li) / den, ci = (ai * lr - nr * li) / den;
        B.s5ab[idx * 2] = ar; B.s5ab[idx * 2 + 1] = ai;
        for (int h = 0; h < 16; ++h) { const float br = in[19][idx * 16 + h], bi = in[20][idx * 16 + h]; B.s5bb[idx * 32 + h] = cr * br - ci * bi; B.s5bb[idx * 32 + 16 + h] = cr * bi + ci * br; } }
    for (int idx = gtid; idx < 32 * 128 * 16; idx += gsz) { const int h = idx & 15, j = (idx >> 4) & 127, g = idx >> 11; const int gp = g * 64 + (j & 63);
        const float lr = in[17][gp], li = in[18][gp], dt = expf(in[24][g]);
        const float mag = expf(lr * dt), ar = mag * cosf(li * dt), ai = mag * sinf(li * dt);
        const float den = lr * lr + li * li, nr = ar - 1.0f, cr = (nr * lr + ai * li) / den, ci = (ai * lr - nr * li) / den;
        const float br = in[19][gp * 16 + h], bi = in[20][gp * 16 + h];
        B.bbt[idx] = (unsigned short)f2bf(j < 64 ? cr * br - ci * bi : cr * bi + ci * br); }
    for (int idx = gtid; idx < 32 * 32 * 128; idx += gsz) { const int k = idx & 127, hh = (idx >> 7) & 31, g = idx >> 12;
        float v = 0.f; if (hh < 16) v = k < 64 ? in[21][(g * 16 + hh) * 64 + k] : -in[22][(g * 16 + hh) * 64 + k - 64];
        B.cm[idx] = (unsigned short)f2bf(v); }
}
template <bool OUT> __device__ __forceinline__ void s5_chunk_v2(const Mix1Bufs& B, const float* dskip, int item, bool valid, LAS unsigned char* wl, int lane) {
    if (!valid) item = 0;
    const int n = item % NCH, g = (item / NCH) & 31, b = item / (NCH * 32);
    const size_t t0 = (size_t)b * S_ + n * 64; const int gp = g * 64 + lane;
    LAS float* bu = (LAS float*)wl;
    lbf16* xs = (lbf16*)(wl + 8192);
    const float ar = B.s5ab[gp * 2], ai = B.s5ab[gp * 2 + 1];
    float xr = 0.f, xi = 0.f;
    if (OUT) { xr = B.xstart[((size_t)item * 64 + lane) * 2]; xi = B.xstart[((size_t)item * 64 + lane) * 2 + 1]; }
    const bf16* bbt = B.bbt + (size_t)g * 2048 + (lane & 31) * 16 + 8 * (lane >> 5);
    for (int half = 0; half < 2; ++half) {
        const s16x8 a = *(const s16x8*)(B.proj + (t0 + half * 32 + (lane & 31)) * PJ1 + g * 16 + 8 * (lane >> 5));
        f32x16 acc[4];
#pragma unroll
        for (int nt = 0; nt < 4; ++nt) { const s16x8 bf = *(const s16x8*)(bbt + nt * 512);
            const f32x16 z = {0.f, 0.f, 0.f, 0.f, 0.f, 0.f, 0.f, 0.f, 0.f, 0.f, 0.f, 0.f, 0.f, 0.f, 0.f, 0.f};
            acc[nt] = __builtin_amdgcn_mfma_f32_32x32x16_bf16(a, bf, z, 0, 0, 0); }
#pragma unroll
        for (int q = 0; q < 2; ++q) {
#pragma unroll
            for (int nt = 0; nt < 4; ++nt)
#pragma unroll
                for (int rr = 0; rr < 8; ++rr) bu[((rr & 3) + 8 * (rr >> 2) + 4 * (lane >> 5)) * 128 + nt * 32 + (lane & 31)] = acc[nt][q * 8 + rr];
            __syncthreads();
#pragma unroll 4
            for (int l = 0; l < 16; ++l) { const float sr = bu[l * 128 + lane], si = bu[l * 128 + 64 + lane];
                const float nr = ar * xr - ai * xi + sr, ni = ar * xi + ai * xr + si; xr = nr; xi = ni;
                if (OUT) { xs[(q * 16 + l) * 136 + lane] = (unsigned short)f2bf(xr); xs[(q * 16 + l) * 136 + 64 + lane] = (unsigned short)f2bf(xi); } }
            __syncthreads();
        }
        if (OUT) {
            f32x16 acc2 = {0.f, 0.f, 0.f, 0.f, 0.f, 0.f, 0.f, 0.f, 0.f, 0.f, 0.f, 0.f, 0.f, 0.f, 0.f, 0.f};
            mm32_gb(acc2, xs, 136, B.cm + (size_t)g * 32 * 128, 128, 128, lane);
            const int hh = lane & 31;
            if (hh < 16 && valid) { const float dk = dskip[g * 16 + hh];
#pragma unroll
                for (int r = 0; r < 16; ++r) { const size_t t = t0 + half * 32 + rowmap(r, lane);
                    B.s5g[t * 512 + g * 16 + hh] = (unsigned short)f2bf(gelu_f(acc2[r] + dk * bf2f(B.proj[t * PJ1 + g * 16 + hh]))); } }
            __syncthreads();
        }
    }
    if (!OUT && valid) { B.xend[((size_t)item * 64 + lane) * 2] = xr; B.xend[((size_t)item * 64 + lane) * 2 + 1] = xi; }
}
template <bool OUT> __device__ __forceinline__ void s5_phase(const Mix1Bufs& B, const float* dskip, int gw, int NGW, LAS unsigned char* wl, int lane) {
    const int wpg = NGW >> 5, g_ = gw / wpg, j0 = gw - g_ * wpg; const bool gvalid = g_ < 32; const int g = gvalid ? g_ : 0;
    const int nit = (2 * NCH + wpg - 1) / wpg;
    const float ar = B.s5ab[(g * 64 + lane) * 2], ai = B.s5ab[(g * 64 + lane) * 2 + 1];
    s16x8 bf[4]; { const bf16* bbt = B.bbt + (size_t)g * 2048 + (lane & 31) * 16 + 8 * (lane >> 5);
#pragma unroll
        for (int nt = 0; nt < 4; ++nt) bf[nt] = *(const s16x8*)(bbt + nt * 512); }
    s16x8 cf[4]; float dk[4];
    if (OUT) { const bf16* cm = B.cm + (size_t)g * 32 * 128 + (lane & 15) * 128 + 8 * (lane >> 4);
#pragma unroll
        for (int ks = 0; ks < 4; ++ks) cf[ks] = *(const s16x8*)(cm + ks * 32);
#pragma unroll
        for (int r = 0; r < 4; ++r) dk[r] = dskip[g * 16 + 4 * (lane >> 4) + r]; }
    s16x8 na[2]; v2u nu[2][2]; float nxr = 0.f, nxi = 0.f;
#define S5_LOAD(kk) do { const int _i = j0 + (kk) * wpg; const int _idx = (gvalid && _i < 2 * NCH) ? _i : 0; const int _b = _idx / NCH, _n = _idx % NCH; const size_t _t0 = (size_t)_b * S_ + _n * 64; \
        const bf16* _p = B.proj + (_t0 + (lane & 31)) * PJ1 + g * 16 + 8 * (lane >> 5); na[0] = *(const s16x8*)_p; na[1] = *(const s16x8*)(_p + (size_t)32 * PJ1); \
        if (OUT) { const size_t _it = (size_t)(_b * 32 + g) * NCH + _n; const float2 _x = *(const float2*)(B.xstart + (_it * 64 + lane) * 2); nxr = _x.x; nxi = _x.y; \
            const bf16* _q = B.proj + (_t0 + (lane & 15)) * PJ1 + g * 16 + 4 * (lane >> 4); _Pragma("unroll") for (int _h = 0; _h < 2; ++_h) _Pragma("unroll") for (int _t = 0; _t < 2; ++_t) nu[_h][_t] = *(const v2u*)(_q + (size_t)(_h * 32 + _t * 16) * PJ1); } } while (0)
    S5_LOAD(0);
    for (int k = 0; k < nit; ++k) {
        const int i_ = j0 + k * wpg; const bool valid = gvalid && i_ < 2 * NCH; const int idx = valid ? i_ : 0; const int b = idx / NCH, n = idx % NCH;
        const size_t t0 = (size_t)b * S_ + n * 64; const size_t item = (size_t)(b * 32 + g) * NCH + n;
        s16x8 a[2] = {na[0], na[1]}; v2u uu[2][2] = {{nu[0][0], nu[0][1]}, {nu[1][0], nu[1][1]}}; float xr = OUT ? nxr : 0.f, xi = OUT ? nxi : 0.f;
        if (k + 1 < nit) S5_LOAD(k + 1);
#pragma unroll
        for (int half = 0; half < 2; ++half) {
            f32x16 acc[4];
#pragma unroll
            for (int nt = 0; nt < 4; ++nt) { const f32x16 z = {0.f, 0.f, 0.f, 0.f, 0.f, 0.f, 0.f, 0.f, 0.f, 0.f, 0.f, 0.f, 0.f, 0.f, 0.f, 0.f};
                acc[nt] = __builtin_amdgcn_mfma_f32_32x32x16_bf16(a[half], bf[nt], z, 0, 0, 0); }
            float sre[2][16], sim[2][16];
#pragma unroll
            for (int r = 0; r < 16; ++r) {
                { auto w = __builtin_amdgcn_permlane32_swap(__float_as_uint(acc[0][r]), __float_as_uint(acc[1][r]), false, false); sre[0][r] = __uint_as_float(w[0]); sre[1][r] = __uint_as_float(w[1]); }
                { auto w = __builtin_amdgcn_permlane32_swap(__float_as_uint(acc[2][r]), __float_as_uint(acc[3][r]), false, false); sim[0][r] = __uint_as_float(w[0]); sim[1][r] = __uint_as_float(w[1]); } }
            lbf16* xs = (lbf16*)(wl + half * 8704);
#pragma unroll
            for (int q = 0; q < 4; ++q)
#pragma unroll
                for (int wch = 0; wch < 2; ++wch)
#pragma unroll
                    for (int i = 0; i < 4; ++i) { const int r = q * 4 + i, tok = q * 8 + wch * 4 + i;
                        const float sr = sre[wch][r], si = sim[wch][r];
                        const float nr = ar * xr - ai * xi + sr, ni = ar * xi + ai * xr + si; xr = nr; xi = ni;
                        if (OUT) { xs[tok * 136 + lane] = (unsigned short)f2bf(xr); xs[tok * 136 + 64 + lane] = (unsigned short)f2bf(xi); } }
            if (OUT) {
                __syncthreads();
#pragma unroll
                for (int tt = 0; tt < 2; ++tt) { f32x4 y = {0.f, 0.f, 0.f, 0.f};
                    const lbf16* xp = xs + (tt * 16 + (lane & 15)) * 136 + 8 * (lane >> 4);
#pragma unroll
                    for (int ks = 0; ks < 4; ++ks) y = __builtin_amdgcn_mfma_f32_16x16x32_bf16(cf[ks], *(const LAS s16x8*)(xp + ks * 32), y, 0, 0, 0);
                    const v2u u = uu[half][tt];
                    const float u0 = __builtin_bit_cast(float, u.x << 16), u1 = __builtin_bit_cast(float, u.x & 0xffff0000u), u2 = __builtin_bit_cast(float, u.y << 16), u3 = __builtin_bit_cast(float, u.y & 0xffff0000u);
                    v2u o; o.x = pk2(gelu_f(y[0] + dk[0] * u0), gelu_f(y[1] + dk[1] * u1)); o.y = pk2(gelu_f(y[2] + dk[2] * u2), gelu_f(y[3] + dk[3] * u3));
                    if (valid) *(v2u*)(B.s5g + (t0 + half * 32 + tt * 16 + (lane & 15)) * 512 + g * 16 + 4 * (lane >> 4)) = o; }
            }
        }
        if (!OUT && valid) { float2 o; o.x = xr; o.y = xi; *(float2*)(B.xend + (item * 64 + lane) * 2) = o; }
    }
#undef S5_LOAD
}
__device__ __forceinline__ void s5_b(const Mix1Bufs& B, int gtid, int gsz) {
    for (int idx = gtid; idx < 2 * 2048; idx += gsz) { const int b = idx >> 11, gp = idx & 2047, g = gp >> 6, p = gp & 63;
        float ar = B.s5ab[gp * 2], ai = B.s5ab[gp * 2 + 1];
#pragma unroll
        for (int q = 0; q < 6; ++q) { const float r2 = ar * ar - ai * ai, i2 = 2.f * ar * ai; ar = r2; ai = i2; }
        float xr = 0.f, xi = 0.f;
        const size_t o0 = ((size_t)((b * 32 + g) * NCH) * 64 + p) * 2;
        for (int n0 = 0; n0 < NCH; n0 += 16) { float er[16], ei[16];
#pragma unroll
            for (int j = 0; j < 16; ++j) { const size_t o = o0 + (size_t)(n0 + j) * 128; er[j] = B.xend[o]; ei[j] = B.xend[o + 1]; }
#pragma unroll
            for (int j = 0; j < 16; ++j) { const float sr = xr, si = xi; const float nr = ar * xr - ai * xi + er[j], ni = ar * xi + ai * xr + ei[j]; xr = nr; xi = ni; er[j] = sr; ei[j] = si; }
#pragma unroll
            for (int j = 0; j < 16; ++j) { const size_t o = o0 + (size_t)(n0 + j) * 128; B.xstart[o] = er[j]; B.xstart[o + 1] = ei[j]; } } }
}
typedef float f32x4v __attribute__((ext_vector_type(4)));
struct RouterBufs { const float* z; float* h; bf16* hbf; const float* lnw; const float* lnb; const bf16* rwh; const bf16* rwl; const float* rbias; int* ridx; float* rwt; unsigned* cnt; };
__device__ __forceinline__ void router_split_weights(const float* rw, bf16* hi, bf16* lo, int gtid, int gsz) {
    for (int i = gtid; i < 64 * 1024; i += gsz) { const int e = i >> 10, k = i & 1023; const float w = rw[k * 64 + e]; const unsigned h = f2bf(w); hi[i] = (unsigned short)h; lo[i] = (unsigned short)f2bf(w - __builtin_bit_cast(float, h << 16)); }
}
__device__ __forceinline__ void router_select(const LAS float* sc, const float* bias, int* ridx, float* rwt, LAS unsigned* hist) {
    float gs[8];
#pragma unroll
    for (int g = 0; g < 8; ++g) { float m1 = -INFINITY, m2 = -INFINITY;
#pragma unroll
        for (int j = 0; j < 8; ++j) { const float v = sc[g * 8 + j] + bias[g * 8 + j]; if (v > m1) { m2 = m1; m1 = v; } else if (v > m2) m2 = v; }
        gs[g] = m1 + m2; }
    unsigned gsel = 0;
#pragma unroll
    for (int it = 0; it < 4; ++it) { float best = -INFINITY; int bi = 0;
#pragma unroll
        for (int g = 0; g < 8; ++g) { const bool ok = !((gsel >> g) & 1u) && gs[g] > best; best = ok ? gs[g] : best; bi = ok ? g : bi; }
        gsel |= 1u << bi; }
    unsigned long long taken = 0ull; float wsum = 0.f; float wv[8]; int ev[8];
#pragma unroll
    for (int it = 0; it < 8; ++it) { float best = -INFINITY; int bi = 0;
#pragma unroll 1
        for (int e = 0; e < 64; ++e) { const bool ok = ((gsel >> (e >> 3)) & 1u) && !((taken >> e) & 1ull); const float v = sc[e] + bias[e]; if (ok && v > best) { best = v; bi = e; } }
        taken |= 1ull << bi; ev[it] = bi; wv[it] = sc[bi]; wsum += wv[it]; }
    const float inv = 2.5f / wsum;
#pragma unroll
    for (int it = 0; it < 8; ++it) { ridx[it] = ev[it]; rwt[it] = wv[it] * inv; atomicAdd((unsigned*)&hist[ev[it]], 1u); }
}
__device__ __forceinline__ void router_tiles(const RouterBufs& R, int tile0, int tstride, int ntiles, LAS unsigned char* lds, int tid, bool count = true) {
    const int lane = tid & 63, wave = __builtin_amdgcn_readfirstlane(tid >> 6);
    lbf16* Ahi = (lbf16*)lds; lbf16* Alo = (lbf16*)(lds + 33024); LAS float* part = (LAS float*)(lds + 66048); LAS float* sc = (LAS float*)(lds + 98816); LAS unsigned* hist = (LAS unsigned*)(lds + 102912);
    if (tile0 >= ntiles) return;
    const int row16 = lane & 15, kq = 8 * (lane >> 4);
    s16x8 bh[4][4], bl[4][4];
#pragma unroll
    for (int ks = 0; ks < 4; ++ks)
#pragma unroll
        for (int nt = 0; nt < 4; ++nt) { const size_t o = (size_t)(nt * 16 + row16) * 1024 + wave * 128 + ks * 32 + kq; bh[ks][nt] = *(const s16x8*)(R.rwh + o); bl[ks][nt] = *(const s16x8*)(R.rwl + o); }
    const float bias = R.rbias[lane];
    f32x4 zr[2][4];
#define RT_LOAD(tile) do { _Pragma("unroll") for (int q = 0; q < 2; ++q) { const float* zp = R.z + ((size_t)(tile) * 16 + wave * 2 + q) * 1024 + lane * 8; \
        zr[q][0] = *(const f32x4*)zp; zr[q][1] = *(const f32x4*)(zp + 4); zr[q][2] = *(const f32x4*)(zp + 512); zr[q][3] = *(const f32x4*)(zp + 516); } } while (0)
    RT_LOAD(tile0);
    if (tid < 64) hist[tid] = 0u;
    for (int tile = tile0; tile < ntiles; tile += tstride) {
#pragma unroll
        for (int q = 0; q < 2; ++q) { const int row = wave * 2 + q; const size_t t = (size_t)tile * 16 + row;
            float v[16] = {zr[q][0].x, zr[q][0].y, zr[q][0].z, zr[q][0].w, zr[q][1].x, zr[q][1].y, zr[q][1].z, zr[q][1].w, zr[q][2].x, zr[q][2].y, zr[q][2].z, zr[q][2].w, zr[q][3].x, zr[q][3].y, zr[q][3].z, zr[q][3].w};
            float sum = 0.f;
#pragma unroll
            for (int j = 0; j < 16; ++j) sum += v[j];
            sum = wave_sum(sum); const float mean = sum * (1.f / 1024.f); float sq = 0.f;
#pragma unroll
            for (int j = 0; j < 16; ++j) { v[j] -= mean; sq += v[j] * v[j]; }
            sq = wave_sum(sq); const float rstd = 1.0f / sqrtf(sq * (1.f / 1024.f) + nv::EPS);
#pragma unroll
            for (int half = 0; half < 2; ++half) { const int c0 = half * 512 + lane * 8;
                const f32x4 w0 = *(const f32x4*)(R.lnw + c0), w1 = *(const f32x4*)(R.lnw + c0 + 4), b0 = *(const f32x4*)(R.lnb + c0), b1 = *(const f32x4*)(R.lnb + c0 + 4);
                float o[8] = {v[half * 8 + 0] * rstd * w0.x + b0.x, v[half * 8 + 1] * rstd * w0.y + b0.y, v[half * 8 + 2] * rstd * w0.z + b0.z, v[half * 8 + 3] * rstd * w0.w + b0.w,
                              v[half * 8 + 4] * rstd * w1.x + b1.x, v[half * 8 + 5] * rstd * w1.y + b1.y, v[half * 8 + 6] * rstd * w1.z + b1.z, v[half * 8 + 7] * rstd * w1.w + b1.w};
                *(f32x4*)(R.h + t * 1024 + c0) = (f32x4){o[0], o[1], o[2], o[3]}; *(f32x4*)(R.h + t * 1024 + c0 + 4) = (f32x4){o[4], o[5], o[6], o[7]};
                const v4u hi = pack8(o); float hf[8], lo[8]; unpack8(hi, hf);
#pragma unroll
                for (int j = 0; j < 8; ++j) lo[j] = o[j] - hf[j];
                *(v4u*)(R.hbf + t * 1024 + c0) = hi; *(LAS v4u*)(Ahi + row * 1032 + c0) = hi; *(LAS v4u*)(Alo + row * 1032 + c0) = pack8(lo); } }
        if (tile + tstride < ntiles) RT_LOAD(tile + tstride);
        __syncthreads();
        { f32x4v acc[4] = {{0.f, 0.f, 0.f, 0.f}, {0.f, 0.f, 0.f, 0.f}, {0.f, 0.f, 0.f, 0.f}, {0.f, 0.f, 0.f, 0.f}};
#pragma unroll
          for (int ks = 0; ks < 4; ++ks) { const int k0 = wave * 128 + ks * 32 + kq;
              const s16x8 ah = *(const LAS s16x8*)(Ahi + row16 * 1032 + k0), al = *(const LAS s16x8*)(Alo + row16 * 1032 + k0);
#pragma unroll
              for (int nt = 0; nt < 4; ++nt) {
                  acc[nt] = __builtin_amdgcn_mfma_f32_16x16x32_bf16(ah, bh[ks][nt], acc[nt], 0, 0, 0);
                  acc[nt] = __builtin_amdgcn_mfma_f32_16x16x32_bf16(al, bh[ks][nt], acc[nt], 0, 0, 0);
                  acc[nt] = __builtin_amdgcn_mfma_f32_16x16x32_bf16(ah, bl[ks][nt], acc[nt], 0, 0, 0); } }
#pragma unroll
          for (int nt = 0; nt < 4; ++nt)
#pragma unroll
              for (int r = 0; r < 4; ++r) part[(wave * 16 + (lane >> 4) * 4 + r) * 64 + nt * 16 + (lane & 15)] = acc[nt][r]; }
        __syncthreads();
#pragma unroll
        for (int q = 0; q < 2; ++q) { const int o = tid + q * 512; float s = 0.f;
#pragma unroll
            for (int w = 0; w < 8; ++w) s += part[w * 1024 + o];
            sc[o] = 1.0f / (1.0f + expf(-s)); }
        __syncthreads();
        { LAS float* gsl = part; LAS float* cvl = part + 128;
#pragma unroll 1
          for (int q = 0; q < 2; ++q) { const int tk = wave * 2 + q; const size_t t = (size_t)tile * 16 + tk;
              const float s = sc[tk * 64 + lane], v = s + bias;
#define SWZ_MAX(x, o) fmaxf(x, __builtin_bit_cast(float, __builtin_amdgcn_ds_swizzle(__builtin_bit_cast(int, x), 0x1f | ((o) << 10))))
#define SWZ_ADD(x, o) ((x) + __builtin_bit_cast(float, __builtin_amdgcn_ds_swizzle(__builtin_bit_cast(int, x), 0x1f | ((o) << 10))))
              float m1 = v; m1 = SWZ_MAX(m1, 1); m1 = SWZ_MAX(m1, 2); m1 = SWZ_MAX(m1, 4);
              float c1 = (v == m1) ? 1.f : 0.f; c1 = SWZ_ADD(c1, 1); c1 = SWZ_ADD(c1, 2); c1 = SWZ_ADD(c1, 4);
              float m2 = (v == m1) ? -INFINITY : v; m2 = SWZ_MAX(m2, 1); m2 = SWZ_MAX(m2, 2); m2 = SWZ_MAX(m2, 4);
              const float gs = m1 + (c1 >= 2.f ? m1 : m2);
              if ((lane & 7) == 0) gsl[tk * 8 + (lane >> 3)] = gs;
              __syncthreads();
              int grank = 0; const int g = lane >> 3;
#pragma unroll
              for (int j = 0; j < 8; ++j) { const float x = gsl[tk * 8 + j]; grank += (x > gs || (x == gs && j < g)) ? 1 : 0; }
              const bool gsel = grank < 4; const float cv = gsel ? v : -INFINITY;
              cvl[tk * 64 + lane] = cv;
              __syncthreads();
              int rank = 0;
#pragma unroll 16
              for (int j = 0; j < 64; ++j) { const float x = cvl[tk * 64 + j]; rank += (x > cv || (x == cv && j < lane)) ? 1 : 0; }
              const bool sel = gsel && rank < 8;
              const float wsum = wave_sum(sel ? s : 0.f);
              if (sel) { R.ridx[t * 8 + rank] = lane; R.rwt[t * 8 + rank] = s * (2.5f / wsum); atomicAdd((unsigned*)&hist[lane], 1u); }
#undef SWZ_MAX
#undef SWZ_ADD
          } }
        __syncthreads();
    }
#undef RT_LOAD
    if (count && tid < 64 && hist[tid]) atomicAdd(&R.cnt[tid], hist[tid]);
    __syncthreads();
}
#ifndef DUP_PHASE
#define DUP_PHASE -1
#endif
constexpr int CTX_OFF = LDS_CTL + 1024, TAB_OFF = LDS_CTL + 7168;
constexpr size_t WS_WINE = 1 * MiB, WS_WINO = WS_WINE + (size_t)EINP * 1024 * 2, WS_WOUT = WS_WINO + (size_t)OINP * 1024 * 2, WS_XBF = 16 * MiB, WS_NAIVE = 80 * MiB;
#if defined(WITH_NAIVE)
constexpr size_t WS_MIXBF = 48 * MiB;
#else
constexpr size_t WS_MIXBF = 453 * MiB;
#endif
__device__ __forceinline__ int conv_split(int nwg, int G) {
#if defined(WITH_NAIVE)
    return 0;
#else
    const int rem = nwg % G; return rem == 0 ? 0 : (G - rem) * NWAVES * 4;
#endif
}
static_assert(WS_WOUT + 2 * 1024 * 1024 * 2 <= WS_XBF, "ws map");
constexpr size_t WS_WD = 48 * MiB, WS_WGU = WS_WD + 65 * 512 * 1024, WS_LISTS = 146 * MiB, WS_RIDX = 148 * MiB, WS_H = 149 * MiB, WS_ROWS8 = 229 * MiB;
static_assert(WS_WGU + (size_t)65 * 1024 * 1024 <= WS_LISTS && WS_H + (size_t)MOE_MAXBLK * 256 * 512 <= WS_ROWS8 && WS_ROWS8 + (size_t)nv::T_ * 8 * 2048 <= 512 * MiB, "moe ws map");
constexpr size_t WS_PROJB = 149 * MiB, WS_CT = 253 * MiB, WS_HLOC = 317 * MiB, WS_PC = 349 * MiB, WS_M0SMALL = 381 * MiB, WS_LRUW = 486 * MiB;
constexpr size_t WS_UT = 221 * MiB, WS_S5G = 253 * MiB, WS_M1SMALL = 269 * MiB, WS_GLUW = 486 * MiB + 256 * 1024;
constexpr size_t WS_RW = 487 * MiB;
constexpr int CW_PROBE = 9000;
struct Tab { const float* in[38]; float* out; unsigned char* ws; };
struct Env { const Tab* tab; unsigned char* ws; float* out; LAS unsigned char* lds; int tid, lane, wave, bid, G, gw, NGW, gtid, gsz, vcu; };
__device__ __forceinline__ Env penv(unsigned char* lds_raw) {
    Env e; e.tab = (const Tab*)(lds_raw + TAB_OFF); e.ws = e.tab->ws; e.out = e.tab->out; e.lds = (LAS unsigned char*)lds_raw;
    int t = threadIdx.x; asm volatile("" : "+v"(t)); e.tid = t; e.lane = t & 63; e.wave = __builtin_amdgcn_readfirstlane(t >> 6);
    int b = blockIdx.x; asm volatile("" : "+s"(b)); e.bid = b; int g = gridDim.x; asm volatile("" : "+s"(g)); e.G = g;
    e.vcu = (g % 8 == 0) ? (b % 8) * (g / 8) + b / 8 : b;
    e.gw = b * NWAVES + e.wave; e.NGW = g * NWAVES; e.gtid = b * NTHREADS + t; e.gsz = g * NTHREADS;
    return e;
}
__device__ __forceinline__ void grid_bar(const Env& e) {
    XcdBarrier b; b.bar = (unsigned*)e.ws + 4096; b.x = xb_xcc_id(); b.st = (volatile LAS unsigned*)(e.lds + MISC_OFF) + 8;
    xcd_barrier(b);
}
#if defined(WITH_NAIVE)
template <int ST> __device__ __forceinline__ void run_naive(unsigned char* lds_raw, int ci, long n) {
    const Env e = penv(lds_raw);
    const nv::Ctx& c = ((const nv::Ctx*)(lds_raw + CTX_OFF))[ci];
    for (long i = e.gtid; i < n; i += e.gsz) nv::item<ST>(c, i);
    grid_bar(e);
}
#endif
__device__ __forceinline__ void phase_p0(unsigned char* lds_raw) {
    const Env e = penv(lds_raw);
    LAS float* scr = (LAS float*)(e.lds + e.wave * 16640);
    constexpr int I0 = 16 * (EINP / 64), I1 = I0 + 16 * (OINP / 64), I2 = I1 + 256, I3 = I2 + 256, I4 = I3 + 32, I5 = I4 + 64;
    for (int it = e.gw; it < I5; it += e.NGW) {
        if (it < I0) tr_matrix_item(e.tab->in[6], 1024, nv::EIN, EINP, (bf16*)(e.ws + WS_WINE), scr, it, e.lane);
        else if (it < I1) tr_matrix_item(e.tab->in[16], 1024, nv::OIN, OINP, (bf16*)(e.ws + WS_WINO), scr, it - I0, e.lane);
        else if (it < I2) tr_matrix_item(e.tab->in[5], 1024, 1024, 1024, (bf16*)(e.ws + WS_WOUT), scr, it - I1, e.lane);
        else if (it < I3) tr_matrix_item(e.tab->in[5] + 1024 * 1024, 1024, 1024, 1024, (bf16*)(e.ws + WS_WOUT) + 1024 * 1024, scr, it - I2, e.lane);
        else if (it < I4) { const int r = it - I3, mtx = r >> 2, h = mtx & 3, which = mtx >> 2;
            tr_matrix_item(e.tab->in[which ? 13 : 11] + h * 16384, 128, 128, 128, (bf16*)(e.ws + WS_LRUW) + which * 65536 + h * 16384, scr, r & 3, e.lane); }
        else tr_matrix_item(e.tab->in[25], 512, 512, 512, (bf16*)(e.ws + WS_GLUW), scr, it - I4, e.lane);
    }
    for (int l = 0; l < 2; ++l) router_split_weights(e.tab->in[30] + (size_t)l * 65536, (bf16*)(e.ws + WS_RW) + (size_t)l * 131072, (bf16*)(e.ws + WS_RW) + (size_t)l * 131072 + 65536, e.gtid, e.gsz);
    cvt_rows(e.tab->in[0], (bf16*)(e.ws + WS_XBF), (long)T_ * 1024, e.gtid, e.gsz);
    grid_bar(e);
}
__device__ __forceinline__ void phase_inproj(unsigned char* lds_raw, int layer) {
    const Env e = penv(lds_raw);
    float* proj = (float*)(e.ws + WS_NAIVE) + ((size_t)T_ * 1024 + (size_t)T_ * 64 + (size_t)T_ * 8 * 2);
    const int NP = layer == 0 ? EINP : OINP;
    pg8::Gemm g{(const bf16*)(e.ws + WS_XBF), (const bf16*)(e.ws + (layer == 0 ? WS_WINE : WS_WINO)), 1024, 0, 0, nullptr};
    pg8::StaticOrder S; S.init(T_, NP, e.G, e.bid);
    pg8::EpiF32R E{proj, NP, nullptr, 0.f};
    pg8::gemm_phase<pg8::EpiF32R, pg8::StaticOrder, true, false>(e.lds, g, S, E);
    grid_bar(e);
}
__device__ __forceinline__ void phase_cvt_mixed(unsigned char* lds_raw) {
    const Env e = penv(lds_raw);
    cvt_rows((const float*)(e.ws + WS_NAIVE), (bf16*)(e.ws + WS_MIXBF), (long)T_ * 1024, e.gtid, e.gsz);
    grid_bar(e);
}
__device__ __forceinline__ void phase_outproj(unsigned char* lds_raw, int layer) {
    const Env e = penv(lds_raw);
    float* z = (float*)(e.ws + WS_NAIVE) + ((size_t)T_ * 1024 + (size_t)T_ * 64 + (size_t)T_ * 8 * 2);
    const float* hcur = layer == 0 ? e.tab->in[0] : e.out;
    pg8::Gemm g{(const bf16*)(e.ws + WS_MIXBF), (const bf16*)(e.ws + WS_WOUT) + (size_t)layer * 1024 * 1024, 1024, 0, 0, nullptr};
    pg8::StaticOrder S; S.init(T_, 1024, e.G, e.bid);
    pg8::EpiF32R E{z, 1024, hcur, nv::ALPHA};
    pg8::gemm_phase<pg8::EpiF32R, pg8::StaticOrder, true, false>(e.lds, g, S, E);
    grid_bar(e);
}
__device__ __forceinline__ Mix0Bufs mix0_bufs(unsigned char* ws) {
    Mix0Bufs B; B.proj = (const bf16*)(ws + WS_PROJB); B.ct = (bf16*)(ws + WS_CT); B.hloc = (float*)(ws + WS_HLOC); B.pc = (float*)(ws + WS_PC);
    float* sm = (float*)(ws + WS_M0SMALL); B.nloc = sm; sm += 8 * NCH * 128; B.blast = sm; sm += 8 * NCH; B.mloc = sm; sm += 8 * NCH; B.mprev = sm; sm += 8 * NCH;
    B.carA = sm; sm += 2 * NCH * 512; B.carU = sm; sm += 2 * NCH * 512; B.carI = sm;
    B.mixbf = (bf16*)(ws + WS_MIXBF); B.lruw = (const bf16*)(ws + WS_LRUW); return B;
}
__device__ __forceinline__ Mix1Bufs mix1_bufs(unsigned char* ws) {
    Mix1Bufs B; B.proj = (const bf16*)(ws + WS_PROJB); B.ut = (bf16*)(ws + WS_UT); B.s5g = (bf16*)(ws + WS_S5G);
    float* sm = (float*)(ws + WS_M1SMALL); B.gbl = sm; sm += 8 * NCH * 64; B.xend = sm; sm += 8192 * 128; B.xstart = sm; sm += 8192 * 128; B.s5ab = sm; sm += 4096; B.s5bb = sm; sm += 2048 * 32;
    B.cm = (bf16*)sm; B.bbt = B.cm + 32 * 32 * 128; B.mixbf = (bf16*)(ws + WS_MIXBF); return B;
}
__device__ __forceinline__ void phase_inproj_bf16(unsigned char* lds_raw, int layer) {
    const Env e = penv(lds_raw);
    const int NP = layer == 0 ? EINP : OINP;
    if (layer == 1) { const Mix1Bufs B = mix1_bufs(e.ws); s5_params(B, e.tab->in, e.gtid, e.gsz); }
    pg8::Gemm g{(const bf16*)(e.ws + WS_XBF), (const bf16*)(e.ws + (layer == 0 ? WS_WINE : WS_WINO)), 1024, 0, 0, nullptr};
    pg8::StaticOrder S; S.init(T_, NP, e.G, e.bid);
    pg8::EpiBf16P E{(bf16*)(e.ws + WS_PROJB), NP};
    pg8::gemm_phase<pg8::EpiBf16P, pg8::StaticOrder, true, false>(e.lds, g, S, E);
    { const int nwg = (T_ / 256) * (NP / 256), rem = nwg % e.G, na = conv_split(nwg, e.G);
      if (na > 0 && e.bid >= rem) { const int nlight = e.G - rem; LAS float* scr = (LAS float*)(e.lds + e.wave * 16640);
          moe_convert_weights(e.tab->in[32] + (size_t)layer * 64 * 262144, e.tab->in[33] + (size_t)layer * 64 * 262144, e.tab->in[34] + (size_t)layer * 64 * 262144,
                              e.tab->in[35] + (size_t)layer * 262144, e.tab->in[36] + (size_t)layer * 262144, e.tab->in[37] + (size_t)layer * 262144,
                              (bf16*)(e.ws + WS_WGU), (bf16*)(e.ws + WS_WD), scr, (e.bid - rem) * NWAVES + e.wave, na, nlight * NWAVES, e.lane); } }
    grid_bar(e);
}
__device__ __forceinline__ void phase_mix0_a(unsigned char* lds_raw) {
    const Env e = penv(lds_raw); const Mix0Bufs B = mix0_bufs(e.ws);
    for (int it = e.bid; it < 256 + 8 * NCH; it += e.G) {
        if (it < 256) { lru_a_item(B, e.tab->in, it, e.lds, e.tid); if (DUP_PHASE == 31) lru_a_item(B, e.tab->in, it, e.lds, e.tid); }
        else { mlstm_a_item(B, e.tab->in[7], it - 256, e.lds, e.tid); if (DUP_PHASE == 30) mlstm_a_item(B, e.tab->in[7], it - 256, e.lds, e.tid); } }
    grid_bar(e);
}
__device__ __forceinline__ int conv_rest(int nwg, int G, int NGW) {
#if defined(WITH_NAIVE)
    return 0;
#else
    const int nb = conv_split(nwg, G) + NGW * 3; return nb > 65 * 192 ? 65 * 192 : nb;
#endif
}
__device__ __forceinline__ void conv_in_scan_phase(const Env& e, int layer) {
#if !defined(WITH_NAIVE)
    const int na = conv_split((T_ / 256) * ((layer == 0 ? EINP : OINP) / 256), e.G); int nb = na + e.NGW * 3; if (nb > 65 * 192) nb = 65 * 192;
    LAS float* scr = (LAS float*)(e.lds + e.wave * 16640);
    moe_convert_weights(e.tab->in[32] + (size_t)layer * 64 * 262144, e.tab->in[33] + (size_t)layer * 64 * 262144, e.tab->in[34] + (size_t)layer * 64 * 262144,
                        e.tab->in[35] + (size_t)layer * 262144, e.tab->in[36] + (size_t)layer * 262144, e.tab->in[37] + (size_t)layer * 262144,
                        (bf16*)(e.ws + WS_WGU), (bf16*)(e.ws + WS_WD), scr, na + e.gw, nb, e.NGW, e.lane);
#endif
}
__device__ __forceinline__ void phase_mix0_b(unsigned char* lds_raw) {
    const Env e = penv(lds_raw); const Mix0Bufs B = mix0_bufs(e.ws);
    lru_b(B, e.gtid, e.gsz); mlstm_b(B, e.gtid, e.gsz);
    grid_bar(e);
}
__device__ __forceinline__ void phase_mix0_c(unsigned char* lds_raw) {
    const Env e = penv(lds_raw); const Mix0Bufs B = mix0_bufs(e.ws);
    for (int it = e.bid; it < 8 * NCH; it += e.G) { mlstm_c_item(B, e.tab->in[7], e.tab->in[8], it, e.lds, e.tid); if (DUP_PHASE == 32) mlstm_c_item(B, e.tab->in[7], e.tab->in[8], it, e.lds, e.tid); }
    lru_c(B, e.gtid, e.gsz); if (DUP_PHASE == 33) lru_c(B, e.gtid, e.gsz);
    grid_bar(e);
}
__device__ __forceinline__ void phase_mix1_a(unsigned char* lds_raw) {
    const Env e = penv(lds_raw); const Mix1Bufs B = mix1_bufs(e.ws);
    for (int it = e.bid; it < 8 * NCH; it += e.G) { gla_a_item(B, e.tab->in[27], e.tab->in[28], it, e.lds, e.tid); if (DUP_PHASE == 34) gla_a_item(B, e.tab->in[27], e.tab->in[28], it, e.lds, e.tid); }
    s5_phase<false>(B, e.tab->in[23], e.gw, e.NGW, e.lds + e.wave * 17408, e.lane); if (DUP_PHASE == 35) s5_phase<false>(B, e.tab->in[23], e.gw, e.NGW, e.lds + e.wave * 17408, e.lane);
    grid_bar(e);
}
__device__ __forceinline__ void phase_mix1_b(unsigned char* lds_raw) {
    const Env e = penv(lds_raw); const Mix1Bufs B = mix1_bufs(e.ws);
    s5_b(B, e.gtid, e.gsz); gla_b(B, e.gtid, e.gsz);
    grid_bar(e);
}
__device__ __forceinline__ void phase_mix1_c(unsigned char* lds_raw) {
    const Env e = penv(lds_raw); const Mix1Bufs B = mix1_bufs(e.ws);
    for (int it = e.bid; it < 8 * NCH; it += e.G) { gla_c_item(B, e.tab->in[27], e.tab->in[28], e.tab->in[29], it, e.lds, e.tid); if (DUP_PHASE == 36) gla_c_item(B, e.tab->in[27], e.tab->in[28], e.tab->in[29], it, e.lds, e.tid); }
#if defined(S5_OLD_C)
    for (int it = e.gw, k = 0; k < (2 * 32 * NCH + e.NGW - 1) / e.NGW; ++k, it += e.NGW) s5_chunk_v2<true>(B, e.tab->in[23], it, it < 2 * 32 * NCH, e.lds + e.wave * 16896, e.lane);
#else
    s5_phase<true>(B, e.tab->in[23], e.gw, e.NGW, e.lds + e.wave * 17408, e.lane); if (DUP_PHASE == 37) s5_phase<true>(B, e.tab->in[23], e.gw, e.NGW, e.lds + e.wave * 17408, e.lane);
#endif
    grid_bar(e);
}
__device__ __forceinline__ void phase_glu(unsigned char* lds_raw) {
    const Env e = penv(lds_raw);
    pg8::Gemm g{(const bf16*)(e.ws + WS_S5G), (const bf16*)(e.ws + WS_GLUW), 512, 0, 0, nullptr};
    pg8::StaticOrder S; S.init(T_, 512, e.G, e.bid);
    pg8::EpiGlu E{(bf16*)(e.ws + WS_MIXBF), 1024, (const bf16*)(e.ws + WS_S5G), 512, e.tab->in[26]};
    pg8::gemm_phase<pg8::EpiGlu, pg8::StaticOrder, true, false>(e.lds, g, S, E);
    grid_bar(e);
}
__device__ __forceinline__ void phase_probe(unsigned char* lds_raw, int c0, int c1) {
    const Env e = penv(lds_raw);
    const bf16* a = (const bf16*)(e.ws + WS_MIXBF); const float* b = (const float*)(e.ws + WS_NAIVE);
    float sd = 0.f, sr = 0.f; const int w = c1 - c0;
    for (long i = e.gtid; i < (long)T_ * w; i += e.gsz) { const long t = i / w; const int c = c0 + (int)(i % w); const float x = bf2f(a[t * 1024 + c]), y = b[t * 1024 + c]; sd += (x - y) * (x - y); sr += y * y; }
    sd = wave_sum(sd); sr = wave_sum(sr);
    if (e.lane == 0) { atomicAdd((float*)e.ws + CW_PROBE, sd); atomicAdd((float*)e.ws + CW_PROBE + 1, sr); }
    grid_bar(e);
}
__device__ __forceinline__ void phase_probe_apply(unsigned char* lds_raw) {
    const Env e = penv(lds_raw);
    const float sd = __hip_atomic_load((float*)e.ws + CW_PROBE, __ATOMIC_RELAXED, __HIP_MEMORY_SCOPE_AGENT), sr = __hip_atomic_load((float*)e.ws + CW_PROBE + 1, __ATOMIC_RELAXED, __HIP_MEMORY_SCOPE_AGENT);
    const float f = 1.0f + 10.0f * sqrtf(sd / fmaxf(sr, 1e-30f));
    for (long i = e.gtid; i < (long)T_ * 1024; i += e.gsz) e.out[i] *= f;
}
__device__ __forceinline__ void phase_ln_router(unsigned char* lds_raw, int layer, bool count = true) {
    const Env e = penv(lds_raw);
    RouterBufs R; R.z = (const float*)(e.ws + WS_NAIVE) + ((size_t)T_ * 1024 + (size_t)T_ * 64 + (size_t)T_ * 8 * 2); R.h = e.out; R.hbf = (bf16*)(e.ws + WS_XBF);
    R.lnw = e.tab->in[1] + layer * 1024; R.lnb = e.tab->in[2] + layer * 1024; R.rwh = (const bf16*)(e.ws + WS_RW) + (size_t)layer * 131072; R.rwl = R.rwh + 65536;
    R.rbias = e.tab->in[31] + layer * 64; R.ridx = (int*)(e.ws + WS_RIDX); R.rwt = (float*)(e.ws + WS_RIDX) + (size_t)T_ * 8; R.cnt = (unsigned*)e.ws + CW_CNT + layer * 256;
    router_tiles(R, e.bid, e.G, T_ / 16, e.lds, e.tid, count);
    grid_bar(e);
}
__device__ __forceinline__ MoeLists moe_lists(unsigned char* ws) {
    MoeLists L; L.tok = (int*)(ws + WS_LISTS); L.dest = L.tok + MOE_MAXBLK * 256; L.w = (float*)(L.dest + MOE_MAXBLK * 256); L.blk_e = (int*)(L.w + MOE_MAXBLK * 256); return L;
}
__device__ __forceinline__ void phase_moe_x1(unsigned char* lds_raw, int layer, int curoff = 0) {
    const Env e = penv(lds_raw);
    moe_build_lists((const int*)(e.ws + WS_RIDX), (const float*)(e.ws + WS_RIDX) + (size_t)T_ * 8, (unsigned*)e.ws + CW_CNT + layer * 256, (unsigned*)e.ws + CW_CUR + layer * 256 + curoff,
                    moe_lists(e.ws), (LAS int*)e.lds, e.tid, e.bid, e.G);
    LAS float* scr = (LAS float*)(e.lds + e.wave * 16640);
    moe_convert_weights(e.tab->in[32] + (size_t)layer * 64 * 262144, e.tab->in[33] + (size_t)layer * 64 * 262144, e.tab->in[34] + (size_t)layer * 64 * 262144,
                        e.tab->in[35] + (size_t)layer * 262144, e.tab->in[36] + (size_t)layer * 262144, e.tab->in[37] + (size_t)layer * 262144,
                        (bf16*)(e.ws + WS_WGU), (bf16*)(e.ws + WS_WD), scr, conv_split((T_ / 256) * ((layer == 0 ? EINP : OINP) / 256), e.G) + e.gw, 65 * 192, e.NGW, e.lane);
    grid_bar(e);
}
__device__ __forceinline__ void phase_moe_g1(unsigned char* lds_raw) {
    const Env e = penv(lds_raw);
    const MoeLists L = moe_lists(e.ws);
    const int nblk = __builtin_amdgcn_readfirstlane(L.blk_e[MOE_MAXBLK]);
    pg8::Gemm g{(const bf16*)(e.ws + WS_XBF), (const bf16*)(e.ws + WS_WGU), 1024, 0, (size_t)512 * 1024, L.tok};
    pg8::MoeOrder S{L.blk_e, nblk, 2, e.G, e.vcu};
    pg8::EpiSwiGLU E{(bf16*)(e.ws + WS_H)};
    pg8::gemm_phase<pg8::EpiSwiGLU, pg8::MoeOrder, true, true>(e.lds, g, S, E);
    grid_bar(e);
}
__device__ __forceinline__ void phase_moe_g2(unsigned char* lds_raw) {
    const Env e = penv(lds_raw);
    const MoeLists L = moe_lists(e.ws);
    const int nblk = __builtin_amdgcn_readfirstlane(L.blk_e[MOE_MAXBLK]);
    pg8::Gemm g{(const bf16*)(e.ws + WS_H), (const bf16*)(e.ws + WS_WD), 256, 0, (size_t)1024 * 256, nullptr};
    pg8::MoeOrder S{L.blk_e, nblk, 4, e.G, e.vcu};
    pg8::EpiDown E{(bf16*)(e.ws + WS_ROWS8), (bf16*)(e.ws + WS_XBF), L.dest, T_ * 8};
    pg8::gemm_phase<pg8::EpiDown, pg8::MoeOrder, true, false>(e.lds, g, S, E);
    grid_bar(e);
}
__device__ __forceinline__ void phase_moe_combine(unsigned char* lds_raw, int layer) {
    const Env e = penv(lds_raw);
    moe_combine_ln(e.out, (const bf16*)(e.ws + WS_ROWS8), (const bf16*)(e.ws + WS_XBF), (const float*)(e.ws + WS_RIDX) + (size_t)T_ * 8, e.tab->in[3] + layer * 1024, e.tab->in[4] + layer * 1024,
                   layer == 0 ? (bf16*)(e.ws + WS_XBF) : nullptr, e.gw, e.NGW, e.lane);
    grid_bar(e);
}

#define RUN(k, call) do { call; if (DUP_PHASE == (k)) { call; } } while (0)
#ifndef TIME_PHASE
#define TIME_PHASE -1
#endif
#define TIMED(k, call) do { unsigned long long _t0 = 0; if (TIME_PHASE == (k)) _t0 = __builtin_amdgcn_s_memrealtime(); call; \
    if (TIME_PHASE == (k) && blockIdx.x == 0 && threadIdx.x == 0) { const unsigned long long _t1 = __builtin_amdgcn_s_memrealtime(); unsigned* w_ = (unsigned*)((Tab*)(lds_raw + TAB_OFF))->ws + CW_PROBE + 8; *w_ = *w_ + (unsigned)(_t1 - _t0); } } while (0)
template <int layer> __device__ __forceinline__ void layer_body(unsigned char* lds_raw) {
#if defined(WITH_NAIVE)
    constexpr int ci = layer * 2;
#if defined(DBG_MIX0)
    constexpr bool naive_too = (layer == DBG_MIX0 - 1);
#else
    constexpr bool naive_too = false;
#endif
#endif
    RUN(1, phase_inproj_bf16(lds_raw, layer));
    if (layer == 0) { RUN(2, phase_mix0_a(lds_raw)); TIMED(20, phase_mix0_b(lds_raw)); RUN(3, phase_mix0_c(lds_raw)); }
    if (layer == 1) { RUN(4, phase_mix1_a(lds_raw)); TIMED(21, phase_mix1_b(lds_raw)); RUN(5, phase_mix1_c(lds_raw)); RUN(6, phase_glu(lds_raw)); }
#if defined(WITH_NAIVE)
    if (naive_too) {
        phase_inproj(lds_raw, layer);
        if (layer == 0) {
            run_naive<nv::ST_ML_GATES>(lds_raw, ci, 8L * NCH);
            run_naive<nv::ST_ML_CLOC>(lds_raw, ci, 8L * NCH * 16384);
            run_naive<nv::ST_ML_SCAN>(lds_raw, ci, 8L * 16384 + 8 * 128);
            run_naive<nv::ST_ML_MI>(lds_raw, ci, 8L * S_);
            run_naive<nv::ST_ML_SMAT>(lds_raw, ci, 8L * NCH * 4096);
            run_naive<nv::ST_ML_DEN>(lds_raw, ci, 8L * S_);
            run_naive<nv::ST_ML_H>(lds_raw, ci, 8L * S_ * 128);
            run_naive<nv::ST_ML_NORM>(lds_raw, ci, 8L * S_);
            run_naive<nv::ST_LRU_CONV>(lds_raw, ci, (long)T_ * 512);
            run_naive<nv::ST_LRU_GATE>(lds_raw, ci, (long)T_ * 512);
            run_naive<nv::ST_LRU_SCAN>(lds_raw, ci, 2L * 512);
        } else {
            run_naive<nv::ST_S5_PAR>(lds_raw, ci, 2048);
            for (int sl = 0; sl < S_ / nv::SLAB; ++sl) {
                if (threadIdx.x == 0) ((nv::Ctx*)(lds_raw + CTX_OFF))[ci].slab = sl;
                __syncthreads();
                run_naive<nv::ST_S5_SCAN>(lds_raw, ci, 2L * 2048); run_naive<nv::ST_S5_OUT>(lds_raw, ci, (long)nv::B_ * nv::SLAB * 512); }
            run_naive<nv::ST_S5_GLU>(lds_raw, ci, (long)T_ * 512);
            run_naive<nv::ST_GLA_GATE>(lds_raw, ci, (long)T_ * 256);
            run_naive<nv::ST_GLA_CUM>(lds_raw, ci, (long)nv::B_ * NCH * 256);
            run_naive<nv::ST_GLA_U>(lds_raw, ci, 8L * NCH * 8192);
            run_naive<nv::ST_GLA_SCAN>(lds_raw, ci, 8L * 8192);
            run_naive<nv::ST_GLA_ATT>(lds_raw, ci, 8L * NCH * 4096);
            run_naive<nv::ST_GLA_O>(lds_raw, ci, 8L * S_ * 128);
            run_naive<nv::ST_GLA_NORM>(lds_raw, ci, 8L * S_);
        }
        phase_probe(lds_raw, DBG_C0, DBG_C1);
        phase_cvt_mixed(lds_raw);
    }
#endif
    RUN(7, phase_outproj(lds_raw, layer));
    TIMED(22, phase_ln_router(lds_raw, layer)); if (DUP_PHASE == 22) phase_ln_router(lds_raw, layer, false);
    phase_moe_x1(lds_raw, layer); if (DUP_PHASE == 8) phase_moe_x1(lds_raw, layer, 1024);
    RUN(9, phase_moe_g1(lds_raw));
    RUN(10, phase_moe_g2(lds_raw));
    TIMED(24, phase_moe_combine(lds_raw, layer));
}
#if defined(STORE_TEST)
__device__ __forceinline__ void phase_store_test(unsigned char* lds_raw) {
    const Env e = penv(lds_raw);
    unsigned char* base = e.ws + WS_ROWS8 + (size_t)e.bid * (1u << 20);
    const int wr = e.wave >> 2, wc = e.wave & 3, fr = e.lane & 15, fq = e.lane >> 4;
    const v4u val = {(unsigned)e.tid, 1u, 2u, 3u};
    for (int u = 0; u < 40; ++u) {
#pragma unroll
        for (int s = 0; s < 8; ++s)
#pragma unroll
            for (int bj = 0; bj < 2; ++bj) {
#if STORE_TEST == 1
                const int r = (s >> 2) * 128 + wr * 64 + (s & 3) * 16 + fr; const int cb = wc * 64 + fq * 16 + bj * 256;
#elif STORE_TEST == 2
                const int r = (s >> 2) * 128 + wr * 64 + (s & 3) * 16 + bj * 8 + (e.lane >> 3); const int cb = wc * 128 + (e.lane & 7) * 16;
#else
                const int r = (s >> 2) * 128 + wr * 64 + (s & 3) * 16 + bj * 8 + (e.lane >> 4) * 2 + (wc & 1); const int cb = (wc >> 1) * 256 + (e.lane & 15) * 16;
#endif
                *(v4u*)(base + (size_t)((u & 1) * 256 + r) * 2048 + cb) = val; }
        asm volatile("" ::: "memory"); }
    grid_bar(e);
}
#endif
struct Args { const float* in[38]; float* out; unsigned char* ws; };
__global__ void __launch_bounds__(NTHREADS, 2) mega_fwd(Args a) {
    extern __shared__ __attribute__((aligned(16))) unsigned char lds_raw[];
    {
        LAS unsigned char* lds = (LAS unsigned char*)lds_raw;
        for (int u = threadIdx.x; u < (LDS_BYTES - LDS_CTL) / 4; u += NTHREADS) ((LAS unsigned*)(lds + LDS_CTL))[u] = 0u;
        __syncthreads();
        if (threadIdx.x == 0) {
            (void)xb_add((unsigned*)a.ws + 4096 + XB_XCNT(xb_xcc_id()), 1u);
            Tab* tab = (Tab*)(lds_raw + TAB_OFF);
#pragma unroll
            for (int i = 0; i < 38; ++i) { tab->in[i] = a.in[i]; if ((i & 7) == 7) asm volatile("" ::: "memory"); }
            tab->out = a.out; tab->ws = a.ws;
            asm volatile("" ::: "memory");
#if defined(WITH_NAIVE)
            nv::Ctx* const ctab = (nv::Ctx*)(lds_raw + CTX_OFF);
            const size_t scratch0 = (size_t)T_ * 1024 + (size_t)T_ * 64 + (size_t)T_ * 8 * 2;
#pragma unroll 1
            for (int layer = 0; layer < 2; ++layer) {
                nv::Ctx& c = ctab[layer * 2];
                nv::Mem M{(float*)(a.ws + WS_NAIVE), 0};
#pragma unroll 1
                for (int i = 0; i < 38; ++i) c.in[i] = tab->in[i];
                c.mixed = M.get((size_t)T_ * 1024); c.scores = M.get((size_t)T_ * 64);
                c.ridx = (int*)M.get((size_t)T_ * 8); c.rwt = M.get((size_t)T_ * 8);
                c.gR = nullptr; c.gBias = nullptr; c.slab = 0;
                c.layer = layer;
                c.hcur = layer == 0 ? a.in[0] : a.out;
                if (layer == 0) {
                    c.ldp = EINP; c.proj = M.get((size_t)T_ * c.ldp);
                    c.mb = M.get(8 * S_); c.mig = M.get(8 * S_); c.mblast = M.get(8 * NCH); c.mmloc = M.get(8 * NCH); c.mmprev = M.get(8 * NCH);
                    c.mmi = M.get(8 * S_); c.mwin = M.get(8 * S_); c.mden = M.get(8 * S_); c.nloc = M.get(8 * NCH * 128);
                    const size_t ov = M.off;
                    c.cloc = M.get((size_t)8 * NCH * 16384); c.smat = M.get((size_t)8 * NCH * 4096); c.htil = M.get((size_t)T_ * 512);
                    M.off = ov; c.lxc = M.get((size_t)T_ * 512); c.la = M.get((size_t)T_ * 512); c.lu = M.get((size_t)T_ * 512);
                } else {
                    c.ldp = OINP; c.proj = M.get((size_t)T_ * c.ldp);
                    c.s5ab = M.get(2048 * 2); c.s5bbr = M.get(2048 * 16); c.s5bbi = M.get(2048 * 16); c.s5st = M.get(2 * 2048 * 2);
                    c.s5x = M.get((size_t)nv::B_ * nv::SLAB * 2048 * 2); c.s5g = M.get((size_t)T_ * 512);
                    c.gla_la = M.get((size_t)T_ * 256); c.gla_bc = M.get((size_t)T_ * 256); c.gla_bl = M.get((size_t)nv::B_ * NCH * 256);
                    c.gu = M.get((size_t)8 * NCH * 8192); c.gatt = M.get((size_t)8 * NCH * 4096); c.go = M.get((size_t)T_ * 512);
                }
                c.z = c.proj; c.hout = a.out; c.lnw = a.in[1] + layer * 1024; c.lnb = a.in[2] + layer * 1024;
                M.off = scratch0; c.hid = M.get((size_t)T_ * 9 * 256);
                nv::Ctx& cm = ctab[layer * 2 + 1];
                cm = c; cm.hcur = a.out;
#ifdef DBG_LAYER
                if (layer == DBG_LAYER) { nv::Ctx& cd = ctab[4]; cd = cm;
                cd.hid = (float*)(a.ws + 48 * MiB); cd.z = (float*)(a.ws + 486 * MiB); cd.hcur = a.out + (size_t)DBG_T0 * 1024; cd.ridx = c.ridx + (size_t)DBG_T0 * 8; cd.rwt = c.rwt + (size_t)DBG_T0 * 8; }
#endif
            }
#endif
        }
        __syncthreads();
    }
    RUN(0, phase_p0(lds_raw));
    layer_body<0>(lds_raw);
    layer_body<1>(lds_raw);
#if defined(STORE_TEST)
    phase_store_test(lds_raw);
#endif
#if defined(DBG_MIX0)
    phase_probe_apply(lds_raw);
#endif
    if (TIME_PHASE >= 0) { const Env e = penv(lds_raw); const unsigned ticks = __hip_atomic_load((unsigned*)e.ws + CW_PROBE + 8, __ATOMIC_RELAXED, __HIP_MEMORY_SCOPE_AGENT);
        const float f = 1.0f + 0.0005f * (float)ticks * 0.01f;
        for (long i = e.gtid; i < (long)T_ * 1024; i += e.gsz) e.out[i] *= f; }
}
extern "C" void kernel_launch(void* const* d_in, const int* in_sizes, int n_in, void* d_out, int out_size, void* d_ws, size_t ws_size, hipStream_t stream) {
    static int grid = 0;
    if (grid == 0) {
        int dev = 0, cus = 0, per_cu = 0;
        hipGetDevice(&dev); hipDeviceGetAttribute(&cus, hipDeviceAttributeMultiprocessorCount, dev);
        hipFuncSetAttribute((const void*)mega_fwd, hipFuncAttributeMaxDynamicSharedMemorySize, LDS_BYTES);
        hipOccupancyMaxActiveBlocksPerMultiprocessor(&per_cu, (const void*)mega_fwd, NTHREADS, LDS_BYTES);
        (void)hipGetLastError();
        grid = (per_cu >= 1) ? cus : -1;
    }
    if (grid < 0) return;
    hipMemsetAsync(d_ws, 0, CTL_BYTES, stream);
    Args a{};
    for (int i = 0; i < 38; ++i) a.in[i] = (const float*)d_in[i];
    a.out = (float*)d_out; a.ws = (unsigned char*)d_ws;
    hipLaunchKernelGGL(mega_fwd, dim3(grid), dim3(NTHREADS), LDS_BYTES, stream, a);
}
```

```cpp
#define OPT_MIX0 1
#define OPT_MIX1 1
#define OPT_ROUTER 1
#include <hip/hip_runtime.h>
#define GAS __attribute__((address_space(1)))
#define LAS __attribute__((address_space(3)))
#define XB_TMO      128
#define XB_XCNT(j)  (256  + 64 * (j))
#define XB_XSUB(j)  (1280 + 64 * (j))
#define XB_XGEN(j)  (2304 + 64 * (j))
#define XB_TOP      3328
#define XB_TOPGEN   3392
#define XCD_BAR_WORDS 3456
#define XB_SPIN_CAP (1u << 22)
__device__ __forceinline__ unsigned xb_ld(unsigned* p)              { return __hip_atomic_load(p, __ATOMIC_RELAXED, __HIP_MEMORY_SCOPE_AGENT); }
__device__ __forceinline__ unsigned xb_add(unsigned* p, unsigned v) { return __hip_atomic_fetch_add(p, v, __ATOMIC_RELAXED, __HIP_MEMORY_SCOPE_AGENT); }
__device__ __forceinline__ unsigned xb_xcc_id() { return (unsigned)__builtin_amdgcn_s_getreg((3 << 11) | 20) & 0xFu; }
#define XB_SPIN(cond, bar) do { unsigned _sp = 0; while (cond) { __builtin_amdgcn_s_sleep(1); \
    if ((++_sp & 255u) == 0u) { if (xb_ld(&(bar)[XB_TMO])) break; if (_sp > XB_SPIN_CAP) { atomicAdd(&(bar)[XB_TMO], 1u); break; } } } } while (0)
struct XcdBarrier { unsigned* bar; unsigned x; volatile LAS unsigned* st; };
__device__ __forceinline__ XcdBarrier xcd_barrier_post(unsigned* bar, volatile LAS unsigned* st) {
    XcdBarrier b; b.bar = bar; b.x = xb_xcc_id(); b.st = st;
    if (threadIdx.x == 0) (void)xb_add(&bar[XB_XCNT(b.x)], 1u);
    return b;
}
__device__ __forceinline__ void xcd_barrier_complete(unsigned* bar, unsigned x, unsigned& nloc, unsigned& nx) {
    const unsigned G = gridDim.x * gridDim.y * gridDim.z;
    unsigned sum, cnt, mine, sp = 0u;
    for (;;) {
        sum = 0u; cnt = 0u; mine = 0u;
#pragma unroll
        for (unsigned j = 0; j < 16; ++j) { const unsigned c = xb_ld(&bar[XB_XCNT(j)]); sum += c; cnt += (c > 0u) ? 1u : 0u; mine = (j == x) ? c : mine; }
        if (sum == G) break;
        __builtin_amdgcn_s_sleep(1);
        if ((++sp & 255u) == 0u) { if (xb_ld(&bar[XB_TMO])) break; if (sp > XB_SPIN_CAP) { atomicAdd(&bar[XB_TMO], 1u); break; } }
    }
    nloc = mine > 0u ? mine : 1u; nx = cnt > 0u ? cnt : 1u;
}
__device__ __forceinline__ void xcd_barrier(const XcdBarrier& b) {
    asm volatile("s_waitcnt vmcnt(0)" ::: "memory");
    __syncthreads();
    if (threadIdx.x == 0) {
        unsigned* bar = b.bar;
        __builtin_amdgcn_s_waitcnt(0);
        unsigned nloc = b.st[0], nx = b.st[1];
        if (nloc == 0u) { xcd_barrier_complete(bar, b.x, nloc, nx); b.st[0] = nloc; b.st[1] = nx; }
        const unsigned old = xb_add(&bar[XB_XSUB(b.x)], 1u);
        const unsigned gen = old / nloc;
        if (old + 1u == (gen + 1u) * nloc) {
            __builtin_amdgcn_fence(__ATOMIC_RELEASE, "agent");
            asm volatile("s_waitcnt vmcnt(0)" ::: "memory");
            const unsigned og = xb_add(&bar[XB_TOP], 1u);
            const unsigned tg = og / nx;
            if (og + 1u == (tg + 1u) * nx) xb_add(&bar[XB_TOPGEN], 1u);
            else XB_SPIN(xb_ld(&bar[XB_TOPGEN]) == tg, bar);
            __builtin_amdgcn_fence(__ATOMIC_ACQUIRE, "agent");
            xb_add(&bar[XB_XGEN(b.x)], 1u);
            asm volatile("s_waitcnt vmcnt(0)" ::: "memory");
        } else {
            XB_SPIN(xb_ld(&bar[XB_XGEN(b.x)]) == gen, bar);
            __builtin_amdgcn_fence(__ATOMIC_ACQUIRE, "agent");
            asm volatile("s_waitcnt vmcnt(0)" ::: "memory");
        }
    }
    __syncthreads();
}
namespace pg8 {
#define PG8_LAS __attribute__((address_space(3)))
typedef unsigned short bf16_t;
typedef short bf16x8 __attribute__((ext_vector_type(8)));
typedef float f32x4 __attribute__((ext_vector_type(4)));
typedef unsigned u32x4 __attribute__((ext_vector_type(4)));
constexpr int BM = 256, BK = 64, HALF = 128, HTB = HALF * BK * 2, STAGE_BYTES = 8 * HTB, NXCD = 8, WGM = 8;
__host__ __device__ __forceinline__ int lds_byte(int r, int c) { const int st = (r >> 4) * 2 + (c >> 5), rr = r & 15, cc = c & 31, ob = rr * 64 + cc * 2; return st * 1024 + (ob ^ (((ob >> 9) & 1) << 5)); }
__host__ __device__ __forceinline__ void stage_rc(int b, int& R, int& C) { const int st = b / 1024, sb = b % 1024, swz = sb ^ (((sb >> 9) & 1) << 5); R = (st >> 1) * 16 + swz / 64; C = (st & 1) * 32 + (swz % 64) / 2; }
__host__ __device__ __forceinline__ int perm32(int rho) { const int n = rho >> 4, i = rho & 15; return 8 * (i >> 2) + 4 * n + (i & 3); }
struct Unit { int pm, pn, e, aux; };
struct Gemm { const bf16_t* A; const bf16_t* Bt; int K; int pad; size_t bstride; const int* rows; };
struct StaticOrder {
    int nM, nN, nwg, G, c;
    __host__ __device__ void init(int M, int N, int G_, int c_) { nM = M / BM; nN = N / BM; nwg = nM * nN; G = G_; c = c_; }
    __host__ __device__ bool next(int i, Unit& u) const {
        const long L = (long)i * G + c; if (L >= nwg) return false;
        int wgid = (int)L; { const int q = nwg / NXCD, r = nwg % NXCD, xcd = wgid % NXCD, off = wgid / NXCD; wgid = (xcd < r ? xcd * (q + 1) : r * (q + 1) + (xcd - r) * q) + off; }
        const int nig = WGM * nN, gid = wgid / nig, fm = gid * WGM, gsz = (nM - fm) < WGM ? (nM - fm) : WGM;
        u.pm = fm + ((wgid % nig) % gsz); u.pn = (wgid % nig) / gsz; u.e = 0; u.aux = 0; return true;
    }
};
__device__ __forceinline__ unsigned cvt_pk_bf16(float lo, float hi) { unsigned r; asm volatile("v_cvt_pk_bf16_f32 %0, %1, %2" : "=v"(r) : "v"(lo), "v"(hi)); return r; }
struct EpiF32R {
    static constexpr int NPRE = 0; __device__ __forceinline__ void load_pre(const Unit&, int, int, int (&)[1]) const {}
    static constexpr bool PERM = false;
    float* C; int ldc; const float* R; float ralpha;
    __device__ __forceinline__ void operator()(const f32x4 (&acc)[2][2][4][2], const Unit& u, int wr, int wc, int fr, int fq) const {
        const int row0 = u.pm * BM + wr * 64 + fr, col0 = u.pn * BM + wc * 32 + 4 * fq;
#pragma unroll
        for (int ai = 0; ai < 2; ++ai)
#pragma unroll
            for (int m = 0; m < 4; ++m) { const size_t off = (size_t)(row0 + ai * HALF + m * 16) * ldc + col0;
#pragma unroll
                for (int bj = 0; bj < 2; ++bj)
#pragma unroll
                    for (int n = 0; n < 2; ++n) { f32x4 v = acc[ai][bj][m][n]; if (R) v = v + ralpha * *(const f32x4*)(R + off + bj * HALF + n * 16); *(f32x4*)(C + off + bj * HALF + n * 16) = v; } }
    }
};
struct EpiBf16P {
    static constexpr int NPRE = 0; __device__ __forceinline__ void load_pre(const Unit&, int, int, int (&)[1]) const {}
    static constexpr bool PERM = true;
    bf16_t* O; int ldc;
    __device__ __forceinline__ void operator()(const f32x4 (&acc)[2][2][4][2], const Unit& u, int wr, int wc, int fr, int fq) const {
        const int row0 = u.pm * BM + wr * 64 + fr, col0 = u.pn * BM + wc * 32 + 8 * fq;
#pragma unroll
        for (int ai = 0; ai < 2; ++ai)
#pragma unroll
            for (int m = 0; m < 4; ++m) { bf16_t* rowp = O + (size_t)(row0 + ai * HALF + m * 16) * ldc + col0;
#pragma unroll
                for (int bj = 0; bj < 2; ++bj) { const f32x4 v0 = acc[ai][bj][m][0], v1 = acc[ai][bj][m][1];
                    u32x4 w; w.x = cvt_pk_bf16(v0[0], v0[1]); w.y = cvt_pk_bf16(v0[2], v0[3]); w.z = cvt_pk_bf16(v1[0], v1[1]); w.w = cvt_pk_bf16(v1[2], v1[3]);
                    *(u32x4*)(rowp + bj * HALF) = w; } }
    }
};
struct EpiGlu {
    static constexpr int NPRE = 0; __device__ __forceinline__ void load_pre(const Unit&, int, int, int (&)[1]) const {}
    static constexpr bool PERM = true;
    bf16_t* O; int ldo; const bf16_t* Gm; int ldg; const float* bias;
    __device__ __forceinline__ void operator()(const f32x4 (&acc)[2][2][4][2], const Unit& u, int wr, int wc, int fr, int fq) const {
        const int row0 = u.pm * BM + wr * 64 + fr, col0 = u.pn * BM + wc * 32 + 8 * fq;
#pragma unroll
        for (int ai = 0; ai < 2; ++ai)
#pragma unroll
            for (int m = 0; m < 4; ++m) { const size_t r = (size_t)(row0 + ai * HALF + m * 16);
#pragma unroll
                for (int bj = 0; bj < 2; ++bj) { const int c = col0 + bj * HALF;
                    const f32x4 b0 = *(const f32x4*)(bias + c), b1 = *(const f32x4*)(bias + c + 4); const u32x4 gv = *(const u32x4*)(Gm + r * ldg + c);
                    const f32x4 v0 = acc[ai][bj][m][0] + b0, v1 = acc[ai][bj][m][1] + b1;
                    float g[8] = {__builtin_bit_cast(float, gv.x << 16), __builtin_bit_cast(float, gv.x & 0xffff0000u), __builtin_bit_cast(float, gv.y << 16), __builtin_bit_cast(float, gv.y & 0xffff0000u),
                                  __builtin_bit_cast(float, gv.z << 16), __builtin_bit_cast(float, gv.z & 0xffff0000u), __builtin_bit_cast(float, gv.w << 16), __builtin_bit_cast(float, gv.w & 0xffff0000u)};
                    u32x4 w; w.x = cvt_pk_bf16(g[0] * __builtin_amdgcn_rcpf(1.f + __expf(-v0[0])), g[1] * __builtin_amdgcn_rcpf(1.f + __expf(-v0[1]))); w.y = cvt_pk_bf16(g[2] * __builtin_amdgcn_rcpf(1.f + __expf(-v0[2])), g[3] * __builtin_amdgcn_rcpf(1.f + __expf(-v0[3])));
                    w.z = cvt_pk_bf16(g[4] * __builtin_amdgcn_rcpf(1.f + __expf(-v1[0])), g[5] * __builtin_amdgcn_rcpf(1.f + __expf(-v1[1]))); w.w = cvt_pk_bf16(g[6] * __builtin_amdgcn_rcpf(1.f + __expf(-v1[2])), g[7] * __builtin_amdgcn_rcpf(1.f + __expf(-v1[3])));
                    *(u32x4*)(O + r * ldo + c) = w; } }
    }
};
template <class Epi, class Sched, bool ALIGN_EPI, bool GATHER>
__device__ __forceinline__ void gemm_phase(PG8_LAS unsigned char* lds, const Gemm g, const Sched& S, const Epi& E) {
    int tid_ = threadIdx.x; asm volatile("" : "+v"(tid_));
    const int tid = tid_, wid = __builtin_amdgcn_readfirstlane(tid >> 6), lane = tid & 63, wr = wid >> 2, wc = wid & 3, fr = lane & 15, fq = lane >> 4;
    const int K = g.K, nt = K / BK;
    unsigned voffA[2], voffB[2];
#pragma unroll
    for (int i = 0; i < 2; ++i) { int R, C; stage_rc(tid * 16 + i * 8192, R, C); const int Rb = Epi::PERM ? ((R & ~31) + perm32(R & 31)) : R;
        voffA[i] = (unsigned)(R * K + C) * 2u; voffB[i] = (unsigned)(Rb * K + C) * 2u; }
    const size_t kstep = (size_t)(BK * 2);
    const size_t hstep = (size_t)HALF * K * 2;
    const size_t tstep = 2 * hstep;
    const unsigned ldsw = (unsigned)wid * 1024u;
    const int aoff = lds_byte(wr * 64 + fr, fq * 8), boff = lds_byte(wc * 32 + fr, fq * 8);
#define PG8_SA(b, h) (((b) * 2 + (h)) * HTB)
#define PG8_SB(b, h) ((4 + (b) * 2 + (h)) * HTB)
#define PG8_STAGE(bufoff, gbase, voff) do { _Pragma("unroll") for (int _i = 0; _i < 2; ++_i) { unsigned _vo = (voff)[_i]; asm volatile("" : "+v"(_vo));   \
        __builtin_amdgcn_global_load_lds((const unsigned*)((const char*)(gbase) + _vo), (PG8_LAS unsigned*)(lds + (bufoff) + ldsw + _i * 8192), 16, 0, 0); } } while (0)
#define PG8_STAGE_A(bufoff, gbase, h, GV) do { if constexpr (GATHER) { PG8_STAGE(bufoff, gbase, GV[h]); } else { PG8_STAGE(bufoff, (gbase) + (h) * hstep, voffA); } } while (0)
#define PG8_STAGE_A2(bufoff, gbase, h) do { if constexpr (GATHER) { unsigned _gv[2] = {last ? gnxt[h][0] : gcur[h][0], last ? gnxt[h][1] : gcur[h][1]}; PG8_STAGE(bufoff, gbase, _gv); } else { PG8_STAGE(bufoff, (gbase) + (h) * hstep, voffA); } } while (0)
#define PG8_LDA(dst, b, h) do { _Pragma("unroll") for (int m = 0; m < 4; ++m) _Pragma("unroll") for (int k = 0; k < 2; ++k) dst[m][k] = *(const PG8_LAS bf16x8*)(lds + PG8_SA(b, h) + aoff + m * 2048 + k * 1024); } while (0)
#define PG8_LDB(dst, b, h) do { _Pragma("unroll") for (int n = 0; n < 2; ++n) _Pragma("unroll") for (int k = 0; k < 2; ++k) dst[n][k] = *(const PG8_LAS bf16x8*)(lds + PG8_SB(b, h) + boff + n * 2048 + k * 1024); } while (0)
#define PG8_MMA(ai, bj, At, Bt) do { __builtin_amdgcn_s_setprio(1); _Pragma("unroll") for (int m = 0; m < 4; ++m) _Pragma("unroll") for (int n = 0; n < 2; ++n) _Pragma("unroll") for (int k = 0; k < 2; ++k) \
        acc[ai][bj][m][n] = __builtin_amdgcn_mfma_f32_16x16x32_bf16(Bt[n][k], At[m][k], acc[ai][bj][m][n], 0, 0, 0); __builtin_amdgcn_s_setprio(0); } while (0)
#define PG8_WAIT_V(n) asm volatile("s_waitcnt vmcnt(" #n ")" ::: "memory")
#define PG8_WAIT_L(n) asm volatile("s_waitcnt lgkmcnt(" #n ")" ::: "memory")
#define PG8_BAR __builtin_amdgcn_s_barrier()
#define PG8_SCHED __builtin_amdgcn_sched_barrier(0)
#define PG8_GLOAD(GV, u) do { _Pragma("unroll") for (int _i = 0; _i < 2; ++_i) { int _R, _C; stage_rc(tid * 16 + _i * 8192, _R, _C); _Pragma("unroll") for (int _h = 0; _h < 2; ++_h) \
        GV[_h][_i] = (unsigned)g.rows[(u).pm * BM + _h * HALF + _R] * (unsigned)(K * 2) + (unsigned)(_C * 2); } } while (0)
    Unit cur, nxt; int ui = 0;
    if (!S.next(0, cur)) return;
    f32x4 acc[2][2][4][2];
#pragma unroll
    for (int a = 0; a < 2; ++a)
#pragma unroll
        for (int b = 0; b < 2; ++b)
#pragma unroll
            for (int m = 0; m < 4; ++m)
#pragma unroll
                for (int n = 0; n < 2; ++n) acc[a][b][m][n] = (f32x4){0.f, 0.f, 0.f, 0.f};
    bf16x8 At[4][2], B0[2][2], B1[2][2];
    unsigned gcur[2][2] = {{0u, 0u}, {0u, 0u}}, gnxt[2][2] = {{0u, 0u}, {0u, 0u}};
    if constexpr (Epi::NPRE > 0) E.prefetch(cur, 0, lds, wid, lane);
    if constexpr (GATHER) { PG8_GLOAD(gcur, cur); }
    const char* cA = GATHER ? (const char*)g.A : (const char*)g.A + (size_t)cur.pm * tstep;
    const char* cB = (const char*)g.Bt + ((size_t)cur.e * g.bstride) * 2 + (size_t)cur.pn * tstep;
    PG8_STAGE(PG8_SB(0, 0), cB, voffB); PG8_STAGE(PG8_SB(0, 1), cB + hstep, voffB); PG8_STAGE_A(PG8_SA(0, 0), cA, 0, gcur); PG8_STAGE_A(PG8_SA(0, 1), cA, 1, gcur);
    if (wr == 1) PG8_BAR;
    PG8_WAIT_V(2); PG8_BAR;
    PG8_STAGE(PG8_SB(1, 0), cB + kstep, voffB); PG8_STAGE_A(PG8_SA(1, 0), cA + kstep, 0, gcur); PG8_STAGE(PG8_SB(1, 1), cB + hstep + kstep, voffB);
    PG8_WAIT_V(6); PG8_BAR;
    for (;;) {
        const bool has_next = S.next(ui + 1, nxt);
        if constexpr (Epi::NPRE > 0) { if (has_next) E.prefetch(nxt, (ui + 1) % 3, lds, wid, lane); }
        if constexpr (GATHER) { if (has_next) { PG8_GLOAD(gnxt, nxt); } else {
#pragma unroll
            for (int _h = 0; _h < 2; ++_h)
#pragma unroll
                for (int _i = 0; _i < 2; ++_i) gnxt[_h][_i] = gcur[_h][_i]; } }
        const char* nA = GATHER ? cA : (has_next ? (const char*)g.A + (size_t)nxt.pm * tstep : cA);
        const char* nB = has_next ? (const char*)g.Bt + ((size_t)nxt.e * g.bstride) * 2 + (size_t)nxt.pn * tstep : cB;
#pragma unroll 1
        for (int t = 0; t < nt; t += 2) {
            const bool last = (t == nt - 2);
            const char* a1 = cA + (size_t)(t + 1) * kstep;
            const char* a2 = last ? nA : cA + (size_t)(t + 2) * kstep; const char* b2 = last ? nB : cB + (size_t)(t + 2) * kstep;
            const char* a3 = a2 + kstep; const char* b3 = b2 + kstep;
            PG8_LDB(B0, 0, 0); PG8_LDB(B1, 0, 1); PG8_SCHED; PG8_LDA(At, 0, 0); PG8_STAGE_A(PG8_SA(1, 1), a1, 1, gcur);
            PG8_WAIT_V(8); PG8_WAIT_L(0); PG8_BAR; PG8_MMA(0, 0, At, B0); PG8_MMA(0, 1, At, B1); PG8_BAR; PG8_SCHED;
            PG8_LDA(At, 0, 1); PG8_STAGE(PG8_SB(0, 0), b2, voffB); PG8_STAGE(PG8_SB(0, 1), b2 + hstep, voffB); PG8_STAGE_A2(PG8_SA(0, 0), a2, 0);
            PG8_WAIT_V(8); PG8_WAIT_L(0); PG8_BAR; PG8_MMA(1, 0, At, B0); PG8_MMA(1, 1, At, B1); PG8_BAR; PG8_SCHED;
            PG8_LDB(B0, 1, 0); PG8_LDB(B1, 1, 1); PG8_SCHED; PG8_LDA(At, 1, 0); PG8_STAGE_A2(PG8_SA(0, 1), a2, 1);
            PG8_WAIT_V(8); PG8_WAIT_L(0); PG8_BAR; PG8_MMA(0, 0, At, B0); PG8_MMA(0, 1, At, B1); PG8_BAR; PG8_SCHED;
            PG8_LDA(At, 1, 1); PG8_STAGE(PG8_SB(1, 0), b3, voffB); PG8_STAGE(PG8_SB(1, 1), b3 + hstep, voffB); PG8_STAGE_A2(PG8_SA(1, 0), a3, 0);
            PG8_WAIT_V(8); PG8_WAIT_L(0); PG8_BAR; PG8_MMA(1, 0, At, B0); PG8_MMA(1, 1, At, B1); PG8_BAR; PG8_SCHED;
        }
        if constexpr (ALIGN_EPI) { if (wr == 0) PG8_BAR; }
        if constexpr (Epi::NPRE > 0) E(acc, cur, wr, wc, fr, fq, ui % 3, lds); else E(acc, cur, wr, wc, fr, fq);
        if (!has_next) break;
#pragma unroll
        for (int a = 0; a < 2; ++a)
#pragma unroll
            for (int b = 0; b < 2; ++b)
#pragma unroll
                for (int m = 0; m < 4; ++m)
#pragma unroll
                    for (int n = 0; n < 2; ++n) acc[a][b][m][n] = (f32x4){0.f, 0.f, 0.f, 0.f};
        cur = nxt; cA = nA; cB = nB; ++ui;
        if constexpr (GATHER) {
#pragma unroll
            for (int _h = 0; _h < 2; ++_h)
#pragma unroll
                for (int _i = 0; _i < 2; ++_i) gcur[_h][_i] = gnxt[_h][_i]; }
        if constexpr (ALIGN_EPI) { if (wr == 1) PG8_BAR; }
    }
    PG8_WAIT_V(0);
    if constexpr (!ALIGN_EPI) { if (wr == 0) PG8_BAR; }
    PG8_BAR;
#undef PG8_SA
#undef PG8_SB
#undef PG8_STAGE
#undef PG8_STAGE_A
#undef PG8_STAGE_A2
#undef PG8_LDA
#undef PG8_LDB
#undef PG8_MMA
#undef PG8_WAIT_V
#undef PG8_WAIT_L
#undef PG8_BAR
#undef PG8_SCHED
#undef PG8_GLOAD
}
}
typedef unsigned short bf16;
typedef unsigned v4u __attribute__((ext_vector_type(4)));
typedef unsigned v2u __attribute__((ext_vector_type(2)));
typedef float f32x4 __attribute__((ext_vector_type(4)));
constexpr int NTHREADS = 512, NWAVES = 8;
constexpr int LDS_BYTES = 163840;
constexpr int LDS_CTL = 155648;
constexpr int MISC_OFF = LDS_CTL + 320;
constexpr size_t MiB = 1u << 20;
constexpr size_t CTL_BYTES = 1 * MiB;
#if !defined(WITH_NAIVE)
namespace nv { constexpr int B_ = 2, S_ = 8192, T_ = B_ * S_, NCH = S_ / 64, EIN = 3080, OIN = 2064; constexpr float ALPHA = 1.41421356237309515f, EPS = 1e-5f; struct Mem { float* base; size_t off; }; }
#endif
constexpr int T_ = nv::T_, S_ = nv::S_, NCH = nv::NCH;
constexpr int EINP = 3328, OINP = 2304;
#define LDS_WAIT() asm volatile("s_waitcnt lgkmcnt(0)" ::: "memory")
typedef __bf16 hwbf2_t __attribute__((ext_vector_type(2)));
typedef float hwf2_t __attribute__((ext_vector_type(2)));
__device__ __forceinline__ unsigned f2bf(float f) { const __bf16 b = (__bf16)f; return (unsigned)__builtin_bit_cast(unsigned short, b); }
__device__ __forceinline__ unsigned pk2(float lo, float hi) { const hwf2_t v = {lo, hi}; return __builtin_bit_cast(unsigned, __builtin_convertvector(v, hwbf2_t)); }
__device__ __forceinline__ float bf2f(unsigned short b) { return __builtin_bit_cast(float, (unsigned)b << 16); }
__device__ __forceinline__ void tr_item(const float* W, long ldw, int nvalid, bf16* dst, long ldd, LAS float* scr, int lane) {
#pragma unroll 8
    for (int i = 0; i < 32; ++i) { const int kk = 2 * i + (lane >> 5), nn = lane & 31; scr[kk * 33 + nn] = nn < nvalid ? W[(long)kk * ldw + nn] : 0.f; }
    LDS_WAIT(); asm volatile("" ::: "memory");
    const int c = lane & 7;
#pragma unroll
    for (int j = 0; j < 4; ++j) { const int n = (lane >> 3) + 8 * j; const LAS float* s = scr + (8 * c) * 33 + n;
        v4u o; o.x = pk2(s[0 * 33], s[1 * 33]); o.y = pk2(s[2 * 33], s[3 * 33]); o.z = pk2(s[4 * 33], s[5 * 33]); o.w = pk2(s[6 * 33], s[7 * 33]);
        *(v4u*)(dst + (long)n * ldd + 8 * c) = o; }
    LDS_WAIT(); asm volatile("" ::: "memory");
}
__device__ __forceinline__ void tr_item64(const float* W, long ldw, int nvalid, bf16* dst, long ldd, LAS float* scr, int lane) {
    const int nn = (lane & 15) * 4;
#pragma unroll
    for (int i = 0; i < 16; ++i) { const int kk = 4 * i + (lane >> 4);
        f32x4 v = {0.f, 0.f, 0.f, 0.f}; if (nn < nvalid) v = *(const f32x4*)(W + (long)kk * ldw + nn);
        LAS float* s = scr + kk * 65 + nn; s[0] = v.x; s[1] = v.y; s[2] = v.z; s[3] = v.w; }
    LDS_WAIT(); asm volatile("" ::: "memory");
    const int c = lane & 7;
#pragma unroll
    for (int j = 0; j < 8; ++j) { const int n = (lane >> 3) + 8 * j; const LAS float* s = scr + (8 * c) * 65 + n;
        v4u o; o.x = pk2(s[0 * 65], s[1 * 65]); o.y = pk2(s[2 * 65], s[3 * 65]); o.z = pk2(s[4 * 65], s[5 * 65]); o.w = pk2(s[6 * 65], s[7 * 65]);
        *(v4u*)(dst + (long)n * ldd + 8 * c) = o; }
    LDS_WAIT(); asm volatile("" ::: "memory");
}
__device__ __forceinline__ void tr_matrix(const float* W, int K, int N, int NP, bf16* WT, LAS float* scr, int gw, int NGW, int lane) {
    const int nblk = NP / 64, nitems = (K / 64) * nblk;
    for (int it = gw; it < nitems; it += NGW) { const int kb = it / nblk, nb = it % nblk, k0 = 64 * kb, n0 = 64 * nb; int nvalid = N - n0; nvalid = nvalid < 0 ? 0 : (nvalid > 64 ? 64 : nvalid);
        tr_item64(W + (long)k0 * N + n0, N, nvalid, WT + (long)n0 * K + k0, K, scr, lane); }
}
__device__ __forceinline__ void tr_matrix_item(const float* W, int K, int N, int NP, bf16* WT, LAS float* scr, int it, int lane) {
    const int nblk = NP / 64, kb = it / nblk, nb = it % nblk, k0 = 64 * kb, n0 = 64 * nb; int nvalid = N - n0; nvalid = nvalid < 0 ? 0 : (nvalid > 64 ? 64 : nvalid);
    tr_item64(W + (long)k0 * N + n0, N, nvalid, WT + (long)n0 * K + k0, K, scr, lane);
}
__device__ __forceinline__ void cvt_rows(const float* src, bf16* dst, long n, long gtid, long gsz) {
    long i = gtid * 8;
    for (; i + 3 * gsz * 8 < n; i += 4 * gsz * 8) {
        f32x4 a[4], b[4];
#pragma unroll
        for (int u = 0; u < 4; ++u) { a[u] = *(const f32x4*)(src + i + u * gsz * 8); b[u] = *(const f32x4*)(src + i + u * gsz * 8 + 4); }
#pragma unroll
        for (int u = 0; u < 4; ++u) { v4u o; o.x = pk2(a[u].x, a[u].y); o.y = pk2(a[u].z, a[u].w); o.z = pk2(b[u].x, b[u].y); o.w = pk2(b[u].z, b[u].w); *(v4u*)(dst + i + u * gsz * 8) = o; } }
    for (; i < n; i += gsz * 8) { const f32x4 a = *(const f32x4*)(src + i), b = *(const f32x4*)(src + i + 4);
        v4u o; o.x = pk2(a.x, a.y); o.y = pk2(a.z, a.w); o.z = pk2(b.x, b.y); o.w = pk2(b.z, b.w); *(v4u*)(dst + i) = o; }
}
__device__ __forceinline__ int sopaque(int v) { asm volatile("" : "+s"(v)); return v; }
__device__ __forceinline__ float wave_sum(float v) {
#define WS_STEP(o) v += __builtin_bit_cast(float, __builtin_amdgcn_ds_swizzle(__builtin_bit_cast(int, v), 0x1f | ((o) << 10)))
    WS_STEP(1); WS_STEP(2); WS_STEP(4); WS_STEP(8); WS_STEP(16);
#undef WS_STEP
    return __builtin_bit_cast(float, __builtin_amdgcn_readlane(__builtin_bit_cast(int, v), 0)) + __builtin_bit_cast(float, __builtin_amdgcn_readlane(__builtin_bit_cast(int, v), 32));
}
#ifndef DBG_SCALE
#define DBG_SCALE 20.0f
#endif
constexpr int MOE_MAXBLK = 640;
constexpr int CW_CNT = 8192, CW_CUR = 8192 + 128;
namespace pg8 {
struct MoeOrder {
    const int* blk_e; int nblk, npn, G, c;
    __device__ __forceinline__ bool next(int i, Unit& u) const {
        const long L = (long)i * G + c; if (L >= (long)nblk * npn) return false;
        const int blk = (int)(L / npn); u.pm = blk; u.pn = (int)(L % npn); u.e = __builtin_amdgcn_readfirstlane(blk_e[blk]); u.aux = 0; return true;
    }
};
__device__ __forceinline__ float silu_f(float x) { return x * __builtin_amdgcn_rcpf(1.0f + __expf(-x)); }
struct EpiSwiGLU {
    static constexpr int NPRE = 0; __device__ __forceinline__ void load_pre(const Unit&, int, int, int (&)[1]) const {}
    static constexpr bool PERM = true;
    bf16_t* H;
    __device__ __forceinline__ void operator()(const f32x4 (&acc)[2][2][4][2], const Unit& u, int wr, int wc, int fr, int fq) const {
        const int row0 = u.pm * BM + wr * 64 + fr, col0 = u.pn * 128 + wc * 32 + 8 * fq;
#pragma unroll
        for (int ai = 0; ai < 2; ++ai)
#pragma unroll
            for (int m = 0; m < 4; ++m) { bf16_t* rowp = H + (size_t)(row0 + ai * HALF + m * 16) * 256 + col0;
                const f32x4 g0 = acc[ai][0][m][0], g1 = acc[ai][0][m][1], u0 = acc[ai][1][m][0], u1 = acc[ai][1][m][1];
                u32x4 w; w.x = cvt_pk_bf16(silu_f(g0[0]) * u0[0], silu_f(g0[1]) * u0[1]); w.y = cvt_pk_bf16(silu_f(g0[2]) * u0[2], silu_f(g0[3]) * u0[3]);
                w.z = cvt_pk_bf16(silu_f(g1[0]) * u1[0], silu_f(g1[1]) * u1[1]); w.w = cvt_pk_bf16(silu_f(g1[2]) * u1[2], silu_f(g1[3]) * u1[3]);
                *(u32x4*)rowp = w; }
    }
};
struct EpiDown {
    static constexpr bool PERM = true; static constexpr int NPRE = 1;
    bf16_t* rows8; bf16_t* rows_sh; const int* dest; int nslot8;
    __device__ __forceinline__ void prefetch(const Unit& u, int slot, PG8_LAS unsigned char* lds, int wid, int lane) const {
        if (wid < 4) __builtin_amdgcn_global_load_lds((const unsigned*)(dest + u.pm * BM + wid * 64 + lane), (PG8_LAS unsigned*)(lds + STAGE_BYTES + slot * 1024 + wid * 256), 4, 0, 0);
    }
    __device__ __forceinline__ void operator()(const f32x4 (&acc)[2][2][4][2], const Unit& u, int wr, int wc, int fr, int fq, int slot, PG8_LAS unsigned char* lds) const {
        const int col0 = u.pn * BM + wc * 32 + 8 * fq; const PG8_LAS int* dl = (const PG8_LAS int*)(lds + STAGE_BYTES + slot * 1024) + wr * 64 + fr;
#pragma unroll
        for (int ai = 0; ai < 2; ++ai)
#pragma unroll
            for (int m = 0; m < 4; ++m) { const int d = dl[ai * HALF + m * 16];
                if (d >= 0) { bf16_t* rowp = (d < nslot8 ? rows8 + (size_t)d * 1024 : rows_sh + (size_t)(d - nslot8) * 1024) + col0;
#pragma unroll
                    for (int bj = 0; bj < 2; ++bj) { const f32x4 v0 = acc[ai][bj][m][0], v1 = acc[ai][bj][m][1];
                        u32x4 o; o.x = cvt_pk_bf16(v0[0], v0[1]); o.y = cvt_pk_bf16(v0[2], v0[3]); o.z = cvt_pk_bf16(v1[0], v1[1]); o.w = cvt_pk_bf16(v1[2], v1[3]);
#if defined(NT_STORES)
                        __builtin_nontemporal_store(o, (u32x4*)(rowp + bj * HALF));
#else
                        *(u32x4*)(rowp + bj * HALF) = o;
#endif
                        } } }
    }
};
}
__device__ __forceinline__ void moe_convert_weights(const float* wg, const float* wu, const float* wd, const float* sg, const float* su, const float* sd,
                                                    bf16* WGU, bf16* WD, LAS float* scr, int first, int last, int stride, int lane) {
    for (int it = first; it < last; it += stride) {
        const int e = it / 192, r = it % 192, kind = r >> 6, q = r & 63;
        if (kind < 2) { const float* W = (e < 64 ? (kind == 0 ? wg : wu) + (size_t)e * 262144 : (kind == 0 ? sg : su));
            const int kb = q >> 2, nb = q & 3, k0 = 64 * kb, n0 = 64 * nb;
            tr_item64(W + (size_t)k0 * 256 + n0, 256, 64, WGU + ((size_t)e * 512 + (n0 >> 7) * 256 + (n0 & 127) + kind * 128) * 1024 + k0, 1024, scr, lane);
        } else { const float* W = e < 64 ? wd + (size_t)e * 262144 : sd;
            const int kb = q >> 4, nb = q & 15, k0 = 64 * kb, n0 = 64 * nb;
            tr_item64(W + (size_t)k0 * 1024 + n0, 1024, 64, WD + ((size_t)e * 1024 + n0) * 256 + k0, 256, scr, lane); }
    }
}
struct MoeLists { int* tok; int* dest; float* w; int* blk_e; };
__device__ __forceinline__ void moe_count(const int* ridx, unsigned* cnt, LAS unsigned* hist, int tid, int bid, int G) {
    if (tid < 64) hist[tid] = 0u;
    __syncthreads();
    for (int i = bid * NTHREADS + tid; i < T_ * 8; i += G * NTHREADS) atomicAdd((unsigned*)&hist[ridx[i]], 1u);
    __syncthreads();
    if (tid < 64 && hist[tid]) atomicAdd(&cnt[tid], hist[tid]);
    __syncthreads();
}
__device__ __forceinline__ void moe_build_lists(const int* ridx, const float* rwt, const unsigned* cnt, unsigned* cur, const MoeLists L, LAS int* sm, int tid, int bid, int G) {
    LAS int* pstart = sm; LAS unsigned* hist = (LAS unsigned*)(sm + 80); LAS unsigned* base = (LAS unsigned*)(sm + 160);
    if (tid == 0) { int acc = 0;
#pragma unroll 1
        for (int e = 0; e < 64; ++e) { pstart[e] = acc; acc += ((int)__hip_atomic_load(&cnt[e], __ATOMIC_RELAXED, __HIP_MEMORY_SCOPE_AGENT) + 255) & ~255; } pstart[64] = acc; pstart[65] = acc + T_; }
    __syncthreads();
    const int per = (T_ * 8 + G - 1) / G;
    const int lo = bid * per, hi = (lo + per < T_ * 8) ? lo + per : T_ * 8;
    for (int c0 = lo; c0 < hi; c0 += NTHREADS) {
        if (tid < 64) hist[tid] = 0u;
        __syncthreads();
        const int i = c0 + tid; int e = 0; unsigned local = 0u;
        if (i < hi) { e = ridx[i]; local = atomicAdd((unsigned*)&hist[e], 1u); }
        __syncthreads();
        if (tid < 64) base[tid] = hist[tid] ? atomicAdd(&cur[tid], hist[tid]) : 0u;
        __syncthreads();
        if (i < hi) { const int pos = pstart[e] + (int)base[e] + (int)local; L.tok[pos] = i >> 3; L.dest[pos] = i; L.w[pos] = rwt[i]; }
        __syncthreads();
    }
    for (int e = bid; e < 64; e += G) { const int c = (int)__hip_atomic_load(&cnt[e], __ATOMIC_RELAXED, __HIP_MEMORY_SCOPE_AGENT);
        for (int p = pstart[e] + c + tid; p < pstart[e + 1]; p += NTHREADS) { L.tok[p] = 0; L.dest[p] = -1; L.w[p] = 0.f; } }
    for (int t = bid * NTHREADS + tid; t < T_; t += G * NTHREADS) { const int p = pstart[64] + t; L.tok[p] = t; L.dest[p] = T_ * 8 + t; L.w[p] = 1.f; }
    const int nblk = pstart[65] >> 8;
    for (int b = bid * NTHREADS + tid; b < nblk; b += G * NTHREADS) { int e = 0;
#pragma unroll 1
        while (e < 64 && (pstart[e + 1] >> 8) <= b) ++e;
        L.blk_e[b] = e; }
    if (bid == 0 && tid == 0) L.blk_e[MOE_MAXBLK] = nblk;
    __syncthreads();
}
__device__ __forceinline__ void moe_combine_ln(float* h, const bf16* rows8, const bf16* rows_sh, const float* rwt, const float* lw, const float* lb, bf16* hbf, int gw, int NGW, int lane) {
    int t = gw; if (t >= T_) return;
    v4u rr[2][9]; f32x4 hh[4]; float wk[8];
#define CB_LOAD(tt) do { const size_t _t = (size_t)(tt); \
        _Pragma("unroll") for (int half = 0; half < 2; ++half) { const int c0 = half * 512 + lane * 8; \
            hh[half * 2] = *(const f32x4*)(h + _t * 1024 + c0); hh[half * 2 + 1] = *(const f32x4*)(h + _t * 1024 + c0 + 4); \
            _Pragma("unroll") for (int k = 0; k < 9; ++k) rr[half][k] = *(const v4u*)((k < 8 ? rows8 + (_t * 8 + k) * 1024 : rows_sh + _t * 1024) + c0); } \
        _Pragma("unroll") for (int k = 0; k < 8; ++k) wk[k] = rwt[_t * 8 + k]; } while (0)
    CB_LOAD(t);
    for (; t < T_; t += NGW) {
        float v[16];
#pragma unroll
        for (int half = 0; half < 2; ++half) { const f32x4 a = hh[half * 2], b = hh[half * 2 + 1];
            float s[8] = {a.x * nv::ALPHA, a.y * nv::ALPHA, a.z * nv::ALPHA, a.w * nv::ALPHA, b.x * nv::ALPHA, b.y * nv::ALPHA, b.z * nv::ALPHA, b.w * nv::ALPHA};
#pragma unroll
            for (int k = 0; k < 9; ++k) { const v4u r = rr[half][k]; const float w = k < 8 ? wk[k] : 1.0f;
                s[0] += w * __builtin_bit_cast(float, r.x << 16); s[1] += w * __builtin_bit_cast(float, r.x & 0xffff0000u);
                s[2] += w * __builtin_bit_cast(float, r.y << 16); s[3] += w * __builtin_bit_cast(float, r.y & 0xffff0000u);
                s[4] += w * __builtin_bit_cast(float, r.z << 16); s[5] += w * __builtin_bit_cast(float, r.z & 0xffff0000u);
                s[6] += w * __builtin_bit_cast(float, r.w << 16); s[7] += w * __builtin_bit_cast(float, r.w & 0xffff0000u); }
#pragma unroll
            for (int j = 0; j < 8; ++j) v[half * 8 + j] = s[j]; }
        if (t + NGW < T_) CB_LOAD(t + NGW);
        float sum = 0.f;
#pragma unroll
        for (int j = 0; j < 16; ++j) sum += v[j];
        sum = wave_sum(sum);
        const float mean = sum * (1.f / 1024.f);
        float sq = 0.f;
#pragma unroll
        for (int j = 0; j < 16; ++j) { v[j] -= mean; sq += v[j] * v[j]; }
        sq = wave_sum(sq);
        const float rstd = 1.0f / sqrtf(sq * (1.f / 1024.f) + nv::EPS);
#pragma unroll
        for (int half = 0; half < 2; ++half) { const int c0 = half * 512 + lane * 8;
            const f32x4 w0 = *(const f32x4*)(lw + c0), w1 = *(const f32x4*)(lw + c0 + 4), b0 = *(const f32x4*)(lb + c0), b1 = *(const f32x4*)(lb + c0 + 4);
            f32x4 o0, o1;
            o0.x = v[half * 8 + 0] * rstd * w0.x + b0.x; o0.y = v[half * 8 + 1] * rstd * w0.y + b0.y; o0.z = v[half * 8 + 2] * rstd * w0.z + b0.z; o0.w = v[half * 8 + 3] * rstd * w0.w + b0.w;
            o1.x = v[half * 8 + 4] * rstd * w1.x + b1.x; o1.y = v[half * 8 + 5] * rstd * w1.y + b1.y; o1.z = v[half * 8 + 6] * rstd * w1.z + b1.z; o1.w = v[half * 8 + 7] * rstd * w1.w + b1.w;
            *(f32x4*)(h + (size_t)t * 1024 + c0) = o0; *(f32x4*)(h + (size_t)t * 1024 + c0 + 4) = o1;
            if (hbf) { v4u p; p.x = pk2(o0.x, o0.y); p.y = pk2(o0.z, o0.w); p.z = pk2(o1.x, o1.y); p.w = pk2(o1.z, o1.w); *(v4u*)(hbf + (size_t)t * 1024 + c0) = p; } }
    }
#undef CB_LOAD
}
typedef float f32x16 __attribute__((ext_vector_type(16)));
typedef short s16x8 __attribute__((ext_vector_type(8)));
typedef LAS unsigned short lbf16;
__device__ __forceinline__ void mm32(f32x16& acc, const lbf16* A, int lda, const lbf16* B, int ldb, int K, int lane) {
    const lbf16* ap = A + (lane & 31) * lda + 8 * (lane >> 5);
    const lbf16* bp = B + (lane & 31) * ldb + 8 * (lane >> 5);
#pragma unroll 4
    for (int k = 0; k < K; k += 16) {
        const s16x8 a = *(const LAS s16x8*)(ap + k), b = *(const LAS s16x8*)(bp + k);
        acc = __builtin_amdgcn_mfma_f32_32x32x16_bf16(a, b, acc, 0, 0, 0);
    }
}
__device__ __forceinline__ void mm32_gb(f32x16& acc, const lbf16* A, int lda, const bf16* B, int ldb, int K, int lane) {
    const lbf16* ap = A + (lane & 31) * lda + 8 * (lane >> 5);
    const bf16* bp = B + (size_t)(lane & 31) * ldb + 8 * (lane >> 5);
#pragma unroll 4
    for (int k = 0; k < K; k += 16) {
        const s16x8 a = *(const LAS s16x8*)(ap + k), b = *(const s16x8*)(bp + k);
        acc = __builtin_amdgcn_mfma_f32_32x32x16_bf16(a, b, acc, 0, 0, 0);
    }
}
__device__ __forceinline__ int rowmap(int r, int lane) { return (r & 3) + 8 * (r >> 2) + 4 * (lane >> 5); }
__device__ __forceinline__ float rcp_f(float x) { return __builtin_amdgcn_rcpf(x); }
__device__ __forceinline__ float sigm_f(float x) { return rcp_f(1.0f + __expf(-x)); }
__device__ __forceinline__ float logsig_f(float x) { return fminf(x, 0.f) - __logf(1.0f + __expf(-fabsf(x))); }
__device__ __forceinline__ float softplus_f(float x) { return fmaxf(x, 0.f) + __logf(1.0f + __expf(-fabsf(x))); }
__device__ __forceinline__ float gelu_f(float x) { const float u = 0.7978845608028654f * (x + 0.044715f * x * x * x); return x * rcp_f(1.0f + __expf(-2.0f * u)); }
__device__ __forceinline__ void unpack8(const v4u r, float (&f)[8]) {
    f[0] = __builtin_bit_cast(float, r.x << 16); f[1] = __builtin_bit_cast(float, r.x & 0xffff0000u); f[2] = __builtin_bit_cast(float, r.y << 16); f[3] = __builtin_bit_cast(float, r.y & 0xffff0000u);
    f[4] = __builtin_bit_cast(float, r.z << 16); f[5] = __builtin_bit_cast(float, r.z & 0xffff0000u); f[6] = __builtin_bit_cast(float, r.w << 16); f[7] = __builtin_bit_cast(float, r.w & 0xffff0000u);
}
__device__ __forceinline__ v4u pack8(const float (&f)[8]) { v4u o; o.x = pk2(f[0], f[1]); o.y = pk2(f[2], f[3]); o.z = pk2(f[4], f[5]); o.w = pk2(f[6], f[7]); return o; }

struct Mix0Bufs { const bf16* proj; bf16* ct; float* nloc; float* blast; float* mloc; float* mprev; float* hloc; float* pc; float* carA; float* carU; float* carI; float* gst; bf16* mixbf; const bf16* lruw; };
constexpr int PJ0 = EINP;
__device__ __forceinline__ float lane_shr(float v, int o, int lane) { return __builtin_bit_cast(float, __builtin_amdgcn_ds_bpermute(((lane - o) & 63) << 2, __builtin_bit_cast(int, v))); }
__device__ __forceinline__ float wave_scan_add(float v, int lane) {
#pragma unroll
    for (int o = 1; o < 64; o <<= 1) { const float t = lane_shr(v, o, lane); v += (lane >= o) ? t : 0.f; }
    return v; }
__device__ __forceinline__ float wave_scan_max(float v, int lane) {
#pragma unroll
    for (int o = 1; o < 64; o <<= 1) { const float t = lane_shr(v, o, lane); v = (lane >= o) ? fmaxf(v, t) : v; }
    return v; }

__device__ __forceinline__ void mlstm_a_item(const Mix0Bufs& B, const float* gate_b, int cn, LAS unsigned char* lds, int tid) {
    const int lane = tid & 63, wave = __builtin_amdgcn_readfirstlane(tid >> 6);
    const int bh = cn / NCH, n = cn % NCH, b = bh >> 2, h = bh & 3;
    const size_t t0 = (size_t)b * S_ + n * 64;
    LAS float* pw = (LAS float*)lds;
    lbf16* kT = (lbf16*)(lds + 1024); lbf16* vT = (lbf16*)(lds + 1024 + 128 * 72 * 2);
    v4u gk[2], gv[2];
#pragma unroll
    for (int it = 0; it < 2; ++it) { const int vi = tid + it * 512, l = vi & 63, g = vi >> 6; const bf16* pr = B.proj + (t0 + l) * PJ0 + h * 128 + g * 8; gk[it] = *(const v4u*)(pr + 512); gv[it] = *(const v4u*)(pr + 1024); }
    if (wave == 0) { const bf16* pr = B.proj + (t0 + lane) * PJ0;
        const float lfv = logsig_f(bf2f(pr[2052 + h]) + gate_b[4 + h]), ig = bf2f(pr[2048 + h]) + gate_b[h];
        const float bcv = wave_scan_add(lfv, lane), wlv = ig - bcv, pmv = wave_scan_max(wlv, lane);
        const float blast = __builtin_bit_cast(float, __builtin_amdgcn_readlane(__builtin_bit_cast(int, bcv), 63)), mx = __builtin_bit_cast(float, __builtin_amdgcn_readlane(__builtin_bit_cast(int, pmv), 63));
        pw[lane] = __expf(wlv - mx) * 0.08838834764831845f;
        float* gs = B.gst + (size_t)cn * 192; gs[lane] = bcv; gs[64 + lane] = wlv; gs[128 + lane] = pmv;
        if (lane == 0) { B.blast[cn] = blast; B.mloc[cn] = blast + mx; } }
    __syncthreads();
#pragma unroll
    for (int it = 0; it < 2; ++it) { const int vi = tid + it * 512, l = vi & 63, g = vi >> 6;
        float kf[8], vf[8]; unpack8(gk[it], kf); unpack8(gv[it], vf);
        const float p = pw[l];
#pragma unroll
        for (int j = 0; j < 8; ++j) { kT[(g * 8 + j) * 72 + l] = (unsigned short)f2bf(kf[j] * p); vT[(g * 8 + j) * 72 + l] = (unsigned short)f2bf(vf[j]); } }
    __syncthreads();
    const int et = wave >> 1;
#pragma unroll
    for (int q = 0; q < 2; ++q) { const int dt = (wave & 1) * 2 + q;
        f32x16 acc = {0.f, 0.f, 0.f, 0.f, 0.f, 0.f, 0.f, 0.f, 0.f, 0.f, 0.f, 0.f, 0.f, 0.f, 0.f, 0.f};
        mm32(acc, kT + dt * 32 * 72, 72, vT + et * 32 * 72, 72, 64, lane);
        bf16* out = B.ct + (size_t)cn * 16384 + (et * 4 + dt) * 1024 + lane * 16;
        v4u o0, o1; o0.x = pk2(acc[0], acc[1]); o0.y = pk2(acc[2], acc[3]); o0.z = pk2(acc[4], acc[5]); o0.w = pk2(acc[6], acc[7]);
        o1.x = pk2(acc[8], acc[9]); o1.y = pk2(acc[10], acc[11]); o1.z = pk2(acc[12], acc[13]); o1.w = pk2(acc[14], acc[15]);
        *(v4u*)out = o0; *(v4u*)(out + 8) = o1; }
    { const int d = tid >> 2, qq = tid & 3; float f0[8], f1[8]; unpack8(*(const LAS v4u*)(kT + d * 72 + qq * 16), f0); unpack8(*(const LAS v4u*)(kT + d * 72 + qq * 16 + 8), f1);
      float sacc = 0.f;
#pragma unroll
      for (int j = 0; j < 8; ++j) sacc += f0[j] + f1[j];
      sacc += __builtin_bit_cast(float, __builtin_amdgcn_ds_swizzle(__builtin_bit_cast(int, sacc), 0x1f | (1 << 10)));
      sacc += __builtin_bit_cast(float, __builtin_amdgcn_ds_swizzle(__builtin_bit_cast(int, sacc), 0x1f | (2 << 10)));
      if (qq == 0) B.nloc[(size_t)cn * 128 + d] = sacc; }
    __syncthreads();
}
__device__ __forceinline__ void mlstm_b(const Mix0Bufs& B, int gtid, int gsz) {
    for (int idx = gtid; idx < 8 * 8192 + 8 * 128; idx += gsz) {
        const bool isn = idx >= 8 * 8192;
        if (!isn) { const int bh = idx >> 13, pe = idx & 8191;
            float s0 = 0.f, s1 = 0.f, m = 0.f; unsigned* p = (unsigned*)B.ct + (size_t)bh * NCH * 8192 + pe;
            for (int n0 = 0; n0 < NCH; n0 += 16) { unsigned cl[16]; float bl[16], ml[16];
#pragma unroll
                for (int j = 0; j < 16; ++j) { cl[j] = p[(size_t)(n0 + j) * 8192]; bl[j] = B.blast[bh * NCH + n0 + j]; ml[j] = B.mloc[bh * NCH + n0 + j]; }
#pragma unroll
                for (int j = 0; j < 16; ++j) { const unsigned out = pk2(s0, s1); const float mn = fmaxf(bl[j] + m, ml[j]), kf = __expf(bl[j] + m - mn), af = __expf(ml[j] - mn);
                    s0 = kf * s0 + af * __builtin_bit_cast(float, cl[j] << 16); s1 = kf * s1 + af * __builtin_bit_cast(float, cl[j] & 0xffff0000u);
                    if (pe == 0) B.mprev[bh * NCH + n0 + j] = m;
                    m = mn; cl[j] = out; }
#pragma unroll
                for (int j = 0; j < 16; ++j) p[(size_t)(n0 + j) * 8192] = cl[j]; }
        } else { const int r = idx - 8 * 8192, bh = r >> 7, de = r & 127;
            float st = 0.f, m = 0.f; float* p = B.nloc + (size_t)bh * NCH * 128 + de;
            for (int n0 = 0; n0 < NCH; n0 += 16) { float cl[16], bl[16], ml[16];
#pragma unroll
                for (int j = 0; j < 16; ++j) { cl[j] = p[(size_t)(n0 + j) * 128]; bl[j] = B.blast[bh * NCH + n0 + j]; ml[j] = B.mloc[bh * NCH + n0 + j]; }
#pragma unroll
                for (int j = 0; j < 16; ++j) { const float out = st; const float mn = fmaxf(bl[j] + m, ml[j]);
                    st = __expf(bl[j] + m - mn) * st + __expf(ml[j] - mn) * cl[j]; m = mn; cl[j] = out; }
#pragma unroll
                for (int j = 0; j < 16; ++j) p[(size_t)(n0 + j) * 128] = cl[j]; } }
    }
}
__device__ __forceinline__ void mlstm_c_item(const Mix0Bufs& B, const float* gate_b, const float* norm_w, int cn, LAS unsigned char* lds, int tid) {
    const int lane = tid & 63, wave = __builtin_amdgcn_readfirstlane(tid >> 6);
    const int bh = cn / NCH, n = cn % NCH, b = bh >> 2, h = bh & 3;
    const size_t t0 = (size_t)b * S_ + n * 64;
    LAS float* bm = (LAS float*)lds; LAS float* wl = bm + 64; LAS float* den = bm + 256; LAS float* emi = bm + 320;
    lbf16* qs = (lbf16*)(lds + 2048); lbf16* ks = (lbf16*)(lds + 19456); lbf16* qw = (lbf16*)(lds + 36864);
    lbf16* vT = (lbf16*)(lds + 54272); lbf16* cT = (lbf16*)(lds + 77312); lbf16* sm = (lbf16*)(lds + 120832);
    LAS float* hb = (LAS float*)(lds + 2048);
    const float mprev = B.mprev[cn];
    const float* gs = B.gst + (size_t)cn * 192;
    v4u gq[2], gk[2], gv[2], go[2], gc[4]; float sb[2], sp[2];
#pragma unroll
    for (int it = 0; it < 2; ++it) { const int vi = tid + it * 512; { const int l = vi >> 4, g = vi & 15; const bf16* pr = B.proj + (t0 + l) * PJ0 + h * 128 + g * 8; gq[it] = *(const v4u*)pr; gk[it] = *(const v4u*)(pr + 512); sb[it] = gs[l]; sp[it] = gs[128 + l]; }
        { const int l = vi & 63, g = vi >> 6; gv[it] = *(const v4u*)(B.proj + (t0 + l) * PJ0 + 1024 + h * 128 + g * 8); } }
    { const bf16* cg = B.ct + (size_t)cn * 16384;
#pragma unroll
      for (int it = 0; it < 4; ++it) gc[it] = *(const v4u*)(cg + (tid + it * 512) * 8); }
    { const int i = tid >> 3, sub = tid & 7; const bf16* op = B.proj + (t0 + i) * PJ0 + 1536 + h * 128 + sub * 16; go[0] = *(const v4u*)op; go[1] = *(const v4u*)(op + 8); }
    const float gnl = tid < 128 ? B.nloc[(size_t)cn * 128 + tid] : 0.f;
    if (wave == 0) { const float bi = gs[lane], wv = gs[64 + lane], pm = gs[128 + lane]; const float m = bi + fmaxf(mprev, pm);
        bm[lane] = bi - m; wl[lane] = wv; emi[lane] = __expf(-m); vT[128 * 72 + lane] = (unsigned short)0x3f80; }
#pragma unroll
    for (int it = 0; it < 2; ++it) { const int vi = tid + it * 512, l = vi >> 4, g = vi & 15;
        float qf[8], kf[8]; unpack8(gq[it], qf); unpack8(gk[it], kf);
        const float w = __expf(mprev - fmaxf(mprev, sp[it])); float qwf[8];
#pragma unroll
        for (int j = 0; j < 8; ++j) { kf[j] *= 0.08838834764831845f; qwf[j] = qf[j] * w; }
        *(LAS v4u*)(qs + l * 136 + g * 8) = gq[it]; *(LAS v4u*)(ks + l * 136 + g * 8) = pack8(kf); *(LAS v4u*)(qw + l * 136 + g * 8) = pack8(qwf); }
#pragma unroll
    for (int it = 0; it < 2; ++it) { const int vi = tid + it * 512, l = vi & 63, g = vi >> 6;
        float vf[8]; unpack8(gv[it], vf);
#pragma unroll
        for (int j = 0; j < 8; ++j) vT[(g * 8 + j) * 72 + l] = (unsigned short)f2bf(vf[j]); }
#pragma unroll
    for (int it = 0; it < 4; ++it) { const int vi = tid + it * 512, T = vi >> 7, ln = (vi >> 1) & 63, hr = vi & 1; const v4u x = gc[it];
        LAS unsigned char* dp = (LAS unsigned char*)(cT + ((T >> 2) * 32 + (ln & 31)) * 136 + (T & 3) * 32 + 16 * hr + 4 * (ln >> 5));
        *(LAS v2u*)dp = (v2u){x.x, x.y}; *(LAS v2u*)(dp + 16) = (v2u){x.z, x.w}; }
    if (tid < 128) cT[128 * 136 + tid] = (unsigned short)f2bf(gnl);
    __syncthreads();
    if (wave < 4) { const int it = wave >> 1, jt = wave & 1;
        f32x16 acc = {0.f, 0.f, 0.f, 0.f, 0.f, 0.f, 0.f, 0.f, 0.f, 0.f, 0.f, 0.f, 0.f, 0.f, 0.f, 0.f};
        if (jt <= it) mm32(acc, ks + jt * 32 * 136, 136, qs + it * 32 * 136, 136, 128, lane);
        const int i = it * 32 + (lane & 31); const float bmi = bm[i];
#pragma unroll
        for (int g4 = 0; g4 < 4; ++g4) { const int j0 = jt * 32 + 8 * g4 + 4 * (lane >> 5); const f32x4 w4 = *(const LAS f32x4*)(wl + j0);
            const float v0 = j0 <= i ? acc[g4 * 4] * __expf(bmi + w4.x) : 0.f, v1 = j0 + 1 <= i ? acc[g4 * 4 + 1] * __expf(bmi + w4.y) : 0.f;
            const float v2 = j0 + 2 <= i ? acc[g4 * 4 + 2] * __expf(bmi + w4.z) : 0.f, v3 = j0 + 3 <= i ? acc[g4 * 4 + 3] * __expf(bmi + w4.w) : 0.f;
            *(LAS v2u*)(sm + i * 72 + j0) = (v2u){pk2(v0, v1), pk2(v2, v3)}; } }
    __syncthreads();
    f32x16 accA = {0.f, 0.f, 0.f, 0.f, 0.f, 0.f, 0.f, 0.f, 0.f, 0.f, 0.f, 0.f, 0.f, 0.f, 0.f, 0.f}, accB = accA;
    { const int id = wave, it = id / 5, nt = id % 5;
      mm32(accA, vT + nt * 32 * 72, 72, sm + it * 32 * 72, 72, 64, lane); mm32(accA, cT + nt * 32 * 136, 136, qw + it * 32 * 136, 136, 128, lane);
      if (nt == 4 && lane < 32) den[it * 32 + lane] = accA[0]; }
    if (wave < 2) { const int id = wave + 8, it = id / 5, nt = id % 5;
      mm32(accB, vT + nt * 32 * 72, 72, sm + it * 32 * 72, 72, 64, lane); mm32(accB, cT + nt * 32 * 136, 136, qw + it * 32 * 136, 136, 128, lane);
      if (nt == 4 && lane < 32) den[it * 32 + lane] = accB[0]; }
    __syncthreads();
    { const int id = wave, it = id / 5, nt = id % 5;
      if (nt < 4) { const int i = it * 32 + (lane & 31); const float rd = rcp_f(fmaxf(fabsf(den[i]), emi[i]));
#pragma unroll
          for (int g4 = 0; g4 < 4; ++g4) *(LAS f32x4*)(hb + i * 132 + nt * 32 + 8 * g4 + 4 * (lane >> 5)) = (f32x4){accA[g4 * 4] * rd, accA[g4 * 4 + 1] * rd, accA[g4 * 4 + 2] * rd, accA[g4 * 4 + 3] * rd}; } }
    if (wave < 2) { const int id = wave + 8, it = id / 5, nt = id % 5;
      if (nt < 4) { const int i = it * 32 + (lane & 31); const float rd = rcp_f(fmaxf(fabsf(den[i]), emi[i]));
#pragma unroll
          for (int g4 = 0; g4 < 4; ++g4) *(LAS f32x4*)(hb + i * 132 + nt * 32 + 8 * g4 + 4 * (lane >> 5)) = (f32x4){accB[g4 * 4] * rd, accB[g4 * 4 + 1] * rd, accB[g4 * 4 + 2] * rd, accB[g4 * 4 + 3] * rd}; } }
    __syncthreads();
    { const int i = tid >> 3, sub = tid & 7; const LAS float* hr = hb + i * 132 + sub * 16;
      float x[16]; float s = 0.f;
#pragma unroll
      for (int j = 0; j < 16; ++j) { x[j] = hr[j]; s += x[j]; }
      s += __builtin_bit_cast(float, __builtin_amdgcn_ds_swizzle(__builtin_bit_cast(int, s), 0x1f | (1 << 10)));
      s += __builtin_bit_cast(float, __builtin_amdgcn_ds_swizzle(__builtin_bit_cast(int, s), 0x1f | (2 << 10)));
      s += __builtin_bit_cast(float, __builtin_amdgcn_ds_swizzle(__builtin_bit_cast(int, s), 0x1f | (4 << 10)));
      const float mean = s * (1.f / 128.f); float q = 0.f;
#pragma unroll
      for (int j = 0; j < 16; ++j) { x[j] -= mean; q += x[j] * x[j]; }
      q += __builtin_bit_cast(float, __builtin_amdgcn_ds_swizzle(__builtin_bit_cast(int, q), 0x1f | (1 << 10)));
      q += __builtin_bit_cast(float, __builtin_amdgcn_ds_swizzle(__builtin_bit_cast(int, q), 0x1f | (2 << 10)));
      q += __builtin_bit_cast(float, __builtin_amdgcn_ds_swizzle(__builtin_bit_cast(int, q), 0x1f | (4 << 10)));
      const float rstd = __builtin_amdgcn_rsqf(q * (1.f / 128.f) + nv::EPS);
      const float* nw = norm_w + h * 128 + sub * 16;
      float o0[8], o1[8]; unpack8(go[0], o0); unpack8(go[1], o1);
      float y0[8], y1[8];
#pragma unroll
      for (int j = 0; j < 8; ++j) { y0[j] = x[j] * rstd * nw[j] * sigm_f(o0[j]); y1[j] = x[8 + j] * rstd * nw[8 + j] * sigm_f(o1[j]); }
      bf16* dst = B.mixbf + (t0 + i) * 1024 + h * 128 + sub * 16;
      *(v4u*)dst = pack8(y0); *(v4u*)(dst + 8) = pack8(y1); }
    __syncthreads();
}
__device__ __forceinline__ void lru_a_item(const Mix0Bufs& B, const float* const* in, int ch, LAS unsigned char* lds, int tid) {
    const int lane = tid & 63, wave = __builtin_amdgcn_readfirstlane(tid >> 6);
    const size_t t0 = (size_t)ch * 64; const int s0 = (ch % NCH) * 64;
    lbf16* xc = (lbf16*)lds; LAS float* al = (LAS float*)(lds + 17408); LAS float* ul = (LAS float*)(lds + 17408 + 32768);
    const float* cw = in[9]; const float* cb = in[10]; const float* ba = in[12]; const float* bx = in[14]; const float* lam = in[15];
    for (int hh = 0; hh < 4; ++hh) {
#pragma unroll
        for (int it = 0; it < 2; ++it) { const int vi = tid + it * 512, l = vi >> 4, g = vi & 15, c0 = hh * 128 + g * 8;
            float acc[8];
#pragma unroll
            for (int j = 0; j < 8; ++j) acc[j] = cb[c0 + j];
#pragma unroll
            for (int tap = 0; tap < 4; ++tap) { const int ls = s0 + l - 3 + tap;
                if (ls >= 0) { float xf[8]; unpack8(*(const v4u*)(B.proj + (t0 + l - 3 + tap) * PJ0 + 2056 + c0), xf);
#pragma unroll
                    for (int j = 0; j < 8; ++j) acc[j] += cw[tap * 512 + c0 + j] * xf[j]; } }
            *(LAS v4u*)(xc + l * 136 + g * 8) = pack8(acc);
#pragma unroll
            for (int j = 0; j < 8; ++j) ul[l * 128 + g * 8 + j] = acc[j]; }
        __syncthreads();
        { const int it = wave & 1, nt = wave >> 1;
          f32x16 ra = {0.f, 0.f, 0.f, 0.f, 0.f, 0.f, 0.f, 0.f, 0.f, 0.f, 0.f, 0.f, 0.f, 0.f, 0.f, 0.f}, xa = ra;
          mm32_gb(ra, xc + it * 32 * 136, 136, B.lruw + (size_t)(hh * 128 + nt * 32) * 128, 128, 128, lane);
          mm32_gb(xa, xc + it * 32 * 136, 136, B.lruw + (size_t)(512 + hh * 128 + nt * 32) * 128, 128, 128, lane);
          const int c = nt * 32 + (lane & 31), cg = hh * 128 + c; const float bav = ba[cg], bxv = bx[cg], sp = softplus_f(-lam[cg]);
#pragma unroll
          for (int r = 0; r < 16; ++r) { const int l = it * 32 + rowmap(r, lane);
              const float rr = sigm_f(ra[r] + bav), ii = sigm_f(xa[r] + bxv), la = -8.0f * rr * sp;
              const float xv = ul[l * 128 + c];
              al[l * 128 + c] = __expf(la); ul[l * 128 + c] = __builtin_amdgcn_sqrtf(1.0f - __expf(2.0f * la)) * ii * xv; } }
        __syncthreads();
        if (tid < 128) { float hst = 0.f, P = 1.f; float* hp = B.hloc + t0 * 512 + hh * 128 + tid; float* pp = B.pc + t0 * 512 + hh * 128 + tid;
            for (int l = 0; l < 64; ++l) { const float a = al[l * 128 + tid]; hst = a * hst + ul[l * 128 + tid]; P *= a; hp[(size_t)l * 512] = hst; pp[(size_t)l * 512] = P; }
            B.carA[(size_t)ch * 512 + hh * 128 + tid] = P; B.carU[(size_t)ch * 512 + hh * 128 + tid] = hst; }
        __syncthreads();
    }
}
__device__ __forceinline__ void lru_b(const Mix0Bufs& B, int gtid, int gsz) {
    for (int idx = gtid; idx < 2 * 512; idx += gsz) { const int b = idx >> 9, c = idx & 511; float hst = 0.f;
        for (int n0 = 0; n0 < NCH; n0 += 16) { float a[16], u[16];
#pragma unroll
            for (int j = 0; j < 16; ++j) { const size_t o = (size_t)(b * NCH + n0 + j) * 512 + c; a[j] = B.carA[o]; u[j] = B.carU[o]; }
#pragma unroll
            for (int j = 0; j < 16; ++j) { const float in = hst; hst = a[j] * hst + u[j]; a[j] = in; }
#pragma unroll
            for (int j = 0; j < 16; ++j) B.carI[(size_t)(b * NCH + n0 + j) * 512 + c] = a[j]; } }
}
__device__ __forceinline__ void lru_c(const Mix0Bufs& B, int gtid, int gsz) {
    for (int idx = gtid; idx < T_ * 64; idx += gsz) { const size_t t = idx >> 6; const int c0 = (idx & 63) * 8; const size_t ch = t >> 6;
        float gb[8], y[8]; unpack8(*(const v4u*)(B.proj + t * PJ0 + 2568 + c0), gb);
        const float* hp = B.hloc + t * 512 + c0; const float* pp = B.pc + t * 512 + c0; const float* ci = B.carI + ch * 512 + c0;
#pragma unroll
        for (int j = 0; j < 8; ++j) y[j] = (hp[j] + pp[j] * ci[j]) * gelu_f(gb[j]);
        *(v4u*)(B.mixbf + t * 1024 + 512 + c0) = pack8(y); }
}
constexpr int PJ1 = OINP;
struct Mix1Bufs { const bf16* proj; bf16* ut; float* gbl; bf16* s5g; float* xend; float* xstart; float* s5ab; float* s5bb; bf16* cm; bf16* bbt; bf16* mixbf; };
__device__ __forceinline__ void gla_gates(const bf16* proj, const float* gw, const float* gb, size_t t0, int h, LAS float* bc, LAS float* gl, LAS float* tot, int tid) {
    const int d = tid & 63, lg = __builtin_amdgcn_readfirstlane(tid >> 6);
    if (tid < 128) { const int l = tid >> 1, hf = tid & 1; float f[8]; unpack8(*(const v4u*)(proj + (t0 + l) * PJ1 + 2048 + hf * 8), f);
        *(LAS f32x4*)(gl + l * 16 + hf * 8) = (f32x4){f[0], f[1], f[2], f[3]}; *(LAS f32x4*)(gl + l * 16 + hf * 8 + 4) = (f32x4){f[4], f[5], f[6], f[7]}; }
    float w[16];
#pragma unroll
    for (int r = 0; r < 16; ++r) w[r] = gw[r * 256 + h * 64 + d];
    const float bias = gb[h * 64 + d];
    __syncthreads();
    float v[8];
#pragma unroll
    for (int q = 0; q < 8; ++q) { const int l = lg * 8 + q; float acc = bias;
#pragma unroll
        for (int r4 = 0; r4 < 4; ++r4) { const f32x4 g4 = *(const LAS f32x4*)(gl + l * 16 + r4 * 4); acc += g4.x * w[r4 * 4] + g4.y * w[r4 * 4 + 1] + g4.z * w[r4 * 4 + 2] + g4.w * w[r4 * 4 + 3]; }
        v[q] = logsig_f(acc) * 0.0625f; }
#pragma unroll
    for (int q = 1; q < 8; ++q) v[q] += v[q - 1];
    tot[lg * 64 + d] = v[7];
    __syncthreads();
    float pre = 0.f;
#pragma unroll
    for (int s = 0; s < 7; ++s) { const float t = tot[s * 64 + d]; pre += (s < lg) ? t : 0.f; }
#pragma unroll
    for (int q = 0; q < 8; ++q) bc[(lg * 8 + q) * 64 + d] = v[q] + pre;
    __syncthreads();
}
__device__ __forceinline__ void gla_a_item(const Mix1Bufs& B, const float* gw, const float* gb, int cn, LAS unsigned char* lds, int tid) {
    const int lane = tid & 63, wave = __builtin_amdgcn_readfirstlane(tid >> 6);
    const int bh = cn / NCH, n = cn % NCH, b = bh >> 2, h = bh & 3;
    const size_t t0 = (size_t)b * S_ + n * 64;
    LAS float* bc = (LAS float*)lds; LAS float* gl = (LAS float*)(lds + 16384); LAS float* tot = (LAS float*)(lds + 118784);
    lbf16* kT = (lbf16*)(lds + 20480); lbf16* vT = (lbf16*)(lds + 20480 + 64 * 72 * 2);
    v4u gk, gv[2];
    { const int l = tid & 63, g = tid >> 6; gk = *(const v4u*)(B.proj + (t0 + l) * PJ1 + 768 + h * 64 + g * 8); }
#pragma unroll
    for (int it = 0; it < 2; ++it) { const int vi = tid + it * 512, l = vi & 63, g = vi >> 6; gv[it] = *(const v4u*)(B.proj + (t0 + l) * PJ1 + 1024 + h * 128 + g * 8); }
    gla_gates(B.proj, gw, gb, t0, h, bc, gl, tot, tid);
    { const int l = tid & 63, g = tid >> 6; float kf[8]; unpack8(gk, kf);
#pragma unroll
      for (int j = 0; j < 8; ++j) { const int d = g * 8 + j; kT[d * 72 + l] = (unsigned short)f2bf(kf[j] * __expf(bc[63 * 64 + d] - bc[l * 64 + d])); } }
#pragma unroll
    for (int it = 0; it < 2; ++it) { const int vi = tid + it * 512, l = vi & 63, g = vi >> 6; float vf[8]; unpack8(gv[it], vf);
#pragma unroll
        for (int j = 0; j < 8; ++j) vT[(g * 8 + j) * 72 + l] = (unsigned short)f2bf(vf[j]); }
    __syncthreads();
    { const int et = wave >> 1, dt = wave & 1;
      f32x16 acc = {0.f, 0.f, 0.f, 0.f, 0.f, 0.f, 0.f, 0.f, 0.f, 0.f, 0.f, 0.f, 0.f, 0.f, 0.f, 0.f};
      mm32(acc, kT + dt * 32 * 72, 72, vT + et * 32 * 72, 72, 64, lane);
      bf16* out = B.ut + (size_t)cn * 8192 + (et * 2 + dt) * 1024 + lane * 16;
      v4u o0, o1; o0.x = pk2(acc[0], acc[1]); o0.y = pk2(acc[2], acc[3]); o0.z = pk2(acc[4], acc[5]); o0.w = pk2(acc[6], acc[7]);
      o1.x = pk2(acc[8], acc[9]); o1.y = pk2(acc[10], acc[11]); o1.z = pk2(acc[12], acc[13]); o1.w = pk2(acc[14], acc[15]);
      *(v4u*)out = o0; *(v4u*)(out + 8) = o1; }
    if (tid < 64) B.gbl[(size_t)cn * 64 + tid] = bc[63 * 64 + tid];
    __syncthreads();
}
__device__ __forceinline__ void gla_b(const Mix1Bufs& B, int gtid, int gsz) {
    for (int idx = gtid; idx < 8 * 4096; idx += gsz) { const int bh = idx >> 12, pe = idx & 4095, d = ((pe >> 9) & 1) * 32 + ((pe * 2) & 3) + 8 * ((pe >> 1) & 3) + 4 * ((pe >> 8) & 1); float s0 = 0.f, s1 = 0.f;
        unsigned* p = (unsigned*)B.ut + (size_t)bh * NCH * 4096 + pe; const float* gp = B.gbl + (size_t)bh * NCH * 64 + d;
        for (int n0 = 0; n0 < NCH; n0 += 16) { unsigned u[16]; float g0[16], g1[16];
#pragma unroll
            for (int j = 0; j < 16; ++j) { u[j] = p[(size_t)(n0 + j) * 4096]; g0[j] = gp[(n0 + j) * 64]; g1[j] = gp[(n0 + j) * 64 + 1]; }
#pragma unroll
            for (int j = 0; j < 16; ++j) { const unsigned out = pk2(s0, s1);
                s0 = __expf(g0[j]) * s0 + __builtin_bit_cast(float, u[j] << 16); s1 = __expf(g1[j]) * s1 + __builtin_bit_cast(float, u[j] & 0xffff0000u); u[j] = out; }
#pragma unroll
            for (int j = 0; j < 16; ++j) p[(size_t)(n0 + j) * 4096] = u[j]; } }
}
__device__ __forceinline__ void gla_c_item(const Mix1Bufs& B, const float* gw, const float* gb, const float* norm_w, int cn, LAS unsigned char* lds, int tid) {
    const int lane = tid & 63, wave = __builtin_amdgcn_readfirstlane(tid >> 6);
    const int bh = cn / NCH, n = cn % NCH, b = bh >> 2, h = bh & 3;
    const size_t t0 = (size_t)b * S_ + n * 64;
    LAS float* bc = (LAS float*)lds; LAS float* gl = (LAS float*)(lds + 16384);
    lbf16* qd = (lbf16*)(lds + 20480); lbf16* ki = (lbf16*)(lds + 29696); lbf16* vT = (lbf16*)(lds + 38912); lbf16* sT = (lbf16*)(lds + 57344); lbf16* att = (lbf16*)(lds + 75776);
    LAS float* ob = (LAS float*)(lds + 84992); LAS float* tot = (LAS float*)(lds + 118784);
    gla_gates(B.proj, gw, gb, t0, h, bc, gl, tot, tid);
    { const int l = tid >> 3, g = tid & 7; const bf16* pr = B.proj + (t0 + l) * PJ1 + h * 64 + g * 8; float qf[8], kf[8]; unpack8(*(const v4u*)(pr + 512), qf); unpack8(*(const v4u*)(pr + 768), kf);
#pragma unroll
      for (int j = 0; j < 8; ++j) { const float bb = bc[l * 64 + g * 8 + j]; qf[j] *= 0.125f * __expf(bb); kf[j] *= __expf(-bb); }
      *(LAS v4u*)(qd + l * 72 + g * 8) = pack8(qf); *(LAS v4u*)(ki + l * 72 + g * 8) = pack8(kf); }
#pragma unroll
    for (int it = 0; it < 2; ++it) { const int vi = tid + it * 512, l = vi & 63, g = vi >> 6; float vf[8]; unpack8(*(const v4u*)(B.proj + (t0 + l) * PJ1 + 1024 + h * 128 + g * 8), vf);
#pragma unroll
        for (int j = 0; j < 8; ++j) vT[(g * 8 + j) * 72 + l] = (unsigned short)f2bf(vf[j]); }
    { const bf16* sg = B.ut + (size_t)cn * 8192;
#pragma unroll
      for (int it = 0; it < 2; ++it) { const int vi = tid + it * 512, T = vi >> 7, ln = (vi >> 1) & 63, hr = vi & 1; const v4u x = *(const v4u*)(sg + vi * 8);
          LAS unsigned char* dp = (LAS unsigned char*)(sT + ((T >> 1) * 32 + (ln & 31)) * 72 + (T & 1) * 32 + 16 * hr + 4 * (ln >> 5));
          *(LAS v2u*)dp = (v2u){x.x, x.y}; *(LAS v2u*)(dp + 16) = (v2u){x.z, x.w}; } }
    __syncthreads();
    if (wave < 4) { const int it = wave >> 1, jt = wave & 1;
        f32x16 acc = {0.f, 0.f, 0.f, 0.f, 0.f, 0.f, 0.f, 0.f, 0.f, 0.f, 0.f, 0.f, 0.f, 0.f, 0.f, 0.f};
        if (jt <= it) mm32(acc, ki + jt * 32 * 72, 72, qd + it * 32 * 72, 72, 64, lane);
        const int i = it * 32 + (lane & 31);
#pragma unroll
        for (int g4 = 0; g4 < 4; ++g4) { const int j0 = jt * 32 + 8 * g4 + 4 * (lane >> 5);
            v2u o; o.x = pk2(j0 <= i ? acc[g4 * 4] : 0.f, j0 + 1 <= i ? acc[g4 * 4 + 1] : 0.f); o.y = pk2(j0 + 2 <= i ? acc[g4 * 4 + 2] : 0.f, j0 + 3 <= i ? acc[g4 * 4 + 3] : 0.f);
            *(LAS v2u*)(att + i * 72 + j0) = o; } }
    __syncthreads();
    { const int it = wave >> 2, nt = wave & 3;
      f32x16 acc = {0.f, 0.f, 0.f, 0.f, 0.f, 0.f, 0.f, 0.f, 0.f, 0.f, 0.f, 0.f, 0.f, 0.f, 0.f, 0.f};
      mm32(acc, vT + nt * 32 * 72, 72, att + it * 32 * 72, 72, 64, lane); mm32(acc, sT + nt * 32 * 72, 72, qd + it * 32 * 72, 72, 64, lane);
#pragma unroll
      for (int g4 = 0; g4 < 4; ++g4) *(LAS f32x4*)(ob + (it * 32 + (lane & 31)) * 132 + nt * 32 + 8 * g4 + 4 * (lane >> 5)) = (f32x4){acc[g4 * 4], acc[g4 * 4 + 1], acc[g4 * 4 + 2], acc[g4 * 4 + 3]}; }
    __syncthreads();
    { const int i = tid >> 3, sub = tid & 7; const LAS float* hr = ob + i * 132 + sub * 16;
      float x[16]; float q = 0.f;
#pragma unroll
      for (int j = 0; j < 16; ++j) { x[j] = hr[j]; q += x[j] * x[j]; }
      q += __builtin_bit_cast(float, __builtin_amdgcn_ds_swizzle(__builtin_bit_cast(int, q), 0x1f | (1 << 10)));
      q += __builtin_bit_cast(float, __builtin_amdgcn_ds_swizzle(__builtin_bit_cast(int, q), 0x1f | (2 << 10)));
      q += __builtin_bit_cast(float, __builtin_amdgcn_ds_swizzle(__builtin_bit_cast(int, q), 0x1f | (4 << 10)));
      const float rstd = __builtin_amdgcn_rsqf(q * (1.f / 128.f) + nv::EPS);
      const bf16* rp = B.proj + (t0 + i) * PJ1 + 1536 + h * 128 + sub * 16; const float* nw = norm_w + h * 128 + sub * 16;
      float r0[8], r1[8]; unpack8(*(const v4u*)rp, r0); unpack8(*(const v4u*)(rp + 8), r1);
      float y0[8], y1[8];
#pragma unroll
      for (int j = 0; j < 8; ++j) { y0[j] = x[j] * rstd * nw[j] * r0[j] * sigm_f(r0[j]); y1[j] = x[8 + j] * rstd * nw[8 + j] * r1[j] * sigm_f(r1[j]); }
      bf16* dst = B.mixbf + (t0 + i) * 1024 + 512 + h * 128 + sub * 16;
      *(v4u*)dst = pack8(y0); *(v4u*)(dst + 8) = pack8(y1); }
    __syncthreads();
}
__device__ __forceinline__ void s5_params(const Mix1Bufs& B, const float* const* in, int gtid, int gsz) {

    for (int idx = gtid; idx < 2048; idx += gsz) { const int g = idx >> 6;
        const float lr = in[17][idx], li = in[18][idx], dt = expf(in[24][g]);
        const float mag = expf(lr * dt), ar = mag * cosf(li * dt), ai = mag * sinf(li * dt);
        const float den = lr * lr + li * li, nr = ar - 1.0f, cr = (nr * lr + ai * li) / den, ci = (ai * lr - nr * li) / den;
        B.s5ab[idx * 2] = ar; B.s5ab[idx * 2 + 1] = ai;
        for (int h = 0; h < 16; ++h) { const float br = in[19][idx * 16 + h], bi = in[20][idx * 16 + h]; B.s5bb[idx * 32 + h] = cr * br - ci * bi; B.s5bb[idx * 32 + 16 + h] = cr * bi + ci * br; } }
    for (int idx = gtid; idx < 32 * 128 * 16; idx += gsz) { const int h = idx & 15, j = (idx >> 4) & 127, g = idx >> 11; const int gp = g * 64 + (j & 63);
        const float lr = in[17][gp], li = in[18][gp], dt = expf(in[24][g]);
        const float mag = expf(lr * dt), ar = mag * cosf(li * dt), ai = mag * sinf(li * dt);
        const float den = lr * lr + li * li, nr = ar - 1.0f, cr = (nr * lr + ai * li) / den, ci = (ai * lr - nr * li) / den;
        const float br = in[19][gp * 16 + h], bi = in[20][gp * 16 + h];
        B.bbt[idx] = (unsigned short)f2bf(j < 64 ? cr * br - ci * bi : cr * bi + ci * br); }
    for (int idx = gtid; idx < 32 * 32 * 128; idx += gsz) { const int k = idx & 127, hh = (idx >> 7) & 31, g = idx >> 12;
        float v = 0.f; if (hh < 16) v = k < 64 ? in[21][(g * 16 + hh) * 64 + k] : -in[22][(g * 16 + hh) * 64 + k - 64];
        B.cm[idx] = (unsigned short)f2bf(v); }
}
template <bool OUT> __device__ __forceinline__ void s5_chunk_v2(const Mix1Bufs& B, const float* dskip, int item, bool valid, LAS unsigned char* wl, int lane) {
    if (!valid) item = 0;
    const int n = item % NCH, g = (item / NCH) & 31, b = item / (NCH * 32);
    const size_t t0 = (size_t)b * S_ + n * 64; const int gp = g * 64 + lane;
    LAS float* bu = (LAS float*)wl;
    lbf16* xs = (lbf16*)(wl + 8192);
    const float ar = B.s5ab[gp * 2], ai = B.s5ab[gp * 2 + 1];
    float xr = 0.f, xi = 0.f;
    if (OUT) { xr = B.xstart[((size_t)item * 64 + lane) * 2]; xi = B.xstart[((size_t)item * 64 + lane) * 2 + 1]; }
    const bf16* bbt = B.bbt + (size_t)g * 2048 + (lane & 31) * 16 + 8 * (lane >> 5);
    for (int half = 0; half < 2; ++half) {
        const s16x8 a = *(const s16x8*)(B.proj + (t0 + half * 32 + (lane & 31)) * PJ1 + g * 16 + 8 * (lane >> 5));
        f32x16 acc[4];
#pragma unroll
        for (int nt = 0; nt < 4; ++nt) { const s16x8 bf = *(const s16x8*)(bbt + nt * 512);
            const f32x16 z = {0.f, 0.f, 0.f, 0.f, 0.f, 0.f, 0.f, 0.f, 0.f, 0.f, 0.f, 0.f, 0.f, 0.f, 0.f, 0.f};
            acc[nt] = __builtin_amdgcn_mfma_f32_32x32x16_bf16(a, bf, z, 0, 0, 0); }
#pragma unroll
        for (int q = 0; q < 2; ++q) {
#pragma unroll
            for (int nt = 0; nt < 4; ++nt)
#pragma unroll
                for (int rr = 0; rr < 8; ++rr) bu[((rr & 3) + 8 * (rr >> 2) + 4 * (lane >> 5)) * 128 + nt * 32 + (lane & 31)] = acc[nt][q * 8 + rr];
            __syncthreads();
#pragma unroll 4
            for (int l = 0; l < 16; ++l) { const float sr = bu[l * 128 + lane], si = bu[l * 128 + 64 + lane];
                const float nr = ar * xr - ai * xi + sr, ni = ar * xi + ai * xr + si; xr = nr; xi = ni;
                if (OUT) { xs[(q * 16 + l) * 136 + lane] = (unsigned short)f2bf(xr); xs[(q * 16 + l) * 136 + 64 + lane] = (unsigned short)f2bf(xi); } }
            __syncthreads();
        }
        if (OUT) {
            f32x16 acc2 = {0.f, 0.f, 0.f, 0.f, 0.f, 0.f, 0.f, 0.f, 0.f, 0.f, 0.f, 0.f, 0.f, 0.f, 0.f, 0.f};
            mm32_gb(acc2, xs, 136, B.cm + (size_t)g * 32 * 128, 128, 128, lane);
            const int hh = lane & 31;
            if (hh < 16 && valid) { const float dk = dskip[g * 16 + hh];
#pragma unroll
                for (int r = 0; r < 16; ++r) { const size_t t = t0 + half * 32 + rowmap(r, lane);
                    B.s5g[t * 512 + g * 16 + hh] = (unsigned short)f2bf(gelu_f(acc2[r] + dk * bf2f(B.proj[t * PJ1 + g * 16 + hh]))); } }
            __syncthreads();
        }
    }
    if (!OUT && valid) { B.xend[((size_t)item * 64 + lane) * 2] = xr; B.xend[((size_t)item * 64 + lane) * 2 + 1] = xi; }
}
template <bool OUT> __device__ __forceinline__ void s5_phase(const Mix1Bufs& B, const float* dskip, int gw, int NGW, LAS unsigned char* wl, int lane) {
    const int wpg = NGW >> 5, g_ = gw / wpg, j0 = gw - g_ * wpg; const bool gvalid = g_ < 32; const int g = gvalid ? g_ : 0;
    const int nit = (2 * NCH + wpg - 1) / wpg;
    const float ar = B.s5ab[(g * 64 + lane) * 2], ai = B.s5ab[(g * 64 + lane) * 2 + 1];
    s16x8 bf[4]; { const bf16* bbt = B.bbt + (size_t)g * 2048 + (lane & 31) * 16 + 8 * (lane >> 5);
#pragma unroll
        for (int nt = 0; nt < 4; ++nt) bf[nt] = *(const s16x8*)(bbt + nt * 512); }
    s16x8 cf[4]; float dk[4];
    if (OUT) { const bf16* cm = B.cm + (size_t)g * 32 * 128 + (lane & 15) * 128 + 8 * (lane >> 4);
#pragma unroll
        for (int ks = 0; ks < 4; ++ks) cf[ks] = *(const s16x8*)(cm + ks * 32);
#pragma unroll
        for (int r = 0; r < 4; ++r) dk[r] = dskip[g * 16 + 4 * (lane >> 4) + r]; }
    s16x8 na[2]; v2u nu[2][2]; float nxr = 0.f, nxi = 0.f;
#define S5_LOAD(kk) do { const int _i = j0 + (kk) * wpg; const int _idx = (gvalid && _i < 2 * NCH) ? _i : 0; const int _b = _idx / NCH, _n = _idx % NCH; const size_t _t0 = (size_t)_b * S_ + _n * 64; \
        const bf16* _p = B.proj + (_t0 + (lane & 31)) * PJ1 + g * 16 + 8 * (lane >> 5); na[0] = *(const s16x8*)_p; na[1] = *(const s16x8*)(_p + (size_t)32 * PJ1); \
        if (OUT) { const size_t _it = (size_t)(_b * 32 + g) * NCH + _n; const float2 _x = *(const float2*)(B.xstart + (_it * 64 + lane) * 2); nxr = _x.x; nxi = _x.y; \
            const bf16* _q = B.proj + (_t0 + (lane & 15)) * PJ1 + g * 16 + 4 * (lane >> 4); _Pragma("unroll") for (int _h = 0; _h < 2; ++_h) _Pragma("unroll") for (int _t = 0; _t < 2; ++_t) nu[_h][_t] = *(const v2u*)(_q + (size_t)(_h * 32 + _t * 16) * PJ1); } } while (0)
    S5_LOAD(0);
    for (int k = 0; k < nit; ++k) {
        const int i_ = j0 + k * wpg; const bool valid = gvalid && i_ < 2 * NCH; const int idx = valid ? i_ : 0; const int b = idx / NCH, n = idx % NCH;
        const size_t t0 = (size_t)b * S_ + n * 64; const size_t item = (size_t)(b * 32 + g) * NCH + n;
        s16x8 a[2] = {na[0], na[1]}; v2u uu[2][2] = {{nu[0][0], nu[0][1]}, {nu[1][0], nu[1][1]}}; float xr = OUT ? nxr : 0.f, xi = OUT ? nxi : 0.f;
        if (k + 1 < nit) S5_LOAD(k + 1);
#pragma unroll
        for (int half = 0; half < 2; ++half) {
            f32x16 acc[4];
#pragma unroll
            for (int nt = 0; nt < 4; ++nt) { const f32x16 z = {0.f, 0.f, 0.f, 0.f, 0.f, 0.f, 0.f, 0.f, 0.f, 0.f, 0.f, 0.f, 0.f, 0.f, 0.f, 0.f};
                acc[nt] = __builtin_amdgcn_mfma_f32_32x32x16_bf16(a[half], bf[nt], z, 0, 0, 0); }
            float sre[2][16], sim[2][16];
#pragma unroll
            for (int r = 0; r < 16; ++r) {
                { auto w = __builtin_amdgcn_permlane32_swap(__float_as_uint(acc[0][r]), __float_as_uint(acc[1][r]), false, false); sre[0][r] = __uint_as_float(w[0]); sre[1][r] = __uint_as_float(w[1]); }
                { auto w = __builtin_amdgcn_permlane32_swap(__float_as_uint(acc[2][r]), __float_as_uint(acc[3][r]), false, false); sim[0][r] = __uint_as_float(w[0]); sim[1][r] = __uint_as_float(w[1]); } }
            lbf16* xs = (lbf16*)(wl + half * 8704);
#pragma unroll
            for (int q = 0; q < 4; ++q)
#pragma unroll
                for (int wch = 0; wch < 2; ++wch)
#pragma unroll
                    for (int i = 0; i < 4; ++i) { const int r = q * 4 + i, tok = q * 8 + wch * 4 + i;
                        const float sr = sre[wch][r], si = sim[wch][r];
                        const float nr = ar * xr - ai * xi + sr, ni = ar * xi + ai * xr + si; xr = nr; xi = ni;
                        if (OUT) { xs[tok * 136 + lane] = (unsigned short)f2bf(xr); xs[tok * 136 + 64 + lane] = (unsigned short)f2bf(xi); } }
            if (OUT) {
                __syncthreads();
#pragma unroll
                for (int tt = 0; tt < 2; ++tt) { f32x4 y = {0.f, 0.f, 0.f, 0.f};
                    const lbf16* xp = xs + (tt * 16 + (lane & 15)) * 136 + 8 * (lane >> 4);
#pragma unroll
                    for (int ks = 0; ks < 4; ++ks) y = __builtin_amdgcn_mfma_f32_16x16x32_bf16(cf[ks], *(const LAS s16x8*)(xp + ks * 32), y, 0, 0, 0);
                    const v2u u = uu[half][tt];
                    const float u0 = __builtin_bit_cast(float, u.x << 16), u1 = __builtin_bit_cast(float, u.x & 0xffff0000u), u2 = __builtin_bit_cast(float, u.y << 16), u3 = __builtin_bit_cast(float, u.y & 0xffff0000u);
                    v2u o; o.x = pk2(gelu_f(y[0] + dk[0] * u0), gelu_f(y[1] + dk[1] * u1)); o.y = pk2(gelu_f(y[2] + dk[2] * u2), gelu_f(y[3] + dk[3] * u3));
                    if (valid) *(v2u*)(B.s5g + (t0 + half * 32 + tt * 16 + (lane & 15)) * 512 + g * 16 + 4 * (lane >> 4)) = o; }
            }
        }
        if (!OUT && valid) { float2 o; o.x = xr; o.y = xi; *(float2*)(B.xend + (item * 64 + lane) * 2) = o; }
    }
#undef S5_LOAD
}
__device__ __forceinline__ void s5_b(const Mix1Bufs& B, int gtid, int gsz) {
    for (int idx = gtid; idx < 2 * 2048; idx += gsz) { const int b = idx >> 11, gp = idx & 2047, g = gp >> 6, p = gp & 63;
        float ar = B.s5ab[gp * 2], ai = B.s5ab[gp * 2 + 1];
#pragma unroll
        for (int q = 0; q < 6; ++q) { const float r2 = ar * ar - ai * ai, i2 = 2.f * ar * ai; ar = r2; ai = i2; }
        float xr = 0.f, xi = 0.f;
        const size_t o0 = ((size_t)((b * 32 + g) * NCH) * 64 + p) * 2;
        for (int n0 = 0; n0 < NCH; n0 += 16) { float er[16], ei[16];
#pragma unroll
            for (int j = 0; j < 16; ++j) { const size_t o = o0 + (size_t)(n0 + j) * 128; er[j] = B.xend[o]; ei[j] = B.xend[o + 1]; }
#pragma unroll
            for (int j = 0; j < 16; ++j) { const float sr = xr, si = xi; const float nr = ar * xr - ai * xi + er[j], ni = ar * xi + ai * xr + ei[j]; xr = nr; xi = ni; er[j] = sr; ei[j] = si; }
#pragma unroll
            for (int j = 0; j < 16; ++j) { const size_t o = o0 + (size_t)(n0 + j) * 128; B.xstart[o] = er[j]; B.xstart[o + 1] = ei[j]; } } }
}
typedef float f32x4v __attribute__((ext_vector_type(4)));
struct RouterBufs { const float* z; float* h; bf16* hbf; const float* lnw; const float* lnb; const bf16* rwh; const bf16* rwl; const float* rbias; int* ridx; float* rwt; unsigned* cnt; };
__device__ __forceinline__ void router_split_weights(const float* rw, bf16* hi, bf16* lo, int gtid, int gsz) {
    for (int i = gtid; i < 64 * 1024; i += gsz) { const int e = i >> 10, k = i & 1023; const float w = rw[k * 64 + e]; const unsigned h = f2bf(w); hi[i] = (unsigned short)h; lo[i] = (unsigned short)f2bf(w - __builtin_bit_cast(float, h << 16)); }
}
__device__ __forceinline__ void router_select(const LAS float* sc, const float* bias, int* ridx, float* rwt, LAS unsigned* hist) {
    float gs[8];
#pragma unroll
    for (int g = 0; g < 8; ++g) { float m1 = -INFINITY, m2 = -INFINITY;
#pragma unroll
        for (int j = 0; j < 8; ++j) { const float v = sc[g * 8 + j] + bias[g * 8 + j]; if (v > m1) { m2 = m1; m1 = v; } else if (v > m2) m2 = v; }
        gs[g] = m1 + m2; }
    unsigned gsel = 0;
#pragma unroll
    for (int it = 0; it < 4; ++it) { float best = -INFINITY; int bi = 0;
#pragma unroll
        for (int g = 0; g < 8; ++g) { const bool ok = !((gsel >> g) & 1u) && gs[g] > best; best = ok ? gs[g] : best; bi = ok ? g : bi; }
        gsel |= 1u << bi; }
    unsigned long long taken = 0ull; float wsum = 0.f; float wv[8]; int ev[8];
#pragma unroll
    for (int it = 0; it < 8; ++it) { float best = -INFINITY; int bi = 0;
#pragma unroll 1
        for (int e = 0; e < 64; ++e) { const bool ok = ((gsel >> (e >> 3)) & 1u) && !((taken >> e) & 1ull); const float v = sc[e] + bias[e]; if (ok && v > best) { best = v; bi = e; } }
        taken |= 1ull << bi; ev[it] = bi; wv[it] = sc[bi]; wsum += wv[it]; }
    const float inv = 2.5f / wsum;
#pragma unroll
    for (int it = 0; it < 8; ++it) { ridx[it] = ev[it]; rwt[it] = wv[it] * inv; atomicAdd((unsigned*)&hist[ev[it]], 1u); }
}
__device__ __forceinline__ void router_tiles(const RouterBufs& R, int tile0, int tstride, int ntiles, LAS unsigned char* lds, int tid, bool count = true) {
    const int lane = tid & 63, wave = __builtin_amdgcn_readfirstlane(tid >> 6);
    lbf16* Ahi = (lbf16*)lds; lbf16* Alo = (lbf16*)(lds + 33024); LAS float* part = (LAS float*)(lds + 66048); LAS float* sc = (LAS float*)(lds + 98816); LAS unsigned* hist = (LAS unsigned*)(lds + 102912);
    if (tile0 >= ntiles) return;
    const int row16 = lane & 15, kq = 8 * (lane >> 4);
    s16x8 bh[4][4], bl[4][4];
#pragma unroll
    for (int ks = 0; ks < 4; ++ks)
#pragma unroll
        for (int nt = 0; nt < 4; ++nt) { const size_t o = (size_t)(nt * 16 + row16) * 1024 + wave * 128 + ks * 32 + kq; bh[ks][nt] = *(const s16x8*)(R.rwh + o); bl[ks][nt] = *(const s16x8*)(R.rwl + o); }
    const float bias = R.rbias[lane];
    f32x4 zr[2][4];
#define RT_LOAD(tile) do { _Pragma("unroll") for (int q = 0; q < 2; ++q) { const float* zp = R.z + ((size_t)(tile) * 16 + wave * 2 + q) * 1024 + lane * 8; \
        zr[q][0] = *(const f32x4*)zp; zr[q][1] = *(const f32x4*)(zp + 4); zr[q][2] = *(const f32x4*)(zp + 512); zr[q][3] = *(const f32x4*)(zp + 516); } } while (0)
    RT_LOAD(tile0);
    if (tid < 64) hist[tid] = 0u;
    for (int tile = tile0; tile < ntiles; tile += tstride) {
#pragma unroll
        for (int q = 0; q < 2; ++q) { const int row = wave * 2 + q; const size_t t = (size_t)tile * 16 + row;
            float v[16] = {zr[q][0].x, zr[q][0].y, zr[q][0].z, zr[q][0].w, zr[q][1].x, zr[q][1].y, zr[q][1].z, zr[q][1].w, zr[q][2].x, zr[q][2].y, zr[q][2].z, zr[q][2].w, zr[q][3].x, zr[q][3].y, zr[q][3].z, zr[q][3].w};
            float sum = 0.f;
#pragma unroll
            for (int j = 0; j < 16; ++j) sum += v[j];
            sum = wave_sum(sum); const float mean = sum * (1.f / 1024.f); float sq = 0.f;
#pragma unroll
            for (int j = 0; j < 16; ++j) { v[j] -= mean; sq += v[j] * v[j]; }
            sq = wave_sum(sq); const float rstd = 1.0f / sqrtf(sq * (1.f / 1024.f) + nv::EPS);
#pragma unroll
            for (int half = 0; half < 2; ++half) { const int c0 = half * 512 + lane * 8;
                const f32x4 w0 = *(const f32x4*)(R.lnw + c0), w1 = *(const f32x4*)(R.lnw + c0 + 4), b0 = *(const f32x4*)(R.lnb + c0), b1 = *(const f32x4*)(R.lnb + c0 + 4);
                float o[8] = {v[half * 8 + 0] * rstd * w0.x + b0.x, v[half * 8 + 1] * rstd * w0.y + b0.y, v[half * 8 + 2] * rstd * w0.z + b0.z, v[half * 8 + 3] * rstd * w0.w + b0.w,
                              v[half * 8 + 4] * rstd * w1.x + b1.x, v[half * 8 + 5] * rstd * w1.y + b1.y, v[half * 8 + 6] * rstd * w1.z + b1.z, v[half * 8 + 7] * rstd * w1.w + b1.w};
                *(f32x4*)(R.h + t * 1024 + c0) = (f32x4){o[0], o[1], o[2], o[3]}; *(f32x4*)(R.h + t * 1024 + c0 + 4) = (f32x4){o[4], o[5], o[6], o[7]};
                const v4u hi = pack8(o); float hf[8], lo[8]; unpack8(hi, hf);
#pragma unroll
                for (int j = 0; j < 8; ++j) lo[j] = o[j] - hf[j];
                *(v4u*)(R.hbf + t * 1024 + c0) = hi; *(LAS v4u*)(Ahi + row * 1032 + c0) = hi; *(LAS v4u*)(Alo + row * 1032 + c0) = pack8(lo); } }
        if (tile + tstride < ntiles) RT_LOAD(tile + tstride);
        __syncthreads();
        { f32x4v acc[4] = {{0.f, 0.f, 0.f, 0.f}, {0.f, 0.f, 0.f, 0.f}, {0.f, 0.f, 0.f, 0.f}, {0.f, 0.f, 0.f, 0.f}};
#pragma unroll
          for (int ks = 0; ks < 4; ++ks) { const int k0 = wave * 128 + ks * 32 + kq;
              const s16x8 ah = *(const LAS s16x8*)(Ahi + row16 * 1032 + k0), al = *(const LAS s16x8*)(Alo + row16 * 1032 + k0);
#pragma unroll
              for (int nt = 0; nt < 4; ++nt) {
                  acc[nt] = __builtin_amdgcn_mfma_f32_16x16x32_bf16(ah, bh[ks][nt], acc[nt], 0, 0, 0);
                  acc[nt] = __builtin_amdgcn_mfma_f32_16x16x32_bf16(al, bh[ks][nt], acc[nt], 0, 0, 0);
                  acc[nt] = __builtin_amdgcn_mfma_f32_16x16x32_bf16(ah, bl[ks][nt], acc[nt], 0, 0, 0); } }
#pragma unroll
          for (int nt = 0; nt < 4; ++nt)
#pragma unroll
              for (int r = 0; r < 4; ++r) part[(wave * 16 + (lane >> 4) * 4 + r) * 64 + nt * 16 + (lane & 15)] = acc[nt][r]; }
        __syncthreads();
#pragma unroll
        for (int q = 0; q < 2; ++q) { const int o = tid + q * 512; float s = 0.f;
#pragma unroll
            for (int w = 0; w < 8; ++w) s += part[w * 1024 + o];
            sc[o] = 1.0f / (1.0f + expf(-s)); }
        __syncthreads();
        { LAS float* gsl = part; LAS float* cvl = part + 128;
#pragma unroll 1
          for (int q = 0; q < 2; ++q) { const int tk = wave * 2 + q; const size_t t = (size_t)tile * 16 + tk;
              const float s = sc[tk * 64 + lane], v = s + bias;
#define SWZ_MAX(x, o) fmaxf(x, __builtin_bit_cast(float, __builtin_amdgcn_ds_swizzle(__builtin_bit_cast(int, x), 0x1f | ((o) << 10))))
#define SWZ_ADD(x, o) ((x) + __builtin_bit_cast(float, __builtin_amdgcn_ds_swizzle(__builtin_bit_cast(int, x), 0x1f | ((o) << 10))))
              float m1 = v; m1 = SWZ_MAX(m1, 1); m1 = SWZ_MAX(m1, 2); m1 = SWZ_MAX(m1, 4);
              float c1 = (v == m1) ? 1.f : 0.f; c1 = SWZ_ADD(c1, 1); c1 = SWZ_ADD(c1, 2); c1 = SWZ_ADD(c1, 4);
              float m2 = (v == m1) ? -INFINITY : v; m2 = SWZ_MAX(m2, 1); m2 = SWZ_MAX(m2, 2); m2 = SWZ_MAX(m2, 4);
              const float gs = m1 + (c1 >= 2.f ? m1 : m2);
              if ((lane & 7) == 0) gsl[tk * 8 + (lane >> 3)] = gs;
              __syncthreads();
              int grank = 0; const int g = lane >> 3;
#pragma unroll
              for (int j = 0; j < 8; ++j) { const float x = gsl[tk * 8 + j]; grank += (x > gs || (x == gs && j < g)) ? 1 : 0; }
              const bool gsel = grank < 4; const float cv = gsel ? v : -INFINITY;
              cvl[tk * 64 + lane] = cv;
              __syncthreads();
              int rank = 0;
#pragma unroll 16
              for (int j = 0; j < 64; ++j) { const float x = cvl[tk * 64 + j]; rank += (x > cv || (x == cv && j < lane)) ? 1 : 0; }
              const bool sel = gsel && rank < 8;
              const float wsum = wave_sum(sel ? s : 0.f);
              if (sel) { R.ridx[t * 8 + rank] = lane; R.rwt[t * 8 + rank] = s * (2.5f / wsum); atomicAdd((unsigned*)&hist[lane], 1u); }
#undef SWZ_MAX
#undef SWZ_ADD
          } }
        __syncthreads();
    }
#undef RT_LOAD
    if (count && tid < 64 && hist[tid]) atomicAdd(&R.cnt[tid], hist[tid]);
    __syncthreads();
}
#ifndef DUP_PHASE
#define DUP_PHASE -1
#endif
constexpr int CTX_OFF = LDS_CTL + 1024, TAB_OFF = LDS_CTL + 7168;
constexpr size_t WS_WINE = 1 * MiB, WS_WINO = WS_WINE + (size_t)EINP * 1024 * 2, WS_WOUT = WS_WINO + (size_t)OINP * 1024 * 2, WS_XBF = 16 * MiB, WS_NAIVE = 80 * MiB;
#if defined(WITH_NAIVE)
constexpr size_t WS_MIXBF = 48 * MiB;
#else
constexpr size_t WS_MIXBF = 453 * MiB;
#endif
__device__ __forceinline__ int conv_split(int nwg, int G) {
#if defined(WITH_NAIVE)
    return 0;
#else
    const int rem = nwg % G; return rem == 0 ? 0 : (G - rem) * NWAVES * 4;
#endif
}
static_assert(WS_WOUT + 2 * 1024 * 1024 * 2 <= WS_XBF, "ws map");
constexpr size_t WS_WD = 48 * MiB, WS_WGU = WS_WD + 65 * 512 * 1024, WS_LISTS = 146 * MiB, WS_RIDX = 148 * MiB, WS_H = 149 * MiB, WS_ROWS8 = 229 * MiB;
static_assert(WS_WGU + (size_t)65 * 1024 * 1024 <= WS_LISTS && WS_H + (size_t)MOE_MAXBLK * 256 * 512 <= WS_ROWS8 && WS_ROWS8 + (size_t)nv::T_ * 8 * 2048 <= 512 * MiB, "moe ws map");
constexpr size_t WS_PROJB = 149 * MiB, WS_CT = 253 * MiB, WS_HLOC = 317 * MiB, WS_PC = 349 * MiB, WS_M0SMALL = 381 * MiB, WS_LRUW = 486 * MiB;
constexpr size_t WS_UT = 221 * MiB, WS_S5G = 253 * MiB, WS_M1SMALL = 269 * MiB, WS_GLUW = 486 * MiB + 256 * 1024;
constexpr size_t WS_RW = 487 * MiB;
constexpr int CW_PROBE = 9000;
struct Tab { const float* in[38]; float* out; unsigned char* ws; };
struct Env { const Tab* tab; unsigned char* ws; float* out; LAS unsigned char* lds; int tid, lane, wave, bid, G, gw, NGW, gtid, gsz, vcu; };
__device__ __forceinline__ Env penv(unsigned char* lds_raw) {
    Env e; e.tab = (const Tab*)(lds_raw + TAB_OFF); e.ws = e.tab->ws; e.out = e.tab->out; e.lds = (LAS unsigned char*)lds_raw;
    int t = threadIdx.x; asm volatile("" : "+v"(t)); e.tid = t; e.lane = t & 63; e.wave = __builtin_amdgcn_readfirstlane(t >> 6);
    int b = blockIdx.x; asm volatile("" : "+s"(b)); e.bid = b; int g = gridDim.x; asm volatile("" : "+s"(g)); e.G = g;
    e.vcu = (g % 8 == 0) ? (b % 8) * (g / 8) + b / 8 : b;
    e.gw = b * NWAVES + e.wave; e.NGW = g * NWAVES; e.gtid = b * NTHREADS + t; e.gsz = g * NTHREADS;
    return e;
}
__device__ __forceinline__ void grid_bar(const Env& e) {
    XcdBarrier b; b.bar = (unsigned*)e.ws + 4096; b.x = xb_xcc_id(); b.st = (volatile LAS unsigned*)(e.lds + MISC_OFF) + 8;
    xcd_barrier(b);
}
#if defined(WITH_NAIVE)
template <int ST> __device__ __forceinline__ void run_naive(unsigned char* lds_raw, int ci, long n) {
    const Env e = penv(lds_raw);
    const nv::Ctx& c = ((const nv::Ctx*)(lds_raw + CTX_OFF))[ci];
    for (long i = e.gtid; i < n; i += e.gsz) nv::item<ST>(c, i);
    grid_bar(e);
}
#endif
__device__ __forceinline__ void phase_p0(unsigned char* lds_raw) {
    const Env e = penv(lds_raw);
    LAS float* scr = (LAS float*)(e.lds + e.wave * 16640);
    constexpr int I0 = 16 * (EINP / 64), I1 = I0 + 16 * (OINP / 64), I2 = I1 + 256, I3 = I2 + 256, I4 = I3 + 32, I5 = I4 + 64;
    for (int it = e.gw; it < I5; it += e.NGW) {
        if (it < I0) tr_matrix_item(e.tab->in[6], 1024, nv::EIN, EINP, (bf16*)(e.ws + WS_WINE), scr, it, e.lane);
        else if (it < I1) tr_matrix_item(e.tab->in[16], 1024, nv::OIN, OINP, (bf16*)(e.ws + WS_WINO), scr, it - I0, e.lane);
        else if (it < I2) tr_matrix_item(e.tab->in[5], 1024, 1024, 1024, (bf16*)(e.ws + WS_WOUT), scr, it - I1, e.lane);
        else if (it < I3) tr_matrix_item(e.tab->in[5] + 1024 * 1024, 1024, 1024, 1024, (bf16*)(e.ws + WS_WOUT) + 1024 * 1024, scr, it - I2, e.lane);
        else if (it < I4) { const int r = it - I3, mtx = r >> 2, h = mtx & 3, which = mtx >> 2;
            tr_matrix_item(e.tab->in[which ? 13 : 11] + h * 16384, 128, 128, 128, (bf16*)(e.ws + WS_LRUW) + which * 65536 + h * 16384, scr, r & 3, e.lane); }
        else tr_matrix_item(e.tab->in[25], 512, 512, 512, (bf16*)(e.ws + WS_GLUW), scr, it - I4, e.lane);
    }
    for (int l = 0; l < 2; ++l) router_split_weights(e.tab->in[30] + (size_t)l * 65536, (bf16*)(e.ws + WS_RW) + (size_t)l * 131072, (bf16*)(e.ws + WS_RW) + (size_t)l * 131072 + 65536, e.gtid, e.gsz);
    cvt_rows(e.tab->in[0], (bf16*)(e.ws + WS_XBF), (long)T_ * 1024, e.gtid, e.gsz);
    grid_bar(e);
}
__device__ __forceinline__ void phase_inproj(unsigned char* lds_raw, int layer) {
    const Env e = penv(lds_raw);
    float* proj = (float*)(e.ws + WS_NAIVE) + ((size_t)T_ * 1024 + (size_t)T_ * 64 + (size_t)T_ * 8 * 2);
    const int NP = layer == 0 ? EINP : OINP;
    pg8::Gemm g{(const bf16*)(e.ws + WS_XBF), (const bf16*)(e.ws + (layer == 0 ? WS_WINE : WS_WINO)), 1024, 0, 0, nullptr};
    pg8::StaticOrder S; S.init(T_, NP, e.G, e.bid);
    pg8::EpiF32R E{proj, NP, nullptr, 0.f};
    pg8::gemm_phase<pg8::EpiF32R, pg8::StaticOrder, true, false>(e.lds, g, S, E);
    grid_bar(e);
}
__device__ __forceinline__ void phase_cvt_mixed(unsigned char* lds_raw) {
    const Env e = penv(lds_raw);
    cvt_rows((const float*)(e.ws + WS_NAIVE), (bf16*)(e.ws + WS_MIXBF), (long)T_ * 1024, e.gtid, e.gsz);
    grid_bar(e);
}
__device__ __forceinline__ void phase_outproj(unsigned char* lds_raw, int layer) {
    const Env e = penv(lds_raw);
    float* z = (float*)(e.ws + WS_NAIVE) + ((size_t)T_ * 1024 + (size_t)T_ * 64 + (size_t)T_ * 8 * 2);
    const float* hcur = layer == 0 ? e.tab->in[0] : e.out;
    pg8::Gemm g{(const bf16*)(e.ws + WS_MIXBF), (const bf16*)(e.ws + WS_WOUT) + (size_t)layer * 1024 * 1024, 1024, 0, 0, nullptr};
    pg8::StaticOrder S; S.init(T_, 1024, e.G, e.bid);
    pg8::EpiF32R E{z, 1024, hcur, nv::ALPHA};
    pg8::gemm_phase<pg8::EpiF32R, pg8::StaticOrder, true, false>(e.lds, g, S, E);
    grid_bar(e);
}
__device__ __forceinline__ Mix0Bufs mix0_bufs(unsigned char* ws) {
    Mix0Bufs B; B.proj = (const bf16*)(ws + WS_PROJB); B.ct = (bf16*)(ws + WS_CT); B.hloc = (float*)(ws + WS_HLOC); B.pc = (float*)(ws + WS_PC);
    float* sm = (float*)(ws + WS_M0SMALL); B.nloc = sm; sm += 8 * NCH * 128; B.blast = sm; sm += 8 * NCH; B.mloc = sm; sm += 8 * NCH; B.mprev = sm; sm += 8 * NCH;
    B.carA = sm; sm += 2 * NCH * 512; B.carU = sm; sm += 2 * NCH * 512; B.carI = sm; sm += 2 * NCH * 512; B.gst = sm;
    B.mixbf = (bf16*)(ws + WS_MIXBF); B.lruw = (const bf16*)(ws + WS_LRUW); return B;
}
__device__ __forceinline__ Mix1Bufs mix1_bufs(unsigned char* ws) {
    Mix1Bufs B; B.proj = (const bf16*)(ws + WS_PROJB); B.ut = (bf16*)(ws + WS_UT); B.s5g = (bf16*)(ws + WS_S5G);
    float* sm = (float*)(ws + WS_M1SMALL); B.gbl = sm; sm += 8 * NCH * 64; B.xend = sm; sm += 8192 * 128; B.xstart = sm; sm += 8192 * 128; B.s5ab = sm; sm += 4096; B.s5bb = sm; sm += 2048 * 32;
    B.cm = (bf16*)sm; B.bbt = B.cm + 32 * 32 * 128; B.mixbf = (bf16*)(ws + WS_MIXBF); return B;
}
__device__ __forceinline__ void phase_inproj_bf16(unsigned char* lds_raw, int layer) {
    const Env e = penv(lds_raw);
    const int NP = layer == 0 ? EINP : OINP;
    if (layer == 1) { const Mix1Bufs B = mix1_bufs(e.ws); s5_params(B, e.tab->in, e.gtid, e.gsz); }
    pg8::Gemm g{(const bf16*)(e.ws + WS_XBF), (const bf16*)(e.ws + (layer == 0 ? WS_WINE : WS_WINO)), 1024, 0, 0, nullptr};
    pg8::StaticOrder S; S.init(T_, NP, e.G, e.bid);
    pg8::EpiBf16P E{(bf16*)(e.ws + WS_PROJB), NP};
    pg8::gemm_phase<pg8::EpiBf16P, pg8::StaticOrder, true, false>(e.lds, g, S, E);
    { const int nwg = (T_ / 256) * (NP / 256), rem = nwg % e.G, na = conv_split(nwg, e.G);
      if (na > 0 && e.bid >= rem) { const int nlight = e.G - rem; LAS float* scr = (LAS float*)(e.lds + e.wave * 16640);
          moe_convert_weights(e.tab->in[32] + (size_t)layer * 64 * 262144, e.tab->in[33] + (size_t)layer * 64 * 262144, e.tab->in[34] + (size_t)layer * 64 * 262144,
                              e.tab->in[35] + (size_t)layer * 262144, e.tab->in[36] + (size_t)layer * 262144, e.tab->in[37] + (size_t)layer * 262144,
                              (bf16*)(e.ws + WS_WGU), (bf16*)(e.ws + WS_WD), scr, (e.bid - rem) * NWAVES + e.wave, na, nlight * NWAVES, e.lane); } }
    grid_bar(e);
}
__device__ __forceinline__ void phase_mix0_a(unsigned char* lds_raw) {
    const Env e = penv(lds_raw); const Mix0Bufs B = mix0_bufs(e.ws);
    for (int it = e.bid; it < 256 + 8 * NCH; it += e.G) {
        if (it < 256) { lru_a_item(B, e.tab->in, it, e.lds, e.tid); if (DUP_PHASE == 31) lru_a_item(B, e.tab->in, it, e.lds, e.tid); }
        else { mlstm_a_item(B, e.tab->in[7], it - 256, e.lds, e.tid); if (DUP_PHASE == 30) mlstm_a_item(B, e.tab->in[7], it - 256, e.lds, e.tid); } }
    grid_bar(e);
}
__device__ __forceinline__ int conv_rest(int nwg, int G, int NGW) {
#if defined(WITH_NAIVE)
    return 0;
#else
    const int nb = conv_split(nwg, G) + NGW * 3; return nb > 65 * 192 ? 65 * 192 : nb;
#endif
}
__device__ __forceinline__ void conv_in_scan_phase(const Env& e, int layer) {
#if !defined(WITH_NAIVE)
    const int na = conv_split((T_ / 256) * ((layer == 0 ? EINP : OINP) / 256), e.G); int nb = na + e.NGW * 3; if (nb > 65 * 192) nb = 65 * 192;
    LAS float* scr = (LAS float*)(e.lds + e.wave * 16640);
    moe_convert_weights(e.tab->in[32] + (size_t)layer * 64 * 262144, e.tab->in[33] + (size_t)layer * 64 * 262144, e.tab->in[34] + (size_t)layer * 64 * 262144,
                        e.tab->in[35] + (size_t)layer * 262144, e.tab->in[36] + (size_t)layer * 262144, e.tab->in[37] + (size_t)layer * 262144,
                        (bf16*)(e.ws + WS_WGU), (bf16*)(e.ws + WS_WD), scr, na + e.gw, nb, e.NGW, e.lane);
#endif
}
__device__ __forceinline__ void phase_mix0_b(unsigned char* lds_raw) {
    const Env e = penv(lds_raw); const Mix0Bufs B = mix0_bufs(e.ws);
    lru_b(B, e.gtid, e.gsz); mlstm_b(B, e.gtid, e.gsz);
    grid_bar(e);
}
__device__ __forceinline__ void phase_mix0_c(unsigned char* lds_raw) {
    const Env e = penv(lds_raw); const Mix0Bufs B = mix0_bufs(e.ws);
    for (int it = e.bid; it < 8 * NCH; it += e.G) { mlstm_c_item(B, e.tab->in[7], e.tab->in[8], it, e.lds, e.tid); if (DUP_PHASE == 32) mlstm_c_item(B, e.tab->in[7], e.tab->in[8], it, e.lds, e.tid); }
    lru_c(B, e.gtid, e.gsz); if (DUP_PHASE == 33) lru_c(B, e.gtid, e.gsz);
    grid_bar(e);
}
__device__ __forceinline__ void phase_mix1_a(unsigned char* lds_raw) {
    const Env e = penv(lds_raw); const Mix1Bufs B = mix1_bufs(e.ws);
    for (int it = e.bid; it < 8 * NCH; it += e.G) { gla_a_item(B, e.tab->in[27], e.tab->in[28], it, e.lds, e.tid); if (DUP_PHASE == 34) gla_a_item(B, e.tab->in[27], e.tab->in[28], it, e.lds, e.tid); }
    s5_phase<false>(B, e.tab->in[23], e.gw, e.NGW, e.lds + e.wave * 17408, e.lane); if (DUP_PHASE == 35) s5_phase<false>(B, e.tab->in[23], e.gw, e.NGW, e.lds + e.wave * 17408, e.lane);
    grid_bar(e);
}
__device__ __forceinline__ void phase_mix1_b(unsigned char* lds_raw) {
    const Env e = penv(lds_raw); const Mix1Bufs B = mix1_bufs(e.ws);
    s5_b(B, e.gtid, e.gsz); gla_b(B, e.gtid, e.gsz);
    grid_bar(e);
}
__device__ __forceinline__ void phase_mix1_c(unsigned char* lds_raw) {
    const Env e = penv(lds_raw); const Mix1Bufs B = mix1_bufs(e.ws);
    for (int it = e.bid; it < 8 * NCH; it += e.G) { gla_c_item(B, e.tab->in[27], e.tab->in[28], e.tab->in[29], it, e.lds, e.tid); if (DUP_PHASE == 36) gla_c_item(B, e.tab->in[27], e.tab->in[28], e.tab->in[29], it, e.lds, e.tid); }
#if defined(S5_OLD_C)
    for (int it = e.gw, k = 0; k < (2 * 32 * NCH + e.NGW - 1) / e.NGW; ++k, it += e.NGW) s5_chunk_v2<true>(B, e.tab->in[23], it, it < 2 * 32 * NCH, e.lds + e.wave * 16896, e.lane);
#else
    s5_phase<true>(B, e.tab->in[23], e.gw, e.NGW, e.lds + e.wave * 17408, e.lane); if (DUP_PHASE == 37) s5_phase<true>(B, e.tab->in[23], e.gw, e.NGW, e.lds + e.wave * 17408, e.lane);
#endif
    grid_bar(e);
}
__device__ __forceinline__ void phase_glu(unsigned char* lds_raw) {
    const Env e = penv(lds_raw);
    pg8::Gemm g{(const bf16*)(e.ws + WS_S5G), (const bf16*)(e.ws + WS_GLUW), 512, 0, 0, nullptr};
    pg8::StaticOrder S; S.init(T_, 512, e.G, e.bid);
    pg8::EpiGlu E{(bf16*)(e.ws + WS_MIXBF), 1024, (const bf16*)(e.ws + WS_S5G), 512, e.tab->in[26]};
    pg8::gemm_phase<pg8::EpiGlu, pg8::StaticOrder, true, false>(e.lds, g, S, E);
    grid_bar(e);
}
__device__ __forceinline__ void phase_probe(unsigned char* lds_raw, int c0, int c1) {
    const Env e = penv(lds_raw);
    const bf16* a = (const bf16*)(e.ws + WS_MIXBF); const float* b = (const float*)(e.ws + WS_NAIVE);
    float sd = 0.f, sr = 0.f; const int w = c1 - c0;
    for (long i = e.gtid; i < (long)T_ * w; i += e.gsz) { const long t = i / w; const int c = c0 + (int)(i % w); const float x = bf2f(a[t * 1024 + c]), y = b[t * 1024 + c]; sd += (x - y) * (x - y); sr += y * y; }
    sd = wave_sum(sd); sr = wave_sum(sr);
    if (e.lane == 0) { atomicAdd((float*)e.ws + CW_PROBE, sd); atomicAdd((float*)e.ws + CW_PROBE + 1, sr); }
    grid_bar(e);
}
__device__ __forceinline__ void phase_probe_apply(unsigned char* lds_raw) {
    const Env e = penv(lds_raw);
    const float sd = __hip_atomic_load((float*)e.ws + CW_PROBE, __ATOMIC_RELAXED, __HIP_MEMORY_SCOPE_AGENT), sr = __hip_atomic_load((float*)e.ws + CW_PROBE + 1, __ATOMIC_RELAXED, __HIP_MEMORY_SCOPE_AGENT);
    const float f = 1.0f + 10.0f * sqrtf(sd / fmaxf(sr, 1e-30f));
    for (long i = e.gtid; i < (long)T_ * 1024; i += e.gsz) e.out[i] *= f;
}
__device__ __forceinline__ void phase_ln_router(unsigned char* lds_raw, int layer, bool count = true) {
    const Env e = penv(lds_raw);
    RouterBufs R; R.z = (const float*)(e.ws + WS_NAIVE) + ((size_t)T_ * 1024 + (size_t)T_ * 64 + (size_t)T_ * 8 * 2); R.h = e.out; R.hbf = (bf16*)(e.ws + WS_XBF);
    R.lnw = e.tab->in[1] + layer * 1024; R.lnb = e.tab->in[2] + layer * 1024; R.rwh = (const bf16*)(e.ws + WS_RW) + (size_t)layer * 131072; R.rwl = R.rwh + 65536;
    R.rbias = e.tab->in[31] + layer * 64; R.ridx = (int*)(e.ws + WS_RIDX); R.rwt = (float*)(e.ws + WS_RIDX) + (size_t)T_ * 8; R.cnt = (unsigned*)e.ws + CW_CNT + layer * 256;
    router_tiles(R, e.bid, e.G, T_ / 16, e.lds, e.tid, count);
    grid_bar(e);
}
__device__ __forceinline__ MoeLists moe_lists(unsigned char* ws) {
    MoeLists L; L.tok = (int*)(ws + WS_LISTS); L.dest = L.tok + MOE_MAXBLK * 256; L.w = (float*)(L.dest + MOE_MAXBLK * 256); L.blk_e = (int*)(L.w + MOE_MAXBLK * 256); return L;
}
__device__ __forceinline__ void phase_moe_x1(unsigned char* lds_raw, int layer, int curoff = 0) {
    const Env e = penv(lds_raw);
    moe_build_lists((const int*)(e.ws + WS_RIDX), (const float*)(e.ws + WS_RIDX) + (size_t)T_ * 8, (unsigned*)e.ws + CW_CNT + layer * 256, (unsigned*)e.ws + CW_CUR + layer * 256 + curoff,
                    moe_lists(e.ws), (LAS int*)e.lds, e.tid, e.bid, e.G);
    LAS float* scr = (LAS float*)(e.lds + e.wave * 16640);
    moe_convert_weights(e.tab->in[32] + (size_t)layer * 64 * 262144, e.tab->in[33] + (size_t)layer * 64 * 262144, e.tab->in[34] + (size_t)layer * 64 * 262144,
                        e.tab->in[35] + (size_t)layer * 262144, e.tab->in[36] + (size_t)layer * 262144, e.tab->in[37] + (size_t)layer * 262144,
                        (bf16*)(e.ws + WS_WGU), (bf16*)(e.ws + WS_WD), scr, conv_split((T_ / 256) * ((layer == 0 ? EINP : OINP) / 256), e.G) + e.gw, 65 * 192, e.NGW, e.lane);
    grid_bar(e);
}
__device__ __forceinline__ void phase_moe_g1(unsigned char* lds_raw) {
    const Env e = penv(lds_raw);
    const MoeLists L = moe_lists(e.ws);
    const int nblk = __builtin_amdgcn_readfirstlane(L.blk_e[MOE_MAXBLK]);
    pg8::Gemm g{(const bf16*)(e.ws + WS_XBF), (const bf16*)(e.ws + WS_WGU), 1024, 0, (size_t)512 * 1024, L.tok};
    pg8::MoeOrder S{L.blk_e, nblk, 2, e.G, e.vcu};
    pg8::EpiSwiGLU E{(bf16*)(e.ws + WS_H)};
    pg8::gemm_phase<pg8::EpiSwiGLU, pg8::MoeOrder, true, true>(e.lds, g, S, E);
    grid_bar(e);
}
__device__ __forceinline__ void phase_moe_g2(unsigned char* lds_raw) {
    const Env e = penv(lds_raw);
    const MoeLists L = moe_lists(e.ws);
    const int nblk = __builtin_amdgcn_readfirstlane(L.blk_e[MOE_MAXBLK]);
    pg8::Gemm g{(const bf16*)(e.ws + WS_H), (const bf16*)(e.ws + WS_WD), 256, 0, (size_t)1024 * 256, nullptr};
    pg8::MoeOrder S{L.blk_e, nblk, 4, e.G, e.vcu};
    pg8::EpiDown E{(bf16*)(e.ws + WS_ROWS8), (bf16*)(e.ws + WS_XBF), L.dest, T_ * 8};
    pg8::gemm_phase<pg8::EpiDown, pg8::MoeOrder, true, false>(e.lds, g, S, E);
    grid_bar(e);
}
__device__ __forceinline__ void phase_moe_combine(unsigned char* lds_raw, int layer) {
    const Env e = penv(lds_raw);
    moe_combine_ln(e.out, (const bf16*)(e.ws + WS_ROWS8), (const bf16*)(e.ws + WS_XBF), (const float*)(e.ws + WS_RIDX) + (size_t)T_ * 8, e.tab->in[3] + layer * 1024, e.tab->in[4] + layer * 1024,
                   layer == 0 ? (bf16*)(e.ws + WS_XBF) : nullptr, e.gw, e.NGW, e.lane);
    grid_bar(e);
}

#define RUN(k, call) do { call; if (DUP_PHASE == (k)) { call; } } while (0)
#ifndef TIME_PHASE
#define TIME_PHASE -1
#endif
#define TIMED(k, call) do { unsigned long long _t0 = 0; if (TIME_PHASE == (k)) _t0 = __builtin_amdgcn_s_memrealtime(); call; \
    if (TIME_PHASE == (k) && blockIdx.x == 0 && threadIdx.x == 0) { const unsigned long long _t1 = __builtin_amdgcn_s_memrealtime(); unsigned* w_ = (unsigned*)((Tab*)(lds_raw + TAB_OFF))->ws + CW_PROBE + 8; *w_ = *w_ + (unsigned)(_t1 - _t0); } } while (0)
template <int layer> __device__ __forceinline__ void layer_body(unsigned char* lds_raw) {
#if defined(WITH_NAIVE)
    constexpr int ci = layer * 2;
#if defined(DBG_MIX0)
    constexpr bool naive_too = (layer == DBG_MIX0 - 1);
#else
    constexpr bool naive_too = false;
#endif
#endif
    RUN(1, phase_inproj_bf16(lds_raw, layer));
    if (layer == 0) { RUN(2, phase_mix0_a(lds_raw)); TIMED(20, phase_mix0_b(lds_raw)); RUN(3, phase_mix0_c(lds_raw)); }
    if (layer == 1) { RUN(4, phase_mix1_a(lds_raw)); TIMED(21, phase_mix1_b(lds_raw)); RUN(5, phase_mix1_c(lds_raw)); RUN(6, phase_glu(lds_raw)); }
#if defined(WITH_NAIVE)
    if (naive_too) {
        phase_inproj(lds_raw, layer);
        if (layer == 0) {
            run_naive<nv::ST_ML_GATES>(lds_raw, ci, 8L * NCH);
            run_naive<nv::ST_ML_CLOC>(lds_raw, ci, 8L * NCH * 16384);
            run_naive<nv::ST_ML_SCAN>(lds_raw, ci, 8L * 16384 + 8 * 128);
            run_naive<nv::ST_ML_MI>(lds_raw, ci, 8L * S_);
            run_naive<nv::ST_ML_SMAT>(lds_raw, ci, 8L * NCH * 4096);
            run_naive<nv::ST_ML_DEN>(lds_raw, ci, 8L * S_);
            run_naive<nv::ST_ML_H>(lds_raw, ci, 8L * S_ * 128);
            run_naive<nv::ST_ML_NORM>(lds_raw, ci, 8L * S_);
            run_naive<nv::ST_LRU_CONV>(lds_raw, ci, (long)T_ * 512);
            run_naive<nv::ST_LRU_GATE>(lds_raw, ci, (long)T_ * 512);
            run_naive<nv::ST_LRU_SCAN>(lds_raw, ci, 2L * 512);
        } else {
            run_naive<nv::ST_S5_PAR>(lds_raw, ci, 2048);
            for (int sl = 0; sl < S_ / nv::SLAB; ++sl) {
                if (threadIdx.x == 0) ((nv::Ctx*)(lds_raw + CTX_OFF))[ci].slab = sl;
                __syncthreads();
                run_naive<nv::ST_S5_SCAN>(lds_raw, ci, 2L * 2048); run_naive<nv::ST_S5_OUT>(lds_raw, ci, (long)nv::B_ * nv::SLAB * 512); }
            run_naive<nv::ST_S5_GLU>(lds_raw, ci, (long)T_ * 512);
            run_naive<nv::ST_GLA_GATE>(lds_raw, ci, (long)T_ * 256);
            run_naive<nv::ST_GLA_CUM>(lds_raw, ci, (long)nv::B_ * NCH * 256);
            run_naive<nv::ST_GLA_U>(lds_raw, ci, 8L * NCH * 8192);
            run_naive<nv::ST_GLA_SCAN>(lds_raw, ci, 8L * 8192);
            run_naive<nv::ST_GLA_ATT>(lds_raw, ci, 8L * NCH * 4096);
            run_naive<nv::ST_GLA_O>(lds_raw, ci, 8L * S_ * 128);
            run_naive<nv::ST_GLA_NORM>(lds_raw, ci, 8L * S_);
        }
        phase_probe(lds_raw, DBG_C0, DBG_C1);
        phase_cvt_mixed(lds_raw);
    }
#endif
    RUN(7, phase_outproj(lds_raw, layer));
    TIMED(22, phase_ln_router(lds_raw, layer)); if (DUP_PHASE == 22) phase_ln_router(lds_raw, layer, false);
    phase_moe_x1(lds_raw, layer); if (DUP_PHASE == 8) phase_moe_x1(lds_raw, layer, 1024);
    RUN(9, phase_moe_g1(lds_raw));
    RUN(10, phase_moe_g2(lds_raw));
    TIMED(24, phase_moe_combine(lds_raw, layer));
}
#if defined(STORE_TEST)
__device__ __forceinline__ void phase_store_test(unsigned char* lds_raw) {
    const Env e = penv(lds_raw);
    unsigned char* base = e.ws + WS_ROWS8 + (size_t)e.bid * (1u << 20);
    const int wr = e.wave >> 2, wc = e.wave & 3, fr = e.lane & 15, fq = e.lane >> 4;
    const v4u val = {(unsigned)e.tid, 1u, 2u, 3u};
    for (int u = 0; u < 40; ++u) {
#pragma unroll
        for (int s = 0; s < 8; ++s)
#pragma unroll
            for (int bj = 0; bj < 2; ++bj) {
#if STORE_TEST == 1
                const int r = (s >> 2) * 128 + wr * 64 + (s & 3) * 16 + fr; const int cb = wc * 64 + fq * 16 + bj * 256;
#elif STORE_TEST == 2
                const int r = (s >> 2) * 128 + wr * 64 + (s & 3) * 16 + bj * 8 + (e.lane >> 3); const int cb = wc * 128 + (e.lane & 7) * 16;
#else
                const int r = (s >> 2) * 128 + wr * 64 + (s & 3) * 16 + bj * 8 + (e.lane >> 4) * 2 + (wc & 1); const int cb = (wc >> 1) * 256 + (e.lane & 15) * 16;
#endif
                *(v4u*)(base + (size_t)((u & 1) * 256 + r) * 2048 + cb) = val; }
        asm volatile("" ::: "memory"); }
    grid_bar(e);
}
#endif
struct Args { const float* in[38]; float* out; unsigned char* ws; };
__global__ void __launch_bounds__(NTHREADS, 2) mega_fwd(Args a) {
    extern __shared__ __attribute__((aligned(16))) unsigned char lds_raw[];
    {
        LAS unsigned char* lds = (LAS unsigned char*)lds_raw;
        for (int u = threadIdx.x; u < (LDS_BYTES - LDS_CTL) / 4; u += NTHREADS) ((LAS unsigned*)(lds + LDS_CTL))[u] = 0u;
        __syncthreads();
        if (threadIdx.x == 0) {
            (void)xb_add((unsigned*)a.ws + 4096 + XB_XCNT(xb_xcc_id()), 1u);
            Tab* tab = (Tab*)(lds_raw + TAB_OFF);
#pragma unroll
            for (int i = 0; i < 38; ++i) { tab->in[i] = a.in[i]; if ((i & 7) == 7) asm volatile("" ::: "memory"); }
            tab->out = a.out; tab->ws = a.ws;
            asm volatile("" ::: "memory");
#if defined(WITH_NAIVE)
            nv::Ctx* const ctab = (nv::Ctx*)(lds_raw + CTX_OFF);
            const size_t scratch0 = (size_t)T_ * 1024 + (size_t)T_ * 64 + (size_t)T_ * 8 * 2;
#pragma unroll 1
            for (int layer = 0; layer < 2; ++layer) {
                nv::Ctx& c = ctab[layer * 2];
                nv::Mem M{(float*)(a.ws + WS_NAIVE), 0};
#pragma unroll 1
                for (int i = 0; i < 38; ++i) c.in[i] = tab->in[i];
                c.mixed = M.get((size_t)T_ * 1024); c.scores = M.get((size_t)T_ * 64);
                c.ridx = (int*)M.get((size_t)T_ * 8); c.rwt = M.get((size_t)T_ * 8);
                c.gR = nullptr; c.gBias = nullptr; c.slab = 0;
                c.layer = layer;
                c.hcur = layer == 0 ? a.in[0] : a.out;
                if (layer == 0) {
                    c.ldp = EINP; c.proj = M.get((size_t)T_ * c.ldp);
                    c.mb = M.get(8 * S_); c.mig = M.get(8 * S_); c.mblast = M.get(8 * NCH); c.mmloc = M.get(8 * NCH); c.mmprev = M.get(8 * NCH);
                    c.mmi = M.get(8 * S_); c.mwin = M.get(8 * S_); c.mden = M.get(8 * S_); c.nloc = M.get(8 * NCH * 128);
                    const size_t ov = M.off;
                    c.cloc = M.get((size_t)8 * NCH * 16384); c.smat = M.get((size_t)8 * NCH * 4096); c.htil = M.get((size_t)T_ * 512);
                    M.off = ov; c.lxc = M.get((size_t)T_ * 512); c.la = M.get((size_t)T_ * 512); c.lu = M.get((size_t)T_ * 512);
                } else {
                    c.ldp = OINP; c.proj = M.get((size_t)T_ * c.ldp);
                    c.s5ab = M.get(2048 * 2); c.s5bbr = M.get(2048 * 16); c.s5bbi = M.get(2048 * 16); c.s5st = M.get(2 * 2048 * 2);
                    c.s5x = M.get((size_t)nv::B_ * nv::SLAB * 2048 * 2); c.s5g = M.get((size_t)T_ * 512);
                    c.gla_la = M.get((size_t)T_ * 256); c.gla_bc = M.get((size_t)T_ * 256); c.gla_bl = M.get((size_t)nv::B_ * NCH * 256);
                    c.gu = M.get((size_t)8 * NCH * 8192); c.gatt = M.get((size_t)8 * NCH * 4096); c.go = M.get((size_t)T_ * 512);
                }
                c.z = c.proj; c.hout = a.out; c.lnw = a.in[1] + layer * 1024; c.lnb = a.in[2] + layer * 1024;
                M.off = scratch0; c.hid = M.get((size_t)T_ * 9 * 256);
                nv::Ctx& cm = ctab[layer * 2 + 1];
                cm = c; cm.hcur = a.out;
#ifdef DBG_LAYER
                if (layer == DBG_LAYER) { nv::Ctx& cd = ctab[4]; cd = cm;
                cd.hid = (float*)(a.ws + 48 * MiB); cd.z = (float*)(a.ws + 486 * MiB); cd.hcur = a.out + (size_t)DBG_T0 * 1024; cd.ridx = c.ridx + (size_t)DBG_T0 * 8; cd.rwt = c.rwt + (size_t)DBG_T0 * 8; }
#endif
            }
#endif
        }
        __syncthreads();
    }
    RUN(0, phase_p0(lds_raw));
    layer_body<0>(lds_raw);
    layer_body<1>(lds_raw);
#if defined(STORE_TEST)
    phase_store_test(lds_raw);
#endif
#if defined(DBG_MIX0)
    phase_probe_apply(lds_raw);
#endif
    if (TIME_PHASE >= 0) { const Env e = penv(lds_raw); const unsigned ticks = __hip_atomic_load((unsigned*)e.ws + CW_PROBE + 8, __ATOMIC_RELAXED, __HIP_MEMORY_SCOPE_AGENT);
        const float f = 1.0f + 0.0005f * (float)ticks * 0.01f;
        for (long i = e.gtid; i < (long)T_ * 1024; i += e.gsz) e.out[i] *= f; }
}
extern "C" void kernel_launch(void* const* d_in, const int* in_sizes, int n_in, void* d_out, int out_size, void* d_ws, size_t ws_size, hipStream_t stream) {
    static int grid = 0;
    if (grid == 0) {
        int dev = 0, cus = 0, per_cu = 0;
        hipGetDevice(&dev); hipDeviceGetAttribute(&cus, hipDeviceAttributeMultiprocessorCount, dev);
        hipFuncSetAttribute((const void*)mega_fwd, hipFuncAttributeMaxDynamicSharedMemorySize, LDS_BYTES);
        hipOccupancyMaxActiveBlocksPerMultiprocessor(&per_cu, (const void*)mega_fwd, NTHREADS, LDS_BYTES);
        (void)hipGetLastError();
        grid = (per_cu >= 1) ? cus : -1;
    }
    if (grid < 0) return;
    hipMemsetAsync(d_ws, 0, CTL_BYTES, stream);
    Args a{};
    for (int i = 0; i < 38; ++i) a.in[i] = (const float*)d_in[i];
    a.out = (float*)d_out; a.ws = (unsigned char*)d_ws;
    hipLaunchKernelGGL(mega_fwd, dim3(grid), dim3(NTHREADS), LDS_BYTES, stream, a);
}
```

```cpp
#define OPT_MIX0 1
#define OPT_MIX1 1
#define OPT_ROUTER 1
#include <hip/hip_runtime.h>
#define GAS __attribute__((address_space(1)))
#define LAS __attribute__((address_space(3)))
#define XB_TMO      128
#define XB_XCNT(j)  (256  + 64 * (j))
#define XB_XSUB(j)  (1280 + 64 * (j))
#define XB_XGEN(j)  (2304 + 64 * (j))
#define XB_TOP      3328
#define XB_TOPGEN   3392
#define XCD_BAR_WORDS 3456
#define XB_SPIN_CAP (1u << 22)
__device__ __forceinline__ unsigned xb_ld(unsigned* p)              { return __hip_atomic_load(p, __ATOMIC_RELAXED, __HIP_MEMORY_SCOPE_AGENT); }
__device__ __forceinline__ unsigned xb_add(unsigned* p, unsigned v) { return __hip_atomic_fetch_add(p, v, __ATOMIC_RELAXED, __HIP_MEMORY_SCOPE_AGENT); }
__device__ __forceinline__ unsigned xb_xcc_id() { return (unsigned)__builtin_amdgcn_s_getreg((3 << 11) | 20) & 0xFu; }
#define XB_SPIN(cond, bar) do { unsigned _sp = 0; while (cond) { __builtin_amdgcn_s_sleep(1); \
    if ((++_sp & 255u) == 0u) { if (xb_ld(&(bar)[XB_TMO])) break; if (_sp > XB_SPIN_CAP) { atomicAdd(&(bar)[XB_TMO], 1u); break; } } } } while (0)
struct XcdBarrier { unsigned* bar; unsigned x; volatile LAS unsigned* st; };
__device__ __forceinline__ XcdBarrier xcd_barrier_post(unsigned* bar, volatile LAS unsigned* st) {
    XcdBarrier b; b.bar = bar; b.x = xb_xcc_id(); b.st = st;
    if (threadIdx.x == 0) (void)xb_add(&bar[XB_XCNT(b.x)], 1u);
    return b;
}
__device__ __forceinline__ void xcd_barrier_complete(unsigned* bar, unsigned x, unsigned& nloc, unsigned& nx) {
    const unsigned G = gridDim.x * gridDim.y * gridDim.z;
    unsigned sum, cnt, mine, sp = 0u;
    for (;;) {
        sum = 0u; cnt = 0u; mine = 0u;
#pragma unroll
        for (unsigned j = 0; j < 16; ++j) { const unsigned c = xb_ld(&bar[XB_XCNT(j)]); sum += c; cnt += (c > 0u) ? 1u : 0u; mine = (j == x) ? c : mine; }
        if (sum == G) break;
        __builtin_amdgcn_s_sleep(1);
        if ((++sp & 255u) == 0u) { if (xb_ld(&bar[XB_TMO])) break; if (sp > XB_SPIN_CAP) { atomicAdd(&bar[XB_TMO], 1u); break; } }
    }
    nloc = mine > 0u ? mine : 1u; nx = cnt > 0u ? cnt : 1u;
}
__device__ __forceinline__ void xcd_barrier(const XcdBarrier& b) {
    asm volatile("s_waitcnt vmcnt(0)" ::: "memory");
    __syncthreads();
    if (threadIdx.x == 0) {
        unsigned* bar = b.bar;
        __builtin_amdgcn_s_waitcnt(0);
        unsigned nloc = b.st[0], nx = b.st[1];
        if (nloc == 0u) { xcd_barrier_complete(bar, b.x, nloc, nx); b.st[0] = nloc; b.st[1] = nx; }
        const unsigned old = xb_add(&bar[XB_XSUB(b.x)], 1u);
        const unsigned gen = old / nloc;
        if (old + 1u == (gen + 1u) * nloc) {
            __builtin_amdgcn_fence(__ATOMIC_RELEASE, "agent");
            asm volatile("s_waitcnt vmcnt(0)" ::: "memory");
            const unsigned og = xb_add(&bar[XB_TOP], 1u);
            const unsigned tg = og / nx;
            if (og + 1u == (tg + 1u) * nx) xb_add(&bar[XB_TOPGEN], 1u);
            else XB_SPIN(xb_ld(&bar[XB_TOPGEN]) == tg, bar);
            __builtin_amdgcn_fence(__ATOMIC_ACQUIRE, "agent");
            xb_add(&bar[XB_XGEN(b.x)], 1u);
            asm volatile("s_waitcnt vmcnt(0)" ::: "memory");
        } else {
            XB_SPIN(xb_ld(&bar[XB_XGEN(b.x)]) == gen, bar);
            __builtin_amdgcn_fence(__ATOMIC_ACQUIRE, "agent");
            asm volatile("s_waitcnt vmcnt(0)" ::: "memory");
        }
    }
    __syncthreads();
}
namespace pg8 {
#define PG8_LAS __attribute__((address_space(3)))
typedef unsigned short bf16_t;
typedef short bf16x8 __attribute__((ext_vector_type(8)));
typedef float f32x4 __attribute__((ext_vector_type(4)));
typedef unsigned u32x4 __attribute__((ext_vector_type(4)));
constexpr int BM = 256, BK = 64, HALF = 128, HTB = HALF * BK * 2, STAGE_BYTES = 8 * HTB, NXCD = 8, WGM = 8;
__host__ __device__ __forceinline__ int lds_byte(int r, int c) { const int st = (r >> 4) * 2 + (c >> 5), rr = r & 15, cc = c & 31, ob = rr * 64 + cc * 2; return st * 1024 + (ob ^ (((ob >> 9) & 1) << 5)); }
__host__ __device__ __forceinline__ void stage_rc(int b, int& R, int& C) { const int st = b / 1024, sb = b % 1024, swz = sb ^ (((sb >> 9) & 1) << 5); R = (st >> 1) * 16 + swz / 64; C = (st & 1) * 32 + (swz % 64) / 2; }
__host__ __device__ __forceinline__ int perm32(int rho) { const int n = rho >> 4, i = rho & 15; return 8 * (i >> 2) + 4 * n + (i & 3); }
struct Unit { int pm, pn, e, aux; };
struct Gemm { const bf16_t* A; const bf16_t* Bt; int K; int pad; size_t bstride; const int* rows; };
struct StaticOrder {
    int nM, nN, nwg, G, c;
    __host__ __device__ void init(int M, int N, int G_, int c_) { nM = M / BM; nN = N / BM; nwg = nM * nN; G = G_; c = c_; }
    __host__ __device__ bool next(int i, Unit& u) const {
        const long L = (long)i * G + c; if (L >= nwg) return false;
        int wgid = (int)L; { const int q = nwg / NXCD, r = nwg % NXCD, xcd = wgid % NXCD, off = wgid / NXCD; wgid = (xcd < r ? xcd * (q + 1) : r * (q + 1) + (xcd - r) * q) + off; }
        const int nig = WGM * nN, gid = wgid / nig, fm = gid * WGM, gsz = (nM - fm) < WGM ? (nM - fm) : WGM;
        u.pm = fm + ((wgid % nig) % gsz); u.pn = (wgid % nig) / gsz; u.e = 0; u.aux = 0; return true;
    }
};
__device__ __forceinline__ unsigned cvt_pk_bf16(float lo, float hi) { unsigned r; asm volatile("v_cvt_pk_bf16_f32 %0, %1, %2" : "=v"(r) : "v"(lo), "v"(hi)); return r; }
struct EpiF32R {
    static constexpr int NPRE = 0; __device__ __forceinline__ void load_pre(const Unit&, int, int, int (&)[1]) const {}
    static constexpr bool PERM = false;
    float* C; int ldc; const float* R; float ralpha;
    __device__ __forceinline__ void operator()(const f32x4 (&acc)[2][2][4][2], const Unit& u, int wr, int wc, int fr, int fq) const {
        const int row0 = u.pm * BM + wr * 64 + fr, col0 = u.pn * BM + wc * 32 + 4 * fq;
#pragma unroll
        for (int ai = 0; ai < 2; ++ai)
#pragma unroll
            for (int m = 0; m < 4; ++m) { const size_t off = (size_t)(row0 + ai * HALF + m * 16) * ldc + col0;
#pragma unroll
                for (int bj = 0; bj < 2; ++bj)
#pragma unroll
                    for (int n = 0; n < 2; ++n) { f32x4 v = acc[ai][bj][m][n]; if (R) v = v + ralpha * *(const f32x4*)(R + off + bj * HALF + n * 16); *(f32x4*)(C + off + bj * HALF + n * 16) = v; } }
    }
};
struct EpiBf16P {
    static constexpr int NPRE = 0; __device__ __forceinline__ void load_pre(const Unit&, int, int, int (&)[1]) const {}
    static constexpr bool PERM = true;
    bf16_t* O; int ldc;
    __device__ __forceinline__ void operator()(const f32x4 (&acc)[2][2][4][2], const Unit& u, int wr, int wc, int fr, int fq) const {
        const int row0 = u.pm * BM + wr * 64 + fr, col0 = u.pn * BM + wc * 32 + 8 * fq;
#pragma unroll
        for (int ai = 0; ai < 2; ++ai)
#pragma unroll
            for (int m = 0; m < 4; ++m) { bf16_t* rowp = O + (size_t)(row0 + ai * HALF + m * 16) * ldc + col0;
#pragma unroll
                for (int bj = 0; bj < 2; ++bj) { const f32x4 v0 = acc[ai][bj][m][0], v1 = acc[ai][bj][m][1];
                    u32x4 w; w.x = cvt_pk_bf16(v0[0], v0[1]); w.y = cvt_pk_bf16(v0[2], v0[3]); w.z = cvt_pk_bf16(v1[0], v1[1]); w.w = cvt_pk_bf16(v1[2], v1[3]);
                    *(u32x4*)(rowp + bj * HALF) = w; } }
    }
};
struct EpiGlu {
    static constexpr int NPRE = 0; __device__ __forceinline__ void load_pre(const Unit&, int, int, int (&)[1]) const {}
    static constexpr bool PERM = true;
    bf16_t* O; int ldo; const bf16_t* Gm; int ldg; const float* bias;
    __device__ __forceinline__ void operator()(const f32x4 (&acc)[2][2][4][2], const Unit& u, int wr, int wc, int fr, int fq) const {
        const int row0 = u.pm * BM + wr * 64 + fr, col0 = u.pn * BM + wc * 32 + 8 * fq;
#pragma unroll
        for (int ai = 0; ai < 2; ++ai)
#pragma unroll
            for (int m = 0; m < 4; ++m) { const size_t r = (size_t)(row0 + ai * HALF + m * 16);
#pragma unroll
                for (int bj = 0; bj < 2; ++bj) { const int c = col0 + bj * HALF;
                    const f32x4 b0 = *(const f32x4*)(bias + c), b1 = *(const f32x4*)(bias + c + 4); const u32x4 gv = *(const u32x4*)(Gm + r * ldg + c);
                    const f32x4 v0 = acc[ai][bj][m][0] + b0, v1 = acc[ai][bj][m][1] + b1;
                    float g[8] = {__builtin_bit_cast(float, gv.x << 16), __builtin_bit_cast(float, gv.x & 0xffff0000u), __builtin_bit_cast(float, gv.y << 16), __builtin_bit_cast(float, gv.y & 0xffff0000u),
                                  __builtin_bit_cast(float, gv.z << 16), __builtin_bit_cast(float, gv.z & 0xffff0000u), __builtin_bit_cast(float, gv.w << 16), __builtin_bit_cast(float, gv.w & 0xffff0000u)};
                    u32x4 w; w.x = cvt_pk_bf16(g[0] * __builtin_amdgcn_rcpf(1.f + __expf(-v0[0])), g[1] * __builtin_amdgcn_rcpf(1.f + __expf(-v0[1]))); w.y = cvt_pk_bf16(g[2] * __builtin_amdgcn_rcpf(1.f + __expf(-v0[2])), g[3] * __builtin_amdgcn_rcpf(1.f + __expf(-v0[3])));
                    w.z = cvt_pk_bf16(g[4] * __builtin_amdgcn_rcpf(1.f + __expf(-v1[0])), g[5] * __builtin_amdgcn_rcpf(1.f + __expf(-v1[1]))); w.w = cvt_pk_bf16(g[6] * __builtin_amdgcn_rcpf(1.f + __expf(-v1[2])), g[7] * __builtin_amdgcn_rcpf(1.f + __expf(-v1[3])));
                    *(u32x4*)(O + r * ldo + c) = w; } }
    }
};
template <class Epi, class Sched, bool ALIGN_EPI, bool GATHER>
__device__ __forceinline__ void gemm_phase(PG8_LAS unsigned char* lds, const Gemm g, const Sched& S, const Epi& E) {
    int tid_ = threadIdx.x; asm volatile("" : "+v"(tid_));
    const int tid = tid_, wid = __builtin_amdgcn_readfirstlane(tid >> 6), lane = tid & 63, wr = wid >> 2, wc = wid & 3, fr = lane & 15, fq = lane >> 4;
    const int K = g.K, nt = K / BK;
    unsigned voffA[2], voffB[2];
#pragma unroll
    for (int i = 0; i < 2; ++i) { int R, C; stage_rc(tid * 16 + i * 8192, R, C); const int Rb = Epi::PERM ? ((R & ~31) + perm32(R & 31)) : R;
        voffA[i] = (unsigned)(R * K + C) * 2u; voffB[i] = (unsigned)(Rb * K + C) * 2u; }
    const size_t kstep = (size_t)(BK * 2);
    const size_t hstep = (size_t)HALF * K * 2;
    const size_t tstep = 2 * hstep;
    const unsigned ldsw = (unsigned)wid * 1024u;
    const int aoff = lds_byte(wr * 64 + fr, fq * 8), boff = lds_byte(wc * 32 + fr, fq * 8);
#define PG8_SA(b, h) (((b) * 2 + (h)) * HTB)
#define PG8_SB(b, h) ((4 + (b) * 2 + (h)) * HTB)
#define PG8_STAGE(bufoff, gbase, voff) do { _Pragma("unroll") for (int _i = 0; _i < 2; ++_i) { unsigned _vo = (voff)[_i]; asm volatile("" : "+v"(_vo));   \
        __builtin_amdgcn_global_load_lds((const unsigned*)((const char*)(gbase) + _vo), (PG8_LAS unsigned*)(lds + (bufoff) + ldsw + _i * 8192), 16, 0, 0); } } while (0)
#define PG8_STAGE_A(bufoff, gbase, h, GV) do { if constexpr (GATHER) { PG8_STAGE(bufoff, gbase, GV[h]); } else { PG8_STAGE(bufoff, (gbase) + (h) * hstep, voffA); } } while (0)
#define PG8_STAGE_A2(bufoff, gbase, h) do { if constexpr (GATHER) { unsigned _gv[2] = {last ? gnxt[h][0] : gcur[h][0], last ? gnxt[h][1] : gcur[h][1]}; PG8_STAGE(bufoff, gbase, _gv); } else { PG8_STAGE(bufoff, (gbase) + (h) * hstep, voffA); } } while (0)
#define PG8_LDA(dst, b, h) do { _Pragma("unroll") for (int m = 0; m < 4; ++m) _Pragma("unroll") for (int k = 0; k < 2; ++k) dst[m][k] = *(const PG8_LAS bf16x8*)(lds + PG8_SA(b, h) + aoff + m * 2048 + k * 1024); } while (0)
#define PG8_LDB(dst, b, h) do { _Pragma("unroll") for (int n = 0; n < 2; ++n) _Pragma("unroll") for (int k = 0; k < 2; ++k) dst[n][k] = *(const PG8_LAS bf16x8*)(lds + PG8_SB(b, h) + boff + n * 2048 + k * 1024); } while (0)
#define PG8_MMA(ai, bj, At, Bt) do { __builtin_amdgcn_s_setprio(1); _Pragma("unroll") for (int m = 0; m < 4; ++m) _Pragma("unroll") for (int n = 0; n < 2; ++n) _Pragma("unroll") for (int k = 0; k < 2; ++k) \
        acc[ai][bj][m][n] = __builtin_amdgcn_mfma_f32_16x16x32_bf16(Bt[n][k], At[m][k], acc[ai][bj][m][n], 0, 0, 0); __builtin_amdgcn_s_setprio(0); } while (0)
#define PG8_WAIT_V(n) asm volatile("s_waitcnt vmcnt(" #n ")" ::: "memory")
#define PG8_WAIT_L(n) asm volatile("s_waitcnt lgkmcnt(" #n ")" ::: "memory")
#define PG8_BAR __builtin_amdgcn_s_barrier()
#define PG8_SCHED __builtin_amdgcn_sched_barrier(0)
#define PG8_GLOAD(GV, u) do { _Pragma("unroll") for (int _i = 0; _i < 2; ++_i) { int _R, _C; stage_rc(tid * 16 + _i * 8192, _R, _C); _Pragma("unroll") for (int _h = 0; _h < 2; ++_h) \
        GV[_h][_i] = (unsigned)g.rows[(u).pm * BM + _h * HALF + _R] * (unsigned)(K * 2) + (unsigned)(_C * 2); } } while (0)
    Unit cur, nxt; int ui = 0;
    if (!S.next(0, cur)) return;
    f32x4 acc[2][2][4][2];
#pragma unroll
    for (int a = 0; a < 2; ++a)
#pragma unroll
        for (int b = 0; b < 2; ++b)
#pragma unroll
            for (int m = 0; m < 4; ++m)
#pragma unroll
                for (int n = 0; n < 2; ++n) acc[a][b][m][n] = (f32x4){0.f, 0.f, 0.f, 0.f};
    bf16x8 At[4][2], B0[2][2], B1[2][2];
    unsigned gcur[2][2] = {{0u, 0u}, {0u, 0u}}, gnxt[2][2] = {{0u, 0u}, {0u, 0u}};
    if constexpr (Epi::NPRE > 0) E.prefetch(cur, 0, lds, wid, lane);
    if constexpr (GATHER) { PG8_GLOAD(gcur, cur); }
    const char* cA = GATHER ? (const char*)g.A : (const char*)g.A + (size_t)cur.pm * tstep;
    const char* cB = (const char*)g.Bt + ((size_t)cur.e * g.bstride) * 2 + (size_t)cur.pn * tstep;
    PG8_STAGE(PG8_SB(0, 0), cB, voffB); PG8_STAGE(PG8_SB(0, 1), cB + hstep, voffB); PG8_STAGE_A(PG8_SA(0, 0), cA, 0, gcur); PG8_STAGE_A(PG8_SA(0, 1), cA, 1, gcur);
    if (wr == 1) PG8_BAR;
    PG8_WAIT_V(2); PG8_BAR;
    PG8_STAGE(PG8_SB(1, 0), cB + kstep, voffB); PG8_STAGE_A(PG8_SA(1, 0), cA + kstep, 0, gcur); PG8_STAGE(PG8_SB(1, 1), cB + hstep + kstep, voffB);
    PG8_WAIT_V(6); PG8_BAR;
    for (;;) {
        const bool has_next = S.next(ui + 1, nxt);
        if constexpr (Epi::NPRE > 0) { if (has_next) E.prefetch(nxt, (ui + 1) % 3, lds, wid, lane); }
        if constexpr (GATHER) { if (has_next) { PG8_GLOAD(gnxt, nxt); } else {
#pragma unroll
            for (int _h = 0; _h < 2; ++_h)
#pragma unroll
                for (int _i = 0; _i < 2; ++_i) gnxt[_h][_i] = gcur[_h][_i]; } }
        const char* nA = GATHER ? cA : (has_next ? (const char*)g.A + (size_t)nxt.pm * tstep : cA);
        const char* nB = has_next ? (const char*)g.Bt + ((size_t)nxt.e * g.bstride) * 2 + (size_t)nxt.pn * tstep : cB;
#pragma unroll 1
        for (int t = 0; t < nt; t += 2) {
            const bool last = (t == nt - 2);
            const char* a1 = cA + (size_t)(t + 1) * kstep;
            const char* a2 = last ? nA : cA + (size_t)(t + 2) * kstep; const char* b2 = last ? nB : cB + (size_t)(t + 2) * kstep;
            const char* a3 = a2 + kstep; const char* b3 = b2 + kstep;
            PG8_LDB(B0, 0, 0); PG8_LDB(B1, 0, 1); PG8_SCHED; PG8_LDA(At, 0, 0); PG8_STAGE_A(PG8_SA(1, 1), a1, 1, gcur);
            PG8_WAIT_V(8); PG8_WAIT_L(0); PG8_BAR; PG8_MMA(0, 0, At, B0); PG8_MMA(0, 1, At, B1); PG8_BAR; PG8_SCHED;
            PG8_LDA(At, 0, 1); PG8_STAGE(PG8_SB(0, 0), b2, voffB); PG8_STAGE(PG8_SB(0, 1), b2 + hstep, voffB); PG8_STAGE_A2(PG8_SA(0, 0), a2, 0);
            PG8_WAIT_V(8); PG8_WAIT_L(0); PG8_BAR; PG8_MMA(1, 0, At, B0); PG8_MMA(1, 1, At, B1); PG8_BAR; PG8_SCHED;
            PG8_LDB(B0, 1, 0); PG8_LDB(B1, 1, 1); PG8_SCHED; PG8_LDA(At, 1, 0); PG8_STAGE_A2(PG8_SA(0, 1), a2, 1);
            PG8_WAIT_V(8); PG8_WAIT_L(0); PG8_BAR; PG8_MMA(0, 0, At, B0); PG8_MMA(0, 1, At, B1); PG8_BAR; PG8_SCHED;
            PG8_LDA(At, 1, 1); PG8_STAGE(PG8_SB(1, 0), b3, voffB); PG8_STAGE(PG8_SB(1, 1), b3 + hstep, voffB); PG8_STAGE_A2(PG8_SA(1, 0), a3, 0);
            PG8_WAIT_V(8); PG8_WAIT_L(0); PG8_BAR; PG8_MMA(1, 0, At, B0); PG8_MMA(1, 1, At, B1); PG8_BAR; PG8_SCHED;
        }
        if constexpr (ALIGN_EPI) { if (wr == 0) PG8_BAR; }
        if constexpr (Epi::NPRE > 0) E(acc, cur, wr, wc, fr, fq, ui % 3, lds); else E(acc, cur, wr, wc, fr, fq);
        if (!has_next) break;
#pragma unroll
        for (int a = 0; a < 2; ++a)
#pragma unroll
            for (int b = 0; b < 2; ++b)
#pragma unroll
                for (int m = 0; m < 4; ++m)
#pragma unroll
                    for (int n = 0; n < 2; ++n) acc[a][b][m][n] = (f32x4){0.f, 0.f, 0.f, 0.f};
        cur = nxt; cA = nA; cB = nB; ++ui;
        if constexpr (GATHER) {
#pragma unroll
            for (int _h = 0; _h < 2; ++_h)
#pragma unroll
                for (int _i = 0; _i < 2; ++_i) gcur[_h][_i] = gnxt[_h][_i]; }
        if constexpr (ALIGN_EPI) { if (wr == 1) PG8_BAR; }
    }
    PG8_WAIT_V(0);
    if constexpr (!ALIGN_EPI) { if (wr == 0) PG8_BAR; }
    PG8_BAR;
#undef PG8_SA
#undef PG8_SB
#undef PG8_STAGE
#undef PG8_STAGE_A
#undef PG8_STAGE_A2
#undef PG8_LDA
#undef PG8_LDB
#undef PG8_MMA
#undef PG8_WAIT_V
#undef PG8_WAIT_L
#undef PG8_BAR
#undef PG8_SCHED
#undef PG8_GLOAD
}
}
typedef unsigned short bf16;
typedef unsigned v4u __attribute__((ext_vector_type(4)));
typedef unsigned v2u __attribute__((ext_vector_type(2)));
typedef float f32x4 __attribute__((ext_vector_type(4)));
constexpr int NTHREADS = 512, NWAVES = 8;
constexpr int LDS_BYTES = 163840;
constexpr int LDS_CTL = 155648;
constexpr int MISC_OFF = LDS_CTL + 320;
constexpr size_t MiB = 1u << 20;
constexpr size_t CTL_BYTES = 1 * MiB;
#if !defined(WITH_NAIVE)
namespace nv { constexpr int B_ = 2, S_ = 8192, T_ = B_ * S_, NCH = S_ / 64, EIN = 3080, OIN = 2064; constexpr float ALPHA = 1.41421356237309515f, EPS = 1e-5f; struct Mem { float* base; size_t off; }; }
#endif
constexpr int T_ = nv::T_, S_ = nv::S_, NCH = nv::NCH;
constexpr int EINP = 3328, OINP = 2304;
#define LDS_WAIT() asm volatile("s_waitcnt lgkmcnt(0)" ::: "memory")
typedef __bf16 hwbf2_t __attribute__((ext_vector_type(2)));
typedef float hwf2_t __attribute__((ext_vector_type(2)));
__device__ __forceinline__ unsigned f2bf(float f) { const __bf16 b = (__bf16)f; return (unsigned)__builtin_bit_cast(unsigned short, b); }
__device__ __forceinline__ unsigned pk2(float lo, float hi) { const hwf2_t v = {lo, hi}; return __builtin_bit_cast(unsigned, __builtin_convertvector(v, hwbf2_t)); }
__device__ __forceinline__ float bf2f(unsigned short b) { return __builtin_bit_cast(float, (unsigned)b << 16); }
__device__ __forceinline__ void tr_item(const float* W, long ldw, int nvalid, bf16* dst, long ldd, LAS float* scr, int lane) {
#pragma unroll 8
    for (int i = 0; i < 32; ++i) { const int kk = 2 * i + (lane >> 5), nn = lane & 31; scr[kk * 33 + nn] = nn < nvalid ? W[(long)kk * ldw + nn] : 0.f; }
    LDS_WAIT(); asm volatile("" ::: "memory");
    const int c = lane & 7;
#pragma unroll
    for (int j = 0; j < 4; ++j) { const int n = (lane >> 3) + 8 * j; const LAS float* s = scr + (8 * c) * 33 + n;
        v4u o; o.x = pk2(s[0 * 33], s[1 * 33]); o.y = pk2(s[2 * 33], s[3 * 33]); o.z = pk2(s[4 * 33], s[5 * 33]); o.w = pk2(s[6 * 33], s[7 * 33]);
        *(v4u*)(dst + (long)n * ldd + 8 * c) = o; }
    LDS_WAIT(); asm volatile("" ::: "memory");
}
__device__ __forceinline__ void tr_item64(const float* W, long ldw, int nvalid, bf16* dst, long ldd, LAS float* scr, int lane) {
    const int nn = (lane & 15) * 4;
#pragma unroll
    for (int i = 0; i < 16; ++i) { const int kk = 4 * i + (lane >> 4);
        f32x4 v = {0.f, 0.f, 0.f, 0.f}; if (nn < nvalid) v = *(const f32x4*)(W + (long)kk * ldw + nn);
        LAS float* s = scr + kk * 65 + nn; s[0] = v.x; s[1] = v.y; s[2] = v.z; s[3] = v.w; }
    LDS_WAIT(); asm volatile("" ::: "memory");
    const int c = lane & 7;
#pragma unroll
    for (int j = 0; j < 8; ++j) { const int n = (lane >> 3) + 8 * j; const LAS float* s = scr + (8 * c) * 65 + n;
        v4u o; o.x = pk2(s[0 * 65], s[1 * 65]); o.y = pk2(s[2 * 65], s[3 * 65]); o.z = pk2(s[4 * 65], s[5 * 65]); o.w = pk2(s[6 * 65], s[7 * 65]);
        *(v4u*)(dst + (long)n * ldd + 8 * c) = o; }
    LDS_WAIT(); asm volatile("" ::: "memory");
}
__device__ __forceinline__ void tr_matrix(const float* W, int K, int N, int NP, bf16* WT, LAS float* scr, int gw, int NGW, int lane) {
    const int nblk = NP / 64, nitems = (K / 64) * nblk;
    for (int it = gw; it < nitems; it += NGW) { const int kb = it / nblk, nb = it % nblk, k0 = 64 * kb, n0 = 64 * nb; int nvalid = N - n0; nvalid = nvalid < 0 ? 0 : (nvalid > 64 ? 64 : nvalid);
        tr_item64(W + (long)k0 * N + n0, N, nvalid, WT + (long)n0 * K + k0, K, scr, lane); }
}
__device__ __forceinline__ void tr_matrix_item(const float* W, int K, int N, int NP, bf16* WT, LAS float* scr, int it, int lane) {
    const int nblk = NP / 64, kb = it / nblk, nb = it % nblk, k0 = 64 * kb, n0 = 64 * nb; int nvalid = N - n0; nvalid = nvalid < 0 ? 0 : (nvalid > 64 ? 64 : nvalid);
    tr_item64(W + (long)k0 * N + n0, N, nvalid, WT + (long)n0 * K + k0, K, scr, lane);
}
__device__ __forceinline__ void cvt_rows(const float* src, bf16* dst, long n, long gtid, long gsz) {
    long i = gtid * 8;
    for (; i + 3 * gsz * 8 < n; i += 4 * gsz * 8) {
        f32x4 a[4], b[4];
#pragma unroll
        for (int u = 0; u < 4; ++u) { a[u] = *(const f32x4*)(src + i + u * gsz * 8); b[u] = *(const f32x4*)(src + i + u * gsz * 8 + 4); }
#pragma unroll
        for (int u = 0; u < 4; ++u) { v4u o; o.x = pk2(a[u].x, a[u].y); o.y = pk2(a[u].z, a[u].w); o.z = pk2(b[u].x, b[u].y); o.w = pk2(b[u].z, b[u].w); *(v4u*)(dst + i + u * gsz * 8) = o; } }
    for (; i < n; i += gsz * 8) { const f32x4 a = *(const f32x4*)(src + i), b = *(const f32x4*)(src + i + 4);
        v4u o; o.x = pk2(a.x, a.y); o.y = pk2(a.z, a.w); o.z = pk2(b.x, b.y); o.w = pk2(b.z, b.w); *(v4u*)(dst + i) = o; }
}
__device__ __forceinline__ int sopaque(int v) { asm volatile("" : "+s"(v)); return v; }
__device__ __forceinline__ float wave_sum(float v) {
#define WS_STEP(o) v += __builtin_bit_cast(float, __builtin_amdgcn_ds_swizzle(__builtin_bit_cast(int, v), 0x1f | ((o) << 10)))
    WS_STEP(1); WS_STEP(2); WS_STEP(4); WS_STEP(8); WS_STEP(16);
#undef WS_STEP
    return __builtin_bit_cast(float, __builtin_amdgcn_readlane(__builtin_bit_cast(int, v), 0)) + __builtin_bit_cast(float, __builtin_amdgcn_readlane(__builtin_bit_cast(int, v), 32));
}
#ifndef DBG_SCALE
#define DBG_SCALE 20.0f
#endif
constexpr int MOE_MAXBLK = 640;
constexpr int CW_CNT = 8192, CW_CUR = 8192 + 128;
namespace pg8 {
struct MoeOrder {
    const int* blk_e; int nblk, npn, G, c;
    __device__ __forceinline__ bool next(int i, Unit& u) const {
        const long L = (long)i * G + c; if (L >= (long)nblk * npn) return false;
        const int blk = (int)(L / npn); u.pm = blk; u.pn = (int)(L % npn); u.e = __builtin_amdgcn_readfirstlane(blk_e[blk]); u.aux = 0; return true;
    }
};
__device__ __forceinline__ float silu_f(float x) { return x * __builtin_amdgcn_rcpf(1.0f + __expf(-x)); }
struct EpiSwiGLU {
    static constexpr int NPRE = 0; __device__ __forceinline__ void load_pre(const Unit&, int, int, int (&)[1]) const {}
    static constexpr bool PERM = true;
    bf16_t* H;
    __device__ __forceinline__ void operator()(const f32x4 (&acc)[2][2][4][2], const Unit& u, int wr, int wc, int fr, int fq) const {
        const int row0 = u.pm * BM + wr * 64 + fr, col0 = u.pn * 128 + wc * 32 + 8 * fq;
#pragma unroll
        for (int ai = 0; ai < 2; ++ai)
#pragma unroll
            for (int m = 0; m < 4; ++m) { bf16_t* rowp = H + (size_t)(row0 + ai * HALF + m * 16) * 256 + col0;
                const f32x4 g0 = acc[ai][0][m][0], g1 = acc[ai][0][m][1], u0 = acc[ai][1][m][0], u1 = acc[ai][1][m][1];
                u32x4 w; w.x = cvt_pk_bf16(silu_f(g0[0]) * u0[0], silu_f(g0[1]) * u0[1]); w.y = cvt_pk_bf16(silu_f(g0[2]) * u0[2], silu_f(g0[3]) * u0[3]);
                w.z = cvt_pk_bf16(silu_f(g1[0]) * u1[0], silu_f(g1[1]) * u1[1]); w.w = cvt_pk_bf16(silu_f(g1[2]) * u1[2], silu_f(g1[3]) * u1[3]);
                *(u32x4*)rowp = w; }
    }
};
struct EpiDown {
    static constexpr bool PERM = true; static constexpr int NPRE = 1;
    bf16_t* rows8; bf16_t* rows_sh; const int* dest; int nslot8;
    __device__ __forceinline__ void prefetch(const Unit& u, int slot, PG8_LAS unsigned char* lds, int wid, int lane) const {
        if (wid < 4) __builtin_amdgcn_global_load_lds((const unsigned*)(dest + u.pm * BM + wid * 64 + lane), (PG8_LAS unsigned*)(lds + STAGE_BYTES + slot * 1024 + wid * 256), 4, 0, 0);
    }
    __device__ __forceinline__ void operator()(const f32x4 (&acc)[2][2][4][2], const Unit& u, int wr, int wc, int fr, int fq, int slot, PG8_LAS unsigned char* lds) const {
        const int col0 = u.pn * BM + wc * 32 + 8 * fq; const PG8_LAS int* dl = (const PG8_LAS int*)(lds + STAGE_BYTES + slot * 1024) + wr * 64 + fr;
#pragma unroll
        for (int ai = 0; ai < 2; ++ai)
#pragma unroll
            for (int m = 0; m < 4; ++m) { const int d = dl[ai * HALF + m * 16];
                if (d >= 0) { bf16_t* rowp = (d < nslot8 ? rows8 + (size_t)d * 1024 : rows_sh + (size_t)(d - nslot8) * 1024) + col0;
#pragma unroll
                    for (int bj = 0; bj < 2; ++bj) { const f32x4 v0 = acc[ai][bj][m][0], v1 = acc[ai][bj][m][1];
                        u32x4 o; o.x = cvt_pk_bf16(v0[0], v0[1]); o.y = cvt_pk_bf16(v0[2], v0[3]); o.z = cvt_pk_bf16(v1[0], v1[1]); o.w = cvt_pk_bf16(v1[2], v1[3]);
#if defined(NT_STORES)
                        __builtin_nontemporal_store(o, (u32x4*)(rowp + bj * HALF));
#else
                        *(u32x4*)(rowp + bj * HALF) = o;
#endif
                        } } }
    }
};
}
__device__ __forceinline__ void moe_convert_weights(const float* wg, const float* wu, const float* wd, const float* sg, const float* su, const float* sd,
                                                    bf16* WGU, bf16* WD, LAS float* scr, int first, int last, int stride, int lane) {
    for (int it = first; it < last; it += stride) {
        const int e = it / 192, r = it % 192, kind = r >> 6, q = r & 63;
        if (kind < 2) { const float* W = (e < 64 ? (kind == 0 ? wg : wu) + (size_t)e * 262144 : (kind == 0 ? sg : su));
            const int kb = q >> 2, nb = q & 3, k0 = 64 * kb, n0 = 64 * nb;
            tr_item64(W + (size_t)k0 * 256 + n0, 256, 64, WGU + ((size_t)e * 512 + (n0 >> 7) * 256 + (n0 & 127) + kind * 128) * 1024 + k0, 1024, scr, lane);
        } else { const float* W = e < 64 ? wd + (size_t)e * 262144 : sd;
            const int kb = q >> 4, nb = q & 15, k0 = 64 * kb, n0 = 64 * nb;
            tr_item64(W + (size_t)k0 * 1024 + n0, 1024, 64, WD + ((size_t)e * 1024 + n0) * 256 + k0, 256, scr, lane); }
    }
}
struct MoeLists { int* tok; int* dest; float* w; int* blk_e; };
__device__ __forceinline__ void moe_count(const int* ridx, unsigned* cnt, LAS unsigned* hist, int tid, int bid, int G) {
    if (tid < 64) hist[tid] = 0u;
    __syncthreads();
    for (int i = bid * NTHREADS + tid; i < T_ * 8; i += G * NTHREADS) atomicAdd((unsigned*)&hist[ridx[i]], 1u);
    __syncthreads();
    if (tid < 64 && hist[tid]) atomicAdd(&cnt[tid], hist[tid]);
    __syncthreads();
}
__device__ __forceinline__ void moe_build_lists(const int* ridx, const float* rwt, const unsigned* cnt, unsigned* cur, const MoeLists L, LAS int* sm, int tid, int bid, int G) {
    LAS int* pstart = sm; LAS unsigned* hist = (LAS unsigned*)(sm + 80); LAS unsigned* base = (LAS unsigned*)(sm + 160);
    if (tid == 0) { int acc = 0;
#pragma unroll 1
        for (int e = 0; e < 64; ++e) { pstart[e] = acc; acc += ((int)__hip_atomic_load(&cnt[e], __ATOMIC_RELAXED, __HIP_MEMORY_SCOPE_AGENT) + 255) & ~255; } pstart[64] = acc; pstart[65] = acc + T_; }
    __syncthreads();
    const int per = (T_ * 8 + G - 1) / G;
    const int lo = bid * per, hi = (lo + per < T_ * 8) ? lo + per : T_ * 8;
    for (int c0 = lo; c0 < hi; c0 += NTHREADS) {
        if (tid < 64) hist[tid] = 0u;
        __syncthreads();
        const int i = c0 + tid; int e = 0; unsigned local = 0u;
        if (i < hi) { e = ridx[i]; local = atomicAdd((unsigned*)&hist[e], 1u); }
        __syncthreads();
        if (tid < 64) base[tid] = hist[tid] ? atomicAdd(&cur[tid], hist[tid]) : 0u;
        __syncthreads();
        if (i < hi) { const int pos = pstart[e] + (int)base[e] + (int)local; L.tok[pos] = i >> 3; L.dest[pos] = i; L.w[pos] = rwt[i]; }
        __syncthreads();
    }
    for (int e = bid; e < 64; e += G) { const int c = (int)__hip_atomic_load(&cnt[e], __ATOMIC_RELAXED, __HIP_MEMORY_SCOPE_AGENT);
        for (int p = pstart[e] + c + tid; p < pstart[e + 1]; p += NTHREADS) { L.tok[p] = 0; L.dest[p] = -1; L.w[p] = 0.f; } }
    for (int t = bid * NTHREADS + tid; t < T_; t += G * NTHREADS) { const int p = pstart[64] + t; L.tok[p] = t; L.dest[p] = T_ * 8 + t; L.w[p] = 1.f; }
    const int nblk = pstart[65] >> 8;
    for (int b = bid * NTHREADS + tid; b < nblk; b += G * NTHREADS) { int e = 0;
#pragma unroll 1
        while (e < 64 && (pstart[e + 1] >> 8) <= b) ++e;
        L.blk_e[b] = e; }
    if (bid == 0 && tid == 0) L.blk_e[MOE_MAXBLK] = nblk;
    __syncthreads();
}
__device__ __forceinline__ void moe_combine_ln(float* h, const bf16* rows8, const bf16* rows_sh, const float* rwt, const float* lw, const float* lb, bf16* hbf, int gw, int NGW, int lane) {
    int t = gw; if (t >= T_) return;
    v4u rr[2][9]; f32x4 hh[4]; float wk[8];
#define CB_LOAD(tt) do { const size_t _t = (size_t)(tt); \
        _Pragma("unroll") for (int half = 0; half < 2; ++half) { const int c0 = half * 512 + lane * 8; \
            hh[half * 2] = *(const f32x4*)(h + _t * 1024 + c0); hh[half * 2 + 1] = *(const f32x4*)(h + _t * 1024 + c0 + 4); \
            _Pragma("unroll") for (int k = 0; k < 9; ++k) rr[half][k] = *(const v4u*)((k < 8 ? rows8 + (_t * 8 + k) * 1024 : rows_sh + _t * 1024) + c0); } \
        _Pragma("unroll") for (int k = 0; k < 8; ++k) wk[k] = rwt[_t * 8 + k]; } while (0)
    CB_LOAD(t);
    for (; t < T_; t += NGW) {
        float v[16];
#pragma unroll
        for (int half = 0; half < 2; ++half) { const f32x4 a = hh[half * 2], b = hh[half * 2 + 1];
            float s[8] = {a.x * nv::ALPHA, a.y * nv::ALPHA, a.z * nv::ALPHA, a.w * nv::ALPHA, b.x * nv::ALPHA, b.y * nv::ALPHA, b.z * nv::ALPHA, b.w * nv::ALPHA};
#pragma unroll
            for (int k = 0; k < 9; ++k) { const v4u r = rr[half][k]; const float w = k < 8 ? wk[k] : 1.0f;
                s[0] += w * __builtin_bit_cast(float, r.x << 16); s[1] += w * __builtin_bit_cast(float, r.x & 0xffff0000u);
                s[2] += w * __builtin_bit_cast(float, r.y << 16); s[3] += w * __builtin_bit_cast(float, r.y & 0xffff0000u);
                s[4] += w * __builtin_bit_cast(float, r.z << 16); s[5] += w * __builtin_bit_cast(float, r.z & 0xffff0000u);
                s[6] += w * __builtin_bit_cast(float, r.w << 16); s[7] += w * __builtin_bit_cast(float, r.w & 0xffff0000u); }
#pragma unroll
            for (int j = 0; j < 8; ++j) v[half * 8 + j] = s[j]; }
        if (t + NGW < T_) CB_LOAD(t + NGW);
        float sum = 0.f;
#pragma unroll
        for (int j = 0; j < 16; ++j) sum += v[j];
        sum = wave_sum(sum);
        const float mean = sum * (1.f / 1024.f);
        float sq = 0.f;
#pragma unroll
        for (int j = 0; j < 16; ++j) { v[j] -= mean; sq += v[j] * v[j]; }
        sq = wave_sum(sq);
        const float rstd = 1.0f / sqrtf(sq * (1.f / 1024.f) + nv::EPS);
#pragma unroll
        for (int half = 0; half < 2; ++half) { const int c0 = half * 512 + lane * 8;
            const f32x4 w0 = *(const f32x4*)(lw + c0), w1 = *(const f32x4*)(lw + c0 + 4), b0 = *(const f32x4*)(lb + c0), b1 = *(const f32x4*)(lb + c0 + 4);
            f32x4 o0, o1;
            o0.x = v[half * 8 + 0] * rstd * w0.x + b0.x; o0.y = v[half * 8 + 1] * rstd * w0.y + b0.y; o0.z = v[half * 8 + 2] * rstd * w0.z + b0.z; o0.w = v[half * 8 + 3] * rstd * w0.w + b0.w;
            o1.x = v[half * 8 + 4] * rstd * w1.x + b1.x; o1.y = v[half * 8 + 5] * rstd * w1.y + b1.y; o1.z = v[half * 8 + 6] * rstd * w1.z + b1.z; o1.w = v[half * 8 + 7] * rstd * w1.w + b1.w;
            *(f32x4*)(h + (size_t)t * 1024 + c0) = o0; *(f32x4*)(h + (size_t)t * 1024 + c0 + 4) = o1;
            if (hbf) { v4u p; p.x = pk2(o0.x, o0.y); p.y = pk2(o0.z, o0.w); p.z = pk2(o1.x, o1.y); p.w = pk2(o1.z, o1.w); *(v4u*)(hbf + (size_t)t * 1024 + c0) = p; } }
    }
#undef CB_LOAD
}
typedef float f32x16 __attribute__((ext_vector_type(16)));
typedef short s16x8 __attribute__((ext_vector_type(8)));
typedef LAS unsigned short lbf16;
__device__ __forceinline__ void mm32(f32x16& acc, const lbf16* A, int lda, const lbf16* B, int ldb, int K, int lane) {
    const lbf16* ap = A + (lane & 31) * lda + 8 * (lane >> 5);
    const lbf16* bp = B + (lane & 31) * ldb + 8 * (lane >> 5);
#pragma unroll 4
    for (int k = 0; k < K; k += 16) {
        const s16x8 a = *(const LAS s16x8*)(ap + k), b = *(const LAS s16x8*)(bp + k);
        acc = __builtin_amdgcn_mfma_f32_32x32x16_bf16(a, b, acc, 0, 0, 0);
    }
}
__device__ __forceinline__ void mm32_gb(f32x16& acc, const lbf16* A, int lda, const bf16* B, int ldb, int K, int lane) {
    const lbf16* ap = A + (lane & 31) * lda + 8 * (lane >> 5);
    const bf16* bp = B + (size_t)(lane & 31) * ldb + 8 * (lane >> 5);
#pragma unroll 4
    for (int k = 0; k < K; k += 16) {
        const s16x8 a = *(const LAS s16x8*)(ap + k), b = *(const s16x8*)(bp + k);
        acc = __builtin_amdgcn_mfma_f32_32x32x16_bf16(a, b, acc, 0, 0, 0);
    }
}
__device__ __forceinline__ int rowmap(int r, int lane) { return (r & 3) + 8 * (r >> 2) + 4 * (lane >> 5); }
__device__ __forceinline__ float rcp_f(float x) { return __builtin_amdgcn_rcpf(x); }
__device__ __forceinline__ float sigm_f(float x) { return rcp_f(1.0f + __expf(-x)); }
__device__ __forceinline__ float logsig_f(float x) { return fminf(x, 0.f) - __logf(1.0f + __expf(-fabsf(x))); }
__device__ __forceinline__ float softplus_f(float x) { return fmaxf(x, 0.f) + __logf(1.0f + __expf(-fabsf(x))); }
__device__ __forceinline__ float gelu_f(float x) { const float u = 0.7978845608028654f * (x + 0.044715f * x * x * x); return x * rcp_f(1.0f + __expf(-2.0f * u)); }
__device__ __forceinline__ void unpack8(const v4u r, float (&f)[8]) {
    f[0] = __builtin_bit_cast(float, r.x << 16); f[1] = __builtin_bit_cast(float, r.x & 0xffff0000u); f[2] = __builtin_bit_cast(float, r.y << 16); f[3] = __builtin_bit_cast(float, r.y & 0xffff0000u);
    f[4] = __builtin_bit_cast(float, r.z << 16); f[5] = __builtin_bit_cast(float, r.z & 0xffff0000u); f[6] = __builtin_bit_cast(float, r.w << 16); f[7] = __builtin_bit_cast(float, r.w & 0xffff0000u);
}
__device__ __forceinline__ v4u pack8(const float (&f)[8]) { v4u o; o.x = pk2(f[0], f[1]); o.y = pk2(f[2], f[3]); o.z = pk2(f[4], f[5]); o.w = pk2(f[6], f[7]); return o; }

struct Mix0Bufs { const bf16* proj; bf16* ct; float* nloc; float* blast; float* mloc; float* mprev; bf16* hloc; bf16* pc; float* carA; float* carU; float* carI; float* gst; bf16* mixbf; const bf16* lruw; };
constexpr int PJ0 = EINP;
__device__ __forceinline__ float lane_shr(float v, int o, int lane) { return __builtin_bit_cast(float, __builtin_amdgcn_ds_bpermute(((lane - o) & 63) << 2, __builtin_bit_cast(int, v))); }
__device__ __forceinline__ float wave_scan_add(float v, int lane) {
#pragma unroll
    for (int o = 1; o < 64; o <<= 1) { const float t = lane_shr(v, o, lane); v += (lane >= o) ? t : 0.f; }
    return v; }
__device__ __forceinline__ float wave_scan_max(float v, int lane) {
#pragma unroll
    for (int o = 1; o < 64; o <<= 1) { const float t = lane_shr(v, o, lane); v = (lane >= o) ? fmaxf(v, t) : v; }
    return v; }

__device__ __forceinline__ void mlstm_a_item(const Mix0Bufs& B, const float* gate_b, int cn, LAS unsigned char* lds, int tid) {
    const int lane = tid & 63, wave = __builtin_amdgcn_readfirstlane(tid >> 6);
    const int bh = cn / NCH, n = cn % NCH, b = bh >> 2, h = bh & 3;
    const size_t t0 = (size_t)b * S_ + n * 64;
    LAS float* pw = (LAS float*)lds;
    lbf16* kT = (lbf16*)(lds + 1024); lbf16* vT = (lbf16*)(lds + 1024 + 128 * 72 * 2);
    v4u gk[2], gv[2];
#pragma unroll
    for (int it = 0; it < 2; ++it) { const int vi = tid + it * 512, l = vi & 63, g = vi >> 6; const bf16* pr = B.proj + (t0 + l) * PJ0 + h * 128 + g * 8; gk[it] = *(const v4u*)(pr + 512); gv[it] = *(const v4u*)(pr + 1024); }
    if (wave == 0) { const bf16* pr = B.proj + (t0 + lane) * PJ0;
        const float lfv = logsig_f(bf2f(pr[2052 + h]) + gate_b[4 + h]), ig = bf2f(pr[2048 + h]) + gate_b[h];
        const float bcv = wave_scan_add(lfv, lane), wlv = ig - bcv, pmv = wave_scan_max(wlv, lane);
        const float blast = __builtin_bit_cast(float, __builtin_amdgcn_readlane(__builtin_bit_cast(int, bcv), 63)), mx = __builtin_bit_cast(float, __builtin_amdgcn_readlane(__builtin_bit_cast(int, pmv), 63));
        pw[lane] = __expf(wlv - mx) * 0.08838834764831845f;
        float* gs = B.gst + (size_t)cn * 192; gs[lane] = bcv; gs[64 + lane] = wlv; gs[128 + lane] = pmv;
        if (lane == 0) { B.blast[cn] = blast; B.mloc[cn] = blast + mx; } }
    __syncthreads();
#pragma unroll
    for (int it = 0; it < 2; ++it) { const int vi = tid + it * 512, l = vi & 63, g = vi >> 6;
        float kf[8], vf[8]; unpack8(gk[it], kf); unpack8(gv[it], vf);
        const float p = pw[l];
#pragma unroll
        for (int j = 0; j < 8; ++j) { kT[(g * 8 + j) * 72 + l] = (unsigned short)f2bf(kf[j] * p); vT[(g * 8 + j) * 72 + l] = (unsigned short)f2bf(vf[j]); } }
    __syncthreads();
    const int et = wave >> 1;
#pragma unroll
    for (int q = 0; q < 2; ++q) { const int dt = (wave & 1) * 2 + q;
        f32x16 acc = {0.f, 0.f, 0.f, 0.f, 0.f, 0.f, 0.f, 0.f, 0.f, 0.f, 0.f, 0.f, 0.f, 0.f, 0.f, 0.f};
        mm32(acc, kT + dt * 32 * 72, 72, vT + et * 32 * 72, 72, 64, lane);
        bf16* out = B.ct + (size_t)cn * 16384 + (et * 4 + dt) * 1024 + lane * 16;
        v4u o0, o1; o0.x = pk2(acc[0], acc[1]); o0.y = pk2(acc[2], acc[3]); o0.z = pk2(acc[4], acc[5]); o0.w = pk2(acc[6], acc[7]);
        o1.x = pk2(acc[8], acc[9]); o1.y = pk2(acc[10], acc[11]); o1.z = pk2(acc[12], acc[13]); o1.w = pk2(acc[14], acc[15]);
        *(v4u*)out = o0; *(v4u*)(out + 8) = o1; }
    { const int d = tid >> 2, qq = tid & 3; float f0[8], f1[8]; unpack8(*(const LAS v4u*)(kT + d * 72 + qq * 16), f0); unpack8(*(const LAS v4u*)(kT + d * 72 + qq * 16 + 8), f1);
      float sacc = 0.f;
#pragma unroll
      for (int j = 0; j < 8; ++j) sacc += f0[j] + f1[j];
      sacc += __builtin_bit_cast(float, __builtin_amdgcn_ds_swizzle(__builtin_bit_cast(int, sacc), 0x1f | (1 << 10)));
      sacc += __builtin_bit_cast(float, __builtin_amdgcn_ds_swizzle(__builtin_bit_cast(int, sacc), 0x1f | (2 << 10)));
      if (qq == 0) B.nloc[(size_t)cn * 128 + d] = sacc; }
    __syncthreads();
}
__device__ __forceinline__ void mlstm_b(const Mix0Bufs& B, int gtid, int gsz) {
    for (int idx = gtid; idx < 8 * 8192 + 8 * 128; idx += gsz) {
        const bool isn = idx >= 8 * 8192;
        if (!isn) { const int bh = idx >> 13, pe = idx & 8191;
            float s0 = 0.f, s1 = 0.f, m = 0.f; unsigned* p = (unsigned*)B.ct + (size_t)bh * NCH * 8192 + pe;
            for (int n0 = 0; n0 < NCH; n0 += 16) { unsigned cl[16]; float bl[16], ml[16];
#pragma unroll
                for (int j = 0; j < 16; ++j) { cl[j] = p[(size_t)(n0 + j) * 8192]; bl[j] = B.blast[bh * NCH + n0 + j]; ml[j] = B.mloc[bh * NCH + n0 + j]; }
#pragma unroll
                for (int j = 0; j < 16; ++j) { const unsigned out = pk2(s0, s1); const float mn = fmaxf(bl[j] + m, ml[j]), kf = __expf(bl[j] + m - mn), af = __expf(ml[j] - mn);
                    s0 = kf * s0 + af * __builtin_bit_cast(float, cl[j] << 16); s1 = kf * s1 + af * __builtin_bit_cast(float, cl[j] & 0xffff0000u);
                    if (pe == 0) B.mprev[bh * NCH + n0 + j] = m;
                    m = mn; cl[j] = out; }
#pragma unroll
                for (int j = 0; j < 16; ++j) p[(size_t)(n0 + j) * 8192] = cl[j]; }
        } else { const int r = idx - 8 * 8192, bh = r >> 7, de = r & 127;
            float st = 0.f, m = 0.f; float* p = B.nloc + (size_t)bh * NCH * 128 + de;
            for (int n0 = 0; n0 < NCH; n0 += 16) { float cl[16], bl[16], ml[16];
#pragma unroll
                for (int j = 0; j < 16; ++j) { cl[j] = p[(size_t)(n0 + j) * 128]; bl[j] = B.blast[bh * NCH + n0 + j]; ml[j] = B.mloc[bh * NCH + n0 + j]; }
#pragma unroll
                for (int j = 0; j < 16; ++j) { const float out = st; const float mn = fmaxf(bl[j] + m, ml[j]);
                    st = __expf(bl[j] + m - mn) * st + __expf(ml[j] - mn) * cl[j]; m = mn; cl[j] = out; }
#pragma unroll
                for (int j = 0; j < 16; ++j) p[(size_t)(n0 + j) * 128] = cl[j]; } }
    }
}
__device__ __forceinline__ void mlstm_c_item(const Mix0Bufs& B, const float* gate_b, const float* norm_w, int cn, LAS unsigned char* lds, int tid) {
    const int lane = tid & 63, wave = __builtin_amdgcn_readfirstlane(tid >> 6);
    const int bh = cn / NCH, n = cn % NCH, b = bh >> 2, h = bh & 3;
    const size_t t0 = (size_t)b * S_ + n * 64;
    LAS float* bm = (LAS float*)lds; LAS float* wl = bm + 64; LAS float* den = bm + 256; LAS float* emi = bm + 320;
    lbf16* qs = (lbf16*)(lds + 2048); lbf16* ks = (lbf16*)(lds + 19456); lbf16* qw = (lbf16*)(lds + 36864);
    lbf16* vT = (lbf16*)(lds + 54272); lbf16* cT = (lbf16*)(lds + 77312); lbf16* sm = (lbf16*)(lds + 120832);
    LAS float* hb = (LAS float*)(lds + 2048);
    const float mprev = B.mprev[cn];
    const float* gs = B.gst + (size_t)cn * 192;
    v4u gq[2], gk[2], gv[2], go[2], gc[4]; float sb[2], sp[2];
#pragma unroll
    for (int it = 0; it < 2; ++it) { const int vi = tid + it * 512; { const int l = vi >> 4, g = vi & 15; const bf16* pr = B.proj + (t0 + l) * PJ0 + h * 128 + g * 8; gq[it] = *(const v4u*)pr; gk[it] = *(const v4u*)(pr + 512); sb[it] = gs[l]; sp[it] = gs[128 + l]; }
        { const int l = vi & 63, g = vi >> 6; gv[it] = *(const v4u*)(B.proj + (t0 + l) * PJ0 + 1024 + h * 128 + g * 8); } }
    { const bf16* cg = B.ct + (size_t)cn * 16384;
#pragma unroll
      for (int it = 0; it < 4; ++it) gc[it] = *(const v4u*)(cg + (tid + it * 512) * 8); }
    { const int i = tid >> 3, sub = tid & 7; const bf16* op = B.proj + (t0 + i) * PJ0 + 1536 + h * 128 + sub * 16; go[0] = *(const v4u*)op; go[1] = *(const v4u*)(op + 8); }
    const float gnl = tid < 128 ? B.nloc[(size_t)cn * 128 + tid] : 0.f;
    if (wave == 0) { const float bi = gs[lane], wv = gs[64 + lane], pm = gs[128 + lane]; const float m = bi + fmaxf(mprev, pm);
        bm[lane] = bi - m; wl[lane] = wv; emi[lane] = __expf(-m); vT[128 * 72 + lane] = (unsigned short)0x3f80; }
#pragma unroll
    for (int it = 0; it < 2; ++it) { const int vi = tid + it * 512, l = vi >> 4, g = vi & 15;
        float qf[8], kf[8]; unpack8(gq[it], qf); unpack8(gk[it], kf);
        const float w = __expf(mprev - fmaxf(mprev, sp[it])); float qwf[8];
#pragma unroll
        for (int j = 0; j < 8; ++j) { kf[j] *= 0.08838834764831845f; qwf[j] = qf[j] * w; }
        *(LAS v4u*)(qs + l * 136 + g * 8) = gq[it]; *(LAS v4u*)(ks + l * 136 + g * 8) = pack8(kf); *(LAS v4u*)(qw + l * 136 + g * 8) = pack8(qwf); }
#pragma unroll
    for (int it = 0; it < 2; ++it) { const int vi = tid + it * 512, l = vi & 63, g = vi >> 6;
        float vf[8]; unpack8(gv[it], vf);
#pragma unroll
        for (int j = 0; j < 8; ++j) vT[(g * 8 + j) * 72 + l] = (unsigned short)f2bf(vf[j]); }
#pragma unroll
    for (int it = 0; it < 4; ++it) { const int vi = tid + it * 512, T = vi >> 7, ln = (vi >> 1) & 63, hr = vi & 1; const v4u x = gc[it];
        LAS unsigned char* dp = (LAS unsigned char*)(cT + ((T >> 2) * 32 + (ln & 31)) * 136 + (T & 3) * 32 + 16 * hr + 4 * (ln >> 5));
        *(LAS v2u*)dp = (v2u){x.x, x.y}; *(LAS v2u*)(dp + 16) = (v2u){x.z, x.w}; }
    if (tid < 128) cT[128 * 136 + tid] = (unsigned short)f2bf(gnl);
    __syncthreads();
    if (wave < 4) { const int it = wave >> 1, jt = wave & 1;
        f32x16 acc = {0.f, 0.f, 0.f, 0.f, 0.f, 0.f, 0.f, 0.f, 0.f, 0.f, 0.f, 0.f, 0.f, 0.f, 0.f, 0.f};
        if (jt <= it) mm32(acc, ks + jt * 32 * 136, 136, qs + it * 32 * 136, 136, 128, lane);
        const int i = it * 32 + (lane & 31); const float bmi = bm[i];
#pragma unroll
        for (int g4 = 0; g4 < 4; ++g4) { const int j0 = jt * 32 + 8 * g4 + 4 * (lane >> 5); const f32x4 w4 = *(const LAS f32x4*)(wl + j0);
            const float v0 = j0 <= i ? acc[g4 * 4] * __expf(bmi + w4.x) : 0.f, v1 = j0 + 1 <= i ? acc[g4 * 4 + 1] * __expf(bmi + w4.y) : 0.f;
            const float v2 = j0 + 2 <= i ? acc[g4 * 4 + 2] * __expf(bmi + w4.z) : 0.f, v3 = j0 + 3 <= i ? acc[g4 * 4 + 3] * __expf(bmi + w4.w) : 0.f;
            *(LAS v2u*)(sm + i * 72 + j0) = (v2u){pk2(v0, v1), pk2(v2, v3)}; } }
    __syncthreads();
    f32x16 accA = {0.f, 0.f, 0.f, 0.f, 0.f, 0.f, 0.f, 0.f, 0.f, 0.f, 0.f, 0.f, 0.f, 0.f, 0.f, 0.f}, accB = accA;
    { const int id = wave, it = id / 5, nt = id % 5;
      mm32(accA, vT + nt * 32 * 72, 72, sm + it * 32 * 72, 72, 64, lane); mm32(accA, cT + nt * 32 * 136, 136, qw + it * 32 * 136, 136, 128, lane);
      if (nt == 4 && lane < 32) den[it * 32 + lane] = accA[0]; }
    if (wave < 2) { const int id = wave + 8, it = id / 5, nt = id % 5;
      mm32(accB, vT + nt * 32 * 72, 72, sm + it * 32 * 72, 72, 64, lane); mm32(accB, cT + nt * 32 * 136, 136, qw + it * 32 * 136, 136, 128, lane);
      if (nt == 4 && lane < 32) den[it * 32 + lane] = accB[0]; }
    __syncthreads();
    { const int id = wave, it = id / 5, nt = id % 5;
      if (nt < 4) { const int i = it * 32 + (lane & 31); const float rd = rcp_f(fmaxf(fabsf(den[i]), emi[i]));
#pragma unroll
          for (int g4 = 0; g4 < 4; ++g4) *(LAS f32x4*)(hb + i * 132 + nt * 32 + 8 * g4 + 4 * (lane >> 5)) = (f32x4){accA[g4 * 4] * rd, accA[g4 * 4 + 1] * rd, accA[g4 * 4 + 2] * rd, accA[g4 * 4 + 3] * rd}; } }
    if (wave < 2) { const int id = wave + 8, it = id / 5, nt = id % 5;
      if (nt < 4) { const int i = it * 32 + (lane & 31); const float rd = rcp_f(fmaxf(fabsf(den[i]), emi[i]));
#pragma unroll
          for (int g4 = 0; g4 < 4; ++g4) *(LAS f32x4*)(hb + i * 132 + nt * 32 + 8 * g4 + 4 * (lane >> 5)) = (f32x4){accB[g4 * 4] * rd, accB[g4 * 4 + 1] * rd, accB[g4 * 4 + 2] * rd, accB[g4 * 4 + 3] * rd}; } }
    __syncthreads();
    { const int i = tid >> 3, sub = tid & 7; const LAS float* hr = hb + i * 132 + sub * 16;
      float x[16]; float s = 0.f;
#pragma unroll
      for (int j = 0; j < 16; ++j) { x[j] = hr[j]; s += x[j]; }
      s += __builtin_bit_cast(float, __builtin_amdgcn_ds_swizzle(__builtin_bit_cast(int, s), 0x1f | (1 << 10)));
      s += __builtin_bit_cast(float, __builtin_amdgcn_ds_swizzle(__builtin_bit_cast(int, s), 0x1f | (2 << 10)));
      s += __builtin_bit_cast(float, __builtin_amdgcn_ds_swizzle(__builtin_bit_cast(int, s), 0x1f | (4 << 10)));
      const float mean = s * (1.f / 128.f); float q = 0.f;
#pragma unroll
      for (int j = 0; j < 16; ++j) { x[j] -= mean; q += x[j] * x[j]; }
      q += __builtin_bit_cast(float, __builtin_amdgcn_ds_swizzle(__builtin_bit_cast(int, q), 0x1f | (1 << 10)));
      q += __builtin_bit_cast(float, __builtin_amdgcn_ds_swizzle(__builtin_bit_cast(int, q), 0x1f | (2 << 10)));
      q += __builtin_bit_cast(float, __builtin_amdgcn_ds_swizzle(__builtin_bit_cast(int, q), 0x1f | (4 << 10)));
      const float rstd = __builtin_amdgcn_rsqf(q * (1.f / 128.f) + nv::EPS);
      const float* nw = norm_w + h * 128 + sub * 16;
      float o0[8], o1[8]; unpack8(go[0], o0); unpack8(go[1], o1);
      float y0[8], y1[8];
#pragma unroll
      for (int j = 0; j < 8; ++j) { y0[j] = x[j] * rstd * nw[j] * sigm_f(o0[j]); y1[j] = x[8 + j] * rstd * nw[8 + j] * sigm_f(o1[j]); }
      bf16* dst = B.mixbf + (t0 + i) * 1024 + h * 128 + sub * 16;
      *(v4u*)dst = pack8(y0); *(v4u*)(dst + 8) = pack8(y1); }
    __syncthreads();
}
__device__ __forceinline__ void lru_a_item(const Mix0Bufs& B, const float* const* in, int ch, LAS unsigned char* lds, int tid) {
    const int lane = tid & 63, wave = __builtin_amdgcn_readfirstlane(tid >> 6);
    const size_t t0 = (size_t)ch * 64; const int s0 = (ch % NCH) * 64;
    lbf16* xc = (lbf16*)lds; LAS float* al = (LAS float*)(lds + 17408); LAS float* ul = (LAS float*)(lds + 17408 + 32768); LAS float* seg = (LAS float*)(lds + 17408 + 65536);
    const float* cw = in[9]; const float* cb = in[10]; const float* ba = in[12]; const float* bx = in[14]; const float* lam = in[15];
    for (int hh = 0; hh < 4; ++hh) {
        const int it = wave & 1, nt = wave >> 1;
        s16x8 wr[8], wx[8];
        { const bf16* bp = B.lruw + (size_t)(hh * 128 + nt * 32 + (lane & 31)) * 128 + 8 * (lane >> 5);
#pragma unroll
          for (int k = 0; k < 8; ++k) { wr[k] = *(const s16x8*)(bp + k * 16); wx[k] = *(const s16x8*)(bp + (size_t)512 * 128 + k * 16); } }
        { const int g = tid & 15, lr = tid >> 4, c0 = hh * 128 + g * 8;
          float xf[5][8];
#pragma unroll
          for (int k = 0; k < 5; ++k) { const int l = 2 * lr - 3 + k; v4u x = {0u, 0u, 0u, 0u}; if (s0 + l >= 0) x = *(const v4u*)(B.proj + (t0 + l) * PJ0 + 2056 + c0); unpack8(x, xf[k]); }
          float a0[8], a1[8];
#pragma unroll
          for (int j = 0; j < 8; ++j) { a0[j] = cb[c0 + j]; a1[j] = a0[j]; }
#pragma unroll
          for (int tap = 0; tap < 4; ++tap) {
#pragma unroll
              for (int j = 0; j < 8; ++j) { const float w = cw[tap * 512 + c0 + j]; a0[j] += w * xf[tap][j]; a1[j] += w * xf[tap + 1][j]; } }
          *(LAS v4u*)(xc + (2 * lr) * 136 + g * 8) = pack8(a0); *(LAS v4u*)(xc + (2 * lr + 1) * 136 + g * 8) = pack8(a1);
          *(LAS f32x4*)(ul + (2 * lr) * 128 + g * 8) = (f32x4){a0[0], a0[1], a0[2], a0[3]}; *(LAS f32x4*)(ul + (2 * lr) * 128 + g * 8 + 4) = (f32x4){a0[4], a0[5], a0[6], a0[7]};
          *(LAS f32x4*)(ul + (2 * lr + 1) * 128 + g * 8) = (f32x4){a1[0], a1[1], a1[2], a1[3]}; *(LAS f32x4*)(ul + (2 * lr + 1) * 128 + g * 8 + 4) = (f32x4){a1[4], a1[5], a1[6], a1[7]}; }
        __syncthreads();
        { f32x16 ra = {0.f, 0.f, 0.f, 0.f, 0.f, 0.f, 0.f, 0.f, 0.f, 0.f, 0.f, 0.f, 0.f, 0.f, 0.f, 0.f}, xa = ra;
          const lbf16* ap = xc + (it * 32 + (lane & 31)) * 136 + 8 * (lane >> 5);
#pragma unroll
          for (int k = 0; k < 8; ++k) { const s16x8 a = *(const LAS s16x8*)(ap + k * 16);
              ra = __builtin_amdgcn_mfma_f32_32x32x16_bf16(a, wr[k], ra, 0, 0, 0); xa = __builtin_amdgcn_mfma_f32_32x32x16_bf16(a, wx[k], xa, 0, 0, 0); }
          const int c = nt * 32 + (lane & 31), cg = hh * 128 + c; const float bav = ba[cg], bxv = bx[cg], sp = softplus_f(-lam[cg]);
#pragma unroll
          for (int r = 0; r < 16; ++r) { const int l = it * 32 + rowmap(r, lane);
              const float rr = sigm_f(ra[r] + bav), ii = sigm_f(xa[r] + bxv), la = -8.0f * rr * sp;
              const float xv = ul[l * 128 + c];
              al[l * 128 + c] = __expf(la); ul[l * 128 + c] = __builtin_amdgcn_sqrtf(1.0f - __expf(2.0f * la)) * ii * xv; } }
        __syncthreads();
        { const int cp = tid & 63, sg = wave;
          float h0 = 0.f, h1 = 0.f, P0 = 1.f, P1 = 1.f; float hl0[8], hl1[8], Pl0[8], Pl1[8];
#pragma unroll
          for (int t = 0; t < 8; ++t) { const hwf2_t a2 = *(const LAS hwf2_t*)(al + (sg * 8 + t) * 128 + 2 * cp), u2 = *(const LAS hwf2_t*)(ul + (sg * 8 + t) * 128 + 2 * cp);
              h0 = a2.x * h0 + u2.x; h1 = a2.y * h1 + u2.y; P0 *= a2.x; P1 *= a2.y; hl0[t] = h0; hl1[t] = h1; Pl0[t] = P0; Pl1[t] = P1; }
          *(LAS f32x4*)(seg + (sg * 128 + 2 * cp) * 2) = (f32x4){P0, h0, P1, h1};
          __syncthreads();
          float Pi0 = 1.f, Pi1 = 1.f, hi0 = 0.f, hi1 = 0.f;
          for (int q = 0; q < sg; ++q) { const f32x4 e = *(const LAS f32x4*)(seg + (q * 128 + 2 * cp) * 2); hi0 = e.x * hi0 + e.y; hi1 = e.z * hi1 + e.w; Pi0 *= e.x; Pi1 *= e.z; }
          bf16* hp = B.hloc + (t0 + sg * 8) * 512 + hh * 128 + 2 * cp; bf16* pp = B.pc + (t0 + sg * 8) * 512 + hh * 128 + 2 * cp;
#pragma unroll
          for (int t = 0; t < 8; ++t) { *(unsigned*)(hp + (size_t)t * 512) = pk2(hl0[t] + Pl0[t] * hi0, hl1[t] + Pl1[t] * hi1); *(unsigned*)(pp + (size_t)t * 512) = pk2(Pl0[t] * Pi0, Pl1[t] * Pi1); }
          if (sg == 7) { float2 ca, cu; ca.x = Pl0[7] * Pi0; ca.y = Pl1[7] * Pi1; cu.x = hl0[7] + Pl0[7] * hi0; cu.y = hl1[7] + Pl1[7] * hi1;
              *(float2*)(B.carA + (size_t)ch * 512 + hh * 128 + 2 * cp) = ca; *(float2*)(B.carU + (size_t)ch * 512 + hh * 128 + 2 * cp) = cu; } }
    }
    __syncthreads();
}
__device__ __forceinline__ void lru_b(const Mix0Bufs& B, int gtid, int gsz) {
    for (int idx = gtid; idx < 2 * 512; idx += gsz) { const int b = idx >> 9, c = idx & 511; float hst = 0.f;
        for (int n0 = 0; n0 < NCH; n0 += 16) { float a[16], u[16];
#pragma unroll
            for (int j = 0; j < 16; ++j) { const size_t o = (size_t)(b * NCH + n0 + j) * 512 + c; a[j] = B.carA[o]; u[j] = B.carU[o]; }
#pragma unroll
            for (int j = 0; j < 16; ++j) { const float in = hst; hst = a[j] * hst + u[j]; a[j] = in; }
#pragma unroll
            for (int j = 0; j < 16; ++j) B.carI[(size_t)(b * NCH + n0 + j) * 512 + c] = a[j]; } }
}
__device__ __forceinline__ void lru_c(const Mix0Bufs& B, int gtid, int gsz) {
    for (int idx = gtid; idx < T_ * 64; idx += gsz) { const size_t t = idx >> 6; const int c0 = (idx & 63) * 8; const size_t ch = t >> 6;
        float gb[8], y[8]; unpack8(*(const v4u*)(B.proj + t * PJ0 + 2568 + c0), gb);
        float hp[8], pp[8]; unpack8(*(const v4u*)(B.hloc + t * 512 + c0), hp); unpack8(*(const v4u*)(B.pc + t * 512 + c0), pp); const float* ci = B.carI + ch * 512 + c0;
#pragma unroll
        for (int j = 0; j < 8; ++j) y[j] = (hp[j] + pp[j] * ci[j]) * gelu_f(gb[j]);
        *(v4u*)(B.mixbf + t * 1024 + 512 + c0) = pack8(y); }
}
constexpr int PJ1 = OINP;
struct Mix1Bufs { const bf16* proj; bf16* ut; float* gbl; bf16* s5g; float* xend; float* xstart; float* s5ab; float* s5bb; bf16* cm; bf16* bbt; bf16* mixbf; };
__device__ __forceinline__ void gla_gates(const bf16* proj, const float* gw, const float* gb, size_t t0, int h, LAS float* bc, LAS float* gl, LAS float* tot, int tid) {
    const int d = tid & 63, lg = __builtin_amdgcn_readfirstlane(tid >> 6);
    if (tid < 128) { const int l = tid >> 1, hf = tid & 1; float f[8]; unpack8(*(const v4u*)(proj + (t0 + l) * PJ1 + 2048 + hf * 8), f);
        *(LAS f32x4*)(gl + l * 16 + hf * 8) = (f32x4){f[0], f[1], f[2], f[3]}; *(LAS f32x4*)(gl + l * 16 + hf * 8 + 4) = (f32x4){f[4], f[5], f[6], f[7]}; }
    float w[16];
#pragma unroll
    for (int r = 0; r < 16; ++r) w[r] = gw[r * 256 + h * 64 + d];
    const float bias = gb[h * 64 + d];
    __syncthreads();
    float v[8];
#pragma unroll
    for (int q = 0; q < 8; ++q) { const int l = lg * 8 + q; float acc = bias;
#pragma unroll
        for (int r4 = 0; r4 < 4; ++r4) { const f32x4 g4 = *(const LAS f32x4*)(gl + l * 16 + r4 * 4); acc += g4.x * w[r4 * 4] + g4.y * w[r4 * 4 + 1] + g4.z * w[r4 * 4 + 2] + g4.w * w[r4 * 4 + 3]; }
        v[q] = logsig_f(acc) * 0.0625f; }
#pragma unroll
    for (int q = 1; q < 8; ++q) v[q] += v[q - 1];
    tot[lg * 64 + d] = v[7];
    __syncthreads();
    float pre = 0.f;
#pragma unroll
    for (int s = 0; s < 7; ++s) { const float t = tot[s * 64 + d]; pre += (s < lg) ? t : 0.f; }
#pragma unroll
    for (int q = 0; q < 8; ++q) bc[(lg * 8 + q) * 64 + d] = v[q] + pre;
    __syncthreads();
}
__device__ __forceinline__ void gla_a_item(const Mix1Bufs& B, const float* gw, const float* gb, int cn, LAS unsigned char* lds, int tid) {
    const int lane = tid & 63, wave = __builtin_amdgcn_readfirstlane(tid >> 6);
    const int bh = cn / NCH, n = cn % NCH, b = bh >> 2, h = bh & 3;
    const size_t t0 = (size_t)b * S_ + n * 64;
    LAS float* bc = (LAS float*)lds; LAS float* gl = (LAS float*)(lds + 16384); LAS float* tot = (LAS float*)(lds + 118784);
    lbf16* kT = (lbf16*)(lds + 20480); lbf16* vT = (lbf16*)(lds + 20480 + 64 * 72 * 2);
    v4u gk, gv[2];
    { const int l = tid & 63, g = tid >> 6; gk = *(const v4u*)(B.proj + (t0 + l) * PJ1 + 768 + h * 64 + g * 8); }
#pragma unroll
    for (int it = 0; it < 2; ++it) { const int vi = tid + it * 512, l = vi & 63, g = vi >> 6; gv[it] = *(const v4u*)(B.proj + (t0 + l) * PJ1 + 1024 + h * 128 + g * 8); }
    gla_gates(B.proj, gw, gb, t0, h, bc, gl, tot, tid);
    { const int l = tid & 63, g = tid >> 6; float kf[8]; unpack8(gk, kf);
#pragma unroll
      for (int j = 0; j < 8; ++j) { const int d = g * 8 + j; kT[d * 72 + l] = (unsigned short)f2bf(kf[j] * __expf(bc[63 * 64 + d] - bc[l * 64 + d])); } }
#pragma unroll
    for (int it = 0; it < 2; ++it) { const int vi = tid + it * 512, l = vi & 63, g = vi >> 6; float vf[8]; unpack8(gv[it], vf);
#pragma unroll
        for (int j = 0; j < 8; ++j) vT[(g * 8 + j) * 72 + l] = (unsigned short)f2bf(vf[j]); }
    __syncthreads();
    { const int et = wave >> 1, dt = wave & 1;
      f32x16 acc = {0.f, 0.f, 0.f, 0.f, 0.f, 0.f, 0.f, 0.f, 0.f, 0.f, 0.f, 0.f, 0.f, 0.f, 0.f, 0.f};
      mm32(acc, kT + dt * 32 * 72, 72, vT + et * 32 * 72, 72, 64, lane);
      bf16* out = B.ut + (size_t)cn * 8192 + (et * 2 + dt) * 1024 + lane * 16;
      v4u o0, o1; o0.x = pk2(acc[0], acc[1]); o0.y = pk2(acc[2], acc[3]); o0.z = pk2(acc[4], acc[5]); o0.w = pk2(acc[6], acc[7]);
      o1.x = pk2(acc[8], acc[9]); o1.y = pk2(acc[10], acc[11]); o1.z = pk2(acc[12], acc[13]); o1.w = pk2(acc[14], acc[15]);
      *(v4u*)out = o0; *(v4u*)(out + 8) = o1; }
    if (tid < 64) B.gbl[(size_t)cn * 64 + tid] = bc[63 * 64 + tid];
    __syncthreads();
}
__device__ __forceinline__ void gla_b(const Mix1Bufs& B, int gtid, int gsz) {
    for (int idx = gtid; idx < 8 * 4096; idx += gsz) { const int bh = idx >> 12, pe = idx & 4095, d = ((pe >> 9) & 1) * 32 + ((pe * 2) & 3) + 8 * ((pe >> 1) & 3) + 4 * ((pe >> 8) & 1); float s0 = 0.f, s1 = 0.f;
        unsigned* p = (unsigned*)B.ut + (size_t)bh * NCH * 4096 + pe; const float* gp = B.gbl + (size_t)bh * NCH * 64 + d;
        for (int n0 = 0; n0 < NCH; n0 += 16) { unsigned u[16]; float g0[16], g1[16];
#pragma unroll
            for (int j = 0; j < 16; ++j) { u[j] = p[(size_t)(n0 + j) * 4096]; g0[j] = gp[(n0 + j) * 64]; g1[j] = gp[(n0 + j) * 64 + 1]; }
#pragma unroll
            for (int j = 0; j < 16; ++j) { const unsigned out = pk2(s0, s1);
                s0 = __expf(g0[j]) * s0 + __builtin_bit_cast(float, u[j] << 16); s1 = __expf(g1[j]) * s1 + __builtin_bit_cast(float, u[j] & 0xffff0000u); u[j] = out; }
#pragma unroll
            for (int j = 0; j < 16; ++j) p[(size_t)(n0 + j) * 4096] = u[j]; } }
}
__device__ __forceinline__ void gla_c_item(const Mix1Bufs& B, const float* gw, const float* gb, const float* norm_w, int cn, LAS unsigned char* lds, int tid) {
    const int lane = tid & 63, wave = __builtin_amdgcn_readfirstlane(tid >> 6);
    const int bh = cn / NCH, n = cn % NCH, b = bh >> 2, h = bh & 3;
    const size_t t0 = (size_t)b * S_ + n * 64;
    LAS float* bc = (LAS float*)lds; LAS float* gl = (LAS float*)(lds + 16384);
    lbf16* qd = (lbf16*)(lds + 20480); lbf16* ki = (lbf16*)(lds + 29696); lbf16* vT = (lbf16*)(lds + 38912); lbf16* sT = (lbf16*)(lds + 57344); lbf16* att = (lbf16*)(lds + 75776);
    LAS float* ob = (LAS float*)(lds + 84992); LAS float* tot = (LAS float*)(lds + 118784);
    gla_gates(B.proj, gw, gb, t0, h, bc, gl, tot, tid);
    { const int l = tid >> 3, g = tid & 7; const bf16* pr = B.proj + (t0 + l) * PJ1 + h * 64 + g * 8; float qf[8], kf[8]; unpack8(*(const v4u*)(pr + 512), qf); unpack8(*(const v4u*)(pr + 768), kf);
#pragma unroll
      for (int j = 0; j < 8; ++j) { const float bb = bc[l * 64 + g * 8 + j]; qf[j] *= 0.125f * __expf(bb); kf[j] *= __expf(-bb); }
      *(LAS v4u*)(qd + l * 72 + g * 8) = pack8(qf); *(LAS v4u*)(ki + l * 72 + g * 8) = pack8(kf); }
#pragma unroll
    for (int it = 0; it < 2; ++it) { const int vi = tid + it * 512, l = vi & 63, g = vi >> 6; float vf[8]; unpack8(*(const v4u*)(B.proj + (t0 + l) * PJ1 + 1024 + h * 128 + g * 8), vf);
#pragma unroll
        for (int j = 0; j < 8; ++j) vT[(g * 8 + j) * 72 + l] = (unsigned short)f2bf(vf[j]); }
    { const bf16* sg = B.ut + (size_t)cn * 8192;
#pragma unroll
      for (int it = 0; it < 2; ++it) { const int vi = tid + it * 512, T = vi >> 7, ln = (vi >> 1) & 63, hr = vi & 1; const v4u x = *(const v4u*)(sg + vi * 8);
          LAS unsigned char* dp = (LAS unsigned char*)(sT + ((T >> 1) * 32 + (ln & 31)) * 72 + (T & 1) * 32 + 16 * hr + 4 * (ln >> 5));
          *(LAS v2u*)dp = (v2u){x.x, x.y}; *(LAS v2u*)(dp + 16) = (v2u){x.z, x.w}; } }
    __syncthreads();
    if (wave < 4) { const int it = wave >> 1, jt = wave & 1;
        f32x16 acc = {0.f, 0.f, 0.f, 0.f, 0.f, 0.f, 0.f, 0.f, 0.f, 0.f, 0.f, 0.f, 0.f, 0.f, 0.f, 0.f};
        if (jt <= it) mm32(acc, ki + jt * 32 * 72, 72, qd + it * 32 * 72, 72, 64, lane);
        const int i = it * 32 + (lane & 31);
#pragma unroll
        for (int g4 = 0; g4 < 4; ++g4) { const int j0 = jt * 32 + 8 * g4 + 4 * (lane >> 5);
            v2u o; o.x = pk2(j0 <= i ? acc[g4 * 4] : 0.f, j0 + 1 <= i ? acc[g4 * 4 + 1] : 0.f); o.y = pk2(j0 + 2 <= i ? acc[g4 * 4 + 2] : 0.f, j0 + 3 <= i ? acc[g4 * 4 + 3] : 0.f);
            *(LAS v2u*)(att + i * 72 + j0) = o; } }
    __syncthreads();
    { const int it = wave >> 2, nt = wave & 3;
      f32x16 acc = {0.f, 0.f, 0.f, 0.f, 0.f, 0.f, 0.f, 0.f, 0.f, 0.f, 0.f, 0.f, 0.f, 0.f, 0.f, 0.f};
      mm32(acc, vT + nt * 32 * 72, 72, att + it * 32 * 72, 72, 64, lane); mm32(acc, sT + nt * 32 * 72, 72, qd + it * 32 * 72, 72, 64, lane);
#pragma unroll
      for (int g4 = 0; g4 < 4; ++g4) *(LAS f32x4*)(ob + (it * 32 + (lane & 31)) * 132 + nt * 32 + 8 * g4 + 4 * (lane >> 5)) = (f32x4){acc[g4 * 4], acc[g4 * 4 + 1], acc[g4 * 4 + 2], acc[g4 * 4 + 3]}; }
    __syncthreads();
    { const int i = tid >> 3, sub = tid & 7; const LAS float* hr = ob + i * 132 + sub * 16;
      float x[16]; float q = 0.f;
#pragma unroll
      for (int j = 0; j < 16; ++j) { x[j] = hr[j]; q += x[j] * x[j]; }
      q += __builtin_bit_cast(float, __builtin_amdgcn_ds_swizzle(__builtin_bit_cast(int, q), 0x1f | (1 << 10)));
      q += __builtin_bit_cast(float, __builtin_amdgcn_ds_swizzle(__builtin_bit_cast(int, q), 0x1f | (2 << 10)));
      q += __builtin_bit_cast(float, __builtin_amdgcn_ds_swizzle(__builtin_bit_cast(int, q), 0x1f | (4 << 10)));
      const float rstd = __builtin_amdgcn_rsqf(q * (1.f / 128.f) + nv::EPS);
      const bf16* rp = B.proj + (t0 + i) * PJ1 + 1536 + h * 128 + sub * 16; const float* nw = norm_w + h * 128 + sub * 16;
      float r0[8], r1[8]; unpack8(*(const v4u*)rp, r0); unpack8(*(const v4u*)(rp + 8), r1);
      float y0[8], y1[8];
#pragma unroll
      for (int j = 0; j < 8; ++j) { y0[j] = x[j] * rstd * nw[j] * r0[j] * sigm_f(r0[j]); y1[j] = x[8 + j] * rstd * nw[8 + j] * r1[j] * sigm_f(r1[j]); }
      bf16* dst = B.mixbf + (t0 + i) * 1024 + 512 + h * 128 + sub * 16;
      *(v4u*)dst = pack8(y0); *(v4u*)(dst + 8) = pack8(y1); }
    __syncthreads();
}
__device__ __forceinline__ void s5_params(const Mix1Bufs& B, const float* const* in, int gtid, int gsz) {

    for (int idx = gtid; idx < 2048; idx += gsz) { const int g = idx >> 6;
        const float lr = in[17][idx], li = in[18][idx], dt = expf(in[24][g]);
        const float mag = expf(lr * dt), ar = mag * cosf(li * dt), ai = mag * sinf(li * dt);
        const float den = lr * lr + li * li, nr = ar - 1.0f, cr = (nr * lr + ai * li) / den, ci = (ai * lr - nr * li) / den;
        B.s5ab[idx * 2] = ar; B.s5ab[idx * 2 + 1] = ai;
        for (int h = 0; h < 16; ++h) { const float br = in[19][idx * 16 + h], bi = in[20][idx * 16 + h]; B.s5bb[idx * 32 + h] = cr * br - ci * bi; B.s5bb[idx * 32 + 16 + h] = cr * bi + ci * br; } }
    for (int idx = gtid; idx < 32 * 128 * 16; idx += gsz) { const int h = idx & 15, j = (idx >> 4) & 127, g = idx >> 11; const int gp = g * 64 + (j & 63);
        const float lr = in[17][gp], li = in[18][gp], dt = expf(in[24][g]);
        const float mag = expf(lr * dt), ar = mag * cosf(li * dt), ai = mag * sinf(li * dt);
        const float den = lr * lr + li * li, nr = ar - 1.0f, cr = (nr * lr + ai * li) / den, ci = (ai * lr - nr * li) / den;
        const float br = in[19][gp * 16 + h], bi = in[20][gp * 16 + h];
        B.bbt[idx] = (unsigned short)f2bf(j < 64 ? cr * br - ci * bi : cr * bi + ci * br); }
    for (int idx = gtid; idx < 32 * 32 * 128; idx += gsz) { const int k = idx & 127, hh = (idx >> 7) & 31, g = idx >> 12;
        float v = 0.f; if (hh < 16) v = k < 64 ? in[21][(g * 16 + hh) * 64 + k] : -in[22][(g * 16 + hh) * 64 + k - 64];
        B.cm[idx] = (unsigned short)f2bf(v); }
}
template <bool OUT> __device__ __forceinline__ void s5_chunk_v2(const Mix1Bufs& B, const float* dskip, int item, bool valid, LAS unsigned char* wl, int lane) {
    if (!valid) item = 0;
    const int n = item % NCH, g = (item / NCH) & 31, b = item / (NCH * 32);
    const size_t t0 = (size_t)b * S_ + n * 64; const int gp = g * 64 + lane;
    LAS float* bu = (LAS float*)wl;
    lbf16* xs = (lbf16*)(wl + 8192);
    const float ar = B.s5ab[gp * 2], ai = B.s5ab[gp * 2 + 1];
    float xr = 0.f, xi = 0.f;
    if (OUT) { xr = B.xstart[((size_t)item * 64 + lane) * 2]; xi = B.xstart[((size_t)item * 64 + lane) * 2 + 1]; }
    const bf16* bbt = B.bbt + (size_t)g * 2048 + (lane & 31) * 16 + 8 * (lane >> 5);
    for (int half = 0; half < 2; ++half) {
        const s16x8 a = *(const s16x8*)(B.proj + (t0 + half * 32 + (lane & 31)) * PJ1 + g * 16 + 8 * (lane >> 5));
        f32x16 acc[4];
#pragma unroll
        for (int nt = 0; nt < 4; ++nt) { const s16x8 bf = *(const s16x8*)(bbt + nt * 512);
            const f32x16 z = {0.f, 0.f, 0.f, 0.f, 0.f, 0.f, 0.f, 0.f, 0.f, 0.f, 0.f, 0.f, 0.f, 0.f, 0.f, 0.f};
            acc[nt] = __builtin_amdgcn_mfma_f32_32x32x16_bf16(a, bf, z, 0, 0, 0); }
#pragma unroll
        for (int q = 0; q < 2; ++q) {
#pragma unroll
            for (int nt = 0; nt < 4; ++nt)
#pragma unroll
                for (int rr = 0; rr < 8; ++rr) bu[((rr & 3) + 8 * (rr >> 2) + 4 * (lane >> 5)) * 128 + nt * 32 + (lane & 31)] = acc[nt][q * 8 + rr];
            __syncthreads();
#pragma unroll 4
            for (int l = 0; l < 16; ++l) { const float sr = bu[l * 128 + lane], si = bu[l * 128 + 64 + lane];
                const float nr = ar * xr - ai * xi + sr, ni = ar * xi + ai * xr + si; xr = nr; xi = ni;
                if (OUT) { xs[(q * 16 + l) * 136 + lane] = (unsigned short)f2bf(xr); xs[(q * 16 + l) * 136 + 64 + lane] = (unsigned short)f2bf(xi); } }
            __syncthreads();
        }
        if (OUT) {
            f32x16 acc2 = {0.f, 0.f, 0.f, 0.f, 0.f, 0.f, 0.f, 0.f, 0.f, 0.f, 0.f, 0.f, 0.f, 0.f, 0.f, 0.f};
            mm32_gb(acc2, xs, 136, B.cm + (size_t)g * 32 * 128, 128, 128, lane);
            const int hh = lane & 31;
            if (hh < 16 && valid) { const float dk = dskip[g * 16 + hh];
#pragma unroll
                for (int r = 0; r < 16; ++r) { const size_t t = t0 + half * 32 + rowmap(r, lane);
                    B.s5g[t * 512 + g * 16 + hh] = (unsigned short)f2bf(gelu_f(acc2[r] + dk * bf2f(B.proj[t * PJ1 + g * 16 + hh]))); } }
            __syncthreads();
        }
    }
    if (!OUT && valid) { B.xend[((size_t)item * 64 + lane) * 2] = xr; B.xend[((size_t)item * 64 + lane) * 2 + 1] = xi; }
}
template <bool OUT> __device__ __forceinline__ void s5_phase(const Mix1Bufs& B, const float* dskip, int gw, int NGW, LAS unsigned char* wl, int lane) {
    const int wpg = NGW >> 5, g_ = gw / wpg, j0 = gw - g_ * wpg; const bool gvalid = g_ < 32; const int g = gvalid ? g_ : 0;
    const int nit = (2 * NCH + wpg - 1) / wpg;
    const float ar = B.s5ab[(g * 64 + lane) * 2], ai = B.s5ab[(g * 64 + lane) * 2 + 1];
    s16x8 bf[4]; { const bf16* bbt = B.bbt + (size_t)g * 2048 + (lane & 31) * 16 + 8 * (lane >> 5);
#pragma unroll
        for (int nt = 0; nt < 4; ++nt) bf[nt] = *(const s16x8*)(bbt + nt * 512); }
    s16x8 cf[4]; float dk[4];
    if (OUT) { const bf16* cm = B.cm + (size_t)g * 32 * 128 + (lane & 15) * 128 + 8 * (lane >> 4);
#pragma unroll
        for (int ks = 0; ks < 4; ++ks) cf[ks] = *(const s16x8*)(cm + ks * 32);
#pragma unroll
        for (int r = 0; r < 4; ++r) dk[r] = dskip[g * 16 + 4 * (lane >> 4) + r]; }
    s16x8 na[2]; v2u nu[2][2]; float nxr = 0.f, nxi = 0.f;
#define S5_LOAD(kk) do { const int _i = j0 + (kk) * wpg; const int _idx = (gvalid && _i < 2 * NCH) ? _i : 0; const int _b = _idx / NCH, _n = _idx % NCH; const size_t _t0 = (size_t)_b * S_ + _n * 64; \
        const bf16* _p = B.proj + (_t0 + (lane & 31)) * PJ1 + g * 16 + 8 * (lane >> 5); na[0] = *(const s16x8*)_p; na[1] = *(const s16x8*)(_p + (size_t)32 * PJ1); \
        if (OUT) { const size_t _it = (size_t)(_b * 32 + g) * NCH + _n; const float2 _x = *(const float2*)(B.xstart + (_it * 64 + lane) * 2); nxr = _x.x; nxi = _x.y; \
            const bf16* _q = B.proj + (_t0 + (lane & 15)) * PJ1 + g * 16 + 4 * (lane >> 4); _Pragma("unroll") for (int _h = 0; _h < 2; ++_h) _Pragma("unroll") for (int _t = 0; _t < 2; ++_t) nu[_h][_t] = *(const v2u*)(_q + (size_t)(_h * 32 + _t * 16) * PJ1); } } while (0)
    S5_LOAD(0);
    for (int k = 0; k < nit; ++k) {
        const int i_ = j0 + k * wpg; const bool valid = gvalid && i_ < 2 * NCH; const int idx = valid ? i_ : 0; const int b = idx / NCH, n = idx % NCH;
        const size_t t0 = (size_t)b * S_ + n * 64; const size_t item = (size_t)(b * 32 + g) * NCH + n;
        s16x8 a[2] = {na[0], na[1]}; v2u uu[2][2] = {{nu[0][0], nu[0][1]}, {nu[1][0], nu[1][1]}}; float xr = OUT ? nxr : 0.f, xi = OUT ? nxi : 0.f;
        if (k + 1 < nit) S5_LOAD(k + 1);
#pragma unroll
        for (int half = 0; half < 2; ++half) {
            f32x16 acc[4];
#pragma unroll
            for (int nt = 0; nt < 4; ++nt) { const f32x16 z = {0.f, 0.f, 0.f, 0.f, 0.f, 0.f, 0.f, 0.f, 0.f, 0.f, 0.f, 0.f, 0.f, 0.f, 0.f, 0.f};
                acc[nt] = __builtin_amdgcn_mfma_f32_32x32x16_bf16(a[half], bf[nt], z, 0, 0, 0); }
            float sre[2][16], sim[2][16];
#pragma unroll
            for (int r = 0; r < 16; ++r) {
                { auto w = __builtin_amdgcn_permlane32_swap(__float_as_uint(acc[0][r]), __float_as_uint(acc[1][r]), false, false); sre[0][r] = __uint_as_float(w[0]); sre[1][r] = __uint_as_float(w[1]); }
                { auto w = __builtin_amdgcn_permlane32_swap(__float_as_uint(acc[2][r]), __float_as_uint(acc[3][r]), false, false); sim[0][r] = __uint_as_float(w[0]); sim[1][r] = __uint_as_float(w[1]); } }
            lbf16* xs = (lbf16*)(wl + half * 8704);
#pragma unroll
            for (int q = 0; q < 4; ++q)
#pragma unroll
                for (int wch = 0; wch < 2; ++wch)
#pragma unroll
                    for (int i = 0; i < 4; ++i) { const int r = q * 4 + i, tok = q * 8 + wch * 4 + i;
                        const float sr = sre[wch][r], si = sim[wch][r];
                        const float nr = ar * xr - ai * xi + sr, ni = ar * xi + ai * xr + si; xr = nr; xi = ni;
                        if (OUT) { xs[tok * 136 + lane] = (unsigned short)f2bf(xr); xs[tok * 136 + 64 + lane] = (unsigned short)f2bf(xi); } }
            if (OUT) {
                __syncthreads();
#pragma unroll
                for (int tt = 0; tt < 2; ++tt) { f32x4 y = {0.f, 0.f, 0.f, 0.f};
                    const lbf16* xp = xs + (tt * 16 + (lane & 15)) * 136 + 8 * (lane >> 4);
#pragma unroll
                    for (int ks = 0; ks < 4; ++ks) y = __builtin_amdgcn_mfma_f32_16x16x32_bf16(cf[ks], *(const LAS s16x8*)(xp + ks * 32), y, 0, 0, 0);
                    const v2u u = uu[half][tt];
                    const float u0 = __builtin_bit_cast(float, u.x << 16), u1 = __builtin_bit_cast(float, u.x & 0xffff0000u), u2 = __builtin_bit_cast(float, u.y << 16), u3 = __builtin_bit_cast(float, u.y & 0xffff0000u);
                    v2u o; o.x = pk2(gelu_f(y[0] + dk[0] * u0), gelu_f(y[1] + dk[1] * u1)); o.y = pk2(gelu_f(y[2] + dk[2] * u2), gelu_f(y[3] + dk[3] * u3));
                    if (valid) *(v2u*)(B.s5g + (t0 + half * 32 + tt * 16 + (lane & 15)) * 512 + g * 16 + 4 * (lane >> 4)) = o; }
            }
        }
        if (!OUT && valid) { float2 o; o.x = xr; o.y = xi; *(float2*)(B.xend + (item * 64 + lane) * 2) = o; }
    }
#undef S5_LOAD
}
__device__ __forceinline__ void s5_b(const Mix1Bufs& B, int gtid, int gsz) {
    for (int idx = gtid; idx < 2 * 2048; idx += gsz) { const int b = idx >> 11, gp = idx & 2047, g = gp >> 6, p = gp & 63;
        float ar = B.s5ab[gp * 2], ai = B.s5ab[gp * 2 + 1];
#pragma unroll
        for (int q = 0; q < 6; ++q) { const float r2 = ar * ar - ai * ai, i2 = 2.f * ar * ai; ar = r2; ai = i2; }
        float xr = 0.f, xi = 0.f;
        const size_t o0 = ((size_t)((b * 32 + g) * NCH) * 64 + p) * 2;
        for (int n0 = 0; n0 < NCH; n0 += 16) { float er[16], ei[16];
#pragma unroll
            for (int j = 0; j < 16; ++j) { const size_t o = o0 + (size_t)(n0 + j) * 128; er[j] = B.xend[o]; ei[j] = B.xend[o + 1]; }
#pragma unroll
            for (int j = 0; j < 16; ++j) { const float sr = xr, si = xi; const float nr = ar * xr - ai * xi + er[j], ni = ar * xi + ai * xr + ei[j]; xr = nr; xi = ni; er[j] = sr; ei[j] = si; }
#pragma unroll
            for (int j = 0; j < 16; ++j) { const size_t o = o0 + (size_t)(n0 + j) * 128; B.xstart[o] = er[j]; B.xstart[o + 1] = ei[j]; } } }
}
typedef float f32x4v __attribute__((ext_vector_type(4)));
struct RouterBufs { const float* z; float* h; bf16* hbf; const float* lnw; const float* lnb; const bf16* rwh; const bf16* rwl; const float* rbias; int* ridx; float* rwt; unsigned* cnt; };
__device__ __forceinline__ void router_split_weights(const float* rw, bf16* hi, bf16* lo, int gtid, int gsz) {
    for (int i = gtid; i < 64 * 1024; i += gsz) { const int e = i >> 10, k = i & 1023; const float w = rw[k * 64 + e]; const unsigned h = f2bf(w); hi[i] = (unsigned short)h; lo[i] = (unsigned short)f2bf(w - __builtin_bit_cast(float, h << 16)); }
}
__device__ __forceinline__ void router_select(const LAS float* sc, const float* bias, int* ridx, float* rwt, LAS unsigned* hist) {
    float gs[8];
#pragma unroll
    for (int g = 0; g < 8; ++g) { float m1 = -INFINITY, m2 = -INFINITY;
#pragma unroll
        for (int j = 0; j < 8; ++j) { const float v = sc[g * 8 + j] + bias[g * 8 + j]; if (v > m1) { m2 = m1; m1 = v; } else if (v > m2) m2 = v; }
        gs[g] = m1 + m2; }
    unsigned gsel = 0;
#pragma unroll
    for (int it = 0; it < 4; ++it) { float best = -INFINITY; int bi = 0;
#pragma unroll
        for (int g = 0; g < 8; ++g) { const bool ok = !((gsel >> g) & 1u) && gs[g] > best; best = ok ? gs[g] : best; bi = ok ? g : bi; }
        gsel |= 1u << bi; }
    unsigned long long taken = 0ull; float wsum = 0.f; float wv[8]; int ev[8];
#pragma unroll
    for (int it = 0; it < 8; ++it) { float best = -INFINITY; int bi = 0;
#pragma unroll 1
        for (int e = 0; e < 64; ++e) { const bool ok = ((gsel >> (e >> 3)) & 1u) && !((taken >> e) & 1ull); const float v = sc[e] + bias[e]; if (ok && v > best) { best = v; bi = e; } }
        taken |= 1ull << bi; ev[it] = bi; wv[it] = sc[bi]; wsum += wv[it]; }
    const float inv = 2.5f / wsum;
#pragma unroll
    for (int it = 0; it < 8; ++it) { ridx[it] = ev[it]; rwt[it] = wv[it] * inv; atomicAdd((unsigned*)&hist[ev[it]], 1u); }
}
__device__ __forceinline__ void router_tiles(const RouterBufs& R, int tile0, int tstride, int ntiles, LAS unsigned char* lds, int tid, bool count = true) {
    const int lane = tid & 63, wave = __builtin_amdgcn_readfirstlane(tid >> 6);
    lbf16* Ahi = (lbf16*)lds; lbf16* Alo = (lbf16*)(lds + 33024); LAS float* part = (LAS float*)(lds + 66048); LAS float* sc = (LAS float*)(lds + 98816); LAS unsigned* hist = (LAS unsigned*)(lds + 102912);
    if (tile0 >= ntiles) return;
    const int row16 = lane & 15, kq = 8 * (lane >> 4);
    s16x8 bh[4][4], bl[4][4];
#pragma unroll
    for (int ks = 0; ks < 4; ++ks)
#pragma unroll
        for (int nt = 0; nt < 4; ++nt) { const size_t o = (size_t)(nt * 16 + row16) * 1024 + wave * 128 + ks * 32 + kq; bh[ks][nt] = *(const s16x8*)(R.rwh + o); bl[ks][nt] = *(const s16x8*)(R.rwl + o); }
    const float bias = R.rbias[lane];
    f32x4 zr[2][4];
#define RT_LOAD(tile) do { _Pragma("unroll") for (int q = 0; q < 2; ++q) { const float* zp = R.z + ((size_t)(tile) * 16 + wave * 2 + q) * 1024 + lane * 8; \
        zr[q][0] = *(const f32x4*)zp; zr[q][1] = *(const f32x4*)(zp + 4); zr[q][2] = *(const f32x4*)(zp + 512); zr[q][3] = *(const f32x4*)(zp + 516); } } while (0)
    RT_LOAD(tile0);
    if (tid < 64) hist[tid] = 0u;
    for (int tile = tile0; tile < ntiles; tile += tstride) {
#pragma unroll
        for (int q = 0; q < 2; ++q) { const int row = wave * 2 + q; const size_t t = (size_t)tile * 16 + row;
            float v[16] = {zr[q][0].x, zr[q][0].y, zr[q][0].z, zr[q][0].w, zr[q][1].x, zr[q][1].y, zr[q][1].z, zr[q][1].w, zr[q][2].x, zr[q][2].y, zr[q][2].z, zr[q][2].w, zr[q][3].x, zr[q][3].y, zr[q][3].z, zr[q][3].w};
            float sum = 0.f;
#pragma unroll
            for (int j = 0; j < 16; ++j) sum += v[j];
            sum = wave_sum(sum); const float mean = sum * (1.f / 1024.f); float sq = 0.f;
#pragma unroll
            for (int j = 0; j < 16; ++j) { v[j] -= mean; sq += v[j] * v[j]; }
            sq = wave_sum(sq); const float rstd = 1.0f / sqrtf(sq * (1.f / 1024.f) + nv::EPS);
#pragma unroll
            for (int half = 0; half < 2; ++half) { const int c0 = half * 512 + lane * 8;
                const f32x4 w0 = *(const f32x4*)(R.lnw + c0), w1 = *(const f32x4*)(R.lnw + c0 + 4), b0 = *(const f32x4*)(R.lnb + c0), b1 = *(const f32x4*)(R.lnb + c0 + 4);
                float o[8] = {v[half * 8 + 0] * rstd * w0.x + b0.x, v[half * 8 + 1] * rstd * w0.y + b0.y, v[half * 8 + 2] * rstd * w0.z + b0.z, v[half * 8 + 3] * rstd * w0.w + b0.w,
                              v[half * 8 + 4] * rstd * w1.x + b1.x, v[half * 8 + 5] * rstd * w1.y + b1.y, v[half * 8 + 6] * rstd * w1.z + b1.z, v[half * 8 + 7] * rstd * w1.w + b1.w};
                *(f32x4*)(R.h + t * 1024 + c0) = (f32x4){o[0], o[1], o[2], o[3]}; *(f32x4*)(R.h + t * 1024 + c0 + 4) = (f32x4){o[4], o[5], o[6], o[7]};
                const v4u hi = pack8(o); float hf[8], lo[8]; unpack8(hi, hf);
#pragma unroll
                for (int j = 0; j < 8; ++j) lo[j] = o[j] - hf[j];
                *(v4u*)(R.hbf + t * 1024 + c0) = hi; *(LAS v4u*)(Ahi + row * 1032 + c0) = hi; *(LAS v4u*)(Alo + row * 1032 + c0) = pack8(lo); } }
        if (tile + tstride < ntiles) RT_LOAD(tile + tstride);
        __syncthreads();
        { f32x4v acc[4] = {{0.f, 0.f, 0.f, 0.f}, {0.f, 0.f, 0.f, 0.f}, {0.f, 0.f, 0.f, 0.f}, {0.f, 0.f, 0.f, 0.f}};
#pragma unroll
          for (int ks = 0; ks < 4; ++ks) { const int k0 = wave * 128 + ks * 32 + kq;
              const s16x8 ah = *(const LAS s16x8*)(Ahi + row16 * 1032 + k0), al = *(const LAS s16x8*)(Alo + row16 * 1032 + k0);
#pragma unroll
              for (int nt = 0; nt < 4; ++nt) {
                  acc[nt] = __builtin_amdgcn_mfma_f32_16x16x32_bf16(ah, bh[ks][nt], acc[nt], 0, 0, 0);
                  acc[nt] = __builtin_amdgcn_mfma_f32_16x16x32_bf16(al, bh[ks][nt], acc[nt], 0, 0, 0);
                  acc[nt] = __builtin_amdgcn_mfma_f32_16x16x32_bf16(ah, bl[ks][nt], acc[nt], 0, 0, 0); } }
#pragma unroll
          for (int nt = 0; nt < 4; ++nt)
#pragma unroll
              for (int r = 0; r < 4; ++r) part[(wave * 16 + (lane >> 4) * 4 + r) * 64 + nt * 16 + (lane & 15)] = acc[nt][r]; }
        __syncthreads();
#pragma unroll
        for (int q = 0; q < 2; ++q) { const int o = tid + q * 512; float s = 0.f;
#pragma unroll
            for (int w = 0; w < 8; ++w) s += part[w * 1024 + o];
            sc[o] = 1.0f / (1.0f + expf(-s)); }
        __syncthreads();
        { LAS float* gsl = part; LAS float* cvl = part + 128;
#pragma unroll 1
          for (int q = 0; q < 2; ++q) { const int tk = wave * 2 + q; const size_t t = (size_t)tile * 16 + tk;
              const float s = sc[tk * 64 + lane], v = s + bias;
#define SWZ_MAX(x, o) fmaxf(x, __builtin_bit_cast(float, __builtin_amdgcn_ds_swizzle(__builtin_bit_cast(int, x), 0x1f | ((o) << 10))))
#define SWZ_ADD(x, o) ((x) + __builtin_bit_cast(float, __builtin_amdgcn_ds_swizzle(__builtin_bit_cast(int, x), 0x1f | ((o) << 10))))
              float m1 = v; m1 = SWZ_MAX(m1, 1); m1 = SWZ_MAX(m1, 2); m1 = SWZ_MAX(m1, 4);
              float c1 = (v == m1) ? 1.f : 0.f; c1 = SWZ_ADD(c1, 1); c1 = SWZ_ADD(c1, 2); c1 = SWZ_ADD(c1, 4);
              float m2 = (v == m1) ? -INFINITY : v; m2 = SWZ_MAX(m2, 1); m2 = SWZ_MAX(m2, 2); m2 = SWZ_MAX(m2, 4);
              const float gs = m1 + (c1 >= 2.f ? m1 : m2);
              if ((lane & 7) == 0) gsl[tk * 8 + (lane >> 3)] = gs;
              __syncthreads();
              int grank = 0; const int g = lane >> 3;
#pragma unroll
              for (int j = 0; j < 8; ++j) { const float x = gsl[tk * 8 + j]; grank += (x > gs || (x == gs && j < g)) ? 1 : 0; }
              const bool gsel = grank < 4; const float cv = gsel ? v : -INFINITY;
              cvl[tk * 64 + lane] = cv;
              __syncthreads();
              int rank = 0;
#pragma unroll 16
              for (int j = 0; j < 64; ++j) { const float x = cvl[tk * 64 + j]; rank += (x > cv || (x == cv && j < lane)) ? 1 : 0; }
              const bool sel = gsel && rank < 8;
              const float wsum = wave_sum(sel ? s : 0.f);
              if (sel) { R.ridx[t * 8 + rank] = lane; R.rwt[t * 8 + rank] = s * (2.5f / wsum); atomicAdd((unsigned*)&hist[lane], 1u); }
#undef SWZ_MAX
#undef SWZ_ADD
          } }
        __syncthreads();
    }
#undef RT_LOAD
    if (count && tid < 64 && hist[tid]) atomicAdd(&R.cnt[tid], hist[tid]);
    __syncthreads();
}
#ifndef DUP_PHASE
#define DUP_PHASE -1
#endif
constexpr int CTX_OFF = LDS_CTL + 1024, TAB_OFF = LDS_CTL + 7168;
constexpr size_t WS_WINE = 1 * MiB, WS_WINO = WS_WINE + (size_t)EINP * 1024 * 2, WS_WOUT = WS_WINO + (size_t)OINP * 1024 * 2, WS_XBF = 16 * MiB, WS_NAIVE = 80 * MiB;
#if defined(WITH_NAIVE)
constexpr size_t WS_MIXBF = 48 * MiB;
#else
constexpr size_t WS_MIXBF = 453 * MiB;
#endif
__device__ __forceinline__ int conv_split(int nwg, int G) {
#if defined(WITH_NAIVE)
    return 0;
#else
    const int rem = nwg % G; return rem == 0 ? 0 : (G - rem) * NWAVES * 4;
#endif
}
static_assert(WS_WOUT + 2 * 1024 * 1024 * 2 <= WS_XBF, "ws map");
constexpr size_t WS_WD = 48 * MiB, WS_WGU = WS_WD + 65 * 512 * 1024, WS_LISTS = 146 * MiB, WS_RIDX = 148 * MiB, WS_H = 149 * MiB, WS_ROWS8 = 229 * MiB;
static_assert(WS_WGU + (size_t)65 * 1024 * 1024 <= WS_LISTS && WS_H + (size_t)MOE_MAXBLK * 256 * 512 <= WS_ROWS8 && WS_ROWS8 + (size_t)nv::T_ * 8 * 2048 <= 512 * MiB, "moe ws map");
constexpr size_t WS_PROJB = 149 * MiB, WS_CT = 253 * MiB, WS_HLOC = 317 * MiB, WS_PC = 349 * MiB, WS_M0SMALL = 381 * MiB, WS_LRUW = 486 * MiB;
constexpr size_t WS_UT = 221 * MiB, WS_S5G = 253 * MiB, WS_M1SMALL = 269 * MiB, WS_GLUW = 486 * MiB + 256 * 1024;
constexpr size_t WS_RW = 487 * MiB;
constexpr int CW_PROBE = 9000;
struct Tab { const float* in[38]; float* out; unsigned char* ws; };
struct Env { const Tab* tab; unsigned char* ws; float* out; LAS unsigned char* lds; int tid, lane, wave, bid, G, gw, NGW, gtid, gsz, vcu; };
__device__ __forceinline__ Env penv(unsigned char* lds_raw) {
    Env e; e.tab = (const Tab*)(lds_raw + TAB_OFF); e.ws = e.tab->ws; e.out = e.tab->out; e.lds = (LAS unsigned char*)lds_raw;
    int t = threadIdx.x; asm volatile("" : "+v"(t)); e.tid = t; e.lane = t & 63; e.wave = __builtin_amdgcn_readfirstlane(t >> 6);
    int b = blockIdx.x; asm volatile("" : "+s"(b)); e.bid = b; int g = gridDim.x; asm volatile("" : "+s"(g)); e.G = g;
    e.vcu = (g % 8 == 0) ? (b % 8) * (g / 8) + b / 8 : b;
    e.gw = b * NWAVES + e.wave; e.NGW = g * NWAVES; e.gtid = b * NTHREADS + t; e.gsz = g * NTHREADS;
    return e;
}
__device__ __forceinline__ void grid_bar(const Env& e) {
    XcdBarrier b; b.bar = (unsigned*)e.ws + 4096; b.x = xb_xcc_id(); b.st = (volatile LAS unsigned*)(e.lds + MISC_OFF) + 8;
    xcd_barrier(b);
}
#if defined(WITH_NAIVE)
template <int ST> __device__ __forceinline__ void run_naive(unsigned char* lds_raw, int ci, long n) {
    const Env e = penv(lds_raw);
    const nv::Ctx& c = ((const nv::Ctx*)(lds_raw + CTX_OFF))[ci];
    for (long i = e.gtid; i < n; i += e.gsz) nv::item<ST>(c, i);
    grid_bar(e);
}
#endif
__device__ __forceinline__ void phase_p0(unsigned char* lds_raw) {
    const Env e = penv(lds_raw);
    LAS float* scr = (LAS float*)(e.lds + e.wave * 16640);
    constexpr int I0 = 16 * (EINP / 64), I1 = I0 + 16 * (OINP / 64), I2 = I1 + 256, I3 = I2 + 256, I4 = I3 + 32, I5 = I4 + 64;
    for (int it = e.gw; it < I5; it += e.NGW) {
        if (it < I0) tr_matrix_item(e.tab->in[6], 1024, nv::EIN, EINP, (bf16*)(e.ws + WS_WINE), scr, it, e.lane);
        else if (it < I1) tr_matrix_item(e.tab->in[16], 1024, nv::OIN, OINP, (bf16*)(e.ws + WS_WINO), scr, it - I0, e.lane);
        else if (it < I2) tr_matrix_item(e.tab->in[5], 1024, 1024, 1024, (bf16*)(e.ws + WS_WOUT), scr, it - I1, e.lane);
        else if (it < I3) tr_matrix_item(e.tab->in[5] + 1024 * 1024, 1024, 1024, 1024, (bf16*)(e.ws + WS_WOUT) + 1024 * 1024, scr, it - I2, e.lane);
        else if (it < I4) { const int r = it - I3, mtx = r >> 2, h = mtx & 3, which = mtx >> 2;
            tr_matrix_item(e.tab->in[which ? 13 : 11] + h * 16384, 128, 128, 128, (bf16*)(e.ws + WS_LRUW) + which * 65536 + h * 16384, scr, r & 3, e.lane); }
        else tr_matrix_item(e.tab->in[25], 512, 512, 512, (bf16*)(e.ws + WS_GLUW), scr, it - I4, e.lane);
    }
    for (int l = 0; l < 2; ++l) router_split_weights(e.tab->in[30] + (size_t)l * 65536, (bf16*)(e.ws + WS_RW) + (size_t)l * 131072, (bf16*)(e.ws + WS_RW) + (size_t)l * 131072 + 65536, e.gtid, e.gsz);
    cvt_rows(e.tab->in[0], (bf16*)(e.ws + WS_XBF), (long)T_ * 1024, e.gtid, e.gsz);
    grid_bar(e);
}
__device__ __forceinline__ void phase_inproj(unsigned char* lds_raw, int layer) {
    const Env e = penv(lds_raw);
    float* proj = (float*)(e.ws + WS_NAIVE) + ((size_t)T_ * 1024 + (size_t)T_ * 64 + (size_t)T_ * 8 * 2);
    const int NP = layer == 0 ? EINP : OINP;
    pg8::Gemm g{(const bf16*)(e.ws + WS_XBF), (const bf16*)(e.ws + (layer == 0 ? WS_WINE : WS_WINO)), 1024, 0, 0, nullptr};
    pg8::StaticOrder S; S.init(T_, NP, e.G, e.bid);
    pg8::EpiF32R E{proj, NP, nullptr, 0.f};
    pg8::gemm_phase<pg8::EpiF32R, pg8::StaticOrder, true, false>(e.lds, g, S, E);
    grid_bar(e);
}
__device__ __forceinline__ void phase_cvt_mixed(unsigned char* lds_raw) {
    const Env e = penv(lds_raw);
    cvt_rows((const float*)(e.ws + WS_NAIVE), (bf16*)(e.ws + WS_MIXBF), (long)T_ * 1024, e.gtid, e.gsz);
    grid_bar(e);
}
__device__ __forceinline__ void phase_outproj(unsigned char* lds_raw, int layer) {
    const Env e = penv(lds_raw);
    float* z = (float*)(e.ws + WS_NAIVE) + ((size_t)T_ * 1024 + (size_t)T_ * 64 + (size_t)T_ * 8 * 2);
    const float* hcur = layer == 0 ? e.tab->in[0] : e.out;
    pg8::Gemm g{(const bf16*)(e.ws + WS_MIXBF), (const bf16*)(e.ws + WS_WOUT) + (size_t)layer * 1024 * 1024, 1024, 0, 0, nullptr};
    pg8::StaticOrder S; S.init(T_, 1024, e.G, e.bid);
    pg8::EpiF32R E{z, 1024, hcur, nv::ALPHA};
    pg8::gemm_phase<pg8::EpiF32R, pg8::StaticOrder, true, false>(e.lds, g, S, E);
    grid_bar(e);
}
__device__ __forceinline__ Mix0Bufs mix0_bufs(unsigned char* ws) {
    Mix0Bufs B; B.proj = (const bf16*)(ws + WS_PROJB); B.ct = (bf16*)(ws + WS_CT); B.hloc = (bf16*)(ws + WS_HLOC); B.pc = (bf16*)(ws + WS_PC);
    float* sm = (float*)(ws + WS_M0SMALL); B.nloc = sm; sm += 8 * NCH * 128; B.blast = sm; sm += 8 * NCH; B.mloc = sm; sm += 8 * NCH; B.mprev = sm; sm += 8 * NCH;
    B.carA = sm; sm += 2 * NCH * 512; B.carU = sm; sm += 2 * NCH * 512; B.carI = sm; sm += 2 * NCH * 512; B.gst = sm;
    B.mixbf = (bf16*)(ws + WS_MIXBF); B.lruw = (const bf16*)(ws + WS_LRUW); return B;
}
__device__ __forceinline__ Mix1Bufs mix1_bufs(unsigned char* ws) {
    Mix1Bufs B; B.proj = (const bf16*)(ws + WS_PROJB); B.ut = (bf16*)(ws + WS_UT); B.s5g = (bf16*)(ws + WS_S5G);
    float* sm = (float*)(ws + WS_M1SMALL); B.gbl = sm; sm += 8 * NCH * 64; B.xend = sm; sm += 8192 * 128; B.xstart = sm; sm += 8192 * 128; B.s5ab = sm; sm += 4096; B.s5bb = sm; sm += 2048 * 32;
    B.cm = (bf16*)sm; B.bbt = B.cm + 32 * 32 * 128; B.mixbf = (bf16*)(ws + WS_MIXBF); return B;
}
__device__ __forceinline__ void phase_inproj_bf16(unsigned char* lds_raw, int layer) {
    const Env e = penv(lds_raw);
    const int NP = layer == 0 ? EINP : OINP;
    if (layer == 1) { const Mix1Bufs B = mix1_bufs(e.ws); s5_params(B, e.tab->in, e.gtid, e.gsz); }
    pg8::Gemm g{(const bf16*)(e.ws + WS_XBF), (const bf16*)(e.ws + (layer == 0 ? WS_WINE : WS_WINO)), 1024, 0, 0, nullptr};
    pg8::StaticOrder S; S.init(T_, NP, e.G, e.bid);
    pg8::EpiBf16P E{(bf16*)(e.ws + WS_PROJB), NP};
    pg8::gemm_phase<pg8::EpiBf16P, pg8::StaticOrder, true, false>(e.lds, g, S, E);
    { const int nwg = (T_ / 256) * (NP / 256), rem = nwg % e.G, na = conv_split(nwg, e.G);
      if (na > 0 && e.bid >= rem) { const int nlight = e.G - rem; LAS float* scr = (LAS float*)(e.lds + e.wave * 16640);
          moe_convert_weights(e.tab->in[32] + (size_t)layer * 64 * 262144, e.tab->in[33] + (size_t)layer * 64 * 262144, e.tab->in[34] + (size_t)layer * 64 * 262144,
                              e.tab->in[35] + (size_t)layer * 262144, e.tab->in[36] + (size_t)layer * 262144, e.tab->in[37] + (size_t)layer * 262144,
                              (bf16*)(e.ws + WS_WGU), (bf16*)(e.ws + WS_WD), scr, (e.bid - rem) * NWAVES + e.wave, na, nlight * NWAVES, e.lane); } }
    grid_bar(e);
}
__device__ __forceinline__ void phase_mix0_a(unsigned char* lds_raw) {
    const Env e = penv(lds_raw); const Mix0Bufs B = mix0_bufs(e.ws);
    for (int it = e.bid; it < 256 + 8 * NCH; it += e.G) {
        if (it < 256) { lru_a_item(B, e.tab->in, it, e.lds, e.tid); if (DUP_PHASE == 31) lru_a_item(B, e.tab->in, it, e.lds, e.tid); }
        else { mlstm_a_item(B, e.tab->in[7], it - 256, e.lds, e.tid); if (DUP_PHASE == 30) mlstm_a_item(B, e.tab->in[7], it - 256, e.lds, e.tid); } }
    grid_bar(e);
}
__device__ __forceinline__ int conv_rest(int nwg, int G, int NGW) {
#if defined(WITH_NAIVE)
    return 0;
#else
    const int nb = conv_split(nwg, G) + NGW * 3; return nb > 65 * 192 ? 65 * 192 : nb;
#endif
}
__device__ __forceinline__ void conv_in_scan_phase(const Env& e, int layer) {
#if !defined(WITH_NAIVE)
    const int na = conv_split((T_ / 256) * ((layer == 0 ? EINP : OINP) / 256), e.G); int nb = na + e.NGW * 3; if (nb > 65 * 192) nb = 65 * 192;
    LAS float* scr = (LAS float*)(e.lds + e.wave * 16640);
    moe_convert_weights(e.tab->in[32] + (size_t)layer * 64 * 262144, e.tab->in[33] + (size_t)layer * 64 * 262144, e.tab->in[34] + (size_t)layer * 64 * 262144,
                        e.tab->in[35] + (size_t)layer * 262144, e.tab->in[36] + (size_t)layer * 262144, e.tab->in[37] + (size_t)layer * 262144,
                        (bf16*)(e.ws + WS_WGU), (bf16*)(e.ws + WS_WD), scr, na + e.gw, nb, e.NGW, e.lane);
#endif
}
__device__ __forceinline__ void phase_mix0_b(unsigned char* lds_raw) {
    const Env e = penv(lds_raw); const Mix0Bufs B = mix0_bufs(e.ws);
    lru_b(B, e.gtid, e.gsz); mlstm_b(B, e.gtid, e.gsz);
    grid_bar(e);
}
__device__ __forceinline__ void phase_mix0_c(unsigned char* lds_raw) {
    const Env e = penv(lds_raw); const Mix0Bufs B = mix0_bufs(e.ws);
    for (int it = e.bid; it < 8 * NCH; it += e.G) { mlstm_c_item(B, e.tab->in[7], e.tab->in[8], it, e.lds, e.tid); if (DUP_PHASE == 32) mlstm_c_item(B, e.tab->in[7], e.tab->in[8], it, e.lds, e.tid); }
    lru_c(B, e.gtid, e.gsz); if (DUP_PHASE == 33) lru_c(B, e.gtid, e.gsz);
    grid_bar(e);
}
__device__ __forceinline__ void phase_mix1_a(unsigned char* lds_raw) {
    const Env e = penv(lds_raw); const Mix1Bufs B = mix1_bufs(e.ws);
    for (int it = e.bid; it < 8 * NCH; it += e.G) { gla_a_item(B, e.tab->in[27], e.tab->in[28], it, e.lds, e.tid); if (DUP_PHASE == 34) gla_a_item(B, e.tab->in[27], e.tab->in[28], it, e.lds, e.tid); }
    s5_phase<false>(B, e.tab->in[23], e.gw, e.NGW, e.lds + e.wave * 17408, e.lane); if (DUP_PHASE == 35) s5_phase<false>(B, e.tab->in[23], e.gw, e.NGW, e.lds + e.wave * 17408, e.lane);
    grid_bar(e);
}
__device__ __forceinline__ void phase_mix1_b(unsigned char* lds_raw) {
    const Env e = penv(lds_raw); const Mix1Bufs B = mix1_bufs(e.ws);
    s5_b(B, e.gtid, e.gsz); gla_b(B, e.gtid, e.gsz);
    grid_bar(e);
}
__device__ __forceinline__ void phase_mix1_c(unsigned char* lds_raw) {
    const Env e = penv(lds_raw); const Mix1Bufs B = mix1_bufs(e.ws);
    for (int it = e.bid; it < 8 * NCH; it += e.G) { gla_c_item(B, e.tab->in[27], e.tab->in[28], e.tab->in[29], it, e.lds, e.tid); if (DUP_PHASE == 36) gla_c_item(B, e.tab->in[27], e.tab->in[28], e.tab->in[29], it, e.lds, e.tid); }
#if defined(S5_OLD_C)
    for (int it = e.gw, k = 0; k < (2 * 32 * NCH + e.NGW - 1) / e.NGW; ++k, it += e.NGW) s5_chunk_v2<true>(B, e.tab->in[23], it, it < 2 * 32 * NCH, e.lds + e.wave * 16896, e.lane);
#else
    s5_phase<true>(B, e.tab->in[23], e.gw, e.NGW, e.lds + e.wave * 17408, e.lane); if (DUP_PHASE == 37) s5_phase<true>(B, e.tab->in[23], e.gw, e.NGW, e.lds + e.wave * 17408, e.lane);
#endif
    grid_bar(e);
}
__device__ __forceinline__ void phase_glu(unsigned char* lds_raw) {
    const Env e = penv(lds_raw);
    pg8::Gemm g{(const bf16*)(e.ws + WS_S5G), (const bf16*)(e.ws + WS_GLUW), 512, 0, 0, nullptr};
    pg8::StaticOrder S; S.init(T_, 512, e.G, e.bid);
    pg8::EpiGlu E{(bf16*)(e.ws + WS_MIXBF), 1024, (const bf16*)(e.ws + WS_S5G), 512, e.tab->in[26]};
    pg8::gemm_phase<pg8::EpiGlu, pg8::StaticOrder, true, false>(e.lds, g, S, E);
    grid_bar(e);
}
__device__ __forceinline__ void phase_probe(unsigned char* lds_raw, int c0, int c1) {
    const Env e = penv(lds_raw);
    const bf16* a = (const bf16*)(e.ws + WS_MIXBF); const float* b = (const float*)(e.ws + WS_NAIVE);
    float sd = 0.f, sr = 0.f; const int w = c1 - c0;
    for (long i = e.gtid; i < (long)T_ * w; i += e.gsz) { const long t = i / w; const int c = c0 + (int)(i % w); const float x = bf2f(a[t * 1024 + c]), y = b[t * 1024 + c]; sd += (x - y) * (x - y); sr += y * y; }
    sd = wave_sum(sd); sr = wave_sum(sr);
    if (e.lane == 0) { atomicAdd((float*)e.ws + CW_PROBE, sd); atomicAdd((float*)e.ws + CW_PROBE + 1, sr); }
    grid_bar(e);
}
__device__ __forceinline__ void phase_probe_apply(unsigned char* lds_raw) {
    const Env e = penv(lds_raw);
    const float sd = __hip_atomic_load((float*)e.ws + CW_PROBE, __ATOMIC_RELAXED, __HIP_MEMORY_SCOPE_AGENT), sr = __hip_atomic_load((float*)e.ws + CW_PROBE + 1, __ATOMIC_RELAXED, __HIP_MEMORY_SCOPE_AGENT);
    const float f = 1.0f + 10.0f * sqrtf(sd / fmaxf(sr, 1e-30f));
    for (long i = e.gtid; i < (long)T_ * 1024; i += e.gsz) e.out[i] *= f;
}
__device__ __forceinline__ void phase_ln_router(unsigned char* lds_raw, int layer, bool count = true) {
    const Env e = penv(lds_raw);
    RouterBufs R; R.z = (const float*)(e.ws + WS_NAIVE) + ((size_t)T_ * 1024 + (size_t)T_ * 64 + (size_t)T_ * 8 * 2); R.h = e.out; R.hbf = (bf16*)(e.ws + WS_XBF);
    R.lnw = e.tab->in[1] + layer * 1024; R.lnb = e.tab->in[2] + layer * 1024; R.rwh = (const bf16*)(e.ws + WS_RW) + (size_t)layer * 131072; R.rwl = R.rwh + 65536;
    R.rbias = e.tab->in[31] + layer * 64; R.ridx = (int*)(e.ws + WS_RIDX); R.rwt = (float*)(e.ws + WS_RIDX) + (size_t)T_ * 8; R.cnt = (unsigned*)e.ws + CW_CNT + layer * 256;
    router_tiles(R, e.bid, e.G, T_ / 16, e.lds, e.tid, count);
    grid_bar(e);
}
__device__ __forceinline__ MoeLists moe_lists(unsigned char* ws) {
    MoeLists L; L.tok = (int*)(ws + WS_LISTS); L.dest = L.tok + MOE_MAXBLK * 256; L.w = (float*)(L.dest + MOE_MAXBLK * 256); L.blk_e = (int*)(L.w + MOE_MAXBLK * 256); return L;
}
__device__ __forceinline__ void phase_moe_x1(unsigned char* lds_raw, int layer, int curoff = 0) {
    const Env e = penv(lds_raw);
    moe_build_lists((const int*)(e.ws + WS_RIDX), (const float*)(e.ws + WS_RIDX) + (size_t)T_ * 8, (unsigned*)e.ws + CW_CNT + layer * 256, (unsigned*)e.ws + CW_CUR + layer * 256 + curoff,
                    moe_lists(e.ws), (LAS int*)e.lds, e.tid, e.bid, e.G);
    LAS float* scr = (LAS float*)(e.lds + e.wave * 16640);
    moe_convert_weights(e.tab->in[32] + (size_t)layer * 64 * 262144, e.tab->in[33] + (size_t)layer * 64 * 262144, e.tab->in[34] + (size_t)layer * 64 * 262144,
                        e.tab->in[35] + (size_t)layer * 262144, e.tab->in[36] + (size_t)layer * 262144, e.tab->in[37] + (size_t)layer * 262144,
                        (bf16*)(e.ws + WS_WGU), (bf16*)(e.ws + WS_WD), scr, conv_split((T_ / 256) * ((layer == 0 ? EINP : OINP) / 256), e.G) + e.gw, 65 * 192, e.NGW, e.lane);
    grid_bar(e);
}
__device__ __forceinline__ void phase_moe_g1(unsigned char* lds_raw) {
    const Env e = penv(lds_raw);
    const MoeLists L = moe_lists(e.ws);
    const int nblk = __builtin_amdgcn_readfirstlane(L.blk_e[MOE_MAXBLK]);
    pg8::Gemm g{(const bf16*)(e.ws + WS_XBF), (const bf16*)(e.ws + WS_WGU), 1024, 0, (size_t)512 * 1024, L.tok};
    pg8::MoeOrder S{L.blk_e, nblk, 2, e.G, e.vcu};
    pg8::EpiSwiGLU E{(bf16*)(e.ws + WS_H)};
    pg8::gemm_phase<pg8::EpiSwiGLU, pg8::MoeOrder, true, true>(e.lds, g, S, E);
    grid_bar(e);
}
__device__ __forceinline__ void phase_moe_g2(unsigned char* lds_raw) {
    const Env e = penv(lds_raw);
    const MoeLists L = moe_lists(e.ws);
    const int nblk = __builtin_amdgcn_readfirstlane(L.blk_e[MOE_MAXBLK]);
    pg8::Gemm g{(const bf16*)(e.ws + WS_H), (const bf16*)(e.ws + WS_WD), 256, 0, (size_t)1024 * 256, nullptr};
    pg8::MoeOrder S{L.blk_e, nblk, 4, e.G, e.vcu};
    pg8::EpiDown E{(bf16*)(e.ws + WS_ROWS8), (bf16*)(e.ws + WS_XBF), L.dest, T_ * 8};
    pg8::gemm_phase<pg8::EpiDown, pg8::MoeOrder, true, false>(e.lds, g, S, E);
    grid_bar(e);
}
__device__ __forceinline__ void phase_moe_combine(unsigned char* lds_raw, int layer) {
    const Env e = penv(lds_raw);
    moe_combine_ln(e.out, (const bf16*)(e.ws + WS_ROWS8), (const bf16*)(e.ws + WS_XBF), (const float*)(e.ws + WS_RIDX) + (size_t)T_ * 8, e.tab->in[3] + layer * 1024, e.tab->in[4] + layer * 1024,
                   layer == 0 ? (bf16*)(e.ws + WS_XBF) : nullptr, e.gw, e.NGW, e.lane);
    grid_bar(e);
}

#define RUN(k, call) do { call; if (DUP_PHASE == (k)) { call; } } while (0)
#ifndef TIME_PHASE
#define TIME_PHASE -1
#endif
#define TIMED(k, call) do { unsigned long long _t0 = 0; if (TIME_PHASE == (k)) _t0 = __builtin_amdgcn_s_memrealtime(); call; \
    if (TIME_PHASE == (k) && blockIdx.x == 0 && threadIdx.x == 0) { const unsigned long long _t1 = __builtin_amdgcn_s_memrealtime(); unsigned* w_ = (unsigned*)((Tab*)(lds_raw + TAB_OFF))->ws + CW_PROBE + 8; *w_ = *w_ + (unsigned)(_t1 - _t0); } } while (0)
template <int layer> __device__ __forceinline__ void layer_body(unsigned char* lds_raw) {
#if defined(WITH_NAIVE)
    constexpr int ci = layer * 2;
#if defined(DBG_MIX0)
    constexpr bool naive_too = (layer == DBG_MIX0 - 1);
#else
    constexpr bool naive_too = false;
#endif
#endif
    RUN(1, phase_inproj_bf16(lds_raw, layer));
    if (layer == 0) { RUN(2, phase_mix0_a(lds_raw)); TIMED(20, phase_mix0_b(lds_raw)); RUN(3, phase_mix0_c(lds_raw)); }
    if (layer == 1) { RUN(4, phase_mix1_a(lds_raw)); TIMED(21, phase_mix1_b(lds_raw)); RUN(5, phase_mix1_c(lds_raw)); RUN(6, phase_glu(lds_raw)); }
#if defined(WITH_NAIVE)
    if (naive_too) {
        phase_inproj(lds_raw, layer);
        if (layer == 0) {
            run_naive<nv::ST_ML_GATES>(lds_raw, ci, 8L * NCH);
            run_naive<nv::ST_ML_CLOC>(lds_raw, ci, 8L * NCH * 16384);
            run_naive<nv::ST_ML_SCAN>(lds_raw, ci, 8L * 16384 + 8 * 128);
            run_naive<nv::ST_ML_MI>(lds_raw, ci, 8L * S_);
            run_naive<nv::ST_ML_SMAT>(lds_raw, ci, 8L * NCH * 4096);
            run_naive<nv::ST_ML_DEN>(lds_raw, ci, 8L * S_);
            run_naive<nv::ST_ML_H>(lds_raw, ci, 8L * S_ * 128);
            run_naive<nv::ST_ML_NORM>(lds_raw, ci, 8L * S_);
            run_naive<nv::ST_LRU_CONV>(lds_raw, ci, (long)T_ * 512);
            run_naive<nv::ST_LRU_GATE>(lds_raw, ci, (long)T_ * 512);
            run_naive<nv::ST_LRU_SCAN>(lds_raw, ci, 2L * 512);
        } else {
            run_naive<nv::ST_S5_PAR>(lds_raw, ci, 2048);
            for (int sl = 0; sl < S_ / nv::SLAB; ++sl) {
                if (threadIdx.x == 0) ((nv::Ctx*)(lds_raw + CTX_OFF))[ci].slab = sl;
                __syncthreads();
                run_naive<nv::ST_S5_SCAN>(lds_raw, ci, 2L * 2048); run_naive<nv::ST_S5_OUT>(lds_raw, ci, (long)nv::B_ * nv::SLAB * 512); }
            run_naive<nv::ST_S5_GLU>(lds_raw, ci, (long)T_ * 512);
            run_naive<nv::ST_GLA_GATE>(lds_raw, ci, (long)T_ * 256);
            run_naive<nv::ST_GLA_CUM>(lds_raw, ci, (long)nv::B_ * NCH * 256);
            run_naive<nv::ST_GLA_U>(lds_raw, ci, 8L * NCH * 8192);
            run_naive<nv::ST_GLA_SCAN>(lds_raw, ci, 8L * 8192);
            run_naive<nv::ST_GLA_ATT>(lds_raw, ci, 8L * NCH * 4096);
            run_naive<nv::ST_GLA_O>(lds_raw, ci, 8L * S_ * 128);
            run_naive<nv::ST_GLA_NORM>(lds_raw, ci, 8L * S_);
        }
        phase_probe(lds_raw, DBG_C0, DBG_C1);
        phase_cvt_mixed(lds_raw);
    }
#endif
    RUN(7, phase_outproj(lds_raw, layer));
    TIMED(22, phase_ln_router(lds_raw, layer)); if (DUP_PHASE == 22) phase_ln_router(lds_raw, layer, false);
    phase_moe_x1(lds_raw, layer); if (DUP_PHASE == 8) phase_moe_x1(lds_raw, layer, 1024);
    RUN(9, phase_moe_g1(lds_raw));
    RUN(10, phase_moe_g2(lds_raw));
    TIMED(24, phase_moe_combine(lds_raw, layer));
}
#if defined(STORE_TEST)
__device__ __forceinline__ void phase_store_test(unsigned char* lds_raw) {
    const Env e = penv(lds_raw);
    unsigned char* base = e.ws + WS_ROWS8 + (size_t)e.bid * (1u << 20);
    const int wr = e.wave >> 2, wc = e.wave & 3, fr = e.lane & 15, fq = e.lane >> 4;
    const v4u val = {(unsigned)e.tid, 1u, 2u, 3u};
    for (int u = 0; u < 40; ++u) {
#pragma unroll
        for (int s = 0; s < 8; ++s)
#pragma unroll
            for (int bj = 0; bj < 2; ++bj) {
#if STORE_TEST == 1
                const int r = (s >> 2) * 128 + wr * 64 + (s & 3) * 16 + fr; const int cb = wc * 64 + fq * 16 + bj * 256;
#elif STORE_TEST == 2
                const int r = (s >> 2) * 128 + wr * 64 + (s & 3) * 16 + bj * 8 + (e.lane >> 3); const int cb = wc * 128 + (e.lane & 7) * 16;
#else
                const int r = (s >> 2) * 128 + wr * 64 + (s & 3) * 16 + bj * 8 + (e.lane >> 4) * 2 + (wc & 1); const int cb = (wc >> 1) * 256 + (e.lane & 15) * 16;
#endif
                *(v4u*)(base + (size_t)((u & 1) * 256 + r) * 2048 + cb) = val; }
        asm volatile("" ::: "memory"); }
    grid_bar(e);
}
#endif
struct Args { const float* in[38]; float* out; unsigned char* ws; };
__global__ void __launch_bounds__(NTHREADS, 2) mega_fwd(Args a) {
    extern __shared__ __attribute__((aligned(16))) unsigned char lds_raw[];
    {
        LAS unsigned char* lds = (LAS unsigned char*)lds_raw;
        for (int u = threadIdx.x; u < (LDS_BYTES - LDS_CTL) / 4; u += NTHREADS) ((LAS unsigned*)(lds + LDS_CTL))[u] = 0u;
        __syncthreads();
        if (threadIdx.x == 0) {
            (void)xb_add((unsigned*)a.ws + 4096 + XB_XCNT(xb_xcc_id()), 1u);
            Tab* tab = (Tab*)(lds_raw + TAB_OFF);
#pragma unroll
            for (int i = 0; i < 38; ++i) { tab->in[i] = a.in[i]; if ((i & 7) == 7) asm volatile("" ::: "memory"); }
            tab->out = a.out; tab->ws = a.ws;
            asm volatile("" ::: "memory");
#if defined(WITH_NAIVE)
            nv::Ctx* const ctab = (nv::Ctx*)(lds_raw + CTX_OFF);
            const size_t scratch0 = (size_t)T_ * 1024 + (size_t)T_ * 64 + (size_t)T_ * 8 * 2;
#pragma unroll 1
            for (int layer = 0; layer < 2; ++layer) {
                nv::Ctx& c = ctab[layer * 2];
                nv::Mem M{(float*)(a.ws + WS_NAIVE), 0};
#pragma unroll 1
                for (int i = 0; i < 38; ++i) c.in[i] = tab->in[i];
                c.mixed = M.get((size_t)T_ * 1024); c.scores = M.get((size_t)T_ * 64);
                c.ridx = (int*)M.get((size_t)T_ * 8); c.rwt = M.get((size_t)T_ * 8);
                c.gR = nullptr; c.gBias = nullptr; c.slab = 0;
                c.layer = layer;
                c.hcur = layer == 0 ? a.in[0] : a.out;
                if (layer == 0) {
                    c.ldp = EINP; c.proj = M.get((size_t)T_ * c.ldp);
                    c.mb = M.get(8 * S_); c.mig = M.get(8 * S_); c.mblast = M.get(8 * NCH); c.mmloc = M.get(8 * NCH); c.mmprev = M.get(8 * NCH);
                    c.mmi = M.get(8 * S_); c.mwin = M.get(8 * S_); c.mden = M.get(8 * S_); c.nloc = M.get(8 * NCH * 128);
                    const size_t ov = M.off;
                    c.cloc = M.get((size_t)8 * NCH * 16384); c.smat = M.get((size_t)8 * NCH * 4096); c.htil = M.get((size_t)T_ * 512);
                    M.off = ov; c.lxc = M.get((size_t)T_ * 512); c.la = M.get((size_t)T_ * 512); c.lu = M.get((size_t)T_ * 512);
                } else {
                    c.ldp = OINP; c.proj = M.get((size_t)T_ * c.ldp);
                    c.s5ab = M.get(2048 * 2); c.s5bbr = M.get(2048 * 16); c.s5bbi = M.get(2048 * 16); c.s5st = M.get(2 * 2048 * 2);
                    c.s5x = M.get((size_t)nv::B_ * nv::SLAB * 2048 * 2); c.s5g = M.get((size_t)T_ * 512);
                    c.gla_la = M.get((size_t)T_ * 256); c.gla_bc = M.get((size_t)T_ * 256); c.gla_bl = M.get((size_t)nv::B_ * NCH * 256);
                    c.gu = M.get((size_t)8 * NCH * 8192); c.gatt = M.get((size_t)8 * NCH * 4096); c.go = M.get((size_t)T_ * 512);
                }
                c.z = c.proj; c.hout = a.out; c.lnw = a.in[1] + layer * 1024; c.lnb = a.in[2] + layer * 1024;
                M.off = scratch0; c.hid = M.get((size_t)T_ * 9 * 256);
                nv::Ctx& cm = ctab[layer * 2 + 1];
                cm = c; cm.hcur = a.out;
#ifdef DBG_LAYER
                if (layer == DBG_LAYER) { nv::Ctx& cd = ctab[4]; cd = cm;
                cd.hid = (float*)(a.ws + 48 * MiB); cd.z = (float*)(a.ws + 486 * MiB); cd.hcur = a.out + (size_t)DBG_T0 * 1024; cd.ridx = c.ridx + (size_t)DBG_T0 * 8; cd.rwt = c.rwt + (size_t)DBG_T0 * 8; }
#endif
            }
#endif
        }
        __syncthreads();
    }
    RUN(0, phase_p0(lds_raw));
    layer_body<0>(lds_raw);
    layer_body<1>(lds_raw);
#if defined(STORE_TEST)
    phase_store_test(lds_raw);
#endif
#if defined(DBG_MIX0)
    phase_probe_apply(lds_raw);
#endif
    if (TIME_PHASE >= 0) { const Env e = penv(lds_raw); const unsigned ticks = __hip_atomic_load((unsigned*)e.ws + CW_PROBE + 8, __ATOMIC_RELAXED, __HIP_MEMORY_SCOPE_AGENT);
        const float f = 1.0f + 0.0005f * (float)ticks * 0.01f;
        for (long i = e.gtid; i < (long)T_ * 1024; i += e.gsz) e.out[i] *= f; }
}
extern "C" void kernel_launch(void* const* d_in, const int* in_sizes, int n_in, void* d_out, int out_size, void* d_ws, size_t ws_size, hipStream_t stream) {
    static int grid = 0;
    if (grid == 0) {
        int dev = 0, cus = 0, per_cu = 0;
        hipGetDevice(&dev); hipDeviceGetAttribute(&cus, hipDeviceAttributeMultiprocessorCount, dev);
        hipFuncSetAttribute((const void*)mega_fwd, hipFuncAttributeMaxDynamicSharedMemorySize, LDS_BYTES);
        hipOccupancyMaxActiveBlocksPerMultiprocessor(&per_cu, (const void*)mega_fwd, NTHREADS, LDS_BYTES);
        (void)hipGetLastError();
        grid = (per_cu >= 1) ? cus : -1;
    }
    if (grid < 0) return;
    hipMemsetAsync(d_ws, 0, CTL_BYTES, stream);
    Args a{};
    for (int i = 0; i < 38; ++i) a.in[i] = (const float*)d_in[i];
    a.out = (float*)d_out; a.ws = (unsigned char*)d_ws;
    hipLaunchKernelGGL(mega_fwd, dim3(grid), dim3(NTHREADS), LDS_BYTES, stream, a);
}
```

```cpp
#define OPT_MIX0 1
#define OPT_MIX1 1
#define OPT_ROUTER 1
#include <hip/hip_runtime.h>
#define GAS __attribute__((address_space(1)))
#define LAS __attribute__((address_space(3)))
#define XB_TMO      128
#define XB_XCNT(j)  (256  + 64 * (j))
#define XB_XSUB(j)  (1280 + 64 * (j))
#define XB_XGEN(j)  (2304 + 64 * (j))
#define XB_TOP      3328
#define XB_TOPGEN   3392
#define XCD_BAR_WORDS 3456
#define XB_SPIN_CAP (1u << 22)
__device__ __forceinline__ unsigned xb_ld(unsigned* p)              { return __hip_atomic_load(p, __ATOMIC_RELAXED, __HIP_MEMORY_SCOPE_AGENT); }
__device__ __forceinline__ unsigned xb_add(unsigned* p, unsigned v) { return __hip_atomic_fetch_add(p, v, __ATOMIC_RELAXED, __HIP_MEMORY_SCOPE_AGENT); }
__device__ __forceinline__ unsigned xb_xcc_id() { return (unsigned)__builtin_amdgcn_s_getreg((3 << 11) | 20) & 0xFu; }
#define XB_SPIN(cond, bar) do { unsigned _sp = 0; while (cond) { __builtin_amdgcn_s_sleep(1); \
    if ((++_sp & 255u) == 0u) { if (xb_ld(&(bar)[XB_TMO])) break; if (_sp > XB_SPIN_CAP) { atomicAdd(&(bar)[XB_TMO], 1u); break; } } } } while (0)
struct XcdBarrier { unsigned* bar; unsigned x; volatile LAS unsigned* st; };
__device__ __forceinline__ XcdBarrier xcd_barrier_post(unsigned* bar, volatile LAS unsigned* st) {
    XcdBarrier b; b.bar = bar; b.x = xb_xcc_id(); b.st = st;
    if (threadIdx.x == 0) (void)xb_add(&bar[XB_XCNT(b.x)], 1u);
    return b;
}
__device__ __forceinline__ void xcd_barrier_complete(unsigned* bar, unsigned x, unsigned& nloc, unsigned& nx) {
    const unsigned G = gridDim.x * gridDim.y * gridDim.z;
    unsigned sum, cnt, mine, sp = 0u;
    for (;;) {
        sum = 0u; cnt = 0u; mine = 0u;
#pragma unroll
        for (unsigned j = 0; j < 16; ++j) { const unsigned c = xb_ld(&bar[XB_XCNT(j)]); sum += c; cnt += (c > 0u) ? 1u : 0u; mine = (j == x) ? c : mine; }
        if (sum == G) break;
        __builtin_amdgcn_s_sleep(1);
        if ((++sp & 255u) == 0u) { if (xb_ld(&bar[XB_TMO])) break; if (sp > XB_SPIN_CAP) { atomicAdd(&bar[XB_TMO], 1u); break; } }
    }
    nloc = mine > 0u ? mine : 1u; nx = cnt > 0u ? cnt : 1u;
}
__device__ __forceinline__ void xcd_barrier(const XcdBarrier& b) {
    asm volatile("s_waitcnt vmcnt(0)" ::: "memory");
    __syncthreads();
    if (threadIdx.x == 0) {
        unsigned* bar = b.bar;
        __builtin_amdgcn_s_waitcnt(0);
        unsigned nloc = b.st[0], nx = b.st[1];
        if (nloc == 0u) { xcd_barrier_complete(bar, b.x, nloc, nx); b.st[0] = nloc; b.st[1] = nx; }
        const unsigned old = xb_add(&bar[XB_XSUB(b.x)], 1u);
        const unsigned gen = old / nloc;
        if (old + 1u == (gen + 1u) * nloc) {
            __builtin_amdgcn_fence(__ATOMIC_RELEASE, "agent");
            asm volatile("s_waitcnt vmcnt(0)" ::: "memory");
            const unsigned og = xb_add(&bar[XB_TOP], 1u);
            const unsigned tg = og / nx;
            if (og + 1u == (tg + 1u) * nx) xb_add(&bar[XB_TOPGEN], 1u);
            else XB_SPIN(xb_ld(&bar[XB_TOPGEN]) == tg, bar);
            __builtin_amdgcn_fence(__ATOMIC_ACQUIRE, "agent");
            xb_add(&bar[XB_XGEN(b.x)], 1u);
            asm volatile("s_waitcnt vmcnt(0)" ::: "memory");
        } else {
            XB_SPIN(xb_ld(&bar[XB_XGEN(b.x)]) == gen, bar);
            __builtin_amdgcn_fence(__ATOMIC_ACQUIRE, "agent");
            asm volatile("s_waitcnt vmcnt(0)" ::: "memory");
        }
    }
    __syncthreads();
}
namespace pg8 {
#define PG8_LAS __attribute__((address_space(3)))
typedef unsigned short bf16_t;
typedef short bf16x8 __attribute__((ext_vector_type(8)));
typedef float f32x4 __attribute__((ext_vector_type(4)));
typedef unsigned u32x4 __attribute__((ext_vector_type(4)));
constexpr int BM = 256, BK = 64, HALF = 128, HTB = HALF * BK * 2, STAGE_BYTES = 8 * HTB, NXCD = 8, WGM = 8;
__host__ __device__ __forceinline__ int lds_byte(int r, int c) { const int st = (r >> 4) * 2 + (c >> 5), rr = r & 15, cc = c & 31, ob = rr * 64 + cc * 2; return st * 1024 + (ob ^ (((ob >> 9) & 1) << 5)); }
__host__ __device__ __forceinline__ void stage_rc(int b, int& R, int& C) { const int st = b / 1024, sb = b % 1024, swz = sb ^ (((sb >> 9) & 1) << 5); R = (st >> 1) * 16 + swz / 64; C = (st & 1) * 32 + (swz % 64) / 2; }
__host__ __device__ __forceinline__ int perm32(int rho) { const int n = rho >> 4, i = rho & 15; return 8 * (i >> 2) + 4 * n + (i & 3); }
struct Unit { int pm, pn, e, aux; };
struct Gemm { const bf16_t* A; const bf16_t* Bt; int K; int pad; size_t bstride; const int* rows; };
struct StaticOrder {
    int nM, nN, nwg, G, c;
    __host__ __device__ void init(int M, int N, int G_, int c_) { nM = M / BM; nN = N / BM; nwg = nM * nN; G = G_; c = c_; }
    __host__ __device__ bool next(int i, Unit& u) const {
        const long L = (long)i * G + c; if (L >= nwg) return false;
        int wgid = (int)L; { const int q = nwg / NXCD, r = nwg % NXCD, xcd = wgid % NXCD, off = wgid / NXCD; wgid = (xcd < r ? xcd * (q + 1) : r * (q + 1) + (xcd - r) * q) + off; }
        const int nig = WGM * nN, gid = wgid / nig, fm = gid * WGM, gsz = (nM - fm) < WGM ? (nM - fm) : WGM;
        u.pm = fm + ((wgid % nig) % gsz); u.pn = (wgid % nig) / gsz; u.e = 0; u.aux = 0; return true;
    }
};
__device__ __forceinline__ unsigned cvt_pk_bf16(float lo, float hi) { unsigned r; asm volatile("v_cvt_pk_bf16_f32 %0, %1, %2" : "=v"(r) : "v"(lo), "v"(hi)); return r; }
struct EpiF32R {
    static constexpr int NPRE = 0; __device__ __forceinline__ void load_pre(const Unit&, int, int, int (&)[1]) const {}
    static constexpr bool PERM = false;
    float* C; int ldc; const float* R; float ralpha;
    __device__ __forceinline__ void operator()(const f32x4 (&acc)[2][2][4][2], const Unit& u, int wr, int wc, int fr, int fq) const {
        const int row0 = u.pm * BM + wr * 64 + fr, col0 = u.pn * BM + wc * 32 + 4 * fq;
#pragma unroll
        for (int ai = 0; ai < 2; ++ai)
#pragma unroll
            for (int m = 0; m < 4; ++m) { const size_t off = (size_t)(row0 + ai * HALF + m * 16) * ldc + col0;
#pragma unroll
                for (int bj = 0; bj < 2; ++bj)
#pragma unroll
                    for (int n = 0; n < 2; ++n) { f32x4 v = acc[ai][bj][m][n]; if (R) v = v + ralpha * *(const f32x4*)(R + off + bj * HALF + n * 16); *(f32x4*)(C + off + bj * HALF + n * 16) = v; } }
    }
};
struct EpiBf16P {
    static constexpr int NPRE = 0; __device__ __forceinline__ void load_pre(const Unit&, int, int, int (&)[1]) const {}
    static constexpr bool PERM = true;
    bf16_t* O; int ldc;
    __device__ __forceinline__ void operator()(const f32x4 (&acc)[2][2][4][2], const Unit& u, int wr, int wc, int fr, int fq) const {
        const int row0 = u.pm * BM + wr * 64 + fr, col0 = u.pn * BM + wc * 32 + 8 * fq;
#pragma unroll
        for (int ai = 0; ai < 2; ++ai)
#pragma unroll
            for (int m = 0; m < 4; ++m) { bf16_t* rowp = O + (size_t)(row0 + ai * HALF + m * 16) * ldc + col0;
#pragma unroll
                for (int bj = 0; bj < 2; ++bj) { const f32x4 v0 = acc[ai][bj][m][0], v1 = acc[ai][bj][m][1];
                    u32x4 w; w.x = cvt_pk_bf16(v0[0], v0[1]); w.y = cvt_pk_bf16(v0[2], v0[3]); w.z = cvt_pk_bf16(v1[0], v1[1]); w.w = cvt_pk_bf16(v1[2], v1[3]);
                    *(u32x4*)(rowp + bj * HALF) = w; } }
    }
};
struct EpiGlu {
    static constexpr int NPRE = 0; __device__ __forceinline__ void load_pre(const Unit&, int, int, int (&)[1]) const {}
    static constexpr bool PERM = true;
    bf16_t* O; int ldo; const bf16_t* Gm; int ldg; const float* bias;
    __device__ __forceinline__ void operator()(const f32x4 (&acc)[2][2][4][2], const Unit& u, int wr, int wc, int fr, int fq) const {
        const int row0 = u.pm * BM + wr * 64 + fr, col0 = u.pn * BM + wc * 32 + 8 * fq;
#pragma unroll
        for (int ai = 0; ai < 2; ++ai)
#pragma unroll
            for (int m = 0; m < 4; ++m) { const size_t r = (size_t)(row0 + ai * HALF + m * 16);
#pragma unroll
                for (int bj = 0; bj < 2; ++bj) { const int c = col0 + bj * HALF;
                    const f32x4 b0 = *(const f32x4*)(bias + c), b1 = *(const f32x4*)(bias + c + 4); const u32x4 gv = *(const u32x4*)(Gm + r * ldg + c);
                    const f32x4 v0 = acc[ai][bj][m][0] + b0, v1 = acc[ai][bj][m][1] + b1;
                    float g[8] = {__builtin_bit_cast(float, gv.x << 16), __builtin_bit_cast(float, gv.x & 0xffff0000u), __builtin_bit_cast(float, gv.y << 16), __builtin_bit_cast(float, gv.y & 0xffff0000u),
                                  __builtin_bit_cast(float, gv.z << 16), __builtin_bit_cast(float, gv.z & 0xffff0000u), __builtin_bit_cast(float, gv.w << 16), __builtin_bit_cast(float, gv.w & 0xffff0000u)};
                    u32x4 w; w.x = cvt_pk_bf16(g[0] * __builtin_amdgcn_rcpf(1.f + __expf(-v0[0])), g[1] * __builtin_amdgcn_rcpf(1.f + __expf(-v0[1]))); w.y = cvt_pk_bf16(g[2] * __builtin_amdgcn_rcpf(1.f + __expf(-v0[2])), g[3] * __builtin_amdgcn_rcpf(1.f + __expf(-v0[3])));
                    w.z = cvt_pk_bf16(g[4] * __builtin_amdgcn_rcpf(1.f + __expf(-v1[0])), g[5] * __builtin_amdgcn_rcpf(1.f + __expf(-v1[1]))); w.w = cvt_pk_bf16(g[6] * __builtin_amdgcn_rcpf(1.f + __expf(-v1[2])), g[7] * __builtin_amdgcn_rcpf(1.f + __expf(-v1[3])));
                    *(u32x4*)(O + r * ldo + c) = w; } }
    }
};
template <class Epi, class Sched, bool ALIGN_EPI, bool GATHER>
__device__ __forceinline__ void gemm_phase(PG8_LAS unsigned char* lds, const Gemm g, const Sched& S, const Epi& E) {
    int tid_ = threadIdx.x; asm volatile("" : "+v"(tid_));
    const int tid = tid_, wid = __builtin_amdgcn_readfirstlane(tid >> 6), lane = tid & 63, wr = wid >> 2, wc = wid & 3, fr = lane & 15, fq = lane >> 4;
    const int K = g.K, nt = K / BK;
    unsigned voffA[2], voffB[2];
#pragma unroll
    for (int i = 0; i < 2; ++i) { int R, C; stage_rc(tid * 16 + i * 8192, R, C); const int Rb = Epi::PERM ? ((R & ~31) + perm32(R & 31)) : R;
        voffA[i] = (unsigned)(R * K + C) * 2u; voffB[i] = (unsigned)(Rb * K + C) * 2u; }
    const size_t kstep = (size_t)(BK * 2);
    const size_t hstep = (size_t)HALF * K * 2;
    const size_t tstep = 2 * hstep;
    const unsigned ldsw = (unsigned)wid * 1024u;
    const int aoff = lds_byte(wr * 64 + fr, fq * 8), boff = lds_byte(wc * 32 + fr, fq * 8);
#define PG8_SA(b, h) (((b) * 2 + (h)) * HTB)
#define PG8_SB(b, h) ((4 + (b) * 2 + (h)) * HTB)
#define PG8_STAGE(bufoff, gbase, voff) do { _Pragma("unroll") for (int _i = 0; _i < 2; ++_i) { unsigned _vo = (voff)[_i]; asm volatile("" : "+v"(_vo));   \
        __builtin_amdgcn_global_load_lds((const unsigned*)((const char*)(gbase) + _vo), (PG8_LAS unsigned*)(lds + (bufoff) + ldsw + _i * 8192), 16, 0, 0); } } while (0)
#define PG8_STAGE_A(bufoff, gbase, h, GV) do { if constexpr (GATHER) { PG8_STAGE(bufoff, gbase, GV[h]); } else { PG8_STAGE(bufoff, (gbase) + (h) * hstep, voffA); } } while (0)
#define PG8_STAGE_A2(bufoff, gbase, h) do { if constexpr (GATHER) { unsigned _gv[2] = {last ? gnxt[h][0] : gcur[h][0], last ? gnxt[h][1] : gcur[h][1]}; PG8_STAGE(bufoff, gbase, _gv); } else { PG8_STAGE(bufoff, (gbase) + (h) * hstep, voffA); } } while (0)
#define PG8_LDA(dst, b, h) do { _Pragma("unroll") for (int m = 0; m < 4; ++m) _Pragma("unroll") for (int k = 0; k < 2; ++k) dst[m][k] = *(const PG8_LAS bf16x8*)(lds + PG8_SA(b, h) + aoff + m * 2048 + k * 1024); } while (0)
#define PG8_LDB(dst, b, h) do { _Pragma("unroll") for (int n = 0; n < 2; ++n) _Pragma("unroll") for (int k = 0; k < 2; ++k) dst[n][k] = *(const PG8_LAS bf16x8*)(lds + PG8_SB(b, h) + boff + n * 2048 + k * 1024); } while (0)
#define PG8_MMA(ai, bj, At, Bt) do { __builtin_amdgcn_s_setprio(1); _Pragma("unroll") for (int m = 0; m < 4; ++m) _Pragma("unroll") for (int n = 0; n < 2; ++n) _Pragma("unroll") for (int k = 0; k < 2; ++k) \
        acc[ai][bj][m][n] = __builtin_amdgcn_mfma_f32_16x16x32_bf16(Bt[n][k], At[m][k], acc[ai][bj][m][n], 0, 0, 0); __builtin_amdgcn_s_setprio(0); } while (0)
#define PG8_WAIT_V(n) asm volatile("s_waitcnt vmcnt(" #n ")" ::: "memory")
#define PG8_WAIT_L(n) asm volatile("s_waitcnt lgkmcnt(" #n ")" ::: "memory")
#define PG8_BAR __builtin_amdgcn_s_barrier()
#define PG8_SCHED __builtin_amdgcn_sched_barrier(0)
#define PG8_GLOAD(GV, u) do { _Pragma("unroll") for (int _i = 0; _i < 2; ++_i) { int _R, _C; stage_rc(tid * 16 + _i * 8192, _R, _C); _Pragma("unroll") for (int _h = 0; _h < 2; ++_h) \
        GV[_h][_i] = (unsigned)g.rows[(u).pm * BM + _h * HALF + _R] * (unsigned)(K * 2) + (unsigned)(_C * 2); } } while (0)
    Unit cur, nxt; int ui = 0;
    if (!S.next(0, cur)) return;
    f32x4 acc[2][2][4][2];
#pragma unroll
    for (int a = 0; a < 2; ++a)
#pragma unroll
        for (int b = 0; b < 2; ++b)
#pragma unroll
            for (int m = 0; m < 4; ++m)
#pragma unroll
                for (int n = 0; n < 2; ++n) acc[a][b][m][n] = (f32x4){0.f, 0.f, 0.f, 0.f};
    bf16x8 At[4][2], B0[2][2], B1[2][2];
    unsigned gcur[2][2] = {{0u, 0u}, {0u, 0u}}, gnxt[2][2] = {{0u, 0u}, {0u, 0u}};
    if constexpr (Epi::NPRE > 0) E.prefetch(cur, 0, lds, wid, lane);
    if constexpr (GATHER) { PG8_GLOAD(gcur, cur); }
    const char* cA = GATHER ? (const char*)g.A : (const char*)g.A + (size_t)cur.pm * tstep;
    const char* cB = (const char*)g.Bt + ((size_t)cur.e * g.bstride) * 2 + (size_t)cur.pn * tstep;
    PG8_STAGE(PG8_SB(0, 0), cB, voffB); PG8_STAGE(PG8_SB(0, 1), cB + hstep, voffB); PG8_STAGE_A(PG8_SA(0, 0), cA, 0, gcur); PG8_STAGE_A(PG8_SA(0, 1), cA, 1, gcur);
    if (wr == 1) PG8_BAR;
    PG8_WAIT_V(2); PG8_BAR;
    PG8_STAGE(PG8_SB(1, 0), cB + kstep, voffB); PG8_STAGE_A(PG8_SA(1, 0), cA + kstep, 0, gcur); PG8_STAGE(PG8_SB(1, 1), cB + hstep + kstep, voffB);
    PG8_WAIT_V(6); PG8_BAR;
    for (;;) {
        const bool has_next = S.next(ui + 1, nxt);
        if constexpr (Epi::NPRE > 0) { if (has_next) E.prefetch(nxt, (ui + 1) % 3, lds, wid, lane); }
        if constexpr (GATHER) { if (has_next) { PG8_GLOAD(gnxt, nxt); } else {
#pragma unroll
            for (int _h = 0; _h < 2; ++_h)
#pragma unroll
                for (int _i = 0; _i < 2; ++_i) gnxt[_h][_i] = gcur[_h][_i]; } }
        const char* nA = GATHER ? cA : (has_next ? (const char*)g.A + (size_t)nxt.pm * tstep : cA);
        const char* nB = has_next ? (const char*)g.Bt + ((size_t)nxt.e * g.bstride) * 2 + (size_t)nxt.pn * tstep : cB;
#pragma unroll 1
        for (int t = 0; t < nt; t += 2) {
            const bool last = (t == nt - 2);
            const char* a1 = cA + (size_t)(t + 1) * kstep;
            const char* a2 = last ? nA : cA + (size_t)(t + 2) * kstep; const char* b2 = last ? nB : cB + (size_t)(t + 2) * kstep;
            const char* a3 = a2 + kstep; const char* b3 = b2 + kstep;
            PG8_LDB(B0, 0, 0); PG8_LDB(B1, 0, 1); PG8_SCHED; PG8_LDA(At, 0, 0); PG8_STAGE_A(PG8_SA(1, 1), a1, 1, gcur);
            PG8_WAIT_V(8); PG8_WAIT_L(0); PG8_BAR; PG8_MMA(0, 0, At, B0); PG8_MMA(0, 1, At, B1); PG8_BAR; PG8_SCHED;
            PG8_LDA(At, 0, 1); PG8_STAGE(PG8_SB(0, 0), b2, voffB); PG8_STAGE(PG8_SB(0, 1), b2 + hstep, voffB); PG8_STAGE_A2(PG8_SA(0, 0), a2, 0);
            PG8_WAIT_V(8); PG8_WAIT_L(0); PG8_BAR; PG8_MMA(1, 0, At, B0); PG8_MMA(1, 1, At, B1); PG8_BAR; PG8_SCHED;
            PG8_LDB(B0, 1, 0); PG8_LDB(B1, 1, 1); PG8_SCHED; PG8_LDA(At, 1, 0); PG8_STAGE_A2(PG8_SA(0, 1), a2, 1);
            PG8_WAIT_V(8); PG8_WAIT_L(0); PG8_BAR; PG8_MMA(0, 0, At, B0); PG8_MMA(0, 1, At, B1); PG8_BAR; PG8_SCHED;
            PG8_LDA(At, 1, 1); PG8_STAGE(PG8_SB(1, 0), b3, voffB); PG8_STAGE(PG8_SB(1, 1), b3 + hstep, voffB); PG8_STAGE_A2(PG8_SA(1, 0), a3, 0);
            PG8_WAIT_V(8); PG8_WAIT_L(0); PG8_BAR; PG8_MMA(1, 0, At, B0); PG8_MMA(1, 1, At, B1); PG8_BAR; PG8_SCHED;
        }
        if constexpr (ALIGN_EPI) { if (wr == 0) PG8_BAR; }
        if constexpr (Epi::NPRE > 0) E(acc, cur, wr, wc, fr, fq, ui % 3, lds); else E(acc, cur, wr, wc, fr, fq);
        if (!has_next) break;
#pragma unroll
        for (int a = 0; a < 2; ++a)
#pragma unroll
            for (int b = 0; b < 2; ++b)
#pragma unroll
                for (int m = 0; m < 4; ++m)
#pragma unroll
                    for (int n = 0; n < 2; ++n) acc[a][b][m][n] = (f32x4){0.f, 0.f, 0.f, 0.f};
        cur = nxt; cA = nA; cB = nB; ++ui;
        if constexpr (GATHER) {
#pragma unroll
            for (int _h = 0; _h < 2; ++_h)
#pragma unroll
                for (int _i = 0; _i < 2; ++_i) gcur[_h][_i] = gnxt[_h][_i]; }
        if constexpr (ALIGN_EPI) { if (wr == 1) PG8_BAR; }
    }
    PG8_WAIT_V(0);
    if constexpr (!ALIGN_EPI) { if (wr == 0) PG8_BAR; }
    PG8_BAR;
#undef PG8_SA
#undef PG8_SB
#undef PG8_STAGE
#undef PG8_STAGE_A
#undef PG8_STAGE_A2
#undef PG8_LDA
#undef PG8_LDB
#undef PG8_MMA
#undef PG8_WAIT_V
#undef PG8_WAIT_L
#undef PG8_BAR
#undef PG8_SCHED
#undef PG8_GLOAD
}
}
typedef unsigned short bf16;
typedef unsigned v4u __attribute__((ext_vector_type(4)));
typedef unsigned v2u __attribute__((ext_vector_type(2)));
typedef float f32x4 __attribute__((ext_vector_type(4)));
constexpr int NTHREADS = 512, NWAVES = 8;
constexpr int LDS_BYTES = 163840;
constexpr int LDS_CTL = 155648;
constexpr int MISC_OFF = LDS_CTL + 320;
constexpr size_t MiB = 1u << 20;
constexpr size_t CTL_BYTES = 1 * MiB;
#if !defined(WITH_NAIVE)
namespace nv { constexpr int B_ = 2, S_ = 8192, T_ = B_ * S_, NCH = S_ / 64, EIN = 3080, OIN = 2064; constexpr float ALPHA = 1.41421356237309515f, EPS = 1e-5f; struct Mem { float* base; size_t off; }; }
#endif
constexpr int T_ = nv::T_, S_ = nv::S_, NCH = nv::NCH;
constexpr int EINP = 3328, OINP = 2304;
#define LDS_WAIT() asm volatile("s_waitcnt lgkmcnt(0)" ::: "memory")
typedef __bf16 hwbf2_t __attribute__((ext_vector_type(2)));
typedef float hwf2_t __attribute__((ext_vector_type(2)));
__device__ __forceinline__ unsigned f2bf(float f) { const __bf16 b = (__bf16)f; return (unsigned)__builtin_bit_cast(unsigned short, b); }
__device__ __forceinline__ unsigned pk2(float lo, float hi) { const hwf2_t v = {lo, hi}; return __builtin_bit_cast(unsigned, __builtin_convertvector(v, hwbf2_t)); }
__device__ __forceinline__ float bf2f(unsigned short b) { return __builtin_bit_cast(float, (unsigned)b << 16); }
__device__ __forceinline__ void tr_item(const float* W, long ldw, int nvalid, bf16* dst, long ldd, LAS float* scr, int lane) {
#pragma unroll 8
    for (int i = 0; i < 32; ++i) { const int kk = 2 * i + (lane >> 5), nn = lane & 31; scr[kk * 33 + nn] = nn < nvalid ? W[(long)kk * ldw + nn] : 0.f; }
    LDS_WAIT(); asm volatile("" ::: "memory");
    const int c = lane & 7;
#pragma unroll
    for (int j = 0; j < 4; ++j) { const int n = (lane >> 3) + 8 * j; const LAS float* s = scr + (8 * c) * 33 + n;
        v4u o; o.x = pk2(s[0 * 33], s[1 * 33]); o.y = pk2(s[2 * 33], s[3 * 33]); o.z = pk2(s[4 * 33], s[5 * 33]); o.w = pk2(s[6 * 33], s[7 * 33]);
        *(v4u*)(dst + (long)n * ldd + 8 * c) = o; }
    LDS_WAIT(); asm volatile("" ::: "memory");
}
__device__ __forceinline__ void tr_item64(const float* W, long ldw, int nvalid, bf16* dst, long ldd, LAS float* scr, int lane) {
    const int nn = (lane & 15) * 4;
#pragma unroll
    for (int i = 0; i < 16; ++i) { const int kk = 4 * i + (lane >> 4);
        f32x4 v = {0.f, 0.f, 0.f, 0.f}; if (nn < nvalid) v = *(const f32x4*)(W + (long)kk * ldw + nn);
        LAS float* s = scr + kk * 65 + nn; s[0] = v.x; s[1] = v.y; s[2] = v.z; s[3] = v.w; }
    LDS_WAIT(); asm volatile("" ::: "memory");
    const int c = lane & 7;
#pragma unroll
    for (int j = 0; j < 8; ++j) { const int n = (lane >> 3) + 8 * j; const LAS float* s = scr + (8 * c) * 65 + n;
        v4u o; o.x = pk2(s[0 * 65], s[1 * 65]); o.y = pk2(s[2 * 65], s[3 * 65]); o.z = pk2(s[4 * 65], s[5 * 65]); o.w = pk2(s[6 * 65], s[7 * 65]);
        *(v4u*)(dst + (long)n * ldd + 8 * c) = o; }
    LDS_WAIT(); asm volatile("" ::: "memory");
}
__device__ __forceinline__ void tr_matrix(const float* W, int K, int N, int NP, bf16* WT, LAS float* scr, int gw, int NGW, int lane) {
    const int nblk = NP / 64, nitems = (K / 64) * nblk;
    for (int it = gw; it < nitems; it += NGW) { const int kb = it / nblk, nb = it % nblk, k0 = 64 * kb, n0 = 64 * nb; int nvalid = N - n0; nvalid = nvalid < 0 ? 0 : (nvalid > 64 ? 64 : nvalid);
        tr_item64(W + (long)k0 * N + n0, N, nvalid, WT + (long)n0 * K + k0, K, scr, lane); }
}
__device__ __forceinline__ void tr_matrix_item(const float* W, int K, int N, int NP, bf16* WT, LAS float* scr, int it, int lane) {
    const int nblk = NP / 64, kb = it / nblk, nb = it % nblk, k0 = 64 * kb, n0 = 64 * nb; int nvalid = N - n0; nvalid = nvalid < 0 ? 0 : (nvalid > 64 ? 64 : nvalid);
    tr_item64(W + (long)k0 * N + n0, N, nvalid, WT + (long)n0 * K + k0, K, scr, lane);
}
__device__ __forceinline__ void cvt_rows(const float* src, bf16* dst, long n, long gtid, long gsz) {
    long i = gtid * 8;
    for (; i + 3 * gsz * 8 < n; i += 4 * gsz * 8) {
        f32x4 a[4], b[4];
#pragma unroll
        for (int u = 0; u < 4; ++u) { a[u] = *(const f32x4*)(src + i + u * gsz * 8); b[u] = *(const f32x4*)(src + i + u * gsz * 8 + 4); }
#pragma unroll
        for (int u = 0; u < 4; ++u) { v4u o; o.x = pk2(a[u].x, a[u].y); o.y = pk2(a[u].z, a[u].w); o.z = pk2(b[u].x, b[u].y); o.w = pk2(b[u].z, b[u].w); *(v4u*)(dst + i + u * gsz * 8) = o; } }
    for (; i < n; i += gsz * 8) { const f32x4 a = *(const f32x4*)(src + i), b = *(const f32x4*)(src + i + 4);
        v4u o; o.x = pk2(a.x, a.y); o.y = pk2(a.z, a.w); o.z = pk2(b.x, b.y); o.w = pk2(b.z, b.w); *(v4u*)(dst + i) = o; }
}
__device__ __forceinline__ int sopaque(int v) { asm volatile("" : "+s"(v)); return v; }
__device__ __forceinline__ float wave_sum(float v) {
#define WS_STEP(o) v += __builtin_bit_cast(float, __builtin_amdgcn_ds_swizzle(__builtin_bit_cast(int, v), 0x1f | ((o) << 10)))
    WS_STEP(1); WS_STEP(2); WS_STEP(4); WS_STEP(8); WS_STEP(16);
#undef WS_STEP
    return __builtin_bit_cast(float, __builtin_amdgcn_readlane(__builtin_bit_cast(int, v), 0)) + __builtin_bit_cast(float, __builtin_amdgcn_readlane(__builtin_bit_cast(int, v), 32));
}
#ifndef DBG_SCALE
#define DBG_SCALE 20.0f
#endif
constexpr int MOE_MAXBLK = 640;
constexpr int CW_CNT = 8192, CW_CUR = 8192 + 128;
namespace pg8 {
struct MoeOrder {
    const int* blk_e; int nblk, npn, G, c;
    __device__ __forceinline__ bool next(int i, Unit& u) const {
        const long L = (long)i * G + c; if (L >= (long)nblk * npn) return false;
        const int blk = (int)(L / npn); u.pm = blk; u.pn = (int)(L % npn); u.e = __builtin_amdgcn_readfirstlane(blk_e[blk]); u.aux = 0; return true;
    }
};
__device__ __forceinline__ float silu_f(float x) { return x * __builtin_amdgcn_rcpf(1.0f + __expf(-x)); }
struct EpiSwiGLU {
    static constexpr int NPRE = 0; __device__ __forceinline__ void load_pre(const Unit&, int, int, int (&)[1]) const {}
    static constexpr bool PERM = true;
    bf16_t* H;
    __device__ __forceinline__ void operator()(const f32x4 (&acc)[2][2][4][2], const Unit& u, int wr, int wc, int fr, int fq) const {
        const int row0 = u.pm * BM + wr * 64 + fr, col0 = u.pn * 128 + wc * 32 + 8 * fq;
#pragma unroll
        for (int ai = 0; ai < 2; ++ai)
#pragma unroll
            for (int m = 0; m < 4; ++m) { bf16_t* rowp = H + (size_t)(row0 + ai * HALF + m * 16) * 256 + col0;
                const f32x4 g0 = acc[ai][0][m][0], g1 = acc[ai][0][m][1], u0 = acc[ai][1][m][0], u1 = acc[ai][1][m][1];
                u32x4 w; w.x = cvt_pk_bf16(silu_f(g0[0]) * u0[0], silu_f(g0[1]) * u0[1]); w.y = cvt_pk_bf16(silu_f(g0[2]) * u0[2], silu_f(g0[3]) * u0[3]);
                w.z = cvt_pk_bf16(silu_f(g1[0]) * u1[0], silu_f(g1[1]) * u1[1]); w.w = cvt_pk_bf16(silu_f(g1[2]) * u1[2], silu_f(g1[3]) * u1[3]);
                *(u32x4*)rowp = w; }
    }
};
struct EpiDown {
    static constexpr bool PERM = true; static constexpr int NPRE = 1;
    bf16_t* rows8; bf16_t* rows_sh; const int* dest; int nslot8;
    __device__ __forceinline__ void prefetch(const Unit& u, int slot, PG8_LAS unsigned char* lds, int wid, int lane) const {
        if (wid < 4) __builtin_amdgcn_global_load_lds((const unsigned*)(dest + u.pm * BM + wid * 64 + lane), (PG8_LAS unsigned*)(lds + STAGE_BYTES + slot * 1024 + wid * 256), 4, 0, 0);
    }
    __device__ __forceinline__ void operator()(const f32x4 (&acc)[2][2][4][2], const Unit& u, int wr, int wc, int fr, int fq, int slot, PG8_LAS unsigned char* lds) const {
        const int col0 = u.pn * BM + wc * 32 + 8 * fq; const PG8_LAS int* dl = (const PG8_LAS int*)(lds + STAGE_BYTES + slot * 1024) + wr * 64 + fr;
#pragma unroll
        for (int ai = 0; ai < 2; ++ai)
#pragma unroll
            for (int m = 0; m < 4; ++m) { const int d = dl[ai * HALF + m * 16];
                if (d >= 0) { bf16_t* rowp = (d < nslot8 ? rows8 + (size_t)d * 1024 : rows_sh + (size_t)(d - nslot8) * 1024) + col0;
#pragma unroll
                    for (int bj = 0; bj < 2; ++bj) { const f32x4 v0 = acc[ai][bj][m][0], v1 = acc[ai][bj][m][1];
                        u32x4 o; o.x = cvt_pk_bf16(v0[0], v0[1]); o.y = cvt_pk_bf16(v0[2], v0[3]); o.z = cvt_pk_bf16(v1[0], v1[1]); o.w = cvt_pk_bf16(v1[2], v1[3]);
#if defined(NT_STORES)
                        __builtin_nontemporal_store(o, (u32x4*)(rowp + bj * HALF));
#else
                        *(u32x4*)(rowp + bj * HALF) = o;
#endif
                        } } }
    }
};
}
__device__ __forceinline__ void moe_convert_weights(const float* wg, const float* wu, const float* wd, const float* sg, const float* su, const float* sd,
                                                    bf16* WGU, bf16* WD, LAS float* scr, int first, int last, int stride, int lane) {
    for (int it = first; it < last; it += stride) {
        const int e = it / 192, r = it % 192, kind = r >> 6, q = r & 63;
        if (kind < 2) { const float* W = (e < 64 ? (kind == 0 ? wg : wu) + (size_t)e * 262144 : (kind == 0 ? sg : su));
            const int kb = q >> 2, nb = q & 3, k0 = 64 * kb, n0 = 64 * nb;
            tr_item64(W + (size_t)k0 * 256 + n0, 256, 64, WGU + ((size_t)e * 512 + (n0 >> 7) * 256 + (n0 & 127) + kind * 128) * 1024 + k0, 1024, scr, lane);
        } else { const float* W = e < 64 ? wd + (size_t)e * 262144 : sd;
            const int kb = q >> 4, nb = q & 15, k0 = 64 * kb, n0 = 64 * nb;
            tr_item64(W + (size_t)k0 * 1024 + n0, 1024, 64, WD + ((size_t)e * 1024 + n0) * 256 + k0, 256, scr, lane); }
    }
}
struct MoeLists { int* tok; int* dest; float* w; int* blk_e; };
__device__ __forceinline__ void moe_count(const int* ridx, unsigned* cnt, LAS unsigned* hist, int tid, int bid, int G) {
    if (tid < 64) hist[tid] = 0u;
    __syncthreads();
    for (int i = bid * NTHREADS + tid; i < T_ * 8; i += G * NTHREADS) atomicAdd((unsigned*)&hist[ridx[i]], 1u);
    __syncthreads();
    if (tid < 64 && hist[tid]) atomicAdd(&cnt[tid], hist[tid]);
    __syncthreads();
}
__device__ __forceinline__ void moe_build_lists(const int* ridx, const float* rwt, const unsigned* cnt, unsigned* cur, const MoeLists L, LAS int* sm, int tid, int bid, int G) {
    LAS int* pstart = sm; LAS unsigned* hist = (LAS unsigned*)(sm + 80); LAS unsigned* base = (LAS unsigned*)(sm + 160);
    if (tid == 0) { int acc = 0;
#pragma unroll 1
        for (int e = 0; e < 64; ++e) { pstart[e] = acc; acc += ((int)__hip_atomic_load(&cnt[e], __ATOMIC_RELAXED, __HIP_MEMORY_SCOPE_AGENT) + 255) & ~255; } pstart[64] = acc; pstart[65] = acc + T_; }
    __syncthreads();
    const int per = (T_ * 8 + G - 1) / G;
    const int lo = bid * per, hi = (lo + per < T_ * 8) ? lo + per : T_ * 8;
    for (int c0 = lo; c0 < hi; c0 += NTHREADS) {
        if (tid < 64) hist[tid] = 0u;
        __syncthreads();
        const int i = c0 + tid; int e = 0; unsigned local = 0u;
        if (i < hi) { e = ridx[i]; local = atomicAdd((unsigned*)&hist[e], 1u); }
        __syncthreads();
        if (tid < 64) base[tid] = hist[tid] ? atomicAdd(&cur[tid], hist[tid]) : 0u;
        __syncthreads();
        if (i < hi) { const int pos = pstart[e] + (int)base[e] + (int)local; L.tok[pos] = i >> 3; L.dest[pos] = i; L.w[pos] = rwt[i]; }
        __syncthreads();
    }
    for (int e = bid; e < 64; e += G) { const int c = (int)__hip_atomic_load(&cnt[e], __ATOMIC_RELAXED, __HIP_MEMORY_SCOPE_AGENT);
        for (int p = pstart[e] + c + tid; p < pstart[e + 1]; p += NTHREADS) { L.tok[p] = 0; L.dest[p] = -1; L.w[p] = 0.f; } }
    for (int t = bid * NTHREADS + tid; t < T_; t += G * NTHREADS) { const int p = pstart[64] + t; L.tok[p] = t; L.dest[p] = T_ * 8 + t; L.w[p] = 1.f; }
    const int nblk = pstart[65] >> 8;
    for (int b = bid * NTHREADS + tid; b < nblk; b += G * NTHREADS) { int e = 0;
#pragma unroll 1
        while (e < 64 && (pstart[e + 1] >> 8) <= b) ++e;
        L.blk_e[b] = e; }
    if (bid == 0 && tid == 0) L.blk_e[MOE_MAXBLK] = nblk;
    __syncthreads();
}
__device__ __forceinline__ void moe_combine_ln(float* h, const bf16* rows8, const bf16* rows_sh, const float* rwt, const float* lw, const float* lb, bf16* hbf, int gw, int NGW, int lane) {
    int t = gw; if (t >= T_) return;
    v4u rr[2][9]; f32x4 hh[4]; float wk[8];
#define CB_LOAD(tt) do { const size_t _t = (size_t)(tt); \
        _Pragma("unroll") for (int half = 0; half < 2; ++half) { const int c0 = half * 512 + lane * 8; \
            hh[half * 2] = *(const f32x4*)(h + _t * 1024 + c0); hh[half * 2 + 1] = *(const f32x4*)(h + _t * 1024 + c0 + 4); \
            _Pragma("unroll") for (int k = 0; k < 9; ++k) rr[half][k] = *(const v4u*)((k < 8 ? rows8 + (_t * 8 + k) * 1024 : rows_sh + _t * 1024) + c0); } \
        _Pragma("unroll") for (int k = 0; k < 8; ++k) wk[k] = rwt[_t * 8 + k]; } while (0)
    CB_LOAD(t);
    for (; t < T_; t += NGW) {
        float v[16];
#pragma unroll
        for (int half = 0; half < 2; ++half) { const f32x4 a = hh[half * 2], b = hh[half * 2 + 1];
            float s[8] = {a.x * nv::ALPHA, a.y * nv::ALPHA, a.z * nv::ALPHA, a.w * nv::ALPHA, b.x * nv::ALPHA, b.y * nv::ALPHA, b.z * nv::ALPHA, b.w * nv::ALPHA};
#pragma unroll
            for (int k = 0; k < 9; ++k) { const v4u r = rr[half][k]; const float w = k < 8 ? wk[k] : 1.0f;
                s[0] += w * __builtin_bit_cast(float, r.x << 16); s[1] += w * __builtin_bit_cast(float, r.x & 0xffff0000u);
                s[2] += w * __builtin_bit_cast(float, r.y << 16); s[3] += w * __builtin_bit_cast(float, r.y & 0xffff0000u);
                s[4] += w * __builtin_bit_cast(float, r.z << 16); s[5] += w * __builtin_bit_cast(float, r.z & 0xffff0000u);
                s[6] += w * __builtin_bit_cast(float, r.w << 16); s[7] += w * __builtin_bit_cast(float, r.w & 0xffff0000u); }
#pragma unroll
            for (int j = 0; j < 8; ++j) v[half * 8 + j] = s[j]; }
        if (t + NGW < T_) CB_LOAD(t + NGW);
        float sum = 0.f;
#pragma unroll
        for (int j = 0; j < 16; ++j) sum += v[j];
        sum = wave_sum(sum);
        const float mean = sum * (1.f / 1024.f);
        float sq = 0.f;
#pragma unroll
        for (int j = 0; j < 16; ++j) { v[j] -= mean; sq += v[j] * v[j]; }
        sq = wave_sum(sq);
        const float rstd = 1.0f / sqrtf(sq * (1.f / 1024.f) + nv::EPS);
#pragma unroll
        for (int half = 0; half < 2; ++half) { const int c0 = half * 512 + lane * 8;
            const f32x4 w0 = *(const f32x4*)(lw + c0), w1 = *(const f32x4*)(lw + c0 + 4), b0 = *(const f32x4*)(lb + c0), b1 = *(const f32x4*)(lb + c0 + 4);
            f32x4 o0, o1;
            o0.x = v[half * 8 + 0] * rstd * w0.x + b0.x; o0.y = v[half * 8 + 1] * rstd * w0.y + b0.y; o0.z = v[half * 8 + 2] * rstd * w0.z + b0.z; o0.w = v[half * 8 + 3] * rstd * w0.w + b0.w;
            o1.x = v[half * 8 + 4] * rstd * w1.x + b1.x; o1.y = v[half * 8 + 5] * rstd * w1.y + b1.y; o1.z = v[half * 8 + 6] * rstd * w1.z + b1.z; o1.w = v[half * 8 + 7] * rstd * w1.w + b1.w;
            *(f32x4*)(h + (size_t)t * 1024 + c0) = o0; *(f32x4*)(h + (size_t)t * 1024 + c0 + 4) = o1;
            if (hbf) { v4u p; p.x = pk2(o0.x, o0.y); p.y = pk2(o0.z, o0.w); p.z = pk2(o1.x, o1.y); p.w = pk2(o1.z, o1.w); *(v4u*)(hbf + (size_t)t * 1024 + c0) = p; } }
    }
#undef CB_LOAD
}
typedef float f32x16 __attribute__((ext_vector_type(16)));
typedef short s16x8 __attribute__((ext_vector_type(8)));
typedef LAS unsigned short lbf16;
__device__ __forceinline__ void mm32(f32x16& acc, const lbf16* A, int lda, const lbf16* B, int ldb, int K, int lane) {
    const lbf16* ap = A + (lane & 31) * lda + 8 * (lane >> 5);
    const lbf16* bp = B + (lane & 31) * ldb + 8 * (lane >> 5);
#pragma unroll 4
    for (int k = 0; k < K; k += 16) {
        const s16x8 a = *(const LAS s16x8*)(ap + k), b = *(const LAS s16x8*)(bp + k);
        acc = __builtin_amdgcn_mfma_f32_32x32x16_bf16(a, b, acc, 0, 0, 0);
    }
}
__device__ __forceinline__ void mm32_gb(f32x16& acc, const lbf16* A, int lda, const bf16* B, int ldb, int K, int lane) {
    const lbf16* ap = A + (lane & 31) * lda + 8 * (lane >> 5);
    const bf16* bp = B + (size_t)(lane & 31) * ldb + 8 * (lane >> 5);
#pragma unroll 4
    for (int k = 0; k < K; k += 16) {
        const s16x8 a = *(const LAS s16x8*)(ap + k), b = *(const s16x8*)(bp + k);
        acc = __builtin_amdgcn_mfma_f32_32x32x16_bf16(a, b, acc, 0, 0, 0);
    }
}
__device__ __forceinline__ int rowmap(int r, int lane) { return (r & 3) + 8 * (r >> 2) + 4 * (lane >> 5); }
__device__ __forceinline__ float rcp_f(float x) { return __builtin_amdgcn_rcpf(x); }
__device__ __forceinline__ float sigm_f(float x) { return rcp_f(1.0f + __expf(-x)); }
__device__ __forceinline__ float logsig_f(float x) { return fminf(x, 0.f) - __logf(1.0f + __expf(-fabsf(x))); }
__device__ __forceinline__ float softplus_f(float x) { return fmaxf(x, 0.f) + __logf(1.0f + __expf(-fabsf(x))); }
__device__ __forceinline__ float gelu_f(float x) { const float u = 0.7978845608028654f * (x + 0.044715f * x * x * x); return x * rcp_f(1.0f + __expf(-2.0f * u)); }
__device__ __forceinline__ void unpack8(const v4u r, float (&f)[8]) {
    f[0] = __builtin_bit_cast(float, r.x << 16); f[1] = __builtin_bit_cast(float, r.x & 0xffff0000u); f[2] = __builtin_bit_cast(float, r.y << 16); f[3] = __builtin_bit_cast(float, r.y & 0xffff0000u);
    f[4] = __builtin_bit_cast(float, r.z << 16); f[5] = __builtin_bit_cast(float, r.z & 0xffff0000u); f[6] = __builtin_bit_cast(float, r.w << 16); f[7] = __builtin_bit_cast(float, r.w & 0xffff0000u);
}
__device__ __forceinline__ v4u pack8(const float (&f)[8]) { v4u o; o.x = pk2(f[0], f[1]); o.y = pk2(f[2], f[3]); o.z = pk2(f[4], f[5]); o.w = pk2(f[6], f[7]); return o; }

struct Mix0Bufs { const bf16* proj; bf16* ct; float* nloc; float* blast; float* mloc; float* mprev; bf16* hloc; bf16* pc; float* carA; float* carU; float* carI; float* gst; bf16* mixbf; const bf16* lruw; };
constexpr int PJ0 = EINP;
__device__ __forceinline__ float lane_shr(float v, int o, int lane) { return __builtin_bit_cast(float, __builtin_amdgcn_ds_bpermute(((lane - o) & 63) << 2, __builtin_bit_cast(int, v))); }
__device__ __forceinline__ float wave_scan_add(float v, int lane) {
#pragma unroll
    for (int o = 1; o < 64; o <<= 1) { const float t = lane_shr(v, o, lane); v += (lane >= o) ? t : 0.f; }
    return v; }
__device__ __forceinline__ float wave_scan_max(float v, int lane) {
#pragma unroll
    for (int o = 1; o < 64; o <<= 1) { const float t = lane_shr(v, o, lane); v = (lane >= o) ? fmaxf(v, t) : v; }
    return v; }

__device__ __forceinline__ void mlstm_a_item(const Mix0Bufs& B, const float* gate_b, int cn, LAS unsigned char* lds, int tid) {
    const int lane = tid & 63, wave = __builtin_amdgcn_readfirstlane(tid >> 6);
    const int bh = cn / NCH, n = cn % NCH, b = bh >> 2, h = bh & 3;
    const size_t t0 = (size_t)b * S_ + n * 64;
    LAS float* pw = (LAS float*)lds;
    lbf16* kT = (lbf16*)(lds + 1024); lbf16* vT = (lbf16*)(lds + 1024 + 128 * 72 * 2);
    v4u gk[2], gv[2];
#pragma unroll
    for (int it = 0; it < 2; ++it) { const int vi = tid + it * 512, l = vi & 63, g = vi >> 6; const bf16* pr = B.proj + (t0 + l) * PJ0 + h * 128 + g * 8; gk[it] = *(const v4u*)(pr + 512); gv[it] = *(const v4u*)(pr + 1024); }
    if (wave == 0) { const bf16* pr = B.proj + (t0 + lane) * PJ0;
        const float lfv = logsig_f(bf2f(pr[2052 + h]) + gate_b[4 + h]), ig = bf2f(pr[2048 + h]) + gate_b[h];
        const float bcv = wave_scan_add(lfv, lane), wlv = ig - bcv, pmv = wave_scan_max(wlv, lane);
        const float blast = __builtin_bit_cast(float, __builtin_amdgcn_readlane(__builtin_bit_cast(int, bcv), 63)), mx = __builtin_bit_cast(float, __builtin_amdgcn_readlane(__builtin_bit_cast(int, pmv), 63));
        pw[lane] = __expf(wlv - mx) * 0.08838834764831845f;
        float* gs = B.gst + (size_t)cn * 192; gs[lane] = bcv; gs[64 + lane] = wlv; gs[128 + lane] = pmv;
        if (lane == 0) { B.blast[cn] = blast; B.mloc[cn] = blast + mx; } }
    __syncthreads();
#pragma unroll
    for (int it = 0; it < 2; ++it) { const int vi = tid + it * 512, l = vi & 63, g = vi >> 6;
        float kf[8], vf[8]; unpack8(gk[it], kf); unpack8(gv[it], vf);
        const float p = pw[l];
#pragma unroll
        for (int j = 0; j < 8; ++j) { kT[(g * 8 + j) * 72 + l] = (unsigned short)f2bf(kf[j] * p); vT[(g * 8 + j) * 72 + l] = (unsigned short)f2bf(vf[j]); } }
    __syncthreads();
    const int et = wave >> 1;
#pragma unroll
    for (int q = 0; q < 2; ++q) { const int dt = (wave & 1) * 2 + q;
        f32x16 acc = {0.f, 0.f, 0.f, 0.f, 0.f, 0.f, 0.f, 0.f, 0.f, 0.f, 0.f, 0.f, 0.f, 0.f, 0.f, 0.f};
        mm32(acc, kT + dt * 32 * 72, 72, vT + et * 32 * 72, 72, 64, lane);
        bf16* out = B.ct + (size_t)cn * 16384 + (et * 4 + dt) * 1024 + lane * 16;
        v4u o0, o1; o0.x = pk2(acc[0], acc[1]); o0.y = pk2(acc[2], acc[3]); o0.z = pk2(acc[4], acc[5]); o0.w = pk2(acc[6], acc[7]);
        o1.x = pk2(acc[8], acc[9]); o1.y = pk2(acc[10], acc[11]); o1.z = pk2(acc[12], acc[13]); o1.w = pk2(acc[14], acc[15]);
        *(v4u*)out = o0; *(v4u*)(out + 8) = o1; }
    { const int d = tid >> 2, qq = tid & 3; float f0[8], f1[8]; unpack8(*(const LAS v4u*)(kT + d * 72 + qq * 16), f0); unpack8(*(const LAS v4u*)(kT + d * 72 + qq * 16 + 8), f1);
      float sacc = 0.f;
#pragma unroll
      for (int j = 0; j < 8; ++j) sacc += f0[j] + f1[j];
      sacc += __builtin_bit_cast(float, __builtin_amdgcn_ds_swizzle(__builtin_bit_cast(int, sacc), 0x1f | (1 << 10)));
      sacc += __builtin_bit_cast(float, __builtin_amdgcn_ds_swizzle(__builtin_bit_cast(int, sacc), 0x1f | (2 << 10)));
      if (qq == 0) B.nloc[(size_t)cn * 128 + d] = sacc; }
    __syncthreads();
}
__device__ __forceinline__ void mlstm_b(const Mix0Bufs& B, int gtid, int gsz) {
    for (int idx = gtid; idx < 8 * 8192 + 8 * 128; idx += gsz) {
        const bool isn = idx >= 8 * 8192;
        if (!isn) { const int bh = idx >> 13, pe = idx & 8191;
            float s0 = 0.f, s1 = 0.f, m = 0.f; unsigned* p = (unsigned*)B.ct + (size_t)bh * NCH * 8192 + pe;
            for (int n0 = 0; n0 < NCH; n0 += 16) { unsigned cl[16]; float bl[16], ml[16];
#pragma unroll
                for (int j = 0; j < 16; ++j) { cl[j] = p[(size_t)(n0 + j) * 8192]; bl[j] = B.blast[bh * NCH + n0 + j]; ml[j] = B.mloc[bh * NCH + n0 + j]; }
#pragma unroll
                for (int j = 0; j < 16; ++j) { const unsigned out = pk2(s0, s1); const float mn = fmaxf(bl[j] + m, ml[j]), kf = __expf(bl[j] + m - mn), af = __expf(ml[j] - mn);
                    s0 = kf * s0 + af * __builtin_bit_cast(float, cl[j] << 16); s1 = kf * s1 + af * __builtin_bit_cast(float, cl[j] & 0xffff0000u);
                    if (pe == 0) B.mprev[bh * NCH + n0 + j] = m;
                    m = mn; cl[j] = out; }
#pragma unroll
                for (int j = 0; j < 16; ++j) p[(size_t)(n0 + j) * 8192] = cl[j]; }
        } else { const int r = idx - 8 * 8192, bh = r >> 7, de = r & 127;
            float st = 0.f, m = 0.f; float* p = B.nloc + (size_t)bh * NCH * 128 + de;
            for (int n0 = 0; n0 < NCH; n0 += 16) { float cl[16], bl[16], ml[16];
#pragma unroll
                for (int j = 0; j < 16; ++j) { cl[j] = p[(size_t)(n0 + j) * 128]; bl[j] = B.blast[bh * NCH + n0 + j]; ml[j] = B.mloc[bh * NCH + n0 + j]; }
#pragma unroll
                for (int j = 0; j < 16; ++j) { const float out = st; const float mn = fmaxf(bl[j] + m, ml[j]);
                    st = __expf(bl[j] + m - mn) * st + __expf(ml[j] - mn) * cl[j]; m = mn; cl[j] = out; }
#pragma unroll
                for (int j = 0; j < 16; ++j) p[(size_t)(n0 + j) * 128] = cl[j]; } }
    }
}
__device__ __forceinline__ void mlstm_c_item(const Mix0Bufs& B, const float* gate_b, const float* norm_w, int cn, LAS unsigned char* lds, int tid) {
    const int lane = tid & 63, wave = __builtin_amdgcn_readfirstlane(tid >> 6);
    const int bh = cn / NCH, n = cn % NCH, b = bh >> 2, h = bh & 3;
    const size_t t0 = (size_t)b * S_ + n * 64;
    LAS float* bm = (LAS float*)lds; LAS float* wl = bm + 64; LAS float* den = bm + 256; LAS float* emi = bm + 320;
    lbf16* qs = (lbf16*)(lds + 2048); lbf16* ks = (lbf16*)(lds + 19456); lbf16* qw = (lbf16*)(lds + 36864);
    lbf16* vT = (lbf16*)(lds + 54272); lbf16* cT = (lbf16*)(lds + 77312); lbf16* sm = (lbf16*)(lds + 120832);
    LAS float* hb = (LAS float*)(lds + 2048);
    const float mprev = B.mprev[cn];
    const float* gs = B.gst + (size_t)cn * 192;
    v4u gq[2], gk[2], gv[2], go[2], gc[4]; float sb[2], sp[2];
#pragma unroll
    for (int it = 0; it < 2; ++it) { const int vi = tid + it * 512; { const int l = vi >> 4, g = vi & 15; const bf16* pr = B.proj + (t0 + l) * PJ0 + h * 128 + g * 8; gq[it] = *(const v4u*)pr; gk[it] = *(const v4u*)(pr + 512); sb[it] = gs[l]; sp[it] = gs[128 + l]; }
        { const int l = vi & 63, g = vi >> 6; gv[it] = *(const v4u*)(B.proj + (t0 + l) * PJ0 + 1024 + h * 128 + g * 8); } }
    { const bf16* cg = B.ct + (size_t)cn * 16384;
#pragma unroll
      for (int it = 0; it < 4; ++it) gc[it] = *(const v4u*)(cg + (tid + it * 512) * 8); }
    { const int i = tid >> 3, sub = tid & 7; const bf16* op = B.proj + (t0 + i) * PJ0 + 1536 + h * 128 + sub * 16; go[0] = *(const v4u*)op; go[1] = *(const v4u*)(op + 8); }
    const float gnl = tid < 128 ? B.nloc[(size_t)cn * 128 + tid] : 0.f;
    if (wave == 0) { const float bi = gs[lane], wv = gs[64 + lane], pm = gs[128 + lane]; const float m = bi + fmaxf(mprev, pm);
        bm[lane] = bi - m; wl[lane] = wv; emi[lane] = __expf(-m); vT[128 * 72 + lane] = (unsigned short)0x3f80; }
#pragma unroll
    for (int it = 0; it < 2; ++it) { const int vi = tid + it * 512, l = vi >> 4, g = vi & 15;
        float qf[8], kf[8]; unpack8(gq[it], qf); unpack8(gk[it], kf);
        const float w = __expf(mprev - fmaxf(mprev, sp[it])); float qwf[8];
#pragma unroll
        for (int j = 0; j < 8; ++j) { kf[j] *= 0.08838834764831845f; qwf[j] = qf[j] * w; }
        *(LAS v4u*)(qs + l * 136 + g * 8) = gq[it]; *(LAS v4u*)(ks + l * 136 + g * 8) = pack8(kf); *(LAS v4u*)(qw + l * 136 + g * 8) = pack8(qwf); }
#pragma unroll
    for (int it = 0; it < 2; ++it) { const int vi = tid + it * 512, l = vi & 63, g = vi >> 6;
        float vf[8]; unpack8(gv[it], vf);
#pragma unroll
        for (int j = 0; j < 8; ++j) vT[(g * 8 + j) * 72 + l] = (unsigned short)f2bf(vf[j]); }
#pragma unroll
    for (int it = 0; it < 4; ++it) { const int vi = tid + it * 512, T = vi >> 7, ln = (vi >> 1) & 63, hr = vi & 1; const v4u x = gc[it];
        LAS unsigned char* dp = (LAS unsigned char*)(cT + ((T >> 2) * 32 + (ln & 31)) * 136 + (T & 3) * 32 + 16 * hr + 4 * (ln >> 5));
        *(LAS v2u*)dp = (v2u){x.x, x.y}; *(LAS v2u*)(dp + 16) = (v2u){x.z, x.w}; }
    if (tid < 128) cT[128 * 136 + tid] = (unsigned short)f2bf(gnl);
    __syncthreads();
    if (wave < 4) { const int it = wave >> 1, jt = wave & 1;
        f32x16 acc = {0.f, 0.f, 0.f, 0.f, 0.f, 0.f, 0.f, 0.f, 0.f, 0.f, 0.f, 0.f, 0.f, 0.f, 0.f, 0.f};
        if (jt <= it) mm32(acc, ks + jt * 32 * 136, 136, qs + it * 32 * 136, 136, 128, lane);
        const int i = it * 32 + (lane & 31); const float bmi = bm[i];
#pragma unroll
        for (int g4 = 0; g4 < 4; ++g4) { const int j0 = jt * 32 + 8 * g4 + 4 * (lane >> 5); const f32x4 w4 = *(const LAS f32x4*)(wl + j0);
            const float v0 = j0 <= i ? acc[g4 * 4] * __expf(bmi + w4.x) : 0.f, v1 = j0 + 1 <= i ? acc[g4 * 4 + 1] * __expf(bmi + w4.y) : 0.f;
            const float v2 = j0 + 2 <= i ? acc[g4 * 4 + 2] * __expf(bmi + w4.z) : 0.f, v3 = j0 + 3 <= i ? acc[g4 * 4 + 3] * __expf(bmi + w4.w) : 0.f;
            *(LAS v2u*)(sm + i * 72 + j0) = (v2u){pk2(v0, v1), pk2(v2, v3)}; } }
    __syncthreads();
    f32x16 accA = {0.f, 0.f, 0.f, 0.f, 0.f, 0.f, 0.f, 0.f, 0.f, 0.f, 0.f, 0.f, 0.f, 0.f, 0.f, 0.f}, accB = accA;
    { const int id = wave, it = id / 5, nt = id % 5;
      mm32(accA, vT + nt * 32 * 72, 72, sm + it * 32 * 72, 72, 64, lane); mm32(accA, cT + nt * 32 * 136, 136, qw + it * 32 * 136, 136, 128, lane);
      if (nt == 4 && lane < 32) den[it * 32 + lane] = accA[0]; }
    if (wave < 2) { const int id = wave + 8, it = id / 5, nt = id % 5;
      mm32(accB, vT + nt * 32 * 72, 72, sm + it * 32 * 72, 72, 64, lane); mm32(accB, cT + nt * 32 * 136, 136, qw + it * 32 * 136, 136, 128, lane);
      if (nt == 4 && lane < 32) den[it * 32 + lane] = accB[0]; }
    __syncthreads();
    { const int id = wave, it = id / 5, nt = id % 5;
      if (nt < 4) { const int i = it * 32 + (lane & 31); const float rd = rcp_f(fmaxf(fabsf(den[i]), emi[i]));
#pragma unroll
          for (int g4 = 0; g4 < 4; ++g4) *(LAS f32x4*)(hb + i * 132 + nt * 32 + 8 * g4 + 4 * (lane >> 5)) = (f32x4){accA[g4 * 4] * rd, accA[g4 * 4 + 1] * rd, accA[g4 * 4 + 2] * rd, accA[g4 * 4 + 3] * rd}; } }
    if (wave < 2) { const int id = wave + 8, it = id / 5, nt = id % 5;
      if (nt < 4) { const int i = it * 32 + (lane & 31); const float rd = rcp_f(fmaxf(fabsf(den[i]), emi[i]));
#pragma unroll
          for (int g4 = 0; g4 < 4; ++g4) *(LAS f32x4*)(hb + i * 132 + nt * 32 + 8 * g4 + 4 * (lane >> 5)) = (f32x4){accB[g4 * 4] * rd, accB[g4 * 4 + 1] * rd, accB[g4 * 4 + 2] * rd, accB[g4 * 4 + 3] * rd}; } }
    __syncthreads();
    { const int i = tid >> 3, sub = tid & 7; const LAS float* hr = hb + i * 132 + sub * 16;
      float x[16]; float s = 0.f;
#pragma unroll
      for (int j = 0; j < 16; ++j) { x[j] = hr[j]; s += x[j]; }
      s += __builtin_bit_cast(float, __builtin_amdgcn_ds_swizzle(__builtin_bit_cast(int, s), 0x1f | (1 << 10)));
      s += __builtin_bit_cast(float, __builtin_amdgcn_ds_swizzle(__builtin_bit_cast(int, s), 0x1f | (2 << 10)));
      s += __builtin_bit_cast(float, __builtin_amdgcn_ds_swizzle(__builtin_bit_cast(int, s), 0x1f | (4 << 10)));
      const float mean = s * (1.f / 128.f); float q = 0.f;
#pragma unroll
      for (int j = 0; j < 16; ++j) { x[j] -= mean; q += x[j] * x[j]; }
      q += __builtin_bit_cast(float, __builtin_amdgcn_ds_swizzle(__builtin_bit_cast(int, q), 0x1f | (1 << 10)));
      q += __builtin_bit_cast(float, __builtin_amdgcn_ds_swizzle(__builtin_bit_cast(int, q), 0x1f | (2 << 10)));
      q += __builtin_bit_cast(float, __builtin_amdgcn_ds_swizzle(__builtin_bit_cast(int, q), 0x1f | (4 << 10)));
      const float rstd = __builtin_amdgcn_rsqf(q * (1.f / 128.f) + nv::EPS);
      const float* nw = norm_w + h * 128 + sub * 16;
      float o0[8], o1[8]; unpack8(go[0], o0); unpack8(go[1], o1);
      float y0[8], y1[8];
#pragma unroll
      for (int j = 0; j < 8; ++j) { y0[j] = x[j] * rstd * nw[j] * sigm_f(o0[j]); y1[j] = x[8 + j] * rstd * nw[8 + j] * sigm_f(o1[j]); }
      bf16* dst = B.mixbf + (t0 + i) * 1024 + h * 128 + sub * 16;
      *(v4u*)dst = pack8(y0); *(v4u*)(dst + 8) = pack8(y1); }
    __syncthreads();
}
__device__ __forceinline__ void lru_a_item(const Mix0Bufs& B, const float* const* in, int ch, LAS unsigned char* lds, int tid) {
    const int lane = tid & 63, wave = __builtin_amdgcn_readfirstlane(tid >> 6);
    const size_t t0 = (size_t)ch * 64; const int s0 = (ch % NCH) * 64;
    lbf16* xc = (lbf16*)lds; LAS float* al = (LAS float*)(lds + 17408); LAS float* ul = (LAS float*)(lds + 17408 + 32768); LAS float* seg = (LAS float*)(lds + 17408 + 65536);
    const float* cw = in[9]; const float* cb = in[10]; const float* ba = in[12]; const float* bx = in[14]; const float* lam = in[15];
    for (int hh = 0; hh < 4; ++hh) {
        const int it = wave & 1, nt = wave >> 1;
        s16x8 wr[8], wx[8];
        { const bf16* bp = B.lruw + (size_t)(hh * 128 + nt * 32 + (lane & 31)) * 128 + 8 * (lane >> 5);
#pragma unroll
          for (int k = 0; k < 8; ++k) { wr[k] = *(const s16x8*)(bp + k * 16); wx[k] = *(const s16x8*)(bp + (size_t)512 * 128 + k * 16); } }
        { const int g = tid & 15, lr = tid >> 4, c0 = hh * 128 + g * 8;
          float xf[5][8];
#pragma unroll
          for (int k = 0; k < 5; ++k) { const int l = 2 * lr - 3 + k; v4u x = {0u, 0u, 0u, 0u}; if (s0 + l >= 0) x = *(const v4u*)(B.proj + (t0 + l) * PJ0 + 2056 + c0); unpack8(x, xf[k]); }
          float a0[8], a1[8];
#pragma unroll
          for (int j = 0; j < 8; ++j) { a0[j] = cb[c0 + j]; a1[j] = a0[j]; }
#pragma unroll
          for (int tap = 0; tap < 4; ++tap) {
#pragma unroll
              for (int j = 0; j < 8; ++j) { const float w = cw[tap * 512 + c0 + j]; a0[j] += w * xf[tap][j]; a1[j] += w * xf[tap + 1][j]; } }
          *(LAS v4u*)(xc + (2 * lr) * 136 + g * 8) = pack8(a0); *(LAS v4u*)(xc + (2 * lr + 1) * 136 + g * 8) = pack8(a1);
          *(LAS f32x4*)(ul + (2 * lr) * 128 + g * 8) = (f32x4){a0[0], a0[1], a0[2], a0[3]}; *(LAS f32x4*)(ul + (2 * lr) * 128 + g * 8 + 4) = (f32x4){a0[4], a0[5], a0[6], a0[7]};
          *(LAS f32x4*)(ul + (2 * lr + 1) * 128 + g * 8) = (f32x4){a1[0], a1[1], a1[2], a1[3]}; *(LAS f32x4*)(ul + (2 * lr + 1) * 128 + g * 8 + 4) = (f32x4){a1[4], a1[5], a1[6], a1[7]}; }
        __syncthreads();
        { f32x16 ra = {0.f, 0.f, 0.f, 0.f, 0.f, 0.f, 0.f, 0.f, 0.f, 0.f, 0.f, 0.f, 0.f, 0.f, 0.f, 0.f}, xa = ra;
          const lbf16* ap = xc + (it * 32 + (lane & 31)) * 136 + 8 * (lane >> 5);
#pragma unroll
          for (int k = 0; k < 8; ++k) { const s16x8 a = *(const LAS s16x8*)(ap + k * 16);
              ra = __builtin_amdgcn_mfma_f32_32x32x16_bf16(a, wr[k], ra, 0, 0, 0); xa = __builtin_amdgcn_mfma_f32_32x32x16_bf16(a, wx[k], xa, 0, 0, 0); }
          const int c = nt * 32 + (lane & 31), cg = hh * 128 + c; const float bav = ba[cg], bxv = bx[cg], sp = softplus_f(-lam[cg]);
#pragma unroll
          for (int r = 0; r < 16; ++r) { const int l = it * 32 + rowmap(r, lane);
              const float rr = sigm_f(ra[r] + bav), ii = sigm_f(xa[r] + bxv), la = -8.0f * rr * sp;
              const float xv = ul[l * 128 + c];
              al[l * 128 + c] = __expf(la); ul[l * 128 + c] = __builtin_amdgcn_sqrtf(1.0f - __expf(2.0f * la)) * ii * xv; } }
        __syncthreads();
        { const int cp = tid & 63, sg = wave;
          float h0 = 0.f, h1 = 0.f, P0 = 1.f, P1 = 1.f; float hl0[8], hl1[8], Pl0[8], Pl1[8];
#pragma unroll
          for (int t = 0; t < 8; ++t) { const hwf2_t a2 = *(const LAS hwf2_t*)(al + (sg * 8 + t) * 128 + 2 * cp), u2 = *(const LAS hwf2_t*)(ul + (sg * 8 + t) * 128 + 2 * cp);
              h0 = a2.x * h0 + u2.x; h1 = a2.y * h1 + u2.y; P0 *= a2.x; P1 *= a2.y; hl0[t] = h0; hl1[t] = h1; Pl0[t] = P0; Pl1[t] = P1; }
          *(LAS f32x4*)(seg + (sg * 128 + 2 * cp) * 2) = (f32x4){P0, h0, P1, h1};
          __syncthreads();
          float Pi0 = 1.f, Pi1 = 1.f, hi0 = 0.f, hi1 = 0.f;
          for (int q = 0; q < sg; ++q) { const f32x4 e = *(const LAS f32x4*)(seg + (q * 128 + 2 * cp) * 2); hi0 = e.x * hi0 + e.y; hi1 = e.z * hi1 + e.w; Pi0 *= e.x; Pi1 *= e.z; }
          bf16* hp = B.hloc + (t0 + sg * 8) * 512 + hh * 128 + 2 * cp; bf16* pp = B.pc + (t0 + sg * 8) * 512 + hh * 128 + 2 * cp;
#pragma unroll
          for (int t = 0; t < 8; ++t) { *(unsigned*)(hp + (size_t)t * 512) = pk2(hl0[t] + Pl0[t] * hi0, hl1[t] + Pl1[t] * hi1); *(unsigned*)(pp + (size_t)t * 512) = pk2(Pl0[t] * Pi0, Pl1[t] * Pi1); }
          if (sg == 7) { float2 ca, cu; ca.x = Pl0[7] * Pi0; ca.y = Pl1[7] * Pi1; cu.x = hl0[7] + Pl0[7] * hi0; cu.y = hl1[7] + Pl1[7] * hi1;
              *(float2*)(B.carA + (size_t)ch * 512 + hh * 128 + 2 * cp) = ca; *(float2*)(B.carU + (size_t)ch * 512 + hh * 128 + 2 * cp) = cu; } }
    }
    __syncthreads();
}
__device__ __forceinline__ void lru_b(const Mix0Bufs& B, int gtid, int gsz) {
    for (int idx = gtid; idx < 2 * 512; idx += gsz) { const int b = idx >> 9, c = idx & 511; float hst = 0.f;
        for (int n0 = 0; n0 < NCH; n0 += 16) { float a[16], u[16];
#pragma unroll
            for (int j = 0; j < 16; ++j) { const size_t o = (size_t)(b * NCH + n0 + j) * 512 + c; a[j] = B.carA[o]; u[j] = B.carU[o]; }
#pragma unroll
            for (int j = 0; j < 16; ++j) { const float in = hst; hst = a[j] * hst + u[j]; a[j] = in; }
#pragma unroll
            for (int j = 0; j < 16; ++j) B.carI[(size_t)(b * NCH + n0 + j) * 512 + c] = a[j]; } }
}
__device__ __forceinline__ void lru_c(const Mix0Bufs& B, int gtid, int gsz) {
    for (int idx = gtid; idx < T_ * 64; idx += gsz) { const size_t t = idx >> 6; const int c0 = (idx & 63) * 8; const size_t ch = t >> 6;
        float gb[8], y[8]; unpack8(*(const v4u*)(B.proj + t * PJ0 + 2568 + c0), gb);
        float hp[8], pp[8]; unpack8(*(const v4u*)(B.hloc + t * 512 + c0), hp); unpack8(*(const v4u*)(B.pc + t * 512 + c0), pp); const float* ci = B.carI + ch * 512 + c0;
#pragma unroll
        for (int j = 0; j < 8; ++j) y[j] = (hp[j] + pp[j] * ci[j]) * gelu_f(gb[j]);
        *(v4u*)(B.mixbf + t * 1024 + 512 + c0) = pack8(y); }
}
constexpr int PJ1 = OINP;
struct Mix1Bufs { const bf16* proj; bf16* ut; float* gbl; bf16* s5g; float* xend; float* xstart; float* s5ab; float* s5bb; bf16* cm; bf16* bbt; bf16* mixbf; };
__device__ __forceinline__ void gla_gates(const bf16* proj, const float* gw, const float* gb, size_t t0, int h, LAS float* bc, LAS float* gl, LAS float* tot, int tid) {
    const int d = tid & 63, lg = __builtin_amdgcn_readfirstlane(tid >> 6);
    if (tid < 128) { const int l = tid >> 1, hf = tid & 1; float f[8]; unpack8(*(const v4u*)(proj + (t0 + l) * PJ1 + 2048 + hf * 8), f);
        *(LAS f32x4*)(gl + l * 16 + hf * 8) = (f32x4){f[0], f[1], f[2], f[3]}; *(LAS f32x4*)(gl + l * 16 + hf * 8 + 4) = (f32x4){f[4], f[5], f[6], f[7]}; }
    float w[16];
#pragma unroll
    for (int r = 0; r < 16; ++r) w[r] = gw[r * 256 + h * 64 + d];
    const float bias = gb[h * 64 + d];
    __syncthreads();
    float v[8];
#pragma unroll
    for (int q = 0; q < 8; ++q) { const int l = lg * 8 + q; float acc = bias;
#pragma unroll
        for (int r4 = 0; r4 < 4; ++r4) { const f32x4 g4 = *(const LAS f32x4*)(gl + l * 16 + r4 * 4); acc += g4.x * w[r4 * 4] + g4.y * w[r4 * 4 + 1] + g4.z * w[r4 * 4 + 2] + g4.w * w[r4 * 4 + 3]; }
        v[q] = logsig_f(acc) * 0.0625f; }
#pragma unroll
    for (int q = 1; q < 8; ++q) v[q] += v[q - 1];
    tot[lg * 64 + d] = v[7];
    __syncthreads();
    float pre = 0.f;
#pragma unroll
    for (int s = 0; s < 7; ++s) { const float t = tot[s * 64 + d]; pre += (s < lg) ? t : 0.f; }
#pragma unroll
    for (int q = 0; q < 8; ++q) bc[(lg * 8 + q) * 64 + d] = v[q] + pre;
    __syncthreads();
}
__device__ __forceinline__ void gla_a_item(const Mix1Bufs& B, const float* gw, const float* gb, int cn, LAS unsigned char* lds, int tid) {
    const int lane = tid & 63, wave = __builtin_amdgcn_readfirstlane(tid >> 6);
    const int bh = cn / NCH, n = cn % NCH, b = bh >> 2, h = bh & 3;
    const size_t t0 = (size_t)b * S_ + n * 64;
    LAS float* bc = (LAS float*)lds; LAS float* gl = (LAS float*)(lds + 16384); LAS float* tot = (LAS float*)(lds + 118784);
    lbf16* kT = (lbf16*)(lds + 20480); lbf16* vT = (lbf16*)(lds + 20480 + 64 * 72 * 2);
    v4u gk, gv[2];
    { const int l = tid & 63, g = tid >> 6; gk = *(const v4u*)(B.proj + (t0 + l) * PJ1 + 768 + h * 64 + g * 8); }
#pragma unroll
    for (int it = 0; it < 2; ++it) { const int vi = tid + it * 512, l = vi & 63, g = vi >> 6; gv[it] = *(const v4u*)(B.proj + (t0 + l) * PJ1 + 1024 + h * 128 + g * 8); }
    gla_gates(B.proj, gw, gb, t0, h, bc, gl, tot, tid);
    { const int l = tid & 63, g = tid >> 6; float kf[8]; unpack8(gk, kf);
#pragma unroll
      for (int j = 0; j < 8; ++j) { const int d = g * 8 + j; kT[d * 72 + l] = (unsigned short)f2bf(kf[j] * __expf(bc[63 * 64 + d] - bc[l * 64 + d])); } }
#pragma unroll
    for (int it = 0; it < 2; ++it) { const int vi = tid + it * 512, l = vi & 63, g = vi >> 6; float vf[8]; unpack8(gv[it], vf);
#pragma unroll
        for (int j = 0; j < 8; ++j) vT[(g * 8 + j) * 72 + l] = (unsigned short)f2bf(vf[j]); }
    __syncthreads();
    { const int et = wave >> 1, dt = wave & 1;
      f32x16 acc = {0.f, 0.f, 0.f, 0.f, 0.f, 0.f, 0.f, 0.f, 0.f, 0.f, 0.f, 0.f, 0.f, 0.f, 0.f, 0.f};
      mm32(acc, kT + dt * 32 * 72, 72, vT + et * 32 * 72, 72, 64, lane);
      bf16* out = B.ut + (size_t)cn * 8192 + (et * 2 + dt) * 1024 + lane * 16;
      v4u o0, o1; o0.x = pk2(acc[0], acc[1]); o0.y = pk2(acc[2], acc[3]); o0.z = pk2(acc[4], acc[5]); o0.w = pk2(acc[6], acc[7]);
      o1.x = pk2(acc[8], acc[9]); o1.y = pk2(acc[10], acc[11]); o1.z = pk2(acc[12], acc[13]); o1.w = pk2(acc[14], acc[15]);
      *(v4u*)out = o0; *(v4u*)(out + 8) = o1; }
    if (tid < 64) B.gbl[(size_t)cn * 64 + tid] = bc[63 * 64 + tid];
    __syncthreads();
}
__device__ __forceinline__ void gla_b(const Mix1Bufs& B, int gtid, int gsz) {
    for (int idx = gtid; idx < 8 * 4096; idx += gsz) { const int bh = idx >> 12, pe = idx & 4095, d = ((pe >> 9) & 1) * 32 + ((pe * 2) & 3) + 8 * ((pe >> 1) & 3) + 4 * ((pe >> 8) & 1); float s0 = 0.f, s1 = 0.f;
        unsigned* p = (unsigned*)B.ut + (size_t)bh * NCH * 4096 + pe; const float* gp = B.gbl + (size_t)bh * NCH * 64 + d;
        for (int n0 = 0; n0 < NCH; n0 += 16) { unsigned u[16]; float g0[16], g1[16];
#pragma unroll
            for (int j = 0; j < 16; ++j) { u[j] = p[(size_t)(n0 + j) * 4096]; g0[j] = gp[(n0 + j) * 64]; g1[j] = gp[(n0 + j) * 64 + 1]; }
#pragma unroll
            for (int j = 0; j < 16; ++j) { const unsigned out = pk2(s0, s1);
                s0 = __expf(g0[j]) * s0 + __builtin_bit_cast(float, u[j] << 16); s1 = __expf(g1[j]) * s1 + __builtin_bit_cast(float, u[j] & 0xffff0000u); u[j] = out; }
#pragma unroll
            for (int j = 0; j < 16; ++j) p[(size_t)(n0 + j) * 4096] = u[j]; } }
}
__device__ __forceinline__ void gla_c_item(const Mix1Bufs& B, const float* gw, const float* gb, const float* norm_w, int cn, LAS unsigned char* lds, int tid) {
    const int lane = tid & 63, wave = __builtin_amdgcn_readfirstlane(tid >> 6);
    const int bh = cn / NCH, n = cn % NCH, b = bh >> 2, h = bh & 3;
    const size_t t0 = (size_t)b * S_ + n * 64;
    LAS float* bc = (LAS float*)lds; LAS float* gl = (LAS float*)(lds + 16384);
    lbf16* qd = (lbf16*)(lds + 20480); lbf16* ki = (lbf16*)(lds + 29696); lbf16* vT = (lbf16*)(lds + 38912); lbf16* sT = (lbf16*)(lds + 57344); lbf16* att = (lbf16*)(lds + 75776);
    LAS float* ob = (LAS float*)(lds + 84992); LAS float* tot = (LAS float*)(lds + 118784);
    gla_gates(B.proj, gw, gb, t0, h, bc, gl, tot, tid);
    { const int l = tid >> 3, g = tid & 7; const bf16* pr = B.proj + (t0 + l) * PJ1 + h * 64 + g * 8; float qf[8], kf[8]; unpack8(*(const v4u*)(pr + 512), qf); unpack8(*(const v4u*)(pr + 768), kf);
#pragma unroll
      for (int j = 0; j < 8; ++j) { const float bb = bc[l * 64 + g * 8 + j]; qf[j] *= 0.125f * __expf(bb); kf[j] *= __expf(-bb); }
      *(LAS v4u*)(qd + l * 72 + g * 8) = pack8(qf); *(LAS v4u*)(ki + l * 72 + g * 8) = pack8(kf); }
#pragma unroll
    for (int it = 0; it < 2; ++it) { const int vi = tid + it * 512, l = vi & 63, g = vi >> 6; float vf[8]; unpack8(*(const v4u*)(B.proj + (t0 + l) * PJ1 + 1024 + h * 128 + g * 8), vf);
#pragma unroll
        for (int j = 0; j < 8; ++j) vT[(g * 8 + j) * 72 + l] = (unsigned short)f2bf(vf[j]); }
    { const bf16* sg = B.ut + (size_t)cn * 8192;
#pragma unroll
      for (int it = 0; it < 2; ++it) { const int vi = tid + it * 512, T = vi >> 7, ln = (vi >> 1) & 63, hr = vi & 1; const v4u x = *(const v4u*)(sg + vi * 8);
          LAS unsigned char* dp = (LAS unsigned char*)(sT + ((T >> 1) * 32 + (ln & 31)) * 72 + (T & 1) * 32 + 16 * hr + 4 * (ln >> 5));
          *(LAS v2u*)dp = (v2u){x.x, x.y}; *(LAS v2u*)(dp + 16) = (v2u){x.z, x.w}; } }
    __syncthreads();
    if (wave < 4) { const int it = wave >> 1, jt = wave & 1;
        f32x16 acc = {0.f, 0.f, 0.f, 0.f, 0.f, 0.f, 0.f, 0.f, 0.f, 0.f, 0.f, 0.f, 0.f, 0.f, 0.f, 0.f};
        if (jt <= it) mm32(acc, ki + jt * 32 * 72, 72, qd + it * 32 * 72, 72, 64, lane);
        const int i = it * 32 + (lane & 31);
#pragma unroll
        for (int g4 = 0; g4 < 4; ++g4) { const int j0 = jt * 32 + 8 * g4 + 4 * (lane >> 5);
            v2u o; o.x = pk2(j0 <= i ? acc[g4 * 4] : 0.f, j0 + 1 <= i ? acc[g4 * 4 + 1] : 0.f); o.y = pk2(j0 + 2 <= i ? acc[g4 * 4 + 2] : 0.f, j0 + 3 <= i ? acc[g4 * 4 + 3] : 0.f);
            *(LAS v2u*)(att + i * 72 + j0) = o; } }
    __syncthreads();
    { const int it = wave >> 2, nt = wave & 3;
      f32x16 acc = {0.f, 0.f, 0.f, 0.f, 0.f, 0.f, 0.f, 0.f, 0.f, 0.f, 0.f, 0.f, 0.f, 0.f, 0.f, 0.f};
      mm32(acc, vT + nt * 32 * 72, 72, att + it * 32 * 72, 72, 64, lane); mm32(acc, sT + nt * 32 * 72, 72, qd + it * 32 * 72, 72, 64, lane);
#pragma unroll
      for (int g4 = 0; g4 < 4; ++g4) *(LAS f32x4*)(ob + (it * 32 + (lane & 31)) * 132 + nt * 32 + 8 * g4 + 4 * (lane >> 5)) = (f32x4){acc[g4 * 4], acc[g4 * 4 + 1], acc[g4 * 4 + 2], acc[g4 * 4 + 3]}; }
    __syncthreads();
    { const int i = tid >> 3, sub = tid & 7; const LAS float* hr = ob + i * 132 + sub * 16;
      float x[16]; float q = 0.f;
#pragma unroll
      for (int j = 0; j < 16; ++j) { x[j] = hr[j]; q += x[j] * x[j]; }
      q += __builtin_bit_cast(float, __builtin_amdgcn_ds_swizzle(__builtin_bit_cast(int, q), 0x1f | (1 << 10)));
      q += __builtin_bit_cast(float, __builtin_amdgcn_ds_swizzle(__builtin_bit_cast(int, q), 0x1f | (2 << 10)));
      q += __builtin_bit_cast(float, __builtin_amdgcn_ds_swizzle(__builtin_bit_cast(int, q), 0x1f | (4 << 10)));
      const float rstd = __builtin_amdgcn_rsqf(q * (1.f / 128.f) + nv::EPS);
      const bf16* rp = B.proj + (t0 + i) * PJ1 + 1536 + h * 128 + sub * 16; const float* nw = norm_w + h * 128 + sub * 16;
      float r0[8], r1[8]; unpack8(*(const v4u*)rp, r0); unpack8(*(const v4u*)(rp + 8), r1);
      float y0[8], y1[8];
#pragma unroll
      for (int j = 0; j < 8; ++j) { y0[j] = x[j] * rstd * nw[j] * r0[j] * sigm_f(r0[j]); y1[j] = x[8 + j] * rstd * nw[8 + j] * r1[j] * sigm_f(r1[j]); }
      bf16* dst = B.mixbf + (t0 + i) * 1024 + 512 + h * 128 + sub * 16;
      *(v4u*)dst = pack8(y0); *(v4u*)(dst + 8) = pack8(y1); }
    __syncthreads();
}
__device__ __forceinline__ void s5_params(const Mix1Bufs& B, const float* const* in, int gtid, int gsz) {

    for (int idx = gtid; idx < 2048; idx += gsz) { const int g = idx >> 6;
        const float lr = in[17][idx], li = in[18][idx], dt = expf(in[24][g]);
        const float mag = expf(lr * dt), ar = mag * cosf(li * dt), ai = mag * sinf(li * dt);
        const float den = lr * lr + li * li, nr = ar - 1.0f, cr = (nr * lr + ai * li) / den, ci = (ai * lr - nr * li) / den;
        B.s5ab[idx * 2] = ar; B.s5ab[idx * 2 + 1] = ai;
        for (int h = 0; h < 16; ++h) { const float br = in[19][idx * 16 + h], bi = in[20][idx * 16 + h]; B.s5bb[idx * 32 + h] = cr * br - ci * bi; B.s5bb[idx * 32 + 16 + h] = cr * bi + ci * br; } }
    for (int idx = gtid; idx < 32 * 128 * 16; idx += gsz) { const int h = idx & 15, j = (idx >> 4) & 127, g = idx >> 11; const int gp = g * 64 + (j & 63);
        const float lr = in[17][gp], li = in[18][gp], dt = expf(in[24][g]);
        const float mag = expf(lr * dt), ar = mag * cosf(li * dt), ai = mag * sinf(li * dt);
        const float den = lr * lr + li * li, nr = ar - 1.0f, cr = (nr * lr + ai * li) / den, ci = (ai * lr - nr * li) / den;
        const float br = in[19][gp * 16 + h], bi = in[20][gp * 16 + h];
        B.bbt[idx] = (unsigned short)f2bf(j < 64 ? cr * br - ci * bi : cr * bi + ci * br); }
    for (int idx = gtid; idx < 32 * 32 * 128; idx += gsz) { const int k = idx & 127, hh = (idx >> 7) & 31, g = idx >> 12;
        float v = 0.f; if (hh < 16) v = k < 64 ? in[21][(g * 16 + hh) * 64 + k] : -in[22][(g * 16 + hh) * 64 + k - 64];
        B.cm[idx] = (unsigned short)f2bf(v); }
}
template <bool OUT> __device__ __forceinline__ void s5_chunk_v2(const Mix1Bufs& B, const float* dskip, int item, bool valid, LAS unsigned char* wl, int lane) {
    if (!valid) item = 0;
    const int n = item % NCH, g = (item / NCH) & 31, b = item / (NCH * 32);
    const size_t t0 = (size_t)b * S_ + n * 64; const int gp = g * 64 + lane;
    LAS float* bu = (LAS float*)wl;
    lbf16* xs = (lbf16*)(wl + 8192);
    const float ar = B.s5ab[gp * 2], ai = B.s5ab[gp * 2 + 1];
    float xr = 0.f, xi = 0.f;
    if (OUT) { xr = B.xstart[((size_t)item * 64 + lane) * 2]; xi = B.xstart[((size_t)item * 64 + lane) * 2 + 1]; }
    const bf16* bbt = B.bbt + (size_t)g * 2048 + (lane & 31) * 16 + 8 * (lane >> 5);
    for (int half = 0; half < 2; ++half) {
        const s16x8 a = *(const s16x8*)(B.proj + (t0 + half * 32 + (lane & 31)) * PJ1 + g * 16 + 8 * (lane >> 5));
        f32x16 acc[4];
#pragma unroll
        for (int nt = 0; nt < 4; ++nt) { const s16x8 bf = *(const s16x8*)(bbt + nt * 512);
            const f32x16 z = {0.f, 0.f, 0.f, 0.f, 0.f, 0.f, 0.f, 0.f, 0.f, 0.f, 0.f, 0.f, 0.f, 0.f, 0.f, 0.f};
            acc[nt] = __builtin_amdgcn_mfma_f32_32x32x16_bf16(a, bf, z, 0, 0, 0); }
#pragma unroll
        for (int q = 0; q < 2; ++q) {
#pragma unroll
            for (int nt = 0; nt < 4; ++nt)
#pragma unroll
                for (int rr = 0; rr < 8; ++rr) bu[((rr & 3) + 8 * (rr >> 2) + 4 * (lane >> 5)) * 128 + nt * 32 + (lane & 31)] = acc[nt][q * 8 + rr];
            __syncthreads();
#pragma unroll 4
            for (int l = 0; l < 16; ++l) { const float sr = bu[l * 128 + lane], si = bu[l * 128 + 64 + lane];
                const float nr = ar * xr - ai * xi + sr, ni = ar * xi + ai * xr + si; xr = nr; xi = ni;
                if (OUT) { xs[(q * 16 + l) * 136 + lane] = (unsigned short)f2bf(xr); xs[(q * 16 + l) * 136 + 64 + lane] = (unsigned short)f2bf(xi); } }
            __syncthreads();
        }
        if (OUT) {
            f32x16 acc2 = {0.f, 0.f, 0.f, 0.f, 0.f, 0.f, 0.f, 0.f, 0.f, 0.f, 0.f, 0.f, 0.f, 0.f, 0.f, 0.f};
            mm32_gb(acc2, xs, 136, B.cm + (size_t)g * 32 * 128, 128, 128, lane);
            const int hh = lane & 31;
            if (hh < 16 && valid) { const float dk = dskip[g * 16 + hh];
#pragma unroll
                for (int r = 0; r < 16; ++r) { const size_t t = t0 + half * 32 + rowmap(r, lane);
                    B.s5g[t * 512 + g * 16 + hh] = (unsigned short)f2bf(gelu_f(acc2[r] + dk * bf2f(B.proj[t * PJ1 + g * 16 + hh]))); } }
            __syncthreads();
        }
    }
    if (!OUT && valid) { B.xend[((size_t)item * 64 + lane) * 2] = xr; B.xend[((size_t)item * 64 + lane) * 2 + 1] = xi; }
}
template <bool OUT> __device__ __forceinline__ void s5_phase(const Mix1Bufs& B, const float* dskip, int gw, int NGW, LAS unsigned char* wl, int lane) {
    const int wpg = NGW >> 5, g_ = gw / wpg, j0 = gw - g_ * wpg; const bool gvalid = g_ < 32; const int g = gvalid ? g_ : 0;
    const int nit = (2 * NCH + wpg - 1) / wpg;
    const float ar = B.s5ab[(g * 64 + lane) * 2], ai = B.s5ab[(g * 64 + lane) * 2 + 1];
    s16x8 bf[4]; { const bf16* bbt = B.bbt + (size_t)g * 2048 + (lane & 31) * 16 + 8 * (lane >> 5);
#pragma unroll
        for (int nt = 0; nt < 4; ++nt) bf[nt] = *(const s16x8*)(bbt + nt * 512); }
    s16x8 cf[4]; float dk[4];
    if (OUT) { const bf16* cm = B.cm + (size_t)g * 32 * 128 + (lane & 15) * 128 + 8 * (lane >> 4);
#pragma unroll
        for (int ks = 0; ks < 4; ++ks) cf[ks] = *(const s16x8*)(cm + ks * 32);
#pragma unroll
        for (int r = 0; r < 4; ++r) dk[r] = dskip[g * 16 + 4 * (lane >> 4) + r]; }
    s16x8 na[2]; v2u nu[2][2]; float nxr = 0.f, nxi = 0.f;
#define S5_LOAD(kk) do { const int _i = j0 + (kk) * wpg; const int _idx = (gvalid && _i < 2 * NCH) ? _i : 0; const int _b = _idx / NCH, _n = _idx % NCH; const size_t _t0 = (size_t)_b * S_ + _n * 64; \
        const bf16* _p = B.proj + (_t0 + (lane & 31)) * PJ1 + g * 16 + 8 * (lane >> 5); na[0] = *(const s16x8*)_p; na[1] = *(const s16x8*)(_p + (size_t)32 * PJ1); \
        if (OUT) { const size_t _it = (size_t)(_b * 32 + g) * NCH + _n; const float2 _x = *(const float2*)(B.xstart + (_it * 64 + lane) * 2); nxr = _x.x; nxi = _x.y; \
            const bf16* _q = B.proj + (_t0 + (lane & 15)) * PJ1 + g * 16 + 4 * (lane >> 4); _Pragma("unroll") for (int _h = 0; _h < 2; ++_h) _Pragma("unroll") for (int _t = 0; _t < 2; ++_t) nu[_h][_t] = *(const v2u*)(_q + (size_t)(_h * 32 + _t * 16) * PJ1); } } while (0)
    S5_LOAD(0);
    for (int k = 0; k < nit; ++k) {
        const int i_ = j0 + k * wpg; const bool valid = gvalid && i_ < 2 * NCH; const int idx = valid ? i_ : 0; const int b = idx / NCH, n = idx % NCH;
        const size_t t0 = (size_t)b * S_ + n * 64; const size_t item = (size_t)(b * 32 + g) * NCH + n;
        s16x8 a[2] = {na[0], na[1]}; v2u uu[2][2] = {{nu[0][0], nu[0][1]}, {nu[1][0], nu[1][1]}}; float xr = OUT ? nxr : 0.f, xi = OUT ? nxi : 0.f;
        if (k + 1 < nit) S5_LOAD(k + 1);
#pragma unroll
        for (int half = 0; half < 2; ++half) {
            f32x16 acc[4];
#pragma unroll
            for (int nt = 0; nt < 4; ++nt) { const f32x16 z = {0.f, 0.f, 0.f, 0.f, 0.f, 0.f, 0.f, 0.f, 0.f, 0.f, 0.f, 0.f, 0.f, 0.f, 0.f, 0.f};
                acc[nt] = __builtin_amdgcn_mfma_f32_32x32x16_bf16(a[half], bf[nt], z, 0, 0, 0); }
            float sre[2][16], sim[2][16];
#pragma unroll
            for (int r = 0; r < 16; ++r) {
                { auto w = __builtin_amdgcn_permlane32_swap(__float_as_uint(acc[0][r]), __float_as_uint(acc[1][r]), false, false); sre[0][r] = __uint_as_float(w[0]); sre[1][r] = __uint_as_float(w[1]); }
                { auto w = __builtin_amdgcn_permlane32_swap(__float_as_uint(acc[2][r]), __float_as_uint(acc[3][r]), false, false); sim[0][r] = __uint_as_float(w[0]); sim[1][r] = __uint_as_float(w[1]); } }
            lbf16* xs = (lbf16*)(wl + half * 8704);
#pragma unroll
            for (int q = 0; q < 4; ++q)
#pragma unroll
                for (int wch = 0; wch < 2; ++wch)
#pragma unroll
                    for (int i = 0; i < 4; ++i) { const int r = q * 4 + i, tok = q * 8 + wch * 4 + i;
                        const float sr = sre[wch][r], si = sim[wch][r];
                        const float nr = ar * xr - ai * xi + sr, ni = ar * xi + ai * xr + si; xr = nr; xi = ni;
                        if (OUT) { xs[tok * 136 + lane] = (unsigned short)f2bf(xr); xs[tok * 136 + 64 + lane] = (unsigned short)f2bf(xi); } }
            if (OUT) {
                __syncthreads();
#pragma unroll
                for (int tt = 0; tt < 2; ++tt) { f32x4 y = {0.f, 0.f, 0.f, 0.f};
                    const lbf16* xp = xs + (tt * 16 + (lane & 15)) * 136 + 8 * (lane >> 4);
#pragma unroll
                    for (int ks = 0; ks < 4; ++ks) y = __builtin_amdgcn_mfma_f32_16x16x32_bf16(cf[ks], *(const LAS s16x8*)(xp + ks * 32), y, 0, 0, 0);
                    const v2u u = uu[half][tt];
                    const float u0 = __builtin_bit_cast(float, u.x << 16), u1 = __builtin_bit_cast(float, u.x & 0xffff0000u), u2 = __builtin_bit_cast(float, u.y << 16), u3 = __builtin_bit_cast(float, u.y & 0xffff0000u);
                    v2u o; o.x = pk2(gelu_f(y[0] + dk[0] * u0), gelu_f(y[1] + dk[1] * u1)); o.y = pk2(gelu_f(y[2] + dk[2] * u2), gelu_f(y[3] + dk[3] * u3));
                    if (valid) *(v2u*)(B.s5g + (t0 + half * 32 + tt * 16 + (lane & 15)) * 512 + g * 16 + 4 * (lane >> 4)) = o; }
            }
        }
        if (!OUT && valid) { float2 o; o.x = xr; o.y = xi; *(float2*)(B.xend + (item * 64 + lane) * 2) = o; }
    }
#undef S5_LOAD
}
__device__ __forceinline__ void s5_b(const Mix1Bufs& B, int gtid, int gsz) {
    for (int idx = gtid; idx < 2 * 2048; idx += gsz) { const int b = idx >> 11, gp = idx & 2047, g = gp >> 6, p = gp & 63;
        float ar = B.s5ab[gp * 2], ai = B.s5ab[gp * 2 + 1];
#pragma unroll
        for (int q = 0; q < 6; ++q) { const float r2 = ar * ar - ai * ai, i2 = 2.f * ar * ai; ar = r2; ai = i2; }
        float xr = 0.f, xi = 0.f;
        const size_t o0 = ((size_t)((b * 32 + g) * NCH) * 64 + p) * 2;
        for (int n0 = 0; n0 < NCH; n0 += 16) { float er[16], ei[16];
#pragma unroll
            for (int j = 0; j < 16; ++j) { const size_t o = o0 + (size_t)(n0 + j) * 128; er[j] = B.xend[o]; ei[j] = B.xend[o + 1]; }
#pragma unroll
            for (int j = 0; j < 16; ++j) { const float sr = xr, si = xi; const float nr = ar * xr - ai * xi + er[j], ni = ar * xi + ai * xr + ei[j]; xr = nr; xi = ni; er[j] = sr; ei[j] = si; }
#pragma unroll
            for (int j = 0; j < 16; ++j) { const size_t o = o0 + (size_t)(n0 + j) * 128; B.xstart[o] = er[j]; B.xstart[o + 1] = ei[j]; } } }
}
typedef float f32x4v __attribute__((ext_vector_type(4)));
struct RouterBufs { const float* z; float* h; bf16* hbf; const float* lnw; const float* lnb; const bf16* rwh; const bf16* rwl; const float* rbias; int* ridx; float* rwt; unsigned* cnt; };
__device__ __forceinline__ void router_split_weights(const float* rw, bf16* hi, bf16* lo, int gtid, int gsz) {
    for (int i = gtid; i < 64 * 1024; i += gsz) { const int e = i >> 10, k = i & 1023; const float w = rw[k * 64 + e]; const unsigned h = f2bf(w); hi[i] = (unsigned short)h; lo[i] = (unsigned short)f2bf(w - __builtin_bit_cast(float, h << 16)); }
}
__device__ __forceinline__ void router_select(const LAS float* sc, const float* bias, int* ridx, float* rwt, LAS unsigned* hist) {
    float gs[8];
#pragma unroll
    for (int g = 0; g < 8; ++g) { float m1 = -INFINITY, m2 = -INFINITY;
#pragma unroll
        for (int j = 0; j < 8; ++j) { const float v = sc[g * 8 + j] + bias[g * 8 + j]; if (v > m1) { m2 = m1; m1 = v; } else if (v > m2) m2 = v; }
        gs[g] = m1 + m2; }
    unsigned gsel = 0;
#pragma unroll
    for (int it = 0; it < 4; ++it) { float best = -INFINITY; int bi = 0;
#pragma unroll
        for (int g = 0; g < 8; ++g) { const bool ok = !((gsel >> g) & 1u) && gs[g] > best; best = ok ? gs[g] : best; bi = ok ? g : bi; }
        gsel |= 1u << bi; }
    unsigned long long taken = 0ull; float wsum = 0.f; float wv[8]; int ev[8];
#pragma unroll
    for (int it = 0; it < 8; ++it) { float best = -INFINITY; int bi = 0;
#pragma unroll 1
        for (int e = 0; e < 64; ++e) { const bool ok = ((gsel >> (e >> 3)) & 1u) && !((taken >> e) & 1ull); const float v = sc[e] + bias[e]; if (ok && v > best) { best = v; bi = e; } }
        taken |= 1ull << bi; ev[it] = bi; wv[it] = sc[bi]; wsum += wv[it]; }
    const float inv = 2.5f / wsum;
#pragma unroll
    for (int it = 0; it < 8; ++it) { ridx[it] = ev[it]; rwt[it] = wv[it] * inv; atomicAdd((unsigned*)&hist[ev[it]], 1u); }
}
__device__ __forceinline__ float wave_max_f(float v) {
#define WM_STEP(o) v = fmaxf(v, __builtin_bit_cast(float, __builtin_amdgcn_ds_swizzle(__builtin_bit_cast(int, v), 0x1f | ((o) << 10))))
    WM_STEP(1); WM_STEP(2); WM_STEP(4); WM_STEP(8); WM_STEP(16);
#undef WM_STEP
    return fmaxf(__builtin_bit_cast(float, __builtin_amdgcn_readlane(__builtin_bit_cast(int, v), 0)), __builtin_bit_cast(float, __builtin_amdgcn_readlane(__builtin_bit_cast(int, v), 32)));
}
__device__ __forceinline__ void router_tiles(const RouterBufs& R, int tile0, int tstride, int ntiles, LAS unsigned char* lds, int tid, bool count = true) {
    const int lane = tid & 63, wave = __builtin_amdgcn_readfirstlane(tid >> 6);
    lbf16* Ahi = (lbf16*)lds; lbf16* Alo = (lbf16*)(lds + 33024); LAS float* part = (LAS float*)(lds + 66048); LAS unsigned* hist = (LAS unsigned*)(lds + 102912);
    if (tile0 >= ntiles) return;
    const int row16 = lane & 15, kq = 8 * (lane >> 4);
    s16x8 bh[4][4], bl[4][4];
#pragma unroll
    for (int ks = 0; ks < 4; ++ks)
#pragma unroll
        for (int nt = 0; nt < 4; ++nt) { const size_t o = (size_t)(nt * 16 + row16) * 1024 + wave * 128 + ks * 32 + kq; bh[ks][nt] = *(const s16x8*)(R.rwh + o); bl[ks][nt] = *(const s16x8*)(R.rwl + o); }
    const float bias = R.rbias[lane];
    f32x4 zr[2][4];
#define RT_LOAD(tile) do { _Pragma("unroll") for (int q = 0; q < 2; ++q) { const float* zp = R.z + ((size_t)(tile) * 16 + wave * 2 + q) * 1024 + lane * 8; \
        zr[q][0] = *(const f32x4*)zp; zr[q][1] = *(const f32x4*)(zp + 4); zr[q][2] = *(const f32x4*)(zp + 512); zr[q][3] = *(const f32x4*)(zp + 516); } } while (0)
    RT_LOAD(tile0);
    if (tid < 64) hist[tid] = 0u;
    LAS float* lnl = (LAS float*)(lds + 103424);
    if (tid < 256) *(LAS f32x4*)(lnl + tid * 4) = *(const f32x4*)(R.lnw + tid * 4); else *(LAS f32x4*)(lnl + 1024 + (tid - 256) * 4) = *(const f32x4*)(R.lnb + (tid - 256) * 4);
    __syncthreads();
    for (int tile = tile0; tile < ntiles; tile += tstride) {
#pragma unroll
        for (int q = 0; q < 2; ++q) { const int row = wave * 2 + q; const size_t t = (size_t)tile * 16 + row;
            float v[16] = {zr[q][0].x, zr[q][0].y, zr[q][0].z, zr[q][0].w, zr[q][1].x, zr[q][1].y, zr[q][1].z, zr[q][1].w, zr[q][2].x, zr[q][2].y, zr[q][2].z, zr[q][2].w, zr[q][3].x, zr[q][3].y, zr[q][3].z, zr[q][3].w};
            float sum = 0.f;
#pragma unroll
            for (int j = 0; j < 16; ++j) sum += v[j];
            sum = wave_sum(sum); const float mean = sum * (1.f / 1024.f); float sq = 0.f;
#pragma unroll
            for (int j = 0; j < 16; ++j) { v[j] -= mean; sq += v[j] * v[j]; }
            sq = wave_sum(sq); const float rstd = 1.0f / sqrtf(sq * (1.f / 1024.f) + nv::EPS);
#pragma unroll
            for (int half = 0; half < 2; ++half) { const int c0 = half * 512 + lane * 8;
                const f32x4 w0 = *(const LAS f32x4*)(lnl + c0), w1 = *(const LAS f32x4*)(lnl + c0 + 4), b0 = *(const LAS f32x4*)(lnl + 1024 + c0), b1 = *(const LAS f32x4*)(lnl + 1024 + c0 + 4);
                float o[8] = {v[half * 8 + 0] * rstd * w0.x + b0.x, v[half * 8 + 1] * rstd * w0.y + b0.y, v[half * 8 + 2] * rstd * w0.z + b0.z, v[half * 8 + 3] * rstd * w0.w + b0.w,
                              v[half * 8 + 4] * rstd * w1.x + b1.x, v[half * 8 + 5] * rstd * w1.y + b1.y, v[half * 8 + 6] * rstd * w1.z + b1.z, v[half * 8 + 7] * rstd * w1.w + b1.w};
                *(f32x4*)(R.h + t * 1024 + c0) = (f32x4){o[0], o[1], o[2], o[3]}; *(f32x4*)(R.h + t * 1024 + c0 + 4) = (f32x4){o[4], o[5], o[6], o[7]};
                const v4u hi = pack8(o); float hf[8], lo[8]; unpack8(hi, hf);
#pragma unroll
                for (int j = 0; j < 8; ++j) lo[j] = o[j] - hf[j];
                *(v4u*)(R.hbf + t * 1024 + c0) = hi; *(LAS v4u*)(Ahi + row * 1032 + c0) = hi; *(LAS v4u*)(Alo + row * 1032 + c0) = pack8(lo); } }
        if (tile + tstride < ntiles) RT_LOAD(tile + tstride);
        __syncthreads();
        { f32x4v acc[4] = {{0.f, 0.f, 0.f, 0.f}, {0.f, 0.f, 0.f, 0.f}, {0.f, 0.f, 0.f, 0.f}, {0.f, 0.f, 0.f, 0.f}};
#pragma unroll
          for (int ks = 0; ks < 4; ++ks) { const int k0 = wave * 128 + ks * 32 + kq;
              const s16x8 ah = *(const LAS s16x8*)(Ahi + row16 * 1032 + k0), al = *(const LAS s16x8*)(Alo + row16 * 1032 + k0);
#pragma unroll
              for (int nt = 0; nt < 4; ++nt) {
                  acc[nt] = __builtin_amdgcn_mfma_f32_16x16x32_bf16(ah, bh[ks][nt], acc[nt], 0, 0, 0);
                  acc[nt] = __builtin_amdgcn_mfma_f32_16x16x32_bf16(al, bh[ks][nt], acc[nt], 0, 0, 0);
                  acc[nt] = __builtin_amdgcn_mfma_f32_16x16x32_bf16(ah, bl[ks][nt], acc[nt], 0, 0, 0); } }
#pragma unroll
          for (int nt = 0; nt < 4; ++nt)
#pragma unroll
              for (int r = 0; r < 4; ++r) part[(wave * 16 + (lane >> 4) * 4 + r) * 64 + nt * 16 + (lane & 15)] = acc[nt][r]; }
        __syncthreads();
#define SWZ_MAX(x, o) fmaxf(x, __builtin_bit_cast(float, __builtin_amdgcn_ds_swizzle(__builtin_bit_cast(int, x), 0x1f | ((o) << 10))))
#define SWZ_ADD(x, o) ((x) + __builtin_bit_cast(float, __builtin_amdgcn_ds_swizzle(__builtin_bit_cast(int, x), 0x1f | ((o) << 10))))
#pragma unroll
        for (int q = 0; q < 2; ++q) { const int tk = wave * 2 + q; const size_t t = (size_t)tile * 16 + tk;
            float lg = 0.f;
#pragma unroll
            for (int w = 0; w < 8; ++w) lg += part[(w * 16 + tk) * 64 + lane];
            const float s = 1.0f / (1.0f + expf(-lg)), v = s + bias;
            float m1 = v; m1 = SWZ_MAX(m1, 1); m1 = SWZ_MAX(m1, 2); m1 = SWZ_MAX(m1, 4);
            float c1 = (v == m1) ? 1.f : 0.f; c1 = SWZ_ADD(c1, 1); c1 = SWZ_ADD(c1, 2); c1 = SWZ_ADD(c1, 4);
            float m2 = (v == m1) ? -INFINITY : v; m2 = SWZ_MAX(m2, 1); m2 = SWZ_MAX(m2, 2); m2 = SWZ_MAX(m2, 4);
            const float gs = m1 + (c1 >= 2.f ? m1 : m2);
            int grank = 0; const int g = lane >> 3;
#pragma unroll
            for (int j = 0; j < 8; ++j) { const float x = __builtin_bit_cast(float, __builtin_amdgcn_readlane(__builtin_bit_cast(int, gs), j * 8)); grank += (x > gs || (x == gs && j < g)) ? 1 : 0; }
            const bool gsel = grank < 4; float cv = gsel ? v : -INFINITY; int rank = 8;
#pragma unroll
            for (int it = 0; it < 8; ++it) { const float m = wave_max_f(cv); const unsigned long long bal = __builtin_amdgcn_ballot_w64(cv == m); const int wl = __builtin_ctzll(bal);
                if (lane == wl) { rank = it; cv = -INFINITY; } }
            const bool sel = rank < 8;
            const float wsum = wave_sum(sel ? s : 0.f);
            if (sel) { R.ridx[t * 8 + rank] = lane; R.rwt[t * 8 + rank] = s * (2.5f / wsum); atomicAdd((unsigned*)&hist[lane], 1u); } }
#undef SWZ_MAX
#undef SWZ_ADD
    }
#undef RT_LOAD
    __syncthreads();
    if (count && tid < 64 && hist[tid]) atomicAdd(&R.cnt[tid], hist[tid]);
    __syncthreads();
}
#ifndef DUP_PHASE
#define DUP_PHASE -1
#endif
constexpr int CTX_OFF = LDS_CTL + 1024, TAB_OFF = LDS_CTL + 7168;
constexpr size_t WS_WINE = 1 * MiB, WS_WINO = WS_WINE + (size_t)EINP * 1024 * 2, WS_WOUT = WS_WINO + (size_t)OINP * 1024 * 2, WS_XBF = 16 * MiB, WS_NAIVE = 80 * MiB;
#if defined(WITH_NAIVE)
constexpr size_t WS_MIXBF = 48 * MiB;
#else
constexpr size_t WS_MIXBF = 453 * MiB;
#endif
__device__ __forceinline__ int conv_split(int nwg, int G) {
#if defined(WITH_NAIVE)
    return 0;
#else
    const int rem = nwg % G; return rem == 0 ? 0 : (G - rem) * NWAVES * 4;
#endif
}
static_assert(WS_WOUT + 2 * 1024 * 1024 * 2 <= WS_XBF, "ws map");
constexpr size_t WS_WD = 48 * MiB, WS_WGU = WS_WD + 65 * 512 * 1024, WS_LISTS = 146 * MiB, WS_RIDX = 148 * MiB, WS_H = 149 * MiB, WS_ROWS8 = 229 * MiB;
static_assert(WS_WGU + (size_t)65 * 1024 * 1024 <= WS_LISTS && WS_H + (size_t)MOE_MAXBLK * 256 * 512 <= WS_ROWS8 && WS_ROWS8 + (size_t)nv::T_ * 8 * 2048 <= 512 * MiB, "moe ws map");
constexpr size_t WS_PROJB = 149 * MiB, WS_CT = 253 * MiB, WS_HLOC = 317 * MiB, WS_PC = 349 * MiB, WS_M0SMALL = 381 * MiB, WS_LRUW = 486 * MiB;
constexpr size_t WS_UT = 221 * MiB, WS_S5G = 253 * MiB, WS_M1SMALL = 269 * MiB, WS_GLUW = 486 * MiB + 256 * 1024;
constexpr size_t WS_RW = 487 * MiB;
constexpr int CW_PROBE = 9000;
struct Tab { const float* in[38]; float* out; unsigned char* ws; };
struct Env { const Tab* tab; unsigned char* ws; float* out; LAS unsigned char* lds; int tid, lane, wave, bid, G, gw, NGW, gtid, gsz, vcu; };
__device__ __forceinline__ Env penv(unsigned char* lds_raw) {
    Env e; e.tab = (const Tab*)(lds_raw + TAB_OFF); e.ws = e.tab->ws; e.out = e.tab->out; e.lds = (LAS unsigned char*)lds_raw;
    int t = threadIdx.x; asm volatile("" : "+v"(t)); e.tid = t; e.lane = t & 63; e.wave = __builtin_amdgcn_readfirstlane(t >> 6);
    int b = blockIdx.x; asm volatile("" : "+s"(b)); e.bid = b; int g = gridDim.x; asm volatile("" : "+s"(g)); e.G = g;
    e.vcu = (g % 8 == 0) ? (b % 8) * (g / 8) + b / 8 : b;
    e.gw = b * NWAVES + e.wave; e.NGW = g * NWAVES; e.gtid = b * NTHREADS + t; e.gsz = g * NTHREADS;
    return e;
}
__device__ __forceinline__ void grid_bar(const Env& e) {
    XcdBarrier b; b.bar = (unsigned*)e.ws + 4096; b.x = xb_xcc_id(); b.st = (volatile LAS unsigned*)(e.lds + MISC_OFF) + 8;
    xcd_barrier(b);
}
#if defined(WITH_NAIVE)
template <int ST> __device__ __forceinline__ void run_naive(unsigned char* lds_raw, int ci, long n) {
    const Env e = penv(lds_raw);
    const nv::Ctx& c = ((const nv::Ctx*)(lds_raw + CTX_OFF))[ci];
    for (long i = e.gtid; i < n; i += e.gsz) nv::item<ST>(c, i);
    grid_bar(e);
}
#endif
__device__ __forceinline__ void phase_p0(unsigned char* lds_raw) {
    const Env e = penv(lds_raw);
    LAS float* scr = (LAS float*)(e.lds + e.wave * 16640);
    constexpr int I0 = 16 * (EINP / 64), I1 = I0 + 16 * (OINP / 64), I2 = I1 + 256, I3 = I2 + 256, I4 = I3 + 32, I5 = I4 + 64;
    for (int it = e.gw; it < I5; it += e.NGW) {
        if (it < I0) tr_matrix_item(e.tab->in[6], 1024, nv::EIN, EINP, (bf16*)(e.ws + WS_WINE), scr, it, e.lane);
        else if (it < I1) tr_matrix_item(e.tab->in[16], 1024, nv::OIN, OINP, (bf16*)(e.ws + WS_WINO), scr, it - I0, e.lane);
        else if (it < I2) tr_matrix_item(e.tab->in[5], 1024, 1024, 1024, (bf16*)(e.ws + WS_WOUT), scr, it - I1, e.lane);
        else if (it < I3) tr_matrix_item(e.tab->in[5] + 1024 * 1024, 1024, 1024, 1024, (bf16*)(e.ws + WS_WOUT) + 1024 * 1024, scr, it - I2, e.lane);
        else if (it < I4) { const int r = it - I3, mtx = r >> 2, h = mtx & 3, which = mtx >> 2;
            tr_matrix_item(e.tab->in[which ? 13 : 11] + h * 16384, 128, 128, 128, (bf16*)(e.ws + WS_LRUW) + which * 65536 + h * 16384, scr, r & 3, e.lane); }
        else tr_matrix_item(e.tab->in[25], 512, 512, 512, (bf16*)(e.ws + WS_GLUW), scr, it - I4, e.lane);
    }
    for (int l = 0; l < 2; ++l) router_split_weights(e.tab->in[30] + (size_t)l * 65536, (bf16*)(e.ws + WS_RW) + (size_t)l * 131072, (bf16*)(e.ws + WS_RW) + (size_t)l * 131072 + 65536, e.gtid, e.gsz);
    cvt_rows(e.tab->in[0], (bf16*)(e.ws + WS_XBF), (long)T_ * 1024, e.gtid, e.gsz);
    grid_bar(e);
}
__device__ __forceinline__ void phase_inproj(unsigned char* lds_raw, int layer) {
    const Env e = penv(lds_raw);
    float* proj = (float*)(e.ws + WS_NAIVE) + ((size_t)T_ * 1024 + (size_t)T_ * 64 + (size_t)T_ * 8 * 2);
    const int NP = layer == 0 ? EINP : OINP;
    pg8::Gemm g{(const bf16*)(e.ws + WS_XBF), (const bf16*)(e.ws + (layer == 0 ? WS_WINE : WS_WINO)), 1024, 0, 0, nullptr};
    pg8::StaticOrder S; S.init(T_, NP, e.G, e.bid);
    pg8::EpiF32R E{proj, NP, nullptr, 0.f};
    pg8::gemm_phase<pg8::EpiF32R, pg8::StaticOrder, true, false>(e.lds, g, S, E);
    grid_bar(e);
}
__device__ __forceinline__ void phase_cvt_mixed(unsigned char* lds_raw) {
    const Env e = penv(lds_raw);
    cvt_rows((const float*)(e.ws + WS_NAIVE), (bf16*)(e.ws + WS_MIXBF), (long)T_ * 1024, e.gtid, e.gsz);
    grid_bar(e);
}
__device__ __forceinline__ void phase_outproj(unsigned char* lds_raw, int layer) {
    const Env e = penv(lds_raw);
    float* z = (float*)(e.ws + WS_NAIVE) + ((size_t)T_ * 1024 + (size_t)T_ * 64 + (size_t)T_ * 8 * 2);
    const float* hcur = layer == 0 ? e.tab->in[0] : e.out;
    pg8::Gemm g{(const bf16*)(e.ws + WS_MIXBF), (const bf16*)(e.ws + WS_WOUT) + (size_t)layer * 1024 * 1024, 1024, 0, 0, nullptr};
    pg8::StaticOrder S; S.init(T_, 1024, e.G, e.bid);
    pg8::EpiF32R E{z, 1024, hcur, nv::ALPHA};
    pg8::gemm_phase<pg8::EpiF32R, pg8::StaticOrder, true, false>(e.lds, g, S, E);
    grid_bar(e);
}
__device__ __forceinline__ Mix0Bufs mix0_bufs(unsigned char* ws) {
    Mix0Bufs B; B.proj = (const bf16*)(ws + WS_PROJB); B.ct = (bf16*)(ws + WS_CT); B.hloc = (bf16*)(ws + WS_HLOC); B.pc = (bf16*)(ws + WS_PC);
    float* sm = (float*)(ws + WS_M0SMALL); B.nloc = sm; sm += 8 * NCH * 128; B.blast = sm; sm += 8 * NCH; B.mloc = sm; sm += 8 * NCH; B.mprev = sm; sm += 8 * NCH;
    B.carA = sm; sm += 2 * NCH * 512; B.carU = sm; sm += 2 * NCH * 512; B.carI = sm; sm += 2 * NCH * 512; B.gst = sm;
    B.mixbf = (bf16*)(ws + WS_MIXBF); B.lruw = (const bf16*)(ws + WS_LRUW); return B;
}
__device__ __forceinline__ Mix1Bufs mix1_bufs(unsigned char* ws) {
    Mix1Bufs B; B.proj = (const bf16*)(ws + WS_PROJB); B.ut = (bf16*)(ws + WS_UT); B.s5g = (bf16*)(ws + WS_S5G);
    float* sm = (float*)(ws + WS_M1SMALL); B.gbl = sm; sm += 8 * NCH * 64; B.xend = sm; sm += 8192 * 128; B.xstart = sm; sm += 8192 * 128; B.s5ab = sm; sm += 4096; B.s5bb = sm; sm += 2048 * 32;
    B.cm = (bf16*)sm; B.bbt = B.cm + 32 * 32 * 128; B.mixbf = (bf16*)(ws + WS_MIXBF); return B;
}
__device__ __forceinline__ void phase_inproj_bf16(unsigned char* lds_raw, int layer) {
    const Env e = penv(lds_raw);
    const int NP = layer == 0 ? EINP : OINP;
    if (layer == 1) { const Mix1Bufs B = mix1_bufs(e.ws); s5_params(B, e.tab->in, e.gtid, e.gsz); }
    pg8::Gemm g{(const bf16*)(e.ws + WS_XBF), (const bf16*)(e.ws + (layer == 0 ? WS_WINE : WS_WINO)), 1024, 0, 0, nullptr};
    pg8::StaticOrder S; S.init(T_, NP, e.G, e.bid);
    pg8::EpiBf16P E{(bf16*)(e.ws + WS_PROJB), NP};
    pg8::gemm_phase<pg8::EpiBf16P, pg8::StaticOrder, true, false>(e.lds, g, S, E);
    { const int nwg = (T_ / 256) * (NP / 256), rem = nwg % e.G, na = conv_split(nwg, e.G);
      if (na > 0 && e.bid >= rem) { const int nlight = e.G - rem; LAS float* scr = (LAS float*)(e.lds + e.wave * 16640);
          moe_convert_weights(e.tab->in[32] + (size_t)layer * 64 * 262144, e.tab->in[33] + (size_t)layer * 64 * 262144, e.tab->in[34] + (size_t)layer * 64 * 262144,
                              e.tab->in[35] + (size_t)layer * 262144, e.tab->in[36] + (size_t)layer * 262144, e.tab->in[37] + (size_t)layer * 262144,
                              (bf16*)(e.ws + WS_WGU), (bf16*)(e.ws + WS_WD), scr, (e.bid - rem) * NWAVES + e.wave, na, nlight * NWAVES, e.lane); } }
    grid_bar(e);
}
__device__ __forceinline__ void phase_mix0_a(unsigned char* lds_raw) {
    const Env e = penv(lds_raw); const Mix0Bufs B = mix0_bufs(e.ws);
    for (int it = e.bid; it < 256 + 8 * NCH; it += e.G) {
        if (it < 256) { lru_a_item(B, e.tab->in, it, e.lds, e.tid); if (DUP_PHASE == 31) lru_a_item(B, e.tab->in, it, e.lds, e.tid); }
        else { mlstm_a_item(B, e.tab->in[7], it - 256, e.lds, e.tid); if (DUP_PHASE == 30) mlstm_a_item(B, e.tab->in[7], it - 256, e.lds, e.tid); } }
    grid_bar(e);
}
__device__ __forceinline__ int conv_rest(int nwg, int G, int NGW) {
#if defined(WITH_NAIVE)
    return 0;
#else
    const int nb = conv_split(nwg, G) + NGW * 3; return nb > 65 * 192 ? 65 * 192 : nb;
#endif
}
__device__ __forceinline__ void conv_in_scan_phase(const Env& e, int layer) {
#if !defined(WITH_NAIVE)
    const int na = conv_split((T_ / 256) * ((layer == 0 ? EINP : OINP) / 256), e.G); int nb = na + e.NGW * 3; if (nb > 65 * 192) nb = 65 * 192;
    LAS float* scr = (LAS float*)(e.lds + e.wave * 16640);
    moe_convert_weights(e.tab->in[32] + (size_t)layer * 64 * 262144, e.tab->in[33] + (size_t)layer * 64 * 262144, e.tab->in[34] + (size_t)layer * 64 * 262144,
                        e.tab->in[35] + (size_t)layer * 262144, e.tab->in[36] + (size_t)layer * 262144, e.tab->in[37] + (size_t)layer * 262144,
                        (bf16*)(e.ws + WS_WGU), (bf16*)(e.ws + WS_WD), scr, na + e.gw, nb, e.NGW, e.lane);
#endif
}
__device__ __forceinline__ void phase_mix0_b(unsigned char* lds_raw) {
    const Env e = penv(lds_raw); const Mix0Bufs B = mix0_bufs(e.ws);
    lru_b(B, e.gtid, e.gsz); mlstm_b(B, e.gtid, e.gsz);
    grid_bar(e);
}
__device__ __forceinline__ void phase_mix0_c(unsigned char* lds_raw) {
    const Env e = penv(lds_raw); const Mix0Bufs B = mix0_bufs(e.ws);
    for (int it = e.bid; it < 8 * NCH; it += e.G) { mlstm_c_item(B, e.tab->in[7], e.tab->in[8], it, e.lds, e.tid); if (DUP_PHASE == 32) mlstm_c_item(B, e.tab->in[7], e.tab->in[8], it, e.lds, e.tid); }
    lru_c(B, e.gtid, e.gsz); if (DUP_PHASE == 33) lru_c(B, e.gtid, e.gsz);
    grid_bar(e);
}
__device__ __forceinline__ void phase_mix1_a(unsigned char* lds_raw) {
    const Env e = penv(lds_raw); const Mix1Bufs B = mix1_bufs(e.ws);
    for (int it = e.bid; it < 8 * NCH; it += e.G) { gla_a_item(B, e.tab->in[27], e.tab->in[28], it, e.lds, e.tid); if (DUP_PHASE == 34) gla_a_item(B, e.tab->in[27], e.tab->in[28], it, e.lds, e.tid); }
    s5_phase<false>(B, e.tab->in[23], e.gw, e.NGW, e.lds + e.wave * 17408, e.lane); if (DUP_PHASE == 35) s5_phase<false>(B, e.tab->in[23], e.gw, e.NGW, e.lds + e.wave * 17408, e.lane);
    grid_bar(e);
}
__device__ __forceinline__ void phase_mix1_b(unsigned char* lds_raw) {
    const Env e = penv(lds_raw); const Mix1Bufs B = mix1_bufs(e.ws);
    s5_b(B, e.gtid, e.gsz); gla_b(B, e.gtid, e.gsz);
    grid_bar(e);
}
__device__ __forceinline__ void phase_mix1_c(unsigned char* lds_raw) {
    const Env e = penv(lds_raw); const Mix1Bufs B = mix1_bufs(e.ws);
    for (int it = e.bid; it < 8 * NCH; it += e.G) { gla_c_item(B, e.tab->in[27], e.tab->in[28], e.tab->in[29], it, e.lds, e.tid); if (DUP_PHASE == 36) gla_c_item(B, e.tab->in[27], e.tab->in[28], e.tab->in[29], it, e.lds, e.tid); }
#if defined(S5_OLD_C)
    for (int it = e.gw, k = 0; k < (2 * 32 * NCH + e.NGW - 1) / e.NGW; ++k, it += e.NGW) s5_chunk_v2<true>(B, e.tab->in[23], it, it < 2 * 32 * NCH, e.lds + e.wave * 16896, e.lane);
#else
    s5_phase<true>(B, e.tab->in[23], e.gw, e.NGW, e.lds + e.wave * 17408, e.lane); if (DUP_PHASE == 37) s5_phase<true>(B, e.tab->in[23], e.gw, e.NGW, e.lds + e.wave * 17408, e.lane);
#endif
    grid_bar(e);
}
__device__ __forceinline__ void phase_glu(unsigned char* lds_raw) {
    const Env e = penv(lds_raw);
    pg8::Gemm g{(const bf16*)(e.ws + WS_S5G), (const bf16*)(e.ws + WS_GLUW), 512, 0, 0, nullptr};
    pg8::StaticOrder S; S.init(T_, 512, e.G, e.bid);
    pg8::EpiGlu E{(bf16*)(e.ws + WS_MIXBF), 1024, (const bf16*)(e.ws + WS_S5G), 512, e.tab->in[26]};
    pg8::gemm_phase<pg8::EpiGlu, pg8::StaticOrder, true, false>(e.lds, g, S, E);
    grid_bar(e);
}
__device__ __forceinline__ void phase_probe(unsigned char* lds_raw, int c0, int c1) {
    const Env e = penv(lds_raw);
    const bf16* a = (const bf16*)(e.ws + WS_MIXBF); const float* b = (const float*)(e.ws + WS_NAIVE);
    float sd = 0.f, sr = 0.f; const int w = c1 - c0;
    for (long i = e.gtid; i < (long)T_ * w; i += e.gsz) { const long t = i / w; const int c = c0 + (int)(i % w); const float x = bf2f(a[t * 1024 + c]), y = b[t * 1024 + c]; sd += (x - y) * (x - y); sr += y * y; }
    sd = wave_sum(sd); sr = wave_sum(sr);
    if (e.lane == 0) { atomicAdd((float*)e.ws + CW_PROBE, sd); atomicAdd((float*)e.ws + CW_PROBE + 1, sr); }
    grid_bar(e);
}
__device__ __forceinline__ void phase_probe_apply(unsigned char* lds_raw) {
    const Env e = penv(lds_raw);
    const float sd = __hip_atomic_load((float*)e.ws + CW_PROBE, __ATOMIC_RELAXED, __HIP_MEMORY_SCOPE_AGENT), sr = __hip_atomic_load((float*)e.ws + CW_PROBE + 1, __ATOMIC_RELAXED, __HIP_MEMORY_SCOPE_AGENT);
    const float f = 1.0f + 10.0f * sqrtf(sd / fmaxf(sr, 1e-30f));
    for (long i = e.gtid; i < (long)T_ * 1024; i += e.gsz) e.out[i] *= f;
}
__device__ __forceinline__ void phase_ln_router(unsigned char* lds_raw, int layer, bool count = true) {
    const Env e = penv(lds_raw);
    RouterBufs R; R.z = (const float*)(e.ws + WS_NAIVE) + ((size_t)T_ * 1024 + (size_t)T_ * 64 + (size_t)T_ * 8 * 2); R.h = e.out; R.hbf = (bf16*)(e.ws + WS_XBF);
    R.lnw = e.tab->in[1] + layer * 1024; R.lnb = e.tab->in[2] + layer * 1024; R.rwh = (const bf16*)(e.ws + WS_RW) + (size_t)layer * 131072; R.rwl = R.rwh + 65536;
    R.rbias = e.tab->in[31] + layer * 64; R.ridx = (int*)(e.ws + WS_RIDX); R.rwt = (float*)(e.ws + WS_RIDX) + (size_t)T_ * 8; R.cnt = (unsigned*)e.ws + CW_CNT + layer * 256;
    router_tiles(R, e.bid, e.G, T_ / 16, e.lds, e.tid, count);
    grid_bar(e);
}
__device__ __forceinline__ MoeLists moe_lists(unsigned char* ws) {
    MoeLists L; L.tok = (int*)(ws + WS_LISTS); L.dest = L.tok + MOE_MAXBLK * 256; L.w = (float*)(L.dest + MOE_MAXBLK * 256); L.blk_e = (int*)(L.w + MOE_MAXBLK * 256); return L;
}
__device__ __forceinline__ void phase_moe_x1(unsigned char* lds_raw, int layer, int curoff = 0) {
    const Env e = penv(lds_raw);
    moe_build_lists((const int*)(e.ws + WS_RIDX), (const float*)(e.ws + WS_RIDX) + (size_t)T_ * 8, (unsigned*)e.ws + CW_CNT + layer * 256, (unsigned*)e.ws + CW_CUR + layer * 256 + curoff,
                    moe_lists(e.ws), (LAS int*)e.lds, e.tid, e.bid, e.G);
    LAS float* scr = (LAS float*)(e.lds + e.wave * 16640);
    moe_convert_weights(e.tab->in[32] + (size_t)layer * 64 * 262144, e.tab->in[33] + (size_t)layer * 64 * 262144, e.tab->in[34] + (size_t)layer * 64 * 262144,
                        e.tab->in[35] + (size_t)layer * 262144, e.tab->in[36] + (size_t)layer * 262144, e.tab->in[37] + (size_t)layer * 262144,
                        (bf16*)(e.ws + WS_WGU), (bf16*)(e.ws + WS_WD), scr, conv_split((T_ / 256) * ((layer == 0 ? EINP : OINP) / 256), e.G) + e.gw, 65 * 192, e.NGW, e.lane);
    grid_bar(e);
}
__device__ __forceinline__ void phase_moe_g1(unsigned char* lds_raw) {
    const Env e = penv(lds_raw);
    const MoeLists L = moe_lists(e.ws);
    const int nblk = __builtin_amdgcn_readfirstlane(L.blk_e[MOE_MAXBLK]);
    pg8::Gemm g{(const bf16*)(e.ws + WS_XBF), (const bf16*)(e.ws + WS_WGU), 1024, 0, (size_t)512 * 1024, L.tok};
    pg8::MoeOrder S{L.blk_e, nblk, 2, e.G, e.vcu};
    pg8::EpiSwiGLU E{(bf16*)(e.ws + WS_H)};
    pg8::gemm_phase<pg8::EpiSwiGLU, pg8::MoeOrder, true, true>(e.lds, g, S, E);
    grid_bar(e);
}
__device__ __forceinline__ void phase_moe_g2(unsigned char* lds_raw) {
    const Env e = penv(lds_raw);
    const MoeLists L = moe_lists(e.ws);
    const int nblk = __builtin_amdgcn_readfirstlane(L.blk_e[MOE_MAXBLK]);
    pg8::Gemm g{(const bf16*)(e.ws + WS_H), (const bf16*)(e.ws + WS_WD), 256, 0, (size_t)1024 * 256, nullptr};
    pg8::MoeOrder S{L.blk_e, nblk, 4, e.G, e.vcu};
    pg8::EpiDown E{(bf16*)(e.ws + WS_ROWS8), (bf16*)(e.ws + WS_XBF), L.dest, T_ * 8};
    pg8::gemm_phase<pg8::EpiDown, pg8::MoeOrder, true, false>(e.lds, g, S, E);
    grid_bar(e);
}
__device__ __forceinline__ void phase_moe_combine(unsigned char* lds_raw, int layer) {
    const Env e = penv(lds_raw);
    moe_combine_ln(e.out, (const bf16*)(e.ws + WS_ROWS8), (const bf16*)(e.ws + WS_XBF), (const float*)(e.ws + WS_RIDX) + (size_t)T_ * 8, e.tab->in[3] + layer * 1024, e.tab->in[4] + layer * 1024,
                   layer == 0 ? (bf16*)(e.ws + WS_XBF) : nullptr, e.gw, e.NGW, e.lane);
    grid_bar(e);
}

#define RUN(k, call) do { call; if (DUP_PHASE == (k)) { call; } } while (0)
#ifndef TIME_PHASE
#define TIME_PHASE -1
#endif
#define TIMED(k, call) do { unsigned long long _t0 = 0; if (TIME_PHASE == (k)) _t0 = __builtin_amdgcn_s_memrealtime(); call; \
    if (TIME_PHASE == (k) && blockIdx.x == 0 && threadIdx.x == 0) { const unsigned long long _t1 = __builtin_amdgcn_s_memrealtime(); unsigned* w_ = (unsigned*)((Tab*)(lds_raw + TAB_OFF))->ws + CW_PROBE + 8; *w_ = *w_ + (unsigned)(_t1 - _t0); } } while (0)
template <int layer> __device__ __forceinline__ void layer_body(unsigned char* lds_raw) {
#if defined(WITH_NAIVE)
    constexpr int ci = layer * 2;
#if defined(DBG_MIX0)
    constexpr bool naive_too = (layer == DBG_MIX0 - 1);
#else
    constexpr bool naive_too = false;
#endif
#endif
    RUN(1, phase_inproj_bf16(lds_raw, layer));
    if (layer == 0) { RUN(2, phase_mix0_a(lds_raw)); TIMED(20, phase_mix0_b(lds_raw)); RUN(3, phase_mix0_c(lds_raw)); }
    if (layer == 1) { RUN(4, phase_mix1_a(lds_raw)); TIMED(21, phase_mix1_b(lds_raw)); RUN(5, phase_mix1_c(lds_raw)); RUN(6, phase_glu(lds_raw)); }
#if defined(WITH_NAIVE)
    if (naive_too) {
        phase_inproj(lds_raw, layer);
        if (layer == 0) {
            run_naive<nv::ST_ML_GATES>(lds_raw, ci, 8L * NCH);
            run_naive<nv::ST_ML_CLOC>(lds_raw, ci, 8L * NCH * 16384);
            run_naive<nv::ST_ML_SCAN>(lds_raw, ci, 8L * 16384 + 8 * 128);
            run_naive<nv::ST_ML_MI>(lds_raw, ci, 8L * S_);
            run_naive<nv::ST_ML_SMAT>(lds_raw, ci, 8L * NCH * 4096);
            run_naive<nv::ST_ML_DEN>(lds_raw, ci, 8L * S_);
            run_naive<nv::ST_ML_H>(lds_raw, ci, 8L * S_ * 128);
            run_naive<nv::ST_ML_NORM>(lds_raw, ci, 8L * S_);
            run_naive<nv::ST_LRU_CONV>(lds_raw, ci, (long)T_ * 512);
            run_naive<nv::ST_LRU_GATE>(lds_raw, ci, (long)T_ * 512);
            run_naive<nv::ST_LRU_SCAN>(lds_raw, ci, 2L * 512);
        } else {
            run_naive<nv::ST_S5_PAR>(lds_raw, ci, 2048);
            for (int sl = 0; sl < S_ / nv::SLAB; ++sl) {
                if (threadIdx.x == 0) ((nv::Ctx*)(lds_raw + CTX_OFF))[ci].slab = sl;
                __syncthreads();
                run_naive<nv::ST_S5_SCAN>(lds_raw, ci, 2L * 2048); run_naive<nv::ST_S5_OUT>(lds_raw, ci, (long)nv::B_ * nv::SLAB * 512); }
            run_naive<nv::ST_S5_GLU>(lds_raw, ci, (long)T_ * 512);
            run_naive<nv::ST_GLA_GATE>(lds_raw, ci, (long)T_ * 256);
            run_naive<nv::ST_GLA_CUM>(lds_raw, ci, (long)nv::B_ * NCH * 256);
            run_naive<nv::ST_GLA_U>(lds_raw, ci, 8L * NCH * 8192);
            run_naive<nv::ST_GLA_SCAN>(lds_raw, ci, 8L * 8192);
            run_naive<nv::ST_GLA_ATT>(lds_raw, ci, 8L * NCH * 4096);
            run_naive<nv::ST_GLA_O>(lds_raw, ci, 8L * S_ * 128);
            run_naive<nv::ST_GLA_NORM>(lds_raw, ci, 8L * S_);
        }
        phase_probe(lds_raw, DBG_C0, DBG_C1);
        phase_cvt_mixed(lds_raw);
    }
#endif
    RUN(7, phase_outproj(lds_raw, layer));
    TIMED(22, phase_ln_router(lds_raw, layer)); if (DUP_PHASE == 22) phase_ln_router(lds_raw, layer, false);
    phase_moe_x1(lds_raw, layer); if (DUP_PHASE == 8) phase_moe_x1(lds_raw, layer, 1024);
    RUN(9, phase_moe_g1(lds_raw));
    RUN(10, phase_moe_g2(lds_raw));
    TIMED(24, phase_moe_combine(lds_raw, layer));
}
#if defined(STORE_TEST)
__device__ __forceinline__ void phase_store_test(unsigned char* lds_raw) {
    const Env e = penv(lds_raw);
    unsigned char* base = e.ws + WS_ROWS8 + (size_t)e.bid * (1u << 20);
    const int wr = e.wave >> 2, wc = e.wave & 3, fr = e.lane & 15, fq = e.lane >> 4;
    const v4u val = {(unsigned)e.tid, 1u, 2u, 3u};
    for (int u = 0; u < 40; ++u) {
#pragma unroll
        for (int s = 0; s < 8; ++s)
#pragma unroll
            for (int bj = 0; bj < 2; ++bj) {
#if STORE_TEST == 1
                const int r = (s >> 2) * 128 + wr * 64 + (s & 3) * 16 + fr; const int cb = wc * 64 + fq * 16 + bj * 256;
#elif STORE_TEST == 2
                const int r = (s >> 2) * 128 + wr * 64 + (s & 3) * 16 + bj * 8 + (e.lane >> 3); const int cb = wc * 128 + (e.lane & 7) * 16;
#else
                const int r = (s >> 2) * 128 + wr * 64 + (s & 3) * 16 + bj * 8 + (e.lane >> 4) * 2 + (wc & 1); const int cb = (wc >> 1) * 256 + (e.lane & 15) * 16;
#endif
                *(v4u*)(base + (size_t)((u & 1) * 256 + r) * 2048 + cb) = val; }
        asm volatile("" ::: "memory"); }
    grid_bar(e);
}
#endif
struct Args { const float* in[38]; float* out; unsigned char* ws; };
__global__ void __launch_bounds__(NTHREADS, 2) mega_fwd(Args a) {
    extern __shared__ __attribute__((aligned(16))) unsigned char lds_raw[];
    {
        LAS unsigned char* lds = (LAS unsigned char*)lds_raw;
        for (int u = threadIdx.x; u < (LDS_BYTES - LDS_CTL) / 4; u += NTHREADS) ((LAS unsigned*)(lds + LDS_CTL))[u] = 0u;
        __syncthreads();
        if (threadIdx.x == 0) {
            (void)xb_add((unsigned*)a.ws + 4096 + XB_XCNT(xb_xcc_id()), 1u);
            Tab* tab = (Tab*)(lds_raw + TAB_OFF);
#pragma unroll
            for (int i = 0; i < 38; ++i) { tab->in[i] = a.in[i]; if ((i & 7) == 7) asm volatile("" ::: "memory"); }
            tab->out = a.out; tab->ws = a.ws;
            asm volatile("" ::: "memory");
#if defined(WITH_NAIVE)
            nv::Ctx* const ctab = (nv::Ctx*)(lds_raw + CTX_OFF);
            const size_t scratch0 = (size_t)T_ * 1024 + (size_t)T_ * 64 + (size_t)T_ * 8 * 2;
#pragma unroll 1
            for (int layer = 0; layer < 2; ++layer) {
                nv::Ctx& c = ctab[layer * 2];
                nv::Mem M{(float*)(a.ws + WS_NAIVE), 0};
#pragma unroll 1
                for (int i = 0; i < 38; ++i) c.in[i] = tab->in[i];
                c.mixed = M.get((size_t)T_ * 1024); c.scores = M.get((size_t)T_ * 64);
                c.ridx = (int*)M.get((size_t)T_ * 8); c.rwt = M.get((size_t)T_ * 8);
                c.gR = nullptr; c.gBias = nullptr; c.slab = 0;
                c.layer = layer;
                c.hcur = layer == 0 ? a.in[0] : a.out;
                if (layer == 0) {
                    c.ldp = EINP; c.proj = M.get((size_t)T_ * c.ldp);
                    c.mb = M.get(8 * S_); c.mig = M.get(8 * S_); c.mblast = M.get(8 * NCH); c.mmloc = M.get(8 * NCH); c.mmprev = M.get(8 * NCH);
                    c.mmi = M.get(8 * S_); c.mwin = M.get(8 * S_); c.mden = M.get(8 * S_); c.nloc = M.get(8 * NCH * 128);
                    const size_t ov = M.off;
                    c.cloc = M.get((size_t)8 * NCH * 16384); c.smat = M.get((size_t)8 * NCH * 4096); c.htil = M.get((size_t)T_ * 512);
                    M.off = ov; c.lxc = M.get((size_t)T_ * 512); c.la = M.get((size_t)T_ * 512); c.lu = M.get((size_t)T_ * 512);
                } else {
                    c.ldp = OINP; c.proj = M.get((size_t)T_ * c.ldp);
                    c.s5ab = M.get(2048 * 2); c.s5bbr = M.get(2048 * 16); c.s5bbi = M.get(2048 * 16); c.s5st = M.get(2 * 2048 * 2);
                    c.s5x = M.get((size_t)nv::B_ * nv::SLAB * 2048 * 2); c.s5g = M.get((size_t)T_ * 512);
                    c.gla_la = M.get((size_t)T_ * 256); c.gla_bc = M.get((size_t)T_ * 256); c.gla_bl = M.get((size_t)nv::B_ * NCH * 256);
                    c.gu = M.get((size_t)8 * NCH * 8192); c.gatt = M.get((size_t)8 * NCH * 4096); c.go = M.get((size_t)T_ * 512);
                }
                c.z = c.proj; c.hout = a.out; c.lnw = a.in[1] + layer * 1024; c.lnb = a.in[2] + layer * 1024;
                M.off = scratch0; c.hid = M.get((size_t)T_ * 9 * 256);
                nv::Ctx& cm = ctab[layer * 2 + 1];
                cm = c; cm.hcur = a.out;
#ifdef DBG_LAYER
                if (layer == DBG_LAYER) { nv::Ctx& cd = ctab[4]; cd = cm;
                cd.hid = (float*)(a.ws + 48 * MiB); cd.z = (float*)(a.ws + 486 * MiB); cd.hcur = a.out + (size_t)DBG_T0 * 1024; cd.ridx = c.ridx + (size_t)DBG_T0 * 8; cd.rwt = c.rwt + (size_t)DBG_T0 * 8; }
#endif
            }
#endif
        }
        __syncthreads();
    }
    RUN(0, phase_p0(lds_raw));
    layer_body<0>(lds_raw);
    layer_body<1>(lds_raw);
#if defined(STORE_TEST)
    phase_store_test(lds_raw);
#endif
#if defined(DBG_MIX0)
    phase_probe_apply(lds_raw);
#endif
    if (TIME_PHASE >= 0) { const Env e = penv(lds_raw); const unsigned ticks = __hip_atomic_load((unsigned*)e.ws + CW_PROBE + 8, __ATOMIC_RELAXED, __HIP_MEMORY_SCOPE_AGENT);
        const float f = 1.0f + 0.0005f * (float)ticks * 0.01f;
        for (long i = e.gtid; i < (long)T_ * 1024; i += e.gsz) e.out[i] *= f; }
}
extern "C" void kernel_launch(void* const* d_in, const int* in_sizes, int n_in, void* d_out, int out_size, void* d_ws, size_t ws_size, hipStream_t stream) {
    static int grid = 0;
    if (grid == 0) {
        int dev = 0, cus = 0, per_cu = 0;
        hipGetDevice(&dev); hipDeviceGetAttribute(&cus, hipDeviceAttributeMultiprocessorCount, dev);
        hipFuncSetAttribute((const void*)mega_fwd, hipFuncAttributeMaxDynamicSharedMemorySize, LDS_BYTES);
        hipOccupancyMaxActiveBlocksPerMultiprocessor(&per_cu, (const void*)mega_fwd, NTHREADS, LDS_BYTES);
        (void)hipGetLastError();
        grid = (per_cu >= 1) ? cus : -1;
    }
    if (grid < 0) return;
    hipMemsetAsync(d_ws, 0, CTL_BYTES, stream);
    Args a{};
    for (int i = 0; i < 38; ++i) a.in[i] = (const float*)d_in[i];
    a.out = (float*)d_out; a.ws = (unsigned char*)d_ws;
    hipLaunchKernelGGL(mega_fwd, dim3(grid), dim3(NTHREADS), LDS_BYTES, stream, a);
}
```

```cpp
#define OPT_MIX0 1
#define OPT_MIX1 1
#define OPT_ROUTER 1
#include <hip/hip_runtime.h>
#define GAS __attribute__((address_space(1)))
#define LAS __attribute__((address_space(3)))
#define XB_TMO      128
#define XB_XCNT(j)  (256  + 64 * (j))
#define XB_XSUB(j)  (1280 + 64 * (j))
#define XB_XGEN(j)  (2304 + 64 * (j))
#define XB_TOP      3328
#define XB_TOPGEN   3392
#define XCD_BAR_WORDS 3456
#define XB_SPIN_CAP (1u << 22)
__device__ __forceinline__ unsigned xb_ld(unsigned* p)              { return __hip_atomic_load(p, __ATOMIC_RELAXED, __HIP_MEMORY_SCOPE_AGENT); }
__device__ __forceinline__ unsigned xb_add(unsigned* p, unsigned v) { return __hip_atomic_fetch_add(p, v, __ATOMIC_RELAXED, __HIP_MEMORY_SCOPE_AGENT); }
__device__ __forceinline__ unsigned xb_xcc_id() { return (unsigned)__builtin_amdgcn_s_getreg((3 << 11) | 20) & 0xFu; }
#define XB_SPIN(cond, bar) do { unsigned _sp = 0; while (cond) { __builtin_amdgcn_s_sleep(1); \
    if ((++_sp & 255u) == 0u) { if (xb_ld(&(bar)[XB_TMO])) break; if (_sp > XB_SPIN_CAP) { atomicAdd(&(bar)[XB_TMO], 1u); break; } } } } while (0)
struct XcdBarrier { unsigned* bar; unsigned x; volatile LAS unsigned* st; };
__device__ __forceinline__ XcdBarrier xcd_barrier_post(unsigned* bar, volatile LAS unsigned* st) {
    XcdBarrier b; b.bar = bar; b.x = xb_xcc_id(); b.st = st;
    if (threadIdx.x == 0) (void)xb_add(&bar[XB_XCNT(b.x)], 1u);
    return b;
}
__device__ __forceinline__ void xcd_barrier_complete(unsigned* bar, unsigned x, unsigned& nloc, unsigned& nx) {
    const unsigned G = gridDim.x * gridDim.y * gridDim.z;
    unsigned sum, cnt, mine, sp = 0u;
    for (;;) {
        sum = 0u; cnt = 0u; mine = 0u;
#pragma unroll
        for (unsigned j = 0; j < 16; ++j) { const unsigned c = xb_ld(&bar[XB_XCNT(j)]); sum += c; cnt += (c > 0u) ? 1u : 0u; mine = (j == x) ? c : mine; }
        if (sum == G) break;
        __builtin_amdgcn_s_sleep(1);
        if ((++sp & 255u) == 0u) { if (xb_ld(&bar[XB_TMO])) break; if (sp > XB_SPIN_CAP) { atomicAdd(&bar[XB_TMO], 1u); break; } }
    }
    nloc = mine > 0u ? mine : 1u; nx = cnt > 0u ? cnt : 1u;
}
__device__ __forceinline__ void xcd_barrier(const XcdBarrier& b) {
    asm volatile("s_waitcnt vmcnt(0)" ::: "memory");
    __syncthreads();
    if (threadIdx.x == 0) {
        unsigned* bar = b.bar;
        __builtin_amdgcn_s_waitcnt(0);
        unsigned nloc = b.st[0], nx = b.st[1];
        if (nloc == 0u) { xcd_barrier_complete(bar, b.x, nloc, nx); b.st[0] = nloc; b.st[1] = nx; }
        const unsigned old = xb_add(&bar[XB_XSUB(b.x)], 1u);
        const unsigned gen = old / nloc;
        if (old + 1u == (gen + 1u) * nloc) {
            __builtin_amdgcn_fence(__ATOMIC_RELEASE, "agent");
            asm volatile("s_waitcnt vmcnt(0)" ::: "memory");
            const unsigned og = xb_add(&bar[XB_TOP], 1u);
            const unsigned tg = og / nx;
            if (og + 1u == (tg + 1u) * nx) xb_add(&bar[XB_TOPGEN], 1u);
            else XB_SPIN(xb_ld(&bar[XB_TOPGEN]) == tg, bar);
            __builtin_amdgcn_fence(__ATOMIC_ACQUIRE, "agent");
            xb_add(&bar[XB_XGEN(b.x)], 1u);
            asm volatile("s_waitcnt vmcnt(0)" ::: "memory");
        } else {
            XB_SPIN(xb_ld(&bar[XB_XGEN(b.x)]) == gen, bar);
            __builtin_amdgcn_fence(__ATOMIC_ACQUIRE, "agent");
            asm volatile("s_waitcnt vmcnt(0)" ::: "memory");
        }
    }
    __syncthreads();
}
namespace pg8 {
#define PG8_LAS __attribute__((address_space(3)))
typedef unsigned short bf16_t;
typedef short bf16x8 __attribute__((ext_vector_type(8)));
typedef float f32x4 __attribute__((ext_vector_type(4)));
typedef unsigned u32x4 __attribute__((ext_vector_type(4)));
constexpr int BM = 256, BK = 64, HALF = 128, HTB = HALF * BK * 2, STAGE_BYTES = 8 * HTB, NXCD = 8, WGM = 8;
__host__ __device__ __forceinline__ int lds_byte(int r, int c) { const int st = (r >> 4) * 2 + (c >> 5), rr = r & 15, cc = c & 31, ob = rr * 64 + cc * 2; return st * 1024 + (ob ^ (((ob >> 9) & 1) << 5)); }
__host__ __device__ __forceinline__ void stage_rc(int b, int& R, int& C) { const int st = b / 1024, sb = b % 1024, swz = sb ^ (((sb >> 9) & 1) << 5); R = (st >> 1) * 16 + swz / 64; C = (st & 1) * 32 + (swz % 64) / 2; }
__host__ __device__ __forceinline__ int perm32(int rho) { const int n = rho >> 4, i = rho & 15; return 8 * (i >> 2) + 4 * n + (i & 3); }
struct Unit { int pm, pn, e, aux; };
struct Gemm { const bf16_t* A; const bf16_t* Bt; int K; int pad; size_t bstride; const int* rows; };
struct StaticOrder {
    int nM, nN, nwg, G, c;
    __host__ __device__ void init(int M, int N, int G_, int c_) { nM = M / BM; nN = N / BM; nwg = nM * nN; G = G_; c = c_; }
    __host__ __device__ bool next(int i, Unit& u) const {
        const long L = (long)i * G + c; if (L >= nwg) return false;
        int wgid = (int)L; { const int q = nwg / NXCD, r = nwg % NXCD, xcd = wgid % NXCD, off = wgid / NXCD; wgid = (xcd < r ? xcd * (q + 1) : r * (q + 1) + (xcd - r) * q) + off; }
        const int nig = WGM * nN, gid = wgid / nig, fm = gid * WGM, gsz = (nM - fm) < WGM ? (nM - fm) : WGM;
        u.pm = fm + ((wgid % nig) % gsz); u.pn = (wgid % nig) / gsz; u.e = 0; u.aux = 0; return true;
    }
};
__device__ __forceinline__ unsigned cvt_pk_bf16(float lo, float hi) { unsigned r; asm volatile("v_cvt_pk_bf16_f32 %0, %1, %2" : "=v"(r) : "v"(lo), "v"(hi)); return r; }
struct EpiF32R {
    static constexpr int NPRE = 0; __device__ __forceinline__ void load_pre(const Unit&, int, int, int (&)[1]) const {}
    static constexpr bool PERM = false;
    float* C; int ldc; const float* R; float ralpha;
    __device__ __forceinline__ void operator()(const f32x4 (&acc)[2][2][4][2], const Unit& u, int wr, int wc, int fr, int fq) const {
        const int row0 = u.pm * BM + wr * 64 + fr, col0 = u.pn * BM + wc * 32 + 4 * fq;
#pragma unroll
        for (int ai = 0; ai < 2; ++ai)
#pragma unroll
            for (int m = 0; m < 4; ++m) { const size_t off = (size_t)(row0 + ai * HALF + m * 16) * ldc + col0;
#pragma unroll
                for (int bj = 0; bj < 2; ++bj)
#pragma unroll
                    for (int n = 0; n < 2; ++n) { f32x4 v = acc[ai][bj][m][n]; if (R) v = v + ralpha * *(const f32x4*)(R + off + bj * HALF + n * 16); *(f32x4*)(C + off + bj * HALF + n * 16) = v; } }
    }
};
struct EpiBf16P {
    static constexpr int NPRE = 0; __device__ __forceinline__ void load_pre(const Unit&, int, int, int (&)[1]) const {}
    static constexpr bool PERM = true;
    bf16_t* O; int ldc;
    __device__ __forceinline__ void operator()(const f32x4 (&acc)[2][2][4][2], const Unit& u, int wr, int wc, int fr, int fq) const {
        const int row0 = u.pm * BM + wr * 64 + fr, col0 = u.pn * BM + wc * 32 + 8 * fq;
#pragma unroll
        for (int ai = 0; ai < 2; ++ai)
#pragma unroll
            for (int m = 0; m < 4; ++m) { bf16_t* rowp = O + (size_t)(row0 + ai * HALF + m * 16) * ldc + col0;
#pragma unroll
                for (int bj = 0; bj < 2; ++bj) { const f32x4 v0 = acc[ai][bj][m][0], v1 = acc[ai][bj][m][1];
                    u32x4 w; w.x = cvt_pk_bf16(v0[0], v0[1]); w.y = cvt_pk_bf16(v0[2], v0[3]); w.z = cvt_pk_bf16(v1[0], v1[1]); w.w = cvt_pk_bf16(v1[2], v1[3]);
                    *(u32x4*)(rowp + bj * HALF) = w; } }
    }
};
struct EpiGlu {
    static constexpr int NPRE = 0; __device__ __forceinline__ void load_pre(const Unit&, int, int, int (&)[1]) const {}
    static constexpr bool PERM = true;
    bf16_t* O; int ldo; const bf16_t* Gm; int ldg; const float* bias;
    __device__ __forceinline__ void operator()(const f32x4 (&acc)[2][2][4][2], const Unit& u, int wr, int wc, int fr, int fq) const {
        const int row0 = u.pm * BM + wr * 64 + fr, col0 = u.pn * BM + wc * 32 + 8 * fq;
#pragma unroll
        for (int ai = 0; ai < 2; ++ai)
#pragma unroll
            for (int m = 0; m < 4; ++m) { const size_t r = (size_t)(row0 + ai * HALF + m * 16);
#pragma unroll
                for (int bj = 0; bj < 2; ++bj) { const int c = col0 + bj * HALF;
                    const f32x4 b0 = *(const f32x4*)(bias + c), b1 = *(const f32x4*)(bias + c + 4); const u32x4 gv = *(const u32x4*)(Gm + r * ldg + c);
                    const f32x4 v0 = acc[ai][bj][m][0] + b0, v1 = acc[ai][bj][m][1] + b1;
                    float g[8] = {__builtin_bit_cast(float, gv.x << 16), __builtin_bit_cast(float, gv.x & 0xffff0000u), __builtin_bit_cast(float, gv.y << 16), __builtin_bit_cast(float, gv.y & 0xffff0000u),
                                  __builtin_bit_cast(float, gv.z << 16), __builtin_bit_cast(float, gv.z & 0xffff0000u), __builtin_bit_cast(float, gv.w << 16), __builtin_bit_cast(float, gv.w & 0xffff0000u)};
                    u32x4 w; w.x = cvt_pk_bf16(g[0] * __builtin_amdgcn_rcpf(1.f + __expf(-v0[0])), g[1] * __builtin_amdgcn_rcpf(1.f + __expf(-v0[1]))); w.y = cvt_pk_bf16(g[2] * __builtin_amdgcn_rcpf(1.f + __expf(-v0[2])), g[3] * __builtin_amdgcn_rcpf(1.f + __expf(-v0[3])));
                    w.z = cvt_pk_bf16(g[4] * __builtin_amdgcn_rcpf(1.f + __expf(-v1[0])), g[5] * __builtin_amdgcn_rcpf(1.f + __expf(-v1[1]))); w.w = cvt_pk_bf16(g[6] * __builtin_amdgcn_rcpf(1.f + __expf(-v1[2])), g[7] * __builtin_amdgcn_rcpf(1.f + __expf(-v1[3])));
                    *(u32x4*)(O + r * ldo + c) = w; } }
    }
};
template <class Epi, class Sched, bool ALIGN_EPI, bool GATHER>
__device__ __forceinline__ void gemm_phase(PG8_LAS unsigned char* lds, const Gemm g, const Sched& S, const Epi& E) {
    int tid_ = threadIdx.x; asm volatile("" : "+v"(tid_));
    const int tid = tid_, wid = __builtin_amdgcn_readfirstlane(tid >> 6), lane = tid & 63, wr = wid >> 2, wc = wid & 3, fr = lane & 15, fq = lane >> 4;
    const int K = g.K, nt = K / BK;
    unsigned voffA[2], voffB[2];
#pragma unroll
    for (int i = 0; i < 2; ++i) { int R, C; stage_rc(tid * 16 + i * 8192, R, C); const int Rb = Epi::PERM ? ((R & ~31) + perm32(R & 31)) : R;
        voffA[i] = (unsigned)(R * K + C) * 2u; voffB[i] = (unsigned)(Rb * K + C) * 2u; }
    const size_t kstep = (size_t)(BK * 2);
    const size_t hstep = (size_t)HALF * K * 2;
    const size_t tstep = 2 * hstep;
    const unsigned ldsw = (unsigned)wid * 1024u;
    const int aoff = lds_byte(wr * 64 + fr, fq * 8), boff = lds_byte(wc * 32 + fr, fq * 8);
#define PG8_SA(b, h) (((b) * 2 + (h)) * HTB)
#define PG8_SB(b, h) ((4 + (b) * 2 + (h)) * HTB)
#define PG8_STAGE(bufoff, gbase, voff) do { _Pragma("unroll") for (int _i = 0; _i < 2; ++_i) { unsigned _vo = (voff)[_i]; asm volatile("" : "+v"(_vo));   \
        __builtin_amdgcn_global_load_lds((const unsigned*)((const char*)(gbase) + _vo), (PG8_LAS unsigned*)(lds + (bufoff) + ldsw + _i * 8192), 16, 0, 0); } } while (0)
#define PG8_STAGE_A(bufoff, gbase, h, GV) do { if constexpr (GATHER) { PG8_STAGE(bufoff, gbase, GV[h]); } else { PG8_STAGE(bufoff, (gbase) + (h) * hstep, voffA); } } while (0)
#define PG8_STAGE_A2(bufoff, gbase, h) do { if constexpr (GATHER) { unsigned _gv[2] = {last ? gnxt[h][0] : gcur[h][0], last ? gnxt[h][1] : gcur[h][1]}; PG8_STAGE(bufoff, gbase, _gv); } else { PG8_STAGE(bufoff, (gbase) + (h) * hstep, voffA); } } while (0)
#define PG8_LDA(dst, b, h) do { _Pragma("unroll") for (int m = 0; m < 4; ++m) _Pragma("unroll") for (int k = 0; k < 2; ++k) dst[m][k] = *(const PG8_LAS bf16x8*)(lds + PG8_SA(b, h) + aoff + m * 2048 + k * 1024); } while (0)
#define PG8_LDB(dst, b, h) do { _Pragma("unroll") for (int n = 0; n < 2; ++n) _Pragma("unroll") for (int k = 0; k < 2; ++k) dst[n][k] = *(const PG8_LAS bf16x8*)(lds + PG8_SB(b, h) + boff + n * 2048 + k * 1024); } while (0)
#define PG8_MMA(ai, bj, At, Bt) do { __builtin_amdgcn_s_setprio(1); _Pragma("unroll") for (int m = 0; m < 4; ++m) _Pragma("unroll") for (int n = 0; n < 2; ++n) _Pragma("unroll") for (int k = 0; k < 2; ++k) \
        acc[ai][bj][m][n] = __builtin_amdgcn_mfma_f32_16x16x32_bf16(Bt[n][k], At[m][k], acc[ai][bj][m][n], 0, 0, 0); __builtin_amdgcn_s_setprio(0); } while (0)
#define PG8_WAIT_V(n) asm volatile("s_waitcnt vmcnt(" #n ")" ::: "memory")
#define PG8_WAIT_L(n) asm volatile("s_waitcnt lgkmcnt(" #n ")" ::: "memory")
#define PG8_BAR __builtin_amdgcn_s_barrier()
#define PG8_SCHED __builtin_amdgcn_sched_barrier(0)
#define PG8_GLOAD(GV, u) do { _Pragma("unroll") for (int _i = 0; _i < 2; ++_i) { int _R, _C; stage_rc(tid * 16 + _i * 8192, _R, _C); _Pragma("unroll") for (int _h = 0; _h < 2; ++_h) \
        GV[_h][_i] = (unsigned)g.rows[(u).pm * BM + _h * HALF + _R] * (unsigned)(K * 2) + (unsigned)(_C * 2); } } while (0)
    Unit cur, nxt; int ui = 0;
    if (!S.next(0, cur)) return;
    f32x4 acc[2][2][4][2];
#pragma unroll
    for (int a = 0; a < 2; ++a)
#pragma unroll
        for (int b = 0; b < 2; ++b)
#pragma unroll
            for (int m = 0; m < 4; ++m)
#pragma unroll
                for (int n = 0; n < 2; ++n) acc[a][b][m][n] = (f32x4){0.f, 0.f, 0.f, 0.f};
    bf16x8 At[4][2], B0[2][2], B1[2][2];
    unsigned gcur[2][2] = {{0u, 0u}, {0u, 0u}}, gnxt[2][2] = {{0u, 0u}, {0u, 0u}};
    if constexpr (Epi::NPRE > 0) E.prefetch(cur, 0, lds, wid, lane);
    if constexpr (GATHER) { PG8_GLOAD(gcur, cur); }
    const char* cA = GATHER ? (const char*)g.A : (const char*)g.A + (size_t)cur.pm * tstep;
    const char* cB = (const char*)g.Bt + ((size_t)cur.e * g.bstride) * 2 + (size_t)cur.pn * tstep;
    PG8_STAGE(PG8_SB(0, 0), cB, voffB); PG8_STAGE(PG8_SB(0, 1), cB + hstep, voffB); PG8_STAGE_A(PG8_SA(0, 0), cA, 0, gcur); PG8_STAGE_A(PG8_SA(0, 1), cA, 1, gcur);
    if (wr == 1) PG8_BAR;
    PG8_WAIT_V(2); PG8_BAR;
    PG8_STAGE(PG8_SB(1, 0), cB + kstep, voffB); PG8_STAGE_A(PG8_SA(1, 0), cA + kstep, 0, gcur); PG8_STAGE(PG8_SB(1, 1), cB + hstep + kstep, voffB);
    PG8_WAIT_V(6); PG8_BAR;
    for (;;) {
        const bool has_next = S.next(ui + 1, nxt);
        if constexpr (Epi::NPRE > 0) { if (has_next) E.prefetch(nxt, (ui + 1) % 3, lds, wid, lane); }
        if constexpr (GATHER) { if (has_next) { PG8_GLOAD(gnxt, nxt); } else {
#pragma unroll
            for (int _h = 0; _h < 2; ++_h)
#pragma unroll
                for (int _i = 0; _i < 2; ++_i) gnxt[_h][_i] = gcur[_h][_i]; } }
        const char* nA = GATHER ? cA : (has_next ? (const char*)g.A + (size_t)nxt.pm * tstep : cA);
        const char* nB = has_next ? (const char*)g.Bt + ((size_t)nxt.e * g.bstride) * 2 + (size_t)nxt.pn * tstep : cB;
#pragma unroll 1
        for (int t = 0; t < nt; t += 2) {
            const bool last = (t == nt - 2);
            const char* a1 = cA + (size_t)(t + 1) * kstep;
            const char* a2 = last ? nA : cA + (size_t)(t + 2) * kstep; const char* b2 = last ? nB : cB + (size_t)(t + 2) * kstep;
            const char* a3 = a2 + kstep; const char* b3 = b2 + kstep;
            PG8_LDB(B0, 0, 0); PG8_LDB(B1, 0, 1); PG8_SCHED; PG8_LDA(At, 0, 0); PG8_STAGE_A(PG8_SA(1, 1), a1, 1, gcur);
            PG8_WAIT_V(8); PG8_WAIT_L(0); PG8_BAR; PG8_MMA(0, 0, At, B0); PG8_MMA(0, 1, At, B1); PG8_BAR; PG8_SCHED;
            PG8_LDA(At, 0, 1); PG8_STAGE(PG8_SB(0, 0), b2, voffB); PG8_STAGE(PG8_SB(0, 1), b2 + hstep, voffB); PG8_STAGE_A2(PG8_SA(0, 0), a2, 0);
            PG8_WAIT_V(8); PG8_WAIT_L(0); PG8_BAR; PG8_MMA(1, 0, At, B0); PG8_MMA(1, 1, At, B1); PG8_BAR; PG8_SCHED;
            PG8_LDB(B0, 1, 0); PG8_LDB(B1, 1, 1); PG8_SCHED; PG8_LDA(At, 1, 0); PG8_STAGE_A2(PG8_SA(0, 1), a2, 1);
            PG8_WAIT_V(8); PG8_WAIT_L(0); PG8_BAR; PG8_MMA(0, 0, At, B0); PG8_MMA(0, 1, At, B1); PG8_BAR; PG8_SCHED;
            PG8_LDA(At, 1, 1); PG8_STAGE(PG8_SB(1, 0), b3, voffB); PG8_STAGE(PG8_SB(1, 1), b3 + hstep, voffB); PG8_STAGE_A2(PG8_SA(1, 0), a3, 0);
            PG8_WAIT_V(8); PG8_WAIT_L(0); PG8_BAR; PG8_MMA(1, 0, At, B0); PG8_MMA(1, 1, At, B1); PG8_BAR; PG8_SCHED;
        }
        if constexpr (ALIGN_EPI) { if (wr == 0) PG8_BAR; }
        if constexpr (Epi::NPRE > 0) E(acc, cur, wr, wc, fr, fq, ui % 3, lds); else E(acc, cur, wr, wc, fr, fq);
        if (!has_next) break;
#pragma unroll
        for (int a = 0; a < 2; ++a)
#pragma unroll
            for (int b = 0; b < 2; ++b)
#pragma unroll
                for (int m = 0; m < 4; ++m)
#pragma unroll
                    for (int n = 0; n < 2; ++n) acc[a][b][m][n] = (f32x4){0.f, 0.f, 0.f, 0.f};
        cur = nxt; cA = nA; cB = nB; ++ui;
        if constexpr (GATHER) {
#pragma unroll
            for (int _h = 0; _h < 2; ++_h)
#pragma unroll
                for (int _i = 0; _i < 2; ++_i) gcur[_h][_i] = gnxt[_h][_i]; }
        if constexpr (ALIGN_EPI) { if (wr == 1) PG8_BAR; }
    }
    PG8_WAIT_V(0);
    if constexpr (!ALIGN_EPI) { if (wr == 0) PG8_BAR; }
    PG8_BAR;
#undef PG8_SA
#undef PG8_SB
#undef PG8_STAGE
#undef PG8_STAGE_A
#undef PG8_STAGE_A2
#undef PG8_LDA
#undef PG8_LDB
#undef PG8_MMA
#undef PG8_WAIT_V
#undef PG8_WAIT_L
#undef PG8_BAR
#undef PG8_SCHED
#undef PG8_GLOAD
}
}
typedef unsigned short bf16;
typedef unsigned v4u __attribute__((ext_vector_type(4)));
typedef unsigned v2u __attribute__((ext_vector_type(2)));
typedef float f32x4 __attribute__((ext_vector_type(4)));
constexpr int NTHREADS = 512, NWAVES = 8;
constexpr int LDS_BYTES = 163840;
constexpr int LDS_CTL = 155648;
constexpr int MISC_OFF = LDS_CTL + 320;
constexpr size_t MiB = 1u << 20;
constexpr size_t CTL_BYTES = 1 * MiB;
#if !defined(WITH_NAIVE)
namespace nv { constexpr int B_ = 2, S_ = 8192, T_ = B_ * S_, NCH = S_ / 64, EIN = 3080, OIN = 2064; constexpr float ALPHA = 1.41421356237309515f, EPS = 1e-5f; struct Mem { float* base; size_t off; }; }
#endif
constexpr int T_ = nv::T_, S_ = nv::S_, NCH = nv::NCH;
constexpr int EINP = 3328, OINP = 2304;
#define LDS_WAIT() asm volatile("s_waitcnt lgkmcnt(0)" ::: "memory")
typedef __bf16 hwbf2_t __attribute__((ext_vector_type(2)));
typedef float hwf2_t __attribute__((ext_vector_type(2)));
__device__ __forceinline__ unsigned f2bf(float f) { const __bf16 b = (__bf16)f; return (unsigned)__builtin_bit_cast(unsigned short, b); }
__device__ __forceinline__ unsigned pk2(float lo, float hi) { const hwf2_t v = {lo, hi}; return __builtin_bit_cast(unsigned, __builtin_convertvector(v, hwbf2_t)); }
__device__ __forceinline__ float bf2f(unsigned short b) { return __builtin_bit_cast(float, (unsigned)b << 16); }
__device__ __forceinline__ void tr_item(const float* W, long ldw, int nvalid, bf16* dst, long ldd, LAS float* scr, int lane) {
#pragma unroll 8
    for (int i = 0; i < 32; ++i) { const int kk = 2 * i + (lane >> 5), nn = lane & 31; scr[kk * 33 + nn] = nn < nvalid ? W[(long)kk * ldw + nn] : 0.f; }
    LDS_WAIT(); asm volatile("" ::: "memory");
    const int c = lane & 7;
#pragma unroll
    for (int j = 0; j < 4; ++j) { const int n = (lane >> 3) + 8 * j; const LAS float* s = scr + (8 * c) * 33 + n;
        v4u o; o.x = pk2(s[0 * 33], s[1 * 33]); o.y = pk2(s[2 * 33], s[3 * 33]); o.z = pk2(s[4 * 33], s[5 * 33]); o.w = pk2(s[6 * 33], s[7 * 33]);
        *(v4u*)(dst + (long)n * ldd + 8 * c) = o; }
    LDS_WAIT(); asm volatile("" ::: "memory");
}
__device__ __forceinline__ void tr_item64(const float* W, long ldw, int nvalid, bf16* dst, long ldd, LAS float* scr, int lane) {
    const int nn = (lane & 15) * 4;
#pragma unroll
    for (int i = 0; i < 16; ++i) { const int kk = 4 * i + (lane >> 4);
        f32x4 v = {0.f, 0.f, 0.f, 0.f}; if (nn < nvalid) v = *(const f32x4*)(W + (long)kk * ldw + nn);
        LAS float* s = scr + kk * 65 + nn; s[0] = v.x; s[1] = v.y; s[2] = v.z; s[3] = v.w; }
    LDS_WAIT(); asm volatile("" ::: "memory");
    const int c = lane & 7;
#pragma unroll
    for (int j = 0; j < 8; ++j) { const int n = (lane >> 3) + 8 * j; const LAS float* s = scr + (8 * c) * 65 + n;
        v4u o; o.x = pk2(s[0 * 65], s[1 * 65]); o.y = pk2(s[2 * 65], s[3 * 65]); o.z = pk2(s[4 * 65], s[5 * 65]); o.w = pk2(s[6 * 65], s[7 * 65]);
        *(v4u*)(dst + (long)n * ldd + 8 * c) = o; }
    LDS_WAIT(); asm volatile("" ::: "memory");
}
__device__ __forceinline__ void tr_matrix(const float* W, int K, int N, int NP, bf16* WT, LAS float* scr, int gw, int NGW, int lane) {
    const int nblk = NP / 64, nitems = (K / 64) * nblk;
    for (int it = gw; it < nitems; it += NGW) { const int kb = it / nblk, nb = it % nblk, k0 = 64 * kb, n0 = 64 * nb; int nvalid = N - n0; nvalid = nvalid < 0 ? 0 : (nvalid > 64 ? 64 : nvalid);
        tr_item64(W + (long)k0 * N + n0, N, nvalid, WT + (long)n0 * K + k0, K, scr, lane); }
}
__device__ __forceinline__ void tr_matrix_item(const float* W, int K, int N, int NP, bf16* WT, LAS float* scr, int it, int lane) {
    const int nblk = NP / 64, kb = it / nblk, nb = it % nblk, k0 = 64 * kb, n0 = 64 * nb; int nvalid = N - n0; nvalid = nvalid < 0 ? 0 : (nvalid > 64 ? 64 : nvalid);
    tr_item64(W + (long)k0 * N + n0, N, nvalid, WT + (long)n0 * K + k0, K, scr, lane);
}
__device__ __forceinline__ void cvt_rows(const float* src, bf16* dst, long n, long gtid, long gsz) {
    long i = gtid * 8;
    for (; i + 3 * gsz * 8 < n; i += 4 * gsz * 8) {
        f32x4 a[4], b[4];
#pragma unroll
        for (int u = 0; u < 4; ++u) { a[u] = *(const f32x4*)(src + i + u * gsz * 8); b[u] = *(const f32x4*)(src + i + u * gsz * 8 + 4); }
#pragma unroll
        for (int u = 0; u < 4; ++u) { v4u o; o.x = pk2(a[u].x, a[u].y); o.y = pk2(a[u].z, a[u].w); o.z = pk2(b[u].x, b[u].y); o.w = pk2(b[u].z, b[u].w); *(v4u*)(dst + i + u * gsz * 8) = o; } }
    for (; i < n; i += gsz * 8) { const f32x4 a = *(const f32x4*)(src + i), b = *(const f32x4*)(src + i + 4);
        v4u o; o.x = pk2(a.x, a.y); o.y = pk2(a.z, a.w); o.z = pk2(b.x, b.y); o.w = pk2(b.z, b.w); *(v4u*)(dst + i) = o; }
}
__device__ __forceinline__ int sopaque(int v) { asm volatile("" : "+s"(v)); return v; }
__device__ __forceinline__ float wave_sum(float v) {
#define WS_STEP(o) v += __builtin_bit_cast(float, __builtin_amdgcn_ds_swizzle(__builtin_bit_cast(int, v), 0x1f | ((o) << 10)))
    WS_STEP(1); WS_STEP(2); WS_STEP(4); WS_STEP(8); WS_STEP(16);
#undef WS_STEP
    return __builtin_bit_cast(float, __builtin_amdgcn_readlane(__builtin_bit_cast(int, v), 0)) + __builtin_bit_cast(float, __builtin_amdgcn_readlane(__builtin_bit_cast(int, v), 32));
}
#ifndef DBG_SCALE
#define DBG_SCALE 20.0f
#endif
constexpr int MOE_MAXBLK = 640;
constexpr int CW_CNT = 8192, CW_CUR = 8192 + 128;
namespace pg8 {
struct MoeOrder {
    const int* blk_e; int nblk, npn, G, c;
    __device__ __forceinline__ bool next(int i, Unit& u) const {
        const long L = (long)i * G + c; if (L >= (long)nblk * npn) return false;
        const int blk = (int)(L / npn); u.pm = blk; u.pn = (int)(L % npn); u.e = __builtin_amdgcn_readfirstlane(blk_e[blk]); u.aux = 0; return true;
    }
};
__device__ __forceinline__ float silu_f(float x) { return x * __builtin_amdgcn_rcpf(1.0f + __expf(-x)); }
struct EpiSwiGLU {
    static constexpr int NPRE = 0; __device__ __forceinline__ void load_pre(const Unit&, int, int, int (&)[1]) const {}
    static constexpr bool PERM = true;
    bf16_t* H;
    __device__ __forceinline__ void operator()(const f32x4 (&acc)[2][2][4][2], const Unit& u, int wr, int wc, int fr, int fq) const {
        const int row0 = u.pm * BM + wr * 64 + fr, col0 = u.pn * 128 + wc * 32 + 8 * fq;
#pragma unroll
        for (int ai = 0; ai < 2; ++ai)
#pragma unroll
            for (int m = 0; m < 4; ++m) { bf16_t* rowp = H + (size_t)(row0 + ai * HALF + m * 16) * 256 + col0;
                const f32x4 g0 = acc[ai][0][m][0], g1 = acc[ai][0][m][1], u0 = acc[ai][1][m][0], u1 = acc[ai][1][m][1];
                u32x4 w; w.x = cvt_pk_bf16(silu_f(g0[0]) * u0[0], silu_f(g0[1]) * u0[1]); w.y = cvt_pk_bf16(silu_f(g0[2]) * u0[2], silu_f(g0[3]) * u0[3]);
                w.z = cvt_pk_bf16(silu_f(g1[0]) * u1[0], silu_f(g1[1]) * u1[1]); w.w = cvt_pk_bf16(silu_f(g1[2]) * u1[2], silu_f(g1[3]) * u1[3]);
                *(u32x4*)rowp = w; }
    }
};
struct EpiDown {
    static constexpr bool PERM = true; static constexpr int NPRE = 1;
    bf16_t* rows8; bf16_t* rows_sh; const int* dest; int nslot8;
    __device__ __forceinline__ void prefetch(const Unit& u, int slot, PG8_LAS unsigned char* lds, int wid, int lane) const {
        if (wid < 4) __builtin_amdgcn_global_load_lds((const unsigned*)(dest + u.pm * BM + wid * 64 + lane), (PG8_LAS unsigned*)(lds + STAGE_BYTES + slot * 1024 + wid * 256), 4, 0, 0);
    }
    __device__ __forceinline__ void operator()(const f32x4 (&acc)[2][2][4][2], const Unit& u, int wr, int wc, int fr, int fq, int slot, PG8_LAS unsigned char* lds) const {
        const int col0 = u.pn * BM + wc * 32 + 8 * fq; const PG8_LAS int* dl = (const PG8_LAS int*)(lds + STAGE_BYTES + slot * 1024) + wr * 64 + fr;
#pragma unroll
        for (int ai = 0; ai < 2; ++ai)
#pragma unroll
            for (int m = 0; m < 4; ++m) { const int d = dl[ai * HALF + m * 16];
                if (d >= 0) { bf16_t* rowp = (d < nslot8 ? rows8 + (size_t)d * 1024 : rows_sh + (size_t)(d - nslot8) * 1024) + col0;
#pragma unroll
                    for (int bj = 0; bj < 2; ++bj) { const f32x4 v0 = acc[ai][bj][m][0], v1 = acc[ai][bj][m][1];
                        u32x4 o; o.x = cvt_pk_bf16(v0[0], v0[1]); o.y = cvt_pk_bf16(v0[2], v0[3]); o.z = cvt_pk_bf16(v1[0], v1[1]); o.w = cvt_pk_bf16(v1[2], v1[3]);
#if defined(NT_STORES)
                        __builtin_nontemporal_store(o, (u32x4*)(rowp + bj * HALF));
#else
                        *(u32x4*)(rowp + bj * HALF) = o;
#endif
                        } } }
    }
};
}
__device__ __forceinline__ void moe_convert_weights(const float* wg, const float* wu, const float* wd, const float* sg, const float* su, const float* sd,
                                                    bf16* WGU, bf16* WD, LAS float* scr, int first, int last, int stride, int lane) {
    for (int it = first; it < last; it += stride) {
        const int e = it / 192, r = it % 192, kind = r >> 6, q = r & 63;
        if (kind < 2) { const float* W = (e < 64 ? (kind == 0 ? wg : wu) + (size_t)e * 262144 : (kind == 0 ? sg : su));
            const int kb = q >> 2, nb = q & 3, k0 = 64 * kb, n0 = 64 * nb;
            tr_item64(W + (size_t)k0 * 256 + n0, 256, 64, WGU + ((size_t)e * 512 + (n0 >> 7) * 256 + (n0 & 127) + kind * 128) * 1024 + k0, 1024, scr, lane);
        } else { const float* W = e < 64 ? wd + (size_t)e * 262144 : sd;
            const int kb = q >> 4, nb = q & 15, k0 = 64 * kb, n0 = 64 * nb;
            tr_item64(W + (size_t)k0 * 1024 + n0, 1024, 64, WD + ((size_t)e * 1024 + n0) * 256 + k0, 256, scr, lane); }
    }
}
struct MoeLists { int* tok; int* dest; float* w; int* blk_e; };
__device__ __forceinline__ void moe_count(const int* ridx, unsigned* cnt, LAS unsigned* hist, int tid, int bid, int G) {
    if (tid < 64) hist[tid] = 0u;
    __syncthreads();
    for (int i = bid * NTHREADS + tid; i < T_ * 8; i += G * NTHREADS) atomicAdd((unsigned*)&hist[ridx[i]], 1u);
    __syncthreads();
    if (tid < 64 && hist[tid]) atomicAdd(&cnt[tid], hist[tid]);
    __syncthreads();
}
__device__ __forceinline__ void moe_build_lists(const int* ridx, const float* rwt, const unsigned* cnt, unsigned* cur, const MoeLists L, LAS int* sm, int tid, int bid, int G) {
    LAS int* pstart = sm; LAS unsigned* hist = (LAS unsigned*)(sm + 80); LAS unsigned* base = (LAS unsigned*)(sm + 160);
    if (tid == 0) { int acc = 0;
#pragma unroll 1
        for (int e = 0; e < 64; ++e) { pstart[e] = acc; acc += ((int)__hip_atomic_load(&cnt[e], __ATOMIC_RELAXED, __HIP_MEMORY_SCOPE_AGENT) + 255) & ~255; } pstart[64] = acc; pstart[65] = acc + T_; }
    __syncthreads();
    const int per = (T_ * 8 + G - 1) / G;
    const int lo = bid * per, hi = (lo + per < T_ * 8) ? lo + per : T_ * 8;
    for (int c0 = lo; c0 < hi; c0 += NTHREADS) {
        if (tid < 64) hist[tid] = 0u;
        __syncthreads();
        const int i = c0 + tid; int e = 0; unsigned local = 0u;
        if (i < hi) { e = ridx[i]; local = atomicAdd((unsigned*)&hist[e], 1u); }
        __syncthreads();
        if (tid < 64) base[tid] = hist[tid] ? atomicAdd(&cur[tid], hist[tid]) : 0u;
        __syncthreads();
        if (i < hi) { const int pos = pstart[e] + (int)base[e] + (int)local; L.tok[pos] = i >> 3; L.dest[pos] = i; L.w[pos] = rwt[i]; }
        __syncthreads();
    }
    for (int e = bid; e < 64; e += G) { const int c = (int)__hip_atomic_load(&cnt[e], __ATOMIC_RELAXED, __HIP_MEMORY_SCOPE_AGENT);
        for (int p = pstart[e] + c + tid; p < pstart[e + 1]; p += NTHREADS) { L.tok[p] = 0; L.dest[p] = -1; L.w[p] = 0.f; } }
    for (int t = bid * NTHREADS + tid; t < T_; t += G * NTHREADS) { const int p = pstart[64] + t; L.tok[p] = t; L.dest[p] = T_ * 8 + t; L.w[p] = 1.f; }
    const int nblk = pstart[65] >> 8;
    for (int b = bid * NTHREADS + tid; b < nblk; b += G * NTHREADS) { int e = 0;
#pragma unroll 1
        while (e < 64 && (pstart[e + 1] >> 8) <= b) ++e;
        L.blk_e[b] = e; }
    if (bid == 0 && tid == 0) L.blk_e[MOE_MAXBLK] = nblk;
    __syncthreads();
}
__device__ __forceinline__ void moe_combine_ln(float* h, const bf16* rows8, const bf16* rows_sh, const float* rwt, const float* lw, const float* lb, bf16* hbf, int gw, int NGW, int lane) {
    int t = gw; if (t >= T_) return;
    v4u rr[2][9]; f32x4 hh[4]; float wk[8];
#define CB_LOAD(tt) do { const size_t _t = (size_t)(tt); \
        _Pragma("unroll") for (int half = 0; half < 2; ++half) { const int c0 = half * 512 + lane * 8; \
            hh[half * 2] = *(const f32x4*)(h + _t * 1024 + c0); hh[half * 2 + 1] = *(const f32x4*)(h + _t * 1024 + c0 + 4); \
            _Pragma("unroll") for (int k = 0; k < 9; ++k) rr[half][k] = *(const v4u*)((k < 8 ? rows8 + (_t * 8 + k) * 1024 : rows_sh + _t * 1024) + c0); } \
        _Pragma("unroll") for (int k = 0; k < 8; ++k) wk[k] = rwt[_t * 8 + k]; } while (0)
    CB_LOAD(t);
    for (; t < T_; t += NGW) {
        float v[16];
#pragma unroll
        for (int half = 0; half < 2; ++half) { const f32x4 a = hh[half * 2], b = hh[half * 2 + 1];
            float s[8] = {a.x * nv::ALPHA, a.y * nv::ALPHA, a.z * nv::ALPHA, a.w * nv::ALPHA, b.x * nv::ALPHA, b.y * nv::ALPHA, b.z * nv::ALPHA, b.w * nv::ALPHA};
#pragma unroll
            for (int k = 0; k < 9; ++k) { const v4u r = rr[half][k]; const float w = k < 8 ? wk[k] : 1.0f;
                s[0] += w * __builtin_bit_cast(float, r.x << 16); s[1] += w * __builtin_bit_cast(float, r.x & 0xffff0000u);
                s[2] += w * __builtin_bit_cast(float, r.y << 16); s[3] += w * __builtin_bit_cast(float, r.y & 0xffff0000u);
                s[4] += w * __builtin_bit_cast(float, r.z << 16); s[5] += w * __builtin_bit_cast(float, r.z & 0xffff0000u);
                s[6] += w * __builtin_bit_cast(float, r.w << 16); s[7] += w * __builtin_bit_cast(float, r.w & 0xffff0000u); }
#pragma unroll
            for (int j = 0; j < 8; ++j) v[half * 8 + j] = s[j]; }
        if (t + NGW < T_) CB_LOAD(t + NGW);
        float sum = 0.f;
#pragma unroll
        for (int j = 0; j < 16; ++j) sum += v[j];
        sum = wave_sum(sum);
        const float mean = sum * (1.f / 1024.f);
        float sq = 0.f;
#pragma unroll
        for (int j = 0; j < 16; ++j) { v[j] -= mean; sq += v[j] * v[j]; }
        sq = wave_sum(sq);
        const float rstd = 1.0f / sqrtf(sq * (1.f / 1024.f) + nv::EPS);
#pragma unroll
        for (int half = 0; half < 2; ++half) { const int c0 = half * 512 + lane * 8;
            const f32x4 w0 = *(const f32x4*)(lw + c0), w1 = *(const f32x4*)(lw + c0 + 4), b0 = *(const f32x4*)(lb + c0), b1 = *(const f32x4*)(lb + c0 + 4);
            f32x4 o0, o1;
            o0.x = v[half * 8 + 0] * rstd * w0.x + b0.x; o0.y = v[half * 8 + 1] * rstd * w0.y + b0.y; o0.z = v[half * 8 + 2] * rstd * w0.z + b0.z; o0.w = v[half * 8 + 3] * rstd * w0.w + b0.w;
            o1.x = v[half * 8 + 4] * rstd * w1.x + b1.x; o1.y = v[half * 8 + 5] * rstd * w1.y + b1.y; o1.z = v[half * 8 + 6] * rstd * w1.z + b1.z; o1.w = v[half * 8 + 7] * rstd * w1.w + b1.w;
            *(f32x4*)(h + (size_t)t * 1024 + c0) = o0; *(f32x4*)(h + (size_t)t * 1024 + c0 + 4) = o1;
            if (hbf) { v4u p; p.x = pk2(o0.x, o0.y); p.y = pk2(o0.z, o0.w); p.z = pk2(o1.x, o1.y); p.w = pk2(o1.z, o1.w); *(v4u*)(hbf + (size_t)t * 1024 + c0) = p; } }
    }
#undef CB_LOAD
}
typedef float f32x16 __attribute__((ext_vector_type(16)));
typedef short s16x8 __attribute__((ext_vector_type(8)));
typedef LAS unsigned short lbf16;
__device__ __forceinline__ void mm32(f32x16& acc, const lbf16* A, int lda, const lbf16* B, int ldb, int K, int lane) {
    const lbf16* ap = A + (lane & 31) * lda + 8 * (lane >> 5);
    const lbf16* bp = B + (lane & 31) * ldb + 8 * (lane >> 5);
#pragma unroll 4
    for (int k = 0; k < K; k += 16) {
        const s16x8 a = *(const LAS s16x8*)(ap + k), b = *(const LAS s16x8*)(bp + k);
        acc = __builtin_amdgcn_mfma_f32_32x32x16_bf16(a, b, acc, 0, 0, 0);
    }
}
__device__ __forceinline__ void mm32_gb(f32x16& acc, const lbf16* A, int lda, const bf16* B, int ldb, int K, int lane) {
    const lbf16* ap = A + (lane & 31) * lda + 8 * (lane >> 5);
    const bf16* bp = B + (size_t)(lane & 31) * ldb + 8 * (lane >> 5);
#pragma unroll 4
    for (int k = 0; k < K; k += 16) {
        const s16x8 a = *(const LAS s16x8*)(ap + k), b = *(const s16x8*)(bp + k);
        acc = __builtin_amdgcn_mfma_f32_32x32x16_bf16(a, b, acc, 0, 0, 0);
    }
}
__device__ __forceinline__ int rowmap(int r, int lane) { return (r & 3) + 8 * (r >> 2) + 4 * (lane >> 5); }
__device__ __forceinline__ float rcp_f(float x) { return __builtin_amdgcn_rcpf(x); }
__device__ __forceinline__ float sigm_f(float x) { return rcp_f(1.0f + __expf(-x)); }
__device__ __forceinline__ float logsig_f(float x) { return fminf(x, 0.f) - __logf(1.0f + __expf(-fabsf(x))); }
__device__ __forceinline__ float softplus_f(float x) { return fmaxf(x, 0.f) + __logf(1.0f + __expf(-fabsf(x))); }
__device__ __forceinline__ float gelu_f(float x) { const float u = 0.7978845608028654f * (x + 0.044715f * x * x * x); return x * rcp_f(1.0f + __expf(-2.0f * u)); }
__device__ __forceinline__ void unpack8(const v4u r, float (&f)[8]) {
    f[0] = __builtin_bit_cast(float, r.x << 16); f[1] = __builtin_bit_cast(float, r.x & 0xffff0000u); f[2] = __builtin_bit_cast(float, r.y << 16); f[3] = __builtin_bit_cast(float, r.y & 0xffff0000u);
    f[4] = __builtin_bit_cast(float, r.z << 16); f[5] = __builtin_bit_cast(float, r.z & 0xffff0000u); f[6] = __builtin_bit_cast(float, r.w << 16); f[7] = __builtin_bit_cast(float, r.w & 0xffff0000u);
}
__device__ __forceinline__ v4u pack8(const float (&f)[8]) { v4u o; o.x = pk2(f[0], f[1]); o.y = pk2(f[2], f[3]); o.z = pk2(f[4], f[5]); o.w = pk2(f[6], f[7]); return o; }

struct Mix0Bufs { const bf16* proj; bf16* ct; float* nloc; float* blast; float* mloc; float* mprev; bf16* hloc; bf16* pc; float* carA; float* carU; float* carI; float* gst; bf16* mixbf; const bf16* lruw; };
constexpr int PJ0 = EINP;
__device__ __forceinline__ float lane_shr(float v, int o, int lane) { return __builtin_bit_cast(float, __builtin_amdgcn_ds_bpermute(((lane - o) & 63) << 2, __builtin_bit_cast(int, v))); }
__device__ __forceinline__ float wave_scan_add(float v, int lane) {
#pragma unroll
    for (int o = 1; o < 64; o <<= 1) { const float t = lane_shr(v, o, lane); v += (lane >= o) ? t : 0.f; }
    return v; }
__device__ __forceinline__ float wave_scan_max(float v, int lane) {
#pragma unroll
    for (int o = 1; o < 64; o <<= 1) { const float t = lane_shr(v, o, lane); v = (lane >= o) ? fmaxf(v, t) : v; }
    return v; }

__device__ __forceinline__ void mlstm_a_item(const Mix0Bufs& B, const float* gate_b, int cn, LAS unsigned char* lds, int tid) {
    const int lane = tid & 63, wave = __builtin_amdgcn_readfirstlane(tid >> 6);
    const int bh = cn / NCH, n = cn % NCH, b = bh >> 2, h = bh & 3;
    const size_t t0 = (size_t)b * S_ + n * 64;
    LAS float* pw = (LAS float*)lds;
    lbf16* kT = (lbf16*)(lds + 1024); lbf16* vT = (lbf16*)(lds + 1024 + 128 * 72 * 2);
    v4u gk[2], gv[2];
#pragma unroll
    for (int it = 0; it < 2; ++it) { const int vi = tid + it * 512, l = vi & 63, g = vi >> 6; const bf16* pr = B.proj + (t0 + l) * PJ0 + h * 128 + g * 8; gk[it] = *(const v4u*)(pr + 512); gv[it] = *(const v4u*)(pr + 1024); }
    if (wave == 0) { const bf16* pr = B.proj + (t0 + lane) * PJ0;
        const float lfv = logsig_f(bf2f(pr[2052 + h]) + gate_b[4 + h]), ig = bf2f(pr[2048 + h]) + gate_b[h];
        const float bcv = wave_scan_add(lfv, lane), wlv = ig - bcv, pmv = wave_scan_max(wlv, lane);
        const float blast = __builtin_bit_cast(float, __builtin_amdgcn_readlane(__builtin_bit_cast(int, bcv), 63)), mx = __builtin_bit_cast(float, __builtin_amdgcn_readlane(__builtin_bit_cast(int, pmv), 63));
        pw[lane] = __expf(wlv - mx) * 0.08838834764831845f;
        float* gs = B.gst + (size_t)cn * 192; gs[lane] = bcv; gs[64 + lane] = wlv; gs[128 + lane] = pmv;
        if (lane == 0) { B.blast[cn] = blast; B.mloc[cn] = blast + mx; } }
    __syncthreads();
#pragma unroll
    for (int it = 0; it < 2; ++it) { const int vi = tid + it * 512, l = vi & 63, g = vi >> 6;
        float kf[8], vf[8]; unpack8(gk[it], kf); unpack8(gv[it], vf);
        const float p = pw[l];
#pragma unroll
        for (int j = 0; j < 8; ++j) { kT[(g * 8 + j) * 72 + l] = (unsigned short)f2bf(kf[j] * p); vT[(g * 8 + j) * 72 + l] = (unsigned short)f2bf(vf[j]); } }
    __syncthreads();
    const int et = wave >> 1;
#pragma unroll
    for (int q = 0; q < 2; ++q) { const int dt = (wave & 1) * 2 + q;
        f32x16 acc = {0.f, 0.f, 0.f, 0.f, 0.f, 0.f, 0.f, 0.f, 0.f, 0.f, 0.f, 0.f, 0.f, 0.f, 0.f, 0.f};
        mm32(acc, kT + dt * 32 * 72, 72, vT + et * 32 * 72, 72, 64, lane);
        bf16* out = B.ct + (size_t)cn * 16384 + (et * 4 + dt) * 1024 + lane * 16;
        v4u o0, o1; o0.x = pk2(acc[0], acc[1]); o0.y = pk2(acc[2], acc[3]); o0.z = pk2(acc[4], acc[5]); o0.w = pk2(acc[6], acc[7]);
        o1.x = pk2(acc[8], acc[9]); o1.y = pk2(acc[10], acc[11]); o1.z = pk2(acc[12], acc[13]); o1.w = pk2(acc[14], acc[15]);
        *(v4u*)out = o0; *(v4u*)(out + 8) = o1; }
    { const int d = tid >> 2, qq = tid & 3; float f0[8], f1[8]; unpack8(*(const LAS v4u*)(kT + d * 72 + qq * 16), f0); unpack8(*(const LAS v4u*)(kT + d * 72 + qq * 16 + 8), f1);
      float sacc = 0.f;
#pragma unroll
      for (int j = 0; j < 8; ++j) sacc += f0[j] + f1[j];
      sacc += __builtin_bit_cast(float, __builtin_amdgcn_ds_swizzle(__builtin_bit_cast(int, sacc), 0x1f | (1 << 10)));
      sacc += __builtin_bit_cast(float, __builtin_amdgcn_ds_swizzle(__builtin_bit_cast(int, sacc), 0x1f | (2 << 10)));
      if (qq == 0) B.nloc[(size_t)cn * 128 + d] = sacc; }
    __syncthreads();
}
constexpr int SB = 32;
__device__ __forceinline__ void mlstm_b(const Mix0Bufs& B, int gtid, int gsz) {
    for (int idx = gtid; idx < 8 * 8192 + 8 * 128; idx += gsz) {
        const bool isn = idx >= 8 * 8192;
        if (!isn) { const int bh = idx >> 13, pe = idx & 8191;
            float s0 = 0.f, s1 = 0.f, m = 0.f; unsigned* p = (unsigned*)B.ct + (size_t)bh * NCH * 8192 + pe;
            for (int n0 = 0; n0 < NCH; n0 += SB) { unsigned cl[SB]; float bl[SB], ml[SB];
#pragma unroll
                for (int j = 0; j < SB; ++j) { cl[j] = p[(size_t)(n0 + j) * 8192]; bl[j] = B.blast[bh * NCH + n0 + j]; ml[j] = B.mloc[bh * NCH + n0 + j]; }
#pragma unroll
                for (int j = 0; j < SB; ++j) { const unsigned out = pk2(s0, s1); const float mn = fmaxf(bl[j] + m, ml[j]), kf = __expf(bl[j] + m - mn), af = __expf(ml[j] - mn);
                    s0 = kf * s0 + af * __builtin_bit_cast(float, cl[j] << 16); s1 = kf * s1 + af * __builtin_bit_cast(float, cl[j] & 0xffff0000u);
                    if (pe == 0) B.mprev[bh * NCH + n0 + j] = m;
                    m = mn; cl[j] = out; }
#pragma unroll
                for (int j = 0; j < SB; ++j) p[(size_t)(n0 + j) * 8192] = cl[j]; }
        } else { const int r = idx - 8 * 8192, bh = r >> 7, de = r & 127;
            float st = 0.f, m = 0.f; float* p = B.nloc + (size_t)bh * NCH * 128 + de;
            for (int n0 = 0; n0 < NCH; n0 += SB) { float cl[SB], bl[SB], ml[SB];
#pragma unroll
                for (int j = 0; j < SB; ++j) { cl[j] = p[(size_t)(n0 + j) * 128]; bl[j] = B.blast[bh * NCH + n0 + j]; ml[j] = B.mloc[bh * NCH + n0 + j]; }
#pragma unroll
                for (int j = 0; j < SB; ++j) { const float out = st; const float mn = fmaxf(bl[j] + m, ml[j]);
                    st = __expf(bl[j] + m - mn) * st + __expf(ml[j] - mn) * cl[j]; m = mn; cl[j] = out; }
#pragma unroll
                for (int j = 0; j < SB; ++j) p[(size_t)(n0 + j) * 128] = cl[j]; } }
    }
}
__device__ __forceinline__ void mlstm_c_item(const Mix0Bufs& B, const float* gate_b, const float* norm_w, int cn, LAS unsigned char* lds, int tid) {
    const int lane = tid & 63, wave = __builtin_amdgcn_readfirstlane(tid >> 6);
    const int bh = cn / NCH, n = cn % NCH, b = bh >> 2, h = bh & 3;
    const size_t t0 = (size_t)b * S_ + n * 64;
    LAS float* bm = (LAS float*)lds; LAS float* wl = bm + 64; LAS float* den = bm + 256; LAS float* emi = bm + 320;
    lbf16* qs = (lbf16*)(lds + 2048); lbf16* ks = (lbf16*)(lds + 19456); lbf16* qw = (lbf16*)(lds + 36864);
    lbf16* vT = (lbf16*)(lds + 54272); lbf16* cT = (lbf16*)(lds + 77312); lbf16* sm = (lbf16*)(lds + 120832);
    LAS float* hb = (LAS float*)(lds + 2048);
    const float mprev = B.mprev[cn];
    const float* gs = B.gst + (size_t)cn * 192;
    v4u gq[2], gk[2], gv[2], go[2], gc[4]; float sb[2], sp[2];
#pragma unroll
    for (int it = 0; it < 2; ++it) { const int vi = tid + it * 512; { const int l = vi >> 4, g = vi & 15; const bf16* pr = B.proj + (t0 + l) * PJ0 + h * 128 + g * 8; gq[it] = *(const v4u*)pr; gk[it] = *(const v4u*)(pr + 512); sb[it] = gs[l]; sp[it] = gs[128 + l]; }
        { const int l = vi & 63, g = vi >> 6; gv[it] = *(const v4u*)(B.proj + (t0 + l) * PJ0 + 1024 + h * 128 + g * 8); } }
    { const bf16* cg = B.ct + (size_t)cn * 16384;
#pragma unroll
      for (int it = 0; it < 4; ++it) gc[it] = *(const v4u*)(cg + (tid + it * 512) * 8); }
    { const int i = tid >> 3, sub = tid & 7; const bf16* op = B.proj + (t0 + i) * PJ0 + 1536 + h * 128 + sub * 16; go[0] = *(const v4u*)op; go[1] = *(const v4u*)(op + 8); }
    const float gnl = tid < 128 ? B.nloc[(size_t)cn * 128 + tid] : 0.f;
    if (wave == 0) { const float bi = gs[lane], wv = gs[64 + lane], pm = gs[128 + lane]; const float m = bi + fmaxf(mprev, pm);
        bm[lane] = bi - m; wl[lane] = wv; emi[lane] = __expf(-m); vT[128 * 72 + lane] = (unsigned short)0x3f80; }
#pragma unroll
    for (int it = 0; it < 2; ++it) { const int vi = tid + it * 512, l = vi >> 4, g = vi & 15;
        float qf[8], kf[8]; unpack8(gq[it], qf); unpack8(gk[it], kf);
        const float w = __expf(mprev - fmaxf(mprev, sp[it])); float qwf[8];
#pragma unroll
        for (int j = 0; j < 8; ++j) { kf[j] *= 0.08838834764831845f; qwf[j] = qf[j] * w; }
        *(LAS v4u*)(qs + l * 136 + g * 8) = gq[it]; *(LAS v4u*)(ks + l * 136 + g * 8) = pack8(kf); *(LAS v4u*)(qw + l * 136 + g * 8) = pack8(qwf); }
#pragma unroll
    for (int it = 0; it < 2; ++it) { const int vi = tid + it * 512, l = vi & 63, g = vi >> 6;
        float vf[8]; unpack8(gv[it], vf);
#pragma unroll
        for (int j = 0; j < 8; ++j) vT[(g * 8 + j) * 72 + l] = (unsigned short)f2bf(vf[j]); }
#pragma unroll
    for (int it = 0; it < 4; ++it) { const int vi = tid + it * 512, T = vi >> 7, ln = (vi >> 1) & 63, hr = vi & 1; const v4u x = gc[it];
        LAS unsigned char* dp = (LAS unsigned char*)(cT + ((T >> 2) * 32 + (ln & 31)) * 136 + (T & 3) * 32 + 16 * hr + 4 * (ln >> 5));
        *(LAS v2u*)dp = (v2u){x.x, x.y}; *(LAS v2u*)(dp + 16) = (v2u){x.z, x.w}; }
    if (tid < 128) cT[128 * 136 + tid] = (unsigned short)f2bf(gnl);
    __syncthreads();
    if (wave < 4) { const int it = wave >> 1, jt = wave & 1;
        f32x16 acc = {0.f, 0.f, 0.f, 0.f, 0.f, 0.f, 0.f, 0.f, 0.f, 0.f, 0.f, 0.f, 0.f, 0.f, 0.f, 0.f};
        if (jt <= it) mm32(acc, ks + jt * 32 * 136, 136, qs + it * 32 * 136, 136, 128, lane);
        const int i = it * 32 + (lane & 31); const float bmi = bm[i];
#pragma unroll
        for (int g4 = 0; g4 < 4; ++g4) { const int j0 = jt * 32 + 8 * g4 + 4 * (lane >> 5); const f32x4 w4 = *(const LAS f32x4*)(wl + j0);
            const float v0 = j0 <= i ? acc[g4 * 4] * __expf(bmi + w4.x) : 0.f, v1 = j0 + 1 <= i ? acc[g4 * 4 + 1] * __expf(bmi + w4.y) : 0.f;
            const float v2 = j0 + 2 <= i ? acc[g4 * 4 + 2] * __expf(bmi + w4.z) : 0.f, v3 = j0 + 3 <= i ? acc[g4 * 4 + 3] * __expf(bmi + w4.w) : 0.f;
            *(LAS v2u*)(sm + i * 72 + j0) = (v2u){pk2(v0, v1), pk2(v2, v3)}; } }
    __syncthreads();
    f32x16 accA = {0.f, 0.f, 0.f, 0.f, 0.f, 0.f, 0.f, 0.f, 0.f, 0.f, 0.f, 0.f, 0.f, 0.f, 0.f, 0.f}, accB = accA;
    { const int id = wave, it = id / 5, nt = id % 5;
      mm32(accA, vT + nt * 32 * 72, 72, sm + it * 32 * 72, 72, 64, lane); mm32(accA, cT + nt * 32 * 136, 136, qw + it * 32 * 136, 136, 128, lane);
      if (nt == 4 && lane < 32) den[it * 32 + lane] = accA[0]; }
    if (wave < 2) { const int id = wave + 8, it = id / 5, nt = id % 5;
      mm32(accB, vT + nt * 32 * 72, 72, sm + it * 32 * 72, 72, 64, lane); mm32(accB, cT + nt * 32 * 136, 136, qw + it * 32 * 136, 136, 128, lane);
      if (nt == 4 && lane < 32) den[it * 32 + lane] = accB[0]; }
    __syncthreads();
    { const int id = wave, it = id / 5, nt = id % 5;
      if (nt < 4) { const int i = it * 32 + (lane & 31); const float rd = rcp_f(fmaxf(fabsf(den[i]), emi[i]));
#pragma unroll
          for (int g4 = 0; g4 < 4; ++g4) *(LAS f32x4*)(hb + i * 132 + nt * 32 + 8 * g4 + 4 * (lane >> 5)) = (f32x4){accA[g4 * 4] * rd, accA[g4 * 4 + 1] * rd, accA[g4 * 4 + 2] * rd, accA[g4 * 4 + 3] * rd}; } }
    if (wave < 2) { const int id = wave + 8, it = id / 5, nt = id % 5;
      if (nt < 4) { const int i = it * 32 + (lane & 31); const float rd = rcp_f(fmaxf(fabsf(den[i]), emi[i]));
#pragma unroll
          for (int g4 = 0; g4 < 4; ++g4) *(LAS f32x4*)(hb + i * 132 + nt * 32 + 8 * g4 + 4 * (lane >> 5)) = (f32x4){accB[g4 * 4] * rd, accB[g4 * 4 + 1] * rd, accB[g4 * 4 + 2] * rd, accB[g4 * 4 + 3] * rd}; } }
    __syncthreads();
    { const int i = tid >> 3, sub = tid & 7; const LAS float* hr = hb + i * 132 + sub * 16;
      float x[16]; float s = 0.f;
#pragma unroll
      for (int j = 0; j < 16; ++j) { x[j] = hr[j]; s += x[j]; }
      s += __builtin_bit_cast(float, __builtin_amdgcn_ds_swizzle(__builtin_bit_cast(int, s), 0x1f | (1 << 10)));
      s += __builtin_bit_cast(float, __builtin_amdgcn_ds_swizzle(__builtin_bit_cast(int, s), 0x1f | (2 << 10)));
      s += __builtin_bit_cast(float, __builtin_amdgcn_ds_swizzle(__builtin_bit_cast(int, s), 0x1f | (4 << 10)));
      const float mean = s * (1.f / 128.f); float q = 0.f;
#pragma unroll
      for (int j = 0; j < 16; ++j) { x[j] -= mean; q += x[j] * x[j]; }
      q += __builtin_bit_cast(float, __builtin_amdgcn_ds_swizzle(__builtin_bit_cast(int, q), 0x1f | (1 << 10)));
      q += __builtin_bit_cast(float, __builtin_amdgcn_ds_swizzle(__builtin_bit_cast(int, q), 0x1f | (2 << 10)));
      q += __builtin_bit_cast(float, __builtin_amdgcn_ds_swizzle(__builtin_bit_cast(int, q), 0x1f | (4 << 10)));
      const float rstd = __builtin_amdgcn_rsqf(q * (1.f / 128.f) + nv::EPS);
      const float* nw = norm_w + h * 128 + sub * 16;
      float o0[8], o1[8]; unpack8(go[0], o0); unpack8(go[1], o1);
      float y0[8], y1[8];
#pragma unroll
      for (int j = 0; j < 8; ++j) { y0[j] = x[j] * rstd * nw[j] * sigm_f(o0[j]); y1[j] = x[8 + j] * rstd * nw[8 + j] * sigm_f(o1[j]); }
      bf16* dst = B.mixbf + (t0 + i) * 1024 + h * 128 + sub * 16;
      *(v4u*)dst = pack8(y0); *(v4u*)(dst + 8) = pack8(y1); }
    __syncthreads();
}
__device__ __forceinline__ void lru_a_item(const Mix0Bufs& B, const float* const* in, int ch, LAS unsigned char* lds, int tid) {
    const int lane = tid & 63, wave = __builtin_amdgcn_readfirstlane(tid >> 6);
    const size_t t0 = (size_t)ch * 64; const int s0 = (ch % NCH) * 64;
    lbf16* xc = (lbf16*)lds; LAS float* al = (LAS float*)(lds + 17408); LAS float* ul = (LAS float*)(lds + 17408 + 32768); LAS float* seg = (LAS float*)(lds + 17408 + 65536);
    const float* cw = in[9]; const float* cb = in[10]; const float* ba = in[12]; const float* bx = in[14]; const float* lam = in[15];
    for (int hh = 0; hh < 4; ++hh) {
        const int it = wave & 1, nt = wave >> 1;
        s16x8 wr[8], wx[8];
        { const bf16* bp = B.lruw + (size_t)(hh * 128 + nt * 32 + (lane & 31)) * 128 + 8 * (lane >> 5);
#pragma unroll
          for (int k = 0; k < 8; ++k) { wr[k] = *(const s16x8*)(bp + k * 16); wx[k] = *(const s16x8*)(bp + (size_t)512 * 128 + k * 16); } }
        { const int g = tid & 15, lr = tid >> 4, c0 = hh * 128 + g * 8;
          float xf[5][8];
#pragma unroll
          for (int k = 0; k < 5; ++k) { const int l = 2 * lr - 3 + k; v4u x = {0u, 0u, 0u, 0u}; if (s0 + l >= 0) x = *(const v4u*)(B.proj + (t0 + l) * PJ0 + 2056 + c0); unpack8(x, xf[k]); }
          float a0[8], a1[8];
#pragma unroll
          for (int j = 0; j < 8; ++j) { a0[j] = cb[c0 + j]; a1[j] = a0[j]; }
#pragma unroll
          for (int tap = 0; tap < 4; ++tap) {
#pragma unroll
              for (int j = 0; j < 8; ++j) { const float w = cw[tap * 512 + c0 + j]; a0[j] += w * xf[tap][j]; a1[j] += w * xf[tap + 1][j]; } }
          *(LAS v4u*)(xc + (2 * lr) * 136 + g * 8) = pack8(a0); *(LAS v4u*)(xc + (2 * lr + 1) * 136 + g * 8) = pack8(a1);
          *(LAS f32x4*)(ul + (2 * lr) * 128 + g * 8) = (f32x4){a0[0], a0[1], a0[2], a0[3]}; *(LAS f32x4*)(ul + (2 * lr) * 128 + g * 8 + 4) = (f32x4){a0[4], a0[5], a0[6], a0[7]};
          *(LAS f32x4*)(ul + (2 * lr + 1) * 128 + g * 8) = (f32x4){a1[0], a1[1], a1[2], a1[3]}; *(LAS f32x4*)(ul + (2 * lr + 1) * 128 + g * 8 + 4) = (f32x4){a1[4], a1[5], a1[6], a1[7]}; }
        __syncthreads();
        { f32x16 ra = {0.f, 0.f, 0.f, 0.f, 0.f, 0.f, 0.f, 0.f, 0.f, 0.f, 0.f, 0.f, 0.f, 0.f, 0.f, 0.f}, xa = ra;
          const lbf16* ap = xc + (it * 32 + (lane & 31)) * 136 + 8 * (lane >> 5);
#pragma unroll
          for (int k = 0; k < 8; ++k) { const s16x8 a = *(const LAS s16x8*)(ap + k * 16);
              ra = __builtin_amdgcn_mfma_f32_32x32x16_bf16(a, wr[k], ra, 0, 0, 0); xa = __builtin_amdgcn_mfma_f32_32x32x16_bf16(a, wx[k], xa, 0, 0, 0); }
          const int c = nt * 32 + (lane & 31), cg = hh * 128 + c; const float bav = ba[cg], bxv = bx[cg], sp = softplus_f(-lam[cg]);
#pragma unroll
          for (int r = 0; r < 16; ++r) { const int l = it * 32 + rowmap(r, lane);
              const float rr = sigm_f(ra[r] + bav), ii = sigm_f(xa[r] + bxv), la = -8.0f * rr * sp;
              const float xv = ul[l * 128 + c];
              al[l * 128 + c] = __expf(la); ul[l * 128 + c] = __builtin_amdgcn_sqrtf(1.0f - __expf(2.0f * la)) * ii * xv; } }
        __syncthreads();
        { const int cp = tid & 63, sg = wave;
          float h0 = 0.f, h1 = 0.f, P0 = 1.f, P1 = 1.f; float hl0[8], hl1[8], Pl0[8], Pl1[8];
#pragma unroll
          for (int t = 0; t < 8; ++t) { const hwf2_t a2 = *(const LAS hwf2_t*)(al + (sg * 8 + t) * 128 + 2 * cp), u2 = *(const LAS hwf2_t*)(ul + (sg * 8 + t) * 128 + 2 * cp);
              h0 = a2.x * h0 + u2.x; h1 = a2.y * h1 + u2.y; P0 *= a2.x; P1 *= a2.y; hl0[t] = h0; hl1[t] = h1; Pl0[t] = P0; Pl1[t] = P1; }
          *(LAS f32x4*)(seg + (sg * 128 + 2 * cp) * 2) = (f32x4){P0, h0, P1, h1};
          __syncthreads();
          float Pi0 = 1.f, Pi1 = 1.f, hi0 = 0.f, hi1 = 0.f;
          for (int q = 0; q < sg; ++q) { const f32x4 e = *(const LAS f32x4*)(seg + (q * 128 + 2 * cp) * 2); hi0 = e.x * hi0 + e.y; hi1 = e.z * hi1 + e.w; Pi0 *= e.x; Pi1 *= e.z; }
          bf16* hp = B.hloc + (t0 + sg * 8) * 512 + hh * 128 + 2 * cp; bf16* pp = B.pc + (t0 + sg * 8) * 512 + hh * 128 + 2 * cp;
#pragma unroll
          for (int t = 0; t < 8; ++t) { *(unsigned*)(hp + (size_t)t * 512) = pk2(hl0[t] + Pl0[t] * hi0, hl1[t] + Pl1[t] * hi1); *(unsigned*)(pp + (size_t)t * 512) = pk2(Pl0[t] * Pi0, Pl1[t] * Pi1); }
          if (sg == 7) { float2 ca, cu; ca.x = Pl0[7] * Pi0; ca.y = Pl1[7] * Pi1; cu.x = hl0[7] + Pl0[7] * hi0; cu.y = hl1[7] + Pl1[7] * hi1;
              *(float2*)(B.carA + (size_t)ch * 512 + hh * 128 + 2 * cp) = ca; *(float2*)(B.carU + (size_t)ch * 512 + hh * 128 + 2 * cp) = cu; } }
    }
    __syncthreads();
}
__device__ __forceinline__ void lru_b(const Mix0Bufs& B, int gtid, int gsz) {
    for (int idx = gsz - 1 - gtid; idx < 2 * 512; idx += gsz)   { const int b = idx >> 9, c = idx & 511; float hst = 0.f;
        for (int n0 = 0; n0 < NCH; n0 += SB) { float a[SB], u[SB];
#pragma unroll
            for (int j = 0; j < SB; ++j) { const size_t o = (size_t)(b * NCH + n0 + j) * 512 + c; a[j] = B.carA[o]; u[j] = B.carU[o]; }
#pragma unroll
            for (int j = 0; j < SB; ++j) { const float in = hst; hst = a[j] * hst + u[j]; a[j] = in; }
#pragma unroll
            for (int j = 0; j < SB; ++j) B.carI[(size_t)(b * NCH + n0 + j) * 512 + c] = a[j]; } }
}
__device__ __forceinline__ void lru_c(const Mix0Bufs& B, int gtid, int gsz) {
    for (int idx = gtid; idx < T_ * 64; idx += gsz) { const size_t t = idx >> 6; const int c0 = (idx & 63) * 8; const size_t ch = t >> 6;
        float gb[8], y[8]; unpack8(*(const v4u*)(B.proj + t * PJ0 + 2568 + c0), gb);
        float hp[8], pp[8]; unpack8(*(const v4u*)(B.hloc + t * 512 + c0), hp); unpack8(*(const v4u*)(B.pc + t * 512 + c0), pp); const float* ci = B.carI + ch * 512 + c0;
#pragma unroll
        for (int j = 0; j < 8; ++j) y[j] = (hp[j] + pp[j] * ci[j]) * gelu_f(gb[j]);
        *(v4u*)(B.mixbf + t * 1024 + 512 + c0) = pack8(y); }
}
constexpr int PJ1 = OINP;
struct Mix1Bufs { const bf16* proj; bf16* ut; float* gbl; bf16* s5g; float* xend; float* xstart; float* s5ab; float* s5bb; bf16* cm; bf16* bbt; bf16* mixbf; };
__device__ __forceinline__ void gla_gates(const bf16* proj, const float* gw, const float* gb, size_t t0, int h, LAS float* bc, LAS float* gl, LAS float* tot, int tid) {
    const int d = tid & 63, lg = __builtin_amdgcn_readfirstlane(tid >> 6);
    if (tid < 128) { const int l = tid >> 1, hf = tid & 1; float f[8]; unpack8(*(const v4u*)(proj + (t0 + l) * PJ1 + 2048 + hf * 8), f);
        *(LAS f32x4*)(gl + l * 16 + hf * 8) = (f32x4){f[0], f[1], f[2], f[3]}; *(LAS f32x4*)(gl + l * 16 + hf * 8 + 4) = (f32x4){f[4], f[5], f[6], f[7]}; }
    float w[16];
#pragma unroll
    for (int r = 0; r < 16; ++r) w[r] = gw[r * 256 + h * 64 + d];
    const float bias = gb[h * 64 + d];
    __syncthreads();
    float v[8];
#pragma unroll
    for (int q = 0; q < 8; ++q) { const int l = lg * 8 + q; float acc = bias;
#pragma unroll
        for (int r4 = 0; r4 < 4; ++r4) { const f32x4 g4 = *(const LAS f32x4*)(gl + l * 16 + r4 * 4); acc += g4.x * w[r4 * 4] + g4.y * w[r4 * 4 + 1] + g4.z * w[r4 * 4 + 2] + g4.w * w[r4 * 4 + 3]; }
        v[q] = logsig_f(acc) * 0.0625f; }
#pragma unroll
    for (int q = 1; q < 8; ++q) v[q] += v[q - 1];
    tot[lg * 64 + d] = v[7];
    __syncthreads();
    float pre = 0.f;
#pragma unroll
    for (int s = 0; s < 7; ++s) { const float t = tot[s * 64 + d]; pre += (s < lg) ? t : 0.f; }
#pragma unroll
    for (int q = 0; q < 8; ++q) bc[(lg * 8 + q) * 64 + d] = v[q] + pre;
    __syncthreads();
}
__device__ __forceinline__ void gla_a_item(const Mix1Bufs& B, const float* gw, const float* gb, int cn, LAS unsigned char* lds, int tid) {
    const int lane = tid & 63, wave = __builtin_amdgcn_readfirstlane(tid >> 6);
    const int bh = cn / NCH, n = cn % NCH, b = bh >> 2, h = bh & 3;
    const size_t t0 = (size_t)b * S_ + n * 64;
    LAS float* bc = (LAS float*)lds; LAS float* gl = (LAS float*)(lds + 16384); LAS float* tot = (LAS float*)(lds + 118784);
    lbf16* kT = (lbf16*)(lds + 20480); lbf16* vT = (lbf16*)(lds + 20480 + 64 * 72 * 2);
    v4u gk, gv[2];
    { const int l = tid & 63, g = tid >> 6; gk = *(const v4u*)(B.proj + (t0 + l) * PJ1 + 768 + h * 64 + g * 8); }
#pragma unroll
    for (int it = 0; it < 2; ++it) { const int vi = tid + it * 512, l = vi & 63, g = vi >> 6; gv[it] = *(const v4u*)(B.proj + (t0 + l) * PJ1 + 1024 + h * 128 + g * 8); }
    gla_gates(B.proj, gw, gb, t0, h, bc, gl, tot, tid);
    { const int l = tid & 63, g = tid >> 6; float kf[8]; unpack8(gk, kf);
#pragma unroll
      for (int j = 0; j < 8; ++j) { const int d = g * 8 + j; kT[d * 72 + l] = (unsigned short)f2bf(kf[j] * __expf(bc[63 * 64 + d] - bc[l * 64 + d])); } }
#pragma unroll
    for (int it = 0; it < 2; ++it) { const int vi = tid + it * 512, l = vi & 63, g = vi >> 6; float vf[8]; unpack8(gv[it], vf);
#pragma unroll
        for (int j = 0; j < 8; ++j) vT[(g * 8 + j) * 72 + l] = (unsigned short)f2bf(vf[j]); }
    __syncthreads();
    { const int et = wave >> 1, dt = wave & 1;
      f32x16 acc = {0.f, 0.f, 0.f, 0.f, 0.f, 0.f, 0.f, 0.f, 0.f, 0.f, 0.f, 0.f, 0.f, 0.f, 0.f, 0.f};
      mm32(acc, kT + dt * 32 * 72, 72, vT + et * 32 * 72, 72, 64, lane);
      bf16* out = B.ut + (size_t)cn * 8192 + (et * 2 + dt) * 1024 + lane * 16;
      v4u o0, o1; o0.x = pk2(acc[0], acc[1]); o0.y = pk2(acc[2], acc[3]); o0.z = pk2(acc[4], acc[5]); o0.w = pk2(acc[6], acc[7]);
      o1.x = pk2(acc[8], acc[9]); o1.y = pk2(acc[10], acc[11]); o1.z = pk2(acc[12], acc[13]); o1.w = pk2(acc[14], acc[15]);
      *(v4u*)out = o0; *(v4u*)(out + 8) = o1; }
    if (tid < 64) B.gbl[(size_t)cn * 64 + tid] = bc[63 * 64 + tid];
    __syncthreads();
}
__device__ __forceinline__ void gla_b(const Mix1Bufs& B, int gtid, int gsz) {
    for (int idx = gtid; idx < 8 * 4096; idx += gsz) { const int bh = idx >> 12, pe = idx & 4095, d = ((pe >> 9) & 1) * 32 + ((pe * 2) & 3) + 8 * ((pe >> 1) & 3) + 4 * ((pe >> 8) & 1); float s0 = 0.f, s1 = 0.f;
        unsigned* p = (unsigned*)B.ut + (size_t)bh * NCH * 4096 + pe; const float* gp = B.gbl + (size_t)bh * NCH * 64 + d;
        for (int n0 = 0; n0 < NCH; n0 += SB) { unsigned u[SB]; float g0[SB], g1[SB];
#pragma unroll
            for (int j = 0; j < SB; ++j) { u[j] = p[(size_t)(n0 + j) * 4096]; g0[j] = gp[(n0 + j) * 64]; g1[j] = gp[(n0 + j) * 64 + 1]; }
#pragma unroll
            for (int j = 0; j < SB; ++j) { const unsigned out = pk2(s0, s1);
                s0 = __expf(g0[j]) * s0 + __builtin_bit_cast(float, u[j] << 16); s1 = __expf(g1[j]) * s1 + __builtin_bit_cast(float, u[j] & 0xffff0000u); u[j] = out; }
#pragma unroll
            for (int j = 0; j < SB; ++j) p[(size_t)(n0 + j) * 4096] = u[j]; } }
}
__device__ __forceinline__ void gla_c_item(const Mix1Bufs& B, const float* gw, const float* gb, const float* norm_w, int cn, LAS unsigned char* lds, int tid) {
    const int lane = tid & 63, wave = __builtin_amdgcn_readfirstlane(tid >> 6);
    const int bh = cn / NCH, n = cn % NCH, b = bh >> 2, h = bh & 3;
    const size_t t0 = (size_t)b * S_ + n * 64;
    LAS float* bc = (LAS float*)lds; LAS float* gl = (LAS float*)(lds + 16384);
    lbf16* qd = (lbf16*)(lds + 20480); lbf16* ki = (lbf16*)(lds + 29696); lbf16* vT = (lbf16*)(lds + 38912); lbf16* sT = (lbf16*)(lds + 57344); lbf16* att = (lbf16*)(lds + 75776);
    LAS float* ob = (LAS float*)(lds + 84992); LAS float* tot = (LAS float*)(lds + 118784);
    gla_gates(B.proj, gw, gb, t0, h, bc, gl, tot, tid);
    { const int l = tid >> 3, g = tid & 7; const bf16* pr = B.proj + (t0 + l) * PJ1 + h * 64 + g * 8; float qf[8], kf[8]; unpack8(*(const v4u*)(pr + 512), qf); unpack8(*(const v4u*)(pr + 768), kf);
#pragma unroll
      for (int j = 0; j < 8; ++j) { const float bb = bc[l * 64 + g * 8 + j]; qf[j] *= 0.125f * __expf(bb); kf[j] *= __expf(-bb); }
      *(LAS v4u*)(qd + l * 72 + g * 8) = pack8(qf); *(LAS v4u*)(ki + l * 72 + g * 8) = pack8(kf); }
#pragma unroll
    for (int it = 0; it < 2; ++it) { const int vi = tid + it * 512, l = vi & 63, g = vi >> 6; float vf[8]; unpack8(*(const v4u*)(B.proj + (t0 + l) * PJ1 + 1024 + h * 128 + g * 8), vf);
#pragma unroll
        for (int j = 0; j < 8; ++j) vT[(g * 8 + j) * 72 + l] = (unsigned short)f2bf(vf[j]); }
    { const bf16* sg = B.ut + (size_t)cn * 8192;
#pragma unroll
      for (int it = 0; it < 2; ++it) { const int vi = tid + it * 512, T = vi >> 7, ln = (vi >> 1) & 63, hr = vi & 1; const v4u x = *(const v4u*)(sg + vi * 8);
          LAS unsigned char* dp = (LAS unsigned char*)(sT + ((T >> 1) * 32 + (ln & 31)) * 72 + (T & 1) * 32 + 16 * hr + 4 * (ln >> 5));
          *(LAS v2u*)dp = (v2u){x.x, x.y}; *(LAS v2u*)(dp + 16) = (v2u){x.z, x.w}; } }
    __syncthreads();
    if (wave < 4) { const int it = wave >> 1, jt = wave & 1;
        f32x16 acc = {0.f, 0.f, 0.f, 0.f, 0.f, 0.f, 0.f, 0.f, 0.f, 0.f, 0.f, 0.f, 0.f, 0.f, 0.f, 0.f};
        if (jt <= it) mm32(acc, ki + jt * 32 * 72, 72, qd + it * 32 * 72, 72, 64, lane);
        const int i = it * 32 + (lane & 31);
#pragma unroll
        for (int g4 = 0; g4 < 4; ++g4) { const int j0 = jt * 32 + 8 * g4 + 4 * (lane >> 5);
            v2u o; o.x = pk2(j0 <= i ? acc[g4 * 4] : 0.f, j0 + 1 <= i ? acc[g4 * 4 + 1] : 0.f); o.y = pk2(j0 + 2 <= i ? acc[g4 * 4 + 2] : 0.f, j0 + 3 <= i ? acc[g4 * 4 + 3] : 0.f);
            *(LAS v2u*)(att + i * 72 + j0) = o; } }
    __syncthreads();
    { const int it = wave >> 2, nt = wave & 3;
      f32x16 acc = {0.f, 0.f, 0.f, 0.f, 0.f, 0.f, 0.f, 0.f, 0.f, 0.f, 0.f, 0.f, 0.f, 0.f, 0.f, 0.f};
      mm32(acc, vT + nt * 32 * 72, 72, att + it * 32 * 72, 72, 64, lane); mm32(acc, sT + nt * 32 * 72, 72, qd + it * 32 * 72, 72, 64, lane);
#pragma unroll
      for (int g4 = 0; g4 < 4; ++g4) *(LAS f32x4*)(ob + (it * 32 + (lane & 31)) * 132 + nt * 32 + 8 * g4 + 4 * (lane >> 5)) = (f32x4){acc[g4 * 4], acc[g4 * 4 + 1], acc[g4 * 4 + 2], acc[g4 * 4 + 3]}; }
    __syncthreads();
    { const int i = tid >> 3, sub = tid & 7; const LAS float* hr = ob + i * 132 + sub * 16;
      float x[16]; float q = 0.f;
#pragma unroll
      for (int j = 0; j < 16; ++j) { x[j] = hr[j]; q += x[j] * x[j]; }
      q += __builtin_bit_cast(float, __builtin_amdgcn_ds_swizzle(__builtin_bit_cast(int, q), 0x1f | (1 << 10)));
      q += __builtin_bit_cast(float, __builtin_amdgcn_ds_swizzle(__builtin_bit_cast(int, q), 0x1f | (2 << 10)));
      q += __builtin_bit_cast(float, __builtin_amdgcn_ds_swizzle(__builtin_bit_cast(int, q), 0x1f | (4 << 10)));
      const float rstd = __builtin_amdgcn_rsqf(q * (1.f / 128.f) + nv::EPS);
      const bf16* rp = B.proj + (t0 + i) * PJ1 + 1536 + h * 128 + sub * 16; const float* nw = norm_w + h * 128 + sub * 16;
      float r0[8], r1[8]; unpack8(*(const v4u*)rp, r0); unpack8(*(const v4u*)(rp + 8), r1);
      float y0[8], y1[8];
#pragma unroll
      for (int j = 0; j < 8; ++j) { y0[j] = x[j] * rstd * nw[j] * r0[j] * sigm_f(r0[j]); y1[j] = x[8 + j] * rstd * nw[8 + j] * r1[j] * sigm_f(r1[j]); }
      bf16* dst = B.mixbf + (t0 + i) * 1024 + 512 + h * 128 + sub * 16;
      *(v4u*)dst = pack8(y0); *(v4u*)(dst + 8) = pack8(y1); }
    __syncthreads();
}
__device__ __forceinline__ void s5_params(const Mix1Bufs& B, const float* const* in, int gtid, int gsz) {

    for (int idx = gtid; idx < 2048; idx += gsz) { const int g = idx >> 6;
        const float lr = in[17][idx], li = in[18][idx], dt = expf(in[24][g]);
        const float mag = expf(lr * dt), ar = mag * cosf(li * dt), ai = mag * sinf(li * dt);
        const float den = lr * lr + li * li, nr = ar - 1.0f, cr = (nr * lr + ai * li) / den, ci = (ai * lr - nr * li) / den;
        B.s5ab[idx * 2] = ar; B.s5ab[idx * 2 + 1] = ai;
        for (int h = 0; h < 16; ++h) { const float br = in[19][idx * 16 + h], bi = in[20][idx * 16 + h]; B.s5bb[idx * 32 + h] = cr * br - ci * bi; B.s5bb[idx * 32 + 16 + h] = cr * bi + ci * br; } }
    for (int idx = gtid; idx < 32 * 128 * 16; idx += gsz) { const int h = idx & 15, j = (idx >> 4) & 127, g = idx >> 11; const int gp = g * 64 + (j & 63);
        const float lr = in[17][gp], li = in[18][gp], dt = expf(in[24][g]);
        const float mag = expf(lr * dt), ar = mag * cosf(li * dt), ai = mag * sinf(li * dt);
        const float den = lr * lr + li * li, nr = ar - 1.0f, cr = (nr * lr + ai * li) / den, ci = (ai * lr - nr * li) / den;
        const float br = in[19][gp * 16 + h], bi = in[20][gp * 16 + h];
        B.bbt[idx] = (unsigned short)f2bf(j < 64 ? cr * br - ci * bi : cr * bi + ci * br); }
    for (int idx = gtid; idx < 32 * 32 * 128; idx += gsz) { const int k = idx & 127, hh = (idx >> 7) & 31, g = idx >> 12;
        float v = 0.f; if (hh < 16) v = k < 64 ? in[21][(g * 16 + hh) * 64 + k] : -in[22][(g * 16 + hh) * 64 + k - 64];
        B.cm[idx] = (unsigned short)f2bf(v); }
}
template <bool OUT> __device__ __forceinline__ void s5_chunk_v2(const Mix1Bufs& B, const float* dskip, int item, bool valid, LAS unsigned char* wl, int lane) {
    if (!valid) item = 0;
    const int n = item % NCH, g = (item / NCH) & 31, b = item / (NCH * 32);
    const size_t t0 = (size_t)b * S_ + n * 64; const int gp = g * 64 + lane;
    LAS float* bu = (LAS float*)wl;
    lbf16* xs = (lbf16*)(wl + 8192);
    const float ar = B.s5ab[gp * 2], ai = B.s5ab[gp * 2 + 1];
    float xr = 0.f, xi = 0.f;
    if (OUT) { xr = B.xstart[((size_t)item * 64 + lane) * 2]; xi = B.xstart[((size_t)item * 64 + lane) * 2 + 1]; }
    const bf16* bbt = B.bbt + (size_t)g * 2048 + (lane & 31) * 16 + 8 * (lane >> 5);
    for (int half = 0; half < 2; ++half) {
        const s16x8 a = *(const s16x8*)(B.proj + (t0 + half * 32 + (lane & 31)) * PJ1 + g * 16 + 8 * (lane >> 5));
        f32x16 acc[4];
#pragma unroll
        for (int nt = 0; nt < 4; ++nt) { const s16x8 bf = *(const s16x8*)(bbt + nt * 512);
            const f32x16 z = {0.f, 0.f, 0.f, 0.f, 0.f, 0.f, 0.f, 0.f, 0.f, 0.f, 0.f, 0.f, 0.f, 0.f, 0.f, 0.f};
            acc[nt] = __builtin_amdgcn_mfma_f32_32x32x16_bf16(a, bf, z, 0, 0, 0); }
#pragma unroll
        for (int q = 0; q < 2; ++q) {
#pragma unroll
            for (int nt = 0; nt < 4; ++nt)
#pragma unroll
                for (int rr = 0; rr < 8; ++rr) bu[((rr & 3) + 8 * (rr >> 2) + 4 * (lane >> 5)) * 128 + nt * 32 + (lane & 31)] = acc[nt][q * 8 + rr];
            __syncthreads();
#pragma unroll 4
            for (int l = 0; l < 16; ++l) { const float sr = bu[l * 128 + lane], si = bu[l * 128 + 64 + lane];
                const float nr = ar * xr - ai * xi + sr, ni = ar * xi + ai * xr + si; xr = nr; xi = ni;
                if (OUT) { xs[(q * 16 + l) * 136 + lane] = (unsigned short)f2bf(xr); xs[(q * 16 + l) * 136 + 64 + lane] = (unsigned short)f2bf(xi); } }
            __syncthreads();
        }
        if (OUT) {
            f32x16 acc2 = {0.f, 0.f, 0.f, 0.f, 0.f, 0.f, 0.f, 0.f, 0.f, 0.f, 0.f, 0.f, 0.f, 0.f, 0.f, 0.f};
            mm32_gb(acc2, xs, 136, B.cm + (size_t)g * 32 * 128, 128, 128, lane);
            const int hh = lane & 31;
            if (hh < 16 && valid) { const float dk = dskip[g * 16 + hh];
#pragma unroll
                for (int r = 0; r < 16; ++r) { const size_t t = t0 + half * 32 + rowmap(r, lane);
                    B.s5g[t * 512 + g * 16 + hh] = (unsigned short)f2bf(gelu_f(acc2[r] + dk * bf2f(B.proj[t * PJ1 + g * 16 + hh]))); } }
            __syncthreads();
        }
    }
    if (!OUT && valid) { B.xend[((size_t)item * 64 + lane) * 2] = xr; B.xend[((size_t)item * 64 + lane) * 2 + 1] = xi; }
}
template <bool OUT> __device__ __forceinline__ void s5_phase(const Mix1Bufs& B, const float* dskip, int gw, int NGW, LAS unsigned char* wl, int lane) {
    const int wpg = NGW >> 5, g_ = gw / wpg, j0 = gw - g_ * wpg; const bool gvalid = g_ < 32; const int g = gvalid ? g_ : 0;
    const int nit = (2 * NCH + wpg - 1) / wpg;
    const float ar = B.s5ab[(g * 64 + lane) * 2], ai = B.s5ab[(g * 64 + lane) * 2 + 1];
    s16x8 bf[4]; { const bf16* bbt = B.bbt + (size_t)g * 2048 + (lane & 31) * 16 + 8 * (lane >> 5);
#pragma unroll
        for (int nt = 0; nt < 4; ++nt) bf[nt] = *(const s16x8*)(bbt + nt * 512); }
    s16x8 cf[4]; float dk[4];
    if (OUT) { const bf16* cm = B.cm + (size_t)g * 32 * 128 + (lane & 15) * 128 + 8 * (lane >> 4);
#pragma unroll
        for (int ks = 0; ks < 4; ++ks) cf[ks] = *(const s16x8*)(cm + ks * 32);
#pragma unroll
        for (int r = 0; r < 4; ++r) dk[r] = dskip[g * 16 + 4 * (lane >> 4) + r]; }
    s16x8 na[2]; v2u nu[2][2]; float nxr = 0.f, nxi = 0.f;
#define S5_LOAD(kk) do { const int _i = j0 + (kk) * wpg; const int _idx = (gvalid && _i < 2 * NCH) ? _i : 0; const int _b = _idx / NCH, _n = _idx % NCH; const size_t _t0 = (size_t)_b * S_ + _n * 64; \
        const bf16* _p = B.proj + (_t0 + (lane & 31)) * PJ1 + g * 16 + 8 * (lane >> 5); na[0] = *(const s16x8*)_p; na[1] = *(const s16x8*)(_p + (size_t)32 * PJ1); \
        if (OUT) { const size_t _it = (size_t)(_b * 32 + g) * NCH + _n; const float2 _x = *(const float2*)(B.xstart + (_it * 64 + lane) * 2); nxr = _x.x; nxi = _x.y; \
            const bf16* _q = B.proj + (_t0 + (lane & 15)) * PJ1 + g * 16 + 4 * (lane >> 4); _Pragma("unroll") for (int _h = 0; _h < 2; ++_h) _Pragma("unroll") for (int _t = 0; _t < 2; ++_t) nu[_h][_t] = *(const v2u*)(_q + (size_t)(_h * 32 + _t * 16) * PJ1); } } while (0)
    S5_LOAD(0);
    for (int k = 0; k < nit; ++k) {
        const int i_ = j0 + k * wpg; const bool valid = gvalid && i_ < 2 * NCH; const int idx = valid ? i_ : 0; const int b = idx / NCH, n = idx % NCH;
        const size_t t0 = (size_t)b * S_ + n * 64; const size_t item = (size_t)(b * 32 + g) * NCH + n;
        s16x8 a[2] = {na[0], na[1]}; v2u uu[2][2] = {{nu[0][0], nu[0][1]}, {nu[1][0], nu[1][1]}}; float xr = OUT ? nxr : 0.f, xi = OUT ? nxi : 0.f;
        if (k + 1 < nit) S5_LOAD(k + 1);
#pragma unroll
        for (int half = 0; half < 2; ++half) {
            f32x16 acc[4];
#pragma unroll
            for (int nt = 0; nt < 4; ++nt) { const f32x16 z = {0.f, 0.f, 0.f, 0.f, 0.f, 0.f, 0.f, 0.f, 0.f, 0.f, 0.f, 0.f, 0.f, 0.f, 0.f, 0.f};
                acc[nt] = __builtin_amdgcn_mfma_f32_32x32x16_bf16(a[half], bf[nt], z, 0, 0, 0); }
            float sre[2][16], sim[2][16];
#pragma unroll
            for (int r = 0; r < 16; ++r) {
                { auto w = __builtin_amdgcn_permlane32_swap(__float_as_uint(acc[0][r]), __float_as_uint(acc[1][r]), false, false); sre[0][r] = __uint_as_float(w[0]); sre[1][r] = __uint_as_float(w[1]); }
                { auto w = __builtin_amdgcn_permlane32_swap(__float_as_uint(acc[2][r]), __float_as_uint(acc[3][r]), false, false); sim[0][r] = __uint_as_float(w[0]); sim[1][r] = __uint_as_float(w[1]); } }
            lbf16* xs = (lbf16*)(wl + half * 8704);
#pragma unroll
            for (int q = 0; q < 4; ++q)
#pragma unroll
                for (int wch = 0; wch < 2; ++wch)
#pragma unroll
                    for (int i = 0; i < 4; ++i) { const int r = q * 4 + i, tok = q * 8 + wch * 4 + i;
                        const float sr = sre[wch][r], si = sim[wch][r];
                        const float nr = ar * xr - ai * xi + sr, ni = ar * xi + ai * xr + si; xr = nr; xi = ni;
                        if (OUT) { xs[tok * 136 + lane] = (unsigned short)f2bf(xr); xs[tok * 136 + 64 + lane] = (unsigned short)f2bf(xi); } }
            if (OUT) {
                __syncthreads();
#pragma unroll
                for (int tt = 0; tt < 2; ++tt) { f32x4 y = {0.f, 0.f, 0.f, 0.f};
                    const lbf16* xp = xs + (tt * 16 + (lane & 15)) * 136 + 8 * (lane >> 4);
#pragma unroll
                    for (int ks = 0; ks < 4; ++ks) y = __builtin_amdgcn_mfma_f32_16x16x32_bf16(cf[ks], *(const LAS s16x8*)(xp + ks * 32), y, 0, 0, 0);
                    const v2u u = uu[half][tt];
                    const float u0 = __builtin_bit_cast(float, u.x << 16), u1 = __builtin_bit_cast(float, u.x & 0xffff0000u), u2 = __builtin_bit_cast(float, u.y << 16), u3 = __builtin_bit_cast(float, u.y & 0xffff0000u);
                    v2u o; o.x = pk2(gelu_f(y[0] + dk[0] * u0), gelu_f(y[1] + dk[1] * u1)); o.y = pk2(gelu_f(y[2] + dk[2] * u2), gelu_f(y[3] + dk[3] * u3));
                    if (valid) *(v2u*)(B.s5g + (t0 + half * 32 + tt * 16 + (lane & 15)) * 512 + g * 16 + 4 * (lane >> 4)) = o; }
            }
        }
        if (!OUT && valid) { float2 o; o.x = xr; o.y = xi; *(float2*)(B.xend + (item * 64 + lane) * 2) = o; }
    }
#undef S5_LOAD
}
__device__ __forceinline__ void s5_b(const Mix1Bufs& B, int gtid, int gsz) {
    for (int idx = gsz - 1 - gtid; idx < 2 * 2048; idx += gsz)   { const int b = idx >> 11, gp = idx & 2047, g = gp >> 6, p = gp & 63;
        float ar = B.s5ab[gp * 2], ai = B.s5ab[gp * 2 + 1];
#pragma unroll
        for (int q = 0; q < 6; ++q) { const float r2 = ar * ar - ai * ai, i2 = 2.f * ar * ai; ar = r2; ai = i2; }
        float xr = 0.f, xi = 0.f;
        const size_t o0 = ((size_t)((b * 32 + g) * NCH) * 64 + p) * 2;
        for (int n0 = 0; n0 < NCH; n0 += SB) { float er[SB], ei[SB];
#pragma unroll
            for (int j = 0; j < SB; ++j) { const size_t o = o0 + (size_t)(n0 + j) * 128; er[j] = B.xend[o]; ei[j] = B.xend[o + 1]; }
#pragma unroll
            for (int j = 0; j < SB; ++j) { const float sr = xr, si = xi; const float nr = ar * xr - ai * xi + er[j], ni = ar * xi + ai * xr + ei[j]; xr = nr; xi = ni; er[j] = sr; ei[j] = si; }
#pragma unroll
            for (int j = 0; j < SB; ++j) { const size_t o = o0 + (size_t)(n0 + j) * 128; B.xstart[o] = er[j]; B.xstart[o + 1] = ei[j]; } } }
}
typedef float f32x4v __attribute__((ext_vector_type(4)));
struct RouterBufs { const float* z; float* h; bf16* hbf; const float* lnw; const float* lnb; const bf16* rwh; const bf16* rwl; const float* rbias; int* ridx; float* rwt; unsigned* cnt; };
__device__ __forceinline__ void router_split_weights(const float* rw, bf16* hi, bf16* lo, int gtid, int gsz) {
    for (int i = gtid; i < 64 * 1024; i += gsz) { const int e = i >> 10, k = i & 1023; const float w = rw[k * 64 + e]; const unsigned h = f2bf(w); hi[i] = (unsigned short)h; lo[i] = (unsigned short)f2bf(w - __builtin_bit_cast(float, h << 16)); }
}
__device__ __forceinline__ void router_select(const LAS float* sc, const float* bias, int* ridx, float* rwt, LAS unsigned* hist) {
    float gs[8];
#pragma unroll
    for (int g = 0; g < 8; ++g) { float m1 = -INFINITY, m2 = -INFINITY;
#pragma unroll
        for (int j = 0; j < 8; ++j) { const float v = sc[g * 8 + j] + bias[g * 8 + j]; if (v > m1) { m2 = m1; m1 = v; } else if (v > m2) m2 = v; }
        gs[g] = m1 + m2; }
    unsigned gsel = 0;
#pragma unroll
    for (int it = 0; it < 4; ++it) { float best = -INFINITY; int bi = 0;
#pragma unroll
        for (int g = 0; g < 8; ++g) { const bool ok = !((gsel >> g) & 1u) && gs[g] > best; best = ok ? gs[g] : best; bi = ok ? g : bi; }
        gsel |= 1u << bi; }
    unsigned long long taken = 0ull; float wsum = 0.f; float wv[8]; int ev[8];
#pragma unroll
    for (int it = 0; it < 8; ++it) { float best = -INFINITY; int bi = 0;
#pragma unroll 1
        for (int e = 0; e < 64; ++e) { const bool ok = ((gsel >> (e >> 3)) & 1u) && !((taken >> e) & 1ull); const float v = sc[e] + bias[e]; if (ok && v > best) { best = v; bi = e; } }
        taken |= 1ull << bi; ev[it] = bi; wv[it] = sc[bi]; wsum += wv[it]; }
    const float inv = 2.5f / wsum;
#pragma unroll
    for (int it = 0; it < 8; ++it) { ridx[it] = ev[it]; rwt[it] = wv[it] * inv; atomicAdd((unsigned*)&hist[ev[it]], 1u); }
}
__device__ __forceinline__ float wave_max_f(float v) {
#define WM_STEP(o) v = fmaxf(v, __builtin_bit_cast(float, __builtin_amdgcn_ds_swizzle(__builtin_bit_cast(int, v), 0x1f | ((o) << 10))))
    WM_STEP(1); WM_STEP(2); WM_STEP(4); WM_STEP(8); WM_STEP(16);
#undef WM_STEP
    return fmaxf(__builtin_bit_cast(float, __builtin_amdgcn_readlane(__builtin_bit_cast(int, v), 0)), __builtin_bit_cast(float, __builtin_amdgcn_readlane(__builtin_bit_cast(int, v), 32)));
}
__device__ __forceinline__ void router_tiles(const RouterBufs& R, int tile0, int tstride, int ntiles, LAS unsigned char* lds, int tid, bool count = true) {
    const int lane = tid & 63, wave = __builtin_amdgcn_readfirstlane(tid >> 6);
    lbf16* Ahi = (lbf16*)lds; lbf16* Alo = (lbf16*)(lds + 33024); LAS float* part = (LAS float*)(lds + 66048); LAS unsigned* hist = (LAS unsigned*)(lds + 102912);
    if (tile0 >= ntiles) return;
    const int row16 = lane & 15, kq = 8 * (lane >> 4);
    s16x8 bh[4][4], bl[4][4];
#pragma unroll
    for (int ks = 0; ks < 4; ++ks)
#pragma unroll
        for (int nt = 0; nt < 4; ++nt) { const size_t o = (size_t)(nt * 16 + row16) * 1024 + wave * 128 + ks * 32 + kq; bh[ks][nt] = *(const s16x8*)(R.rwh + o); bl[ks][nt] = *(const s16x8*)(R.rwl + o); }
    const float bias = R.rbias[lane];
    f32x4 zr[2][4];
#define RT_LOAD(tile) do { _Pragma("unroll") for (int q = 0; q < 2; ++q) { const float* zp = R.z + ((size_t)(tile) * 16 + wave * 2 + q) * 1024 + lane * 8; \
        zr[q][0] = *(const f32x4*)zp; zr[q][1] = *(const f32x4*)(zp + 4); zr[q][2] = *(const f32x4*)(zp + 512); zr[q][3] = *(const f32x4*)(zp + 516); } } while (0)
    RT_LOAD(tile0);
    if (tid < 64) hist[tid] = 0u;
    LAS float* lnl = (LAS float*)(lds + 103424);
    if (tid < 256) *(LAS f32x4*)(lnl + tid * 4) = *(const f32x4*)(R.lnw + tid * 4); else *(LAS f32x4*)(lnl + 1024 + (tid - 256) * 4) = *(const f32x4*)(R.lnb + (tid - 256) * 4);
    __syncthreads();
    for (int tile = tile0; tile < ntiles; tile += tstride) {
#pragma unroll
        for (int q = 0; q < 2; ++q) { const int row = wave * 2 + q; const size_t t = (size_t)tile * 16 + row;
            float v[16] = {zr[q][0].x, zr[q][0].y, zr[q][0].z, zr[q][0].w, zr[q][1].x, zr[q][1].y, zr[q][1].z, zr[q][1].w, zr[q][2].x, zr[q][2].y, zr[q][2].z, zr[q][2].w, zr[q][3].x, zr[q][3].y, zr[q][3].z, zr[q][3].w};
            float sum = 0.f;
#pragma unroll
            for (int j = 0; j < 16; ++j) sum += v[j];
            sum = wave_sum(sum); const float mean = sum * (1.f / 1024.f); float sq = 0.f;
#pragma unroll
            for (int j = 0; j < 16; ++j) { v[j] -= mean; sq += v[j] * v[j]; }
            sq = wave_sum(sq); const float rstd = 1.0f / sqrtf(sq * (1.f / 1024.f) + nv::EPS);
#pragma unroll
            for (int half = 0; half < 2; ++half) { const int c0 = half * 512 + lane * 8;
                const f32x4 w0 = *(const LAS f32x4*)(lnl + c0), w1 = *(const LAS f32x4*)(lnl + c0 + 4), b0 = *(const LAS f32x4*)(lnl + 1024 + c0), b1 = *(const LAS f32x4*)(lnl + 1024 + c0 + 4);
                float o[8] = {v[half * 8 + 0] * rstd * w0.x + b0.x, v[half * 8 + 1] * rstd * w0.y + b0.y, v[half * 8 + 2] * rstd * w0.z + b0.z, v[half * 8 + 3] * rstd * w0.w + b0.w,
                              v[half * 8 + 4] * rstd * w1.x + b1.x, v[half * 8 + 5] * rstd * w1.y + b1.y, v[half * 8 + 6] * rstd * w1.z + b1.z, v[half * 8 + 7] * rstd * w1.w + b1.w};
                *(f32x4*)(R.h + t * 1024 + c0) = (f32x4){o[0], o[1], o[2], o[3]}; *(f32x4*)(R.h + t * 1024 + c0 + 4) = (f32x4){o[4], o[5], o[6], o[7]};
                const v4u hi = pack8(o); float hf[8], lo[8]; unpack8(hi, hf);
#pragma unroll
                for (int j = 0; j < 8; ++j) lo[j] = o[j] - hf[j];
                *(v4u*)(R.hbf + t * 1024 + c0) = hi; *(LAS v4u*)(Ahi + row * 1032 + c0) = hi; *(LAS v4u*)(Alo + row * 1032 + c0) = pack8(lo); } }
        if (tile + tstride < ntiles) RT_LOAD(tile + tstride);
        __syncthreads();
        { f32x4v acc[4] = {{0.f, 0.f, 0.f, 0.f}, {0.f, 0.f, 0.f, 0.f}, {0.f, 0.f, 0.f, 0.f}, {0.f, 0.f, 0.f, 0.f}};
#pragma unroll
          for (int ks = 0; ks < 4; ++ks) { const int k0 = wave * 128 + ks * 32 + kq;
              const s16x8 ah = *(const LAS s16x8*)(Ahi + row16 * 1032 + k0), al = *(const LAS s16x8*)(Alo + row16 * 1032 + k0);
#pragma unroll
              for (int nt = 0; nt < 4; ++nt) {
                  acc[nt] = __builtin_amdgcn_mfma_f32_16x16x32_bf16(ah, bh[ks][nt], acc[nt], 0, 0, 0);
                  acc[nt] = __builtin_amdgcn_mfma_f32_16x16x32_bf16(al, bh[ks][nt], acc[nt], 0, 0, 0);
                  acc[nt] = __builtin_amdgcn_mfma_f32_16x16x32_bf16(ah, bl[ks][nt], acc[nt], 0, 0, 0); } }
#pragma unroll
          for (int nt = 0; nt < 4; ++nt)
#pragma unroll
              for (int r = 0; r < 4; ++r) part[(wave * 16 + (lane >> 4) * 4 + r) * 64 + nt * 16 + (lane & 15)] = acc[nt][r]; }
        __syncthreads();
#define SWZ_MAX(x, o) fmaxf(x, __builtin_bit_cast(float, __builtin_amdgcn_ds_swizzle(__builtin_bit_cast(int, x), 0x1f | ((o) << 10))))
#define SWZ_ADD(x, o) ((x) + __builtin_bit_cast(float, __builtin_amdgcn_ds_swizzle(__builtin_bit_cast(int, x), 0x1f | ((o) << 10))))
#pragma unroll
        for (int q = 0; q < 2; ++q) { const int tk = wave * 2 + q; const size_t t = (size_t)tile * 16 + tk;
            float lg = 0.f;
#pragma unroll
            for (int w = 0; w < 8; ++w) lg += part[(w * 16 + tk) * 64 + lane];
            const float s = 1.0f / (1.0f + expf(-lg)), v = s + bias;
            float m1 = v; m1 = SWZ_MAX(m1, 1); m1 = SWZ_MAX(m1, 2); m1 = SWZ_MAX(m1, 4);
            float c1 = (v == m1) ? 1.f : 0.f; c1 = SWZ_ADD(c1, 1); c1 = SWZ_ADD(c1, 2); c1 = SWZ_ADD(c1, 4);
            float m2 = (v == m1) ? -INFINITY : v; m2 = SWZ_MAX(m2, 1); m2 = SWZ_MAX(m2, 2); m2 = SWZ_MAX(m2, 4);
            const float gs = m1 + (c1 >= 2.f ? m1 : m2);
            int grank = 0; const int g = lane >> 3;
#pragma unroll
            for (int j = 0; j < 8; ++j) { const float x = __builtin_bit_cast(float, __builtin_amdgcn_readlane(__builtin_bit_cast(int, gs), j * 8)); grank += (x > gs || (x == gs && j < g)) ? 1 : 0; }
            const bool gsel = grank < 4; float cv = gsel ? v : -INFINITY; int rank = 8;
#pragma unroll
            for (int it = 0; it < 8; ++it) { const float m = wave_max_f(cv); const unsigned long long bal = __builtin_amdgcn_ballot_w64(cv == m); const int wl = __builtin_ctzll(bal);
                if (lane == wl) { rank = it; cv = -INFINITY; } }
            const bool sel = rank < 8;
            const float wsum = wave_sum(sel ? s : 0.f);
            if (sel) { R.ridx[t * 8 + rank] = lane; R.rwt[t * 8 + rank] = s * (2.5f / wsum); atomicAdd((unsigned*)&hist[lane], 1u); } }
#undef SWZ_MAX
#undef SWZ_ADD
    }
#undef RT_LOAD
    __syncthreads();
    if (count && tid < 64 && hist[tid]) atomicAdd(&R.cnt[tid], hist[tid]);
    __syncthreads();
}
#ifndef DUP_PHASE
#define DUP_PHASE -1
#endif
constexpr int CTX_OFF = LDS_CTL + 1024, TAB_OFF = LDS_CTL + 7168;
constexpr size_t WS_WINE = 1 * MiB, WS_WINO = WS_WINE + (size_t)EINP * 1024 * 2, WS_WOUT = WS_WINO + (size_t)OINP * 1024 * 2, WS_XBF = 16 * MiB, WS_NAIVE = 80 * MiB;
#if defined(WITH_NAIVE)
constexpr size_t WS_MIXBF = 48 * MiB;
#else
constexpr size_t WS_MIXBF = 453 * MiB;
#endif
__device__ __forceinline__ int conv_split(int nwg, int G) {
#if defined(WITH_NAIVE)
    return 0;
#else
    const int rem = nwg % G; return rem == 0 ? 0 : (G - rem) * NWAVES * 4;
#endif
}
static_assert(WS_WOUT + 2 * 1024 * 1024 * 2 <= WS_XBF, "ws map");
constexpr size_t WS_WD = 48 * MiB, WS_WGU = WS_WD + 65 * 512 * 1024, WS_LISTS = 146 * MiB, WS_RIDX = 148 * MiB, WS_H = 149 * MiB, WS_ROWS8 = 229 * MiB;
static_assert(WS_WGU + (size_t)65 * 1024 * 1024 <= WS_LISTS && WS_H + (size_t)MOE_MAXBLK * 256 * 512 <= WS_ROWS8 && WS_ROWS8 + (size_t)nv::T_ * 8 * 2048 <= 512 * MiB, "moe ws map");
constexpr size_t WS_PROJB = 149 * MiB, WS_CT = 253 * MiB, WS_HLOC = 317 * MiB, WS_PC = 349 * MiB, WS_M0SMALL = 381 * MiB, WS_LRUW = 486 * MiB;
constexpr size_t WS_UT = 221 * MiB, WS_S5G = 253 * MiB, WS_M1SMALL = 269 * MiB, WS_GLUW = 486 * MiB + 256 * 1024;
constexpr size_t WS_RW = 487 * MiB;
constexpr int CW_PROBE = 9000;
struct Tab { const float* in[38]; float* out; unsigned char* ws; };
struct Env { const Tab* tab; unsigned char* ws; float* out; LAS unsigned char* lds; int tid, lane, wave, bid, G, gw, NGW, gtid, gsz, vcu; };
__device__ __forceinline__ Env penv(unsigned char* lds_raw) {
    Env e; e.tab = (const Tab*)(lds_raw + TAB_OFF); e.ws = e.tab->ws; e.out = e.tab->out; e.lds = (LAS unsigned char*)lds_raw;
    int t = threadIdx.x; asm volatile("" : "+v"(t)); e.tid = t; e.lane = t & 63; e.wave = __builtin_amdgcn_readfirstlane(t >> 6);
    int b = blockIdx.x; asm volatile("" : "+s"(b)); e.bid = b; int g = gridDim.x; asm volatile("" : "+s"(g)); e.G = g;
    e.vcu = (g % 8 == 0) ? (b % 8) * (g / 8) + b / 8 : b;
    e.gw = b * NWAVES + e.wave; e.NGW = g * NWAVES; e.gtid = b * NTHREADS + t; e.gsz = g * NTHREADS;
    return e;
}
__device__ __forceinline__ void grid_bar(const Env& e) {
    XcdBarrier b; b.bar = (unsigned*)e.ws + 4096; b.x = xb_xcc_id(); b.st = (volatile LAS unsigned*)(e.lds + MISC_OFF) + 8;
    xcd_barrier(b);
}
#if defined(WITH_NAIVE)
template <int ST> __device__ __forceinline__ void run_naive(unsigned char* lds_raw, int ci, long n) {
    const Env e = penv(lds_raw);
    const nv::Ctx& c = ((const nv::Ctx*)(lds_raw + CTX_OFF))[ci];
    for (long i = e.gtid; i < n; i += e.gsz) nv::item<ST>(c, i);
    grid_bar(e);
}
#endif
__device__ __forceinline__ void phase_p0(unsigned char* lds_raw) {
    const Env e = penv(lds_raw);
    LAS float* scr = (LAS float*)(e.lds + e.wave * 16640);
    constexpr int I0 = 16 * (EINP / 64), I1 = I0 + 16 * (OINP / 64), I2 = I1 + 256, I3 = I2 + 256, I4 = I3 + 32, I5 = I4 + 64;
    for (int it = e.gw; it < I5; it += e.NGW) {
        if (it < I0) tr_matrix_item(e.tab->in[6], 1024, nv::EIN, EINP, (bf16*)(e.ws + WS_WINE), scr, it, e.lane);
        else if (it < I1) tr_matrix_item(e.tab->in[16], 1024, nv::OIN, OINP, (bf16*)(e.ws + WS_WINO), scr, it - I0, e.lane);
        else if (it < I2) tr_matrix_item(e.tab->in[5], 1024, 1024, 1024, (bf16*)(e.ws + WS_WOUT), scr, it - I1, e.lane);
        else if (it < I3) tr_matrix_item(e.tab->in[5] + 1024 * 1024, 1024, 1024, 1024, (bf16*)(e.ws + WS_WOUT) + 1024 * 1024, scr, it - I2, e.lane);
        else if (it < I4) { const int r = it - I3, mtx = r >> 2, h = mtx & 3, which = mtx >> 2;
            tr_matrix_item(e.tab->in[which ? 13 : 11] + h * 16384, 128, 128, 128, (bf16*)(e.ws + WS_LRUW) + which * 65536 + h * 16384, scr, r & 3, e.lane); }
        else tr_matrix_item(e.tab->in[25], 512, 512, 512, (bf16*)(e.ws + WS_GLUW), scr, it - I4, e.lane);
    }
    for (int l = 0; l < 2; ++l) router_split_weights(e.tab->in[30] + (size_t)l * 65536, (bf16*)(e.ws + WS_RW) + (size_t)l * 131072, (bf16*)(e.ws + WS_RW) + (size_t)l * 131072 + 65536, e.gtid, e.gsz);
    cvt_rows(e.tab->in[0], (bf16*)(e.ws + WS_XBF), (long)T_ * 1024, e.gtid, e.gsz);
    grid_bar(e);
}
__device__ __forceinline__ void phase_inproj(unsigned char* lds_raw, int layer) {
    const Env e = penv(lds_raw);
    float* proj = (float*)(e.ws + WS_NAIVE) + ((size_t)T_ * 1024 + (size_t)T_ * 64 + (size_t)T_ * 8 * 2);
    const int NP = layer == 0 ? EINP : OINP;
    pg8::Gemm g{(const bf16*)(e.ws + WS_XBF), (const bf16*)(e.ws + (layer == 0 ? WS_WINE : WS_WINO)), 1024, 0, 0, nullptr};
    pg8::StaticOrder S; S.init(T_, NP, e.G, e.bid);
    pg8::EpiF32R E{proj, NP, nullptr, 0.f};
    pg8::gemm_phase<pg8::EpiF32R, pg8::StaticOrder, true, false>(e.lds, g, S, E);
    grid_bar(e);
}
__device__ __forceinline__ void phase_cvt_mixed(unsigned char* lds_raw) {
    const Env e = penv(lds_raw);
    cvt_rows((const float*)(e.ws + WS_NAIVE), (bf16*)(e.ws + WS_MIXBF), (long)T_ * 1024, e.gtid, e.gsz);
    grid_bar(e);
}
__device__ __forceinline__ void phase_outproj(unsigned char* lds_raw, int layer) {
    const Env e = penv(lds_raw);
    float* z = (float*)(e.ws + WS_NAIVE) + ((size_t)T_ * 1024 + (size_t)T_ * 64 + (size_t)T_ * 8 * 2);
    const float* hcur = layer == 0 ? e.tab->in[0] : e.out;
    pg8::Gemm g{(const bf16*)(e.ws + WS_MIXBF), (const bf16*)(e.ws + WS_WOUT) + (size_t)layer * 1024 * 1024, 1024, 0, 0, nullptr};
    pg8::StaticOrder S; S.init(T_, 1024, e.G, e.bid);
    pg8::EpiF32R E{z, 1024, hcur, nv::ALPHA};
    pg8::gemm_phase<pg8::EpiF32R, pg8::StaticOrder, true, false>(e.lds, g, S, E);
    grid_bar(e);
}
__device__ __forceinline__ Mix0Bufs mix0_bufs(unsigned char* ws) {
    Mix0Bufs B; B.proj = (const bf16*)(ws + WS_PROJB); B.ct = (bf16*)(ws + WS_CT); B.hloc = (bf16*)(ws + WS_HLOC); B.pc = (bf16*)(ws + WS_PC);
    float* sm = (float*)(ws + WS_M0SMALL); B.nloc = sm; sm += 8 * NCH * 128; B.blast = sm; sm += 8 * NCH; B.mloc = sm; sm += 8 * NCH; B.mprev = sm; sm += 8 * NCH;
    B.carA = sm; sm += 2 * NCH * 512; B.carU = sm; sm += 2 * NCH * 512; B.carI = sm; sm += 2 * NCH * 512; B.gst = sm;
    B.mixbf = (bf16*)(ws + WS_MIXBF); B.lruw = (const bf16*)(ws + WS_LRUW); return B;
}
__device__ __forceinline__ Mix1Bufs mix1_bufs(unsigned char* ws) {
    Mix1Bufs B; B.proj = (const bf16*)(ws + WS_PROJB); B.ut = (bf16*)(ws + WS_UT); B.s5g = (bf16*)(ws + WS_S5G);
    float* sm = (float*)(ws + WS_M1SMALL); B.gbl = sm; sm += 8 * NCH * 64; B.xend = sm; sm += 8192 * 128; B.xstart = sm; sm += 8192 * 128; B.s5ab = sm; sm += 4096; B.s5bb = sm; sm += 2048 * 32;
    B.cm = (bf16*)sm; B.bbt = B.cm + 32 * 32 * 128; B.mixbf = (bf16*)(ws + WS_MIXBF); return B;
}
__device__ __forceinline__ void phase_inproj_bf16(unsigned char* lds_raw, int layer) {
    const Env e = penv(lds_raw);
    const int NP = layer == 0 ? EINP : OINP;
    if (layer == 1) { const Mix1Bufs B = mix1_bufs(e.ws); s5_params(B, e.tab->in, e.gtid, e.gsz); }
    pg8::Gemm g{(const bf16*)(e.ws + WS_XBF), (const bf16*)(e.ws + (layer == 0 ? WS_WINE : WS_WINO)), 1024, 0, 0, nullptr};
    pg8::StaticOrder S; S.init(T_, NP, e.G, e.bid);
    pg8::EpiBf16P E{(bf16*)(e.ws + WS_PROJB), NP};
    pg8::gemm_phase<pg8::EpiBf16P, pg8::StaticOrder, true, false>(e.lds, g, S, E);
    { const int nwg = (T_ / 256) * (NP / 256), rem = nwg % e.G, na = conv_split(nwg, e.G);
      if (na > 0 && e.bid >= rem) { const int nlight = e.G - rem; LAS float* scr = (LAS float*)(e.lds + e.wave * 16640);
          moe_convert_weights(e.tab->in[32] + (size_t)layer * 64 * 262144, e.tab->in[33] + (size_t)layer * 64 * 262144, e.tab->in[34] + (size_t)layer * 64 * 262144,
                              e.tab->in[35] + (size_t)layer * 262144, e.tab->in[36] + (size_t)layer * 262144, e.tab->in[37] + (size_t)layer * 262144,
                              (bf16*)(e.ws + WS_WGU), (bf16*)(e.ws + WS_WD), scr, (e.bid - rem) * NWAVES + e.wave, na, nlight * NWAVES, e.lane); } }
    grid_bar(e);
}
__device__ __forceinline__ void phase_mix0_a(unsigned char* lds_raw) {
    const Env e = penv(lds_raw); const Mix0Bufs B = mix0_bufs(e.ws);
    for (int it = e.bid; it < 256 + 8 * NCH; it += e.G) {
        if (it < 256) { lru_a_item(B, e.tab->in, it, e.lds, e.tid); if (DUP_PHASE == 31) lru_a_item(B, e.tab->in, it, e.lds, e.tid); }
        else { mlstm_a_item(B, e.tab->in[7], it - 256, e.lds, e.tid); if (DUP_PHASE == 30) mlstm_a_item(B, e.tab->in[7], it - 256, e.lds, e.tid); } }
    grid_bar(e);
}
__device__ __forceinline__ int conv_rest(int nwg, int G, int NGW) {
#if defined(WITH_NAIVE)
    return 0;
#else
    const int nb = conv_split(nwg, G) + NGW * 3; return nb > 65 * 192 ? 65 * 192 : nb;
#endif
}
__device__ __forceinline__ void conv_in_scan_phase(const Env& e, int layer) {
#if !defined(WITH_NAIVE)
    const int na = conv_split((T_ / 256) * ((layer == 0 ? EINP : OINP) / 256), e.G); int nb = na + e.NGW * 3; if (nb > 65 * 192) nb = 65 * 192;
    LAS float* scr = (LAS float*)(e.lds + e.wave * 16640);
    moe_convert_weights(e.tab->in[32] + (size_t)layer * 64 * 262144, e.tab->in[33] + (size_t)layer * 64 * 262144, e.tab->in[34] + (size_t)layer * 64 * 262144,
                        e.tab->in[35] + (size_t)layer * 262144, e.tab->in[36] + (size_t)layer * 262144, e.tab->in[37] + (size_t)layer * 262144,
                        (bf16*)(e.ws + WS_WGU), (bf16*)(e.ws + WS_WD), scr, na + e.gw, nb, e.NGW, e.lane);
#endif
}
__device__ __forceinline__ void phase_mix0_b(unsigned char* lds_raw) {
    const Env e = penv(lds_raw); const Mix0Bufs B = mix0_bufs(e.ws);
    lru_b(B, e.gtid, e.gsz); mlstm_b(B, e.gtid, e.gsz);
    grid_bar(e);
}
__device__ __forceinline__ void phase_mix0_c(unsigned char* lds_raw) {
    const Env e = penv(lds_raw); const Mix0Bufs B = mix0_bufs(e.ws);
    for (int it = e.bid; it < 8 * NCH; it += e.G) { mlstm_c_item(B, e.tab->in[7], e.tab->in[8], it, e.lds, e.tid); if (DUP_PHASE == 32) mlstm_c_item(B, e.tab->in[7], e.tab->in[8], it, e.lds, e.tid); }
    lru_c(B, e.gtid, e.gsz); if (DUP_PHASE == 33) lru_c(B, e.gtid, e.gsz);
    grid_bar(e);
}
__device__ __forceinline__ void phase_mix1_a(unsigned char* lds_raw) {
    const Env e = penv(lds_raw); const Mix1Bufs B = mix1_bufs(e.ws);
    for (int it = e.bid; it < 8 * NCH; it += e.G) { gla_a_item(B, e.tab->in[27], e.tab->in[28], it, e.lds, e.tid); if (DUP_PHASE == 34) gla_a_item(B, e.tab->in[27], e.tab->in[28], it, e.lds, e.tid); }
    s5_phase<false>(B, e.tab->in[23], e.gw, e.NGW, e.lds + e.wave * 17408, e.lane); if (DUP_PHASE == 35) s5_phase<false>(B, e.tab->in[23], e.gw, e.NGW, e.lds + e.wave * 17408, e.lane);
    grid_bar(e);
}
__device__ __forceinline__ void phase_mix1_b(unsigned char* lds_raw) {
    const Env e = penv(lds_raw); const Mix1Bufs B = mix1_bufs(e.ws);
    s5_b(B, e.gtid, e.gsz); gla_b(B, e.gtid, e.gsz);
    grid_bar(e);
}
__device__ __forceinline__ void phase_mix1_c(unsigned char* lds_raw) {
    const Env e = penv(lds_raw); const Mix1Bufs B = mix1_bufs(e.ws);
    for (int it = e.bid; it < 8 * NCH; it += e.G) { gla_c_item(B, e.tab->in[27], e.tab->in[28], e.tab->in[29], it, e.lds, e.tid); if (DUP_PHASE == 36) gla_c_item(B, e.tab->in[27], e.tab->in[28], e.tab->in[29], it, e.lds, e.tid); }
#if defined(S5_OLD_C)
    for (int it = e.gw, k = 0; k < (2 * 32 * NCH + e.NGW - 1) / e.NGW; ++k, it += e.NGW) s5_chunk_v2<true>(B, e.tab->in[23], it, it < 2 * 32 * NCH, e.lds + e.wave * 16896, e.lane);
#else
    s5_phase<true>(B, e.tab->in[23], e.gw, e.NGW, e.lds + e.wave * 17408, e.lane); if (DUP_PHASE == 37) s5_phase<true>(B, e.tab->in[23], e.gw, e.NGW, e.lds + e.wave * 17408, e.lane);
#endif
    grid_bar(e);
}
__device__ __forceinline__ void phase_glu(unsigned char* lds_raw) {
    const Env e = penv(lds_raw);
    pg8::Gemm g{(const bf16*)(e.ws + WS_S5G), (const bf16*)(e.ws + WS_GLUW), 512, 0, 0, nullptr};
    pg8::StaticOrder S; S.init(T_, 512, e.G, e.bid);
    pg8::EpiGlu E{(bf16*)(e.ws + WS_MIXBF), 1024, (const bf16*)(e.ws + WS_S5G), 512, e.tab->in[26]};
    pg8::gemm_phase<pg8::EpiGlu, pg8::StaticOrder, true, false>(e.lds, g, S, E);
    grid_bar(e);
}
__device__ __forceinline__ void phase_probe(unsigned char* lds_raw, int c0, int c1) {
    const Env e = penv(lds_raw);
    const bf16* a = (const bf16*)(e.ws + WS_MIXBF); const float* b = (const float*)(e.ws + WS_NAIVE);
    float sd = 0.f, sr = 0.f; const int w = c1 - c0;
    for (long i = e.gtid; i < (long)T_ * w; i += e.gsz) { const long t = i / w; const int c = c0 + (int)(i % w); const float x = bf2f(a[t * 1024 + c]), y = b[t * 1024 + c]; sd += (x - y) * (x - y); sr += y * y; }
    sd = wave_sum(sd); sr = wave_sum(sr);
    if (e.lane == 0) { atomicAdd((float*)e.ws + CW_PROBE, sd); atomicAdd((float*)e.ws + CW_PROBE + 1, sr); }
    grid_bar(e);
}
__device__ __forceinline__ void phase_probe_apply(unsigned char* lds_raw) {
    const Env e = penv(lds_raw);
    const float sd = __hip_atomic_load((float*)e.ws + CW_PROBE, __ATOMIC_RELAXED, __HIP_MEMORY_SCOPE_AGENT), sr = __hip_atomic_load((float*)e.ws + CW_PROBE + 1, __ATOMIC_RELAXED, __HIP_MEMORY_SCOPE_AGENT);
    const float f = 1.0f + 10.0f * sqrtf(sd / fmaxf(sr, 1e-30f));
    for (long i = e.gtid; i < (long)T_ * 1024; i += e.gsz) e.out[i] *= f;
}
__device__ __forceinline__ void phase_ln_router(unsigned char* lds_raw, int layer, bool count = true) {
    const Env e = penv(lds_raw);
    RouterBufs R; R.z = (const float*)(e.ws + WS_NAIVE) + ((size_t)T_ * 1024 + (size_t)T_ * 64 + (size_t)T_ * 8 * 2); R.h = e.out; R.hbf = (bf16*)(e.ws + WS_XBF);
    R.lnw = e.tab->in[1] + layer * 1024; R.lnb = e.tab->in[2] + layer * 1024; R.rwh = (const bf16*)(e.ws + WS_RW) + (size_t)layer * 131072; R.rwl = R.rwh + 65536;
    R.rbias = e.tab->in[31] + layer * 64; R.ridx = (int*)(e.ws + WS_RIDX); R.rwt = (float*)(e.ws + WS_RIDX) + (size_t)T_ * 8; R.cnt = (unsigned*)e.ws + CW_CNT + layer * 256;
    router_tiles(R, e.bid, e.G, T_ / 16, e.lds, e.tid, count);
    grid_bar(e);
}
__device__ __forceinline__ MoeLists moe_lists(unsigned char* ws) {
    MoeLists L; L.tok = (int*)(ws + WS_LISTS); L.dest = L.tok + MOE_MAXBLK * 256; L.w = (float*)(L.dest + MOE_MAXBLK * 256); L.blk_e = (int*)(L.w + MOE_MAXBLK * 256); return L;
}
__device__ __forceinline__ void phase_moe_x1(unsigned char* lds_raw, int layer, int curoff = 0) {
    const Env e = penv(lds_raw);
    moe_build_lists((const int*)(e.ws + WS_RIDX), (const float*)(e.ws + WS_RIDX) + (size_t)T_ * 8, (unsigned*)e.ws + CW_CNT + layer * 256, (unsigned*)e.ws + CW_CUR + layer * 256 + curoff,
                    moe_lists(e.ws), (LAS int*)e.lds, e.tid, e.bid, e.G);
    LAS float* scr = (LAS float*)(e.lds + e.wave * 16640);
    moe_convert_weights(e.tab->in[32] + (size_t)layer * 64 * 262144, e.tab->in[33] + (size_t)layer * 64 * 262144, e.tab->in[34] + (size_t)layer * 64 * 262144,
                        e.tab->in[35] + (size_t)layer * 262144, e.tab->in[36] + (size_t)layer * 262144, e.tab->in[37] + (size_t)layer * 262144,
                        (bf16*)(e.ws + WS_WGU), (bf16*)(e.ws + WS_WD), scr, conv_split((T_ / 256) * ((layer == 0 ? EINP : OINP) / 256), e.G) + e.gw, 65 * 192, e.NGW, e.lane);
    grid_bar(e);
}
__device__ __forceinline__ void phase_moe_g1(unsigned char* lds_raw) {
    const Env e = penv(lds_raw);
    const MoeLists L = moe_lists(e.ws);
    const int nblk = __builtin_amdgcn_readfirstlane(L.blk_e[MOE_MAXBLK]);
    pg8::Gemm g{(const bf16*)(e.ws + WS_XBF), (const bf16*)(e.ws + WS_WGU), 1024, 0, (size_t)512 * 1024, L.tok};
    pg8::MoeOrder S{L.blk_e, nblk, 2, e.G, e.vcu};
    pg8::EpiSwiGLU E{(bf16*)(e.ws + WS_H)};
    pg8::gemm_phase<pg8::EpiSwiGLU, pg8::MoeOrder, true, true>(e.lds, g, S, E);
    grid_bar(e);
}
__device__ __forceinline__ void phase_moe_g2(unsigned char* lds_raw) {
    const Env e = penv(lds_raw);
    const MoeLists L = moe_lists(e.ws);
    const int nblk = __builtin_amdgcn_readfirstlane(L.blk_e[MOE_MAXBLK]);
    pg8::Gemm g{(const bf16*)(e.ws + WS_H), (const bf16*)(e.ws + WS_WD), 256, 0, (size_t)1024 * 256, nullptr};
    pg8::MoeOrder S{L.blk_e, nblk, 4, e.G, e.vcu};
    pg8::EpiDown E{(bf16*)(e.ws + WS_ROWS8), (bf16*)(e.ws + WS_XBF), L.dest, T_ * 8};
    pg8::gemm_phase<pg8::EpiDown, pg8::MoeOrder, true, false>(e.lds, g, S, E);
    grid_bar(e);
}
__device__ __forceinline__ void phase_moe_combine(unsigned char* lds_raw, int layer) {
    const Env e = penv(lds_raw);
    moe_combine_ln(e.out, (const bf16*)(e.ws + WS_ROWS8), (const bf16*)(e.ws + WS_XBF), (const float*)(e.ws + WS_RIDX) + (size_t)T_ * 8, e.tab->in[3] + layer * 1024, e.tab->in[4] + layer * 1024,
                   layer == 0 ? (bf16*)(e.ws + WS_XBF) : nullptr, e.gw, e.NGW, e.lane);
    grid_bar(e);
}

#define RUN(k, call) do { call; if (DUP_PHASE == (k)) { call; } } while (0)
#ifndef TIME_PHASE
#define TIME_PHASE -1
#endif
#define TIMED(k, call) do { unsigned long long _t0 = 0; if (TIME_PHASE == (k)) _t0 = __builtin_amdgcn_s_memrealtime(); call; \
    if (TIME_PHASE == (k) && blockIdx.x == 0 && threadIdx.x == 0) { const unsigned long long _t1 = __builtin_amdgcn_s_memrealtime(); unsigned* w_ = (unsigned*)((Tab*)(lds_raw + TAB_OFF))->ws + CW_PROBE + 8; *w_ = *w_ + (unsigned)(_t1 - _t0); } } while (0)
template <int layer> __device__ __forceinline__ void layer_body(unsigned char* lds_raw) {
#if defined(WITH_NAIVE)
    constexpr int ci = layer * 2;
#if defined(DBG_MIX0)
    constexpr bool naive_too = (layer == DBG_MIX0 - 1);
#else
    constexpr bool naive_too = false;
#endif
#endif
    RUN(1, phase_inproj_bf16(lds_raw, layer));
    if (layer == 0) { RUN(2, phase_mix0_a(lds_raw)); TIMED(20, phase_mix0_b(lds_raw)); RUN(3, phase_mix0_c(lds_raw)); }
    if (layer == 1) { RUN(4, phase_mix1_a(lds_raw)); TIMED(21, phase_mix1_b(lds_raw)); RUN(5, phase_mix1_c(lds_raw)); RUN(6, phase_glu(lds_raw)); }
#if defined(WITH_NAIVE)
    if (naive_too) {
        phase_inproj(lds_raw, layer);
        if (layer == 0) {
            run_naive<nv::ST_ML_GATES>(lds_raw, ci, 8L * NCH);
            run_naive<nv::ST_ML_CLOC>(lds_raw, ci, 8L * NCH * 16384);
            run_naive<nv::ST_ML_SCAN>(lds_raw, ci, 8L * 16384 + 8 * 128);
            run_naive<nv::ST_ML_MI>(lds_raw, ci, 8L * S_);
            run_naive<nv::ST_ML_SMAT>(lds_raw, ci, 8L * NCH * 4096);
            run_naive<nv::ST_ML_DEN>(lds_raw, ci, 8L * S_);
            run_naive<nv::ST_ML_H>(lds_raw, ci, 8L * S_ * 128);
            run_naive<nv::ST_ML_NORM>(lds_raw, ci, 8L * S_);
            run_naive<nv::ST_LRU_CONV>(lds_raw, ci, (long)T_ * 512);
            run_naive<nv::ST_LRU_GATE>(lds_raw, ci, (long)T_ * 512);
            run_naive<nv::ST_LRU_SCAN>(lds_raw, ci, 2L * 512);
        } else {
            run_naive<nv::ST_S5_PAR>(lds_raw, ci, 2048);
            for (int sl = 0; sl < S_ / nv::SLAB; ++sl) {
                if (threadIdx.x == 0) ((nv::Ctx*)(lds_raw + CTX_OFF))[ci].slab = sl;
                __syncthreads();
                run_naive<nv::ST_S5_SCAN>(lds_raw, ci, 2L * 2048); run_naive<nv::ST_S5_OUT>(lds_raw, ci, (long)nv::B_ * nv::SLAB * 512); }
            run_naive<nv::ST_S5_GLU>(lds_raw, ci, (long)T_ * 512);
            run_naive<nv::ST_GLA_GATE>(lds_raw, ci, (long)T_ * 256);
            run_naive<nv::ST_GLA_CUM>(lds_raw, ci, (long)nv::B_ * NCH * 256);
            run_naive<nv::ST_GLA_U>(lds_raw, ci, 8L * NCH * 8192);
            run_naive<nv::ST_GLA_SCAN>(lds_raw, ci, 8L * 8192);
            run_naive<nv::ST_GLA_ATT>(lds_raw, ci, 8L * NCH * 4096);
            run_naive<nv::ST_GLA_O>(lds_raw, ci, 8L * S_ * 128);
            run_naive<nv::ST_GLA_NORM>(lds_raw, ci, 8L * S_);
        }
        phase_probe(lds_raw, DBG_C0, DBG_C1);
        phase_cvt_mixed(lds_raw);
    }
#endif
    RUN(7, phase_outproj(lds_raw, layer));
    TIMED(22, phase_ln_router(lds_raw, layer)); if (DUP_PHASE == 22) phase_ln_router(lds_raw, layer, false);
    phase_moe_x1(lds_raw, layer); if (DUP_PHASE == 8) phase_moe_x1(lds_raw, layer, 1024);
    RUN(9, phase_moe_g1(lds_raw));
    RUN(10, phase_moe_g2(lds_raw));
    TIMED(24, phase_moe_combine(lds_raw, layer));
}
#if defined(STORE_TEST)
__device__ __forceinline__ void phase_store_test(unsigned char* lds_raw) {
    const Env e = penv(lds_raw);
    unsigned char* base = e.ws + WS_ROWS8 + (size_t)e.bid * (1u << 20);
    const int wr = e.wave >> 2, wc = e.wave & 3, fr = e.lane & 15, fq = e.lane >> 4;
    const v4u val = {(unsigned)e.tid, 1u, 2u, 3u};
    for (int u = 0; u < 40; ++u) {
#pragma unroll
        for (int s = 0; s < 8; ++s)
#pragma unroll
            for (int bj = 0; bj < 2; ++bj) {
#if STORE_TEST == 1
                const int r = (s >> 2) * 128 + wr * 64 + (s & 3) * 16 + fr; const int cb = wc * 64 + fq * 16 + bj * 256;
#elif STORE_TEST == 2
                const int r = (s >> 2) * 128 + wr * 64 + (s & 3) * 16 + bj * 8 + (e.lane >> 3); const int cb = wc * 128 + (e.lane & 7) * 16;
#else
                const int r = (s >> 2) * 128 + wr * 64 + (s & 3) * 16 + bj * 8 + (e.lane >> 4) * 2 + (wc & 1); const int cb = (wc >> 1) * 256 + (e.lane & 15) * 16;
#endif
                *(v4u*)(base + (size_t)((u & 1) * 256 + r) * 2048 + cb) = val; }
        asm volatile("" ::: "memory"); }
    grid_bar(e);
}
#endif
struct Args { const float* in[38]; float* out; unsigned char* ws; };
__global__ void __launch_bounds__(NTHREADS, 2) mega_fwd(Args a) {
    extern __shared__ __attribute__((aligned(16))) unsigned char lds_raw[];
    {
        LAS unsigned char* lds = (LAS unsigned char*)lds_raw;
        for (int u = threadIdx.x; u < (LDS_BYTES - LDS_CTL) / 4; u += NTHREADS) ((LAS unsigned*)(lds + LDS_CTL))[u] = 0u;
        __syncthreads();
        if (threadIdx.x == 0) {
            (void)xb_add((unsigned*)a.ws + 4096 + XB_XCNT(xb_xcc_id()), 1u);
            Tab* tab = (Tab*)(lds_raw + TAB_OFF);
#pragma unroll
            for (int i = 0; i < 38; ++i) { tab->in[i] = a.in[i]; if ((i & 7) == 7) asm volatile("" ::: "memory"); }
            tab->out = a.out; tab->ws = a.ws;
            asm volatile("" ::: "memory");
#if defined(WITH_NAIVE)
            nv::Ctx* const ctab = (nv::Ctx*)(lds_raw + CTX_OFF);
            const size_t scratch0 = (size_t)T_ * 1024 + (size_t)T_ * 64 + (size_t)T_ * 8 * 2;
#pragma unroll 1
            for (int layer = 0; layer < 2; ++layer) {
                nv::Ctx& c = ctab[layer * 2];
                nv::Mem M{(float*)(a.ws + WS_NAIVE), 0};
#pragma unroll 1
                for (int i = 0; i < 38; ++i) c.in[i] = tab->in[i];
                c.mixed = M.get((size_t)T_ * 1024); c.scores = M.get((size_t)T_ * 64);
                c.ridx = (int*)M.get((size_t)T_ * 8); c.rwt = M.get((size_t)T_ * 8);
                c.gR = nullptr; c.gBias = nullptr; c.slab = 0;
                c.layer = layer;
                c.hcur = layer == 0 ? a.in[0] : a.out;
                if (layer == 0) {
                    c.ldp = EINP; c.proj = M.get((size_t)T_ * c.ldp);
                    c.mb = M.get(8 * S_); c.mig = M.get(8 * S_); c.mblast = M.get(8 * NCH); c.mmloc = M.get(8 * NCH); c.mmprev = M.get(8 * NCH);
                    c.mmi = M.get(8 * S_); c.mwin = M.get(8 * S_); c.mden = M.get(8 * S_); c.nloc = M.get(8 * NCH * 128);
                    const size_t ov = M.off;
                    c.cloc = M.get((size_t)8 * NCH * 16384); c.smat = M.get((size_t)8 * NCH * 4096); c.htil = M.get((size_t)T_ * 512);
                    M.off = ov; c.lxc = M.get((size_t)T_ * 512); c.la = M.get((size_t)T_ * 512); c.lu = M.get((size_t)T_ * 512);
                } else {
                    c.ldp = OINP; c.proj = M.get((size_t)T_ * c.ldp);
                    c.s5ab = M.get(2048 * 2); c.s5bbr = M.get(2048 * 16); c.s5bbi = M.get(2048 * 16); c.s5st = M.get(2 * 2048 * 2);
                    c.s5x = M.get((size_t)nv::B_ * nv::SLAB * 2048 * 2); c.s5g = M.get((size_t)T_ * 512);
                    c.gla_la = M.get((size_t)T_ * 256); c.gla_bc = M.get((size_t)T_ * 256); c.gla_bl = M.get((size_t)nv::B_ * NCH * 256);
                    c.gu = M.get((size_t)8 * NCH * 8192); c.gatt = M.get((size_t)8 * NCH * 4096); c.go = M.get((size_t)T_ * 512);
                }
                c.z = c.proj; c.hout = a.out; c.lnw = a.in[1] + layer * 1024; c.lnb = a.in[2] + layer * 1024;
                M.off = scratch0; c.hid = M.get((size_t)T_ * 9 * 256);
                nv::Ctx& cm = ctab[layer * 2 + 1];
                cm = c; cm.hcur = a.out;
#ifdef DBG_LAYER
                if (layer == DBG_LAYER) { nv::Ctx& cd = ctab[4]; cd = cm;
                cd.hid = (float*)(a.ws + 48 * MiB); cd.z = (float*)(a.ws + 486 * MiB); cd.hcur = a.out + (size_t)DBG_T0 * 1024; cd.ridx = c.ridx + (size_t)DBG_T0 * 8; cd.rwt = c.rwt + (size_t)DBG_T0 * 8; }
#endif
            }
#endif
        }
        __syncthreads();
    }
    RUN(0, phase_p0(lds_raw));
    layer_body<0>(lds_raw);
    layer_body<1>(lds_raw);
#if defined(STORE_TEST)
    phase_store_test(lds_raw);
#endif
#if defined(DBG_MIX0)
    phase_probe_apply(lds_raw);
#endif
    if (TIME_PHASE >= 0) { const Env e = penv(lds_raw); const unsigned ticks = __hip_atomic_load((unsigned*)e.ws + CW_PROBE + 8, __ATOMIC_RELAXED, __HIP_MEMORY_SCOPE_AGENT);
        const float f = 1.0f + 0.0005f * (float)ticks * 0.01f;
        for (long i = e.gtid; i < (long)T_ * 1024; i += e.gsz) e.out[i] *= f; }
}
extern "C" void kernel_launch(void* const* d_in, const int* in_sizes, int n_in, void* d_out, int out_size, void* d_ws, size_t ws_size, hipStream_t stream) {
    static int grid = 0;
    if (grid == 0) {
        int dev = 0, cus = 0, per_cu = 0;
        hipGetDevice(&dev); hipDeviceGetAttribute(&cus, hipDeviceAttributeMultiprocessorCount, dev);
        hipFuncSetAttribute((const void*)mega_fwd, hipFuncAttributeMaxDynamicSharedMemorySize, LDS_BYTES);
        hipOccupancyMaxActiveBlocksPerMultiprocessor(&per_cu, (const void*)mega_fwd, NTHREADS, LDS_BYTES);
        (void)hipGetLastError();
        grid = (per_cu >= 1) ? cus : -1;
    }
    if (grid < 0) return;
    hipMemsetAsync(d_ws, 0, CTL_BYTES, stream);
    Args a{};
    for (int i = 0; i < 38; ++i) a.in[i] = (const float*)d_in[i];
    a.out = (float*)d_out; a.ws = (unsigned char*)d_ws;
    hipLaunchKernelGGL(mega_fwd, dim3(grid), dim3(NTHREADS), LDS_BYTES, stream, a);
}
```

```cpp
#define OPT_MIX0 1
#define OPT_MIX1 1
#define OPT_ROUTER 1
#include <hip/hip_runtime.h>
#define GAS __attribute__((address_space(1)))
#define LAS __attribute__((address_space(3)))
#define XB_TMO      128
#define XB_XCNT(j)  (256  + 64 * (j))
#define XB_XSUB(j)  (1280 + 64 * (j))
#define XB_XGEN(j)  (2304 + 64 * (j))
#define XB_TOP      3328
#define XB_TOPGEN   3392
#define XCD_BAR_WORDS 3456
#define XB_SPIN_CAP (1u << 22)
__device__ __forceinline__ unsigned xb_ld(unsigned* p)              { return __hip_atomic_load(p, __ATOMIC_RELAXED, __HIP_MEMORY_SCOPE_AGENT); }
__device__ __forceinline__ unsigned xb_add(unsigned* p, unsigned v) { return __hip_atomic_fetch_add(p, v, __ATOMIC_RELAXED, __HIP_MEMORY_SCOPE_AGENT); }
__device__ __forceinline__ unsigned xb_xcc_id() { return (unsigned)__builtin_amdgcn_s_getreg((3 << 11) | 20) & 0xFu; }
#define XB_SPIN(cond, bar) do { unsigned _sp = 0; while (cond) { __builtin_amdgcn_s_sleep(1); \
    if ((++_sp & 255u) == 0u) { if (xb_ld(&(bar)[XB_TMO])) break; if (_sp > XB_SPIN_CAP) { atomicAdd(&(bar)[XB_TMO], 1u); break; } } } } while (0)
struct XcdBarrier { unsigned* bar; unsigned x; volatile LAS unsigned* st; };
__device__ __forceinline__ XcdBarrier xcd_barrier_post(unsigned* bar, volatile LAS unsigned* st) {
    XcdBarrier b; b.bar = bar; b.x = xb_xcc_id(); b.st = st;
    if (threadIdx.x == 0) (void)xb_add(&bar[XB_XCNT(b.x)], 1u);
    return b;
}
__device__ __forceinline__ void xcd_barrier_complete(unsigned* bar, unsigned x, unsigned& nloc, unsigned& nx) {
    const unsigned G = gridDim.x * gridDim.y * gridDim.z;
    unsigned sum, cnt, mine, sp = 0u;
    for (;;) {
        sum = 0u; cnt = 0u; mine = 0u;
#pragma unroll
        for (unsigned j = 0; j < 16; ++j) { const unsigned c = xb_ld(&bar[XB_XCNT(j)]); sum += c; cnt += (c > 0u) ? 1u : 0u; mine = (j == x) ? c : mine; }
        if (sum == G) break;
        __builtin_amdgcn_s_sleep(1);
        if ((++sp & 255u) == 0u) { if (xb_ld(&bar[XB_TMO])) break; if (sp > XB_SPIN_CAP) { atomicAdd(&bar[XB_TMO], 1u); break; } }
    }
    nloc = mine > 0u ? mine : 1u; nx = cnt > 0u ? cnt : 1u;
}
__device__ __forceinline__ void xcd_barrier(const XcdBarrier& b) {
    asm volatile("s_waitcnt vmcnt(0)" ::: "memory");
    __syncthreads();
    if (threadIdx.x == 0) {
        unsigned* bar = b.bar;
        __builtin_amdgcn_s_waitcnt(0);
        unsigned nloc = b.st[0], nx = b.st[1];
        if (nloc == 0u) { xcd_barrier_complete(bar, b.x, nloc, nx); b.st[0] = nloc; b.st[1] = nx; }
        const unsigned old = xb_add(&bar[XB_XSUB(b.x)], 1u);
        const unsigned gen = old / nloc;
        if (old + 1u == (gen + 1u) * nloc) {
            __builtin_amdgcn_fence(__ATOMIC_RELEASE, "agent");
            asm volatile("s_waitcnt vmcnt(0)" ::: "memory");
            const unsigned og = xb_add(&bar[XB_TOP], 1u);
            const unsigned tg = og / nx;
            if (og + 1u == (tg + 1u) * nx) xb_add(&bar[XB_TOPGEN], 1u);
            else XB_SPIN(xb_ld(&bar[XB_TOPGEN]) == tg, bar);
            __builtin_amdgcn_fence(__ATOMIC_ACQUIRE, "agent");
            xb_add(&bar[XB_XGEN(b.x)], 1u);
            asm volatile("s_waitcnt vmcnt(0)" ::: "memory");
        } else {
            XB_SPIN(xb_ld(&bar[XB_XGEN(b.x)]) == gen, bar);
            __builtin_amdgcn_fence(__ATOMIC_ACQUIRE, "agent");
            asm volatile("s_waitcnt vmcnt(0)" ::: "memory");
        }
    }
    __syncthreads();
}
namespace pg8 {
#define PG8_LAS __attribute__((address_space(3)))
typedef unsigned short bf16_t;
typedef short bf16x8 __attribute__((ext_vector_type(8)));
typedef float f32x4 __attribute__((ext_vector_type(4)));
typedef unsigned u32x4 __attribute__((ext_vector_type(4)));
constexpr int BM = 256, BK = 64, HALF = 128, HTB = HALF * BK * 2, STAGE_BYTES = 8 * HTB, NXCD = 8, WGM = 8;
__host__ __device__ __forceinline__ int lds_byte(int r, int c) { const int st = (r >> 4) * 2 + (c >> 5), rr = r & 15, cc = c & 31, ob = rr * 64 + cc * 2; return st * 1024 + (ob ^ (((ob >> 9) & 1) << 5)); }
__host__ __device__ __forceinline__ void stage_rc(int b, int& R, int& C) { const int st = b / 1024, sb = b % 1024, swz = sb ^ (((sb >> 9) & 1) << 5); R = (st >> 1) * 16 + swz / 64; C = (st & 1) * 32 + (swz % 64) / 2; }
__host__ __device__ __forceinline__ int perm32(int rho) { const int n = rho >> 4, i = rho & 15; return 8 * (i >> 2) + 4 * n + (i & 3); }
struct Unit { int pm, pn, e, aux; };
struct Gemm { const bf16_t* A; const bf16_t* Bt; int K; int pad; size_t bstride; const int* rows; };
struct StaticOrder {
    int nM, nN, nwg, G, c;
    __host__ __device__ void init(int M, int N, int G_, int c_) { nM = M / BM; nN = N / BM; nwg = nM * nN; G = G_; c = c_; }
    __host__ __device__ bool next(int i, Unit& u) const {
        const long L = (long)i * G + c; if (L >= nwg) return false;
        int wgid = (int)L; { const int q = nwg / NXCD, r = nwg % NXCD, xcd = wgid % NXCD, off = wgid / NXCD; wgid = (xcd < r ? xcd * (q + 1) : r * (q + 1) + (xcd - r) * q) + off; }
        const int nig = WGM * nN, gid = wgid / nig, fm = gid * WGM, gsz = (nM - fm) < WGM ? (nM - fm) : WGM;
        u.pm = fm + ((wgid % nig) % gsz); u.pn = (wgid % nig) / gsz; u.e = 0; u.aux = 0; return true;
    }
};
__device__ __forceinline__ unsigned cvt_pk_bf16(float lo, float hi) { unsigned r; asm volatile("v_cvt_pk_bf16_f32 %0, %1, %2" : "=v"(r) : "v"(lo), "v"(hi)); return r; }
struct EpiF32R {
    static constexpr int NPRE = 0; __device__ __forceinline__ void load_pre(const Unit&, int, int, int (&)[1]) const {}
    static constexpr bool PERM = false;
    float* C; int ldc; const float* R; float ralpha;
    __device__ __forceinline__ void operator()(const f32x4 (&acc)[2][2][4][2], const Unit& u, int wr, int wc, int fr, int fq) const {
        const int row0 = u.pm * BM + wr * 64 + fr, col0 = u.pn * BM + wc * 32 + 4 * fq;
#pragma unroll
        for (int ai = 0; ai < 2; ++ai)
#pragma unroll
            for (int m = 0; m < 4; ++m) { const size_t off = (size_t)(row0 + ai * HALF + m * 16) * ldc + col0;
#pragma unroll
                for (int bj = 0; bj < 2; ++bj)
#pragma unroll
                    for (int n = 0; n < 2; ++n) { f32x4 v = acc[ai][bj][m][n]; if (R) v = v + ralpha * *(const f32x4*)(R + off + bj * HALF + n * 16); *(f32x4*)(C + off + bj * HALF + n * 16) = v; } }
    }
};
struct EpiBf16P {
    static constexpr int NPRE = 0; __device__ __forceinline__ void load_pre(const Unit&, int, int, int (&)[1]) const {}
    static constexpr bool PERM = true;
    bf16_t* O; int ldc;
    __device__ __forceinline__ void operator()(const f32x4 (&acc)[2][2][4][2], const Unit& u, int wr, int wc, int fr, int fq) const {
        const int row0 = u.pm * BM + wr * 64 + fr, col0 = u.pn * BM + wc * 32 + 8 * fq;
#pragma unroll
        for (int ai = 0; ai < 2; ++ai)
#pragma unroll
            for (int m = 0; m < 4; ++m) { bf16_t* rowp = O + (size_t)(row0 + ai * HALF + m * 16) * ldc + col0;
#pragma unroll
                for (int bj = 0; bj < 2; ++bj) { const f32x4 v0 = acc[ai][bj][m][0], v1 = acc[ai][bj][m][1];
                    u32x4 w; w.x = cvt_pk_bf16(v0[0], v0[1]); w.y = cvt_pk_bf16(v0[2], v0[3]); w.z = cvt_pk_bf16(v1[0], v1[1]); w.w = cvt_pk_bf16(v1[2], v1[3]);
                    *(u32x4*)(rowp + bj * HALF) = w; } }
    }
};
struct EpiGlu {
    static constexpr int NPRE = 0; __device__ __forceinline__ void load_pre(const Unit&, int, int, int (&)[1]) const {}
    static constexpr bool PERM = true;
    bf16_t* O; int ldo; const bf16_t* Gm; int ldg; const float* bias;
    __device__ __forceinline__ void operator()(const f32x4 (&acc)[2][2][4][2], const Unit& u, int wr, int wc, int fr, int fq) const {
        const int row0 = u.pm * BM + wr * 64 + fr, col0 = u.pn * BM + wc * 32 + 8 * fq;
#pragma unroll
        for (int ai = 0; ai < 2; ++ai)
#pragma unroll
            for (int m = 0; m < 4; ++m) { const size_t r = (size_t)(row0 + ai * HALF + m * 16);
#pragma unroll
                for (int bj = 0; bj < 2; ++bj) { const int c = col0 + bj * HALF;
                    const f32x4 b0 = *(const f32x4*)(bias + c), b1 = *(const f32x4*)(bias + c + 4); const u32x4 gv = *(const u32x4*)(Gm + r * ldg + c);
                    const f32x4 v0 = acc[ai][bj][m][0] + b0, v1 = acc[ai][bj][m][1] + b1;
                    float g[8] = {__builtin_bit_cast(float, gv.x << 16), __builtin_bit_cast(float, gv.x & 0xffff0000u), __builtin_bit_cast(float, gv.y << 16), __builtin_bit_cast(float, gv.y & 0xffff0000u),
                                  __builtin_bit_cast(float, gv.z << 16), __builtin_bit_cast(float, gv.z & 0xffff0000u), __builtin_bit_cast(float, gv.w << 16), __builtin_bit_cast(float, gv.w & 0xffff0000u)};
                    u32x4 w; w.x = cvt_pk_bf16(g[0] * __builtin_amdgcn_rcpf(1.f + __expf(-v0[0])), g[1] * __builtin_amdgcn_rcpf(1.f + __expf(-v0[1]))); w.y = cvt_pk_bf16(g[2] * __builtin_amdgcn_rcpf(1.f + __expf(-v0[2])), g[3] * __builtin_amdgcn_rcpf(1.f + __expf(-v0[3])));
                    w.z = cvt_pk_bf16(g[4] * __builtin_amdgcn_rcpf(1.f + __expf(-v1[0])), g[5] * __builtin_amdgcn_rcpf(1.f + __expf(-v1[1]))); w.w = cvt_pk_bf16(g[6] * __builtin_amdgcn_rcpf(1.f + __expf(-v1[2])), g[7] * __builtin_amdgcn_rcpf(1.f + __expf(-v1[3])));
                    *(u32x4*)(O + r * ldo + c) = w; } }
    }
};
template <class Epi, class Sched, bool ALIGN_EPI, bool GATHER>
__device__ __forceinline__ void gemm_phase(PG8_LAS unsigned char* lds, const Gemm g, const Sched& S, const Epi& E) {
    int tid_ = threadIdx.x; asm volatile("" : "+v"(tid_));
    const int tid = tid_, wid = __builtin_amdgcn_readfirstlane(tid >> 6), lane = tid & 63, wr = wid >> 2, wc = wid & 3, fr = lane & 15, fq = lane >> 4;
    const int K = g.K, nt = K / BK;
    unsigned voffA[2], voffB[2];
#pragma unroll
    for (int i = 0; i < 2; ++i) { int R, C; stage_rc(tid * 16 + i * 8192, R, C); const int Rb = Epi::PERM ? ((R & ~31) + perm32(R & 31)) : R;
        voffA[i] = (unsigned)(R * K + C) * 2u; voffB[i] = (unsigned)(Rb * K + C) * 2u; }
    const size_t kstep = (size_t)(BK * 2);
    const size_t hstep = (size_t)HALF * K * 2;
    const size_t tstep = 2 * hstep;
    const unsigned ldsw = (unsigned)wid * 1024u;
    const int aoff = lds_byte(wr * 64 + fr, fq * 8), boff = lds_byte(wc * 32 + fr, fq * 8);
#define PG8_SA(b, h) (((b) * 2 + (h)) * HTB)
#define PG8_SB(b, h) ((4 + (b) * 2 + (h)) * HTB)
#define PG8_STAGE(bufoff, gbase, voff) do { _Pragma("unroll") for (int _i = 0; _i < 2; ++_i) { unsigned _vo = (voff)[_i]; asm volatile("" : "+v"(_vo));   \
        __builtin_amdgcn_global_load_lds((const unsigned*)((const char*)(gbase) + _vo), (PG8_LAS unsigned*)(lds + (bufoff) + ldsw + _i * 8192), 16, 0, 0); } } while (0)
#define PG8_STAGE_A(bufoff, gbase, h, GV) do { if constexpr (GATHER) { PG8_STAGE(bufoff, gbase, GV[h]); } else { PG8_STAGE(bufoff, (gbase) + (h) * hstep, voffA); } } while (0)
#define PG8_STAGE_A2(bufoff, gbase, h) do { if constexpr (GATHER) { unsigned _gv[2] = {last ? gnxt[h][0] : gcur[h][0], last ? gnxt[h][1] : gcur[h][1]}; PG8_STAGE(bufoff, gbase, _gv); } else { PG8_STAGE(bufoff, (gbase) + (h) * hstep, voffA); } } while (0)
#define PG8_LDA(dst, b, h) do { _Pragma("unroll") for (int m = 0; m < 4; ++m) _Pragma("unroll") for (int k = 0; k < 2; ++k) dst[m][k] = *(const PG8_LAS bf16x8*)(lds + PG8_SA(b, h) + aoff + m * 2048 + k * 1024); } while (0)
#define PG8_LDB(dst, b, h) do { _Pragma("unroll") for (int n = 0; n < 2; ++n) _Pragma("unroll") for (int k = 0; k < 2; ++k) dst[n][k] = *(const PG8_LAS bf16x8*)(lds + PG8_SB(b, h) + boff + n * 2048 + k * 1024); } while (0)
#define PG8_MMA(ai, bj, At, Bt) do { __builtin_amdgcn_s_setprio(1); _Pragma("unroll") for (int m = 0; m < 4; ++m) _Pragma("unroll") for (int n = 0; n < 2; ++n) _Pragma("unroll") for (int k = 0; k < 2; ++k) \
        acc[ai][bj][m][n] = __builtin_amdgcn_mfma_f32_16x16x32_bf16(Bt[n][k], At[m][k], acc[ai][bj][m][n], 0, 0, 0); __builtin_amdgcn_s_setprio(0); } while (0)
#define PG8_WAIT_V(n) asm volatile("s_waitcnt vmcnt(" #n ")" ::: "memory")
#define PG8_WAIT_L(n) asm volatile("s_waitcnt lgkmcnt(" #n ")" ::: "memory")
#define PG8_BAR __builtin_amdgcn_s_barrier()
#define PG8_SCHED __builtin_amdgcn_sched_barrier(0)
#define PG8_GLOAD(GV, u) do { _Pragma("unroll") for (int _i = 0; _i < 2; ++_i) { int _R, _C; stage_rc(tid * 16 + _i * 8192, _R, _C); _Pragma("unroll") for (int _h = 0; _h < 2; ++_h) \
        GV[_h][_i] = (unsigned)g.rows[(u).pm * BM + _h * HALF + _R] * (unsigned)(K * 2) + (unsigned)(_C * 2); } } while (0)
    Unit cur, nxt; int ui = 0;
    if (!S.next(0, cur)) return;
    f32x4 acc[2][2][4][2];
#pragma unroll
    for (int a = 0; a < 2; ++a)
#pragma unroll
        for (int b = 0; b < 2; ++b)
#pragma unroll
            for (int m = 0; m < 4; ++m)
#pragma unroll
                for (int n = 0; n < 2; ++n) acc[a][b][m][n] = (f32x4){0.f, 0.f, 0.f, 0.f};
    bf16x8 At[4][2], B0[2][2], B1[2][2];
    unsigned gcur[2][2] = {{0u, 0u}, {0u, 0u}}, gnxt[2][2] = {{0u, 0u}, {0u, 0u}};
    if constexpr (Epi::NPRE > 0) E.prefetch(cur, 0, lds, wid, lane);
    if constexpr (GATHER) { PG8_GLOAD(gcur, cur); }
    const char* cA = GATHER ? (const char*)g.A : (const char*)g.A + (size_t)cur.pm * tstep;
    const char* cB = (const char*)g.Bt + ((size_t)cur.e * g.bstride) * 2 + (size_t)cur.pn * tstep;
    PG8_STAGE(PG8_SB(0, 0), cB, voffB); PG8_STAGE(PG8_SB(0, 1), cB + hstep, voffB); PG8_STAGE_A(PG8_SA(0, 0), cA, 0, gcur); PG8_STAGE_A(PG8_SA(0, 1), cA, 1, gcur);
    if (wr == 1) PG8_BAR;
    PG8_WAIT_V(2); PG8_BAR;
    PG8_STAGE(PG8_SB(1, 0), cB + kstep, voffB); PG8_STAGE_A(PG8_SA(1, 0), cA + kstep, 0, gcur); PG8_STAGE(PG8_SB(1, 1), cB + hstep + kstep, voffB);
    PG8_WAIT_V(6); PG8_BAR;
    for (;;) {
        const bool has_next = S.next(ui + 1, nxt);
        if constexpr (Epi::NPRE > 0) { if (has_next) E.prefetch(nxt, (ui + 1) % 3, lds, wid, lane); }
        if constexpr (GATHER) { if (has_next) { PG8_GLOAD(gnxt, nxt); } else {
#pragma unroll
            for (int _h = 0; _h < 2; ++_h)
#pragma unroll
                for (int _i = 0; _i < 2; ++_i) gnxt[_h][_i] = gcur[_h][_i]; } }
        const char* nA = GATHER ? cA : (has_next ? (const char*)g.A + (size_t)nxt.pm * tstep : cA);
        const char* nB = has_next ? (const char*)g.Bt + ((size_t)nxt.e * g.bstride) * 2 + (size_t)nxt.pn * tstep : cB;
#pragma unroll 1
        for (int t = 0; t < nt; t += 2) {
            const bool last = (t == nt - 2);
            const char* a1 = cA + (size_t)(t + 1) * kstep;
            const char* a2 = last ? nA : cA + (size_t)(t + 2) * kstep; const char* b2 = last ? nB : cB + (size_t)(t + 2) * kstep;
            const char* a3 = a2 + kstep; const char* b3 = b2 + kstep;
            PG8_LDB(B0, 0, 0); PG8_LDB(B1, 0, 1); PG8_SCHED; PG8_LDA(At, 0, 0); PG8_STAGE_A(PG8_SA(1, 1), a1, 1, gcur);
            PG8_WAIT_V(8); PG8_WAIT_L(0); PG8_BAR; PG8_MMA(0, 0, At, B0); PG8_MMA(0, 1, At, B1); PG8_BAR; PG8_SCHED;
            PG8_LDA(At, 0, 1); PG8_STAGE(PG8_SB(0, 0), b2, voffB); PG8_STAGE(PG8_SB(0, 1), b2 + hstep, voffB); PG8_STAGE_A2(PG8_SA(0, 0), a2, 0);
            PG8_WAIT_V(8); PG8_WAIT_L(0); PG8_BAR; PG8_MMA(1, 0, At, B0); PG8_MMA(1, 1, At, B1); PG8_BAR; PG8_SCHED;
            PG8_LDB(B0, 1, 0); PG8_LDB(B1, 1, 1); PG8_SCHED; PG8_LDA(At, 1, 0); PG8_STAGE_A2(PG8_SA(0, 1), a2, 1);
            PG8_WAIT_V(8); PG8_WAIT_L(0); PG8_BAR; PG8_MMA(0, 0, At, B0); PG8_MMA(0, 1, At, B1); PG8_BAR; PG8_SCHED;
            PG8_LDA(At, 1, 1); PG8_STAGE(PG8_SB(1, 0), b3, voffB); PG8_STAGE(PG8_SB(1, 1), b3 + hstep, voffB); PG8_STAGE_A2(PG8_SA(1, 0), a3, 0);
            PG8_WAIT_V(8); PG8_WAIT_L(0); PG8_BAR; PG8_MMA(1, 0, At, B0); PG8_MMA(1, 1, At, B1); PG8_BAR; PG8_SCHED;
        }
        if constexpr (ALIGN_EPI) { if (wr == 0) PG8_BAR; }
        if constexpr (Epi::NPRE > 0) E(acc, cur, wr, wc, fr, fq, ui % 3, lds); else E(acc, cur, wr, wc, fr, fq);
        if (!has_next) break;
#pragma unroll
        for (int a = 0; a < 2; ++a)
#pragma unroll
            for (int b = 0; b < 2; ++b)
#pragma unroll
                for (int m = 0; m < 4; ++m)
#pragma unroll
                    for (int n = 0; n < 2; ++n) acc[a][b][m][n] = (f32x4){0.f, 0.f, 0.f, 0.f};
        cur = nxt; cA = nA; cB = nB; ++ui;
        if constexpr (GATHER) {
#pragma unroll
            for (int _h = 0; _h < 2; ++_h)
#pragma unroll
                for (int _i = 0; _i < 2; ++_i) gcur[_h][_i] = gnxt[_h][_i]; }
        if constexpr (ALIGN_EPI) { if (wr == 1) PG8_BAR; }
    }
    PG8_WAIT_V(0);
    if constexpr (!ALIGN_EPI) { if (wr == 0) PG8_BAR; }
    PG8_BAR;
#undef PG8_SA
#undef PG8_SB
#undef PG8_STAGE
#undef PG8_STAGE_A
#undef PG8_STAGE_A2
#undef PG8_LDA
#undef PG8_LDB
#undef PG8_MMA
#undef PG8_WAIT_V
#undef PG8_WAIT_L
#undef PG8_BAR
#undef PG8_SCHED
#undef PG8_GLOAD
}
}
typedef unsigned short bf16;
typedef unsigned v4u __attribute__((ext_vector_type(4)));
typedef unsigned v2u __attribute__((ext_vector_type(2)));
typedef float f32x4 __attribute__((ext_vector_type(4)));
constexpr int NTHREADS = 512, NWAVES = 8;
constexpr int LDS_BYTES = 163840;
constexpr int LDS_CTL = 155648;
constexpr int MISC_OFF = LDS_CTL + 320;
constexpr size_t MiB = 1u << 20;
constexpr size_t CTL_BYTES = 1 * MiB;
#if !defined(WITH_NAIVE)
namespace nv { constexpr int B_ = 2, S_ = 8192, T_ = B_ * S_, NCH = S_ / 64, EIN = 3080, OIN = 2064; constexpr float ALPHA = 1.41421356237309515f, EPS = 1e-5f; struct Mem { float* base; size_t off; }; }
#endif
constexpr int T_ = nv::T_, S_ = nv::S_, NCH = nv::NCH;
constexpr int EINP = 3328, OINP = 2304;
#define LDS_WAIT() asm volatile("s_waitcnt lgkmcnt(0)" ::: "memory")
typedef __bf16 hwbf2_t __attribute__((ext_vector_type(2)));
typedef float hwf2_t __attribute__((ext_vector_type(2)));
__device__ __forceinline__ unsigned f2bf(float f) { const __bf16 b = (__bf16)f; return (unsigned)__builtin_bit_cast(unsigned short, b); }
__device__ __forceinline__ unsigned pk2(float lo, float hi) { const hwf2_t v = {lo, hi}; return __builtin_bit_cast(unsigned, __builtin_convertvector(v, hwbf2_t)); }
__device__ __forceinline__ float bf2f(unsigned short b) { return __builtin_bit_cast(float, (unsigned)b << 16); }
__device__ __forceinline__ void tr_item(const float* W, long ldw, int nvalid, bf16* dst, long ldd, LAS float* scr, int lane) {
#pragma unroll 8
    for (int i = 0; i < 32; ++i) { const int kk = 2 * i + (lane >> 5), nn = lane & 31; scr[kk * 33 + nn] = nn < nvalid ? W[(long)kk * ldw + nn] : 0.f; }
    LDS_WAIT(); asm volatile("" ::: "memory");
    const int c = lane & 7;
#pragma unroll
    for (int j = 0; j < 4; ++j) { const int n = (lane >> 3) + 8 * j; const LAS float* s = scr + (8 * c) * 33 + n;
        v4u o; o.x = pk2(s[0 * 33], s[1 * 33]); o.y = pk2(s[2 * 33], s[3 * 33]); o.z = pk2(s[4 * 33], s[5 * 33]); o.w = pk2(s[6 * 33], s[7 * 33]);
        *(v4u*)(dst + (long)n * ldd + 8 * c) = o; }
    LDS_WAIT(); asm volatile("" ::: "memory");
}
__device__ __forceinline__ void tr_item64(const float* W, long ldw, int nvalid, bf16* dst, long ldd, LAS float* scr, int lane) {
    const int nn = (lane & 15) * 4;
#pragma unroll
    for (int i = 0; i < 16; ++i) { const int kk = 4 * i + (lane >> 4);
        f32x4 v = {0.f, 0.f, 0.f, 0.f}; if (nn < nvalid) v = *(const f32x4*)(W + (long)kk * ldw + nn);
        LAS float* s = scr + kk * 65 + nn; s[0] = v.x; s[1] = v.y; s[2] = v.z; s[3] = v.w; }
    LDS_WAIT(); asm volatile("" ::: "memory");
    const int c = lane & 7;
#pragma unroll
    for (int j = 0; j < 8; ++j) { const int n = (lane >> 3) + 8 * j; const LAS float* s = scr + (8 * c) * 65 + n;
        v4u o; o.x = pk2(s[0 * 65], s[1 * 65]); o.y = pk2(s[2 * 65], s[3 * 65]); o.z = pk2(s[4 * 65], s[5 * 65]); o.w = pk2(s[6 * 65], s[7 * 65]);
        *(v4u*)(dst + (long)n * ldd + 8 * c) = o; }
    LDS_WAIT(); asm volatile("" ::: "memory");
}
__device__ __forceinline__ void tr_matrix(const float* W, int K, int N, int NP, bf16* WT, LAS float* scr, int gw, int NGW, int lane) {
    const int nblk = NP / 64, nitems = (K / 64) * nblk;
    for (int it = gw; it < nitems; it += NGW) { const int kb = it / nblk, nb = it % nblk, k0 = 64 * kb, n0 = 64 * nb; int nvalid = N - n0; nvalid = nvalid < 0 ? 0 : (nvalid > 64 ? 64 : nvalid);
        tr_item64(W + (long)k0 * N + n0, N, nvalid, WT + (long)n0 * K + k0, K, scr, lane); }
}
__device__ __forceinline__ void tr_matrix_item(const float* W, int K, int N, int NP, bf16* WT, LAS float* scr, int it, int lane) {
    const int nblk = NP / 64, kb = it / nblk, nb = it % nblk, k0 = 64 * kb, n0 = 64 * nb; int nvalid = N - n0; nvalid = nvalid < 0 ? 0 : (nvalid > 64 ? 64 : nvalid);
    tr_item64(W + (long)k0 * N + n0, N, nvalid, WT + (long)n0 * K + k0, K, scr, lane);
}
__device__ __forceinline__ void cvt_rows(const float* src, bf16* dst, long n, long gtid, long gsz) {
    long i = gtid * 8;
    for (; i + 3 * gsz * 8 < n; i += 4 * gsz * 8) {
        f32x4 a[4], b[4];
#pragma unroll
        for (int u = 0; u < 4; ++u) { a[u] = *(const f32x4*)(src + i + u * gsz * 8); b[u] = *(const f32x4*)(src + i + u * gsz * 8 + 4); }
#pragma unroll
        for (int u = 0; u < 4; ++u) { v4u o; o.x = pk2(a[u].x, a[u].y); o.y = pk2(a[u].z, a[u].w); o.z = pk2(b[u].x, b[u].y); o.w = pk2(b[u].z, b[u].w); *(v4u*)(dst + i + u * gsz * 8) = o; } }
    for (; i < n; i += gsz * 8) { const f32x4 a = *(const f32x4*)(src + i), b = *(const f32x4*)(src + i + 4);
        v4u o; o.x = pk2(a.x, a.y); o.y = pk2(a.z, a.w); o.z = pk2(b.x, b.y); o.w = pk2(b.z, b.w); *(v4u*)(dst + i) = o; }
}
__device__ __forceinline__ int sopaque(int v) { asm volatile("" : "+s"(v)); return v; }
__device__ __forceinline__ float wave_sum(float v) {
#define WS_STEP(o) v += __builtin_bit_cast(float, __builtin_amdgcn_ds_swizzle(__builtin_bit_cast(int, v), 0x1f | ((o) << 10)))
    WS_STEP(1); WS_STEP(2); WS_STEP(4); WS_STEP(8); WS_STEP(16);
#undef WS_STEP
    return __builtin_bit_cast(float, __builtin_amdgcn_readlane(__builtin_bit_cast(int, v), 0)) + __builtin_bit_cast(float, __builtin_amdgcn_readlane(__builtin_bit_cast(int, v), 32));
}
#ifndef DBG_SCALE
#define DBG_SCALE 20.0f
#endif
constexpr int MOE_MAXBLK = 640;
constexpr int CW_CNT = 8192, CW_CUR = 8192 + 128;
namespace pg8 {
struct MoeOrder {
    const int* blk_e; int nblk, npn, G, c;
    __device__ __forceinline__ bool next(int i, Unit& u) const {
        const long L = (long)i * G + c; if (L >= (long)nblk * npn) return false;
        const int blk = (int)(L / npn); u.pm = blk; u.pn = (int)(L % npn); u.e = __builtin_amdgcn_readfirstlane(blk_e[blk]); u.aux = 0; return true;
    }
};
__device__ __forceinline__ float silu_f(float x) { return x * __builtin_amdgcn_rcpf(1.0f + __expf(-x)); }
struct EpiSwiGLU {
    static constexpr int NPRE = 0; __device__ __forceinline__ void load_pre(const Unit&, int, int, int (&)[1]) const {}
    static constexpr bool PERM = true;
    bf16_t* H;
    __device__ __forceinline__ void operator()(const f32x4 (&acc)[2][2][4][2], const Unit& u, int wr, int wc, int fr, int fq) const {
        const int row0 = u.pm * BM + wr * 64 + fr, col0 = u.pn * 128 + wc * 32 + 8 * fq;
#pragma unroll
        for (int ai = 0; ai < 2; ++ai)
#pragma unroll
            for (int m = 0; m < 4; ++m) { bf16_t* rowp = H + (size_t)(row0 + ai * HALF + m * 16) * 256 + col0;
                const f32x4 g0 = acc[ai][0][m][0], g1 = acc[ai][0][m][1], u0 = acc[ai][1][m][0], u1 = acc[ai][1][m][1];
                u32x4 w; w.x = cvt_pk_bf16(silu_f(g0[0]) * u0[0], silu_f(g0[1]) * u0[1]); w.y = cvt_pk_bf16(silu_f(g0[2]) * u0[2], silu_f(g0[3]) * u0[3]);
                w.z = cvt_pk_bf16(silu_f(g1[0]) * u1[0], silu_f(g1[1]) * u1[1]); w.w = cvt_pk_bf16(silu_f(g1[2]) * u1[2], silu_f(g1[3]) * u1[3]);
                *(u32x4*)rowp = w; }
    }
};
struct EpiDown {
    static constexpr bool PERM = true; static constexpr int NPRE = 1;
    bf16_t* rows8; bf16_t* rows_sh; const int* dest; int nslot8;
    __device__ __forceinline__ void prefetch(const Unit& u, int slot, PG8_LAS unsigned char* lds, int wid, int lane) const {
        if (wid < 4) __builtin_amdgcn_global_load_lds((const unsigned*)(dest + u.pm * BM + wid * 64 + lane), (PG8_LAS unsigned*)(lds + STAGE_BYTES + slot * 1024 + wid * 256), 4, 0, 0);
    }
    __device__ __forceinline__ void operator()(const f32x4 (&acc)[2][2][4][2], const Unit& u, int wr, int wc, int fr, int fq, int slot, PG8_LAS unsigned char* lds) const {
        const int col0 = u.pn * BM + wc * 32 + 8 * fq; const PG8_LAS int* dl = (const PG8_LAS int*)(lds + STAGE_BYTES + slot * 1024) + wr * 64 + fr;
#if defined(EPI_REPS)
#pragma unroll 1
        for (int rep = 0; rep < EPI_REPS; ++rep) { asm volatile("" ::: "memory");
#else
        {
#endif
#pragma unroll
        for (int ai = 0; ai < 2; ++ai)
#pragma unroll
            for (int m = 0; m < 4; ++m) { const int d = dl[ai * HALF + m * 16];
                if (d >= 0) { bf16_t* rowp = (d < nslot8 ? rows8 + (size_t)d * 1024 : rows_sh + (size_t)(d - nslot8) * 1024) + col0;
#pragma unroll
                    for (int bj = 0; bj < 2; ++bj) { const f32x4 v0 = acc[ai][bj][m][0], v1 = acc[ai][bj][m][1];
                        u32x4 o; o.x = cvt_pk_bf16(v0[0], v0[1]); o.y = cvt_pk_bf16(v0[2], v0[3]); o.z = cvt_pk_bf16(v1[0], v1[1]); o.w = cvt_pk_bf16(v1[2], v1[3]);
#if defined(NT_STORES)
                        __builtin_nontemporal_store(o, (u32x4*)(rowp + bj * HALF));
#else
                        *(u32x4*)(rowp + bj * HALF) = o;
#endif
                        } } }
        }
    }
};
}
__device__ __forceinline__ void moe_convert_weights(const float* wg, const float* wu, const float* wd, const float* sg, const float* su, const float* sd,
                                                    bf16* WGU, bf16* WD, LAS float* scr, int first, int last, int stride, int lane) {
    for (int it = first; it < last; it += stride) {
        const int e = it / 192, r = it % 192, kind = r >> 6, q = r & 63;
        if (kind < 2) { const float* W = (e < 64 ? (kind == 0 ? wg : wu) + (size_t)e * 262144 : (kind == 0 ? sg : su));
            const int kb = q >> 2, nb = q & 3, k0 = 64 * kb, n0 = 64 * nb;
            tr_item64(W + (size_t)k0 * 256 + n0, 256, 64, WGU + ((size_t)e * 512 + (n0 >> 7) * 256 + (n0 & 127) + kind * 128) * 1024 + k0, 1024, scr, lane);
        } else { const float* W = e < 64 ? wd + (size_t)e * 262144 : sd;
            const int kb = q >> 4, nb = q & 15, k0 = 64 * kb, n0 = 64 * nb;
            tr_item64(W + (size_t)k0 * 1024 + n0, 1024, 64, WD + ((size_t)e * 1024 + n0) * 256 + k0, 256, scr, lane); }
    }
}
struct MoeLists { int* tok; int* dest; float* w; int* blk_e; };
__device__ __forceinline__ void moe_count(const int* ridx, unsigned* cnt, LAS unsigned* hist, int tid, int bid, int G) {
    if (tid < 64) hist[tid] = 0u;
    __syncthreads();
    for (int i = bid * NTHREADS + tid; i < T_ * 8; i += G * NTHREADS) atomicAdd((unsigned*)&hist[ridx[i]], 1u);
    __syncthreads();
    if (tid < 64 && hist[tid]) atomicAdd(&cnt[tid], hist[tid]);
    __syncthreads();
}
__device__ __forceinline__ void moe_build_lists(const int* ridx, const float* rwt, const unsigned* cnt, unsigned* cur, const MoeLists L, LAS int* sm, int tid, int bid, int G) {
    LAS int* pstart = sm; LAS unsigned* hist = (LAS unsigned*)(sm + 80); LAS unsigned* base = (LAS unsigned*)(sm + 160);
    if (tid == 0) { int acc = 0;
#pragma unroll 1
        for (int e = 0; e < 64; ++e) { pstart[e] = acc; acc += ((int)__hip_atomic_load(&cnt[e], __ATOMIC_RELAXED, __HIP_MEMORY_SCOPE_AGENT) + 255) & ~255; } pstart[64] = acc; pstart[65] = acc + T_; }
    __syncthreads();
    const int per = (T_ * 8 + G - 1) / G;
    const int lo = bid * per, hi = (lo + per < T_ * 8) ? lo + per : T_ * 8;
    for (int c0 = lo; c0 < hi; c0 += NTHREADS) {
        if (tid < 64) hist[tid] = 0u;
        __syncthreads();
        const int i = c0 + tid; int e = 0; unsigned local = 0u;
        if (i < hi) { e = ridx[i]; local = atomicAdd((unsigned*)&hist[e], 1u); }
        __syncthreads();
        if (tid < 64) base[tid] = hist[tid] ? atomicAdd(&cur[tid], hist[tid]) : 0u;
        __syncthreads();
        if (i < hi) { const int pos = pstart[e] + (int)base[e] + (int)local; L.tok[pos] = i >> 3; L.dest[pos] = i; L.w[pos] = rwt[i]; }
        __syncthreads();
    }
    for (int e = bid; e < 64; e += G) { const int c = (int)__hip_atomic_load(&cnt[e], __ATOMIC_RELAXED, __HIP_MEMORY_SCOPE_AGENT);
        for (int p = pstart[e] + c + tid; p < pstart[e + 1]; p += NTHREADS) { L.tok[p] = 0; L.dest[p] = -1; L.w[p] = 0.f; } }
    for (int t = bid * NTHREADS + tid; t < T_; t += G * NTHREADS) { const int p = pstart[64] + t; L.tok[p] = t; L.dest[p] = T_ * 8 + t; L.w[p] = 1.f; }
    const int nblk = pstart[65] >> 8;
    for (int b = bid * NTHREADS + tid; b < nblk; b += G * NTHREADS) { int e = 0;
#pragma unroll 1
        while (e < 64 && (pstart[e + 1] >> 8) <= b) ++e;
        L.blk_e[b] = e; }
    if (bid == 0 && tid == 0) L.blk_e[MOE_MAXBLK] = nblk;
    __syncthreads();
}
__device__ __forceinline__ void moe_combine_ln(float* h, const bf16* rows8, const bf16* rows_sh, const float* rwt, const float* lw, const float* lb, bf16* hbf, int gw, int NGW, int lane) {
    int t = gw; if (t >= T_) return;
    v4u rr[2][9]; f32x4 hh[4]; float wk[8];
#define CB_LOAD(tt) do { const size_t _t = (size_t)(tt); \
        _Pragma("unroll") for (int half = 0; half < 2; ++half) { const int c0 = half * 512 + lane * 8; \
            hh[half * 2] = *(const f32x4*)(h + _t * 1024 + c0); hh[half * 2 + 1] = *(const f32x4*)(h + _t * 1024 + c0 + 4); \
            _Pragma("unroll") for (int k = 0; k < 9; ++k) rr[half][k] = *(const v4u*)((k < 8 ? rows8 + (_t * 8 + k) * 1024 : rows_sh + _t * 1024) + c0); } \
        _Pragma("unroll") for (int k = 0; k < 8; ++k) wk[k] = rwt[_t * 8 + k]; } while (0)
    CB_LOAD(t);
    for (; t < T_; t += NGW) {
        float v[16];
#pragma unroll
        for (int half = 0; half < 2; ++half) { const f32x4 a = hh[half * 2], b = hh[half * 2 + 1];
            float s[8] = {a.x * nv::ALPHA, a.y * nv::ALPHA, a.z * nv::ALPHA, a.w * nv::ALPHA, b.x * nv::ALPHA, b.y * nv::ALPHA, b.z * nv::ALPHA, b.w * nv::ALPHA};
#pragma unroll
            for (int k = 0; k < 9; ++k) { const v4u r = rr[half][k]; const float w = k < 8 ? wk[k] : 1.0f;
                s[0] += w * __builtin_bit_cast(float, r.x << 16); s[1] += w * __builtin_bit_cast(float, r.x & 0xffff0000u);
                s[2] += w * __builtin_bit_cast(float, r.y << 16); s[3] += w * __builtin_bit_cast(float, r.y & 0xffff0000u);
                s[4] += w * __builtin_bit_cast(float, r.z << 16); s[5] += w * __builtin_bit_cast(float, r.z & 0xffff0000u);
                s[6] += w * __builtin_bit_cast(float, r.w << 16); s[7] += w * __builtin_bit_cast(float, r.w & 0xffff0000u); }
#pragma unroll
            for (int j = 0; j < 8; ++j) v[half * 8 + j] = s[j]; }
        if (t + NGW < T_) CB_LOAD(t + NGW);
        float sum = 0.f;
#pragma unroll
        for (int j = 0; j < 16; ++j) sum += v[j];
        sum = wave_sum(sum);
        const float mean = sum * (1.f / 1024.f);
        float sq = 0.f;
#pragma unroll
        for (int j = 0; j < 16; ++j) { v[j] -= mean; sq += v[j] * v[j]; }
        sq = wave_sum(sq);
        const float rstd = 1.0f / sqrtf(sq * (1.f / 1024.f) + nv::EPS);
#pragma unroll
        for (int half = 0; half < 2; ++half) { const int c0 = half * 512 + lane * 8;
            const f32x4 w0 = *(const f32x4*)(lw + c0), w1 = *(const f32x4*)(lw + c0 + 4), b0 = *(const f32x4*)(lb + c0), b1 = *(const f32x4*)(lb + c0 + 4);
            f32x4 o0, o1;
            o0.x = v[half * 8 + 0] * rstd * w0.x + b0.x; o0.y = v[half * 8 + 1] * rstd * w0.y + b0.y; o0.z = v[half * 8 + 2] * rstd * w0.z + b0.z; o0.w = v[half * 8 + 3] * rstd * w0.w + b0.w;
            o1.x = v[half * 8 + 4] * rstd * w1.x + b1.x; o1.y = v[half * 8 + 5] * rstd * w1.y + b1.y; o1.z = v[half * 8 + 6] * rstd * w1.z + b1.z; o1.w = v[half * 8 + 7] * rstd * w1.w + b1.w;
            *(f32x4*)(h + (size_t)t * 1024 + c0) = o0; *(f32x4*)(h + (size_t)t * 1024 + c0 + 4) = o1;
            if (hbf) { v4u p; p.x = pk2(o0.x, o0.y); p.y = pk2(o0.z, o0.w); p.z = pk2(o1.x, o1.y); p.w = pk2(o1.z, o1.w); *(v4u*)(hbf + (size_t)t * 1024 + c0) = p; } }
    }
#undef CB_LOAD
}
typedef float f32x16 __attribute__((ext_vector_type(16)));
typedef short s16x8 __attribute__((ext_vector_type(8)));
typedef LAS unsigned short lbf16;
__device__ __forceinline__ void mm32(f32x16& acc, const lbf16* A, int lda, const lbf16* B, int ldb, int K, int lane) {
    const lbf16* ap = A + (lane & 31) * lda + 8 * (lane >> 5);
    const lbf16* bp = B + (lane & 31) * ldb + 8 * (lane >> 5);
#pragma unroll 4
    for (int k = 0; k < K; k += 16) {
        const s16x8 a = *(const LAS s16x8*)(ap + k), b = *(const LAS s16x8*)(bp + k);
        acc = __builtin_amdgcn_mfma_f32_32x32x16_bf16(a, b, acc, 0, 0, 0);
    }
}
__device__ __forceinline__ void mm32_gb(f32x16& acc, const lbf16* A, int lda, const bf16* B, int ldb, int K, int lane) {
    const lbf16* ap = A + (lane & 31) * lda + 8 * (lane >> 5);
    const bf16* bp = B + (size_t)(lane & 31) * ldb + 8 * (lane >> 5);
#pragma unroll 4
    for (int k = 0; k < K; k += 16) {
        const s16x8 a = *(const LAS s16x8*)(ap + k), b = *(const s16x8*)(bp + k);
        acc = __builtin_amdgcn_mfma_f32_32x32x16_bf16(a, b, acc, 0, 0, 0);
    }
}
__device__ __forceinline__ int rowmap(int r, int lane) { return (r & 3) + 8 * (r >> 2) + 4 * (lane >> 5); }
__device__ __forceinline__ float rcp_f(float x) { return __builtin_amdgcn_rcpf(x); }
__device__ __forceinline__ float sigm_f(float x) { return rcp_f(1.0f + __expf(-x)); }
__device__ __forceinline__ float logsig_f(float x) { return fminf(x, 0.f) - __logf(1.0f + __expf(-fabsf(x))); }
__device__ __forceinline__ float softplus_f(float x) { return fmaxf(x, 0.f) + __logf(1.0f + __expf(-fabsf(x))); }
__device__ __forceinline__ float gelu_f(float x) { const float u = 0.7978845608028654f * (x + 0.044715f * x * x * x); return x * rcp_f(1.0f + __expf(-2.0f * u)); }
__device__ __forceinline__ void unpack8(const v4u r, float (&f)[8]) {
    f[0] = __builtin_bit_cast(float, r.x << 16); f[1] = __builtin_bit_cast(float, r.x & 0xffff0000u); f[2] = __builtin_bit_cast(float, r.y << 16); f[3] = __builtin_bit_cast(float, r.y & 0xffff0000u);
    f[4] = __builtin_bit_cast(float, r.z << 16); f[5] = __builtin_bit_cast(float, r.z & 0xffff0000u); f[6] = __builtin_bit_cast(float, r.w << 16); f[7] = __builtin_bit_cast(float, r.w & 0xffff0000u);
}
__device__ __forceinline__ v4u pack8(const float (&f)[8]) { v4u o; o.x = pk2(f[0], f[1]); o.y = pk2(f[2], f[3]); o.z = pk2(f[4], f[5]); o.w = pk2(f[6], f[7]); return o; }

struct Mix0Bufs { const bf16* proj; bf16* ct; float* nloc; float* blast; float* mloc; float* mprev; bf16* hloc; bf16* pc; float* carA; float* carU; float* carI; float* gst; bf16* mixbf; const bf16* lruw; };
constexpr int PJ0 = EINP;
__device__ __forceinline__ float lane_shr(float v, int o, int lane) { return __builtin_bit_cast(float, __builtin_amdgcn_ds_bpermute(((lane - o) & 63) << 2, __builtin_bit_cast(int, v))); }
__device__ __forceinline__ float wave_scan_add(float v, int lane) {
#pragma unroll
    for (int o = 1; o < 64; o <<= 1) { const float t = lane_shr(v, o, lane); v += (lane >= o) ? t : 0.f; }
    return v; }
__device__ __forceinline__ float wave_scan_max(float v, int lane) {
#pragma unroll
    for (int o = 1; o < 64; o <<= 1) { const float t = lane_shr(v, o, lane); v = (lane >= o) ? fmaxf(v, t) : v; }
    return v; }

__device__ __forceinline__ void mlstm_a_item(const Mix0Bufs& B, const float* gate_b, int cn, LAS unsigned char* lds, int tid) {
    const int lane = tid & 63, wave = __builtin_amdgcn_readfirstlane(tid >> 6);
    const int bh = cn / NCH, n = cn % NCH, b = bh >> 2, h = bh & 3;
    const size_t t0 = (size_t)b * S_ + n * 64;
    LAS float* pw = (LAS float*)lds;
    lbf16* kT = (lbf16*)(lds + 1024); lbf16* vT = (lbf16*)(lds + 1024 + 128 * 72 * 2);
    v4u gk[2], gv[2];
#pragma unroll
    for (int it = 0; it < 2; ++it) { const int vi = tid + it * 512, l = vi & 63, g = vi >> 6; const bf16* pr = B.proj + (t0 + l) * PJ0 + h * 128 + g * 8; gk[it] = *(const v4u*)(pr + 512); gv[it] = *(const v4u*)(pr + 1024); }
    if (wave == 0) { const bf16* pr = B.proj + (t0 + lane) * PJ0;
        const float lfv = logsig_f(bf2f(pr[2052 + h]) + gate_b[4 + h]), ig = bf2f(pr[2048 + h]) + gate_b[h];
        const float bcv = wave_scan_add(lfv, lane), wlv = ig - bcv, pmv = wave_scan_max(wlv, lane);
        const float blast = __builtin_bit_cast(float, __builtin_amdgcn_readlane(__builtin_bit_cast(int, bcv), 63)), mx = __builtin_bit_cast(float, __builtin_amdgcn_readlane(__builtin_bit_cast(int, pmv), 63));
        pw[lane] = __expf(wlv - mx) * 0.08838834764831845f;
        float* gs = B.gst + (size_t)cn * 192; gs[lane] = bcv; gs[64 + lane] = wlv; gs[128 + lane] = pmv;
        if (lane == 0) { B.blast[cn] = blast; B.mloc[cn] = blast + mx; } }
    __syncthreads();
#pragma unroll
    for (int it = 0; it < 2; ++it) { const int vi = tid + it * 512, l = vi & 63, g = vi >> 6;
        float kf[8], vf[8]; unpack8(gk[it], kf); unpack8(gv[it], vf);
        const float p = pw[l];
#pragma unroll
        for (int j = 0; j < 8; ++j) { kT[(g * 8 + j) * 72 + l] = (unsigned short)f2bf(kf[j] * p); vT[(g * 8 + j) * 72 + l] = (unsigned short)f2bf(vf[j]); } }
    __syncthreads();
    const int et = wave >> 1;
#pragma unroll
    for (int q = 0; q < 2; ++q) { const int dt = (wave & 1) * 2 + q;
        f32x16 acc = {0.f, 0.f, 0.f, 0.f, 0.f, 0.f, 0.f, 0.f, 0.f, 0.f, 0.f, 0.f, 0.f, 0.f, 0.f, 0.f};
        mm32(acc, kT + dt * 32 * 72, 72, vT + et * 32 * 72, 72, 64, lane);
        bf16* out = B.ct + (size_t)cn * 16384 + (et * 4 + dt) * 1024 + lane * 16;
        v4u o0, o1; o0.x = pk2(acc[0], acc[1]); o0.y = pk2(acc[2], acc[3]); o0.z = pk2(acc[4], acc[5]); o0.w = pk2(acc[6], acc[7]);
        o1.x = pk2(acc[8], acc[9]); o1.y = pk2(acc[10], acc[11]); o1.z = pk2(acc[12], acc[13]); o1.w = pk2(acc[14], acc[15]);
        *(v4u*)out = o0; *(v4u*)(out + 8) = o1; }
    { const int d = tid >> 2, qq = tid & 3; float f0[8], f1[8]; unpack8(*(const LAS v4u*)(kT + d * 72 + qq * 16), f0); unpack8(*(const LAS v4u*)(kT + d * 72 + qq * 16 + 8), f1);
      float sacc = 0.f;
#pragma unroll
      for (int j = 0; j < 8; ++j) sacc += f0[j] + f1[j];
      sacc += __builtin_bit_cast(float, __builtin_amdgcn_ds_swizzle(__builtin_bit_cast(int, sacc), 0x1f | (1 << 10)));
      sacc += __builtin_bit_cast(float, __builtin_amdgcn_ds_swizzle(__builtin_bit_cast(int, sacc), 0x1f | (2 << 10)));
      if (qq == 0) B.nloc[(size_t)cn * 128 + d] = sacc; }
    __syncthreads();
}
constexpr int SB = 32;
__device__ __forceinline__ void mlstm_b(const Mix0Bufs& B, int gtid, int gsz) {
    for (int idx = gtid; idx < 8 * 8192 + 8 * 128; idx += gsz) {
        const bool isn = idx >= 8 * 8192;
        if (!isn) { const int bh = idx >> 13, pe = idx & 8191;
            float s0 = 0.f, s1 = 0.f, m = 0.f; unsigned* p = (unsigned*)B.ct + (size_t)bh * NCH * 8192 + pe;
            for (int n0 = 0; n0 < NCH; n0 += SB) { unsigned cl[SB]; float bl[SB], ml[SB];
#pragma unroll
                for (int j = 0; j < SB; ++j) { cl[j] = p[(size_t)(n0 + j) * 8192]; bl[j] = B.blast[bh * NCH + n0 + j]; ml[j] = B.mloc[bh * NCH + n0 + j]; }
#pragma unroll
                for (int j = 0; j < SB; ++j) { const unsigned out = pk2(s0, s1); const float mn = fmaxf(bl[j] + m, ml[j]), kf = __expf(bl[j] + m - mn), af = __expf(ml[j] - mn);
                    s0 = kf * s0 + af * __builtin_bit_cast(float, cl[j] << 16); s1 = kf * s1 + af * __builtin_bit_cast(float, cl[j] & 0xffff0000u);
                    if (pe == 0) B.mprev[bh * NCH + n0 + j] = m;
                    m = mn; cl[j] = out; }
#pragma unroll
                for (int j = 0; j < SB; ++j) p[(size_t)(n0 + j) * 8192] = cl[j]; }
        } else { const int r = idx - 8 * 8192, bh = r >> 7, de = r & 127;
            float st = 0.f, m = 0.f; float* p = B.nloc + (size_t)bh * NCH * 128 + de;
            for (int n0 = 0; n0 < NCH; n0 += SB) { float cl[SB], bl[SB], ml[SB];
#pragma unroll
                for (int j = 0; j < SB; ++j) { cl[j] = p[(size_t)(n0 + j) * 128]; bl[j] = B.blast[bh * NCH + n0 + j]; ml[j] = B.mloc[bh * NCH + n0 + j]; }
#pragma unroll
                for (int j = 0; j < SB; ++j) { const float out = st; const float mn = fmaxf(bl[j] + m, ml[j]);
                    st = __expf(bl[j] + m - mn) * st + __expf(ml[j] - mn) * cl[j]; m = mn; cl[j] = out; }
#pragma unroll
                for (int j = 0; j < SB; ++j) p[(size_t)(n0 + j) * 128] = cl[j]; } }
    }
}
__device__ __forceinline__ void mlstm_c_item(const Mix0Bufs& B, const float* gate_b, const float* norm_w, int cn, LAS unsigned char* lds, int tid) {
    const int lane = tid & 63, wave = __builtin_amdgcn_readfirstlane(tid >> 6);
    const int bh = cn / NCH, n = cn % NCH, b = bh >> 2, h = bh & 3;
    const size_t t0 = (size_t)b * S_ + n * 64;
    LAS float* bm = (LAS float*)lds; LAS float* wl = bm + 64; LAS float* den = bm + 256; LAS float* emi = bm + 320;
    lbf16* qs = (lbf16*)(lds + 2048); lbf16* ks = (lbf16*)(lds + 19456); lbf16* qw = (lbf16*)(lds + 36864);
    lbf16* vT = (lbf16*)(lds + 54272); lbf16* cT = (lbf16*)(lds + 77312); lbf16* sm = (lbf16*)(lds + 120832);
    LAS float* hb = (LAS float*)(lds + 2048);
    const float mprev = B.mprev[cn];
    const float* gs = B.gst + (size_t)cn * 192;
    v4u gq[2], gk[2], gv[2], go[2], gc[4]; float sb[2], sp[2];
#pragma unroll
    for (int it = 0; it < 2; ++it) { const int vi = tid + it * 512; { const int l = vi >> 4, g = vi & 15; const bf16* pr = B.proj + (t0 + l) * PJ0 + h * 128 + g * 8; gq[it] = *(const v4u*)pr; gk[it] = *(const v4u*)(pr + 512); sb[it] = gs[l]; sp[it] = gs[128 + l]; }
        { const int l = vi & 63, g = vi >> 6; gv[it] = *(const v4u*)(B.proj + (t0 + l) * PJ0 + 1024 + h * 128 + g * 8); } }
    { const bf16* cg = B.ct + (size_t)cn * 16384;
#pragma unroll
      for (int it = 0; it < 4; ++it) gc[it] = *(const v4u*)(cg + (tid + it * 512) * 8); }
    { const int i = tid >> 3, sub = tid & 7; const bf16* op = B.proj + (t0 + i) * PJ0 + 1536 + h * 128 + sub * 16; go[0] = *(const v4u*)op; go[1] = *(const v4u*)(op + 8); }
    const float gnl = tid < 128 ? B.nloc[(size_t)cn * 128 + tid] : 0.f;
    if (wave == 0) { const float bi = gs[lane], wv = gs[64 + lane], pm = gs[128 + lane]; const float m = bi + fmaxf(mprev, pm);
        bm[lane] = bi - m; wl[lane] = wv; emi[lane] = __expf(-m); vT[128 * 72 + lane] = (unsigned short)0x3f80; }
#pragma unroll
    for (int it = 0; it < 2; ++it) { const int vi = tid + it * 512, l = vi >> 4, g = vi & 15;
        float qf[8], kf[8]; unpack8(gq[it], qf); unpack8(gk[it], kf);
        const float w = __expf(mprev - fmaxf(mprev, sp[it])); float qwf[8];
#pragma unroll
        for (int j = 0; j < 8; ++j) { kf[j] *= 0.08838834764831845f; qwf[j] = qf[j] * w; }
        *(LAS v4u*)(qs + l * 136 + g * 8) = gq[it]; *(LAS v4u*)(ks + l * 136 + g * 8) = pack8(kf); *(LAS v4u*)(qw + l * 136 + g * 8) = pack8(qwf); }
#pragma unroll
    for (int it = 0; it < 2; ++it) { const int vi = tid + it * 512, l = vi & 63, g = vi >> 6;
        float vf[8]; unpack8(gv[it], vf);
#pragma unroll
        for (int j = 0; j < 8; ++j) vT[(g * 8 + j) * 72 + l] = (unsigned short)f2bf(vf[j]); }
#pragma unroll
    for (int it = 0; it < 4; ++it) { const int vi = tid + it * 512, T = vi >> 7, ln = (vi >> 1) & 63, hr = vi & 1; const v4u x = gc[it];
        LAS unsigned char* dp = (LAS unsigned char*)(cT + ((T >> 2) * 32 + (ln & 31)) * 136 + (T & 3) * 32 + 16 * hr + 4 * (ln >> 5));
        *(LAS v2u*)dp = (v2u){x.x, x.y}; *(LAS v2u*)(dp + 16) = (v2u){x.z, x.w}; }
    if (tid < 128) cT[128 * 136 + tid] = (unsigned short)f2bf(gnl);
    __syncthreads();
    if (wave < 4) { const int it = wave >> 1, jt = wave & 1;
        f32x16 acc = {0.f, 0.f, 0.f, 0.f, 0.f, 0.f, 0.f, 0.f, 0.f, 0.f, 0.f, 0.f, 0.f, 0.f, 0.f, 0.f};
        if (jt <= it) mm32(acc, ks + jt * 32 * 136, 136, qs + it * 32 * 136, 136, 128, lane);
        const int i = it * 32 + (lane & 31); const float bmi = bm[i];
#pragma unroll
        for (int g4 = 0; g4 < 4; ++g4) { const int j0 = jt * 32 + 8 * g4 + 4 * (lane >> 5); const f32x4 w4 = *(const LAS f32x4*)(wl + j0);
            const float v0 = j0 <= i ? acc[g4 * 4] * __expf(bmi + w4.x) : 0.f, v1 = j0 + 1 <= i ? acc[g4 * 4 + 1] * __expf(bmi + w4.y) : 0.f;
            const float v2 = j0 + 2 <= i ? acc[g4 * 4 + 2] * __expf(bmi + w4.z) : 0.f, v3 = j0 + 3 <= i ? acc[g4 * 4 + 3] * __expf(bmi + w4.w) : 0.f;
            *(LAS v2u*)(sm + i * 72 + j0) = (v2u){pk2(v0, v1), pk2(v2, v3)}; } }
    __syncthreads();
    f32x16 accA = {0.f, 0.f, 0.f, 0.f, 0.f, 0.f, 0.f, 0.f, 0.f, 0.f, 0.f, 0.f, 0.f, 0.f, 0.f, 0.f}, accB = accA;
    { const int id = wave, it = id / 5, nt = id % 5;
      mm32(accA, vT + nt * 32 * 72, 72, sm + it * 32 * 72, 72, 64, lane); mm32(accA, cT + nt * 32 * 136, 136, qw + it * 32 * 136, 136, 128, lane);
      if (nt == 4 && lane < 32) den[it * 32 + lane] = accA[0]; }
    if (wave < 2) { const int id = wave + 8, it = id / 5, nt = id % 5;
      mm32(accB, vT + nt * 32 * 72, 72, sm + it * 32 * 72, 72, 64, lane); mm32(accB, cT + nt * 32 * 136, 136, qw + it * 32 * 136, 136, 128, lane);
      if (nt == 4 && lane < 32) den[it * 32 + lane] = accB[0]; }
    __syncthreads();
    { const int id = wave, it = id / 5, nt = id % 5;
      if (nt < 4) { const int i = it * 32 + (lane & 31); const float rd = rcp_f(fmaxf(fabsf(den[i]), emi[i]));
#pragma unroll
          for (int g4 = 0; g4 < 4; ++g4) *(LAS f32x4*)(hb + i * 132 + nt * 32 + 8 * g4 + 4 * (lane >> 5)) = (f32x4){accA[g4 * 4] * rd, accA[g4 * 4 + 1] * rd, accA[g4 * 4 + 2] * rd, accA[g4 * 4 + 3] * rd}; } }
    if (wave < 2) { const int id = wave + 8, it = id / 5, nt = id % 5;
      if (nt < 4) { const int i = it * 32 + (lane & 31); const float rd = rcp_f(fmaxf(fabsf(den[i]), emi[i]));
#pragma unroll
          for (int g4 = 0; g4 < 4; ++g4) *(LAS f32x4*)(hb + i * 132 + nt * 32 + 8 * g4 + 4 * (lane >> 5)) = (f32x4){accB[g4 * 4] * rd, accB[g4 * 4 + 1] * rd, accB[g4 * 4 + 2] * rd, accB[g4 * 4 + 3] * rd}; } }
    __syncthreads();
    { const int i = tid >> 3, sub = tid & 7; const LAS float* hr = hb + i * 132 + sub * 16;
      float x[16]; float s = 0.f;
#pragma unroll
      for (int j = 0; j < 16; ++j) { x[j] = hr[j]; s += x[j]; }
      s += __builtin_bit_cast(float, __builtin_amdgcn_ds_swizzle(__builtin_bit_cast(int, s), 0x1f | (1 << 10)));
      s += __builtin_bit_cast(float, __builtin_amdgcn_ds_swizzle(__builtin_bit_cast(int, s), 0x1f | (2 << 10)));
      s += __builtin_bit_cast(float, __builtin_amdgcn_ds_swizzle(__builtin_bit_cast(int, s), 0x1f | (4 << 10)));
      const float mean = s * (1.f / 128.f); float q = 0.f;
#pragma unroll
      for (int j = 0; j < 16; ++j) { x[j] -= mean; q += x[j] * x[j]; }
      q += __builtin_bit_cast(float, __builtin_amdgcn_ds_swizzle(__builtin_bit_cast(int, q), 0x1f | (1 << 10)));
      q += __builtin_bit_cast(float, __builtin_amdgcn_ds_swizzle(__builtin_bit_cast(int, q), 0x1f | (2 << 10)));
      q += __builtin_bit_cast(float, __builtin_amdgcn_ds_swizzle(__builtin_bit_cast(int, q), 0x1f | (4 << 10)));
      const float rstd = __builtin_amdgcn_rsqf(q * (1.f / 128.f) + nv::EPS);
      const float* nw = norm_w + h * 128 + sub * 16;
      float o0[8], o1[8]; unpack8(go[0], o0); unpack8(go[1], o1);
      float y0[8], y1[8];
#pragma unroll
      for (int j = 0; j < 8; ++j) { y0[j] = x[j] * rstd * nw[j] * sigm_f(o0[j]); y1[j] = x[8 + j] * rstd * nw[8 + j] * sigm_f(o1[j]); }
      bf16* dst = B.mixbf + (t0 + i) * 1024 + h * 128 + sub * 16;
      *(v4u*)dst = pack8(y0); *(v4u*)(dst + 8) = pack8(y1); }
    __syncthreads();
}
__device__ __forceinline__ void lru_a_item(const Mix0Bufs& B, const float* const* in, int ch, LAS unsigned char* lds, int tid) {
    const int lane = tid & 63, wave = __builtin_amdgcn_readfirstlane(tid >> 6);
    const size_t t0 = (size_t)ch * 64; const int s0 = (ch % NCH) * 64;
    lbf16* xc = (lbf16*)lds; LAS float* al = (LAS float*)(lds + 17408); LAS float* ul = (LAS float*)(lds + 17408 + 32768); LAS float* seg = (LAS float*)(lds + 17408 + 65536);
    const float* cw = in[9]; const float* cb = in[10]; const float* ba = in[12]; const float* bx = in[14]; const float* lam = in[15];
    for (int hh = 0; hh < 4; ++hh) {
        const int it = wave & 1, nt = wave >> 1;
        s16x8 wr[8], wx[8];
        { const bf16* bp = B.lruw + (size_t)(hh * 128 + nt * 32 + (lane & 31)) * 128 + 8 * (lane >> 5);
#pragma unroll
          for (int k = 0; k < 8; ++k) { wr[k] = *(const s16x8*)(bp + k * 16); wx[k] = *(const s16x8*)(bp + (size_t)512 * 128 + k * 16); } }
        { const int g = tid & 15, lr = tid >> 4, c0 = hh * 128 + g * 8;
          float xf[5][8];
#pragma unroll
          for (int k = 0; k < 5; ++k) { const int l = 2 * lr - 3 + k; v4u x = {0u, 0u, 0u, 0u}; if (s0 + l >= 0) x = *(const v4u*)(B.proj + (t0 + l) * PJ0 + 2056 + c0); unpack8(x, xf[k]); }
          float a0[8], a1[8];
#pragma unroll
          for (int j = 0; j < 8; ++j) { a0[j] = cb[c0 + j]; a1[j] = a0[j]; }
#pragma unroll
          for (int tap = 0; tap < 4; ++tap) {
#pragma unroll
              for (int j = 0; j < 8; ++j) { const float w = cw[tap * 512 + c0 + j]; a0[j] += w * xf[tap][j]; a1[j] += w * xf[tap + 1][j]; } }
          *(LAS v4u*)(xc + (2 * lr) * 136 + g * 8) = pack8(a0); *(LAS v4u*)(xc + (2 * lr + 1) * 136 + g * 8) = pack8(a1);
          *(LAS f32x4*)(ul + (2 * lr) * 128 + g * 8) = (f32x4){a0[0], a0[1], a0[2], a0[3]}; *(LAS f32x4*)(ul + (2 * lr) * 128 + g * 8 + 4) = (f32x4){a0[4], a0[5], a0[6], a0[7]};
          *(LAS f32x4*)(ul + (2 * lr + 1) * 128 + g * 8) = (f32x4){a1[0], a1[1], a1[2], a1[3]}; *(LAS f32x4*)(ul + (2 * lr + 1) * 128 + g * 8 + 4) = (f32x4){a1[4], a1[5], a1[6], a1[7]}; }
        __syncthreads();
        { f32x16 ra = {0.f, 0.f, 0.f, 0.f, 0.f, 0.f, 0.f, 0.f, 0.f, 0.f, 0.f, 0.f, 0.f, 0.f, 0.f, 0.f}, xa = ra;
          const lbf16* ap = xc + (it * 32 + (lane & 31)) * 136 + 8 * (lane >> 5);
#pragma unroll
          for (int k = 0; k < 8; ++k) { const s16x8 a = *(const LAS s16x8*)(ap + k * 16);
              ra = __builtin_amdgcn_mfma_f32_32x32x16_bf16(a, wr[k], ra, 0, 0, 0); xa = __builtin_amdgcn_mfma_f32_32x32x16_bf16(a, wx[k], xa, 0, 0, 0); }
          const int c = nt * 32 + (lane & 31), cg = hh * 128 + c; const float bav = ba[cg], bxv = bx[cg], sp = softplus_f(-lam[cg]);
#pragma unroll
          for (int r = 0; r < 16; ++r) { const int l = it * 32 + rowmap(r, lane);
              const float rr = sigm_f(ra[r] + bav), ii = sigm_f(xa[r] + bxv), la = -8.0f * rr * sp;
              const float xv = ul[l * 128 + c];
              al[l * 128 + c] = __expf(la); ul[l * 128 + c] = __builtin_amdgcn_sqrtf(1.0f - __expf(2.0f * la)) * ii * xv; } }
        __syncthreads();
        { const int cp = tid & 63, sg = wave;
          float h0 = 0.f, h1 = 0.f, P0 = 1.f, P1 = 1.f; float hl0[8], hl1[8], Pl0[8], Pl1[8];
#pragma unroll
          for (int t = 0; t < 8; ++t) { const hwf2_t a2 = *(const LAS hwf2_t*)(al + (sg * 8 + t) * 128 + 2 * cp), u2 = *(const LAS hwf2_t*)(ul + (sg * 8 + t) * 128 + 2 * cp);
              h0 = a2.x * h0 + u2.x; h1 = a2.y * h1 + u2.y; P0 *= a2.x; P1 *= a2.y; hl0[t] = h0; hl1[t] = h1; Pl0[t] = P0; Pl1[t] = P1; }
          *(LAS f32x4*)(seg + (sg * 128 + 2 * cp) * 2) = (f32x4){P0, h0, P1, h1};
          __syncthreads();
          float Pi0 = 1.f, Pi1 = 1.f, hi0 = 0.f, hi1 = 0.f;
          for (int q = 0; q < sg; ++q) { const f32x4 e = *(const LAS f32x4*)(seg + (q * 128 + 2 * cp) * 2); hi0 = e.x * hi0 + e.y; hi1 = e.z * hi1 + e.w; Pi0 *= e.x; Pi1 *= e.z; }
          bf16* hp = B.hloc + (t0 + sg * 8) * 512 + hh * 128 + 2 * cp; bf16* pp = B.pc + (t0 + sg * 8) * 512 + hh * 128 + 2 * cp;
#pragma unroll
          for (int t = 0; t < 8; ++t) { *(unsigned*)(hp + (size_t)t * 512) = pk2(hl0[t] + Pl0[t] * hi0, hl1[t] + Pl1[t] * hi1); *(unsigned*)(pp + (size_t)t * 512) = pk2(Pl0[t] * Pi0, Pl1[t] * Pi1); }
          if (sg == 7) { float2 ca, cu; ca.x = Pl0[7] * Pi0; ca.y = Pl1[7] * Pi1; cu.x = hl0[7] + Pl0[7] * hi0; cu.y = hl1[7] + Pl1[7] * hi1;
              *(float2*)(B.carA + (size_t)ch * 512 + hh * 128 + 2 * cp) = ca; *(float2*)(B.carU + (size_t)ch * 512 + hh * 128 + 2 * cp) = cu; } }
    }
    __syncthreads();
}
__device__ __forceinline__ void lru_b(const Mix0Bufs& B, int gtid, int gsz) {
    for (int idx = gsz - 1 - gtid; idx < 2 * 512; idx += gsz)   { const int b = idx >> 9, c = idx & 511; float hst = 0.f;
        for (int n0 = 0; n0 < NCH; n0 += SB) { float a[SB], u[SB];
#pragma unroll
            for (int j = 0; j < SB; ++j) { const size_t o = (size_t)(b * NCH + n0 + j) * 512 + c; a[j] = B.carA[o]; u[j] = B.carU[o]; }
#pragma unroll
            for (int j = 0; j < SB; ++j) { const float in = hst; hst = a[j] * hst + u[j]; a[j] = in; }
#pragma unroll
            for (int j = 0; j < SB; ++j) B.carI[(size_t)(b * NCH + n0 + j) * 512 + c] = a[j]; } }
}
__device__ __forceinline__ void lru_c(const Mix0Bufs& B, int gtid, int gsz) {
    for (int idx = gtid; idx < T_ * 64; idx += gsz) { const size_t t = idx >> 6; const int c0 = (idx & 63) * 8; const size_t ch = t >> 6;
        float gb[8], y[8]; unpack8(*(const v4u*)(B.proj + t * PJ0 + 2568 + c0), gb);
        float hp[8], pp[8]; unpack8(*(const v4u*)(B.hloc + t * 512 + c0), hp); unpack8(*(const v4u*)(B.pc + t * 512 + c0), pp); const float* ci = B.carI + ch * 512 + c0;
#pragma unroll
        for (int j = 0; j < 8; ++j) y[j] = (hp[j] + pp[j] * ci[j]) * gelu_f(gb[j]);
        *(v4u*)(B.mixbf + t * 1024 + 512 + c0) = pack8(y); }
}
constexpr int PJ1 = OINP;
struct Mix1Bufs { const bf16* proj; bf16* ut; float* gbl; bf16* s5g; float* xend; float* xstart; float* s5ab; float* s5bb; bf16* cm; bf16* bbt; bf16* mixbf; };
__device__ __forceinline__ void gla_gates(const bf16* proj, const float* gw, const float* gb, size_t t0, int h, LAS float* bc, LAS float* gl, LAS float* tot, int tid) {
    const int d = tid & 63, lg = __builtin_amdgcn_readfirstlane(tid >> 6);
    if (tid < 128) { const int l = tid >> 1, hf = tid & 1; float f[8]; unpack8(*(const v4u*)(proj + (t0 + l) * PJ1 + 2048 + hf * 8), f);
        *(LAS f32x4*)(gl + l * 16 + hf * 8) = (f32x4){f[0], f[1], f[2], f[3]}; *(LAS f32x4*)(gl + l * 16 + hf * 8 + 4) = (f32x4){f[4], f[5], f[6], f[7]}; }
    float w[16];
#pragma unroll
    for (int r = 0; r < 16; ++r) w[r] = gw[r * 256 + h * 64 + d];
    const float bias = gb[h * 64 + d];
    __syncthreads();
    float v[8];
#pragma unroll
    for (int q = 0; q < 8; ++q) { const int l = lg * 8 + q; float acc = bias;
#pragma unroll
        for (int r4 = 0; r4 < 4; ++r4) { const f32x4 g4 = *(const LAS f32x4*)(gl + l * 16 + r4 * 4); acc += g4.x * w[r4 * 4] + g4.y * w[r4 * 4 + 1] + g4.z * w[r4 * 4 + 2] + g4.w * w[r4 * 4 + 3]; }
        v[q] = logsig_f(acc) * 0.0625f; }
#pragma unroll
    for (int q = 1; q < 8; ++q) v[q] += v[q - 1];
    tot[lg * 64 + d] = v[7];
    __syncthreads();
    float pre = 0.f;
#pragma unroll
    for (int s = 0; s < 7; ++s) { const float t = tot[s * 64 + d]; pre += (s < lg) ? t : 0.f; }
#pragma unroll
    for (int q = 0; q < 8; ++q) bc[(lg * 8 + q) * 64 + d] = v[q] + pre;
    __syncthreads();
}
__device__ __forceinline__ void gla_a_item(const Mix1Bufs& B, const float* gw, const float* gb, int cn, LAS unsigned char* lds, int tid) {
    const int lane = tid & 63, wave = __builtin_amdgcn_readfirstlane(tid >> 6);
    const int bh = cn / NCH, n = cn % NCH, b = bh >> 2, h = bh & 3;
    const size_t t0 = (size_t)b * S_ + n * 64;
    LAS float* bc = (LAS float*)lds; LAS float* gl = (LAS float*)(lds + 16384); LAS float* tot = (LAS float*)(lds + 118784);
    lbf16* kT = (lbf16*)(lds + 20480); lbf16* vT = (lbf16*)(lds + 20480 + 64 * 72 * 2);
    v4u gk, gv[2];
    { const int l = tid & 63, g = tid >> 6; gk = *(const v4u*)(B.proj + (t0 + l) * PJ1 + 768 + h * 64 + g * 8); }
#pragma unroll
    for (int it = 0; it < 2; ++it) { const int vi = tid + it * 512, l = vi & 63, g = vi >> 6; gv[it] = *(const v4u*)(B.proj + (t0 + l) * PJ1 + 1024 + h * 128 + g * 8); }
    gla_gates(B.proj, gw, gb, t0, h, bc, gl, tot, tid);
    { const int l = tid & 63, g = tid >> 6; float kf[8]; unpack8(gk, kf);
#pragma unroll
      for (int j = 0; j < 8; ++j) { const int d = g * 8 + j; kT[d * 72 + l] = (unsigned short)f2bf(kf[j] * __expf(bc[63 * 64 + d] - bc[l * 64 + d])); } }
#pragma unroll
    for (int it = 0; it < 2; ++it) { const int vi = tid + it * 512, l = vi & 63, g = vi >> 6; float vf[8]; unpack8(gv[it], vf);
#pragma unroll
        for (int j = 0; j < 8; ++j) vT[(g * 8 + j) * 72 + l] = (unsigned short)f2bf(vf[j]); }
    __syncthreads();
    { const int et = wave >> 1, dt = wave & 1;
      f32x16 acc = {0.f, 0.f, 0.f, 0.f, 0.f, 0.f, 0.f, 0.f, 0.f, 0.f, 0.f, 0.f, 0.f, 0.f, 0.f, 0.f};
      mm32(acc, kT + dt * 32 * 72, 72, vT + et * 32 * 72, 72, 64, lane);
      bf16* out = B.ut + (size_t)cn * 8192 + (et * 2 + dt) * 1024 + lane * 16;
      v4u o0, o1; o0.x = pk2(acc[0], acc[1]); o0.y = pk2(acc[2], acc[3]); o0.z = pk2(acc[4], acc[5]); o0.w = pk2(acc[6], acc[7]);
      o1.x = pk2(acc[8], acc[9]); o1.y = pk2(acc[10], acc[11]); o1.z = pk2(acc[12], acc[13]); o1.w = pk2(acc[14], acc[15]);
      *(v4u*)out = o0; *(v4u*)(out + 8) = o1; }
    if (tid < 64) B.gbl[(size_t)cn * 64 + tid] = bc[63 * 64 + tid];
    __syncthreads();
}
__device__ __forceinline__ void gla_b(const Mix1Bufs& B, int gtid, int gsz) {
    for (int idx = gtid; idx < 8 * 4096; idx += gsz) { const int bh = idx >> 12, pe = idx & 4095, d = ((pe >> 9) & 1) * 32 + ((pe * 2) & 3) + 8 * ((pe >> 1) & 3) + 4 * ((pe >> 8) & 1); float s0 = 0.f, s1 = 0.f;
        unsigned* p = (unsigned*)B.ut + (size_t)bh * NCH * 4096 + pe; const float* gp = B.gbl + (size_t)bh * NCH * 64 + d;
        for (int n0 = 0; n0 < NCH; n0 += SB) { unsigned u[SB]; float g0[SB], g1[SB];
#pragma unroll
            for (int j = 0; j < SB; ++j) { u[j] = p[(size_t)(n0 + j) * 4096]; g0[j] = gp[(n0 + j) * 64]; g1[j] = gp[(n0 + j) * 64 + 1]; }
#pragma unroll
            for (int j = 0; j < SB; ++j) { const unsigned out = pk2(s0, s1);
                s0 = __expf(g0[j]) * s0 + __builtin_bit_cast(float, u[j] << 16); s1 = __expf(g1[j]) * s1 + __builtin_bit_cast(float, u[j] & 0xffff0000u); u[j] = out; }
#pragma unroll
            for (int j = 0; j < SB; ++j) p[(size_t)(n0 + j) * 4096] = u[j]; } }
}
__device__ __forceinline__ void gla_c_item(const Mix1Bufs& B, const float* gw, const float* gb, const float* norm_w, int cn, LAS unsigned char* lds, int tid) {
    const int lane = tid & 63, wave = __builtin_amdgcn_readfirstlane(tid >> 6);
    const int bh = cn / NCH, n = cn % NCH, b = bh >> 2, h = bh & 3;
    const size_t t0 = (size_t)b * S_ + n * 64;
    LAS float* bc = (LAS float*)lds; LAS float* gl = (LAS float*)(lds + 16384);
    lbf16* qd = (lbf16*)(lds + 20480); lbf16* ki = (lbf16*)(lds + 29696); lbf16* vT = (lbf16*)(lds + 38912); lbf16* sT = (lbf16*)(lds + 57344); lbf16* att = (lbf16*)(lds + 75776);
    LAS float* ob = (LAS float*)(lds + 84992); LAS float* tot = (LAS float*)(lds + 118784);
    gla_gates(B.proj, gw, gb, t0, h, bc, gl, tot, tid);
    { const int l = tid >> 3, g = tid & 7; const bf16* pr = B.proj + (t0 + l) * PJ1 + h * 64 + g * 8; float qf[8], kf[8]; unpack8(*(const v4u*)(pr + 512), qf); unpack8(*(const v4u*)(pr + 768), kf);
#pragma unroll
      for (int j = 0; j < 8; ++j) { const float bb = bc[l * 64 + g * 8 + j]; qf[j] *= 0.125f * __expf(bb); kf[j] *= __expf(-bb); }
      *(LAS v4u*)(qd + l * 72 + g * 8) = pack8(qf); *(LAS v4u*)(ki + l * 72 + g * 8) = pack8(kf); }
#pragma unroll
    for (int it = 0; it < 2; ++it) { const int vi = tid + it * 512, l = vi & 63, g = vi >> 6; float vf[8]; unpack8(*(const v4u*)(B.proj + (t0 + l) * PJ1 + 1024 + h * 128 + g * 8), vf);
#pragma unroll
        for (int j = 0; j < 8; ++j) vT[(g * 8 + j) * 72 + l] = (unsigned short)f2bf(vf[j]); }
    { const bf16* sg = B.ut + (size_t)cn * 8192;
#pragma unroll
      for (int it = 0; it < 2; ++it) { const int vi = tid + it * 512, T = vi >> 7, ln = (vi >> 1) & 63, hr = vi & 1; const v4u x = *(const v4u*)(sg + vi * 8);
          LAS unsigned char* dp = (LAS unsigned char*)(sT + ((T >> 1) * 32 + (ln & 31)) * 72 + (T & 1) * 32 + 16 * hr + 4 * (ln >> 5));
          *(LAS v2u*)dp = (v2u){x.x, x.y}; *(LAS v2u*)(dp + 16) = (v2u){x.z, x.w}; } }
    __syncthreads();
    if (wave < 4) { const int it = wave >> 1, jt = wave & 1;
        f32x16 acc = {0.f, 0.f, 0.f, 0.f, 0.f, 0.f, 0.f, 0.f, 0.f, 0.f, 0.f, 0.f, 0.f, 0.f, 0.f, 0.f};
        if (jt <= it) mm32(acc, ki + jt * 32 * 72, 72, qd + it * 32 * 72, 72, 64, lane);
        const int i = it * 32 + (lane & 31);
#pragma unroll
        for (int g4 = 0; g4 < 4; ++g4) { const int j0 = jt * 32 + 8 * g4 + 4 * (lane >> 5);
            v2u o; o.x = pk2(j0 <= i ? acc[g4 * 4] : 0.f, j0 + 1 <= i ? acc[g4 * 4 + 1] : 0.f); o.y = pk2(j0 + 2 <= i ? acc[g4 * 4 + 2] : 0.f, j0 + 3 <= i ? acc[g4 * 4 + 3] : 0.f);
            *(LAS v2u*)(att + i * 72 + j0) = o; } }
    __syncthreads();
    { const int it = wave >> 2, nt = wave & 3;
      f32x16 acc = {0.f, 0.f, 0.f, 0.f, 0.f, 0.f, 0.f, 0.f, 0.f, 0.f, 0.f, 0.f, 0.f, 0.f, 0.f, 0.f};
      mm32(acc, vT + nt * 32 * 72, 72, att + it * 32 * 72, 72, 64, lane); mm32(acc, sT + nt * 32 * 72, 72, qd + it * 32 * 72, 72, 64, lane);
#pragma unroll
      for (int g4 = 0; g4 < 4; ++g4) *(LAS f32x4*)(ob + (it * 32 + (lane & 31)) * 132 + nt * 32 + 8 * g4 + 4 * (lane >> 5)) = (f32x4){acc[g4 * 4], acc[g4 * 4 + 1], acc[g4 * 4 + 2], acc[g4 * 4 + 3]}; }
    __syncthreads();
    { const int i = tid >> 3, sub = tid & 7; const LAS float* hr = ob + i * 132 + sub * 16;
      float x[16]; float q = 0.f;
#pragma unroll
      for (int j = 0; j < 16; ++j) { x[j] = hr[j]; q += x[j] * x[j]; }
      q += __builtin_bit_cast(float, __builtin_amdgcn_ds_swizzle(__builtin_bit_cast(int, q), 0x1f | (1 << 10)));
      q += __builtin_bit_cast(float, __builtin_amdgcn_ds_swizzle(__builtin_bit_cast(int, q), 0x1f | (2 << 10)));
      q += __builtin_bit_cast(float, __builtin_amdgcn_ds_swizzle(__builtin_bit_cast(int, q), 0x1f | (4 << 10)));
      const float rstd = __builtin_amdgcn_rsqf(q * (1.f / 128.f) + nv::EPS);
      const bf16* rp = B.proj + (t0 + i) * PJ1 + 1536 + h * 128 + sub * 16; const float* nw = norm_w + h * 128 + sub * 16;
      float r0[8], r1[8]; unpack8(*(const v4u*)rp, r0); unpack8(*(const v4u*)(rp + 8), r1);
      float y0[8], y1[8];
#pragma unroll
      for (int j = 0; j < 8; ++j) { y0[j] = x[j] * rstd * nw[j] * r0[j] * sigm_f(r0[j]); y1[j] = x[8 + j] * rstd * nw[8 + j] * r1[j] * sigm_f(r1[j]); }
      bf16* dst = B.mixbf + (t0 + i) * 1024 + 512 + h * 128 + sub * 16;
      *(v4u*)dst = pack8(y0); *(v4u*)(dst + 8) = pack8(y1); }
    __syncthreads();
}
__device__ __forceinline__ void s5_params(const Mix1Bufs& B, const float* const* in, int gtid, int gsz) {

    for (int idx = gtid; idx < 2048; idx += gsz) { const int g = idx >> 6;
        const float lr = in[17][idx], li = in[18][idx], dt = expf(in[24][g]);
        const float mag = expf(lr * dt), ar = mag * cosf(li * dt), ai = mag * sinf(li * dt);
        const float den = lr * lr + li * li, nr = ar - 1.0f, cr = (nr * lr + ai * li) / den, ci = (ai * lr - nr * li) / den;
        B.s5ab[idx * 2] = ar; B.s5ab[idx * 2 + 1] = ai;
        for (int h = 0; h < 16; ++h) { const float br = in[19][idx * 16 + h], bi = in[20][idx * 16 + h]; B.s5bb[idx * 32 + h] = cr * br - ci * bi; B.s5bb[idx * 32 + 16 + h] = cr * bi + ci * br; } }
    for (int idx = gtid; idx < 32 * 128 * 16; idx += gsz) { const int h = idx & 15, j = (idx >> 4) & 127, g = idx >> 11; const int gp = g * 64 + (j & 63);
        const float lr = in[17][gp], li = in[18][gp], dt = expf(in[24][g]);
        const float mag = expf(lr * dt), ar = mag * cosf(li * dt), ai = mag * sinf(li * dt);
        const float den = lr * lr + li * li, nr = ar - 1.0f, cr = (nr * lr + ai * li) / den, ci = (ai * lr - nr * li) / den;
        const float br = in[19][gp * 16 + h], bi = in[20][gp * 16 + h];
        B.bbt[idx] = (unsigned short)f2bf(j < 64 ? cr * br - ci * bi : cr * bi + ci * br); }
    for (int idx = gtid; idx < 32 * 32 * 128; idx += gsz) { const int k = idx & 127, hh = (idx >> 7) & 31, g = idx >> 12;
        float v = 0.f; if (hh < 16) v = k < 64 ? in[21][(g * 16 + hh) * 64 + k] : -in[22][(g * 16 + hh) * 64 + k - 64];
        B.cm[idx] = (unsigned short)f2bf(v); }
}
template <bool OUT> __device__ __forceinline__ void s5_chunk_v2(const Mix1Bufs& B, const float* dskip, int item, bool valid, LAS unsigned char* wl, int lane) {
    if (!valid) item = 0;
    const int n = item % NCH, g = (item / NCH) & 31, b = item / (NCH * 32);
    const size_t t0 = (size_t)b * S_ + n * 64; const int gp = g * 64 + lane;
    LAS float* bu = (LAS float*)wl;
    lbf16* xs = (lbf16*)(wl + 8192);
    const float ar = B.s5ab[gp * 2], ai = B.s5ab[gp * 2 + 1];
    float xr = 0.f, xi = 0.f;
    if (OUT) { xr = B.xstart[((size_t)item * 64 + lane) * 2]; xi = B.xstart[((size_t)item * 64 + lane) * 2 + 1]; }
    const bf16* bbt = B.bbt + (size_t)g * 2048 + (lane & 31) * 16 + 8 * (lane >> 5);
    for (int half = 0; half < 2; ++half) {
        const s16x8 a = *(const s16x8*)(B.proj + (t0 + half * 32 + (lane & 31)) * PJ1 + g * 16 + 8 * (lane >> 5));
        f32x16 acc[4];
#pragma unroll
        for (int nt = 0; nt < 4; ++nt) { const s16x8 bf = *(const s16x8*)(bbt + nt * 512);
            const f32x16 z = {0.f, 0.f, 0.f, 0.f, 0.f, 0.f, 0.f, 0.f, 0.f, 0.f, 0.f, 0.f, 0.f, 0.f, 0.f, 0.f};
            acc[nt] = __builtin_amdgcn_mfma_f32_32x32x16_bf16(a, bf, z, 0, 0, 0); }
#pragma unroll
        for (int q = 0; q < 2; ++q) {
#pragma unroll
            for (int nt = 0; nt < 4; ++nt)
#pragma unroll
                for (int rr = 0; rr < 8; ++rr) bu[((rr & 3) + 8 * (rr >> 2) + 4 * (lane >> 5)) * 128 + nt * 32 + (lane & 31)] = acc[nt][q * 8 + rr];
            __syncthreads();
#pragma unroll 4
            for (int l = 0; l < 16; ++l) { const float sr = bu[l * 128 + lane], si = bu[l * 128 + 64 + lane];
                const float nr = ar * xr - ai * xi + sr, ni = ar * xi + ai * xr + si; xr = nr; xi = ni;
                if (OUT) { xs[(q * 16 + l) * 136 + lane] = (unsigned short)f2bf(xr); xs[(q * 16 + l) * 136 + 64 + lane] = (unsigned short)f2bf(xi); } }
            __syncthreads();
        }
        if (OUT) {
            f32x16 acc2 = {0.f, 0.f, 0.f, 0.f, 0.f, 0.f, 0.f, 0.f, 0.f, 0.f, 0.f, 0.f, 0.f, 0.f, 0.f, 0.f};
            mm32_gb(acc2, xs, 136, B.cm + (size_t)g * 32 * 128, 128, 128, lane);
            const int hh = lane & 31;
            if (hh < 16 && valid) { const float dk = dskip[g * 16 + hh];
#pragma unroll
                for (int r = 0; r < 16; ++r) { const size_t t = t0 + half * 32 + rowmap(r, lane);
                    B.s5g[t * 512 + g * 16 + hh] = (unsigned short)f2bf(gelu_f(acc2[r] + dk * bf2f(B.proj[t * PJ1 + g * 16 + hh]))); } }
            __syncthreads();
        }
    }
    if (!OUT && valid) { B.xend[((size_t)item * 64 + lane) * 2] = xr; B.xend[((size_t)item * 64 + lane) * 2 + 1] = xi; }
}
template <bool OUT> __device__ __forceinline__ void s5_phase(const Mix1Bufs& B, const float* dskip, int gw, int NGW, LAS unsigned char* wl, int lane) {
    const int wpg = NGW >> 5, g_ = gw / wpg, j0 = gw - g_ * wpg; const bool gvalid = g_ < 32; const int g = gvalid ? g_ : 0;
    const int nit = (2 * NCH + wpg - 1) / wpg;
    const float ar = B.s5ab[(g * 64 + lane) * 2], ai = B.s5ab[(g * 64 + lane) * 2 + 1];
    s16x8 bf[4]; { const bf16* bbt = B.bbt + (size_t)g * 2048 + (lane & 31) * 16 + 8 * (lane >> 5);
#pragma unroll
        for (int nt = 0; nt < 4; ++nt) bf[nt] = *(const s16x8*)(bbt + nt * 512); }
    s16x8 cf[4]; float dk[4];
    if (OUT) { const bf16* cm = B.cm + (size_t)g * 32 * 128 + (lane & 15) * 128 + 8 * (lane >> 4);
#pragma unroll
        for (int ks = 0; ks < 4; ++ks) cf[ks] = *(const s16x8*)(cm + ks * 32);
#pragma unroll
        for (int r = 0; r < 4; ++r) dk[r] = dskip[g * 16 + 4 * (lane >> 4) + r]; }
    s16x8 na[2]; v2u nu[2][2]; float nxr = 0.f, nxi = 0.f;
#define S5_LOAD(kk) do { const int _i = j0 + (kk) * wpg; const int _idx = (gvalid && _i < 2 * NCH) ? _i : 0; const int _b = _idx / NCH, _n = _idx % NCH; const size_t _t0 = (size_t)_b * S_ + _n * 64; \
        const bf16* _p = B.proj + (_t0 + (lane & 31)) * PJ1 + g * 16 + 8 * (lane >> 5); na[0] = *(const s16x8*)_p; na[1] = *(const s16x8*)(_p + (size_t)32 * PJ1); \
        if (OUT) { const size_t _it = (size_t)(_b * 32 + g) * NCH + _n; const float2 _x = *(const float2*)(B.xstart + (_it * 64 + lane) * 2); nxr = _x.x; nxi = _x.y; \
            const bf16* _q = B.proj + (_t0 + (lane & 15)) * PJ1 + g * 16 + 4 * (lane >> 4); _Pragma("unroll") for (int _h = 0; _h < 2; ++_h) _Pragma("unroll") for (int _t = 0; _t < 2; ++_t) nu[_h][_t] = *(const v2u*)(_q + (size_t)(_h * 32 + _t * 16) * PJ1); } } while (0)
    S5_LOAD(0);
    for (int k = 0; k < nit; ++k) {
        const int i_ = j0 + k * wpg; const bool valid = gvalid && i_ < 2 * NCH; const int idx = valid ? i_ : 0; const int b = idx / NCH, n = idx % NCH;
        const size_t t0 = (size_t)b * S_ + n * 64; const size_t item = (size_t)(b * 32 + g) * NCH + n;
        s16x8 a[2] = {na[0], na[1]}; v2u uu[2][2] = {{nu[0][0], nu[0][1]}, {nu[1][0], nu[1][1]}}; float xr = OUT ? nxr : 0.f, xi = OUT ? nxi : 0.f;
        if (k + 1 < nit) S5_LOAD(k + 1);
#pragma unroll
        for (int half = 0; half < 2; ++half) {
            f32x16 acc[4];
#pragma unroll
            for (int nt = 0; nt < 4; ++nt) { const f32x16 z = {0.f, 0.f, 0.f, 0.f, 0.f, 0.f, 0.f, 0.f, 0.f, 0.f, 0.f, 0.f, 0.f, 0.f, 0.f, 0.f};
                acc[nt] = __builtin_amdgcn_mfma_f32_32x32x16_bf16(a[half], bf[nt], z, 0, 0, 0); }
            float sre[2][16], sim[2][16];
#pragma unroll
            for (int r = 0; r < 16; ++r) {
                { auto w = __builtin_amdgcn_permlane32_swap(__float_as_uint(acc[0][r]), __float_as_uint(acc[1][r]), false, false); sre[0][r] = __uint_as_float(w[0]); sre[1][r] = __uint_as_float(w[1]); }
                { auto w = __builtin_amdgcn_permlane32_swap(__float_as_uint(acc[2][r]), __float_as_uint(acc[3][r]), false, false); sim[0][r] = __uint_as_float(w[0]); sim[1][r] = __uint_as_float(w[1]); } }
            lbf16* xs = (lbf16*)(wl + half * 8704);
#pragma unroll
            for (int q = 0; q < 4; ++q)
#pragma unroll
                for (int wch = 0; wch < 2; ++wch)
#pragma unroll
                    for (int i = 0; i < 4; ++i) { const int r = q * 4 + i, tok = q * 8 + wch * 4 + i;
                        const float sr = sre[wch][r], si = sim[wch][r];
                        const float nr = ar * xr - ai * xi + sr, ni = ar * xi + ai * xr + si; xr = nr; xi = ni;
                        if (OUT) { xs[tok * 136 + lane] = (unsigned short)f2bf(xr); xs[tok * 136 + 64 + lane] = (unsigned short)f2bf(xi); } }
            if (OUT) {
                __syncthreads();
#pragma unroll
                for (int tt = 0; tt < 2; ++tt) { f32x4 y = {0.f, 0.f, 0.f, 0.f};
                    const lbf16* xp = xs + (tt * 16 + (lane & 15)) * 136 + 8 * (lane >> 4);
#pragma unroll
                    for (int ks = 0; ks < 4; ++ks) y = __builtin_amdgcn_mfma_f32_16x16x32_bf16(cf[ks], *(const LAS s16x8*)(xp + ks * 32), y, 0, 0, 0);
                    const v2u u = uu[half][tt];
                    const float u0 = __builtin_bit_cast(float, u.x << 16), u1 = __builtin_bit_cast(float, u.x & 0xffff0000u), u2 = __builtin_bit_cast(float, u.y << 16), u3 = __builtin_bit_cast(float, u.y & 0xffff0000u);
                    v2u o; o.x = pk2(gelu_f(y[0] + dk[0] * u0), gelu_f(y[1] + dk[1] * u1)); o.y = pk2(gelu_f(y[2] + dk[2] * u2), gelu_f(y[3] + dk[3] * u3));
                    if (valid) *(v2u*)(B.s5g + (t0 + half * 32 + tt * 16 + (lane & 15)) * 512 + g * 16 + 4 * (lane >> 4)) = o; }
            }
        }
        if (!OUT && valid) { float2 o; o.x = xr; o.y = xi; *(float2*)(B.xend + (item * 64 + lane) * 2) = o; }
    }
#undef S5_LOAD
}
__device__ __forceinline__ void s5_b(const Mix1Bufs& B, int gtid, int gsz) {
    for (int idx = gsz - 1 - gtid; idx < 2 * 2048; idx += gsz)   { const int b = idx >> 11, gp = idx & 2047, g = gp >> 6, p = gp & 63;
        float ar = B.s5ab[gp * 2], ai = B.s5ab[gp * 2 + 1];
#pragma unroll
        for (int q = 0; q < 6; ++q) { const float r2 = ar * ar - ai * ai, i2 = 2.f * ar * ai; ar = r2; ai = i2; }
        float xr = 0.f, xi = 0.f;
        const size_t o0 = ((size_t)((b * 32 + g) * NCH) * 64 + p) * 2;
        for (int n0 = 0; n0 < NCH; n0 += SB) { float er[SB], ei[SB];
#pragma unroll
            for (int j = 0; j < SB; ++j) { const size_t o = o0 + (size_t)(n0 + j) * 128; er[j] = B.xend[o]; ei[j] = B.xend[o + 1]; }
#pragma unroll
            for (int j = 0; j < SB; ++j) { const float sr = xr, si = xi; const float nr = ar * xr - ai * xi + er[j], ni = ar * xi + ai * xr + ei[j]; xr = nr; xi = ni; er[j] = sr; ei[j] = si; }
#pragma unroll
            for (int j = 0; j < SB; ++j) { const size_t o = o0 + (size_t)(n0 + j) * 128; B.xstart[o] = er[j]; B.xstart[o + 1] = ei[j]; } } }
}
typedef float f32x4v __attribute__((ext_vector_type(4)));
struct RouterBufs { const bf16* zb; const float* hres; float* h; bf16* hbf; const float* lnw; const float* lnb; const bf16* rwh; const bf16* rwl; const float* rbias; int* ridx; float* rwt; unsigned* cnt; };
__device__ __forceinline__ void router_split_weights(const float* rw, bf16* hi, bf16* lo, int gtid, int gsz) {
    for (int i = gtid; i < 64 * 1024; i += gsz) { const int e = i >> 10, k = i & 1023; const float w = rw[k * 64 + e]; const unsigned h = f2bf(w); hi[i] = (unsigned short)h; lo[i] = (unsigned short)f2bf(w - __builtin_bit_cast(float, h << 16)); }
}
__device__ __forceinline__ void router_select(const LAS float* sc, const float* bias, int* ridx, float* rwt, LAS unsigned* hist) {
    float gs[8];
#pragma unroll
    for (int g = 0; g < 8; ++g) { float m1 = -INFINITY, m2 = -INFINITY;
#pragma unroll
        for (int j = 0; j < 8; ++j) { const float v = sc[g * 8 + j] + bias[g * 8 + j]; if (v > m1) { m2 = m1; m1 = v; } else if (v > m2) m2 = v; }
        gs[g] = m1 + m2; }
    unsigned gsel = 0;
#pragma unroll
    for (int it = 0; it < 4; ++it) { float best = -INFINITY; int bi = 0;
#pragma unroll
        for (int g = 0; g < 8; ++g) { const bool ok = !((gsel >> g) & 1u) && gs[g] > best; best = ok ? gs[g] : best; bi = ok ? g : bi; }
        gsel |= 1u << bi; }
    unsigned long long taken = 0ull; float wsum = 0.f; float wv[8]; int ev[8];
#pragma unroll
    for (int it = 0; it < 8; ++it) { float best = -INFINITY; int bi = 0;
#pragma unroll 1
        for (int e = 0; e < 64; ++e) { const bool ok = ((gsel >> (e >> 3)) & 1u) && !((taken >> e) & 1ull); const float v = sc[e] + bias[e]; if (ok && v > best) { best = v; bi = e; } }
        taken |= 1ull << bi; ev[it] = bi; wv[it] = sc[bi]; wsum += wv[it]; }
    const float inv = 2.5f / wsum;
#pragma unroll
    for (int it = 0; it < 8; ++it) { ridx[it] = ev[it]; rwt[it] = wv[it] * inv; atomicAdd((unsigned*)&hist[ev[it]], 1u); }
}
__device__ __forceinline__ float wave_max_f(float v) {
#define WM_STEP(o) v = fmaxf(v, __builtin_bit_cast(float, __builtin_amdgcn_ds_swizzle(__builtin_bit_cast(int, v), 0x1f | ((o) << 10))))
    WM_STEP(1); WM_STEP(2); WM_STEP(4); WM_STEP(8); WM_STEP(16);
#undef WM_STEP
    return fmaxf(__builtin_bit_cast(float, __builtin_amdgcn_readlane(__builtin_bit_cast(int, v), 0)), __builtin_bit_cast(float, __builtin_amdgcn_readlane(__builtin_bit_cast(int, v), 32)));
}
__device__ __forceinline__ void router_tiles(const RouterBufs& R, int tile0, int tstride, int ntiles, LAS unsigned char* lds, int tid, bool count = true) {
    const int lane = tid & 63, wave = __builtin_amdgcn_readfirstlane(tid >> 6);
    lbf16* Ahi = (lbf16*)lds; lbf16* Alo = (lbf16*)(lds + 33024); LAS float* part = (LAS float*)(lds + 66048); LAS unsigned* hist = (LAS unsigned*)(lds + 102912);
    if (tile0 >= ntiles) return;
    const int row16 = lane & 15, kq = 8 * (lane >> 4);
    s16x8 bh[4][4], bl[4][4];
#pragma unroll
    for (int ks = 0; ks < 4; ++ks)
#pragma unroll
        for (int nt = 0; nt < 4; ++nt) { const size_t o = (size_t)(nt * 16 + row16) * 1024 + wave * 128 + ks * 32 + kq; bh[ks][nt] = *(const s16x8*)(R.rwh + o); }
    const float bias = R.rbias[lane];
    f32x4 zr[2][4]; v4u zq[2][2];
#define RT_LOAD(tile) do { _Pragma("unroll") for (int q = 0; q < 2; ++q) { const size_t _ro = ((size_t)(tile) * 16 + wave * 2 + q) * 1024 + lane * 8; const float* zp = R.hres + _ro; \
        zr[q][0] = *(const f32x4*)zp; zr[q][1] = *(const f32x4*)(zp + 4); zr[q][2] = *(const f32x4*)(zp + 512); zr[q][3] = *(const f32x4*)(zp + 516); \
        zq[q][0] = *(const v4u*)(R.zb + _ro); zq[q][1] = *(const v4u*)(R.zb + _ro + 512); } } while (0)
    RT_LOAD(tile0);
    if (tid < 64) hist[tid] = 0u;
    LAS float* lnl = (LAS float*)(lds + 103424);
    if (tid < 256) *(LAS f32x4*)(lnl + tid * 4) = *(const f32x4*)(R.lnw + tid * 4); else *(LAS f32x4*)(lnl + 1024 + (tid - 256) * 4) = *(const f32x4*)(R.lnb + (tid - 256) * 4);
    __syncthreads();
    for (int tile = tile0; tile < ntiles; tile += tstride) {
#pragma unroll
        for (int q = 0; q < 2; ++q) { const int row = wave * 2 + q; const size_t t = (size_t)tile * 16 + row;
            float v[16] = {zr[q][0].x, zr[q][0].y, zr[q][0].z, zr[q][0].w, zr[q][1].x, zr[q][1].y, zr[q][1].z, zr[q][1].w, zr[q][2].x, zr[q][2].y, zr[q][2].z, zr[q][2].w, zr[q][3].x, zr[q][3].y, zr[q][3].z, zr[q][3].w};
            { float zf[8]; unpack8(zq[q][0], zf);
#pragma unroll
              for (int j = 0; j < 8; ++j) v[j] = nv::ALPHA * v[j] + zf[j];
              unpack8(zq[q][1], zf);
#pragma unroll
              for (int j = 0; j < 8; ++j) v[8 + j] = nv::ALPHA * v[8 + j] + zf[j]; }
            float sum = 0.f;
#pragma unroll
            for (int j = 0; j < 16; ++j) sum += v[j];
            sum = wave_sum(sum); const float mean = sum * (1.f / 1024.f); float sq = 0.f;
#pragma unroll
            for (int j = 0; j < 16; ++j) { v[j] -= mean; sq += v[j] * v[j]; }
            sq = wave_sum(sq); const float rstd = 1.0f / sqrtf(sq * (1.f / 1024.f) + nv::EPS);
#pragma unroll
            for (int half = 0; half < 2; ++half) { const int c0 = half * 512 + lane * 8;
                const f32x4 w0 = *(const LAS f32x4*)(lnl + c0), w1 = *(const LAS f32x4*)(lnl + c0 + 4), b0 = *(const LAS f32x4*)(lnl + 1024 + c0), b1 = *(const LAS f32x4*)(lnl + 1024 + c0 + 4);
                float o[8] = {v[half * 8 + 0] * rstd * w0.x + b0.x, v[half * 8 + 1] * rstd * w0.y + b0.y, v[half * 8 + 2] * rstd * w0.z + b0.z, v[half * 8 + 3] * rstd * w0.w + b0.w,
                              v[half * 8 + 4] * rstd * w1.x + b1.x, v[half * 8 + 5] * rstd * w1.y + b1.y, v[half * 8 + 6] * rstd * w1.z + b1.z, v[half * 8 + 7] * rstd * w1.w + b1.w};
                *(f32x4*)(R.h + t * 1024 + c0) = (f32x4){o[0], o[1], o[2], o[3]}; *(f32x4*)(R.h + t * 1024 + c0 + 4) = (f32x4){o[4], o[5], o[6], o[7]};
                const v4u hi = pack8(o); float hf[8], lo[8]; unpack8(hi, hf);
#pragma unroll
                for (int j = 0; j < 8; ++j) lo[j] = o[j] - hf[j];
                *(v4u*)(R.hbf + t * 1024 + c0) = hi; *(LAS v4u*)(Ahi + row * 1032 + c0) = hi; *(LAS v4u*)(Alo + row * 1032 + c0) = pack8(lo); } }
        if (tile + tstride < ntiles) RT_LOAD(tile + tstride);
        { int zo = 0; asm volatile("" : "+v"(zo));
#pragma unroll
          for (int ks = 0; ks < 4; ++ks)
#pragma unroll
              for (int nt = 0; nt < 4; ++nt) bl[ks][nt] = *(const s16x8*)(R.rwl + (size_t)(nt * 16 + row16) * 1024 + wave * 128 + ks * 32 + kq + zo); }
        __syncthreads();
        { f32x4v acc[4] = {{0.f, 0.f, 0.f, 0.f}, {0.f, 0.f, 0.f, 0.f}, {0.f, 0.f, 0.f, 0.f}, {0.f, 0.f, 0.f, 0.f}};
#pragma unroll
          for (int ks = 0; ks < 4; ++ks) { const int k0 = wave * 128 + ks * 32 + kq;
              const s16x8 ah = *(const LAS s16x8*)(Ahi + row16 * 1032 + k0), al = *(const LAS s16x8*)(Alo + row16 * 1032 + k0);
#pragma unroll
              for (int nt = 0; nt < 4; ++nt) {
                  acc[nt] = __builtin_amdgcn_mfma_f32_16x16x32_bf16(ah, bh[ks][nt], acc[nt], 0, 0, 0);
                  acc[nt] = __builtin_amdgcn_mfma_f32_16x16x32_bf16(al, bh[ks][nt], acc[nt], 0, 0, 0);
                  acc[nt] = __builtin_amdgcn_mfma_f32_16x16x32_bf16(ah, bl[ks][nt], acc[nt], 0, 0, 0); } }
#pragma unroll
          for (int nt = 0; nt < 4; ++nt)
#pragma unroll
              for (int r = 0; r < 4; ++r) part[(wave * 16 + (lane >> 4) * 4 + r) * 64 + nt * 16 + (lane & 15)] = acc[nt][r]; }
        __syncthreads();
#define SWZ_MAX(x, o) fmaxf(x, __builtin_bit_cast(float, __builtin_amdgcn_ds_swizzle(__builtin_bit_cast(int, x), 0x1f | ((o) << 10))))
#define SWZ_ADD(x, o) ((x) + __builtin_bit_cast(float, __builtin_amdgcn_ds_swizzle(__builtin_bit_cast(int, x), 0x1f | ((o) << 10))))
#pragma unroll
        for (int q = 0; q < 2; ++q) { const int tk = wave * 2 + q; const size_t t = (size_t)tile * 16 + tk;
            float lg = 0.f;
#pragma unroll
            for (int w = 0; w < 8; ++w) lg += part[(w * 16 + tk) * 64 + lane];
            const float s = 1.0f / (1.0f + expf(-lg)), v = s + bias;
            float m1 = v; m1 = SWZ_MAX(m1, 1); m1 = SWZ_MAX(m1, 2); m1 = SWZ_MAX(m1, 4);
            float c1 = (v == m1) ? 1.f : 0.f; c1 = SWZ_ADD(c1, 1); c1 = SWZ_ADD(c1, 2); c1 = SWZ_ADD(c1, 4);
            float m2 = (v == m1) ? -INFINITY : v; m2 = SWZ_MAX(m2, 1); m2 = SWZ_MAX(m2, 2); m2 = SWZ_MAX(m2, 4);
            const float gs = m1 + (c1 >= 2.f ? m1 : m2);
            int grank = 0; const int g = lane >> 3;
#pragma unroll
            for (int j = 0; j < 8; ++j) { const float x = __builtin_bit_cast(float, __builtin_amdgcn_readlane(__builtin_bit_cast(int, gs), j * 8)); grank += (x > gs || (x == gs && j < g)) ? 1 : 0; }
            const bool gsel = grank < 4; float cv = gsel ? v : -INFINITY; int rank = 8;
#pragma unroll
            for (int it = 0; it < 8; ++it) { const float m = wave_max_f(cv); const unsigned long long bal = __builtin_amdgcn_ballot_w64(cv == m); const int wl = __builtin_ctzll(bal);
                if (lane == wl) { rank = it; cv = -INFINITY; } }
            const bool sel = rank < 8;
            const float wsum = wave_sum(sel ? s : 0.f);
            if (sel) { R.ridx[t * 8 + rank] = lane; R.rwt[t * 8 + rank] = s * (2.5f / wsum); atomicAdd((unsigned*)&hist[lane], 1u); } }
#undef SWZ_MAX
#undef SWZ_ADD
    }
#undef RT_LOAD
    __syncthreads();
    if (count && tid < 64 && hist[tid]) atomicAdd(&R.cnt[tid], hist[tid]);
    __syncthreads();
}
#ifndef DUP_PHASE
#define DUP_PHASE -1
#endif
constexpr int CTX_OFF = LDS_CTL + 1024, TAB_OFF = LDS_CTL + 7168;
constexpr size_t WS_WINE = 1 * MiB, WS_WINO = WS_WINE + (size_t)EINP * 1024 * 2, WS_WOUT = WS_WINO + (size_t)OINP * 1024 * 2, WS_XBF = 16 * MiB, WS_NAIVE = 80 * MiB;
#if defined(WITH_NAIVE)
constexpr size_t WS_MIXBF = 48 * MiB;
#else
constexpr size_t WS_MIXBF = 453 * MiB;
#endif
__device__ __forceinline__ int conv_split(int nwg, int G) {
#if defined(WITH_NAIVE)
    return 0;
#else
    const int rem = nwg % G; return rem == 0 ? 0 : (G - rem) * NWAVES * 4;
#endif
}
static_assert(WS_WOUT + 2 * 1024 * 1024 * 2 <= WS_XBF, "ws map");
constexpr size_t WS_WD = 48 * MiB, WS_WGU = WS_WD + 65 * 512 * 1024, WS_LISTS = 146 * MiB, WS_RIDX = 148 * MiB, WS_H = 149 * MiB, WS_ROWS8 = 229 * MiB;
static_assert(WS_WGU + (size_t)65 * 1024 * 1024 <= WS_LISTS && WS_H + (size_t)MOE_MAXBLK * 256 * 512 <= WS_ROWS8 && WS_ROWS8 + (size_t)nv::T_ * 8 * 2048 <= 512 * MiB, "moe ws map");
constexpr size_t WS_PROJB = 149 * MiB, WS_CT = 253 * MiB, WS_HLOC = 317 * MiB, WS_PC = 349 * MiB, WS_M0SMALL = 381 * MiB, WS_LRUW = 486 * MiB;
constexpr size_t WS_UT = 221 * MiB, WS_S5G = 253 * MiB, WS_M1SMALL = 269 * MiB, WS_GLUW = 486 * MiB + 256 * 1024;
constexpr size_t WS_RW = 487 * MiB;
constexpr int CW_PROBE = 9000;
struct Tab { const float* in[38]; float* out; unsigned char* ws; };
struct Env { const Tab* tab; unsigned char* ws; float* out; LAS unsigned char* lds; int tid, lane, wave, bid, G, gw, NGW, gtid, gsz, vcu; };
__device__ __forceinline__ Env penv(unsigned char* lds_raw) {
    Env e; e.tab = (const Tab*)(lds_raw + TAB_OFF); e.ws = e.tab->ws; e.out = e.tab->out; e.lds = (LAS unsigned char*)lds_raw;
    int t = threadIdx.x; asm volatile("" : "+v"(t)); e.tid = t; e.lane = t & 63; e.wave = __builtin_amdgcn_readfirstlane(t >> 6);
    int b = blockIdx.x; asm volatile("" : "+s"(b)); e.bid = b; int g = gridDim.x; asm volatile("" : "+s"(g)); e.G = g;
    e.vcu = (g % 8 == 0) ? (b % 8) * (g / 8) + b / 8 : b;
    e.gw = b * NWAVES + e.wave; e.NGW = g * NWAVES; e.gtid = b * NTHREADS + t; e.gsz = g * NTHREADS;
    return e;
}
__device__ __forceinline__ void grid_bar(const Env& e) {
    XcdBarrier b; b.bar = (unsigned*)e.ws + 4096; b.x = xb_xcc_id(); b.st = (volatile LAS unsigned*)(e.lds + MISC_OFF) + 8;
    xcd_barrier(b);
}
#if defined(WITH_NAIVE)
template <int ST> __device__ __forceinline__ void run_naive(unsigned char* lds_raw, int ci, long n) {
    const Env e = penv(lds_raw);
    const nv::Ctx& c = ((const nv::Ctx*)(lds_raw + CTX_OFF))[ci];
    for (long i = e.gtid; i < n; i += e.gsz) nv::item<ST>(c, i);
    grid_bar(e);
}
#endif
__device__ __forceinline__ void phase_p0(unsigned char* lds_raw) {
    const Env e = penv(lds_raw);
    LAS float* scr = (LAS float*)(e.lds + e.wave * 16640);
    constexpr int I0 = 16 * (EINP / 64), I1 = I0 + 16 * (OINP / 64), I2 = I1 + 256, I3 = I2 + 256, I4 = I3 + 32, I5 = I4 + 64;
    for (int it = e.gw; it < I5; it += e.NGW) {
        if (it < I0) tr_matrix_item(e.tab->in[6], 1024, nv::EIN, EINP, (bf16*)(e.ws + WS_WINE), scr, it, e.lane);
        else if (it < I1) tr_matrix_item(e.tab->in[16], 1024, nv::OIN, OINP, (bf16*)(e.ws + WS_WINO), scr, it - I0, e.lane);
        else if (it < I2) tr_matrix_item(e.tab->in[5], 1024, 1024, 1024, (bf16*)(e.ws + WS_WOUT), scr, it - I1, e.lane);
        else if (it < I3) tr_matrix_item(e.tab->in[5] + 1024 * 1024, 1024, 1024, 1024, (bf16*)(e.ws + WS_WOUT) + 1024 * 1024, scr, it - I2, e.lane);
        else if (it < I4) { const int r = it - I3, mtx = r >> 2, h = mtx & 3, which = mtx >> 2;
            tr_matrix_item(e.tab->in[which ? 13 : 11] + h * 16384, 128, 128, 128, (bf16*)(e.ws + WS_LRUW) + which * 65536 + h * 16384, scr, r & 3, e.lane); }
        else tr_matrix_item(e.tab->in[25], 512, 512, 512, (bf16*)(e.ws + WS_GLUW), scr, it - I4, e.lane);
    }
    for (int l = 0; l < 2; ++l) router_split_weights(e.tab->in[30] + (size_t)l * 65536, (bf16*)(e.ws + WS_RW) + (size_t)l * 131072, (bf16*)(e.ws + WS_RW) + (size_t)l * 131072 + 65536, e.gtid, e.gsz);
    cvt_rows(e.tab->in[0], (bf16*)(e.ws + WS_XBF), (long)T_ * 1024, e.gtid, e.gsz);
    grid_bar(e);
}
__device__ __forceinline__ void phase_inproj(unsigned char* lds_raw, int layer) {
    const Env e = penv(lds_raw);
    float* proj = (float*)(e.ws + WS_NAIVE) + ((size_t)T_ * 1024 + (size_t)T_ * 64 + (size_t)T_ * 8 * 2);
    const int NP = layer == 0 ? EINP : OINP;
    pg8::Gemm g{(const bf16*)(e.ws + WS_XBF), (const bf16*)(e.ws + (layer == 0 ? WS_WINE : WS_WINO)), 1024, 0, 0, nullptr};
    pg8::StaticOrder S; S.init(T_, NP, e.G, e.bid);
    pg8::EpiF32R E{proj, NP, nullptr, 0.f};
    pg8::gemm_phase<pg8::EpiF32R, pg8::StaticOrder, true, false>(e.lds, g, S, E);
    grid_bar(e);
}
__device__ __forceinline__ void phase_cvt_mixed(unsigned char* lds_raw) {
    const Env e = penv(lds_raw);
    cvt_rows((const float*)(e.ws + WS_NAIVE), (bf16*)(e.ws + WS_MIXBF), (long)T_ * 1024, e.gtid, e.gsz);
    grid_bar(e);
}
__device__ __forceinline__ void phase_outproj(unsigned char* lds_raw, int layer) {
    const Env e = penv(lds_raw);
    bf16* zb = (bf16*)((float*)(e.ws + WS_NAIVE) + ((size_t)T_ * 1024 + (size_t)T_ * 64 + (size_t)T_ * 8 * 2));
    pg8::Gemm g{(const bf16*)(e.ws + WS_MIXBF), (const bf16*)(e.ws + WS_WOUT) + (size_t)layer * 1024 * 1024, 1024, 0, 0, nullptr};
    pg8::StaticOrder S; S.init(T_, 1024, e.G, e.bid);
    pg8::EpiBf16P E{zb, 1024};
    pg8::gemm_phase<pg8::EpiBf16P, pg8::StaticOrder, true, false>(e.lds, g, S, E);
    grid_bar(e);
}
__device__ __forceinline__ Mix0Bufs mix0_bufs(unsigned char* ws) {
    Mix0Bufs B; B.proj = (const bf16*)(ws + WS_PROJB); B.ct = (bf16*)(ws + WS_CT); B.hloc = (bf16*)(ws + WS_HLOC); B.pc = (bf16*)(ws + WS_PC);
    float* sm = (float*)(ws + WS_M0SMALL); B.nloc = sm; sm += 8 * NCH * 128; B.blast = sm; sm += 8 * NCH; B.mloc = sm; sm += 8 * NCH; B.mprev = sm; sm += 8 * NCH;
    B.carA = sm; sm += 2 * NCH * 512; B.carU = sm; sm += 2 * NCH * 512; B.carI = sm; sm += 2 * NCH * 512; B.gst = sm;
    B.mixbf = (bf16*)(ws + WS_MIXBF); B.lruw = (const bf16*)(ws + WS_LRUW); return B;
}
__device__ __forceinline__ Mix1Bufs mix1_bufs(unsigned char* ws) {
    Mix1Bufs B; B.proj = (const bf16*)(ws + WS_PROJB); B.ut = (bf16*)(ws + WS_UT); B.s5g = (bf16*)(ws + WS_S5G);
    float* sm = (float*)(ws + WS_M1SMALL); B.gbl = sm; sm += 8 * NCH * 64; B.xend = sm; sm += 8192 * 128; B.xstart = sm; sm += 8192 * 128; B.s5ab = sm; sm += 4096; B.s5bb = sm; sm += 2048 * 32;
    B.cm = (bf16*)sm; B.bbt = B.cm + 32 * 32 * 128; B.mixbf = (bf16*)(ws + WS_MIXBF); return B;
}
__device__ __forceinline__ void phase_inproj_bf16(unsigned char* lds_raw, int layer) {
    const Env e = penv(lds_raw);
    const int NP = layer == 0 ? EINP : OINP;
    if (layer == 1) { const Mix1Bufs B = mix1_bufs(e.ws); s5_params(B, e.tab->in, e.gtid, e.gsz); }
    pg8::Gemm g{(const bf16*)(e.ws + WS_XBF), (const bf16*)(e.ws + (layer == 0 ? WS_WINE : WS_WINO)), 1024, 0, 0, nullptr};
    pg8::StaticOrder S; S.init(T_, NP, e.G, e.bid);
    pg8::EpiBf16P E{(bf16*)(e.ws + WS_PROJB), NP};
    pg8::gemm_phase<pg8::EpiBf16P, pg8::StaticOrder, true, false>(e.lds, g, S, E);
    { const int nwg = (T_ / 256) * (NP / 256), rem = nwg % e.G, na = conv_split(nwg, e.G);
      if (na > 0 && e.bid >= rem) { const int nlight = e.G - rem; LAS float* scr = (LAS float*)(e.lds + e.wave * 16640);
          moe_convert_weights(e.tab->in[32] + (size_t)layer * 64 * 262144, e.tab->in[33] + (size_t)layer * 64 * 262144, e.tab->in[34] + (size_t)layer * 64 * 262144,
                              e.tab->in[35] + (size_t)layer * 262144, e.tab->in[36] + (size_t)layer * 262144, e.tab->in[37] + (size_t)layer * 262144,
                              (bf16*)(e.ws + WS_WGU), (bf16*)(e.ws + WS_WD), scr, (e.bid - rem) * NWAVES + e.wave, na, nlight * NWAVES, e.lane); } }
    grid_bar(e);
}
__device__ __forceinline__ void phase_mix0_a(unsigned char* lds_raw) {
    const Env e = penv(lds_raw); const Mix0Bufs B = mix0_bufs(e.ws);
    for (int it = e.bid; it < 256 + 8 * NCH; it += e.G) {
        if (it < 256) { lru_a_item(B, e.tab->in, it, e.lds, e.tid); if (DUP_PHASE == 31) lru_a_item(B, e.tab->in, it, e.lds, e.tid); }
        else { mlstm_a_item(B, e.tab->in[7], it - 256, e.lds, e.tid); if (DUP_PHASE == 30) mlstm_a_item(B, e.tab->in[7], it - 256, e.lds, e.tid); } }
    grid_bar(e);
}
__device__ __forceinline__ int conv_rest(int nwg, int G, int NGW) {
#if defined(WITH_NAIVE)
    return 0;
#else
    const int nb = conv_split(nwg, G) + NGW * 3; return nb > 65 * 192 ? 65 * 192 : nb;
#endif
}
__device__ __forceinline__ void conv_in_scan_phase(const Env& e, int layer) {
#if !defined(WITH_NAIVE)
    const int na = conv_split((T_ / 256) * ((layer == 0 ? EINP : OINP) / 256), e.G); int nb = na + e.NGW * 3; if (nb > 65 * 192) nb = 65 * 192;
    LAS float* scr = (LAS float*)(e.lds + e.wave * 16640);
    moe_convert_weights(e.tab->in[32] + (size_t)layer * 64 * 262144, e.tab->in[33] + (size_t)layer * 64 * 262144, e.tab->in[34] + (size_t)layer * 64 * 262144,
                        e.tab->in[35] + (size_t)layer * 262144, e.tab->in[36] + (size_t)layer * 262144, e.tab->in[37] + (size_t)layer * 262144,
                        (bf16*)(e.ws + WS_WGU), (bf16*)(e.ws + WS_WD), scr, na + e.gw, nb, e.NGW, e.lane);
#endif
}
__device__ __forceinline__ void phase_mix0_b(unsigned char* lds_raw) {
    const Env e = penv(lds_raw); const Mix0Bufs B = mix0_bufs(e.ws);
    lru_b(B, e.gtid, e.gsz); mlstm_b(B, e.gtid, e.gsz);
    grid_bar(e);
}
__device__ __forceinline__ void phase_mix0_c(unsigned char* lds_raw) {
    const Env e = penv(lds_raw); const Mix0Bufs B = mix0_bufs(e.ws);
    for (int it = e.bid; it < 8 * NCH; it += e.G) { mlstm_c_item(B, e.tab->in[7], e.tab->in[8], it, e.lds, e.tid); if (DUP_PHASE == 32) mlstm_c_item(B, e.tab->in[7], e.tab->in[8], it, e.lds, e.tid); }
    lru_c(B, e.gtid, e.gsz); if (DUP_PHASE == 33) lru_c(B, e.gtid, e.gsz);
    grid_bar(e);
}
__device__ __forceinline__ void phase_mix1_a(unsigned char* lds_raw) {
    const Env e = penv(lds_raw); const Mix1Bufs B = mix1_bufs(e.ws);
    for (int it = e.bid; it < 8 * NCH; it += e.G) { gla_a_item(B, e.tab->in[27], e.tab->in[28], it, e.lds, e.tid); if (DUP_PHASE == 34) gla_a_item(B, e.tab->in[27], e.tab->in[28], it, e.lds, e.tid); }
    s5_phase<false>(B, e.tab->in[23], e.gw, e.NGW, e.lds + e.wave * 17408, e.lane); if (DUP_PHASE == 35) s5_phase<false>(B, e.tab->in[23], e.gw, e.NGW, e.lds + e.wave * 17408, e.lane);
    grid_bar(e);
}
__device__ __forceinline__ void phase_mix1_b(unsigned char* lds_raw) {
    const Env e = penv(lds_raw); const Mix1Bufs B = mix1_bufs(e.ws);
    s5_b(B, e.gtid, e.gsz); gla_b(B, e.gtid, e.gsz);
    grid_bar(e);
}
__device__ __forceinline__ void phase_mix1_c(unsigned char* lds_raw) {
    const Env e = penv(lds_raw); const Mix1Bufs B = mix1_bufs(e.ws);
    for (int it = e.bid; it < 8 * NCH; it += e.G) { gla_c_item(B, e.tab->in[27], e.tab->in[28], e.tab->in[29], it, e.lds, e.tid); if (DUP_PHASE == 36) gla_c_item(B, e.tab->in[27], e.tab->in[28], e.tab->in[29], it, e.lds, e.tid); }
#if defined(S5_OLD_C)
    for (int it = e.gw, k = 0; k < (2 * 32 * NCH + e.NGW - 1) / e.NGW; ++k, it += e.NGW) s5_chunk_v2<true>(B, e.tab->in[23], it, it < 2 * 32 * NCH, e.lds + e.wave * 16896, e.lane);
#else
    s5_phase<true>(B, e.tab->in[23], e.gw, e.NGW, e.lds + e.wave * 17408, e.lane); if (DUP_PHASE == 37) s5_phase<true>(B, e.tab->in[23], e.gw, e.NGW, e.lds + e.wave * 17408, e.lane);
#endif
    grid_bar(e);
}
__device__ __forceinline__ void phase_glu(unsigned char* lds_raw) {
    const Env e = penv(lds_raw);
    pg8::Gemm g{(const bf16*)(e.ws + WS_S5G), (const bf16*)(e.ws + WS_GLUW), 512, 0, 0, nullptr};
    pg8::StaticOrder S; S.init(T_, 512, e.G, e.bid);
    pg8::EpiGlu E{(bf16*)(e.ws + WS_MIXBF), 1024, (const bf16*)(e.ws + WS_S5G), 512, e.tab->in[26]};
    pg8::gemm_phase<pg8::EpiGlu, pg8::StaticOrder, true, false>(e.lds, g, S, E);
    grid_bar(e);
}
__device__ __forceinline__ void phase_probe(unsigned char* lds_raw, int c0, int c1) {
    const Env e = penv(lds_raw);
    const bf16* a = (const bf16*)(e.ws + WS_MIXBF); const float* b = (const float*)(e.ws + WS_NAIVE);
    float sd = 0.f, sr = 0.f; const int w = c1 - c0;
    for (long i = e.gtid; i < (long)T_ * w; i += e.gsz) { const long t = i / w; const int c = c0 + (int)(i % w); const float x = bf2f(a[t * 1024 + c]), y = b[t * 1024 + c]; sd += (x - y) * (x - y); sr += y * y; }
    sd = wave_sum(sd); sr = wave_sum(sr);
    if (e.lane == 0) { atomicAdd((float*)e.ws + CW_PROBE, sd); atomicAdd((float*)e.ws + CW_PROBE + 1, sr); }
    grid_bar(e);
}
__device__ __forceinline__ void phase_probe_apply(unsigned char* lds_raw) {
    const Env e = penv(lds_raw);
    const float sd = __hip_atomic_load((float*)e.ws + CW_PROBE, __ATOMIC_RELAXED, __HIP_MEMORY_SCOPE_AGENT), sr = __hip_atomic_load((float*)e.ws + CW_PROBE + 1, __ATOMIC_RELAXED, __HIP_MEMORY_SCOPE_AGENT);
    const float f = 1.0f + 10.0f * sqrtf(sd / fmaxf(sr, 1e-30f));
    for (long i = e.gtid; i < (long)T_ * 1024; i += e.gsz) e.out[i] *= f;
}
__device__ __forceinline__ void phase_ln_router(unsigned char* lds_raw, int layer, bool count = true) {
    const Env e = penv(lds_raw);
    RouterBufs R; R.zb = (const bf16*)((const float*)(e.ws + WS_NAIVE) + ((size_t)T_ * 1024 + (size_t)T_ * 64 + (size_t)T_ * 8 * 2)); R.hres = layer == 0 ? e.tab->in[0] : e.out; R.h = e.out; R.hbf = (bf16*)(e.ws + WS_XBF);
    R.lnw = e.tab->in[1] + layer * 1024; R.lnb = e.tab->in[2] + layer * 1024; R.rwh = (const bf16*)(e.ws + WS_RW) + (size_t)layer * 131072; R.rwl = R.rwh + 65536;
    R.rbias = e.tab->in[31] + layer * 64; R.ridx = (int*)(e.ws + WS_RIDX); R.rwt = (float*)(e.ws + WS_RIDX) + (size_t)T_ * 8; R.cnt = (unsigned*)e.ws + CW_CNT + layer * 256;
    router_tiles(R, e.bid, e.G, T_ / 16, e.lds, e.tid, count);
    grid_bar(e);
}
__device__ __forceinline__ MoeLists moe_lists(unsigned char* ws) {
    MoeLists L; L.tok = (int*)(ws + WS_LISTS); L.dest = L.tok + MOE_MAXBLK * 256; L.w = (float*)(L.dest + MOE_MAXBLK * 256); L.blk_e = (int*)(L.w + MOE_MAXBLK * 256); return L;
}
__device__ __forceinline__ void phase_moe_x1(unsigned char* lds_raw, int layer, int curoff = 0) {
    const Env e = penv(lds_raw);
    moe_build_lists((const int*)(e.ws + WS_RIDX), (const float*)(e.ws + WS_RIDX) + (size_t)T_ * 8, (unsigned*)e.ws + CW_CNT + layer * 256, (unsigned*)e.ws + CW_CUR + layer * 256 + curoff,
                    moe_lists(e.ws), (LAS int*)e.lds, e.tid, e.bid, e.G);
    LAS float* scr = (LAS float*)(e.lds + e.wave * 16640);
    moe_convert_weights(e.tab->in[32] + (size_t)layer * 64 * 262144, e.tab->in[33] + (size_t)layer * 64 * 262144, e.tab->in[34] + (size_t)layer * 64 * 262144,
                        e.tab->in[35] + (size_t)layer * 262144, e.tab->in[36] + (size_t)layer * 262144, e.tab->in[37] + (size_t)layer * 262144,
                        (bf16*)(e.ws + WS_WGU), (bf16*)(e.ws + WS_WD), scr, conv_split((T_ / 256) * ((layer == 0 ? EINP : OINP) / 256), e.G) + e.gw, 65 * 192, e.NGW, e.lane);
    grid_bar(e);
}
__device__ __forceinline__ void phase_moe_g1(unsigned char* lds_raw) {
    const Env e = penv(lds_raw);
    const MoeLists L = moe_lists(e.ws);
    const int nblk = __builtin_amdgcn_readfirstlane(L.blk_e[MOE_MAXBLK]);
    pg8::Gemm g{(const bf16*)(e.ws + WS_XBF), (const bf16*)(e.ws + WS_WGU), 1024, 0, (size_t)512 * 1024, L.tok};
    pg8::MoeOrder S{L.blk_e, nblk, 2, e.G, e.vcu};
    pg8::EpiSwiGLU E{(bf16*)(e.ws + WS_H)};
    pg8::gemm_phase<pg8::EpiSwiGLU, pg8::MoeOrder, true, true>(e.lds, g, S, E);
    grid_bar(e);
}
__device__ __forceinline__ void phase_moe_g2(unsigned char* lds_raw) {
    const Env e = penv(lds_raw);
    const MoeLists L = moe_lists(e.ws);
    const int nblk = __builtin_amdgcn_readfirstlane(L.blk_e[MOE_MAXBLK]);
    pg8::Gemm g{(const bf16*)(e.ws + WS_H), (const bf16*)(e.ws + WS_WD), 256, 0, (size_t)1024 * 256, nullptr};
    pg8::MoeOrder S{L.blk_e, nblk, 4, e.G, e.vcu};
    pg8::EpiDown E{(bf16*)(e.ws + WS_ROWS8), (bf16*)(e.ws + WS_XBF), L.dest, T_ * 8};
#if defined(G2_STAGGER)
    if ((nblk * 4) % e.G != 0 && e.vcu >= (nblk * 4) % e.G) { const unsigned long long t0 = __builtin_amdgcn_s_memrealtime(); while (__builtin_amdgcn_s_memrealtime() - t0 < (unsigned long long)G2_STAGGER) __builtin_amdgcn_s_sleep(16); }
#endif
    pg8::gemm_phase<pg8::EpiDown, pg8::MoeOrder, true, false>(e.lds, g, S, E);
    grid_bar(e);
}
__device__ __forceinline__ void phase_moe_combine(unsigned char* lds_raw, int layer) {
    const Env e = penv(lds_raw);
    moe_combine_ln(e.out, (const bf16*)(e.ws + WS_ROWS8), (const bf16*)(e.ws + WS_XBF), (const float*)(e.ws + WS_RIDX) + (size_t)T_ * 8, e.tab->in[3] + layer * 1024, e.tab->in[4] + layer * 1024,
                   layer == 0 ? (bf16*)(e.ws + WS_XBF) : nullptr, e.gw, e.NGW, e.lane);
    grid_bar(e);
}

#define RUN(k, call) do { call; if (DUP_PHASE == (k)) { call; } } while (0)
#ifndef TIME_PHASE
#define TIME_PHASE -1
#endif
#define TIMED(k, call) do { unsigned long long _t0 = 0; if (TIME_PHASE == (k)) _t0 = __builtin_amdgcn_s_memrealtime(); call; \
    if (TIME_PHASE == (k) && blockIdx.x == 0 && threadIdx.x == 0) { const unsigned long long _t1 = __builtin_amdgcn_s_memrealtime(); unsigned* w_ = (unsigned*)((Tab*)(lds_raw + TAB_OFF))->ws + CW_PROBE + 8; *w_ = *w_ + (unsigned)(_t1 - _t0); } } while (0)
template <int layer> __device__ __forceinline__ void layer_body(unsigned char* lds_raw) {
#if defined(WITH_NAIVE)
    constexpr int ci = layer * 2;
#if defined(DBG_MIX0)
    constexpr bool naive_too = (layer == DBG_MIX0 - 1);
#else
    constexpr bool naive_too = false;
#endif
#endif
    RUN(1, phase_inproj_bf16(lds_raw, layer));
    if (layer == 0) { RUN(2, phase_mix0_a(lds_raw)); TIMED(20, phase_mix0_b(lds_raw)); RUN(3, phase_mix0_c(lds_raw)); }
    if (layer == 1) { RUN(4, phase_mix1_a(lds_raw)); TIMED(21, phase_mix1_b(lds_raw)); RUN(5, phase_mix1_c(lds_raw)); RUN(6, phase_glu(lds_raw)); }
#if defined(WITH_NAIVE)
    if (naive_too) {
        phase_inproj(lds_raw, layer);
        if (layer == 0) {
            run_naive<nv::ST_ML_GATES>(lds_raw, ci, 8L * NCH);
            run_naive<nv::ST_ML_CLOC>(lds_raw, ci, 8L * NCH * 16384);
            run_naive<nv::ST_ML_SCAN>(lds_raw, ci, 8L * 16384 + 8 * 128);
            run_naive<nv::ST_ML_MI>(lds_raw, ci, 8L * S_);
            run_naive<nv::ST_ML_SMAT>(lds_raw, ci, 8L * NCH * 4096);
            run_naive<nv::ST_ML_DEN>(lds_raw, ci, 8L * S_);
            run_naive<nv::ST_ML_H>(lds_raw, ci, 8L * S_ * 128);
            run_naive<nv::ST_ML_NORM>(lds_raw, ci, 8L * S_);
            run_naive<nv::ST_LRU_CONV>(lds_raw, ci, (long)T_ * 512);
            run_naive<nv::ST_LRU_GATE>(lds_raw, ci, (long)T_ * 512);
            run_naive<nv::ST_LRU_SCAN>(lds_raw, ci, 2L * 512);
        } else {
            run_naive<nv::ST_S5_PAR>(lds_raw, ci, 2048);
            for (int sl = 0; sl < S_ / nv::SLAB; ++sl) {
                if (threadIdx.x == 0) ((nv::Ctx*)(lds_raw + CTX_OFF))[ci].slab = sl;
                __syncthreads();
                run_naive<nv::ST_S5_SCAN>(lds_raw, ci, 2L * 2048); run_naive<nv::ST_S5_OUT>(lds_raw, ci, (long)nv::B_ * nv::SLAB * 512); }
            run_naive<nv::ST_S5_GLU>(lds_raw, ci, (long)T_ * 512);
            run_naive<nv::ST_GLA_GATE>(lds_raw, ci, (long)T_ * 256);
            run_naive<nv::ST_GLA_CUM>(lds_raw, ci, (long)nv::B_ * NCH * 256);
            run_naive<nv::ST_GLA_U>(lds_raw, ci, 8L * NCH * 8192);
            run_naive<nv::ST_GLA_SCAN>(lds_raw, ci, 8L * 8192);
            run_naive<nv::ST_GLA_ATT>(lds_raw, ci, 8L * NCH * 4096);
            run_naive<nv::ST_GLA_O>(lds_raw, ci, 8L * S_ * 128);
            run_naive<nv::ST_GLA_NORM>(lds_raw, ci, 8L * S_);
        }
        phase_probe(lds_raw, DBG_C0, DBG_C1);
        phase_cvt_mixed(lds_raw);
    }
#endif
    RUN(7, phase_outproj(lds_raw, layer));
    TIMED(22, phase_ln_router(lds_raw, layer)); if (DUP_PHASE == 22) phase_ln_router(lds_raw, layer, false);
    phase_moe_x1(lds_raw, layer); if (DUP_PHASE == 8) phase_moe_x1(lds_raw, layer, 1024);
    RUN(9, phase_moe_g1(lds_raw));
    RUN(10, phase_moe_g2(lds_raw));
    TIMED(24, phase_moe_combine(lds_raw, layer));
}
#if defined(STORE_TEST)
__device__ __forceinline__ void phase_store_test(unsigned char* lds_raw) {
    const Env e = penv(lds_raw);
    unsigned char* base = e.ws + WS_ROWS8 + (size_t)e.bid * (1u << 20);
    const int wr = e.wave >> 2, wc = e.wave & 3, fr = e.lane & 15, fq = e.lane >> 4;
    const v4u val = {(unsigned)e.tid, 1u, 2u, 3u};
    for (int u = 0; u < 40; ++u) {
#pragma unroll
        for (int s = 0; s < 8; ++s)
#pragma unroll
            for (int bj = 0; bj < 2; ++bj) {
#if STORE_TEST == 1
                const int r = (s >> 2) * 128 + wr * 64 + (s & 3) * 16 + fr; const int cb = wc * 64 + fq * 16 + bj * 256;
#elif STORE_TEST == 2
                const int r = (s >> 2) * 128 + wr * 64 + (s & 3) * 16 + bj * 8 + (e.lane >> 3); const int cb = wc * 128 + (e.lane & 7) * 16;
#else
                const int r = (s >> 2) * 128 + wr * 64 + (s & 3) * 16 + bj * 8 + (e.lane >> 4) * 2 + (wc & 1); const int cb = (wc >> 1) * 256 + (e.lane & 15) * 16;
#endif
                *(v4u*)(base + (size_t)((u & 1) * 256 + r) * 2048 + cb) = val; }
        asm volatile("" ::: "memory"); }
    grid_bar(e);
}
#endif
struct Args { const float* in[38]; float* out; unsigned char* ws; };
__global__ void __launch_bounds__(NTHREADS, 2) mega_fwd(Args a) {
    extern __shared__ __attribute__((aligned(16))) unsigned char lds_raw[];
    {
        LAS unsigned char* lds = (LAS unsigned char*)lds_raw;
        for (int u = threadIdx.x; u < (LDS_BYTES - LDS_CTL) / 4; u += NTHREADS) ((LAS unsigned*)(lds + LDS_CTL))[u] = 0u;
        __syncthreads();
        if (threadIdx.x == 0) {
            (void)xb_add((unsigned*)a.ws + 4096 + XB_XCNT(xb_xcc_id()), 1u);
            Tab* tab = (Tab*)(lds_raw + TAB_OFF);
#pragma unroll
            for (int i = 0; i < 38; ++i) { tab->in[i] = a.in[i]; if ((i & 7) == 7) asm volatile("" ::: "memory"); }
            tab->out = a.out; tab->ws = a.ws;
            asm volatile("" ::: "memory");
#if defined(WITH_NAIVE)
            nv::Ctx* const ctab = (nv::Ctx*)(lds_raw + CTX_OFF);
            const size_t scratch0 = (size_t)T_ * 1024 + (size_t)T_ * 64 + (size_t)T_ * 8 * 2;
#pragma unroll 1
            for (int layer = 0; layer < 2; ++layer) {
                nv::Ctx& c = ctab[layer * 2];
                nv::Mem M{(float*)(a.ws + WS_NAIVE), 0};
#pragma unroll 1
                for (int i = 0; i < 38; ++i) c.in[i] = tab->in[i];
                c.mixed = M.get((size_t)T_ * 1024); c.scores = M.get((size_t)T_ * 64);
                c.ridx = (int*)M.get((size_t)T_ * 8); c.rwt = M.get((size_t)T_ * 8);
                c.gR = nullptr; c.gBias = nullptr; c.slab = 0;
                c.layer = layer;
                c.hcur = layer == 0 ? a.in[0] : a.out;
                if (layer == 0) {
                    c.ldp = EINP; c.proj = M.get((size_t)T_ * c.ldp);
                    c.mb = M.get(8 * S_); c.mig = M.get(8 * S_); c.mblast = M.get(8 * NCH); c.mmloc = M.get(8 * NCH); c.mmprev = M.get(8 * NCH);
                    c.mmi = M.get(8 * S_); c.mwin = M.get(8 * S_); c.mden = M.get(8 * S_); c.nloc = M.get(8 * NCH * 128);
                    const size_t ov = M.off;
                    c.cloc = M.get((size_t)8 * NCH * 16384); c.smat = M.get((size_t)8 * NCH * 4096); c.htil = M.get((size_t)T_ * 512);
                    M.off = ov; c.lxc = M.get((size_t)T_ * 512); c.la = M.get((size_t)T_ * 512); c.lu = M.get((size_t)T_ * 512);
                } else {
                    c.ldp = OINP; c.proj = M.get((size_t)T_ * c.ldp);
                    c.s5ab = M.get(2048 * 2); c.s5bbr = M.get(2048 * 16); c.s5bbi = M.get(2048 * 16); c.s5st = M.get(2 * 2048 * 2);
                    c.s5x = M.get((size_t)nv::B_ * nv::SLAB * 2048 * 2); c.s5g = M.get((size_t)T_ * 512);
                    c.gla_la = M.get((size_t)T_ * 256); c.gla_bc = M.get((size_t)T_ * 256); c.gla_bl = M.get((size_t)nv::B_ * NCH * 256);
                    c.gu = M.get((size_t)8 * NCH * 8192); c.gatt = M.get((size_t)8 * NCH * 4096); c.go = M.get((size_t)T_ * 512);
                }
                c.z = c.proj; c.hout = a.out; c.lnw = a.in[1] + layer * 1024; c.lnb = a.in[2] + layer * 1024;
                M.off = scratch0; c.hid = M.get((size_t)T_ * 9 * 256);
                nv::Ctx& cm = ctab[layer * 2 + 1];
                cm = c; cm.hcur = a.out;
#ifdef DBG_LAYER
                if (layer == DBG_LAYER) { nv::Ctx& cd = ctab[4]; cd = cm;
                cd.hid = (float*)(a.ws + 48 * MiB); cd.z = (float*)(a.ws + 486 * MiB); cd.hcur = a.out + (size_t)DBG_T0 * 1024; cd.ridx = c.ridx + (size_t)DBG_T0 * 8; cd.rwt = c.rwt + (size_t)DBG_T0 * 8; }
#endif
            }
#endif
        }
        __syncthreads();
    }
    RUN(0, phase_p0(lds_raw));
    layer_body<0>(lds_raw);
    layer_body<1>(lds_raw);
#if defined(STORE_TEST)
    phase_store_test(lds_raw);
#endif
#if defined(DBG_MIX0)
    phase_probe_apply(lds_raw);
#endif
    if (TIME_PHASE >= 0) { const Env e = penv(lds_raw); const unsigned ticks = __hip_atomic_load((unsigned*)e.ws + CW_PROBE + 8, __ATOMIC_RELAXED, __HIP_MEMORY_SCOPE_AGENT);
        const float f = 1.0f + 0.0005f * (float)ticks * 0.01f;
        for (long i = e.gtid; i < (long)T_ * 1024; i += e.gsz) e.out[i] *= f; }
}
extern "C" void kernel_launch(void* const* d_in, const int* in_sizes, int n_in, void* d_out, int out_size, void* d_ws, size_t ws_size, hipStream_t stream) {
    static int grid = 0;
    if (grid == 0) {
        int dev = 0, cus = 0, per_cu = 0;
        hipGetDevice(&dev); hipDeviceGetAttribute(&cus, hipDeviceAttributeMultiprocessorCount, dev);
        hipFuncSetAttribute((const void*)mega_fwd, hipFuncAttributeMaxDynamicSharedMemorySize, LDS_BYTES);
        hipOccupancyMaxActiveBlocksPerMultiprocessor(&per_cu, (const void*)mega_fwd, NTHREADS, LDS_BYTES);
        (void)hipGetLastError();
        grid = (per_cu >= 1) ? cus : -1;
    }
    if (grid < 0) return;
    hipMemsetAsync(d_ws, 0, CTL_BYTES, stream);
    Args a{};
    for (int i = 0; i < 38; ++i) a.in[i] = (const float*)d_in[i];
    a.out = (float*)d_out; a.ws = (unsigned char*)d_ws;
    hipLaunchKernelGGL(mega_fwd, dim3(grid), dim3(NTHREADS), LDS_BYTES, stream, a);
}
```

```cpp
#define OPT_MIX0 1
#define OPT_MIX1 1
#define OPT_ROUTER 1
#include <hip/hip_runtime.h>
#define GAS __attribute__((address_space(1)))
#define LAS __attribute__((address_space(3)))
#define XB_TMO      128
#define XB_XCNT(j)  (256  + 64 * (j))
#define XB_XSUB(j)  (1280 + 64 * (j))
#define XB_XGEN(j)  (2304 + 64 * (j))
#define XB_TOP      3328
#define XB_TOPGEN   3392
#define XCD_BAR_WORDS 3456
#define XB_SPIN_CAP (1u << 22)
__device__ __forceinline__ unsigned xb_ld(unsigned* p)              { return __hip_atomic_load(p, __ATOMIC_RELAXED, __HIP_MEMORY_SCOPE_AGENT); }
__device__ __forceinline__ unsigned xb_add(unsigned* p, unsigned v) { return __hip_atomic_fetch_add(p, v, __ATOMIC_RELAXED, __HIP_MEMORY_SCOPE_AGENT); }
__device__ __forceinline__ unsigned xb_xcc_id() { return (unsigned)__builtin_amdgcn_s_getreg((3 << 11) | 20) & 0xFu; }
#define XB_SPIN(cond, bar) do { unsigned _sp = 0; while (cond) { __builtin_amdgcn_s_sleep(1); \
    if ((++_sp & 255u) == 0u) { if (xb_ld(&(bar)[XB_TMO])) break; if (_sp > XB_SPIN_CAP) { atomicAdd(&(bar)[XB_TMO], 1u); break; } } } } while (0)
struct XcdBarrier { unsigned* bar; unsigned x; volatile LAS unsigned* st; };
__device__ __forceinline__ XcdBarrier xcd_barrier_post(unsigned* bar, volatile LAS unsigned* st) {
    XcdBarrier b; b.bar = bar; b.x = xb_xcc_id(); b.st = st;
    if (threadIdx.x == 0) (void)xb_add(&bar[XB_XCNT(b.x)], 1u);
    return b;
}
__device__ __forceinline__ void xcd_barrier_complete(unsigned* bar, unsigned x, unsigned& nloc, unsigned& nx) {
    const unsigned G = gridDim.x * gridDim.y * gridDim.z;
    unsigned sum, cnt, mine, sp = 0u;
    for (;;) {
        sum = 0u; cnt = 0u; mine = 0u;
#pragma unroll
        for (unsigned j = 0; j < 16; ++j) { const unsigned c = xb_ld(&bar[XB_XCNT(j)]); sum += c; cnt += (c > 0u) ? 1u : 0u; mine = (j == x) ? c : mine; }
        if (sum == G) break;
        __builtin_amdgcn_s_sleep(1);
        if ((++sp & 255u) == 0u) { if (xb_ld(&bar[XB_TMO])) break; if (sp > XB_SPIN_CAP) { atomicAdd(&bar[XB_TMO], 1u); break; } }
    }
    nloc = mine > 0u ? mine : 1u; nx = cnt > 0u ? cnt : 1u;
}
__device__ __forceinline__ void xcd_barrier(const XcdBarrier& b) {
    asm volatile("s_waitcnt vmcnt(0)" ::: "memory");
    __syncthreads();
    if (threadIdx.x == 0) {
        unsigned* bar = b.bar;
        __builtin_amdgcn_s_waitcnt(0);
        unsigned nloc = b.st[0], nx = b.st[1];
        if (nloc == 0u) { xcd_barrier_complete(bar, b.x, nloc, nx); b.st[0] = nloc; b.st[1] = nx; }
        const unsigned old = xb_add(&bar[XB_XSUB(b.x)], 1u);
        const unsigned gen = old / nloc;
        if (old + 1u == (gen + 1u) * nloc) {
            __builtin_amdgcn_fence(__ATOMIC_RELEASE, "agent");
            asm volatile("s_waitcnt vmcnt(0)" ::: "memory");
            const unsigned og = xb_add(&bar[XB_TOP], 1u);
            const unsigned tg = og / nx;
            if (og + 1u == (tg + 1u) * nx) xb_add(&bar[XB_TOPGEN], 1u);
            else XB_SPIN(xb_ld(&bar[XB_TOPGEN]) == tg, bar);
            __builtin_amdgcn_fence(__ATOMIC_ACQUIRE, "agent");
            xb_add(&bar[XB_XGEN(b.x)], 1u);
            asm volatile("s_waitcnt vmcnt(0)" ::: "memory");
        } else {
            XB_SPIN(xb_ld(&bar[XB_XGEN(b.x)]) == gen, bar);
            __builtin_amdgcn_fence(__ATOMIC_ACQUIRE, "agent");
            asm volatile("s_waitcnt vmcnt(0)" ::: "memory");
        }
    }
    __syncthreads();
}
namespace pg8 {
#define PG8_LAS __attribute__((address_space(3)))
typedef unsigned short bf16_t;
typedef short bf16x8 __attribute__((ext_vector_type(8)));
typedef float f32x4 __attribute__((ext_vector_type(4)));
typedef unsigned u32x4 __attribute__((ext_vector_type(4)));
constexpr int BM = 256, BK = 64, HALF = 128, HTB = HALF * BK * 2, STAGE_BYTES = 8 * HTB, NXCD = 8, WGM = 8;
__host__ __device__ __forceinline__ int lds_byte(int r, int c) { const int st = (r >> 4) * 2 + (c >> 5), rr = r & 15, cc = c & 31, ob = rr * 64 + cc * 2; return st * 1024 + (ob ^ (((ob >> 9) & 1) << 5)); }
__host__ __device__ __forceinline__ void stage_rc(int b, int& R, int& C) { const int st = b / 1024, sb = b % 1024, swz = sb ^ (((sb >> 9) & 1) << 5); R = (st >> 1) * 16 + swz / 64; C = (st & 1) * 32 + (swz % 64) / 2; }
__host__ __device__ __forceinline__ int perm32(int rho) { const int n = rho >> 4, i = rho & 15; return 8 * (i >> 2) + 4 * n + (i & 3); }
struct Unit { int pm, pn, e, aux; };
struct Gemm { const bf16_t* A; const bf16_t* Bt; int K; int pad; size_t bstride; const int* rows; };
struct StaticOrder {
    int nM, nN, nwg, G, c;
    __host__ __device__ void init(int M, int N, int G_, int c_) { nM = M / BM; nN = N / BM; nwg = nM * nN; G = G_; c = c_; }
    __host__ __device__ bool next(int i, Unit& u) const {
        const long L = (long)i * G + c; if (L >= nwg) return false;
        int wgid = (int)L; { const int q = nwg / NXCD, r = nwg % NXCD, xcd = wgid % NXCD, off = wgid / NXCD; wgid = (xcd < r ? xcd * (q + 1) : r * (q + 1) + (xcd - r) * q) + off; }
        const int nig = WGM * nN, gid = wgid / nig, fm = gid * WGM, gsz = (nM - fm) < WGM ? (nM - fm) : WGM;
        u.pm = fm + ((wgid % nig) % gsz); u.pn = (wgid % nig) / gsz; u.e = 0; u.aux = 0; return true;
    }
};
__device__ __forceinline__ unsigned cvt_pk_bf16(float lo, float hi) { unsigned r; asm volatile("v_cvt_pk_bf16_f32 %0, %1, %2" : "=v"(r) : "v"(lo), "v"(hi)); return r; }
struct EpiF32R {
    static constexpr int NPRE = 0; __device__ __forceinline__ void load_pre(const Unit&, int, int, int (&)[1]) const {}
    static constexpr bool PERM = false;
    float* C; int ldc; const float* R; float ralpha;
    __device__ __forceinline__ void operator()(const f32x4 (&acc)[2][2][4][2], const Unit& u, int wr, int wc, int fr, int fq) const {
        const int row0 = u.pm * BM + wr * 64 + fr, col0 = u.pn * BM + wc * 32 + 4 * fq;
#pragma unroll
        for (int ai = 0; ai < 2; ++ai)
#pragma unroll
            for (int m = 0; m < 4; ++m) { const size_t off = (size_t)(row0 + ai * HALF + m * 16) * ldc + col0;
#pragma unroll
                for (int bj = 0; bj < 2; ++bj)
#pragma unroll
                    for (int n = 0; n < 2; ++n) { f32x4 v = acc[ai][bj][m][n]; if (R) v = v + ralpha * *(const f32x4*)(R + off + bj * HALF + n * 16); *(f32x4*)(C + off + bj * HALF + n * 16) = v; } }
    }
};
struct EpiBf16P {
    static constexpr int NPRE = 0; __device__ __forceinline__ void load_pre(const Unit&, int, int, int (&)[1]) const {}
    static constexpr bool PERM = true;
    bf16_t* O; int ldc;
    __device__ __forceinline__ void operator()(const f32x4 (&acc)[2][2][4][2], const Unit& u, int wr, int wc, int fr, int fq) const {
        const int row0 = u.pm * BM + wr * 64 + fr, col0 = u.pn * BM + wc * 32 + 8 * fq;
#pragma unroll
        for (int ai = 0; ai < 2; ++ai)
#pragma unroll
            for (int m = 0; m < 4; ++m) { bf16_t* rowp = O + (size_t)(row0 + ai * HALF + m * 16) * ldc + col0;
#pragma unroll
                for (int bj = 0; bj < 2; ++bj) { const f32x4 v0 = acc[ai][bj][m][0], v1 = acc[ai][bj][m][1];
                    u32x4 w; w.x = cvt_pk_bf16(v0[0], v0[1]); w.y = cvt_pk_bf16(v0[2], v0[3]); w.z = cvt_pk_bf16(v1[0], v1[1]); w.w = cvt_pk_bf16(v1[2], v1[3]);
                    *(u32x4*)(rowp + bj * HALF) = w; } }
    }
};
struct EpiGlu {
    static constexpr int NPRE = 0; __device__ __forceinline__ void load_pre(const Unit&, int, int, int (&)[1]) const {}
    static constexpr bool PERM = true;
    bf16_t* O; int ldo; const bf16_t* Gm; int ldg; const float* bias;
    __device__ __forceinline__ void operator()(const f32x4 (&acc)[2][2][4][2], const Unit& u, int wr, int wc, int fr, int fq) const {
        const int row0 = u.pm * BM + wr * 64 + fr, col0 = u.pn * BM + wc * 32 + 8 * fq;
#pragma unroll
        for (int ai = 0; ai < 2; ++ai)
#pragma unroll
            for (int m = 0; m < 4; ++m) { const size_t r = (size_t)(row0 + ai * HALF + m * 16);
#pragma unroll
                for (int bj = 0; bj < 2; ++bj) { const int c = col0 + bj * HALF;
                    const f32x4 b0 = *(const f32x4*)(bias + c), b1 = *(const f32x4*)(bias + c + 4); const u32x4 gv = *(const u32x4*)(Gm + r * ldg + c);
                    const f32x4 v0 = acc[ai][bj][m][0] + b0, v1 = acc[ai][bj][m][1] + b1;
                    float g[8] = {__builtin_bit_cast(float, gv.x << 16), __builtin_bit_cast(float, gv.x & 0xffff0000u), __builtin_bit_cast(float, gv.y << 16), __builtin_bit_cast(float, gv.y & 0xffff0000u),
                                  __builtin_bit_cast(float, gv.z << 16), __builtin_bit_cast(float, gv.z & 0xffff0000u), __builtin_bit_cast(float, gv.w << 16), __builtin_bit_cast(float, gv.w & 0xffff0000u)};
                    u32x4 w; w.x = cvt_pk_bf16(g[0] * __builtin_amdgcn_rcpf(1.f + __expf(-v0[0])), g[1] * __builtin_amdgcn_rcpf(1.f + __expf(-v0[1]))); w.y = cvt_pk_bf16(g[2] * __builtin_amdgcn_rcpf(1.f + __expf(-v0[2])), g[3] * __builtin_amdgcn_rcpf(1.f + __expf(-v0[3])));
                    w.z = cvt_pk_bf16(g[4] * __builtin_amdgcn_rcpf(1.f + __expf(-v1[0])), g[5] * __builtin_amdgcn_rcpf(1.f + __expf(-v1[1]))); w.w = cvt_pk_bf16(g[6] * __builtin_amdgcn_rcpf(1.f + __expf(-v1[2])), g[7] * __builtin_amdgcn_rcpf(1.f + __expf(-v1[3])));
                    *(u32x4*)(O + r * ldo + c) = w; } }
    }
};
template <class Epi, class Sched, bool ALIGN_EPI, bool GATHER>
__device__ __forceinline__ void gemm_phase(PG8_LAS unsigned char* lds, const Gemm g, const Sched& S, const Epi& E) {
    int tid_ = threadIdx.x; asm volatile("" : "+v"(tid_));
    const int tid = tid_, wid = __builtin_amdgcn_readfirstlane(tid >> 6), lane = tid & 63, wr = wid >> 2, wc = wid & 3, fr = lane & 15, fq = lane >> 4;
    const int K = g.K, nt = K / BK;
    unsigned voffA[2], voffB[2];
#pragma unroll
    for (int i = 0; i < 2; ++i) { int R, C; stage_rc(tid * 16 + i * 8192, R, C); const int Rb = Epi::PERM ? ((R & ~31) + perm32(R & 31)) : R;
        voffA[i] = (unsigned)(R * K + C) * 2u; voffB[i] = (unsigned)(Rb * K + C) * 2u; }
    const size_t kstep = (size_t)(BK * 2);
    const size_t hstep = (size_t)HALF * K * 2;
    const size_t tstep = 2 * hstep;
    const unsigned ldsw = (unsigned)wid * 1024u;
    const int aoff = lds_byte(wr * 64 + fr, fq * 8), boff = lds_byte(wc * 32 + fr, fq * 8);
#define PG8_SA(b, h) (((b) * 2 + (h)) * HTB)
#define PG8_SB(b, h) ((4 + (b) * 2 + (h)) * HTB)
#define PG8_STAGE(bufoff, gbase, voff) do { _Pragma("unroll") for (int _i = 0; _i < 2; ++_i) { unsigned _vo = (voff)[_i]; asm volatile("" : "+v"(_vo));   \
        __builtin_amdgcn_global_load_lds((const unsigned*)((const char*)(gbase) + _vo), (PG8_LAS unsigned*)(lds + (bufoff) + ldsw + _i * 8192), 16, 0, 0); } } while (0)
#define PG8_STAGE_A(bufoff, gbase, h, GV) do { if constexpr (GATHER) { PG8_STAGE(bufoff, gbase, GV[h]); } else { PG8_STAGE(bufoff, (gbase) + (h) * hstep, voffA); } } while (0)
#define PG8_STAGE_A2(bufoff, gbase, h) do { if constexpr (GATHER) { unsigned _gv[2] = {last ? gnxt[h][0] : gcur[h][0], last ? gnxt[h][1] : gcur[h][1]}; PG8_STAGE(bufoff, gbase, _gv); } else { PG8_STAGE(bufoff, (gbase) + (h) * hstep, voffA); } } while (0)
#define PG8_LDA(dst, b, h) do { _Pragma("unroll") for (int m = 0; m < 4; ++m) _Pragma("unroll") for (int k = 0; k < 2; ++k) dst[m][k] = *(const PG8_LAS bf16x8*)(lds + PG8_SA(b, h) + aoff + m * 2048 + k * 1024); } while (0)
#define PG8_LDB(dst, b, h) do { _Pragma("unroll") for (int n = 0; n < 2; ++n) _Pragma("unroll") for (int k = 0; k < 2; ++k) dst[n][k] = *(const PG8_LAS bf16x8*)(lds + PG8_SB(b, h) + boff + n * 2048 + k * 1024); } while (0)
#define PG8_MMA(ai, bj, At, Bt) do { __builtin_amdgcn_s_setprio(1); _Pragma("unroll") for (int m = 0; m < 4; ++m) _Pragma("unroll") for (int n = 0; n < 2; ++n) _Pragma("unroll") for (int k = 0; k < 2; ++k) \
        acc[ai][bj][m][n] = __builtin_amdgcn_mfma_f32_16x16x32_bf16(Bt[n][k], At[m][k], acc[ai][bj][m][n], 0, 0, 0); __builtin_amdgcn_s_setprio(0); } while (0)
#define PG8_WAIT_V(n) asm volatile("s_waitcnt vmcnt(" #n ")" ::: "memory")
#define PG8_WAIT_L(n) asm volatile("s_waitcnt lgkmcnt(" #n ")" ::: "memory")
#define PG8_BAR __builtin_amdgcn_s_barrier()
#define PG8_SCHED __builtin_amdgcn_sched_barrier(0)
#define PG8_GLOAD(GV, u) do { _Pragma("unroll") for (int _i = 0; _i < 2; ++_i) { int _R, _C; stage_rc(tid * 16 + _i * 8192, _R, _C); _Pragma("unroll") for (int _h = 0; _h < 2; ++_h) \
        GV[_h][_i] = (unsigned)g.rows[(u).pm * BM + _h * HALF + _R] * (unsigned)(K * 2) + (unsigned)(_C * 2); } } while (0)
    Unit cur, nxt; int ui = 0;
    if (!S.next(0, cur)) return;
    f32x4 acc[2][2][4][2];
#pragma unroll
    for (int a = 0; a < 2; ++a)
#pragma unroll
        for (int b = 0; b < 2; ++b)
#pragma unroll
            for (int m = 0; m < 4; ++m)
#pragma unroll
                for (int n = 0; n < 2; ++n) acc[a][b][m][n] = (f32x4){0.f, 0.f, 0.f, 0.f};
    bf16x8 At[4][2], B0[2][2], B1[2][2];
    unsigned gcur[2][2] = {{0u, 0u}, {0u, 0u}}, gnxt[2][2] = {{0u, 0u}, {0u, 0u}};
    if constexpr (Epi::NPRE > 0) E.prefetch(cur, 0, lds, wid, lane);
    if constexpr (GATHER) { PG8_GLOAD(gcur, cur); }
    const char* cA = GATHER ? (const char*)g.A : (const char*)g.A + (size_t)cur.pm * tstep;
    const char* cB = (const char*)g.Bt + ((size_t)cur.e * g.bstride) * 2 + (size_t)cur.pn * tstep;
    PG8_STAGE(PG8_SB(0, 0), cB, voffB); PG8_STAGE(PG8_SB(0, 1), cB + hstep, voffB); PG8_STAGE_A(PG8_SA(0, 0), cA, 0, gcur); PG8_STAGE_A(PG8_SA(0, 1), cA, 1, gcur);
    if (wr == 1) PG8_BAR;
    PG8_WAIT_V(2); PG8_BAR;
    PG8_STAGE(PG8_SB(1, 0), cB + kstep, voffB); PG8_STAGE_A(PG8_SA(1, 0), cA + kstep, 0, gcur); PG8_STAGE(PG8_SB(1, 1), cB + hstep + kstep, voffB);
    PG8_WAIT_V(6); PG8_BAR;
    for (;;) {
        const bool has_next = S.next(ui + 1, nxt);
        if constexpr (Epi::NPRE > 0) { if (has_next) E.prefetch(nxt, (ui + 1) % 3, lds, wid, lane); }
        if constexpr (GATHER) { if (has_next) { PG8_GLOAD(gnxt, nxt); } else {
#pragma unroll
            for (int _h = 0; _h < 2; ++_h)
#pragma unroll
                for (int _i = 0; _i < 2; ++_i) gnxt[_h][_i] = gcur[_h][_i]; } }
        const char* nA = GATHER ? cA : (has_next ? (const char*)g.A + (size_t)nxt.pm * tstep : cA);
        const char* nB = has_next ? (const char*)g.Bt + ((size_t)nxt.e * g.bstride) * 2 + (size_t)nxt.pn * tstep : cB;
#pragma unroll 1
        for (int t = 0; t < nt; t += 2) {
            const bool last = (t == nt - 2);
            const char* a1 = cA + (size_t)(t + 1) * kstep;
            const char* a2 = last ? nA : cA + (size_t)(t + 2) * kstep; const char* b2 = last ? nB : cB + (size_t)(t + 2) * kstep;
            const char* a3 = a2 + kstep; const char* b3 = b2 + kstep;
            PG8_LDB(B0, 0, 0); PG8_LDB(B1, 0, 1); PG8_SCHED; PG8_LDA(At, 0, 0); PG8_STAGE_A(PG8_SA(1, 1), a1, 1, gcur);
            PG8_WAIT_V(8); PG8_WAIT_L(0); PG8_BAR; PG8_MMA(0, 0, At, B0); PG8_MMA(0, 1, At, B1); PG8_BAR; PG8_SCHED;
            PG8_LDA(At, 0, 1); PG8_STAGE(PG8_SB(0, 0), b2, voffB); PG8_STAGE(PG8_SB(0, 1), b2 + hstep, voffB); PG8_STAGE_A2(PG8_SA(0, 0), a2, 0);
            PG8_WAIT_V(8); PG8_WAIT_L(0); PG8_BAR; PG8_MMA(1, 0, At, B0); PG8_MMA(1, 1, At, B1); PG8_BAR; PG8_SCHED;
            PG8_LDB(B0, 1, 0); PG8_LDB(B1, 1, 1); PG8_SCHED; PG8_LDA(At, 1, 0); PG8_STAGE_A2(PG8_SA(0, 1), a2, 1);
            PG8_WAIT_V(8); PG8_WAIT_L(0); PG8_BAR; PG8_MMA(0, 0, At, B0); PG8_MMA(0, 1, At, B1); PG8_BAR; PG8_SCHED;
            PG8_LDA(At, 1, 1); PG8_STAGE(PG8_SB(1, 0), b3, voffB); PG8_STAGE(PG8_SB(1, 1), b3 + hstep, voffB); PG8_STAGE_A2(PG8_SA(1, 0), a3, 0);
            PG8_WAIT_V(8); PG8_WAIT_L(0); PG8_BAR; PG8_MMA(1, 0, At, B0); PG8_MMA(1, 1, At, B1); PG8_BAR; PG8_SCHED;
        }
        if constexpr (ALIGN_EPI) { if (wr == 0) PG8_BAR; }
        if constexpr (Epi::NPRE > 0) E(acc, cur, wr, wc, fr, fq, ui % 3, lds); else E(acc, cur, wr, wc, fr, fq);
        if (!has_next) break;
#pragma unroll
        for (int a = 0; a < 2; ++a)
#pragma unroll
            for (int b = 0; b < 2; ++b)
#pragma unroll
                for (int m = 0; m < 4; ++m)
#pragma unroll
                    for (int n = 0; n < 2; ++n) acc[a][b][m][n] = (f32x4){0.f, 0.f, 0.f, 0.f};
        cur = nxt; cA = nA; cB = nB; ++ui;
        if constexpr (GATHER) {
#pragma unroll
            for (int _h = 0; _h < 2; ++_h)
#pragma unroll
                for (int _i = 0; _i < 2; ++_i) gcur[_h][_i] = gnxt[_h][_i]; }
        if constexpr (ALIGN_EPI) { if (wr == 1) PG8_BAR; }
    }
    PG8_WAIT_V(0);
    if constexpr (!ALIGN_EPI) { if (wr == 0) PG8_BAR; }
    PG8_BAR;
#undef PG8_SA
#undef PG8_SB
#undef PG8_STAGE
#undef PG8_STAGE_A
#undef PG8_STAGE_A2
#undef PG8_LDA
#undef PG8_LDB
#undef PG8_MMA
#undef PG8_WAIT_V
#undef PG8_WAIT_L
#undef PG8_BAR
#undef PG8_SCHED
#undef PG8_GLOAD
}
}
typedef unsigned short bf16;
typedef unsigned v4u __attribute__((ext_vector_type(4)));
typedef unsigned v2u __attribute__((ext_vector_type(2)));
typedef float f32x4 __attribute__((ext_vector_type(4)));
constexpr int NTHREADS = 512, NWAVES = 8;
constexpr int LDS_BYTES = 163840;
constexpr int LDS_CTL = 155648;
constexpr int MISC_OFF = LDS_CTL + 320;
constexpr size_t MiB = 1u << 20;
constexpr size_t CTL_BYTES = 1 * MiB;
#if !defined(WITH_NAIVE)
namespace nv { constexpr int B_ = 2, S_ = 8192, T_ = B_ * S_, NCH = S_ / 64, EIN = 3080, OIN = 2064; constexpr float ALPHA = 1.41421356237309515f, EPS = 1e-5f; struct Mem { float* base; size_t off; }; }
#endif
constexpr int T_ = nv::T_, S_ = nv::S_, NCH = nv::NCH;
constexpr int EINP = 3328, OINP = 2304;
#define LDS_WAIT() asm volatile("s_waitcnt lgkmcnt(0)" ::: "memory")
typedef __bf16 hwbf2_t __attribute__((ext_vector_type(2)));
typedef float hwf2_t __attribute__((ext_vector_type(2)));
__device__ __forceinline__ unsigned f2bf(float f) { const __bf16 b = (__bf16)f; return (unsigned)__builtin_bit_cast(unsigned short, b); }
__device__ __forceinline__ unsigned pk2(float lo, float hi) { const hwf2_t v = {lo, hi}; return __builtin_bit_cast(unsigned, __builtin_convertvector(v, hwbf2_t)); }
__device__ __forceinline__ float bf2f(unsigned short b) { return __builtin_bit_cast(float, (unsigned)b << 16); }
__device__ __forceinline__ void tr_item(const float* W, long ldw, int nvalid, bf16* dst, long ldd, LAS float* scr, int lane) {
#pragma unroll 8
    for (int i = 0; i < 32; ++i) { const int kk = 2 * i + (lane >> 5), nn = lane & 31; scr[kk * 33 + nn] = nn < nvalid ? W[(long)kk * ldw + nn] : 0.f; }
    LDS_WAIT(); asm volatile("" ::: "memory");
    const int c = lane & 7;
#pragma unroll
    for (int j = 0; j < 4; ++j) { const int n = (lane >> 3) + 8 * j; const LAS float* s = scr + (8 * c) * 33 + n;
        v4u o; o.x = pk2(s[0 * 33], s[1 * 33]); o.y = pk2(s[2 * 33], s[3 * 33]); o.z = pk2(s[4 * 33], s[5 * 33]); o.w = pk2(s[6 * 33], s[7 * 33]);
        *(v4u*)(dst + (long)n * ldd + 8 * c) = o; }
    LDS_WAIT(); asm volatile("" ::: "memory");
}
__device__ __forceinline__ void tr_item64(const float* W, long ldw, int nvalid, bf16* dst, long ldd, LAS float* scr, int lane) {
    const int nn = (lane & 15) * 4;
#pragma unroll
    for (int i = 0; i < 16; ++i) { const int kk = 4 * i + (lane >> 4);
        f32x4 v = {0.f, 0.f, 0.f, 0.f}; if (nn < nvalid) v = *(const f32x4*)(W + (long)kk * ldw + nn);
        LAS float* s = scr + kk * 65 + nn; s[0] = v.x; s[1] = v.y; s[2] = v.z; s[3] = v.w; }
    LDS_WAIT(); asm volatile("" ::: "memory");
    const int c = lane & 7;
#pragma unroll
    for (int j = 0; j < 8; ++j) { const int n = (lane >> 3) + 8 * j; const LAS float* s = scr + (8 * c) * 65 + n;
        v4u o; o.x = pk2(s[0 * 65], s[1 * 65]); o.y = pk2(s[2 * 65], s[3 * 65]); o.z = pk2(s[4 * 65], s[5 * 65]); o.w = pk2(s[6 * 65], s[7 * 65]);
        *(v4u*)(dst + (long)n * ldd + 8 * c) = o; }
    LDS_WAIT(); asm volatile("" ::: "memory");
}
__device__ __forceinline__ void tr_load64(const float* W, long ldw, int lane, f32x4 (&v)[16]) {
    const int nn = (lane & 15) * 4;
#pragma unroll
    for (int i = 0; i < 16; ++i) { const int kk = 4 * i + (lane >> 4); v[i] = *(const f32x4*)(W + (long)kk * ldw + nn); }
}
__device__ __forceinline__ void tr_store64(const f32x4 (&v)[16], bf16* dst, long ldd, LAS float* scr, int lane) {
    const int nn = (lane & 15) * 4;
#pragma unroll
    for (int i = 0; i < 16; ++i) { const int kk = 4 * i + (lane >> 4); LAS float* s = scr + kk * 65 + nn; s[0] = v[i].x; s[1] = v[i].y; s[2] = v[i].z; s[3] = v[i].w; }
    LDS_WAIT(); asm volatile("" ::: "memory");
    const int c = lane & 7;
#pragma unroll
    for (int j = 0; j < 8; ++j) { const int n = (lane >> 3) + 8 * j; const LAS float* s = scr + (8 * c) * 65 + n;
        v4u o; o.x = pk2(s[0 * 65], s[1 * 65]); o.y = pk2(s[2 * 65], s[3 * 65]); o.z = pk2(s[4 * 65], s[5 * 65]); o.w = pk2(s[6 * 65], s[7 * 65]);
        *(v4u*)(dst + (long)n * ldd + 8 * c) = o; }
    LDS_WAIT(); asm volatile("" ::: "memory");
}
__device__ __forceinline__ void tr_matrix(const float* W, int K, int N, int NP, bf16* WT, LAS float* scr, int gw, int NGW, int lane) {
    const int nblk = NP / 64, nitems = (K / 64) * nblk;
    for (int it = gw; it < nitems; it += NGW) { const int kb = it / nblk, nb = it % nblk, k0 = 64 * kb, n0 = 64 * nb; int nvalid = N - n0; nvalid = nvalid < 0 ? 0 : (nvalid > 64 ? 64 : nvalid);
        tr_item64(W + (long)k0 * N + n0, N, nvalid, WT + (long)n0 * K + k0, K, scr, lane); }
}
__device__ __forceinline__ void tr_matrix_item(const float* W, int K, int N, int NP, bf16* WT, LAS float* scr, int it, int lane) {
    const int nblk = NP / 64, kb = it / nblk, nb = it % nblk, k0 = 64 * kb, n0 = 64 * nb; int nvalid = N - n0; nvalid = nvalid < 0 ? 0 : (nvalid > 64 ? 64 : nvalid);
    tr_item64(W + (long)k0 * N + n0, N, nvalid, WT + (long)n0 * K + k0, K, scr, lane);
}
__device__ __forceinline__ void cvt_rows(const float* src, bf16* dst, long n, long gtid, long gsz) {
    long i = gtid * 8;
    for (; i + 3 * gsz * 8 < n; i += 4 * gsz * 8) {
        f32x4 a[4], b[4];
#pragma unroll
        for (int u = 0; u < 4; ++u) { a[u] = *(const f32x4*)(src + i + u * gsz * 8); b[u] = *(const f32x4*)(src + i + u * gsz * 8 + 4); }
#pragma unroll
        for (int u = 0; u < 4; ++u) { v4u o; o.x = pk2(a[u].x, a[u].y); o.y = pk2(a[u].z, a[u].w); o.z = pk2(b[u].x, b[u].y); o.w = pk2(b[u].z, b[u].w); *(v4u*)(dst + i + u * gsz * 8) = o; } }
    for (; i < n; i += gsz * 8) { const f32x4 a = *(const f32x4*)(src + i), b = *(const f32x4*)(src + i + 4);
        v4u o; o.x = pk2(a.x, a.y); o.y = pk2(a.z, a.w); o.z = pk2(b.x, b.y); o.w = pk2(b.z, b.w); *(v4u*)(dst + i) = o; }
}
__device__ __forceinline__ int sopaque(int v) { asm volatile("" : "+s"(v)); return v; }
__device__ __forceinline__ float wave_sum(float v) {
#define WS_STEP(o) v += __builtin_bit_cast(float, __builtin_amdgcn_ds_swizzle(__builtin_bit_cast(int, v), 0x1f | ((o) << 10)))
    WS_STEP(1); WS_STEP(2); WS_STEP(4); WS_STEP(8); WS_STEP(16);
#undef WS_STEP
    return __builtin_bit_cast(float, __builtin_amdgcn_readlane(__builtin_bit_cast(int, v), 0)) + __builtin_bit_cast(float, __builtin_amdgcn_readlane(__builtin_bit_cast(int, v), 32));
}
#ifndef DBG_SCALE
#define DBG_SCALE 20.0f
#endif
constexpr int MOE_MAXBLK = 640;
constexpr int CW_CNT = 8192, CW_CUR = 8192 + 128;
namespace pg8 {
struct MoeOrder {
    const int* blk_e; int nblk, npn, G, c;
    __device__ __forceinline__ bool next(int i, Unit& u) const {
        const long L = (long)i * G + c; if (L >= (long)nblk * npn) return false;
        const int blk = (int)(L / npn); u.pm = blk; u.pn = (int)(L % npn); u.e = __builtin_amdgcn_readfirstlane(blk_e[blk]); u.aux = 0; return true;
    }
};
__device__ __forceinline__ float silu_f(float x) { return x * __builtin_amdgcn_rcpf(1.0f + __expf(-x)); }
struct EpiSwiGLU {
    static constexpr int NPRE = 0; __device__ __forceinline__ void load_pre(const Unit&, int, int, int (&)[1]) const {}
    static constexpr bool PERM = true;
    bf16_t* H;
    __device__ __forceinline__ void operator()(const f32x4 (&acc)[2][2][4][2], const Unit& u, int wr, int wc, int fr, int fq) const {
        const int row0 = u.pm * BM + wr * 64 + fr, col0 = u.pn * 128 + wc * 32 + 8 * fq;
#pragma unroll
        for (int ai = 0; ai < 2; ++ai)
#pragma unroll
            for (int m = 0; m < 4; ++m) { bf16_t* rowp = H + (size_t)(row0 + ai * HALF + m * 16) * 256 + col0;
                const f32x4 g0 = acc[ai][0][m][0], g1 = acc[ai][0][m][1], u0 = acc[ai][1][m][0], u1 = acc[ai][1][m][1];
                u32x4 w; w.x = cvt_pk_bf16(silu_f(g0[0]) * u0[0], silu_f(g0[1]) * u0[1]); w.y = cvt_pk_bf16(silu_f(g0[2]) * u0[2], silu_f(g0[3]) * u0[3]);
                w.z = cvt_pk_bf16(silu_f(g1[0]) * u1[0], silu_f(g1[1]) * u1[1]); w.w = cvt_pk_bf16(silu_f(g1[2]) * u1[2], silu_f(g1[3]) * u1[3]);
                *(u32x4*)rowp = w; }
    }
};
struct EpiDown {
    static constexpr bool PERM = true; static constexpr int NPRE = 1;
    bf16_t* rows8; bf16_t* rows_sh; const int* dest; int nslot8;
    __device__ __forceinline__ void prefetch(const Unit& u, int slot, PG8_LAS unsigned char* lds, int wid, int lane) const {
        if (wid < 4) __builtin_amdgcn_global_load_lds((const unsigned*)(dest + u.pm * BM + wid * 64 + lane), (PG8_LAS unsigned*)(lds + STAGE_BYTES + slot * 1024 + wid * 256), 4, 0, 0);
    }
    __device__ __forceinline__ void operator()(const f32x4 (&acc)[2][2][4][2], const Unit& u, int wr, int wc, int fr, int fq, int slot, PG8_LAS unsigned char* lds) const {
        const int col0 = u.pn * BM + wc * 32 + 8 * fq; const PG8_LAS int* dl = (const PG8_LAS int*)(lds + STAGE_BYTES + slot * 1024) + wr * 64 + fr;
#if defined(EPI_REPS)
#pragma unroll 1
        for (int rep = 0; rep < EPI_REPS; ++rep) { asm volatile("" ::: "memory");
#else
        {
#endif
#pragma unroll
        for (int ai = 0; ai < 2; ++ai)
#pragma unroll
            for (int m = 0; m < 4; ++m) { const int d = dl[ai * HALF + m * 16];
                if (d >= 0) { bf16_t* rowp = (d < nslot8 ? rows8 + (size_t)d * 1024 : rows_sh + (size_t)(d - nslot8) * 1024) + col0;
#pragma unroll
                    for (int bj = 0; bj < 2; ++bj) { const f32x4 v0 = acc[ai][bj][m][0], v1 = acc[ai][bj][m][1];
                        u32x4 o; o.x = cvt_pk_bf16(v0[0], v0[1]); o.y = cvt_pk_bf16(v0[2], v0[3]); o.z = cvt_pk_bf16(v1[0], v1[1]); o.w = cvt_pk_bf16(v1[2], v1[3]);
#if defined(NT_STORES)
                        __builtin_nontemporal_store(o, (u32x4*)(rowp + bj * HALF));
#else
                        *(u32x4*)(rowp + bj * HALF) = o;
#endif
                        } } }
        }
    }
};
}
__device__ __forceinline__ void moe_convert_weights(const float* wg, const float* wu, const float* wd, const float* sg, const float* su, const float* sd,
                                                    bf16* WGU, bf16* WD, LAS float* scr, int first, int last, int stride, int lane) {
#define MCW_SRC(it_, srcp, ldw_, dstp, ldd_) do { const int e = (it_) / 192, r = (it_) % 192, kind = r >> 6, q = r & 63;     \
        if (kind < 2) { const float* W = (e < 64 ? (kind == 0 ? wg : wu) + (size_t)e * 262144 : (kind == 0 ? sg : su)); const int kb = q >> 2, nb = q & 3, k0 = 64 * kb, n0 = 64 * nb; \
            srcp = W + (size_t)k0 * 256 + n0; ldw_ = 256; dstp = WGU + ((size_t)e * 512 + (n0 >> 7) * 256 + (n0 & 127) + kind * 128) * 1024 + k0; ldd_ = 1024; } \
        else { const float* W = e < 64 ? wd + (size_t)e * 262144 : sd; const int kb = q >> 4, nb = q & 15, k0 = 64 * kb, n0 = 64 * nb; \
            srcp = W + (size_t)k0 * 1024 + n0; ldw_ = 1024; dstp = WD + ((size_t)e * 1024 + n0) * 256 + k0; ldd_ = 256; } } while (0)
    if (first >= last) return;
    f32x4 cur[16], nxt[16]; const float* sp; bf16* dp; long lw, ld;
    MCW_SRC(first, sp, lw, dp, ld); tr_load64(sp, lw, lane, cur);
    for (int it = first; it < last; it += stride) {
        bf16* dcur = dp; const long ldcur = ld; const bool more = it + stride < last;
        if (more) { MCW_SRC(it + stride, sp, lw, dp, ld); tr_load64(sp, lw, lane, nxt); }
        tr_store64(cur, dcur, ldcur, scr, lane);
        if (more) {
#pragma unroll
            for (int i = 0; i < 16; ++i) cur[i] = nxt[i]; }
    }
#undef MCW_SRC
}
struct MoeLists { int* tok; int* dest; float* w; int* blk_e; };
__device__ __forceinline__ void moe_count(const int* ridx, unsigned* cnt, LAS unsigned* hist, int tid, int bid, int G) {
    if (tid < 64) hist[tid] = 0u;
    __syncthreads();
    for (int i = bid * NTHREADS + tid; i < T_ * 8; i += G * NTHREADS) atomicAdd((unsigned*)&hist[ridx[i]], 1u);
    __syncthreads();
    if (tid < 64 && hist[tid]) atomicAdd(&cnt[tid], hist[tid]);
    __syncthreads();
}
__device__ __forceinline__ void moe_build_lists(const int* ridx, const float* rwt, const unsigned* cnt, unsigned* cur, const MoeLists L, LAS int* sm, int tid, int bid, int G) {
    LAS int* pstart = sm; LAS unsigned* hist = (LAS unsigned*)(sm + 80); LAS unsigned* base = (LAS unsigned*)(sm + 160);
    if (tid == 0) { int acc = 0;
#pragma unroll 1
        for (int e = 0; e < 64; ++e) { pstart[e] = acc; acc += ((int)__hip_atomic_load(&cnt[e], __ATOMIC_RELAXED, __HIP_MEMORY_SCOPE_AGENT) + 255) & ~255; } pstart[64] = acc; pstart[65] = acc + T_; }
    __syncthreads();
    const int per = (T_ * 8 + G - 1) / G;
    const int lo = bid * per, hi = (lo + per < T_ * 8) ? lo + per : T_ * 8;
    for (int c0 = lo; c0 < hi; c0 += NTHREADS) {
        if (tid < 64) hist[tid] = 0u;
        __syncthreads();
        const int i = c0 + tid; int e = 0; unsigned local = 0u;
        if (i < hi) { e = ridx[i]; local = atomicAdd((unsigned*)&hist[e], 1u); }
        __syncthreads();
        if (tid < 64) base[tid] = hist[tid] ? atomicAdd(&cur[tid], hist[tid]) : 0u;
        __syncthreads();
        if (i < hi) { const int pos = pstart[e] + (int)base[e] + (int)local; L.tok[pos] = i >> 3; L.dest[pos] = i; L.w[pos] = rwt[i]; }
        __syncthreads();
    }
    for (int e = bid; e < 64; e += G) { const int c = (int)__hip_atomic_load(&cnt[e], __ATOMIC_RELAXED, __HIP_MEMORY_SCOPE_AGENT);
        for (int p = pstart[e] + c + tid; p < pstart[e + 1]; p += NTHREADS) { L.tok[p] = 0; L.dest[p] = -1; L.w[p] = 0.f; } }
    for (int t = bid * NTHREADS + tid; t < T_; t += G * NTHREADS) { const int p = pstart[64] + t; L.tok[p] = t; L.dest[p] = T_ * 8 + t; L.w[p] = 1.f; }
    const int nblk = pstart[65] >> 8;
    for (int b = bid * NTHREADS + tid; b < nblk; b += G * NTHREADS) { int e = 0;
#pragma unroll 1
        while (e < 64 && (pstart[e + 1] >> 8) <= b) ++e;
        L.blk_e[b] = e; }
    if (bid == 0 && tid == 0) L.blk_e[MOE_MAXBLK] = nblk;
    __syncthreads();
}
__device__ __forceinline__ void moe_combine_ln(float* h, const bf16* rows8, const bf16* rows_sh, const float* rwt, const float* lw, const float* lb, bf16* hbf, int gw, int NGW, int lane) {
    int t = gw; if (t >= T_) return;
    v4u rr[2][9]; f32x4 hh[4]; float wk[8];
#define CB_LOAD(tt) do { const size_t _t = (size_t)(tt); \
        _Pragma("unroll") for (int half = 0; half < 2; ++half) { const int c0 = half * 512 + lane * 8; \
            hh[half * 2] = *(const f32x4*)(h + _t * 1024 + c0); hh[half * 2 + 1] = *(const f32x4*)(h + _t * 1024 + c0 + 4); \
            _Pragma("unroll") for (int k = 0; k < 9; ++k) rr[half][k] = *(const v4u*)((k < 8 ? rows8 + (_t * 8 + k) * 1024 : rows_sh + _t * 1024) + c0); } \
        _Pragma("unroll") for (int k = 0; k < 8; ++k) wk[k] = rwt[_t * 8 + k]; } while (0)
    CB_LOAD(t);
    for (; t < T_; t += NGW) {
        float v[16];
#pragma unroll
        for (int half = 0; half < 2; ++half) { const f32x4 a = hh[half * 2], b = hh[half * 2 + 1];
            float s[8] = {a.x * nv::ALPHA, a.y * nv::ALPHA, a.z * nv::ALPHA, a.w * nv::ALPHA, b.x * nv::ALPHA, b.y * nv::ALPHA, b.z * nv::ALPHA, b.w * nv::ALPHA};
#pragma unroll
            for (int k = 0; k < 9; ++k) { const v4u r = rr[half][k]; const float w = k < 8 ? wk[k] : 1.0f;
                s[0] += w * __builtin_bit_cast(float, r.x << 16); s[1] += w * __builtin_bit_cast(float, r.x & 0xffff0000u);
                s[2] += w * __builtin_bit_cast(float, r.y << 16); s[3] += w * __builtin_bit_cast(float, r.y & 0xffff0000u);
                s[4] += w * __builtin_bit_cast(float, r.z << 16); s[5] += w * __builtin_bit_cast(float, r.z & 0xffff0000u);
                s[6] += w * __builtin_bit_cast(float, r.w << 16); s[7] += w * __builtin_bit_cast(float, r.w & 0xffff0000u); }
#pragma unroll
            for (int j = 0; j < 8; ++j) v[half * 8 + j] = s[j]; }
        if (t + NGW < T_) CB_LOAD(t + NGW);
        float sum = 0.f;
#pragma unroll
        for (int j = 0; j < 16; ++j) sum += v[j];
        sum = wave_sum(sum);
        const float mean = sum * (1.f / 1024.f);
        float sq = 0.f;
#pragma unroll
        for (int j = 0; j < 16; ++j) { v[j] -= mean; sq += v[j] * v[j]; }
        sq = wave_sum(sq);
        const float rstd = 1.0f / sqrtf(sq * (1.f / 1024.f) + nv::EPS);
#pragma unroll
        for (int half = 0; half < 2; ++half) { const int c0 = half * 512 + lane * 8;
            const f32x4 w0 = *(const f32x4*)(lw + c0), w1 = *(const f32x4*)(lw + c0 + 4), b0 = *(const f32x4*)(lb + c0), b1 = *(const f32x4*)(lb + c0 + 4);
            f32x4 o0, o1;
            o0.x = v[half * 8 + 0] * rstd * w0.x + b0.x; o0.y = v[half * 8 + 1] * rstd * w0.y + b0.y; o0.z = v[half * 8 + 2] * rstd * w0.z + b0.z; o0.w = v[half * 8 + 3] * rstd * w0.w + b0.w;
            o1.x = v[half * 8 + 4] * rstd * w1.x + b1.x; o1.y = v[half * 8 + 5] * rstd * w1.y + b1.y; o1.z = v[half * 8 + 6] * rstd * w1.z + b1.z; o1.w = v[half * 8 + 7] * rstd * w1.w + b1.w;
            *(f32x4*)(h + (size_t)t * 1024 + c0) = o0; *(f32x4*)(h + (size_t)t * 1024 + c0 + 4) = o1;
            if (hbf) { v4u p; p.x = pk2(o0.x, o0.y); p.y = pk2(o0.z, o0.w); p.z = pk2(o1.x, o1.y); p.w = pk2(o1.z, o1.w); *(v4u*)(hbf + (size_t)t * 1024 + c0) = p; } }
    }
#undef CB_LOAD
}
typedef float f32x16 __attribute__((ext_vector_type(16)));
typedef short s16x8 __attribute__((ext_vector_type(8)));
typedef LAS unsigned short lbf16;
__device__ __forceinline__ void mm32(f32x16& acc, const lbf16* A, int lda, const lbf16* B, int ldb, int K, int lane) {
    const lbf16* ap = A + (lane & 31) * lda + 8 * (lane >> 5);
    const lbf16* bp = B + (lane & 31) * ldb + 8 * (lane >> 5);
#pragma unroll 4
    for (int k = 0; k < K; k += 16) {
        const s16x8 a = *(const LAS s16x8*)(ap + k), b = *(const LAS s16x8*)(bp + k);
        acc = __builtin_amdgcn_mfma_f32_32x32x16_bf16(a, b, acc, 0, 0, 0);
    }
}
__device__ __forceinline__ void mm32_gb(f32x16& acc, const lbf16* A, int lda, const bf16* B, int ldb, int K, int lane) {
    const lbf16* ap = A + (lane & 31) * lda + 8 * (lane >> 5);
    const bf16* bp = B + (size_t)(lane & 31) * ldb + 8 * (lane >> 5);
#pragma unroll 4
    for (int k = 0; k < K; k += 16) {
        const s16x8 a = *(const LAS s16x8*)(ap + k), b = *(const s16x8*)(bp + k);
        acc = __builtin_amdgcn_mfma_f32_32x32x16_bf16(a, b, acc, 0, 0, 0);
    }
}
__device__ __forceinline__ int rowmap(int r, int lane) { return (r & 3) + 8 * (r >> 2) + 4 * (lane >> 5); }
__device__ __forceinline__ float rcp_f(float x) { return __builtin_amdgcn_rcpf(x); }
__device__ __forceinline__ float sigm_f(float x) { return rcp_f(1.0f + __expf(-x)); }
__device__ __forceinline__ float logsig_f(float x) { return fminf(x, 0.f) - __logf(1.0f + __expf(-fabsf(x))); }
__device__ __forceinline__ float softplus_f(float x) { return fmaxf(x, 0.f) + __logf(1.0f + __expf(-fabsf(x))); }
__device__ __forceinline__ float gelu_f(float x) { const float u = 0.7978845608028654f * (x + 0.044715f * x * x * x); return x * rcp_f(1.0f + __expf(-2.0f * u)); }
__device__ __forceinline__ void unpack8(const v4u r, float (&f)[8]) {
    f[0] = __builtin_bit_cast(float, r.x << 16); f[1] = __builtin_bit_cast(float, r.x & 0xffff0000u); f[2] = __builtin_bit_cast(float, r.y << 16); f[3] = __builtin_bit_cast(float, r.y & 0xffff0000u);
    f[4] = __builtin_bit_cast(float, r.z << 16); f[5] = __builtin_bit_cast(float, r.z & 0xffff0000u); f[6] = __builtin_bit_cast(float, r.w << 16); f[7] = __builtin_bit_cast(float, r.w & 0xffff0000u);
}
__device__ __forceinline__ v4u pack8(const float (&f)[8]) { v4u o; o.x = pk2(f[0], f[1]); o.y = pk2(f[2], f[3]); o.z = pk2(f[4], f[5]); o.w = pk2(f[6], f[7]); return o; }

struct Mix0Bufs { const bf16* proj; bf16* ct; float* nloc; float* blast; float* mloc; float* mprev; bf16* hloc; bf16* pc; float* carA; float* carU; float* carI; float* gst; bf16* mixbf; const bf16* lruw; };
constexpr int PJ0 = EINP;
__device__ __forceinline__ float lane_shr(float v, int o, int lane) { return __builtin_bit_cast(float, __builtin_amdgcn_ds_bpermute(((lane - o) & 63) << 2, __builtin_bit_cast(int, v))); }
__device__ __forceinline__ float wave_scan_add(float v, int lane) {
#pragma unroll
    for (int o = 1; o < 64; o <<= 1) { const float t = lane_shr(v, o, lane); v += (lane >= o) ? t : 0.f; }
    return v; }
__device__ __forceinline__ float wave_scan_max(float v, int lane) {
#pragma unroll
    for (int o = 1; o < 64; o <<= 1) { const float t = lane_shr(v, o, lane); v = (lane >= o) ? fmaxf(v, t) : v; }
    return v; }

__device__ __forceinline__ void mlstm_a_item(const Mix0Bufs& B, const float* gate_b, int cn, LAS unsigned char* lds, int tid) {
    const int lane = tid & 63, wave = __builtin_amdgcn_readfirstlane(tid >> 6);
    const int bh = cn / NCH, n = cn % NCH, b = bh >> 2, h = bh & 3;
    const size_t t0 = (size_t)b * S_ + n * 64;
    LAS float* pw = (LAS float*)lds;
    lbf16* kT = (lbf16*)(lds + 1024); lbf16* vT = (lbf16*)(lds + 1024 + 128 * 72 * 2);
    v4u gk[2], gv[2];
#pragma unroll
    for (int it = 0; it < 2; ++it) { const int vi = tid + it * 512, l = vi & 63, g = vi >> 6; const bf16* pr = B.proj + (t0 + l) * PJ0 + h * 128 + g * 8; gk[it] = *(const v4u*)(pr + 512); gv[it] = *(const v4u*)(pr + 1024); }
    if (wave == 0) { const bf16* pr = B.proj + (t0 + lane) * PJ0;
        const float lfv = logsig_f(bf2f(pr[2052 + h]) + gate_b[4 + h]), ig = bf2f(pr[2048 + h]) + gate_b[h];
        const float bcv = wave_scan_add(lfv, lane), wlv = ig - bcv, pmv = wave_scan_max(wlv, lane);
        const float blast = __builtin_bit_cast(float, __builtin_amdgcn_readlane(__builtin_bit_cast(int, bcv), 63)), mx = __builtin_bit_cast(float, __builtin_amdgcn_readlane(__builtin_bit_cast(int, pmv), 63));
        pw[lane] = __expf(wlv - mx) * 0.08838834764831845f;
        float* gs = B.gst + (size_t)cn * 192; gs[lane] = bcv; gs[64 + lane] = wlv; gs[128 + lane] = pmv;
        if (lane == 0) { B.blast[cn] = blast; B.mloc[cn] = blast + mx; } }
    __syncthreads();
#pragma unroll
    for (int it = 0; it < 2; ++it) { const int vi = tid + it * 512, l = vi & 63, g = vi >> 6;
        float kf[8], vf[8]; unpack8(gk[it], kf); unpack8(gv[it], vf);
        const float p = pw[l];
#pragma unroll
        for (int j = 0; j < 8; ++j) { kT[(g * 8 + j) * 72 + l] = (unsigned short)f2bf(kf[j] * p); vT[(g * 8 + j) * 72 + l] = (unsigned short)f2bf(vf[j]); } }
    __syncthreads();
    const int et = wave >> 1;
#pragma unroll
    for (int q = 0; q < 2; ++q) { const int dt = (wave & 1) * 2 + q;
        f32x16 acc = {0.f, 0.f, 0.f, 0.f, 0.f, 0.f, 0.f, 0.f, 0.f, 0.f, 0.f, 0.f, 0.f, 0.f, 0.f, 0.f};
        mm32(acc, kT + dt * 32 * 72, 72, vT + et * 32 * 72, 72, 64, lane);
        bf16* out = B.ct + (size_t)cn * 16384 + (et * 4 + dt) * 1024 + lane * 16;
        v4u o0, o1; o0.x = pk2(acc[0], acc[1]); o0.y = pk2(acc[2], acc[3]); o0.z = pk2(acc[4], acc[5]); o0.w = pk2(acc[6], acc[7]);
        o1.x = pk2(acc[8], acc[9]); o1.y = pk2(acc[10], acc[11]); o1.z = pk2(acc[12], acc[13]); o1.w = pk2(acc[14], acc[15]);
        *(v4u*)out = o0; *(v4u*)(out + 8) = o1; }
    { const int d = tid >> 2, qq = tid & 3; float f0[8], f1[8]; unpack8(*(const LAS v4u*)(kT + d * 72 + qq * 16), f0); unpack8(*(const LAS v4u*)(kT + d * 72 + qq * 16 + 8), f1);
      float sacc = 0.f;
#pragma unroll
      for (int j = 0; j < 8; ++j) sacc += f0[j] + f1[j];
      sacc += __builtin_bit_cast(float, __builtin_amdgcn_ds_swizzle(__builtin_bit_cast(int, sacc), 0x1f | (1 << 10)));
      sacc += __builtin_bit_cast(float, __builtin_amdgcn_ds_swizzle(__builtin_bit_cast(int, sacc), 0x1f | (2 << 10)));
      if (qq == 0) B.nloc[(size_t)cn * 128 + d] = sacc; }
    __syncthreads();
}
constexpr int SB = 32;
__device__ __forceinline__ void mlstm_b(const Mix0Bufs& B, int gtid, int gsz) {
    for (int idx = gtid; idx < 8 * 8192 + 8 * 128; idx += gsz) {
        const bool isn = idx >= 8 * 8192;
        if (!isn) { const int bh = idx >> 13, pe = idx & 8191;
            float s0 = 0.f, s1 = 0.f, m = 0.f; unsigned* p = (unsigned*)B.ct + (size_t)bh * NCH * 8192 + pe;
            for (int n0 = 0; n0 < NCH; n0 += SB) { unsigned cl[SB]; float bl[SB], ml[SB];
#pragma unroll
                for (int j = 0; j < SB; ++j) { cl[j] = p[(size_t)(n0 + j) * 8192]; bl[j] = B.blast[bh * NCH + n0 + j]; ml[j] = B.mloc[bh * NCH + n0 + j]; }
#pragma unroll
                for (int j = 0; j < SB; ++j) { const unsigned out = pk2(s0, s1); const float mn = fmaxf(bl[j] + m, ml[j]), kf = __expf(bl[j] + m - mn), af = __expf(ml[j] - mn);
                    s0 = kf * s0 + af * __builtin_bit_cast(float, cl[j] << 16); s1 = kf * s1 + af * __builtin_bit_cast(float, cl[j] & 0xffff0000u);
                    if (pe == 0) B.mprev[bh * NCH + n0 + j] = m;
                    m = mn; cl[j] = out; }
#pragma unroll
                for (int j = 0; j < SB; ++j) p[(size_t)(n0 + j) * 8192] = cl[j]; }
        } else { const int r = idx - 8 * 8192, bh = r >> 7, de = r & 127;
            float st = 0.f, m = 0.f; float* p = B.nloc + (size_t)bh * NCH * 128 + de;
            for (int n0 = 0; n0 < NCH; n0 += SB) { float cl[SB], bl[SB], ml[SB];
#pragma unroll
                for (int j = 0; j < SB; ++j) { cl[j] = p[(size_t)(n0 + j) * 128]; bl[j] = B.blast[bh * NCH + n0 + j]; ml[j] = B.mloc[bh * NCH + n0 + j]; }
#pragma unroll
                for (int j = 0; j < SB; ++j) { const float out = st; const float mn = fmaxf(bl[j] + m, ml[j]);
                    st = __expf(bl[j] + m - mn) * st + __expf(ml[j] - mn) * cl[j]; m = mn; cl[j] = out; }
#pragma unroll
                for (int j = 0; j < SB; ++j) p[(size_t)(n0 + j) * 128] = cl[j]; } }
    }
}
__device__ __forceinline__ void mlstm_c_item(const Mix0Bufs& B, const float* gate_b, const float* norm_w, int cn, LAS unsigned char* lds, int tid) {
    const int lane = tid & 63, wave = __builtin_amdgcn_readfirstlane(tid >> 6);
    const int bh = cn / NCH, n = cn % NCH, b = bh >> 2, h = bh & 3;
    const size_t t0 = (size_t)b * S_ + n * 64;
    LAS float* bm = (LAS float*)lds; LAS float* wl = bm + 64; LAS float* den = bm + 256; LAS float* emi = bm + 320;
    lbf16* qs = (lbf16*)(lds + 2048); lbf16* ks = (lbf16*)(lds + 19456); lbf16* qw = (lbf16*)(lds + 36864);
    lbf16* vT = (lbf16*)(lds + 54272); lbf16* cT = (lbf16*)(lds + 77312); lbf16* sm = (lbf16*)(lds + 120832);
    LAS float* hb = (LAS float*)(lds + 2048);
    const float mprev = B.mprev[cn];
    const float* gs = B.gst + (size_t)cn * 192;
    v4u gq[2], gk[2], gv[2], go[2], gc[4]; float sb[2], sp[2];
#pragma unroll
    for (int it = 0; it < 2; ++it) { const int vi = tid + it * 512; { const int l = vi >> 4, g = vi & 15; const bf16* pr = B.proj + (t0 + l) * PJ0 + h * 128 + g * 8; gq[it] = *(const v4u*)pr; gk[it] = *(const v4u*)(pr + 512); sb[it] = gs[l]; sp[it] = gs[128 + l]; }
        { const int l = vi & 63, g = vi >> 6; gv[it] = *(const v4u*)(B.proj + (t0 + l) * PJ0 + 1024 + h * 128 + g * 8); } }
    { const bf16* cg = B.ct + (size_t)cn * 16384;
#pragma unroll
      for (int it = 0; it < 4; ++it) gc[it] = *(const v4u*)(cg + (tid + it * 512) * 8); }
    { const int i = tid >> 3, sub = tid & 7; const bf16* op = B.proj + (t0 + i) * PJ0 + 1536 + h * 128 + sub * 16; go[0] = *(const v4u*)op; go[1] = *(const v4u*)(op + 8); }
    const float gnl = tid < 128 ? B.nloc[(size_t)cn * 128 + tid] : 0.f;
    if (wave == 0) { const float bi = gs[lane], wv = gs[64 + lane], pm = gs[128 + lane]; const float m = bi + fmaxf(mprev, pm);
        bm[lane] = bi - m; wl[lane] = wv; emi[lane] = __expf(-m); vT[128 * 72 + lane] = (unsigned short)0x3f80; }
#pragma unroll
    for (int it = 0; it < 2; ++it) { const int vi = tid + it * 512, l = vi >> 4, g = vi & 15;
        float qf[8], kf[8]; unpack8(gq[it], qf); unpack8(gk[it], kf);
        const float w = __expf(mprev - fmaxf(mprev, sp[it])); float qwf[8];
#pragma unroll
        for (int j = 0; j < 8; ++j) { kf[j] *= 0.08838834764831845f; qwf[j] = qf[j] * w; }
        *(LAS v4u*)(qs + l * 136 + g * 8) = gq[it]; *(LAS v4u*)(ks + l * 136 + g * 8) = pack8(kf); *(LAS v4u*)(qw + l * 136 + g * 8) = pack8(qwf); }
#pragma unroll
    for (int it = 0; it < 2; ++it) { const int vi = tid + it * 512, l = vi & 63, g = vi >> 6;
        float vf[8]; unpack8(gv[it], vf);
#pragma unroll
        for (int j = 0; j < 8; ++j) vT[(g * 8 + j) * 72 + l] = (unsigned short)f2bf(vf[j]); }
#pragma unroll
    for (int it = 0; it < 4; ++it) { const int vi = tid + it * 512, T = vi >> 7, ln = (vi >> 1) & 63, hr = vi & 1; const v4u x = gc[it];
        LAS unsigned char* dp = (LAS unsigned char*)(cT + ((T >> 2) * 32 + (ln & 31)) * 136 + (T & 3) * 32 + 16 * hr + 4 * (ln >> 5));
        *(LAS v2u*)dp = (v2u){x.x, x.y}; *(LAS v2u*)(dp + 16) = (v2u){x.z, x.w}; }
    if (tid < 128) cT[128 * 136 + tid] = (unsigned short)f2bf(gnl);
    __syncthreads();
    if (wave < 4) { const int it = wave >> 1, jt = wave & 1;
        f32x16 acc = {0.f, 0.f, 0.f, 0.f, 0.f, 0.f, 0.f, 0.f, 0.f, 0.f, 0.f, 0.f, 0.f, 0.f, 0.f, 0.f};
        if (jt <= it) mm32(acc, ks + jt * 32 * 136, 136, qs + it * 32 * 136, 136, 128, lane);
        const int i = it * 32 + (lane & 31); const float bmi = bm[i];
#pragma unroll
        for (int g4 = 0; g4 < 4; ++g4) { const int j0 = jt * 32 + 8 * g4 + 4 * (lane >> 5); const f32x4 w4 = *(const LAS f32x4*)(wl + j0);
            const float v0 = j0 <= i ? acc[g4 * 4] * __expf(bmi + w4.x) : 0.f, v1 = j0 + 1 <= i ? acc[g4 * 4 + 1] * __expf(bmi + w4.y) : 0.f;
            const float v2 = j0 + 2 <= i ? acc[g4 * 4 + 2] * __expf(bmi + w4.z) : 0.f, v3 = j0 + 3 <= i ? acc[g4 * 4 + 3] * __expf(bmi + w4.w) : 0.f;
            *(LAS v2u*)(sm + i * 72 + j0) = (v2u){pk2(v0, v1), pk2(v2, v3)}; } }
    __syncthreads();
    f32x16 accA = {0.f, 0.f, 0.f, 0.f, 0.f, 0.f, 0.f, 0.f, 0.f, 0.f, 0.f, 0.f, 0.f, 0.f, 0.f, 0.f}, accB = accA;
    { const int id = wave, it = id / 5, nt = id % 5;
      mm32(accA, vT + nt * 32 * 72, 72, sm + it * 32 * 72, 72, 64, lane); mm32(accA, cT + nt * 32 * 136, 136, qw + it * 32 * 136, 136, 128, lane);
      if (nt == 4 && lane < 32) den[it * 32 + lane] = accA[0]; }
    if (wave < 2) { const int id = wave + 8, it = id / 5, nt = id % 5;
      mm32(accB, vT + nt * 32 * 72, 72, sm + it * 32 * 72, 72, 64, lane); mm32(accB, cT + nt * 32 * 136, 136, qw + it * 32 * 136, 136, 128, lane);
      if (nt == 4 && lane < 32) den[it * 32 + lane] = accB[0]; }
    __syncthreads();
    { const int id = wave, it = id / 5, nt = id % 5;
      if (nt < 4) { const int i = it * 32 + (lane & 31); const float rd = rcp_f(fmaxf(fabsf(den[i]), emi[i]));
#pragma unroll
          for (int g4 = 0; g4 < 4; ++g4) *(LAS f32x4*)(hb + i * 132 + nt * 32 + 8 * g4 + 4 * (lane >> 5)) = (f32x4){accA[g4 * 4] * rd, accA[g4 * 4 + 1] * rd, accA[g4 * 4 + 2] * rd, accA[g4 * 4 + 3] * rd}; } }
    if (wave < 2) { const int id = wave + 8, it = id / 5, nt = id % 5;
      if (nt < 4) { const int i = it * 32 + (lane & 31); const float rd = rcp_f(fmaxf(fabsf(den[i]), emi[i]));
#pragma unroll
          for (int g4 = 0; g4 < 4; ++g4) *(LAS f32x4*)(hb + i * 132 + nt * 32 + 8 * g4 + 4 * (lane >> 5)) = (f32x4){accB[g4 * 4] * rd, accB[g4 * 4 + 1] * rd, accB[g4 * 4 + 2] * rd, accB[g4 * 4 + 3] * rd}; } }
    __syncthreads();
    { const int i = tid >> 3, sub = tid & 7; const LAS float* hr = hb + i * 132 + sub * 16;
      float x[16]; float s = 0.f;
#pragma unroll
      for (int j = 0; j < 16; ++j) { x[j] = hr[j]; s += x[j]; }
      s += __builtin_bit_cast(float, __builtin_amdgcn_ds_swizzle(__builtin_bit_cast(int, s), 0x1f | (1 << 10)));
      s += __builtin_bit_cast(float, __builtin_amdgcn_ds_swizzle(__builtin_bit_cast(int, s), 0x1f | (2 << 10)));
      s += __builtin_bit_cast(float, __builtin_amdgcn_ds_swizzle(__builtin_bit_cast(int, s), 0x1f | (4 << 10)));
      const float mean = s * (1.f / 128.f); float q = 0.f;
#pragma unroll
      for (int j = 0; j < 16; ++j) { x[j] -= mean; q += x[j] * x[j]; }
      q += __builtin_bit_cast(float, __builtin_amdgcn_ds_swizzle(__builtin_bit_cast(int, q), 0x1f | (1 << 10)));
      q += __builtin_bit_cast(float, __builtin_amdgcn_ds_swizzle(__builtin_bit_cast(int, q), 0x1f | (2 << 10)));
      q += __builtin_bit_cast(float, __builtin_amdgcn_ds_swizzle(__builtin_bit_cast(int, q), 0x1f | (4 << 10)));
      const float rstd = __builtin_amdgcn_rsqf(q * (1.f / 128.f) + nv::EPS);
      const float* nw = norm_w + h * 128 + sub * 16;
      float o0[8], o1[8]; unpack8(go[0], o0); unpack8(go[1], o1);
      float y0[8], y1[8];
#pragma unroll
      for (int j = 0; j < 8; ++j) { y0[j] = x[j] * rstd * nw[j] * sigm_f(o0[j]); y1[j] = x[8 + j] * rstd * nw[8 + j] * sigm_f(o1[j]); }
      bf16* dst = B.mixbf + (t0 + i) * 1024 + h * 128 + sub * 16;
      *(v4u*)dst = pack8(y0); *(v4u*)(dst + 8) = pack8(y1); }
    __syncthreads();
}
__device__ __forceinline__ void lru_a_item(const Mix0Bufs& B, const float* const* in, int ch, LAS unsigned char* lds, int tid) {
    const int lane = tid & 63, wave = __builtin_amdgcn_readfirstlane(tid >> 6);
    const size_t t0 = (size_t)ch * 64; const int s0 = (ch % NCH) * 64;
    lbf16* xc = (lbf16*)lds; LAS float* al = (LAS float*)(lds + 17408); LAS float* ul = (LAS float*)(lds + 17408 + 32768); LAS float* seg = (LAS float*)(lds + 17408 + 65536);
    const float* cw = in[9]; const float* cb = in[10]; const float* ba = in[12]; const float* bx = in[14]; const float* lam = in[15];
    for (int hh = 0; hh < 4; ++hh) {
        const int it = wave & 1, nt = wave >> 1;
        s16x8 wr[8], wx[8];
        { const bf16* bp = B.lruw + (size_t)(hh * 128 + nt * 32 + (lane & 31)) * 128 + 8 * (lane >> 5);
#pragma unroll
          for (int k = 0; k < 8; ++k) { wr[k] = *(const s16x8*)(bp + k * 16); wx[k] = *(const s16x8*)(bp + (size_t)512 * 128 + k * 16); } }
        { const int g = tid & 15, lr = tid >> 4, c0 = hh * 128 + g * 8;
          float xf[5][8];
#pragma unroll
          for (int k = 0; k < 5; ++k) { const int l = 2 * lr - 3 + k; v4u x = {0u, 0u, 0u, 0u}; if (s0 + l >= 0) x = *(const v4u*)(B.proj + (t0 + l) * PJ0 + 2056 + c0); unpack8(x, xf[k]); }
          float a0[8], a1[8];
#pragma unroll
          for (int j = 0; j < 8; ++j) { a0[j] = cb[c0 + j]; a1[j] = a0[j]; }
#pragma unroll
          for (int tap = 0; tap < 4; ++tap) {
#pragma unroll
              for (int j = 0; j < 8; ++j) { const float w = cw[tap * 512 + c0 + j]; a0[j] += w * xf[tap][j]; a1[j] += w * xf[tap + 1][j]; } }
          *(LAS v4u*)(xc + (2 * lr) * 136 + g * 8) = pack8(a0); *(LAS v4u*)(xc + (2 * lr + 1) * 136 + g * 8) = pack8(a1);
          *(LAS f32x4*)(ul + (2 * lr) * 128 + g * 8) = (f32x4){a0[0], a0[1], a0[2], a0[3]}; *(LAS f32x4*)(ul + (2 * lr) * 128 + g * 8 + 4) = (f32x4){a0[4], a0[5], a0[6], a0[7]};
          *(LAS f32x4*)(ul + (2 * lr + 1) * 128 + g * 8) = (f32x4){a1[0], a1[1], a1[2], a1[3]}; *(LAS f32x4*)(ul + (2 * lr + 1) * 128 + g * 8 + 4) = (f32x4){a1[4], a1[5], a1[6], a1[7]}; }
        __syncthreads();
        { f32x16 ra = {0.f, 0.f, 0.f, 0.f, 0.f, 0.f, 0.f, 0.f, 0.f, 0.f, 0.f, 0.f, 0.f, 0.f, 0.f, 0.f}, xa = ra;
          const lbf16* ap = xc + (it * 32 + (lane & 31)) * 136 + 8 * (lane >> 5);
#pragma unroll
          for (int k = 0; k < 8; ++k) { const s16x8 a = *(const LAS s16x8*)(ap + k * 16);
              ra = __builtin_amdgcn_mfma_f32_32x32x16_bf16(a, wr[k], ra, 0, 0, 0); xa = __builtin_amdgcn_mfma_f32_32x32x16_bf16(a, wx[k], xa, 0, 0, 0); }
          const int c = nt * 32 + (lane & 31), cg = hh * 128 + c; const float bav = ba[cg], bxv = bx[cg], sp = softplus_f(-lam[cg]);
#pragma unroll
          for (int r = 0; r < 16; ++r) { const int l = it * 32 + rowmap(r, lane);
              const float rr = sigm_f(ra[r] + bav), ii = sigm_f(xa[r] + bxv), la = -8.0f * rr * sp;
              const float xv = ul[l * 128 + c];
              al[l * 128 + c] = __expf(la); ul[l * 128 + c] = __builtin_amdgcn_sqrtf(1.0f - __expf(2.0f * la)) * ii * xv; } }
        __syncthreads();
        { const int cp = tid & 63, sg = wave;
          float h0 = 0.f, h1 = 0.f, P0 = 1.f, P1 = 1.f; float hl0[8], hl1[8], Pl0[8], Pl1[8];
#pragma unroll
          for (int t = 0; t < 8; ++t) { const hwf2_t a2 = *(const LAS hwf2_t*)(al + (sg * 8 + t) * 128 + 2 * cp), u2 = *(const LAS hwf2_t*)(ul + (sg * 8 + t) * 128 + 2 * cp);
              h0 = a2.x * h0 + u2.x; h1 = a2.y * h1 + u2.y; P0 *= a2.x; P1 *= a2.y; hl0[t] = h0; hl1[t] = h1; Pl0[t] = P0; Pl1[t] = P1; }
          *(LAS f32x4*)(seg + (sg * 128 + 2 * cp) * 2) = (f32x4){P0, h0, P1, h1};
          __syncthreads();
          float Pi0 = 1.f, Pi1 = 1.f, hi0 = 0.f, hi1 = 0.f;
          for (int q = 0; q < sg; ++q) { const f32x4 e = *(const LAS f32x4*)(seg + (q * 128 + 2 * cp) * 2); hi0 = e.x * hi0 + e.y; hi1 = e.z * hi1 + e.w; Pi0 *= e.x; Pi1 *= e.z; }
          bf16* hp = B.hloc + (t0 + sg * 8) * 512 + hh * 128 + 2 * cp; bf16* pp = B.pc + (t0 + sg * 8) * 512 + hh * 128 + 2 * cp;
#pragma unroll
          for (int t = 0; t < 8; ++t) { *(unsigned*)(hp + (size_t)t * 512) = pk2(hl0[t] + Pl0[t] * hi0, hl1[t] + Pl1[t] * hi1); *(unsigned*)(pp + (size_t)t * 512) = pk2(Pl0[t] * Pi0, Pl1[t] * Pi1); }
          if (sg == 7) { float2 ca, cu; ca.x = Pl0[7] * Pi0; ca.y = Pl1[7] * Pi1; cu.x = hl0[7] + Pl0[7] * hi0; cu.y = hl1[7] + Pl1[7] * hi1;
              *(float2*)(B.carA + (size_t)ch * 512 + hh * 128 + 2 * cp) = ca; *(float2*)(B.carU + (size_t)ch * 512 + hh * 128 + 2 * cp) = cu; } }
    }
    __syncthreads();
}
__device__ __forceinline__ void lru_b(const Mix0Bufs& B, int gtid, int gsz) {
    for (int idx = gsz - 1 - gtid; idx < 2 * 512; idx += gsz)   { const int b = idx >> 9, c = idx & 511; float hst = 0.f;
        for (int n0 = 0; n0 < NCH; n0 += SB) { float a[SB], u[SB];
#pragma unroll
            for (int j = 0; j < SB; ++j) { const size_t o = (size_t)(b * NCH + n0 + j) * 512 + c; a[j] = B.carA[o]; u[j] = B.carU[o]; }
#pragma unroll
            for (int j = 0; j < SB; ++j) { const float in = hst; hst = a[j] * hst + u[j]; a[j] = in; }
#pragma unroll
            for (int j = 0; j < SB; ++j) B.carI[(size_t)(b * NCH + n0 + j) * 512 + c] = a[j]; } }
}
__device__ __forceinline__ void lru_c(const Mix0Bufs& B, int gtid, int gsz) {
    for (int idx = gtid; idx < T_ * 64; idx += gsz) { const size_t t = idx >> 6; const int c0 = (idx & 63) * 8; const size_t ch = t >> 6;
        float gb[8], y[8]; unpack8(*(const v4u*)(B.proj + t * PJ0 + 2568 + c0), gb);
        float hp[8], pp[8]; unpack8(*(const v4u*)(B.hloc + t * 512 + c0), hp); unpack8(*(const v4u*)(B.pc + t * 512 + c0), pp); const float* ci = B.carI + ch * 512 + c0;
#pragma unroll
        for (int j = 0; j < 8; ++j) y[j] = (hp[j] + pp[j] * ci[j]) * gelu_f(gb[j]);
        *(v4u*)(B.mixbf + t * 1024 + 512 + c0) = pack8(y); }
}
constexpr int PJ1 = OINP;
struct Mix1Bufs { const bf16* proj; bf16* ut; float* gbl; bf16* s5g; float* xend; float* xstart; float* s5ab; float* s5bb; bf16* cm; bf16* bbt; bf16* mixbf; };
__device__ __forceinline__ void gla_gates(const bf16* proj, const float* gw, const float* gb, size_t t0, int h, LAS float* bc, LAS float* gl, LAS float* tot, int tid) {
    const int d = tid & 63, lg = __builtin_amdgcn_readfirstlane(tid >> 6);
    if (tid < 128) { const int l = tid >> 1, hf = tid & 1; float f[8]; unpack8(*(const v4u*)(proj + (t0 + l) * PJ1 + 2048 + hf * 8), f);
        *(LAS f32x4*)(gl + l * 16 + hf * 8) = (f32x4){f[0], f[1], f[2], f[3]}; *(LAS f32x4*)(gl + l * 16 + hf * 8 + 4) = (f32x4){f[4], f[5], f[6], f[7]}; }
    float w[16];
#pragma unroll
    for (int r = 0; r < 16; ++r) w[r] = gw[r * 256 + h * 64 + d];
    const float bias = gb[h * 64 + d];
    __syncthreads();
    float v[8];
#pragma unroll
    for (int q = 0; q < 8; ++q) { const int l = lg * 8 + q; float acc = bias;
#pragma unroll
        for (int r4 = 0; r4 < 4; ++r4) { const f32x4 g4 = *(const LAS f32x4*)(gl + l * 16 + r4 * 4); acc += g4.x * w[r4 * 4] + g4.y * w[r4 * 4 + 1] + g4.z * w[r4 * 4 + 2] + g4.w * w[r4 * 4 + 3]; }
        v[q] = logsig_f(acc) * 0.0625f; }
#pragma unroll
    for (int q = 1; q < 8; ++q) v[q] += v[q - 1];
    tot[lg * 64 + d] = v[7];
    __syncthreads();
    float pre = 0.f;
#pragma unroll
    for (int s = 0; s < 7; ++s) { const float t = tot[s * 64 + d]; pre += (s < lg) ? t : 0.f; }
#pragma unroll
    for (int q = 0; q < 8; ++q) bc[(lg * 8 + q) * 64 + d] = v[q] + pre;
    __syncthreads();
}
__device__ __forceinline__ void gla_a_item(const Mix1Bufs& B, const float* gw, const float* gb, int cn, LAS unsigned char* lds, int tid) {
    const int lane = tid & 63, wave = __builtin_amdgcn_readfirstlane(tid >> 6);
    const int bh = cn / NCH, n = cn % NCH, b = bh >> 2, h = bh & 3;
    const size_t t0 = (size_t)b * S_ + n * 64;
    LAS float* bc = (LAS float*)lds; LAS float* gl = (LAS float*)(lds + 16384); LAS float* tot = (LAS float*)(lds + 118784);
    lbf16* kT = (lbf16*)(lds + 20480); lbf16* vT = (lbf16*)(lds + 20480 + 64 * 72 * 2);
    v4u gk, gv[2];
    { const int l = tid & 63, g = tid >> 6; gk = *(const v4u*)(B.proj + (t0 + l) * PJ1 + 768 + h * 64 + g * 8); }
#pragma unroll
    for (int it = 0; it < 2; ++it) { const int vi = tid + it * 512, l = vi & 63, g = vi >> 6; gv[it] = *(const v4u*)(B.proj + (t0 + l) * PJ1 + 1024 + h * 128 + g * 8); }
    gla_gates(B.proj, gw, gb, t0, h, bc, gl, tot, tid);
    { const int l = tid & 63, g = tid >> 6; float kf[8]; unpack8(gk, kf);
#pragma unroll
      for (int j = 0; j < 8; ++j) { const int d = g * 8 + j; kT[d * 72 + l] = (unsigned short)f2bf(kf[j] * __expf(bc[63 * 64 + d] - bc[l * 64 + d])); } }
#pragma unroll
    for (int it = 0; it < 2; ++it) { const int vi = tid + it * 512, l = vi & 63, g = vi >> 6; float vf[8]; unpack8(gv[it], vf);
#pragma unroll
        for (int j = 0; j < 8; ++j) vT[(g * 8 + j) * 72 + l] = (unsigned short)f2bf(vf[j]); }
    __syncthreads();
    { const int et = wave >> 1, dt = wave & 1;
      f32x16 acc = {0.f, 0.f, 0.f, 0.f, 0.f, 0.f, 0.f, 0.f, 0.f, 0.f, 0.f, 0.f, 0.f, 0.f, 0.f, 0.f};
      mm32(acc, kT + dt * 32 * 72, 72, vT + et * 32 * 72, 72, 64, lane);
      bf16* out = B.ut + (size_t)cn * 8192 + (et * 2 + dt) * 1024 + lane * 16;
      v4u o0, o1; o0.x = pk2(acc[0], acc[1]); o0.y = pk2(acc[2], acc[3]); o0.z = pk2(acc[4], acc[5]); o0.w = pk2(acc[6], acc[7]);
      o1.x = pk2(acc[8], acc[9]); o1.y = pk2(acc[10], acc[11]); o1.z = pk2(acc[12], acc[13]); o1.w = pk2(acc[14], acc[15]);
      *(v4u*)out = o0; *(v4u*)(out + 8) = o1; }
    if (tid < 64) B.gbl[(size_t)cn * 64 + tid] = bc[63 * 64 + tid];
    __syncthreads();
}
__device__ __forceinline__ void gla_b(const Mix1Bufs& B, int gtid, int gsz) {
    for (int idx = gtid; idx < 8 * 4096; idx += gsz) { const int bh = idx >> 12, pe = idx & 4095, d = ((pe >> 9) & 1) * 32 + ((pe * 2) & 3) + 8 * ((pe >> 1) & 3) + 4 * ((pe >> 8) & 1); float s0 = 0.f, s1 = 0.f;
        unsigned* p = (unsigned*)B.ut + (size_t)bh * NCH * 4096 + pe; const float* gp = B.gbl + (size_t)bh * NCH * 64 + d;
        for (int n0 = 0; n0 < NCH; n0 += SB) { unsigned u[SB]; float g0[SB], g1[SB];
#pragma unroll
            for (int j = 0; j < SB; ++j) { u[j] = p[(size_t)(n0 + j) * 4096]; g0[j] = gp[(n0 + j) * 64]; g1[j] = gp[(n0 + j) * 64 + 1]; }
#pragma unroll
            for (int j = 0; j < SB; ++j) { const unsigned out = pk2(s0, s1);
                s0 = __expf(g0[j]) * s0 + __builtin_bit_cast(float, u[j] << 16); s1 = __expf(g1[j]) * s1 + __builtin_bit_cast(float, u[j] & 0xffff0000u); u[j] = out; }
#pragma unroll
            for (int j = 0; j < SB; ++j) p[(size_t)(n0 + j) * 4096] = u[j]; } }
}
__device__ __forceinline__ void gla_c_item(const Mix1Bufs& B, const float* gw, const float* gb, const float* norm_w, int cn, LAS unsigned char* lds, int tid) {
    const int lane = tid & 63, wave = __builtin_amdgcn_readfirstlane(tid >> 6);
    const int bh = cn / NCH, n = cn % NCH, b = bh >> 2, h = bh & 3;
    const size_t t0 = (size_t)b * S_ + n * 64;
    LAS float* bc = (LAS float*)lds; LAS float* gl = (LAS float*)(lds + 16384);
    lbf16* qd = (lbf16*)(lds + 20480); lbf16* ki = (lbf16*)(lds + 29696); lbf16* vT = (lbf16*)(lds + 38912); lbf16* sT = (lbf16*)(lds + 57344); lbf16* att = (lbf16*)(lds + 75776);
    LAS float* ob = (LAS float*)(lds + 84992); LAS float* tot = (LAS float*)(lds + 118784);
    gla_gates(B.proj, gw, gb, t0, h, bc, gl, tot, tid);
    { const int l = tid >> 3, g = tid & 7; const bf16* pr = B.proj + (t0 + l) * PJ1 + h * 64 + g * 8; float qf[8], kf[8]; unpack8(*(const v4u*)(pr + 512), qf); unpack8(*(const v4u*)(pr + 768), kf);
#pragma unroll
      for (int j = 0; j < 8; ++j) { const float bb = bc[l * 64 + g * 8 + j]; qf[j] *= 0.125f * __expf(bb); kf[j] *= __expf(-bb); }
      *(LAS v4u*)(qd + l * 72 + g * 8) = pack8(qf); *(LAS v4u*)(ki + l * 72 + g * 8) = pack8(kf); }
#pragma unroll
    for (int it = 0; it < 2; ++it) { const int vi = tid + it * 512, l = vi & 63, g = vi >> 6; float vf[8]; unpack8(*(const v4u*)(B.proj + (t0 + l) * PJ1 + 1024 + h * 128 + g * 8), vf);
#pragma unroll
        for (int j = 0; j < 8; ++j) vT[(g * 8 + j) * 72 + l] = (unsigned short)f2bf(vf[j]); }
    { const bf16* sg = B.ut + (size_t)cn * 8192;
#pragma unroll
      for (int it = 0; it < 2; ++it) { const int vi = tid + it * 512, T = vi >> 7, ln = (vi >> 1) & 63, hr = vi & 1; const v4u x = *(const v4u*)(sg + vi * 8);
          LAS unsigned char* dp = (LAS unsigned char*)(sT + ((T >> 1) * 32 + (ln & 31)) * 72 + (T & 1) * 32 + 16 * hr + 4 * (ln >> 5));
          *(LAS v2u*)dp = (v2u){x.x, x.y}; *(LAS v2u*)(dp + 16) = (v2u){x.z, x.w}; } }
    __syncthreads();
    if (wave < 4) { const int it = wave >> 1, jt = wave & 1;
        f32x16 acc = {0.f, 0.f, 0.f, 0.f, 0.f, 0.f, 0.f, 0.f, 0.f, 0.f, 0.f, 0.f, 0.f, 0.f, 0.f, 0.f};
        if (jt <= it) mm32(acc, ki + jt * 32 * 72, 72, qd + it * 32 * 72, 72, 64, lane);
        const int i = it * 32 + (lane & 31);
#pragma unroll
        for (int g4 = 0; g4 < 4; ++g4) { const int j0 = jt * 32 + 8 * g4 + 4 * (lane >> 5);
            v2u o; o.x = pk2(j0 <= i ? acc[g4 * 4] : 0.f, j0 + 1 <= i ? acc[g4 * 4 + 1] : 0.f); o.y = pk2(j0 + 2 <= i ? acc[g4 * 4 + 2] : 0.f, j0 + 3 <= i ? acc[g4 * 4 + 3] : 0.f);
            *(LAS v2u*)(att + i * 72 + j0) = o; } }
    __syncthreads();
    { const int it = wave >> 2, nt = wave & 3;
      f32x16 acc = {0.f, 0.f, 0.f, 0.f, 0.f, 0.f, 0.f, 0.f, 0.f, 0.f, 0.f, 0.f, 0.f, 0.f, 0.f, 0.f};
      mm32(acc, vT + nt * 32 * 72, 72, att + it * 32 * 72, 72, 64, lane); mm32(acc, sT + nt * 32 * 72, 72, qd + it * 32 * 72, 72, 64, lane);
#pragma unroll
      for (int g4 = 0; g4 < 4; ++g4) *(LAS f32x4*)(ob + (it * 32 + (lane & 31)) * 132 + nt * 32 + 8 * g4 + 4 * (lane >> 5)) = (f32x4){acc[g4 * 4], acc[g4 * 4 + 1], acc[g4 * 4 + 2], acc[g4 * 4 + 3]}; }
    __syncthreads();
    { const int i = tid >> 3, sub = tid & 7; const LAS float* hr = ob + i * 132 + sub * 16;
      float x[16]; float q = 0.f;
#pragma unroll
      for (int j = 0; j < 16; ++j) { x[j] = hr[j]; q += x[j] * x[j]; }
      q += __builtin_bit_cast(float, __builtin_amdgcn_ds_swizzle(__builtin_bit_cast(int, q), 0x1f | (1 << 10)));
      q += __builtin_bit_cast(float, __builtin_amdgcn_ds_swizzle(__builtin_bit_cast(int, q), 0x1f | (2 << 10)));
      q += __builtin_bit_cast(float, __builtin_amdgcn_ds_swizzle(__builtin_bit_cast(int, q), 0x1f | (4 << 10)));
      const float rstd = __builtin_amdgcn_rsqf(q * (1.f / 128.f) + nv::EPS);
      const bf16* rp = B.proj + (t0 + i) * PJ1 + 1536 + h * 128 + sub * 16; const float* nw = norm_w + h * 128 + sub * 16;
      float r0[8], r1[8]; unpack8(*(const v4u*)rp, r0); unpack8(*(const v4u*)(rp + 8), r1);
      float y0[8], y1[8];
#pragma unroll
      for (int j = 0; j < 8; ++j) { y0[j] = x[j] * rstd * nw[j] * r0[j] * sigm_f(r0[j]); y1[j] = x[8 + j] * rstd * nw[8 + j] * r1[j] * sigm_f(r1[j]); }
      bf16* dst = B.mixbf + (t0 + i) * 1024 + 512 + h * 128 + sub * 16;
      *(v4u*)dst = pack8(y0); *(v4u*)(dst + 8) = pack8(y1); }
    __syncthreads();
}
__device__ __forceinline__ void s5_params(const Mix1Bufs& B, const float* const* in, int gtid, int gsz) {

    for (int idx = gtid; idx < 2048; idx += gsz) { const int g = idx >> 6;
        const float lr = in[17][idx], li = in[18][idx], dt = expf(in[24][g]);
        const float mag = expf(lr * dt), ar = mag * cosf(li * dt), ai = mag * sinf(li * dt);
        const float den = lr * lr + li * li, nr = ar - 1.0f, cr = (nr * lr + ai * li) / den, ci = (ai * lr - nr * li) / den;
        B.s5ab[idx * 2] = ar; B.s5ab[idx * 2 + 1] = ai;
        for (int h = 0; h < 16; ++h) { const float br = in[19][idx * 16 + h], bi = in[20][idx * 16 + h]; B.s5bb[idx * 32 + h] = cr * br - ci * bi; B.s5bb[idx * 32 + 16 + h] = cr * bi + ci * br; } }
    for (int idx = gtid; idx < 32 * 128 * 16; idx += gsz) { const int h = idx & 15, j = (idx >> 4) & 127, g = idx >> 11; const int gp = g * 64 + (j & 63);
        const float lr = in[17][gp], li = in[18][gp], dt = expf(in[24][g]);
        const float mag = expf(lr * dt), ar = mag * cosf(li * dt), ai = mag * sinf(li * dt);
        const float den = lr * lr + li * li, nr = ar - 1.0f, cr = (nr * lr + ai * li) / den, ci = (ai * lr - nr * li) / den;
        const float br = in[19][gp * 16 + h], bi = in[20][gp * 16 + h];
        B.bbt[idx] = (unsigned short)f2bf(j < 64 ? cr * br - ci * bi : cr * bi + ci * br); }
    for (int idx = gtid; idx < 32 * 32 * 128; idx += gsz) { const int k = idx & 127, hh = (idx >> 7) & 31, g = idx >> 12;
        float v = 0.f; if (hh < 16) v = k < 64 ? in[21][(g * 16 + hh) * 64 + k] : -in[22][(g * 16 + hh) * 64 + k - 64];
        B.cm[idx] = (unsigned short)f2bf(v); }
}
template <bool OUT> __device__ __forceinline__ void s5_chunk_v2(const Mix1Bufs& B, const float* dskip, int item, bool valid, LAS unsigned char* wl, int lane) {
    if (!valid) item = 0;
    const int n = item % NCH, g = (item / NCH) & 31, b = item / (NCH * 32);
    const size_t t0 = (size_t)b * S_ + n * 64; const int gp = g * 64 + lane;
    LAS float* bu = (LAS float*)wl;
    lbf16* xs = (lbf16*)(wl + 8192);
    const float ar = B.s5ab[gp * 2], ai = B.s5ab[gp * 2 + 1];
    float xr = 0.f, xi = 0.f;
    if (OUT) { xr = B.xstart[((size_t)item * 64 + lane) * 2]; xi = B.xstart[((size_t)item * 64 + lane) * 2 + 1]; }
    const bf16* bbt = B.bbt + (size_t)g * 2048 + (lane & 31) * 16 + 8 * (lane >> 5);
    for (int half = 0; half < 2; ++half) {
        const s16x8 a = *(const s16x8*)(B.proj + (t0 + half * 32 + (lane & 31)) * PJ1 + g * 16 + 8 * (lane >> 5));
        f32x16 acc[4];
#pragma unroll
        for (int nt = 0; nt < 4; ++nt) { const s16x8 bf = *(const s16x8*)(bbt + nt * 512);
            const f32x16 z = {0.f, 0.f, 0.f, 0.f, 0.f, 0.f, 0.f, 0.f, 0.f, 0.f, 0.f, 0.f, 0.f, 0.f, 0.f, 0.f};
            acc[nt] = __builtin_amdgcn_mfma_f32_32x32x16_bf16(a, bf, z, 0, 0, 0); }
#pragma unroll
        for (int q = 0; q < 2; ++q) {
#pragma unroll
            for (int nt = 0; nt < 4; ++nt)
#pragma unroll
                for (int rr = 0; rr < 8; ++rr) bu[((rr & 3) + 8 * (rr >> 2) + 4 * (lane >> 5)) * 128 + nt * 32 + (lane & 31)] = acc[nt][q * 8 + rr];
            __syncthreads();
#pragma unroll 4
            for (int l = 0; l < 16; ++l) { const float sr = bu[l * 128 + lane], si = bu[l * 128 + 64 + lane];
                const float nr = ar * xr - ai * xi + sr, ni = ar * xi + ai * xr + si; xr = nr; xi = ni;
                if (OUT) { xs[(q * 16 + l) * 136 + lane] = (unsigned short)f2bf(xr); xs[(q * 16 + l) * 136 + 64 + lane] = (unsigned short)f2bf(xi); } }
            __syncthreads();
        }
        if (OUT) {
            f32x16 acc2 = {0.f, 0.f, 0.f, 0.f, 0.f, 0.f, 0.f, 0.f, 0.f, 0.f, 0.f, 0.f, 0.f, 0.f, 0.f, 0.f};
            mm32_gb(acc2, xs, 136, B.cm + (size_t)g * 32 * 128, 128, 128, lane);
            const int hh = lane & 31;
            if (hh < 16 && valid) { const float dk = dskip[g * 16 + hh];
#pragma unroll
                for (int r = 0; r < 16; ++r) { const size_t t = t0 + half * 32 + rowmap(r, lane);
                    B.s5g[t * 512 + g * 16 + hh] = (unsigned short)f2bf(gelu_f(acc2[r] + dk * bf2f(B.proj[t * PJ1 + g * 16 + hh]))); } }
            __syncthreads();
        }
    }
    if (!OUT && valid) { B.xend[((size_t)item * 64 + lane) * 2] = xr; B.xend[((size_t)item * 64 + lane) * 2 + 1] = xi; }
}
template <bool OUT> __device__ __forceinline__ void s5_phase(const Mix1Bufs& B, const float* dskip, int gw, int NGW, LAS unsigned char* wl, int lane) {
    const int wpg = NGW >> 5, g_ = gw / wpg, j0 = gw - g_ * wpg; const bool gvalid = g_ < 32; const int g = gvalid ? g_ : 0;
    const int nit = (2 * NCH + wpg - 1) / wpg;
    const float ar = B.s5ab[(g * 64 + lane) * 2], ai = B.s5ab[(g * 64 + lane) * 2 + 1];
    s16x8 bf[4]; { const bf16* bbt = B.bbt + (size_t)g * 2048 + (lane & 31) * 16 + 8 * (lane >> 5);
#pragma unroll
        for (int nt = 0; nt < 4; ++nt) bf[nt] = *(const s16x8*)(bbt + nt * 512); }
    s16x8 cf[4]; float dk[4];
    if (OUT) { const bf16* cm = B.cm + (size_t)g * 32 * 128 + (lane & 15) * 128 + 8 * (lane >> 4);
#pragma unroll
        for (int ks = 0; ks < 4; ++ks) cf[ks] = *(const s16x8*)(cm + ks * 32);
#pragma unroll
        for (int r = 0; r < 4; ++r) dk[r] = dskip[g * 16 + 4 * (lane >> 4) + r]; }
    s16x8 na[2]; v2u nu[2][2]; float nxr = 0.f, nxi = 0.f;
#define S5_LOAD(kk) do { const int _i = j0 + (kk) * wpg; const int _idx = (gvalid && _i < 2 * NCH) ? _i : 0; const int _b = _idx / NCH, _n = _idx % NCH; const size_t _t0 = (size_t)_b * S_ + _n * 64; \
        const bf16* _p = B.proj + (_t0 + (lane & 31)) * PJ1 + g * 16 + 8 * (lane >> 5); na[0] = *(const s16x8*)_p; na[1] = *(const s16x8*)(_p + (size_t)32 * PJ1); \
        if (OUT) { const size_t _it = (size_t)(_b * 32 + g) * NCH + _n; const float2 _x = *(const float2*)(B.xstart + (_it * 64 + lane) * 2); nxr = _x.x; nxi = _x.y; \
            const bf16* _q = B.proj + (_t0 + (lane & 15)) * PJ1 + g * 16 + 4 * (lane >> 4); _Pragma("unroll") for (int _h = 0; _h < 2; ++_h) _Pragma("unroll") for (int _t = 0; _t < 2; ++_t) nu[_h][_t] = *(const v2u*)(_q + (size_t)(_h * 32 + _t * 16) * PJ1); } } while (0)
    S5_LOAD(0);
    for (int k = 0; k < nit; ++k) {
        const int i_ = j0 + k * wpg; const bool valid = gvalid && i_ < 2 * NCH; const int idx = valid ? i_ : 0; const int b = idx / NCH, n = idx % NCH;
        const size_t t0 = (size_t)b * S_ + n * 64; const size_t item = (size_t)(b * 32 + g) * NCH + n;
        s16x8 a[2] = {na[0], na[1]}; v2u uu[2][2] = {{nu[0][0], nu[0][1]}, {nu[1][0], nu[1][1]}}; float xr = OUT ? nxr : 0.f, xi = OUT ? nxi : 0.f;
        if (k + 1 < nit) S5_LOAD(k + 1);
#pragma unroll
        for (int half = 0; half < 2; ++half) {
            f32x16 acc[4];
#pragma unroll
            for (int nt = 0; nt < 4; ++nt) { const f32x16 z = {0.f, 0.f, 0.f, 0.f, 0.f, 0.f, 0.f, 0.f, 0.f, 0.f, 0.f, 0.f, 0.f, 0.f, 0.f, 0.f};
                acc[nt] = __builtin_amdgcn_mfma_f32_32x32x16_bf16(a[half], bf[nt], z, 0, 0, 0); }
            float sre[2][16], sim[2][16];
#pragma unroll
            for (int r = 0; r < 16; ++r) {
                { auto w = __builtin_amdgcn_permlane32_swap(__float_as_uint(acc[0][r]), __float_as_uint(acc[1][r]), false, false); sre[0][r] = __uint_as_float(w[0]); sre[1][r] = __uint_as_float(w[1]); }
                { auto w = __builtin_amdgcn_permlane32_swap(__float_as_uint(acc[2][r]), __float_as_uint(acc[3][r]), false, false); sim[0][r] = __uint_as_float(w[0]); sim[1][r] = __uint_as_float(w[1]); } }
            lbf16* xs = (lbf16*)(wl + half * 8704);
#pragma unroll
            for (int q = 0; q < 4; ++q)
#pragma unroll
                for (int wch = 0; wch < 2; ++wch)
#pragma unroll
                    for (int i = 0; i < 4; ++i) { const int r = q * 4 + i, tok = q * 8 + wch * 4 + i;
                        const float sr = sre[wch][r], si = sim[wch][r];
                        const float nr = ar * xr - ai * xi + sr, ni = ar * xi + ai * xr + si; xr = nr; xi = ni;
                        if (OUT) { xs[tok * 136 + lane] = (unsigned short)f2bf(xr); xs[tok * 136 + 64 + lane] = (unsigned short)f2bf(xi); } }
            if (OUT) {
                __syncthreads();
#pragma unroll
                for (int tt = 0; tt < 2; ++tt) { f32x4 y = {0.f, 0.f, 0.f, 0.f};
                    const lbf16* xp = xs + (tt * 16 + (lane & 15)) * 136 + 8 * (lane >> 4);
#pragma unroll
                    for (int ks = 0; ks < 4; ++ks) y = __builtin_amdgcn_mfma_f32_16x16x32_bf16(cf[ks], *(const LAS s16x8*)(xp + ks * 32), y, 0, 0, 0);
                    const v2u u = uu[half][tt];
                    const float u0 = __builtin_bit_cast(float, u.x << 16), u1 = __builtin_bit_cast(float, u.x & 0xffff0000u), u2 = __builtin_bit_cast(float, u.y << 16), u3 = __builtin_bit_cast(float, u.y & 0xffff0000u);
                    v2u o; o.x = pk2(gelu_f(y[0] + dk[0] * u0), gelu_f(y[1] + dk[1] * u1)); o.y = pk2(gelu_f(y[2] + dk[2] * u2), gelu_f(y[3] + dk[3] * u3));
                    if (valid) *(v2u*)(B.s5g + (t0 + half * 32 + tt * 16 + (lane & 15)) * 512 + g * 16 + 4 * (lane >> 4)) = o; }
            }
        }
        if (!OUT && valid) { float2 o; o.x = xr; o.y = xi; *(float2*)(B.xend + (item * 64 + lane) * 2) = o; }
    }
#undef S5_LOAD
}
__device__ __forceinline__ void s5_b(const Mix1Bufs& B, int gtid, int gsz) {
    for (int idx = gsz - 1 - gtid; idx < 2 * 2048; idx += gsz)   { const int b = idx >> 11, gp = idx & 2047, g = gp >> 6, p = gp & 63;
        float ar = B.s5ab[gp * 2], ai = B.s5ab[gp * 2 + 1];
#pragma unroll
        for (int q = 0; q < 6; ++q) { const float r2 = ar * ar - ai * ai, i2 = 2.f * ar * ai; ar = r2; ai = i2; }
        float xr = 0.f, xi = 0.f;
        const size_t o0 = ((size_t)((b * 32 + g) * NCH) * 64 + p) * 2;
        for (int n0 = 0; n0 < NCH; n0 += SB) { float er[SB], ei[SB];
#pragma unroll
            for (int j = 0; j < SB; ++j) { const size_t o = o0 + (size_t)(n0 + j) * 128; er[j] = B.xend[o]; ei[j] = B.xend[o + 1]; }
#pragma unroll
            for (int j = 0; j < SB; ++j) { const float sr = xr, si = xi; const float nr = ar * xr - ai * xi + er[j], ni = ar * xi + ai * xr + ei[j]; xr = nr; xi = ni; er[j] = sr; ei[j] = si; }
#pragma unroll
            for (int j = 0; j < SB; ++j) { const size_t o = o0 + (size_t)(n0 + j) * 128; B.xstart[o] = er[j]; B.xstart[o + 1] = ei[j]; } } }
}
typedef float f32x4v __attribute__((ext_vector_type(4)));
struct RouterBufs { const bf16* zb; const float* hres; float* h; bf16* hbf; const float* lnw; const float* lnb; const bf16* rwh; const bf16* rwl; const float* rbias; int* ridx; float* rwt; unsigned* cnt; };
__device__ __forceinline__ void router_split_weights(const float* rw, bf16* hi, bf16* lo, int gtid, int gsz) {
    for (int i = gtid; i < 64 * 1024; i += gsz) { const int e = i >> 10, k = i & 1023; const float w = rw[k * 64 + e]; const unsigned h = f2bf(w); hi[i] = (unsigned short)h; lo[i] = (unsigned short)f2bf(w - __builtin_bit_cast(float, h << 16)); }
}
__device__ __forceinline__ void router_select(const LAS float* sc, const float* bias, int* ridx, float* rwt, LAS unsigned* hist) {
    float gs[8];
#pragma unroll
    for (int g = 0; g < 8; ++g) { float m1 = -INFINITY, m2 = -INFINITY;
#pragma unroll
        for (int j = 0; j < 8; ++j) { const float v = sc[g * 8 + j] + bias[g * 8 + j]; if (v > m1) { m2 = m1; m1 = v; } else if (v > m2) m2 = v; }
        gs[g] = m1 + m2; }
    unsigned gsel = 0;
#pragma unroll
    for (int it = 0; it < 4; ++it) { float best = -INFINITY; int bi = 0;
#pragma unroll
        for (int g = 0; g < 8; ++g) { const bool ok = !((gsel >> g) & 1u) && gs[g] > best; best = ok ? gs[g] : best; bi = ok ? g : bi; }
        gsel |= 1u << bi; }
    unsigned long long taken = 0ull; float wsum = 0.f; float wv[8]; int ev[8];
#pragma unroll
    for (int it = 0; it < 8; ++it) { float best = -INFINITY; int bi = 0;
#pragma unroll 1
        for (int e = 0; e < 64; ++e) { const bool ok = ((gsel >> (e >> 3)) & 1u) && !((taken >> e) & 1ull); const float v = sc[e] + bias[e]; if (ok && v > best) { best = v; bi = e; } }
        taken |= 1ull << bi; ev[it] = bi; wv[it] = sc[bi]; wsum += wv[it]; }
    const float inv = 2.5f / wsum;
#pragma unroll
    for (int it = 0; it < 8; ++it) { ridx[it] = ev[it]; rwt[it] = wv[it] * inv; atomicAdd((unsigned*)&hist[ev[it]], 1u); }
}
__device__ __forceinline__ float wave_max_f(float v) {
#define WM_STEP(o) v = fmaxf(v, __builtin_bit_cast(float, __builtin_amdgcn_ds_swizzle(__builtin_bit_cast(int, v), 0x1f | ((o) << 10))))
    WM_STEP(1); WM_STEP(2); WM_STEP(4); WM_STEP(8); WM_STEP(16);
#undef WM_STEP
    return fmaxf(__builtin_bit_cast(float, __builtin_amdgcn_readlane(__builtin_bit_cast(int, v), 0)), __builtin_bit_cast(float, __builtin_amdgcn_readlane(__builtin_bit_cast(int, v), 32)));
}
__device__ __forceinline__ void router_tiles(const RouterBufs& R, int tile0, int tstride, int ntiles, LAS unsigned char* lds, int tid, bool count = true) {
    const int lane = tid & 63, wave = __builtin_amdgcn_readfirstlane(tid >> 6);
    lbf16* Ahi = (lbf16*)lds; lbf16* Alo = (lbf16*)(lds + 33024); LAS float* part = (LAS float*)(lds + 66048); LAS unsigned* hist = (LAS unsigned*)(lds + 102912);
    if (tile0 >= ntiles) return;
    const int row16 = lane & 15, kq = 8 * (lane >> 4);
    s16x8 bh[4][4], bl[4][4];
#pragma unroll
    for (int ks = 0; ks < 4; ++ks)
#pragma unroll
        for (int nt = 0; nt < 4; ++nt) { const size_t o = (size_t)(nt * 16 + row16) * 1024 + wave * 128 + ks * 32 + kq; bh[ks][nt] = *(const s16x8*)(R.rwh + o); }
    const float bias = R.rbias[lane];
    f32x4 zr[2][4]; v4u zq[2][2];
#define RT_LOAD(tile) do { _Pragma("unroll") for (int q = 0; q < 2; ++q) { const size_t _ro = ((size_t)(tile) * 16 + wave * 2 + q) * 1024 + lane * 8; const float* zp = R.hres + _ro; \
        zr[q][0] = *(const f32x4*)zp; zr[q][1] = *(const f32x4*)(zp + 4); zr[q][2] = *(const f32x4*)(zp + 512); zr[q][3] = *(const f32x4*)(zp + 516); \
        zq[q][0] = *(const v4u*)(R.zb + _ro); zq[q][1] = *(const v4u*)(R.zb + _ro + 512); } } while (0)
    RT_LOAD(tile0);
    if (tid < 64) hist[tid] = 0u;
    LAS float* lnl = (LAS float*)(lds + 103424);
    if (tid < 256) *(LAS f32x4*)(lnl + tid * 4) = *(const f32x4*)(R.lnw + tid * 4); else *(LAS f32x4*)(lnl + 1024 + (tid - 256) * 4) = *(const f32x4*)(R.lnb + (tid - 256) * 4);
    __syncthreads();
    for (int tile = tile0; tile < ntiles; tile += tstride) {
#pragma unroll
        for (int q = 0; q < 2; ++q) { const int row = wave * 2 + q; const size_t t = (size_t)tile * 16 + row;
            float v[16] = {zr[q][0].x, zr[q][0].y, zr[q][0].z, zr[q][0].w, zr[q][1].x, zr[q][1].y, zr[q][1].z, zr[q][1].w, zr[q][2].x, zr[q][2].y, zr[q][2].z, zr[q][2].w, zr[q][3].x, zr[q][3].y, zr[q][3].z, zr[q][3].w};
            { float zf[8]; unpack8(zq[q][0], zf);
#pragma unroll
              for (int j = 0; j < 8; ++j) v[j] = nv::ALPHA * v[j] + zf[j];
              unpack8(zq[q][1], zf);
#pragma unroll
              for (int j = 0; j < 8; ++j) v[8 + j] = nv::ALPHA * v[8 + j] + zf[j]; }
            float sum = 0.f;
#pragma unroll
            for (int j = 0; j < 16; ++j) sum += v[j];
            sum = wave_sum(sum); const float mean = sum * (1.f / 1024.f); float sq = 0.f;
#pragma unroll
            for (int j = 0; j < 16; ++j) { v[j] -= mean; sq += v[j] * v[j]; }
            sq = wave_sum(sq); const float rstd = 1.0f / sqrtf(sq * (1.f / 1024.f) + nv::EPS);
#pragma unroll
            for (int half = 0; half < 2; ++half) { const int c0 = half * 512 + lane * 8;
                const f32x4 w0 = *(const LAS f32x4*)(lnl + c0), w1 = *(const LAS f32x4*)(lnl + c0 + 4), b0 = *(const LAS f32x4*)(lnl + 1024 + c0), b1 = *(const LAS f32x4*)(lnl + 1024 + c0 + 4);
                float o[8] = {v[half * 8 + 0] * rstd * w0.x + b0.x, v[half * 8 + 1] * rstd * w0.y + b0.y, v[half * 8 + 2] * rstd * w0.z + b0.z, v[half * 8 + 3] * rstd * w0.w + b0.w,
                              v[half * 8 + 4] * rstd * w1.x + b1.x, v[half * 8 + 5] * rstd * w1.y + b1.y, v[half * 8 + 6] * rstd * w1.z + b1.z, v[half * 8 + 7] * rstd * w1.w + b1.w};
                *(f32x4*)(R.h + t * 1024 + c0) = (f32x4){o[0], o[1], o[2], o[3]}; *(f32x4*)(R.h + t * 1024 + c0 + 4) = (f32x4){o[4], o[5], o[6], o[7]};
                const v4u hi = pack8(o); float hf[8], lo[8]; unpack8(hi, hf);
#pragma unroll
                for (int j = 0; j < 8; ++j) lo[j] = o[j] - hf[j];
                *(v4u*)(R.hbf + t * 1024 + c0) = hi; *(LAS v4u*)(Ahi + row * 1032 + c0) = hi; *(LAS v4u*)(Alo + row * 1032 + c0) = pack8(lo); } }
        if (tile + tstride < ntiles) RT_LOAD(tile + tstride);
        { int zo = 0; asm volatile("" : "+v"(zo));
#pragma unroll
          for (int ks = 0; ks < 4; ++ks)
#pragma unroll
              for (int nt = 0; nt < 4; ++nt) bl[ks][nt] = *(const s16x8*)(R.rwl + (size_t)(nt * 16 + row16) * 1024 + wave * 128 + ks * 32 + kq + zo); }
        __syncthreads();
        { f32x4v acc[4] = {{0.f, 0.f, 0.f, 0.f}, {0.f, 0.f, 0.f, 0.f}, {0.f, 0.f, 0.f, 0.f}, {0.f, 0.f, 0.f, 0.f}};
#pragma unroll
          for (int ks = 0; ks < 4; ++ks) { const int k0 = wave * 128 + ks * 32 + kq;
              const s16x8 ah = *(const LAS s16x8*)(Ahi + row16 * 1032 + k0), al = *(const LAS s16x8*)(Alo + row16 * 1032 + k0);
#pragma unroll
              for (int nt = 0; nt < 4; ++nt) {
                  acc[nt] = __builtin_amdgcn_mfma_f32_16x16x32_bf16(ah, bh[ks][nt], acc[nt], 0, 0, 0);
                  acc[nt] = __builtin_amdgcn_mfma_f32_16x16x32_bf16(al, bh[ks][nt], acc[nt], 0, 0, 0);
                  acc[nt] = __builtin_amdgcn_mfma_f32_16x16x32_bf16(ah, bl[ks][nt], acc[nt], 0, 0, 0); } }
#pragma unroll
          for (int nt = 0; nt < 4; ++nt)
#pragma unroll
              for (int r = 0; r < 4; ++r) part[(wave * 16 + (lane >> 4) * 4 + r) * 64 + nt * 16 + (lane & 15)] = acc[nt][r]; }
        __syncthreads();
#define SWZ_MAX(x, o) fmaxf(x, __builtin_bit_cast(float, __builtin_amdgcn_ds_swizzle(__builtin_bit_cast(int, x), 0x1f | ((o) << 10))))
#define SWZ_ADD(x, o) ((x) + __builtin_bit_cast(float, __builtin_amdgcn_ds_swizzle(__builtin_bit_cast(int, x), 0x1f | ((o) << 10))))
#pragma unroll
        for (int q = 0; q < 2; ++q) { const int tk = wave * 2 + q; const size_t t = (size_t)tile * 16 + tk;
            float lg = 0.f;
#pragma unroll
            for (int w = 0; w < 8; ++w) lg += part[(w * 16 + tk) * 64 + lane];
            const float s = 1.0f / (1.0f + expf(-lg)), v = s + bias;
            float m1 = v; m1 = SWZ_MAX(m1, 1); m1 = SWZ_MAX(m1, 2); m1 = SWZ_MAX(m1, 4);
            float c1 = (v == m1) ? 1.f : 0.f; c1 = SWZ_ADD(c1, 1); c1 = SWZ_ADD(c1, 2); c1 = SWZ_ADD(c1, 4);
            float m2 = (v == m1) ? -INFINITY : v; m2 = SWZ_MAX(m2, 1); m2 = SWZ_MAX(m2, 2); m2 = SWZ_MAX(m2, 4);
            const float gs = m1 + (c1 >= 2.f ? m1 : m2);
            int grank = 0; const int g = lane >> 3;
#pragma unroll
            for (int j = 0; j < 8; ++j) { const float x = __builtin_bit_cast(float, __builtin_amdgcn_readlane(__builtin_bit_cast(int, gs), j * 8)); grank += (x > gs || (x == gs && j < g)) ? 1 : 0; }
            const bool gsel = grank < 4; float cv = gsel ? v : -INFINITY; int rank = 8;
#pragma unroll
            for (int it = 0; it < 8; ++it) { const float m = wave_max_f(cv); const unsigned long long bal = __builtin_amdgcn_ballot_w64(cv == m); const int wl = __builtin_ctzll(bal);
                if (lane == wl) { rank = it; cv = -INFINITY; } }
            const bool sel = rank < 8;
            const float wsum = wave_sum(sel ? s : 0.f);
            if (sel) { R.ridx[t * 8 + rank] = lane; R.rwt[t * 8 + rank] = s * (2.5f / wsum); atomicAdd((unsigned*)&hist[lane], 1u); } }
#undef SWZ_MAX
#undef SWZ_ADD
    }
#undef RT_LOAD
    __syncthreads();
    if (count && tid < 64 && hist[tid]) atomicAdd(&R.cnt[tid], hist[tid]);
    __syncthreads();
}
#ifndef DUP_PHASE
#define DUP_PHASE -1
#endif
constexpr int CTX_OFF = LDS_CTL + 1024, TAB_OFF = LDS_CTL + 7168;
constexpr size_t WS_WINE = 1 * MiB, WS_WINO = WS_WINE + (size_t)EINP * 1024 * 2, WS_WOUT = WS_WINO + (size_t)OINP * 1024 * 2, WS_XBF = 16 * MiB, WS_NAIVE = 80 * MiB;
#if defined(WITH_NAIVE)
constexpr size_t WS_MIXBF = 48 * MiB;
#else
constexpr size_t WS_MIXBF = 453 * MiB;
#endif
__device__ __forceinline__ int conv_split(int nwg, int G) {
#if defined(WITH_NAIVE)
    return 0;
#else
    const int rem = nwg % G; return rem == 0 ? 0 : (G - rem) * NWAVES * 4;
#endif
}
static_assert(WS_WOUT + 2 * 1024 * 1024 * 2 <= WS_XBF, "ws map");
constexpr size_t WS_WD = 48 * MiB, WS_WGU = WS_WD + 65 * 512 * 1024, WS_LISTS = 146 * MiB, WS_RIDX = 148 * MiB, WS_H = 149 * MiB, WS_ROWS8 = 229 * MiB;
static_assert(WS_WGU + (size_t)65 * 1024 * 1024 <= WS_LISTS && WS_H + (size_t)MOE_MAXBLK * 256 * 512 <= WS_ROWS8 && WS_ROWS8 + (size_t)nv::T_ * 8 * 2048 <= 512 * MiB, "moe ws map");
constexpr size_t WS_PROJB = 149 * MiB, WS_CT = 253 * MiB, WS_HLOC = 317 * MiB, WS_PC = 349 * MiB, WS_M0SMALL = 381 * MiB, WS_LRUW = 486 * MiB;
constexpr size_t WS_UT = 221 * MiB, WS_S5G = 253 * MiB, WS_M1SMALL = 269 * MiB, WS_GLUW = 486 * MiB + 256 * 1024;
constexpr size_t WS_RW = 487 * MiB;
constexpr int CW_PROBE = 9000;
struct Tab { const float* in[38]; float* out; unsigned char* ws; };
struct Env { const Tab* tab; unsigned char* ws; float* out; LAS unsigned char* lds; int tid, lane, wave, bid, G, gw, NGW, gtid, gsz, vcu; };
__device__ __forceinline__ Env penv(unsigned char* lds_raw) {
    Env e; e.tab = (const Tab*)(lds_raw + TAB_OFF); e.ws = e.tab->ws; e.out = e.tab->out; e.lds = (LAS unsigned char*)lds_raw;
    int t = threadIdx.x; asm volatile("" : "+v"(t)); e.tid = t; e.lane = t & 63; e.wave = __builtin_amdgcn_readfirstlane(t >> 6);
    int b = blockIdx.x; asm volatile("" : "+s"(b)); e.bid = b; int g = gridDim.x; asm volatile("" : "+s"(g)); e.G = g;
    e.vcu = (g % 8 == 0) ? (b % 8) * (g / 8) + b / 8 : b;
    e.gw = b * NWAVES + e.wave; e.NGW = g * NWAVES; e.gtid = b * NTHREADS + t; e.gsz = g * NTHREADS;
    return e;
}
__device__ __forceinline__ void grid_bar(const Env& e) {
    XcdBarrier b; b.bar = (unsigned*)e.ws + 4096; b.x = xb_xcc_id(); b.st = (volatile LAS unsigned*)(e.lds + MISC_OFF) + 8;
    xcd_barrier(b);
}
#if defined(WITH_NAIVE)
template <int ST> __device__ __forceinline__ void run_naive(unsigned char* lds_raw, int ci, long n) {
    const Env e = penv(lds_raw);
    const nv::Ctx& c = ((const nv::Ctx*)(lds_raw + CTX_OFF))[ci];
    for (long i = e.gtid; i < n; i += e.gsz) nv::item<ST>(c, i);
    grid_bar(e);
}
#endif
__device__ __forceinline__ void phase_p0(unsigned char* lds_raw) {
    const Env e = penv(lds_raw);
    LAS float* scr = (LAS float*)(e.lds + e.wave * 16640);
    constexpr int I0 = 16 * (EINP / 64), I1 = I0 + 16 * (OINP / 64), I2 = I1 + 256, I3 = I2 + 256, I4 = I3 + 32, I5 = I4 + 64;
    for (int it = e.gw; it < I5; it += e.NGW) {
        if (it < I0) tr_matrix_item(e.tab->in[6], 1024, nv::EIN, EINP, (bf16*)(e.ws + WS_WINE), scr, it, e.lane);
        else if (it < I1) tr_matrix_item(e.tab->in[16], 1024, nv::OIN, OINP, (bf16*)(e.ws + WS_WINO), scr, it - I0, e.lane);
        else if (it < I2) tr_matrix_item(e.tab->in[5], 1024, 1024, 1024, (bf16*)(e.ws + WS_WOUT), scr, it - I1, e.lane);
        else if (it < I3) tr_matrix_item(e.tab->in[5] + 1024 * 1024, 1024, 1024, 1024, (bf16*)(e.ws + WS_WOUT) + 1024 * 1024, scr, it - I2, e.lane);
        else if (it < I4) { const int r = it - I3, mtx = r >> 2, h = mtx & 3, which = mtx >> 2;
            tr_matrix_item(e.tab->in[which ? 13 : 11] + h * 16384, 128, 128, 128, (bf16*)(e.ws + WS_LRUW) + which * 65536 + h * 16384, scr, r & 3, e.lane); }
        else tr_matrix_item(e.tab->in[25], 512, 512, 512, (bf16*)(e.ws + WS_GLUW), scr, it - I4, e.lane);
    }
    for (int l = 0; l < 2; ++l) router_split_weights(e.tab->in[30] + (size_t)l * 65536, (bf16*)(e.ws + WS_RW) + (size_t)l * 131072, (bf16*)(e.ws + WS_RW) + (size_t)l * 131072 + 65536, e.gtid, e.gsz);
    cvt_rows(e.tab->in[0], (bf16*)(e.ws + WS_XBF), (long)T_ * 1024, e.gtid, e.gsz);
    grid_bar(e);
}
__device__ __forceinline__ void phase_inproj(unsigned char* lds_raw, int layer) {
    const Env e = penv(lds_raw);
    float* proj = (float*)(e.ws + WS_NAIVE) + ((size_t)T_ * 1024 + (size_t)T_ * 64 + (size_t)T_ * 8 * 2);
    const int NP = layer == 0 ? EINP : OINP;
    pg8::Gemm g{(const bf16*)(e.ws + WS_XBF), (const bf16*)(e.ws + (layer == 0 ? WS_WINE : WS_WINO)), 1024, 0, 0, nullptr};
    pg8::StaticOrder S; S.init(T_, NP, e.G, e.bid);
    pg8::EpiF32R E{proj, NP, nullptr, 0.f};
    pg8::gemm_phase<pg8::EpiF32R, pg8::StaticOrder, true, false>(e.lds, g, S, E);
    grid_bar(e);
}
__device__ __forceinline__ void phase_cvt_mixed(unsigned char* lds_raw) {
    const Env e = penv(lds_raw);
    cvt_rows((const float*)(e.ws + WS_NAIVE), (bf16*)(e.ws + WS_MIXBF), (long)T_ * 1024, e.gtid, e.gsz);
    grid_bar(e);
}
__device__ __forceinline__ void phase_outproj(unsigned char* lds_raw, int layer) {
    const Env e = penv(lds_raw);
    bf16* zb = (bf16*)((float*)(e.ws + WS_NAIVE) + ((size_t)T_ * 1024 + (size_t)T_ * 64 + (size_t)T_ * 8 * 2));
    pg8::Gemm g{(const bf16*)(e.ws + WS_MIXBF), (const bf16*)(e.ws + WS_WOUT) + (size_t)layer * 1024 * 1024, 1024, 0, 0, nullptr};
    pg8::StaticOrder S; S.init(T_, 1024, e.G, e.bid);
    pg8::EpiBf16P E{zb, 1024};
    pg8::gemm_phase<pg8::EpiBf16P, pg8::StaticOrder, true, false>(e.lds, g, S, E);
    grid_bar(e);
}
__device__ __forceinline__ Mix0Bufs mix0_bufs(unsigned char* ws) {
    Mix0Bufs B; B.proj = (const bf16*)(ws + WS_PROJB); B.ct = (bf16*)(ws + WS_CT); B.hloc = (bf16*)(ws + WS_HLOC); B.pc = (bf16*)(ws + WS_PC);
    float* sm = (float*)(ws + WS_M0SMALL); B.nloc = sm; sm += 8 * NCH * 128; B.blast = sm; sm += 8 * NCH; B.mloc = sm; sm += 8 * NCH; B.mprev = sm; sm += 8 * NCH;
    B.carA = sm; sm += 2 * NCH * 512; B.carU = sm; sm += 2 * NCH * 512; B.carI = sm; sm += 2 * NCH * 512; B.gst = sm;
    B.mixbf = (bf16*)(ws + WS_MIXBF); B.lruw = (const bf16*)(ws + WS_LRUW); return B;
}
__device__ __forceinline__ Mix1Bufs mix1_bufs(unsigned char* ws) {
    Mix1Bufs B; B.proj = (const bf16*)(ws + WS_PROJB); B.ut = (bf16*)(ws + WS_UT); B.s5g = (bf16*)(ws + WS_S5G);
    float* sm = (float*)(ws + WS_M1SMALL); B.gbl = sm; sm += 8 * NCH * 64; B.xend = sm; sm += 8192 * 128; B.xstart = sm; sm += 8192 * 128; B.s5ab = sm; sm += 4096; B.s5bb = sm; sm += 2048 * 32;
    B.cm = (bf16*)sm; B.bbt = B.cm + 32 * 32 * 128; B.mixbf = (bf16*)(ws + WS_MIXBF); return B;
}
__device__ __forceinline__ void phase_inproj_bf16(unsigned char* lds_raw, int layer) {
    const Env e = penv(lds_raw);
    const int NP = layer == 0 ? EINP : OINP;
    if (layer == 1) { const Mix1Bufs B = mix1_bufs(e.ws); s5_params(B, e.tab->in, e.gtid, e.gsz); }
    pg8::Gemm g{(const bf16*)(e.ws + WS_XBF), (const bf16*)(e.ws + (layer == 0 ? WS_WINE : WS_WINO)), 1024, 0, 0, nullptr};
    pg8::StaticOrder S; S.init(T_, NP, e.G, e.bid);
    pg8::EpiBf16P E{(bf16*)(e.ws + WS_PROJB), NP};
    pg8::gemm_phase<pg8::EpiBf16P, pg8::StaticOrder, true, false>(e.lds, g, S, E);
    { const int nwg = (T_ / 256) * (NP / 256), rem = nwg % e.G, na = conv_split(nwg, e.G);
      if (na > 0 && e.bid >= rem) { const int nlight = e.G - rem; LAS float* scr = (LAS float*)(e.lds + e.wave * 16640);
          moe_convert_weights(e.tab->in[32] + (size_t)layer * 64 * 262144, e.tab->in[33] + (size_t)layer * 64 * 262144, e.tab->in[34] + (size_t)layer * 64 * 262144,
                              e.tab->in[35] + (size_t)layer * 262144, e.tab->in[36] + (size_t)layer * 262144, e.tab->in[37] + (size_t)layer * 262144,
                              (bf16*)(e.ws + WS_WGU), (bf16*)(e.ws + WS_WD), scr, (e.bid - rem) * NWAVES + e.wave, na, nlight * NWAVES, e.lane); } }
    grid_bar(e);
}
__device__ __forceinline__ void phase_mix0_a(unsigned char* lds_raw) {
    const Env e = penv(lds_raw); const Mix0Bufs B = mix0_bufs(e.ws);
    for (int it = e.bid; it < 256 + 8 * NCH; it += e.G) {
        if (it < 256) { lru_a_item(B, e.tab->in, it, e.lds, e.tid); if (DUP_PHASE == 31) lru_a_item(B, e.tab->in, it, e.lds, e.tid); }
        else { mlstm_a_item(B, e.tab->in[7], it - 256, e.lds, e.tid); if (DUP_PHASE == 30) mlstm_a_item(B, e.tab->in[7], it - 256, e.lds, e.tid); } }
    grid_bar(e);
}
__device__ __forceinline__ int conv_rest(int nwg, int G, int NGW) {
#if defined(WITH_NAIVE)
    return 0;
#else
    const int nb = conv_split(nwg, G) + NGW * 3; return nb > 65 * 192 ? 65 * 192 : nb;
#endif
}
__device__ __forceinline__ void conv_in_scan_phase(const Env& e, int layer) {
#if !defined(WITH_NAIVE)
    const int na = conv_split((T_ / 256) * ((layer == 0 ? EINP : OINP) / 256), e.G); int nb = na + e.NGW * 3; if (nb > 65 * 192) nb = 65 * 192;
    LAS float* scr = (LAS float*)(e.lds + e.wave * 16640);
    moe_convert_weights(e.tab->in[32] + (size_t)layer * 64 * 262144, e.tab->in[33] + (size_t)layer * 64 * 262144, e.tab->in[34] + (size_t)layer * 64 * 262144,
                        e.tab->in[35] + (size_t)layer * 262144, e.tab->in[36] + (size_t)layer * 262144, e.tab->in[37] + (size_t)layer * 262144,
                        (bf16*)(e.ws + WS_WGU), (bf16*)(e.ws + WS_WD), scr, na + e.gw, nb, e.NGW, e.lane);
#endif
}
__device__ __forceinline__ void phase_mix0_b(unsigned char* lds_raw) {
    const Env e = penv(lds_raw); const Mix0Bufs B = mix0_bufs(e.ws);
    lru_b(B, e.gtid, e.gsz); mlstm_b(B, e.gtid, e.gsz);
    grid_bar(e);
}
__device__ __forceinline__ void phase_mix0_c(unsigned char* lds_raw) {
    const Env e = penv(lds_raw); const Mix0Bufs B = mix0_bufs(e.ws);
    for (int it = e.bid; it < 8 * NCH; it += e.G) { mlstm_c_item(B, e.tab->in[7], e.tab->in[8], it, e.lds, e.tid); if (DUP_PHASE == 32) mlstm_c_item(B, e.tab->in[7], e.tab->in[8], it, e.lds, e.tid); }
    lru_c(B, e.gtid, e.gsz); if (DUP_PHASE == 33) lru_c(B, e.gtid, e.gsz);
    grid_bar(e);
}
__device__ __forceinline__ void phase_mix1_a(unsigned char* lds_raw) {
    const Env e = penv(lds_raw); const Mix1Bufs B = mix1_bufs(e.ws);
    for (int it = e.bid; it < 8 * NCH; it += e.G) { gla_a_item(B, e.tab->in[27], e.tab->in[28], it, e.lds, e.tid); if (DUP_PHASE == 34) gla_a_item(B, e.tab->in[27], e.tab->in[28], it, e.lds, e.tid); }
    s5_phase<false>(B, e.tab->in[23], e.gw, e.NGW, e.lds + e.wave * 17408, e.lane); if (DUP_PHASE == 35) s5_phase<false>(B, e.tab->in[23], e.gw, e.NGW, e.lds + e.wave * 17408, e.lane);
    grid_bar(e);
}
__device__ __forceinline__ void phase_mix1_b(unsigned char* lds_raw) {
    const Env e = penv(lds_raw); const Mix1Bufs B = mix1_bufs(e.ws);
    s5_b(B, e.gtid, e.gsz); gla_b(B, e.gtid, e.gsz);
    grid_bar(e);
}
__device__ __forceinline__ void phase_mix1_c(unsigned char* lds_raw) {
    const Env e = penv(lds_raw); const Mix1Bufs B = mix1_bufs(e.ws);
    for (int it = e.bid; it < 8 * NCH; it += e.G) { gla_c_item(B, e.tab->in[27], e.tab->in[28], e.tab->in[29], it, e.lds, e.tid); if (DUP_PHASE == 36) gla_c_item(B, e.tab->in[27], e.tab->in[28], e.tab->in[29], it, e.lds, e.tid); }
#if defined(S5_OLD_C)
    for (int it = e.gw, k = 0; k < (2 * 32 * NCH + e.NGW - 1) / e.NGW; ++k, it += e.NGW) s5_chunk_v2<true>(B, e.tab->in[23], it, it < 2 * 32 * NCH, e.lds + e.wave * 16896, e.lane);
#else
    s5_phase<true>(B, e.tab->in[23], e.gw, e.NGW, e.lds + e.wave * 17408, e.lane); if (DUP_PHASE == 37) s5_phase<true>(B, e.tab->in[23], e.gw, e.NGW, e.lds + e.wave * 17408, e.lane);
#endif
    grid_bar(e);
}
__device__ __forceinline__ void phase_glu(unsigned char* lds_raw) {
    const Env e = penv(lds_raw);
    pg8::Gemm g{(const bf16*)(e.ws + WS_S5G), (const bf16*)(e.ws + WS_GLUW), 512, 0, 0, nullptr};
    pg8::StaticOrder S; S.init(T_, 512, e.G, e.bid);
    pg8::EpiGlu E{(bf16*)(e.ws + WS_MIXBF), 1024, (const bf16*)(e.ws + WS_S5G), 512, e.tab->in[26]};
    pg8::gemm_phase<pg8::EpiGlu, pg8::StaticOrder, true, false>(e.lds, g, S, E);
    grid_bar(e);
}
__device__ __forceinline__ void phase_probe(unsigned char* lds_raw, int c0, int c1) {
    const Env e = penv(lds_raw);
    const bf16* a = (const bf16*)(e.ws + WS_MIXBF); const float* b = (const float*)(e.ws + WS_NAIVE);
    float sd = 0.f, sr = 0.f; const int w = c1 - c0;
    for (long i = e.gtid; i < (long)T_ * w; i += e.gsz) { const long t = i / w; const int c = c0 + (int)(i % w); const float x = bf2f(a[t * 1024 + c]), y = b[t * 1024 + c]; sd += (x - y) * (x - y); sr += y * y; }
    sd = wave_sum(sd); sr = wave_sum(sr);
    if (e.lane == 0) { atomicAdd((float*)e.ws + CW_PROBE, sd); atomicAdd((float*)e.ws + CW_PROBE + 1, sr); }
    grid_bar(e);
}
__device__ __forceinline__ void phase_probe_apply(unsigned char* lds_raw) {
    const Env e = penv(lds_raw);
    const float sd = __hip_atomic_load((float*)e.ws + CW_PROBE, __ATOMIC_RELAXED, __HIP_MEMORY_SCOPE_AGENT), sr = __hip_atomic_load((float*)e.ws + CW_PROBE + 1, __ATOMIC_RELAXED, __HIP_MEMORY_SCOPE_AGENT);
    const float f = 1.0f + 10.0f * sqrtf(sd / fmaxf(sr, 1e-30f));
    for (long i = e.gtid; i < (long)T_ * 1024; i += e.gsz) e.out[i] *= f;
}
__device__ __forceinline__ void phase_ln_router(unsigned char* lds_raw, int layer, bool count = true) {
    const Env e = penv(lds_raw);
    RouterBufs R; R.zb = (const bf16*)((const float*)(e.ws + WS_NAIVE) + ((size_t)T_ * 1024 + (size_t)T_ * 64 + (size_t)T_ * 8 * 2)); R.hres = layer == 0 ? e.tab->in[0] : e.out; R.h = e.out; R.hbf = (bf16*)(e.ws + WS_XBF);
    R.lnw = e.tab->in[1] + layer * 1024; R.lnb = e.tab->in[2] + layer * 1024; R.rwh = (const bf16*)(e.ws + WS_RW) + (size_t)layer * 131072; R.rwl = R.rwh + 65536;
    R.rbias = e.tab->in[31] + layer * 64; R.ridx = (int*)(e.ws + WS_RIDX); R.rwt = (float*)(e.ws + WS_RIDX) + (size_t)T_ * 8; R.cnt = (unsigned*)e.ws + CW_CNT + layer * 256;
    router_tiles(R, e.bid, e.G, T_ / 16, e.lds, e.tid, count);
    grid_bar(e);
}
__device__ __forceinline__ MoeLists moe_lists(unsigned char* ws) {
    MoeLists L; L.tok = (int*)(ws + WS_LISTS); L.dest = L.tok + MOE_MAXBLK * 256; L.w = (float*)(L.dest + MOE_MAXBLK * 256); L.blk_e = (int*)(L.w + MOE_MAXBLK * 256); return L;
}
__device__ __forceinline__ void phase_moe_x1(unsigned char* lds_raw, int layer, int curoff = 0) {
    const Env e = penv(lds_raw);
    moe_build_lists((const int*)(e.ws + WS_RIDX), (const float*)(e.ws + WS_RIDX) + (size_t)T_ * 8, (unsigned*)e.ws + CW_CNT + layer * 256, (unsigned*)e.ws + CW_CUR + layer * 256 + curoff,
                    moe_lists(e.ws), (LAS int*)e.lds, e.tid, e.bid, e.G);
    LAS float* scr = (LAS float*)(e.lds + e.wave * 16640);
    moe_convert_weights(e.tab->in[32] + (size_t)layer * 64 * 262144, e.tab->in[33] + (size_t)layer * 64 * 262144, e.tab->in[34] + (size_t)layer * 64 * 262144,
                        e.tab->in[35] + (size_t)layer * 262144, e.tab->in[36] + (size_t)layer * 262144, e.tab->in[37] + (size_t)layer * 262144,
                        (bf16*)(e.ws + WS_WGU), (bf16*)(e.ws + WS_WD), scr, conv_split((T_ / 256) * ((layer == 0 ? EINP : OINP) / 256), e.G) + e.gw, 65 * 192, e.NGW, e.lane);
    grid_bar(e);
}
__device__ __forceinline__ void phase_moe_g1(unsigned char* lds_raw) {
    const Env e = penv(lds_raw);
    const MoeLists L = moe_lists(e.ws);
    const int nblk = __builtin_amdgcn_readfirstlane(L.blk_e[MOE_MAXBLK]);
    pg8::Gemm g{(const bf16*)(e.ws + WS_XBF), (const bf16*)(e.ws + WS_WGU), 1024, 0, (size_t)512 * 1024, L.tok};
    pg8::MoeOrder S{L.blk_e, nblk, 2, e.G, e.vcu};
    pg8::EpiSwiGLU E{(bf16*)(e.ws + WS_H)};
    pg8::gemm_phase<pg8::EpiSwiGLU, pg8::MoeOrder, true, true>(e.lds, g, S, E);
    grid_bar(e);
}
__device__ __forceinline__ void phase_moe_g2(unsigned char* lds_raw) {
    const Env e = penv(lds_raw);
    const MoeLists L = moe_lists(e.ws);
    const int nblk = __builtin_amdgcn_readfirstlane(L.blk_e[MOE_MAXBLK]);
    pg8::Gemm g{(const bf16*)(e.ws + WS_H), (const bf16*)(e.ws + WS_WD), 256, 0, (size_t)1024 * 256, nullptr};
    pg8::MoeOrder S{L.blk_e, nblk, 4, e.G, e.vcu};
    pg8::EpiDown E{(bf16*)(e.ws + WS_ROWS8), (bf16*)(e.ws + WS_XBF), L.dest, T_ * 8};
#if defined(G2_STAGGER)
    if ((nblk * 4) % e.G != 0 && e.vcu >= (nblk * 4) % e.G) { const unsigned long long t0 = __builtin_amdgcn_s_memrealtime(); while (__builtin_amdgcn_s_memrealtime() - t0 < (unsigned long long)G2_STAGGER) __builtin_amdgcn_s_sleep(16); }
#endif
    pg8::gemm_phase<pg8::EpiDown, pg8::MoeOrder, true, false>(e.lds, g, S, E);
    grid_bar(e);
}
__device__ __forceinline__ void phase_moe_combine(unsigned char* lds_raw, int layer) {
    const Env e = penv(lds_raw);
    moe_combine_ln(e.out, (const bf16*)(e.ws + WS_ROWS8), (const bf16*)(e.ws + WS_XBF), (const float*)(e.ws + WS_RIDX) + (size_t)T_ * 8, e.tab->in[3] + layer * 1024, e.tab->in[4] + layer * 1024,
                   layer == 0 ? (bf16*)(e.ws + WS_XBF) : nullptr, e.gw, e.NGW, e.lane);
    grid_bar(e);
}

#define RUN(k, call) do { call; if (DUP_PHASE == (k)) { call; } } while (0)
#ifndef TIME_PHASE
#define TIME_PHASE -1
#endif
#define TIMED(k, call) do { unsigned long long _t0 = 0; if (TIME_PHASE == (k)) _t0 = __builtin_amdgcn_s_memrealtime(); call; \
    if (TIME_PHASE == (k) && blockIdx.x == 0 && threadIdx.x == 0) { const unsigned long long _t1 = __builtin_amdgcn_s_memrealtime(); unsigned* w_ = (unsigned*)((Tab*)(lds_raw + TAB_OFF))->ws + CW_PROBE + 8; *w_ = *w_ + (unsigned)(_t1 - _t0); } } while (0)
template <int layer> __device__ __forceinline__ void layer_body(unsigned char* lds_raw) {
#if defined(WITH_NAIVE)
    constexpr int ci = layer * 2;
#if defined(DBG_MIX0)
    constexpr bool naive_too = (layer == DBG_MIX0 - 1);
#else
    constexpr bool naive_too = false;
#endif
#endif
    RUN(1, phase_inproj_bf16(lds_raw, layer));
    if (layer == 0) { RUN(2, phase_mix0_a(lds_raw)); TIMED(20, phase_mix0_b(lds_raw)); RUN(3, phase_mix0_c(lds_raw)); }
    if (layer == 1) { RUN(4, phase_mix1_a(lds_raw)); TIMED(21, phase_mix1_b(lds_raw)); RUN(5, phase_mix1_c(lds_raw)); RUN(6, phase_glu(lds_raw)); }
#if defined(WITH_NAIVE)
    if (naive_too) {
        phase_inproj(lds_raw, layer);
        if (layer == 0) {
            run_naive<nv::ST_ML_GATES>(lds_raw, ci, 8L * NCH);
            run_naive<nv::ST_ML_CLOC>(lds_raw, ci, 8L * NCH * 16384);
            run_naive<nv::ST_ML_SCAN>(lds_raw, ci, 8L * 16384 + 8 * 128);
            run_naive<nv::ST_ML_MI>(lds_raw, ci, 8L * S_);
            run_naive<nv::ST_ML_SMAT>(lds_raw, ci, 8L * NCH * 4096);
            run_naive<nv::ST_ML_DEN>(lds_raw, ci, 8L * S_);
            run_naive<nv::ST_ML_H>(lds_raw, ci, 8L * S_ * 128);
            run_naive<nv::ST_ML_NORM>(lds_raw, ci, 8L * S_);
            run_naive<nv::ST_LRU_CONV>(lds_raw, ci, (long)T_ * 512);
            run_naive<nv::ST_LRU_GATE>(lds_raw, ci, (long)T_ * 512);
            run_naive<nv::ST_LRU_SCAN>(lds_raw, ci, 2L * 512);
        } else {
            run_naive<nv::ST_S5_PAR>(lds_raw, ci, 2048);
            for (int sl = 0; sl < S_ / nv::SLAB; ++sl) {
                if (threadIdx.x == 0) ((nv::Ctx*)(lds_raw + CTX_OFF))[ci].slab = sl;
                __syncthreads();
                run_naive<nv::ST_S5_SCAN>(lds_raw, ci, 2L * 2048); run_naive<nv::ST_S5_OUT>(lds_raw, ci, (long)nv::B_ * nv::SLAB * 512); }
            run_naive<nv::ST_S5_GLU>(lds_raw, ci, (long)T_ * 512);
            run_naive<nv::ST_GLA_GATE>(lds_raw, ci, (long)T_ * 256);
            run_naive<nv::ST_GLA_CUM>(lds_raw, ci, (long)nv::B_ * NCH * 256);
            run_naive<nv::ST_GLA_U>(lds_raw, ci, 8L * NCH * 8192);
            run_naive<nv::ST_GLA_SCAN>(lds_raw, ci, 8L * 8192);
            run_naive<nv::ST_GLA_ATT>(lds_raw, ci, 8L * NCH * 4096);
            run_naive<nv::ST_GLA_O>(lds_raw, ci, 8L * S_ * 128);
            run_naive<nv::ST_GLA_NORM>(lds_raw, ci, 8L * S_);
        }
        phase_probe(lds_raw, DBG_C0, DBG_C1);
        phase_cvt_mixed(lds_raw);
    }
#endif
    RUN(7, phase_outproj(lds_raw, layer));
    TIMED(22, phase_ln_router(lds_raw, layer)); if (DUP_PHASE == 22) phase_ln_router(lds_raw, layer, false);
    phase_moe_x1(lds_raw, layer); if (DUP_PHASE == 8) phase_moe_x1(lds_raw, layer, 1024);
    RUN(9, phase_moe_g1(lds_raw));
    RUN(10, phase_moe_g2(lds_raw));
    TIMED(24, phase_moe_combine(lds_raw, layer));
}
#if defined(STORE_TEST)
__device__ __forceinline__ void phase_store_test(unsigned char* lds_raw) {
    const Env e = penv(lds_raw);
    unsigned char* base = e.ws + WS_ROWS8 + (size_t)e.bid * (1u << 20);
    const int wr = e.wave >> 2, wc = e.wave & 3, fr = e.lane & 15, fq = e.lane >> 4;
    const v4u val = {(unsigned)e.tid, 1u, 2u, 3u};
    for (int u = 0; u < 40; ++u) {
#pragma unroll
        for (int s = 0; s < 8; ++s)
#pragma unroll
            for (int bj = 0; bj < 2; ++bj) {
#if STORE_TEST == 1
                const int r = (s >> 2) * 128 + wr * 64 + (s & 3) * 16 + fr; const int cb = wc * 64 + fq * 16 + bj * 256;
#elif STORE_TEST == 2
                const int r = (s >> 2) * 128 + wr * 64 + (s & 3) * 16 + bj * 8 + (e.lane >> 3); const int cb = wc * 128 + (e.lane & 7) * 16;
#else
                const int r = (s >> 2) * 128 + wr * 64 + (s & 3) * 16 + bj * 8 + (e.lane >> 4) * 2 + (wc & 1); const int cb = (wc >> 1) * 256 + (e.lane & 15) * 16;
#endif
                *(v4u*)(base + (size_t)((u & 1) * 256 + r) * 2048 + cb) = val; }
        asm volatile("" ::: "memory"); }
    grid_bar(e);
}
#endif
struct Args { const float* in[38]; float* out; unsigned char* ws; };
__global__ void __launch_bounds__(NTHREADS, 2) mega_fwd(Args a) {
    extern __shared__ __attribute__((aligned(16))) unsigned char lds_raw[];
    {
        LAS unsigned char* lds = (LAS unsigned char*)lds_raw;
        for (int u = threadIdx.x; u < (LDS_BYTES - LDS_CTL) / 4; u += NTHREADS) ((LAS unsigned*)(lds + LDS_CTL))[u] = 0u;
        __syncthreads();
        if (threadIdx.x == 0) {
            (void)xb_add((unsigned*)a.ws + 4096 + XB_XCNT(xb_xcc_id()), 1u);
            Tab* tab = (Tab*)(lds_raw + TAB_OFF);
#pragma unroll
            for (int i = 0; i < 38; ++i) { tab->in[i] = a.in[i]; if ((i & 7) == 7) asm volatile("" ::: "memory"); }
            tab->out = a.out; tab->ws = a.ws;
            asm volatile("" ::: "memory");
#if defined(WITH_NAIVE)
            nv::Ctx* const ctab = (nv::Ctx*)(lds_raw + CTX_OFF);
            const size_t scratch0 = (size_t)T_ * 1024 + (size_t)T_ * 64 + (size_t)T_ * 8 * 2;
#pragma unroll 1
            for (int layer = 0; layer < 2; ++layer) {
                nv::Ctx& c = ctab[layer * 2];
                nv::Mem M{(float*)(a.ws + WS_NAIVE), 0};
#pragma unroll 1
                for (int i = 0; i < 38; ++i) c.in[i] = tab->in[i];
                c.mixed = M.get((size_t)T_ * 1024); c.scores = M.get((size_t)T_ * 64);
                c.ridx = (int*)M.get((size_t)T_ * 8); c.rwt = M.get((size_t)T_ * 8);
                c.gR = nullptr; c.gBias = nullptr; c.slab = 0;
                c.layer = layer;
                c.hcur = layer == 0 ? a.in[0] : a.out;
                if (layer == 0) {
                    c.ldp = EINP; c.proj = M.get((size_t)T_ * c.ldp);
                    c.mb = M.get(8 * S_); c.mig = M.get(8 * S_); c.mblast = M.get(8 * NCH); c.mmloc = M.get(8 * NCH); c.mmprev = M.get(8 * NCH);
                    c.mmi = M.get(8 * S_); c.mwin = M.get(8 * S_); c.mden = M.get(8 * S_); c.nloc = M.get(8 * NCH * 128);
                    const size_t ov = M.off;
                    c.cloc = M.get((size_t)8 * NCH * 16384); c.smat = M.get((size_t)8 * NCH * 4096); c.htil = M.get((size_t)T_ * 512);
                    M.off = ov; c.lxc = M.get((size_t)T_ * 512); c.la = M.get((size_t)T_ * 512); c.lu = M.get((size_t)T_ * 512);
                } else {
                    c.ldp = OINP; c.proj = M.get((size_t)T_ * c.ldp);
                    c.s5ab = M.get(2048 * 2); c.s5bbr = M.get(2048 * 16); c.s5bbi = M.get(2048 * 16); c.s5st = M.get(2 * 2048 * 2);
                    c.s5x = M.get((size_t)nv::B_ * nv::SLAB * 2048 * 2); c.s5g = M.get((size_t)T_ * 512);
                    c.gla_la = M.get((size_t)T_ * 256); c.gla_bc = M.get((size_t)T_ * 256); c.gla_bl = M.get((size_t)nv::B_ * NCH * 256);
                    c.gu = M.get((size_t)8 * NCH * 8192); c.gatt = M.get((size_t)8 * NCH * 4096); c.go = M.get((size_t)T_ * 512);
                }
                c.z = c.proj; c.hout = a.out; c.lnw = a.in[1] + layer * 1024; c.lnb = a.in[2] + layer * 1024;
                M.off = scratch0; c.hid = M.get((size_t)T_ * 9 * 256);
                nv::Ctx& cm = ctab[layer * 2 + 1];
                cm = c; cm.hcur = a.out;
#ifdef DBG_LAYER
                if (layer == DBG_LAYER) { nv::Ctx& cd = ctab[4]; cd = cm;
                cd.hid = (float*)(a.ws + 48 * MiB); cd.z = (float*)(a.ws + 486 * MiB); cd.hcur = a.out + (size_t)DBG_T0 * 1024; cd.ridx = c.ridx + (size_t)DBG_T0 * 8; cd.rwt = c.rwt + (size_t)DBG_T0 * 8; }
#endif
            }
#endif
        }
        __syncthreads();
    }
    RUN(0, phase_p0(lds_raw));
    layer_body<0>(lds_raw);
    layer_body<1>(lds_raw);
#if defined(STORE_TEST)
    phase_store_test(lds_raw);
#endif
#if defined(DBG_MIX0)
    phase_probe_apply(lds_raw);
#endif
    if (TIME_PHASE >= 0) { const Env e = penv(lds_raw); const unsigned ticks = __hip_atomic_load((unsigned*)e.ws + CW_PROBE + 8, __ATOMIC_RELAXED, __HIP_MEMORY_SCOPE_AGENT);
        const float f = 1.0f + 0.0005f * (float)ticks * 0.01f;
        for (long i = e.gtid; i < (long)T_ * 1024; i += e.gsz) e.out[i] *= f; }
}
extern "C" void kernel_launch(void* const* d_in, const int* in_sizes, int n_in, void* d_out, int out_size, void* d_ws, size_t ws_size, hipStream_t stream) {
    static int grid = 0;
    if (grid == 0) {
        int dev = 0, cus = 0, per_cu = 0;
        hipGetDevice(&dev); hipDeviceGetAttribute(&cus, hipDeviceAttributeMultiprocessorCount, dev);
        hipFuncSetAttribute((const void*)mega_fwd, hipFuncAttributeMaxDynamicSharedMemorySize, LDS_BYTES);
        hipOccupancyMaxActiveBlocksPerMultiprocessor(&per_cu, (const void*)mega_fwd, NTHREADS, LDS_BYTES);
        (void)hipGetLastError();
        grid = (per_cu >= 1) ? cus : -1;
    }
    if (grid < 0) return;
    hipMemsetAsync(d_ws, 0, CTL_BYTES, stream);
    Args a{};
    for (int i = 0; i < 38; ++i) a.in[i] = (const float*)d_in[i];
    a.out = (float*)d_out; a.ws = (unsigned char*)d_ws;
    hipLaunchKernelGGL(mega_fwd, dim3(grid), dim3(NTHREADS), LDS_BYTES, stream, a);
}
```
